# Optimizing an MI355X kernel written in HIP

```python
import math
import jax
import jax.numpy as jnp
from jax import lax
import numpy as np

D_MODEL = 1024
BATCH = 16
SEQ = 2048
DEPTH = 4

GRID_W = 64
CTX_LEN = 256
N_MIXERS = 2
N_ATTN_LAYERS = (DEPTH + N_MIXERS - 1) // N_MIXERS
N_HYENA_LAYERS = DEPTH // N_MIXERS
EPS = 1e-6

HEAD_DIM = 64
N_Q_HEADS = D_MODEL // HEAD_DIM
N_KV_HEADS = 4
Q_PER_KV = N_Q_HEADS // N_KV_HEADS
Q_BLOCK = 128
ROPE_THETA = 10000.0
ROPE_PAIRS_PER_AXIS = HEAD_DIM // 4

HY_WIDTH = D_MODEL
HY_SHORT = 3
HY_EMB = 33
HY_BANDS = (HY_EMB - 1) // 2
HY_FFN = 64
HY_FAST_DECAY = 0.3
HY_SLOW_DECAY = 1.5
HY_TARGET = 1e-2

N_EXPERTS = 32
TOP_K = 4
D_EXPERT = D_MODEL
SWIGLU_LIMIT = 7.0
SWIGLU_ALPHA = 1.702
MOE_BLOCK = 128

kernel_name = 'hybrid_gqa_hyena_moe_dit'


def rms_norm(x, g):
    xf = x.astype(jnp.float32)
    y = xf * lax.rsqrt(jnp.mean(xf * xf, axis=-1, keepdims=True) + EPS)
    return (y * g.astype(jnp.float32)).astype(x.dtype)


def modulate(h, shift, scale):
    return h * (1.0 + scale[:, None, :]) + shift[:, None, :]


def axial_rope_angles(n_tokens):
    n_rows = n_tokens // GRID_W
    row = jnp.repeat(jnp.arange(n_rows, dtype=jnp.float32), GRID_W)
    col = jnp.tile(jnp.arange(GRID_W, dtype=jnp.float32), n_rows)
    inv_freq = ROPE_THETA ** (-jnp.arange(ROPE_PAIRS_PER_AXIS, dtype=jnp.float32) / ROPE_PAIRS_PER_AXIS)
    return row[:, None] * inv_freq, col[:, None] * inv_freq


def rope_1d(x, ang):
    cos = jnp.cos(ang)[:, None, :]
    sin = jnp.sin(ang)[:, None, :]
    x1, x2 = jnp.split(x.astype(jnp.float32), 2, axis=-1)
    return jnp.concatenate([x1 * cos - x2 * sin, x2 * cos + x1 * sin], axis=-1)


def rope_2d(x, ang_row, ang_col):
    x_row, x_col = jnp.split(x, 2, axis=-1)
    return jnp.concatenate([rope_1d(x_row, ang_row), rope_1d(x_col, ang_col)], axis=-1).astype(x.dtype)


def split_qkv(p, q_gain, k_gain, with_q):
    B, T, _ = p.shape
    q_cols = N_Q_HEADS * HEAD_DIM if with_q else 0
    kv_cols = N_KV_HEADS * HEAD_DIM
    k = rms_norm(p[..., q_cols:q_cols + kv_cols].reshape(B, T, N_KV_HEADS, HEAD_DIM), k_gain)
    v = p[..., q_cols + kv_cols:].reshape(B, T, N_KV_HEADS, HEAD_DIM)
    q = rms_norm(p[..., :q_cols].reshape(B, T, N_Q_HEADS, HEAD_DIM), q_gain) if with_q else None
    return q, k, v


def gqa_attend(q, k, v):
    B, Tq = q.shape[:2]
    qg = q.reshape(B, Tq, N_KV_HEADS, Q_PER_KV, HEAD_DIM)
    s = jnp.einsum('bqkgd,bskd->bkgqs', qg, k).astype(jnp.float32) * (HEAD_DIM ** -0.5)
    p = jax.nn.softmax(s, axis=-1).astype(v.dtype)
    o = jnp.einsum('bkgqs,bskd->bqkgd', p, v)
    return o.reshape(B, Tq, N_Q_HEADS * HEAD_DIM)


def attention_mixer(h, h_c, w_qkv, q_gain, k_gain, w_o, ang_row, ang_col, ctx_queries):
    B, L, _ = h.shape
    q, k, v = split_qkv(h @ w_qkv, q_gain, k_gain, True)
    q = rope_2d(q, ang_row, ang_col)
    k = rope_2d(k, ang_row, ang_col)
    w_ctx = w_qkv if ctx_queries else w_qkv[:, N_Q_HEADS * HEAD_DIM:]
    q_c, k_c, v_c = split_qkv(h_c @ w_ctx, q_gain, k_gain, ctx_queries)
    k_all = jnp.concatenate([k, k_c], axis=1)
    v_all = jnp.concatenate([v, v_c], axis=1)
    n_blocks = L // Q_BLOCK
    q_blocks = q.reshape(B, n_blocks, Q_BLOCK, N_Q_HEADS, HEAD_DIM).swapaxes(0, 1)
    o = lax.map(lambda qb: gqa_attend(qb, k_all, v_all), q_blocks)
    o = o.swapaxes(0, 1).reshape(B, L, N_Q_HEADS * HEAD_DIM) @ w_o
    o_c = gqa_attend(q_c, k_c, v_c) @ w_o if ctx_queries else None
    return o, o_c


def hyena_filter(n_tokens, w1, b1, w2, b2, w3, b3, sin_freq):
    L = n_tokens
    t = jnp.linspace(0.0, 1.0, L, dtype=jnp.float32)[:, None]
    w = 2.0 * math.pi * jnp.arange(L, dtype=jnp.float32)[:, None] / L
    f = jnp.linspace(1e-4, HY_BANDS - 1, HY_BANDS, dtype=jnp.float32)
    z = jnp.concatenate([t, jnp.cos(f * w), -jnp.sin(f * w)], axis=-1)
    a = jnp.sin(sin_freq * (z @ w1 + b1))
    a = jnp.sin(sin_freq * (a @ w2 + b2))
    filt = (a @ w3 + b3).astype(jnp.float32).reshape(L, 2, HY_WIDTH)
    max_decay = math.log(HY_TARGET) / HY_FAST_DECAY
    min_decay = math.log(HY_TARGET) / HY_SLOW_DECAY
    deltas = jnp.linspace(min_decay, max_decay, HY_WIDTH, dtype=jnp.float32)
    filt = filt * jnp.exp(-t[:, :, None] * jnp.abs(deltas))
    h_fwd, h_bwd = filt[:, 0], filt[:, 1]
    kern = jnp.concatenate([h_fwd, jnp.zeros((1, HY_WIDTH), jnp.float32), h_bwd[:0:-1]], axis=0)
    return kern / (jnp.sum(jnp.abs(kern), axis=0, keepdims=True) + EPS)


def short_conv(u, w, b):
    L = u.shape[1]
    pad = HY_SHORT // 2
    up = jnp.pad(u, ((0, 0), (pad, pad), (0, 0)))
    return sum(up[:, j:j + L] * w[j] for j in range(HY_SHORT)) + b


def long_conv(v, kern, d_bias):
    L = v.shape[1]
    vf = jnp.fft.rfft(v.astype(jnp.float32), n=2 * L, axis=1)
    kf = jnp.fft.rfft(kern, n=2 * L, axis=0)
    y = jnp.fft.irfft(vf * kf[None], n=2 * L, axis=1)[:, :L]
    return (y + v.astype(jnp.float32) * d_bias).astype(v.dtype)


def hyena_mixer(h, w_in, b_in, conv_w, conv_b, w1, b1, w2, b2, w3, b3, sin_freq, d_bias, w_out, b_out):
    u = short_conv(h @ w_in + b_in, conv_w, conv_b)
    x0, x1, v = jnp.split(u, 3, axis=-1)
    kern = hyena_filter(h.shape[1], w1, b1, w2, b2, w3, b3, sin_freq)
    y = x0 * long_conv(v * x1, kern, d_bias)
    return y @ w_out + b_out


def moe_ffn(h, router_w, router_b, w_gu, b_gu, w_down, b_down):
    n, d = h.shape
    logits = (h @ router_w + router_b).astype(jnp.float32)
    top_logit, top_e = lax.top_k(logits, TOP_K)
    gates = jax.nn.softmax(top_logit, axis=-1)
    n_pairs = n * TOP_K
    flat_e = top_e.reshape(-1)
    order = jnp.argsort(flat_e)
    sorted_e = flat_e[order]
    counts = jnp.bincount(flat_e, length=N_EXPERTS)
    padded = (counts + MOE_BLOCK - 1) // MOE_BLOCK * MOE_BLOCK
    pad_end = jnp.cumsum(padded)
    pad_start = pad_end - padded
    start = jnp.cumsum(counts) - counts
    dest = pad_start[sorted_e] + jnp.arange(n_pairs) - start[sorted_e]
    n_blocks = (n_pairs + N_EXPERTS * (MOE_BLOCK - 1) + MOE_BLOCK - 1) // MOE_BLOCK
    xs = jnp.zeros((n_blocks * MOE_BLOCK, d), h.dtype).at[dest].set(h[order // TOP_K])
    blk_e = jnp.minimum(jnp.searchsorted(pad_end, jnp.arange(n_blocks) * MOE_BLOCK, side='right'), N_EXPERTS - 1)

    def expert_block(args):
        xb, e = args
        gu = xb @ w_gu[e] + b_gu[e]
        g = jnp.minimum(gu[:, 0::2], SWIGLU_LIMIT)
        u = jnp.clip(gu[:, 1::2], -SWIGLU_LIMIT, SWIGLU_LIMIT)
        a = (u + 1.0) * g * jax.nn.sigmoid(SWIGLU_ALPHA * g)
        return a @ w_down[e] + b_down[e]

    ys = lax.map(expert_block, (xs.reshape(n_blocks, MOE_BLOCK, d), blk_e)).reshape(-1, d)
    pair_dest = jnp.zeros((n_pairs,), dest.dtype).at[order].set(dest)
    y_pairs = ys[pair_dest].reshape(n, TOP_K, d)
    return jnp.einsum('nk,nkd->nd', gates.astype(y_pairs.dtype), y_pairs)


def setup_inputs(seed: int = 0) -> dict:
    key = jax.random.key(seed)
    ks = iter(jax.random.split(key, 32))

    def nrm(shape, scale):
        return jax.random.normal(next(ks), shape, jnp.float32) * scale

    D, W, E, F = D_MODEL, HY_WIDTH, N_EXPERTS, D_EXPERT
    NA, NH = N_ATTN_LAYERS, N_HYENA_LAYERS
    qkv_cols = (N_Q_HEADS + 2 * N_KV_HEADS) * HEAD_DIM
    return {
        'x': nrm((BATCH, SEQ, D), 1.0),
        'c': nrm((BATCH, D), 1.0),
        'ctx': nrm((BATCH, CTX_LEN, D), 1.0),
        'c_ctx': nrm((D,), 1.0),
        'w_mod': nrm((DEPTH, D, 6 * D), 0.5 * D ** -0.5),
        'b_mod': nrm((DEPTH, 6 * D), 0.01),
        'norm1_g': 1.0 + nrm((DEPTH, D), 0.02),
        'norm2_g': 1.0 + nrm((DEPTH, D), 0.02),
        'attn_w_qkv': nrm((NA, D, qkv_cols), D ** -0.5),
        'attn_q_gain': 1.0 + nrm((NA, HEAD_DIM), 0.02),
        'attn_k_gain': 1.0 + nrm((NA, HEAD_DIM), 0.02),
        'attn_w_o': nrm((NA, N_Q_HEADS * HEAD_DIM, D), (N_Q_HEADS * HEAD_DIM) ** -0.5),
        'hy_w_in': nrm((NH, D, 3 * W), D ** -0.5),
        'hy_b_in': nrm((NH, 3 * W), 0.01),
        'hy_conv_w': nrm((NH, HY_SHORT, 3 * W), HY_SHORT ** -0.5),
        'hy_conv_b': nrm((NH, 3 * W), 0.01),
        'hy_filt_w1': nrm((NH, HY_EMB, HY_FFN), HY_EMB ** -0.5),
        'hy_filt_b1': nrm((NH, HY_FFN), 0.1),
        'hy_filt_w2': nrm((NH, HY_FFN, HY_FFN), HY_FFN ** -0.5),
        'hy_filt_b2': nrm((NH, HY_FFN), 0.1),
        'hy_filt_w3': nrm((NH, HY_FFN, 2 * W), HY_FFN ** -0.5),
        'hy_filt_b3': nrm((NH, 2 * W), 0.1),
        'hy_sin_freq': 1.0 + nrm((NH, HY_FFN), 0.02),
        'hy_d_bias': nrm((NH, W), 0.5),
        'hy_w_out': nrm((NH, W, D), W ** -0.5),
        'hy_b_out': nrm((NH, D), 0.01),
        'moe_router_w': nrm((DEPTH, D, E), D ** -0.5),
        'moe_router_b': nrm((DEPTH, E), 0.01),
        'moe_w_gu': nrm((DEPTH, E, D, 2 * F), D ** -0.5),
        'moe_b_gu': nrm((DEPTH, E, 2 * F), 0.01),
        'moe_w_down': nrm((DEPTH, E, F, D), F ** -0.5),
        'moe_b_down': nrm((DEPTH, E, D), 0.01),
    }


def reference(x, c, ctx, c_ctx, w_mod, b_mod, norm1_g, norm2_g, attn_w_qkv, attn_q_gain, attn_k_gain, attn_w_o, hy_w_in, hy_b_in, hy_conv_w, hy_conv_b, hy_filt_w1, hy_filt_b1, hy_filt_w2, hy_filt_b2, hy_filt_w3, hy_filt_b3, hy_sin_freq, hy_d_bias, hy_w_out, hy_b_out, moe_router_w, moe_router_b, moe_w_gu, moe_b_gu, moe_w_down, moe_b_down):
    B, L, D = x.shape
    ang_row, ang_col = axial_rope_angles(L)
    n_lat = B * L
    for i in range(DEPTH):
        j = i // N_MIXERS
        is_attn = i % N_MIXERS == 0
        ctx_live = any(m % N_MIXERS == 0 for m in range(i + 1, DEPTH))
        mod = jnp.split(jax.nn.silu(c) @ w_mod[i] + b_mod[i], 6, axis=-1)
        mod_c = jnp.split(jax.nn.silu(c_ctx)[None] @ w_mod[i] + b_mod[i], 6, axis=-1)
        h = modulate(rms_norm(x, norm1_g[i]), mod[0], mod[1])
        if is_attn or ctx_live:
            h_c = modulate(rms_norm(ctx, norm1_g[i]), mod_c[0], mod_c[1])
        if is_attn:
            o, o_c = attention_mixer(h, h_c, attn_w_qkv[j], attn_q_gain[j], attn_k_gain[j], attn_w_o[j], ang_row, ang_col, ctx_live)
        else:
            hy = (hy_w_in[j], hy_b_in[j], hy_conv_w[j], hy_conv_b[j], hy_filt_w1[j], hy_filt_b1[j], hy_filt_w2[j], hy_filt_b2[j], hy_filt_w3[j], hy_filt_b3[j], hy_sin_freq[j], hy_d_bias[j], hy_w_out[j], hy_b_out[j])
            o = hyena_mixer(h, *hy)
            o_c = hyena_mixer(h_c, *hy) if ctx_live else None
        x = x + mod[2][:, None, :] * o
        h = modulate(rms_norm(x, norm2_g[i]), mod[3], mod[4])
        moe = (moe_router_w[i], moe_router_b[i], moe_w_gu[i], moe_b_gu[i], moe_w_down[i], moe_b_down[i])
        if ctx_live:
            ctx = ctx + mod_c[2][:, None, :] * o_c
            h_c = modulate(rms_norm(ctx, norm2_g[i]), mod_c[3], mod_c[4])
            y = moe_ffn(jnp.concatenate([h.reshape(n_lat, D), h_c.reshape(-1, D)], axis=0), *moe)
            x = x + mod[5][:, None, :] * y[:n_lat].reshape(B, L, D)
            ctx = ctx + mod_c[5][:, None, :] * y[n_lat:].reshape(ctx.shape)
        else:
            y = moe_ffn(h.reshape(n_lat, D), *moe)
            x = x + mod[5][:, None, :] * y.reshape(B, L, D)
    return x
```

```cpp
#include <hip/hip_runtime.h>
#include <cstdio>
#include <cstdint>

#ifndef EN_PRO
#define EN_PRO 1
#endif
#ifndef EN_ATT
#define EN_ATT 1
#endif
#ifndef EN_CONV
#define EN_CONV 1
#endif
#ifndef EN_ROUTER
#define EN_ROUTER 1
#endif
#ifndef EN_GEMM
#define EN_GEMM 1
#endif
#ifndef EN_MISC
#define EN_MISC 1
#endif
#ifndef MK_ONE_LAUNCH
#define MK_ONE_LAUNCH 0
#endif

#define GAS __attribute__((address_space(1)))
#define LAS __attribute__((address_space(3)))
typedef unsigned short bf16_t;
typedef short bf16x8 __attribute__((ext_vector_type(8)));
typedef float f32x4 __attribute__((ext_vector_type(4)));
typedef float f32x2 __attribute__((ext_vector_type(2)));
typedef unsigned u32x4 __attribute__((ext_vector_type(4)));
typedef unsigned u32x2 __attribute__((ext_vector_type(2)));
typedef GAS unsigned gu32;
typedef float f32x16 __attribute__((ext_vector_type(16)));

constexpr int D = 1024, NB = 16, SEQ = 2048, CL = 256, KVL = SEQ + CL;
constexpr int NLAT = NB * SEQ, NCTX = NB * CL, NTOK = NLAT + NCTX;
constexpr int NE = 32, TOPK = 4, DEPTH = 4;
constexpr int MODW = 6 * D, NMODROW = NB + 1;
constexpr int NQKV = 1536, NHY = 3072, NGU = 2048;
constexpr float EPS = 1e-6f;
constexpr float C2 = 0.125f * 1.4426950408889634f;
constexpr int NWAVES = 8, NTHR = 512;
constexpr int NPADROWS = 155648;
constexpr int MAXTILES = NPADROWS / 256;

constexpr size_t MiB = 1u << 20;
constexpr size_t WS_CTL = 0, CTL_ZERO_BYTES = 1 * MiB;
constexpr size_t WS_MODP = 2 * MiB;
constexpr size_t WS_MOD = 16 * MiB;
constexpr size_t WS_ROPE = 18 * MiB;
constexpr size_t WS_A2 = 19 * MiB;
constexpr size_t WS_PAIR = 21 * MiB;
constexpr size_t WS_CTX = 24 * MiB;
constexpr size_t WS_FI = 40 * MiB;
constexpr int FP_L = 2 * SEQ + 8, FP_C = 2 * CL + 8;
constexpr size_t FI_L_BYTES = (size_t)1024 * 8 * FP_L * 2, FI_C_BYTES = (size_t)1024 * 8 * FP_C * 2;
constexpr size_t WS_FI0 = WS_FI, WS_FI1 = WS_FI0 + 65 * MiB, WS_FI2 = WS_FI1 + 65 * MiB;
static_assert(FI_L_BYTES <= 65 * MiB && WS_FI2 + FI_C_BYTES <= 180 * MiB, "filter map");
constexpr size_t WS_WQKV = 180 * MiB, WS_WO = 186 * MiB, WS_WIN = 190 * MiB, WS_WOUT = 202 * MiB, WS_WGU = 206 * MiB, WS_WDN = 718 * MiB;
constexpr size_t WS_HA = 974 * MiB;
constexpr size_t WS_Q = 1046 * MiB;
constexpr size_t WS_K = 1118 * MiB, WS_V = 1136 * MiB;
constexpr size_t WS_UPRE = 1154 * MiB;
constexpr size_t WS_WC = 1370 * MiB;
constexpr size_t WS_YC = 1442 * MiB;
constexpr size_t WS_XS = 1514 * MiB;
constexpr size_t WS_AB = 1818 * MiB;
constexpr size_t WS_END = 2122 * MiB;
constexpr size_t WC_CTX_OFF = (size_t)1024 * 16 * 2048;
constexpr int CW_TMO = 0, CW_BAR = 4096, CW_CNT = 16384;

constexpr int LDS_BYTES = 160 * 1024;
constexpr int MISC_OFF = LDS_BYTES - 256;

#define RLX_AGENT __ATOMIC_RELAXED, __HIP_MEMORY_SCOPE_AGENT
#define LDS_WAIT() asm volatile("s_waitcnt lgkmcnt(0)" ::: "memory")
#define VM_WAIT() asm volatile("s_waitcnt vmcnt(0)" ::: "memory")
__device__ __forceinline__ unsigned f2bf(float f) { unsigned u = __builtin_bit_cast(unsigned, f); return (u + 0x7fffu + ((u >> 16) & 1u)) >> 16; }
__device__ __forceinline__ unsigned pk2(float lo, float hi) { return f2bf(lo) | (f2bf(hi) << 16); }
__device__ __forceinline__ float bf2f(unsigned h) { return __builtin_bit_cast(float, h << 16); }
__device__ __forceinline__ float bflo(unsigned w) { return __builtin_bit_cast(float, w << 16); }
__device__ __forceinline__ float bfhi(unsigned w) { return __builtin_bit_cast(float, w & 0xffff0000u); }
__device__ __forceinline__ float wave_sum(float v) {
#pragma unroll
    for (int o = 1; o < 64; o <<= 1) v += __shfl_xor(v, o);
    return v;
}

#define XB_TMO      128
#define XB_XCNT(j)  (256  + 64 * (j))
#define XB_XSUB(j)  (1280 + 64 * (j))
#define XB_XGEN(j)  (2304 + 64 * (j))
#define XB_TOP      3328
#define XB_TOPGEN   3392
#define XCD_BAR_WORDS 3456
#define XB_SPIN_CAP (1u << 22)
__device__ __forceinline__ unsigned xb_ld(unsigned* p)              { return __hip_atomic_load(p, __ATOMIC_RELAXED, __HIP_MEMORY_SCOPE_AGENT); }
__device__ __forceinline__ unsigned xb_add(unsigned* p, unsigned v) { return __hip_atomic_fetch_add(p, v, __ATOMIC_RELAXED, __HIP_MEMORY_SCOPE_AGENT); }
__device__ __forceinline__ unsigned xb_xcc_id() { return (unsigned)__builtin_amdgcn_s_getreg((3 << 11) | 20) & 0xFu; }
#define XB_SPIN(cond, bar) do { unsigned _sp = 0; while (cond) { __builtin_amdgcn_s_sleep(1); \
    if ((++_sp & 255u) == 0u) { if (xb_ld(&(bar)[XB_TMO])) break; if (_sp > XB_SPIN_CAP) { atomicAdd(&(bar)[XB_TMO], 1u); break; } } } } while (0)
struct XcdBarrier { unsigned* bar; unsigned x; volatile LAS unsigned* st; };
__device__ __forceinline__ XcdBarrier xcd_barrier_post(unsigned* bar, volatile LAS unsigned* st) {
    XcdBarrier b; b.bar = bar; b.x = xb_xcc_id(); b.st = st;
    if (threadIdx.x == 0) (void)xb_add(&bar[XB_XCNT(b.x)], 1u);
    return b;
}
__device__ __forceinline__ void xcd_barrier_complete(unsigned* bar, unsigned x, unsigned& nloc, unsigned& nx) {
    const unsigned G = gridDim.x * gridDim.y * gridDim.z;
    unsigned sum, cnt, mine, sp = 0u;
    for (;;) {
        sum = 0u; cnt = 0u; mine = 0u;
#pragma unroll
        for (unsigned j = 0; j < 16; ++j) { const unsigned c = xb_ld(&bar[XB_XCNT(j)]); sum += c; cnt += (c > 0u) ? 1u : 0u; mine = (j == x) ? c : mine; }
        if (sum == G) break;
        __builtin_amdgcn_s_sleep(1);
        if ((++sp & 255u) == 0u) { if (xb_ld(&bar[XB_TMO])) break; if (sp > XB_SPIN_CAP) { atomicAdd(&bar[XB_TMO], 1u); break; } }
    }
    nloc = mine > 0u ? mine : 1u; nx = cnt > 0u ? cnt : 1u;
}
__device__ __forceinline__ void xcd_barrier(const XcdBarrier& b) {
    asm volatile("s_waitcnt vmcnt(0)" ::: "memory");
    __syncthreads();
    if (threadIdx.x == 0) {
        unsigned* bar = b.bar;
        __builtin_amdgcn_s_waitcnt(0);
        unsigned nloc = b.st[0], nx = b.st[1];
        if (nloc == 0u) { xcd_barrier_complete(bar, b.x, nloc, nx); b.st[0] = nloc; b.st[1] = nx; }
        const unsigned old = xb_add(&bar[XB_XSUB(b.x)], 1u);
        const unsigned gen = old / nloc;
        if (old + 1u == (gen + 1u) * nloc) {
            __builtin_amdgcn_fence(__ATOMIC_RELEASE, "agent");
            asm volatile("s_waitcnt vmcnt(0)" ::: "memory");
            const unsigned og = xb_add(&bar[XB_TOP], 1u);
            const unsigned tg = og / nx;
            if (og + 1u == (tg + 1u) * nx) xb_add(&bar[XB_TOPGEN], 1u);
            else XB_SPIN(xb_ld(&bar[XB_TOPGEN]) == tg, bar);
            __builtin_amdgcn_fence(__ATOMIC_ACQUIRE, "agent");
            xb_add(&bar[XB_XGEN(b.x)], 1u);
            asm volatile("s_waitcnt vmcnt(0)" ::: "memory");
        } else {
            XB_SPIN(xb_ld(&bar[XB_XGEN(b.x)]) == gen, bar);
            __builtin_amdgcn_fence(__ATOMIC_ACQUIRE, "agent");
            asm volatile("s_waitcnt vmcnt(0)" ::: "memory");
        }
    }
    __syncthreads();
}

struct Args { const float* in[32]; float* out; unsigned char* ws; int ph_lo, ph_hi; };
struct Ctx {
    LAS unsigned char* lds;
    int tid, lane, wave, G, bid;
    const float* const* in;
};
enum { I_X = 0, I_C, I_CTX, I_CCTX, I_WMOD, I_BMOD, I_N1G, I_N2G, I_WQKV, I_QG, I_KG, I_WO, I_HWIN, I_HBIN, I_HCW, I_HCB, I_HW1, I_HB1, I_HW2, I_HB2, I_HW3, I_HB3,
       I_HSF, I_HDB, I_HWOUT, I_HBOUT, I_RW, I_RB, I_WGU, I_BGU, I_WDN, I_BDN };

__device__ __forceinline__ int mod_row(int r) { return r < NLAT ? (r >> 11) : NB; }

__device__ __forceinline__ void gemm_unit_simple(const bf16_t* At, const bf16_t* Bt, f32x4 (&acc)[2][2][4][2], int wr, int wc, int fr, int fq) {
    constexpr int K = D;
#pragma unroll
    for (int a = 0; a < 2; ++a)
#pragma unroll
        for (int b = 0; b < 2; ++b)
#pragma unroll
            for (int m = 0; m < 4; ++m)
#pragma unroll
                for (int n = 0; n < 2; ++n) acc[a][b][m][n] = (f32x4){0.f, 0.f, 0.f, 0.f};
    const bf16_t* ap = At + (size_t)(wr * 64 + fr) * K + fq * 8;
    const bf16_t* bp = Bt + (size_t)(wc * 32 + fr) * K + fq * 8;
    for (int k0 = 0; k0 < K; k0 += 32) {
        bf16x8 bfr[2][2];
#pragma unroll
        for (int bj = 0; bj < 2; ++bj)
#pragma unroll
            for (int n = 0; n < 2; ++n) bfr[bj][n] = *(const bf16x8*)(bp + (size_t)(bj * 128 + n * 16) * K + k0);
#pragma unroll
        for (int ai = 0; ai < 2; ++ai)
#pragma unroll
            for (int m = 0; m < 4; ++m) {
                const bf16x8 afr = *(const bf16x8*)(ap + (size_t)(ai * 128 + m * 16) * K + k0);
#pragma unroll
                for (int bj = 0; bj < 2; ++bj)
#pragma unroll
                    for (int n = 0; n < 2; ++n) acc[ai][bj][m][n] = __builtin_amdgcn_mfma_f32_16x16x32_bf16(bfr[bj][n], afr, acc[ai][bj][m][n], 0, 0, 0);
            }
    }
}

struct EpiQKV {
    bf16_t *Q, *Kb, *Vb; const float *qg, *kg, *cosT, *sinT;
    __device__ __forceinline__ void operator()(const f32x4 (&acc)[2][2][4][2], int pm, int pn, int wr, int wc, int fr, int fq) const {
        const int kind = pn < 4 ? 0 : (pn == 4 ? 1 : 2);
        const float* gain = kind == 0 ? qg : kg;
        f32x4 gv[2][2];
#pragma unroll
        for (int bj = 0; bj < 2; ++bj)
#pragma unroll
            for (int n = 0; n < 2; ++n) gv[bj][n] = *(const f32x4*)(gain + 32 * bj + 16 * n + 4 * fq);
#pragma unroll
        for (int ai = 0; ai < 2; ++ai)
#pragma unroll
            for (int m = 0; m < 4; ++m) {
                const int r = pm * 256 + ai * 128 + wr * 64 + m * 16 + fr;
                const bool lat = r < NLAT;
                const int b = lat ? (r >> 11) : ((r - NLAT) >> 8);
                const int pos = lat ? (r & (SEQ - 1)) : (SEQ + ((r - NLAT) & (CL - 1)));
                f32x4 v[2][2];
#pragma unroll
                for (int bj = 0; bj < 2; ++bj)
#pragma unroll
                    for (int n = 0; n < 2; ++n) v[bj][n] = acc[ai][bj][m][n];
                if (kind != 2) {
                    float ss = 0.f;
#pragma unroll
                    for (int bj = 0; bj < 2; ++bj)
#pragma unroll
                        for (int n = 0; n < 2; ++n) ss += (v[bj][n][0] * v[bj][n][0] + v[bj][n][1] * v[bj][n][1]) + (v[bj][n][2] * v[bj][n][2] + v[bj][n][3] * v[bj][n][3]);
                    ss += __shfl_xor(ss, 16); ss += __shfl_xor(ss, 32);
                    const float rinv = 1.0f / sqrtf(ss * (1.0f / 64.0f) + EPS);
#pragma unroll
                    for (int bj = 0; bj < 2; ++bj)
#pragma unroll
                        for (int n = 0; n < 2; ++n) v[bj][n] = v[bj][n] * rinv * gv[bj][n];
                    if (lat) {
#pragma unroll
                        for (int bj = 0; bj < 2; ++bj) {
                            const f32x4 cs = *(const f32x4*)(cosT + pos * 32 + bj * 16 + 4 * fq), sn = *(const f32x4*)(sinT + pos * 32 + bj * 16 + 4 * fq);
                            const f32x4 x1 = v[bj][0], x2 = v[bj][1];
                            v[bj][0] = x1 * cs - x2 * sn; v[bj][1] = x2 * cs + x1 * sn;
                        }
                    }
                    if (kind == 0) {
#pragma unroll
                        for (int bj = 0; bj < 2; ++bj)
#pragma unroll
                            for (int n = 0; n < 2; ++n) v[bj][n] = v[bj][n] * C2;
                    }
                }
                bf16_t* dst = kind == 0 ? Q + (size_t)r * D + pn * 256 + wc * 64
                                        : (kind == 1 ? Kb : Vb) + ((size_t)b * KVL + pos) * 256 + wc * 64;
#pragma unroll
                for (int bj = 0; bj < 2; ++bj)
#pragma unroll
                    for (int n = 0; n < 2; ++n) { u32x2 w; w.x = pk2(v[bj][n][0], v[bj][n][1]); w.y = pk2(v[bj][n][2], v[bj][n][3]); *(u32x2*)(dst + 32 * bj + 16 * n + 4 * fq) = w; }
            }
    }
};
struct EpiBiasBf16 {
    bf16_t* O; int ldc; const float* bias;
    __device__ __forceinline__ void operator()(const f32x4 (&acc)[2][2][4][2], int row0, int col0t, int wr, int wc, int fr, int fq) const {
#pragma unroll
        for (int bj = 0; bj < 2; ++bj)
#pragma unroll
            for (int n = 0; n < 2; ++n) {
                const int c = col0t + bj * 128 + wc * 32 + n * 16 + 4 * fq;
                const f32x4 bv = *(const f32x4*)(bias + c);
#pragma unroll
                for (int ai = 0; ai < 2; ++ai)
#pragma unroll
                    for (int m = 0; m < 4; ++m) { const int r = row0 + ai * 128 + wr * 64 + m * 16 + fr; const f32x4 v = acc[ai][bj][m][n] + bv;
                        u32x2 w; w.x = pk2(v[0], v[1]); w.y = pk2(v[2], v[3]); *(u32x2*)(O + (size_t)r * ldc + c) = w; }
            }
    }
};
struct EpiResid {
    const float *srcL, *srcC; float *dstL, *dstC; const float* gate  ; const float* bias;
    __device__ __forceinline__ void operator()(const f32x4 (&acc)[2][2][4][2], int row0, int col0t, int wr, int wc, int fr, int fq) const {
#pragma unroll
        for (int bj = 0; bj < 2; ++bj)
#pragma unroll
            for (int n = 0; n < 2; ++n) {
                const int c = col0t + bj * 128 + wc * 32 + n * 16 + 4 * fq;
                const f32x4 bv = bias ? *(const f32x4*)(bias + c) : (f32x4){0.f, 0.f, 0.f, 0.f};
#pragma unroll
                for (int ai = 0; ai < 2; ++ai)
#pragma unroll
                    for (int m = 0; m < 4; ++m) { const int r = row0 + ai * 128 + wr * 64 + m * 16 + fr;
                        const f32x4 g = *(const f32x4*)(gate + (size_t)mod_row(r) * MODW + c);
                        const float* s = r < NLAT ? srcL + (size_t)r * D : srcC + (size_t)(r - NLAT) * D;
                        float* d = r < NLAT ? dstL + (size_t)r * D : dstC + (size_t)(r - NLAT) * D;
                        const f32x4 x = *(const f32x4*)(s + c);
                        *(f32x4*)(d + c) = x + g * (acc[ai][bj][m][n] + bv); }
            }
    }
};
struct EpiSwiglu {
    bf16_t* O; const float* bgu  ;
    __device__ __forceinline__ void operator()(const f32x4 (&acc)[2][2][4][2], int row0, int pn, int wr, int wc, int fr, int fq) const {
#pragma unroll
        for (int n = 0; n < 2; ++n) {
            const int f = pn * 128 + wc * 32 + n * 16 + 4 * fq;
            const f32x4 b0 = *(const f32x4*)(bgu + 2 * f), b1 = *(const f32x4*)(bgu + 2 * f + 4);
            const f32x4 bg = (f32x4){b0[0], b0[2], b1[0], b1[2]}, bu = (f32x4){b0[1], b0[3], b1[1], b1[3]};
#pragma unroll
            for (int ai = 0; ai < 2; ++ai)
#pragma unroll
                for (int m = 0; m < 4; ++m) { const int r = row0 + ai * 128 + wr * 64 + m * 16 + fr;
                    const f32x4 gg = acc[ai][0][m][n] + bg, uu = acc[ai][1][m][n] + bu; float o[4];
#pragma unroll
                    for (int e = 0; e < 4; ++e) { const float g = fminf(gg[e], 7.0f), u = fminf(fmaxf(uu[e], -7.0f), 7.0f);
                        const float sg = 1.0f / (1.0f + __expf(-1.702f * g)); o[e] = (u + 1.0f) * g * sg; }
                    u32x2 w; w.x = pk2(o[0], o[1]); w.y = pk2(o[2], o[3]); *(u32x2*)(O + (size_t)r * D + f) = w; }
        }
    }
};

template <int MODE> __device__ __forceinline__ int wrow_map(int n) {
    if (MODE == 0) return n;
    if (MODE == 1) { const int pn = n >> 8, wc = (n >> 6) & 3, bj = (n >> 5) & 1, j = n & 31; return (pn << 8) + (bj << 7) + (wc << 5) + j; }
    { const int f = n >> 1, pn = f >> 7, fo = f & 127; return (pn << 8) + ((n & 1) << 7) + fo; }
}
template <int MODE> __device__ __forceinline__ void transpose_item(const float* W, int N, bf16_t* WT, LAS float* scr, int item, int lane) {
    constexpr int K = D;
    const int nblk = N / 32, kb = item / nblk, nb = item % nblk, k0 = 64 * kb, n0 = 32 * nb;
#pragma unroll 8
    for (int i = 0; i < 32; ++i) { const int kk = 2 * i + (lane >> 5); scr[kk * 33 + (lane & 31)] = W[(size_t)(k0 + kk) * N + n0 + (lane & 31)]; }
    LDS_WAIT(); asm volatile("" ::: "memory");
    const int c = lane & 7;
#pragma unroll
    for (int j = 0; j < 4; ++j) { const int n = (lane >> 3) + 8 * j; const LAS float* s = scr + (8 * c) * 33 + n;
        u32x4 o; o.x = pk2(s[0 * 33], s[1 * 33]); o.y = pk2(s[2 * 33], s[3 * 33]); o.z = pk2(s[4 * 33], s[5 * 33]); o.w = pk2(s[6 * 33], s[7 * 33]);
        *(u32x4*)(WT + (size_t)wrow_map<MODE>(n0 + n) * K + k0 + 8 * c) = o; }
    LDS_WAIT(); asm volatile("" ::: "memory");
}

__device__ __forceinline__ void norm_mod_store(const f32x4 (&v)[4], const float* gain, const float* shift, const float* scale, bf16_t* dst, int lane, f32x4 (&h)[4]) {
    float ss = 0.f;
#pragma unroll
    for (int j = 0; j < 4; ++j) ss += (v[j][0] * v[j][0] + v[j][1] * v[j][1]) + (v[j][2] * v[j][2] + v[j][3] * v[j][3]);
    ss = wave_sum(ss);
    const float rinv = 1.0f / sqrtf(ss * (1.0f / D) + EPS);
#pragma unroll
    for (int j = 0; j < 4; ++j) {
        const f32x4 g = ((const f32x4*)gain)[lane + 64 * j], sh = ((const f32x4*)shift)[lane + 64 * j], sc = ((const f32x4*)scale)[lane + 64 * j];
        h[j] = (v[j] * rinv * g) * (sc + 1.0f) + sh;
        u32x2 w; w.x = pk2(h[j][0], h[j][1]); w.y = pk2(h[j][2], h[j][3]);
        ((u32x2*)dst)[lane + 64 * j] = w;
    }
}

#define IN(k) (lo <= (k) && (k) < hi)
#define SEAM(k) do { if (IN(k) && IN((k) + 1)) xcd_barrier(bar); } while (0)
#define KLOCALS \
    const float* x_in = args.in[I_X]; const float* c_in = args.in[I_C]; const float* ctx_in = args.in[I_CTX]; const float* cctx_in = args.in[I_CCTX]; \
    float* out = args.out; \
    float* modp = (float*)(ws + WS_MODP); float* modf = (float*)(ws + WS_MOD); \
    float* cosT = (float*)(ws + WS_ROPE); float* sinT = cosT + SEQ * 32; \
    float* a2tab = (float*)(ws + WS_A2); \
    int* top_e = (int*)(ws + WS_PAIR); int* ppos = top_e + NTOK * 4; float* pgate = (float*)(ppos + NTOK * 4); int* pdest = (int*)(pgate + NTOK * 4); \
    float* ctxbuf = (float*)(ws + WS_CTX); \
    bf16_t* Wqkv_t = (bf16_t*)(ws + WS_WQKV); bf16_t* Wo_t = (bf16_t*)(ws + WS_WO); bf16_t* Win_t = (bf16_t*)(ws + WS_WIN); bf16_t* Wout_t = (bf16_t*)(ws + WS_WOUT); \
    bf16_t* Wgu_t = (bf16_t*)(ws + WS_WGU); bf16_t* Wdn_t = (bf16_t*)(ws + WS_WDN); \
    bf16_t* hA = (bf16_t*)(ws + WS_HA); bf16_t* Qb = (bf16_t*)(ws + WS_Q); bf16_t* Kb = (bf16_t*)(ws + WS_K); bf16_t* Vb = (bf16_t*)(ws + WS_V); \
    bf16_t* Upre = (bf16_t*)(ws + WS_UPRE); bf16_t* Wc = (bf16_t*)(ws + WS_WC); bf16_t* Yc = (bf16_t*)(ws + WS_YC); \
    bf16_t* XS = (bf16_t*)(ws + WS_XS); bf16_t* AB = (bf16_t*)(ws + WS_AB); \
    const int wr = wave >> 2, wc = wave & 3, fr = lane & 15, fq = lane >> 4;
template <int layer> __device__ __forceinline__ void layer_body(const Args& args, LAS unsigned char* lds, const XcdBarrier& bar, const int tid, const int lane, const int wave, const int G, const int bid, const int lo, const int hi) {
    const int gw = bid * NWAVES + wave, NGW = G * NWAVES;
    unsigned char* ws = args.ws;
    gu32* ctl = (gu32*)(ws + WS_CTL);
    KLOCALS
        const int pb = 3 + 10 * layer;
        const int jm = layer >> 1;
        const bool ctx_live = layer < 2;
        const int nrows = ctx_live ? NTOK : NLAT;
        const float* mo = modf + (size_t)layer * NMODROW * MODW;
        const float* resL = layer == 0 ? x_in : out; const float* resC = layer == 0 ? ctx_in : ctxbuf;

        if ((layer & 1) == 0) {
            if (EN_GEMM && IN(pb + 0)) {
                EpiQKV E{Qb, Kb, Vb, args.in[I_QG] + jm * 64, args.in[I_KG] + jm * 64, cosT, sinT};
                const bf16_t* Wt = Wqkv_t + (size_t)jm * NQKV * D;
                const int nlat_u = 128 * 6, nctx_u = 16 * (ctx_live ? 6 : 2);
                for (int u = bid; u < nlat_u + nctx_u; u += G) {
                    int pm, pn;
                    if (u < nlat_u) { pm = u / 6; pn = u % 6; }
                    else { const int q = u - nlat_u; if (ctx_live) { pm = 128 + q / 6; pn = q % 6; } else { pm = 128 + q / 2; pn = 4 + q % 2; } }
                    f32x4 acc[2][2][4][2];
                    gemm_unit_simple(hA + (size_t)pm * 256 * D, Wt + (size_t)pn * 256 * D, acc, wr, wc, fr, fq);
                    E(acc, pm, pn, wr, wc, fr, fq);
                }
            }
            SEAM(pb + 0);
            if (EN_ATT && IN(pb + 1)) {
                LAS bf16_t* Ks = (LAS bf16_t*)lds;
                LAS bf16_t* Vt = Ks + 64 * 72;
                const int nlat_u = NB * 4 * 32, nctx_u = ctx_live ? NB * 4 * 4 : 0;
                const int r32 = lane & 31, hi = lane >> 5, g = wave >> 1, qh = wave & 1;
                for (int u = bid; u < nlat_u + nctx_u; u += G) {
                    int b, kvh, qrow0, key0, ntile;
                    if (u < nlat_u) { b = u >> 7; kvh = (u >> 5) & 3; qrow0 = b * SEQ + (u & 31) * 64; key0 = 0; ntile = KVL / 64; }
                    else { const int q = u - nlat_u; b = q >> 4; kvh = (q >> 2) & 3; qrow0 = NLAT + b * CL + (q & 3) * 64; key0 = SEQ; ntile = CL / 64; }
                    const int head = kvh * 4 + g; const int qrow = qrow0 + 32 * qh + r32;
                    bf16x8 qr[4];
#pragma unroll
                    for (int d0 = 0; d0 < 4; ++d0) qr[d0] = *(const bf16x8*)(Qb + (size_t)qrow * D + head * 64 + d0 * 16 + hi * 8);
                    f32x16 o0, o1;
#pragma unroll
                    for (int r = 0; r < 16; ++r) { o0[r] = 0.f; o1[r] = 0.f; }
                    float mrun = -INFINITY, lrun = 0.f;
#pragma unroll 1
                    for (int t = 0; t < ntile; ++t) {
                        __syncthreads();
                        { const int key = tid >> 3, dc = (tid & 7) * 8; const size_t off = ((size_t)b * KVL + key0 + t * 64 + key) * 256 + kvh * 64 + dc;
                          const u32x4 kw = *(const u32x4*)(Kb + off), vw = *(const u32x4*)(Vb + off);
                          *(LAS u32x4*)(Ks + key * 72 + dc) = kw;
                          Vt[(dc + 0) * 72 + key] = (bf16_t)(vw.x & 0xffffu); Vt[(dc + 1) * 72 + key] = (bf16_t)(vw.x >> 16);
                          Vt[(dc + 2) * 72 + key] = (bf16_t)(vw.y & 0xffffu); Vt[(dc + 3) * 72 + key] = (bf16_t)(vw.y >> 16);
                          Vt[(dc + 4) * 72 + key] = (bf16_t)(vw.z & 0xffffu); Vt[(dc + 5) * 72 + key] = (bf16_t)(vw.z >> 16);
                          Vt[(dc + 6) * 72 + key] = (bf16_t)(vw.w & 0xffffu); Vt[(dc + 7) * 72 + key] = (bf16_t)(vw.w >> 16); }
                        __syncthreads();
                        f32x16 p0, p1;
#pragma unroll
                        for (int r = 0; r < 16; ++r) { p0[r] = 0.f; p1[r] = 0.f; }
#pragma unroll
                        for (int d0 = 0; d0 < 4; ++d0) {
                            const bf16x8 a0 = *(const LAS bf16x8*)(Ks + r32 * 72 + d0 * 16 + hi * 8), a1 = *(const LAS bf16x8*)(Ks + (32 + r32) * 72 + d0 * 16 + hi * 8);
                            p0 = __builtin_amdgcn_mfma_f32_32x32x16_bf16(a0, qr[d0], p0, 0, 0, 0); p1 = __builtin_amdgcn_mfma_f32_32x32x16_bf16(a1, qr[d0], p1, 0, 0, 0); }
                        float mx = fmaxf(p0[0], p1[0]);
#pragma unroll
                        for (int r = 1; r < 16; ++r) mx = fmaxf(mx, fmaxf(p0[r], p1[r]));
                        mx = fmaxf(mx, __shfl_xor(mx, 32));
                        const float mnew = fmaxf(mrun, mx), alpha = __builtin_amdgcn_exp2f(mrun - mnew); mrun = mnew;
                        float ps = 0.f;
#pragma unroll
                        for (int r = 0; r < 16; ++r) { p0[r] = __builtin_amdgcn_exp2f(p0[r] - mrun); p1[r] = __builtin_amdgcn_exp2f(p1[r] - mrun); ps += p0[r] + p1[r]; }
                        lrun = lrun * alpha + ps;
#pragma unroll
                        for (int r = 0; r < 16; ++r) { o0[r] *= alpha; o1[r] *= alpha; }
#pragma unroll
                        for (int s4 = 0; s4 < 4; ++s4) {
                            u32x4 pw;
                            if (s4 == 0) { pw.x = pk2(p0[0], p0[1]); pw.y = pk2(p0[2], p0[3]); pw.z = pk2(p0[4], p0[5]); pw.w = pk2(p0[6], p0[7]); }
                            else if (s4 == 1) { pw.x = pk2(p0[8], p0[9]); pw.y = pk2(p0[10], p0[11]); pw.z = pk2(p0[12], p0[13]); pw.w = pk2(p0[14], p0[15]); }
                            else if (s4 == 2) { pw.x = pk2(p1[0], p1[1]); pw.y = pk2(p1[2], p1[3]); pw.z = pk2(p1[4], p1[5]); pw.w = pk2(p1[6], p1[7]); }
                            else { pw.x = pk2(p1[8], p1[9]); pw.y = pk2(p1[10], p1[11]); pw.z = pk2(p1[12], p1[13]); pw.w = pk2(p1[14], p1[15]); }
                            const bf16x8 pf = __builtin_bit_cast(bf16x8, pw);
                            const int kvb = 32 * (s4 >> 1) + 16 * (s4 & 1) + 4 * hi;
                            { const u32x2 lo4 = *(const LAS u32x2*)(Vt + r32 * 72 + kvb), hi4 = *(const LAS u32x2*)(Vt + r32 * 72 + kvb + 8);
                              const u32x4 vv = (u32x4){lo4.x, lo4.y, hi4.x, hi4.y}; o0 = __builtin_amdgcn_mfma_f32_32x32x16_bf16(__builtin_bit_cast(bf16x8, vv), pf, o0, 0, 0, 0); }
                            { const u32x2 lo4 = *(const LAS u32x2*)(Vt + (32 + r32) * 72 + kvb), hi4 = *(const LAS u32x2*)(Vt + (32 + r32) * 72 + kvb + 8);
                              const u32x4 vv = (u32x4){lo4.x, lo4.y, hi4.x, hi4.y}; o1 = __builtin_amdgcn_mfma_f32_32x32x16_bf16(__builtin_bit_cast(bf16x8, vv), pf, o1, 0, 0, 0); }
                        }
                    }
                    const float il = 1.0f / (lrun + __shfl_xor(lrun, 32));
                    bf16_t* op = Qb + (size_t)qrow * D + head * 64;
#pragma unroll
                    for (int gq = 0; gq < 4; ++gq) {
                        u32x2 w0, w1;
                        w0.x = pk2(o0[4 * gq] * il, o0[4 * gq + 1] * il); w0.y = pk2(o0[4 * gq + 2] * il, o0[4 * gq + 3] * il);
                        w1.x = pk2(o1[4 * gq] * il, o1[4 * gq + 1] * il); w1.y = pk2(o1[4 * gq + 2] * il, o1[4 * gq + 3] * il);
                        *(u32x2*)(op + 8 * gq + 4 * hi) = w0; *(u32x2*)(op + 32 + 8 * gq + 4 * hi) = w1;
                    }
                }
            }
            SEAM(pb + 1);
            if (EN_GEMM && IN(pb + 2)) {
                EpiResid E{resL, resC, out, ctxbuf, mo + 2 * D, nullptr};
                const bf16_t* Wt = Wo_t + (size_t)jm * D * D;
                const int nu = (nrows / 256) * 4;
                for (int u = bid; u < nu; u += G) { const int pm = u >> 2, pn = u & 3; f32x4 acc[2][2][4][2];
                    gemm_unit_simple(Qb + (size_t)pm * 256 * D, Wt + (size_t)pn * 256 * D, acc, wr, wc, fr, fq);
                    E(acc, pm * 256, pn * 256, wr, wc, fr, fq); }
            }
            SEAM(pb + 2);
        } else {
            const float* cw = args.in[I_HCW] + (size_t)jm * 3 * NHY; const float* cb = args.in[I_HCB] + (size_t)jm * NHY;
            if (EN_GEMM && IN(pb + 0)) {
                EpiBiasBf16 E{Upre, NHY, args.in[I_HBIN] + (size_t)jm * NHY};
                const bf16_t* Wt = Win_t + (size_t)jm * NHY * D;
                const int nu = (nrows / 256) * 12;
                for (int u = bid; u < nu; u += G) { const int pm = u / 12, pn = u % 12; f32x4 acc[2][2][4][2];
                    gemm_unit_simple(hA + (size_t)pm * 256 * D, Wt + (size_t)pn * 256 * D, acc, wr, wc, fr, fq);
                    E(acc, pm * 256, pn * 256, wr, wc, fr, fq); }
            }
            SEAM(pb + 0);
            if (EN_MISC && IN(pb + 1)) {
                LAS bf16_t* T = (LAS bf16_t*)lds;
                const int nlat_u = NB * 32 * 16, nctx_u = ctx_live ? NB * 4 * 16 : 0;
                for (int u = bid; u < nlat_u + nctx_u; u += G) {
                    int b, s0, c0, Ls, rowb; bf16_t* dstb;
                    if (u < nlat_u) { b = u >> 9; s0 = ((u >> 4) & 31) * 64; c0 = (u & 15) * 64; Ls = SEQ; rowb = b * SEQ; dstb = Wc; }
                    else { const int q = u - nlat_u; b = q >> 6; s0 = ((q >> 4) & 3) * 64; c0 = (q & 15) * 64; Ls = CL; rowb = NLAT + b * CL; dstb = Wc + WC_CTX_OFF; }
                    const int sr = tid >> 3, cc = (tid & 7) * 8, s = s0 + sr;
                    float x1[8], vv[8];
#pragma unroll
                    for (int e = 0; e < 8; ++e) { x1[e] = cb[D + c0 + cc + e]; vv[e] = cb[2 * D + c0 + cc + e]; }
#pragma unroll
                    for (int tap = 0; tap < 3; ++tap) { const int sp = s + tap - 1;
                        if (sp >= 0 && sp < Ls) { const bf16_t* ur = Upre + (size_t)(rowb + sp) * NHY + c0 + cc; const u32x4 a = *(const u32x4*)(ur + D), bq = *(const u32x4*)(ur + 2 * D);
                            const float* w1 = cw + tap * NHY + D + c0 + cc; const float* w2 = cw + tap * NHY + 2 * D + c0 + cc;
                            const float af[8] = {bflo(a.x), bfhi(a.x), bflo(a.y), bfhi(a.y), bflo(a.z), bfhi(a.z), bflo(a.w), bfhi(a.w)};
                            const float bf[8] = {bflo(bq.x), bfhi(bq.x), bflo(bq.y), bfhi(bq.y), bflo(bq.z), bfhi(bq.z), bflo(bq.w), bfhi(bq.w)};
#pragma unroll
                            for (int e = 0; e < 8; ++e) { x1[e] += af[e] * w1[e]; vv[e] += bf[e] * w2[e]; } } }
                    __syncthreads();
#pragma unroll
                    for (int e = 0; e < 8; ++e) T[(cc + e) * 72 + sr] = (bf16_t)f2bf(x1[e] * vv[e]);
                    __syncthreads();
                    { const int c = tid >> 3, sc = (tid & 7) * 8; const u32x4 w = *(const LAS u32x4*)(T + c * 72 + sc);
                      *(u32x4*)(dstb + ((size_t)(c0 + c) * NB + b) * Ls + s0 + sc) = w; }
                }
            }
            SEAM(pb + 1);
            if (EN_CONV && IN(pb + 2)) {
                LAS float* GF = (LAS float*)lds;
                const int nlat_u = 1024, nctx_u = ctx_live ? 1024 : 0;
                for (int u = bid; u < nlat_u + nctx_u; u += G) {
                    const bool isl = u < nlat_u; const int c = isl ? u : u - nlat_u; const int Lf = isl ? SEQ : CL; const int P = 2 * Lf + 8;
                    LAS float* WF = GF + 2 * Lf;
                    const bf16_t* FI = (const bf16_t*)(ws + (isl ? (jm == 0 ? WS_FI0 : WS_FI1) : WS_FI2)) + (size_t)c * 8 * P;
                    const bf16_t* wsrc = (isl ? Wc : Wc + WC_CTX_OFF) + (size_t)c * NB * Lf; bf16_t* ydst = (isl ? Yc : Yc + WC_CTX_OFF) + (size_t)c * NB * Lf;
                    __syncthreads();
                    for (int i = tid; i < 2 * Lf; i += NTHR) GF[i] = (i >= 1) ? bf2f(FI[2 * Lf - i]) : 0.f;
                    for (int i = tid; i < NB * Lf / 8; i += NTHR) { const int b = i / (Lf / 8), s8 = (i % (Lf / 8)) * 8; const u32x4 w = *(const u32x4*)(wsrc + (size_t)b * Lf + s8);
                        const float f[8] = {bflo(w.x), bfhi(w.x), bflo(w.y), bfhi(w.y), bflo(w.z), bfhi(w.z), bflo(w.w), bfhi(w.w)};
#pragma unroll
                        for (int e = 0; e < 8; ++e) WF[(s8 + e) * 16 + b] = f[e]; }
                    __syncthreads();
                    float acc[4][16];
#pragma unroll
                    for (int r = 0; r < 4; ++r)
#pragma unroll
                        for (int b = 0; b < 16; ++b) acc[r][b] = 0.f;
                    const int tbase = tid + Lf;
                    const bool act = tid < Lf;
                    if (isl) {
                        for (int s = 0; s < SEQ; ++s) { const LAS f32x4* wp = (const LAS f32x4*)(WF + s * 16); const f32x4 w0 = wp[0], w1 = wp[1], w2 = wp[2], w3 = wp[3];
#pragma unroll
                            for (int r = 0; r < 4; ++r) { const float gi = GF[tbase + 512 * r - s];
                                acc[r][0] += gi * w0[0]; acc[r][1] += gi * w0[1]; acc[r][2] += gi * w0[2]; acc[r][3] += gi * w0[3]; acc[r][4] += gi * w1[0]; acc[r][5] += gi * w1[1]; acc[r][6] += gi * w1[2]; acc[r][7] += gi * w1[3];
                                acc[r][8] += gi * w2[0]; acc[r][9] += gi * w2[1]; acc[r][10] += gi * w2[2]; acc[r][11] += gi * w2[3]; acc[r][12] += gi * w3[0]; acc[r][13] += gi * w3[1]; acc[r][14] += gi * w3[2]; acc[r][15] += gi * w3[3]; } }
#pragma unroll
                        for (int r = 0; r < 4; ++r)
#pragma unroll
                            for (int b = 0; b < 16; ++b) ydst[(size_t)b * SEQ + tid + 512 * r] = (bf16_t)f2bf(acc[r][b]);
                    } else if (act) {
                        for (int s = 0; s < CL; ++s) { const LAS f32x4* wp = (const LAS f32x4*)(WF + s * 16); const f32x4 w0 = wp[0], w1 = wp[1], w2 = wp[2], w3 = wp[3];
                            const float gi = GF[tbase - s];
                            acc[0][0] += gi * w0[0]; acc[0][1] += gi * w0[1]; acc[0][2] += gi * w0[2]; acc[0][3] += gi * w0[3]; acc[0][4] += gi * w1[0]; acc[0][5] += gi * w1[1]; acc[0][6] += gi * w1[2]; acc[0][7] += gi * w1[3];
                            acc[0][8] += gi * w2[0]; acc[0][9] += gi * w2[1]; acc[0][10] += gi * w2[2]; acc[0][11] += gi * w2[3]; acc[0][12] += gi * w3[0]; acc[0][13] += gi * w3[1]; acc[0][14] += gi * w3[2]; acc[0][15] += gi * w3[3]; }
#pragma unroll
                        for (int b = 0; b < 16; ++b) ydst[(size_t)b * CL + tid] = (bf16_t)f2bf(acc[0][b]);
                    }
                }
            }
            SEAM(pb + 2);
            if (EN_MISC && IN(pb + 3)) {
                LAS bf16_t* T = (LAS bf16_t*)lds;
                const int nlat_u = NB * 32 * 16, nctx_u = ctx_live ? NB * 4 * 16 : 0;
                for (int u = bid; u < nlat_u + nctx_u; u += G) {
                    int b, s0, c0, Ls, rowb; const bf16_t* srcb;
                    if (u < nlat_u) { b = u >> 9; s0 = ((u >> 4) & 31) * 64; c0 = (u & 15) * 64; Ls = SEQ; rowb = b * SEQ; srcb = Yc; }
                    else { const int q = u - nlat_u; b = q >> 6; s0 = ((q >> 4) & 3) * 64; c0 = (q & 15) * 64; Ls = CL; rowb = NLAT + b * CL; srcb = Yc + WC_CTX_OFF; }
                    __syncthreads();
                    { const int c = tid >> 3, sc = (tid & 7) * 8; *(LAS u32x4*)(T + c * 72 + sc) = *(const u32x4*)(srcb + ((size_t)(c0 + c) * NB + b) * Ls + s0 + sc); }
                    __syncthreads();
                    const int sr = tid >> 3, cc = (tid & 7) * 8, s = s0 + sr;
                    float x0[8];
#pragma unroll
                    for (int e = 0; e < 8; ++e) x0[e] = cb[c0 + cc + e];
#pragma unroll
                    for (int tap = 0; tap < 3; ++tap) { const int sp = s + tap - 1;
                        if (sp >= 0 && sp < Ls) { const u32x4 a = *(const u32x4*)(Upre + (size_t)(rowb + sp) * NHY + c0 + cc); const float* w0 = cw + tap * NHY + c0 + cc;
                            const float af[8] = {bflo(a.x), bfhi(a.x), bflo(a.y), bfhi(a.y), bflo(a.z), bfhi(a.z), bflo(a.w), bfhi(a.w)};
#pragma unroll
                            for (int e = 0; e < 8; ++e) x0[e] += af[e] * w0[e]; } }
                    float z[8];
#pragma unroll
                    for (int e = 0; e < 8; ++e) z[e] = x0[e] * bf2f(T[(cc + e) * 72 + sr]);
                    u32x4 o; o.x = pk2(z[0], z[1]); o.y = pk2(z[2], z[3]); o.z = pk2(z[4], z[5]); o.w = pk2(z[6], z[7]);
                    *(u32x4*)(hA + (size_t)(rowb + s) * D + c0 + cc) = o;
                }
            }
            SEAM(pb + 3);
            if (EN_GEMM && IN(pb + 4)) {
                EpiResid E{resL, resC, out, ctxbuf, mo + 2 * D, args.in[I_HBOUT] + (size_t)jm * D};
                const bf16_t* Wt = Wout_t + (size_t)jm * D * D;
                const int nu = (nrows / 256) * 4;
                for (int u = bid; u < nu; u += G) { const int pm = u >> 2, pn = u & 3; f32x4 acc[2][2][4][2];
                    gemm_unit_simple(hA + (size_t)pm * 256 * D, Wt + (size_t)pn * 256 * D, acc, wr, wc, fr, fq);
                    E(acc, pm * 256, pn * 256, wr, wc, fr, fq); }
            }
            SEAM(pb + 4);
        }

        gu32* cnt = ctl + CW_CNT + layer * 32 * 64;
        if (EN_ROUTER && IN(pb + 5)) {
            LAS float* WrT = (LAS float*)lds;
            __syncthreads();
            { const float* rw = args.in[I_RW] + (size_t)layer * D * NE;
              for (int i = tid; i < D * NE; i += NTHR) { const int k = i >> 5, e = i & 31; WrT[e * D + k] = rw[i]; } }
            __syncthreads();
            const float* rb = args.in[I_RB] + layer * NE; const float* g2 = args.in[I_N2G] + layer * D;
            for (int r = gw; r < nrows; r += NGW) {
                const float* src = r < NLAT ? out + (size_t)r * D : ctxbuf + (size_t)(r - NLAT) * D;
                f32x4 v[4], h[4];
#pragma unroll
                for (int j = 0; j < 4; ++j) v[j] = ((const f32x4*)src)[lane + 64 * j];
                const float* mr = mo + (size_t)mod_row(r) * MODW;
                norm_mod_store(v, g2, mr + 3 * D, mr + 4 * D, hA + (size_t)r * D, lane, h);
                float p[32];
                asm volatile("" ::: "memory");
#pragma unroll
                for (int e = 0; e < 32; ++e) { float a = 0.f; if ((e & 3) == 0) asm volatile("" ::: "memory");
#pragma unroll
                    for (int j = 0; j < 4; ++j) { const f32x4 w = *(const LAS f32x4*)(WrT + e * D + 256 * j + 4 * lane); a += (h[j][0] * w[0] + h[j][1] * w[1]) + (h[j][2] * w[2] + h[j][3] * w[3]); }
                    p[e] = a; }
#pragma unroll
                for (int i = 0; i < 16; ++i) { const bool up = (lane & 32) != 0; const float send = up ? p[i] : p[i + 16], keep = up ? p[i + 16] : p[i]; p[i] = keep + __shfl_xor(send, 32); }
#pragma unroll
                for (int i = 0; i < 8; ++i) { const bool up = (lane & 16) != 0; const float send = up ? p[i] : p[i + 8], keep = up ? p[i + 8] : p[i]; p[i] = keep + __shfl_xor(send, 16); }
#pragma unroll
                for (int i = 0; i < 4; ++i) { const bool up = (lane & 8) != 0; const float send = up ? p[i] : p[i + 4], keep = up ? p[i + 4] : p[i]; p[i] = keep + __shfl_xor(send, 8); }
#pragma unroll
                for (int i = 0; i < 2; ++i) { const bool up = (lane & 4) != 0; const float send = up ? p[i] : p[i + 2], keep = up ? p[i + 2] : p[i]; p[i] = keep + __shfl_xor(send, 4); }
                { const bool up = (lane & 2) != 0; const float send = up ? p[0] : p[1], keep = up ? p[1] : p[0]; p[0] = keep + __shfl_xor(send, 2); }
                p[0] += __shfl_xor(p[0], 1);
                const int myE = lane >> 1;
                float val = p[0] + rb[myE];
                float sv[4]; int si[4];
#pragma unroll
                for (int k = 0; k < 4; ++k) { float bv = val; int bi = myE;
#pragma unroll
                    for (int off = 1; off < 64; off <<= 1) { const float ov = __shfl_xor(bv, off); const int oi = __shfl_xor(bi, off); if (ov > bv || (ov == bv && oi < bi)) { bv = ov; bi = oi; } }
                    sv[k] = bv; si[k] = bi; if (myE == bi) val = -INFINITY; }
                const float e1 = __expf(sv[1] - sv[0]), e2 = __expf(sv[2] - sv[0]), e3 = __expf(sv[3] - sv[0]); const float inv = 1.0f / (1.0f + e1 + e2 + e3);
                if (lane < 4) { const int e = lane == 0 ? si[0] : (lane == 1 ? si[1] : (lane == 2 ? si[2] : si[3])); const float gt = (lane == 0 ? 1.0f : (lane == 1 ? e1 : (lane == 2 ? e2 : e3))) * inv;
                    const unsigned pos = __hip_atomic_fetch_add(cnt + e * 64, 1u, RLX_AGENT);
                    top_e[r * 4 + lane] = e; ppos[r * 4 + lane] = (int)pos; pgate[r * 4 + lane] = gt; }
            }
        }
        SEAM(pb + 5);
        LAS int* PADS = (LAS int*)(lds + LDS_BYTES - 4096);
        LAS unsigned char* TE = (LAS unsigned char*)(PADS + 128);
        if (IN(pb + 6) || IN(pb + 7) || IN(pb + 8) || IN(pb + 9)) {
            __syncthreads();
            if (tid < 32) PADS[64 + tid] = (int)__hip_atomic_load(cnt + tid * 64, RLX_AGENT);
            __syncthreads();
            if (tid == 0) { int a = 0; for (int e = 0; e < 32; ++e) { PADS[e] = a; const int nt = (PADS[64 + e] + 255) >> 8; for (int t = 0; t < nt; ++t) TE[(a >> 8) + t] = (unsigned char)e; a += nt * 256; } PADS[32] = a; }
            __syncthreads();
        }
        if (EN_MISC && IN(pb + 6)) {
            for (int pr = gw; pr < nrows * 4; pr += NGW) {
                const int e = top_e[pr], dest = PADS[e] + ppos[pr]; if (lane == 0) pdest[pr] = dest;
                const u32x4* s = (const u32x4*)(hA + (size_t)(pr >> 2) * D); u32x4* d = (u32x4*)(XS + (size_t)dest * D);
                d[lane] = s[lane]; d[lane + 64] = s[lane + 64];
            }
            for (int e = 0; e < 32; ++e) { const int c0 = PADS[e] + PADS[64 + e], c1 = PADS[e + 1];
                for (int rr = c0 + gw; rr < c1; rr += NGW) { u32x4* d = (u32x4*)(XS + (size_t)rr * D); d[lane] = (u32x4){0u, 0u, 0u, 0u}; d[lane + 64] = (u32x4){0u, 0u, 0u, 0u}; } }
        }
        SEAM(pb + 6);
        if (EN_GEMM && IN(pb + 7)) {
            const int ntile = PADS[32] >> 8;
            for (int u = bid; u < ntile * 8; u += G) { const int rt = u >> 3, pn = u & 7, e = TE[rt]; f32x4 acc[2][2][4][2];
                gemm_unit_simple(XS + (size_t)rt * 256 * D, Wgu_t + ((size_t)(layer * NE + e) * NGU + pn * 256) * D, acc, wr, wc, fr, fq);
                EpiSwiglu E{AB, args.in[I_BGU] + (size_t)(layer * NE + e) * NGU};
                E(acc, rt * 256, pn, wr, wc, fr, fq); }
        }
        SEAM(pb + 7);
        if (EN_GEMM && IN(pb + 8)) {
            const int ntile = PADS[32] >> 8;
            for (int u = bid; u < ntile * 4; u += G) { const int rt = u >> 2, pn = u & 3, e = TE[rt]; f32x4 acc[2][2][4][2];
                gemm_unit_simple(AB + (size_t)rt * 256 * D, Wdn_t + ((size_t)(layer * NE + e) * D + pn * 256) * D, acc, wr, wc, fr, fq);
                EpiBiasBf16 E{XS, D, args.in[I_BDN] + (size_t)(layer * NE + e) * D};
                E(acc, rt * 256, pn * 256, wr, wc, fr, fq); }
        }
        SEAM(pb + 8);
        if (EN_MISC && IN(pb + 9)) {
            const bool has_next = layer + 1 < DEPTH;
            const float* mo_n = modf + (size_t)(layer + 1) * NMODROW * MODW; const float* g1n = args.in[I_N1G] + (has_next ? (layer + 1) * D : 0);
            const int nnext = (layer + 1 < 3) ? NTOK : NLAT;
            for (int r = gw; r < nrows; r += NGW) {
                float* xr = r < NLAT ? out + (size_t)r * D : ctxbuf + (size_t)(r - NLAT) * D;
                const float* mr = mo + (size_t)mod_row(r) * MODW + 5 * D;
                f32x4 y[4];
#pragma unroll
                for (int j = 0; j < 4; ++j) y[j] = (f32x4){0.f, 0.f, 0.f, 0.f};
#pragma unroll
                for (int k = 0; k < 4; ++k) { const int dest = pdest[r * 4 + k]; const float gt = pgate[r * 4 + k]; const u32x2* yr = (const u32x2*)(XS + (size_t)dest * D);
#pragma unroll
                    for (int j = 0; j < 4; ++j) { const u32x2 w = yr[lane + 64 * j]; y[j][0] += gt * bflo(w.x); y[j][1] += gt * bfhi(w.x); y[j][2] += gt * bflo(w.y); y[j][3] += gt * bfhi(w.y); } }
                f32x4 v[4], h[4];
#pragma unroll
                for (int j = 0; j < 4; ++j) { const f32x4 g = ((const f32x4*)mr)[lane + 64 * j]; v[j] = ((const f32x4*)xr)[lane + 64 * j] + g * y[j]; ((f32x4*)xr)[lane + 64 * j] = v[j]; }
                if (has_next && r < nnext) { const float* mn = mo_n + (size_t)mod_row(r) * MODW; norm_mod_store(v, g1n, mn, mn + D, hA + (size_t)r * D, lane, h); }
            }
        }
        SEAM(pb + 9);
}

__global__ void __launch_bounds__(NTHR, 2) fwd(Args args) {
    extern __shared__ __attribute__((aligned(16))) unsigned char lds_raw[];
    LAS unsigned char* lds = (LAS unsigned char*)lds_raw;
    const int tid = threadIdx.x, lane = tid & 63, wave = __builtin_amdgcn_readfirstlane(tid >> 6);
    const int G = gridDim.x, bid = blockIdx.x;
    const int gw = bid * NWAVES + wave, NGW = G * NWAVES;
    unsigned char* ws = args.ws;
    gu32* ctl = (gu32*)(ws + WS_CTL);
    volatile LAS unsigned* MISC = (volatile LAS unsigned*)(lds + MISC_OFF);
    if (tid < 64) MISC[tid] = 0u;
    __syncthreads();
    XcdBarrier bar; bar.bar = (unsigned*)ctl + CW_BAR; bar.x = 0; bar.st = MISC + 8;
    const int lo = args.ph_lo, hi = args.ph_hi;
    if (hi - lo > 1) bar = xcd_barrier_post((unsigned*)ctl + CW_BAR, MISC + 8);

    KLOCALS

    if (EN_PRO && IN(0)) {
        {
            LAS float* scr = (LAS float*)(lds + wave * 8448);
            constexpr int IT_QKV = 16 * (NQKV / 32), IT_SQ = 16 * (D / 32), IT_IN = 16 * (NHY / 32), IT_GU = 16 * (NGU / 32);
            constexpr int N0 = 2 * IT_QKV, N1 = N0 + 2 * IT_SQ, N2 = N1 + 2 * IT_IN, N3 = N2 + 2 * IT_SQ, N4 = N3 + 128 * IT_GU, N5 = N4 + 128 * IT_SQ;
            for (int it = gw; it < N5; it += NGW) {
                if (it < N0) { const int mtx = it / IT_QKV, r = it % IT_QKV; transpose_item<1>(args.in[I_WQKV] + (size_t)mtx * D * NQKV, NQKV, Wqkv_t + (size_t)mtx * NQKV * D, scr, r, lane); }
                else if (it < N1) { const int q = it - N0, mtx = q / IT_SQ, r = q % IT_SQ; transpose_item<0>(args.in[I_WO] + (size_t)mtx * D * D, D, Wo_t + (size_t)mtx * D * D, scr, r, lane); }
                else if (it < N2) { const int q = it - N1, mtx = q / IT_IN, r = q % IT_IN; transpose_item<0>(args.in[I_HWIN] + (size_t)mtx * D * NHY, NHY, Win_t + (size_t)mtx * NHY * D, scr, r, lane); }
                else if (it < N3) { const int q = it - N2, mtx = q / IT_SQ, r = q % IT_SQ; transpose_item<0>(args.in[I_HWOUT] + (size_t)mtx * D * D, D, Wout_t + (size_t)mtx * D * D, scr, r, lane); }
                else if (it < N4) { const int q = it - N3, mtx = q / IT_GU, r = q % IT_GU; transpose_item<2>(args.in[I_WGU] + (size_t)mtx * D * NGU, NGU, Wgu_t + (size_t)mtx * NGU * D, scr, r, lane); }
                else { const int q = it - N4, mtx = q / IT_SQ, r = q % IT_SQ; transpose_item<0>(args.in[I_WDN] + (size_t)mtx * D * D, D, Wdn_t + (size_t)mtx * D * D, scr, r, lane); }
            }
        }
        __syncthreads();
        {
            LAS float* S = (LAS float*)lds;
            for (int u = bid; u < 4 * 12 * 8; u += G) {
                const int kc = u & 7, cc = (u >> 3) % 12, layer = u / 96;
                __syncthreads();
                for (int i = tid; i < 128 * 20; i += NTHR) { const int k = i / 20, r = i % 20; float v = 0.f;
                    if (r < NMODROW) { const float cv = r < NB ? c_in[r * D + kc * 128 + k] : cctx_in[kc * 128 + k]; v = cv / (1.0f + __expf(-cv)); }
                    S[i] = v; }
                __syncthreads();
                const int col = cc * 512 + tid;
                const float* wp = args.in[I_WMOD] + ((size_t)layer * D + kc * 128) * MODW + col;
                float acc[20];
#pragma unroll
                for (int r = 0; r < 20; ++r) acc[r] = 0.f;
                for (int k = 0; k < 128; ++k) { const float w = wp[(size_t)k * MODW];
#pragma unroll
                    for (int q = 0; q < 5; ++q) { const f32x4 s = *(const LAS f32x4*)(S + k * 20 + 4 * q);
                        acc[4 * q] += s[0] * w; acc[4 * q + 1] += s[1] * w; acc[4 * q + 2] += s[2] * w; acc[4 * q + 3] += s[3] * w; } }
#pragma unroll
                for (int r = 0; r < NMODROW; ++r) modp[((size_t)(kc * 4 + layer) * NMODROW + r) * MODW + col] = acc[r];
            }
        }
        for (int i = bid * NTHR + tid; i < SEQ * 32; i += G * NTHR) {
            const int t = i >> 5, j = i & 31, fi = j & 15; const int pos = (j >> 4) == 0 ? (t >> 6) : (t & 63);
            const float inv = powf(10000.0f, -(float)fi / 16.0f); const float ang = (float)pos * inv;
            cosT[i] = cosf(ang); sinT[i] = sinf(ang);
        }
        {
            __syncthreads();
            LAS float* Z = (LAS float*)lds;
            LAS float* A1 = Z + 8 * 36;
            for (int u = bid; u < 256 + 256 + 32; u += G) {
                const int combo = u < 256 ? 0 : (u < 512 ? 1 : 2); const int ub = combo == 0 ? u : (combo == 1 ? u - 256 : u - 512);
                const int j = combo == 1 ? 1 : 0, Lf = combo == 2 ? CL : SEQ;
                const int tl = tid >> 6, o = tid & 63, t = ub * 8 + tl;
                __syncthreads();
                if (o < 33) { float z;
                    const float tt = (float)t / (float)(Lf - 1), w = 6.283185307179586f * (float)t / (float)Lf;
                    if (o == 0) z = tt; else { const int b = (o - 1) & 15; const float f = 1e-4f + (float)b * ((15.0f - 1e-4f) / 15.0f); z = o <= 16 ? cosf(f * w) : -sinf(f * w); }
                    Z[tl * 36 + o] = z; }
                __syncthreads();
                const float sf = args.in[I_HSF][j * 64 + o];
                { const float* w1 = args.in[I_HW1] + (size_t)j * 33 * 64; float a = args.in[I_HB1][j * 64 + o];
                  for (int i = 0; i < 33; ++i) a += Z[tl * 36 + i] * w1[i * 64 + o];
                  A1[tl * 64 + o] = sinf(sf * a); }
                __syncthreads();
                { const float* w2 = args.in[I_HW2] + (size_t)j * 64 * 64; float a = args.in[I_HB2][j * 64 + o];
                  for (int i = 0; i < 64; ++i) a += A1[tl * 64 + i] * w2[i * 64 + o];
                  a2tab[((size_t)combo * SEQ + t) * 64 + o] = sinf(sf * a); }
            }
        }
    }
    SEAM(0);

    if (EN_PRO && IN(1)) {
        for (int i = bid * NTHR + tid; i < DEPTH * NMODROW * MODW; i += G * NTHR) {
            const int layer = i / (NMODROW * MODW), rem = i % (NMODROW * MODW), col = rem % MODW; float s = args.in[I_BMOD][layer * MODW + col];
#pragma unroll
            for (int kc = 0; kc < 8; ++kc) s += modp[(size_t)(kc * 4 + layer) * NMODROW * MODW + rem];
            modf[i] = s;
        }
        {
            LAS float* W3 = (LAS float*)lds;
            LAS float* RED = W3 + 512;
            LAS float* NRM = RED + 32;
            LAS float* HF = NRM + 4;
            for (int u = bid; u < 3 * 256; u += G) {
                const int combo = u >> 8, cg = u & 255; const int j = combo == 1 ? 1 : 0, Lf = combo == 2 ? CL : SEQ; const int c0 = cg * 4;
                LAS float* HB = HF + 4 * Lf;
                __syncthreads();
                { const int i = tid >> 3, q = tid & 7; const int col = (q >> 2) * 1024 + c0 + (q & 3);
                  W3[i * 8 + q] = args.in[I_HW3][((size_t)j * 64 + i) * 2048 + col]; }
                __syncthreads();
                float b3v[8], dec[4], asum[4] = {0.f, 0.f, 0.f, 0.f};
#pragma unroll
                for (int q = 0; q < 8; ++q) b3v[q] = args.in[I_HB3][j * 2048 + (q >> 2) * 1024 + c0 + (q & 3)];
#pragma unroll
                for (int ch = 0; ch < 4; ++ch) dec[ch] = 3.0701134573253945f + (float)(c0 + ch) * ((15.350567286626972f - 3.0701134573253945f) / 1023.0f);
                for (int t = tid; t < Lf; t += NTHR) {
                    asm volatile("" ::: "memory");
                    const float* ar = a2tab + ((size_t)combo * SEQ + t) * 64; float d[8];
#pragma unroll
                    for (int q = 0; q < 8; ++q) d[q] = b3v[q];
#pragma unroll
                    for (int i4 = 0; i4 < 16; ++i4) { const f32x4 a = *(const f32x4*)(ar + 4 * i4); asm volatile("" ::: "memory");
#pragma unroll
                        for (int e = 0; e < 4; ++e) { const f32x4 w0 = *(const LAS f32x4*)(W3 + (4 * i4 + e) * 8), w1 = *(const LAS f32x4*)(W3 + (4 * i4 + e) * 8 + 4);
                            d[0] += a[e] * w0[0]; d[1] += a[e] * w0[1]; d[2] += a[e] * w0[2]; d[3] += a[e] * w0[3]; d[4] += a[e] * w1[0]; d[5] += a[e] * w1[1]; d[6] += a[e] * w1[2]; d[7] += a[e] * w1[3]; } }
                    const float tt = (float)t / (float)(Lf - 1);
#pragma unroll
                    for (int ch = 0; ch < 4; ++ch) { const float dk = __expf(-tt * dec[ch]); const float f = d[ch] * dk, bb = d[4 + ch] * dk;
                        HF[ch * Lf + t] = f; HB[ch * Lf + t] = bb; asum[ch] += fabsf(f) + (t >= 1 ? fabsf(bb) : 0.f); }
                }
#pragma unroll
                for (int ch = 0; ch < 4; ++ch) { const float s = wave_sum(asum[ch]); if (lane == 0) RED[wave * 4 + ch] = s; }
                __syncthreads();
                if (tid < 4) { float s = 0.f; for (int w = 0; w < 8; ++w) s += RED[w * 4 + tid]; NRM[tid] = 1.0f / (s + EPS); }
                __syncthreads();
                const int P = 2 * Lf + 8, PC8 = P / 8;
                bf16_t* FI = (bf16_t*)(ws + (combo == 0 ? WS_FI0 : (combo == 1 ? WS_FI1 : WS_FI2)));
                for (int q = tid; q < 4 * 8 * PC8; q += NTHR) {
                    const int ch = q / (8 * PC8), r = q % (8 * PC8), cidx = r / PC8, x0 = (r % PC8) * 8;
                    const float nr = NRM[ch], db = args.in[I_HDB][j * 1024 + c0 + ch]; float v[8];
#pragma unroll
                    for (int e = 0; e < 8; ++e) { const int m = Lf - (x0 + e) + cidx; const int am = m < 0 ? -m : m; float g = 0.f;
                        if (am <= Lf - 1) { g = (m >= 0 ? HF[ch * Lf + am] : HB[ch * Lf + am]) * nr; if (m == 0) g += db; }
                        v[e] = g; }
                    u32x4 o; o.x = pk2(v[0], v[1]); o.y = pk2(v[2], v[3]); o.z = pk2(v[4], v[5]); o.w = pk2(v[6], v[7]);
                    *(u32x4*)(FI + ((size_t)((c0 + ch) * 8 + cidx)) * P + x0) = o;
                }
            }
        }
    }
    SEAM(1);

    if (IN(2)) {
        const float* mo = modf;
        for (int r = gw; r < NTOK; r += NGW) {
            const float* src = r < NLAT ? x_in + (size_t)r * D : ctx_in + (size_t)(r - NLAT) * D;
            f32x4 v[4], h[4];
#pragma unroll
            for (int j = 0; j < 4; ++j) v[j] = ((const f32x4*)src)[lane + 64 * j];
            const float* mr = mo + (size_t)mod_row(r) * MODW;
            norm_mod_store(v, args.in[I_N1G], mr, mr + D, hA + (size_t)r * D, lane, h);
        }
    }
    SEAM(2);

    layer_body<0>(args, lds, bar, tid, lane, wave, G, bid, lo, hi);
    layer_body<1>(args, lds, bar, tid, lane, wave, G, bid, lo, hi);
    layer_body<2>(args, lds, bar, tid, lane, wave, G, bid, lo, hi);
    layer_body<3>(args, lds, bar, tid, lane, wave, G, bid, lo, hi);
#undef IN
#undef SEAM
}

extern "C" void kernel_launch(void* const* d_in, const int* in_sizes, int n_in, void* d_out, int out_size, void* d_ws, size_t ws_size, hipStream_t stream) {
    static int grid = 0;
    if (grid == 0) {
        if (n_in != 32 || out_size != NLAT * D || ws_size < WS_END) { fprintf(stderr, "kernel_launch: unexpected problem (n_in %d, out %d, ws %zu)\n", n_in, out_size, ws_size); grid = -1; return; }
        int dev = 0, cus = 0, per_cu = 0;
        if (hipGetDevice(&dev) != hipSuccess || hipDeviceGetAttribute(&cus, hipDeviceAttributeMultiprocessorCount, dev) != hipSuccess) { grid = -1; return; }
        if (hipFuncSetAttribute((const void*)fwd, hipFuncAttributeMaxDynamicSharedMemorySize, LDS_BYTES) != hipSuccess) { fprintf(stderr, "kernel_launch: hipFuncSetAttribute failed\n"); grid = -1; return; }
        if (hipOccupancyMaxActiveBlocksPerMultiprocessor(&per_cu, (const void*)fwd, NTHR, LDS_BYTES) != hipSuccess || per_cu < 1) fprintf(stderr, "kernel_launch: occupancy query says %d\n", per_cu);
        (void)hipGetLastError();
        grid = cus;
    }
    if (grid < 0) return;
    (void)hipMemsetAsync((char*)d_ws + WS_CTL, 0, CTL_ZERO_BYTES, stream);
    Args a{};
    for (int i = 0; i < 32; ++i) a.in[i] = (const float*)d_in[i];
    a.out = (float*)d_out; a.ws = (unsigned char*)d_ws;
    constexpr int NPH = 3 + 10 * DEPTH;
#if MK_ONE_LAUNCH
    a.ph_lo = 0; a.ph_hi = NPH;
    hipLaunchKernelGGL(fwd, dim3(grid), dim3(NTHR), LDS_BYTES, stream, a);
#else
    for (int p = 0; p < NPH; ++p) {
        if (p >= 3) { const int layer = (p - 3) / 10, loc = (p - 3) % 10; if ((layer & 1) == 0 && (loc == 3 || loc == 4)) continue; }
        a.ph_lo = p; a.ph_hi = p + 1;
        hipLaunchKernelGGL(fwd, dim3(grid), dim3(NTHR), LDS_BYTES, stream, a);
    }
#endif
}
```

```cpp
#include <hip/hip_runtime.h>
#include <cstdio>
#include <cstdint>

#ifndef EN_PRO
#define EN_PRO 1
#endif
#ifndef EN_ATT
#define EN_ATT 1
#endif
#ifndef EN_CONV
#define EN_CONV 1
#endif
#ifndef EN_ROUTER
#define EN_ROUTER 1
#endif
#ifndef EN_GEMM
#define EN_GEMM 1
#endif
#ifndef EN_MISC
#define EN_MISC 1
#endif
#ifndef MK_ONE_LAUNCH
#define MK_ONE_LAUNCH 1
#endif

#define GAS __attribute__((address_space(1)))
#define LAS __attribute__((address_space(3)))
typedef unsigned short bf16_t;
typedef short bf16x8 __attribute__((ext_vector_type(8)));
typedef float f32x4 __attribute__((ext_vector_type(4)));
typedef float f32x2 __attribute__((ext_vector_type(2)));
typedef unsigned u32x4 __attribute__((ext_vector_type(4)));
typedef unsigned u32x2 __attribute__((ext_vector_type(2)));
typedef GAS unsigned gu32;
typedef float f32x16 __attribute__((ext_vector_type(16)));

constexpr int D = 1024, NB = 16, SEQ = 2048, CL = 256, KVL = SEQ + CL;
constexpr int NLAT = NB * SEQ, NCTX = NB * CL, NTOK = NLAT + NCTX;
constexpr int NE = 32, TOPK = 4, DEPTH = 4;
constexpr int MODW = 6 * D, NMODROW = NB + 1;
constexpr int NQKV = 1536, NHY = 3072, NGU = 2048;
constexpr float EPS = 1e-6f;
constexpr float C2 = 0.125f * 1.4426950408889634f;
constexpr int NWAVES = 8, NTHR = 512;
constexpr int NPADROWS = 155648;
constexpr int MAXTILES = NPADROWS / 256;

constexpr size_t MiB = 1u << 20;
constexpr size_t WS_CTL = 0, CTL_ZERO_BYTES = 1 * MiB;
constexpr size_t WS_MODP = 2 * MiB;
constexpr size_t WS_MOD = 16 * MiB;
constexpr size_t WS_ROPE = 18 * MiB;
constexpr size_t WS_A2 = 19 * MiB;
constexpr size_t WS_PAIR = 21 * MiB;
constexpr size_t WS_CTX = 24 * MiB;
constexpr size_t WS_FI = 40 * MiB;
constexpr int FP_L = 2 * SEQ + 8, FP_C = 2 * CL + 8;
constexpr size_t FI_L_BYTES = (size_t)1024 * 8 * FP_L * 2, FI_C_BYTES = (size_t)1024 * 8 * FP_C * 2;
constexpr size_t WS_FI0 = WS_FI, WS_FI1 = WS_FI0 + 65 * MiB, WS_FI2 = WS_FI1 + 65 * MiB;
static_assert(FI_L_BYTES <= 65 * MiB && WS_FI2 + FI_C_BYTES <= 180 * MiB, "filter map");
constexpr size_t WS_WQKV = 180 * MiB, WS_WO = 186 * MiB, WS_WIN = 190 * MiB, WS_WOUT = 202 * MiB, WS_WGU = 206 * MiB, WS_WDN = 718 * MiB;
constexpr size_t WS_HA = 974 * MiB;
constexpr size_t WS_Q = 1046 * MiB;
constexpr size_t WS_K = 1118 * MiB, WS_V = 1136 * MiB;
constexpr size_t WS_UPRE = 1154 * MiB;
constexpr size_t WS_WC = 1370 * MiB;
constexpr size_t WS_YC = 1442 * MiB;
constexpr size_t WS_XS = 1514 * MiB;
constexpr size_t WS_AB = 1818 * MiB;
constexpr size_t WS_END = 2122 * MiB;
constexpr size_t WC_CTX_OFF = (size_t)1024 * 16 * 2048;
constexpr int CW_TMO = 0, CW_BAR = 4096, CW_CNT = 16384;

constexpr int LDS_BYTES = 160 * 1024;
constexpr int MISC_OFF = LDS_BYTES - 256;

#define RLX_AGENT __ATOMIC_RELAXED, __HIP_MEMORY_SCOPE_AGENT
#define LDS_WAIT() asm volatile("s_waitcnt lgkmcnt(0)" ::: "memory")
#define VM_WAIT() asm volatile("s_waitcnt vmcnt(0)" ::: "memory")
__device__ __forceinline__ unsigned f2bf(float f) { unsigned u = __builtin_bit_cast(unsigned, f); return (u + 0x7fffu + ((u >> 16) & 1u)) >> 16; }
__device__ __forceinline__ unsigned pk2(float lo, float hi) { return f2bf(lo) | (f2bf(hi) << 16); }
__device__ __forceinline__ float bf2f(unsigned h) { return __builtin_bit_cast(float, h << 16); }
__device__ __forceinline__ float bflo(unsigned w) { return __builtin_bit_cast(float, w << 16); }
__device__ __forceinline__ float bfhi(unsigned w) { return __builtin_bit_cast(float, w & 0xffff0000u); }
__device__ __forceinline__ float wave_sum(float v) {
#pragma unroll
    for (int o = 1; o < 64; o <<= 1) v += __shfl_xor(v, o);
    return v;
}

#define XB_TMO      128
#define XB_XCNT(j)  (256  + 64 * (j))
#define XB_XSUB(j)  (1280 + 64 * (j))
#define XB_XGEN(j)  (2304 + 64 * (j))
#define XB_TOP      3328
#define XB_TOPGEN   3392
#define XCD_BAR_WORDS 3456
#define XB_SPIN_CAP (1u << 22)
__device__ __forceinline__ unsigned xb_ld(unsigned* p)              { return __hip_atomic_load(p, __ATOMIC_RELAXED, __HIP_MEMORY_SCOPE_AGENT); }
__device__ __forceinline__ unsigned xb_add(unsigned* p, unsigned v) { return __hip_atomic_fetch_add(p, v, __ATOMIC_RELAXED, __HIP_MEMORY_SCOPE_AGENT); }
__device__ __forceinline__ unsigned xb_xcc_id() { return (unsigned)__builtin_amdgcn_s_getreg((3 << 11) | 20) & 0xFu; }
#define XB_SPIN(cond, bar) do { unsigned _sp = 0; while (cond) { __builtin_amdgcn_s_sleep(1); \
    if ((++_sp & 255u) == 0u) { if (xb_ld(&(bar)[XB_TMO])) break; if (_sp > XB_SPIN_CAP) { atomicAdd(&(bar)[XB_TMO], 1u); break; } } } } while (0)
struct XcdBarrier { unsigned* bar; unsigned x; volatile LAS unsigned* st; };
__device__ __forceinline__ XcdBarrier xcd_barrier_post(unsigned* bar, volatile LAS unsigned* st) {
    XcdBarrier b; b.bar = bar; b.x = xb_xcc_id(); b.st = st;
    if (threadIdx.x == 0) (void)xb_add(&bar[XB_XCNT(b.x)], 1u);
    return b;
}
__device__ __forceinline__ void xcd_barrier_complete(unsigned* bar, unsigned x, unsigned& nloc, unsigned& nx) {
    const unsigned G = gridDim.x * gridDim.y * gridDim.z;
    unsigned sum, cnt, mine, sp = 0u;
    for (;;) {
        sum = 0u; cnt = 0u; mine = 0u;
#pragma unroll
        for (unsigned j = 0; j < 16; ++j) { const unsigned c = xb_ld(&bar[XB_XCNT(j)]); sum += c; cnt += (c > 0u) ? 1u : 0u; mine = (j == x) ? c : mine; }
        if (sum == G) break;
        __builtin_amdgcn_s_sleep(1);
        if ((++sp & 255u) == 0u) { if (xb_ld(&bar[XB_TMO])) break; if (sp > XB_SPIN_CAP) { atomicAdd(&bar[XB_TMO], 1u); break; } }
    }
    nloc = mine > 0u ? mine : 1u; nx = cnt > 0u ? cnt : 1u;
}
__device__ __forceinline__ void xcd_barrier(const XcdBarrier& b) {
    asm volatile("s_waitcnt vmcnt(0)" ::: "memory");
    __syncthreads();
    if (threadIdx.x == 0) {
        unsigned* bar = b.bar;
        __builtin_amdgcn_s_waitcnt(0);
        unsigned nloc = b.st[0], nx = b.st[1];
        if (nloc == 0u) { xcd_barrier_complete(bar, b.x, nloc, nx); b.st[0] = nloc; b.st[1] = nx; }
        const unsigned old = xb_add(&bar[XB_XSUB(b.x)], 1u);
        const unsigned gen = old / nloc;
        if (old + 1u == (gen + 1u) * nloc) {
            __builtin_amdgcn_fence(__ATOMIC_RELEASE, "agent");
            asm volatile("s_waitcnt vmcnt(0)" ::: "memory");
            const unsigned og = xb_add(&bar[XB_TOP], 1u);
            const unsigned tg = og / nx;
            if (og + 1u == (tg + 1u) * nx) xb_add(&bar[XB_TOPGEN], 1u);
            else XB_SPIN(xb_ld(&bar[XB_TOPGEN]) == tg, bar);
            __builtin_amdgcn_fence(__ATOMIC_ACQUIRE, "agent");
            xb_add(&bar[XB_XGEN(b.x)], 1u);
            asm volatile("s_waitcnt vmcnt(0)" ::: "memory");
        } else {
            XB_SPIN(xb_ld(&bar[XB_XGEN(b.x)]) == gen, bar);
            __builtin_amdgcn_fence(__ATOMIC_ACQUIRE, "agent");
            asm volatile("s_waitcnt vmcnt(0)" ::: "memory");
        }
    }
    __syncthreads();
}

struct Args { const float* in[32]; float* out; unsigned char* ws; int ph_lo, ph_hi; };
struct Ctx {
    LAS unsigned char* lds;
    int tid, lane, wave, G, bid;
    const float* const* in;
};
enum { I_X = 0, I_C, I_CTX, I_CCTX, I_WMOD, I_BMOD, I_N1G, I_N2G, I_WQKV, I_QG, I_KG, I_WO, I_HWIN, I_HBIN, I_HCW, I_HCB, I_HW1, I_HB1, I_HW2, I_HB2, I_HW3, I_HB3,
       I_HSF, I_HDB, I_HWOUT, I_HBOUT, I_RW, I_RB, I_WGU, I_BGU, I_WDN, I_BDN };

__device__ __forceinline__ int mod_row(int r) { return r < NLAT ? (r >> 11) : NB; }

__device__ __forceinline__ void gemm_unit_simple(const bf16_t* At, const bf16_t* Bt, f32x4 (&acc)[2][2][4][2], int wr, int wc, int fr, int fq) {
    constexpr int K = D;
#pragma unroll
    for (int a = 0; a < 2; ++a)
#pragma unroll
        for (int b = 0; b < 2; ++b)
#pragma unroll
            for (int m = 0; m < 4; ++m)
#pragma unroll
                for (int n = 0; n < 2; ++n) acc[a][b][m][n] = (f32x4){0.f, 0.f, 0.f, 0.f};
    const bf16_t* ap = At + (size_t)(wr * 64 + fr) * K + fq * 8;
    const bf16_t* bp = Bt + (size_t)(wc * 32 + fr) * K + fq * 8;
    for (int k0 = 0; k0 < K; k0 += 32) {
        bf16x8 bfr[2][2];
#pragma unroll
        for (int bj = 0; bj < 2; ++bj)
#pragma unroll
            for (int n = 0; n < 2; ++n) bfr[bj][n] = *(const bf16x8*)(bp + (size_t)(bj * 128 + n * 16) * K + k0);
#pragma unroll
        for (int ai = 0; ai < 2; ++ai)
#pragma unroll
            for (int m = 0; m < 4; ++m) {
                const bf16x8 afr = *(const bf16x8*)(ap + (size_t)(ai * 128 + m * 16) * K + k0);
#pragma unroll
                for (int bj = 0; bj < 2; ++bj)
#pragma unroll
                    for (int n = 0; n < 2; ++n) acc[ai][bj][m][n] = __builtin_amdgcn_mfma_f32_16x16x32_bf16(bfr[bj][n], afr, acc[ai][bj][m][n], 0, 0, 0);
            }
    }
}

struct EpiQKV {
    bf16_t *Q, *Kb, *Vb; const float *qg, *kg, *cosT, *sinT;
    __device__ __forceinline__ void operator()(const f32x4 (&acc)[2][2][4][2], int pm, int pn, int wr, int wc, int fr, int fq) const {
        const int kind = pn < 4 ? 0 : (pn == 4 ? 1 : 2);
        const float* gain = kind == 0 ? qg : kg;
        f32x4 gv[2][2];
#pragma unroll
        for (int bj = 0; bj < 2; ++bj)
#pragma unroll
            for (int n = 0; n < 2; ++n) gv[bj][n] = *(const f32x4*)(gain + 32 * bj + 16 * n + 4 * fq);
#pragma unroll
        for (int ai = 0; ai < 2; ++ai)
#pragma unroll
            for (int m = 0; m < 4; ++m) {
                const int r = pm * 256 + ai * 128 + wr * 64 + m * 16 + fr;
                const bool lat = r < NLAT;
                const int b = lat ? (r >> 11) : ((r - NLAT) >> 8);
                const int pos = lat ? (r & (SEQ - 1)) : (SEQ + ((r - NLAT) & (CL - 1)));
                f32x4 v[2][2];
#pragma unroll
                for (int bj = 0; bj < 2; ++bj)
#pragma unroll
                    for (int n = 0; n < 2; ++n) v[bj][n] = acc[ai][bj][m][n];
                if (kind != 2) {
                    float ss = 0.f;
#pragma unroll
                    for (int bj = 0; bj < 2; ++bj)
#pragma unroll
                        for (int n = 0; n < 2; ++n) ss += (v[bj][n][0] * v[bj][n][0] + v[bj][n][1] * v[bj][n][1]) + (v[bj][n][2] * v[bj][n][2] + v[bj][n][3] * v[bj][n][3]);
                    ss += __shfl_xor(ss, 16); ss += __shfl_xor(ss, 32);
                    const float rinv = 1.0f / sqrtf(ss * (1.0f / 64.0f) + EPS);
#pragma unroll
                    for (int bj = 0; bj < 2; ++bj)
#pragma unroll
                        for (int n = 0; n < 2; ++n) v[bj][n] = v[bj][n] * rinv * gv[bj][n];
                    if (lat) {
#pragma unroll
                        for (int bj = 0; bj < 2; ++bj) {
                            const f32x4 cs = *(const f32x4*)(cosT + pos * 32 + bj * 16 + 4 * fq), sn = *(const f32x4*)(sinT + pos * 32 + bj * 16 + 4 * fq);
                            const f32x4 x1 = v[bj][0], x2 = v[bj][1];
                            v[bj][0] = x1 * cs - x2 * sn; v[bj][1] = x2 * cs + x1 * sn;
                        }
                    }
                    if (kind == 0) {
#pragma unroll
                        for (int bj = 0; bj < 2; ++bj)
#pragma unroll
                            for (int n = 0; n < 2; ++n) v[bj][n] = v[bj][n] * C2;
                    }
                }
                bf16_t* dst = kind == 0 ? Q + (size_t)r * D + pn * 256 + wc * 64
                                        : (kind == 1 ? Kb : Vb) + ((size_t)b * KVL + pos) * 256 + wc * 64;
#pragma unroll
                for (int bj = 0; bj < 2; ++bj)
#pragma unroll
                    for (int n = 0; n < 2; ++n) { u32x2 w; w.x = pk2(v[bj][n][0], v[bj][n][1]); w.y = pk2(v[bj][n][2], v[bj][n][3]); *(u32x2*)(dst + 32 * bj + 16 * n + 4 * fq) = w; }
            }
    }
};
struct EpiBiasBf16 {
    bf16_t* O; int ldc; const float* bias;
    __device__ __forceinline__ void operator()(const f32x4 (&acc)[2][2][4][2], int row0, int col0t, int wr, int wc, int fr, int fq) const {
#pragma unroll
        for (int bj = 0; bj < 2; ++bj)
#pragma unroll
            for (int n = 0; n < 2; ++n) {
                const int c = col0t + bj * 128 + wc * 32 + n * 16 + 4 * fq;
                const f32x4 bv = *(const f32x4*)(bias + c);
#pragma unroll
                for (int ai = 0; ai < 2; ++ai)
#pragma unroll
                    for (int m = 0; m < 4; ++m) { const int r = row0 + ai * 128 + wr * 64 + m * 16 + fr; const f32x4 v = acc[ai][bj][m][n] + bv;
                        u32x2 w; w.x = pk2(v[0], v[1]); w.y = pk2(v[2], v[3]); *(u32x2*)(O + (size_t)r * ldc + c) = w; }
            }
    }
};
struct EpiResid {
    const float *srcL, *srcC; float *dstL, *dstC; const float* gate  ; const float* bias;
    __device__ __forceinline__ void operator()(const f32x4 (&acc)[2][2][4][2], int row0, int col0t, int wr, int wc, int fr, int fq) const {
#pragma unroll
        for (int bj = 0; bj < 2; ++bj)
#pragma unroll
            for (int n = 0; n < 2; ++n) {
                const int c = col0t + bj * 128 + wc * 32 + n * 16 + 4 * fq;
                const f32x4 bv = bias ? *(const f32x4*)(bias + c) : (f32x4){0.f, 0.f, 0.f, 0.f};
#pragma unroll
                for (int ai = 0; ai < 2; ++ai)
#pragma unroll
                    for (int m = 0; m < 4; ++m) { const int r = row0 + ai * 128 + wr * 64 + m * 16 + fr;
                        const f32x4 g = *(const f32x4*)(gate + (size_t)mod_row(r) * MODW + c);
                        const float* s = r < NLAT ? srcL + (size_t)r * D : srcC + (size_t)(r - NLAT) * D;
                        float* d = r < NLAT ? dstL + (size_t)r * D : dstC + (size_t)(r - NLAT) * D;
                        const f32x4 x = *(const f32x4*)(s + c);
                        *(f32x4*)(d + c) = x + g * (acc[ai][bj][m][n] + bv); }
            }
    }
};
struct EpiSwiglu {
    bf16_t* O; const float* bgu  ;
    __device__ __forceinline__ void operator()(const f32x4 (&acc)[2][2][4][2], int row0, int pn, int wr, int wc, int fr, int fq) const {
#pragma unroll
        for (int n = 0; n < 2; ++n) {
            const int f = pn * 128 + wc * 32 + n * 16 + 4 * fq;
            const f32x4 b0 = *(const f32x4*)(bgu + 2 * f), b1 = *(const f32x4*)(bgu + 2 * f + 4);
            const f32x4 bg = (f32x4){b0[0], b0[2], b1[0], b1[2]}, bu = (f32x4){b0[1], b0[3], b1[1], b1[3]};
#pragma unroll
            for (int ai = 0; ai < 2; ++ai)
#pragma unroll
                for (int m = 0; m < 4; ++m) { const int r = row0 + ai * 128 + wr * 64 + m * 16 + fr;
                    const f32x4 gg = acc[ai][0][m][n] + bg, uu = acc[ai][1][m][n] + bu; float o[4];
#pragma unroll
                    for (int e = 0; e < 4; ++e) { const float g = fminf(gg[e], 7.0f), u = fminf(fmaxf(uu[e], -7.0f), 7.0f);
                        const float sg = 1.0f / (1.0f + __expf(-1.702f * g)); o[e] = (u + 1.0f) * g * sg; }
                    u32x2 w; w.x = pk2(o[0], o[1]); w.y = pk2(o[2], o[3]); *(u32x2*)(O + (size_t)r * D + f) = w; }
        }
    }
};

template <int MODE> __device__ __forceinline__ int wrow_map(int n) {
    if (MODE == 0) return n;
    if (MODE == 1) { const int pn = n >> 8, wc = (n >> 6) & 3, bj = (n >> 5) & 1, j = n & 31; return (pn << 8) + (bj << 7) + (wc << 5) + j; }
    { const int f = n >> 1, pn = f >> 7, fo = f & 127; return (pn << 8) + ((n & 1) << 7) + fo; }
}
template <int MODE> __device__ __forceinline__ void transpose_item(const float* W, int N, bf16_t* WT, LAS float* scr, int item, int lane) {
    constexpr int K = D;
    const int nblk = N / 32, kb = item / nblk, nb = item % nblk, k0 = 64 * kb, n0 = 32 * nb;
#pragma unroll 8
    for (int i = 0; i < 32; ++i) { const int kk = 2 * i + (lane >> 5); scr[kk * 33 + (lane & 31)] = W[(size_t)(k0 + kk) * N + n0 + (lane & 31)]; }
    LDS_WAIT(); asm volatile("" ::: "memory");
    const int c = lane & 7;
#pragma unroll
    for (int j = 0; j < 4; ++j) { const int n = (lane >> 3) + 8 * j; const LAS float* s = scr + (8 * c) * 33 + n;
        u32x4 o; o.x = pk2(s[0 * 33], s[1 * 33]); o.y = pk2(s[2 * 33], s[3 * 33]); o.z = pk2(s[4 * 33], s[5 * 33]); o.w = pk2(s[6 * 33], s[7 * 33]);
        *(u32x4*)(WT + (size_t)wrow_map<MODE>(n0 + n) * K + k0 + 8 * c) = o; }
    LDS_WAIT(); asm volatile("" ::: "memory");
}

__device__ __forceinline__ void norm_mod_store(const f32x4 (&v)[4], const float* gain, const float* shift, const float* scale, bf16_t* dst, int lane, f32x4 (&h)[4]) {
    float ss = 0.f;
#pragma unroll
    for (int j = 0; j < 4; ++j) ss += (v[j][0] * v[j][0] + v[j][1] * v[j][1]) + (v[j][2] * v[j][2] + v[j][3] * v[j][3]);
    ss = wave_sum(ss);
    const float rinv = 1.0f / sqrtf(ss * (1.0f / D) + EPS);
#pragma unroll
    for (int j = 0; j < 4; ++j) {
        const f32x4 g = ((const f32x4*)gain)[lane + 64 * j], sh = ((const f32x4*)shift)[lane + 64 * j], sc = ((const f32x4*)scale)[lane + 64 * j];
        h[j] = (v[j] * rinv * g) * (sc + 1.0f) + sh;
        u32x2 w; w.x = pk2(h[j][0], h[j][1]); w.y = pk2(h[j][2], h[j][3]);
        ((u32x2*)dst)[lane + 64 * j] = w;
    }
}

#define IN(k) (lo <= (k) && (k) < hi)
#define SEAM(k) do { if (IN(k) && IN((k) + 1)) xcd_barrier(bar); } while (0)
#define KLOCALS \
    const float* x_in = args.in[I_X]; const float* c_in = args.in[I_C]; const float* ctx_in = args.in[I_CTX]; const float* cctx_in = args.in[I_CCTX]; \
    float* out = args.out; \
    float* modp = (float*)(ws + WS_MODP); float* modf = (float*)(ws + WS_MOD); \
    float* cosT = (float*)(ws + WS_ROPE); float* sinT = cosT + SEQ * 32; \
    float* a2tab = (float*)(ws + WS_A2); \
    int* top_e = (int*)(ws + WS_PAIR); int* ppos = top_e + NTOK * 4; float* pgate = (float*)(ppos + NTOK * 4); int* pdest = (int*)(pgate + NTOK * 4); \
    float* ctxbuf = (float*)(ws + WS_CTX); \
    bf16_t* Wqkv_t = (bf16_t*)(ws + WS_WQKV); bf16_t* Wo_t = (bf16_t*)(ws + WS_WO); bf16_t* Win_t = (bf16_t*)(ws + WS_WIN); bf16_t* Wout_t = (bf16_t*)(ws + WS_WOUT); \
    bf16_t* Wgu_t = (bf16_t*)(ws + WS_WGU); bf16_t* Wdn_t = (bf16_t*)(ws + WS_WDN); \
    bf16_t* hA = (bf16_t*)(ws + WS_HA); bf16_t* Qb = (bf16_t*)(ws + WS_Q); bf16_t* Kb = (bf16_t*)(ws + WS_K); bf16_t* Vb = (bf16_t*)(ws + WS_V); \
    bf16_t* Upre = (bf16_t*)(ws + WS_UPRE); bf16_t* Wc = (bf16_t*)(ws + WS_WC); bf16_t* Yc = (bf16_t*)(ws + WS_YC); \
    bf16_t* XS = (bf16_t*)(ws + WS_XS); bf16_t* AB = (bf16_t*)(ws + WS_AB); \
    const int wr = wave >> 2, wc = wave & 3, fr = lane & 15, fq = lane >> 4;
template <int layer> __device__ __forceinline__ void layer_body(const Args& args, LAS unsigned char* lds, const XcdBarrier& bar, const int tid, const int lane, const int wave, const int G, const int bid, const int lo, const int hi) {
    const int gw = bid * NWAVES + wave, NGW = G * NWAVES;
    unsigned char* ws = args.ws;
    gu32* ctl = (gu32*)(ws + WS_CTL);
    KLOCALS
        const int pb = 3 + 10 * layer;
        const int jm = layer >> 1;
        const bool ctx_live = layer < 2;
        const int nrows = ctx_live ? NTOK : NLAT;
        const float* mo = modf + (size_t)layer * NMODROW * MODW;
        const float* resL = layer == 0 ? x_in : out; const float* resC = layer == 0 ? ctx_in : ctxbuf;

        if ((layer & 1) == 0) {
            if (EN_GEMM && IN(pb + 0)) {
                EpiQKV E{Qb, Kb, Vb, args.in[I_QG] + jm * 64, args.in[I_KG] + jm * 64, cosT, sinT};
                const bf16_t* Wt = Wqkv_t + (size_t)jm * NQKV * D;
                const int nlat_u = 128 * 6, nctx_u = 16 * (ctx_live ? 6 : 2);
                for (int u = bid; u < nlat_u + nctx_u; u += G) {
                    int pm, pn;
                    if (u < nlat_u) { pm = u / 6; pn = u % 6; }
                    else { const int q = u - nlat_u; if (ctx_live) { pm = 128 + q / 6; pn = q % 6; } else { pm = 128 + q / 2; pn = 4 + q % 2; } }
                    f32x4 acc[2][2][4][2];
                    gemm_unit_simple(hA + (size_t)pm * 256 * D, Wt + (size_t)pn * 256 * D, acc, wr, wc, fr, fq);
                    E(acc, pm, pn, wr, wc, fr, fq);
                }
            }
            SEAM(pb + 0);
            if (EN_ATT && IN(pb + 1)) {
                LAS bf16_t* Ks = (LAS bf16_t*)lds;
                LAS bf16_t* Vt = Ks + 64 * 72;
                const int nlat_u = NB * 4 * 32, nctx_u = ctx_live ? NB * 4 * 4 : 0;
                const int r32 = lane & 31, hi = lane >> 5, g = wave >> 1, qh = wave & 1;
                for (int u = bid; u < nlat_u + nctx_u; u += G) {
                    int b, kvh, qrow0, key0, ntile;
                    if (u < nlat_u) { b = u >> 7; kvh = (u >> 5) & 3; qrow0 = b * SEQ + (u & 31) * 64; key0 = 0; ntile = KVL / 64; }
                    else { const int q = u - nlat_u; b = q >> 4; kvh = (q >> 2) & 3; qrow0 = NLAT + b * CL + (q & 3) * 64; key0 = SEQ; ntile = CL / 64; }
                    const int head = kvh * 4 + g; const int qrow = qrow0 + 32 * qh + r32;
                    bf16x8 qr[4];
#pragma unroll
                    for (int d0 = 0; d0 < 4; ++d0) qr[d0] = *(const bf16x8*)(Qb + (size_t)qrow * D + head * 64 + d0 * 16 + hi * 8);
                    f32x16 o0, o1;
#pragma unroll
                    for (int r = 0; r < 16; ++r) { o0[r] = 0.f; o1[r] = 0.f; }
                    float mrun = -INFINITY, lrun = 0.f;
#pragma unroll 1
                    for (int t = 0; t < ntile; ++t) {
                        __syncthreads();
                        { const int key = tid >> 3, dc = (tid & 7) * 8; const size_t off = ((size_t)b * KVL + key0 + t * 64 + key) * 256 + kvh * 64 + dc;
                          const u32x4 kw = *(const u32x4*)(Kb + off), vw = *(const u32x4*)(Vb + off);
                          *(LAS u32x4*)(Ks + key * 72 + dc) = kw;
                          Vt[(dc + 0) * 72 + key] = (bf16_t)(vw.x & 0xffffu); Vt[(dc + 1) * 72 + key] = (bf16_t)(vw.x >> 16);
                          Vt[(dc + 2) * 72 + key] = (bf16_t)(vw.y & 0xffffu); Vt[(dc + 3) * 72 + key] = (bf16_t)(vw.y >> 16);
                          Vt[(dc + 4) * 72 + key] = (bf16_t)(vw.z & 0xffffu); Vt[(dc + 5) * 72 + key] = (bf16_t)(vw.z >> 16);
                          Vt[(dc + 6) * 72 + key] = (bf16_t)(vw.w & 0xffffu); Vt[(dc + 7) * 72 + key] = (bf16_t)(vw.w >> 16); }
                        __syncthreads();
                        f32x16 p0, p1;
#pragma unroll
                        for (int r = 0; r < 16; ++r) { p0[r] = 0.f; p1[r] = 0.f; }
#pragma unroll
                        for (int d0 = 0; d0 < 4; ++d0) {
                            const bf16x8 a0 = *(const LAS bf16x8*)(Ks + r32 * 72 + d0 * 16 + hi * 8), a1 = *(const LAS bf16x8*)(Ks + (32 + r32) * 72 + d0 * 16 + hi * 8);
                            p0 = __builtin_amdgcn_mfma_f32_32x32x16_bf16(a0, qr[d0], p0, 0, 0, 0); p1 = __builtin_amdgcn_mfma_f32_32x32x16_bf16(a1, qr[d0], p1, 0, 0, 0); }
                        float mx = fmaxf(p0[0], p1[0]);
#pragma unroll
                        for (int r = 1; r < 16; ++r) mx = fmaxf(mx, fmaxf(p0[r], p1[r]));
                        mx = fmaxf(mx, __shfl_xor(mx, 32));
                        const float mnew = fmaxf(mrun, mx), alpha = __builtin_amdgcn_exp2f(mrun - mnew); mrun = mnew;
                        float ps = 0.f;
#pragma unroll
                        for (int r = 0; r < 16; ++r) { p0[r] = __builtin_amdgcn_exp2f(p0[r] - mrun); p1[r] = __builtin_amdgcn_exp2f(p1[r] - mrun); ps += p0[r] + p1[r]; }
                        lrun = lrun * alpha + ps;
#pragma unroll
                        for (int r = 0; r < 16; ++r) { o0[r] *= alpha; o1[r] *= alpha; }
#pragma unroll
                        for (int s4 = 0; s4 < 4; ++s4) {
                            u32x4 pw;
                            if (s4 == 0) { pw.x = pk2(p0[0], p0[1]); pw.y = pk2(p0[2], p0[3]); pw.z = pk2(p0[4], p0[5]); pw.w = pk2(p0[6], p0[7]); }
                            else if (s4 == 1) { pw.x = pk2(p0[8], p0[9]); pw.y = pk2(p0[10], p0[11]); pw.z = pk2(p0[12], p0[13]); pw.w = pk2(p0[14], p0[15]); }
                            else if (s4 == 2) { pw.x = pk2(p1[0], p1[1]); pw.y = pk2(p1[2], p1[3]); pw.z = pk2(p1[4], p1[5]); pw.w = pk2(p1[6], p1[7]); }
                            else { pw.x = pk2(p1[8], p1[9]); pw.y = pk2(p1[10], p1[11]); pw.z = pk2(p1[12], p1[13]); pw.w = pk2(p1[14], p1[15]); }
                            const bf16x8 pf = __builtin_bit_cast(bf16x8, pw);
                            const int kvb = 32 * (s4 >> 1) + 16 * (s4 & 1) + 4 * hi;
                            { const u32x2 lo4 = *(const LAS u32x2*)(Vt + r32 * 72 + kvb), hi4 = *(const LAS u32x2*)(Vt + r32 * 72 + kvb + 8);
                              const u32x4 vv = (u32x4){lo4.x, lo4.y, hi4.x, hi4.y}; o0 = __builtin_amdgcn_mfma_f32_32x32x16_bf16(__builtin_bit_cast(bf16x8, vv), pf, o0, 0, 0, 0); }
                            { const u32x2 lo4 = *(const LAS u32x2*)(Vt + (32 + r32) * 72 + kvb), hi4 = *(const LAS u32x2*)(Vt + (32 + r32) * 72 + kvb + 8);
                              const u32x4 vv = (u32x4){lo4.x, lo4.y, hi4.x, hi4.y}; o1 = __builtin_amdgcn_mfma_f32_32x32x16_bf16(__builtin_bit_cast(bf16x8, vv), pf, o1, 0, 0, 0); }
                        }
                    }
                    const float il = 1.0f / (lrun + __shfl_xor(lrun, 32));
                    bf16_t* op = Qb + (size_t)qrow * D + head * 64;
#pragma unroll
                    for (int gq = 0; gq < 4; ++gq) {
                        u32x2 w0, w1;
                        w0.x = pk2(o0[4 * gq] * il, o0[4 * gq + 1] * il); w0.y = pk2(o0[4 * gq + 2] * il, o0[4 * gq + 3] * il);
                        w1.x = pk2(o1[4 * gq] * il, o1[4 * gq + 1] * il); w1.y = pk2(o1[4 * gq + 2] * il, o1[4 * gq + 3] * il);
                        *(u32x2*)(op + 8 * gq + 4 * hi) = w0; *(u32x2*)(op + 32 + 8 * gq + 4 * hi) = w1;
                    }
                }
            }
            SEAM(pb + 1);
            if (EN_GEMM && IN(pb + 2)) {
                EpiResid E{resL, resC, out, ctxbuf, mo + 2 * D, nullptr};
                const bf16_t* Wt = Wo_t + (size_t)jm * D * D;
                const int nu = (nrows / 256) * 4;
                for (int u = bid; u < nu; u += G) { const int pm = u >> 2, pn = u & 3; f32x4 acc[2][2][4][2];
                    gemm_unit_simple(Qb + (size_t)pm * 256 * D, Wt + (size_t)pn * 256 * D, acc, wr, wc, fr, fq);
                    E(acc, pm * 256, pn * 256, wr, wc, fr, fq); }
            }
            SEAM(pb + 2);
        } else {
            const float* cw = args.in[I_HCW] + (size_t)jm * 3 * NHY; const float* cb = args.in[I_HCB] + (size_t)jm * NHY;
            if (EN_GEMM && IN(pb + 0)) {
                EpiBiasBf16 E{Upre, NHY, args.in[I_HBIN] + (size_t)jm * NHY};
                const bf16_t* Wt = Win_t + (size_t)jm * NHY * D;
                const int nu = (nrows / 256) * 12;
                for (int u = bid; u < nu; u += G) { const int pm = u / 12, pn = u % 12; f32x4 acc[2][2][4][2];
                    gemm_unit_simple(hA + (size_t)pm * 256 * D, Wt + (size_t)pn * 256 * D, acc, wr, wc, fr, fq);
                    E(acc, pm * 256, pn * 256, wr, wc, fr, fq); }
            }
            SEAM(pb + 0);
            if (EN_MISC && IN(pb + 1)) {
                LAS bf16_t* T = (LAS bf16_t*)lds;
                const int nlat_u = NB * 32 * 16, nctx_u = ctx_live ? NB * 4 * 16 : 0;
                for (int u = bid; u < nlat_u + nctx_u; u += G) {
                    int b, s0, c0, Ls, rowb; bf16_t* dstb;
                    if (u < nlat_u) { b = u >> 9; s0 = ((u >> 4) & 31) * 64; c0 = (u & 15) * 64; Ls = SEQ; rowb = b * SEQ; dstb = Wc; }
                    else { const int q = u - nlat_u; b = q >> 6; s0 = ((q >> 4) & 3) * 64; c0 = (q & 15) * 64; Ls = CL; rowb = NLAT + b * CL; dstb = Wc + WC_CTX_OFF; }
                    const int sr = tid >> 3, cc = (tid & 7) * 8, s = s0 + sr;
                    float x1[8], vv[8];
#pragma unroll
                    for (int e = 0; e < 8; ++e) { x1[e] = cb[D + c0 + cc + e]; vv[e] = cb[2 * D + c0 + cc + e]; }
#pragma unroll
                    for (int tap = 0; tap < 3; ++tap) { const int sp = s + tap - 1;
                        if (sp >= 0 && sp < Ls) { const bf16_t* ur = Upre + (size_t)(rowb + sp) * NHY + c0 + cc; const u32x4 a = *(const u32x4*)(ur + D), bq = *(const u32x4*)(ur + 2 * D);
                            const float* w1 = cw + tap * NHY + D + c0 + cc; const float* w2 = cw + tap * NHY + 2 * D + c0 + cc;
                            const float af[8] = {bflo(a.x), bfhi(a.x), bflo(a.y), bfhi(a.y), bflo(a.z), bfhi(a.z), bflo(a.w), bfhi(a.w)};
                            const float bf[8] = {bflo(bq.x), bfhi(bq.x), bflo(bq.y), bfhi(bq.y), bflo(bq.z), bfhi(bq.z), bflo(bq.w), bfhi(bq.w)};
#pragma unroll
                            for (int e = 0; e < 8; ++e) { x1[e] += af[e] * w1[e]; vv[e] += bf[e] * w2[e]; } } }
                    __syncthreads();
#pragma unroll
                    for (int e = 0; e < 8; ++e) T[(cc + e) * 72 + sr] = (bf16_t)f2bf(x1[e] * vv[e]);
                    __syncthreads();
                    { const int c = tid >> 3, sc = (tid & 7) * 8; const u32x4 w = *(const LAS u32x4*)(T + c * 72 + sc);
                      *(u32x4*)(dstb + ((size_t)(c0 + c) * NB + b) * Ls + s0 + sc) = w; }
                }
            }
            SEAM(pb + 1);
            if (EN_CONV && IN(pb + 2)) {
                LAS float* GF = (LAS float*)lds;
                const int nlat_u = 1024, nctx_u = ctx_live ? 1024 : 0;
                for (int u = bid; u < nlat_u + nctx_u; u += G) {
                    const bool isl = u < nlat_u; const int c = isl ? u : u - nlat_u; const int Lf = isl ? SEQ : CL; const int P = 2 * Lf + 8;
                    LAS float* WF = GF + 2 * Lf;
                    const bf16_t* FI = (const bf16_t*)(ws + (isl ? (jm == 0 ? WS_FI0 : WS_FI1) : WS_FI2)) + (size_t)c * 8 * P;
                    const bf16_t* wsrc = (isl ? Wc : Wc + WC_CTX_OFF) + (size_t)c * NB * Lf; bf16_t* ydst = (isl ? Yc : Yc + WC_CTX_OFF) + (size_t)c * NB * Lf;
                    __syncthreads();
                    for (int i = tid; i < 2 * Lf; i += NTHR) GF[i] = (i >= 1) ? bf2f(FI[2 * Lf - i]) : 0.f;
                    for (int i = tid; i < NB * Lf / 8; i += NTHR) { const int b = i / (Lf / 8), s8 = (i % (Lf / 8)) * 8; const u32x4 w = *(const u32x4*)(wsrc + (size_t)b * Lf + s8);
                        const float f[8] = {bflo(w.x), bfhi(w.x), bflo(w.y), bfhi(w.y), bflo(w.z), bfhi(w.z), bflo(w.w), bfhi(w.w)};
#pragma unroll
                        for (int e = 0; e < 8; ++e) WF[(s8 + e) * 16 + b] = f[e]; }
                    __syncthreads();
                    float acc[4][16];
#pragma unroll
                    for (int r = 0; r < 4; ++r)
#pragma unroll
                        for (int b = 0; b < 16; ++b) acc[r][b] = 0.f;
                    const int tbase = tid + Lf;
                    const bool act = tid < Lf;
                    if (isl) {
                        for (int s = 0; s < SEQ; ++s) { const LAS f32x4* wp = (const LAS f32x4*)(WF + s * 16); const f32x4 w0 = wp[0], w1 = wp[1], w2 = wp[2], w3 = wp[3];
#pragma unroll
                            for (int r = 0; r < 4; ++r) { const float gi = GF[tbase + 512 * r - s];
                                acc[r][0] += gi * w0[0]; acc[r][1] += gi * w0[1]; acc[r][2] += gi * w0[2]; acc[r][3] += gi * w0[3]; acc[r][4] += gi * w1[0]; acc[r][5] += gi * w1[1]; acc[r][6] += gi * w1[2]; acc[r][7] += gi * w1[3];
                                acc[r][8] += gi * w2[0]; acc[r][9] += gi * w2[1]; acc[r][10] += gi * w2[2]; acc[r][11] += gi * w2[3]; acc[r][12] += gi * w3[0]; acc[r][13] += gi * w3[1]; acc[r][14] += gi * w3[2]; acc[r][15] += gi * w3[3]; } }
#pragma unroll
                        for (int r = 0; r < 4; ++r)
#pragma unroll
                            for (int b = 0; b < 16; ++b) ydst[(size_t)b * SEQ + tid + 512 * r] = (bf16_t)f2bf(acc[r][b]);
                    } else if (act) {
                        for (int s = 0; s < CL; ++s) { const LAS f32x4* wp = (const LAS f32x4*)(WF + s * 16); const f32x4 w0 = wp[0], w1 = wp[1], w2 = wp[2], w3 = wp[3];
                            const float gi = GF[tbase - s];
                            acc[0][0] += gi * w0[0]; acc[0][1] += gi * w0[1]; acc[0][2] += gi * w0[2]; acc[0][3] += gi * w0[3]; acc[0][4] += gi * w1[0]; acc[0][5] += gi * w1[1]; acc[0][6] += gi * w1[2]; acc[0][7] += gi * w1[3];
                            acc[0][8] += gi * w2[0]; acc[0][9] += gi * w2[1]; acc[0][10] += gi * w2[2]; acc[0][11] += gi * w2[3]; acc[0][12] += gi * w3[0]; acc[0][13] += gi * w3[1]; acc[0][14] += gi * w3[2]; acc[0][15] += gi * w3[3]; }
#pragma unroll
                        for (int b = 0; b < 16; ++b) ydst[(size_t)b * CL + tid] = (bf16_t)f2bf(acc[0][b]);
                    }
                }
            }
            SEAM(pb + 2);
            if (EN_MISC && IN(pb + 3)) {
                LAS bf16_t* T = (LAS bf16_t*)lds;
                const int nlat_u = NB * 32 * 16, nctx_u = ctx_live ? NB * 4 * 16 : 0;
                for (int u = bid; u < nlat_u + nctx_u; u += G) {
                    int b, s0, c0, Ls, rowb; const bf16_t* srcb;
                    if (u < nlat_u) { b = u >> 9; s0 = ((u >> 4) & 31) * 64; c0 = (u & 15) * 64; Ls = SEQ; rowb = b * SEQ; srcb = Yc; }
                    else { const int q = u - nlat_u; b = q >> 6; s0 = ((q >> 4) & 3) * 64; c0 = (q & 15) * 64; Ls = CL; rowb = NLAT + b * CL; srcb = Yc + WC_CTX_OFF; }
                    __syncthreads();
                    { const int c = tid >> 3, sc = (tid & 7) * 8; *(LAS u32x4*)(T + c * 72 + sc) = *(const u32x4*)(srcb + ((size_t)(c0 + c) * NB + b) * Ls + s0 + sc); }
                    __syncthreads();
                    const int sr = tid >> 3, cc = (tid & 7) * 8, s = s0 + sr;
                    float x0[8];
#pragma unroll
                    for (int e = 0; e < 8; ++e) x0[e] = cb[c0 + cc + e];
#pragma unroll
                    for (int tap = 0; tap < 3; ++tap) { const int sp = s + tap - 1;
                        if (sp >= 0 && sp < Ls) { const u32x4 a = *(const u32x4*)(Upre + (size_t)(rowb + sp) * NHY + c0 + cc); const float* w0 = cw + tap * NHY + c0 + cc;
                            const float af[8] = {bflo(a.x), bfhi(a.x), bflo(a.y), bfhi(a.y), bflo(a.z), bfhi(a.z), bflo(a.w), bfhi(a.w)};
#pragma unroll
                            for (int e = 0; e < 8; ++e) x0[e] += af[e] * w0[e]; } }
                    float z[8];
#pragma unroll
                    for (int e = 0; e < 8; ++e) z[e] = x0[e] * bf2f(T[(cc + e) * 72 + sr]);
                    u32x4 o; o.x = pk2(z[0], z[1]); o.y = pk2(z[2], z[3]); o.z = pk2(z[4], z[5]); o.w = pk2(z[6], z[7]);
                    *(u32x4*)(hA + (size_t)(rowb + s) * D + c0 + cc) = o;
                }
            }
            SEAM(pb + 3);
            if (EN_GEMM && IN(pb + 4)) {
                EpiResid E{resL, resC, out, ctxbuf, mo + 2 * D, args.in[I_HBOUT] + (size_t)jm * D};
                const bf16_t* Wt = Wout_t + (size_t)jm * D * D;
                const int nu = (nrows / 256) * 4;
                for (int u = bid; u < nu; u += G) { const int pm = u >> 2, pn = u & 3; f32x4 acc[2][2][4][2];
                    gemm_unit_simple(hA + (size_t)pm * 256 * D, Wt + (size_t)pn * 256 * D, acc, wr, wc, fr, fq);
                    E(acc, pm * 256, pn * 256, wr, wc, fr, fq); }
            }
            SEAM(pb + 4);
        }

        gu32* cnt = ctl + CW_CNT + layer * 32 * 64;
        if (EN_ROUTER && IN(pb + 5)) {
            LAS float* WrT = (LAS float*)lds;
            __syncthreads();
            { const float* rw = args.in[I_RW] + (size_t)layer * D * NE;
              for (int i = tid; i < D * NE; i += NTHR) { const int k = i >> 5, e = i & 31; WrT[e * D + k] = rw[i]; } }
            __syncthreads();
            const float* rb = args.in[I_RB] + layer * NE; const float* g2 = args.in[I_N2G] + layer * D;
            for (int r = gw; r < nrows; r += NGW) {
                const float* src = r < NLAT ? out + (size_t)r * D : ctxbuf + (size_t)(r - NLAT) * D;
                f32x4 v[4], h[4];
#pragma unroll
                for (int j = 0; j < 4; ++j) v[j] = ((const f32x4*)src)[lane + 64 * j];
                const float* mr = mo + (size_t)mod_row(r) * MODW;
                norm_mod_store(v, g2, mr + 3 * D, mr + 4 * D, hA + (size_t)r * D, lane, h);
                float p[32];
                asm volatile("" ::: "memory");
#pragma unroll
                for (int e = 0; e < 32; ++e) { float a = 0.f; if ((e & 3) == 0) asm volatile("" ::: "memory");
#pragma unroll
                    for (int j = 0; j < 4; ++j) { const f32x4 w = *(const LAS f32x4*)(WrT + e * D + 256 * j + 4 * lane); a += (h[j][0] * w[0] + h[j][1] * w[1]) + (h[j][2] * w[2] + h[j][3] * w[3]); }
                    p[e] = a; }
#pragma unroll
                for (int i = 0; i < 16; ++i) { const bool up = (lane & 32) != 0; const float send = up ? p[i] : p[i + 16], keep = up ? p[i + 16] : p[i]; p[i] = keep + __shfl_xor(send, 32); }
#pragma unroll
                for (int i = 0; i < 8; ++i) { const bool up = (lane & 16) != 0; const float send = up ? p[i] : p[i + 8], keep = up ? p[i + 8] : p[i]; p[i] = keep + __shfl_xor(send, 16); }
#pragma unroll
                for (int i = 0; i < 4; ++i) { const bool up = (lane & 8) != 0; const float send = up ? p[i] : p[i + 4], keep = up ? p[i + 4] : p[i]; p[i] = keep + __shfl_xor(send, 8); }
#pragma unroll
                for (int i = 0; i < 2; ++i) { const bool up = (lane & 4) != 0; const float send = up ? p[i] : p[i + 2], keep = up ? p[i + 2] : p[i]; p[i] = keep + __shfl_xor(send, 4); }
                { const bool up = (lane & 2) != 0; const float send = up ? p[0] : p[1], keep = up ? p[1] : p[0]; p[0] = keep + __shfl_xor(send, 2); }
                p[0] += __shfl_xor(p[0], 1);
                const int myE = lane >> 1;
                float val = p[0] + rb[myE];
                float sv[4]; int si[4];
#pragma unroll
                for (int k = 0; k < 4; ++k) { float bv = val; int bi = myE;
#pragma unroll
                    for (int off = 1; off < 64; off <<= 1) { const float ov = __shfl_xor(bv, off); const int oi = __shfl_xor(bi, off); if (ov > bv || (ov == bv && oi < bi)) { bv = ov; bi = oi; } }
                    sv[k] = bv; si[k] = bi; if (myE == bi) val = -INFINITY; }
                const float e1 = __expf(sv[1] - sv[0]), e2 = __expf(sv[2] - sv[0]), e3 = __expf(sv[3] - sv[0]); const float inv = 1.0f / (1.0f + e1 + e2 + e3);
                if (lane < 4) { const int e = lane == 0 ? si[0] : (lane == 1 ? si[1] : (lane == 2 ? si[2] : si[3])); const float gt = (lane == 0 ? 1.0f : (lane == 1 ? e1 : (lane == 2 ? e2 : e3))) * inv;
                    const unsigned pos = __hip_atomic_fetch_add(cnt + e * 64, 1u, RLX_AGENT);
                    top_e[r * 4 + lane] = e; ppos[r * 4 + lane] = (int)pos; pgate[r * 4 + lane] = gt; }
            }
        }
        SEAM(pb + 5);
        LAS int* PADS = (LAS int*)(lds + LDS_BYTES - 4096);
        LAS unsigned char* TE = (LAS unsigned char*)(PADS + 128);
        if (IN(pb + 6) || IN(pb + 7) || IN(pb + 8) || IN(pb + 9)) {
            __syncthreads();
            if (tid < 32) PADS[64 + tid] = (int)__hip_atomic_load(cnt + tid * 64, RLX_AGENT);
            __syncthreads();
            if (tid == 0) { int a = 0; for (int e = 0; e < 32; ++e) { PADS[e] = a; const int nt = (PADS[64 + e] + 255) >> 8; for (int t = 0; t < nt; ++t) TE[(a >> 8) + t] = (unsigned char)e; a += nt * 256; } PADS[32] = a; }
            __syncthreads();
        }
        if (EN_MISC && IN(pb + 6)) {
            for (int pr = gw; pr < nrows * 4; pr += NGW) {
                const int e = top_e[pr], dest = PADS[e] + ppos[pr]; if (lane == 0) pdest[pr] = dest;
                const u32x4* s = (const u32x4*)(hA + (size_t)(pr >> 2) * D); u32x4* d = (u32x4*)(XS + (size_t)dest * D);
                d[lane] = s[lane]; d[lane + 64] = s[lane + 64];
            }
            for (int e = 0; e < 32; ++e) { const int c0 = PADS[e] + PADS[64 + e], c1 = PADS[e + 1];
                for (int rr = c0 + gw; rr < c1; rr += NGW) { u32x4* d = (u32x4*)(XS + (size_t)rr * D); d[lane] = (u32x4){0u, 0u, 0u, 0u}; d[lane + 64] = (u32x4){0u, 0u, 0u, 0u}; } }
        }
        SEAM(pb + 6);
        if (EN_GEMM && IN(pb + 7)) {
            const int ntile = PADS[32] >> 8;
            for (int u = bid; u < ntile * 8; u += G) { const int rt = u >> 3, pn = u & 7, e = TE[rt]; f32x4 acc[2][2][4][2];
                gemm_unit_simple(XS + (size_t)rt * 256 * D, Wgu_t + ((size_t)(layer * NE + e) * NGU + pn * 256) * D, acc, wr, wc, fr, fq);
                EpiSwiglu E{AB, args.in[I_BGU] + (size_t)(layer * NE + e) * NGU};
                E(acc, rt * 256, pn, wr, wc, fr, fq); }
        }
        SEAM(pb + 7);
        if (EN_GEMM && IN(pb + 8)) {
            const int ntile = PADS[32] >> 8;
            for (int u = bid; u < ntile * 4; u += G) { const int rt = u >> 2, pn = u & 3, e = TE[rt]; f32x4 acc[2][2][4][2];
                gemm_unit_simple(AB + (size_t)rt * 256 * D, Wdn_t + ((size_t)(layer * NE + e) * D + pn * 256) * D, acc, wr, wc, fr, fq);
                EpiBiasBf16 E{XS, D, args.in[I_BDN] + (size_t)(layer * NE + e) * D};
                E(acc, rt * 256, pn * 256, wr, wc, fr, fq); }
        }
        SEAM(pb + 8);
        if (EN_MISC && IN(pb + 9)) {
            const bool has_next = layer + 1 < DEPTH;
            const float* mo_n = modf + (size_t)(layer + 1) * NMODROW * MODW; const float* g1n = args.in[I_N1G] + (has_next ? (layer + 1) * D : 0);
            const int nnext = (layer + 1 < 3) ? NTOK : NLAT;
            for (int r = gw; r < nrows; r += NGW) {
                float* xr = r < NLAT ? out + (size_t)r * D : ctxbuf + (size_t)(r - NLAT) * D;
                const float* mr = mo + (size_t)mod_row(r) * MODW + 5 * D;
                f32x4 y[4];
#pragma unroll
                for (int j = 0; j < 4; ++j) y[j] = (f32x4){0.f, 0.f, 0.f, 0.f};
#pragma unroll
                for (int k = 0; k < 4; ++k) { const int dest = pdest[r * 4 + k]; const float gt = pgate[r * 4 + k]; const u32x2* yr = (const u32x2*)(XS + (size_t)dest * D);
#pragma unroll
                    for (int j = 0; j < 4; ++j) { const u32x2 w = yr[lane + 64 * j]; y[j][0] += gt * bflo(w.x); y[j][1] += gt * bfhi(w.x); y[j][2] += gt * bflo(w.y); y[j][3] += gt * bfhi(w.y); } }
                f32x4 v[4], h[4];
#pragma unroll
                for (int j = 0; j < 4; ++j) { const f32x4 g = ((const f32x4*)mr)[lane + 64 * j]; v[j] = ((const f32x4*)xr)[lane + 64 * j] + g * y[j]; ((f32x4*)xr)[lane + 64 * j] = v[j]; }
                if (has_next && r < nnext) { const float* mn = mo_n + (size_t)mod_row(r) * MODW; norm_mod_store(v, g1n, mn, mn + D, hA + (size_t)r * D, lane, h); }
            }
        }
        SEAM(pb + 9);
}

__global__ void __launch_bounds__(NTHR, 2) fwd(Args args) {
    extern __shared__ __attribute__((aligned(16))) unsigned char lds_raw[];
    LAS unsigned char* lds = (LAS unsigned char*)lds_raw;
    const int tid = threadIdx.x, lane = tid & 63, wave = __builtin_amdgcn_readfirstlane(tid >> 6);
    const int G = gridDim.x, bid = blockIdx.x;
    const int gw = bid * NWAVES + wave, NGW = G * NWAVES;
    unsigned char* ws = args.ws;
    gu32* ctl = (gu32*)(ws + WS_CTL);
    volatile LAS unsigned* MISC = (volatile LAS unsigned*)(lds + MISC_OFF);
    if (tid < 64) MISC[tid] = 0u;
    __syncthreads();
    XcdBarrier bar; bar.bar = (unsigned*)ctl + CW_BAR; bar.x = 0; bar.st = MISC + 8;
    const int lo = args.ph_lo, hi = args.ph_hi;
    if (hi - lo > 1) bar = xcd_barrier_post((unsigned*)ctl + CW_BAR, MISC + 8);

    KLOCALS

    if (EN_PRO && IN(0)) {
        {
            LAS float* scr = (LAS float*)(lds + wave * 8448);
            constexpr int IT_QKV = 16 * (NQKV / 32), IT_SQ = 16 * (D / 32), IT_IN = 16 * (NHY / 32), IT_GU = 16 * (NGU / 32);
            constexpr int N0 = 2 * IT_QKV, N1 = N0 + 2 * IT_SQ, N2 = N1 + 2 * IT_IN, N3 = N2 + 2 * IT_SQ, N4 = N3 + 128 * IT_GU, N5 = N4 + 128 * IT_SQ;
            for (int it = gw; it < N5; it += NGW) {
                if (it < N0) { const int mtx = it / IT_QKV, r = it % IT_QKV; transpose_item<1>(args.in[I_WQKV] + (size_t)mtx * D * NQKV, NQKV, Wqkv_t + (size_t)mtx * NQKV * D, scr, r, lane); }
                else if (it < N1) { const int q = it - N0, mtx = q / IT_SQ, r = q % IT_SQ; transpose_item<0>(args.in[I_WO] + (size_t)mtx * D * D, D, Wo_t + (size_t)mtx * D * D, scr, r, lane); }
                else if (it < N2) { const int q = it - N1, mtx = q / IT_IN, r = q % IT_IN; transpose_item<0>(args.in[I_HWIN] + (size_t)mtx * D * NHY, NHY, Win_t + (size_t)mtx * NHY * D, scr, r, lane); }
                else if (it < N3) { const int q = it - N2, mtx = q / IT_SQ, r = q % IT_SQ; transpose_item<0>(args.in[I_HWOUT] + (size_t)mtx * D * D, D, Wout_t + (size_t)mtx * D * D, scr, r, lane); }
                else if (it < N4) { const int q = it - N3, mtx = q / IT_GU, r = q % IT_GU; transpose_item<2>(args.in[I_WGU] + (size_t)mtx * D * NGU, NGU, Wgu_t + (size_t)mtx * NGU * D, scr, r, lane); }
                else { const int q = it - N4, mtx = q / IT_SQ, r = q % IT_SQ; transpose_item<0>(args.in[I_WDN] + (size_t)mtx * D * D, D, Wdn_t + (size_t)mtx * D * D, scr, r, lane); }
            }
        }
        __syncthreads();
        {
            LAS float* S = (LAS float*)lds;
            for (int u = bid; u < 4 * 12 * 8; u += G) {
                const int kc = u & 7, cc = (u >> 3) % 12, layer = u / 96;
                __syncthreads();
                for (int i = tid; i < 128 * 20; i += NTHR) { const int k = i / 20, r = i % 20; float v = 0.f;
                    if (r < NMODROW) { const float cv = r < NB ? c_in[r * D + kc * 128 + k] : cctx_in[kc * 128 + k]; v = cv / (1.0f + __expf(-cv)); }
                    S[i] = v; }
                __syncthreads();
                const int col = cc * 512 + tid;
                const float* wp = args.in[I_WMOD] + ((size_t)layer * D + kc * 128) * MODW + col;
                float acc[20];
#pragma unroll
                for (int r = 0; r < 20; ++r) acc[r] = 0.f;
                for (int k = 0; k < 128; ++k) { const float w = wp[(size_t)k * MODW];
#pragma unroll
                    for (int q = 0; q < 5; ++q) { const f32x4 s = *(const LAS f32x4*)(S + k * 20 + 4 * q);
                        acc[4 * q] += s[0] * w; acc[4 * q + 1] += s[1] * w; acc[4 * q + 2] += s[2] * w; acc[4 * q + 3] += s[3] * w; } }
#pragma unroll
                for (int r = 0; r < NMODROW; ++r) modp[((size_t)(kc * 4 + layer) * NMODROW + r) * MODW + col] = acc[r];
            }
        }
        for (int i = bid * NTHR + tid; i < SEQ * 32; i += G * NTHR) {
            const int t = i >> 5, j = i & 31, fi = j & 15; const int pos = (j >> 4) == 0 ? (t >> 6) : (t & 63);
            const float inv = powf(10000.0f, -(float)fi / 16.0f); const float ang = (float)pos * inv;
            cosT[i] = cosf(ang); sinT[i] = sinf(ang);
        }
        {
            __syncthreads();
            LAS float* Z = (LAS float*)lds;
            LAS float* A1 = Z + 8 * 36;
            for (int u = bid; u < 256 + 256 + 32; u += G) {
                const int combo = u < 256 ? 0 : (u < 512 ? 1 : 2); const int ub = combo == 0 ? u : (combo == 1 ? u - 256 : u - 512);
                const int j = combo == 1 ? 1 : 0, Lf = combo == 2 ? CL : SEQ;
                const int tl = tid >> 6, o = tid & 63, t = ub * 8 + tl;
                __syncthreads();
                if (o < 33) { float z;
                    const float tt = (float)t / (float)(Lf - 1), w = 6.283185307179586f * (float)t / (float)Lf;
                    if (o == 0) z = tt; else { const int b = (o - 1) & 15; const float f = 1e-4f + (float)b * ((15.0f - 1e-4f) / 15.0f); z = o <= 16 ? cosf(f * w) : -sinf(f * w); }
                    Z[tl * 36 + o] = z; }
                __syncthreads();
                const float sf = args.in[I_HSF][j * 64 + o];
                { const float* w1 = args.in[I_HW1] + (size_t)j * 33 * 64; float a = args.in[I_HB1][j * 64 + o];
                  for (int i = 0; i < 33; ++i) a += Z[tl * 36 + i] * w1[i * 64 + o];
                  A1[tl * 64 + o] = sinf(sf * a); }
                __syncthreads();
                { const float* w2 = args.in[I_HW2] + (size_t)j * 64 * 64; float a = args.in[I_HB2][j * 64 + o];
                  for (int i = 0; i < 64; ++i) a += A1[tl * 64 + i] * w2[i * 64 + o];
                  a2tab[((size_t)combo * SEQ + t) * 64 + o] = sinf(sf * a); }
            }
        }
    }
    SEAM(0);

    if (EN_PRO && IN(1)) {
        for (int i = bid * NTHR + tid; i < DEPTH * NMODROW * MODW; i += G * NTHR) {
            const int layer = i / (NMODROW * MODW), rem = i % (NMODROW * MODW), col = rem % MODW; float s = args.in[I_BMOD][layer * MODW + col];
#pragma unroll
            for (int kc = 0; kc < 8; ++kc) s += modp[(size_t)(kc * 4 + layer) * NMODROW * MODW + rem];
            modf[i] = s;
        }
        {
            LAS float* W3 = (LAS float*)lds;
            LAS float* RED = W3 + 512;
            LAS float* NRM = RED + 32;
            LAS float* HF = NRM + 4;
            for (int u = bid; u < 3 * 256; u += G) {
                const int combo = u >> 8, cg = u & 255; const int j = combo == 1 ? 1 : 0, Lf = combo == 2 ? CL : SEQ; const int c0 = cg * 4;
                LAS float* HB = HF + 4 * Lf;
                __syncthreads();
                { const int i = tid >> 3, q = tid & 7; const int col = (q >> 2) * 1024 + c0 + (q & 3);
                  W3[i * 8 + q] = args.in[I_HW3][((size_t)j * 64 + i) * 2048 + col]; }
                __syncthreads();
                float b3v[8], dec[4], asum[4] = {0.f, 0.f, 0.f, 0.f};
#pragma unroll
                for (int q = 0; q < 8; ++q) b3v[q] = args.in[I_HB3][j * 2048 + (q >> 2) * 1024 + c0 + (q & 3)];
#pragma unroll
                for (int ch = 0; ch < 4; ++ch) dec[ch] = 3.0701134573253945f + (float)(c0 + ch) * ((15.350567286626972f - 3.0701134573253945f) / 1023.0f);
                for (int t = tid; t < Lf; t += NTHR) {
                    asm volatile("" ::: "memory");
                    const float* ar = a2tab + ((size_t)combo * SEQ + t) * 64; float d[8];
#pragma unroll
                    for (int q = 0; q < 8; ++q) d[q] = b3v[q];
#pragma unroll
                    for (int i4 = 0; i4 < 16; ++i4) { const f32x4 a = *(const f32x4*)(ar + 4 * i4); asm volatile("" ::: "memory");
#pragma unroll
                        for (int e = 0; e < 4; ++e) { const f32x4 w0 = *(const LAS f32x4*)(W3 + (4 * i4 + e) * 8), w1 = *(const LAS f32x4*)(W3 + (4 * i4 + e) * 8 + 4);
                            d[0] += a[e] * w0[0]; d[1] += a[e] * w0[1]; d[2] += a[e] * w0[2]; d[3] += a[e] * w0[3]; d[4] += a[e] * w1[0]; d[5] += a[e] * w1[1]; d[6] += a[e] * w1[2]; d[7] += a[e] * w1[3]; } }
                    const float tt = (float)t / (float)(Lf - 1);
#pragma unroll
                    for (int ch = 0; ch < 4; ++ch) { const float dk = __expf(-tt * dec[ch]); const float f = d[ch] * dk, bb = d[4 + ch] * dk;
                        HF[ch * Lf + t] = f; HB[ch * Lf + t] = bb; asum[ch] += fabsf(f) + (t >= 1 ? fabsf(bb) : 0.f); }
                }
#pragma unroll
                for (int ch = 0; ch < 4; ++ch) { const float s = wave_sum(asum[ch]); if (lane == 0) RED[wave * 4 + ch] = s; }
                __syncthreads();
                if (tid < 4) { float s = 0.f; for (int w = 0; w < 8; ++w) s += RED[w * 4 + tid]; NRM[tid] = 1.0f / (s + EPS); }
                __syncthreads();
                const int P = 2 * Lf + 8, PC8 = P / 8;
                bf16_t* FI = (bf16_t*)(ws + (combo == 0 ? WS_FI0 : (combo == 1 ? WS_FI1 : WS_FI2)));
                for (int q = tid; q < 4 * 8 * PC8; q += NTHR) {
                    const int ch = q / (8 * PC8), r = q % (8 * PC8), cidx = r / PC8, x0 = (r % PC8) * 8;
                    const float nr = NRM[ch], db = args.in[I_HDB][j * 1024 + c0 + ch]; float v[8];
#pragma unroll
                    for (int e = 0; e < 8; ++e) { const int m = Lf - (x0 + e) + cidx; const int am = m < 0 ? -m : m; float g = 0.f;
                        if (am <= Lf - 1) { g = (m >= 0 ? HF[ch * Lf + am] : HB[ch * Lf + am]) * nr; if (m == 0) g += db; }
                        v[e] = g; }
                    u32x4 o; o.x = pk2(v[0], v[1]); o.y = pk2(v[2], v[3]); o.z = pk2(v[4], v[5]); o.w = pk2(v[6], v[7]);
                    *(u32x4*)(FI + ((size_t)((c0 + ch) * 8 + cidx)) * P + x0) = o;
                }
            }
        }
    }
    SEAM(1);

    if (IN(2)) {
        const float* mo = modf;
        for (int r = gw; r < NTOK; r += NGW) {
            const float* src = r < NLAT ? x_in + (size_t)r * D : ctx_in + (size_t)(r - NLAT) * D;
            f32x4 v[4], h[4];
#pragma unroll
            for (int j = 0; j < 4; ++j) v[j] = ((const f32x4*)src)[lane + 64 * j];
            const float* mr = mo + (size_t)mod_row(r) * MODW;
            norm_mod_store(v, args.in[I_N1G], mr, mr + D, hA + (size_t)r * D, lane, h);
        }
    }
    SEAM(2);

    layer_body<0>(args, lds, bar, tid, lane, wave, G, bid, lo, hi);
    layer_body<1>(args, lds, bar, tid, lane, wave, G, bid, lo, hi);
    layer_body<2>(args, lds, bar, tid, lane, wave, G, bid, lo, hi);
    layer_body<3>(args, lds, bar, tid, lane, wave, G, bid, lo, hi);
#undef IN
#undef SEAM
}

extern "C" void kernel_launch(void* const* d_in, const int* in_sizes, int n_in, void* d_out, int out_size, void* d_ws, size_t ws_size, hipStream_t stream) {
    static int grid = 0;
    if (grid == 0) {
        if (n_in != 32 || out_size != NLAT * D || ws_size < WS_END) { fprintf(stderr, "kernel_launch: unexpected problem (n_in %d, out %d, ws %zu)\n", n_in, out_size, ws_size); grid = -1; return; }
        int dev = 0, cus = 0, per_cu = 0;
        if (hipGetDevice(&dev) != hipSuccess || hipDeviceGetAttribute(&cus, hipDeviceAttributeMultiprocessorCount, dev) != hipSuccess) { grid = -1; return; }
        if (hipFuncSetAttribute((const void*)fwd, hipFuncAttributeMaxDynamicSharedMemorySize, LDS_BYTES) != hipSuccess) { fprintf(stderr, "kernel_launch: hipFuncSetAttribute failed\n"); grid = -1; return; }
        if (hipOccupancyMaxActiveBlocksPerMultiprocessor(&per_cu, (const void*)fwd, NTHR, LDS_BYTES) != hipSuccess || per_cu < 1) fprintf(stderr, "kernel_launch: occupancy query says %d\n", per_cu);
        (void)hipGetLastError();
        grid = cus;
    }
    if (grid < 0) return;
    (void)hipMemsetAsync((char*)d_ws + WS_CTL, 0, CTL_ZERO_BYTES, stream);
    Args a{};
    for (int i = 0; i < 32; ++i) a.in[i] = (const float*)d_in[i];
    a.out = (float*)d_out; a.ws = (unsigned char*)d_ws;
    constexpr int NPH = 3 + 10 * DEPTH;
#if MK_ONE_LAUNCH
    a.ph_lo = 0; a.ph_hi = NPH;
    hipLaunchKernelGGL(fwd, dim3(grid), dim3(NTHR), LDS_BYTES, stream, a);
#else
    for (int p = 0; p < NPH; ++p) {
        if (p >= 3) { const int layer = (p - 3) / 10, loc = (p - 3) % 10; if ((layer & 1) == 0 && (loc == 3 || loc == 4)) continue; }
        a.ph_lo = p; a.ph_hi = p + 1;
        hipLaunchKernelGGL(fwd, dim3(grid), dim3(NTHR), LDS_BYTES, stream, a);
    }
#endif
}
```

```cpp
#include <hip/hip_runtime.h>
#include <cstdio>
#include <cstdint>

#ifndef EN_PRO
#define EN_PRO 1
#endif
#ifndef EN_ATT
#define EN_ATT 1
#endif
#ifndef EN_CONV
#define EN_CONV 1
#endif
#ifndef EN_ROUTER
#define EN_ROUTER 1
#endif
#ifndef EN_GEMM
#define EN_GEMM 1
#endif
#ifndef EN_MISC
#define EN_MISC 1
#endif
#ifndef MK_ONE_LAUNCH
#define MK_ONE_LAUNCH 1
#endif

#define GAS __attribute__((address_space(1)))
#define LAS __attribute__((address_space(3)))
typedef unsigned short bf16_t;
typedef short bf16x8 __attribute__((ext_vector_type(8)));
typedef float f32x4 __attribute__((ext_vector_type(4)));
typedef float f32x2 __attribute__((ext_vector_type(2)));
typedef unsigned u32x4 __attribute__((ext_vector_type(4)));
typedef unsigned u32x2 __attribute__((ext_vector_type(2)));
typedef GAS unsigned gu32;
typedef float f32x16 __attribute__((ext_vector_type(16)));

constexpr int D = 1024, NB = 16, SEQ = 2048, CL = 256, KVL = SEQ + CL;
constexpr int NLAT = NB * SEQ, NCTX = NB * CL, NTOK = NLAT + NCTX;
constexpr int NE = 32, TOPK = 4, DEPTH = 4;
constexpr int MODW = 6 * D, NMODROW = NB + 1;
constexpr int NQKV = 1536, NHY = 3072, NGU = 2048;
constexpr float EPS = 1e-6f;
constexpr float C2 = 0.125f * 1.4426950408889634f;
constexpr int NWAVES = 8, NTHR = 512;
constexpr int NPADROWS = 155648;
constexpr int MAXTILES = NPADROWS / 256;

constexpr size_t MiB = 1u << 20;
constexpr size_t WS_CTL = 0, CTL_ZERO_BYTES = 1 * MiB;
constexpr size_t WS_MODP = 2 * MiB;
constexpr size_t WS_MOD = 16 * MiB;
constexpr size_t WS_ROPE = 18 * MiB;
constexpr size_t WS_A2 = 19 * MiB;
constexpr size_t WS_PAIR = 21 * MiB;
constexpr size_t WS_CTX = 24 * MiB;
constexpr size_t WS_FI = 40 * MiB;
constexpr int FP_L = 2 * SEQ + 8, FP_C = 2 * CL + 8;
constexpr size_t FI_L_BYTES = (size_t)1024 * 8 * FP_L * 2, FI_C_BYTES = (size_t)1024 * 8 * FP_C * 2;
constexpr size_t WS_FI0 = WS_FI, WS_FI1 = WS_FI0 + 65 * MiB, WS_FI2 = WS_FI1 + 65 * MiB;
static_assert(FI_L_BYTES <= 65 * MiB && WS_FI2 + FI_C_BYTES <= 180 * MiB, "filter map");
constexpr size_t WS_WQKV = 180 * MiB, WS_WO = 186 * MiB, WS_WIN = 190 * MiB, WS_WOUT = 202 * MiB, WS_WGU = 206 * MiB, WS_WDN = 718 * MiB;
constexpr size_t WS_HA = 974 * MiB;
constexpr size_t WS_Q = 1046 * MiB;
constexpr size_t WS_K = 1118 * MiB, WS_V = 1136 * MiB;
constexpr size_t WS_UPRE = 1154 * MiB;
constexpr size_t WS_WC = 1370 * MiB;
constexpr size_t WS_YC = 1442 * MiB;
constexpr size_t WS_XS = 1514 * MiB;
constexpr size_t WS_AB = 1818 * MiB;
constexpr size_t WS_END = 2122 * MiB;
constexpr size_t WC_CTX_OFF = (size_t)1024 * 16 * 2048;
constexpr int CW_TMO = 0, CW_BAR = 4096, CW_CNT = 16384;

constexpr int LDS_BYTES = 160 * 1024;
constexpr int MISC_OFF = LDS_BYTES - 256;

#define RLX_AGENT __ATOMIC_RELAXED, __HIP_MEMORY_SCOPE_AGENT
#define LDS_WAIT() asm volatile("s_waitcnt lgkmcnt(0)" ::: "memory")
#define VM_WAIT() asm volatile("s_waitcnt vmcnt(0)" ::: "memory")
__device__ __forceinline__ unsigned f2bf(float f) { unsigned u = __builtin_bit_cast(unsigned, f); return (u + 0x7fffu + ((u >> 16) & 1u)) >> 16; }
__device__ __forceinline__ unsigned pk2(float lo, float hi) { return f2bf(lo) | (f2bf(hi) << 16); }
__device__ __forceinline__ float bf2f(unsigned h) { return __builtin_bit_cast(float, h << 16); }
__device__ __forceinline__ float bflo(unsigned w) { return __builtin_bit_cast(float, w << 16); }
__device__ __forceinline__ float bfhi(unsigned w) { return __builtin_bit_cast(float, w & 0xffff0000u); }
__device__ __forceinline__ float wave_sum(float v) {
#pragma unroll
    for (int o = 1; o < 64; o <<= 1) v += __shfl_xor(v, o);
    return v;
}

#define XB_TMO      128
#define XB_XCNT(j)  (256  + 64 * (j))
#define XB_XSUB(j)  (1280 + 64 * (j))
#define XB_XGEN(j)  (2304 + 64 * (j))
#define XB_TOP      3328
#define XB_TOPGEN   3392
#define XCD_BAR_WORDS 3456
#define XB_SPIN_CAP (1u << 22)
__device__ __forceinline__ unsigned xb_ld(unsigned* p)              { return __hip_atomic_load(p, __ATOMIC_RELAXED, __HIP_MEMORY_SCOPE_AGENT); }
__device__ __forceinline__ unsigned xb_add(unsigned* p, unsigned v) { return __hip_atomic_fetch_add(p, v, __ATOMIC_RELAXED, __HIP_MEMORY_SCOPE_AGENT); }
__device__ __forceinline__ unsigned xb_xcc_id() { return (unsigned)__builtin_amdgcn_s_getreg((3 << 11) | 20) & 0xFu; }
#define XB_SPIN(cond, bar) do { unsigned _sp = 0; while (cond) { __builtin_amdgcn_s_sleep(1); \
    if ((++_sp & 255u) == 0u) { if (xb_ld(&(bar)[XB_TMO])) break; if (_sp > XB_SPIN_CAP) { atomicAdd(&(bar)[XB_TMO], 1u); break; } } } } while (0)
struct XcdBarrier { unsigned* bar; unsigned x; volatile LAS unsigned* st; };
__device__ __forceinline__ XcdBarrier xcd_barrier_post(unsigned* bar, volatile LAS unsigned* st) {
    XcdBarrier b; b.bar = bar; b.x = xb_xcc_id(); b.st = st;
    if (threadIdx.x == 0) (void)xb_add(&bar[XB_XCNT(b.x)], 1u);
    return b;
}
__device__ __forceinline__ void xcd_barrier_complete(unsigned* bar, unsigned x, unsigned& nloc, unsigned& nx) {
    const unsigned G = gridDim.x * gridDim.y * gridDim.z;
    unsigned sum, cnt, mine, sp = 0u;
    for (;;) {
        sum = 0u; cnt = 0u; mine = 0u;
#pragma unroll
        for (unsigned j = 0; j < 16; ++j) { const unsigned c = xb_ld(&bar[XB_XCNT(j)]); sum += c; cnt += (c > 0u) ? 1u : 0u; mine = (j == x) ? c : mine; }
        if (sum == G) break;
        __builtin_amdgcn_s_sleep(1);
        if ((++sp & 255u) == 0u) { if (xb_ld(&bar[XB_TMO])) break; if (sp > XB_SPIN_CAP) { atomicAdd(&bar[XB_TMO], 1u); break; } }
    }
    nloc = mine > 0u ? mine : 1u; nx = cnt > 0u ? cnt : 1u;
}
__device__ __forceinline__ void xcd_barrier(const XcdBarrier& b) {
    asm volatile("s_waitcnt vmcnt(0)" ::: "memory");
    __syncthreads();
    if (threadIdx.x == 0) {
        unsigned* bar = b.bar;
        __builtin_amdgcn_s_waitcnt(0);
        unsigned nloc = b.st[0], nx = b.st[1];
        if (nloc == 0u) { xcd_barrier_complete(bar, b.x, nloc, nx); b.st[0] = nloc; b.st[1] = nx; }
        const unsigned old = xb_add(&bar[XB_XSUB(b.x)], 1u);
        const unsigned gen = old / nloc;
        if (old + 1u == (gen + 1u) * nloc) {
            __builtin_amdgcn_fence(__ATOMIC_RELEASE, "agent");
            asm volatile("s_waitcnt vmcnt(0)" ::: "memory");
            const unsigned og = xb_add(&bar[XB_TOP], 1u);
            const unsigned tg = og / nx;
            if (og + 1u == (tg + 1u) * nx) xb_add(&bar[XB_TOPGEN], 1u);
            else XB_SPIN(xb_ld(&bar[XB_TOPGEN]) == tg, bar);
            __builtin_amdgcn_fence(__ATOMIC_ACQUIRE, "agent");
            xb_add(&bar[XB_XGEN(b.x)], 1u);
            asm volatile("s_waitcnt vmcnt(0)" ::: "memory");
        } else {
            XB_SPIN(xb_ld(&bar[XB_XGEN(b.x)]) == gen, bar);
            __builtin_amdgcn_fence(__ATOMIC_ACQUIRE, "agent");
            asm volatile("s_waitcnt vmcnt(0)" ::: "memory");
        }
    }
    __syncthreads();
}

struct Args { const float* in[32]; float* out; unsigned char* ws; int ph_lo, ph_hi; };
struct Ctx {
    LAS unsigned char* lds;
    int tid, lane, wave, G, bid;
    const float* const* in;
};
enum { I_X = 0, I_C, I_CTX, I_CCTX, I_WMOD, I_BMOD, I_N1G, I_N2G, I_WQKV, I_QG, I_KG, I_WO, I_HWIN, I_HBIN, I_HCW, I_HCB, I_HW1, I_HB1, I_HW2, I_HB2, I_HW3, I_HB3,
       I_HSF, I_HDB, I_HWOUT, I_HBOUT, I_RW, I_RB, I_WGU, I_BGU, I_WDN, I_BDN };

__device__ __forceinline__ int mod_row(int r) { return r < NLAT ? (r >> 11) : NB; }

__device__ __forceinline__ void gemm_unit_simple(const bf16_t* At, const bf16_t* Bt, f32x4 (&acc)[2][2][4][2], int wr, int wc, int fr, int fq) {
    constexpr int K = D;
#pragma unroll
    for (int a = 0; a < 2; ++a)
#pragma unroll
        for (int b = 0; b < 2; ++b)
#pragma unroll
            for (int m = 0; m < 4; ++m)
#pragma unroll
                for (int n = 0; n < 2; ++n) acc[a][b][m][n] = (f32x4){0.f, 0.f, 0.f, 0.f};
    const bf16_t* ap = At + (size_t)(wr * 64 + fr) * K + fq * 8;
    const bf16_t* bp = Bt + (size_t)(wc * 32 + fr) * K + fq * 8;
    for (int k0 = 0; k0 < K; k0 += 32) {
        bf16x8 bfr[2][2];
#pragma unroll
        for (int bj = 0; bj < 2; ++bj)
#pragma unroll
            for (int n = 0; n < 2; ++n) bfr[bj][n] = *(const bf16x8*)(bp + (size_t)(bj * 128 + n * 16) * K + k0);
#pragma unroll
        for (int ai = 0; ai < 2; ++ai)
#pragma unroll
            for (int m = 0; m < 4; ++m) {
                const bf16x8 afr = *(const bf16x8*)(ap + (size_t)(ai * 128 + m * 16) * K + k0);
#pragma unroll
                for (int bj = 0; bj < 2; ++bj)
#pragma unroll
                    for (int n = 0; n < 2; ++n) acc[ai][bj][m][n] = __builtin_amdgcn_mfma_f32_16x16x32_bf16(bfr[bj][n], afr, acc[ai][bj][m][n], 0, 0, 0);
            }
    }
}


struct Unit { int pm, pn, e; };
namespace pg8 {
constexpr int BM = 256, BK = 64, HALF = 128, HTB = HALF * BK * 2, STAGE_BYTES = 8 * HTB;
__device__ __forceinline__ int lds_byte(int r, int c) { const int st = (r >> 4) * 2 + (c >> 5), rr = r & 15, cc = c & 31, ob = rr * 64 + cc * 2; return st * 1024 + (ob ^ (((ob >> 9) & 1) << 5)); }
__device__ __forceinline__ void stage_rc(int b, int& R, int& C) { const int st = b / 1024, sb = b % 1024, swz = sb ^ (((sb >> 9) & 1) << 5); R = (st >> 1) * 16 + swz / 64; C = (st & 1) * 32 + (swz % 64) / 2; }
template <class Epi, class Sched>
__device__ __forceinline__ void gemm_phase(LAS unsigned char* lds, const Sched& S, const Epi& E) {
    constexpr int K = D, nt = K / BK;
    const int tid = threadIdx.x, wid = __builtin_amdgcn_readfirstlane(tid >> 6), lane = tid & 63, wr = wid >> 2, wc = wid & 3, fr = lane & 15, fq = lane >> 4;
    unsigned voffA[2];
#pragma unroll
    for (int i = 0; i < 2; ++i) { int R, C; stage_rc(tid * 16 + i * 8192, R, C); voffA[i] = (unsigned)(R * K + C) * 2u; }
    const size_t kstep = (size_t)(BK * 2);
    const size_t hstep = (size_t)HALF * K * 2;
    const unsigned ldsw = (unsigned)wid * 1024u;
    const int aoff = lds_byte(wr * 64 + fr, fq * 8), boff = lds_byte(wc * 32 + fr, fq * 8);
#define PG8_SA(b, h) (((b) * 2 + (h)) * HTB)
#define PG8_SB(b, h) ((4 + (b) * 2 + (h)) * HTB)
#define PG8_STAGE(bufoff, gbase, voff) do { _Pragma("unroll") for (int _i = 0; _i < 2; ++_i) \
        __builtin_amdgcn_global_load_lds((const unsigned*)((const char*)(gbase) + (voff)[_i]), (LAS unsigned*)(lds + (bufoff) + ldsw + _i * 8192), 16, 0, 0); } while (0)
#define PG8_LDA(dst, b, h) do { _Pragma("unroll") for (int m = 0; m < 4; ++m) _Pragma("unroll") for (int k = 0; k < 2; ++k) dst[m][k] = *(const LAS bf16x8*)(lds + PG8_SA(b, h) + aoff + m * 2048 + k * 1024); } while (0)
#define PG8_LDB(dst, b, h) do { _Pragma("unroll") for (int n = 0; n < 2; ++n) _Pragma("unroll") for (int k = 0; k < 2; ++k) dst[n][k] = *(const LAS bf16x8*)(lds + PG8_SB(b, h) + boff + n * 2048 + k * 1024); } while (0)
#define PG8_MMA(ai, bj, At, Bt) do { __builtin_amdgcn_s_setprio(1); _Pragma("unroll") for (int m = 0; m < 4; ++m) _Pragma("unroll") for (int n = 0; n < 2; ++n) _Pragma("unroll") for (int k = 0; k < 2; ++k) \
        acc[ai][bj][m][n] = __builtin_amdgcn_mfma_f32_16x16x32_bf16(Bt[n][k], At[m][k], acc[ai][bj][m][n], 0, 0, 0); __builtin_amdgcn_s_setprio(0); } while (0)
#define PG8_WAIT_V(n) asm volatile("s_waitcnt vmcnt(" #n ")" ::: "memory")
#define PG8_WAIT_L(n) asm volatile("s_waitcnt lgkmcnt(" #n ")" ::: "memory")
#define PG8_BAR __builtin_amdgcn_s_barrier()
#define PG8_SCHED __builtin_amdgcn_sched_barrier(0)
    Unit cur, nxt; int ui = 0;
    if (!S.next(0, cur)) return;
    f32x4 acc[2][2][4][2];
#pragma unroll
    for (int a = 0; a < 2; ++a)
#pragma unroll
        for (int b = 0; b < 2; ++b)
#pragma unroll
            for (int m = 0; m < 4; ++m)
#pragma unroll
                for (int n = 0; n < 2; ++n) acc[a][b][m][n] = (f32x4){0.f, 0.f, 0.f, 0.f};
    bf16x8 At[4][2], B0[2][2], B1[2][2];
    const char* cA = S.a_ptr(cur); const char* cB = S.b_ptr(cur);
    PG8_STAGE(PG8_SB(0, 0), cB, voffA); PG8_STAGE(PG8_SB(0, 1), cB + hstep, voffA); PG8_STAGE(PG8_SA(0, 0), cA, voffA); PG8_STAGE(PG8_SA(0, 1), cA + hstep, voffA);
    if (wr == 1) PG8_BAR;
    PG8_WAIT_V(2); PG8_BAR;
    PG8_STAGE(PG8_SB(1, 0), cB + kstep, voffA); PG8_STAGE(PG8_SA(1, 0), cA + kstep, voffA); PG8_STAGE(PG8_SB(1, 1), cB + hstep + kstep, voffA);
    PG8_WAIT_V(6); PG8_BAR;
    for (;;) {
        const bool has_next = S.next(ui + 1, nxt);
        const char* nA = has_next ? S.a_ptr(nxt) : cA; const char* nB = has_next ? S.b_ptr(nxt) : cB;
        for (int t = 0; t < nt; t += 2) {
            const bool last = (t == nt - 2);
            const char* a1 = cA + (size_t)(t + 1) * kstep;
            const char* a2 = last ? nA : cA + (size_t)(t + 2) * kstep; const char* b2 = last ? nB : cB + (size_t)(t + 2) * kstep;
            const char* a3 = a2 + kstep; const char* b3 = b2 + kstep;
            PG8_LDB(B0, 0, 0); PG8_LDB(B1, 0, 1); PG8_SCHED; PG8_LDA(At, 0, 0); PG8_STAGE(PG8_SA(1, 1), a1 + hstep, voffA);
            PG8_WAIT_V(8); PG8_WAIT_L(0); PG8_BAR; PG8_MMA(0, 0, At, B0); PG8_MMA(0, 1, At, B1); PG8_BAR; PG8_SCHED;
            PG8_LDA(At, 0, 1); PG8_STAGE(PG8_SB(0, 0), b2, voffA); PG8_STAGE(PG8_SB(0, 1), b2 + hstep, voffA); PG8_STAGE(PG8_SA(0, 0), a2, voffA);
            PG8_WAIT_V(8); PG8_WAIT_L(0); PG8_BAR; PG8_MMA(1, 0, At, B0); PG8_MMA(1, 1, At, B1); PG8_BAR; PG8_SCHED;
            PG8_LDB(B0, 1, 0); PG8_LDB(B1, 1, 1); PG8_SCHED; PG8_LDA(At, 1, 0); PG8_STAGE(PG8_SA(0, 1), a2 + hstep, voffA);
            PG8_WAIT_V(8); PG8_WAIT_L(0); PG8_BAR; PG8_MMA(0, 0, At, B0); PG8_MMA(0, 1, At, B1); PG8_BAR; PG8_SCHED;
            PG8_LDA(At, 1, 1); PG8_STAGE(PG8_SB(1, 0), b3, voffA); PG8_STAGE(PG8_SB(1, 1), b3 + hstep, voffA); PG8_STAGE(PG8_SA(1, 0), a3, voffA);
            PG8_WAIT_V(8); PG8_WAIT_L(0); PG8_BAR; PG8_MMA(1, 0, At, B0); PG8_MMA(1, 1, At, B1); PG8_BAR; PG8_SCHED;
        }
        if (wr == 0) PG8_BAR;
        E(acc, cur, wr, wc, fr, fq);
        if (!has_next) break;
#pragma unroll
        for (int a = 0; a < 2; ++a)
#pragma unroll
            for (int b = 0; b < 2; ++b)
#pragma unroll
                for (int m = 0; m < 4; ++m)
#pragma unroll
                    for (int n = 0; n < 2; ++n) acc[a][b][m][n] = (f32x4){0.f, 0.f, 0.f, 0.f};
        cur = nxt; cA = nA; cB = nB; ++ui;
        if (wr == 1) PG8_BAR;
    }
    PG8_WAIT_V(0);
    PG8_BAR;
#undef PG8_SA
#undef PG8_SB
#undef PG8_STAGE
#undef PG8_LDA
#undef PG8_LDB
#undef PG8_MMA
#undef PG8_WAIT_V
#undef PG8_WAIT_L
#undef PG8_BAR
#undef PG8_SCHED
}
}

template <class Epi, class Sched>
__device__ __forceinline__ void gemm_phase_simple(const Sched& S, const Epi& E) {
    const int tid = threadIdx.x, wid = __builtin_amdgcn_readfirstlane(tid >> 6), lane = tid & 63, wr = wid >> 2, wc = wid & 3, fr = lane & 15, fq = lane >> 4;
    Unit u;
    for (int i = 0; S.next(i, u); ++i) { f32x4 acc[2][2][4][2];
        gemm_unit_simple((const bf16_t*)S.a_ptr(u), (const bf16_t*)S.b_ptr(u), acc, wr, wc, fr, fq);
        E(acc, u, wr, wc, fr, fq); }
}
#ifndef FAST_GEMM
#define FAST_GEMM 1
#endif
template <class Epi, class Sched>
__device__ __forceinline__ void run_gemm(LAS unsigned char* lds, const Sched& S, const Epi& E) {
#if FAST_GEMM
    pg8::gemm_phase<Epi, Sched>(lds, S, E);
#else
    gemm_phase_simple<Epi, Sched>(S, E);
#endif
}
struct DenseSched {
    const bf16_t* A; const bf16_t* Bt; int nN, ntot, G, c;
    __device__ __forceinline__ bool next(int i, Unit& u) const { const int L = i * G + c; if (L >= ntot) return false; u.pm = L / nN; u.pn = L - u.pm * nN; u.e = 0; return true; }
    __device__ __forceinline__ const char* a_ptr(const Unit& u) const { return (const char*)(A + (size_t)u.pm * 256 * D); }
    __device__ __forceinline__ const char* b_ptr(const Unit& u) const { return (const char*)(Bt + (size_t)u.pn * 256 * D); }
};
struct QkvSched {
    const bf16_t* A; const bf16_t* Bt; int live, ntot, G, c;
    __device__ __forceinline__ bool next(int i, Unit& u) const { const int L = i * G + c; if (L >= ntot) return false; u.e = 0;
        if (L < 768) { u.pm = L / 6; u.pn = L - u.pm * 6; } else { const int q = L - 768; if (live) { u.pm = 128 + q / 6; u.pn = q % 6; } else { u.pm = 128 + (q >> 1); u.pn = 4 + (q & 1); } } return true; }
    __device__ __forceinline__ const char* a_ptr(const Unit& u) const { return (const char*)(A + (size_t)u.pm * 256 * D); }
    __device__ __forceinline__ const char* b_ptr(const Unit& u) const { return (const char*)(Bt + (size_t)u.pn * 256 * D); }
};
struct MoeSched {
    const bf16_t* A; const bf16_t* Bt  ; const LAS unsigned char* TE; int nN, lgN, N, ntot, G, c;
    __device__ __forceinline__ bool next(int i, Unit& u) const { const int L = i * G + c; if (L >= ntot) return false; u.pm = L >> lgN; u.pn = L & (nN - 1); u.e = TE[u.pm]; return true; }
    __device__ __forceinline__ const char* a_ptr(const Unit& u) const { return (const char*)(A + (size_t)u.pm * 256 * D); }
    __device__ __forceinline__ const char* b_ptr(const Unit& u) const { return (const char*)(Bt + ((size_t)u.e * N + (size_t)u.pn * 256) * D); }
};

struct EpiQKV {
    bf16_t *Q, *Kb, *Vb; const float *qg, *kg, *cosT, *sinT;
    __device__ __forceinline__ void operator()(const f32x4 (&acc)[2][2][4][2], const Unit& uu, int wr, int wc, int fr, int fq) const {
        const int pm = uu.pm, pn = uu.pn;
        const int kind = pn < 4 ? 0 : (pn == 4 ? 1 : 2);
        const float* gain = kind == 0 ? qg : kg;
        f32x4 gv[2][2];
#pragma unroll
        for (int bj = 0; bj < 2; ++bj)
#pragma unroll
            for (int n = 0; n < 2; ++n) gv[bj][n] = *(const f32x4*)(gain + 32 * bj + 16 * n + 4 * fq);
#pragma unroll
        for (int ai = 0; ai < 2; ++ai)
#pragma unroll
            for (int m = 0; m < 4; ++m) {
                const int r = pm * 256 + ai * 128 + wr * 64 + m * 16 + fr;
                const bool lat = r < NLAT;
                const int b = lat ? (r >> 11) : ((r - NLAT) >> 8);
                const int pos = lat ? (r & (SEQ - 1)) : (SEQ + ((r - NLAT) & (CL - 1)));
                f32x4 v[2][2];
#pragma unroll
                for (int bj = 0; bj < 2; ++bj)
#pragma unroll
                    for (int n = 0; n < 2; ++n) v[bj][n] = acc[ai][bj][m][n];
                if (kind != 2) {
                    float ss = 0.f;
#pragma unroll
                    for (int bj = 0; bj < 2; ++bj)
#pragma unroll
                        for (int n = 0; n < 2; ++n) ss += (v[bj][n][0] * v[bj][n][0] + v[bj][n][1] * v[bj][n][1]) + (v[bj][n][2] * v[bj][n][2] + v[bj][n][3] * v[bj][n][3]);
                    ss += __shfl_xor(ss, 16); ss += __shfl_xor(ss, 32);
                    const float rinv = 1.0f / sqrtf(ss * (1.0f / 64.0f) + EPS);
#pragma unroll
                    for (int bj = 0; bj < 2; ++bj)
#pragma unroll
                        for (int n = 0; n < 2; ++n) v[bj][n] = v[bj][n] * rinv * gv[bj][n];
                    if (lat) {
#pragma unroll
                        for (int bj = 0; bj < 2; ++bj) {
                            const f32x4 cs = *(const f32x4*)(cosT + pos * 32 + bj * 16 + 4 * fq), sn = *(const f32x4*)(sinT + pos * 32 + bj * 16 + 4 * fq);
                            const f32x4 x1 = v[bj][0], x2 = v[bj][1];
                            v[bj][0] = x1 * cs - x2 * sn; v[bj][1] = x2 * cs + x1 * sn;
                        }
                    }
                    if (kind == 0) {
#pragma unroll
                        for (int bj = 0; bj < 2; ++bj)
#pragma unroll
                            for (int n = 0; n < 2; ++n) v[bj][n] = v[bj][n] * C2;
                    }
                }
                bf16_t* dst = kind == 0 ? Q + (size_t)r * D + pn * 256 + wc * 64
                                        : (kind == 1 ? Kb : Vb) + ((size_t)b * KVL + pos) * 256 + wc * 64;
#pragma unroll
                for (int bj = 0; bj < 2; ++bj)
#pragma unroll
                    for (int n = 0; n < 2; ++n) { u32x2 w; w.x = pk2(v[bj][n][0], v[bj][n][1]); w.y = pk2(v[bj][n][2], v[bj][n][3]); *(u32x2*)(dst + 32 * bj + 16 * n + 4 * fq) = w; }
            }
    }
};
struct EpiBiasBf16 {
    bf16_t* O; int ldc; const float* bias0; int estride;
    __device__ __forceinline__ void operator()(const f32x4 (&acc)[2][2][4][2], const Unit& uu, int wr, int wc, int fr, int fq) const {
        const int row0 = uu.pm * 256, col0t = uu.pn * 256;
#pragma unroll
        for (int bj = 0; bj < 2; ++bj)
#pragma unroll
            for (int n = 0; n < 2; ++n) {
                const int c = col0t + bj * 128 + wc * 32 + n * 16 + 4 * fq;
                const f32x4 bv = *(const f32x4*)(bias0 + (size_t)uu.e * estride + c);
#pragma unroll
                for (int ai = 0; ai < 2; ++ai)
#pragma unroll
                    for (int m = 0; m < 4; ++m) { const int r = row0 + ai * 128 + wr * 64 + m * 16 + fr; const f32x4 v = acc[ai][bj][m][n] + bv;
                        u32x2 w; w.x = pk2(v[0], v[1]); w.y = pk2(v[2], v[3]); *(u32x2*)(O + (size_t)r * ldc + c) = w; }
            }
    }
};
struct EpiResid {
    const float *srcL, *srcC; float *dstL, *dstC; const float* gate  ; const float* bias;
    __device__ __forceinline__ void operator()(const f32x4 (&acc)[2][2][4][2], const Unit& uu, int wr, int wc, int fr, int fq) const {
        const int row0 = uu.pm * 256, col0t = uu.pn * 256;
#pragma unroll
        for (int bj = 0; bj < 2; ++bj)
#pragma unroll
            for (int n = 0; n < 2; ++n) {
                const int c = col0t + bj * 128 + wc * 32 + n * 16 + 4 * fq;
                const f32x4 bv = bias ? *(const f32x4*)(bias + c) : (f32x4){0.f, 0.f, 0.f, 0.f};
#pragma unroll
                for (int ai = 0; ai < 2; ++ai)
#pragma unroll
                    for (int m = 0; m < 4; ++m) { const int r = row0 + ai * 128 + wr * 64 + m * 16 + fr;
                        const f32x4 g = *(const f32x4*)(gate + (size_t)mod_row(r) * MODW + c);
                        const float* s = r < NLAT ? srcL + (size_t)r * D : srcC + (size_t)(r - NLAT) * D;
                        float* d = r < NLAT ? dstL + (size_t)r * D : dstC + (size_t)(r - NLAT) * D;
                        const f32x4 x = *(const f32x4*)(s + c);
                        *(f32x4*)(d + c) = x + g * (acc[ai][bj][m][n] + bv); }
            }
    }
};
struct EpiSwiglu {
    bf16_t* O; const float* bgu0  ;
    __device__ __forceinline__ void operator()(const f32x4 (&acc)[2][2][4][2], const Unit& uu, int wr, int wc, int fr, int fq) const {
        const int row0 = uu.pm * 256, pn = uu.pn; const float* bgu = bgu0 + (size_t)uu.e * NGU;
#pragma unroll
        for (int n = 0; n < 2; ++n) {
            const int f = pn * 128 + wc * 32 + n * 16 + 4 * fq;
            const f32x4 b0 = *(const f32x4*)(bgu + 2 * f), b1 = *(const f32x4*)(bgu + 2 * f + 4);
            const f32x4 bg = (f32x4){b0[0], b0[2], b1[0], b1[2]}, bu = (f32x4){b0[1], b0[3], b1[1], b1[3]};
#pragma unroll
            for (int ai = 0; ai < 2; ++ai)
#pragma unroll
                for (int m = 0; m < 4; ++m) { const int r = row0 + ai * 128 + wr * 64 + m * 16 + fr;
                    const f32x4 gg = acc[ai][0][m][n] + bg, uu = acc[ai][1][m][n] + bu; float o[4];
#pragma unroll
                    for (int e = 0; e < 4; ++e) { const float g = fminf(gg[e], 7.0f), u = fminf(fmaxf(uu[e], -7.0f), 7.0f);
                        const float sg = 1.0f / (1.0f + __expf(-1.702f * g)); o[e] = (u + 1.0f) * g * sg; }
                    u32x2 w; w.x = pk2(o[0], o[1]); w.y = pk2(o[2], o[3]); *(u32x2*)(O + (size_t)r * D + f) = w; }
        }
    }
};

template <int MODE> __device__ __forceinline__ int wrow_map(int n) {
    if (MODE == 0) return n;
    if (MODE == 1) { const int pn = n >> 8, wc = (n >> 6) & 3, bj = (n >> 5) & 1, j = n & 31; return (pn << 8) + (bj << 7) + (wc << 5) + j; }
    { const int f = n >> 1, pn = f >> 7, fo = f & 127; return (pn << 8) + ((n & 1) << 7) + fo; }
}
template <int MODE> __device__ __forceinline__ void transpose_item(const float* W, int N, bf16_t* WT, LAS float* scr, int item, int lane) {
    constexpr int K = D;
    const int nblk = N / 32, kb = item / nblk, nb = item % nblk, k0 = 64 * kb, n0 = 32 * nb;
#pragma unroll 8
    for (int i = 0; i < 32; ++i) { const int kk = 2 * i + (lane >> 5); scr[kk * 33 + (lane & 31)] = W[(size_t)(k0 + kk) * N + n0 + (lane & 31)]; }
    LDS_WAIT(); asm volatile("" ::: "memory");
    const int c = lane & 7;
#pragma unroll
    for (int j = 0; j < 4; ++j) { const int n = (lane >> 3) + 8 * j; const LAS float* s = scr + (8 * c) * 33 + n;
        u32x4 o; o.x = pk2(s[0 * 33], s[1 * 33]); o.y = pk2(s[2 * 33], s[3 * 33]); o.z = pk2(s[4 * 33], s[5 * 33]); o.w = pk2(s[6 * 33], s[7 * 33]);
        *(u32x4*)(WT + (size_t)wrow_map<MODE>(n0 + n) * K + k0 + 8 * c) = o; }
    LDS_WAIT(); asm volatile("" ::: "memory");
}

__device__ __forceinline__ void norm_mod_store(const f32x4 (&v)[4], const float* gain, const float* shift, const float* scale, bf16_t* dst, int lane, f32x4 (&h)[4]) {
    float ss = 0.f;
#pragma unroll
    for (int j = 0; j < 4; ++j) ss += (v[j][0] * v[j][0] + v[j][1] * v[j][1]) + (v[j][2] * v[j][2] + v[j][3] * v[j][3]);
    ss = wave_sum(ss);
    const float rinv = 1.0f / sqrtf(ss * (1.0f / D) + EPS);
#pragma unroll
    for (int j = 0; j < 4; ++j) {
        const f32x4 g = ((const f32x4*)gain)[lane + 64 * j], sh = ((const f32x4*)shift)[lane + 64 * j], sc = ((const f32x4*)scale)[lane + 64 * j];
        h[j] = (v[j] * rinv * g) * (sc + 1.0f) + sh;
        u32x2 w; w.x = pk2(h[j][0], h[j][1]); w.y = pk2(h[j][2], h[j][3]);
        ((u32x2*)dst)[lane + 64 * j] = w;
    }
}

#define IN(k) (lo <= (k) && (k) < hi)
#define SEAM(k) do { if (IN(k) && IN((k) + 1)) xcd_barrier(bar); } while (0)
#define KLOCALS \
    const float* x_in = args.in[I_X]; const float* c_in = args.in[I_C]; const float* ctx_in = args.in[I_CTX]; const float* cctx_in = args.in[I_CCTX]; \
    float* out = args.out; \
    float* modp = (float*)(ws + WS_MODP); float* modf = (float*)(ws + WS_MOD); \
    float* cosT = (float*)(ws + WS_ROPE); float* sinT = cosT + SEQ * 32; \
    float* a2tab = (float*)(ws + WS_A2); \
    int* top_e = (int*)(ws + WS_PAIR); int* ppos = top_e + NTOK * 4; float* pgate = (float*)(ppos + NTOK * 4); int* pdest = (int*)(pgate + NTOK * 4); \
    float* ctxbuf = (float*)(ws + WS_CTX); \
    bf16_t* Wqkv_t = (bf16_t*)(ws + WS_WQKV); bf16_t* Wo_t = (bf16_t*)(ws + WS_WO); bf16_t* Win_t = (bf16_t*)(ws + WS_WIN); bf16_t* Wout_t = (bf16_t*)(ws + WS_WOUT); \
    bf16_t* Wgu_t = (bf16_t*)(ws + WS_WGU); bf16_t* Wdn_t = (bf16_t*)(ws + WS_WDN); \
    bf16_t* hA = (bf16_t*)(ws + WS_HA); bf16_t* Qb = (bf16_t*)(ws + WS_Q); bf16_t* Kb = (bf16_t*)(ws + WS_K); bf16_t* Vb = (bf16_t*)(ws + WS_V); \
    bf16_t* Upre = (bf16_t*)(ws + WS_UPRE); bf16_t* Wc = (bf16_t*)(ws + WS_WC); bf16_t* Yc = (bf16_t*)(ws + WS_YC); \
    bf16_t* XS = (bf16_t*)(ws + WS_XS); bf16_t* AB = (bf16_t*)(ws + WS_AB); \
    const int wr = wave >> 2, wc = wave & 3, fr = lane & 15, fq = lane >> 4;
template <int layer> __device__ __forceinline__ void layer_body(const Args& args, LAS unsigned char* lds, const XcdBarrier& bar, const int tid, const int lane, const int wave, const int G, const int bid, const int lo, const int hi) {
    const int gw = bid * NWAVES + wave, NGW = G * NWAVES;
    unsigned char* ws = args.ws;
    gu32* ctl = (gu32*)(ws + WS_CTL);
    KLOCALS
        const int pb = 3 + 10 * layer;
        const int jm = layer >> 1;
        const bool ctx_live = layer < 2;
        const int nrows = ctx_live ? NTOK : NLAT;
        const float* mo = modf + (size_t)layer * NMODROW * MODW;
        const float* resL = layer == 0 ? x_in : out; const float* resC = layer == 0 ? ctx_in : ctxbuf;

        if ((layer & 1) == 0) {
            if (EN_GEMM && IN(pb + 0)) {
                EpiQKV E{Qb, Kb, Vb, args.in[I_QG] + jm * 64, args.in[I_KG] + jm * 64, cosT, sinT};
                const bf16_t* Wt = Wqkv_t + (size_t)jm * NQKV * D;
                const QkvSched S{hA, Wt, ctx_live ? 1 : 0, 768 + 16 * (ctx_live ? 6 : 2), G, bid};
                run_gemm(lds, S, E);
            }
            SEAM(pb + 0);
            if (EN_ATT && IN(pb + 1)) {
                LAS bf16_t* Ks = (LAS bf16_t*)lds;
                LAS bf16_t* Vt = Ks + 64 * 72;
                const int nlat_u = NB * 4 * 32, nctx_u = ctx_live ? NB * 4 * 4 : 0;
                const int r32 = lane & 31, hi = lane >> 5, g = wave >> 1, qh = wave & 1;
                for (int u = bid; u < nlat_u + nctx_u; u += G) {
                    int b, kvh, qrow0, key0, ntile;
                    if (u < nlat_u) { b = u >> 7; kvh = (u >> 5) & 3; qrow0 = b * SEQ + (u & 31) * 64; key0 = 0; ntile = KVL / 64; }
                    else { const int q = u - nlat_u; b = q >> 4; kvh = (q >> 2) & 3; qrow0 = NLAT + b * CL + (q & 3) * 64; key0 = SEQ; ntile = CL / 64; }
                    const int head = kvh * 4 + g; const int qrow = qrow0 + 32 * qh + r32;
                    bf16x8 qr[4];
#pragma unroll
                    for (int d0 = 0; d0 < 4; ++d0) qr[d0] = *(const bf16x8*)(Qb + (size_t)qrow * D + head * 64 + d0 * 16 + hi * 8);
                    f32x16 o0, o1;
#pragma unroll
                    for (int r = 0; r < 16; ++r) { o0[r] = 0.f; o1[r] = 0.f; }
                    float mrun = -INFINITY, lrun = 0.f;
#pragma unroll 1
                    for (int t = 0; t < ntile; ++t) {
                        __syncthreads();
                        { const int key = tid >> 3, dc = (tid & 7) * 8; const size_t off = ((size_t)b * KVL + key0 + t * 64 + key) * 256 + kvh * 64 + dc;
                          const u32x4 kw = *(const u32x4*)(Kb + off), vw = *(const u32x4*)(Vb + off);
                          *(LAS u32x4*)(Ks + key * 72 + dc) = kw;
                          Vt[(dc + 0) * 72 + key] = (bf16_t)(vw.x & 0xffffu); Vt[(dc + 1) * 72 + key] = (bf16_t)(vw.x >> 16);
                          Vt[(dc + 2) * 72 + key] = (bf16_t)(vw.y & 0xffffu); Vt[(dc + 3) * 72 + key] = (bf16_t)(vw.y >> 16);
                          Vt[(dc + 4) * 72 + key] = (bf16_t)(vw.z & 0xffffu); Vt[(dc + 5) * 72 + key] = (bf16_t)(vw.z >> 16);
                          Vt[(dc + 6) * 72 + key] = (bf16_t)(vw.w & 0xffffu); Vt[(dc + 7) * 72 + key] = (bf16_t)(vw.w >> 16); }
                        __syncthreads();
                        f32x16 p0, p1;
#pragma unroll
                        for (int r = 0; r < 16; ++r) { p0[r] = 0.f; p1[r] = 0.f; }
#pragma unroll
                        for (int d0 = 0; d0 < 4; ++d0) {
                            const bf16x8 a0 = *(const LAS bf16x8*)(Ks + r32 * 72 + d0 * 16 + hi * 8), a1 = *(const LAS bf16x8*)(Ks + (32 + r32) * 72 + d0 * 16 + hi * 8);
                            p0 = __builtin_amdgcn_mfma_f32_32x32x16_bf16(a0, qr[d0], p0, 0, 0, 0); p1 = __builtin_amdgcn_mfma_f32_32x32x16_bf16(a1, qr[d0], p1, 0, 0, 0); }
                        float mx = fmaxf(p0[0], p1[0]);
#pragma unroll
                        for (int r = 1; r < 16; ++r) mx = fmaxf(mx, fmaxf(p0[r], p1[r]));
                        mx = fmaxf(mx, __shfl_xor(mx, 32));
                        const float mnew = fmaxf(mrun, mx), alpha = __builtin_amdgcn_exp2f(mrun - mnew); mrun = mnew;
                        float ps = 0.f;
#pragma unroll
                        for (int r = 0; r < 16; ++r) { p0[r] = __builtin_amdgcn_exp2f(p0[r] - mrun); p1[r] = __builtin_amdgcn_exp2f(p1[r] - mrun); ps += p0[r] + p1[r]; }
                        lrun = lrun * alpha + ps;
#pragma unroll
                        for (int r = 0; r < 16; ++r) { o0[r] *= alpha; o1[r] *= alpha; }
#pragma unroll
                        for (int s4 = 0; s4 < 4; ++s4) {
                            u32x4 pw;
                            if (s4 == 0) { pw.x = pk2(p0[0], p0[1]); pw.y = pk2(p0[2], p0[3]); pw.z = pk2(p0[4], p0[5]); pw.w = pk2(p0[6], p0[7]); }
                            else if (s4 == 1) { pw.x = pk2(p0[8], p0[9]); pw.y = pk2(p0[10], p0[11]); pw.z = pk2(p0[12], p0[13]); pw.w = pk2(p0[14], p0[15]); }
                            else if (s4 == 2) { pw.x = pk2(p1[0], p1[1]); pw.y = pk2(p1[2], p1[3]); pw.z = pk2(p1[4], p1[5]); pw.w = pk2(p1[6], p1[7]); }
                            else { pw.x = pk2(p1[8], p1[9]); pw.y = pk2(p1[10], p1[11]); pw.z = pk2(p1[12], p1[13]); pw.w = pk2(p1[14], p1[15]); }
                            const bf16x8 pf = __builtin_bit_cast(bf16x8, pw);
                            const int kvb = 32 * (s4 >> 1) + 16 * (s4 & 1) + 4 * hi;
                            { const u32x2 lo4 = *(const LAS u32x2*)(Vt + r32 * 72 + kvb), hi4 = *(const LAS u32x2*)(Vt + r32 * 72 + kvb + 8);
                              const u32x4 vv = (u32x4){lo4.x, lo4.y, hi4.x, hi4.y}; o0 = __builtin_amdgcn_mfma_f32_32x32x16_bf16(__builtin_bit_cast(bf16x8, vv), pf, o0, 0, 0, 0); }
                            { const u32x2 lo4 = *(const LAS u32x2*)(Vt + (32 + r32) * 72 + kvb), hi4 = *(const LAS u32x2*)(Vt + (32 + r32) * 72 + kvb + 8);
                              const u32x4 vv = (u32x4){lo4.x, lo4.y, hi4.x, hi4.y}; o1 = __builtin_amdgcn_mfma_f32_32x32x16_bf16(__builtin_bit_cast(bf16x8, vv), pf, o1, 0, 0, 0); }
                        }
                    }
                    const float il = 1.0f / (lrun + __shfl_xor(lrun, 32));
                    bf16_t* op = Qb + (size_t)qrow * D + head * 64;
#pragma unroll
                    for (int gq = 0; gq < 4; ++gq) {
                        u32x2 w0, w1;
                        w0.x = pk2(o0[4 * gq] * il, o0[4 * gq + 1] * il); w0.y = pk2(o0[4 * gq + 2] * il, o0[4 * gq + 3] * il);
                        w1.x = pk2(o1[4 * gq] * il, o1[4 * gq + 1] * il); w1.y = pk2(o1[4 * gq + 2] * il, o1[4 * gq + 3] * il);
                        *(u32x2*)(op + 8 * gq + 4 * hi) = w0; *(u32x2*)(op + 32 + 8 * gq + 4 * hi) = w1;
                    }
                }
            }
            SEAM(pb + 1);
            if (EN_GEMM && IN(pb + 2)) {
                EpiResid E{resL, resC, out, ctxbuf, mo + 2 * D, nullptr};
                const bf16_t* Wt = Wo_t + (size_t)jm * D * D;
                const DenseSched S{Qb, Wt, 4, (nrows / 256) * 4, G, bid};
                run_gemm(lds, S, E);
            }
            SEAM(pb + 2);
        } else {
            const float* cw = args.in[I_HCW] + (size_t)jm * 3 * NHY; const float* cb = args.in[I_HCB] + (size_t)jm * NHY;
            if (EN_GEMM && IN(pb + 0)) {
                EpiBiasBf16 E{Upre, NHY, args.in[I_HBIN] + (size_t)jm * NHY, 0};
                const bf16_t* Wt = Win_t + (size_t)jm * NHY * D;
                const DenseSched S{hA, Wt, 12, (nrows / 256) * 12, G, bid};
                run_gemm(lds, S, E);
            }
            SEAM(pb + 0);
            if (EN_MISC && IN(pb + 1)) {
                LAS bf16_t* T = (LAS bf16_t*)lds;
                const int nlat_u = NB * 32 * 16, nctx_u = ctx_live ? NB * 4 * 16 : 0;
                for (int u = bid; u < nlat_u + nctx_u; u += G) {
                    int b, s0, c0, Ls, rowb; bf16_t* dstb;
                    if (u < nlat_u) { b = u >> 9; s0 = ((u >> 4) & 31) * 64; c0 = (u & 15) * 64; Ls = SEQ; rowb = b * SEQ; dstb = Wc; }
                    else { const int q = u - nlat_u; b = q >> 6; s0 = ((q >> 4) & 3) * 64; c0 = (q & 15) * 64; Ls = CL; rowb = NLAT + b * CL; dstb = Wc + WC_CTX_OFF; }
                    const int sr = tid >> 3, cc = (tid & 7) * 8, s = s0 + sr;
                    float x1[8], vv[8];
#pragma unroll
                    for (int e = 0; e < 8; ++e) { x1[e] = cb[D + c0 + cc + e]; vv[e] = cb[2 * D + c0 + cc + e]; }
#pragma unroll
                    for (int tap = 0; tap < 3; ++tap) { const int sp = s + tap - 1;
                        if (sp >= 0 && sp < Ls) { const bf16_t* ur = Upre + (size_t)(rowb + sp) * NHY + c0 + cc; const u32x4 a = *(const u32x4*)(ur + D), bq = *(const u32x4*)(ur + 2 * D);
                            const float* w1 = cw + tap * NHY + D + c0 + cc; const float* w2 = cw + tap * NHY + 2 * D + c0 + cc;
                            const float af[8] = {bflo(a.x), bfhi(a.x), bflo(a.y), bfhi(a.y), bflo(a.z), bfhi(a.z), bflo(a.w), bfhi(a.w)};
                            const float bf[8] = {bflo(bq.x), bfhi(bq.x), bflo(bq.y), bfhi(bq.y), bflo(bq.z), bfhi(bq.z), bflo(bq.w), bfhi(bq.w)};
#pragma unroll
                            for (int e = 0; e < 8; ++e) { x1[e] += af[e] * w1[e]; vv[e] += bf[e] * w2[e]; } } }
                    __syncthreads();
#pragma unroll
                    for (int e = 0; e < 8; ++e) T[(cc + e) * 72 + sr] = (bf16_t)f2bf(x1[e] * vv[e]);
                    __syncthreads();
                    { const int c = tid >> 3, sc = (tid & 7) * 8; const u32x4 w = *(const LAS u32x4*)(T + c * 72 + sc);
                      *(u32x4*)(dstb + ((size_t)(c0 + c) * NB + b) * Ls + s0 + sc) = w; }
                }
            }
            SEAM(pb + 1);
            if (EN_CONV && IN(pb + 2)) {
                LAS float* GF = (LAS float*)lds;
                const int nlat_u = 1024, nctx_u = ctx_live ? 1024 : 0;
                for (int u = bid; u < nlat_u + nctx_u; u += G) {
                    const bool isl = u < nlat_u; const int c = isl ? u : u - nlat_u; const int Lf = isl ? SEQ : CL; const int P = 2 * Lf + 8;
                    LAS float* WF = GF + 2 * Lf;
                    const bf16_t* FI = (const bf16_t*)(ws + (isl ? (jm == 0 ? WS_FI0 : WS_FI1) : WS_FI2)) + (size_t)c * 8 * P;
                    const bf16_t* wsrc = (isl ? Wc : Wc + WC_CTX_OFF) + (size_t)c * NB * Lf; bf16_t* ydst = (isl ? Yc : Yc + WC_CTX_OFF) + (size_t)c * NB * Lf;
                    __syncthreads();
                    for (int i = tid; i < 2 * Lf; i += NTHR) GF[i] = (i >= 1) ? bf2f(FI[2 * Lf - i]) : 0.f;
                    for (int i = tid; i < NB * Lf / 8; i += NTHR) { const int b = i / (Lf / 8), s8 = (i % (Lf / 8)) * 8; const u32x4 w = *(const u32x4*)(wsrc + (size_t)b * Lf + s8);
                        const float f[8] = {bflo(w.x), bfhi(w.x), bflo(w.y), bfhi(w.y), bflo(w.z), bfhi(w.z), bflo(w.w), bfhi(w.w)};
#pragma unroll
                        for (int e = 0; e < 8; ++e) WF[(s8 + e) * 16 + b] = f[e]; }
                    __syncthreads();
                    float acc[4][16];
#pragma unroll
                    for (int r = 0; r < 4; ++r)
#pragma unroll
                        for (int b = 0; b < 16; ++b) acc[r][b] = 0.f;
                    const int tbase = tid + Lf;
                    const bool act = tid < Lf;
                    if (isl) {
                        for (int s = 0; s < SEQ; ++s) { const LAS f32x4* wp = (const LAS f32x4*)(WF + s * 16); const f32x4 w0 = wp[0], w1 = wp[1], w2 = wp[2], w3 = wp[3];
#pragma unroll
                            for (int r = 0; r < 4; ++r) { const float gi = GF[tbase + 512 * r - s];
                                acc[r][0] += gi * w0[0]; acc[r][1] += gi * w0[1]; acc[r][2] += gi * w0[2]; acc[r][3] += gi * w0[3]; acc[r][4] += gi * w1[0]; acc[r][5] += gi * w1[1]; acc[r][6] += gi * w1[2]; acc[r][7] += gi * w1[3];
                                acc[r][8] += gi * w2[0]; acc[r][9] += gi * w2[1]; acc[r][10] += gi * w2[2]; acc[r][11] += gi * w2[3]; acc[r][12] += gi * w3[0]; acc[r][13] += gi * w3[1]; acc[r][14] += gi * w3[2]; acc[r][15] += gi * w3[3]; } }
#pragma unroll
                        for (int r = 0; r < 4; ++r)
#pragma unroll
                            for (int b = 0; b < 16; ++b) ydst[(size_t)b * SEQ + tid + 512 * r] = (bf16_t)f2bf(acc[r][b]);
                    } else if (act) {
                        for (int s = 0; s < CL; ++s) { const LAS f32x4* wp = (const LAS f32x4*)(WF + s * 16); const f32x4 w0 = wp[0], w1 = wp[1], w2 = wp[2], w3 = wp[3];
                            const float gi = GF[tbase - s];
                            acc[0][0] += gi * w0[0]; acc[0][1] += gi * w0[1]; acc[0][2] += gi * w0[2]; acc[0][3] += gi * w0[3]; acc[0][4] += gi * w1[0]; acc[0][5] += gi * w1[1]; acc[0][6] += gi * w1[2]; acc[0][7] += gi * w1[3];
                            acc[0][8] += gi * w2[0]; acc[0][9] += gi * w2[1]; acc[0][10] += gi * w2[2]; acc[0][11] += gi * w2[3]; acc[0][12] += gi * w3[0]; acc[0][13] += gi * w3[1]; acc[0][14] += gi * w3[2]; acc[0][15] += gi * w3[3]; }
#pragma unroll
                        for (int b = 0; b < 16; ++b) ydst[(size_t)b * CL + tid] = (bf16_t)f2bf(acc[0][b]);
                    }
                }
            }
            SEAM(pb + 2);
            if (EN_MISC && IN(pb + 3)) {
                LAS bf16_t* T = (LAS bf16_t*)lds;
                const int nlat_u = NB * 32 * 16, nctx_u = ctx_live ? NB * 4 * 16 : 0;
                for (int u = bid; u < nlat_u + nctx_u; u += G) {
                    int b, s0, c0, Ls, rowb; const bf16_t* srcb;
                    if (u < nlat_u) { b = u >> 9; s0 = ((u >> 4) & 31) * 64; c0 = (u & 15) * 64; Ls = SEQ; rowb = b * SEQ; srcb = Yc; }
                    else { const int q = u - nlat_u; b = q >> 6; s0 = ((q >> 4) & 3) * 64; c0 = (q & 15) * 64; Ls = CL; rowb = NLAT + b * CL; srcb = Yc + WC_CTX_OFF; }
                    __syncthreads();
                    { const int c = tid >> 3, sc = (tid & 7) * 8; *(LAS u32x4*)(T + c * 72 + sc) = *(const u32x4*)(srcb + ((size_t)(c0 + c) * NB + b) * Ls + s0 + sc); }
                    __syncthreads();
                    const int sr = tid >> 3, cc = (tid & 7) * 8, s = s0 + sr;
                    float x0[8];
#pragma unroll
                    for (int e = 0; e < 8; ++e) x0[e] = cb[c0 + cc + e];
#pragma unroll
                    for (int tap = 0; tap < 3; ++tap) { const int sp = s + tap - 1;
                        if (sp >= 0 && sp < Ls) { const u32x4 a = *(const u32x4*)(Upre + (size_t)(rowb + sp) * NHY + c0 + cc); const float* w0 = cw + tap * NHY + c0 + cc;
                            const float af[8] = {bflo(a.x), bfhi(a.x), bflo(a.y), bfhi(a.y), bflo(a.z), bfhi(a.z), bflo(a.w), bfhi(a.w)};
#pragma unroll
                            for (int e = 0; e < 8; ++e) x0[e] += af[e] * w0[e]; } }
                    float z[8];
#pragma unroll
                    for (int e = 0; e < 8; ++e) z[e] = x0[e] * bf2f(T[(cc + e) * 72 + sr]);
                    u32x4 o; o.x = pk2(z[0], z[1]); o.y = pk2(z[2], z[3]); o.z = pk2(z[4], z[5]); o.w = pk2(z[6], z[7]);
                    *(u32x4*)(hA + (size_t)(rowb + s) * D + c0 + cc) = o;
                }
            }
            SEAM(pb + 3);
            if (EN_GEMM && IN(pb + 4)) {
                EpiResid E{resL, resC, out, ctxbuf, mo + 2 * D, args.in[I_HBOUT] + (size_t)jm * D};
                const bf16_t* Wt = Wout_t + (size_t)jm * D * D;
                const DenseSched S{hA, Wt, 4, (nrows / 256) * 4, G, bid};
                run_gemm(lds, S, E);
            }
            SEAM(pb + 4);
        }

        gu32* cnt = ctl + CW_CNT + layer * 32 * 64;
        if (EN_ROUTER && IN(pb + 5)) {
            LAS float* WrT = (LAS float*)lds;
            __syncthreads();
            { const float* rw = args.in[I_RW] + (size_t)layer * D * NE;
              for (int i = tid; i < D * NE; i += NTHR) { const int k = i >> 5, e = i & 31; WrT[e * D + k] = rw[i]; } }
            __syncthreads();
            const float* rb = args.in[I_RB] + layer * NE; const float* g2 = args.in[I_N2G] + layer * D;
            for (int r = gw; r < nrows; r += NGW) {
                const float* src = r < NLAT ? out + (size_t)r * D : ctxbuf + (size_t)(r - NLAT) * D;
                f32x4 v[4], h[4];
#pragma unroll
                for (int j = 0; j < 4; ++j) v[j] = ((const f32x4*)src)[lane + 64 * j];
                const float* mr = mo + (size_t)mod_row(r) * MODW;
                norm_mod_store(v, g2, mr + 3 * D, mr + 4 * D, hA + (size_t)r * D, lane, h);
                float p[32];
                asm volatile("" ::: "memory");
#pragma unroll
                for (int e = 0; e < 32; ++e) { float a = 0.f; if ((e & 3) == 0) asm volatile("" ::: "memory");
#pragma unroll
                    for (int j = 0; j < 4; ++j) { const f32x4 w = *(const LAS f32x4*)(WrT + e * D + 256 * j + 4 * lane); a += (h[j][0] * w[0] + h[j][1] * w[1]) + (h[j][2] * w[2] + h[j][3] * w[3]); }
                    p[e] = a; }
#pragma unroll
                for (int i = 0; i < 16; ++i) { const bool up = (lane & 32) != 0; const float send = up ? p[i] : p[i + 16], keep = up ? p[i + 16] : p[i]; p[i] = keep + __shfl_xor(send, 32); }
#pragma unroll
                for (int i = 0; i < 8; ++i) { const bool up = (lane & 16) != 0; const float send = up ? p[i] : p[i + 8], keep = up ? p[i + 8] : p[i]; p[i] = keep + __shfl_xor(send, 16); }
#pragma unroll
                for (int i = 0; i < 4; ++i) { const bool up = (lane & 8) != 0; const float send = up ? p[i] : p[i + 4], keep = up ? p[i + 4] : p[i]; p[i] = keep + __shfl_xor(send, 8); }
#pragma unroll
                for (int i = 0; i < 2; ++i) { const bool up = (lane & 4) != 0; const float send = up ? p[i] : p[i + 2], keep = up ? p[i + 2] : p[i]; p[i] = keep + __shfl_xor(send, 4); }
                { const bool up = (lane & 2) != 0; const float send = up ? p[0] : p[1], keep = up ? p[1] : p[0]; p[0] = keep + __shfl_xor(send, 2); }
                p[0] += __shfl_xor(p[0], 1);
                const int myE = lane >> 1;
                float val = p[0] + rb[myE];
                float sv[4]; int si[4];
#pragma unroll
                for (int k = 0; k < 4; ++k) { float bv = val; int bi = myE;
#pragma unroll
                    for (int off = 1; off < 64; off <<= 1) { const float ov = __shfl_xor(bv, off); const int oi = __shfl_xor(bi, off); if (ov > bv || (ov == bv && oi < bi)) { bv = ov; bi = oi; } }
                    sv[k] = bv; si[k] = bi; if (myE == bi) val = -INFINITY; }
                const float e1 = __expf(sv[1] - sv[0]), e2 = __expf(sv[2] - sv[0]), e3 = __expf(sv[3] - sv[0]); const float inv = 1.0f / (1.0f + e1 + e2 + e3);
                if (lane < 4) { const int e = lane == 0 ? si[0] : (lane == 1 ? si[1] : (lane == 2 ? si[2] : si[3])); const float gt = (lane == 0 ? 1.0f : (lane == 1 ? e1 : (lane == 2 ? e2 : e3))) * inv;
                    const unsigned pos = __hip_atomic_fetch_add(cnt + e * 64, 1u, RLX_AGENT);
                    top_e[r * 4 + lane] = e; ppos[r * 4 + lane] = (int)pos; pgate[r * 4 + lane] = gt; }
            }
        }
        SEAM(pb + 5);
        LAS int* PADS = (LAS int*)(lds + LDS_BYTES - 4096);
        LAS unsigned char* TE = (LAS unsigned char*)(PADS + 128);
        if (IN(pb + 6) || IN(pb + 7) || IN(pb + 8) || IN(pb + 9)) {
            __syncthreads();
            if (tid < 32) PADS[64 + tid] = (int)__hip_atomic_load(cnt + tid * 64, RLX_AGENT);
            __syncthreads();
            if (tid == 0) { int a = 0; for (int e = 0; e < 32; ++e) { PADS[e] = a; const int nt = (PADS[64 + e] + 255) >> 8; for (int t = 0; t < nt; ++t) TE[(a >> 8) + t] = (unsigned char)e; a += nt * 256; } PADS[32] = a; }
            __syncthreads();
        }
        if (EN_MISC && IN(pb + 6)) {
            for (int pr = gw; pr < nrows * 4; pr += NGW) {
                const int e = top_e[pr], dest = PADS[e] + ppos[pr]; if (lane == 0) pdest[pr] = dest;
                const u32x4* s = (const u32x4*)(hA + (size_t)(pr >> 2) * D); u32x4* d = (u32x4*)(XS + (size_t)dest * D);
                d[lane] = s[lane]; d[lane + 64] = s[lane + 64];
            }
            for (int e = 0; e < 32; ++e) { const int c0 = PADS[e] + PADS[64 + e], c1 = PADS[e + 1];
                for (int rr = c0 + gw; rr < c1; rr += NGW) { u32x4* d = (u32x4*)(XS + (size_t)rr * D); d[lane] = (u32x4){0u, 0u, 0u, 0u}; d[lane + 64] = (u32x4){0u, 0u, 0u, 0u}; } }
        }
        SEAM(pb + 6);
        if (EN_GEMM && IN(pb + 7)) {
            const int ntile = PADS[32] >> 8;
            const MoeSched S{XS, Wgu_t + (size_t)layer * NE * NGU * D, TE, 8, 3, NGU, ntile * 8, G, bid};
            const EpiSwiglu E{AB, args.in[I_BGU] + (size_t)layer * NE * NGU};
            run_gemm(lds, S, E);
        }
        SEAM(pb + 7);
        if (EN_GEMM && IN(pb + 8)) {
            const int ntile = PADS[32] >> 8;
            const MoeSched S{AB, Wdn_t + (size_t)layer * NE * D * D, TE, 4, 2, D, ntile * 4, G, bid};
            const EpiBiasBf16 E{XS, D, args.in[I_BDN] + (size_t)layer * NE * D, D};
            run_gemm(lds, S, E);
        }
        SEAM(pb + 8);
        if (EN_MISC && IN(pb + 9)) {
            const bool has_next = layer + 1 < DEPTH;
            const float* mo_n = modf + (size_t)(layer + 1) * NMODROW * MODW; const float* g1n = args.in[I_N1G] + (has_next ? (layer + 1) * D : 0);
            const int nnext = (layer + 1 < 3) ? NTOK : NLAT;
            for (int r = gw; r < nrows; r += NGW) {
                float* xr = r < NLAT ? out + (size_t)r * D : ctxbuf + (size_t)(r - NLAT) * D;
                const float* mr = mo + (size_t)mod_row(r) * MODW + 5 * D;
                f32x4 y[4];
#pragma unroll
                for (int j = 0; j < 4; ++j) y[j] = (f32x4){0.f, 0.f, 0.f, 0.f};
#pragma unroll
                for (int k = 0; k < 4; ++k) { const int dest = pdest[r * 4 + k]; const float gt = pgate[r * 4 + k]; const u32x2* yr = (const u32x2*)(XS + (size_t)dest * D);
#pragma unroll
                    for (int j = 0; j < 4; ++j) { const u32x2 w = yr[lane + 64 * j]; y[j][0] += gt * bflo(w.x); y[j][1] += gt * bfhi(w.x); y[j][2] += gt * bflo(w.y); y[j][3] += gt * bfhi(w.y); } }
                f32x4 v[4], h[4];
#pragma unroll
                for (int j = 0; j < 4; ++j) { const f32x4 g = ((const f32x4*)mr)[lane + 64 * j]; v[j] = ((const f32x4*)xr)[lane + 64 * j] + g * y[j]; ((f32x4*)xr)[lane + 64 * j] = v[j]; }
                if (has_next && r < nnext) { const float* mn = mo_n + (size_t)mod_row(r) * MODW; norm_mod_store(v, g1n, mn, mn + D, hA + (size_t)r * D, lane, h); }
            }
        }
        SEAM(pb + 9);
}

__global__ void __launch_bounds__(NTHR, 2) fwd(Args args) {
    extern __shared__ __attribute__((aligned(16))) unsigned char lds_raw[];
    LAS unsigned char* lds = (LAS unsigned char*)lds_raw;
    const int tid = threadIdx.x, lane = tid & 63, wave = __builtin_amdgcn_readfirstlane(tid >> 6);
    const int G = gridDim.x, bid = blockIdx.x;
    const int gw = bid * NWAVES + wave, NGW = G * NWAVES;
    unsigned char* ws = args.ws;
    gu32* ctl = (gu32*)(ws + WS_CTL);
    volatile LAS unsigned* MISC = (volatile LAS unsigned*)(lds + MISC_OFF);
    if (tid < 64) MISC[tid] = 0u;
    __syncthreads();
    XcdBarrier bar; bar.bar = (unsigned*)ctl + CW_BAR; bar.x = 0; bar.st = MISC + 8;
    const int lo = args.ph_lo, hi = args.ph_hi;
    if (hi - lo > 1) bar = xcd_barrier_post((unsigned*)ctl + CW_BAR, MISC + 8);

    KLOCALS

    if (EN_PRO && IN(0)) {
        {
            LAS float* scr = (LAS float*)(lds + wave * 8448);
            constexpr int IT_QKV = 16 * (NQKV / 32), IT_SQ = 16 * (D / 32), IT_IN = 16 * (NHY / 32), IT_GU = 16 * (NGU / 32);
            constexpr int N0 = 2 * IT_QKV, N1 = N0 + 2 * IT_SQ, N2 = N1 + 2 * IT_IN, N3 = N2 + 2 * IT_SQ, N4 = N3 + 128 * IT_GU, N5 = N4 + 128 * IT_SQ;
            for (int it = gw; it < N5; it += NGW) {
                if (it < N0) { const int mtx = it / IT_QKV, r = it % IT_QKV; transpose_item<1>(args.in[I_WQKV] + (size_t)mtx * D * NQKV, NQKV, Wqkv_t + (size_t)mtx * NQKV * D, scr, r, lane); }
                else if (it < N1) { const int q = it - N0, mtx = q / IT_SQ, r = q % IT_SQ; transpose_item<0>(args.in[I_WO] + (size_t)mtx * D * D, D, Wo_t + (size_t)mtx * D * D, scr, r, lane); }
                else if (it < N2) { const int q = it - N1, mtx = q / IT_IN, r = q % IT_IN; transpose_item<0>(args.in[I_HWIN] + (size_t)mtx * D * NHY, NHY, Win_t + (size_t)mtx * NHY * D, scr, r, lane); }
                else if (it < N3) { const int q = it - N2, mtx = q / IT_SQ, r = q % IT_SQ; transpose_item<0>(args.in[I_HWOUT] + (size_t)mtx * D * D, D, Wout_t + (size_t)mtx * D * D, scr, r, lane); }
                else if (it < N4) { const int q = it - N3, mtx = q / IT_GU, r = q % IT_GU; transpose_item<2>(args.in[I_WGU] + (size_t)mtx * D * NGU, NGU, Wgu_t + (size_t)mtx * NGU * D, scr, r, lane); }
                else { const int q = it - N4, mtx = q / IT_SQ, r = q % IT_SQ; transpose_item<0>(args.in[I_WDN] + (size_t)mtx * D * D, D, Wdn_t + (size_t)mtx * D * D, scr, r, lane); }
            }
        }
        __syncthreads();
        {
            LAS float* S = (LAS float*)lds;
            for (int u = bid; u < 4 * 12 * 8; u += G) {
                const int kc = u & 7, cc = (u >> 3) % 12, layer = u / 96;
                __syncthreads();
                for (int i = tid; i < 128 * 20; i += NTHR) { const int k = i / 20, r = i % 20; float v = 0.f;
                    if (r < NMODROW) { const float cv = r < NB ? c_in[r * D + kc * 128 + k] : cctx_in[kc * 128 + k]; v = cv / (1.0f + __expf(-cv)); }
                    S[i] = v; }
                __syncthreads();
                const int col = cc * 512 + tid;
                const float* wp = args.in[I_WMOD] + ((size_t)layer * D + kc * 128) * MODW + col;
                float acc[20];
#pragma unroll
                for (int r = 0; r < 20; ++r) acc[r] = 0.f;
                for (int k = 0; k < 128; ++k) { const float w = wp[(size_t)k * MODW];
#pragma unroll
                    for (int q = 0; q < 5; ++q) { const f32x4 s = *(const LAS f32x4*)(S + k * 20 + 4 * q);
                        acc[4 * q] += s[0] * w; acc[4 * q + 1] += s[1] * w; acc[4 * q + 2] += s[2] * w; acc[4 * q + 3] += s[3] * w; } }
#pragma unroll
                for (int r = 0; r < NMODROW; ++r) modp[((size_t)(kc * 4 + layer) * NMODROW + r) * MODW + col] = acc[r];
            }
        }
        for (int i = bid * NTHR + tid; i < SEQ * 32; i += G * NTHR) {
            const int t = i >> 5, j = i & 31, fi = j & 15; const int pos = (j >> 4) == 0 ? (t >> 6) : (t & 63);
            const float inv = powf(10000.0f, -(float)fi / 16.0f); const float ang = (float)pos * inv;
            cosT[i] = cosf(ang); sinT[i] = sinf(ang);
        }
        {
            __syncthreads();
            LAS float* Z = (LAS float*)lds;
            LAS float* A1 = Z + 8 * 36;
            for (int u = bid; u < 256 + 256 + 32; u += G) {
                const int combo = u < 256 ? 0 : (u < 512 ? 1 : 2); const int ub = combo == 0 ? u : (combo == 1 ? u - 256 : u - 512);
                const int j = combo == 1 ? 1 : 0, Lf = combo == 2 ? CL : SEQ;
                const int tl = tid >> 6, o = tid & 63, t = ub * 8 + tl;
                __syncthreads();
                if (o < 33) { float z;
                    const float tt = (float)t / (float)(Lf - 1), w = 6.283185307179586f * (float)t / (float)Lf;
                    if (o == 0) z = tt; else { const int b = (o - 1) & 15; const float f = 1e-4f + (float)b * ((15.0f - 1e-4f) / 15.0f); z = o <= 16 ? cosf(f * w) : -sinf(f * w); }
                    Z[tl * 36 + o] = z; }
                __syncthreads();
                const float sf = args.in[I_HSF][j * 64 + o];
                { const float* w1 = args.in[I_HW1] + (size_t)j * 33 * 64; float a = args.in[I_HB1][j * 64 + o];
                  for (int i = 0; i < 33; ++i) a += Z[tl * 36 + i] * w1[i * 64 + o];
                  A1[tl * 64 + o] = sinf(sf * a); }
                __syncthreads();
                { const float* w2 = args.in[I_HW2] + (size_t)j * 64 * 64; float a = args.in[I_HB2][j * 64 + o];
                  for (int i = 0; i < 64; ++i) a += A1[tl * 64 + i] * w2[i * 64 + o];
                  a2tab[((size_t)combo * SEQ + t) * 64 + o] = sinf(sf * a); }
            }
        }
    }
    SEAM(0);

    if (EN_PRO && IN(1)) {
        for (int i = bid * NTHR + tid; i < DEPTH * NMODROW * MODW; i += G * NTHR) {
            const int layer = i / (NMODROW * MODW), rem = i % (NMODROW * MODW), col = rem % MODW; float s = args.in[I_BMOD][layer * MODW + col];
#pragma unroll
            for (int kc = 0; kc < 8; ++kc) s += modp[(size_t)(kc * 4 + layer) * NMODROW * MODW + rem];
            modf[i] = s;
        }
        {
            LAS float* W3 = (LAS float*)lds;
            LAS float* RED = W3 + 512;
            LAS float* NRM = RED + 32;
            LAS float* HF = NRM + 4;
            for (int u = bid; u < 3 * 256; u += G) {
                const int combo = u >> 8, cg = u & 255; const int j = combo == 1 ? 1 : 0, Lf = combo == 2 ? CL : SEQ; const int c0 = cg * 4;
                LAS float* HB = HF + 4 * Lf;
                __syncthreads();
                { const int i = tid >> 3, q = tid & 7; const int col = (q >> 2) * 1024 + c0 + (q & 3);
                  W3[i * 8 + q] = args.in[I_HW3][((size_t)j * 64 + i) * 2048 + col]; }
                __syncthreads();
                float b3v[8], dec[4], asum[4] = {0.f, 0.f, 0.f, 0.f};
#pragma unroll
                for (int q = 0; q < 8; ++q) b3v[q] = args.in[I_HB3][j * 2048 + (q >> 2) * 1024 + c0 + (q & 3)];
#pragma unroll
                for (int ch = 0; ch < 4; ++ch) dec[ch] = 3.0701134573253945f + (float)(c0 + ch) * ((15.350567286626972f - 3.0701134573253945f) / 1023.0f);
                for (int t = tid; t < Lf; t += NTHR) {
                    asm volatile("" ::: "memory");
                    const float* ar = a2tab + ((size_t)combo * SEQ + t) * 64; float d[8];
#pragma unroll
                    for (int q = 0; q < 8; ++q) d[q] = b3v[q];
#pragma unroll
                    for (int i4 = 0; i4 < 16; ++i4) { const f32x4 a = *(const f32x4*)(ar + 4 * i4); asm volatile("" ::: "memory");
#pragma unroll
                        for (int e = 0; e < 4; ++e) { const f32x4 w0 = *(const LAS f32x4*)(W3 + (4 * i4 + e) * 8), w1 = *(const LAS f32x4*)(W3 + (4 * i4 + e) * 8 + 4);
                            d[0] += a[e] * w0[0]; d[1] += a[e] * w0[1]; d[2] += a[e] * w0[2]; d[3] += a[e] * w0[3]; d[4] += a[e] * w1[0]; d[5] += a[e] * w1[1]; d[6] += a[e] * w1[2]; d[7] += a[e] * w1[3]; } }
                    const float tt = (float)t / (float)(Lf - 1);
#pragma unroll
                    for (int ch = 0; ch < 4; ++ch) { const float dk = __expf(-tt * dec[ch]); const float f = d[ch] * dk, bb = d[4 + ch] * dk;
                        HF[ch * Lf + t] = f; HB[ch * Lf + t] = bb; asum[ch] += fabsf(f) + (t >= 1 ? fabsf(bb) : 0.f); }
                }
#pragma unroll
                for (int ch = 0; ch < 4; ++ch) { const float s = wave_sum(asum[ch]); if (lane == 0) RED[wave * 4 + ch] = s; }
                __syncthreads();
                if (tid < 4) { float s = 0.f; for (int w = 0; w < 8; ++w) s += RED[w * 4 + tid]; NRM[tid] = 1.0f / (s + EPS); }
                __syncthreads();
                const int P = 2 * Lf + 8, PC8 = P / 8;
                bf16_t* FI = (bf16_t*)(ws + (combo == 0 ? WS_FI0 : (combo == 1 ? WS_FI1 : WS_FI2)));
                for (int q = tid; q < 4 * 8 * PC8; q += NTHR) {
                    const int ch = q / (8 * PC8), r = q % (8 * PC8), cidx = r / PC8, x0 = (r % PC8) * 8;
                    const float nr = NRM[ch], db = args.in[I_HDB][j * 1024 + c0 + ch]; float v[8];
#pragma unroll
                    for (int e = 0; e < 8; ++e) { const int m = Lf - (x0 + e) + cidx; const int am = m < 0 ? -m : m; float g = 0.f;
                        if (am <= Lf - 1) { g = (m >= 0 ? HF[ch * Lf + am] : HB[ch * Lf + am]) * nr; if (m == 0) g += db; }
                        v[e] = g; }
                    u32x4 o; o.x = pk2(v[0], v[1]); o.y = pk2(v[2], v[3]); o.z = pk2(v[4], v[5]); o.w = pk2(v[6], v[7]);
                    *(u32x4*)(FI + ((size_t)((c0 + ch) * 8 + cidx)) * P + x0) = o;
                }
            }
        }
    }
    SEAM(1);

    if (IN(2)) {
        const float* mo = modf;
        for (int r = gw; r < NTOK; r += NGW) {
            const float* src = r < NLAT ? x_in + (size_t)r * D : ctx_in + (size_t)(r - NLAT) * D;
            f32x4 v[4], h[4];
#pragma unroll
            for (int j = 0; j < 4; ++j) v[j] = ((const f32x4*)src)[lane + 64 * j];
            const float* mr = mo + (size_t)mod_row(r) * MODW;
            norm_mod_store(v, args.in[I_N1G], mr, mr + D, hA + (size_t)r * D, lane, h);
        }
    }
    SEAM(2);

    layer_body<0>(args, lds, bar, tid, lane, wave, G, bid, lo, hi);
    layer_body<1>(args, lds, bar, tid, lane, wave, G, bid, lo, hi);
    layer_body<2>(args, lds, bar, tid, lane, wave, G, bid, lo, hi);
    layer_body<3>(args, lds, bar, tid, lane, wave, G, bid, lo, hi);
#undef IN
#undef SEAM
}

extern "C" void kernel_launch(void* const* d_in, const int* in_sizes, int n_in, void* d_out, int out_size, void* d_ws, size_t ws_size, hipStream_t stream) {
    static int grid = 0;
    if (grid == 0) {
        if (n_in != 32 || out_size != NLAT * D || ws_size < WS_END) { fprintf(stderr, "kernel_launch: unexpected problem (n_in %d, out %d, ws %zu)\n", n_in, out_size, ws_size); grid = -1; return; }
        int dev = 0, cus = 0, per_cu = 0;
        if (hipGetDevice(&dev) != hipSuccess || hipDeviceGetAttribute(&cus, hipDeviceAttributeMultiprocessorCount, dev) != hipSuccess) { grid = -1; return; }
        if (hipFuncSetAttribute((const void*)fwd, hipFuncAttributeMaxDynamicSharedMemorySize, LDS_BYTES) != hipSuccess) { fprintf(stderr, "kernel_launch: hipFuncSetAttribute failed\n"); grid = -1; return; }
        if (hipOccupancyMaxActiveBlocksPerMultiprocessor(&per_cu, (const void*)fwd, NTHR, LDS_BYTES) != hipSuccess || per_cu < 1) fprintf(stderr, "kernel_launch: occupancy query says %d\n", per_cu);
        (void)hipGetLastError();
        grid = cus;
    }
    if (grid < 0) return;
    (void)hipMemsetAsync((char*)d_ws + WS_CTL, 0, CTL_ZERO_BYTES, stream);
    Args a{};
    for (int i = 0; i < 32; ++i) a.in[i] = (const float*)d_in[i];
    a.out = (float*)d_out; a.ws = (unsigned char*)d_ws;
    constexpr int NPH = 3 + 10 * DEPTH;
#if MK_ONE_LAUNCH
    a.ph_lo = 0; a.ph_hi = NPH;
    hipLaunchKernelGGL(fwd, dim3(grid), dim3(NTHR), LDS_BYTES, stream, a);
#else
    for (int p = 0; p < NPH; ++p) {
        if (p >= 3) { const int layer = (p - 3) / 10, loc = (p - 3) % 10; if ((layer & 1) == 0 && (loc == 3 || loc == 4)) continue; }
        a.ph_lo = p; a.ph_hi = p + 1;
        hipLaunchKernelGGL(fwd, dim3(grid), dim3(NTHR), LDS_BYTES, stream, a);
    }
#endif
}
```

```cpp
#include <hip/hip_runtime.h>
#include <cstdio>
#include <cstdint>

#ifndef EN_PRO
#define EN_PRO 1
#endif
#ifndef EN_ATT
#define EN_ATT 1
#endif
#ifndef EN_CONV
#define EN_CONV 1
#endif
#ifndef EN_ROUTER
#define EN_ROUTER 1
#endif
#ifndef EN_GEMM
#define EN_GEMM 1
#endif
#ifndef EN_MISC
#define EN_MISC 1
#endif
#ifndef MK_ONE_LAUNCH
#define MK_ONE_LAUNCH 1
#endif

#define GAS __attribute__((address_space(1)))
#define LAS __attribute__((address_space(3)))
typedef unsigned short bf16_t;
typedef short bf16x8 __attribute__((ext_vector_type(8)));
typedef float f32x4 __attribute__((ext_vector_type(4)));
typedef float f32x2 __attribute__((ext_vector_type(2)));
typedef unsigned u32x4 __attribute__((ext_vector_type(4)));
typedef unsigned u32x2 __attribute__((ext_vector_type(2)));
typedef GAS unsigned gu32;
typedef float f32x16 __attribute__((ext_vector_type(16)));

constexpr int D = 1024, NB = 16, SEQ = 2048, CL = 256, KVL = SEQ + CL;
constexpr int NLAT = NB * SEQ, NCTX = NB * CL, NTOK = NLAT + NCTX;
constexpr int NE = 32, TOPK = 4, DEPTH = 4;
constexpr int MODW = 6 * D, NMODROW = NB + 1;
constexpr int NQKV = 1536, NHY = 3072, NGU = 2048;
constexpr float EPS = 1e-6f;
constexpr float C2 = 0.125f * 1.4426950408889634f;
constexpr int NWAVES = 8, NTHR = 512;
constexpr int NPADROWS = 155648;
constexpr int MAXTILES = NPADROWS / 256;

constexpr size_t MiB = 1u << 20;
constexpr size_t WS_CTL = 0, CTL_ZERO_BYTES = 1 * MiB;
constexpr size_t WS_MODP = 2 * MiB;
constexpr size_t WS_MOD = 16 * MiB;
constexpr size_t WS_ROPE = 18 * MiB;
constexpr size_t WS_A2 = 19 * MiB;
constexpr size_t WS_PAIR = 21 * MiB;
constexpr size_t WS_CTX = 24 * MiB;
constexpr size_t WS_FI = 40 * MiB;
constexpr int FP_L = 2 * SEQ + 8, FP_C = 2 * CL + 8;
constexpr size_t FI_L_BYTES = (size_t)1024 * 8 * FP_L * 2, FI_C_BYTES = (size_t)1024 * 8 * FP_C * 2;
constexpr size_t WS_FI0 = WS_FI, WS_FI1 = WS_FI0 + 65 * MiB, WS_FI2 = WS_FI1 + 65 * MiB;
static_assert(FI_L_BYTES <= 65 * MiB && WS_FI2 + FI_C_BYTES <= 180 * MiB, "filter map");
constexpr size_t WS_WQKV = 180 * MiB, WS_WO = 186 * MiB, WS_WIN = 190 * MiB, WS_WOUT = 202 * MiB, WS_WGU = 206 * MiB, WS_WDN = 718 * MiB;
constexpr size_t WS_HA = 974 * MiB;
constexpr size_t WS_Q = 1046 * MiB;
constexpr size_t WS_K = 1118 * MiB, WS_V = 1136 * MiB;
constexpr size_t WS_UPRE = 1154 * MiB;
constexpr size_t WS_WC = 1370 * MiB;
constexpr size_t WS_YC = 1442 * MiB;
constexpr size_t WS_XS = 1514 * MiB;
constexpr size_t WS_AB = 1818 * MiB;
constexpr size_t WS_END = 2122 * MiB;
constexpr size_t WC_CTX_OFF = (size_t)1024 * 16 * 2048;
constexpr int CW_TMO = 0, CW_BAR = 4096, CW_CNT = 16384;

constexpr int LDS_BYTES = 160 * 1024;
constexpr int MISC_OFF = LDS_BYTES - 256;

#define RLX_AGENT __ATOMIC_RELAXED, __HIP_MEMORY_SCOPE_AGENT
#define LDS_WAIT() asm volatile("s_waitcnt lgkmcnt(0)" ::: "memory")
#define VM_WAIT() asm volatile("s_waitcnt vmcnt(0)" ::: "memory")
__device__ __forceinline__ unsigned f2bf(float f) { unsigned u = __builtin_bit_cast(unsigned, f); return (u + 0x7fffu + ((u >> 16) & 1u)) >> 16; }
__device__ __forceinline__ unsigned pk2(float lo, float hi) { return f2bf(lo) | (f2bf(hi) << 16); }
__device__ __forceinline__ float bf2f(unsigned h) { return __builtin_bit_cast(float, h << 16); }
__device__ __forceinline__ float bflo(unsigned w) { return __builtin_bit_cast(float, w << 16); }
__device__ __forceinline__ float bfhi(unsigned w) { return __builtin_bit_cast(float, w & 0xffff0000u); }
__device__ __forceinline__ float wave_sum(float v) {
#pragma unroll
    for (int o = 1; o < 64; o <<= 1) v += __shfl_xor(v, o);
    return v;
}

#define XB_TMO      128
#define XB_XCNT(j)  (256  + 64 * (j))
#define XB_XSUB(j)  (1280 + 64 * (j))
#define XB_XGEN(j)  (2304 + 64 * (j))
#define XB_TOP      3328
#define XB_TOPGEN   3392
#define XCD_BAR_WORDS 3456
#define XB_SPIN_CAP (1u << 22)
__device__ __forceinline__ unsigned xb_ld(unsigned* p)              { return __hip_atomic_load(p, __ATOMIC_RELAXED, __HIP_MEMORY_SCOPE_AGENT); }
__device__ __forceinline__ unsigned xb_add(unsigned* p, unsigned v) { return __hip_atomic_fetch_add(p, v, __ATOMIC_RELAXED, __HIP_MEMORY_SCOPE_AGENT); }
__device__ __forceinline__ unsigned xb_xcc_id() { return (unsigned)__builtin_amdgcn_s_getreg((3 << 11) | 20) & 0xFu; }
#define XB_SPIN(cond, bar) do { unsigned _sp = 0; while (cond) { __builtin_amdgcn_s_sleep(1); \
    if ((++_sp & 255u) == 0u) { if (xb_ld(&(bar)[XB_TMO])) break; if (_sp > XB_SPIN_CAP) { atomicAdd(&(bar)[XB_TMO], 1u); break; } } } } while (0)
struct XcdBarrier { unsigned* bar; unsigned x; volatile LAS unsigned* st; };
__device__ __forceinline__ XcdBarrier xcd_barrier_post(unsigned* bar, volatile LAS unsigned* st) {
    XcdBarrier b; b.bar = bar; b.x = xb_xcc_id(); b.st = st;
    if (threadIdx.x == 0) (void)xb_add(&bar[XB_XCNT(b.x)], 1u);
    return b;
}
__device__ __forceinline__ void xcd_barrier_complete(unsigned* bar, unsigned x, unsigned& nloc, unsigned& nx) {
    const unsigned G = gridDim.x * gridDim.y * gridDim.z;
    unsigned sum, cnt, mine, sp = 0u;
    for (;;) {
        sum = 0u; cnt = 0u; mine = 0u;
#pragma unroll
        for (unsigned j = 0; j < 16; ++j) { const unsigned c = xb_ld(&bar[XB_XCNT(j)]); sum += c; cnt += (c > 0u) ? 1u : 0u; mine = (j == x) ? c : mine; }
        if (sum == G) break;
        __builtin_amdgcn_s_sleep(1);
        if ((++sp & 255u) == 0u) { if (xb_ld(&bar[XB_TMO])) break; if (sp > XB_SPIN_CAP) { atomicAdd(&bar[XB_TMO], 1u); break; } }
    }
    nloc = mine > 0u ? mine : 1u; nx = cnt > 0u ? cnt : 1u;
}
__device__ __forceinline__ void xcd_barrier(const XcdBarrier& b) {
    asm volatile("s_waitcnt vmcnt(0)" ::: "memory");
    __syncthreads();
    if (threadIdx.x == 0) {
        unsigned* bar = b.bar;
        __builtin_amdgcn_s_waitcnt(0);
        unsigned nloc = b.st[0], nx = b.st[1];
        if (nloc == 0u) { xcd_barrier_complete(bar, b.x, nloc, nx); b.st[0] = nloc; b.st[1] = nx; }
        const unsigned old = xb_add(&bar[XB_XSUB(b.x)], 1u);
        const unsigned gen = old / nloc;
        if (old + 1u == (gen + 1u) * nloc) {
            __builtin_amdgcn_fence(__ATOMIC_RELEASE, "agent");
            asm volatile("s_waitcnt vmcnt(0)" ::: "memory");
            const unsigned og = xb_add(&bar[XB_TOP], 1u);
            const unsigned tg = og / nx;
            if (og + 1u == (tg + 1u) * nx) xb_add(&bar[XB_TOPGEN], 1u);
            else XB_SPIN(xb_ld(&bar[XB_TOPGEN]) == tg, bar);
            __builtin_amdgcn_fence(__ATOMIC_ACQUIRE, "agent");
            xb_add(&bar[XB_XGEN(b.x)], 1u);
            asm volatile("s_waitcnt vmcnt(0)" ::: "memory");
        } else {
            XB_SPIN(xb_ld(&bar[XB_XGEN(b.x)]) == gen, bar);
            __builtin_amdgcn_fence(__ATOMIC_ACQUIRE, "agent");
            asm volatile("s_waitcnt vmcnt(0)" ::: "memory");
        }
    }
    __syncthreads();
}

struct Args { const float* in[32]; float* out; unsigned char* ws; int ph_lo, ph_hi; };
struct Ctx {
    LAS unsigned char* lds;
    int tid, lane, wave, G, bid;
    const float* const* in;
};
enum { I_X = 0, I_C, I_CTX, I_CCTX, I_WMOD, I_BMOD, I_N1G, I_N2G, I_WQKV, I_QG, I_KG, I_WO, I_HWIN, I_HBIN, I_HCW, I_HCB, I_HW1, I_HB1, I_HW2, I_HB2, I_HW3, I_HB3,
       I_HSF, I_HDB, I_HWOUT, I_HBOUT, I_RW, I_RB, I_WGU, I_BGU, I_WDN, I_BDN };

__device__ __forceinline__ int mod_row(int r) { return r < NLAT ? (r >> 11) : NB; }

__device__ __forceinline__ void gemm_unit_simple(const bf16_t* At, const bf16_t* Bt, f32x4 (&acc)[2][2][4][2], int wr, int wc, int fr, int fq) {
    constexpr int K = D;
#pragma unroll
    for (int a = 0; a < 2; ++a)
#pragma unroll
        for (int b = 0; b < 2; ++b)
#pragma unroll
            for (int m = 0; m < 4; ++m)
#pragma unroll
                for (int n = 0; n < 2; ++n) acc[a][b][m][n] = (f32x4){0.f, 0.f, 0.f, 0.f};
    const bf16_t* ap = At + (size_t)(wr * 64 + fr) * K + fq * 8;
    const bf16_t* bp = Bt + (size_t)(wc * 32 + fr) * K + fq * 8;
    for (int k0 = 0; k0 < K; k0 += 32) {
        bf16x8 bfr[2][2];
#pragma unroll
        for (int bj = 0; bj < 2; ++bj)
#pragma unroll
            for (int n = 0; n < 2; ++n) bfr[bj][n] = *(const bf16x8*)(bp + (size_t)(bj * 128 + n * 16) * K + k0);
#pragma unroll
        for (int ai = 0; ai < 2; ++ai)
#pragma unroll
            for (int m = 0; m < 4; ++m) {
                const bf16x8 afr = *(const bf16x8*)(ap + (size_t)(ai * 128 + m * 16) * K + k0);
#pragma unroll
                for (int bj = 0; bj < 2; ++bj)
#pragma unroll
                    for (int n = 0; n < 2; ++n) acc[ai][bj][m][n] = __builtin_amdgcn_mfma_f32_16x16x32_bf16(bfr[bj][n], afr, acc[ai][bj][m][n], 0, 0, 0);
            }
    }
}


struct Unit { int pm, pn, e; };
namespace pg8 {
constexpr int BM = 256, BK = 64, HALF = 128, HTB = HALF * BK * 2, STAGE_BYTES = 8 * HTB;
__device__ __forceinline__ int lds_byte(int r, int c) { const int st = (r >> 4) * 2 + (c >> 5), rr = r & 15, cc = c & 31, ob = rr * 64 + cc * 2; return st * 1024 + (ob ^ (((ob >> 9) & 1) << 5)); }
__device__ __forceinline__ void stage_rc(int b, int& R, int& C) { const int st = b / 1024, sb = b % 1024, swz = sb ^ (((sb >> 9) & 1) << 5); R = (st >> 1) * 16 + swz / 64; C = (st & 1) * 32 + (swz % 64) / 2; }
template <class Epi, class Sched>
__device__ __forceinline__ void gemm_phase(LAS unsigned char* lds, const Sched& S, const Epi& E) {
    constexpr int K = D, nt = K / BK;
    const int tid = threadIdx.x, wid = __builtin_amdgcn_readfirstlane(tid >> 6), lane = tid & 63, wr = wid >> 2, wc = wid & 3, fr = lane & 15, fq = lane >> 4;
    unsigned voffA[2];
#pragma unroll
    for (int i = 0; i < 2; ++i) { int R, C; stage_rc(tid * 16 + i * 8192, R, C); voffA[i] = (unsigned)(R * K + C) * 2u; }
    const size_t kstep = (size_t)(BK * 2);
    const size_t hstep = (size_t)HALF * K * 2;
    const unsigned ldsw = (unsigned)wid * 1024u;
    const int aoff = lds_byte(wr * 64 + fr, fq * 8), boff = lds_byte(wc * 32 + fr, fq * 8);
#define PG8_SA(b, h) (((b) * 2 + (h)) * HTB)
#define PG8_SB(b, h) ((4 + (b) * 2 + (h)) * HTB)
#define PG8_STAGE(bufoff, gbase, voff) do { _Pragma("unroll") for (int _i = 0; _i < 2; ++_i) \
        __builtin_amdgcn_global_load_lds((const unsigned*)((const char*)(gbase) + (voff)[_i]), (LAS unsigned*)(lds + (bufoff) + ldsw + _i * 8192), 16, 0, 0); } while (0)
#define PG8_LDA(dst, b, h) do { _Pragma("unroll") for (int m = 0; m < 4; ++m) _Pragma("unroll") for (int k = 0; k < 2; ++k) dst[m][k] = *(const LAS bf16x8*)(lds + PG8_SA(b, h) + aoff + m * 2048 + k * 1024); } while (0)
#define PG8_LDB(dst, b, h) do { _Pragma("unroll") for (int n = 0; n < 2; ++n) _Pragma("unroll") for (int k = 0; k < 2; ++k) dst[n][k] = *(const LAS bf16x8*)(lds + PG8_SB(b, h) + boff + n * 2048 + k * 1024); } while (0)
#define PG8_MMA(ai, bj, At, Bt) do { __builtin_amdgcn_s_setprio(1); _Pragma("unroll") for (int m = 0; m < 4; ++m) _Pragma("unroll") for (int n = 0; n < 2; ++n) _Pragma("unroll") for (int k = 0; k < 2; ++k) \
        acc[ai][bj][m][n] = __builtin_amdgcn_mfma_f32_16x16x32_bf16(Bt[n][k], At[m][k], acc[ai][bj][m][n], 0, 0, 0); __builtin_amdgcn_s_setprio(0); } while (0)
#define PG8_WAIT_V(n) asm volatile("s_waitcnt vmcnt(" #n ")" ::: "memory")
#define PG8_WAIT_L(n) asm volatile("s_waitcnt lgkmcnt(" #n ")" ::: "memory")
#define PG8_BAR __builtin_amdgcn_s_barrier()
#define PG8_SCHED __builtin_amdgcn_sched_barrier(0)
    Unit cur, nxt; int ui = 0;
    if (!S.next(0, cur)) return;
    f32x4 acc[2][2][4][2];
#pragma unroll
    for (int a = 0; a < 2; ++a)
#pragma unroll
        for (int b = 0; b < 2; ++b)
#pragma unroll
            for (int m = 0; m < 4; ++m)
#pragma unroll
                for (int n = 0; n < 2; ++n) acc[a][b][m][n] = (f32x4){0.f, 0.f, 0.f, 0.f};
    bf16x8 At[4][2], B0[2][2], B1[2][2];
    const char* cA = S.a_ptr(cur); const char* cB = S.b_ptr(cur);
    PG8_STAGE(PG8_SB(0, 0), cB, voffA); PG8_STAGE(PG8_SB(0, 1), cB + hstep, voffA); PG8_STAGE(PG8_SA(0, 0), cA, voffA); PG8_STAGE(PG8_SA(0, 1), cA + hstep, voffA);
    if (wr == 1) PG8_BAR;
    PG8_WAIT_V(2); PG8_BAR;
    PG8_STAGE(PG8_SB(1, 0), cB + kstep, voffA); PG8_STAGE(PG8_SA(1, 0), cA + kstep, voffA); PG8_STAGE(PG8_SB(1, 1), cB + hstep + kstep, voffA);
    PG8_WAIT_V(6); PG8_BAR;
    for (;;) {
        const bool has_next = S.next(ui + 1, nxt);
        const char* nA = has_next ? S.a_ptr(nxt) : cA; const char* nB = has_next ? S.b_ptr(nxt) : cB;
        for (int t = 0; t < nt; t += 2) {
            const bool last = (t == nt - 2);
            const char* a1 = cA + (size_t)(t + 1) * kstep;
            const char* a2 = last ? nA : cA + (size_t)(t + 2) * kstep; const char* b2 = last ? nB : cB + (size_t)(t + 2) * kstep;
            const char* a3 = a2 + kstep; const char* b3 = b2 + kstep;
            PG8_LDB(B0, 0, 0); PG8_LDB(B1, 0, 1); PG8_SCHED; PG8_LDA(At, 0, 0); PG8_STAGE(PG8_SA(1, 1), a1 + hstep, voffA);
            PG8_WAIT_V(8); PG8_WAIT_L(0); PG8_BAR; PG8_MMA(0, 0, At, B0); PG8_MMA(0, 1, At, B1); PG8_BAR; PG8_SCHED;
            PG8_LDA(At, 0, 1); PG8_STAGE(PG8_SB(0, 0), b2, voffA); PG8_STAGE(PG8_SB(0, 1), b2 + hstep, voffA); PG8_STAGE(PG8_SA(0, 0), a2, voffA);
            PG8_WAIT_V(8); PG8_WAIT_L(0); PG8_BAR; PG8_MMA(1, 0, At, B0); PG8_MMA(1, 1, At, B1); PG8_BAR; PG8_SCHED;
            PG8_LDB(B0, 1, 0); PG8_LDB(B1, 1, 1); PG8_SCHED; PG8_LDA(At, 1, 0); PG8_STAGE(PG8_SA(0, 1), a2 + hstep, voffA);
            PG8_WAIT_V(8); PG8_WAIT_L(0); PG8_BAR; PG8_MMA(0, 0, At, B0); PG8_MMA(0, 1, At, B1); PG8_BAR; PG8_SCHED;
            PG8_LDA(At, 1, 1); PG8_STAGE(PG8_SB(1, 0), b3, voffA); PG8_STAGE(PG8_SB(1, 1), b3 + hstep, voffA); PG8_STAGE(PG8_SA(1, 0), a3, voffA);
            PG8_WAIT_V(8); PG8_WAIT_L(0); PG8_BAR; PG8_MMA(1, 0, At, B0); PG8_MMA(1, 1, At, B1); PG8_BAR; PG8_SCHED;
        }
        if (wr == 0) PG8_BAR;
        E(acc, cur, wr, wc, fr, fq);
        if (!has_next) break;
#pragma unroll
        for (int a = 0; a < 2; ++a)
#pragma unroll
            for (int b = 0; b < 2; ++b)
#pragma unroll
                for (int m = 0; m < 4; ++m)
#pragma unroll
                    for (int n = 0; n < 2; ++n) acc[a][b][m][n] = (f32x4){0.f, 0.f, 0.f, 0.f};
        cur = nxt; cA = nA; cB = nB; ++ui;
        if (wr == 1) PG8_BAR;
    }
    PG8_WAIT_V(0);
    PG8_BAR;
#undef PG8_SA
#undef PG8_SB
#undef PG8_STAGE
#undef PG8_LDA
#undef PG8_LDB
#undef PG8_MMA
#undef PG8_WAIT_V
#undef PG8_WAIT_L
#undef PG8_BAR
#undef PG8_SCHED
}
}

template <class Epi, class Sched>
__device__ __forceinline__ void gemm_phase_simple(const Sched& S, const Epi& E) {
    const int tid = threadIdx.x, wid = __builtin_amdgcn_readfirstlane(tid >> 6), lane = tid & 63, wr = wid >> 2, wc = wid & 3, fr = lane & 15, fq = lane >> 4;
    Unit u;
    for (int i = 0; S.next(i, u); ++i) { f32x4 acc[2][2][4][2];
        gemm_unit_simple((const bf16_t*)S.a_ptr(u), (const bf16_t*)S.b_ptr(u), acc, wr, wc, fr, fq);
        E(acc, u, wr, wc, fr, fq); }
}
#ifndef FAST_GEMM
#define FAST_GEMM 1
#endif
template <class Epi, class Sched>
__device__ __forceinline__ void run_gemm(LAS unsigned char* lds, const Sched& S, const Epi& E) {
#if FAST_GEMM
    pg8::gemm_phase<Epi, Sched>(lds, S, E);
#else
    gemm_phase_simple<Epi, Sched>(S, E);
#endif
}
__device__ __forceinline__ bool xcd_unit(int i, int G, int c, int nM, int nN, int& pm, int& pn) {
    const int x = c & 7, s = c >> 3, nS = G >> 3;
    const int r0 = (nM * x) >> 3, r1 = (nM * (x + 1)) >> 3;
    const int q = i * nS + s; if (q >= (r1 - r0) * nN) return false;
    const int rr = q / nN; pm = r0 + rr; pn = q - rr * nN; return true;
}
struct DenseSched {
    const bf16_t* A; const bf16_t* Bt; int nM, nN, G, c;
    __device__ __forceinline__ bool next(int i, Unit& u) const { u.e = 0; return xcd_unit(i, G, c, nM, nN, u.pm, u.pn); }
    __device__ __forceinline__ const char* a_ptr(const Unit& u) const { return (const char*)(A + (size_t)u.pm * 256 * D); }
    __device__ __forceinline__ const char* b_ptr(const Unit& u) const { return (const char*)(Bt + (size_t)u.pn * 256 * D); }
};
struct QkvSched {
    const bf16_t* A; const bf16_t* Bt; int live, G, c;
    __device__ __forceinline__ bool next(int i, Unit& u) const { u.e = 0;
        if (live) return xcd_unit(i, G, c, 144, 6, u.pm, u.pn);
        const int x = c & 7, s = c >> 3, nS = G >> 3; const int nlat = 16 * 6; const int q = i * nS + s;
        if (q < nlat) { const int rr = q / 6; u.pm = 16 * x + rr; u.pn = q - rr * 6; return true; }
        const int q2 = q - nlat; if (q2 >= 4) return false; const int t = x * 4 + q2; u.pm = 128 + (t >> 1); u.pn = 4 + (t & 1); return true; }
    __device__ __forceinline__ const char* a_ptr(const Unit& u) const { return (const char*)(A + (size_t)u.pm * 256 * D); }
    __device__ __forceinline__ const char* b_ptr(const Unit& u) const { return (const char*)(Bt + (size_t)u.pn * 256 * D); }
};
struct MoeSched {
    const bf16_t* A; const bf16_t* Bt  ; const LAS unsigned char* TE; int nM, nN, N, G, c;
    __device__ __forceinline__ bool next(int i, Unit& u) const { if (!xcd_unit(i, G, c, nM, nN, u.pm, u.pn)) return false; u.e = TE[u.pm]; return true; }
    __device__ __forceinline__ const char* a_ptr(const Unit& u) const { return (const char*)(A + (size_t)u.pm * 256 * D); }
    __device__ __forceinline__ const char* b_ptr(const Unit& u) const { return (const char*)(Bt + ((size_t)u.e * N + (size_t)u.pn * 256) * D); }
};

struct EpiQKV {
    bf16_t *Q, *Kb, *Vb; const float *qg, *kg, *cosT, *sinT;
    __device__ __forceinline__ void operator()(const f32x4 (&acc)[2][2][4][2], const Unit& uu, int wr, int wc, int fr, int fq) const {
        const int pm = uu.pm, pn = uu.pn;
        const int kind = pn < 4 ? 0 : (pn == 4 ? 1 : 2);
        const float* gain = kind == 0 ? qg : kg;
        f32x4 gv[2][2];
#pragma unroll
        for (int bj = 0; bj < 2; ++bj)
#pragma unroll
            for (int n = 0; n < 2; ++n) gv[bj][n] = *(const f32x4*)(gain + 32 * bj + 16 * n + 4 * fq);
#pragma unroll
        for (int ai = 0; ai < 2; ++ai)
#pragma unroll
            for (int m = 0; m < 4; ++m) {
                const int r = pm * 256 + ai * 128 + wr * 64 + m * 16 + fr;
                const bool lat = r < NLAT;
                const int b = lat ? (r >> 11) : ((r - NLAT) >> 8);
                const int pos = lat ? (r & (SEQ - 1)) : (SEQ + ((r - NLAT) & (CL - 1)));
                f32x4 v[2][2];
#pragma unroll
                for (int bj = 0; bj < 2; ++bj)
#pragma unroll
                    for (int n = 0; n < 2; ++n) v[bj][n] = acc[ai][bj][m][n];
                if (kind != 2) {
                    float ss = 0.f;
#pragma unroll
                    for (int bj = 0; bj < 2; ++bj)
#pragma unroll
                        for (int n = 0; n < 2; ++n) ss += (v[bj][n][0] * v[bj][n][0] + v[bj][n][1] * v[bj][n][1]) + (v[bj][n][2] * v[bj][n][2] + v[bj][n][3] * v[bj][n][3]);
                    ss += __shfl_xor(ss, 16); ss += __shfl_xor(ss, 32);
                    const float rinv = 1.0f / sqrtf(ss * (1.0f / 64.0f) + EPS);
#pragma unroll
                    for (int bj = 0; bj < 2; ++bj)
#pragma unroll
                        for (int n = 0; n < 2; ++n) v[bj][n] = v[bj][n] * rinv * gv[bj][n];
                    if (lat) {
#pragma unroll
                        for (int bj = 0; bj < 2; ++bj) {
                            const f32x4 cs = *(const f32x4*)(cosT + pos * 32 + bj * 16 + 4 * fq), sn = *(const f32x4*)(sinT + pos * 32 + bj * 16 + 4 * fq);
                            const f32x4 x1 = v[bj][0], x2 = v[bj][1];
                            v[bj][0] = x1 * cs - x2 * sn; v[bj][1] = x2 * cs + x1 * sn;
                        }
                    }
                    if (kind == 0) {
#pragma unroll
                        for (int bj = 0; bj < 2; ++bj)
#pragma unroll
                            for (int n = 0; n < 2; ++n) v[bj][n] = v[bj][n] * C2;
                    }
                }
                bf16_t* dst = kind == 0 ? Q + (size_t)r * D + pn * 256 + wc * 64
                                        : (kind == 1 ? Kb : Vb) + ((size_t)b * KVL + pos) * 256 + wc * 64;
#pragma unroll
                for (int bj = 0; bj < 2; ++bj)
#pragma unroll
                    for (int n = 0; n < 2; ++n) { u32x2 w; w.x = pk2(v[bj][n][0], v[bj][n][1]); w.y = pk2(v[bj][n][2], v[bj][n][3]); *(u32x2*)(dst + 32 * bj + 16 * n + 4 * fq) = w; }
            }
    }
};
struct EpiBiasBf16 {
    bf16_t* O; int ldc; const float* bias0; int estride;
    __device__ __forceinline__ void operator()(const f32x4 (&acc)[2][2][4][2], const Unit& uu, int wr, int wc, int fr, int fq) const {
        const int row0 = uu.pm * 256, col0t = uu.pn * 256;
#pragma unroll
        for (int bj = 0; bj < 2; ++bj)
#pragma unroll
            for (int n = 0; n < 2; ++n) {
                const int c = col0t + bj * 128 + wc * 32 + n * 16 + 4 * fq;
                const f32x4 bv = *(const f32x4*)(bias0 + (size_t)uu.e * estride + c);
#pragma unroll
                for (int ai = 0; ai < 2; ++ai)
#pragma unroll
                    for (int m = 0; m < 4; ++m) { const int r = row0 + ai * 128 + wr * 64 + m * 16 + fr; const f32x4 v = acc[ai][bj][m][n] + bv;
                        u32x2 w; w.x = pk2(v[0], v[1]); w.y = pk2(v[2], v[3]); *(u32x2*)(O + (size_t)r * ldc + c) = w; }
            }
    }
};
struct EpiResid {
    const float *srcL, *srcC; float *dstL, *dstC; const float* gate  ; const float* bias;
    __device__ __forceinline__ void operator()(const f32x4 (&acc)[2][2][4][2], const Unit& uu, int wr, int wc, int fr, int fq) const {
        const int row0 = uu.pm * 256, col0t = uu.pn * 256;
#pragma unroll
        for (int bj = 0; bj < 2; ++bj)
#pragma unroll
            for (int n = 0; n < 2; ++n) {
                const int c = col0t + bj * 128 + wc * 32 + n * 16 + 4 * fq;
                const f32x4 bv = bias ? *(const f32x4*)(bias + c) : (f32x4){0.f, 0.f, 0.f, 0.f};
#pragma unroll
                for (int ai = 0; ai < 2; ++ai)
#pragma unroll
                    for (int m = 0; m < 4; ++m) { const int r = row0 + ai * 128 + wr * 64 + m * 16 + fr;
                        const f32x4 g = *(const f32x4*)(gate + (size_t)mod_row(r) * MODW + c);
                        const float* s = r < NLAT ? srcL + (size_t)r * D : srcC + (size_t)(r - NLAT) * D;
                        float* d = r < NLAT ? dstL + (size_t)r * D : dstC + (size_t)(r - NLAT) * D;
                        const f32x4 x = *(const f32x4*)(s + c);
                        *(f32x4*)(d + c) = x + g * (acc[ai][bj][m][n] + bv); }
            }
    }
};
struct EpiSwiglu {
    bf16_t* O; const float* bgu0  ;
    __device__ __forceinline__ void operator()(const f32x4 (&acc)[2][2][4][2], const Unit& uu, int wr, int wc, int fr, int fq) const {
        const int row0 = uu.pm * 256, pn = uu.pn; const float* bgu = bgu0 + (size_t)uu.e * NGU;
#pragma unroll
        for (int n = 0; n < 2; ++n) {
            const int f = pn * 128 + wc * 32 + n * 16 + 4 * fq;
            const f32x4 b0 = *(const f32x4*)(bgu + 2 * f), b1 = *(const f32x4*)(bgu + 2 * f + 4);
            const f32x4 bg = (f32x4){b0[0], b0[2], b1[0], b1[2]}, bu = (f32x4){b0[1], b0[3], b1[1], b1[3]};
#pragma unroll
            for (int ai = 0; ai < 2; ++ai)
#pragma unroll
                for (int m = 0; m < 4; ++m) { const int r = row0 + ai * 128 + wr * 64 + m * 16 + fr;
                    const f32x4 gg = acc[ai][0][m][n] + bg, uu = acc[ai][1][m][n] + bu; float o[4];
#pragma unroll
                    for (int e = 0; e < 4; ++e) { const float g = fminf(gg[e], 7.0f), u = fminf(fmaxf(uu[e], -7.0f), 7.0f);
                        const float sg = 1.0f / (1.0f + __expf(-1.702f * g)); o[e] = (u + 1.0f) * g * sg; }
                    u32x2 w; w.x = pk2(o[0], o[1]); w.y = pk2(o[2], o[3]); *(u32x2*)(O + (size_t)r * D + f) = w; }
        }
    }
};

template <int MODE> __device__ __forceinline__ int wrow_map(int n) {
    if (MODE == 0) return n;
    if (MODE == 1) { const int pn = n >> 8, wc = (n >> 6) & 3, bj = (n >> 5) & 1, j = n & 31; return (pn << 8) + (bj << 7) + (wc << 5) + j; }
    { const int f = n >> 1, pn = f >> 7, fo = f & 127; return (pn << 8) + ((n & 1) << 7) + fo; }
}
template <int MODE> __device__ __forceinline__ void transpose_item(const float* W, int N, bf16_t* WT, LAS float* scr, int item, int lane) {
    constexpr int K = D;
    const int nblk = N / 32, kb = item / nblk, nb = item % nblk, k0 = 64 * kb, n0 = 32 * nb;
#pragma unroll 8
    for (int i = 0; i < 32; ++i) { const int kk = 2 * i + (lane >> 5); scr[kk * 33 + (lane & 31)] = W[(size_t)(k0 + kk) * N + n0 + (lane & 31)]; }
    LDS_WAIT(); asm volatile("" ::: "memory");
    const int c = lane & 7;
#pragma unroll
    for (int j = 0; j < 4; ++j) { const int n = (lane >> 3) + 8 * j; const LAS float* s = scr + (8 * c) * 33 + n;
        u32x4 o; o.x = pk2(s[0 * 33], s[1 * 33]); o.y = pk2(s[2 * 33], s[3 * 33]); o.z = pk2(s[4 * 33], s[5 * 33]); o.w = pk2(s[6 * 33], s[7 * 33]);
        *(u32x4*)(WT + (size_t)wrow_map<MODE>(n0 + n) * K + k0 + 8 * c) = o; }
    LDS_WAIT(); asm volatile("" ::: "memory");
}

__device__ __forceinline__ void norm_mod_store(const f32x4 (&v)[4], const float* gain, const float* shift, const float* scale, bf16_t* dst, int lane, f32x4 (&h)[4]) {
    float ss = 0.f;
#pragma unroll
    for (int j = 0; j < 4; ++j) ss += (v[j][0] * v[j][0] + v[j][1] * v[j][1]) + (v[j][2] * v[j][2] + v[j][3] * v[j][3]);
    ss = wave_sum(ss);
    const float rinv = 1.0f / sqrtf(ss * (1.0f / D) + EPS);
#pragma unroll
    for (int j = 0; j < 4; ++j) {
        const f32x4 g = ((const f32x4*)gain)[lane + 64 * j], sh = ((const f32x4*)shift)[lane + 64 * j], sc = ((const f32x4*)scale)[lane + 64 * j];
        h[j] = (v[j] * rinv * g) * (sc + 1.0f) + sh;
        u32x2 w; w.x = pk2(h[j][0], h[j][1]); w.y = pk2(h[j][2], h[j][3]);
        ((u32x2*)dst)[lane + 64 * j] = w;
    }
}


template <int LF>
__device__ __forceinline__ void conv_channel(LAS unsigned char* lds, const bf16_t* FIc, const bf16_t* wsrc, bf16_t* ydst, int tid, int lane, int wv) {
    constexpr int IPW = LF / 256, NBK = LF / 32, P = 2 * LF + 8, WSTR = LF + 8;
    LAS unsigned char* FIL = lds; LAS unsigned char* WL = lds + ((8 * P * 2 + 255) & ~255);
    __syncthreads();
    { const u32x4* fs = (const u32x4*)FIc; for (int i = tid; i < 8 * P * 2 / 16; i += NTHR) ((LAS u32x4*)FIL)[i] = fs[i]; }
    for (int i = tid; i < NB * (LF / 8); i += NTHR) { const int b = i / (LF / 8), ch = i % (LF / 8); *(LAS u32x4*)(WL + b * (WSTR * 2) + ch * 16) = *(const u32x4*)(wsrc + (size_t)b * LF + ch * 8); }
    __syncthreads();
    f32x4 acc[IPW][2]; bf16x8 Bw[IPW];
#pragma unroll
    for (int ii = 0; ii < IPW; ++ii) { acc[ii][0] = (f32x4){0.f, 0.f, 0.f, 0.f}; acc[ii][1] = (f32x4){0.f, 0.f, 0.f, 0.f}; Bw[ii] = (bf16x8){0, 0, 0, 0, 0, 0, 0, 0}; }
    const int rr = lane & 15, q = lane >> 4;
    const int aBase = (rr & 7) * (P * 2) + 2 * (LF - (rr - (rr & 7)) + 8 * q);
    const int bBase = rr * (WSTR * 2) + 16 * q;
#define CONV_STEPS(CHECK) do { _Pragma("unroll") for (int dd = 0; dd < IPW; ++dd) { \
        const int delta = IPW * d + dd; \
        const bf16x8 a0 = *(const LAS bf16x8*)(FIL + aBase - 64 * delta), a1 = *(const LAS bf16x8*)(FIL + aBase - 64 * delta - 32); \
        const int jn = IPW * (wv - d) - dd; \
        if (!(CHECK) || (jn >= 0 && jn < NBK)) Bw[(IPW - dd) % IPW] = *(const LAS bf16x8*)(WL + bBase + 64 * jn); \
        _Pragma("unroll") for (int ii = 0; ii < IPW; ++ii) { const int j = IPW * (wv - d) + ii - dd; \
            if (!(CHECK) || (j >= 0 && j < NBK)) { \
                acc[ii][0] = __builtin_amdgcn_mfma_f32_16x16x32_bf16(a0, Bw[(ii - dd + IPW) % IPW], acc[ii][0], 0, 0, 0); \
                acc[ii][1] = __builtin_amdgcn_mfma_f32_16x16x32_bf16(a1, Bw[(ii - dd + IPW) % IPW], acc[ii][1], 0, 0, 0); } } } } while (0)
    { const int d = wv - 8; CONV_STEPS(true); }
    for (int d = wv - 7; d < wv; ++d) { CONV_STEPS(false); }
    { const int d = wv; CONV_STEPS(true); }
#undef CONV_STEPS
#pragma unroll
    for (int ii = 0; ii < IPW; ++ii)
#pragma unroll
        for (int h = 0; h < 2; ++h) { u32x2 w; w.x = pk2(acc[ii][h][0], acc[ii][h][1]); w.y = pk2(acc[ii][h][2], acc[ii][h][3]);
            *(u32x2*)(ydst + (size_t)rr * LF + 32 * (IPW * wv + ii) + 16 * h + 4 * q) = w; }
}

#define IN(k) (lo <= (k) && (k) < hi)
#define SEAM(k) do { if (IN(k) && IN((k) + 1)) xcd_barrier(bar); } while (0)
#define KLOCALS \
    const float* x_in = args.in[I_X]; const float* c_in = args.in[I_C]; const float* ctx_in = args.in[I_CTX]; const float* cctx_in = args.in[I_CCTX]; \
    float* out = args.out; \
    float* modp = (float*)(ws + WS_MODP); float* modf = (float*)(ws + WS_MOD); \
    float* cosT = (float*)(ws + WS_ROPE); float* sinT = cosT + SEQ * 32; \
    float* a2tab = (float*)(ws + WS_A2); \
    int* top_e = (int*)(ws + WS_PAIR); int* ppos = top_e + NTOK * 4; float* pgate = (float*)(ppos + NTOK * 4); int* pdest = (int*)(pgate + NTOK * 4); \
    float* ctxbuf = (float*)(ws + WS_CTX); \
    bf16_t* Wqkv_t = (bf16_t*)(ws + WS_WQKV); bf16_t* Wo_t = (bf16_t*)(ws + WS_WO); bf16_t* Win_t = (bf16_t*)(ws + WS_WIN); bf16_t* Wout_t = (bf16_t*)(ws + WS_WOUT); \
    bf16_t* Wgu_t = (bf16_t*)(ws + WS_WGU); bf16_t* Wdn_t = (bf16_t*)(ws + WS_WDN); \
    bf16_t* hA = (bf16_t*)(ws + WS_HA); bf16_t* Qb = (bf16_t*)(ws + WS_Q); bf16_t* Kb = (bf16_t*)(ws + WS_K); bf16_t* Vb = (bf16_t*)(ws + WS_V); \
    bf16_t* Upre = (bf16_t*)(ws + WS_UPRE); bf16_t* Wc = (bf16_t*)(ws + WS_WC); bf16_t* Yc = (bf16_t*)(ws + WS_YC); \
    bf16_t* XS = (bf16_t*)(ws + WS_XS); bf16_t* AB = (bf16_t*)(ws + WS_AB); \
    const int wr = wave >> 2, wc = wave & 3, fr = lane & 15, fq = lane >> 4;
template <int layer> __device__ __forceinline__ void layer_body(const Args& args, LAS unsigned char* lds, const XcdBarrier& bar, const int tid, const int lane, const int wave, const int G, const int bid, const int lo, const int hi) {
    const int gw = bid * NWAVES + wave, NGW = G * NWAVES;
    unsigned char* ws = args.ws;
    gu32* ctl = (gu32*)(ws + WS_CTL);
    KLOCALS
        const int pb = 3 + 10 * layer;
        const int jm = layer >> 1;
        const bool ctx_live = layer < 2;
        const int nrows = ctx_live ? NTOK : NLAT;
        const float* mo = modf + (size_t)layer * NMODROW * MODW;
        const float* resL = layer == 0 ? x_in : out; const float* resC = layer == 0 ? ctx_in : ctxbuf;

        if ((layer & 1) == 0) {
            if (EN_GEMM && IN(pb + 0)) {
                EpiQKV E{Qb, Kb, Vb, args.in[I_QG] + jm * 64, args.in[I_KG] + jm * 64, cosT, sinT};
                const bf16_t* Wt = Wqkv_t + (size_t)jm * NQKV * D;
                const QkvSched S{hA, Wt, ctx_live ? 1 : 0, G, bid};
                run_gemm(lds, S, E);
            }
            SEAM(pb + 0);
            if (EN_ATT && IN(pb + 1)) {
                LAS bf16_t* Ks = (LAS bf16_t*)lds;
                LAS bf16_t* Vt = Ks + 64 * 72;
                const int nlat_u = NB * 4 * 32, nctx_u = ctx_live ? NB * 4 * 4 : 0;
                const int r32 = lane & 31, hi = lane >> 5, g = wave >> 1, qh = wave & 1;
                for (int u = bid; u < nlat_u + nctx_u; u += G) {
                    int b, kvh, qrow0, key0, ntile;
                    if (u < nlat_u) { b = u >> 7; kvh = (u >> 5) & 3; qrow0 = b * SEQ + (u & 31) * 64; key0 = 0; ntile = KVL / 64; }
                    else { const int q = u - nlat_u; b = q >> 4; kvh = (q >> 2) & 3; qrow0 = NLAT + b * CL + (q & 3) * 64; key0 = SEQ; ntile = CL / 64; }
                    const int head = kvh * 4 + g; const int qrow = qrow0 + 32 * qh + r32;
                    bf16x8 qr[4];
#pragma unroll
                    for (int d0 = 0; d0 < 4; ++d0) qr[d0] = *(const bf16x8*)(Qb + (size_t)qrow * D + head * 64 + d0 * 16 + hi * 8);
                    f32x16 o0, o1;
#pragma unroll
                    for (int r = 0; r < 16; ++r) { o0[r] = 0.f; o1[r] = 0.f; }
                    float mrun = -INFINITY, lrun = 0.f;
#pragma unroll 1
                    for (int t = 0; t < ntile; ++t) {
                        __syncthreads();
                        { const int key = tid >> 3, dc = (tid & 7) * 8; const size_t off = ((size_t)b * KVL + key0 + t * 64 + key) * 256 + kvh * 64 + dc;
                          const u32x4 kw = *(const u32x4*)(Kb + off), vw = *(const u32x4*)(Vb + off);
                          *(LAS u32x4*)(Ks + key * 72 + dc) = kw;
                          Vt[(dc + 0) * 72 + key] = (bf16_t)(vw.x & 0xffffu); Vt[(dc + 1) * 72 + key] = (bf16_t)(vw.x >> 16);
                          Vt[(dc + 2) * 72 + key] = (bf16_t)(vw.y & 0xffffu); Vt[(dc + 3) * 72 + key] = (bf16_t)(vw.y >> 16);
                          Vt[(dc + 4) * 72 + key] = (bf16_t)(vw.z & 0xffffu); Vt[(dc + 5) * 72 + key] = (bf16_t)(vw.z >> 16);
                          Vt[(dc + 6) * 72 + key] = (bf16_t)(vw.w & 0xffffu); Vt[(dc + 7) * 72 + key] = (bf16_t)(vw.w >> 16); }
                        __syncthreads();
                        f32x16 p0, p1;
#pragma unroll
                        for (int r = 0; r < 16; ++r) { p0[r] = 0.f; p1[r] = 0.f; }
#pragma unroll
                        for (int d0 = 0; d0 < 4; ++d0) {
                            const bf16x8 a0 = *(const LAS bf16x8*)(Ks + r32 * 72 + d0 * 16 + hi * 8), a1 = *(const LAS bf16x8*)(Ks + (32 + r32) * 72 + d0 * 16 + hi * 8);
                            p0 = __builtin_amdgcn_mfma_f32_32x32x16_bf16(a0, qr[d0], p0, 0, 0, 0); p1 = __builtin_amdgcn_mfma_f32_32x32x16_bf16(a1, qr[d0], p1, 0, 0, 0); }
                        float mx = fmaxf(p0[0], p1[0]);
#pragma unroll
                        for (int r = 1; r < 16; ++r) mx = fmaxf(mx, fmaxf(p0[r], p1[r]));
                        mx = fmaxf(mx, __shfl_xor(mx, 32));
                        const float mnew = fmaxf(mrun, mx), alpha = __builtin_amdgcn_exp2f(mrun - mnew); mrun = mnew;
                        float ps = 0.f;
#pragma unroll
                        for (int r = 0; r < 16; ++r) { p0[r] = __builtin_amdgcn_exp2f(p0[r] - mrun); p1[r] = __builtin_amdgcn_exp2f(p1[r] - mrun); ps += p0[r] + p1[r]; }
                        lrun = lrun * alpha + ps;
#pragma unroll
                        for (int r = 0; r < 16; ++r) { o0[r] *= alpha; o1[r] *= alpha; }
#pragma unroll
                        for (int s4 = 0; s4 < 4; ++s4) {
                            u32x4 pw;
                            if (s4 == 0) { pw.x = pk2(p0[0], p0[1]); pw.y = pk2(p0[2], p0[3]); pw.z = pk2(p0[4], p0[5]); pw.w = pk2(p0[6], p0[7]); }
                            else if (s4 == 1) { pw.x = pk2(p0[8], p0[9]); pw.y = pk2(p0[10], p0[11]); pw.z = pk2(p0[12], p0[13]); pw.w = pk2(p0[14], p0[15]); }
                            else if (s4 == 2) { pw.x = pk2(p1[0], p1[1]); pw.y = pk2(p1[2], p1[3]); pw.z = pk2(p1[4], p1[5]); pw.w = pk2(p1[6], p1[7]); }
                            else { pw.x = pk2(p1[8], p1[9]); pw.y = pk2(p1[10], p1[11]); pw.z = pk2(p1[12], p1[13]); pw.w = pk2(p1[14], p1[15]); }
                            const bf16x8 pf = __builtin_bit_cast(bf16x8, pw);
                            const int kvb = 32 * (s4 >> 1) + 16 * (s4 & 1) + 4 * hi;
                            { const u32x2 lo4 = *(const LAS u32x2*)(Vt + r32 * 72 + kvb), hi4 = *(const LAS u32x2*)(Vt + r32 * 72 + kvb + 8);
                              const u32x4 vv = (u32x4){lo4.x, lo4.y, hi4.x, hi4.y}; o0 = __builtin_amdgcn_mfma_f32_32x32x16_bf16(__builtin_bit_cast(bf16x8, vv), pf, o0, 0, 0, 0); }
                            { const u32x2 lo4 = *(const LAS u32x2*)(Vt + (32 + r32) * 72 + kvb), hi4 = *(const LAS u32x2*)(Vt + (32 + r32) * 72 + kvb + 8);
                              const u32x4 vv = (u32x4){lo4.x, lo4.y, hi4.x, hi4.y}; o1 = __builtin_amdgcn_mfma_f32_32x32x16_bf16(__builtin_bit_cast(bf16x8, vv), pf, o1, 0, 0, 0); }
                        }
                    }
                    const float il = 1.0f / (lrun + __shfl_xor(lrun, 32));
                    bf16_t* op = Qb + (size_t)qrow * D + head * 64;
#pragma unroll
                    for (int gq = 0; gq < 4; ++gq) {
                        u32x2 w0, w1;
                        w0.x = pk2(o0[4 * gq] * il, o0[4 * gq + 1] * il); w0.y = pk2(o0[4 * gq + 2] * il, o0[4 * gq + 3] * il);
                        w1.x = pk2(o1[4 * gq] * il, o1[4 * gq + 1] * il); w1.y = pk2(o1[4 * gq + 2] * il, o1[4 * gq + 3] * il);
                        *(u32x2*)(op + 8 * gq + 4 * hi) = w0; *(u32x2*)(op + 32 + 8 * gq + 4 * hi) = w1;
                    }
                }
            }
            SEAM(pb + 1);
            if (EN_GEMM && IN(pb + 2)) {
                EpiResid E{resL, resC, out, ctxbuf, mo + 2 * D, nullptr};
                const bf16_t* Wt = Wo_t + (size_t)jm * D * D;
                const DenseSched S{Qb, Wt, nrows / 256, 4, G, bid};
                run_gemm(lds, S, E);
            }
            SEAM(pb + 2);
        } else {
            const float* cw = args.in[I_HCW] + (size_t)jm * 3 * NHY; const float* cb = args.in[I_HCB] + (size_t)jm * NHY;
            if (EN_GEMM && IN(pb + 0)) {
                EpiBiasBf16 E{Upre, NHY, args.in[I_HBIN] + (size_t)jm * NHY, 0};
                const bf16_t* Wt = Win_t + (size_t)jm * NHY * D;
                const DenseSched S{hA, Wt, nrows / 256, 12, G, bid};
                run_gemm(lds, S, E);
            }
            SEAM(pb + 0);
            if (EN_MISC && IN(pb + 1)) {
                LAS bf16_t* T = (LAS bf16_t*)lds;
                const int nlat_u = NB * 32 * 16, nctx_u = ctx_live ? NB * 4 * 16 : 0;
                for (int u = bid; u < nlat_u + nctx_u; u += G) {
                    int b, s0, c0, Ls, rowb; bf16_t* dstb;
                    if (u < nlat_u) { b = u >> 9; s0 = ((u >> 4) & 31) * 64; c0 = (u & 15) * 64; Ls = SEQ; rowb = b * SEQ; dstb = Wc; }
                    else { const int q = u - nlat_u; b = q >> 6; s0 = ((q >> 4) & 3) * 64; c0 = (q & 15) * 64; Ls = CL; rowb = NLAT + b * CL; dstb = Wc + WC_CTX_OFF; }
                    const int sr = tid >> 3, cc = (tid & 7) * 8, s = s0 + sr;
                    float x1[8], vv[8];
#pragma unroll
                    for (int e = 0; e < 8; ++e) { x1[e] = cb[D + c0 + cc + e]; vv[e] = cb[2 * D + c0 + cc + e]; }
#pragma unroll
                    for (int tap = 0; tap < 3; ++tap) { const int sp = s + tap - 1;
                        if (sp >= 0 && sp < Ls) { const bf16_t* ur = Upre + (size_t)(rowb + sp) * NHY + c0 + cc; const u32x4 a = *(const u32x4*)(ur + D), bq = *(const u32x4*)(ur + 2 * D);
                            const float* w1 = cw + tap * NHY + D + c0 + cc; const float* w2 = cw + tap * NHY + 2 * D + c0 + cc;
                            const float af[8] = {bflo(a.x), bfhi(a.x), bflo(a.y), bfhi(a.y), bflo(a.z), bfhi(a.z), bflo(a.w), bfhi(a.w)};
                            const float bf[8] = {bflo(bq.x), bfhi(bq.x), bflo(bq.y), bfhi(bq.y), bflo(bq.z), bfhi(bq.z), bflo(bq.w), bfhi(bq.w)};
#pragma unroll
                            for (int e = 0; e < 8; ++e) { x1[e] += af[e] * w1[e]; vv[e] += bf[e] * w2[e]; } } }
                    __syncthreads();
#pragma unroll
                    for (int e = 0; e < 8; ++e) T[(cc + e) * 72 + sr] = (bf16_t)f2bf(x1[e] * vv[e]);
                    __syncthreads();
                    { const int c = tid >> 3, sc = (tid & 7) * 8; const u32x4 w = *(const LAS u32x4*)(T + c * 72 + sc);
                      *(u32x4*)(dstb + ((size_t)(c0 + c) * NB + b) * Ls + s0 + sc) = w; }
                }
            }
            SEAM(pb + 1);
            if (EN_CONV && IN(pb + 2)) {
                const int nlat_u = 1024, nctx_u = ctx_live ? 1024 : 0;
                for (int u = bid; u < nlat_u + nctx_u; u += G) {
                    if (u < nlat_u) { const int c = u; conv_channel<SEQ>(lds, (const bf16_t*)(ws + (jm == 0 ? WS_FI0 : WS_FI1)) + (size_t)c * 8 * FP_L, Wc + (size_t)c * NB * SEQ, Yc + (size_t)c * NB * SEQ, tid, lane, wave); }
                    else { const int c = u - nlat_u; conv_channel<CL>(lds, (const bf16_t*)(ws + WS_FI2) + (size_t)c * 8 * FP_C, Wc + WC_CTX_OFF + (size_t)c * NB * CL, Yc + WC_CTX_OFF + (size_t)c * NB * CL, tid, lane, wave); }
                }
            }
            SEAM(pb + 2);
            if (EN_MISC && IN(pb + 3)) {
                LAS bf16_t* T = (LAS bf16_t*)lds;
                const int nlat_u = NB * 32 * 16, nctx_u = ctx_live ? NB * 4 * 16 : 0;
                for (int u = bid; u < nlat_u + nctx_u; u += G) {
                    int b, s0, c0, Ls, rowb; const bf16_t* srcb;
                    if (u < nlat_u) { b = u >> 9; s0 = ((u >> 4) & 31) * 64; c0 = (u & 15) * 64; Ls = SEQ; rowb = b * SEQ; srcb = Yc; }
                    else { const int q = u - nlat_u; b = q >> 6; s0 = ((q >> 4) & 3) * 64; c0 = (q & 15) * 64; Ls = CL; rowb = NLAT + b * CL; srcb = Yc + WC_CTX_OFF; }
                    __syncthreads();
                    { const int c = tid >> 3, sc = (tid & 7) * 8; *(LAS u32x4*)(T + c * 72 + sc) = *(const u32x4*)(srcb + ((size_t)(c0 + c) * NB + b) * Ls + s0 + sc); }
                    __syncthreads();
                    const int sr = tid >> 3, cc = (tid & 7) * 8, s = s0 + sr;
                    float x0[8];
#pragma unroll
                    for (int e = 0; e < 8; ++e) x0[e] = cb[c0 + cc + e];
#pragma unroll
                    for (int tap = 0; tap < 3; ++tap) { const int sp = s + tap - 1;
                        if (sp >= 0 && sp < Ls) { const u32x4 a = *(const u32x4*)(Upre + (size_t)(rowb + sp) * NHY + c0 + cc); const float* w0 = cw + tap * NHY + c0 + cc;
                            const float af[8] = {bflo(a.x), bfhi(a.x), bflo(a.y), bfhi(a.y), bflo(a.z), bfhi(a.z), bflo(a.w), bfhi(a.w)};
#pragma unroll
                            for (int e = 0; e < 8; ++e) x0[e] += af[e] * w0[e]; } }
                    float z[8];
#pragma unroll
                    for (int e = 0; e < 8; ++e) z[e] = x0[e] * bf2f(T[(cc + e) * 72 + sr]);
                    u32x4 o; o.x = pk2(z[0], z[1]); o.y = pk2(z[2], z[3]); o.z = pk2(z[4], z[5]); o.w = pk2(z[6], z[7]);
                    *(u32x4*)(hA + (size_t)(rowb + s) * D + c0 + cc) = o;
                }
            }
            SEAM(pb + 3);
            if (EN_GEMM && IN(pb + 4)) {
                EpiResid E{resL, resC, out, ctxbuf, mo + 2 * D, args.in[I_HBOUT] + (size_t)jm * D};
                const bf16_t* Wt = Wout_t + (size_t)jm * D * D;
                const DenseSched S{hA, Wt, nrows / 256, 4, G, bid};
                run_gemm(lds, S, E);
            }
            SEAM(pb + 4);
        }

        gu32* cnt = ctl + CW_CNT + layer * 32 * 64;
        if (EN_ROUTER && IN(pb + 5)) {
            LAS float* WrT = (LAS float*)lds;
            __syncthreads();
            { const float* rw = args.in[I_RW] + (size_t)layer * D * NE;
              for (int i = tid; i < D * NE; i += NTHR) { const int k = i >> 5, e = i & 31; WrT[e * D + k] = rw[i]; } }
            __syncthreads();
            const float* rb = args.in[I_RB] + layer * NE; const float* g2 = args.in[I_N2G] + layer * D;
            for (int r = gw; r < nrows; r += NGW) {
                const float* src = r < NLAT ? out + (size_t)r * D : ctxbuf + (size_t)(r - NLAT) * D;
                f32x4 v[4], h[4];
#pragma unroll
                for (int j = 0; j < 4; ++j) v[j] = ((const f32x4*)src)[lane + 64 * j];
                const float* mr = mo + (size_t)mod_row(r) * MODW;
                norm_mod_store(v, g2, mr + 3 * D, mr + 4 * D, hA + (size_t)r * D, lane, h);
                float p[32];
                asm volatile("" ::: "memory");
#pragma unroll
                for (int e = 0; e < 32; ++e) { float a = 0.f; if ((e & 3) == 0) asm volatile("" ::: "memory");
#pragma unroll
                    for (int j = 0; j < 4; ++j) { const f32x4 w = *(const LAS f32x4*)(WrT + e * D + 256 * j + 4 * lane); a += (h[j][0] * w[0] + h[j][1] * w[1]) + (h[j][2] * w[2] + h[j][3] * w[3]); }
                    p[e] = a; }
#pragma unroll
                for (int i = 0; i < 16; ++i) { const bool up = (lane & 32) != 0; const float send = up ? p[i] : p[i + 16], keep = up ? p[i + 16] : p[i]; p[i] = keep + __shfl_xor(send, 32); }
#pragma unroll
                for (int i = 0; i < 8; ++i) { const bool up = (lane & 16) != 0; const float send = up ? p[i] : p[i + 8], keep = up ? p[i + 8] : p[i]; p[i] = keep + __shfl_xor(send, 16); }
#pragma unroll
                for (int i = 0; i < 4; ++i) { const bool up = (lane & 8) != 0; const float send = up ? p[i] : p[i + 4], keep = up ? p[i + 4] : p[i]; p[i] = keep + __shfl_xor(send, 8); }
#pragma unroll
                for (int i = 0; i < 2; ++i) { const bool up = (lane & 4) != 0; const float send = up ? p[i] : p[i + 2], keep = up ? p[i + 2] : p[i]; p[i] = keep + __shfl_xor(send, 4); }
                { const bool up = (lane & 2) != 0; const float send = up ? p[0] : p[1], keep = up ? p[1] : p[0]; p[0] = keep + __shfl_xor(send, 2); }
                p[0] += __shfl_xor(p[0], 1);
                const int myE = lane >> 1;
                float val = p[0] + rb[myE];
                float sv[4]; int si[4];
#pragma unroll
                for (int k = 0; k < 4; ++k) { float bv = val; int bi = myE;
#pragma unroll
                    for (int off = 1; off < 64; off <<= 1) { const float ov = __shfl_xor(bv, off); const int oi = __shfl_xor(bi, off); if (ov > bv || (ov == bv && oi < bi)) { bv = ov; bi = oi; } }
                    sv[k] = bv; si[k] = bi; if (myE == bi) val = -INFINITY; }
                const float e1 = __expf(sv[1] - sv[0]), e2 = __expf(sv[2] - sv[0]), e3 = __expf(sv[3] - sv[0]); const float inv = 1.0f / (1.0f + e1 + e2 + e3);
                if (lane < 4) { const int e = lane == 0 ? si[0] : (lane == 1 ? si[1] : (lane == 2 ? si[2] : si[3])); const float gt = (lane == 0 ? 1.0f : (lane == 1 ? e1 : (lane == 2 ? e2 : e3))) * inv;
                    const unsigned pos = __hip_atomic_fetch_add(cnt + e * 64, 1u, RLX_AGENT);
                    top_e[r * 4 + lane] = e; ppos[r * 4 + lane] = (int)pos; pgate[r * 4 + lane] = gt; }
            }
        }
        SEAM(pb + 5);
        LAS int* PADS = (LAS int*)(lds + LDS_BYTES - 4096);
        LAS unsigned char* TE = (LAS unsigned char*)(PADS + 128);
        if (IN(pb + 6) || IN(pb + 7) || IN(pb + 8) || IN(pb + 9)) {
            __syncthreads();
            if (tid < 32) PADS[64 + tid] = (int)__hip_atomic_load(cnt + tid * 64, RLX_AGENT);
            __syncthreads();
            if (tid == 0) { int a = 0; for (int e = 0; e < 32; ++e) { PADS[e] = a; const int nt = (PADS[64 + e] + 255) >> 8; for (int t = 0; t < nt; ++t) TE[(a >> 8) + t] = (unsigned char)e; a += nt * 256; } PADS[32] = a; }
            __syncthreads();
        }
        if (EN_MISC && IN(pb + 6)) {
            for (int pr = gw; pr < nrows * 4; pr += NGW) {
                const int e = top_e[pr], dest = PADS[e] + ppos[pr]; if (lane == 0) pdest[pr] = dest;
                const u32x4* s = (const u32x4*)(hA + (size_t)(pr >> 2) * D); u32x4* d = (u32x4*)(XS + (size_t)dest * D);
                d[lane] = s[lane]; d[lane + 64] = s[lane + 64];
            }
            for (int e = 0; e < 32; ++e) { const int c0 = PADS[e] + PADS[64 + e], c1 = PADS[e + 1];
                for (int rr = c0 + gw; rr < c1; rr += NGW) { u32x4* d = (u32x4*)(XS + (size_t)rr * D); d[lane] = (u32x4){0u, 0u, 0u, 0u}; d[lane + 64] = (u32x4){0u, 0u, 0u, 0u}; } }
        }
        SEAM(pb + 6);
        if (EN_GEMM && IN(pb + 7)) {
            const int ntile = PADS[32] >> 8;
            const MoeSched S{XS, Wgu_t + (size_t)layer * NE * NGU * D, TE, ntile, 8, NGU, G, bid};
            const EpiSwiglu E{AB, args.in[I_BGU] + (size_t)layer * NE * NGU};
            run_gemm(lds, S, E);
        }
        SEAM(pb + 7);
        if (EN_GEMM && IN(pb + 8)) {
            const int ntile = PADS[32] >> 8;
            const MoeSched S{AB, Wdn_t + (size_t)layer * NE * D * D, TE, ntile, 4, D, G, bid};
            const EpiBiasBf16 E{XS, D, args.in[I_BDN] + (size_t)layer * NE * D, D};
            run_gemm(lds, S, E);
        }
        SEAM(pb + 8);
        if (EN_MISC && IN(pb + 9)) {
            const bool has_next = layer + 1 < DEPTH;
            const float* mo_n = modf + (size_t)(layer + 1) * NMODROW * MODW; const float* g1n = args.in[I_N1G] + (has_next ? (layer + 1) * D : 0);
            const int nnext = (layer + 1 < 3) ? NTOK : NLAT;
            for (int r = gw; r < nrows; r += NGW) {
                float* xr = r < NLAT ? out + (size_t)r * D : ctxbuf + (size_t)(r - NLAT) * D;
                const float* mr = mo + (size_t)mod_row(r) * MODW + 5 * D;
                f32x4 y[4];
#pragma unroll
                for (int j = 0; j < 4; ++j) y[j] = (f32x4){0.f, 0.f, 0.f, 0.f};
#pragma unroll
                for (int k = 0; k < 4; ++k) { const int dest = pdest[r * 4 + k]; const float gt = pgate[r * 4 + k]; const u32x2* yr = (const u32x2*)(XS + (size_t)dest * D);
#pragma unroll
                    for (int j = 0; j < 4; ++j) { const u32x2 w = yr[lane + 64 * j]; y[j][0] += gt * bflo(w.x); y[j][1] += gt * bfhi(w.x); y[j][2] += gt * bflo(w.y); y[j][3] += gt * bfhi(w.y); } }
                f32x4 v[4], h[4];
#pragma unroll
                for (int j = 0; j < 4; ++j) { const f32x4 g = ((const f32x4*)mr)[lane + 64 * j]; v[j] = ((const f32x4*)xr)[lane + 64 * j] + g * y[j]; ((f32x4*)xr)[lane + 64 * j] = v[j]; }
                if (has_next && r < nnext) { const float* mn = mo_n + (size_t)mod_row(r) * MODW; norm_mod_store(v, g1n, mn, mn + D, hA + (size_t)r * D, lane, h); }
            }
        }
        SEAM(pb + 9);
}

__global__ void __launch_bounds__(NTHR, 2) fwd(Args args) {
    extern __shared__ __attribute__((aligned(16))) unsigned char lds_raw[];
    LAS unsigned char* lds = (LAS unsigned char*)lds_raw;
    const int tid = threadIdx.x, lane = tid & 63, wave = __builtin_amdgcn_readfirstlane(tid >> 6);
    const int G = gridDim.x, bid = blockIdx.x;
    const int gw = bid * NWAVES + wave, NGW = G * NWAVES;
    unsigned char* ws = args.ws;
    gu32* ctl = (gu32*)(ws + WS_CTL);
    volatile LAS unsigned* MISC = (volatile LAS unsigned*)(lds + MISC_OFF);
    if (tid < 64) MISC[tid] = 0u;
    __syncthreads();
    XcdBarrier bar; bar.bar = (unsigned*)ctl + CW_BAR; bar.x = 0; bar.st = MISC + 8;
    const int lo = args.ph_lo, hi = args.ph_hi;
    if (hi - lo > 1) bar = xcd_barrier_post((unsigned*)ctl + CW_BAR, MISC + 8);

    KLOCALS

    if (EN_PRO && IN(0)) {
        {
            LAS float* scr = (LAS float*)(lds + wave * 8448);
            constexpr int IT_QKV = 16 * (NQKV / 32), IT_SQ = 16 * (D / 32), IT_IN = 16 * (NHY / 32), IT_GU = 16 * (NGU / 32);
            constexpr int N0 = 2 * IT_QKV, N1 = N0 + 2 * IT_SQ, N2 = N1 + 2 * IT_IN, N3 = N2 + 2 * IT_SQ, N4 = N3 + 128 * IT_GU, N5 = N4 + 128 * IT_SQ;
            for (int it = gw; it < N5; it += NGW) {
                if (it < N0) { const int mtx = it / IT_QKV, r = it % IT_QKV; transpose_item<1>(args.in[I_WQKV] + (size_t)mtx * D * NQKV, NQKV, Wqkv_t + (size_t)mtx * NQKV * D, scr, r, lane); }
                else if (it < N1) { const int q = it - N0, mtx = q / IT_SQ, r = q % IT_SQ; transpose_item<0>(args.in[I_WO] + (size_t)mtx * D * D, D, Wo_t + (size_t)mtx * D * D, scr, r, lane); }
                else if (it < N2) { const int q = it - N1, mtx = q / IT_IN, r = q % IT_IN; transpose_item<0>(args.in[I_HWIN] + (size_t)mtx * D * NHY, NHY, Win_t + (size_t)mtx * NHY * D, scr, r, lane); }
                else if (it < N3) { const int q = it - N2, mtx = q / IT_SQ, r = q % IT_SQ; transpose_item<0>(args.in[I_HWOUT] + (size_t)mtx * D * D, D, Wout_t + (size_t)mtx * D * D, scr, r, lane); }
                else if (it < N4) { const int q = it - N3, mtx = q / IT_GU, r = q % IT_GU; transpose_item<2>(args.in[I_WGU] + (size_t)mtx * D * NGU, NGU, Wgu_t + (size_t)mtx * NGU * D, scr, r, lane); }
                else { const int q = it - N4, mtx = q / IT_SQ, r = q % IT_SQ; transpose_item<0>(args.in[I_WDN] + (size_t)mtx * D * D, D, Wdn_t + (size_t)mtx * D * D, scr, r, lane); }
            }
        }
        __syncthreads();
        {
            LAS float* S = (LAS float*)lds;
            for (int u = bid; u < 4 * 12 * 8; u += G) {
                const int kc = u & 7, cc = (u >> 3) % 12, layer = u / 96;
                __syncthreads();
                for (int i = tid; i < 128 * 20; i += NTHR) { const int k = i / 20, r = i % 20; float v = 0.f;
                    if (r < NMODROW) { const float cv = r < NB ? c_in[r * D + kc * 128 + k] : cctx_in[kc * 128 + k]; v = cv / (1.0f + __expf(-cv)); }
                    S[i] = v; }
                __syncthreads();
                const int col = cc * 512 + tid;
                const float* wp = args.in[I_WMOD] + ((size_t)layer * D + kc * 128) * MODW + col;
                float acc[20];
#pragma unroll
                for (int r = 0; r < 20; ++r) acc[r] = 0.f;
                for (int k = 0; k < 128; ++k) { const float w = wp[(size_t)k * MODW];
#pragma unroll
                    for (int q = 0; q < 5; ++q) { const f32x4 s = *(const LAS f32x4*)(S + k * 20 + 4 * q);
                        acc[4 * q] += s[0] * w; acc[4 * q + 1] += s[1] * w; acc[4 * q + 2] += s[2] * w; acc[4 * q + 3] += s[3] * w; } }
#pragma unroll
                for (int r = 0; r < NMODROW; ++r) modp[((size_t)(kc * 4 + layer) * NMODROW + r) * MODW + col] = acc[r];
            }
        }
        for (int i = bid * NTHR + tid; i < SEQ * 32; i += G * NTHR) {
            const int t = i >> 5, j = i & 31, fi = j & 15; const int pos = (j >> 4) == 0 ? (t >> 6) : (t & 63);
            const float inv = powf(10000.0f, -(float)fi / 16.0f); const float ang = (float)pos * inv;
            cosT[i] = cosf(ang); sinT[i] = sinf(ang);
        }
        {
            __syncthreads();
            LAS float* Z = (LAS float*)lds;
            LAS float* A1 = Z + 8 * 36;
            for (int u = bid; u < 256 + 256 + 32; u += G) {
                const int combo = u < 256 ? 0 : (u < 512 ? 1 : 2); const int ub = combo == 0 ? u : (combo == 1 ? u - 256 : u - 512);
                const int j = combo == 1 ? 1 : 0, Lf = combo == 2 ? CL : SEQ;
                const int tl = tid >> 6, o = tid & 63, t = ub * 8 + tl;
                __syncthreads();
                if (o < 33) { float z;
                    const float tt = (float)t / (float)(Lf - 1), w = 6.283185307179586f * (float)t / (float)Lf;
                    if (o == 0) z = tt; else { const int b = (o - 1) & 15; const float f = 1e-4f + (float)b * ((15.0f - 1e-4f) / 15.0f); z = o <= 16 ? cosf(f * w) : -sinf(f * w); }
                    Z[tl * 36 + o] = z; }
                __syncthreads();
                const float sf = args.in[I_HSF][j * 64 + o];
                { const float* w1 = args.in[I_HW1] + (size_t)j * 33 * 64; float a = args.in[I_HB1][j * 64 + o];
                  for (int i = 0; i < 33; ++i) a += Z[tl * 36 + i] * w1[i * 64 + o];
                  A1[tl * 64 + o] = sinf(sf * a); }
                __syncthreads();
                { const float* w2 = args.in[I_HW2] + (size_t)j * 64 * 64; float a = args.in[I_HB2][j * 64 + o];
                  for (int i = 0; i < 64; ++i) a += A1[tl * 64 + i] * w2[i * 64 + o];
                  a2tab[((size_t)combo * SEQ + t) * 64 + o] = sinf(sf * a); }
            }
        }
    }
    SEAM(0);

    if (EN_PRO && IN(1)) {
        for (int i = bid * NTHR + tid; i < DEPTH * NMODROW * MODW; i += G * NTHR) {
            const int layer = i / (NMODROW * MODW), rem = i % (NMODROW * MODW), col = rem % MODW; float s = args.in[I_BMOD][layer * MODW + col];
#pragma unroll
            for (int kc = 0; kc < 8; ++kc) s += modp[(size_t)(kc * 4 + layer) * NMODROW * MODW + rem];
            modf[i] = s;
        }
        {
            LAS float* W3 = (LAS float*)lds;
            LAS float* RED = W3 + 512;
            LAS float* NRM = RED + 32;
            LAS float* HF = NRM + 4;
            for (int u = bid; u < 3 * 256; u += G) {
                const int combo = u >> 8, cg = u & 255; const int j = combo == 1 ? 1 : 0, Lf = combo == 2 ? CL : SEQ; const int c0 = cg * 4;
                LAS float* HB = HF + 4 * Lf;
                __syncthreads();
                { const int i = tid >> 3, q = tid & 7; const int col = (q >> 2) * 1024 + c0 + (q & 3);
                  W3[i * 8 + q] = args.in[I_HW3][((size_t)j * 64 + i) * 2048 + col]; }
                __syncthreads();
                float b3v[8], dec[4], asum[4] = {0.f, 0.f, 0.f, 0.f};
#pragma unroll
                for (int q = 0; q < 8; ++q) b3v[q] = args.in[I_HB3][j * 2048 + (q >> 2) * 1024 + c0 + (q & 3)];
#pragma unroll
                for (int ch = 0; ch < 4; ++ch) dec[ch] = 3.0701134573253945f + (float)(c0 + ch) * ((15.350567286626972f - 3.0701134573253945f) / 1023.0f);
                for (int t = tid; t < Lf; t += NTHR) {
                    asm volatile("" ::: "memory");
                    const float* ar = a2tab + ((size_t)combo * SEQ + t) * 64; float d[8];
#pragma unroll
                    for (int q = 0; q < 8; ++q) d[q] = b3v[q];
#pragma unroll
                    for (int i4 = 0; i4 < 16; ++i4) { const f32x4 a = *(const f32x4*)(ar + 4 * i4); asm volatile("" ::: "memory");
#pragma unroll
                        for (int e = 0; e < 4; ++e) { const f32x4 w0 = *(const LAS f32x4*)(W3 + (4 * i4 + e) * 8), w1 = *(const LAS f32x4*)(W3 + (4 * i4 + e) * 8 + 4);
                            d[0] += a[e] * w0[0]; d[1] += a[e] * w0[1]; d[2] += a[e] * w0[2]; d[3] += a[e] * w0[3]; d[4] += a[e] * w1[0]; d[5] += a[e] * w1[1]; d[6] += a[e] * w1[2]; d[7] += a[e] * w1[3]; } }
                    const float tt = (float)t / (float)(Lf - 1);
#pragma unroll
                    for (int ch = 0; ch < 4; ++ch) { const float dk = __expf(-tt * dec[ch]); const float f = d[ch] * dk, bb = d[4 + ch] * dk;
                        HF[ch * Lf + t] = f; HB[ch * Lf + t] = bb; asum[ch] += fabsf(f) + (t >= 1 ? fabsf(bb) : 0.f); }
                }
#pragma unroll
                for (int ch = 0; ch < 4; ++ch) { const float s = wave_sum(asum[ch]); if (lane == 0) RED[wave * 4 + ch] = s; }
                __syncthreads();
                if (tid < 4) { float s = 0.f; for (int w = 0; w < 8; ++w) s += RED[w * 4 + tid]; NRM[tid] = 1.0f / (s + EPS); }
                __syncthreads();
                const int P = 2 * Lf + 8, PC8 = P / 8;
                bf16_t* FI = (bf16_t*)(ws + (combo == 0 ? WS_FI0 : (combo == 1 ? WS_FI1 : WS_FI2)));
                for (int q = tid; q < 4 * 8 * PC8; q += NTHR) {
                    const int ch = q / (8 * PC8), r = q % (8 * PC8), cidx = r / PC8, x0 = (r % PC8) * 8;
                    const float nr = NRM[ch], db = args.in[I_HDB][j * 1024 + c0 + ch]; float v[8];
#pragma unroll
                    for (int e = 0; e < 8; ++e) { const int m = Lf - (x0 + e) + cidx; const int am = m < 0 ? -m : m; float g = 0.f;
                        if (am <= Lf - 1) { g = (m >= 0 ? HF[ch * Lf + am] : HB[ch * Lf + am]) * nr; if (m == 0) g += db; }
                        v[e] = g; }
                    u32x4 o; o.x = pk2(v[0], v[1]); o.y = pk2(v[2], v[3]); o.z = pk2(v[4], v[5]); o.w = pk2(v[6], v[7]);
                    *(u32x4*)(FI + ((size_t)((c0 + ch) * 8 + cidx)) * P + x0) = o;
                }
            }
        }
    }
    SEAM(1);

    if (IN(2)) {
        const float* mo = modf;
        for (int r = gw; r < NTOK; r += NGW) {
            const float* src = r < NLAT ? x_in + (size_t)r * D : ctx_in + (size_t)(r - NLAT) * D;
            f32x4 v[4], h[4];
#pragma unroll
            for (int j = 0; j < 4; ++j) v[j] = ((const f32x4*)src)[lane + 64 * j];
            const float* mr = mo + (size_t)mod_row(r) * MODW;
            norm_mod_store(v, args.in[I_N1G], mr, mr + D, hA + (size_t)r * D, lane, h);
        }
    }
    SEAM(2);

    layer_body<0>(args, lds, bar, tid, lane, wave, G, bid, lo, hi);
    layer_body<1>(args, lds, bar, tid, lane, wave, G, bid, lo, hi);
    layer_body<2>(args, lds, bar, tid, lane, wave, G, bid, lo, hi);
    layer_body<3>(args, lds, bar, tid, lane, wave, G, bid, lo, hi);
#undef IN
#undef SEAM
}

extern "C" void kernel_launch(void* const* d_in, const int* in_sizes, int n_in, void* d_out, int out_size, void* d_ws, size_t ws_size, hipStream_t stream) {
    static int grid = 0;
    if (grid == 0) {
        if (n_in != 32 || out_size != NLAT * D || ws_size < WS_END) { fprintf(stderr, "kernel_launch: unexpected problem (n_in %d, out %d, ws %zu)\n", n_in, out_size, ws_size); grid = -1; return; }
        int dev = 0, cus = 0, per_cu = 0;
        if (hipGetDevice(&dev) != hipSuccess || hipDeviceGetAttribute(&cus, hipDeviceAttributeMultiprocessorCount, dev) != hipSuccess) { grid = -1; return; }
        if (hipFuncSetAttribute((const void*)fwd, hipFuncAttributeMaxDynamicSharedMemorySize, LDS_BYTES) != hipSuccess) { fprintf(stderr, "kernel_launch: hipFuncSetAttribute failed\n"); grid = -1; return; }
        if (hipOccupancyMaxActiveBlocksPerMultiprocessor(&per_cu, (const void*)fwd, NTHR, LDS_BYTES) != hipSuccess || per_cu < 1) fprintf(stderr, "kernel_launch: occupancy query says %d\n", per_cu);
        (void)hipGetLastError();
        grid = cus;
    }
    if (grid < 0) return;
    (void)hipMemsetAsync((char*)d_ws + WS_CTL, 0, CTL_ZERO_BYTES, stream);
    Args a{};
    for (int i = 0; i < 32; ++i) a.in[i] = (const float*)d_in[i];
    a.out = (float*)d_out; a.ws = (unsigned char*)d_ws;
    constexpr int NPH = 3 + 10 * DEPTH;
#if MK_ONE_LAUNCH
    a.ph_lo = 0; a.ph_hi = NPH;
    hipLaunchKernelGGL(fwd, dim3(grid), dim3(NTHR), LDS_BYTES, stream, a);
#else
    for (int p = 0; p < NPH; ++p) {
        if (p >= 3) { const int layer = (p - 3) / 10, loc = (p - 3) % 10; if ((layer & 1) == 0 && (loc == 3 || loc == 4)) continue; }
        a.ph_lo = p; a.ph_hi = p + 1;
        hipLaunchKernelGGL(fwd, dim3(grid), dim3(NTHR), LDS_BYTES, stream, a);
    }
#endif
}
```

```cpp
#include <hip/hip_runtime.h>
#include <cstdio>
#include <cstdint>
#include <cmath>
#include <hip/hip_bf16.h>

#ifndef EN_PRO
#define EN_PRO 1
#endif
#ifndef EN_ATT
#define EN_ATT 1
#endif
#ifndef EN_CONV
#define EN_CONV 1
#endif
#ifndef EN_ROUTER
#define EN_ROUTER 1
#endif
#ifndef EN_GEMM
#define EN_GEMM 1
#endif
#ifndef EN_MISC
#define EN_MISC 1
#endif
#ifndef MK_ONE_LAUNCH
#define MK_ONE_LAUNCH 1
#endif

#define GAS __attribute__((address_space(1)))
#define LAS __attribute__((address_space(3)))
typedef unsigned short bf16_t;
typedef short bf16x8 __attribute__((ext_vector_type(8)));
typedef float f32x4 __attribute__((ext_vector_type(4)));
typedef float f32x2 __attribute__((ext_vector_type(2)));
typedef unsigned u32x4 __attribute__((ext_vector_type(4)));
typedef unsigned u32x2 __attribute__((ext_vector_type(2)));
typedef GAS unsigned gu32;
typedef float f32x16 __attribute__((ext_vector_type(16)));

constexpr int D = 1024, NB = 16, SEQ = 2048, CL = 256, KVL = SEQ + CL;
constexpr int NLAT = NB * SEQ, NCTX = NB * CL, NTOK = NLAT + NCTX;
constexpr int NE = 32, TOPK = 4, DEPTH = 4;
constexpr int MODW = 6 * D, NMODROW = NB + 1;
constexpr int NQKV = 1536, NHY = 3072, NGU = 2048;
constexpr float EPS = 1e-6f;
constexpr float C2 = 0.125f * 1.4426950408889634f;
constexpr int NWAVES = 8, NTHR = 512;
constexpr int NPADROWS = 155648;
constexpr int MAXTILES = NPADROWS / 256;

constexpr size_t MiB = 1u << 20;
constexpr size_t WS_CTL = 0, CTL_ZERO_BYTES = 1 * MiB;
constexpr size_t WS_MODP = 2 * MiB;
constexpr size_t WS_MOD = 16 * MiB;
constexpr size_t WS_ROPE = 18 * MiB;
constexpr size_t WS_A2 = 19 * MiB;
constexpr size_t WS_PAIR = 21 * MiB;
constexpr size_t WS_CTX = 24 * MiB;
constexpr size_t WS_FI = 40 * MiB;
constexpr int FP_L = 2 * SEQ + 8, FP_C = 2 * CL + 8;
constexpr size_t FI_L_BYTES = (size_t)1024 * 8 * FP_L * 2, FI_C_BYTES = (size_t)1024 * 8 * FP_C * 2;
constexpr size_t WS_FI0 = WS_FI, WS_FI1 = WS_FI0 + 65 * MiB, WS_FI2 = WS_FI1 + 65 * MiB;
static_assert(FI_L_BYTES <= 65 * MiB && WS_FI2 + FI_C_BYTES <= 180 * MiB, "filter map");
constexpr size_t WS_WQKV = 180 * MiB, WS_WO = 186 * MiB, WS_WIN = 190 * MiB, WS_WOUT = 202 * MiB, WS_WGU = 206 * MiB, WS_WDN = 718 * MiB;
constexpr size_t WS_HA = 974 * MiB;
constexpr size_t WS_Q = 1046 * MiB;
constexpr size_t WS_K = 1118 * MiB, WS_V = 1136 * MiB;
constexpr size_t WS_UPRE = 1154 * MiB;
constexpr size_t WS_WC = 1370 * MiB;
constexpr size_t WS_YC = 1442 * MiB;
constexpr size_t WS_XS = 1514 * MiB;
constexpr size_t WS_AB = 1818 * MiB;
constexpr size_t WS_END = 2122 * MiB;
constexpr size_t WC_CTX_OFF = (size_t)1024 * 16 * 2048;
constexpr int CW_TMO = 0, CW_BAR = 4096, CW_CNT = 16384;

constexpr int LDS_BYTES = 160 * 1024;
constexpr int MISC_OFF = LDS_BYTES - 256;

#define RLX_AGENT __ATOMIC_RELAXED, __HIP_MEMORY_SCOPE_AGENT
#define LDS_WAIT() asm volatile("s_waitcnt lgkmcnt(0)" ::: "memory")
#define VM_WAIT() asm volatile("s_waitcnt vmcnt(0)" ::: "memory")
__device__ __forceinline__ unsigned f2bf(float f) { unsigned u = __builtin_bit_cast(unsigned, f); return (u + 0x7fffu + ((u >> 16) & 1u)) >> 16; }
__device__ __forceinline__ unsigned pk2(float lo, float hi) { return f2bf(lo) | (f2bf(hi) << 16); }
__device__ __forceinline__ float bf2f(unsigned h) { return __builtin_bit_cast(float, h << 16); }
__device__ __forceinline__ float bflo(unsigned w) { return __builtin_bit_cast(float, w << 16); }
__device__ __forceinline__ float bfhi(unsigned w) { return __builtin_bit_cast(float, w & 0xffff0000u); }
__device__ __forceinline__ float wave_sum(float v) {
#pragma unroll
    for (int o = 1; o < 64; o <<= 1) v += __shfl_xor(v, o);
    return v;
}

#define XB_TMO      128
#define XB_XCNT(j)  (256  + 64 * (j))
#define XB_XSUB(j)  (1280 + 64 * (j))
#define XB_XGEN(j)  (2304 + 64 * (j))
#define XB_TOP      3328
#define XB_TOPGEN   3392
#define XCD_BAR_WORDS 3456
#define XB_SPIN_CAP (1u << 22)
__device__ __forceinline__ unsigned xb_ld(unsigned* p)              { return __hip_atomic_load(p, __ATOMIC_RELAXED, __HIP_MEMORY_SCOPE_AGENT); }
__device__ __forceinline__ unsigned xb_add(unsigned* p, unsigned v) { return __hip_atomic_fetch_add(p, v, __ATOMIC_RELAXED, __HIP_MEMORY_SCOPE_AGENT); }
__device__ __forceinline__ unsigned xb_xcc_id() { return (unsigned)__builtin_amdgcn_s_getreg((3 << 11) | 20) & 0xFu; }
#define XB_SPIN(cond, bar) do { unsigned _sp = 0; while (cond) { __builtin_amdgcn_s_sleep(1); \
    if ((++_sp & 255u) == 0u) { if (xb_ld(&(bar)[XB_TMO])) break; if (_sp > XB_SPIN_CAP) { atomicAdd(&(bar)[XB_TMO], 1u); break; } } } } while (0)
struct XcdBarrier { unsigned* bar; unsigned x; volatile LAS unsigned* st; };
__device__ __forceinline__ XcdBarrier xcd_barrier_post(unsigned* bar, volatile LAS unsigned* st) {
    XcdBarrier b; b.bar = bar; b.x = xb_xcc_id(); b.st = st;
    if (threadIdx.x == 0) (void)xb_add(&bar[XB_XCNT(b.x)], 1u);
    return b;
}
__device__ __forceinline__ void xcd_barrier_complete(unsigned* bar, unsigned x, unsigned& nloc, unsigned& nx) {
    const unsigned G = gridDim.x * gridDim.y * gridDim.z;
    unsigned sum, cnt, mine, sp = 0u;
    for (;;) {
        sum = 0u; cnt = 0u; mine = 0u;
#pragma unroll
        for (unsigned j = 0; j < 16; ++j) { const unsigned c = xb_ld(&bar[XB_XCNT(j)]); sum += c; cnt += (c > 0u) ? 1u : 0u; mine = (j == x) ? c : mine; }
        if (sum == G) break;
        __builtin_amdgcn_s_sleep(1);
        if ((++sp & 255u) == 0u) { if (xb_ld(&bar[XB_TMO])) break; if (sp > XB_SPIN_CAP) { atomicAdd(&bar[XB_TMO], 1u); break; } }
    }
    nloc = mine > 0u ? mine : 1u; nx = cnt > 0u ? cnt : 1u;
}
__device__ __forceinline__ void xcd_barrier(const XcdBarrier& b) {
    asm volatile("s_waitcnt vmcnt(0)" ::: "memory");
    __syncthreads();
    if (threadIdx.x == 0) {
        unsigned* bar = b.bar;
        __builtin_amdgcn_s_waitcnt(0);
        unsigned nloc = b.st[0], nx = b.st[1];
        if (nloc == 0u) { xcd_barrier_complete(bar, b.x, nloc, nx); b.st[0] = nloc; b.st[1] = nx; }
        const unsigned old = xb_add(&bar[XB_XSUB(b.x)], 1u);
        const unsigned gen = old / nloc;
        if (old + 1u == (gen + 1u) * nloc) {
            __builtin_amdgcn_fence(__ATOMIC_RELEASE, "agent");
            asm volatile("s_waitcnt vmcnt(0)" ::: "memory");
            const unsigned og = xb_add(&bar[XB_TOP], 1u);
            const unsigned tg = og / nx;
            if (og + 1u == (tg + 1u) * nx) xb_add(&bar[XB_TOPGEN], 1u);
            else XB_SPIN(xb_ld(&bar[XB_TOPGEN]) == tg, bar);
            __builtin_amdgcn_fence(__ATOMIC_ACQUIRE, "agent");
            xb_add(&bar[XB_XGEN(b.x)], 1u);
            asm volatile("s_waitcnt vmcnt(0)" ::: "memory");
        } else {
            XB_SPIN(xb_ld(&bar[XB_XGEN(b.x)]) == gen, bar);
            __builtin_amdgcn_fence(__ATOMIC_ACQUIRE, "agent");
            asm volatile("s_waitcnt vmcnt(0)" ::: "memory");
        }
    }
    __syncthreads();
}

struct Args { const float* in[32]; float* out; unsigned char* ws; int ph_lo, ph_hi; };
struct Ctx {
    LAS unsigned char* lds;
    int tid, lane, wave, G, bid;
    const float* const* in;
};
enum { I_X = 0, I_C, I_CTX, I_CCTX, I_WMOD, I_BMOD, I_N1G, I_N2G, I_WQKV, I_QG, I_KG, I_WO, I_HWIN, I_HBIN, I_HCW, I_HCB, I_HW1, I_HB1, I_HW2, I_HB2, I_HW3, I_HB3,
       I_HSF, I_HDB, I_HWOUT, I_HBOUT, I_RW, I_RB, I_WGU, I_BGU, I_WDN, I_BDN };

__device__ __forceinline__ int mod_row(int r) { return r < NLAT ? (r >> 11) : NB; }

__device__ __forceinline__ void gemm_unit_simple(const bf16_t* At, const bf16_t* Bt, f32x4 (&acc)[2][2][4][2], int wr, int wc, int fr, int fq) {
    constexpr int K = D;
#pragma unroll
    for (int a = 0; a < 2; ++a)
#pragma unroll
        for (int b = 0; b < 2; ++b)
#pragma unroll
            for (int m = 0; m < 4; ++m)
#pragma unroll
                for (int n = 0; n < 2; ++n) acc[a][b][m][n] = (f32x4){0.f, 0.f, 0.f, 0.f};
    const bf16_t* ap = At + (size_t)(wr * 64 + fr) * K + fq * 8;
    const bf16_t* bp = Bt + (size_t)(wc * 32 + fr) * K + fq * 8;
    for (int k0 = 0; k0 < K; k0 += 32) {
        bf16x8 bfr[2][2];
#pragma unroll
        for (int bj = 0; bj < 2; ++bj)
#pragma unroll
            for (int n = 0; n < 2; ++n) bfr[bj][n] = *(const bf16x8*)(bp + (size_t)(bj * 128 + n * 16) * K + k0);
#pragma unroll
        for (int ai = 0; ai < 2; ++ai)
#pragma unroll
            for (int m = 0; m < 4; ++m) {
                const bf16x8 afr = *(const bf16x8*)(ap + (size_t)(ai * 128 + m * 16) * K + k0);
#pragma unroll
                for (int bj = 0; bj < 2; ++bj)
#pragma unroll
                    for (int n = 0; n < 2; ++n) acc[ai][bj][m][n] = __builtin_amdgcn_mfma_f32_16x16x32_bf16(bfr[bj][n], afr, acc[ai][bj][m][n], 0, 0, 0);
            }
    }
}


struct Unit { int pm, pn, e; };
namespace pg8 {
constexpr int BM = 256, BK = 64, HALF = 128, HTB = HALF * BK * 2, STAGE_BYTES = 8 * HTB;
__device__ __forceinline__ int lds_byte(int r, int c) { const int st = (r >> 4) * 2 + (c >> 5), rr = r & 15, cc = c & 31, ob = rr * 64 + cc * 2; return st * 1024 + (ob ^ (((ob >> 9) & 1) << 5)); }
__device__ __forceinline__ void stage_rc(int b, int& R, int& C) { const int st = b / 1024, sb = b % 1024, swz = sb ^ (((sb >> 9) & 1) << 5); R = (st >> 1) * 16 + swz / 64; C = (st & 1) * 32 + (swz % 64) / 2; }
template <class Epi, class Sched>
__device__ __forceinline__ void gemm_phase(LAS unsigned char* lds, const Sched& S, const Epi& E) {
    constexpr int K = D, nt = K / BK;
    const int tid = threadIdx.x, wid = __builtin_amdgcn_readfirstlane(tid >> 6), lane = tid & 63, wr = wid >> 2, wc = wid & 3, fr = lane & 15, fq = lane >> 4;
    unsigned voffA[2];
#pragma unroll
    for (int i = 0; i < 2; ++i) { int R, C; stage_rc(tid * 16 + i * 8192, R, C); voffA[i] = (unsigned)(R * K + C) * 2u; }
    const size_t kstep = (size_t)(BK * 2);
    const size_t hstep = (size_t)HALF * K * 2;
    const unsigned ldsw = (unsigned)wid * 1024u;
    const int aoff = lds_byte(wr * 64 + fr, fq * 8), boff = lds_byte(wc * 32 + fr, fq * 8);
#define PG8_SA(b, h) (((b) * 2 + (h)) * HTB)
#define PG8_SB(b, h) ((4 + (b) * 2 + (h)) * HTB)
#define PG8_STAGE(bufoff, gbase, voff) do { _Pragma("unroll") for (int _i = 0; _i < 2; ++_i) \
        __builtin_amdgcn_global_load_lds((const unsigned*)((const char*)(gbase) + (voff)[_i]), (LAS unsigned*)(lds + (bufoff) + ldsw + _i * 8192), 16, 0, 0); } while (0)
#define PG8_LDA(dst, b, h) do { _Pragma("unroll") for (int m = 0; m < 4; ++m) _Pragma("unroll") for (int k = 0; k < 2; ++k) dst[m][k] = *(const LAS bf16x8*)(lds + PG8_SA(b, h) + aoff + m * 2048 + k * 1024); } while (0)
#define PG8_LDB(dst, b, h) do { _Pragma("unroll") for (int n = 0; n < 2; ++n) _Pragma("unroll") for (int k = 0; k < 2; ++k) dst[n][k] = *(const LAS bf16x8*)(lds + PG8_SB(b, h) + boff + n * 2048 + k * 1024); } while (0)
#define PG8_MMA(ai, bj, At, Bt) do { __builtin_amdgcn_s_setprio(1); _Pragma("unroll") for (int m = 0; m < 4; ++m) _Pragma("unroll") for (int n = 0; n < 2; ++n) _Pragma("unroll") for (int k = 0; k < 2; ++k) \
        acc[ai][bj][m][n] = __builtin_amdgcn_mfma_f32_16x16x32_bf16(Bt[n][k], At[m][k], acc[ai][bj][m][n], 0, 0, 0); __builtin_amdgcn_s_setprio(0); } while (0)
#define PG8_WAIT_V(n) asm volatile("s_waitcnt vmcnt(" #n ")" ::: "memory")
#define PG8_WAIT_L(n) asm volatile("s_waitcnt lgkmcnt(" #n ")" ::: "memory")
#define PG8_BAR __builtin_amdgcn_s_barrier()
#define PG8_SCHED __builtin_amdgcn_sched_barrier(0)
    Unit cur, nxt; int ui = 0;
    if (!S.next(0, cur)) return;
    f32x4 acc[2][2][4][2];
#pragma unroll
    for (int a = 0; a < 2; ++a)
#pragma unroll
        for (int b = 0; b < 2; ++b)
#pragma unroll
            for (int m = 0; m < 4; ++m)
#pragma unroll
                for (int n = 0; n < 2; ++n) acc[a][b][m][n] = (f32x4){0.f, 0.f, 0.f, 0.f};
    bf16x8 At[4][2], B0[2][2], B1[2][2];
    const char* cA = S.a_ptr(cur); const char* cB = S.b_ptr(cur);
    PG8_STAGE(PG8_SB(0, 0), cB, voffA); PG8_STAGE(PG8_SB(0, 1), cB + hstep, voffA); PG8_STAGE(PG8_SA(0, 0), cA, voffA); PG8_STAGE(PG8_SA(0, 1), cA + hstep, voffA);
    if (wr == 1) PG8_BAR;
    PG8_WAIT_V(2); PG8_BAR;
    PG8_STAGE(PG8_SB(1, 0), cB + kstep, voffA); PG8_STAGE(PG8_SA(1, 0), cA + kstep, voffA); PG8_STAGE(PG8_SB(1, 1), cB + hstep + kstep, voffA);
    PG8_WAIT_V(6); PG8_BAR;
    for (;;) {
        const bool has_next = S.next(ui + 1, nxt);
        const char* nA = has_next ? S.a_ptr(nxt) : cA; const char* nB = has_next ? S.b_ptr(nxt) : cB;
        for (int t = 0; t < nt; t += 2) {
            const bool last = (t == nt - 2);
            const char* a1 = cA + (size_t)(t + 1) * kstep;
            const char* a2 = last ? nA : cA + (size_t)(t + 2) * kstep; const char* b2 = last ? nB : cB + (size_t)(t + 2) * kstep;
            const char* a3 = a2 + kstep; const char* b3 = b2 + kstep;
            PG8_LDB(B0, 0, 0); PG8_LDB(B1, 0, 1); PG8_SCHED; PG8_LDA(At, 0, 0); PG8_STAGE(PG8_SA(1, 1), a1 + hstep, voffA);
            PG8_WAIT_V(8); PG8_WAIT_L(0); PG8_BAR; PG8_MMA(0, 0, At, B0); PG8_MMA(0, 1, At, B1); PG8_BAR; PG8_SCHED;
            PG8_LDA(At, 0, 1); PG8_STAGE(PG8_SB(0, 0), b2, voffA); PG8_STAGE(PG8_SB(0, 1), b2 + hstep, voffA); PG8_STAGE(PG8_SA(0, 0), a2, voffA);
            PG8_WAIT_V(8); PG8_WAIT_L(0); PG8_BAR; PG8_MMA(1, 0, At, B0); PG8_MMA(1, 1, At, B1); PG8_BAR; PG8_SCHED;
            PG8_LDB(B0, 1, 0); PG8_LDB(B1, 1, 1); PG8_SCHED; PG8_LDA(At, 1, 0); PG8_STAGE(PG8_SA(0, 1), a2 + hstep, voffA);
            PG8_WAIT_V(8); PG8_WAIT_L(0); PG8_BAR; PG8_MMA(0, 0, At, B0); PG8_MMA(0, 1, At, B1); PG8_BAR; PG8_SCHED;
            PG8_LDA(At, 1, 1); PG8_STAGE(PG8_SB(1, 0), b3, voffA); PG8_STAGE(PG8_SB(1, 1), b3 + hstep, voffA); PG8_STAGE(PG8_SA(1, 0), a3, voffA);
            PG8_WAIT_V(8); PG8_WAIT_L(0); PG8_BAR; PG8_MMA(1, 0, At, B0); PG8_MMA(1, 1, At, B1); PG8_BAR; PG8_SCHED;
        }
        if (wr == 0) PG8_BAR;
        E(acc, cur, wr, wc, fr, fq);
        if (!has_next) break;
#pragma unroll
        for (int a = 0; a < 2; ++a)
#pragma unroll
            for (int b = 0; b < 2; ++b)
#pragma unroll
                for (int m = 0; m < 4; ++m)
#pragma unroll
                    for (int n = 0; n < 2; ++n) acc[a][b][m][n] = (f32x4){0.f, 0.f, 0.f, 0.f};
        cur = nxt; cA = nA; cB = nB; ++ui;
        if (wr == 1) PG8_BAR;
    }
    PG8_WAIT_V(0);
    PG8_BAR;
#undef PG8_SA
#undef PG8_SB
#undef PG8_STAGE
#undef PG8_LDA
#undef PG8_LDB
#undef PG8_MMA
#undef PG8_WAIT_V
#undef PG8_WAIT_L
#undef PG8_BAR
#undef PG8_SCHED
}
}

template <class Epi, class Sched>
__device__ __forceinline__ void gemm_phase_simple(const Sched& S, const Epi& E) {
    const int tid = threadIdx.x, wid = __builtin_amdgcn_readfirstlane(tid >> 6), lane = tid & 63, wr = wid >> 2, wc = wid & 3, fr = lane & 15, fq = lane >> 4;
    Unit u;
    for (int i = 0; S.next(i, u); ++i) { f32x4 acc[2][2][4][2];
        gemm_unit_simple((const bf16_t*)S.a_ptr(u), (const bf16_t*)S.b_ptr(u), acc, wr, wc, fr, fq);
        E(acc, u, wr, wc, fr, fq); }
}
#ifndef FAST_GEMM
#define FAST_GEMM 1
#endif
template <class Epi, class Sched>
__device__ __forceinline__ void run_gemm(LAS unsigned char* lds, const Sched& S, const Epi& E) {
#if FAST_GEMM
    pg8::gemm_phase<Epi, Sched>(lds, S, E);
#else
    gemm_phase_simple<Epi, Sched>(S, E);
#endif
}
__device__ __forceinline__ bool xcd_unit(int i, int G, int c, int nM, int nN, int& pm, int& pn) {
    const int x = c & 7, s = c >> 3, nS = G >> 3;
    const int r0 = (nM * x) >> 3, r1 = (nM * (x + 1)) >> 3;
    const int q = i * nS + s; if (q >= (r1 - r0) * nN) return false;
    const int rr = q / nN; pm = r0 + rr; pn = q - rr * nN; return true;
}
struct DenseSched {
    const bf16_t* A; const bf16_t* Bt; int nM, nN, G, c;
    __device__ __forceinline__ bool next(int i, Unit& u) const { u.e = 0; return xcd_unit(i, G, c, nM, nN, u.pm, u.pn); }
    __device__ __forceinline__ const char* a_ptr(const Unit& u) const { return (const char*)(A + (size_t)u.pm * 256 * D); }
    __device__ __forceinline__ const char* b_ptr(const Unit& u) const { return (const char*)(Bt + (size_t)u.pn * 256 * D); }
};
struct QkvSched {
    const bf16_t* A; const bf16_t* Bt; int live, G, c;
    __device__ __forceinline__ bool next(int i, Unit& u) const { u.e = 0;
        if (live) return xcd_unit(i, G, c, 144, 6, u.pm, u.pn);
        const int x = c & 7, s = c >> 3, nS = G >> 3; const int nlat = 16 * 6; const int q = i * nS + s;
        if (q < nlat) { const int rr = q / 6; u.pm = 16 * x + rr; u.pn = q - rr * 6; return true; }
        const int q2 = q - nlat; if (q2 >= 4) return false; const int t = x * 4 + q2; u.pm = 128 + (t >> 1); u.pn = 4 + (t & 1); return true; }
    __device__ __forceinline__ const char* a_ptr(const Unit& u) const { return (const char*)(A + (size_t)u.pm * 256 * D); }
    __device__ __forceinline__ const char* b_ptr(const Unit& u) const { return (const char*)(Bt + (size_t)u.pn * 256 * D); }
};
struct MoeSched {
    const bf16_t* A; const bf16_t* Bt  ; const LAS unsigned char* TE; int nM, nN, N, G, c;
    __device__ __forceinline__ bool next(int i, Unit& u) const { if (!xcd_unit(i, G, c, nM, nN, u.pm, u.pn)) return false; u.e = TE[u.pm]; return true; }
    __device__ __forceinline__ const char* a_ptr(const Unit& u) const { return (const char*)(A + (size_t)u.pm * 256 * D); }
    __device__ __forceinline__ const char* b_ptr(const Unit& u) const { return (const char*)(Bt + ((size_t)u.e * N + (size_t)u.pn * 256) * D); }
};

struct EpiQKV {
    bf16_t *Q, *Kb, *Vb; const float *qg, *kg, *cosT, *sinT;
    __device__ __forceinline__ void operator()(const f32x4 (&acc)[2][2][4][2], const Unit& uu, int wr, int wc, int fr, int fq) const {
        const int pm = uu.pm, pn = uu.pn;
        const int kind = pn < 4 ? 0 : (pn == 4 ? 1 : 2);
        const float* gain = kind == 0 ? qg : kg;
        f32x4 gv[2][2];
#pragma unroll
        for (int bj = 0; bj < 2; ++bj)
#pragma unroll
            for (int n = 0; n < 2; ++n) gv[bj][n] = *(const f32x4*)(gain + 32 * bj + 16 * n + 4 * fq);
#pragma unroll
        for (int ai = 0; ai < 2; ++ai)
#pragma unroll
            for (int m = 0; m < 4; ++m) {
                const int r = pm * 256 + ai * 128 + wr * 64 + m * 16 + fr;
                const bool lat = r < NLAT;
                const int b = lat ? (r >> 11) : ((r - NLAT) >> 8);
                const int pos = lat ? (r & (SEQ - 1)) : (SEQ + ((r - NLAT) & (CL - 1)));
                f32x4 v[2][2];
#pragma unroll
                for (int bj = 0; bj < 2; ++bj)
#pragma unroll
                    for (int n = 0; n < 2; ++n) v[bj][n] = acc[ai][bj][m][n];
                if (kind != 2) {
                    float ss = 0.f;
#pragma unroll
                    for (int bj = 0; bj < 2; ++bj)
#pragma unroll
                        for (int n = 0; n < 2; ++n) ss += (v[bj][n][0] * v[bj][n][0] + v[bj][n][1] * v[bj][n][1]) + (v[bj][n][2] * v[bj][n][2] + v[bj][n][3] * v[bj][n][3]);
                    ss += __shfl_xor(ss, 16); ss += __shfl_xor(ss, 32);
                    const float rinv = 1.0f / sqrtf(ss * (1.0f / 64.0f) + EPS);
#pragma unroll
                    for (int bj = 0; bj < 2; ++bj)
#pragma unroll
                        for (int n = 0; n < 2; ++n) v[bj][n] = v[bj][n] * rinv * gv[bj][n];
                    if (lat) {
#pragma unroll
                        for (int bj = 0; bj < 2; ++bj) {
                            const f32x4 cs = *(const f32x4*)(cosT + pos * 32 + bj * 16 + 4 * fq), sn = *(const f32x4*)(sinT + pos * 32 + bj * 16 + 4 * fq);
                            const f32x4 x1 = v[bj][0], x2 = v[bj][1];
                            v[bj][0] = x1 * cs - x2 * sn; v[bj][1] = x2 * cs + x1 * sn;
                        }
                    }
                    if (kind == 0) {
#pragma unroll
                        for (int bj = 0; bj < 2; ++bj)
#pragma unroll
                            for (int n = 0; n < 2; ++n) v[bj][n] = v[bj][n] * C2;
                    }
                }
                bf16_t* dst = kind == 0 ? Q + (size_t)r * D + pn * 256 + wc * 64
                                        : (kind == 1 ? Kb : Vb) + ((size_t)b * KVL + pos) * 256 + wc * 64;
#pragma unroll
                for (int bj = 0; bj < 2; ++bj)
#pragma unroll
                    for (int n = 0; n < 2; ++n) { u32x2 w; w.x = pk2(v[bj][n][0], v[bj][n][1]); w.y = pk2(v[bj][n][2], v[bj][n][3]); *(u32x2*)(dst + 32 * bj + 16 * n + 4 * fq) = w; }
            }
    }
};
struct EpiBiasBf16 {
    bf16_t* O; int ldc; const float* bias0; int estride;
    __device__ __forceinline__ void operator()(const f32x4 (&acc)[2][2][4][2], const Unit& uu, int wr, int wc, int fr, int fq) const {
        const int row0 = uu.pm * 256, col0t = uu.pn * 256;
#pragma unroll
        for (int bj = 0; bj < 2; ++bj)
#pragma unroll
            for (int n = 0; n < 2; ++n) {
                const int c = col0t + bj * 128 + wc * 32 + n * 16 + 4 * fq;
                const f32x4 bv = *(const f32x4*)(bias0 + (size_t)uu.e * estride + c);
#pragma unroll
                for (int ai = 0; ai < 2; ++ai)
#pragma unroll
                    for (int m = 0; m < 4; ++m) { const int r = row0 + ai * 128 + wr * 64 + m * 16 + fr; const f32x4 v = acc[ai][bj][m][n] + bv;
                        u32x2 w; w.x = pk2(v[0], v[1]); w.y = pk2(v[2], v[3]); *(u32x2*)(O + (size_t)r * ldc + c) = w; }
            }
    }
};
struct EpiResid {
    const float *srcL, *srcC; float *dstL, *dstC; const float* gate  ; const float* bias;
    __device__ __forceinline__ void operator()(const f32x4 (&acc)[2][2][4][2], const Unit& uu, int wr, int wc, int fr, int fq) const {
        const int row0 = uu.pm * 256, col0t = uu.pn * 256;
#pragma unroll
        for (int bj = 0; bj < 2; ++bj)
#pragma unroll
            for (int n = 0; n < 2; ++n) {
                const int c = col0t + bj * 128 + wc * 32 + n * 16 + 4 * fq;
                const f32x4 bv = bias ? *(const f32x4*)(bias + c) : (f32x4){0.f, 0.f, 0.f, 0.f};
#pragma unroll
                for (int ai = 0; ai < 2; ++ai)
#pragma unroll
                    for (int m = 0; m < 4; ++m) { const int r = row0 + ai * 128 + wr * 64 + m * 16 + fr;
                        const f32x4 g = *(const f32x4*)(gate + (size_t)mod_row(r) * MODW + c);
                        const float* s = r < NLAT ? srcL + (size_t)r * D : srcC + (size_t)(r - NLAT) * D;
                        float* d = r < NLAT ? dstL + (size_t)r * D : dstC + (size_t)(r - NLAT) * D;
                        const f32x4 x = *(const f32x4*)(s + c);
                        *(f32x4*)(d + c) = x + g * (acc[ai][bj][m][n] + bv); }
            }
    }
};
struct EpiSwiglu {
    bf16_t* O; const float* bgu0  ;
    __device__ __forceinline__ void operator()(const f32x4 (&acc)[2][2][4][2], const Unit& uu, int wr, int wc, int fr, int fq) const {
        const int row0 = uu.pm * 256, pn = uu.pn; const float* bgu = bgu0 + (size_t)uu.e * NGU;
#pragma unroll
        for (int n = 0; n < 2; ++n) {
            const int f = pn * 128 + wc * 32 + n * 16 + 4 * fq;
            const f32x4 b0 = *(const f32x4*)(bgu + 2 * f), b1 = *(const f32x4*)(bgu + 2 * f + 4);
            const f32x4 bg = (f32x4){b0[0], b0[2], b1[0], b1[2]}, bu = (f32x4){b0[1], b0[3], b1[1], b1[3]};
#pragma unroll
            for (int ai = 0; ai < 2; ++ai)
#pragma unroll
                for (int m = 0; m < 4; ++m) { const int r = row0 + ai * 128 + wr * 64 + m * 16 + fr;
                    const f32x4 gg = acc[ai][0][m][n] + bg, uu = acc[ai][1][m][n] + bu; float o[4];
#pragma unroll
                    for (int e = 0; e < 4; ++e) { const float g = fminf(gg[e], 7.0f), u = fminf(fmaxf(uu[e], -7.0f), 7.0f);
                        const float sg = 1.0f / (1.0f + __expf(-1.702f * g)); o[e] = (u + 1.0f) * g * sg; }
                    u32x2 w; w.x = pk2(o[0], o[1]); w.y = pk2(o[2], o[3]); *(u32x2*)(O + (size_t)r * D + f) = w; }
        }
    }
};

template <int MODE> __device__ __forceinline__ int wrow_map(int n) {
    if (MODE == 0) return n;
    if (MODE == 1) { const int pn = n >> 8, wc = (n >> 6) & 3, bj = (n >> 5) & 1, j = n & 31; return (pn << 8) + (bj << 7) + (wc << 5) + j; }
    { const int f = n >> 1, pn = f >> 7, fo = f & 127; return (pn << 8) + ((n & 1) << 7) + fo; }
}
template <int MODE> __device__ __forceinline__ void transpose_item(const float* W, int N, bf16_t* WT, LAS float* scr, int item, int lane) {
    constexpr int K = D;
    const int nblk = N / 32, kb = item / nblk, nb = item % nblk, k0 = 64 * kb, n0 = 32 * nb;
#pragma unroll 8
    for (int i = 0; i < 32; ++i) { const int kk = 2 * i + (lane >> 5); scr[kk * 33 + (lane & 31)] = W[(size_t)(k0 + kk) * N + n0 + (lane & 31)]; }
    LDS_WAIT(); asm volatile("" ::: "memory");
    const int c = lane & 7;
#pragma unroll
    for (int j = 0; j < 4; ++j) { const int n = (lane >> 3) + 8 * j; const LAS float* s = scr + (8 * c) * 33 + n;
        u32x4 o; o.x = pk2(s[0 * 33], s[1 * 33]); o.y = pk2(s[2 * 33], s[3 * 33]); o.z = pk2(s[4 * 33], s[5 * 33]); o.w = pk2(s[6 * 33], s[7 * 33]);
        *(u32x4*)(WT + (size_t)wrow_map<MODE>(n0 + n) * K + k0 + 8 * c) = o; }
    LDS_WAIT(); asm volatile("" ::: "memory");
}

__device__ __forceinline__ void norm_mod_store(const f32x4 (&v)[4], const float* gain, const float* shift, const float* scale, bf16_t* dst, int lane, f32x4 (&h)[4]) {
    float ss = 0.f;
#pragma unroll
    for (int j = 0; j < 4; ++j) ss += (v[j][0] * v[j][0] + v[j][1] * v[j][1]) + (v[j][2] * v[j][2] + v[j][3] * v[j][3]);
    ss = wave_sum(ss);
    const float rinv = 1.0f / sqrtf(ss * (1.0f / D) + EPS);
#pragma unroll
    for (int j = 0; j < 4; ++j) {
        const f32x4 g = ((const f32x4*)gain)[lane + 64 * j], sh = ((const f32x4*)shift)[lane + 64 * j], sc = ((const f32x4*)scale)[lane + 64 * j];
        h[j] = (v[j] * rinv * g) * (sc + 1.0f) + sh;
        u32x2 w; w.x = pk2(h[j][0], h[j][1]); w.y = pk2(h[j][2], h[j][3]);
        ((u32x2*)dst)[lane + 64 * j] = w;
    }
}


namespace attn_body {
using bf16=__hip_bfloat16;
using bf16x8=__attribute__((ext_vector_type(8)))short;
using s16x4=__attribute__((ext_vector_type(4)))short;
using f32x16=__attribute__((ext_vector_type(16)))float;
using u32x4=__attribute__((ext_vector_type(4)))unsigned;
constexpr int D=64,DM=1024,KVP=256;
constexpr int NW=8,QBLK=32,QB=QBLK*NW,KVBLK=64;
__device__ __forceinline__ int crow(int r,int hi){return (r&3)+8*(r>>2)+4*hi;}
#define SBAR() __builtin_amdgcn_sched_barrier(0)
__device__ __forceinline__ void cmask(f32x16&p0,f32x16&p1,int jb,int qrel,int hi){
  const float NEG=-INFINITY; int kb=64*jb+4*hi;
  #pragma unroll
  for(int r=0;r<16;++r){int kv=kb+(r&3)+8*(r>>2); if(kv>qrel)p0[r]=NEG; if(kv+32>qrel)p1[r]=NEG;}
}

constexpr int NSLOT=3, SLOTB=8192;
constexpr int LDS_K=0, LDS_V=NSLOT*SLOTB, LDS_WS=2*NSLOT*SLOTB, LDS_OST=LDS_WS+NW*64*4, LDS_BYTES=LDS_OST+NW*4096;
constexpr float C2=0.125f*1.4426950408889634f;
__device__ __forceinline__ void glds16(const void*gsrc,unsigned lds_dst){unsigned keep;
  asm volatile("s_mov_b32 %0, m0\n\ts_mov_b32 m0, %2\n\ts_nop 0\n\tglobal_load_lds_dwordx4 %1, off\n\ts_mov_b32 m0, %0":"=&s"(keep):"v"(gsrc),"s"(lds_dst):"memory");}
__device__ __forceinline__ float max3f(float a,float b,float c){float r;asm("v_max3_f32 %0, %1, %2, %3":"=v"(r):"v"(a),"v"(b),"v"(c));return r;}
__device__ __forceinline__ float max2f(float a,float b){float r;asm("v_max_f32_e32 %0, %1, %2":"=v"(r):"v"(a),"v"(b));return r;}
__device__ __forceinline__ float fadd_s(float a,float b){float r;asm("v_add_f32_e32 %0, %1, %2":"=v"(r):"v"(a),"v"(b));return r;}
__device__ __forceinline__ float fsub_s(float a,float b){float r;asm("v_sub_f32_e32 %0, %1, %2":"=v"(r):"v"(a),"v"(b));return r;}
typedef float f32x2_t __attribute__((ext_vector_type(2))); typedef __bf16 bf16x2_t __attribute__((ext_vector_type(2)));
__device__ __forceinline__ unsigned cvtpk_s(float lo,float hi){f32x2_t v={lo,hi};bf16x2_t b=__builtin_convertvector(v,bf16x2_t);return __builtin_bit_cast(unsigned,b);}
#define WAIT_BAR(N) asm volatile("s_waitcnt vmcnt(" #N ") lgkmcnt(0)\n\ts_barrier":::"memory")

__device__ __forceinline__ void qkt(f32x16&p0,f32x16&p1,const char*Kslot,const bf16x8*qr,const f32x16&negm,int r32,int hi){
  const char*kb=Kslot+hi*1024+r32*16;
  #pragma unroll
  for(int d0=0;d0<4;++d0){
    const bf16x8 b0=*reinterpret_cast<const bf16x8*>(kb+d0*2048);
    const bf16x8 b1=*reinterpret_cast<const bf16x8*>(kb+d0*2048+512);
    if(d0==0){p0=__builtin_amdgcn_mfma_f32_32x32x16_bf16(b0,qr[0],negm,0,0,0);p1=__builtin_amdgcn_mfma_f32_32x32x16_bf16(b1,qr[0],negm,0,0,0);}
    else{p0=__builtin_amdgcn_mfma_f32_32x32x16_bf16(b0,qr[d0],p0,0,0,0);p1=__builtin_amdgcn_mfma_f32_32x32x16_bf16(b1,qr[d0],p1,0,0,0);}}
}
typedef __attribute__((address_space(3))) const char* lds_cptr;
typedef short v4i16_t __attribute__((ext_vector_type(4)));
__device__ __forceinline__ void kload8(bf16x8*kf,lds_cptr kp){
  kf[0]=*(const __attribute__((address_space(3))) bf16x8*)(kp);      kf[1]=*(const __attribute__((address_space(3))) bf16x8*)(kp+512);
  kf[2]=*(const __attribute__((address_space(3))) bf16x8*)(kp+2048); kf[3]=*(const __attribute__((address_space(3))) bf16x8*)(kp+2560);
  kf[4]=*(const __attribute__((address_space(3))) bf16x8*)(kp+4096); kf[5]=*(const __attribute__((address_space(3))) bf16x8*)(kp+4608);
  kf[6]=*(const __attribute__((address_space(3))) bf16x8*)(kp+6144); kf[7]=*(const __attribute__((address_space(3))) bf16x8*)(kp+6656);
}
__device__ __forceinline__ void kload2(bf16x8*kf,lds_cptr kp,int j){ kf[2*j]=*(const __attribute__((address_space(3))) bf16x8*)(kp+j*2048); kf[2*j+1]=*(const __attribute__((address_space(3))) bf16x8*)(kp+j*2048+512); }
__device__ __forceinline__ s16x4 vtr(lds_cptr p){ return __builtin_bit_cast(s16x4,__builtin_amdgcn_ds_read_tr16_b64_v4i16((__attribute__((address_space(3))) v4i16_t*)p)); }
__device__ __forceinline__ float rowmax(const f32x16&p0,const f32x16&p1){
  float a=max3f(p0[0],p0[1],p1[0]),b=max3f(p0[2],p0[3],p1[1]);a=max3f(a,p1[2],p1[3]);
  #pragma unroll
  for(int r=4;r<16;r+=4){a=max3f(a,p0[r],p0[r+1]);b=max3f(b,p0[r+2],p0[r+3]);a=max3f(a,p1[r],p1[r+1]);b=max3f(b,p1[r+2],p1[r+3]);}
  const float m=max2f(a,b);
  auto rr=__builtin_amdgcn_permlane32_swap(__float_as_uint(m),__float_as_uint(m),false,false);
  return max2f(__uint_as_float(rr[0]),__uint_as_float(rr[1]));
}
__device__ __forceinline__ void pv(f32x16*o,int vb,bf16x8 pa0,bf16x8 pa1,bf16x8 pa2,bf16x8 pa3){
  #pragma unroll
  for(int d0=0;d0<2;++d0){s16x4 lo[4],hi[4];
    #pragma unroll
    for(int ks=0;ks<4;++ks){
      asm volatile("ds_read_b64_tr_b16 %0,%1 offset:%c2":"=&v"(lo[ks]):"v"(vb),"i"(d0*4096+ks*1024):"memory");
      asm volatile("ds_read_b64_tr_b16 %0,%1 offset:%c2":"=&v"(hi[ks]):"v"(vb),"i"(d0*4096+ks*1024+512):"memory");}
    asm volatile("s_waitcnt lgkmcnt(0)":::"memory");SBAR();
    #define PK(k) (bf16x8){lo[k][0],lo[k][1],lo[k][2],lo[k][3],hi[k][0],hi[k][1],hi[k][2],hi[k][3]}
    o[d0]=__builtin_amdgcn_mfma_f32_32x32x16_bf16(pa0,PK(0),o[d0],0,0,0);
    o[d0]=__builtin_amdgcn_mfma_f32_32x32x16_bf16(pa1,PK(1),o[d0],0,0,0);
    o[d0]=__builtin_amdgcn_mfma_f32_32x32x16_bf16(pa2,PK(2),o[d0],0,0,0);
    o[d0]=__builtin_amdgcn_mfma_f32_32x32x16_bf16(pa3,PK(3),o[d0],0,0,0);
    #undef PK
  }
}

#ifndef ATTN_STORE16
#define ATTN_STORE16(p,v) (*(u32x4*)(p)=(v))
#endif
template<int THRL> __device__ __forceinline__ void attn_unit(const bf16*Qu,const bf16*__restrict__ Kh,const bf16*__restrict__ Vh,bf16*Ou,const int NT,char*shm){
  const int tid=threadIdx.x,lane=tid&63,r32=lane&31,hi=lane>>5; const int wid=__builtin_amdgcn_readfirstlane(tid>>6);
  const bf16*Qw=Qu+(long)(wid*QBLK)*DM;
  const unsigned lds0=(unsigned)(uintptr_t)shm;
  float*wsf=(float*)(shm+LDS_WS)+wid*64;
  const bf16*ksrc=Kh+(long)lane*KVP+wid*8;
  const bf16*vsrc=Vh+(long)(16*(wid&3)+(lane>>2))*KVP+(wid>>2)*32+(lane&3)*8;
  const unsigned kdst=lds0+LDS_K+wid*1024, vdst=lds0+LDS_V+wid*1024;
  #define DMA_K(t,slot) glds16(ksrc+(long)(t)*KVBLK*KVP,(unsigned)__builtin_amdgcn_readfirstlane(kdst+(slot)))
  #define DMA_V(t,slot) glds16(vsrc+(long)(t)*KVBLK*KVP,(unsigned)__builtin_amdgcn_readfirstlane(vdst+(slot)))
  const int vb0=(int)(lds0+LDS_V)+((lane>>4)&1)*32+(lane&3)*8+(4*hi+((lane&15)>>2))*64;
  const char*Kbase=shm+LDS_K; bf16x8 kf[8];
  const lds_cptr shm3=(lds_cptr)shm; const lds_cptr kp0=shm3+LDS_K+hi*1024+r32*16; const lds_cptr vp0=shm3+LDS_V+((lane>>4)&1)*32+(lane&3)*8+(4*hi+((lane&15)>>2))*64;
  DMA_K(0,0);DMA_V(0,0);DMA_K(1,SLOTB);
  bf16x8 qr[4];
  #pragma unroll
  for(int d0=0;d0<4;++d0)qr[d0]=*reinterpret_cast<const bf16x8*>(&Qw[(long)r32*DM+d0*16+hi*8]);
  float mhat=0.f,l_reg=0.f;f32x16 o[2];o[0]=f32x16{};o[1]=f32x16{};f32x16 negm=f32x16{};asm volatile("":"+v"(negm));
  #define CMASK(P0,P1,t) do{}while(0)
  bool resc=false;
  #define START(P0,P1) do{ const float rm=rowmax(P0,P1); resc=false; \
    { const float dl=rm; mhat=fadd_s(mhat,dl); \
      _Pragma("unroll") for(int r=0;r<16;++r){P0[r]=fsub_s(P0[r],dl);P1[r]=fsub_s(P1[r],dl);} \
      _Pragma("unroll") for(int r=0;r<16;++r)negm[r]=-mhat; asm volatile("":"+v"(negm)); } \
    _Pragma("unroll") for(int r=0;r<16;++r)P0[r]=__builtin_amdgcn_exp2f(P0[r]); }while(0)
  #define RESC() do{ if(resc){ asm volatile("s_waitcnt lgkmcnt(0)":::"memory"); \
      _Pragma("unroll") for(int d_=0;d_<2;++d_) _Pragma("unroll") for(int r=0;r<16;++r)o[d_][r]*=wsf[crow(r,hi)]; } }while(0)
  f32x16 pA0,pA1,pB0,pB1;
  int sl_prev=0,sl_cur=0,sl_next=SLOTB;
  #define ROT() do{sl_prev=sl_cur;sl_cur=sl_next;sl_next=(sl_next==(NSLOT-1)*SLOTB)?0:sl_next+SLOTB;}while(0)
  DMA_K(2,2*SLOTB);
  WAIT_BAR(3);
  qkt(pA0,pA1,Kbase,qr,negm,r32,hi);asm volatile("s_nop 15\n\ts_nop 7":"+v"(pA0),"+v"(pA1));CMASK(pA0,pA1,0);
  START(pA0,pA1);
  _Pragma("unroll") for(int r=0;r<16;++r)pA1[r]=__builtin_amdgcn_exp2f(pA1[r]);
  WAIT_BAR(0);
  DMA_K(3,0);DMA_V(1,SLOTB);
  ROT();
  kload8(kf,kp0+sl_cur);
  WAIT_BAR(2);
  s16x4 vlo[8],vhi[8]; u32x4 pw0,pw1,pw2,pw3;
  #define PKW(P,B) cvtpk_s(P[B],P[B+1])
  #define PAF(k) __builtin_bit_cast(bf16x8,pw##k)
  #define VFR(i) (bf16x8){vlo[i][0],vlo[i][1],vlo[i][2],vlo[i][3],vhi[i][0],vhi[i][1],vhi[i][2],vhi[i][3]}
  #define PIN(x) asm volatile("":"+v"(x))
  #define MX3(a,b,c) __builtin_fmaxf(__builtin_fmaxf((a),(b)),(c))
  #define GAPA(MF,A0,A1,A2,A3,W0,W1,PW) do{ MF; sacc+=A0; sacc+=A1; sacc+=A2; sacc+=A3; PIN(sacc); W0; W1; PIN(PW); SBAR(); }while(0)
  #define EX(v) __builtin_amdgcn_exp2f(v)
  #define GAPB(MF,X,B) do{ MF; X[B]=EX(X[B]); X[B+1]=EX(X[B+1]); X[B+2]=EX(X[B+2]); X[B+3]=EX(X[B+3]); PIN(X); SBAR(); }while(0)
  #define VRD(i) do{ vlo[i]=vtr(vp_+(((i)>>2)*4096+((i)&3)*1024)); vhi[i]=vtr(vp_+(((i)>>2)*4096+((i)&3)*1024+512)); }while(0)
  #define KRD(G,j) do{ if(G){ kload2(kf,kp0+sl_next,j); SBAR(); } }while(0)
  #define STEP(C0,C1,P0,P1,t,GK,GV,GL) do{ SBAR(); \
    const lds_cptr vp_=vp0+sl_prev; \
    VRD(0); SBAR(); float sacc=(P0[0]+P0[1]); \
    GAPA(C0=__builtin_amdgcn_mfma_f32_32x32x16_bf16(kf[0],qr[0],negm,0,0,0), P0[2],P0[3],P0[4],P0[5],     pw0[0]=PKW(P0,0), pw0[1]=PKW(P0,2), pw0); \
    VRD(4); SBAR(); GAPA(C1=__builtin_amdgcn_mfma_f32_32x32x16_bf16(kf[1],qr[0],negm,0,0,0), P0[6],P0[7],P0[8],P0[9],     pw0[2]=PKW(P0,4), pw0[3]=PKW(P0,6), pw0); \
    VRD(1); SBAR(); GAPA(C0=__builtin_amdgcn_mfma_f32_32x32x16_bf16(kf[2],qr[1],C0,0,0,0),   P0[10],P0[11],P0[12],P0[13], pw1[0]=PKW(P0,8), pw1[1]=PKW(P0,10), pw1); \
    VRD(5); SBAR(); GAPA(C1=__builtin_amdgcn_mfma_f32_32x32x16_bf16(kf[3],qr[1],C1,0,0,0),   P0[14],P0[15],P1[0],P1[1],   pw1[2]=PKW(P0,12),pw1[3]=PKW(P0,14), pw1); \
    VRD(2); SBAR(); GAPA(C0=__builtin_amdgcn_mfma_f32_32x32x16_bf16(kf[4],qr[2],C0,0,0,0),   P1[2],P1[3],P1[4],P1[5],     pw2[0]=PKW(P1,0), pw2[1]=PKW(P1,2), pw2); \
    VRD(6); SBAR(); GAPA(C1=__builtin_amdgcn_mfma_f32_32x32x16_bf16(kf[5],qr[2],C1,0,0,0),   P1[6],P1[7],P1[8],P1[9],     pw2[2]=PKW(P1,4), pw2[3]=PKW(P1,6), pw2); \
    VRD(3); SBAR(); GAPA(C0=__builtin_amdgcn_mfma_f32_32x32x16_bf16(kf[6],qr[3],C0,0,0,0),   P1[10],P1[11],P1[12],P1[13], pw3[0]=PKW(P1,8), pw3[1]=PKW(P1,10), pw3); \
    VRD(7); SBAR(); GAPA(C1=__builtin_amdgcn_mfma_f32_32x32x16_bf16(kf[7],qr[3],C1,0,0,0),   P1[14],P1[15],0.f,0.f,       pw3[2]=PKW(P1,12),pw3[3]=PKW(P1,14), pw3); \
    l_reg+=sacc; \
    if(GK){DMA_K((t)+3,sl_cur);} if(GV){DMA_V((t)+1,sl_next);} \
    CMASK(C0,C1,t); \
    { float a=MX3(C0[0],C0[1],C1[0]),b=MX3(C0[2],C0[3],C1[1]); a=MX3(a,C1[2],C1[3]); \
      _Pragma("unroll") for(int r=4;r<16;r+=4){a=MX3(a,C0[r],C0[r+1]);b=MX3(b,C0[r+2],C0[r+3]);a=MX3(a,C1[r],C1[r+1]);b=MX3(b,C1[r+2],C1[r+3]);} \
      float rm=__builtin_fmaxf(a,b); { auto rr=__builtin_amdgcn_permlane32_swap(__float_as_uint(rm),__float_as_uint(rm),false,false); rm=__builtin_fmaxf(__uint_as_float(rr[0]),__uint_as_float(rr[1])); } \
      resc=false; \
      if(__builtin_expect(__any(rm>(float)THRL),0)){ const float dl=__builtin_fmaxf(rm,0.f); mhat+=dl; \
        _Pragma("unroll") for(int r=0;r<16;++r){C0[r]-=dl;C1[r]-=dl;} \
        _Pragma("unroll") for(int r=0;r<16;++r)negm[r]=-mhat; asm volatile("":"+v"(negm)); \
        const float f=__builtin_amdgcn_exp2f(-dl); l_reg*=f; if(hi==0)wsf[r32]=f; resc=true; } } \
    SBAR(); \
    GAPB(o[0]=__builtin_amdgcn_mfma_f32_32x32x16_bf16(PAF(0),VFR(0),o[0],0,0,0), C0,0); \
    GAPB(o[1]=__builtin_amdgcn_mfma_f32_32x32x16_bf16(PAF(0),VFR(4),o[1],0,0,0), C0,4); \
    KRD(GL,0); GAPB(o[0]=__builtin_amdgcn_mfma_f32_32x32x16_bf16(PAF(1),VFR(1),o[0],0,0,0), C0,8); \
    KRD(GL,1); GAPB(o[1]=__builtin_amdgcn_mfma_f32_32x32x16_bf16(PAF(1),VFR(5),o[1],0,0,0), C0,12); \
    KRD(GL,2); GAPB(o[0]=__builtin_amdgcn_mfma_f32_32x32x16_bf16(PAF(2),VFR(2),o[0],0,0,0), C1,0); \
    KRD(GL,3); GAPB(o[1]=__builtin_amdgcn_mfma_f32_32x32x16_bf16(PAF(2),VFR(6),o[1],0,0,0), C1,4); \
    GAPB(o[0]=__builtin_amdgcn_mfma_f32_32x32x16_bf16(PAF(3),VFR(3),o[0],0,0,0), C1,8); \
    GAPB(o[1]=__builtin_amdgcn_mfma_f32_32x32x16_bf16(PAF(3),VFR(7),o[1],0,0,0), C1,12); \
    }while(0)
  int t=1;
  #undef CMASK
  #define CMASK(P0,P1,t) do{}while(0)
  for(;t+5<NT;t+=2){
    STEP(pB0,pB1,pA0,pA1,t,true,true,true);     WAIT_BAR(2); RESC(); ROT();
    STEP(pA0,pA1,pB0,pB1,t+1,true,true,true);   WAIT_BAR(2); RESC(); ROT();
  }
  #undef CMASK
  #define CMASK(P0,P1,t) do{}while(0)
  #define ENDW(tt) do{ if((tt)+3<NT){WAIT_BAR(2);} else if((tt)+2<NT){WAIT_BAR(1);} else {WAIT_BAR(0);} }while(0)
  for(;t+1<NT;t+=2){
    STEP(pB0,pB1,pA0,pA1,t,(t+3<NT),(t+1<NT),(t+1<NT));       ENDW(t);   RESC(); ROT();
    STEP(pA0,pA1,pB0,pB1,t+1,(t+4<NT),(t+2<NT),(t+2<NT));     ENDW(t+1); RESC(); ROT();
  }
  STEP(pB0,pB1,pA0,pA1,NT-1,false,false,false); RESC();
  { float sacc=pB0[0]+pB0[1]; _Pragma("unroll") for(int r=2;r<16;++r)sacc+=pB0[r]; _Pragma("unroll") for(int r=0;r<16;++r)sacc+=pB1[r]; l_reg+=sacc;
    pw0=(u32x4){PKW(pB0,0),PKW(pB0,2),PKW(pB0,4),PKW(pB0,6)};pw1=(u32x4){PKW(pB0,8),PKW(pB0,10),PKW(pB0,12),PKW(pB0,14)};pw2=(u32x4){PKW(pB1,0),PKW(pB1,2),PKW(pB1,4),PKW(pB1,6)};pw3=(u32x4){PKW(pB1,8),PKW(pB1,10),PKW(pB1,12),PKW(pB1,14)};
    SBAR(); pv(o,vb0+sl_cur,PAF(0),PAF(1),PAF(2),PAF(3)); }
  #undef PKW
  #undef PAF
  #undef VFR
  #undef PIN
  #undef MX3
  #undef GAPA
  #undef GAPB
  #undef EX
  #undef VRD
  #undef KRD
  #undef STEP
  #undef ENDW
  {auto rr=__builtin_amdgcn_permlane32_swap(__float_as_uint(l_reg),__float_as_uint(l_reg),false,false);l_reg=__uint_as_float(rr[0])+__uint_as_float(rr[1]);}
  if(hi==0)wsf[32+r32]=l_reg;asm volatile("s_waitcnt lgkmcnt(0)":::"memory");
  float rli[16];
  #pragma unroll
  for(int r=0;r<16;++r)rli[r]=__builtin_amdgcn_rcpf(wsf[32+crow(r,hi)]);
  bf16*Ow=Ou+(long)(wid*QBLK)*DM;
  { bf16*stg=(bf16*)(shm+LDS_OST)+wid*2048;
    #pragma unroll
    for(int r=0;r<16;++r){const int orow=crow(r,hi);
      #pragma unroll
      for(int d0=0;d0<2;++d0)stg[orow*64+d0*32+r32]=__float2bfloat16(o[d0][r]*rli[r]);}
    asm volatile("s_waitcnt lgkmcnt(0)":::"memory");
    #pragma unroll
    for(int i=0;i<4;++i){const int row=i*8+(lane>>3),ch=lane&7; const u32x4 v=*(const u32x4*)(stg+row*64+ch*8); ATTN_STORE16(Ow+(long)row*DM+ch*8,v);} }
  asm volatile("s_waitcnt lgkmcnt(0)\n\ts_barrier":::"memory");
  #undef DMA_K
  #undef DMA_V
  #undef CMASK
  #undef START
  #undef RESC
  #undef ROT
}
constexpr int ATTN_LDS_BYTES=LDS_BYTES;
#undef SBAR
#undef WAIT_BAR
}

template <int LF>
__device__ __forceinline__ void conv_channel(LAS unsigned char* lds, const bf16_t* FIc, const bf16_t* wsrc, bf16_t* ydst, int tid, int lane, int wv) {
    constexpr int IPW = LF / 256, NBK = LF / 32, P = 2 * LF + 8, WSTR = LF + 8;
    LAS unsigned char* FIL = lds; LAS unsigned char* WL = lds + ((8 * P * 2 + 255) & ~255);
    __syncthreads();
    { const u32x4* fs = (const u32x4*)FIc; for (int i = tid; i < 8 * P * 2 / 16; i += NTHR) ((LAS u32x4*)FIL)[i] = fs[i]; }
    for (int i = tid; i < NB * (LF / 8); i += NTHR) { const int b = i / (LF / 8), ch = i % (LF / 8); *(LAS u32x4*)(WL + b * (WSTR * 2) + ch * 16) = *(const u32x4*)(wsrc + (size_t)b * LF + ch * 8); }
    __syncthreads();
    f32x4 acc[IPW][2]; bf16x8 Bw[IPW];
#pragma unroll
    for (int ii = 0; ii < IPW; ++ii) { acc[ii][0] = (f32x4){0.f, 0.f, 0.f, 0.f}; acc[ii][1] = (f32x4){0.f, 0.f, 0.f, 0.f}; Bw[ii] = (bf16x8){0, 0, 0, 0, 0, 0, 0, 0}; }
    const int rr = lane & 15, q = lane >> 4;
    const int aBase = (rr & 7) * (P * 2) + 2 * (LF - (rr - (rr & 7)) + 8 * q);
    const int bBase = rr * (WSTR * 2) + 16 * q;
#define CONV_STEPS(CHECK) do { _Pragma("unroll") for (int dd = 0; dd < IPW; ++dd) { \
        const int delta = IPW * d + dd; \
        const bf16x8 a0 = *(const LAS bf16x8*)(FIL + aBase - 64 * delta), a1 = *(const LAS bf16x8*)(FIL + aBase - 64 * delta - 32); \
        const int jn = IPW * (wv - d) - dd; \
        if (!(CHECK) || (jn >= 0 && jn < NBK)) Bw[(IPW - dd) % IPW] = *(const LAS bf16x8*)(WL + bBase + 64 * jn); \
        _Pragma("unroll") for (int ii = 0; ii < IPW; ++ii) { const int j = IPW * (wv - d) + ii - dd; \
            if (!(CHECK) || (j >= 0 && j < NBK)) { \
                acc[ii][0] = __builtin_amdgcn_mfma_f32_16x16x32_bf16(a0, Bw[(ii - dd + IPW) % IPW], acc[ii][0], 0, 0, 0); \
                acc[ii][1] = __builtin_amdgcn_mfma_f32_16x16x32_bf16(a1, Bw[(ii - dd + IPW) % IPW], acc[ii][1], 0, 0, 0); } } } } while (0)
    { const int d = wv - 8; CONV_STEPS(true); }
    for (int d = wv - 7; d < wv; ++d) { CONV_STEPS(false); }
    { const int d = wv; CONV_STEPS(true); }
#undef CONV_STEPS
#pragma unroll
    for (int ii = 0; ii < IPW; ++ii)
#pragma unroll
        for (int h = 0; h < 2; ++h) { u32x2 w; w.x = pk2(acc[ii][h][0], acc[ii][h][1]); w.y = pk2(acc[ii][h][2], acc[ii][h][3]);
            *(u32x2*)(ydst + (size_t)rr * LF + 32 * (IPW * wv + ii) + 16 * h + 4 * q) = w; }
}

#define IN(k) (lo <= (k) && (k) < hi)
#define SEAM(k) do { if (IN(k) && IN((k) + 1)) xcd_barrier(bar); } while (0)
#define KLOCALS \
    const float* x_in = args.in[I_X]; const float* c_in = args.in[I_C]; const float* ctx_in = args.in[I_CTX]; const float* cctx_in = args.in[I_CCTX]; \
    float* out = args.out; \
    float* modp = (float*)(ws + WS_MODP); float* modf = (float*)(ws + WS_MOD); \
    float* cosT = (float*)(ws + WS_ROPE); float* sinT = cosT + SEQ * 32; \
    float* a2tab = (float*)(ws + WS_A2); \
    int* top_e = (int*)(ws + WS_PAIR); int* ppos = top_e + NTOK * 4; float* pgate = (float*)(ppos + NTOK * 4); int* pdest = (int*)(pgate + NTOK * 4); \
    float* ctxbuf = (float*)(ws + WS_CTX); \
    bf16_t* Wqkv_t = (bf16_t*)(ws + WS_WQKV); bf16_t* Wo_t = (bf16_t*)(ws + WS_WO); bf16_t* Win_t = (bf16_t*)(ws + WS_WIN); bf16_t* Wout_t = (bf16_t*)(ws + WS_WOUT); \
    bf16_t* Wgu_t = (bf16_t*)(ws + WS_WGU); bf16_t* Wdn_t = (bf16_t*)(ws + WS_WDN); \
    bf16_t* hA = (bf16_t*)(ws + WS_HA); bf16_t* Qb = (bf16_t*)(ws + WS_Q); bf16_t* Kb = (bf16_t*)(ws + WS_K); bf16_t* Vb = (bf16_t*)(ws + WS_V); \
    bf16_t* Upre = (bf16_t*)(ws + WS_UPRE); bf16_t* Wc = (bf16_t*)(ws + WS_WC); bf16_t* Yc = (bf16_t*)(ws + WS_YC); \
    bf16_t* XS = (bf16_t*)(ws + WS_XS); bf16_t* AB = (bf16_t*)(ws + WS_AB); \
    const int wr = wave >> 2, wc = wave & 3, fr = lane & 15, fq = lane >> 4;
template <int layer> __device__ __forceinline__ void layer_body(const Args& args, LAS unsigned char* lds, const XcdBarrier& bar, const int tid, const int lane, const int wave, const int G, const int bid, const int lo, const int hi) {
    const int gw = bid * NWAVES + wave, NGW = G * NWAVES;
    unsigned char* ws = args.ws;
    gu32* ctl = (gu32*)(ws + WS_CTL);
    KLOCALS
        const int pb = 3 + 10 * layer;
        const int jm = layer >> 1;
        const bool ctx_live = layer < 2;
        const int nrows = ctx_live ? NTOK : NLAT;
        const float* mo = modf + (size_t)layer * NMODROW * MODW;
        const float* resL = layer == 0 ? x_in : out; const float* resC = layer == 0 ? ctx_in : ctxbuf;

        if ((layer & 1) == 0) {
            if (EN_GEMM && IN(pb + 0)) {
                EpiQKV E{Qb, Kb, Vb, args.in[I_QG] + jm * 64, args.in[I_KG] + jm * 64, cosT, sinT};
                const bf16_t* Wt = Wqkv_t + (size_t)jm * NQKV * D;
                const QkvSched S{hA, Wt, ctx_live ? 1 : 0, G, bid};
                run_gemm(lds, S, E);
            }
            SEAM(pb + 0);
            if (EN_ATT && IN(pb + 1)) {
                typedef attn_body::bf16 abf;
                const int x = bid & 7, sl = bid >> 3, nS = G >> 3;
                for (int q = sl; q < 256; q += nS) {
                    const int b = 2 * x + (q >> 7), kvh = (q >> 5) & 3, head = 4 * kvh + ((q >> 3) & 3), qb = q & 7;
                    abf* Qu = (abf*)(Qb + ((size_t)b * SEQ + qb * 256) * D + head * 64);
                    attn_body::attn_unit<8>(Qu, (const abf*)(Kb + (size_t)b * KVL * 256 + kvh * 64), (const abf*)(Vb + (size_t)b * KVL * 256 + kvh * 64), Qu, KVL / 64, (char*)lds);
                }
                if (ctx_live) for (int q = sl; q < 32; q += nS) {
                    const int b = 2 * x + (q >> 4), head = q & 15, kvh = head >> 2;
                    abf* Qu = (abf*)(Qb + ((size_t)NLAT + b * CL) * D + head * 64);
                    attn_body::attn_unit<8>(Qu, (const abf*)(Kb + ((size_t)b * KVL + SEQ) * 256 + kvh * 64), (const abf*)(Vb + ((size_t)b * KVL + SEQ) * 256 + kvh * 64), Qu, CL / 64, (char*)lds);
                }
            }
            SEAM(pb + 1);
            if (EN_GEMM && IN(pb + 2)) {
                EpiResid E{resL, resC, out, ctxbuf, mo + 2 * D, nullptr};
                const bf16_t* Wt = Wo_t + (size_t)jm * D * D;
                const DenseSched S{Qb, Wt, nrows / 256, 4, G, bid};
                run_gemm(lds, S, E);
            }
            SEAM(pb + 2);
        } else {
            const float* cw = args.in[I_HCW] + (size_t)jm * 3 * NHY; const float* cb = args.in[I_HCB] + (size_t)jm * NHY;
            if (EN_GEMM && IN(pb + 0)) {
                EpiBiasBf16 E{Upre, NHY, args.in[I_HBIN] + (size_t)jm * NHY, 0};
                const bf16_t* Wt = Win_t + (size_t)jm * NHY * D;
                const DenseSched S{hA, Wt, nrows / 256, 12, G, bid};
                run_gemm(lds, S, E);
            }
            SEAM(pb + 0);
            if (EN_MISC && IN(pb + 1)) {
                LAS bf16_t* T = (LAS bf16_t*)lds;
                const int nlat_u = NB * 32 * 16, nctx_u = ctx_live ? NB * 4 * 16 : 0;
                for (int u = bid; u < nlat_u + nctx_u; u += G) {
                    int b, s0, c0, Ls, rowb; bf16_t* dstb;
                    if (u < nlat_u) { b = u >> 9; s0 = ((u >> 4) & 31) * 64; c0 = (u & 15) * 64; Ls = SEQ; rowb = b * SEQ; dstb = Wc; }
                    else { const int q = u - nlat_u; b = q >> 6; s0 = ((q >> 4) & 3) * 64; c0 = (q & 15) * 64; Ls = CL; rowb = NLAT + b * CL; dstb = Wc + WC_CTX_OFF; }
                    const int sr = tid >> 3, cc = (tid & 7) * 8, s = s0 + sr;
                    float x1[8], vv[8];
#pragma unroll
                    for (int e = 0; e < 8; ++e) { x1[e] = cb[D + c0 + cc + e]; vv[e] = cb[2 * D + c0 + cc + e]; }
#pragma unroll
                    for (int tap = 0; tap < 3; ++tap) { const int sp = s + tap - 1;
                        if (sp >= 0 && sp < Ls) { const bf16_t* ur = Upre + (size_t)(rowb + sp) * NHY + c0 + cc; const u32x4 a = *(const u32x4*)(ur + D), bq = *(const u32x4*)(ur + 2 * D);
                            const float* w1 = cw + tap * NHY + D + c0 + cc; const float* w2 = cw + tap * NHY + 2 * D + c0 + cc;
                            const float af[8] = {bflo(a.x), bfhi(a.x), bflo(a.y), bfhi(a.y), bflo(a.z), bfhi(a.z), bflo(a.w), bfhi(a.w)};
                            const float bf[8] = {bflo(bq.x), bfhi(bq.x), bflo(bq.y), bfhi(bq.y), bflo(bq.z), bfhi(bq.z), bflo(bq.w), bfhi(bq.w)};
#pragma unroll
                            for (int e = 0; e < 8; ++e) { x1[e] += af[e] * w1[e]; vv[e] += bf[e] * w2[e]; } } }
                    __syncthreads();
#pragma unroll
                    for (int e = 0; e < 8; ++e) T[(cc + e) * 72 + sr] = (bf16_t)f2bf(x1[e] * vv[e]);
                    __syncthreads();
                    { const int c = tid >> 3, sc = (tid & 7) * 8; const u32x4 w = *(const LAS u32x4*)(T + c * 72 + sc);
                      *(u32x4*)(dstb + ((size_t)(c0 + c) * NB + b) * Ls + s0 + sc) = w; }
                }
            }
            SEAM(pb + 1);
            if (EN_CONV && IN(pb + 2)) {
                const int nlat_u = 1024, nctx_u = ctx_live ? 1024 : 0;
                for (int u = bid; u < nlat_u + nctx_u; u += G) {
                    if (u < nlat_u) { const int c = u; conv_channel<SEQ>(lds, (const bf16_t*)(ws + (jm == 0 ? WS_FI0 : WS_FI1)) + (size_t)c * 8 * FP_L, Wc + (size_t)c * NB * SEQ, Yc + (size_t)c * NB * SEQ, tid, lane, wave); }
                    else { const int c = u - nlat_u; conv_channel<CL>(lds, (const bf16_t*)(ws + WS_FI2) + (size_t)c * 8 * FP_C, Wc + WC_CTX_OFF + (size_t)c * NB * CL, Yc + WC_CTX_OFF + (size_t)c * NB * CL, tid, lane, wave); }
                }
            }
            SEAM(pb + 2);
            if (EN_MISC && IN(pb + 3)) {
                LAS bf16_t* T = (LAS bf16_t*)lds;
                const int nlat_u = NB * 32 * 16, nctx_u = ctx_live ? NB * 4 * 16 : 0;
                for (int u = bid; u < nlat_u + nctx_u; u += G) {
                    int b, s0, c0, Ls, rowb; const bf16_t* srcb;
                    if (u < nlat_u) { b = u >> 9; s0 = ((u >> 4) & 31) * 64; c0 = (u & 15) * 64; Ls = SEQ; rowb = b * SEQ; srcb = Yc; }
                    else { const int q = u - nlat_u; b = q >> 6; s0 = ((q >> 4) & 3) * 64; c0 = (q & 15) * 64; Ls = CL; rowb = NLAT + b * CL; srcb = Yc + WC_CTX_OFF; }
                    __syncthreads();
                    { const int c = tid >> 3, sc = (tid & 7) * 8; *(LAS u32x4*)(T + c * 72 + sc) = *(const u32x4*)(srcb + ((size_t)(c0 + c) * NB + b) * Ls + s0 + sc); }
                    __syncthreads();
                    const int sr = tid >> 3, cc = (tid & 7) * 8, s = s0 + sr;
                    float x0[8];
#pragma unroll
                    for (int e = 0; e < 8; ++e) x0[e] = cb[c0 + cc + e];
#pragma unroll
                    for (int tap = 0; tap < 3; ++tap) { const int sp = s + tap - 1;
                        if (sp >= 0 && sp < Ls) { const u32x4 a = *(const u32x4*)(Upre + (size_t)(rowb + sp) * NHY + c0 + cc); const float* w0 = cw + tap * NHY + c0 + cc;
                            const float af[8] = {bflo(a.x), bfhi(a.x), bflo(a.y), bfhi(a.y), bflo(a.z), bfhi(a.z), bflo(a.w), bfhi(a.w)};
#pragma unroll
                            for (int e = 0; e < 8; ++e) x0[e] += af[e] * w0[e]; } }
                    float z[8];
#pragma unroll
                    for (int e = 0; e < 8; ++e) z[e] = x0[e] * bf2f(T[(cc + e) * 72 + sr]);
                    u32x4 o; o.x = pk2(z[0], z[1]); o.y = pk2(z[2], z[3]); o.z = pk2(z[4], z[5]); o.w = pk2(z[6], z[7]);
                    *(u32x4*)(hA + (size_t)(rowb + s) * D + c0 + cc) = o;
                }
            }
            SEAM(pb + 3);
            if (EN_GEMM && IN(pb + 4)) {
                EpiResid E{resL, resC, out, ctxbuf, mo + 2 * D, args.in[I_HBOUT] + (size_t)jm * D};
                const bf16_t* Wt = Wout_t + (size_t)jm * D * D;
                const DenseSched S{hA, Wt, nrows / 256, 4, G, bid};
                run_gemm(lds, S, E);
            }
            SEAM(pb + 4);
        }

        gu32* cnt = ctl + CW_CNT + layer * 32 * 64;
        if (EN_ROUTER && IN(pb + 5)) {
            LAS float* WrT = (LAS float*)lds;
            __syncthreads();
            { const float* rw = args.in[I_RW] + (size_t)layer * D * NE;
              for (int i = tid; i < D * NE; i += NTHR) { const int k = i >> 5, e = i & 31; WrT[e * D + k] = rw[i]; } }
            __syncthreads();
            const float* rb = args.in[I_RB] + layer * NE; const float* g2 = args.in[I_N2G] + layer * D;
            for (int r = gw; r < nrows; r += NGW) {
                const float* src = r < NLAT ? out + (size_t)r * D : ctxbuf + (size_t)(r - NLAT) * D;
                f32x4 v[4], h[4];
#pragma unroll
                for (int j = 0; j < 4; ++j) v[j] = ((const f32x4*)src)[lane + 64 * j];
                const float* mr = mo + (size_t)mod_row(r) * MODW;
                norm_mod_store(v, g2, mr + 3 * D, mr + 4 * D, hA + (size_t)r * D, lane, h);
                float p[32];
                asm volatile("" ::: "memory");
#pragma unroll
                for (int e = 0; e < 32; ++e) { float a = 0.f; if ((e & 3) == 0) asm volatile("" ::: "memory");
#pragma unroll
                    for (int j = 0; j < 4; ++j) { const f32x4 w = *(const LAS f32x4*)(WrT + e * D + 256 * j + 4 * lane); a += (h[j][0] * w[0] + h[j][1] * w[1]) + (h[j][2] * w[2] + h[j][3] * w[3]); }
                    p[e] = a; }
#pragma unroll
                for (int i = 0; i < 16; ++i) { const bool up = (lane & 32) != 0; const float send = up ? p[i] : p[i + 16], keep = up ? p[i + 16] : p[i]; p[i] = keep + __shfl_xor(send, 32); }
#pragma unroll
                for (int i = 0; i < 8; ++i) { const bool up = (lane & 16) != 0; const float send = up ? p[i] : p[i + 8], keep = up ? p[i + 8] : p[i]; p[i] = keep + __shfl_xor(send, 16); }
#pragma unroll
                for (int i = 0; i < 4; ++i) { const bool up = (lane & 8) != 0; const float send = up ? p[i] : p[i + 4], keep = up ? p[i + 4] : p[i]; p[i] = keep + __shfl_xor(send, 8); }
#pragma unroll
                for (int i = 0; i < 2; ++i) { const bool up = (lane & 4) != 0; const float send = up ? p[i] : p[i + 2], keep = up ? p[i + 2] : p[i]; p[i] = keep + __shfl_xor(send, 4); }
                { const bool up = (lane & 2) != 0; const float send = up ? p[0] : p[1], keep = up ? p[1] : p[0]; p[0] = keep + __shfl_xor(send, 2); }
                p[0] += __shfl_xor(p[0], 1);
                const int myE = lane >> 1;
                float val = p[0] + rb[myE];
                float sv[4]; int si[4];
#pragma unroll
                for (int k = 0; k < 4; ++k) { float bv = val; int bi = myE;
#pragma unroll
                    for (int off = 1; off < 64; off <<= 1) { const float ov = __shfl_xor(bv, off); const int oi = __shfl_xor(bi, off); if (ov > bv || (ov == bv && oi < bi)) { bv = ov; bi = oi; } }
                    sv[k] = bv; si[k] = bi; if (myE == bi) val = -INFINITY; }
                const float e1 = __expf(sv[1] - sv[0]), e2 = __expf(sv[2] - sv[0]), e3 = __expf(sv[3] - sv[0]); const float inv = 1.0f / (1.0f + e1 + e2 + e3);
                if (lane < 4) { const int e = lane == 0 ? si[0] : (lane == 1 ? si[1] : (lane == 2 ? si[2] : si[3])); const float gt = (lane == 0 ? 1.0f : (lane == 1 ? e1 : (lane == 2 ? e2 : e3))) * inv;
                    const unsigned pos = __hip_atomic_fetch_add(cnt + e * 64, 1u, RLX_AGENT);
                    top_e[r * 4 + lane] = e; ppos[r * 4 + lane] = (int)pos; pgate[r * 4 + lane] = gt; }
            }
        }
        SEAM(pb + 5);
        LAS int* PADS = (LAS int*)(lds + LDS_BYTES - 4096);
        LAS unsigned char* TE = (LAS unsigned char*)(PADS + 128);
        if (IN(pb + 6) || IN(pb + 7) || IN(pb + 8) || IN(pb + 9)) {
            __syncthreads();
            if (tid < 32) PADS[64 + tid] = (int)__hip_atomic_load(cnt + tid * 64, RLX_AGENT);
            __syncthreads();
            if (tid == 0) { int a = 0; for (int e = 0; e < 32; ++e) { PADS[e] = a; const int nt = (PADS[64 + e] + 255) >> 8; for (int t = 0; t < nt; ++t) TE[(a >> 8) + t] = (unsigned char)e; a += nt * 256; } PADS[32] = a; }
            __syncthreads();
        }
        if (EN_MISC && IN(pb + 6)) {
            for (int pr = gw; pr < nrows * 4; pr += NGW) {
                const int e = top_e[pr], dest = PADS[e] + ppos[pr]; if (lane == 0) pdest[pr] = dest;
                const u32x4* s = (const u32x4*)(hA + (size_t)(pr >> 2) * D); u32x4* d = (u32x4*)(XS + (size_t)dest * D);
                d[lane] = s[lane]; d[lane + 64] = s[lane + 64];
            }
            for (int e = 0; e < 32; ++e) { const int c0 = PADS[e] + PADS[64 + e], c1 = PADS[e + 1];
                for (int rr = c0 + gw; rr < c1; rr += NGW) { u32x4* d = (u32x4*)(XS + (size_t)rr * D); d[lane] = (u32x4){0u, 0u, 0u, 0u}; d[lane + 64] = (u32x4){0u, 0u, 0u, 0u}; } }
        }
        SEAM(pb + 6);
        if (EN_GEMM && IN(pb + 7)) {
            const int ntile = PADS[32] >> 8;
            const MoeSched S{XS, Wgu_t + (size_t)layer * NE * NGU * D, TE, ntile, 8, NGU, G, bid};
            const EpiSwiglu E{AB, args.in[I_BGU] + (size_t)layer * NE * NGU};
            run_gemm(lds, S, E);
        }
        SEAM(pb + 7);
        if (EN_GEMM && IN(pb + 8)) {
            const int ntile = PADS[32] >> 8;
            const MoeSched S{AB, Wdn_t + (size_t)layer * NE * D * D, TE, ntile, 4, D, G, bid};
            const EpiBiasBf16 E{XS, D, args.in[I_BDN] + (size_t)layer * NE * D, D};
            run_gemm(lds, S, E);
        }
        SEAM(pb + 8);
        if (EN_MISC && IN(pb + 9)) {
            const bool has_next = layer + 1 < DEPTH;
            const float* mo_n = modf + (size_t)(layer + 1) * NMODROW * MODW; const float* g1n = args.in[I_N1G] + (has_next ? (layer + 1) * D : 0);
            const int nnext = (layer + 1 < 3) ? NTOK : NLAT;
            for (int r = gw; r < nrows; r += NGW) {
                float* xr = r < NLAT ? out + (size_t)r * D : ctxbuf + (size_t)(r - NLAT) * D;
                const float* mr = mo + (size_t)mod_row(r) * MODW + 5 * D;
                f32x4 y[4];
#pragma unroll
                for (int j = 0; j < 4; ++j) y[j] = (f32x4){0.f, 0.f, 0.f, 0.f};
#pragma unroll
                for (int k = 0; k < 4; ++k) { const int dest = pdest[r * 4 + k]; const float gt = pgate[r * 4 + k]; const u32x2* yr = (const u32x2*)(XS + (size_t)dest * D);
#pragma unroll
                    for (int j = 0; j < 4; ++j) { const u32x2 w = yr[lane + 64 * j]; y[j][0] += gt * bflo(w.x); y[j][1] += gt * bfhi(w.x); y[j][2] += gt * bflo(w.y); y[j][3] += gt * bfhi(w.y); } }
                f32x4 v[4], h[4];
#pragma unroll
                for (int j = 0; j < 4; ++j) { const f32x4 g = ((const f32x4*)mr)[lane + 64 * j]; v[j] = ((const f32x4*)xr)[lane + 64 * j] + g * y[j]; ((f32x4*)xr)[lane + 64 * j] = v[j]; }
                if (has_next && r < nnext) { const float* mn = mo_n + (size_t)mod_row(r) * MODW; norm_mod_store(v, g1n, mn, mn + D, hA + (size_t)r * D, lane, h); }
            }
        }
        SEAM(pb + 9);
}

__global__ void __launch_bounds__(NTHR, 2) fwd(Args args) {
    extern __shared__ __attribute__((aligned(16))) unsigned char lds_raw[];
    LAS unsigned char* lds = (LAS unsigned char*)lds_raw;
    const int tid = threadIdx.x, lane = tid & 63, wave = __builtin_amdgcn_readfirstlane(tid >> 6);
    const int G = gridDim.x, bid = blockIdx.x;
    const int gw = bid * NWAVES + wave, NGW = G * NWAVES;
    unsigned char* ws = args.ws;
    gu32* ctl = (gu32*)(ws + WS_CTL);
    volatile LAS unsigned* MISC = (volatile LAS unsigned*)(lds + MISC_OFF);
    if (tid < 64) MISC[tid] = 0u;
    __syncthreads();
    XcdBarrier bar; bar.bar = (unsigned*)ctl + CW_BAR; bar.x = 0; bar.st = MISC + 8;
    const int lo = args.ph_lo, hi = args.ph_hi;
    if (hi - lo > 1) bar = xcd_barrier_post((unsigned*)ctl + CW_BAR, MISC + 8);

    KLOCALS

    if (EN_PRO && IN(0)) {
        {
            LAS float* scr = (LAS float*)(lds + wave * 8448);
            constexpr int IT_QKV = 16 * (NQKV / 32), IT_SQ = 16 * (D / 32), IT_IN = 16 * (NHY / 32), IT_GU = 16 * (NGU / 32);
            constexpr int N0 = 2 * IT_QKV, N1 = N0 + 2 * IT_SQ, N2 = N1 + 2 * IT_IN, N3 = N2 + 2 * IT_SQ, N4 = N3 + 128 * IT_GU, N5 = N4 + 128 * IT_SQ;
            for (int it = gw; it < N5; it += NGW) {
                if (it < N0) { const int mtx = it / IT_QKV, r = it % IT_QKV; transpose_item<1>(args.in[I_WQKV] + (size_t)mtx * D * NQKV, NQKV, Wqkv_t + (size_t)mtx * NQKV * D, scr, r, lane); }
                else if (it < N1) { const int q = it - N0, mtx = q / IT_SQ, r = q % IT_SQ; transpose_item<0>(args.in[I_WO] + (size_t)mtx * D * D, D, Wo_t + (size_t)mtx * D * D, scr, r, lane); }
                else if (it < N2) { const int q = it - N1, mtx = q / IT_IN, r = q % IT_IN; transpose_item<0>(args.in[I_HWIN] + (size_t)mtx * D * NHY, NHY, Win_t + (size_t)mtx * NHY * D, scr, r, lane); }
                else if (it < N3) { const int q = it - N2, mtx = q / IT_SQ, r = q % IT_SQ; transpose_item<0>(args.in[I_HWOUT] + (size_t)mtx * D * D, D, Wout_t + (size_t)mtx * D * D, scr, r, lane); }
                else if (it < N4) { const int q = it - N3, mtx = q / IT_GU, r = q % IT_GU; transpose_item<2>(args.in[I_WGU] + (size_t)mtx * D * NGU, NGU, Wgu_t + (size_t)mtx * NGU * D, scr, r, lane); }
                else { const int q = it - N4, mtx = q / IT_SQ, r = q % IT_SQ; transpose_item<0>(args.in[I_WDN] + (size_t)mtx * D * D, D, Wdn_t + (size_t)mtx * D * D, scr, r, lane); }
            }
        }
        __syncthreads();
        {
            LAS float* S = (LAS float*)lds;
            for (int u = bid; u < 4 * 12 * 8; u += G) {
                const int kc = u & 7, cc = (u >> 3) % 12, layer = u / 96;
                __syncthreads();
                for (int i = tid; i < 128 * 20; i += NTHR) { const int k = i / 20, r = i % 20; float v = 0.f;
                    if (r < NMODROW) { const float cv = r < NB ? c_in[r * D + kc * 128 + k] : cctx_in[kc * 128 + k]; v = cv / (1.0f + __expf(-cv)); }
                    S[i] = v; }
                __syncthreads();
                const int col = cc * 512 + tid;
                const float* wp = args.in[I_WMOD] + ((size_t)layer * D + kc * 128) * MODW + col;
                float acc[20];
#pragma unroll
                for (int r = 0; r < 20; ++r) acc[r] = 0.f;
                for (int k = 0; k < 128; ++k) { const float w = wp[(size_t)k * MODW];
#pragma unroll
                    for (int q = 0; q < 5; ++q) { const f32x4 s = *(const LAS f32x4*)(S + k * 20 + 4 * q);
                        acc[4 * q] += s[0] * w; acc[4 * q + 1] += s[1] * w; acc[4 * q + 2] += s[2] * w; acc[4 * q + 3] += s[3] * w; } }
#pragma unroll
                for (int r = 0; r < NMODROW; ++r) modp[((size_t)(kc * 4 + layer) * NMODROW + r) * MODW + col] = acc[r];
            }
        }
        for (int i = bid * NTHR + tid; i < SEQ * 32; i += G * NTHR) {
            const int t = i >> 5, j = i & 31, fi = j & 15; const int pos = (j >> 4) == 0 ? (t >> 6) : (t & 63);
            const float inv = powf(10000.0f, -(float)fi / 16.0f); const float ang = (float)pos * inv;
            cosT[i] = cosf(ang); sinT[i] = sinf(ang);
        }
        {
            __syncthreads();
            LAS float* Z = (LAS float*)lds;
            LAS float* A1 = Z + 8 * 36;
            for (int u = bid; u < 256 + 256 + 32; u += G) {
                const int combo = u < 256 ? 0 : (u < 512 ? 1 : 2); const int ub = combo == 0 ? u : (combo == 1 ? u - 256 : u - 512);
                const int j = combo == 1 ? 1 : 0, Lf = combo == 2 ? CL : SEQ;
                const int tl = tid >> 6, o = tid & 63, t = ub * 8 + tl;
                __syncthreads();
                if (o < 33) { float z;
                    const float tt = (float)t / (float)(Lf - 1), w = 6.283185307179586f * (float)t / (float)Lf;
                    if (o == 0) z = tt; else { const int b = (o - 1) & 15; const float f = 1e-4f + (float)b * ((15.0f - 1e-4f) / 15.0f); z = o <= 16 ? cosf(f * w) : -sinf(f * w); }
                    Z[tl * 36 + o] = z; }
                __syncthreads();
                const float sf = args.in[I_HSF][j * 64 + o];
                { const float* w1 = args.in[I_HW1] + (size_t)j * 33 * 64; float a = args.in[I_HB1][j * 64 + o];
                  for (int i = 0; i < 33; ++i) a += Z[tl * 36 + i] * w1[i * 64 + o];
                  A1[tl * 64 + o] = sinf(sf * a); }
                __syncthreads();
                { const float* w2 = args.in[I_HW2] + (size_t)j * 64 * 64; float a = args.in[I_HB2][j * 64 + o];
                  for (int i = 0; i < 64; ++i) a += A1[tl * 64 + i] * w2[i * 64 + o];
                  a2tab[((size_t)combo * SEQ + t) * 64 + o] = sinf(sf * a); }
            }
        }
    }
    SEAM(0);

    if (EN_PRO && IN(1)) {
        for (int i = bid * NTHR + tid; i < DEPTH * NMODROW * MODW; i += G * NTHR) {
            const int layer = i / (NMODROW * MODW), rem = i % (NMODROW * MODW), col = rem % MODW; float s = args.in[I_BMOD][layer * MODW + col];
#pragma unroll
            for (int kc = 0; kc < 8; ++kc) s += modp[(size_t)(kc * 4 + layer) * NMODROW * MODW + rem];
            modf[i] = s;
        }
        {
            LAS float* W3 = (LAS float*)lds;
            LAS float* RED = W3 + 512;
            LAS float* NRM = RED + 32;
            LAS float* HF = NRM + 4;
            for (int u = bid; u < 3 * 256; u += G) {
                const int combo = u >> 8, cg = u & 255; const int j = combo == 1 ? 1 : 0, Lf = combo == 2 ? CL : SEQ; const int c0 = cg * 4;
                LAS float* HB = HF + 4 * Lf;
                __syncthreads();
                { const int i = tid >> 3, q = tid & 7; const int col = (q >> 2) * 1024 + c0 + (q & 3);
                  W3[i * 8 + q] = args.in[I_HW3][((size_t)j * 64 + i) * 2048 + col]; }
                __syncthreads();
                float b3v[8], dec[4], asum[4] = {0.f, 0.f, 0.f, 0.f};
#pragma unroll
                for (int q = 0; q < 8; ++q) b3v[q] = args.in[I_HB3][j * 2048 + (q >> 2) * 1024 + c0 + (q & 3)];
#pragma unroll
                for (int ch = 0; ch < 4; ++ch) dec[ch] = 3.0701134573253945f + (float)(c0 + ch) * ((15.350567286626972f - 3.0701134573253945f) / 1023.0f);
                for (int t = tid; t < Lf; t += NTHR) {
                    asm volatile("" ::: "memory");
                    const float* ar = a2tab + ((size_t)combo * SEQ + t) * 64; float d[8];
#pragma unroll
                    for (int q = 0; q < 8; ++q) d[q] = b3v[q];
#pragma unroll
                    for (int i4 = 0; i4 < 16; ++i4) { const f32x4 a = *(const f32x4*)(ar + 4 * i4); asm volatile("" ::: "memory");
#pragma unroll
                        for (int e = 0; e < 4; ++e) { const f32x4 w0 = *(const LAS f32x4*)(W3 + (4 * i4 + e) * 8), w1 = *(const LAS f32x4*)(W3 + (4 * i4 + e) * 8 + 4);
                            d[0] += a[e] * w0[0]; d[1] += a[e] * w0[1]; d[2] += a[e] * w0[2]; d[3] += a[e] * w0[3]; d[4] += a[e] * w1[0]; d[5] += a[e] * w1[1]; d[6] += a[e] * w1[2]; d[7] += a[e] * w1[3]; } }
                    const float tt = (float)t / (float)(Lf - 1);
#pragma unroll
                    for (int ch = 0; ch < 4; ++ch) { const float dk = __expf(-tt * dec[ch]); const float f = d[ch] * dk, bb = d[4 + ch] * dk;
                        HF[ch * Lf + t] = f; HB[ch * Lf + t] = bb; asum[ch] += fabsf(f) + (t >= 1 ? fabsf(bb) : 0.f); }
                }
#pragma unroll
                for (int ch = 0; ch < 4; ++ch) { const float s = wave_sum(asum[ch]); if (lane == 0) RED[wave * 4 + ch] = s; }
                __syncthreads();
                if (tid < 4) { float s = 0.f; for (int w = 0; w < 8; ++w) s += RED[w * 4 + tid]; NRM[tid] = 1.0f / (s + EPS); }
                __syncthreads();
                const int P = 2 * Lf + 8, PC8 = P / 8;
                bf16_t* FI = (bf16_t*)(ws + (combo == 0 ? WS_FI0 : (combo == 1 ? WS_FI1 : WS_FI2)));
                for (int q = tid; q < 4 * 8 * PC8; q += NTHR) {
                    const int ch = q / (8 * PC8), r = q % (8 * PC8), cidx = r / PC8, x0 = (r % PC8) * 8;
                    const float nr = NRM[ch], db = args.in[I_HDB][j * 1024 + c0 + ch]; float v[8];
#pragma unroll
                    for (int e = 0; e < 8; ++e) { const int m = Lf - (x0 + e) + cidx; const int am = m < 0 ? -m : m; float g = 0.f;
                        if (am <= Lf - 1) { g = (m >= 0 ? HF[ch * Lf + am] : HB[ch * Lf + am]) * nr; if (m == 0) g += db; }
                        v[e] = g; }
                    u32x4 o; o.x = pk2(v[0], v[1]); o.y = pk2(v[2], v[3]); o.z = pk2(v[4], v[5]); o.w = pk2(v[6], v[7]);
                    *(u32x4*)(FI + ((size_t)((c0 + ch) * 8 + cidx)) * P + x0) = o;
                }
            }
        }
    }
    SEAM(1);

    if (IN(2)) {
        const float* mo = modf;
        for (int r = gw; r < NTOK; r += NGW) {
            const float* src = r < NLAT ? x_in + (size_t)r * D : ctx_in + (size_t)(r - NLAT) * D;
            f32x4 v[4], h[4];
#pragma unroll
            for (int j = 0; j < 4; ++j) v[j] = ((const f32x4*)src)[lane + 64 * j];
            const float* mr = mo + (size_t)mod_row(r) * MODW;
            norm_mod_store(v, args.in[I_N1G], mr, mr + D, hA + (size_t)r * D, lane, h);
        }
    }
    SEAM(2);

    layer_body<0>(args, lds, bar, tid, lane, wave, G, bid, lo, hi);
    layer_body<1>(args, lds, bar, tid, lane, wave, G, bid, lo, hi);
    layer_body<2>(args, lds, bar, tid, lane, wave, G, bid, lo, hi);
    layer_body<3>(args, lds, bar, tid, lane, wave, G, bid, lo, hi);
#undef IN
#undef SEAM
}

extern "C" void kernel_launch(void* const* d_in, const int* in_sizes, int n_in, void* d_out, int out_size, void* d_ws, size_t ws_size, hipStream_t stream) {
    static int grid = 0;
    if (grid == 0) {
        if (n_in != 32 || out_size != NLAT * D || ws_size < WS_END) { fprintf(stderr, "kernel_launch: unexpected problem (n_in %d, out %d, ws %zu)\n", n_in, out_size, ws_size); grid = -1; return; }
        int dev = 0, cus = 0, per_cu = 0;
        if (hipGetDevice(&dev) != hipSuccess || hipDeviceGetAttribute(&cus, hipDeviceAttributeMultiprocessorCount, dev) != hipSuccess) { grid = -1; return; }
        if (hipFuncSetAttribute((const void*)fwd, hipFuncAttributeMaxDynamicSharedMemorySize, LDS_BYTES) != hipSuccess) { fprintf(stderr, "kernel_launch: hipFuncSetAttribute failed\n"); grid = -1; return; }
        if (hipOccupancyMaxActiveBlocksPerMultiprocessor(&per_cu, (const void*)fwd, NTHR, LDS_BYTES) != hipSuccess || per_cu < 1) fprintf(stderr, "kernel_launch: occupancy query says %d\n", per_cu);
        (void)hipGetLastError();
        grid = cus;
    }
    if (grid < 0) return;
    (void)hipMemsetAsync((char*)d_ws + WS_CTL, 0, CTL_ZERO_BYTES, stream);
    Args a{};
    for (int i = 0; i < 32; ++i) a.in[i] = (const float*)d_in[i];
    a.out = (float*)d_out; a.ws = (unsigned char*)d_ws;
    constexpr int NPH = 3 + 10 * DEPTH;
#if MK_ONE_LAUNCH
    a.ph_lo = 0; a.ph_hi = NPH;
    hipLaunchKernelGGL(fwd, dim3(grid), dim3(NTHR), LDS_BYTES, stream, a);
#else
    for (int p = 0; p < NPH; ++p) {
        if (p >= 3) { const int layer = (p - 3) / 10, loc = (p - 3) % 10; if ((layer & 1) == 0 && (loc == 3 || loc == 4)) continue; }
        a.ph_lo = p; a.ph_hi = p + 1;
        hipLaunchKernelGGL(fwd, dim3(grid), dim3(NTHR), LDS_BYTES, stream, a);
    }
#endif
}
```

```cpp
#include <hip/hip_runtime.h>
#include <cstdio>
#include <cstdint>
#include <cmath>
#include <hip/hip_bf16.h>

#ifndef EN_PRO
#define EN_PRO 1
#endif
#ifndef EN_ATT
#define EN_ATT 1
#endif
#ifndef EN_CONV
#define EN_CONV 1
#endif
#ifndef EN_ROUTER
#define EN_ROUTER 1
#endif
#ifndef EN_GEMM
#define EN_GEMM 1
#endif
#ifndef EN_MISC
#define EN_MISC 1
#endif
#ifndef MK_ONE_LAUNCH
#define MK_ONE_LAUNCH 1
#endif

#define GAS __attribute__((address_space(1)))
#define LAS __attribute__((address_space(3)))
typedef unsigned short bf16_t;
typedef short bf16x8 __attribute__((ext_vector_type(8)));
typedef float f32x4 __attribute__((ext_vector_type(4)));
typedef float f32x2 __attribute__((ext_vector_type(2)));
typedef unsigned u32x4 __attribute__((ext_vector_type(4)));
typedef unsigned u32x2 __attribute__((ext_vector_type(2)));
typedef GAS unsigned gu32;
typedef float f32x16 __attribute__((ext_vector_type(16)));

constexpr int D = 1024, NB = 16, SEQ = 2048, CL = 256, KVL = SEQ + CL;
constexpr int NLAT = NB * SEQ, NCTX = NB * CL, NTOK = NLAT + NCTX;
constexpr int NE = 32, TOPK = 4, DEPTH = 4;
constexpr int MODW = 6 * D, NMODROW = NB + 1;
constexpr int NQKV = 1536, NHY = 3072, NGU = 2048;
constexpr float EPS = 1e-6f;
constexpr float C2 = 0.125f * 1.4426950408889634f;
constexpr int NWAVES = 8, NTHR = 512;
constexpr int NPADROWS = 155648;
constexpr int MAXTILES = NPADROWS / 256;

constexpr size_t MiB = 1u << 20;
constexpr size_t WS_CTL = 0, CTL_ZERO_BYTES = 1 * MiB;
constexpr size_t WS_MODP = 2 * MiB;
constexpr size_t WS_MOD = 16 * MiB;
constexpr size_t WS_ROPE = 18 * MiB;
constexpr size_t WS_A2 = 19 * MiB;
constexpr size_t WS_PAIR = 21 * MiB;
constexpr size_t WS_CTX = 24 * MiB;
constexpr size_t WS_FI = 40 * MiB;
constexpr int FP_L = 2 * SEQ + 8, FP_C = 2 * CL + 8;
constexpr size_t FI_L_BYTES = (size_t)1024 * 8 * FP_L * 2, FI_C_BYTES = (size_t)1024 * 8 * FP_C * 2;
constexpr size_t WS_FI0 = WS_FI, WS_FI1 = WS_FI0 + 65 * MiB, WS_FI2 = WS_FI1 + 65 * MiB;
static_assert(FI_L_BYTES <= 65 * MiB && WS_FI2 + FI_C_BYTES <= 180 * MiB, "filter map");
constexpr size_t WS_WQKV = 180 * MiB, WS_WO = 186 * MiB, WS_WIN = 190 * MiB, WS_WOUT = 202 * MiB, WS_WGU = 206 * MiB, WS_WDN = 718 * MiB;
constexpr size_t WS_HA = 974 * MiB;
constexpr size_t WS_Q = 1046 * MiB;
constexpr size_t WS_K = 1118 * MiB, WS_V = 1136 * MiB;
constexpr size_t WS_UPRE = 1154 * MiB;
constexpr size_t WS_WC = 1370 * MiB;
constexpr size_t WS_YC = 1442 * MiB;
constexpr size_t WS_XS = 1514 * MiB;
constexpr size_t WS_AB = 1818 * MiB;
constexpr size_t WS_ELIST = 2122 * MiB;
constexpr size_t WS_END = 2128 * MiB;
constexpr size_t WC_CTX_OFF = (size_t)1024 * 16 * 2048;
constexpr int CW_TMO = 0, CW_BAR = 4096, CW_CNT = 16384;

constexpr int LDS_BYTES = 160 * 1024;
constexpr int MISC_OFF = LDS_BYTES - 256;

#define RLX_AGENT __ATOMIC_RELAXED, __HIP_MEMORY_SCOPE_AGENT
#define LDS_WAIT() asm volatile("s_waitcnt lgkmcnt(0)" ::: "memory")
#define VM_WAIT() asm volatile("s_waitcnt vmcnt(0)" ::: "memory")
__device__ __forceinline__ unsigned f2bf(float f) { unsigned u = __builtin_bit_cast(unsigned, f); return (u + 0x7fffu + ((u >> 16) & 1u)) >> 16; }
typedef __bf16 bf16x2_t __attribute__((ext_vector_type(2)));
__device__ __forceinline__ unsigned pk2(float lo, float hi) { const f32x2 v = {lo, hi}; const bf16x2_t b = __builtin_convertvector(v, bf16x2_t); return __builtin_bit_cast(unsigned, b); }
__device__ __forceinline__ float bf2f(unsigned h) { return __builtin_bit_cast(float, h << 16); }
__device__ __forceinline__ float bflo(unsigned w) { return __builtin_bit_cast(float, w << 16); }
__device__ __forceinline__ float bfhi(unsigned w) { return __builtin_bit_cast(float, w & 0xffff0000u); }
__device__ __forceinline__ float wave_sum(float v) {
#pragma unroll
    for (int o = 1; o < 64; o <<= 1) v += __shfl_xor(v, o);
    return v;
}

#define XB_TMO      128
#define XB_XCNT(j)  (256  + 64 * (j))
#define XB_XSUB(j)  (1280 + 64 * (j))
#define XB_XGEN(j)  (2304 + 64 * (j))
#define XB_TOP      3328
#define XB_TOPGEN   3392
#define XCD_BAR_WORDS 3456
#define XB_SPIN_CAP (1u << 22)
__device__ __forceinline__ unsigned xb_ld(unsigned* p)              { return __hip_atomic_load(p, __ATOMIC_RELAXED, __HIP_MEMORY_SCOPE_AGENT); }
__device__ __forceinline__ unsigned xb_add(unsigned* p, unsigned v) { return __hip_atomic_fetch_add(p, v, __ATOMIC_RELAXED, __HIP_MEMORY_SCOPE_AGENT); }
__device__ __forceinline__ unsigned xb_xcc_id() { return (unsigned)__builtin_amdgcn_s_getreg((3 << 11) | 20) & 0xFu; }
#define XB_SPIN(cond, bar) do { unsigned _sp = 0; while (cond) { __builtin_amdgcn_s_sleep(1); \
    if ((++_sp & 255u) == 0u) { if (xb_ld(&(bar)[XB_TMO])) break; if (_sp > XB_SPIN_CAP) { atomicAdd(&(bar)[XB_TMO], 1u); break; } } } } while (0)
struct XcdBarrier { unsigned* bar; unsigned x; volatile LAS unsigned* st; };
__device__ __forceinline__ XcdBarrier xcd_barrier_post(unsigned* bar, volatile LAS unsigned* st) {
    XcdBarrier b; b.bar = bar; b.x = xb_xcc_id(); b.st = st;
    if (threadIdx.x == 0) (void)xb_add(&bar[XB_XCNT(b.x)], 1u);
    return b;
}
__device__ __forceinline__ void xcd_barrier_complete(unsigned* bar, unsigned x, unsigned& nloc, unsigned& nx) {
    const unsigned G = gridDim.x * gridDim.y * gridDim.z;
    unsigned sum, cnt, mine, sp = 0u;
    for (;;) {
        sum = 0u; cnt = 0u; mine = 0u;
#pragma unroll
        for (unsigned j = 0; j < 16; ++j) { const unsigned c = xb_ld(&bar[XB_XCNT(j)]); sum += c; cnt += (c > 0u) ? 1u : 0u; mine = (j == x) ? c : mine; }
        if (sum == G) break;
        __builtin_amdgcn_s_sleep(1);
        if ((++sp & 255u) == 0u) { if (xb_ld(&bar[XB_TMO])) break; if (sp > XB_SPIN_CAP) { atomicAdd(&bar[XB_TMO], 1u); break; } }
    }
    nloc = mine > 0u ? mine : 1u; nx = cnt > 0u ? cnt : 1u;
}
__device__ __forceinline__ void xcd_barrier(const XcdBarrier& b) {
    asm volatile("s_waitcnt vmcnt(0)" ::: "memory");
    __syncthreads();
    if (threadIdx.x == 0) {
        unsigned* bar = b.bar;
        __builtin_amdgcn_s_waitcnt(0);
        unsigned nloc = b.st[0], nx = b.st[1];
        if (nloc == 0u) { xcd_barrier_complete(bar, b.x, nloc, nx); b.st[0] = nloc; b.st[1] = nx; }
        const unsigned old = xb_add(&bar[XB_XSUB(b.x)], 1u);
        const unsigned gen = old / nloc;
        if (old + 1u == (gen + 1u) * nloc) {
            __builtin_amdgcn_fence(__ATOMIC_RELEASE, "agent");
            asm volatile("s_waitcnt vmcnt(0)" ::: "memory");
            const unsigned og = xb_add(&bar[XB_TOP], 1u);
            const unsigned tg = og / nx;
            if (og + 1u == (tg + 1u) * nx) xb_add(&bar[XB_TOPGEN], 1u);
            else XB_SPIN(xb_ld(&bar[XB_TOPGEN]) == tg, bar);
            __builtin_amdgcn_fence(__ATOMIC_ACQUIRE, "agent");
            xb_add(&bar[XB_XGEN(b.x)], 1u);
            asm volatile("s_waitcnt vmcnt(0)" ::: "memory");
        } else {
            XB_SPIN(xb_ld(&bar[XB_XGEN(b.x)]) == gen, bar);
            __builtin_amdgcn_fence(__ATOMIC_ACQUIRE, "agent");
            asm volatile("s_waitcnt vmcnt(0)" ::: "memory");
        }
    }
    __syncthreads();
}

struct Args { const float* in[32]; float* out; unsigned char* ws; int ph_lo, ph_hi; };
struct Ctx {
    LAS unsigned char* lds;
    int tid, lane, wave, G, bid;
    const float* const* in;
};
enum { I_X = 0, I_C, I_CTX, I_CCTX, I_WMOD, I_BMOD, I_N1G, I_N2G, I_WQKV, I_QG, I_KG, I_WO, I_HWIN, I_HBIN, I_HCW, I_HCB, I_HW1, I_HB1, I_HW2, I_HB2, I_HW3, I_HB3,
       I_HSF, I_HDB, I_HWOUT, I_HBOUT, I_RW, I_RB, I_WGU, I_BGU, I_WDN, I_BDN };

__device__ __forceinline__ int mod_row(int r) { return r < NLAT ? (r >> 11) : NB; }

__device__ __forceinline__ void gemm_unit_simple(const bf16_t* At, const bf16_t* Bt, f32x4 (&acc)[2][2][4][2], int wr, int wc, int fr, int fq) {
    constexpr int K = D;
#pragma unroll
    for (int a = 0; a < 2; ++a)
#pragma unroll
        for (int b = 0; b < 2; ++b)
#pragma unroll
            for (int m = 0; m < 4; ++m)
#pragma unroll
                for (int n = 0; n < 2; ++n) acc[a][b][m][n] = (f32x4){0.f, 0.f, 0.f, 0.f};
    const bf16_t* ap = At + (size_t)(wr * 64 + fr) * K + fq * 8;
    const bf16_t* bp = Bt + (size_t)(wc * 32 + fr) * K + fq * 8;
    for (int k0 = 0; k0 < K; k0 += 32) {
        bf16x8 bfr[2][2];
#pragma unroll
        for (int bj = 0; bj < 2; ++bj)
#pragma unroll
            for (int n = 0; n < 2; ++n) bfr[bj][n] = *(const bf16x8*)(bp + (size_t)(bj * 128 + n * 16) * K + k0);
#pragma unroll
        for (int ai = 0; ai < 2; ++ai)
#pragma unroll
            for (int m = 0; m < 4; ++m) {
                const bf16x8 afr = *(const bf16x8*)(ap + (size_t)(ai * 128 + m * 16) * K + k0);
#pragma unroll
                for (int bj = 0; bj < 2; ++bj)
#pragma unroll
                    for (int n = 0; n < 2; ++n) acc[ai][bj][m][n] = __builtin_amdgcn_mfma_f32_16x16x32_bf16(bfr[bj][n], afr, acc[ai][bj][m][n], 0, 0, 0);
            }
    }
}


struct Unit { int pm, pn, e; };
namespace pg8 {
constexpr int BM = 256, BK = 64, HALF = 128, HTB = HALF * BK * 2, STAGE_BYTES = 8 * HTB;
__device__ __forceinline__ int lds_byte(int r, int c) { const int st = (r >> 4) * 2 + (c >> 5), rr = r & 15, cc = c & 31, ob = rr * 64 + cc * 2; return st * 1024 + (ob ^ (((ob >> 9) & 1) << 5)); }
__device__ __forceinline__ void stage_rc(int b, int& R, int& C) { const int st = b / 1024, sb = b % 1024, swz = sb ^ (((sb >> 9) & 1) << 5); R = (st >> 1) * 16 + swz / 64; C = (st & 1) * 32 + (swz % 64) / 2; }
template <class Epi, class Sched, bool GATHER = false>
__device__ __forceinline__ void gemm_phase(LAS unsigned char* lds, const Sched& S, const Epi& E) {
    constexpr int K = D, nt = K / BK;
    const int tid = threadIdx.x, wid = __builtin_amdgcn_readfirstlane(tid >> 6), lane = tid & 63, wr = wid >> 2, wc = wid & 3, fr = lane & 15, fq = lane >> 4;
    unsigned voffA[2];
#pragma unroll
    for (int i = 0; i < 2; ++i) { int R, C; stage_rc(tid * 16 + i * 8192, R, C); voffA[i] = (unsigned)(R * K + C) * 2u; }
    const size_t kstep = (size_t)(BK * 2);
    const size_t hstep = (size_t)HALF * K * 2;
    const unsigned ldsw = (unsigned)wid * 1024u;
    const int aoff = lds_byte(wr * 64 + fr, fq * 8), boff = lds_byte(wc * 32 + fr, fq * 8);
#define PG8_SA(b, h) (((b) * 2 + (h)) * HTB)
#define PG8_SB(b, h) ((4 + (b) * 2 + (h)) * HTB)
#define PG8_STAGE(bufoff, gbase, voff) do { _Pragma("unroll") for (int _i = 0; _i < 2; ++_i) \
        __builtin_amdgcn_global_load_lds((const unsigned*)((const char*)(gbase) + (voff)[_i]), (LAS unsigned*)(lds + (bufoff) + ldsw + _i * 8192), 16, 0, 0); } while (0)
#define PG8_LDA(dst, b, h) do { _Pragma("unroll") for (int m = 0; m < 4; ++m) _Pragma("unroll") for (int k = 0; k < 2; ++k) dst[m][k] = *(const LAS bf16x8*)(lds + PG8_SA(b, h) + aoff + m * 2048 + k * 1024); } while (0)
#define PG8_LDB(dst, b, h) do { _Pragma("unroll") for (int n = 0; n < 2; ++n) _Pragma("unroll") for (int k = 0; k < 2; ++k) dst[n][k] = *(const LAS bf16x8*)(lds + PG8_SB(b, h) + boff + n * 2048 + k * 1024); } while (0)
#define PG8_MMA(ai, bj, At, Bt) do { __builtin_amdgcn_s_setprio(1); _Pragma("unroll") for (int m = 0; m < 4; ++m) _Pragma("unroll") for (int n = 0; n < 2; ++n) _Pragma("unroll") for (int k = 0; k < 2; ++k) \
        acc[ai][bj][m][n] = __builtin_amdgcn_mfma_f32_16x16x32_bf16(Bt[n][k], At[m][k], acc[ai][bj][m][n], 0, 0, 0); __builtin_amdgcn_s_setprio(0); } while (0)
#define PG8_WAIT_V(n) asm volatile("s_waitcnt vmcnt(" #n ")" ::: "memory")
#define PG8_WAIT_L(n) asm volatile("s_waitcnt lgkmcnt(" #n ")" ::: "memory")
#define PG8_BAR __builtin_amdgcn_s_barrier()
#define PG8_SCHED __builtin_amdgcn_sched_barrier(0)
    unsigned vA[2][2], vN[2][2]; unsigned gR[2], gC[2];
    const char* gA = nullptr;
    if constexpr (GATHER) {
        gA = S.a_base();
#pragma unroll
        for (int i = 0; i < 2; ++i) { gR[i] = voffA[i] / (unsigned)(K * 2); gC[i] = voffA[i] % (unsigned)(K * 2); }
        const LAS int* rw = S.rows(0);
#pragma unroll
        for (int h = 0; h < 2; ++h)
#pragma unroll
            for (int i = 0; i < 2; ++i) { vA[h][i] = (unsigned)rw[h * HALF + gR[i]] * (unsigned)(K * 2) + gC[i]; vN[h][i] = vA[h][i]; }
    }
#define PG8_STAGEA(bufoff, P, V, kt, h) do { if constexpr (GATHER) PG8_STAGE(bufoff, gA + (size_t)(kt) * kstep, V[h]); else PG8_STAGE(bufoff, (P) + (size_t)(kt) * kstep + (size_t)(h) * hstep, voffA); } while (0)
    Unit cur, nxt; int ui = 0;
    if (!S.next(0, cur)) return;
    f32x4 acc[2][2][4][2];
#pragma unroll
    for (int a = 0; a < 2; ++a)
#pragma unroll
        for (int b = 0; b < 2; ++b)
#pragma unroll
            for (int m = 0; m < 4; ++m)
#pragma unroll
                for (int n = 0; n < 2; ++n) acc[a][b][m][n] = (f32x4){0.f, 0.f, 0.f, 0.f};
    bf16x8 At[4][2], B0[2][2], B1[2][2];
    const char* cA = nullptr; if constexpr (!GATHER) cA = S.a_ptr(cur);
    const char* cB = S.b_ptr(cur);
    PG8_STAGE(PG8_SB(0, 0), cB, voffA); PG8_STAGE(PG8_SB(0, 1), cB + hstep, voffA); PG8_STAGEA(PG8_SA(0, 0), cA, vA, 0, 0); PG8_STAGEA(PG8_SA(0, 1), cA, vA, 0, 1);
    if (wr == 1) PG8_BAR;
    PG8_WAIT_V(2); PG8_BAR;
    PG8_STAGE(PG8_SB(1, 0), cB + kstep, voffA); PG8_STAGEA(PG8_SA(1, 0), cA, vA, 1, 0); PG8_STAGE(PG8_SB(1, 1), cB + hstep + kstep, voffA);
    PG8_WAIT_V(6); PG8_BAR;
    for (;;) {
        const bool has_next = S.next(ui + 1, nxt);
        const char* nA = cA; if constexpr (!GATHER) { if (has_next) nA = S.a_ptr(nxt); }
        const char* nB = has_next ? S.b_ptr(nxt) : cB;
        if constexpr (GATHER) { if (has_next) { const LAS int* rw = S.rows(ui + 1);
#pragma unroll
            for (int h = 0; h < 2; ++h)
#pragma unroll
                for (int i = 0; i < 2; ++i) vN[h][i] = (unsigned)rw[h * HALF + gR[i]] * (unsigned)(K * 2) + gC[i]; } }
        for (int t = 0; t < nt; t += 2) {
            const bool last = (t == nt - 2);
            const char* b2 = last ? nB : cB + (size_t)(t + 2) * kstep; const char* b3 = b2 + kstep;
            const char* pX = last ? nA : cA; const int kX = last ? 0 : t + 2;
            unsigned vX[2][2];
#pragma unroll
            for (int h = 0; h < 2; ++h)
#pragma unroll
                for (int i = 0; i < 2; ++i) vX[h][i] = last ? vN[h][i] : vA[h][i];
            PG8_LDB(B0, 0, 0); PG8_LDB(B1, 0, 1); PG8_SCHED; PG8_LDA(At, 0, 0); PG8_STAGEA(PG8_SA(1, 1), cA, vA, t + 1, 1);
            PG8_WAIT_V(8); PG8_WAIT_L(0); PG8_BAR; PG8_MMA(0, 0, At, B0); PG8_MMA(0, 1, At, B1); PG8_BAR; PG8_SCHED;
            PG8_LDA(At, 0, 1); PG8_STAGE(PG8_SB(0, 0), b2, voffA); PG8_STAGE(PG8_SB(0, 1), b2 + hstep, voffA); PG8_STAGEA(PG8_SA(0, 0), pX, vX, kX, 0);
            PG8_WAIT_V(8); PG8_WAIT_L(0); PG8_BAR; PG8_MMA(1, 0, At, B0); PG8_MMA(1, 1, At, B1); PG8_BAR; PG8_SCHED;
            PG8_LDB(B0, 1, 0); PG8_LDB(B1, 1, 1); PG8_SCHED; PG8_LDA(At, 1, 0); PG8_STAGEA(PG8_SA(0, 1), pX, vX, kX, 1);
            PG8_WAIT_V(8); PG8_WAIT_L(0); PG8_BAR; PG8_MMA(0, 0, At, B0); PG8_MMA(0, 1, At, B1); PG8_BAR; PG8_SCHED;
            PG8_LDA(At, 1, 1); PG8_STAGE(PG8_SB(1, 0), b3, voffA); PG8_STAGE(PG8_SB(1, 1), b3 + hstep, voffA); PG8_STAGEA(PG8_SA(1, 0), pX, vX, kX + 1, 0);
            PG8_WAIT_V(8); PG8_WAIT_L(0); PG8_BAR; PG8_MMA(1, 0, At, B0); PG8_MMA(1, 1, At, B1); PG8_BAR; PG8_SCHED;
        }
        if (wr == 0) PG8_BAR;
        E(acc, cur, wr, wc, fr, fq);
        if (!has_next) break;
#pragma unroll
        for (int a = 0; a < 2; ++a)
#pragma unroll
            for (int b = 0; b < 2; ++b)
#pragma unroll
                for (int m = 0; m < 4; ++m)
#pragma unroll
                    for (int n = 0; n < 2; ++n) acc[a][b][m][n] = (f32x4){0.f, 0.f, 0.f, 0.f};
        cur = nxt; cA = nA; cB = nB; ++ui;
        if constexpr (GATHER) {
#pragma unroll
            for (int h = 0; h < 2; ++h)
#pragma unroll
                for (int i = 0; i < 2; ++i) vA[h][i] = vN[h][i]; }
        if (wr == 1) PG8_BAR;
    }
    PG8_WAIT_V(0);
    PG8_BAR;
#undef PG8_SA
#undef PG8_SB
#undef PG8_STAGE
#undef PG8_STAGEA
#undef PG8_LDA
#undef PG8_LDB
#undef PG8_MMA
#undef PG8_WAIT_V
#undef PG8_WAIT_L
#undef PG8_BAR
#undef PG8_SCHED
}
}

template <class Epi, class Sched>
__device__ __forceinline__ void gemm_phase_simple(const Sched& S, const Epi& E) {
    const int tid = threadIdx.x, wid = __builtin_amdgcn_readfirstlane(tid >> 6), lane = tid & 63, wr = wid >> 2, wc = wid & 3, fr = lane & 15, fq = lane >> 4;
    Unit u;
    for (int i = 0; S.next(i, u); ++i) { f32x4 acc[2][2][4][2];
        gemm_unit_simple((const bf16_t*)S.a_ptr(u), (const bf16_t*)S.b_ptr(u), acc, wr, wc, fr, fq);
        E(acc, u, wr, wc, fr, fq); }
}
#ifndef FAST_GEMM
#define FAST_GEMM 1
#endif
template <class Epi, class Sched>
__device__ __forceinline__ void run_gemm(LAS unsigned char* lds, const Sched& S, const Epi& E) {
#if FAST_GEMM
    pg8::gemm_phase<Epi, Sched, false>(lds, S, E);
#else
    gemm_phase_simple<Epi, Sched>(S, E);
#endif
}
template <class Epi, class Sched>
__device__ __forceinline__ void run_gemm_gather(LAS unsigned char* lds, const Sched& S, const Epi& E) { pg8::gemm_phase<Epi, Sched, true>(lds, S, E); }
__device__ __forceinline__ bool xcd_unit(int i, int G, int c, int nM, int nN, int& pm, int& pn) {
    const int x = c & 7, s = c >> 3, nS = G >> 3;
    const int r0 = (nM * x) >> 3, r1 = (nM * (x + 1)) >> 3;
    const int q = i * nS + s; if (q >= (r1 - r0) * nN) return false;
    const int rr = q / nN; pm = r0 + rr; pn = q - rr * nN; return true;
}
struct DenseSched {
    const bf16_t* A; const bf16_t* Bt; int nM, nN, G, c;
    __device__ __forceinline__ bool next(int i, Unit& u) const { u.e = 0; return xcd_unit(i, G, c, nM, nN, u.pm, u.pn); }
    __device__ __forceinline__ const char* a_ptr(const Unit& u) const { return (const char*)(A + (size_t)u.pm * 256 * D); }
    __device__ __forceinline__ const char* b_ptr(const Unit& u) const { return (const char*)(Bt + (size_t)u.pn * 256 * D); }
};
struct QkvSched {
    const bf16_t* A; const bf16_t* Bt; int live, G, c;
    __device__ __forceinline__ bool next(int i, Unit& u) const { u.e = 0;
        if (live) return xcd_unit(i, G, c, 144, 6, u.pm, u.pn);
        const int x = c & 7, s = c >> 3, nS = G >> 3; const int nlat = 16 * 6; const int q = i * nS + s;
        if (q < nlat) { const int rr = q / 6; u.pm = 16 * x + rr; u.pn = q - rr * 6; return true; }
        const int q2 = q - nlat; if (q2 >= 4) return false; const int t = x * 4 + q2; u.pm = 128 + (t >> 1); u.pn = 4 + (t & 1); return true; }
    __device__ __forceinline__ const char* a_ptr(const Unit& u) const { return (const char*)(A + (size_t)u.pm * 256 * D); }
    __device__ __forceinline__ const char* b_ptr(const Unit& u) const { return (const char*)(Bt + (size_t)u.pn * 256 * D); }
};
struct MoeSched {
    const bf16_t* A; const bf16_t* Bt  ; const LAS unsigned char* TE; int nM, nN, N, G, c;
    __device__ __forceinline__ bool next(int i, Unit& u) const { if (!xcd_unit(i, G, c, nM, nN, u.pm, u.pn)) return false; u.e = TE[u.pm]; return true; }
    __device__ __forceinline__ const char* a_ptr(const Unit& u) const { return (const char*)(A + (size_t)u.pm * 256 * D); }
    __device__ __forceinline__ const char* b_ptr(const Unit& u) const { return (const char*)(Bt + ((size_t)u.e * N + (size_t)u.pn * 256) * D); }
};
struct MoeGatherSched {
    const bf16_t* A; const bf16_t* Bt; const LAS unsigned char* TE; const LAS int* ROWS; int nM, nN, N, G, c;
    __device__ __forceinline__ bool next(int i, Unit& u) const { if (!xcd_unit(i, G, c, nM, nN, u.pm, u.pn)) return false; u.e = TE[u.pm]; return true; }
    __device__ __forceinline__ const char* a_base() const { return (const char*)A; }
    __device__ __forceinline__ const LAS int* rows(int ui) const { return ROWS + ui * 256; }
    __device__ __forceinline__ const char* a_ptr(const Unit& u) const { return (const char*)A; }
    __device__ __forceinline__ const char* b_ptr(const Unit& u) const { return (const char*)(Bt + ((size_t)u.e * N + (size_t)u.pn * 256) * D); }
};

struct EpiQKV {
    bf16_t *Q, *Kb, *Vb; const float *qg, *kg, *cosT, *sinT;
    __device__ __forceinline__ void operator()(const f32x4 (&acc)[2][2][4][2], const Unit& uu, int wr, int wc, int fr, int fq) const {
        const int pm = uu.pm, pn = uu.pn;
        const int kind = pn < 4 ? 0 : (pn == 4 ? 1 : 2);
        const float* gain = kind == 0 ? qg : kg;
        f32x4 gv[2][2];
#pragma unroll
        for (int bj = 0; bj < 2; ++bj)
#pragma unroll
            for (int n = 0; n < 2; ++n) gv[bj][n] = *(const f32x4*)(gain + 32 * bj + 16 * n + 4 * fq);
#pragma unroll
        for (int ai = 0; ai < 2; ++ai)
#pragma unroll
            for (int m = 0; m < 4; ++m) {
                const int r = pm * 256 + ai * 128 + wr * 64 + m * 16 + fr;
                const bool lat = r < NLAT;
                const int b = lat ? (r >> 11) : ((r - NLAT) >> 8);
                const int pos = lat ? (r & (SEQ - 1)) : (SEQ + ((r - NLAT) & (CL - 1)));
                f32x4 v[2][2];
#pragma unroll
                for (int bj = 0; bj < 2; ++bj)
#pragma unroll
                    for (int n = 0; n < 2; ++n) v[bj][n] = acc[ai][bj][m][n];
                if (kind != 2) {
                    float ss = 0.f;
#pragma unroll
                    for (int bj = 0; bj < 2; ++bj)
#pragma unroll
                        for (int n = 0; n < 2; ++n) ss += (v[bj][n][0] * v[bj][n][0] + v[bj][n][1] * v[bj][n][1]) + (v[bj][n][2] * v[bj][n][2] + v[bj][n][3] * v[bj][n][3]);
                    ss += __shfl_xor(ss, 16); ss += __shfl_xor(ss, 32);
                    const float rinv = 1.0f / sqrtf(ss * (1.0f / 64.0f) + EPS);
#pragma unroll
                    for (int bj = 0; bj < 2; ++bj)
#pragma unroll
                        for (int n = 0; n < 2; ++n) v[bj][n] = v[bj][n] * rinv * gv[bj][n];
                    if (lat) {
#pragma unroll
                        for (int bj = 0; bj < 2; ++bj) {
                            const f32x4 cs = *(const f32x4*)(cosT + pos * 32 + bj * 16 + 4 * fq), sn = *(const f32x4*)(sinT + pos * 32 + bj * 16 + 4 * fq);
                            const f32x4 x1 = v[bj][0], x2 = v[bj][1];
                            v[bj][0] = x1 * cs - x2 * sn; v[bj][1] = x2 * cs + x1 * sn;
                        }
                    }
                    if (kind == 0) {
#pragma unroll
                        for (int bj = 0; bj < 2; ++bj)
#pragma unroll
                            for (int n = 0; n < 2; ++n) v[bj][n] = v[bj][n] * C2;
                    }
                }
                bf16_t* dst = kind == 0 ? Q + (size_t)r * D + pn * 256 + wc * 64
                                        : (kind == 1 ? Kb : Vb) + ((size_t)b * KVL + pos) * 256 + wc * 64;
#pragma unroll
                for (int bj = 0; bj < 2; ++bj)
#pragma unroll
                    for (int n = 0; n < 2; ++n) { u32x2 w; w.x = pk2(v[bj][n][0], v[bj][n][1]); w.y = pk2(v[bj][n][2], v[bj][n][3]); *(u32x2*)(dst + 32 * bj + 16 * n + 4 * fq) = w; }
            }
    }
};
struct EpiBiasBf16 {
    bf16_t* O; int ldc; const float* bias0; int estride;
    __device__ __forceinline__ void operator()(const f32x4 (&acc)[2][2][4][2], const Unit& uu, int wr, int wc, int fr, int fq) const {
        const int row0 = uu.pm * 256, col0t = uu.pn * 256;
#pragma unroll
        for (int bj = 0; bj < 2; ++bj)
#pragma unroll
            for (int n = 0; n < 2; ++n) {
                const int c = col0t + bj * 128 + wc * 32 + n * 16 + 4 * fq;
                const f32x4 bv = *(const f32x4*)(bias0 + (size_t)uu.e * estride + c);
#pragma unroll
                for (int ai = 0; ai < 2; ++ai)
#pragma unroll
                    for (int m = 0; m < 4; ++m) { const int r = row0 + ai * 128 + wr * 64 + m * 16 + fr; const f32x4 v = acc[ai][bj][m][n] + bv;
                        u32x2 w; w.x = pk2(v[0], v[1]); w.y = pk2(v[2], v[3]); *(u32x2*)(O + (size_t)r * ldc + c) = w; }
            }
    }
};
struct EpiResid {
    const float *srcL, *srcC; float *dstL, *dstC; const float* gate  ; const float* bias;
    __device__ __forceinline__ void operator()(const f32x4 (&acc)[2][2][4][2], const Unit& uu, int wr, int wc, int fr, int fq) const {
        const int row0 = uu.pm * 256, col0t = uu.pn * 256;
#pragma unroll
        for (int bj = 0; bj < 2; ++bj)
#pragma unroll
            for (int n = 0; n < 2; ++n) {
                const int c = col0t + bj * 128 + wc * 32 + n * 16 + 4 * fq;
                const f32x4 bv = bias ? *(const f32x4*)(bias + c) : (f32x4){0.f, 0.f, 0.f, 0.f};
#pragma unroll
                for (int ai = 0; ai < 2; ++ai)
#pragma unroll
                    for (int m = 0; m < 4; ++m) { const int r = row0 + ai * 128 + wr * 64 + m * 16 + fr;
                        const f32x4 g = *(const f32x4*)(gate + (size_t)mod_row(r) * MODW + c);
                        const float* s = r < NLAT ? srcL + (size_t)r * D : srcC + (size_t)(r - NLAT) * D;
                        float* d = r < NLAT ? dstL + (size_t)r * D : dstC + (size_t)(r - NLAT) * D;
                        const f32x4 x = *(const f32x4*)(s + c);
                        *(f32x4*)(d + c) = x + g * (acc[ai][bj][m][n] + bv); }
            }
    }
};
struct EpiSwiglu {
    bf16_t* O; const float* bgu0  ;
    __device__ __forceinline__ void operator()(const f32x4 (&acc)[2][2][4][2], const Unit& uu, int wr, int wc, int fr, int fq) const {
        const int row0 = uu.pm * 256, pn = uu.pn; const float* bgu = bgu0 + (size_t)uu.e * NGU;
#pragma unroll
        for (int n = 0; n < 2; ++n) {
            const int f = pn * 128 + wc * 32 + n * 16 + 4 * fq;
            const f32x4 b0 = *(const f32x4*)(bgu + 2 * f), b1 = *(const f32x4*)(bgu + 2 * f + 4);
            const f32x4 bg = (f32x4){b0[0], b0[2], b1[0], b1[2]}, bu = (f32x4){b0[1], b0[3], b1[1], b1[3]};
#pragma unroll
            for (int ai = 0; ai < 2; ++ai)
#pragma unroll
                for (int m = 0; m < 4; ++m) { const int r = row0 + ai * 128 + wr * 64 + m * 16 + fr;
                    const f32x4 gg = acc[ai][0][m][n] + bg, uu = acc[ai][1][m][n] + bu; float o[4];
#pragma unroll
                    for (int e = 0; e < 4; ++e) { const float g = fminf(gg[e], 7.0f), u = fminf(fmaxf(uu[e], -7.0f), 7.0f);
                        const float sg = __builtin_amdgcn_rcpf(1.0f + __builtin_amdgcn_exp2f(-2.4554669595930157f * g)); o[e] = (u + 1.0f) * g * sg; }
                    u32x2 w; w.x = pk2(o[0], o[1]); w.y = pk2(o[2], o[3]); *(u32x2*)(O + (size_t)r * D + f) = w; }
        }
    }
};

template <int MODE> __device__ __forceinline__ int wrow_map(int n) {
    if (MODE == 0) return n;
    if (MODE == 1) { const int pn = n >> 8, wc = (n >> 6) & 3, bj = (n >> 5) & 1, j = n & 31; return (pn << 8) + (bj << 7) + (wc << 5) + j; }
    { const int f = n >> 1, pn = f >> 7, fo = f & 127; return (pn << 8) + ((n & 1) << 7) + fo; }
}
template <int MODE> __device__ __forceinline__ void transpose_item(const float* W, int N, bf16_t* WT, LAS float* scr, int item, int lane) {
    constexpr int K = D;
    const int nblk = N / 32, kb = item / nblk, nb = item % nblk, k0 = 64 * kb, n0 = 32 * nb;
#pragma unroll 8
    for (int i = 0; i < 32; ++i) { const int kk = 2 * i + (lane >> 5); scr[kk * 33 + (lane & 31)] = W[(size_t)(k0 + kk) * N + n0 + (lane & 31)]; }
    LDS_WAIT(); asm volatile("" ::: "memory");
    const int c = lane & 7;
#pragma unroll
    for (int j = 0; j < 4; ++j) { const int n = (lane >> 3) + 8 * j; const LAS float* s = scr + (8 * c) * 33 + n;
        u32x4 o; o.x = pk2(s[0 * 33], s[1 * 33]); o.y = pk2(s[2 * 33], s[3 * 33]); o.z = pk2(s[4 * 33], s[5 * 33]); o.w = pk2(s[6 * 33], s[7 * 33]);
        *(u32x4*)(WT + (size_t)wrow_map<MODE>(n0 + n) * K + k0 + 8 * c) = o; }
    LDS_WAIT(); asm volatile("" ::: "memory");
}

__device__ __forceinline__ void norm_mod_store(const f32x4 (&v)[4], const float* gain, const float* shift, const float* scale, bf16_t* dst, int lane, f32x4 (&h)[4]) {
    float ss = 0.f;
#pragma unroll
    for (int j = 0; j < 4; ++j) ss += (v[j][0] * v[j][0] + v[j][1] * v[j][1]) + (v[j][2] * v[j][2] + v[j][3] * v[j][3]);
    ss = wave_sum(ss);
    const float rinv = 1.0f / sqrtf(ss * (1.0f / D) + EPS);
#pragma unroll
    for (int j = 0; j < 4; ++j) {
        const f32x4 g = ((const f32x4*)gain)[lane + 64 * j], sh = ((const f32x4*)shift)[lane + 64 * j], sc = ((const f32x4*)scale)[lane + 64 * j];
        h[j] = (v[j] * rinv * g) * (sc + 1.0f) + sh;
        u32x2 w; w.x = pk2(h[j][0], h[j][1]); w.y = pk2(h[j][2], h[j][3]);
        ((u32x2*)dst)[lane + 64 * j] = w;
    }
}


namespace attn_body {
using bf16=__hip_bfloat16;
using bf16x8=__attribute__((ext_vector_type(8)))short;
using s16x4=__attribute__((ext_vector_type(4)))short;
using f32x16=__attribute__((ext_vector_type(16)))float;
using u32x4=__attribute__((ext_vector_type(4)))unsigned;
constexpr int D=64,DM=1024,KVP=256;
constexpr int NW=8,QBLK=32,QB=QBLK*NW,KVBLK=64;
__device__ __forceinline__ int crow(int r,int hi){return (r&3)+8*(r>>2)+4*hi;}
#define SBAR() __builtin_amdgcn_sched_barrier(0)
__device__ __forceinline__ void cmask(f32x16&p0,f32x16&p1,int jb,int qrel,int hi){
  const float NEG=-INFINITY; int kb=64*jb+4*hi;
  #pragma unroll
  for(int r=0;r<16;++r){int kv=kb+(r&3)+8*(r>>2); if(kv>qrel)p0[r]=NEG; if(kv+32>qrel)p1[r]=NEG;}
}

constexpr int NSLOT=3, SLOTB=8192;
constexpr int LDS_K=0, LDS_V=NSLOT*SLOTB, LDS_WS=2*NSLOT*SLOTB, LDS_OST=LDS_WS+NW*64*4, LDS_BYTES=LDS_OST+NW*4096;
constexpr float C2=0.125f*1.4426950408889634f;
__device__ __forceinline__ void glds16(const void*gsrc,unsigned lds_dst){unsigned keep;
  asm volatile("s_mov_b32 %0, m0\n\ts_mov_b32 m0, %2\n\ts_nop 0\n\tglobal_load_lds_dwordx4 %1, off\n\ts_mov_b32 m0, %0":"=&s"(keep):"v"(gsrc),"s"(lds_dst):"memory");}
__device__ __forceinline__ float max3f(float a,float b,float c){float r;asm("v_max3_f32 %0, %1, %2, %3":"=v"(r):"v"(a),"v"(b),"v"(c));return r;}
__device__ __forceinline__ float max2f(float a,float b){float r;asm("v_max_f32_e32 %0, %1, %2":"=v"(r):"v"(a),"v"(b));return r;}
__device__ __forceinline__ float fadd_s(float a,float b){float r;asm("v_add_f32_e32 %0, %1, %2":"=v"(r):"v"(a),"v"(b));return r;}
__device__ __forceinline__ float fsub_s(float a,float b){float r;asm("v_sub_f32_e32 %0, %1, %2":"=v"(r):"v"(a),"v"(b));return r;}
typedef float f32x2_t __attribute__((ext_vector_type(2))); typedef __bf16 bf16x2_t __attribute__((ext_vector_type(2)));
__device__ __forceinline__ unsigned cvtpk_s(float lo,float hi){f32x2_t v={lo,hi};bf16x2_t b=__builtin_convertvector(v,bf16x2_t);return __builtin_bit_cast(unsigned,b);}
#define WAIT_BAR(N) asm volatile("s_waitcnt vmcnt(" #N ") lgkmcnt(0)\n\ts_barrier":::"memory")

__device__ __forceinline__ void qkt(f32x16&p0,f32x16&p1,const char*Kslot,const bf16x8*qr,const f32x16&negm,int r32,int hi){
  const char*kb=Kslot+hi*1024+r32*16;
  #pragma unroll
  for(int d0=0;d0<4;++d0){
    const bf16x8 b0=*reinterpret_cast<const bf16x8*>(kb+d0*2048);
    const bf16x8 b1=*reinterpret_cast<const bf16x8*>(kb+d0*2048+512);
    if(d0==0){p0=__builtin_amdgcn_mfma_f32_32x32x16_bf16(b0,qr[0],negm,0,0,0);p1=__builtin_amdgcn_mfma_f32_32x32x16_bf16(b1,qr[0],negm,0,0,0);}
    else{p0=__builtin_amdgcn_mfma_f32_32x32x16_bf16(b0,qr[d0],p0,0,0,0);p1=__builtin_amdgcn_mfma_f32_32x32x16_bf16(b1,qr[d0],p1,0,0,0);}}
}
typedef __attribute__((address_space(3))) const char* lds_cptr;
typedef short v4i16_t __attribute__((ext_vector_type(4)));
__device__ __forceinline__ void kload8(bf16x8*kf,lds_cptr kp){
  kf[0]=*(const __attribute__((address_space(3))) bf16x8*)(kp);      kf[1]=*(const __attribute__((address_space(3))) bf16x8*)(kp+512);
  kf[2]=*(const __attribute__((address_space(3))) bf16x8*)(kp+2048); kf[3]=*(const __attribute__((address_space(3))) bf16x8*)(kp+2560);
  kf[4]=*(const __attribute__((address_space(3))) bf16x8*)(kp+4096); kf[5]=*(const __attribute__((address_space(3))) bf16x8*)(kp+4608);
  kf[6]=*(const __attribute__((address_space(3))) bf16x8*)(kp+6144); kf[7]=*(const __attribute__((address_space(3))) bf16x8*)(kp+6656);
}
__device__ __forceinline__ void kload2(bf16x8*kf,lds_cptr kp,int j){ kf[2*j]=*(const __attribute__((address_space(3))) bf16x8*)(kp+j*2048); kf[2*j+1]=*(const __attribute__((address_space(3))) bf16x8*)(kp+j*2048+512); }
__device__ __forceinline__ s16x4 vtr(lds_cptr p){ return __builtin_bit_cast(s16x4,__builtin_amdgcn_ds_read_tr16_b64_v4i16((__attribute__((address_space(3))) v4i16_t*)p)); }
__device__ __forceinline__ float rowmax(const f32x16&p0,const f32x16&p1){
  float a=max3f(p0[0],p0[1],p1[0]),b=max3f(p0[2],p0[3],p1[1]);a=max3f(a,p1[2],p1[3]);
  #pragma unroll
  for(int r=4;r<16;r+=4){a=max3f(a,p0[r],p0[r+1]);b=max3f(b,p0[r+2],p0[r+3]);a=max3f(a,p1[r],p1[r+1]);b=max3f(b,p1[r+2],p1[r+3]);}
  const float m=max2f(a,b);
  auto rr=__builtin_amdgcn_permlane32_swap(__float_as_uint(m),__float_as_uint(m),false,false);
  return max2f(__uint_as_float(rr[0]),__uint_as_float(rr[1]));
}
__device__ __forceinline__ void pv(f32x16*o,int vb,bf16x8 pa0,bf16x8 pa1,bf16x8 pa2,bf16x8 pa3){
  #pragma unroll
  for(int d0=0;d0<2;++d0){s16x4 lo[4],hi[4];
    #pragma unroll
    for(int ks=0;ks<4;++ks){
      asm volatile("ds_read_b64_tr_b16 %0,%1 offset:%c2":"=&v"(lo[ks]):"v"(vb),"i"(d0*4096+ks*1024):"memory");
      asm volatile("ds_read_b64_tr_b16 %0,%1 offset:%c2":"=&v"(hi[ks]):"v"(vb),"i"(d0*4096+ks*1024+512):"memory");}
    asm volatile("s_waitcnt lgkmcnt(0)":::"memory");SBAR();
    #define PK(k) (bf16x8){lo[k][0],lo[k][1],lo[k][2],lo[k][3],hi[k][0],hi[k][1],hi[k][2],hi[k][3]}
    o[d0]=__builtin_amdgcn_mfma_f32_32x32x16_bf16(pa0,PK(0),o[d0],0,0,0);
    o[d0]=__builtin_amdgcn_mfma_f32_32x32x16_bf16(pa1,PK(1),o[d0],0,0,0);
    o[d0]=__builtin_amdgcn_mfma_f32_32x32x16_bf16(pa2,PK(2),o[d0],0,0,0);
    o[d0]=__builtin_amdgcn_mfma_f32_32x32x16_bf16(pa3,PK(3),o[d0],0,0,0);
    #undef PK
  }
}

#ifndef ATTN_STORE16
#define ATTN_STORE16(p,v) (*(u32x4*)(p)=(v))
#endif
template<int THRL> __device__ __forceinline__ void attn_unit(const bf16*Qu,const bf16*__restrict__ Kh,const bf16*__restrict__ Vh,bf16*Ou,const int NT,char*shm){
  const int tid=threadIdx.x,lane=tid&63,r32=lane&31,hi=lane>>5; const int wid=__builtin_amdgcn_readfirstlane(tid>>6);
  const bf16*Qw=Qu+(long)(wid*QBLK)*DM;
  const unsigned lds0=(unsigned)(uintptr_t)shm;
  float*wsf=(float*)(shm+LDS_WS)+wid*64;
  const bf16*ksrc=Kh+(long)lane*KVP+wid*8;
  const bf16*vsrc=Vh+(long)(16*(wid&3)+(lane>>2))*KVP+(wid>>2)*32+(lane&3)*8;
  const unsigned kdst=lds0+LDS_K+wid*1024, vdst=lds0+LDS_V+wid*1024;
  #define DMA_K(t,slot) glds16(ksrc+(long)(t)*KVBLK*KVP,(unsigned)__builtin_amdgcn_readfirstlane(kdst+(slot)))
  #define DMA_V(t,slot) glds16(vsrc+(long)(t)*KVBLK*KVP,(unsigned)__builtin_amdgcn_readfirstlane(vdst+(slot)))
  const int vb0=(int)(lds0+LDS_V)+((lane>>4)&1)*32+(lane&3)*8+(4*hi+((lane&15)>>2))*64;
  const char*Kbase=shm+LDS_K; bf16x8 kf[8];
  const lds_cptr shm3=(lds_cptr)shm; const lds_cptr kp0=shm3+LDS_K+hi*1024+r32*16; const lds_cptr vp0=shm3+LDS_V+((lane>>4)&1)*32+(lane&3)*8+(4*hi+((lane&15)>>2))*64;
  DMA_K(0,0);DMA_V(0,0);DMA_K(1,SLOTB);
  bf16x8 qr[4];
  #pragma unroll
  for(int d0=0;d0<4;++d0)qr[d0]=*reinterpret_cast<const bf16x8*>(&Qw[(long)r32*DM+d0*16+hi*8]);
  float mhat=0.f,l_reg=0.f;f32x16 o[2];o[0]=f32x16{};o[1]=f32x16{};f32x16 negm=f32x16{};asm volatile("":"+v"(negm));
  #define CMASK(P0,P1,t) do{}while(0)
  bool resc=false;
  #define START(P0,P1) do{ const float rm=rowmax(P0,P1); resc=false; \
    { const float dl=rm; mhat=fadd_s(mhat,dl); \
      _Pragma("unroll") for(int r=0;r<16;++r){P0[r]=fsub_s(P0[r],dl);P1[r]=fsub_s(P1[r],dl);} \
      _Pragma("unroll") for(int r=0;r<16;++r)negm[r]=-mhat; asm volatile("":"+v"(negm)); } \
    _Pragma("unroll") for(int r=0;r<16;++r)P0[r]=__builtin_amdgcn_exp2f(P0[r]); }while(0)
  #define RESC() do{ if(resc){ asm volatile("s_waitcnt lgkmcnt(0)":::"memory"); \
      _Pragma("unroll") for(int d_=0;d_<2;++d_) _Pragma("unroll") for(int r=0;r<16;++r)o[d_][r]*=wsf[crow(r,hi)]; } }while(0)
  f32x16 pA0,pA1,pB0,pB1;
  int sl_prev=0,sl_cur=0,sl_next=SLOTB;
  #define ROT() do{sl_prev=sl_cur;sl_cur=sl_next;sl_next=(sl_next==(NSLOT-1)*SLOTB)?0:sl_next+SLOTB;}while(0)
  DMA_K(2,2*SLOTB);
  WAIT_BAR(3);
  qkt(pA0,pA1,Kbase,qr,negm,r32,hi);asm volatile("s_nop 15\n\ts_nop 7":"+v"(pA0),"+v"(pA1));CMASK(pA0,pA1,0);
  START(pA0,pA1);
  _Pragma("unroll") for(int r=0;r<16;++r)pA1[r]=__builtin_amdgcn_exp2f(pA1[r]);
  WAIT_BAR(0);
  DMA_K(3,0);DMA_V(1,SLOTB);
  ROT();
  kload8(kf,kp0+sl_cur);
  WAIT_BAR(2);
  s16x4 vlo[8],vhi[8]; u32x4 pw0,pw1,pw2,pw3;
  #define PKW(P,B) cvtpk_s(P[B],P[B+1])
  #define PAF(k) __builtin_bit_cast(bf16x8,pw##k)
  #define VFR(i) (bf16x8){vlo[i][0],vlo[i][1],vlo[i][2],vlo[i][3],vhi[i][0],vhi[i][1],vhi[i][2],vhi[i][3]}
  #define PIN(x) asm volatile("":"+v"(x))
  #define MX3(a,b,c) __builtin_fmaxf(__builtin_fmaxf((a),(b)),(c))
  #define GAPA(MF,A0,A1,A2,A3,W0,W1,PW) do{ MF; sacc+=A0; sacc+=A1; sacc+=A2; sacc+=A3; PIN(sacc); W0; W1; PIN(PW); SBAR(); }while(0)
  #define EX(v) __builtin_amdgcn_exp2f(v)
  #define GAPB(MF,X,B) do{ MF; X[B]=EX(X[B]); X[B+1]=EX(X[B+1]); X[B+2]=EX(X[B+2]); X[B+3]=EX(X[B+3]); PIN(X); SBAR(); }while(0)
  #define VRD(i) do{ vlo[i]=vtr(vp_+(((i)>>2)*4096+((i)&3)*1024)); vhi[i]=vtr(vp_+(((i)>>2)*4096+((i)&3)*1024+512)); }while(0)
  #define KRD(G,j) do{ if(G){ kload2(kf,kp0+sl_next,j); SBAR(); } }while(0)
  #define STEP(C0,C1,P0,P1,t,GK,GV,GL) do{ SBAR(); \
    const lds_cptr vp_=vp0+sl_prev; \
    VRD(0); SBAR(); float sacc=(P0[0]+P0[1]); \
    GAPA(C0=__builtin_amdgcn_mfma_f32_32x32x16_bf16(kf[0],qr[0],negm,0,0,0), P0[2],P0[3],P0[4],P0[5],     pw0[0]=PKW(P0,0), pw0[1]=PKW(P0,2), pw0); \
    VRD(4); SBAR(); GAPA(C1=__builtin_amdgcn_mfma_f32_32x32x16_bf16(kf[1],qr[0],negm,0,0,0), P0[6],P0[7],P0[8],P0[9],     pw0[2]=PKW(P0,4), pw0[3]=PKW(P0,6), pw0); \
    VRD(1); SBAR(); GAPA(C0=__builtin_amdgcn_mfma_f32_32x32x16_bf16(kf[2],qr[1],C0,0,0,0),   P0[10],P0[11],P0[12],P0[13], pw1[0]=PKW(P0,8), pw1[1]=PKW(P0,10), pw1); \
    VRD(5); SBAR(); GAPA(C1=__builtin_amdgcn_mfma_f32_32x32x16_bf16(kf[3],qr[1],C1,0,0,0),   P0[14],P0[15],P1[0],P1[1],   pw1[2]=PKW(P0,12),pw1[3]=PKW(P0,14), pw1); \
    VRD(2); SBAR(); GAPA(C0=__builtin_amdgcn_mfma_f32_32x32x16_bf16(kf[4],qr[2],C0,0,0,0),   P1[2],P1[3],P1[4],P1[5],     pw2[0]=PKW(P1,0), pw2[1]=PKW(P1,2), pw2); \
    VRD(6); SBAR(); GAPA(C1=__builtin_amdgcn_mfma_f32_32x32x16_bf16(kf[5],qr[2],C1,0,0,0),   P1[6],P1[7],P1[8],P1[9],     pw2[2]=PKW(P1,4), pw2[3]=PKW(P1,6), pw2); \
    VRD(3); SBAR(); GAPA(C0=__builtin_amdgcn_mfma_f32_32x32x16_bf16(kf[6],qr[3],C0,0,0,0),   P1[10],P1[11],P1[12],P1[13], pw3[0]=PKW(P1,8), pw3[1]=PKW(P1,10), pw3); \
    VRD(7); SBAR(); GAPA(C1=__builtin_amdgcn_mfma_f32_32x32x16_bf16(kf[7],qr[3],C1,0,0,0),   P1[14],P1[15],0.f,0.f,       pw3[2]=PKW(P1,12),pw3[3]=PKW(P1,14), pw3); \
    l_reg+=sacc; \
    if(GK){DMA_K((t)+3,sl_cur);} if(GV){DMA_V((t)+1,sl_next);} \
    CMASK(C0,C1,t); \
    { float a=MX3(C0[0],C0[1],C1[0]),b=MX3(C0[2],C0[3],C1[1]); a=MX3(a,C1[2],C1[3]); \
      _Pragma("unroll") for(int r=4;r<16;r+=4){a=MX3(a,C0[r],C0[r+1]);b=MX3(b,C0[r+2],C0[r+3]);a=MX3(a,C1[r],C1[r+1]);b=MX3(b,C1[r+2],C1[r+3]);} \
      float rm=__builtin_fmaxf(a,b); { auto rr=__builtin_amdgcn_permlane32_swap(__float_as_uint(rm),__float_as_uint(rm),false,false); rm=__builtin_fmaxf(__uint_as_float(rr[0]),__uint_as_float(rr[1])); } \
      resc=false; \
      if(__builtin_expect(__any(rm>(float)THRL),0)){ const float dl=__builtin_fmaxf(rm,0.f); mhat+=dl; \
        _Pragma("unroll") for(int r=0;r<16;++r){C0[r]-=dl;C1[r]-=dl;} \
        _Pragma("unroll") for(int r=0;r<16;++r)negm[r]=-mhat; asm volatile("":"+v"(negm)); \
        const float f=__builtin_amdgcn_exp2f(-dl); l_reg*=f; if(hi==0)wsf[r32]=f; resc=true; } } \
    SBAR(); \
    GAPB(o[0]=__builtin_amdgcn_mfma_f32_32x32x16_bf16(PAF(0),VFR(0),o[0],0,0,0), C0,0); \
    GAPB(o[1]=__builtin_amdgcn_mfma_f32_32x32x16_bf16(PAF(0),VFR(4),o[1],0,0,0), C0,4); \
    KRD(GL,0); GAPB(o[0]=__builtin_amdgcn_mfma_f32_32x32x16_bf16(PAF(1),VFR(1),o[0],0,0,0), C0,8); \
    KRD(GL,1); GAPB(o[1]=__builtin_amdgcn_mfma_f32_32x32x16_bf16(PAF(1),VFR(5),o[1],0,0,0), C0,12); \
    KRD(GL,2); GAPB(o[0]=__builtin_amdgcn_mfma_f32_32x32x16_bf16(PAF(2),VFR(2),o[0],0,0,0), C1,0); \
    KRD(GL,3); GAPB(o[1]=__builtin_amdgcn_mfma_f32_32x32x16_bf16(PAF(2),VFR(6),o[1],0,0,0), C1,4); \
    GAPB(o[0]=__builtin_amdgcn_mfma_f32_32x32x16_bf16(PAF(3),VFR(3),o[0],0,0,0), C1,8); \
    GAPB(o[1]=__builtin_amdgcn_mfma_f32_32x32x16_bf16(PAF(3),VFR(7),o[1],0,0,0), C1,12); \
    }while(0)
  int t=1;
  #undef CMASK
  #define CMASK(P0,P1,t) do{}while(0)
  for(;t+5<NT;t+=2){
    STEP(pB0,pB1,pA0,pA1,t,true,true,true);     WAIT_BAR(2); RESC(); ROT();
    STEP(pA0,pA1,pB0,pB1,t+1,true,true,true);   WAIT_BAR(2); RESC(); ROT();
  }
  #undef CMASK
  #define CMASK(P0,P1,t) do{}while(0)
  #define ENDW(tt) do{ if((tt)+3<NT){WAIT_BAR(2);} else if((tt)+2<NT){WAIT_BAR(1);} else {WAIT_BAR(0);} }while(0)
  for(;t+1<NT;t+=2){
    STEP(pB0,pB1,pA0,pA1,t,(t+3<NT),(t+1<NT),(t+1<NT));       ENDW(t);   RESC(); ROT();
    STEP(pA0,pA1,pB0,pB1,t+1,(t+4<NT),(t+2<NT),(t+2<NT));     ENDW(t+1); RESC(); ROT();
  }
  STEP(pB0,pB1,pA0,pA1,NT-1,false,false,false); RESC();
  { float sacc=pB0[0]+pB0[1]; _Pragma("unroll") for(int r=2;r<16;++r)sacc+=pB0[r]; _Pragma("unroll") for(int r=0;r<16;++r)sacc+=pB1[r]; l_reg+=sacc;
    pw0=(u32x4){PKW(pB0,0),PKW(pB0,2),PKW(pB0,4),PKW(pB0,6)};pw1=(u32x4){PKW(pB0,8),PKW(pB0,10),PKW(pB0,12),PKW(pB0,14)};pw2=(u32x4){PKW(pB1,0),PKW(pB1,2),PKW(pB1,4),PKW(pB1,6)};pw3=(u32x4){PKW(pB1,8),PKW(pB1,10),PKW(pB1,12),PKW(pB1,14)};
    SBAR(); pv(o,vb0+sl_cur,PAF(0),PAF(1),PAF(2),PAF(3)); }
  #undef PKW
  #undef PAF
  #undef VFR
  #undef PIN
  #undef MX3
  #undef GAPA
  #undef GAPB
  #undef EX
  #undef VRD
  #undef KRD
  #undef STEP
  #undef ENDW
  {auto rr=__builtin_amdgcn_permlane32_swap(__float_as_uint(l_reg),__float_as_uint(l_reg),false,false);l_reg=__uint_as_float(rr[0])+__uint_as_float(rr[1]);}
  if(hi==0)wsf[32+r32]=l_reg;asm volatile("s_waitcnt lgkmcnt(0)":::"memory");
  float rli[16];
  #pragma unroll
  for(int r=0;r<16;++r)rli[r]=__builtin_amdgcn_rcpf(wsf[32+crow(r,hi)]);
  bf16*Ow=Ou+(long)(wid*QBLK)*DM;
  { bf16*stg=(bf16*)(shm+LDS_OST)+wid*2048;
    #pragma unroll
    for(int r=0;r<16;++r){const int orow=crow(r,hi);
      #pragma unroll
      for(int d0=0;d0<2;++d0)stg[orow*64+d0*32+r32]=__float2bfloat16(o[d0][r]*rli[r]);}
    asm volatile("s_waitcnt lgkmcnt(0)":::"memory");
    #pragma unroll
    for(int i=0;i<4;++i){const int row=i*8+(lane>>3),ch=lane&7; const u32x4 v=*(const u32x4*)(stg+row*64+ch*8); ATTN_STORE16(Ow+(long)row*DM+ch*8,v);} }
  asm volatile("s_waitcnt lgkmcnt(0)\n\ts_barrier":::"memory");
  #undef DMA_K
  #undef DMA_V
  #undef CMASK
  #undef START
  #undef RESC
  #undef ROT
}
constexpr int ATTN_LDS_BYTES=LDS_BYTES;
#undef SBAR
#undef WAIT_BAR
}

template <int LF>
__device__ __forceinline__ void conv_channel(LAS unsigned char* lds, const bf16_t* FIc, const bf16_t* wsrc, bf16_t* ydst, int tid, int lane, int wv) {
    constexpr int IPW = LF / 256, NBK = LF / 32, P = 2 * LF + 8, WSTR = LF + 8;
    LAS unsigned char* FIL = lds; LAS unsigned char* WL = lds + ((8 * P * 2 + 255) & ~255);
    __syncthreads();
    { const u32x4* fs = (const u32x4*)FIc; for (int i = tid; i < 8 * P * 2 / 16; i += NTHR) ((LAS u32x4*)FIL)[i] = fs[i]; }
    for (int i = tid; i < NB * (LF / 8); i += NTHR) { const int b = i / (LF / 8), ch = i % (LF / 8); *(LAS u32x4*)(WL + b * (WSTR * 2) + ch * 16) = *(const u32x4*)(wsrc + (size_t)b * LF + ch * 8); }
    __syncthreads();
    f32x4 acc[IPW][2]; bf16x8 Bw[IPW];
#pragma unroll
    for (int ii = 0; ii < IPW; ++ii) { acc[ii][0] = (f32x4){0.f, 0.f, 0.f, 0.f}; acc[ii][1] = (f32x4){0.f, 0.f, 0.f, 0.f}; Bw[ii] = (bf16x8){0, 0, 0, 0, 0, 0, 0, 0}; }
    const int rr = lane & 15, q = lane >> 4;
    const int aBase = (rr & 7) * (P * 2) + 2 * (LF - (rr - (rr & 7)) + 8 * q);
    const int bBase = rr * (WSTR * 2) + 16 * q;
#define CONV_STEPS(CHECK) do { _Pragma("unroll") for (int dd = 0; dd < IPW; ++dd) { \
        const int delta = IPW * d + dd; \
        const bf16x8 a0 = *(const LAS bf16x8*)(FIL + aBase - 64 * delta), a1 = *(const LAS bf16x8*)(FIL + aBase - 64 * delta - 32); \
        const int jn = IPW * (wv - d) - dd; \
        if (!(CHECK) || (jn >= 0 && jn < NBK)) Bw[(IPW - dd) % IPW] = *(const LAS bf16x8*)(WL + bBase + 64 * jn); \
        _Pragma("unroll") for (int ii = 0; ii < IPW; ++ii) { const int j = IPW * (wv - d) + ii - dd; \
            if (!(CHECK) || (j >= 0 && j < NBK)) { \
                acc[ii][0] = __builtin_amdgcn_mfma_f32_16x16x32_bf16(a0, Bw[(ii - dd + IPW) % IPW], acc[ii][0], 0, 0, 0); \
                acc[ii][1] = __builtin_amdgcn_mfma_f32_16x16x32_bf16(a1, Bw[(ii - dd + IPW) % IPW], acc[ii][1], 0, 0, 0); } } } } while (0)
    { const int d = wv - 8; CONV_STEPS(true); }
    for (int d = wv - 7; d < wv; ++d) { CONV_STEPS(false); }
    { const int d = wv; CONV_STEPS(true); }
#undef CONV_STEPS
#pragma unroll
    for (int ii = 0; ii < IPW; ++ii)
#pragma unroll
        for (int h = 0; h < 2; ++h) { u32x2 w; w.x = pk2(acc[ii][h][0], acc[ii][h][1]); w.y = pk2(acc[ii][h][2], acc[ii][h][3]);
            *(u32x2*)(ydst + (size_t)rr * LF + 32 * (IPW * wv + ii) + 16 * h + 4 * q) = w; }
}

#define IN(k) (lo <= (k) && (k) < hi)
#define SEAM(k) do { if (IN(k) && IN((k) + 1)) xcd_barrier(bar); } while (0)
#define KLOCALS \
    const float* x_in = args.in[I_X]; const float* c_in = args.in[I_C]; const float* ctx_in = args.in[I_CTX]; const float* cctx_in = args.in[I_CCTX]; \
    float* out = args.out; \
    float* modp = (float*)(ws + WS_MODP); float* modf = (float*)(ws + WS_MOD); \
    float* cosT = (float*)(ws + WS_ROPE); float* sinT = cosT + SEQ * 32; \
    float* a2tab = (float*)(ws + WS_A2); \
    int* top_e = (int*)(ws + WS_PAIR); int* ppos = top_e + NTOK * 4; float* pgate = (float*)(ppos + NTOK * 4); int* pdest = (int*)(pgate + NTOK * 4); \
    float* ctxbuf = (float*)(ws + WS_CTX); \
    bf16_t* Wqkv_t = (bf16_t*)(ws + WS_WQKV); bf16_t* Wo_t = (bf16_t*)(ws + WS_WO); bf16_t* Win_t = (bf16_t*)(ws + WS_WIN); bf16_t* Wout_t = (bf16_t*)(ws + WS_WOUT); \
    bf16_t* Wgu_t = (bf16_t*)(ws + WS_WGU); bf16_t* Wdn_t = (bf16_t*)(ws + WS_WDN); \
    bf16_t* hA = (bf16_t*)(ws + WS_HA); bf16_t* Qb = (bf16_t*)(ws + WS_Q); bf16_t* Kb = (bf16_t*)(ws + WS_K); bf16_t* Vb = (bf16_t*)(ws + WS_V); \
    bf16_t* Upre = (bf16_t*)(ws + WS_UPRE); bf16_t* Wc = (bf16_t*)(ws + WS_WC); bf16_t* Yc = (bf16_t*)(ws + WS_YC); \
    bf16_t* XS = (bf16_t*)(ws + WS_XS); bf16_t* AB = (bf16_t*)(ws + WS_AB); int* elist = (int*)(ws + WS_ELIST); \
    const int wr = wave >> 2, wc = wave & 3, fr = lane & 15, fq = lane >> 4;
template <int layer> __device__ __forceinline__ void layer_body(const Args& args, LAS unsigned char* lds, const XcdBarrier& bar, const int tid, const int lane, const int wave, const int G, const int bid, const int lo, const int hi) {
    const int gw = bid * NWAVES + wave, NGW = G * NWAVES;
    unsigned char* ws = args.ws;
    gu32* ctl = (gu32*)(ws + WS_CTL);
    KLOCALS
        const int pb = 3 + 10 * layer;
        const int jm = layer >> 1;
        const bool ctx_live = layer < 2;
        const int nrows = ctx_live ? NTOK : NLAT;
        const float* mo = modf + (size_t)layer * NMODROW * MODW;
        const float* resL = layer == 0 ? x_in : out; const float* resC = layer == 0 ? ctx_in : ctxbuf;

        if ((layer & 1) == 0) {
            if (EN_GEMM && IN(pb + 0)) {
                EpiQKV E{Qb, Kb, Vb, args.in[I_QG] + jm * 64, args.in[I_KG] + jm * 64, cosT, sinT};
                const bf16_t* Wt = Wqkv_t + (size_t)jm * NQKV * D;
                const QkvSched S{hA, Wt, ctx_live ? 1 : 0, G, bid};
                run_gemm(lds, S, E);
            }
            SEAM(pb + 0);
            if (EN_ATT && IN(pb + 1)) {
                typedef attn_body::bf16 abf;
                const int x = bid & 7, sl = bid >> 3, nS = G >> 3;
                for (int q = sl; q < 256; q += nS) {
                    const int b = 2 * x + (q >> 7), kvh = (q >> 5) & 3, head = 4 * kvh + ((q >> 3) & 3), qb = q & 7;
                    abf* Qu = (abf*)(Qb + ((size_t)b * SEQ + qb * 256) * D + head * 64);
                    attn_body::attn_unit<8>(Qu, (const abf*)(Kb + (size_t)b * KVL * 256 + kvh * 64), (const abf*)(Vb + (size_t)b * KVL * 256 + kvh * 64), Qu, KVL / 64, (char*)lds);
                }
                if (ctx_live) for (int q = sl; q < 32; q += nS) {
                    const int b = 2 * x + (q >> 4), head = q & 15, kvh = head >> 2;
                    abf* Qu = (abf*)(Qb + ((size_t)NLAT + b * CL) * D + head * 64);
                    attn_body::attn_unit<8>(Qu, (const abf*)(Kb + ((size_t)b * KVL + SEQ) * 256 + kvh * 64), (const abf*)(Vb + ((size_t)b * KVL + SEQ) * 256 + kvh * 64), Qu, CL / 64, (char*)lds);
                }
            }
            SEAM(pb + 1);
            if (EN_GEMM && IN(pb + 2)) {
                EpiResid E{resL, resC, out, ctxbuf, mo + 2 * D, nullptr};
                const bf16_t* Wt = Wo_t + (size_t)jm * D * D;
                const DenseSched S{Qb, Wt, nrows / 256, 4, G, bid};
                run_gemm(lds, S, E);
            }
            SEAM(pb + 2);
        } else {
            const float* cw = args.in[I_HCW] + (size_t)jm * 3 * NHY; const float* cb = args.in[I_HCB] + (size_t)jm * NHY;
            if (EN_GEMM && IN(pb + 0)) {
                EpiBiasBf16 E{Upre, NHY, args.in[I_HBIN] + (size_t)jm * NHY, 0};
                const bf16_t* Wt = Win_t + (size_t)jm * NHY * D;
                const DenseSched S{hA, Wt, nrows / 256, 12, G, bid};
                run_gemm(lds, S, E);
            }
            SEAM(pb + 0);
            if (EN_MISC && IN(pb + 1)) {
                LAS bf16_t* T = (LAS bf16_t*)lds;
                const int nlat_u = NB * 32 * 16, nctx_u = ctx_live ? NB * 4 * 16 : 0;
                for (int u = bid; u < nlat_u + nctx_u; u += G) {
                    int b, s0, c0, Ls, rowb; bf16_t* dstb;
                    if (u < nlat_u) { b = u >> 9; s0 = ((u >> 4) & 31) * 64; c0 = (u & 15) * 64; Ls = SEQ; rowb = b * SEQ; dstb = Wc; }
                    else { const int q = u - nlat_u; b = q >> 6; s0 = ((q >> 4) & 3) * 64; c0 = (q & 15) * 64; Ls = CL; rowb = NLAT + b * CL; dstb = Wc + WC_CTX_OFF; }
                    const int sr = tid >> 3, cc = (tid & 7) * 8, s = s0 + sr;
                    float x1[8], vv[8];
#pragma unroll
                    for (int e = 0; e < 8; ++e) { x1[e] = cb[D + c0 + cc + e]; vv[e] = cb[2 * D + c0 + cc + e]; }
#pragma unroll
                    for (int tap = 0; tap < 3; ++tap) { const int sp = s + tap - 1;
                        if (sp >= 0 && sp < Ls) { const bf16_t* ur = Upre + (size_t)(rowb + sp) * NHY + c0 + cc; const u32x4 a = *(const u32x4*)(ur + D), bq = *(const u32x4*)(ur + 2 * D);
                            const float* w1 = cw + tap * NHY + D + c0 + cc; const float* w2 = cw + tap * NHY + 2 * D + c0 + cc;
                            const float af[8] = {bflo(a.x), bfhi(a.x), bflo(a.y), bfhi(a.y), bflo(a.z), bfhi(a.z), bflo(a.w), bfhi(a.w)};
                            const float bf[8] = {bflo(bq.x), bfhi(bq.x), bflo(bq.y), bfhi(bq.y), bflo(bq.z), bfhi(bq.z), bflo(bq.w), bfhi(bq.w)};
#pragma unroll
                            for (int e = 0; e < 8; ++e) { x1[e] += af[e] * w1[e]; vv[e] += bf[e] * w2[e]; } } }
                    __syncthreads();
#pragma unroll
                    for (int e = 0; e < 8; ++e) T[(cc + e) * 72 + sr] = (bf16_t)f2bf(x1[e] * vv[e]);
                    __syncthreads();
                    { const int c = tid >> 3, sc = (tid & 7) * 8; const u32x4 w = *(const LAS u32x4*)(T + c * 72 + sc);
                      *(u32x4*)(dstb + ((size_t)(c0 + c) * NB + b) * Ls + s0 + sc) = w; }
                }
            }
            SEAM(pb + 1);
            if (EN_CONV && IN(pb + 2)) {
                const int nlat_u = 1024, nctx_u = ctx_live ? 1024 : 0;
                for (int u = bid; u < nlat_u + nctx_u; u += G) {
                    if (u < nlat_u) { const int c = u; conv_channel<SEQ>(lds, (const bf16_t*)(ws + (jm == 0 ? WS_FI0 : WS_FI1)) + (size_t)c * 8 * FP_L, Wc + (size_t)c * NB * SEQ, Yc + (size_t)c * NB * SEQ, tid, lane, wave); }
                    else { const int c = u - nlat_u; conv_channel<CL>(lds, (const bf16_t*)(ws + WS_FI2) + (size_t)c * 8 * FP_C, Wc + WC_CTX_OFF + (size_t)c * NB * CL, Yc + WC_CTX_OFF + (size_t)c * NB * CL, tid, lane, wave); }
                }
            }
            SEAM(pb + 2);
            if (EN_MISC && IN(pb + 3)) {
                LAS bf16_t* T = (LAS bf16_t*)lds;
                const int nlat_u = NB * 32 * 16, nctx_u = ctx_live ? NB * 4 * 16 : 0;
                for (int u = bid; u < nlat_u + nctx_u; u += G) {
                    int b, s0, c0, Ls, rowb; const bf16_t* srcb;
                    if (u < nlat_u) { b = u >> 9; s0 = ((u >> 4) & 31) * 64; c0 = (u & 15) * 64; Ls = SEQ; rowb = b * SEQ; srcb = Yc; }
                    else { const int q = u - nlat_u; b = q >> 6; s0 = ((q >> 4) & 3) * 64; c0 = (q & 15) * 64; Ls = CL; rowb = NLAT + b * CL; srcb = Yc + WC_CTX_OFF; }
                    __syncthreads();
                    { const int c = tid >> 3, sc = (tid & 7) * 8; *(LAS u32x4*)(T + c * 72 + sc) = *(const u32x4*)(srcb + ((size_t)(c0 + c) * NB + b) * Ls + s0 + sc); }
                    __syncthreads();
                    const int sr = tid >> 3, cc = (tid & 7) * 8, s = s0 + sr;
                    float x0[8];
#pragma unroll
                    for (int e = 0; e < 8; ++e) x0[e] = cb[c0 + cc + e];
#pragma unroll
                    for (int tap = 0; tap < 3; ++tap) { const int sp = s + tap - 1;
                        if (sp >= 0 && sp < Ls) { const u32x4 a = *(const u32x4*)(Upre + (size_t)(rowb + sp) * NHY + c0 + cc); const float* w0 = cw + tap * NHY + c0 + cc;
                            const float af[8] = {bflo(a.x), bfhi(a.x), bflo(a.y), bfhi(a.y), bflo(a.z), bfhi(a.z), bflo(a.w), bfhi(a.w)};
#pragma unroll
                            for (int e = 0; e < 8; ++e) x0[e] += af[e] * w0[e]; } }
                    float z[8];
#pragma unroll
                    for (int e = 0; e < 8; ++e) z[e] = x0[e] * bf2f(T[(cc + e) * 72 + sr]);
                    u32x4 o; o.x = pk2(z[0], z[1]); o.y = pk2(z[2], z[3]); o.z = pk2(z[4], z[5]); o.w = pk2(z[6], z[7]);
                    *(u32x4*)(hA + (size_t)(rowb + s) * D + c0 + cc) = o;
                }
            }
            SEAM(pb + 3);
            if (EN_GEMM && IN(pb + 4)) {
                EpiResid E{resL, resC, out, ctxbuf, mo + 2 * D, args.in[I_HBOUT] + (size_t)jm * D};
                const bf16_t* Wt = Wout_t + (size_t)jm * D * D;
                const DenseSched S{hA, Wt, nrows / 256, 4, G, bid};
                run_gemm(lds, S, E);
            }
            SEAM(pb + 4);
        }

        gu32* cnt = ctl + CW_CNT + layer * 32 * 64;
        if (EN_ROUTER && IN(pb + 5)) {
            LAS float* WrT = (LAS float*)lds;
            __syncthreads();
            { const float* rw = args.in[I_RW] + (size_t)layer * D * NE;
              for (int i = tid; i < D * NE; i += NTHR) { const int k = i >> 5, e = i & 31; WrT[e * D + k] = rw[i]; } }
            __syncthreads();
            const float* rb = args.in[I_RB] + layer * NE; const float* g2 = args.in[I_N2G] + layer * D;
            for (int r = gw; r < nrows; r += NGW) {
                const float* src = r < NLAT ? out + (size_t)r * D : ctxbuf + (size_t)(r - NLAT) * D;
                f32x4 v[4], h[4];
#pragma unroll
                for (int j = 0; j < 4; ++j) v[j] = ((const f32x4*)src)[lane + 64 * j];
                const float* mr = mo + (size_t)mod_row(r) * MODW;
                norm_mod_store(v, g2, mr + 3 * D, mr + 4 * D, hA + (size_t)r * D, lane, h);
                float p[32];
                asm volatile("" ::: "memory");
#pragma unroll
                for (int e = 0; e < 32; ++e) { float a = 0.f; if ((e & 3) == 0) asm volatile("" ::: "memory");
#pragma unroll
                    for (int j = 0; j < 4; ++j) { const f32x4 w = *(const LAS f32x4*)(WrT + e * D + 256 * j + 4 * lane); a += (h[j][0] * w[0] + h[j][1] * w[1]) + (h[j][2] * w[2] + h[j][3] * w[3]); }
                    p[e] = a; }
#pragma unroll
                for (int i = 0; i < 16; ++i) { const bool up = (lane & 32) != 0; const float send = up ? p[i] : p[i + 16], keep = up ? p[i + 16] : p[i]; p[i] = keep + __shfl_xor(send, 32); }
#pragma unroll
                for (int i = 0; i < 8; ++i) { const bool up = (lane & 16) != 0; const float send = up ? p[i] : p[i + 8], keep = up ? p[i + 8] : p[i]; p[i] = keep + __shfl_xor(send, 16); }
#pragma unroll
                for (int i = 0; i < 4; ++i) { const bool up = (lane & 8) != 0; const float send = up ? p[i] : p[i + 4], keep = up ? p[i + 4] : p[i]; p[i] = keep + __shfl_xor(send, 8); }
#pragma unroll
                for (int i = 0; i < 2; ++i) { const bool up = (lane & 4) != 0; const float send = up ? p[i] : p[i + 2], keep = up ? p[i + 2] : p[i]; p[i] = keep + __shfl_xor(send, 4); }
                { const bool up = (lane & 2) != 0; const float send = up ? p[0] : p[1], keep = up ? p[1] : p[0]; p[0] = keep + __shfl_xor(send, 2); }
                p[0] += __shfl_xor(p[0], 1);
                const int myE = lane >> 1;
                float val = p[0] + rb[myE];
                float sv[4]; int si[4];
#pragma unroll
                for (int k = 0; k < 4; ++k) { float bv = val; int bi = myE;
#pragma unroll
                    for (int off = 1; off < 64; off <<= 1) { const float ov = __shfl_xor(bv, off); const int oi = __shfl_xor(bi, off); if (ov > bv || (ov == bv && oi < bi)) { bv = ov; bi = oi; } }
                    sv[k] = bv; si[k] = bi; if (myE == bi) val = -INFINITY; }
                const float e1 = __expf(sv[1] - sv[0]), e2 = __expf(sv[2] - sv[0]), e3 = __expf(sv[3] - sv[0]); const float inv = 1.0f / (1.0f + e1 + e2 + e3);
                if (lane < 4) { const int e = lane == 0 ? si[0] : (lane == 1 ? si[1] : (lane == 2 ? si[2] : si[3])); const float gt = (lane == 0 ? 1.0f : (lane == 1 ? e1 : (lane == 2 ? e2 : e3))) * inv;
                    const unsigned pos = __hip_atomic_fetch_add(cnt + e * 64, 1u, RLX_AGENT);
                    top_e[r * 4 + lane] = e; ppos[r * 4 + lane] = (int)pos; pgate[r * 4 + lane] = gt; elist[(size_t)e * NTOK + pos] = r; }
            }
        }
        SEAM(pb + 5);
        LAS int* PADS = (LAS int*)(lds + LDS_BYTES - 4096);
        LAS unsigned char* TE = (LAS unsigned char*)(PADS + 128);
        if (IN(pb + 7) || IN(pb + 8) || IN(pb + 9)) {
            __syncthreads();
            if (tid < 32) PADS[64 + tid] = (int)__hip_atomic_load(cnt + tid * 64, RLX_AGENT);
            __syncthreads();
            if (tid == 0) { int a = 0; for (int e = 0; e < 32; ++e) { PADS[e] = a; const int nt = (PADS[64 + e] + 255) >> 8; for (int t = 0; t < nt; ++t) TE[(a >> 8) + t] = (unsigned char)e; a += nt * 256; } PADS[32] = a; }
            __syncthreads();
        }
        if (EN_GEMM && IN(pb + 7)) {
            const int ntile = PADS[32] >> 8;
            LAS int* ROWS = (LAS int*)(lds + 131072);
            { Unit uu; for (int ui = 0; xcd_unit(ui, G, bid, ntile, 8, uu.pm, uu.pn); ++ui) { if (tid < 256) { const int e = TE[uu.pm]; const int pos = uu.pm * 256 - PADS[e] + tid;
                  ROWS[ui * 256 + tid] = pos < PADS[64 + e] ? elist[(size_t)e * NTOK + pos] : 0; } } }
            __syncthreads();
            const MoeGatherSched S{hA, Wgu_t + (size_t)layer * NE * NGU * D, TE, ROWS, ntile, 8, NGU, G, bid};
            const EpiSwiglu E{AB, args.in[I_BGU] + (size_t)layer * NE * NGU};
            run_gemm_gather(lds, S, E);
        }
        SEAM(pb + 7);
        if (EN_GEMM && IN(pb + 8)) {
            const int ntile = PADS[32] >> 8;
            const MoeSched S{AB, Wdn_t + (size_t)layer * NE * D * D, TE, ntile, 4, D, G, bid};
            const EpiBiasBf16 E{XS, D, args.in[I_BDN] + (size_t)layer * NE * D, D};
            run_gemm(lds, S, E);
        }
        SEAM(pb + 8);
        if (EN_MISC && IN(pb + 9)) {
            const bool has_next = layer + 1 < DEPTH;
            const float* mo_n = modf + (size_t)(layer + 1) * NMODROW * MODW; const float* g1n = args.in[I_N1G] + (has_next ? (layer + 1) * D : 0);
            const int nnext = (layer + 1 < 3) ? NTOK : NLAT;
            for (int r = gw; r < nrows; r += NGW) {
                float* xr = r < NLAT ? out + (size_t)r * D : ctxbuf + (size_t)(r - NLAT) * D;
                const float* mr = mo + (size_t)mod_row(r) * MODW + 5 * D;
                f32x4 y[4];
#pragma unroll
                for (int j = 0; j < 4; ++j) y[j] = (f32x4){0.f, 0.f, 0.f, 0.f};
#pragma unroll
                for (int k = 0; k < 4; ++k) { const int dest = PADS[top_e[r * 4 + k]] + ppos[r * 4 + k]; const float gt = pgate[r * 4 + k]; const u32x2* yr = (const u32x2*)(XS + (size_t)dest * D);
#pragma unroll
                    for (int j = 0; j < 4; ++j) { const u32x2 w = yr[lane + 64 * j]; y[j][0] += gt * bflo(w.x); y[j][1] += gt * bfhi(w.x); y[j][2] += gt * bflo(w.y); y[j][3] += gt * bfhi(w.y); } }
                f32x4 v[4], h[4];
#pragma unroll
                for (int j = 0; j < 4; ++j) { const f32x4 g = ((const f32x4*)mr)[lane + 64 * j]; v[j] = ((const f32x4*)xr)[lane + 64 * j] + g * y[j]; ((f32x4*)xr)[lane + 64 * j] = v[j]; }
                if (has_next && r < nnext) { const float* mn = mo_n + (size_t)mod_row(r) * MODW; norm_mod_store(v, g1n, mn, mn + D, hA + (size_t)r * D, lane, h); }
            }
        }
        SEAM(pb + 9);
}

__global__ void __launch_bounds__(NTHR, 2) fwd(Args args) {
    extern __shared__ __attribute__((aligned(16))) unsigned char lds_raw[];
    LAS unsigned char* lds = (LAS unsigned char*)lds_raw;
    const int tid = threadIdx.x, lane = tid & 63, wave = __builtin_amdgcn_readfirstlane(tid >> 6);
    const int G = gridDim.x, bid = blockIdx.x;
    const int gw = bid * NWAVES + wave, NGW = G * NWAVES;
    unsigned char* ws = args.ws;
    gu32* ctl = (gu32*)(ws + WS_CTL);
    volatile LAS unsigned* MISC = (volatile LAS unsigned*)(lds + MISC_OFF);
    if (tid < 64) MISC[tid] = 0u;
    __syncthreads();
    XcdBarrier bar; bar.bar = (unsigned*)ctl + CW_BAR; bar.x = 0; bar.st = MISC + 8;
    const int lo = args.ph_lo, hi = args.ph_hi;
    if (hi - lo > 1) bar = xcd_barrier_post((unsigned*)ctl + CW_BAR, MISC + 8);

    KLOCALS

    if (EN_PRO && IN(0)) {
        {
            LAS float* scr = (LAS float*)(lds + wave * 8448);
            constexpr int IT_QKV = 16 * (NQKV / 32), IT_SQ = 16 * (D / 32), IT_IN = 16 * (NHY / 32), IT_GU = 16 * (NGU / 32);
            constexpr int N0 = 2 * IT_QKV, N1 = N0 + 2 * IT_SQ, N2 = N1 + 2 * IT_IN, N3 = N2 + 2 * IT_SQ, N4 = N3 + 128 * IT_GU, N5 = N4 + 128 * IT_SQ;
            for (int it = gw; it < N5; it += NGW) {
                if (it < N0) { const int mtx = it / IT_QKV, r = it % IT_QKV; transpose_item<1>(args.in[I_WQKV] + (size_t)mtx * D * NQKV, NQKV, Wqkv_t + (size_t)mtx * NQKV * D, scr, r, lane); }
                else if (it < N1) { const int q = it - N0, mtx = q / IT_SQ, r = q % IT_SQ; transpose_item<0>(args.in[I_WO] + (size_t)mtx * D * D, D, Wo_t + (size_t)mtx * D * D, scr, r, lane); }
                else if (it < N2) { const int q = it - N1, mtx = q / IT_IN, r = q % IT_IN; transpose_item<0>(args.in[I_HWIN] + (size_t)mtx * D * NHY, NHY, Win_t + (size_t)mtx * NHY * D, scr, r, lane); }
                else if (it < N3) { const int q = it - N2, mtx = q / IT_SQ, r = q % IT_SQ; transpose_item<0>(args.in[I_HWOUT] + (size_t)mtx * D * D, D, Wout_t + (size_t)mtx * D * D, scr, r, lane); }
                else if (it < N4) { const int q = it - N3, mtx = q / IT_GU, r = q % IT_GU; transpose_item<2>(args.in[I_WGU] + (size_t)mtx * D * NGU, NGU, Wgu_t + (size_t)mtx * NGU * D, scr, r, lane); }
                else { const int q = it - N4, mtx = q / IT_SQ, r = q % IT_SQ; transpose_item<0>(args.in[I_WDN] + (size_t)mtx * D * D, D, Wdn_t + (size_t)mtx * D * D, scr, r, lane); }
            }
        }
        __syncthreads();
        {
            LAS float* S = (LAS float*)lds;
            for (int u = bid; u < 4 * 12 * 8; u += G) {
                const int kc = u & 7, cc = (u >> 3) % 12, layer = u / 96;
                __syncthreads();
                for (int i = tid; i < 128 * 20; i += NTHR) { const int k = i / 20, r = i % 20; float v = 0.f;
                    if (r < NMODROW) { const float cv = r < NB ? c_in[r * D + kc * 128 + k] : cctx_in[kc * 128 + k]; v = cv / (1.0f + __expf(-cv)); }
                    S[i] = v; }
                __syncthreads();
                const int col = cc * 512 + tid;
                const float* wp = args.in[I_WMOD] + ((size_t)layer * D + kc * 128) * MODW + col;
                float acc[20];
#pragma unroll
                for (int r = 0; r < 20; ++r) acc[r] = 0.f;
                for (int k = 0; k < 128; ++k) { const float w = wp[(size_t)k * MODW];
#pragma unroll
                    for (int q = 0; q < 5; ++q) { const f32x4 s = *(const LAS f32x4*)(S + k * 20 + 4 * q);
                        acc[4 * q] += s[0] * w; acc[4 * q + 1] += s[1] * w; acc[4 * q + 2] += s[2] * w; acc[4 * q + 3] += s[3] * w; } }
#pragma unroll
                for (int r = 0; r < NMODROW; ++r) modp[((size_t)(kc * 4 + layer) * NMODROW + r) * MODW + col] = acc[r];
            }
        }
        for (int i = bid * NTHR + tid; i < SEQ * 32; i += G * NTHR) {
            const int t = i >> 5, j = i & 31, fi = j & 15; const int pos = (j >> 4) == 0 ? (t >> 6) : (t & 63);
            const float inv = powf(10000.0f, -(float)fi / 16.0f); const float ang = (float)pos * inv;
            cosT[i] = cosf(ang); sinT[i] = sinf(ang);
        }
        {
            __syncthreads();
            LAS float* Z = (LAS float*)lds;
            LAS float* A1 = Z + 8 * 36;
            for (int u = bid; u < 256 + 256 + 32; u += G) {
                const int combo = u < 256 ? 0 : (u < 512 ? 1 : 2); const int ub = combo == 0 ? u : (combo == 1 ? u - 256 : u - 512);
                const int j = combo == 1 ? 1 : 0, Lf = combo == 2 ? CL : SEQ;
                const int tl = tid >> 6, o = tid & 63, t = ub * 8 + tl;
                __syncthreads();
                if (o < 33) { float z;
                    const float tt = (float)t / (float)(Lf - 1), w = 6.283185307179586f * (float)t / (float)Lf;
                    if (o == 0) z = tt; else { const int b = (o - 1) & 15; const float f = 1e-4f + (float)b * ((15.0f - 1e-4f) / 15.0f); z = o <= 16 ? cosf(f * w) : -sinf(f * w); }
                    Z[tl * 36 + o] = z; }
                __syncthreads();
                const float sf = args.in[I_HSF][j * 64 + o];
                { const float* w1 = args.in[I_HW1] + (size_t)j * 33 * 64; float a = args.in[I_HB1][j * 64 + o];
                  for (int i = 0; i < 33; ++i) a += Z[tl * 36 + i] * w1[i * 64 + o];
                  A1[tl * 64 + o] = sinf(sf * a); }
                __syncthreads();
                { const float* w2 = args.in[I_HW2] + (size_t)j * 64 * 64; float a = args.in[I_HB2][j * 64 + o];
                  for (int i = 0; i < 64; ++i) a += A1[tl * 64 + i] * w2[i * 64 + o];
                  a2tab[((size_t)combo * SEQ + t) * 64 + o] = sinf(sf * a); }
            }
        }
    }
    SEAM(0);

    if (EN_PRO && IN(1)) {
        for (int i = bid * NTHR + tid; i < DEPTH * NMODROW * MODW; i += G * NTHR) {
            const int layer = i / (NMODROW * MODW), rem = i % (NMODROW * MODW), col = rem % MODW; float s = args.in[I_BMOD][layer * MODW + col];
#pragma unroll
            for (int kc = 0; kc < 8; ++kc) s += modp[(size_t)(kc * 4 + layer) * NMODROW * MODW + rem];
            modf[i] = s;
        }
        {
            LAS float* W3 = (LAS float*)lds;
            LAS float* RED = W3 + 512;
            LAS float* NRM = RED + 32;
            LAS float* HF = NRM + 4;
            for (int u = bid; u < 3 * 256; u += G) {
                const int combo = u >> 8, cg = u & 255; const int j = combo == 1 ? 1 : 0, Lf = combo == 2 ? CL : SEQ; const int c0 = cg * 4;
                LAS float* HB = HF + 4 * Lf;
                __syncthreads();
                { const int i = tid >> 3, q = tid & 7; const int col = (q >> 2) * 1024 + c0 + (q & 3);
                  W3[i * 8 + q] = args.in[I_HW3][((size_t)j * 64 + i) * 2048 + col]; }
                __syncthreads();
                float b3v[8], dec[4], asum[4] = {0.f, 0.f, 0.f, 0.f};
#pragma unroll
                for (int q = 0; q < 8; ++q) b3v[q] = args.in[I_HB3][j * 2048 + (q >> 2) * 1024 + c0 + (q & 3)];
#pragma unroll
                for (int ch = 0; ch < 4; ++ch) dec[ch] = 3.0701134573253945f + (float)(c0 + ch) * ((15.350567286626972f - 3.0701134573253945f) / 1023.0f);
                for (int t = tid; t < Lf; t += NTHR) {
                    asm volatile("" ::: "memory");
                    const float* ar = a2tab + ((size_t)combo * SEQ + t) * 64; float d[8];
#pragma unroll
                    for (int q = 0; q < 8; ++q) d[q] = b3v[q];
#pragma unroll
                    for (int i4 = 0; i4 < 16; ++i4) { const f32x4 a = *(const f32x4*)(ar + 4 * i4); asm volatile("" ::: "memory");
#pragma unroll
                        for (int e = 0; e < 4; ++e) { const f32x4 w0 = *(const LAS f32x4*)(W3 + (4 * i4 + e) * 8), w1 = *(const LAS f32x4*)(W3 + (4 * i4 + e) * 8 + 4);
                            d[0] += a[e] * w0[0]; d[1] += a[e] * w0[1]; d[2] += a[e] * w0[2]; d[3] += a[e] * w0[3]; d[4] += a[e] * w1[0]; d[5] += a[e] * w1[1]; d[6] += a[e] * w1[2]; d[7] += a[e] * w1[3]; } }
                    const float tt = (float)t / (float)(Lf - 1);
#pragma unroll
                    for (int ch = 0; ch < 4; ++ch) { const float dk = __expf(-tt * dec[ch]); const float f = d[ch] * dk, bb = d[4 + ch] * dk;
                        HF[ch * Lf + t] = f; HB[ch * Lf + t] = bb; asum[ch] += fabsf(f) + (t >= 1 ? fabsf(bb) : 0.f); }
                }
#pragma unroll
                for (int ch = 0; ch < 4; ++ch) { const float s = wave_sum(asum[ch]); if (lane == 0) RED[wave * 4 + ch] = s; }
                __syncthreads();
                if (tid < 4) { float s = 0.f; for (int w = 0; w < 8; ++w) s += RED[w * 4 + tid]; NRM[tid] = 1.0f / (s + EPS); }
                __syncthreads();
                const int P = 2 * Lf + 8, PC8 = P / 8;
                bf16_t* FI = (bf16_t*)(ws + (combo == 0 ? WS_FI0 : (combo == 1 ? WS_FI1 : WS_FI2)));
                for (int q = tid; q < 4 * 8 * PC8; q += NTHR) {
                    const int ch = q / (8 * PC8), r = q % (8 * PC8), cidx = r / PC8, x0 = (r % PC8) * 8;
                    const float nr = NRM[ch], db = args.in[I_HDB][j * 1024 + c0 + ch]; float v[8];
#pragma unroll
                    for (int e = 0; e < 8; ++e) { const int m = Lf - (x0 + e) + cidx; const int am = m < 0 ? -m : m; float g = 0.f;
                        if (am <= Lf - 1) { g = (m >= 0 ? HF[ch * Lf + am] : HB[ch * Lf + am]) * nr; if (m == 0) g += db; }
                        v[e] = g; }
                    u32x4 o; o.x = pk2(v[0], v[1]); o.y = pk2(v[2], v[3]); o.z = pk2(v[4], v[5]); o.w = pk2(v[6], v[7]);
                    *(u32x4*)(FI + ((size_t)((c0 + ch) * 8 + cidx)) * P + x0) = o;
                }
            }
        }
    }
    SEAM(1);

    if (IN(2)) {
        const float* mo = modf;
        for (int r = gw; r < NTOK; r += NGW) {
            const float* src = r < NLAT ? x_in + (size_t)r * D : ctx_in + (size_t)(r - NLAT) * D;
            f32x4 v[4], h[4];
#pragma unroll
            for (int j = 0; j < 4; ++j) v[j] = ((const f32x4*)src)[lane + 64 * j];
            const float* mr = mo + (size_t)mod_row(r) * MODW;
            norm_mod_store(v, args.in[I_N1G], mr, mr + D, hA + (size_t)r * D, lane, h);
        }
    }
    SEAM(2);

    layer_body<0>(args, lds, bar, tid, lane, wave, G, bid, lo, hi);
    layer_body<1>(args, lds, bar, tid, lane, wave, G, bid, lo, hi);
    layer_body<2>(args, lds, bar, tid, lane, wave, G, bid, lo, hi);
    layer_body<3>(args, lds, bar, tid, lane, wave, G, bid, lo, hi);
#undef IN
#undef SEAM
}

extern "C" void kernel_launch(void* const* d_in, const int* in_sizes, int n_in, void* d_out, int out_size, void* d_ws, size_t ws_size, hipStream_t stream) {
    static int grid = 0;
    if (grid == 0) {
        if (n_in != 32 || out_size != NLAT * D || ws_size < WS_END) { fprintf(stderr, "kernel_launch: unexpected problem (n_in %d, out %d, ws %zu)\n", n_in, out_size, ws_size); grid = -1; return; }
        int dev = 0, cus = 0, per_cu = 0;
        if (hipGetDevice(&dev) != hipSuccess || hipDeviceGetAttribute(&cus, hipDeviceAttributeMultiprocessorCount, dev) != hipSuccess) { grid = -1; return; }
        if (hipFuncSetAttribute((const void*)fwd, hipFuncAttributeMaxDynamicSharedMemorySize, LDS_BYTES) != hipSuccess) { fprintf(stderr, "kernel_launch: hipFuncSetAttribute failed\n"); grid = -1; return; }
        if (hipOccupancyMaxActiveBlocksPerMultiprocessor(&per_cu, (const void*)fwd, NTHR, LDS_BYTES) != hipSuccess || per_cu < 1) fprintf(stderr, "kernel_launch: occupancy query says %d\n", per_cu);
        (void)hipGetLastError();
        grid = cus;
    }
    if (grid < 0) return;
    (void)hipMemsetAsync((char*)d_ws + WS_CTL, 0, CTL_ZERO_BYTES, stream);
    Args a{};
    for (int i = 0; i < 32; ++i) a.in[i] = (const float*)d_in[i];
    a.out = (float*)d_out; a.ws = (unsigned char*)d_ws;
    constexpr int NPH = 3 + 10 * DEPTH;
#if MK_ONE_LAUNCH
    a.ph_lo = 0; a.ph_hi = NPH;
    hipLaunchKernelGGL(fwd, dim3(grid), dim3(NTHR), LDS_BYTES, stream, a);
#else
    for (int p = 0; p < NPH; ++p) {
        if (p >= 3) { const int layer = (p - 3) / 10, loc = (p - 3) % 10; if ((layer & 1) == 0 && (loc == 3 || loc == 4)) continue; }
        a.ph_lo = p; a.ph_hi = p + 1;
        hipLaunchKernelGGL(fwd, dim3(grid), dim3(NTHR), LDS_BYTES, stream, a);
    }
#endif
}
```

```cpp
#include <hip/hip_runtime.h>
#include <cstdio>
#include <cstdint>
#include <cmath>
#include <hip/hip_bf16.h>

#ifndef EN_PRO
#define EN_PRO 1
#endif
#ifndef EN_ATT
#define EN_ATT 1
#endif
#ifndef EN_CONV
#define EN_CONV 1
#endif
#ifndef EN_ROUTER
#define EN_ROUTER 1
#endif
#ifndef EN_GEMM
#define EN_GEMM 1
#endif
#ifndef EN_MISC
#define EN_MISC 1
#endif
#ifndef MK_ONE_LAUNCH
#define MK_ONE_LAUNCH 1
#endif

#define GAS __attribute__((address_space(1)))
#define LAS __attribute__((address_space(3)))
typedef unsigned short bf16_t;
typedef short bf16x8 __attribute__((ext_vector_type(8)));
typedef float f32x4 __attribute__((ext_vector_type(4)));
typedef float f32x2 __attribute__((ext_vector_type(2)));
typedef unsigned u32x4 __attribute__((ext_vector_type(4)));
typedef unsigned u32x2 __attribute__((ext_vector_type(2)));
typedef GAS unsigned gu32;
typedef float f32x16 __attribute__((ext_vector_type(16)));

constexpr int D = 1024, NB = 16, SEQ = 2048, CL = 256, KVL = SEQ + CL;
constexpr int NLAT = NB * SEQ, NCTX = NB * CL, NTOK = NLAT + NCTX;
constexpr int NE = 32, TOPK = 4, DEPTH = 4;
constexpr int MODW = 6 * D, NMODROW = NB + 1;
constexpr int NQKV = 1536, NHY = 3072, NGU = 2048;
constexpr float EPS = 1e-6f;
constexpr float C2 = 0.125f * 1.4426950408889634f;
constexpr int NWAVES = 8, NTHR = 512;
constexpr int NPADROWS = 155648;
constexpr int MAXTILES = NPADROWS / 256;

constexpr size_t MiB = 1u << 20;
constexpr size_t WS_CTL = 0, CTL_ZERO_BYTES = 1 * MiB;
constexpr size_t WS_MODP = 2 * MiB;
constexpr size_t WS_MOD = 16 * MiB;
constexpr size_t WS_ROPE = 18 * MiB;
constexpr size_t WS_A2 = 19 * MiB;
constexpr size_t WS_PAIR = 21 * MiB;
constexpr size_t WS_CTX = 24 * MiB;
constexpr size_t WS_FI = 40 * MiB;
constexpr int FP_L = 2 * SEQ + 8, FP_C = 2 * CL + 8;
constexpr size_t FI_L_BYTES = (size_t)1024 * 8 * FP_L * 2, FI_C_BYTES = (size_t)1024 * 8 * FP_C * 2;
constexpr size_t WS_FI0 = WS_FI, WS_FI1 = WS_FI0 + 65 * MiB, WS_FI2 = WS_FI1 + 65 * MiB;
static_assert(FI_L_BYTES <= 65 * MiB && WS_FI2 + FI_C_BYTES <= 180 * MiB, "filter map");
constexpr size_t WS_WQKV = 180 * MiB, WS_WO = 186 * MiB, WS_WIN = 190 * MiB, WS_WOUT = 202 * MiB, WS_WGU = 206 * MiB, WS_WDN = 718 * MiB;
constexpr size_t WS_HA = 974 * MiB;
constexpr size_t WS_Q = 1046 * MiB;
constexpr size_t WS_K = 1118 * MiB, WS_V = 1136 * MiB;
constexpr size_t WS_UPRE = 1154 * MiB;
constexpr size_t WS_WC = 1370 * MiB;
constexpr size_t WS_YC = 1442 * MiB;
constexpr size_t WS_XS = 1514 * MiB;
constexpr size_t WS_AB = 1818 * MiB;
constexpr size_t WS_ELIST = 2122 * MiB;
constexpr size_t WS_XB = 2128 * MiB;
constexpr size_t WS_END = 2200 * MiB;
constexpr size_t WC_CTX_OFF = (size_t)1024 * 16 * 2048;
constexpr int CW_TMO = 0, CW_BAR = 4096, CW_CNT = 16384;

constexpr int LDS_BYTES = 160 * 1024;
constexpr int MISC_OFF = LDS_BYTES - 256;

#define RLX_AGENT __ATOMIC_RELAXED, __HIP_MEMORY_SCOPE_AGENT
#define LDS_WAIT() asm volatile("s_waitcnt lgkmcnt(0)" ::: "memory")
#define VM_WAIT() asm volatile("s_waitcnt vmcnt(0)" ::: "memory")
__device__ __forceinline__ unsigned f2bf(float f) { unsigned u = __builtin_bit_cast(unsigned, f); return (u + 0x7fffu + ((u >> 16) & 1u)) >> 16; }
typedef __bf16 bf16x2_t __attribute__((ext_vector_type(2)));
__device__ __forceinline__ unsigned pk2(float lo, float hi) { const f32x2 v = {lo, hi}; const bf16x2_t b = __builtin_convertvector(v, bf16x2_t); return __builtin_bit_cast(unsigned, b); }
__device__ __forceinline__ float bf2f(unsigned h) { return __builtin_bit_cast(float, h << 16); }
__device__ __forceinline__ float bflo(unsigned w) { return __builtin_bit_cast(float, w << 16); }
__device__ __forceinline__ float bfhi(unsigned w) { return __builtin_bit_cast(float, w & 0xffff0000u); }
__device__ __forceinline__ float wave_sum(float v) {
#pragma unroll
    for (int o = 1; o < 64; o <<= 1) v += __shfl_xor(v, o);
    return v;
}

#define XB_TMO      128
#define XB_XCNT(j)  (256  + 64 * (j))
#define XB_XSUB(j)  (1280 + 64 * (j))
#define XB_XGEN(j)  (2304 + 64 * (j))
#define XB_TOP      3328
#define XB_TOPGEN   3392
#define XCD_BAR_WORDS 3456
#define XB_SPIN_CAP (1u << 22)
__device__ __forceinline__ unsigned xb_ld(unsigned* p)              { return __hip_atomic_load(p, __ATOMIC_RELAXED, __HIP_MEMORY_SCOPE_AGENT); }
__device__ __forceinline__ unsigned xb_add(unsigned* p, unsigned v) { return __hip_atomic_fetch_add(p, v, __ATOMIC_RELAXED, __HIP_MEMORY_SCOPE_AGENT); }
__device__ __forceinline__ unsigned xb_xcc_id() { return (unsigned)__builtin_amdgcn_s_getreg((3 << 11) | 20) & 0xFu; }
#define XB_SPIN(cond, bar) do { unsigned _sp = 0; while (cond) { __builtin_amdgcn_s_sleep(1); \
    if ((++_sp & 255u) == 0u) { if (xb_ld(&(bar)[XB_TMO])) break; if (_sp > XB_SPIN_CAP) { atomicAdd(&(bar)[XB_TMO], 1u); break; } } } } while (0)
struct XcdBarrier { unsigned* bar; unsigned x; volatile LAS unsigned* st; };
__device__ __forceinline__ XcdBarrier xcd_barrier_post(unsigned* bar, volatile LAS unsigned* st) {
    XcdBarrier b; b.bar = bar; b.x = xb_xcc_id(); b.st = st;
    if (threadIdx.x == 0) (void)xb_add(&bar[XB_XCNT(b.x)], 1u);
    return b;
}
__device__ __forceinline__ void xcd_barrier_complete(unsigned* bar, unsigned x, unsigned& nloc, unsigned& nx) {
    const unsigned G = gridDim.x * gridDim.y * gridDim.z;
    unsigned sum, cnt, mine, sp = 0u;
    for (;;) {
        sum = 0u; cnt = 0u; mine = 0u;
#pragma unroll
        for (unsigned j = 0; j < 16; ++j) { const unsigned c = xb_ld(&bar[XB_XCNT(j)]); sum += c; cnt += (c > 0u) ? 1u : 0u; mine = (j == x) ? c : mine; }
        if (sum == G) break;
        __builtin_amdgcn_s_sleep(1);
        if ((++sp & 255u) == 0u) { if (xb_ld(&bar[XB_TMO])) break; if (sp > XB_SPIN_CAP) { atomicAdd(&bar[XB_TMO], 1u); break; } }
    }
    nloc = mine > 0u ? mine : 1u; nx = cnt > 0u ? cnt : 1u;
}
__device__ __forceinline__ void xcd_barrier(const XcdBarrier& b) {
    asm volatile("s_waitcnt vmcnt(0)" ::: "memory");
    __syncthreads();
    if (threadIdx.x == 0) {
        unsigned* bar = b.bar;
        __builtin_amdgcn_s_waitcnt(0);
        unsigned nloc = b.st[0], nx = b.st[1];
        if (nloc == 0u) { xcd_barrier_complete(bar, b.x, nloc, nx); b.st[0] = nloc; b.st[1] = nx; }
        const unsigned old = xb_add(&bar[XB_XSUB(b.x)], 1u);
        const unsigned gen = old / nloc;
        if (old + 1u == (gen + 1u) * nloc) {
            __builtin_amdgcn_fence(__ATOMIC_RELEASE, "agent");
            asm volatile("s_waitcnt vmcnt(0)" ::: "memory");
            const unsigned og = xb_add(&bar[XB_TOP], 1u);
            const unsigned tg = og / nx;
            if (og + 1u == (tg + 1u) * nx) xb_add(&bar[XB_TOPGEN], 1u);
            else XB_SPIN(xb_ld(&bar[XB_TOPGEN]) == tg, bar);
            __builtin_amdgcn_fence(__ATOMIC_ACQUIRE, "agent");
            xb_add(&bar[XB_XGEN(b.x)], 1u);
            asm volatile("s_waitcnt vmcnt(0)" ::: "memory");
        } else {
            XB_SPIN(xb_ld(&bar[XB_XGEN(b.x)]) == gen, bar);
            __builtin_amdgcn_fence(__ATOMIC_ACQUIRE, "agent");
            asm volatile("s_waitcnt vmcnt(0)" ::: "memory");
        }
    }
    __syncthreads();
}

struct Args { const float* in[32]; float* out; unsigned char* ws; int ph_lo, ph_hi; };
struct Ctx {
    LAS unsigned char* lds;
    int tid, lane, wave, G, bid;
    const float* const* in;
};
enum { I_X = 0, I_C, I_CTX, I_CCTX, I_WMOD, I_BMOD, I_N1G, I_N2G, I_WQKV, I_QG, I_KG, I_WO, I_HWIN, I_HBIN, I_HCW, I_HCB, I_HW1, I_HB1, I_HW2, I_HB2, I_HW3, I_HB3,
       I_HSF, I_HDB, I_HWOUT, I_HBOUT, I_RW, I_RB, I_WGU, I_BGU, I_WDN, I_BDN };

__device__ __forceinline__ int mod_row(int r) { return r < NLAT ? (r >> 11) : NB; }

__device__ __forceinline__ void gemm_unit_simple(const bf16_t* At, const bf16_t* Bt, f32x4 (&acc)[2][2][4][2], int wr, int wc, int fr, int fq) {
    constexpr int K = D;
#pragma unroll
    for (int a = 0; a < 2; ++a)
#pragma unroll
        for (int b = 0; b < 2; ++b)
#pragma unroll
            for (int m = 0; m < 4; ++m)
#pragma unroll
                for (int n = 0; n < 2; ++n) acc[a][b][m][n] = (f32x4){0.f, 0.f, 0.f, 0.f};
    const bf16_t* ap = At + (size_t)(wr * 64 + fr) * K + fq * 8;
    const bf16_t* bp = Bt + (size_t)(wc * 32 + fr) * K + fq * 8;
    for (int k0 = 0; k0 < K; k0 += 32) {
        bf16x8 bfr[2][2];
#pragma unroll
        for (int bj = 0; bj < 2; ++bj)
#pragma unroll
            for (int n = 0; n < 2; ++n) bfr[bj][n] = *(const bf16x8*)(bp + (size_t)(bj * 128 + n * 16) * K + k0);
#pragma unroll
        for (int ai = 0; ai < 2; ++ai)
#pragma unroll
            for (int m = 0; m < 4; ++m) {
                const bf16x8 afr = *(const bf16x8*)(ap + (size_t)(ai * 128 + m * 16) * K + k0);
#pragma unroll
                for (int bj = 0; bj < 2; ++bj)
#pragma unroll
                    for (int n = 0; n < 2; ++n) acc[ai][bj][m][n] = __builtin_amdgcn_mfma_f32_16x16x32_bf16(bfr[bj][n], afr, acc[ai][bj][m][n], 0, 0, 0);
            }
    }
}


struct Unit { int pm, pn, e; };
namespace pg8 {
constexpr int BM = 256, BK = 64, HALF = 128, HTB = HALF * BK * 2, STAGE_BYTES = 8 * HTB;
__device__ __forceinline__ int lds_byte(int r, int c) { const int st = (r >> 4) * 2 + (c >> 5), rr = r & 15, cc = c & 31, ob = rr * 64 + cc * 2; return st * 1024 + (ob ^ (((ob >> 9) & 1) << 5)); }
__device__ __forceinline__ void stage_rc(int b, int& R, int& C) { const int st = b / 1024, sb = b % 1024, swz = sb ^ (((sb >> 9) & 1) << 5); R = (st >> 1) * 16 + swz / 64; C = (st & 1) * 32 + (swz % 64) / 2; }
template <class Epi, class Sched, bool GATHER = false>
__device__ __forceinline__ void gemm_phase(LAS unsigned char* lds, const Sched& S, const Epi& E) {
    constexpr int K = D, nt = K / BK;
    const int tid = threadIdx.x, wid = __builtin_amdgcn_readfirstlane(tid >> 6), lane = tid & 63, wr = wid >> 2, wc = wid & 3, fr = lane & 15, fq = lane >> 4;
    unsigned voffA[2];
#pragma unroll
    for (int i = 0; i < 2; ++i) { int R, C; stage_rc(tid * 16 + i * 8192, R, C); voffA[i] = (unsigned)(R * K + C) * 2u; }
    const size_t kstep = (size_t)(BK * 2);
    const size_t hstep = (size_t)HALF * K * 2;
    const unsigned ldsw = (unsigned)wid * 1024u;
    const int aoff = lds_byte(wr * 64 + fr, fq * 8), boff = lds_byte(wc * 32 + fr, fq * 8);
#define PG8_SA(b, h) (((b) * 2 + (h)) * HTB)
#define PG8_SB(b, h) ((4 + (b) * 2 + (h)) * HTB)
#define PG8_STAGE(bufoff, gbase, voff) do { _Pragma("unroll") for (int _i = 0; _i < 2; ++_i) \
        __builtin_amdgcn_global_load_lds((const unsigned*)((const char*)(gbase) + (voff)[_i]), (LAS unsigned*)(lds + (bufoff) + ldsw + _i * 8192), 16, 0, 0); } while (0)
#define PG8_LDA(dst, b, h) do { _Pragma("unroll") for (int m = 0; m < 4; ++m) _Pragma("unroll") for (int k = 0; k < 2; ++k) dst[m][k] = *(const LAS bf16x8*)(lds + PG8_SA(b, h) + aoff + m * 2048 + k * 1024); } while (0)
#define PG8_LDB(dst, b, h) do { _Pragma("unroll") for (int n = 0; n < 2; ++n) _Pragma("unroll") for (int k = 0; k < 2; ++k) dst[n][k] = *(const LAS bf16x8*)(lds + PG8_SB(b, h) + boff + n * 2048 + k * 1024); } while (0)
#define PG8_MMA(ai, bj, At, Bt) do { __builtin_amdgcn_s_setprio(1); _Pragma("unroll") for (int m = 0; m < 4; ++m) _Pragma("unroll") for (int n = 0; n < 2; ++n) _Pragma("unroll") for (int k = 0; k < 2; ++k) \
        acc[ai][bj][m][n] = __builtin_amdgcn_mfma_f32_16x16x32_bf16(Bt[n][k], At[m][k], acc[ai][bj][m][n], 0, 0, 0); __builtin_amdgcn_s_setprio(0); } while (0)
#define PG8_WAIT_V(n) asm volatile("s_waitcnt vmcnt(" #n ")" ::: "memory")
#define PG8_WAIT_L(n) asm volatile("s_waitcnt lgkmcnt(" #n ")" ::: "memory")
#define PG8_BAR __builtin_amdgcn_s_barrier()
#define PG8_SCHED __builtin_amdgcn_sched_barrier(0)
    unsigned vA[2][2], vN[2][2]; unsigned gR[2], gC[2];
    const char* gA = nullptr;
    if constexpr (GATHER) {
        gA = S.a_base();
#pragma unroll
        for (int i = 0; i < 2; ++i) { gR[i] = voffA[i] / (unsigned)(K * 2); gC[i] = voffA[i] % (unsigned)(K * 2); }
        const LAS int* rw = S.rows(0);
#pragma unroll
        for (int h = 0; h < 2; ++h)
#pragma unroll
            for (int i = 0; i < 2; ++i) { vA[h][i] = (unsigned)rw[h * HALF + gR[i]] * (unsigned)(K * 2) + gC[i]; vN[h][i] = vA[h][i]; }
    }
#define PG8_STAGEA(bufoff, P, V, kt, h) do { if constexpr (GATHER) PG8_STAGE(bufoff, gA + (size_t)(kt) * kstep, V[h]); else PG8_STAGE(bufoff, (P) + (size_t)(kt) * kstep + (size_t)(h) * hstep, voffA); } while (0)
    Unit cur, nxt; int ui = 0;
    if (!S.next(0, cur)) return;
    f32x4 acc[2][2][4][2];
#pragma unroll
    for (int a = 0; a < 2; ++a)
#pragma unroll
        for (int b = 0; b < 2; ++b)
#pragma unroll
            for (int m = 0; m < 4; ++m)
#pragma unroll
                for (int n = 0; n < 2; ++n) acc[a][b][m][n] = (f32x4){0.f, 0.f, 0.f, 0.f};
    bf16x8 At[4][2], B0[2][2], B1[2][2];
    const char* cA = nullptr; if constexpr (!GATHER) cA = S.a_ptr(cur);
    const char* cB = S.b_ptr(cur);
    PG8_STAGE(PG8_SB(0, 0), cB, voffA); PG8_STAGE(PG8_SB(0, 1), cB + hstep, voffA); PG8_STAGEA(PG8_SA(0, 0), cA, vA, 0, 0); PG8_STAGEA(PG8_SA(0, 1), cA, vA, 0, 1);
    if (wr == 1) PG8_BAR;
    PG8_WAIT_V(2); PG8_BAR;
    PG8_STAGE(PG8_SB(1, 0), cB + kstep, voffA); PG8_STAGEA(PG8_SA(1, 0), cA, vA, 1, 0); PG8_STAGE(PG8_SB(1, 1), cB + hstep + kstep, voffA);
    PG8_WAIT_V(6); PG8_BAR;
    for (;;) {
        const bool has_next = S.next(ui + 1, nxt);
        const char* nA = cA; if constexpr (!GATHER) { if (has_next) nA = S.a_ptr(nxt); }
        const char* nB = has_next ? S.b_ptr(nxt) : cB;
        if constexpr (GATHER) { if (has_next) { const LAS int* rw = S.rows(ui + 1);
#pragma unroll
            for (int h = 0; h < 2; ++h)
#pragma unroll
                for (int i = 0; i < 2; ++i) vN[h][i] = (unsigned)rw[h * HALF + gR[i]] * (unsigned)(K * 2) + gC[i]; } }
        for (int t = 0; t < nt; t += 2) {
            const bool last = (t == nt - 2);
            const char* b2 = last ? nB : cB + (size_t)(t + 2) * kstep; const char* b3 = b2 + kstep;
            const char* pX = last ? nA : cA; const int kX = last ? 0 : t + 2;
            unsigned vX[2][2];
#pragma unroll
            for (int h = 0; h < 2; ++h)
#pragma unroll
                for (int i = 0; i < 2; ++i) vX[h][i] = last ? vN[h][i] : vA[h][i];
            PG8_LDB(B0, 0, 0); PG8_LDB(B1, 0, 1); PG8_SCHED; PG8_LDA(At, 0, 0); PG8_STAGEA(PG8_SA(1, 1), cA, vA, t + 1, 1);
            PG8_WAIT_V(8); PG8_WAIT_L(0); PG8_BAR; PG8_MMA(0, 0, At, B0); PG8_MMA(0, 1, At, B1); PG8_BAR; PG8_SCHED;
            PG8_LDA(At, 0, 1); PG8_STAGE(PG8_SB(0, 0), b2, voffA); PG8_STAGE(PG8_SB(0, 1), b2 + hstep, voffA); PG8_STAGEA(PG8_SA(0, 0), pX, vX, kX, 0);
            PG8_WAIT_V(8); PG8_WAIT_L(0); PG8_BAR; PG8_MMA(1, 0, At, B0); PG8_MMA(1, 1, At, B1); PG8_BAR; PG8_SCHED;
            PG8_LDB(B0, 1, 0); PG8_LDB(B1, 1, 1); PG8_SCHED; PG8_LDA(At, 1, 0); PG8_STAGEA(PG8_SA(0, 1), pX, vX, kX, 1);
            PG8_WAIT_V(8); PG8_WAIT_L(0); PG8_BAR; PG8_MMA(0, 0, At, B0); PG8_MMA(0, 1, At, B1); PG8_BAR; PG8_SCHED;
            PG8_LDA(At, 1, 1); PG8_STAGE(PG8_SB(1, 0), b3, voffA); PG8_STAGE(PG8_SB(1, 1), b3 + hstep, voffA); PG8_STAGEA(PG8_SA(1, 0), pX, vX, kX + 1, 0);
            PG8_WAIT_V(8); PG8_WAIT_L(0); PG8_BAR; PG8_MMA(1, 0, At, B0); PG8_MMA(1, 1, At, B1); PG8_BAR; PG8_SCHED;
        }
        if (wr == 0) PG8_BAR;
        E(acc, cur, wr, wc, fr, fq);
        if (!has_next) break;
#pragma unroll
        for (int a = 0; a < 2; ++a)
#pragma unroll
            for (int b = 0; b < 2; ++b)
#pragma unroll
                for (int m = 0; m < 4; ++m)
#pragma unroll
                    for (int n = 0; n < 2; ++n) acc[a][b][m][n] = (f32x4){0.f, 0.f, 0.f, 0.f};
        cur = nxt; cA = nA; cB = nB; ++ui;
        if constexpr (GATHER) {
#pragma unroll
            for (int h = 0; h < 2; ++h)
#pragma unroll
                for (int i = 0; i < 2; ++i) vA[h][i] = vN[h][i]; }
        if (wr == 1) PG8_BAR;
    }
    PG8_WAIT_V(0);
    PG8_BAR;
#undef PG8_SA
#undef PG8_SB
#undef PG8_STAGE
#undef PG8_STAGEA
#undef PG8_LDA
#undef PG8_LDB
#undef PG8_MMA
#undef PG8_WAIT_V
#undef PG8_WAIT_L
#undef PG8_BAR
#undef PG8_SCHED
}
}

template <class Epi, class Sched>
__device__ __forceinline__ void gemm_phase_simple(const Sched& S, const Epi& E) {
    const int tid = threadIdx.x, wid = __builtin_amdgcn_readfirstlane(tid >> 6), lane = tid & 63, wr = wid >> 2, wc = wid & 3, fr = lane & 15, fq = lane >> 4;
    Unit u;
    for (int i = 0; S.next(i, u); ++i) { f32x4 acc[2][2][4][2];
        gemm_unit_simple((const bf16_t*)S.a_ptr(u), (const bf16_t*)S.b_ptr(u), acc, wr, wc, fr, fq);
        E(acc, u, wr, wc, fr, fq); }
}
#ifndef FAST_GEMM
#define FAST_GEMM 1
#endif
template <class Epi, class Sched>
__device__ __forceinline__ void run_gemm(LAS unsigned char* lds, const Sched& S, const Epi& E) {
#if FAST_GEMM
    pg8::gemm_phase<Epi, Sched, false>(lds, S, E);
#else
    gemm_phase_simple<Epi, Sched>(S, E);
#endif
}
template <class Epi, class Sched>
__device__ __forceinline__ void run_gemm_gather(LAS unsigned char* lds, const Sched& S, const Epi& E) { pg8::gemm_phase<Epi, Sched, true>(lds, S, E); }
__device__ __forceinline__ bool xcd_unit(int i, int G, int c, int nM, int nN, int& pm, int& pn) {
    const int x = c & 7, s = c >> 3, nS = G >> 3;
    const int r0 = (nM * x) >> 3, r1 = (nM * (x + 1)) >> 3;
    const int q = i * nS + s; if (q >= (r1 - r0) * nN) return false;
    const int rr = q / nN; pm = r0 + rr; pn = q - rr * nN; return true;
}
struct DenseSched {
    const bf16_t* A; const bf16_t* Bt; int nM, nN, G, c;
    __device__ __forceinline__ bool next(int i, Unit& u) const { u.e = 0; return xcd_unit(i, G, c, nM, nN, u.pm, u.pn); }
    __device__ __forceinline__ const char* a_ptr(const Unit& u) const { return (const char*)(A + (size_t)u.pm * 256 * D); }
    __device__ __forceinline__ const char* b_ptr(const Unit& u) const { return (const char*)(Bt + (size_t)u.pn * 256 * D); }
};
struct QkvSched {
    const bf16_t* A; const bf16_t* Bt; int live, G, c;
    __device__ __forceinline__ bool next(int i, Unit& u) const { u.e = 0;
        if (live) return xcd_unit(i, G, c, 144, 6, u.pm, u.pn);
        const int x = c & 7, s = c >> 3, nS = G >> 3; const int nlat = 16 * 6; const int q = i * nS + s;
        if (q < nlat) { const int rr = q / 6; u.pm = 16 * x + rr; u.pn = q - rr * 6; return true; }
        const int q2 = q - nlat; if (q2 >= 4) return false; const int t = x * 4 + q2; u.pm = 128 + (t >> 1); u.pn = 4 + (t & 1); return true; }
    __device__ __forceinline__ const char* a_ptr(const Unit& u) const { return (const char*)(A + (size_t)u.pm * 256 * D); }
    __device__ __forceinline__ const char* b_ptr(const Unit& u) const { return (const char*)(Bt + (size_t)u.pn * 256 * D); }
};
struct MoeSched {
    const bf16_t* A; const bf16_t* Bt  ; const LAS unsigned char* TE; int nM, nN, N, G, c;
    __device__ __forceinline__ bool next(int i, Unit& u) const { if (!xcd_unit(i, G, c, nM, nN, u.pm, u.pn)) return false; u.e = TE[u.pm]; return true; }
    __device__ __forceinline__ const char* a_ptr(const Unit& u) const { return (const char*)(A + (size_t)u.pm * 256 * D); }
    __device__ __forceinline__ const char* b_ptr(const Unit& u) const { return (const char*)(Bt + ((size_t)u.e * N + (size_t)u.pn * 256) * D); }
};
struct MoeGatherSched {
    const bf16_t* A; const bf16_t* Bt; const LAS unsigned char* TE; const LAS int* ROWS; int nM, nN, N, G, c;
    __device__ __forceinline__ bool next(int i, Unit& u) const { if (!xcd_unit(i, G, c, nM, nN, u.pm, u.pn)) return false; u.e = TE[u.pm]; return true; }
    __device__ __forceinline__ const char* a_base() const { return (const char*)A; }
    __device__ __forceinline__ const LAS int* rows(int ui) const { return ROWS + ui * 256; }
    __device__ __forceinline__ const char* a_ptr(const Unit& u) const { return (const char*)A; }
    __device__ __forceinline__ const char* b_ptr(const Unit& u) const { return (const char*)(Bt + ((size_t)u.e * N + (size_t)u.pn * 256) * D); }
};

struct EpiQKV {
    bf16_t *Q, *Kb, *Vb; const float *qg, *kg, *cosT, *sinT;
    __device__ __forceinline__ void operator()(const f32x4 (&acc)[2][2][4][2], const Unit& uu, int wr, int wc, int fr, int fq) const {
        const int pm = uu.pm, pn = uu.pn;
        const int kind = pn < 4 ? 0 : (pn == 4 ? 1 : 2);
        const float* gain = kind == 0 ? qg : kg;
        f32x4 gv[2][2];
#pragma unroll
        for (int bj = 0; bj < 2; ++bj)
#pragma unroll
            for (int n = 0; n < 2; ++n) gv[bj][n] = *(const f32x4*)(gain + 32 * bj + 16 * n + 4 * fq);
#pragma unroll
        for (int ai = 0; ai < 2; ++ai)
#pragma unroll
            for (int m = 0; m < 4; ++m) {
                const int r = pm * 256 + ai * 128 + wr * 64 + m * 16 + fr;
                const bool lat = r < NLAT;
                const int b = lat ? (r >> 11) : ((r - NLAT) >> 8);
                const int pos = lat ? (r & (SEQ - 1)) : (SEQ + ((r - NLAT) & (CL - 1)));
                f32x4 v[2][2];
#pragma unroll
                for (int bj = 0; bj < 2; ++bj)
#pragma unroll
                    for (int n = 0; n < 2; ++n) v[bj][n] = acc[ai][bj][m][n];
                if (kind != 2) {
                    float ss = 0.f;
#pragma unroll
                    for (int bj = 0; bj < 2; ++bj)
#pragma unroll
                        for (int n = 0; n < 2; ++n) ss += (v[bj][n][0] * v[bj][n][0] + v[bj][n][1] * v[bj][n][1]) + (v[bj][n][2] * v[bj][n][2] + v[bj][n][3] * v[bj][n][3]);
                    ss += __shfl_xor(ss, 16); ss += __shfl_xor(ss, 32);
                    const float rinv = 1.0f / sqrtf(ss * (1.0f / 64.0f) + EPS);
#pragma unroll
                    for (int bj = 0; bj < 2; ++bj)
#pragma unroll
                        for (int n = 0; n < 2; ++n) v[bj][n] = v[bj][n] * rinv * gv[bj][n];
                    if (lat) {
#pragma unroll
                        for (int bj = 0; bj < 2; ++bj) {
                            const f32x4 cs = *(const f32x4*)(cosT + pos * 32 + bj * 16 + 4 * fq), sn = *(const f32x4*)(sinT + pos * 32 + bj * 16 + 4 * fq);
                            const f32x4 x1 = v[bj][0], x2 = v[bj][1];
                            v[bj][0] = x1 * cs - x2 * sn; v[bj][1] = x2 * cs + x1 * sn;
                        }
                    }
                    if (kind == 0) {
#pragma unroll
                        for (int bj = 0; bj < 2; ++bj)
#pragma unroll
                            for (int n = 0; n < 2; ++n) v[bj][n] = v[bj][n] * C2;
                    }
                }
                bf16_t* dst = kind == 0 ? Q + (size_t)r * D + pn * 256 + wc * 64
                                        : (kind == 1 ? Kb : Vb) + ((size_t)b * KVL + pos) * 256 + wc * 64;
#pragma unroll
                for (int bj = 0; bj < 2; ++bj) { u32x4 w; w.x = pk2(v[bj][0][0], v[bj][0][1]); w.y = pk2(v[bj][0][2], v[bj][0][3]); w.z = pk2(v[bj][1][0], v[bj][1][1]); w.w = pk2(v[bj][1][2], v[bj][1][3]);
                    *(u32x4*)(dst + 32 * bj + 8 * fq) = w; }
            }
    }
};
struct EpiBiasBf16 {
    bf16_t* O; int ldc; const float* bias0; int estride;
    __device__ __forceinline__ void operator()(const f32x4 (&acc)[2][2][4][2], const Unit& uu, int wr, int wc, int fr, int fq) const {
        const int row0 = uu.pm * 256, col0t = uu.pn * 256;
#pragma unroll
        for (int bj = 0; bj < 2; ++bj) {
            const int c = col0t + bj * 128 + wc * 32 + 8 * fq;
            const float* bp = bias0 + (size_t)uu.e * estride + c; const f32x4 b0 = *(const f32x4*)bp, b1 = *(const f32x4*)(bp + 4);
#pragma unroll
            for (int ai = 0; ai < 2; ++ai)
#pragma unroll
                for (int m = 0; m < 4; ++m) { const int r = row0 + ai * 128 + wr * 64 + m * 16 + fr; const f32x4 v0 = acc[ai][bj][m][0] + b0, v1 = acc[ai][bj][m][1] + b1;
                    u32x4 w; w.x = pk2(v0[0], v0[1]); w.y = pk2(v0[2], v0[3]); w.z = pk2(v1[0], v1[1]); w.w = pk2(v1[2], v1[3]); *(u32x4*)(O + (size_t)r * ldc + c) = w; }
        }
    }
};
template <bool SRC32> struct EpiResid {
    const float *srcL, *srcC; bf16_t* XB; const float* gate  ; const float* bias;
    __device__ __forceinline__ void operator()(f32x4 (&acc)[2][2][4][2], const Unit& uu, int wr, int wc, int fr, int fq) const {
        const int row0 = uu.pm * 256, col0t = uu.pn * 256;
        const float* gp0 = gate + (size_t)mod_row(row0) * MODW;
        const float* sb = row0 < NLAT ? srcL + (size_t)row0 * D : srcC + (size_t)(row0 - NLAT) * D;
        bf16_t* xb = XB + (size_t)row0 * D;
#pragma unroll
        for (int bj = 0; bj < 2; ++bj) {
            const int c = col0t + bj * 128 + wc * 32 + 8 * fq;
            const f32x4 g0 = *(const f32x4*)(gp0 + c), g1 = *(const f32x4*)(gp0 + c + 4);
            f32x4 b0 = (f32x4){0.f, 0.f, 0.f, 0.f}, b1 = b0; if (bias) { b0 = *(const f32x4*)(bias + c); b1 = *(const f32x4*)(bias + c + 4); }
#pragma unroll
            for (int ai = 0; ai < 2; ++ai) {
                f32x4 x0[4], x1[4];
#pragma unroll
                for (int m = 0; m < 4; ++m) { const size_t ro = (size_t)(ai * 128 + wr * 64 + m * 16 + fr) * D + c;
                    if constexpr (SRC32) { x0[m] = *(const f32x4*)(sb + ro); x1[m] = *(const f32x4*)(sb + ro + 4); }
                    else { const u32x4 w = *(const u32x4*)(xb + ro); x0[m] = (f32x4){bflo(w.x), bfhi(w.x), bflo(w.y), bfhi(w.y)}; x1[m] = (f32x4){bflo(w.z), bfhi(w.z), bflo(w.w), bfhi(w.w)}; } }
#pragma unroll
                for (int m = 0; m < 4; ++m) { const size_t ro = (size_t)(ai * 128 + wr * 64 + m * 16 + fr) * D + c;
                    const f32x4 y0 = x0[m] + g0 * (acc[ai][bj][m][0] + b0), y1 = x1[m] + g1 * (acc[ai][bj][m][1] + b1);
                    u32x4 w; w.x = pk2(y0[0], y0[1]); w.y = pk2(y0[2], y0[3]); w.z = pk2(y1[0], y1[1]); w.w = pk2(y1[2], y1[3]); *(u32x4*)(xb + ro) = w; }
                asm volatile("" ::: "memory");
            }
        }
    }
};
struct EpiSwiglu {
    bf16_t* O; const float* bgu0  ;
    __device__ __forceinline__ void operator()(const f32x4 (&acc)[2][2][4][2], const Unit& uu, int wr, int wc, int fr, int fq) const {
        const int row0 = uu.pm * 256, pn = uu.pn; const float* bgu = bgu0 + (size_t)uu.e * NGU;
        const int f = pn * 128 + wc * 32 + 8 * fq;
        f32x4 bg[2], bu[2];
#pragma unroll
        for (int n = 0; n < 2; ++n) { const f32x4 q0 = *(const f32x4*)(bgu + 2 * (f + 4 * n)), q1 = *(const f32x4*)(bgu + 2 * (f + 4 * n) + 4);
            bg[n] = (f32x4){q0[0], q0[2], q1[0], q1[2]}; bu[n] = (f32x4){q0[1], q0[3], q1[1], q1[3]}; }
#pragma unroll
        for (int ai = 0; ai < 2; ++ai)
#pragma unroll
            for (int m = 0; m < 4; ++m) { const int r = row0 + ai * 128 + wr * 64 + m * 16 + fr; float o[8];
#pragma unroll
                for (int n = 0; n < 2; ++n) { const f32x4 gg = acc[ai][0][m][n] + bg[n], uq = acc[ai][1][m][n] + bu[n];
#pragma unroll
                    for (int p = 0; p < 2; ++p) {
                        f32x2 g2 = {fminf(gg[2 * p], 7.0f), fminf(gg[2 * p + 1], 7.0f)};
                        f32x2 u2 = {__builtin_amdgcn_fmed3f(uq[2 * p], -7.0f, 7.0f), __builtin_amdgcn_fmed3f(uq[2 * p + 1], -7.0f, 7.0f)};
                        const f32x2 z = g2 * (-2.4554669595930157f);
                        f32x2 e2 = {__builtin_amdgcn_exp2f(z.x), __builtin_amdgcn_exp2f(z.y)};
                        e2 = e2 + 1.0f;
                        const f32x2 r2 = {__builtin_amdgcn_rcpf(e2.x), __builtin_amdgcn_rcpf(e2.y)};
                        const f32x2 o2 = ((u2 + 1.0f) * g2) * r2;
                        o[4 * n + 2 * p] = o2.x; o[4 * n + 2 * p + 1] = o2.y; } }
                u32x4 w; w.x = pk2(o[0], o[1]); w.y = pk2(o[2], o[3]); w.z = pk2(o[4], o[5]); w.w = pk2(o[6], o[7]); *(u32x4*)(O + (size_t)r * D + f) = w; }
    }
};

__device__ __forceinline__ int slot32(int cg) { return (((cg >> 2) & 1) << 4) + ((cg >> 3) << 2) + (cg & 3); }
template <int MODE> __device__ __forceinline__ int wrow_map(int n) {
    if (MODE == 0) return (n & ~31) + slot32(n & 31);
    if (MODE == 1) { const int pn = n >> 8, wc = (n >> 6) & 3, bj = (n >> 5) & 1, j = n & 31;
        return (pn << 8) + (bj << 7) + (wc << 5) + (pn < 5 ? j : slot32(j)); }
    { const int f = n >> 1, pn = f >> 7, fo = f & 127; return (pn << 8) + ((n & 1) << 7) + (fo & ~31) + slot32(fo & 31); }
}
template <int MODE> __device__ __forceinline__ void transpose_item(const float* W, int N, bf16_t* WT, LAS float* scr, int item, int lane) {
    constexpr int K = D;
    const int nblk = N / 32, kb = item / nblk, nb = item % nblk, k0 = 64 * kb, n0 = 32 * nb;
#pragma unroll 8
    for (int i = 0; i < 32; ++i) { const int kk = 2 * i + (lane >> 5); scr[kk * 33 + (lane & 31)] = W[(size_t)(k0 + kk) * N + n0 + (lane & 31)]; }
    LDS_WAIT(); asm volatile("" ::: "memory");
    const int c = lane & 7;
#pragma unroll
    for (int j = 0; j < 4; ++j) { const int n = (lane >> 3) + 8 * j; const LAS float* s = scr + (8 * c) * 33 + n;
        u32x4 o; o.x = pk2(s[0 * 33], s[1 * 33]); o.y = pk2(s[2 * 33], s[3 * 33]); o.z = pk2(s[4 * 33], s[5 * 33]); o.w = pk2(s[6 * 33], s[7 * 33]);
        *(u32x4*)(WT + (size_t)wrow_map<MODE>(n0 + n) * K + k0 + 8 * c) = o; }
    LDS_WAIT(); asm volatile("" ::: "memory");
}

__device__ __forceinline__ void norm_mod_store(const f32x4 (&v)[4], const f32x4 (&gs)[4], const f32x4 (&sh)[4], bf16_t* dst, int lane, f32x4 (&h)[4]) {
    float ss = 0.f;
#pragma unroll
    for (int j = 0; j < 4; ++j) ss += (v[j][0] * v[j][0] + v[j][1] * v[j][1]) + (v[j][2] * v[j][2] + v[j][3] * v[j][3]);
    ss = wave_sum(ss);
    const float rinv = __builtin_amdgcn_rsqf(ss * (1.0f / D) + EPS);
#pragma unroll
    for (int j = 0; j < 4; ++j) {
        h[j] = (v[j] * rinv) * gs[j] + sh[j];
        u32x2 w; w.x = pk2(h[j][0], h[j][1]); w.y = pk2(h[j][2], h[j][3]);
        ((u32x2*)dst)[lane + 64 * j] = w;
    }
}
__device__ __forceinline__ void load_vec_bf(const bf16_t* p, int lane, f32x4 (&v)[4]) {
#pragma unroll
    for (int j = 0; j < 4; ++j) { const u32x2 w = ((const u32x2*)p)[lane + 64 * j]; v[j] = (f32x4){bflo(w.x), bfhi(w.x), bflo(w.y), bfhi(w.y)}; }
}
__device__ __forceinline__ void load_vec(const float* p, int lane, f32x4 (&v)[4]) {
#pragma unroll
    for (int j = 0; j < 4; ++j) v[j] = ((const f32x4*)p)[lane + 64 * j];
}


namespace attn_body {
using bf16=__hip_bfloat16;
using bf16x8=__attribute__((ext_vector_type(8)))short;
using s16x4=__attribute__((ext_vector_type(4)))short;
using f32x16=__attribute__((ext_vector_type(16)))float;
using u32x4=__attribute__((ext_vector_type(4)))unsigned;
constexpr int D=64,DM=1024,KVP=256;
constexpr int NW=8,QBLK=32,QB=QBLK*NW,KVBLK=64;
__device__ __forceinline__ int crow(int r,int hi){return (r&3)+8*(r>>2)+4*hi;}
#define SBAR() __builtin_amdgcn_sched_barrier(0)
__device__ __forceinline__ void cmask(f32x16&p0,f32x16&p1,int jb,int qrel,int hi){
  const float NEG=-INFINITY; int kb=64*jb+4*hi;
  #pragma unroll
  for(int r=0;r<16;++r){int kv=kb+(r&3)+8*(r>>2); if(kv>qrel)p0[r]=NEG; if(kv+32>qrel)p1[r]=NEG;}
}

constexpr int NSLOT=3, SLOTB=8192;
constexpr int LDS_K=0, LDS_V=NSLOT*SLOTB, LDS_WS=2*NSLOT*SLOTB, LDS_OST=LDS_WS+NW*64*4, LDS_BYTES=LDS_OST+NW*4096;
constexpr float C2=0.125f*1.4426950408889634f;
__device__ __forceinline__ void glds16(const void*gsrc,unsigned lds_dst){unsigned keep;
  asm volatile("s_mov_b32 %0, m0\n\ts_mov_b32 m0, %2\n\ts_nop 0\n\tglobal_load_lds_dwordx4 %1, off\n\ts_mov_b32 m0, %0":"=&s"(keep):"v"(gsrc),"s"(lds_dst):"memory");}
__device__ __forceinline__ float max3f(float a,float b,float c){float r;asm("v_max3_f32 %0, %1, %2, %3":"=v"(r):"v"(a),"v"(b),"v"(c));return r;}
__device__ __forceinline__ float max2f(float a,float b){float r;asm("v_max_f32_e32 %0, %1, %2":"=v"(r):"v"(a),"v"(b));return r;}
__device__ __forceinline__ float fadd_s(float a,float b){float r;asm("v_add_f32_e32 %0, %1, %2":"=v"(r):"v"(a),"v"(b));return r;}
__device__ __forceinline__ float fsub_s(float a,float b){float r;asm("v_sub_f32_e32 %0, %1, %2":"=v"(r):"v"(a),"v"(b));return r;}
typedef float f32x2_t __attribute__((ext_vector_type(2))); typedef __bf16 bf16x2_t __attribute__((ext_vector_type(2)));
__device__ __forceinline__ unsigned cvtpk_s(float lo,float hi){f32x2_t v={lo,hi};bf16x2_t b=__builtin_convertvector(v,bf16x2_t);return __builtin_bit_cast(unsigned,b);}
#define WAIT_BAR(N) asm volatile("s_waitcnt vmcnt(" #N ") lgkmcnt(0)\n\ts_barrier":::"memory")

__device__ __forceinline__ void qkt(f32x16&p0,f32x16&p1,const char*Kslot,const bf16x8*qr,const f32x16&negm,int r32,int hi){
  const char*kb=Kslot+hi*1024+r32*16;
  #pragma unroll
  for(int d0=0;d0<4;++d0){
    const bf16x8 b0=*reinterpret_cast<const bf16x8*>(kb+d0*2048);
    const bf16x8 b1=*reinterpret_cast<const bf16x8*>(kb+d0*2048+512);
    if(d0==0){p0=__builtin_amdgcn_mfma_f32_32x32x16_bf16(b0,qr[0],negm,0,0,0);p1=__builtin_amdgcn_mfma_f32_32x32x16_bf16(b1,qr[0],negm,0,0,0);}
    else{p0=__builtin_amdgcn_mfma_f32_32x32x16_bf16(b0,qr[d0],p0,0,0,0);p1=__builtin_amdgcn_mfma_f32_32x32x16_bf16(b1,qr[d0],p1,0,0,0);}}
}
typedef __attribute__((address_space(3))) const char* lds_cptr;
typedef short v4i16_t __attribute__((ext_vector_type(4)));
__device__ __forceinline__ void kload8(bf16x8*kf,lds_cptr kp){
  kf[0]=*(const __attribute__((address_space(3))) bf16x8*)(kp);      kf[1]=*(const __attribute__((address_space(3))) bf16x8*)(kp+512);
  kf[2]=*(const __attribute__((address_space(3))) bf16x8*)(kp+2048); kf[3]=*(const __attribute__((address_space(3))) bf16x8*)(kp+2560);
  kf[4]=*(const __attribute__((address_space(3))) bf16x8*)(kp+4096); kf[5]=*(const __attribute__((address_space(3))) bf16x8*)(kp+4608);
  kf[6]=*(const __attribute__((address_space(3))) bf16x8*)(kp+6144); kf[7]=*(const __attribute__((address_space(3))) bf16x8*)(kp+6656);
}
__device__ __forceinline__ void kload2(bf16x8*kf,lds_cptr kp,int j){ kf[2*j]=*(const __attribute__((address_space(3))) bf16x8*)(kp+j*2048); kf[2*j+1]=*(const __attribute__((address_space(3))) bf16x8*)(kp+j*2048+512); }
__device__ __forceinline__ s16x4 vtr(lds_cptr p){ return __builtin_bit_cast(s16x4,__builtin_amdgcn_ds_read_tr16_b64_v4i16((__attribute__((address_space(3))) v4i16_t*)p)); }
__device__ __forceinline__ float rowmax(const f32x16&p0,const f32x16&p1){
  float a=max3f(p0[0],p0[1],p1[0]),b=max3f(p0[2],p0[3],p1[1]);a=max3f(a,p1[2],p1[3]);
  #pragma unroll
  for(int r=4;r<16;r+=4){a=max3f(a,p0[r],p0[r+1]);b=max3f(b,p0[r+2],p0[r+3]);a=max3f(a,p1[r],p1[r+1]);b=max3f(b,p1[r+2],p1[r+3]);}
  const float m=max2f(a,b);
  auto rr=__builtin_amdgcn_permlane32_swap(__float_as_uint(m),__float_as_uint(m),false,false);
  return max2f(__uint_as_float(rr[0]),__uint_as_float(rr[1]));
}
__device__ __forceinline__ void pv(f32x16*o,int vb,bf16x8 pa0,bf16x8 pa1,bf16x8 pa2,bf16x8 pa3){
  #pragma unroll
  for(int d0=0;d0<2;++d0){s16x4 lo[4],hi[4];
    #pragma unroll
    for(int ks=0;ks<4;++ks){
      asm volatile("ds_read_b64_tr_b16 %0,%1 offset:%c2":"=&v"(lo[ks]):"v"(vb),"i"(d0*4096+ks*1024):"memory");
      asm volatile("ds_read_b64_tr_b16 %0,%1 offset:%c2":"=&v"(hi[ks]):"v"(vb),"i"(d0*4096+ks*1024+512):"memory");}
    asm volatile("s_waitcnt lgkmcnt(0)":::"memory");SBAR();
    #define PK(k) (bf16x8){lo[k][0],lo[k][1],lo[k][2],lo[k][3],hi[k][0],hi[k][1],hi[k][2],hi[k][3]}
    o[d0]=__builtin_amdgcn_mfma_f32_32x32x16_bf16(pa0,PK(0),o[d0],0,0,0);
    o[d0]=__builtin_amdgcn_mfma_f32_32x32x16_bf16(pa1,PK(1),o[d0],0,0,0);
    o[d0]=__builtin_amdgcn_mfma_f32_32x32x16_bf16(pa2,PK(2),o[d0],0,0,0);
    o[d0]=__builtin_amdgcn_mfma_f32_32x32x16_bf16(pa3,PK(3),o[d0],0,0,0);
    #undef PK
  }
}

#ifndef ATTN_STORE16
#define ATTN_STORE16(p,v) (*(u32x4*)(p)=(v))
#endif
template<int THRL> __device__ __forceinline__ void attn_unit(const bf16*Qu,const bf16*__restrict__ Kh,const bf16*__restrict__ Vh,bf16*Ou,const int NT,char*shm){
  const int tid=threadIdx.x,lane=tid&63,r32=lane&31,hi=lane>>5; const int wid=__builtin_amdgcn_readfirstlane(tid>>6);
  const bf16*Qw=Qu+(long)(wid*QBLK)*DM;
  const unsigned lds0=(unsigned)(uintptr_t)shm;
  float*wsf=(float*)(shm+LDS_WS)+wid*64;
  const bf16*ksrc=Kh+(long)lane*KVP+wid*8;
  const bf16*vsrc=Vh+(long)(16*(wid&3)+(lane>>2))*KVP+(wid>>2)*32+(lane&3)*8;
  const unsigned kdst=lds0+LDS_K+wid*1024, vdst=lds0+LDS_V+wid*1024;
  #define DMA_K(t,slot) glds16(ksrc+(long)(t)*KVBLK*KVP,(unsigned)__builtin_amdgcn_readfirstlane(kdst+(slot)))
  #define DMA_V(t,slot) glds16(vsrc+(long)(t)*KVBLK*KVP,(unsigned)__builtin_amdgcn_readfirstlane(vdst+(slot)))
  const int vb0=(int)(lds0+LDS_V)+((lane>>4)&1)*32+(lane&3)*8+(4*hi+((lane&15)>>2))*64;
  const char*Kbase=shm+LDS_K; bf16x8 kf[8];
  const lds_cptr shm3=(lds_cptr)shm; const lds_cptr kp0=shm3+LDS_K+hi*1024+r32*16; const lds_cptr vp0=shm3+LDS_V+((lane>>4)&1)*32+(lane&3)*8+(4*hi+((lane&15)>>2))*64;
  DMA_K(0,0);DMA_V(0,0);DMA_K(1,SLOTB);
  bf16x8 qr[4];
  #pragma unroll
  for(int d0=0;d0<4;++d0)qr[d0]=*reinterpret_cast<const bf16x8*>(&Qw[(long)r32*DM+d0*16+hi*8]);
  float mhat=0.f,l_reg=0.f;f32x16 o[2];o[0]=f32x16{};o[1]=f32x16{};f32x16 negm=f32x16{};asm volatile("":"+v"(negm));
  #define CMASK(P0,P1,t) do{}while(0)
  bool resc=false;
  #define START(P0,P1) do{ const float rm=rowmax(P0,P1); resc=false; \
    { const float dl=rm; mhat=fadd_s(mhat,dl); \
      _Pragma("unroll") for(int r=0;r<16;++r){P0[r]=fsub_s(P0[r],dl);P1[r]=fsub_s(P1[r],dl);} \
      _Pragma("unroll") for(int r=0;r<16;++r)negm[r]=-mhat; asm volatile("":"+v"(negm)); } \
    _Pragma("unroll") for(int r=0;r<16;++r)P0[r]=__builtin_amdgcn_exp2f(P0[r]); }while(0)
  #define RESC() do{ if(resc){ asm volatile("s_waitcnt lgkmcnt(0)":::"memory"); \
      _Pragma("unroll") for(int d_=0;d_<2;++d_) _Pragma("unroll") for(int r=0;r<16;++r)o[d_][r]*=wsf[crow(r,hi)]; } }while(0)
  f32x16 pA0,pA1,pB0,pB1;
  int sl_prev=0,sl_cur=0,sl_next=SLOTB;
  #define ROT() do{sl_prev=sl_cur;sl_cur=sl_next;sl_next=(sl_next==(NSLOT-1)*SLOTB)?0:sl_next+SLOTB;}while(0)
  DMA_K(2,2*SLOTB);
  WAIT_BAR(3);
  qkt(pA0,pA1,Kbase,qr,negm,r32,hi);asm volatile("s_nop 15\n\ts_nop 7":"+v"(pA0),"+v"(pA1));CMASK(pA0,pA1,0);
  START(pA0,pA1);
  _Pragma("unroll") for(int r=0;r<16;++r)pA1[r]=__builtin_amdgcn_exp2f(pA1[r]);
  WAIT_BAR(0);
  DMA_K(3,0);DMA_V(1,SLOTB);
  ROT();
  kload8(kf,kp0+sl_cur);
  WAIT_BAR(2);
  s16x4 vlo[8],vhi[8]; u32x4 pw0,pw1,pw2,pw3;
  #define PKW(P,B) cvtpk_s(P[B],P[B+1])
  #define PAF(k) __builtin_bit_cast(bf16x8,pw##k)
  #define VFR(i) (bf16x8){vlo[i][0],vlo[i][1],vlo[i][2],vlo[i][3],vhi[i][0],vhi[i][1],vhi[i][2],vhi[i][3]}
  #define PIN(x) asm volatile("":"+v"(x))
  #define MX3(a,b,c) __builtin_fmaxf(__builtin_fmaxf((a),(b)),(c))
  #define GAPA(MF,A0,A1,A2,A3,W0,W1,PW) do{ MF; sacc+=A0; sacc+=A1; sacc+=A2; sacc+=A3; PIN(sacc); W0; W1; PIN(PW); SBAR(); }while(0)
  #define EX(v) __builtin_amdgcn_exp2f(v)
  #define GAPB(MF,X,B) do{ MF; X[B]=EX(X[B]); X[B+1]=EX(X[B+1]); X[B+2]=EX(X[B+2]); X[B+3]=EX(X[B+3]); PIN(X); SBAR(); }while(0)
  #define VRD(i) do{ vlo[i]=vtr(vp_+(((i)>>2)*4096+((i)&3)*1024)); vhi[i]=vtr(vp_+(((i)>>2)*4096+((i)&3)*1024+512)); }while(0)
  #define KRD(G,j) do{ if(G){ kload2(kf,kp0+sl_next,j); SBAR(); } }while(0)
  #define STEP(C0,C1,P0,P1,t,GK,GV,GL) do{ SBAR(); \
    const lds_cptr vp_=vp0+sl_prev; \
    VRD(0); SBAR(); float sacc=(P0[0]+P0[1]); \
    GAPA(C0=__builtin_amdgcn_mfma_f32_32x32x16_bf16(kf[0],qr[0],negm,0,0,0), P0[2],P0[3],P0[4],P0[5],     pw0[0]=PKW(P0,0), pw0[1]=PKW(P0,2), pw0); \
    VRD(4); SBAR(); GAPA(C1=__builtin_amdgcn_mfma_f32_32x32x16_bf16(kf[1],qr[0],negm,0,0,0), P0[6],P0[7],P0[8],P0[9],     pw0[2]=PKW(P0,4), pw0[3]=PKW(P0,6), pw0); \
    VRD(1); SBAR(); GAPA(C0=__builtin_amdgcn_mfma_f32_32x32x16_bf16(kf[2],qr[1],C0,0,0,0),   P0[10],P0[11],P0[12],P0[13], pw1[0]=PKW(P0,8), pw1[1]=PKW(P0,10), pw1); \
    VRD(5); SBAR(); GAPA(C1=__builtin_amdgcn_mfma_f32_32x32x16_bf16(kf[3],qr[1],C1,0,0,0),   P0[14],P0[15],P1[0],P1[1],   pw1[2]=PKW(P0,12),pw1[3]=PKW(P0,14), pw1); \
    VRD(2); SBAR(); GAPA(C0=__builtin_amdgcn_mfma_f32_32x32x16_bf16(kf[4],qr[2],C0,0,0,0),   P1[2],P1[3],P1[4],P1[5],     pw2[0]=PKW(P1,0), pw2[1]=PKW(P1,2), pw2); \
    VRD(6); SBAR(); GAPA(C1=__builtin_amdgcn_mfma_f32_32x32x16_bf16(kf[5],qr[2],C1,0,0,0),   P1[6],P1[7],P1[8],P1[9],     pw2[2]=PKW(P1,4), pw2[3]=PKW(P1,6), pw2); \
    VRD(3); SBAR(); GAPA(C0=__builtin_amdgcn_mfma_f32_32x32x16_bf16(kf[6],qr[3],C0,0,0,0),   P1[10],P1[11],P1[12],P1[13], pw3[0]=PKW(P1,8), pw3[1]=PKW(P1,10), pw3); \
    VRD(7); SBAR(); GAPA(C1=__builtin_amdgcn_mfma_f32_32x32x16_bf16(kf[7],qr[3],C1,0,0,0),   P1[14],P1[15],0.f,0.f,       pw3[2]=PKW(P1,12),pw3[3]=PKW(P1,14), pw3); \
    l_reg+=sacc; \
    if(GK){DMA_K((t)+3,sl_cur);} if(GV){DMA_V((t)+1,sl_next);} \
    CMASK(C0,C1,t); \
    { float a=MX3(C0[0],C0[1],C1[0]),b=MX3(C0[2],C0[3],C1[1]); a=MX3(a,C1[2],C1[3]); \
      _Pragma("unroll") for(int r=4;r<16;r+=4){a=MX3(a,C0[r],C0[r+1]);b=MX3(b,C0[r+2],C0[r+3]);a=MX3(a,C1[r],C1[r+1]);b=MX3(b,C1[r+2],C1[r+3]);} \
      float rm=__builtin_fmaxf(a,b); { auto rr=__builtin_amdgcn_permlane32_swap(__float_as_uint(rm),__float_as_uint(rm),false,false); rm=__builtin_fmaxf(__uint_as_float(rr[0]),__uint_as_float(rr[1])); } \
      resc=false; \
      if(__builtin_expect(__any(rm>(float)THRL),0)){ const float dl=__builtin_fmaxf(rm,0.f); mhat+=dl; \
        _Pragma("unroll") for(int r=0;r<16;++r){C0[r]-=dl;C1[r]-=dl;} \
        _Pragma("unroll") for(int r=0;r<16;++r)negm[r]=-mhat; asm volatile("":"+v"(negm)); \
        const float f=__builtin_amdgcn_exp2f(-dl); l_reg*=f; if(hi==0)wsf[r32]=f; resc=true; } } \
    SBAR(); \
    GAPB(o[0]=__builtin_amdgcn_mfma_f32_32x32x16_bf16(PAF(0),VFR(0),o[0],0,0,0), C0,0); \
    GAPB(o[1]=__builtin_amdgcn_mfma_f32_32x32x16_bf16(PAF(0),VFR(4),o[1],0,0,0), C0,4); \
    KRD(GL,0); GAPB(o[0]=__builtin_amdgcn_mfma_f32_32x32x16_bf16(PAF(1),VFR(1),o[0],0,0,0), C0,8); \
    KRD(GL,1); GAPB(o[1]=__builtin_amdgcn_mfma_f32_32x32x16_bf16(PAF(1),VFR(5),o[1],0,0,0), C0,12); \
    KRD(GL,2); GAPB(o[0]=__builtin_amdgcn_mfma_f32_32x32x16_bf16(PAF(2),VFR(2),o[0],0,0,0), C1,0); \
    KRD(GL,3); GAPB(o[1]=__builtin_amdgcn_mfma_f32_32x32x16_bf16(PAF(2),VFR(6),o[1],0,0,0), C1,4); \
    GAPB(o[0]=__builtin_amdgcn_mfma_f32_32x32x16_bf16(PAF(3),VFR(3),o[0],0,0,0), C1,8); \
    GAPB(o[1]=__builtin_amdgcn_mfma_f32_32x32x16_bf16(PAF(3),VFR(7),o[1],0,0,0), C1,12); \
    }while(0)
  int t=1;
  #undef CMASK
  #define CMASK(P0,P1,t) do{}while(0)
  for(;t+5<NT;t+=2){
    STEP(pB0,pB1,pA0,pA1,t,true,true,true);     WAIT_BAR(2); RESC(); ROT();
    STEP(pA0,pA1,pB0,pB1,t+1,true,true,true);   WAIT_BAR(2); RESC(); ROT();
  }
  #undef CMASK
  #define CMASK(P0,P1,t) do{}while(0)
  #define ENDW(tt) do{ if((tt)+3<NT){WAIT_BAR(2);} else if((tt)+2<NT){WAIT_BAR(1);} else {WAIT_BAR(0);} }while(0)
  for(;t+1<NT;t+=2){
    STEP(pB0,pB1,pA0,pA1,t,(t+3<NT),(t+1<NT),(t+1<NT));       ENDW(t);   RESC(); ROT();
    STEP(pA0,pA1,pB0,pB1,t+1,(t+4<NT),(t+2<NT),(t+2<NT));     ENDW(t+1); RESC(); ROT();
  }
  STEP(pB0,pB1,pA0,pA1,NT-1,false,false,false); RESC();
  { float sacc=pB0[0]+pB0[1]; _Pragma("unroll") for(int r=2;r<16;++r)sacc+=pB0[r]; _Pragma("unroll") for(int r=0;r<16;++r)sacc+=pB1[r]; l_reg+=sacc;
    pw0=(u32x4){PKW(pB0,0),PKW(pB0,2),PKW(pB0,4),PKW(pB0,6)};pw1=(u32x4){PKW(pB0,8),PKW(pB0,10),PKW(pB0,12),PKW(pB0,14)};pw2=(u32x4){PKW(pB1,0),PKW(pB1,2),PKW(pB1,4),PKW(pB1,6)};pw3=(u32x4){PKW(pB1,8),PKW(pB1,10),PKW(pB1,12),PKW(pB1,14)};
    SBAR(); pv(o,vb0+sl_cur,PAF(0),PAF(1),PAF(2),PAF(3)); }
  #undef PKW
  #undef PAF
  #undef VFR
  #undef PIN
  #undef MX3
  #undef GAPA
  #undef GAPB
  #undef EX
  #undef VRD
  #undef KRD
  #undef STEP
  #undef ENDW
  {auto rr=__builtin_amdgcn_permlane32_swap(__float_as_uint(l_reg),__float_as_uint(l_reg),false,false);l_reg=__uint_as_float(rr[0])+__uint_as_float(rr[1]);}
  if(hi==0)wsf[32+r32]=l_reg;asm volatile("s_waitcnt lgkmcnt(0)":::"memory");
  float rli[16];
  #pragma unroll
  for(int r=0;r<16;++r)rli[r]=__builtin_amdgcn_rcpf(wsf[32+crow(r,hi)]);
  bf16*Ow=Ou+(long)(wid*QBLK)*DM;
  { bf16*stg=(bf16*)(shm+LDS_OST)+wid*2048;
    #pragma unroll
    for(int r=0;r<16;++r){const int orow=crow(r,hi);
      #pragma unroll
      for(int d0=0;d0<2;++d0)stg[orow*64+d0*32+r32]=__float2bfloat16(o[d0][r]*rli[r]);}
    asm volatile("s_waitcnt lgkmcnt(0)":::"memory");
    #pragma unroll
    for(int i=0;i<4;++i){const int row=i*8+(lane>>3),ch=lane&7; const u32x4 v=*(const u32x4*)(stg+row*64+ch*8); ATTN_STORE16(Ow+(long)row*DM+ch*8,v);} }
  asm volatile("s_waitcnt lgkmcnt(0)\n\ts_barrier":::"memory");
  #undef DMA_K
  #undef DMA_V
  #undef CMASK
  #undef START
  #undef RESC
  #undef ROT
}
constexpr int ATTN_LDS_BYTES=LDS_BYTES;
#undef SBAR
#undef WAIT_BAR
}

template <int LF>
__device__ __forceinline__ void conv_channel(LAS unsigned char* lds, const bf16_t* FIc, const bf16_t* wsrc, bf16_t* ydst, int tid, int lane, int wv) {
    constexpr int IPW = LF / 256, NBK = LF / 32, P = 2 * LF + 8, WSTR = LF + 8;
    LAS unsigned char* FIL = lds; LAS unsigned char* WL = lds + ((8 * P * 2 + 255) & ~255);
    __syncthreads();
    { const u32x4* fs = (const u32x4*)FIc; for (int i = tid; i < 8 * P * 2 / 16; i += NTHR) ((LAS u32x4*)FIL)[i] = fs[i]; }
    for (int i = tid; i < NB * (LF / 8); i += NTHR) { const int b = i / (LF / 8), ch = i % (LF / 8); *(LAS u32x4*)(WL + b * (WSTR * 2) + ch * 16) = *(const u32x4*)(wsrc + (size_t)b * LF + ch * 8); }
    __syncthreads();
    f32x4 acc[IPW][2]; bf16x8 Bw[IPW];
#pragma unroll
    for (int ii = 0; ii < IPW; ++ii) { acc[ii][0] = (f32x4){0.f, 0.f, 0.f, 0.f}; acc[ii][1] = (f32x4){0.f, 0.f, 0.f, 0.f}; Bw[ii] = (bf16x8){0, 0, 0, 0, 0, 0, 0, 0}; }
    const int rr = lane & 15, q = lane >> 4;
    const int aBase = (rr & 7) * (P * 2) + 2 * (LF - (rr - (rr & 7)) + 8 * q);
    const int bBase = rr * (WSTR * 2) + 16 * q;
#define CONV_STEPS(CHECK) do { _Pragma("unroll") for (int dd = 0; dd < IPW; ++dd) { \
        const int delta = IPW * d + dd; \
        const bf16x8 a0 = *(const LAS bf16x8*)(FIL + aBase - 64 * delta), a1 = *(const LAS bf16x8*)(FIL + aBase - 64 * delta - 32); \
        const int jn = IPW * (wv - d) - dd; \
        if (!(CHECK) || (jn >= 0 && jn < NBK)) Bw[(IPW - dd) % IPW] = *(const LAS bf16x8*)(WL + bBase + 64 * jn); \
        _Pragma("unroll") for (int ii = 0; ii < IPW; ++ii) { const int j = IPW * (wv - d) + ii - dd; \
            if (!(CHECK) || (j >= 0 && j < NBK)) { \
                acc[ii][0] = __builtin_amdgcn_mfma_f32_16x16x32_bf16(a0, Bw[(ii - dd + IPW) % IPW], acc[ii][0], 0, 0, 0); \
                acc[ii][1] = __builtin_amdgcn_mfma_f32_16x16x32_bf16(a1, Bw[(ii - dd + IPW) % IPW], acc[ii][1], 0, 0, 0); } } } } while (0)
    { const int d = wv - 8; CONV_STEPS(true); }
    for (int d = wv - 7; d < wv; ++d) { CONV_STEPS(false); }
    { const int d = wv; CONV_STEPS(true); }
#undef CONV_STEPS
#pragma unroll
    for (int ii = 0; ii < IPW; ++ii)
#pragma unroll
        for (int h = 0; h < 2; ++h) { u32x2 w; w.x = pk2(acc[ii][h][0], acc[ii][h][1]); w.y = pk2(acc[ii][h][2], acc[ii][h][3]);
            *(u32x2*)(ydst + (size_t)rr * LF + 32 * (IPW * wv + ii) + 16 * h + 4 * q) = w; }
}


__device__ __forceinline__ void route_reduce(float (&p)[32], int lane) {
#pragma unroll
    for (int i = 0; i < 16; ++i) { const bool up = (lane & 32) != 0; const float send = up ? p[i] : p[i + 16], keep = up ? p[i + 16] : p[i]; p[i] = keep + __shfl_xor(send, 32); }
#pragma unroll
    for (int i = 0; i < 8; ++i) { const bool up = (lane & 16) != 0; const float send = up ? p[i] : p[i + 8], keep = up ? p[i + 8] : p[i]; p[i] = keep + __shfl_xor(send, 16); }
#pragma unroll
    for (int i = 0; i < 4; ++i) { const bool up = (lane & 8) != 0; const float send = up ? p[i] : p[i + 4], keep = up ? p[i + 4] : p[i]; p[i] = keep + __shfl_xor(send, 8); }
#pragma unroll
    for (int i = 0; i < 2; ++i) { const bool up = (lane & 4) != 0; const float send = up ? p[i] : p[i + 2], keep = up ? p[i + 2] : p[i]; p[i] = keep + __shfl_xor(send, 4); }
    { const bool up = (lane & 2) != 0; const float send = up ? p[0] : p[1], keep = up ? p[1] : p[0]; p[0] = keep + __shfl_xor(send, 2); }
    p[0] += __shfl_xor(p[0], 1);
}
__device__ __forceinline__ void route_top4(float val, int myE, float (&sv)[4], int (&si)[4]) {
    int rank = 0;
#pragma unroll
    for (int e = 0; e < 32; ++e) { const float o = __builtin_bit_cast(float, __builtin_amdgcn_readlane(__builtin_bit_cast(int, val), 2 * e)); rank += (o > val || (o == val && e < myE)) ? 1 : 0; }
#pragma unroll
    for (int k = 0; k < 4; ++k) { const unsigned long long m = __ballot(rank == k); const int src = __builtin_ctzll(m);
        si[k] = src >> 1; sv[k] = __builtin_bit_cast(float, __builtin_amdgcn_readlane(__builtin_bit_cast(int, val), src)); }
}
#define IN(k) (lo <= (k) && (k) < hi)
#define SEAM(k) do { if (IN(k) && IN((k) + 1)) xcd_barrier(bar); } while (0)
#define SEAMK(k, kind) SEAM(k)
#define KLOCALS \
    const float* x_in = args.in[I_X]; const float* c_in = args.in[I_C]; const float* ctx_in = args.in[I_CTX]; const float* cctx_in = args.in[I_CCTX]; \
    float* out = args.out; \
    float* modp = (float*)(ws + WS_MODP); float* modf = (float*)(ws + WS_MOD); \
    float* cosT = (float*)(ws + WS_ROPE); float* sinT = cosT + SEQ * 32; \
    float* a2tab = (float*)(ws + WS_A2); \
    int* top_e = (int*)(ws + WS_PAIR); int* ppos = top_e + NTOK * 4; float* pgate = (float*)(ppos + NTOK * 4); int* pdest = (int*)(pgate + NTOK * 4); \
    bf16_t* XB = (bf16_t*)(ws + WS_XB); \
    bf16_t* Wqkv_t = (bf16_t*)(ws + WS_WQKV); bf16_t* Wo_t = (bf16_t*)(ws + WS_WO); bf16_t* Win_t = (bf16_t*)(ws + WS_WIN); bf16_t* Wout_t = (bf16_t*)(ws + WS_WOUT); \
    bf16_t* Wgu_t = (bf16_t*)(ws + WS_WGU); bf16_t* Wdn_t = (bf16_t*)(ws + WS_WDN); \
    bf16_t* hA = (bf16_t*)(ws + WS_HA); bf16_t* Qb = (bf16_t*)(ws + WS_Q); bf16_t* Kb = (bf16_t*)(ws + WS_K); bf16_t* Vb = (bf16_t*)(ws + WS_V); \
    bf16_t* Upre = (bf16_t*)(ws + WS_UPRE); bf16_t* Wc = (bf16_t*)(ws + WS_WC); bf16_t* Yc = (bf16_t*)(ws + WS_YC); \
    bf16_t* XS = (bf16_t*)(ws + WS_XS); bf16_t* AB = (bf16_t*)(ws + WS_AB); int* elist = (int*)(ws + WS_ELIST); \
    const int wr = wave >> 2, wc = wave & 3, fr = lane & 15, fq = lane >> 4;
template <int layer> __device__ __forceinline__ void layer_body(const Args& args, LAS unsigned char* lds, const XcdBarrier& bar, const int tid, const int lane, const int wave, const int G, const int bid, const int lo, const int hi) {
    const int gw = bid * NWAVES + wave, NGW = G * NWAVES;
    unsigned char* ws = args.ws;
    gu32* ctl = (gu32*)(ws + WS_CTL);
    KLOCALS
        const int pb = 3 + 10 * layer;
        const int jm = layer >> 1;
        const bool ctx_live = layer < 2;
        const int nrows = ctx_live ? NTOK : NLAT;
        const float* mo = modf + (size_t)layer * NMODROW * MODW;

        if ((layer & 1) == 0) {
            if (EN_GEMM && IN(pb + 0)) {
                EpiQKV E{Qb, Kb, Vb, args.in[I_QG] + jm * 64, args.in[I_KG] + jm * 64, cosT, sinT};
                const bf16_t* Wt = Wqkv_t + (size_t)jm * NQKV * D;
                const QkvSched S{hA, Wt, ctx_live ? 1 : 0, G, bid};
                run_gemm(lds, S, E);
            }
            SEAMK(pb + 0, 3);
            if (EN_ATT && IN(pb + 1)) {
                typedef attn_body::bf16 abf;
                const int x = bid & 7, sl = bid >> 3, nS = G >> 3;
                for (int q = sl; q < 256; q += nS) {
                    const int b = 2 * x + (q >> 7), kvh = (q >> 5) & 3, head = 4 * kvh + ((q >> 3) & 3), qb = q & 7;
                    abf* Qu = (abf*)(Qb + ((size_t)b * SEQ + qb * 256) * D + head * 64);
                    attn_body::attn_unit<8>(Qu, (const abf*)(Kb + (size_t)b * KVL * 256 + kvh * 64), (const abf*)(Vb + (size_t)b * KVL * 256 + kvh * 64), Qu, KVL / 64, (char*)lds);
                }
                if (ctx_live) for (int q = sl; q < 32; q += nS) {
                    const int b = 2 * x + (q >> 4), head = q & 15, kvh = head >> 2;
                    abf* Qu = (abf*)(Qb + ((size_t)NLAT + b * CL) * D + head * 64);
                    attn_body::attn_unit<8>(Qu, (const abf*)(Kb + ((size_t)b * KVL + SEQ) * 256 + kvh * 64), (const abf*)(Vb + ((size_t)b * KVL + SEQ) * 256 + kvh * 64), Qu, CL / 64, (char*)lds);
                }
            }
            SEAMK(pb + 1, 4);
            if (EN_GEMM && IN(pb + 2)) {
                EpiResid<layer == 0> E{x_in, ctx_in, XB, mo + 2 * D, nullptr};
                const bf16_t* Wt = Wo_t + (size_t)jm * D * D;
                const DenseSched S{Qb, Wt, nrows / 256, 4, G, bid};
                run_gemm(lds, S, E);
            }
            SEAMK(pb + 2, 5);
        } else {
            const float* cw = args.in[I_HCW] + (size_t)jm * 3 * NHY; const float* cb = args.in[I_HCB] + (size_t)jm * NHY;
            if (EN_GEMM && IN(pb + 0)) {
                EpiBiasBf16 E{Upre, NHY, args.in[I_HBIN] + (size_t)jm * NHY, 0};
                const bf16_t* Wt = Win_t + (size_t)jm * NHY * D;
                const DenseSched S{hA, Wt, nrows / 256, 12, G, bid};
                run_gemm(lds, S, E);
            }
            SEAMK(pb + 0, 6);
            if (EN_MISC && IN(pb + 1)) {
                LAS unsigned char* T = lds;
                const int nlat_u = NB * 16 * 4, nctx_u = ctx_live ? NB * 2 * 4 : 0;
                const int hw = tid >> 5, l32 = tid & 31;
                for (int u = bid; u < nlat_u + nctx_u; u += G) {
                    int b, s0, c0, Ls, rowb; bf16_t* dstb;
                    if (u < nlat_u) { b = u >> 6; s0 = ((u >> 2) & 15) * 128; c0 = (u & 3) * 256; Ls = SEQ; rowb = b * SEQ; dstb = Wc; }
                    else { const int q = u - nlat_u; b = q >> 3; s0 = ((q >> 2) & 1) * 128; c0 = (q & 3) * 256; Ls = CL; rowb = NLAT + b * CL; dstb = Wc + WC_CTX_OFF; }
                    const int cc = c0 + 8 * l32, sb = s0 + 8 * hw;
                    u32x4 ra[10], rv[10];
#pragma unroll
                    for (int i = 0; i < 10; ++i) { const int sp = sb + i - 1;
                        if (sp >= 0 && sp < Ls) { const bf16_t* ur = Upre + (size_t)(rowb + sp) * NHY + cc; ra[i] = *(const u32x4*)(ur + D); rv[i] = *(const u32x4*)(ur + 2 * D); }
                        else { ra[i] = (u32x4){0u, 0u, 0u, 0u}; rv[i] = (u32x4){0u, 0u, 0u, 0u}; } }
                    f32x4 w1[3][2], w2[3][2], b1[2], b2[2];
#pragma unroll
                    for (int tap = 0; tap < 3; ++tap)
#pragma unroll
                        for (int hh = 0; hh < 2; ++hh) { w1[tap][hh] = *(const f32x4*)(cw + tap * NHY + D + cc + 4 * hh); w2[tap][hh] = *(const f32x4*)(cw + tap * NHY + 2 * D + cc + 4 * hh); }
#pragma unroll
                    for (int hh = 0; hh < 2; ++hh) { b1[hh] = *(const f32x4*)(cb + D + cc + 4 * hh); b2[hh] = *(const f32x4*)(cb + 2 * D + cc + 4 * hh); }
                    unsigned op[8][4];
#pragma unroll
                    for (int sp = 0; sp < 4; ++sp) {
                        float pr[2][8];
#pragma unroll
                        for (int o = 0; o < 2; ++o) { const int si = 2 * sp + o;
                            f32x4 x1[2] = {b1[0], b1[1]}, vv[2] = {b2[0], b2[1]};
#pragma unroll
                            for (int tap = 0; tap < 3; ++tap) { const u32x4 a = ra[si + tap], q = rv[si + tap];
                                x1[0] += (f32x4){bflo(a.x), bfhi(a.x), bflo(a.y), bfhi(a.y)} * w1[tap][0]; x1[1] += (f32x4){bflo(a.z), bfhi(a.z), bflo(a.w), bfhi(a.w)} * w1[tap][1];
                                vv[0] += (f32x4){bflo(q.x), bfhi(q.x), bflo(q.y), bfhi(q.y)} * w2[tap][0]; vv[1] += (f32x4){bflo(q.z), bfhi(q.z), bflo(q.w), bfhi(q.w)} * w2[tap][1]; }
                            const f32x4 p0 = x1[0] * vv[0], p1 = x1[1] * vv[1];
                            pr[o][0] = p0[0]; pr[o][1] = p0[1]; pr[o][2] = p0[2]; pr[o][3] = p0[3]; pr[o][4] = p1[0]; pr[o][5] = p1[1]; pr[o][6] = p1[2]; pr[o][7] = p1[3]; }
#pragma unroll
                        for (int c = 0; c < 8; ++c) op[c][sp] = pk2(pr[0][c], pr[1][c]);
                    }
                    __syncthreads();
#pragma unroll
                    for (int c = 0; c < 8; ++c) { const int ch = 8 * l32 + c; *(LAS u32x4*)(T + ch * 256 + ((hw ^ (l32 & 15)) * 16)) = (u32x4){op[c][0], op[c][1], op[c][2], op[c][3]}; }
                    __syncthreads();
#pragma unroll
                    for (int i = 0; i < 8; ++i) { const int c = i * 32 + (tid >> 4), ch = tid & 15;
                        *(u32x4*)(dstb + ((size_t)(c0 + c) * NB + b) * Ls + s0 + ch * 8) = *(const LAS u32x4*)(T + c * 256 + ((ch ^ ((c >> 3) & 15)) * 16)); }
                }
            }
            SEAMK(pb + 1, 7);
            if (EN_CONV && IN(pb + 2)) {
                const int nlat_u = 1024, nctx_u = ctx_live ? 1024 : 0;
                for (int u = bid; u < nlat_u + nctx_u; u += G) {
                    if (u < nlat_u) { const int c = u; conv_channel<SEQ>(lds, (const bf16_t*)(ws + (jm == 0 ? WS_FI0 : WS_FI1)) + (size_t)c * 8 * FP_L, Wc + (size_t)c * NB * SEQ, Yc + (size_t)c * NB * SEQ, tid, lane, wave); }
                    else { const int c = u - nlat_u; conv_channel<CL>(lds, (const bf16_t*)(ws + WS_FI2) + (size_t)c * 8 * FP_C, Wc + WC_CTX_OFF + (size_t)c * NB * CL, Yc + WC_CTX_OFF + (size_t)c * NB * CL, tid, lane, wave); }
                }
            }
            SEAMK(pb + 2, 8);
            if (EN_MISC && IN(pb + 3)) {
                LAS unsigned char* T = lds;
                const int nlat_u = NB * 16 * 4, nctx_u = ctx_live ? NB * 2 * 4 : 0;
                const int hw = tid >> 5, l32 = tid & 31;
                for (int u = bid; u < nlat_u + nctx_u; u += G) {
                    int b, s0, c0, Ls, rowb; const bf16_t* srcb;
                    if (u < nlat_u) { b = u >> 6; s0 = ((u >> 2) & 15) * 128; c0 = (u & 3) * 256; Ls = SEQ; rowb = b * SEQ; srcb = Yc; }
                    else { const int q = u - nlat_u; b = q >> 3; s0 = ((q >> 2) & 1) * 128; c0 = (q & 3) * 256; Ls = CL; rowb = NLAT + b * CL; srcb = Yc + WC_CTX_OFF; }
                    __syncthreads();
#pragma unroll
                    for (int i = 0; i < 8; ++i) { const int c = i * 32 + (tid >> 4), ch = tid & 15;
                        *(LAS u32x4*)(T + c * 256 + ((ch ^ ((c >> 3) & 15)) * 16)) = *(const u32x4*)(srcb + ((size_t)(c0 + c) * NB + b) * Ls + s0 + ch * 8); }
                    const int cc = c0 + 8 * l32, sb = s0 + 8 * hw;
                    u32x4 ra[10];
#pragma unroll
                    for (int i = 0; i < 10; ++i) { const int sp = sb + i - 1;
                        if (sp >= 0 && sp < Ls) ra[i] = *(const u32x4*)(Upre + (size_t)(rowb + sp) * NHY + cc); else ra[i] = (u32x4){0u, 0u, 0u, 0u}; }
                    f32x4 w0[3][2], b0[2];
#pragma unroll
                    for (int tap = 0; tap < 3; ++tap)
#pragma unroll
                        for (int hh = 0; hh < 2; ++hh) w0[tap][hh] = *(const f32x4*)(cw + tap * NHY + cc + 4 * hh);
#pragma unroll
                    for (int hh = 0; hh < 2; ++hh) b0[hh] = *(const f32x4*)(cb + cc + 4 * hh);
                    __syncthreads();
                    u32x4 yv[8];
#pragma unroll
                    for (int c = 0; c < 8; ++c) yv[c] = *(const LAS u32x4*)(T + (8 * l32 + c) * 256 + ((hw ^ (l32 & 15)) * 16));
#pragma unroll
                    for (int si = 0; si < 8; ++si) {
                        f32x4 x0[2] = {b0[0], b0[1]};
#pragma unroll
                        for (int tap = 0; tap < 3; ++tap) { const u32x4 a = ra[si + tap];
                            x0[0] += (f32x4){bflo(a.x), bfhi(a.x), bflo(a.y), bfhi(a.y)} * w0[tap][0]; x0[1] += (f32x4){bflo(a.z), bfhi(a.z), bflo(a.w), bfhi(a.w)} * w0[tap][1]; }
                        float yy[8];
#pragma unroll
                        for (int c = 0; c < 8; ++c) { const unsigned wd = yv[c][si >> 1]; yy[c] = (si & 1) ? bfhi(wd) : bflo(wd); }
                        u32x4 o; o.x = pk2(x0[0][0] * yy[0], x0[0][1] * yy[1]); o.y = pk2(x0[0][2] * yy[2], x0[0][3] * yy[3]); o.z = pk2(x0[1][0] * yy[4], x0[1][1] * yy[5]); o.w = pk2(x0[1][2] * yy[6], x0[1][3] * yy[7]);
                        *(u32x4*)(hA + (size_t)(rowb + sb + si) * D + cc) = o;
                    }
                }
            }
            SEAMK(pb + 3, 9);
            if (EN_GEMM && IN(pb + 4)) {
                EpiResid<layer == 0> E{x_in, ctx_in, XB, mo + 2 * D, args.in[I_HBOUT] + (size_t)jm * D};
                const bf16_t* Wt = Wout_t + (size_t)jm * D * D;
                const DenseSched S{hA, Wt, nrows / 256, 4, G, bid};
                run_gemm(lds, S, E);
            }
            SEAMK(pb + 4, 10);
        }

        gu32* cnt = ctl + CW_CNT + layer * 32 * 64;
        if (EN_ROUTER && IN(pb + 5)) {
            constexpr int WS_ = D + 4;
            LAS float* WrT = (LAS float*)lds;
            LAS int* LCNT = (LAS int*)(lds + 32 * WS_ * 4);
            LAS int* PREC = LCNT + 64;
            constexpr int MAXT = 20;
            __syncthreads();
            { const float* rw = args.in[I_RW] + (size_t)layer * D * NE;
              for (int i = tid; i < (D / 4) * NE; i += NTHR) { const int k4 = (i >> 5) * 4, e = i & 31;
                  *(LAS f32x4*)(WrT + e * WS_ + k4) = (f32x4){rw[(k4 + 0) * NE + e], rw[(k4 + 1) * NE + e], rw[(k4 + 2) * NE + e], rw[(k4 + 3) * NE + e]}; } }
            if (tid < 64) LCNT[tid] = 0;
            for (int i = tid; i < 8 * MAXT * 4; i += NTHR) PREC[i] = -1;
            __syncthreads();
            const float* rb = args.in[I_RB] + layer * NE;
            const int myE = lane >> 1; const float myB = rb[myE];
            const int TPW = (((nrows + NGW - 1) / NGW) + 1) & ~1;
            int curb = -1; f32x4 gs[4], sh[4];
            for (int ti = 0; ti < TPW; ti += 2) {
                const int r0 = gw * TPW + ti, r1 = r0 + 1; if (r0 >= nrows) break;
                const bool ok1 = r1 < nrows; const int r1c = ok1 ? r1 : r0;
                f32x4 h0[4], h1[4], v0[4], v1[4];
                load_vec_bf(XB + (size_t)r0 * D, lane, v0);
                load_vec_bf(XB + (size_t)r1c * D, lane, v1);
                { const int b = mod_row(r0); if (b != curb) { const float* mr = mo + (size_t)b * MODW; load_vec(mr + 4 * D, lane, gs); load_vec(mr + 3 * D, lane, sh); curb = b; } }
                norm_mod_store(v0, gs, sh, hA + (size_t)r0 * D, lane, h0);
                { const int b = mod_row(r1c); if (b != curb) { const float* mr = mo + (size_t)b * MODW; load_vec(mr + 4 * D, lane, gs); load_vec(mr + 3 * D, lane, sh); curb = b; } }
                norm_mod_store(v1, gs, sh, hA + (size_t)r1c * D, lane, h1);
                float p0[32], p1[32];
                asm volatile("" ::: "memory");
                { f32x2 hp[4][4];
#pragma unroll
                  for (int j = 0; j < 4; ++j)
#pragma unroll
                      for (int c = 0; c < 4; ++c) hp[j][c] = (f32x2){h0[j][c], h1[j][c]};
                  f32x4 wa[8], wb[8];
                  const LAS float* wl = WrT + 4 * lane;
#define RT_LOAD(W, E) do { _Pragma("unroll") for (int q = 0; q < 8; ++q) W[q] = *(const LAS f32x4*)(wl + ((E) + (q >> 2)) * WS_ + 256 * (q & 3)); } while (0)
#define RT_FMA(W, E) do { _Pragma("unroll") for (int x = 0; x < 2; ++x) { f32x2 a = {0.f, 0.f}, b = {0.f, 0.f}; \
                      _Pragma("unroll") for (int j = 0; j < 4; ++j) { const f32x4 w = W[x * 4 + j]; \
                          a = __builtin_elementwise_fma(hp[j][0], (f32x2){w[0], w[0]}, a); b = __builtin_elementwise_fma(hp[j][1], (f32x2){w[1], w[1]}, b); \
                          a = __builtin_elementwise_fma(hp[j][2], (f32x2){w[2], w[2]}, a); b = __builtin_elementwise_fma(hp[j][3], (f32x2){w[3], w[3]}, b); } \
                      a = a + b; p0[(E) + x] = a.x; p1[(E) + x] = a.y; } } while (0)
                  RT_LOAD(wa, 0);
#pragma unroll
                  for (int e = 0; e < 32; e += 4) {
                      RT_LOAD(wb, e + 2); __builtin_amdgcn_sched_barrier(0); RT_FMA(wa, e); __builtin_amdgcn_sched_barrier(0);
                      if (e + 4 < 32) RT_LOAD(wa, e + 4); __builtin_amdgcn_sched_barrier(0); RT_FMA(wb, e + 2); __builtin_amdgcn_sched_barrier(0);
                  }
#undef RT_LOAD
#undef RT_FMA
                }
                route_reduce(p0, lane); route_reduce(p1, lane);
                float sv0[4], sv1[4]; int si0[4], si1[4];
                route_top4(p0[0] + myB, myE, sv0, si0); route_top4(p1[0] + myB, myE, sv1, si1);
                if (lane < 8) { const bool t1 = lane >= 4; const int k = lane & 3;
                    const float s0_ = t1 ? sv1[0] : sv0[0], s1_ = t1 ? sv1[1] : sv0[1], s2_ = t1 ? sv1[2] : sv0[2], s3_ = t1 ? sv1[3] : sv0[3];
                    const int i0_ = t1 ? si1[0] : si0[0], i1_ = t1 ? si1[1] : si0[1], i2_ = t1 ? si1[2] : si0[2], i3_ = t1 ? si1[3] : si0[3];
                    const float e1 = __expf(s1_ - s0_), e2 = __expf(s2_ - s0_), e3 = __expf(s3_ - s0_); const float inv = 1.0f / (1.0f + e1 + e2 + e3);
                    const int e = k == 0 ? i0_ : (k == 1 ? i1_ : (k == 2 ? i2_ : i3_)); const float gt = (k == 0 ? 1.0f : (k == 1 ? e1 : (k == 2 ? e2 : e3))) * inv;
                    if (!t1 || ok1) { const int r = t1 ? r1 : r0; const int rank = __hip_atomic_fetch_add(LCNT + e, 1, __ATOMIC_RELAXED, __HIP_MEMORY_SCOPE_WORKGROUP);
                        top_e[r * 4 + k] = e; pgate[r * 4 + k] = gt; PREC[(wave * MAXT + ti + (t1 ? 1 : 0)) * 4 + k] = e | (rank << 8); } }
            }
            __syncthreads();
            if (tid < 32) LCNT[32 + tid] = (int)__hip_atomic_fetch_add(cnt + tid * 64, (unsigned)LCNT[tid], RLX_AGENT);
            __syncthreads();
            for (int i = tid; i < 8 * MAXT * 4; i += NTHR) { const int rec = PREC[i]; if (rec >= 0) { const int e = rec & 255, rank = rec >> 8, w = i / (MAXT * 4), ti = (i / 4) % MAXT, k = i & 3;
                const int r = (bid * NWAVES + w) * TPW + ti; const int pos = LCNT[32 + e] + rank; ppos[r * 4 + k] = pos; elist[(size_t)e * NTOK + pos] = r; } }
        }
        SEAMK(pb + 5, 11);
        LAS int* PADS = (LAS int*)(lds + LDS_BYTES - 4096);
        LAS unsigned char* TE = (LAS unsigned char*)(PADS + 128);
        if (IN(pb + 7) || IN(pb + 8) || IN(pb + 9)) {
            __syncthreads();
            if (tid < 32) PADS[64 + tid] = (int)__hip_atomic_load(cnt + tid * 64, RLX_AGENT);
            __syncthreads();
            if (tid < 64) {
                const int nt = lane < 32 ? (PADS[64 + lane] + 255) >> 8 : 0; int inc = nt;
#pragma unroll
                for (int o = 1; o < 32; o <<= 1) { const int v = __shfl_up(inc, o); if (lane >= o) inc += v; }
                if (lane < 32) PADS[lane] = (inc - nt) << 8; if (lane == 31) PADS[32] = inc << 8;
            }
            __syncthreads();
            { const int ntile = PADS[32] >> 8; for (int t = tid; t < ntile; t += NTHR) { int e = 0;
#pragma unroll
                  for (int st = 16; st >= 1; st >>= 1) if (PADS[e + st] <= (t << 8)) e += st;
                  TE[t] = (unsigned char)e; } }
            __syncthreads();
        }
        if (EN_GEMM && IN(pb + 7)) {
            const int ntile = PADS[32] >> 8;
            LAS int* ROWS = (LAS int*)(lds + 131072);
            { Unit uu; for (int ui = 0; xcd_unit(ui, G, bid, ntile, 8, uu.pm, uu.pn); ++ui) { if (tid < 256) { const int e = TE[uu.pm]; const int pos = uu.pm * 256 - PADS[e] + tid;
                  ROWS[ui * 256 + tid] = pos < PADS[64 + e] ? elist[(size_t)e * NTOK + pos] : 0; } } }
            __syncthreads();
            const MoeGatherSched S{hA, Wgu_t + (size_t)layer * NE * NGU * D, TE, ROWS, ntile, 8, NGU, G, bid};
            const EpiSwiglu E{AB, args.in[I_BGU] + (size_t)layer * NE * NGU};
            run_gemm_gather(lds, S, E);
        }
        SEAMK(pb + 7, 12);
        if (EN_GEMM && IN(pb + 8)) {
            const int ntile = PADS[32] >> 8;
            const MoeSched S{AB, Wdn_t + (size_t)layer * NE * D * D, TE, ntile, 4, D, G, bid};
            const EpiBiasBf16 E{XS, D, args.in[I_BDN] + (size_t)layer * NE * D, D};
            run_gemm(lds, S, E);
        }
        SEAMK(pb + 8, 13);
        if (EN_MISC && IN(pb + 9)) {
            const bool has_next = layer + 1 < DEPTH;
            const float* mo_n = modf + (size_t)(layer + 1) * NMODROW * MODW; const float* g1n = args.in[I_N1G] + (has_next ? (layer + 1) * D : 0);
            const int nnext = (layer + 1 < 3) ? NTOK : NLAT;
            const int TPW = (nrows + NGW - 1) / NGW;
            int curb = -1; f32x4 gm[4], gsn[4], shn[4];
            for (int ti = 0; ti < TPW; ++ti) {
                const int r = gw * TPW + ti; if (r >= nrows) break;
                bf16_t* xr = XB + (size_t)r * D;
                int dest[4]; float gt[4];
#pragma unroll
                for (int k = 0; k < 4; ++k) { dest[k] = PADS[top_e[r * 4 + k]] + ppos[r * 4 + k]; gt[k] = pgate[r * 4 + k]; }
                u32x2 yw[4][4]; f32x4 v[4], h[4];
#pragma unroll
                for (int k = 0; k < 4; ++k) { const u32x2* yr = (const u32x2*)(XS + (size_t)dest[k] * D);
#pragma unroll
                    for (int j = 0; j < 4; ++j) yw[k][j] = yr[lane + 64 * j]; }
                load_vec_bf(xr, lane, v);
                const int b = mod_row(r);
                if (b != curb) { load_vec(mo + (size_t)b * MODW + 5 * D, lane, gm); if (has_next) { const float* mn = mo_n + (size_t)b * MODW; load_vec(mn + D, lane, gsn); load_vec(mn, lane, shn); } curb = b; }
#pragma unroll
                for (int j = 0; j < 4; ++j) { f32x4 y = (f32x4){0.f, 0.f, 0.f, 0.f};
#pragma unroll
                    for (int k = 0; k < 4; ++k) { const u32x2 w = yw[k][j]; y[0] += gt[k] * bflo(w.x); y[1] += gt[k] * bfhi(w.x); y[2] += gt[k] * bflo(w.y); y[3] += gt[k] * bfhi(w.y); }
                    v[j] = v[j] + gm[j] * y;
                    if (layer == DEPTH - 1) ((f32x4*)(out + (size_t)r * D))[lane + 64 * j] = v[j];
                    else { u32x2 w; w.x = pk2(v[j][0], v[j][1]); w.y = pk2(v[j][2], v[j][3]); ((u32x2*)xr)[lane + 64 * j] = w; } }
                if (has_next && r < nnext) norm_mod_store(v, gsn, shn, hA + (size_t)r * D, lane, h);
            }
        }
        SEAMK(pb + 9, 14);
}

__global__ void __launch_bounds__(NTHR, 2) fwd(Args args) {
    extern __shared__ __attribute__((aligned(16))) unsigned char lds_raw[];
    LAS unsigned char* lds = (LAS unsigned char*)lds_raw;
    const int tid = threadIdx.x, lane = tid & 63, wave = __builtin_amdgcn_readfirstlane(tid >> 6);
    const int G = gridDim.x, bid = blockIdx.x;
    const int gw = bid * NWAVES + wave, NGW = G * NWAVES;
    unsigned char* ws = args.ws;
    gu32* ctl = (gu32*)(ws + WS_CTL);
    volatile LAS unsigned* MISC = (volatile LAS unsigned*)(lds + MISC_OFF);
    if (tid < 64) MISC[tid] = 0u;
    __syncthreads();
    XcdBarrier bar; bar.bar = (unsigned*)ctl + CW_BAR; bar.x = 0; bar.st = MISC + 8;
    const int lo = args.ph_lo, hi = args.ph_hi;
    if (hi - lo > 1) bar = xcd_barrier_post((unsigned*)ctl + CW_BAR, MISC + 8);

    KLOCALS

    if (EN_PRO && IN(0)) {
        {
            LAS float* scr = (LAS float*)(lds + wave * 8448);
            constexpr int IT_QKV = 16 * (NQKV / 32), IT_SQ = 16 * (D / 32), IT_IN = 16 * (NHY / 32), IT_GU = 16 * (NGU / 32);
            constexpr int N0 = 2 * IT_QKV, N1 = N0 + 2 * IT_SQ, N2 = N1 + 2 * IT_IN, N3 = N2 + 2 * IT_SQ, N4 = N3 + 128 * IT_GU, N5 = N4 + 128 * IT_SQ;
            for (int it = gw; it < N5; it += NGW) {
                if (it < N0) { const int mtx = it / IT_QKV, r = it % IT_QKV; transpose_item<1>(args.in[I_WQKV] + (size_t)mtx * D * NQKV, NQKV, Wqkv_t + (size_t)mtx * NQKV * D, scr, r, lane); }
                else if (it < N1) { const int q = it - N0, mtx = q / IT_SQ, r = q % IT_SQ; transpose_item<0>(args.in[I_WO] + (size_t)mtx * D * D, D, Wo_t + (size_t)mtx * D * D, scr, r, lane); }
                else if (it < N2) { const int q = it - N1, mtx = q / IT_IN, r = q % IT_IN; transpose_item<0>(args.in[I_HWIN] + (size_t)mtx * D * NHY, NHY, Win_t + (size_t)mtx * NHY * D, scr, r, lane); }
                else if (it < N3) { const int q = it - N2, mtx = q / IT_SQ, r = q % IT_SQ; transpose_item<0>(args.in[I_HWOUT] + (size_t)mtx * D * D, D, Wout_t + (size_t)mtx * D * D, scr, r, lane); }
                else if (it < N4) { const int q = it - N3, mtx = q / IT_GU, r = q % IT_GU; transpose_item<2>(args.in[I_WGU] + (size_t)mtx * D * NGU, NGU, Wgu_t + (size_t)mtx * NGU * D, scr, r, lane); }
                else { const int q = it - N4, mtx = q / IT_SQ, r = q % IT_SQ; transpose_item<0>(args.in[I_WDN] + (size_t)mtx * D * D, D, Wdn_t + (size_t)mtx * D * D, scr, r, lane); }
            }
        }
        __syncthreads();
        {
            LAS float* S = (LAS float*)lds;
            for (int u = bid; u < 4 * 12 * 8; u += G) {
                const int kc = u & 7, cc = (u >> 3) % 12, layer = u / 96;
                __syncthreads();
                for (int i = tid; i < 128 * 20; i += NTHR) { const int k = i / 20, r = i % 20; float v = 0.f;
                    if (r < NMODROW) { const float cv = r < NB ? c_in[r * D + kc * 128 + k] : cctx_in[kc * 128 + k]; v = cv / (1.0f + __expf(-cv)); }
                    S[i] = v; }
                __syncthreads();
                const int col = cc * 512 + tid;
                const float* wp = args.in[I_WMOD] + ((size_t)layer * D + kc * 128) * MODW + col;
                float acc[20];
#pragma unroll
                for (int r = 0; r < 20; ++r) acc[r] = 0.f;
                for (int k = 0; k < 128; ++k) { const float w = wp[(size_t)k * MODW];
#pragma unroll
                    for (int q = 0; q < 5; ++q) { const f32x4 s = *(const LAS f32x4*)(S + k * 20 + 4 * q);
                        acc[4 * q] += s[0] * w; acc[4 * q + 1] += s[1] * w; acc[4 * q + 2] += s[2] * w; acc[4 * q + 3] += s[3] * w; } }
#pragma unroll
                for (int r = 0; r < NMODROW; ++r) modp[((size_t)(kc * 4 + layer) * NMODROW + r) * MODW + col] = acc[r];
            }
        }
        for (int i = bid * NTHR + tid; i < SEQ * 32; i += G * NTHR) {
            const int t = i >> 5, j = i & 31, fi = j & 15; const int pos = (j >> 4) == 0 ? (t >> 6) : (t & 63);
            const float inv = powf(10000.0f, -(float)fi / 16.0f); const float ang = (float)pos * inv;
            cosT[i] = cosf(ang); sinT[i] = sinf(ang);
        }
        {
            __syncthreads();
            LAS float* Z = (LAS float*)lds;
            LAS float* A1 = Z + 8 * 36;
            for (int u = bid; u < 256 + 256 + 32; u += G) {
                const int combo = u < 256 ? 0 : (u < 512 ? 1 : 2); const int ub = combo == 0 ? u : (combo == 1 ? u - 256 : u - 512);
                const int j = combo == 1 ? 1 : 0, Lf = combo == 2 ? CL : SEQ;
                const int tl = tid >> 6, o = tid & 63, t = ub * 8 + tl;
                __syncthreads();
                if (o < 33) { float z;
                    const float tt = (float)t / (float)(Lf - 1), w = 6.283185307179586f * (float)t / (float)Lf;
                    if (o == 0) z = tt; else { const int b = (o - 1) & 15; const float f = 1e-4f + (float)b * ((15.0f - 1e-4f) / 15.0f); z = o <= 16 ? cosf(f * w) : -sinf(f * w); }
                    Z[tl * 36 + o] = z; }
                __syncthreads();
                const float sf = args.in[I_HSF][j * 64 + o];
                { const float* w1 = args.in[I_HW1] + (size_t)j * 33 * 64; float a = args.in[I_HB1][j * 64 + o];
                  for (int i = 0; i < 33; ++i) a += Z[tl * 36 + i] * w1[i * 64 + o];
                  A1[tl * 64 + o] = sinf(sf * a); }
                __syncthreads();
                { const float* w2 = args.in[I_HW2] + (size_t)j * 64 * 64; float a = args.in[I_HB2][j * 64 + o];
                  for (int i = 0; i < 64; ++i) a += A1[tl * 64 + i] * w2[i * 64 + o];
                  a2tab[((size_t)combo * SEQ + t) * 64 + o] = sinf(sf * a); }
            }
        }
    }
    SEAMK(0, 0);

    if (EN_PRO && IN(1)) {
        for (int i = bid * NTHR + tid; i < DEPTH * NMODROW * MODW; i += G * NTHR) {
            const int layer = i / (NMODROW * MODW), rem = i % (NMODROW * MODW), col = rem % MODW; float s = args.in[I_BMOD][layer * MODW + col];
#pragma unroll
            for (int kc = 0; kc < 8; ++kc) s += modp[(size_t)(kc * 4 + layer) * NMODROW * MODW + rem];
            const int chunk = col >> 10, k = col & (D - 1);
            if (chunk == 1) s = args.in[I_N1G][layer * D + k] * (1.0f + s); else if (chunk == 4) s = args.in[I_N2G][layer * D + k] * (1.0f + s);
            modf[i] = s;
        }
        {
            LAS float* W3 = (LAS float*)lds;
            LAS float* RED = W3 + 512;
            LAS float* NRM = RED + 32;
            LAS float* HF = NRM + 4;
            for (int u = bid; u < 3 * 256; u += G) {
                const int combo = u >> 8, cg = u & 255; const int j = combo == 1 ? 1 : 0, Lf = combo == 2 ? CL : SEQ; const int c0 = cg * 4;
                LAS float* HB = HF + 4 * Lf;
                __syncthreads();
                { const int i = tid >> 3, q = tid & 7; const int col = (q >> 2) * 1024 + c0 + (q & 3);
                  W3[i * 8 + q] = args.in[I_HW3][((size_t)j * 64 + i) * 2048 + col]; }
                __syncthreads();
                float b3v[8], dec[4], asum[4] = {0.f, 0.f, 0.f, 0.f};
#pragma unroll
                for (int q = 0; q < 8; ++q) b3v[q] = args.in[I_HB3][j * 2048 + (q >> 2) * 1024 + c0 + (q & 3)];
#pragma unroll
                for (int ch = 0; ch < 4; ++ch) dec[ch] = 3.0701134573253945f + (float)(c0 + ch) * ((15.350567286626972f - 3.0701134573253945f) / 1023.0f);
                for (int t = tid; t < Lf; t += NTHR) {
                    asm volatile("" ::: "memory");
                    const float* ar = a2tab + ((size_t)combo * SEQ + t) * 64; float d[8];
#pragma unroll
                    for (int q = 0; q < 8; ++q) d[q] = b3v[q];
#pragma unroll
                    for (int i4 = 0; i4 < 16; ++i4) { const f32x4 a = *(const f32x4*)(ar + 4 * i4); asm volatile("" ::: "memory");
#pragma unroll
                        for (int e = 0; e < 4; ++e) { const f32x4 w0 = *(const LAS f32x4*)(W3 + (4 * i4 + e) * 8), w1 = *(const LAS f32x4*)(W3 + (4 * i4 + e) * 8 + 4);
                            d[0] += a[e] * w0[0]; d[1] += a[e] * w0[1]; d[2] += a[e] * w0[2]; d[3] += a[e] * w0[3]; d[4] += a[e] * w1[0]; d[5] += a[e] * w1[1]; d[6] += a[e] * w1[2]; d[7] += a[e] * w1[3]; } }
                    const float tt = (float)t / (float)(Lf - 1);
#pragma unroll
                    for (int ch = 0; ch < 4; ++ch) { const float dk = __expf(-tt * dec[ch]); const float f = d[ch] * dk, bb = d[4 + ch] * dk;
                        HF[ch * Lf + t] = f; HB[ch * Lf + t] = bb; asum[ch] += fabsf(f) + (t >= 1 ? fabsf(bb) : 0.f); }
                }
#pragma unroll
                for (int ch = 0; ch < 4; ++ch) { const float s = wave_sum(asum[ch]); if (lane == 0) RED[wave * 4 + ch] = s; }
                __syncthreads();
                if (tid < 4) { float s = 0.f; for (int w = 0; w < 8; ++w) s += RED[w * 4 + tid]; NRM[tid] = 1.0f / (s + EPS); }
                __syncthreads();
                const int P = 2 * Lf + 8, PC8 = P / 8;
                bf16_t* FI = (bf16_t*)(ws + (combo == 0 ? WS_FI0 : (combo == 1 ? WS_FI1 : WS_FI2)));
                for (int q = tid; q < 4 * 8 * PC8; q += NTHR) {
                    const int ch = q / (8 * PC8), r = q % (8 * PC8), cidx = r / PC8, x0 = (r % PC8) * 8;
                    const float nr = NRM[ch], db = args.in[I_HDB][j * 1024 + c0 + ch]; float v[8];
#pragma unroll
                    for (int e = 0; e < 8; ++e) { const int m = Lf - (x0 + e) + cidx; const int am = m < 0 ? -m : m; float g = 0.f;
                        if (am <= Lf - 1) { g = (m >= 0 ? HF[ch * Lf + am] : HB[ch * Lf + am]) * nr; if (m == 0) g += db; }
                        v[e] = g; }
                    u32x4 o; o.x = pk2(v[0], v[1]); o.y = pk2(v[2], v[3]); o.z = pk2(v[4], v[5]); o.w = pk2(v[6], v[7]);
                    *(u32x4*)(FI + ((size_t)((c0 + ch) * 8 + cidx)) * P + x0) = o;
                }
            }
        }
    }
    SEAMK(1, 1);

    if (IN(2)) {
        const float* mo = modf;
        const int TPW = (NTOK + NGW - 1) / NGW;
        int curb = -1; f32x4 gs[4], sh[4];
        for (int ti = 0; ti < TPW; ++ti) {
            const int r = gw * TPW + ti; if (r >= NTOK) break;
            const float* src = r < NLAT ? x_in + (size_t)r * D : ctx_in + (size_t)(r - NLAT) * D;
            f32x4 v[4], h[4]; load_vec(src, lane, v);
            const int b = mod_row(r); if (b != curb) { const float* mr = mo + (size_t)b * MODW; load_vec(mr + D, lane, gs); load_vec(mr, lane, sh); curb = b; }
            norm_mod_store(v, gs, sh, hA + (size_t)r * D, lane, h);
        }
    }
    SEAMK(2, 2);

    layer_body<0>(args, lds, bar, tid, lane, wave, G, bid, lo, hi);
    layer_body<1>(args, lds, bar, tid, lane, wave, G, bid, lo, hi);
    layer_body<2>(args, lds, bar, tid, lane, wave, G, bid, lo, hi);
    layer_body<3>(args, lds, bar, tid, lane, wave, G, bid, lo, hi);
#undef IN
#undef SEAM
}

extern "C" void kernel_launch(void* const* d_in, const int* in_sizes, int n_in, void* d_out, int out_size, void* d_ws, size_t ws_size, hipStream_t stream) {
    static int grid = 0;
    if (grid == 0) {
        if (n_in != 32 || out_size != NLAT * D || ws_size < WS_END) { fprintf(stderr, "kernel_launch: unexpected problem (n_in %d, out %d, ws %zu)\n", n_in, out_size, ws_size); grid = -1; return; }
        int dev = 0, cus = 0, per_cu = 0;
        if (hipGetDevice(&dev) != hipSuccess || hipDeviceGetAttribute(&cus, hipDeviceAttributeMultiprocessorCount, dev) != hipSuccess) { grid = -1; return; }
        if (hipFuncSetAttribute((const void*)fwd, hipFuncAttributeMaxDynamicSharedMemorySize, LDS_BYTES) != hipSuccess) { fprintf(stderr, "kernel_launch: hipFuncSetAttribute failed\n"); grid = -1; return; }
        if (hipOccupancyMaxActiveBlocksPerMultiprocessor(&per_cu, (const void*)fwd, NTHR, LDS_BYTES) != hipSuccess || per_cu < 1) fprintf(stderr, "kernel_launch: occupancy query says %d\n", per_cu);
        (void)hipGetLastError();
        grid = cus;
    }
    if (grid < 0) return;
    (void)hipMemsetAsync((char*)d_ws + WS_CTL, 0, CTL_ZERO_BYTES, stream);
    Args a{};
    for (int i = 0; i < 32; ++i) a.in[i] = (const float*)d_in[i];
    a.out = (float*)d_out; a.ws = (unsigned char*)d_ws;
    constexpr int NPH = 3 + 10 * DEPTH;
#if MK_ONE_LAUNCH
    a.ph_lo = 0; a.ph_hi = NPH;
    hipLaunchKernelGGL(fwd, dim3(grid), dim3(NTHR), LDS_BYTES, stream, a);
#else
    for (int p = 0; p < NPH; ++p) {
        if (p >= 3) { const int layer = (p - 3) / 10, loc = (p - 3) % 10; if ((layer & 1) == 0 && (loc == 3 || loc == 4)) continue; }
        a.ph_lo = p; a.ph_hi = p + 1;
        hipLaunchKernelGGL(fwd, dim3(grid), dim3(NTHR), LDS_BYTES, stream, a);
    }
#endif
}
```

```cpp
#include <hip/hip_runtime.h>
#include <cstdio>
#include <cstdint>
#include <cmath>
#include <hip/hip_bf16.h>

#ifndef EN_PRO
#define EN_PRO 1
#endif
#ifndef EN_ATT
#define EN_ATT 1
#endif
#ifndef EN_CONV
#define EN_CONV 1
#endif
#ifndef EN_ROUTER
#define EN_ROUTER 1
#endif
#ifndef EN_GEMM
#define EN_GEMM 1
#endif
#ifndef EN_MISC
#define EN_MISC 1
#endif
#ifndef MK_ONE_LAUNCH
#define MK_ONE_LAUNCH 1
#endif

#define GAS __attribute__((address_space(1)))
#define LAS __attribute__((address_space(3)))
typedef unsigned short bf16_t;
typedef short bf16x8 __attribute__((ext_vector_type(8)));
typedef float f32x4 __attribute__((ext_vector_type(4)));
typedef float f32x2 __attribute__((ext_vector_type(2)));
typedef unsigned u32x4 __attribute__((ext_vector_type(4)));
typedef unsigned u32x2 __attribute__((ext_vector_type(2)));
typedef GAS unsigned gu32;
typedef float f32x16 __attribute__((ext_vector_type(16)));

constexpr int D = 1024, NB = 16, SEQ = 2048, CL = 256, KVL = SEQ + CL;
constexpr int NLAT = NB * SEQ, NCTX = NB * CL, NTOK = NLAT + NCTX;
constexpr int NE = 32, TOPK = 4, DEPTH = 4;
constexpr int MODW = 6 * D, NMODROW = NB + 1;
constexpr int NQKV = 1536, NHY = 3072, NGU = 2048;
constexpr float EPS = 1e-6f;
constexpr float C2 = 0.125f * 1.4426950408889634f;
constexpr int NWAVES = 8, NTHR = 512;
constexpr int NPADROWS = 155648;
constexpr int MAXTILES = NPADROWS / 256;

constexpr size_t MiB = 1u << 20;
constexpr size_t WS_CTL = 0, CTL_ZERO_BYTES = 1 * MiB;
constexpr size_t WS_MODP = 2 * MiB;
constexpr size_t WS_MOD = 16 * MiB;
constexpr size_t WS_ROPE = 18 * MiB;
constexpr size_t WS_A2 = 19 * MiB;
constexpr size_t WS_PAIR = 21 * MiB;
constexpr size_t WS_CTX = 24 * MiB;
constexpr size_t WS_FI = 40 * MiB;
constexpr int FP_L = 2 * SEQ + 8, FP_C = 2 * CL + 8;
constexpr size_t FI_L_BYTES = (size_t)1024 * 8 * FP_L * 2, FI_C_BYTES = (size_t)1024 * 8 * FP_C * 2;
constexpr size_t WS_FI0 = WS_FI, WS_FI1 = WS_FI0 + 65 * MiB, WS_FI2 = WS_FI1 + 65 * MiB;
static_assert(FI_L_BYTES <= 65 * MiB && WS_FI2 + FI_C_BYTES <= 180 * MiB, "filter map");
constexpr size_t WS_WQKV = 180 * MiB, WS_WO = 186 * MiB, WS_WIN = 190 * MiB, WS_WOUT = 202 * MiB, WS_WGU = 206 * MiB, WS_WDN = 718 * MiB;
constexpr size_t WS_HA = 974 * MiB;
constexpr size_t WS_Q = 1046 * MiB;
constexpr size_t WS_K = 1118 * MiB, WS_V = 1136 * MiB;
constexpr size_t WS_UPRE = 1154 * MiB;
constexpr size_t WS_WC = 1370 * MiB;
constexpr size_t WS_YC = 1442 * MiB;
constexpr size_t WS_XS = 1514 * MiB;
constexpr size_t WS_AB = 1818 * MiB;
constexpr size_t WS_ELIST = 2122 * MiB;
constexpr size_t WS_XB = 2128 * MiB;
constexpr size_t WS_END = 2200 * MiB;
constexpr size_t WC_CTX_OFF = (size_t)1024 * 16 * 2048;
constexpr int CW_TMO = 0, CW_BAR = 4096, CW_CNT = 16384;

constexpr int LDS_BYTES = 160 * 1024;
constexpr int MISC_OFF = LDS_BYTES - 256;

#define RLX_AGENT __ATOMIC_RELAXED, __HIP_MEMORY_SCOPE_AGENT
#define LDS_WAIT() asm volatile("s_waitcnt lgkmcnt(0)" ::: "memory")
#define VM_WAIT() asm volatile("s_waitcnt vmcnt(0)" ::: "memory")
__device__ __forceinline__ unsigned f2bf(float f) { unsigned u = __builtin_bit_cast(unsigned, f); return (u + 0x7fffu + ((u >> 16) & 1u)) >> 16; }
typedef __bf16 bf16x2_t __attribute__((ext_vector_type(2)));
__device__ __forceinline__ unsigned pk2(float lo, float hi) { const f32x2 v = {lo, hi}; const bf16x2_t b = __builtin_convertvector(v, bf16x2_t); return __builtin_bit_cast(unsigned, b); }
__device__ __forceinline__ float bf2f(unsigned h) { return __builtin_bit_cast(float, h << 16); }
__device__ __forceinline__ float bflo(unsigned w) { return __builtin_bit_cast(float, w << 16); }
__device__ __forceinline__ float bfhi(unsigned w) { return __builtin_bit_cast(float, w & 0xffff0000u); }
__device__ __forceinline__ float wave_sum(float v) {
#pragma unroll
    for (int o = 1; o < 64; o <<= 1) v += __shfl_xor(v, o);
    return v;
}

#define XB_TMO      128
#define XB_XCNT(j)  (256  + 64 * (j))
#define XB_XSUB(j)  (1280 + 64 * (j))
#define XB_XGEN(j)  (2304 + 64 * (j))
#define XB_TOP      3328
#define XB_TOPGEN   3392
#define XCD_BAR_WORDS 3456
#define XB_SPIN_CAP (1u << 22)
__device__ __forceinline__ unsigned xb_ld(unsigned* p)              { return __hip_atomic_load(p, __ATOMIC_RELAXED, __HIP_MEMORY_SCOPE_AGENT); }
__device__ __forceinline__ unsigned xb_add(unsigned* p, unsigned v) { return __hip_atomic_fetch_add(p, v, __ATOMIC_RELAXED, __HIP_MEMORY_SCOPE_AGENT); }
__device__ __forceinline__ unsigned xb_xcc_id() { return (unsigned)__builtin_amdgcn_s_getreg((3 << 11) | 20) & 0xFu; }
#define XB_SPIN(cond, bar) do { unsigned _sp = 0; while (cond) { __builtin_amdgcn_s_sleep(1); \
    if ((++_sp & 255u) == 0u) { if (xb_ld(&(bar)[XB_TMO])) break; if (_sp > XB_SPIN_CAP) { atomicAdd(&(bar)[XB_TMO], 1u); break; } } } } while (0)
struct XcdBarrier { unsigned* bar; unsigned x; volatile LAS unsigned* st; };
__device__ __forceinline__ XcdBarrier xcd_barrier_post(unsigned* bar, volatile LAS unsigned* st) {
    XcdBarrier b; b.bar = bar; b.x = xb_xcc_id(); b.st = st;
    if (threadIdx.x == 0) (void)xb_add(&bar[XB_XCNT(b.x)], 1u);
    return b;
}
__device__ __forceinline__ void xcd_barrier_complete(unsigned* bar, unsigned x, unsigned& nloc, unsigned& nx) {
    const unsigned G = gridDim.x * gridDim.y * gridDim.z;
    unsigned sum, cnt, mine, sp = 0u;
    for (;;) {
        sum = 0u; cnt = 0u; mine = 0u;
#pragma unroll
        for (unsigned j = 0; j < 16; ++j) { const unsigned c = xb_ld(&bar[XB_XCNT(j)]); sum += c; cnt += (c > 0u) ? 1u : 0u; mine = (j == x) ? c : mine; }
        if (sum == G) break;
        __builtin_amdgcn_s_sleep(1);
        if ((++sp & 255u) == 0u) { if (xb_ld(&bar[XB_TMO])) break; if (sp > XB_SPIN_CAP) { atomicAdd(&bar[XB_TMO], 1u); break; } }
    }
    nloc = mine > 0u ? mine : 1u; nx = cnt > 0u ? cnt : 1u;
}
__device__ __forceinline__ void xcd_barrier(const XcdBarrier& b) {
    asm volatile("s_waitcnt vmcnt(0)" ::: "memory");
    __syncthreads();
    if (threadIdx.x == 0) {
        unsigned* bar = b.bar;
        __builtin_amdgcn_s_waitcnt(0);
        unsigned nloc = b.st[0], nx = b.st[1];
        if (nloc == 0u) { xcd_barrier_complete(bar, b.x, nloc, nx); b.st[0] = nloc; b.st[1] = nx; }
        const unsigned old = xb_add(&bar[XB_XSUB(b.x)], 1u);
        const unsigned gen = old / nloc;
        if (old + 1u == (gen + 1u) * nloc) {
            __builtin_amdgcn_fence(__ATOMIC_RELEASE, "agent");
            asm volatile("s_waitcnt vmcnt(0)" ::: "memory");
            const unsigned og = xb_add(&bar[XB_TOP], 1u);
            const unsigned tg = og / nx;
            if (og + 1u == (tg + 1u) * nx) xb_add(&bar[XB_TOPGEN], 1u);
            else XB_SPIN(xb_ld(&bar[XB_TOPGEN]) == tg, bar);
            __builtin_amdgcn_fence(__ATOMIC_ACQUIRE, "agent");
            xb_add(&bar[XB_XGEN(b.x)], 1u);
            asm volatile("s_waitcnt vmcnt(0)" ::: "memory");
        } else {
            XB_SPIN(xb_ld(&bar[XB_XGEN(b.x)]) == gen, bar);
            __builtin_amdgcn_fence(__ATOMIC_ACQUIRE, "agent");
            asm volatile("s_waitcnt vmcnt(0)" ::: "memory");
        }
    }
    __syncthreads();
}

struct Args { const float* in[32]; float* out; unsigned char* ws; int ph_lo, ph_hi; };
struct Ctx {
    LAS unsigned char* lds;
    int tid, lane, wave, G, bid;
    const float* const* in;
};
enum { I_X = 0, I_C, I_CTX, I_CCTX, I_WMOD, I_BMOD, I_N1G, I_N2G, I_WQKV, I_QG, I_KG, I_WO, I_HWIN, I_HBIN, I_HCW, I_HCB, I_HW1, I_HB1, I_HW2, I_HB2, I_HW3, I_HB3,
       I_HSF, I_HDB, I_HWOUT, I_HBOUT, I_RW, I_RB, I_WGU, I_BGU, I_WDN, I_BDN };

__device__ __forceinline__ int mod_row(int r) { return r < NLAT ? (r >> 11) : NB; }

__device__ __forceinline__ void gemm_unit_simple(const bf16_t* At, const bf16_t* Bt, f32x4 (&acc)[2][2][4][2], int wr, int wc, int fr, int fq) {
    constexpr int K = D;
#pragma unroll
    for (int a = 0; a < 2; ++a)
#pragma unroll
        for (int b = 0; b < 2; ++b)
#pragma unroll
            for (int m = 0; m < 4; ++m)
#pragma unroll
                for (int n = 0; n < 2; ++n) acc[a][b][m][n] = (f32x4){0.f, 0.f, 0.f, 0.f};
    const bf16_t* ap = At + (size_t)(wr * 64 + fr) * K + fq * 8;
    const bf16_t* bp = Bt + (size_t)(wc * 32 + fr) * K + fq * 8;
    for (int k0 = 0; k0 < K; k0 += 32) {
        bf16x8 bfr[2][2];
#pragma unroll
        for (int bj = 0; bj < 2; ++bj)
#pragma unroll
            for (int n = 0; n < 2; ++n) bfr[bj][n] = *(const bf16x8*)(bp + (size_t)(bj * 128 + n * 16) * K + k0);
#pragma unroll
        for (int ai = 0; ai < 2; ++ai)
#pragma unroll
            for (int m = 0; m < 4; ++m) {
                const bf16x8 afr = *(const bf16x8*)(ap + (size_t)(ai * 128 + m * 16) * K + k0);
#pragma unroll
                for (int bj = 0; bj < 2; ++bj)
#pragma unroll
                    for (int n = 0; n < 2; ++n) acc[ai][bj][m][n] = __builtin_amdgcn_mfma_f32_16x16x32_bf16(bfr[bj][n], afr, acc[ai][bj][m][n], 0, 0, 0);
            }
    }
}


struct Unit { int pm, pn, e; };
namespace pg8 {
constexpr int BM = 256, BK = 64, HALF = 128, HTB = HALF * BK * 2, STAGE_BYTES = 8 * HTB;
__device__ __forceinline__ int lds_byte(int r, int c) { const int st = (r >> 4) * 2 + (c >> 5), rr = r & 15, cc = c & 31, ob = rr * 64 + cc * 2; return st * 1024 + (ob ^ (((ob >> 9) & 1) << 5)); }
__device__ __forceinline__ void stage_rc(int b, int& R, int& C) { const int st = b / 1024, sb = b % 1024, swz = sb ^ (((sb >> 9) & 1) << 5); R = (st >> 1) * 16 + swz / 64; C = (st & 1) * 32 + (swz % 64) / 2; }
template <class Epi, class Sched, bool GATHER = false>
__device__ __forceinline__ void gemm_phase(LAS unsigned char* lds, const Sched& S, const Epi& E) {
    constexpr int K = D, nt = K / BK;
    const int tid = threadIdx.x, wid = __builtin_amdgcn_readfirstlane(tid >> 6), lane = tid & 63, wr = wid >> 2, wc = wid & 3, fr = lane & 15, fq = lane >> 4;
    unsigned voffA[2];
#pragma unroll
    for (int i = 0; i < 2; ++i) { int R, C; stage_rc(tid * 16 + i * 8192, R, C); voffA[i] = (unsigned)(R * K + C) * 2u; }
    const size_t kstep = (size_t)(BK * 2);
    const size_t hstep = (size_t)HALF * K * 2;
    const unsigned ldsw = (unsigned)wid * 1024u;
    const int aoff = lds_byte(wr * 64 + fr, fq * 8), boff = lds_byte(wc * 32 + fr, fq * 8);
#define PG8_SA(b, h) (((b) * 2 + (h)) * HTB)
#define PG8_SB(b, h) ((4 + (b) * 2 + (h)) * HTB)
#define PG8_STAGE(bufoff, gbase, voff) do { _Pragma("unroll") for (int _i = 0; _i < 2; ++_i) \
        __builtin_amdgcn_global_load_lds((const unsigned*)((const char*)(gbase) + (voff)[_i]), (LAS unsigned*)(lds + (bufoff) + ldsw + _i * 8192), 16, 0, 0); } while (0)
#define PG8_LDA(dst, b, h) do { _Pragma("unroll") for (int m = 0; m < 4; ++m) _Pragma("unroll") for (int k = 0; k < 2; ++k) dst[m][k] = *(const LAS bf16x8*)(lds + PG8_SA(b, h) + aoff + m * 2048 + k * 1024); } while (0)
#define PG8_LDB(dst, b, h) do { _Pragma("unroll") for (int n = 0; n < 2; ++n) _Pragma("unroll") for (int k = 0; k < 2; ++k) dst[n][k] = *(const LAS bf16x8*)(lds + PG8_SB(b, h) + boff + n * 2048 + k * 1024); } while (0)
#define PG8_MMA(ai, bj, At, Bt) do { __builtin_amdgcn_s_setprio(1); _Pragma("unroll") for (int m = 0; m < 4; ++m) _Pragma("unroll") for (int n = 0; n < 2; ++n) _Pragma("unroll") for (int k = 0; k < 2; ++k) \
        acc[ai][bj][m][n] = __builtin_amdgcn_mfma_f32_16x16x32_bf16(Bt[n][k], At[m][k], acc[ai][bj][m][n], 0, 0, 0); __builtin_amdgcn_s_setprio(0); } while (0)
#define PG8_WAIT_V(n) asm volatile("s_waitcnt vmcnt(" #n ")" ::: "memory")
#define PG8_WAIT_L(n) asm volatile("s_waitcnt lgkmcnt(" #n ")" ::: "memory")
#define PG8_BAR __builtin_amdgcn_s_barrier()
#define PG8_SCHED __builtin_amdgcn_sched_barrier(0)
    unsigned vA[2][2], vN[2][2]; unsigned gR[2], gC[2];
    const char* gA = nullptr;
    if constexpr (GATHER) {
        gA = S.a_base();
#pragma unroll
        for (int i = 0; i < 2; ++i) { gR[i] = voffA[i] / (unsigned)(K * 2); gC[i] = voffA[i] % (unsigned)(K * 2); }
        const LAS int* rw = S.rows(0);
#pragma unroll
        for (int h = 0; h < 2; ++h)
#pragma unroll
            for (int i = 0; i < 2; ++i) { vA[h][i] = (unsigned)rw[h * HALF + gR[i]] * (unsigned)(K * 2) + gC[i]; vN[h][i] = vA[h][i]; }
    }
#define PG8_STAGEA(bufoff, P, V, kt, h) do { if constexpr (GATHER) PG8_STAGE(bufoff, gA + (size_t)(kt) * kstep, V[h]); else PG8_STAGE(bufoff, (P) + (size_t)(kt) * kstep + (size_t)(h) * hstep, voffA); } while (0)
    Unit cur, nxt; int ui = 0;
    if (!S.next(0, cur)) return;
    f32x4 acc[2][2][4][2];
#pragma unroll
    for (int a = 0; a < 2; ++a)
#pragma unroll
        for (int b = 0; b < 2; ++b)
#pragma unroll
            for (int m = 0; m < 4; ++m)
#pragma unroll
                for (int n = 0; n < 2; ++n) acc[a][b][m][n] = (f32x4){0.f, 0.f, 0.f, 0.f};
    bf16x8 At[4][2], B0[2][2], B1[2][2];
    const char* cA = nullptr; if constexpr (!GATHER) cA = S.a_ptr(cur);
    const char* cB = S.b_ptr(cur);
    PG8_STAGE(PG8_SB(0, 0), cB, voffA); PG8_STAGE(PG8_SB(0, 1), cB + hstep, voffA); PG8_STAGEA(PG8_SA(0, 0), cA, vA, 0, 0); PG8_STAGEA(PG8_SA(0, 1), cA, vA, 0, 1);
    if (wr == 1) PG8_BAR;
    PG8_WAIT_V(2); PG8_BAR;
    PG8_STAGE(PG8_SB(1, 0), cB + kstep, voffA); PG8_STAGEA(PG8_SA(1, 0), cA, vA, 1, 0); PG8_STAGE(PG8_SB(1, 1), cB + hstep + kstep, voffA);
    PG8_WAIT_V(6); PG8_BAR;
    for (;;) {
        const bool has_next = S.next(ui + 1, nxt);
        const char* nA = cA; if constexpr (!GATHER) { if (has_next) nA = S.a_ptr(nxt); }
        const char* nB = has_next ? S.b_ptr(nxt) : cB;
        if constexpr (GATHER) { if (has_next) { const LAS int* rw = S.rows(ui + 1);
#pragma unroll
            for (int h = 0; h < 2; ++h)
#pragma unroll
                for (int i = 0; i < 2; ++i) vN[h][i] = (unsigned)rw[h * HALF + gR[i]] * (unsigned)(K * 2) + gC[i]; } }
        for (int t = 0; t < nt; t += 2) {
            const bool last = (t == nt - 2);
            const char* b2 = last ? nB : cB + (size_t)(t + 2) * kstep; const char* b3 = b2 + kstep;
            const char* pX = last ? nA : cA; const int kX = last ? 0 : t + 2;
            unsigned vX[2][2];
#pragma unroll
            for (int h = 0; h < 2; ++h)
#pragma unroll
                for (int i = 0; i < 2; ++i) vX[h][i] = last ? vN[h][i] : vA[h][i];
            PG8_LDB(B0, 0, 0); PG8_LDB(B1, 0, 1); PG8_SCHED; PG8_LDA(At, 0, 0); PG8_STAGEA(PG8_SA(1, 1), cA, vA, t + 1, 1);
            PG8_WAIT_V(8); PG8_WAIT_L(0); PG8_BAR; PG8_MMA(0, 0, At, B0); PG8_MMA(0, 1, At, B1); PG8_BAR; PG8_SCHED;
            PG8_LDA(At, 0, 1); PG8_STAGE(PG8_SB(0, 0), b2, voffA); PG8_STAGE(PG8_SB(0, 1), b2 + hstep, voffA); PG8_STAGEA(PG8_SA(0, 0), pX, vX, kX, 0);
            PG8_WAIT_V(8); PG8_WAIT_L(0); PG8_BAR; PG8_MMA(1, 0, At, B0); PG8_MMA(1, 1, At, B1); PG8_BAR; PG8_SCHED;
            PG8_LDB(B0, 1, 0); PG8_LDB(B1, 1, 1); PG8_SCHED; PG8_LDA(At, 1, 0); PG8_STAGEA(PG8_SA(0, 1), pX, vX, kX, 1);
            PG8_WAIT_V(8); PG8_WAIT_L(0); PG8_BAR; PG8_MMA(0, 0, At, B0); PG8_MMA(0, 1, At, B1); PG8_BAR; PG8_SCHED;
            PG8_LDA(At, 1, 1); PG8_STAGE(PG8_SB(1, 0), b3, voffA); PG8_STAGE(PG8_SB(1, 1), b3 + hstep, voffA); PG8_STAGEA(PG8_SA(1, 0), pX, vX, kX + 1, 0);
            PG8_WAIT_V(8); PG8_WAIT_L(0); PG8_BAR; PG8_MMA(1, 0, At, B0); PG8_MMA(1, 1, At, B1); PG8_BAR; PG8_SCHED;
        }
        if (wr == 0) PG8_BAR;
        E(acc, cur, wr, wc, fr, fq);
        if (!has_next) break;
#pragma unroll
        for (int a = 0; a < 2; ++a)
#pragma unroll
            for (int b = 0; b < 2; ++b)
#pragma unroll
                for (int m = 0; m < 4; ++m)
#pragma unroll
                    for (int n = 0; n < 2; ++n) acc[a][b][m][n] = (f32x4){0.f, 0.f, 0.f, 0.f};
        cur = nxt; cA = nA; cB = nB; ++ui;
        if constexpr (GATHER) {
#pragma unroll
            for (int h = 0; h < 2; ++h)
#pragma unroll
                for (int i = 0; i < 2; ++i) vA[h][i] = vN[h][i]; }
        if (wr == 1) PG8_BAR;
    }
    PG8_WAIT_V(0);
    PG8_BAR;
#undef PG8_SA
#undef PG8_SB
#undef PG8_STAGE
#undef PG8_STAGEA
#undef PG8_LDA
#undef PG8_LDB
#undef PG8_MMA
#undef PG8_WAIT_V
#undef PG8_WAIT_L
#undef PG8_BAR
#undef PG8_SCHED
}
}

template <class Epi, class Sched>
__device__ __forceinline__ void gemm_phase_simple(const Sched& S, const Epi& E) {
    const int tid = threadIdx.x, wid = __builtin_amdgcn_readfirstlane(tid >> 6), lane = tid & 63, wr = wid >> 2, wc = wid & 3, fr = lane & 15, fq = lane >> 4;
    Unit u;
    for (int i = 0; S.next(i, u); ++i) { f32x4 acc[2][2][4][2];
        gemm_unit_simple((const bf16_t*)S.a_ptr(u), (const bf16_t*)S.b_ptr(u), acc, wr, wc, fr, fq);
        E(acc, u, wr, wc, fr, fq); }
}
#ifndef FAST_GEMM
#define FAST_GEMM 1
#endif
template <class Epi, class Sched>
__device__ __forceinline__ void run_gemm(LAS unsigned char* lds, const Sched& S, const Epi& E) {
#if FAST_GEMM
    pg8::gemm_phase<Epi, Sched, false>(lds, S, E);
#else
    gemm_phase_simple<Epi, Sched>(S, E);
#endif
}
template <class Epi, class Sched>
__device__ __forceinline__ void run_gemm_gather(LAS unsigned char* lds, const Sched& S, const Epi& E) { pg8::gemm_phase<Epi, Sched, true>(lds, S, E); }
__device__ __forceinline__ bool xcd_unit(int i, int G, int c, int nM, int nN, int& pm, int& pn) {
    const int x = c & 7, s = c >> 3, nS = G >> 3;
    const int r0 = (nM * x) >> 3, r1 = (nM * (x + 1)) >> 3;
    const int q = i * nS + s; if (q >= (r1 - r0) * nN) return false;
    const int rr = q / nN; pm = r0 + rr; pn = q - rr * nN; return true;
}
struct DenseSched {
    const bf16_t* A; const bf16_t* Bt; int nM, nN, G, c;
    __device__ __forceinline__ bool next(int i, Unit& u) const { u.e = 0; return xcd_unit(i, G, c, nM, nN, u.pm, u.pn); }
    __device__ __forceinline__ const char* a_ptr(const Unit& u) const { return (const char*)(A + (size_t)u.pm * 256 * D); }
    __device__ __forceinline__ const char* b_ptr(const Unit& u) const { return (const char*)(Bt + (size_t)u.pn * 256 * D); }
};
struct QkvSched {
    const bf16_t* A; const bf16_t* Bt; int live, G, c;
    __device__ __forceinline__ bool next(int i, Unit& u) const { u.e = 0;
        if (live) return xcd_unit(i, G, c, 144, 6, u.pm, u.pn);
        const int x = c & 7, s = c >> 3, nS = G >> 3; const int nlat = 16 * 6; const int q = i * nS + s;
        if (q < nlat) { const int rr = q / 6; u.pm = 16 * x + rr; u.pn = q - rr * 6; return true; }
        const int q2 = q - nlat; if (q2 >= 4) return false; const int t = x * 4 + q2; u.pm = 128 + (t >> 1); u.pn = 4 + (t & 1); return true; }
    __device__ __forceinline__ const char* a_ptr(const Unit& u) const { return (const char*)(A + (size_t)u.pm * 256 * D); }
    __device__ __forceinline__ const char* b_ptr(const Unit& u) const { return (const char*)(Bt + (size_t)u.pn * 256 * D); }
};
struct MoeSched {
    const bf16_t* A; const bf16_t* Bt  ; const LAS unsigned char* TE; int nM, nN, N, G, c;
    __device__ __forceinline__ bool next(int i, Unit& u) const { if (!xcd_unit(i, G, c, nM, nN, u.pm, u.pn)) return false; u.e = TE[u.pm]; return true; }
    __device__ __forceinline__ const char* a_ptr(const Unit& u) const { return (const char*)(A + (size_t)u.pm * 256 * D); }
    __device__ __forceinline__ const char* b_ptr(const Unit& u) const { return (const char*)(Bt + ((size_t)u.e * N + (size_t)u.pn * 256) * D); }
};
struct MoeGatherSched {
    const bf16_t* A; const bf16_t* Bt; const LAS unsigned char* TE; const LAS int* ROWS; int nM, nN, N, G, c;
    __device__ __forceinline__ bool next(int i, Unit& u) const { if (!xcd_unit(i, G, c, nM, nN, u.pm, u.pn)) return false; u.e = TE[u.pm]; return true; }
    __device__ __forceinline__ const char* a_base() const { return (const char*)A; }
    __device__ __forceinline__ const LAS int* rows(int ui) const { return ROWS + ui * 256; }
    __device__ __forceinline__ const char* a_ptr(const Unit& u) const { return (const char*)A; }
    __device__ __forceinline__ const char* b_ptr(const Unit& u) const { return (const char*)(Bt + ((size_t)u.e * N + (size_t)u.pn * 256) * D); }
};

struct EpiQKV {
    bf16_t *Q, *Kb, *Vb; const float *qg, *kg, *cosT, *sinT;
    __device__ __forceinline__ void operator()(const f32x4 (&acc)[2][2][4][2], const Unit& uu, int wr, int wc, int fr, int fq) const {
        const int pm = uu.pm, pn = uu.pn;
        const int kind = pn < 4 ? 0 : (pn == 4 ? 1 : 2);
        const float* gain = kind == 0 ? qg : kg;
        f32x4 gv[2][2];
#pragma unroll
        for (int bj = 0; bj < 2; ++bj)
#pragma unroll
            for (int n = 0; n < 2; ++n) gv[bj][n] = *(const f32x4*)(gain + 32 * bj + 16 * n + 4 * fq);
#pragma unroll
        for (int ai = 0; ai < 2; ++ai)
#pragma unroll
            for (int m = 0; m < 4; ++m) {
                const int r = pm * 256 + ai * 128 + wr * 64 + m * 16 + fr;
                const bool lat = r < NLAT;
                const int b = lat ? (r >> 11) : ((r - NLAT) >> 8);
                const int pos = lat ? (r & (SEQ - 1)) : (SEQ + ((r - NLAT) & (CL - 1)));
                f32x4 v[2][2];
#pragma unroll
                for (int bj = 0; bj < 2; ++bj)
#pragma unroll
                    for (int n = 0; n < 2; ++n) v[bj][n] = acc[ai][bj][m][n];
                if (kind != 2) {
                    float ss = 0.f;
#pragma unroll
                    for (int bj = 0; bj < 2; ++bj)
#pragma unroll
                        for (int n = 0; n < 2; ++n) ss += (v[bj][n][0] * v[bj][n][0] + v[bj][n][1] * v[bj][n][1]) + (v[bj][n][2] * v[bj][n][2] + v[bj][n][3] * v[bj][n][3]);
                    ss += __shfl_xor(ss, 16); ss += __shfl_xor(ss, 32);
                    const float rinv = 1.0f / sqrtf(ss * (1.0f / 64.0f) + EPS);
#pragma unroll
                    for (int bj = 0; bj < 2; ++bj)
#pragma unroll
                        for (int n = 0; n < 2; ++n) v[bj][n] = v[bj][n] * rinv * gv[bj][n];
                    if (lat) {
#pragma unroll
                        for (int bj = 0; bj < 2; ++bj) {
                            const f32x4 cs = *(const f32x4*)(cosT + pos * 32 + bj * 16 + 4 * fq), sn = *(const f32x4*)(sinT + pos * 32 + bj * 16 + 4 * fq);
                            const f32x4 x1 = v[bj][0], x2 = v[bj][1];
                            v[bj][0] = x1 * cs - x2 * sn; v[bj][1] = x2 * cs + x1 * sn;
                        }
                    }
                    if (kind == 0) {
#pragma unroll
                        for (int bj = 0; bj < 2; ++bj)
#pragma unroll
                            for (int n = 0; n < 2; ++n) v[bj][n] = v[bj][n] * C2;
                    }
                }
                bf16_t* dst = kind == 0 ? Q + (size_t)r * D + pn * 256 + wc * 64
                                        : (kind == 1 ? Kb : Vb) + ((size_t)b * KVL + pos) * 256 + wc * 64;
#pragma unroll
                for (int bj = 0; bj < 2; ++bj) { u32x4 w; w.x = pk2(v[bj][0][0], v[bj][0][1]); w.y = pk2(v[bj][0][2], v[bj][0][3]); w.z = pk2(v[bj][1][0], v[bj][1][1]); w.w = pk2(v[bj][1][2], v[bj][1][3]);
                    *(u32x4*)(dst + 32 * bj + 8 * fq) = w; }
            }
    }
};
struct EpiBiasBf16 {
    bf16_t* O; int ldc; const float* bias0; int estride;
    __device__ __forceinline__ void operator()(const f32x4 (&acc)[2][2][4][2], const Unit& uu, int wr, int wc, int fr, int fq) const {
        const int row0 = uu.pm * 256, col0t = uu.pn * 256;
#pragma unroll
        for (int bj = 0; bj < 2; ++bj) {
            const int c = col0t + bj * 128 + wc * 32 + 8 * fq;
            const float* bp = bias0 + (size_t)uu.e * estride + c; const f32x4 b0 = *(const f32x4*)bp, b1 = *(const f32x4*)(bp + 4);
#pragma unroll
            for (int ai = 0; ai < 2; ++ai)
#pragma unroll
                for (int m = 0; m < 4; ++m) { const int r = row0 + ai * 128 + wr * 64 + m * 16 + fr; const f32x4 v0 = acc[ai][bj][m][0] + b0, v1 = acc[ai][bj][m][1] + b1;
                    u32x4 w; w.x = pk2(v0[0], v0[1]); w.y = pk2(v0[2], v0[3]); w.z = pk2(v1[0], v1[1]); w.w = pk2(v1[2], v1[3]); *(u32x4*)(O + (size_t)r * ldc + c) = w; }
        }
    }
};
template <bool SRC32> struct EpiResid {
    const float *srcL, *srcC; bf16_t* XB; const float* gate  ; const float* bias;
    __device__ __forceinline__ void operator()(f32x4 (&acc)[2][2][4][2], const Unit& uu, int wr, int wc, int fr, int fq) const {
        const int row0 = uu.pm * 256, col0t = uu.pn * 256;
        const float* gp0 = gate + (size_t)mod_row(row0) * MODW;
        const float* sb = row0 < NLAT ? srcL + (size_t)row0 * D : srcC + (size_t)(row0 - NLAT) * D;
        bf16_t* xb = XB + (size_t)row0 * D;
#pragma unroll
        for (int bj = 0; bj < 2; ++bj) {
            const int c = col0t + bj * 128 + wc * 32 + 8 * fq;
            const f32x4 g0 = *(const f32x4*)(gp0 + c), g1 = *(const f32x4*)(gp0 + c + 4);
            f32x4 b0 = (f32x4){0.f, 0.f, 0.f, 0.f}, b1 = b0; if (bias) { b0 = *(const f32x4*)(bias + c); b1 = *(const f32x4*)(bias + c + 4); }
#pragma unroll
            for (int ai = 0; ai < 2; ++ai) {
                f32x4 x0[4], x1[4];
#pragma unroll
                for (int m = 0; m < 4; ++m) { const size_t ro = (size_t)(ai * 128 + wr * 64 + m * 16 + fr) * D + c;
                    if constexpr (SRC32) { x0[m] = *(const f32x4*)(sb + ro); x1[m] = *(const f32x4*)(sb + ro + 4); }
                    else { const u32x4 w = *(const u32x4*)(xb + ro); x0[m] = (f32x4){bflo(w.x), bfhi(w.x), bflo(w.y), bfhi(w.y)}; x1[m] = (f32x4){bflo(w.z), bfhi(w.z), bflo(w.w), bfhi(w.w)}; } }
#pragma unroll
                for (int m = 0; m < 4; ++m) { const size_t ro = (size_t)(ai * 128 + wr * 64 + m * 16 + fr) * D + c;
                    const f32x4 y0 = x0[m] + g0 * (acc[ai][bj][m][0] + b0), y1 = x1[m] + g1 * (acc[ai][bj][m][1] + b1);
                    u32x4 w; w.x = pk2(y0[0], y0[1]); w.y = pk2(y0[2], y0[3]); w.z = pk2(y1[0], y1[1]); w.w = pk2(y1[2], y1[3]); *(u32x4*)(xb + ro) = w; }
                asm volatile("" ::: "memory");
            }
        }
    }
};
struct EpiSwiglu {
    bf16_t* O; const float* bgu0  ;
    __device__ __forceinline__ void operator()(const f32x4 (&acc)[2][2][4][2], const Unit& uu, int wr, int wc, int fr, int fq) const {
        const int row0 = uu.pm * 256, pn = uu.pn; const float* bgu = bgu0 + (size_t)uu.e * NGU;
        const int f = pn * 128 + wc * 32 + 8 * fq;
        f32x4 bg[2], bu[2];
#pragma unroll
        for (int n = 0; n < 2; ++n) { const f32x4 q0 = *(const f32x4*)(bgu + 2 * (f + 4 * n)), q1 = *(const f32x4*)(bgu + 2 * (f + 4 * n) + 4);
            bg[n] = (f32x4){q0[0], q0[2], q1[0], q1[2]}; bu[n] = (f32x4){q0[1], q0[3], q1[1], q1[3]}; }
#pragma unroll
        for (int ai = 0; ai < 2; ++ai)
#pragma unroll
            for (int m = 0; m < 4; ++m) { const int r = row0 + ai * 128 + wr * 64 + m * 16 + fr; float o[8];
#pragma unroll
                for (int n = 0; n < 2; ++n) { const f32x4 gg = acc[ai][0][m][n] + bg[n], uq = acc[ai][1][m][n] + bu[n];
#pragma unroll
                    for (int p = 0; p < 2; ++p) {
                        f32x2 g2 = {fminf(gg[2 * p], 7.0f), fminf(gg[2 * p + 1], 7.0f)};
                        f32x2 u2 = {__builtin_amdgcn_fmed3f(uq[2 * p], -7.0f, 7.0f), __builtin_amdgcn_fmed3f(uq[2 * p + 1], -7.0f, 7.0f)};
                        const f32x2 z = g2 * (-2.4554669595930157f);
                        f32x2 e2 = {__builtin_amdgcn_exp2f(z.x), __builtin_amdgcn_exp2f(z.y)};
                        e2 = e2 + 1.0f;
                        const f32x2 r2 = {__builtin_amdgcn_rcpf(e2.x), __builtin_amdgcn_rcpf(e2.y)};
                        const f32x2 o2 = ((u2 + 1.0f) * g2) * r2;
                        o[4 * n + 2 * p] = o2.x; o[4 * n + 2 * p + 1] = o2.y; } }
                u32x4 w; w.x = pk2(o[0], o[1]); w.y = pk2(o[2], o[3]); w.z = pk2(o[4], o[5]); w.w = pk2(o[6], o[7]); *(u32x4*)(O + (size_t)r * D + f) = w; }
    }
};

__device__ __forceinline__ int slot32(int cg) { return (((cg >> 2) & 1) << 4) + ((cg >> 3) << 2) + (cg & 3); }
template <int MODE> __device__ __forceinline__ int wrow_map(int n) {
    if (MODE == 0) return (n & ~31) + slot32(n & 31);
    if (MODE == 1) { const int pn = n >> 8, wc = (n >> 6) & 3, bj = (n >> 5) & 1, j = n & 31;
        return (pn << 8) + (bj << 7) + (wc << 5) + (pn < 5 ? j : slot32(j)); }
    { const int f = n >> 1, pn = f >> 7, fo = f & 127; return (pn << 8) + ((n & 1) << 7) + (fo & ~31) + slot32(fo & 31); }
}
template <int MODE> __device__ __forceinline__ void transpose_item(const float* W, int N, bf16_t* WT, LAS float* scr, int item, int lane) {
    constexpr int K = D;
    const int nblk = N / 32, kb = item / nblk, nb = item % nblk, k0 = 64 * kb, n0 = 32 * nb;
#pragma unroll 8
    for (int i = 0; i < 32; ++i) { const int kk = 2 * i + (lane >> 5); scr[kk * 33 + (lane & 31)] = __builtin_nontemporal_load(W + (size_t)(k0 + kk) * N + n0 + (lane & 31)); }
    LDS_WAIT(); asm volatile("" ::: "memory");
    const int c = lane & 7;
#pragma unroll
    for (int j = 0; j < 4; ++j) { const int n = (lane >> 3) + 8 * j; const LAS float* s = scr + (8 * c) * 33 + n;
        u32x4 o; o.x = pk2(s[0 * 33], s[1 * 33]); o.y = pk2(s[2 * 33], s[3 * 33]); o.z = pk2(s[4 * 33], s[5 * 33]); o.w = pk2(s[6 * 33], s[7 * 33]);
        __builtin_nontemporal_store(o, (u32x4*)(WT + (size_t)wrow_map<MODE>(n0 + n) * K + k0 + 8 * c)); }
    LDS_WAIT(); asm volatile("" ::: "memory");
}

__device__ __forceinline__ void norm_mod_store(const f32x4 (&v)[4], const f32x4 (&gs)[4], const f32x4 (&sh)[4], bf16_t* dst, int lane, f32x4 (&h)[4]) {
    float ss = 0.f;
#pragma unroll
    for (int j = 0; j < 4; ++j) ss += (v[j][0] * v[j][0] + v[j][1] * v[j][1]) + (v[j][2] * v[j][2] + v[j][3] * v[j][3]);
    ss = wave_sum(ss);
    const float rinv = __builtin_amdgcn_rsqf(ss * (1.0f / D) + EPS);
#pragma unroll
    for (int j = 0; j < 4; ++j) {
        h[j] = (v[j] * rinv) * gs[j] + sh[j];
        u32x2 w; w.x = pk2(h[j][0], h[j][1]); w.y = pk2(h[j][2], h[j][3]);
        ((u32x2*)dst)[lane + 64 * j] = w;
    }
}
__device__ __forceinline__ void load_vec_bf(const bf16_t* p, int lane, f32x4 (&v)[4]) {
#pragma unroll
    for (int j = 0; j < 4; ++j) { const u32x2 w = ((const u32x2*)p)[lane + 64 * j]; v[j] = (f32x4){bflo(w.x), bfhi(w.x), bflo(w.y), bfhi(w.y)}; }
}
__device__ __forceinline__ void load_vec(const float* p, int lane, f32x4 (&v)[4]) {
#pragma unroll
    for (int j = 0; j < 4; ++j) v[j] = ((const f32x4*)p)[lane + 64 * j];
}


namespace attn_body {
using bf16=__hip_bfloat16;
using bf16x8=__attribute__((ext_vector_type(8)))short;
using s16x4=__attribute__((ext_vector_type(4)))short;
using f32x16=__attribute__((ext_vector_type(16)))float;
using u32x4=__attribute__((ext_vector_type(4)))unsigned;
constexpr int D=64,DM=1024,KVP=256;
constexpr int NW=8,QBLK=32,QB=QBLK*NW,KVBLK=64;
__device__ __forceinline__ int crow(int r,int hi){return (r&3)+8*(r>>2)+4*hi;}
#define SBAR() __builtin_amdgcn_sched_barrier(0)
__device__ __forceinline__ void cmask(f32x16&p0,f32x16&p1,int jb,int qrel,int hi){
  const float NEG=-INFINITY; int kb=64*jb+4*hi;
  #pragma unroll
  for(int r=0;r<16;++r){int kv=kb+(r&3)+8*(r>>2); if(kv>qrel)p0[r]=NEG; if(kv+32>qrel)p1[r]=NEG;}
}

constexpr int NSLOT=3, SLOTB=8192;
constexpr int LDS_K=0, LDS_V=NSLOT*SLOTB, LDS_WS=2*NSLOT*SLOTB, LDS_OST=LDS_WS+NW*64*4, LDS_BYTES=LDS_OST+NW*4096;
constexpr float C2=0.125f*1.4426950408889634f;
__device__ __forceinline__ void glds16(const void*gsrc,unsigned lds_dst){unsigned keep;
  asm volatile("s_mov_b32 %0, m0\n\ts_mov_b32 m0, %2\n\ts_nop 0\n\tglobal_load_lds_dwordx4 %1, off\n\ts_mov_b32 m0, %0":"=&s"(keep):"v"(gsrc),"s"(lds_dst):"memory");}
__device__ __forceinline__ float max3f(float a,float b,float c){float r;asm("v_max3_f32 %0, %1, %2, %3":"=v"(r):"v"(a),"v"(b),"v"(c));return r;}
__device__ __forceinline__ float max2f(float a,float b){float r;asm("v_max_f32_e32 %0, %1, %2":"=v"(r):"v"(a),"v"(b));return r;}
__device__ __forceinline__ float fadd_s(float a,float b){float r;asm("v_add_f32_e32 %0, %1, %2":"=v"(r):"v"(a),"v"(b));return r;}
__device__ __forceinline__ float fsub_s(float a,float b){float r;asm("v_sub_f32_e32 %0, %1, %2":"=v"(r):"v"(a),"v"(b));return r;}
typedef float f32x2_t __attribute__((ext_vector_type(2))); typedef __bf16 bf16x2_t __attribute__((ext_vector_type(2)));
__device__ __forceinline__ unsigned cvtpk_s(float lo,float hi){f32x2_t v={lo,hi};bf16x2_t b=__builtin_convertvector(v,bf16x2_t);return __builtin_bit_cast(unsigned,b);}
#define WAIT_BAR(N) asm volatile("s_waitcnt vmcnt(" #N ") lgkmcnt(0)\n\ts_barrier":::"memory")

__device__ __forceinline__ void qkt(f32x16&p0,f32x16&p1,const char*Kslot,const bf16x8*qr,const f32x16&negm,int r32,int hi){
  const char*kb=Kslot+hi*1024+r32*16;
  #pragma unroll
  for(int d0=0;d0<4;++d0){
    const bf16x8 b0=*reinterpret_cast<const bf16x8*>(kb+d0*2048);
    const bf16x8 b1=*reinterpret_cast<const bf16x8*>(kb+d0*2048+512);
    if(d0==0){p0=__builtin_amdgcn_mfma_f32_32x32x16_bf16(b0,qr[0],negm,0,0,0);p1=__builtin_amdgcn_mfma_f32_32x32x16_bf16(b1,qr[0],negm,0,0,0);}
    else{p0=__builtin_amdgcn_mfma_f32_32x32x16_bf16(b0,qr[d0],p0,0,0,0);p1=__builtin_amdgcn_mfma_f32_32x32x16_bf16(b1,qr[d0],p1,0,0,0);}}
}
typedef __attribute__((address_space(3))) const char* lds_cptr;
typedef short v4i16_t __attribute__((ext_vector_type(4)));
__device__ __forceinline__ void kload8(bf16x8*kf,lds_cptr kp){
  kf[0]=*(const __attribute__((address_space(3))) bf16x8*)(kp);      kf[1]=*(const __attribute__((address_space(3))) bf16x8*)(kp+512);
  kf[2]=*(const __attribute__((address_space(3))) bf16x8*)(kp+2048); kf[3]=*(const __attribute__((address_space(3))) bf16x8*)(kp+2560);
  kf[4]=*(const __attribute__((address_space(3))) bf16x8*)(kp+4096); kf[5]=*(const __attribute__((address_space(3))) bf16x8*)(kp+4608);
  kf[6]=*(const __attribute__((address_space(3))) bf16x8*)(kp+6144); kf[7]=*(const __attribute__((address_space(3))) bf16x8*)(kp+6656);
}
__device__ __forceinline__ void kload2(bf16x8*kf,lds_cptr kp,int j){ kf[2*j]=*(const __attribute__((address_space(3))) bf16x8*)(kp+j*2048); kf[2*j+1]=*(const __attribute__((address_space(3))) bf16x8*)(kp+j*2048+512); }
__device__ __forceinline__ s16x4 vtr(lds_cptr p){ return __builtin_bit_cast(s16x4,__builtin_amdgcn_ds_read_tr16_b64_v4i16((__attribute__((address_space(3))) v4i16_t*)p)); }
__device__ __forceinline__ float rowmax(const f32x16&p0,const f32x16&p1){
  float a=max3f(p0[0],p0[1],p1[0]),b=max3f(p0[2],p0[3],p1[1]);a=max3f(a,p1[2],p1[3]);
  #pragma unroll
  for(int r=4;r<16;r+=4){a=max3f(a,p0[r],p0[r+1]);b=max3f(b,p0[r+2],p0[r+3]);a=max3f(a,p1[r],p1[r+1]);b=max3f(b,p1[r+2],p1[r+3]);}
  const float m=max2f(a,b);
  auto rr=__builtin_amdgcn_permlane32_swap(__float_as_uint(m),__float_as_uint(m),false,false);
  return max2f(__uint_as_float(rr[0]),__uint_as_float(rr[1]));
}
__device__ __forceinline__ void pv(f32x16*o,int vb,bf16x8 pa0,bf16x8 pa1,bf16x8 pa2,bf16x8 pa3){
  #pragma unroll
  for(int d0=0;d0<2;++d0){s16x4 lo[4],hi[4];
    #pragma unroll
    for(int ks=0;ks<4;++ks){
      asm volatile("ds_read_b64_tr_b16 %0,%1 offset:%c2":"=&v"(lo[ks]):"v"(vb),"i"(d0*4096+ks*1024):"memory");
      asm volatile("ds_read_b64_tr_b16 %0,%1 offset:%c2":"=&v"(hi[ks]):"v"(vb),"i"(d0*4096+ks*1024+512):"memory");}
    asm volatile("s_waitcnt lgkmcnt(0)":::"memory");SBAR();
    #define PK(k) (bf16x8){lo[k][0],lo[k][1],lo[k][2],lo[k][3],hi[k][0],hi[k][1],hi[k][2],hi[k][3]}
    o[d0]=__builtin_amdgcn_mfma_f32_32x32x16_bf16(pa0,PK(0),o[d0],0,0,0);
    o[d0]=__builtin_amdgcn_mfma_f32_32x32x16_bf16(pa1,PK(1),o[d0],0,0,0);
    o[d0]=__builtin_amdgcn_mfma_f32_32x32x16_bf16(pa2,PK(2),o[d0],0,0,0);
    o[d0]=__builtin_amdgcn_mfma_f32_32x32x16_bf16(pa3,PK(3),o[d0],0,0,0);
    #undef PK
  }
}

#ifndef ATTN_STORE16
#define ATTN_STORE16(p,v) (*(u32x4*)(p)=(v))
#endif
template<int THRL> __device__ __forceinline__ void attn_unit(const bf16*Qu,const bf16*__restrict__ Kh,const bf16*__restrict__ Vh,bf16*Ou,const int NT,char*shm){
  const int tid=threadIdx.x,lane=tid&63,r32=lane&31,hi=lane>>5; const int wid=__builtin_amdgcn_readfirstlane(tid>>6);
  const bf16*Qw=Qu+(long)(wid*QBLK)*DM;
  const unsigned lds0=(unsigned)(uintptr_t)shm;
  float*wsf=(float*)(shm+LDS_WS)+wid*64;
  const bf16*ksrc=Kh+(long)lane*KVP+wid*8;
  const bf16*vsrc=Vh+(long)(16*(wid&3)+(lane>>2))*KVP+(wid>>2)*32+(lane&3)*8;
  const unsigned kdst=lds0+LDS_K+wid*1024, vdst=lds0+LDS_V+wid*1024;
  #define DMA_K(t,slot) glds16(ksrc+(long)(t)*KVBLK*KVP,(unsigned)__builtin_amdgcn_readfirstlane(kdst+(slot)))
  #define DMA_V(t,slot) glds16(vsrc+(long)(t)*KVBLK*KVP,(unsigned)__builtin_amdgcn_readfirstlane(vdst+(slot)))
  const int vb0=(int)(lds0+LDS_V)+((lane>>4)&1)*32+(lane&3)*8+(4*hi+((lane&15)>>2))*64;
  const char*Kbase=shm+LDS_K; bf16x8 kf[8];
  const lds_cptr shm3=(lds_cptr)shm; const lds_cptr kp0=shm3+LDS_K+hi*1024+r32*16; const lds_cptr vp0=shm3+LDS_V+((lane>>4)&1)*32+(lane&3)*8+(4*hi+((lane&15)>>2))*64;
  DMA_K(0,0);DMA_V(0,0);DMA_K(1,SLOTB);
  bf16x8 qr[4];
  #pragma unroll
  for(int d0=0;d0<4;++d0)qr[d0]=*reinterpret_cast<const bf16x8*>(&Qw[(long)r32*DM+d0*16+hi*8]);
  float mhat=0.f,l_reg=0.f;f32x16 o[2];o[0]=f32x16{};o[1]=f32x16{};f32x16 negm=f32x16{};asm volatile("":"+v"(negm));
  #define CMASK(P0,P1,t) do{}while(0)
  bool resc=false;
  #define START(P0,P1) do{ const float rm=rowmax(P0,P1); resc=false; \
    { const float dl=rm; mhat=fadd_s(mhat,dl); \
      _Pragma("unroll") for(int r=0;r<16;++r){P0[r]=fsub_s(P0[r],dl);P1[r]=fsub_s(P1[r],dl);} \
      _Pragma("unroll") for(int r=0;r<16;++r)negm[r]=-mhat; asm volatile("":"+v"(negm)); } \
    _Pragma("unroll") for(int r=0;r<16;++r)P0[r]=__builtin_amdgcn_exp2f(P0[r]); }while(0)
  #define RESC() do{ if(resc){ asm volatile("s_waitcnt lgkmcnt(0)":::"memory"); \
      _Pragma("unroll") for(int d_=0;d_<2;++d_) _Pragma("unroll") for(int r=0;r<16;++r)o[d_][r]*=wsf[crow(r,hi)]; } }while(0)
  f32x16 pA0,pA1,pB0,pB1;
  int sl_prev=0,sl_cur=0,sl_next=SLOTB;
  #define ROT() do{sl_prev=sl_cur;sl_cur=sl_next;sl_next=(sl_next==(NSLOT-1)*SLOTB)?0:sl_next+SLOTB;}while(0)
  DMA_K(2,2*SLOTB);
  WAIT_BAR(3);
  qkt(pA0,pA1,Kbase,qr,negm,r32,hi);asm volatile("s_nop 15\n\ts_nop 7":"+v"(pA0),"+v"(pA1));CMASK(pA0,pA1,0);
  START(pA0,pA1);
  _Pragma("unroll") for(int r=0;r<16;++r)pA1[r]=__builtin_amdgcn_exp2f(pA1[r]);
  WAIT_BAR(0);
  DMA_K(3,0);DMA_V(1,SLOTB);
  ROT();
  kload8(kf,kp0+sl_cur);
  WAIT_BAR(2);
  s16x4 vlo[8],vhi[8]; u32x4 pw0,pw1,pw2,pw3;
  #define PKW(P,B) cvtpk_s(P[B],P[B+1])
  #define PAF(k) __builtin_bit_cast(bf16x8,pw##k)
  #define VFR(i) (bf16x8){vlo[i][0],vlo[i][1],vlo[i][2],vlo[i][3],vhi[i][0],vhi[i][1],vhi[i][2],vhi[i][3]}
  #define PIN(x) asm volatile("":"+v"(x))
  #define MX3(a,b,c) __builtin_fmaxf(__builtin_fmaxf((a),(b)),(c))
  #define GAPA(MF,A0,A1,A2,A3,W0,W1,PW) do{ MF; sacc+=A0; sacc+=A1; sacc+=A2; sacc+=A3; PIN(sacc); W0; W1; PIN(PW); SBAR(); }while(0)
  #define EX(v) __builtin_amdgcn_exp2f(v)
  #define GAPB(MF,X,B) do{ MF; X[B]=EX(X[B]); X[B+1]=EX(X[B+1]); X[B+2]=EX(X[B+2]); X[B+3]=EX(X[B+3]); PIN(X); SBAR(); }while(0)
  #define VRD(i) do{ vlo[i]=vtr(vp_+(((i)>>2)*4096+((i)&3)*1024)); vhi[i]=vtr(vp_+(((i)>>2)*4096+((i)&3)*1024+512)); }while(0)
  #define KRD(G,j) do{ if(G){ kload2(kf,kp0+sl_next,j); SBAR(); } }while(0)
  #define STEP(C0,C1,P0,P1,t,GK,GV,GL) do{ SBAR(); \
    const lds_cptr vp_=vp0+sl_prev; \
    VRD(0); SBAR(); float sacc=(P0[0]+P0[1]); \
    GAPA(C0=__builtin_amdgcn_mfma_f32_32x32x16_bf16(kf[0],qr[0],negm,0,0,0), P0[2],P0[3],P0[4],P0[5],     pw0[0]=PKW(P0,0), pw0[1]=PKW(P0,2), pw0); \
    VRD(4); SBAR(); GAPA(C1=__builtin_amdgcn_mfma_f32_32x32x16_bf16(kf[1],qr[0],negm,0,0,0), P0[6],P0[7],P0[8],P0[9],     pw0[2]=PKW(P0,4), pw0[3]=PKW(P0,6), pw0); \
    VRD(1); SBAR(); GAPA(C0=__builtin_amdgcn_mfma_f32_32x32x16_bf16(kf[2],qr[1],C0,0,0,0),   P0[10],P0[11],P0[12],P0[13], pw1[0]=PKW(P0,8), pw1[1]=PKW(P0,10), pw1); \
    VRD(5); SBAR(); GAPA(C1=__builtin_amdgcn_mfma_f32_32x32x16_bf16(kf[3],qr[1],C1,0,0,0),   P0[14],P0[15],P1[0],P1[1],   pw1[2]=PKW(P0,12),pw1[3]=PKW(P0,14), pw1); \
    VRD(2); SBAR(); GAPA(C0=__builtin_amdgcn_mfma_f32_32x32x16_bf16(kf[4],qr[2],C0,0,0,0),   P1[2],P1[3],P1[4],P1[5],     pw2[0]=PKW(P1,0), pw2[1]=PKW(P1,2), pw2); \
    VRD(6); SBAR(); GAPA(C1=__builtin_amdgcn_mfma_f32_32x32x16_bf16(kf[5],qr[2],C1,0,0,0),   P1[6],P1[7],P1[8],P1[9],     pw2[2]=PKW(P1,4), pw2[3]=PKW(P1,6), pw2); \
    VRD(3); SBAR(); GAPA(C0=__builtin_amdgcn_mfma_f32_32x32x16_bf16(kf[6],qr[3],C0,0,0,0),   P1[10],P1[11],P1[12],P1[13], pw3[0]=PKW(P1,8), pw3[1]=PKW(P1,10), pw3); \
    VRD(7); SBAR(); GAPA(C1=__builtin_amdgcn_mfma_f32_32x32x16_bf16(kf[7],qr[3],C1,0,0,0),   P1[14],P1[15],0.f,0.f,       pw3[2]=PKW(P1,12),pw3[3]=PKW(P1,14), pw3); \
    l_reg+=sacc; \
    if(GK){DMA_K((t)+3,sl_cur);} if(GV){DMA_V((t)+1,sl_next);} \
    CMASK(C0,C1,t); \
    { float a=MX3(C0[0],C0[1],C1[0]),b=MX3(C0[2],C0[3],C1[1]); a=MX3(a,C1[2],C1[3]); \
      _Pragma("unroll") for(int r=4;r<16;r+=4){a=MX3(a,C0[r],C0[r+1]);b=MX3(b,C0[r+2],C0[r+3]);a=MX3(a,C1[r],C1[r+1]);b=MX3(b,C1[r+2],C1[r+3]);} \
      float rm=__builtin_fmaxf(a,b); { auto rr=__builtin_amdgcn_permlane32_swap(__float_as_uint(rm),__float_as_uint(rm),false,false); rm=__builtin_fmaxf(__uint_as_float(rr[0]),__uint_as_float(rr[1])); } \
      resc=false; \
      if(__builtin_expect(__any(rm>(float)THRL),0)){ const float dl=__builtin_fmaxf(rm,0.f); mhat+=dl; \
        _Pragma("unroll") for(int r=0;r<16;++r){C0[r]-=dl;C1[r]-=dl;} \
        _Pragma("unroll") for(int r=0;r<16;++r)negm[r]=-mhat; asm volatile("":"+v"(negm)); \
        const float f=__builtin_amdgcn_exp2f(-dl); l_reg*=f; if(hi==0)wsf[r32]=f; resc=true; } } \
    SBAR(); \
    GAPB(o[0]=__builtin_amdgcn_mfma_f32_32x32x16_bf16(PAF(0),VFR(0),o[0],0,0,0), C0,0); \
    GAPB(o[1]=__builtin_amdgcn_mfma_f32_32x32x16_bf16(PAF(0),VFR(4),o[1],0,0,0), C0,4); \
    KRD(GL,0); GAPB(o[0]=__builtin_amdgcn_mfma_f32_32x32x16_bf16(PAF(1),VFR(1),o[0],0,0,0), C0,8); \
    KRD(GL,1); GAPB(o[1]=__builtin_amdgcn_mfma_f32_32x32x16_bf16(PAF(1),VFR(5),o[1],0,0,0), C0,12); \
    KRD(GL,2); GAPB(o[0]=__builtin_amdgcn_mfma_f32_32x32x16_bf16(PAF(2),VFR(2),o[0],0,0,0), C1,0); \
    KRD(GL,3); GAPB(o[1]=__builtin_amdgcn_mfma_f32_32x32x16_bf16(PAF(2),VFR(6),o[1],0,0,0), C1,4); \
    GAPB(o[0]=__builtin_amdgcn_mfma_f32_32x32x16_bf16(PAF(3),VFR(3),o[0],0,0,0), C1,8); \
    GAPB(o[1]=__builtin_amdgcn_mfma_f32_32x32x16_bf16(PAF(3),VFR(7),o[1],0,0,0), C1,12); \
    }while(0)
  int t=1;
  #undef CMASK
  #define CMASK(P0,P1,t) do{}while(0)
  for(;t+5<NT;t+=2){
    STEP(pB0,pB1,pA0,pA1,t,true,true,true);     WAIT_BAR(2); RESC(); ROT();
    STEP(pA0,pA1,pB0,pB1,t+1,true,true,true);   WAIT_BAR(2); RESC(); ROT();
  }
  #undef CMASK
  #define CMASK(P0,P1,t) do{}while(0)
  #define ENDW(tt) do{ if((tt)+3<NT){WAIT_BAR(2);} else if((tt)+2<NT){WAIT_BAR(1);} else {WAIT_BAR(0);} }while(0)
  for(;t+1<NT;t+=2){
    STEP(pB0,pB1,pA0,pA1,t,(t+3<NT),(t+1<NT),(t+1<NT));       ENDW(t);   RESC(); ROT();
    STEP(pA0,pA1,pB0,pB1,t+1,(t+4<NT),(t+2<NT),(t+2<NT));     ENDW(t+1); RESC(); ROT();
  }
  STEP(pB0,pB1,pA0,pA1,NT-1,false,false,false); RESC();
  { float sacc=pB0[0]+pB0[1]; _Pragma("unroll") for(int r=2;r<16;++r)sacc+=pB0[r]; _Pragma("unroll") for(int r=0;r<16;++r)sacc+=pB1[r]; l_reg+=sacc;
    pw0=(u32x4){PKW(pB0,0),PKW(pB0,2),PKW(pB0,4),PKW(pB0,6)};pw1=(u32x4){PKW(pB0,8),PKW(pB0,10),PKW(pB0,12),PKW(pB0,14)};pw2=(u32x4){PKW(pB1,0),PKW(pB1,2),PKW(pB1,4),PKW(pB1,6)};pw3=(u32x4){PKW(pB1,8),PKW(pB1,10),PKW(pB1,12),PKW(pB1,14)};
    SBAR(); pv(o,vb0+sl_cur,PAF(0),PAF(1),PAF(2),PAF(3)); }
  #undef PKW
  #undef PAF
  #undef VFR
  #undef PIN
  #undef MX3
  #undef GAPA
  #undef GAPB
  #undef EX
  #undef VRD
  #undef KRD
  #undef STEP
  #undef ENDW
  {auto rr=__builtin_amdgcn_permlane32_swap(__float_as_uint(l_reg),__float_as_uint(l_reg),false,false);l_reg=__uint_as_float(rr[0])+__uint_as_float(rr[1]);}
  if(hi==0)wsf[32+r32]=l_reg;asm volatile("s_waitcnt lgkmcnt(0)":::"memory");
  float rli[16];
  #pragma unroll
  for(int r=0;r<16;++r)rli[r]=__builtin_amdgcn_rcpf(wsf[32+crow(r,hi)]);
  bf16*Ow=Ou+(long)(wid*QBLK)*DM;
  { bf16*stg=(bf16*)(shm+LDS_OST)+wid*2048;
    #pragma unroll
    for(int r=0;r<16;++r){const int orow=crow(r,hi);
      #pragma unroll
      for(int d0=0;d0<2;++d0)stg[orow*64+d0*32+r32]=__float2bfloat16(o[d0][r]*rli[r]);}
    asm volatile("s_waitcnt lgkmcnt(0)":::"memory");
    #pragma unroll
    for(int i=0;i<4;++i){const int row=i*8+(lane>>3),ch=lane&7; const u32x4 v=*(const u32x4*)(stg+row*64+ch*8); ATTN_STORE16(Ow+(long)row*DM+ch*8,v);} }
  asm volatile("s_waitcnt lgkmcnt(0)\n\ts_barrier":::"memory");
  #undef DMA_K
  #undef DMA_V
  #undef CMASK
  #undef START
  #undef RESC
  #undef ROT
}
constexpr int ATTN_LDS_BYTES=LDS_BYTES;
#undef SBAR
#undef WAIT_BAR
}

template <int LF>
__device__ __forceinline__ void conv_channel(LAS unsigned char* lds, const bf16_t* FIc, const bf16_t* wsrc, bf16_t* ydst, int tid, int lane, int wv) {
    constexpr int IPW = LF / 256, NBK = LF / 32, P = 2 * LF + 8, WSTR = LF + 8;
    LAS unsigned char* FIL = lds; LAS unsigned char* WL = lds + ((8 * P * 2 + 255) & ~255);
    __syncthreads();
    { const u32x4* fs = (const u32x4*)FIc; for (int i = tid; i < 8 * P * 2 / 16; i += NTHR) ((LAS u32x4*)FIL)[i] = fs[i]; }
    for (int i = tid; i < NB * (LF / 8); i += NTHR) { const int b = i / (LF / 8), ch = i % (LF / 8); *(LAS u32x4*)(WL + b * (WSTR * 2) + ch * 16) = *(const u32x4*)(wsrc + (size_t)b * LF + ch * 8); }
    __syncthreads();
    f32x4 acc[IPW][2]; bf16x8 Bw[IPW];
#pragma unroll
    for (int ii = 0; ii < IPW; ++ii) { acc[ii][0] = (f32x4){0.f, 0.f, 0.f, 0.f}; acc[ii][1] = (f32x4){0.f, 0.f, 0.f, 0.f}; Bw[ii] = (bf16x8){0, 0, 0, 0, 0, 0, 0, 0}; }
    const int rr = lane & 15, q = lane >> 4;
    const int aBase = (rr & 7) * (P * 2) + 2 * (LF - (rr - (rr & 7)) + 8 * q);
    const int bBase = rr * (WSTR * 2) + 16 * q;
#define CONV_STEPS(CHECK) do { _Pragma("unroll") for (int dd = 0; dd < IPW; ++dd) { \
        const int delta = IPW * d + dd; \
        const bf16x8 a0 = *(const LAS bf16x8*)(FIL + aBase - 64 * delta), a1 = *(const LAS bf16x8*)(FIL + aBase - 64 * delta - 32); \
        const int jn = IPW * (wv - d) - dd; \
        if (!(CHECK) || (jn >= 0 && jn < NBK)) Bw[(IPW - dd) % IPW] = *(const LAS bf16x8*)(WL + bBase + 64 * jn); \
        _Pragma("unroll") for (int ii = 0; ii < IPW; ++ii) { const int j = IPW * (wv - d) + ii - dd; \
            if (!(CHECK) || (j >= 0 && j < NBK)) { \
                acc[ii][0] = __builtin_amdgcn_mfma_f32_16x16x32_bf16(a0, Bw[(ii - dd + IPW) % IPW], acc[ii][0], 0, 0, 0); \
                acc[ii][1] = __builtin_amdgcn_mfma_f32_16x16x32_bf16(a1, Bw[(ii - dd + IPW) % IPW], acc[ii][1], 0, 0, 0); } } } } while (0)
    { const int d = wv - 8; CONV_STEPS(true); }
    for (int d = wv - 7; d < wv; ++d) { CONV_STEPS(false); }
    { const int d = wv; CONV_STEPS(true); }
#undef CONV_STEPS
#pragma unroll
    for (int ii = 0; ii < IPW; ++ii)
#pragma unroll
        for (int h = 0; h < 2; ++h) { u32x2 w; w.x = pk2(acc[ii][h][0], acc[ii][h][1]); w.y = pk2(acc[ii][h][2], acc[ii][h][3]);
            *(u32x2*)(ydst + (size_t)rr * LF + 32 * (IPW * wv + ii) + 16 * h + 4 * q) = w; }
}


__device__ __forceinline__ void route_reduce(float (&p)[32], int lane) {
#pragma unroll
    for (int i = 0; i < 16; ++i) { const bool up = (lane & 32) != 0; const float send = up ? p[i] : p[i + 16], keep = up ? p[i + 16] : p[i]; p[i] = keep + __shfl_xor(send, 32); }
#pragma unroll
    for (int i = 0; i < 8; ++i) { const bool up = (lane & 16) != 0; const float send = up ? p[i] : p[i + 8], keep = up ? p[i + 8] : p[i]; p[i] = keep + __shfl_xor(send, 16); }
#pragma unroll
    for (int i = 0; i < 4; ++i) { const bool up = (lane & 8) != 0; const float send = up ? p[i] : p[i + 4], keep = up ? p[i + 4] : p[i]; p[i] = keep + __shfl_xor(send, 8); }
#pragma unroll
    for (int i = 0; i < 2; ++i) { const bool up = (lane & 4) != 0; const float send = up ? p[i] : p[i + 2], keep = up ? p[i + 2] : p[i]; p[i] = keep + __shfl_xor(send, 4); }
    { const bool up = (lane & 2) != 0; const float send = up ? p[0] : p[1], keep = up ? p[1] : p[0]; p[0] = keep + __shfl_xor(send, 2); }
    p[0] += __shfl_xor(p[0], 1);
}
__device__ __forceinline__ void route_top4(float val, int myE, float (&sv)[4], int (&si)[4]) {
    int rank = 0;
#pragma unroll
    for (int e = 0; e < 32; ++e) { const float o = __builtin_bit_cast(float, __builtin_amdgcn_readlane(__builtin_bit_cast(int, val), 2 * e)); rank += (o > val || (o == val && e < myE)) ? 1 : 0; }
#pragma unroll
    for (int k = 0; k < 4; ++k) { const unsigned long long m = __ballot(rank == k); const int src = __builtin_ctzll(m);
        si[k] = src >> 1; sv[k] = __builtin_bit_cast(float, __builtin_amdgcn_readlane(__builtin_bit_cast(int, val), src)); }
}
#define IN(k) (lo <= (k) && (k) < hi)
#define SEAM(k) do { if (IN(k) && IN((k) + 1)) xcd_barrier(bar); } while (0)
#define SEAMK(k, kind) SEAM(k)
#define KLOCALS \
    const float* x_in = args.in[I_X]; const float* c_in = args.in[I_C]; const float* ctx_in = args.in[I_CTX]; const float* cctx_in = args.in[I_CCTX]; \
    float* out = args.out; \
    float* modp = (float*)(ws + WS_MODP); float* modf = (float*)(ws + WS_MOD); \
    float* cosT = (float*)(ws + WS_ROPE); float* sinT = cosT + SEQ * 32; \
    float* a2tab = (float*)(ws + WS_A2); \
    int* top_e = (int*)(ws + WS_PAIR); int* ppos = top_e + NTOK * 4; float* pgate = (float*)(ppos + NTOK * 4); int* pdest = (int*)(pgate + NTOK * 4); \
    bf16_t* XB = (bf16_t*)(ws + WS_XB); \
    bf16_t* Wqkv_t = (bf16_t*)(ws + WS_WQKV); bf16_t* Wo_t = (bf16_t*)(ws + WS_WO); bf16_t* Win_t = (bf16_t*)(ws + WS_WIN); bf16_t* Wout_t = (bf16_t*)(ws + WS_WOUT); \
    bf16_t* Wgu_t = (bf16_t*)(ws + WS_WGU); bf16_t* Wdn_t = (bf16_t*)(ws + WS_WDN); \
    bf16_t* hA = (bf16_t*)(ws + WS_HA); bf16_t* Qb = (bf16_t*)(ws + WS_Q); bf16_t* Kb = (bf16_t*)(ws + WS_K); bf16_t* Vb = (bf16_t*)(ws + WS_V); \
    bf16_t* Upre = (bf16_t*)(ws + WS_UPRE); bf16_t* Wc = (bf16_t*)(ws + WS_WC); bf16_t* Yc = (bf16_t*)(ws + WS_YC); \
    bf16_t* XS = (bf16_t*)(ws + WS_XS); bf16_t* AB = (bf16_t*)(ws + WS_AB); int* elist = (int*)(ws + WS_ELIST); \
    const int wr = wave >> 2, wc = wave & 3, fr = lane & 15, fq = lane >> 4;
template <int layer> __device__ __forceinline__ void layer_body(const Args& args, LAS unsigned char* lds, const XcdBarrier& bar, const int tid, const int lane, const int wave, const int G, const int bid, const int lo, const int hi) {
    const int gw = bid * NWAVES + wave, NGW = G * NWAVES;
    unsigned char* ws = args.ws;
    gu32* ctl = (gu32*)(ws + WS_CTL);
    KLOCALS
        const int pb = 3 + 10 * layer;
        const int jm = layer >> 1;
        const bool ctx_live = layer < 2;
        const int nrows = ctx_live ? NTOK : NLAT;
        const float* mo = modf + (size_t)layer * NMODROW * MODW;

        if ((layer & 1) == 0) {
            if (EN_GEMM && IN(pb + 0)) {
                EpiQKV E{Qb, Kb, Vb, args.in[I_QG] + jm * 64, args.in[I_KG] + jm * 64, cosT, sinT};
                const bf16_t* Wt = Wqkv_t + (size_t)jm * NQKV * D;
                const QkvSched S{hA, Wt, ctx_live ? 1 : 0, G, bid};
                run_gemm(lds, S, E);
            }
            SEAMK(pb + 0, 3);
            if (EN_ATT && IN(pb + 1)) {
                typedef attn_body::bf16 abf;
                const int x = bid & 7, sl = bid >> 3, nS = G >> 3;
                for (int q = sl; q < 256; q += nS) {
                    const int b = 2 * x + (q >> 7), kvh = (q >> 5) & 3, head = 4 * kvh + ((q >> 3) & 3), qb = q & 7;
                    abf* Qu = (abf*)(Qb + ((size_t)b * SEQ + qb * 256) * D + head * 64);
                    attn_body::attn_unit<8>(Qu, (const abf*)(Kb + (size_t)b * KVL * 256 + kvh * 64), (const abf*)(Vb + (size_t)b * KVL * 256 + kvh * 64), Qu, KVL / 64, (char*)lds);
                }
                if (ctx_live) for (int q = sl; q < 32; q += nS) {
                    const int b = 2 * x + (q >> 4), head = q & 15, kvh = head >> 2;
                    abf* Qu = (abf*)(Qb + ((size_t)NLAT + b * CL) * D + head * 64);
                    attn_body::attn_unit<8>(Qu, (const abf*)(Kb + ((size_t)b * KVL + SEQ) * 256 + kvh * 64), (const abf*)(Vb + ((size_t)b * KVL + SEQ) * 256 + kvh * 64), Qu, CL / 64, (char*)lds);
                }
            }
            SEAMK(pb + 1, 4);
            if (EN_GEMM && IN(pb + 2)) {
                EpiResid<layer == 0> E{x_in, ctx_in, XB, mo + 2 * D, nullptr};
                const bf16_t* Wt = Wo_t + (size_t)jm * D * D;
                const DenseSched S{Qb, Wt, nrows / 256, 4, G, bid};
                run_gemm(lds, S, E);
            }
            SEAMK(pb + 2, 5);
        } else {
            const float* cw = args.in[I_HCW] + (size_t)jm * 3 * NHY; const float* cb = args.in[I_HCB] + (size_t)jm * NHY;
            if (EN_GEMM && IN(pb + 0)) {
                EpiBiasBf16 E{Upre, NHY, args.in[I_HBIN] + (size_t)jm * NHY, 0};
                const bf16_t* Wt = Win_t + (size_t)jm * NHY * D;
                const DenseSched S{hA, Wt, nrows / 256, 12, G, bid};
                run_gemm(lds, S, E);
            }
            SEAMK(pb + 0, 6);
            if (EN_MISC && IN(pb + 1)) {
                LAS unsigned char* T = lds;
                const int nlat_u = NB * 16 * 4, nctx_u = ctx_live ? NB * 2 * 4 : 0;
                const int hw = tid >> 5, l32 = tid & 31;
                for (int u = bid; u < nlat_u + nctx_u; u += G) {
                    int b, s0, c0, Ls, rowb; bf16_t* dstb;
                    if (u < nlat_u) { b = u >> 6; s0 = ((u >> 2) & 15) * 128; c0 = (u & 3) * 256; Ls = SEQ; rowb = b * SEQ; dstb = Wc; }
                    else { const int q = u - nlat_u; b = q >> 3; s0 = ((q >> 2) & 1) * 128; c0 = (q & 3) * 256; Ls = CL; rowb = NLAT + b * CL; dstb = Wc + WC_CTX_OFF; }
                    const int cc = c0 + 8 * l32, sb = s0 + 8 * hw;
                    u32x4 ra[10], rv[10];
#pragma unroll
                    for (int i = 0; i < 10; ++i) { const int sp = sb + i - 1;
                        if (sp >= 0 && sp < Ls) { const bf16_t* ur = Upre + (size_t)(rowb + sp) * NHY + cc; ra[i] = *(const u32x4*)(ur + D); rv[i] = *(const u32x4*)(ur + 2 * D); }
                        else { ra[i] = (u32x4){0u, 0u, 0u, 0u}; rv[i] = (u32x4){0u, 0u, 0u, 0u}; } }
                    f32x4 w1[3][2], w2[3][2], b1[2], b2[2];
#pragma unroll
                    for (int tap = 0; tap < 3; ++tap)
#pragma unroll
                        for (int hh = 0; hh < 2; ++hh) { w1[tap][hh] = *(const f32x4*)(cw + tap * NHY + D + cc + 4 * hh); w2[tap][hh] = *(const f32x4*)(cw + tap * NHY + 2 * D + cc + 4 * hh); }
#pragma unroll
                    for (int hh = 0; hh < 2; ++hh) { b1[hh] = *(const f32x4*)(cb + D + cc + 4 * hh); b2[hh] = *(const f32x4*)(cb + 2 * D + cc + 4 * hh); }
                    unsigned op[8][4];
#pragma unroll
                    for (int sp = 0; sp < 4; ++sp) {
                        float pr[2][8];
#pragma unroll
                        for (int o = 0; o < 2; ++o) { const int si = 2 * sp + o;
                            f32x4 x1[2] = {b1[0], b1[1]}, vv[2] = {b2[0], b2[1]};
#pragma unroll
                            for (int tap = 0; tap < 3; ++tap) { const u32x4 a = ra[si + tap], q = rv[si + tap];
                                x1[0] += (f32x4){bflo(a.x), bfhi(a.x), bflo(a.y), bfhi(a.y)} * w1[tap][0]; x1[1] += (f32x4){bflo(a.z), bfhi(a.z), bflo(a.w), bfhi(a.w)} * w1[tap][1];
                                vv[0] += (f32x4){bflo(q.x), bfhi(q.x), bflo(q.y), bfhi(q.y)} * w2[tap][0]; vv[1] += (f32x4){bflo(q.z), bfhi(q.z), bflo(q.w), bfhi(q.w)} * w2[tap][1]; }
                            const f32x4 p0 = x1[0] * vv[0], p1 = x1[1] * vv[1];
                            pr[o][0] = p0[0]; pr[o][1] = p0[1]; pr[o][2] = p0[2]; pr[o][3] = p0[3]; pr[o][4] = p1[0]; pr[o][5] = p1[1]; pr[o][6] = p1[2]; pr[o][7] = p1[3]; }
#pragma unroll
                        for (int c = 0; c < 8; ++c) op[c][sp] = pk2(pr[0][c], pr[1][c]);
                    }
                    __syncthreads();
#pragma unroll
                    for (int c = 0; c < 8; ++c) { const int ch = 8 * l32 + c; *(LAS u32x4*)(T + ch * 256 + ((hw ^ (l32 & 15)) * 16)) = (u32x4){op[c][0], op[c][1], op[c][2], op[c][3]}; }
                    __syncthreads();
#pragma unroll
                    for (int i = 0; i < 8; ++i) { const int c = i * 32 + (tid >> 4), ch = tid & 15;
                        *(u32x4*)(dstb + ((size_t)(c0 + c) * NB + b) * Ls + s0 + ch * 8) = *(const LAS u32x4*)(T + c * 256 + ((ch ^ ((c >> 3) & 15)) * 16)); }
                }
            }
            SEAMK(pb + 1, 7);
            if (EN_CONV && IN(pb + 2)) {
                const int nlat_u = 1024, nctx_u = ctx_live ? 1024 : 0;
                for (int u = bid; u < nlat_u + nctx_u; u += G) {
                    if (u < nlat_u) { const int c = u; conv_channel<SEQ>(lds, (const bf16_t*)(ws + (jm == 0 ? WS_FI0 : WS_FI1)) + (size_t)c * 8 * FP_L, Wc + (size_t)c * NB * SEQ, Yc + (size_t)c * NB * SEQ, tid, lane, wave); }
                    else { const int c = u - nlat_u; conv_channel<CL>(lds, (const bf16_t*)(ws + WS_FI2) + (size_t)c * 8 * FP_C, Wc + WC_CTX_OFF + (size_t)c * NB * CL, Yc + WC_CTX_OFF + (size_t)c * NB * CL, tid, lane, wave); }
                }
            }
            SEAMK(pb + 2, 8);
            if (EN_MISC && IN(pb + 3)) {
                LAS unsigned char* T = lds;
                const int nlat_u = NB * 16 * 4, nctx_u = ctx_live ? NB * 2 * 4 : 0;
                const int hw = tid >> 5, l32 = tid & 31;
                for (int u = bid; u < nlat_u + nctx_u; u += G) {
                    int b, s0, c0, Ls, rowb; const bf16_t* srcb;
                    if (u < nlat_u) { b = u >> 6; s0 = ((u >> 2) & 15) * 128; c0 = (u & 3) * 256; Ls = SEQ; rowb = b * SEQ; srcb = Yc; }
                    else { const int q = u - nlat_u; b = q >> 3; s0 = ((q >> 2) & 1) * 128; c0 = (q & 3) * 256; Ls = CL; rowb = NLAT + b * CL; srcb = Yc + WC_CTX_OFF; }
                    __syncthreads();
#pragma unroll
                    for (int i = 0; i < 8; ++i) { const int c = i * 32 + (tid >> 4), ch = tid & 15;
                        *(LAS u32x4*)(T + c * 256 + ((ch ^ ((c >> 3) & 15)) * 16)) = *(const u32x4*)(srcb + ((size_t)(c0 + c) * NB + b) * Ls + s0 + ch * 8); }
                    const int cc = c0 + 8 * l32, sb = s0 + 8 * hw;
                    u32x4 ra[10];
#pragma unroll
                    for (int i = 0; i < 10; ++i) { const int sp = sb + i - 1;
                        if (sp >= 0 && sp < Ls) ra[i] = *(const u32x4*)(Upre + (size_t)(rowb + sp) * NHY + cc); else ra[i] = (u32x4){0u, 0u, 0u, 0u}; }
                    f32x4 w0[3][2], b0[2];
#pragma unroll
                    for (int tap = 0; tap < 3; ++tap)
#pragma unroll
                        for (int hh = 0; hh < 2; ++hh) w0[tap][hh] = *(const f32x4*)(cw + tap * NHY + cc + 4 * hh);
#pragma unroll
                    for (int hh = 0; hh < 2; ++hh) b0[hh] = *(const f32x4*)(cb + cc + 4 * hh);
                    __syncthreads();
                    u32x4 yv[8];
#pragma unroll
                    for (int c = 0; c < 8; ++c) yv[c] = *(const LAS u32x4*)(T + (8 * l32 + c) * 256 + ((hw ^ (l32 & 15)) * 16));
#pragma unroll
                    for (int si = 0; si < 8; ++si) {
                        f32x4 x0[2] = {b0[0], b0[1]};
#pragma unroll
                        for (int tap = 0; tap < 3; ++tap) { const u32x4 a = ra[si + tap];
                            x0[0] += (f32x4){bflo(a.x), bfhi(a.x), bflo(a.y), bfhi(a.y)} * w0[tap][0]; x0[1] += (f32x4){bflo(a.z), bfhi(a.z), bflo(a.w), bfhi(a.w)} * w0[tap][1]; }
                        float yy[8];
#pragma unroll
                        for (int c = 0; c < 8; ++c) { const unsigned wd = yv[c][si >> 1]; yy[c] = (si & 1) ? bfhi(wd) : bflo(wd); }
                        u32x4 o; o.x = pk2(x0[0][0] * yy[0], x0[0][1] * yy[1]); o.y = pk2(x0[0][2] * yy[2], x0[0][3] * yy[3]); o.z = pk2(x0[1][0] * yy[4], x0[1][1] * yy[5]); o.w = pk2(x0[1][2] * yy[6], x0[1][3] * yy[7]);
                        *(u32x4*)(hA + (size_t)(rowb + sb + si) * D + cc) = o;
                    }
                }
            }
            SEAMK(pb + 3, 9);
            if (EN_GEMM && IN(pb + 4)) {
                EpiResid<layer == 0> E{x_in, ctx_in, XB, mo + 2 * D, args.in[I_HBOUT] + (size_t)jm * D};
                const bf16_t* Wt = Wout_t + (size_t)jm * D * D;
                const DenseSched S{hA, Wt, nrows / 256, 4, G, bid};
                run_gemm(lds, S, E);
            }
            SEAMK(pb + 4, 10);
        }

        gu32* cnt = ctl + CW_CNT + layer * 32 * 64;
        if (EN_ROUTER && IN(pb + 5)) {
            constexpr int WS_ = D + 4;
            LAS float* WrT = (LAS float*)lds;
            LAS int* LCNT = (LAS int*)(lds + 32 * WS_ * 4);
            LAS int* PREC = LCNT + 64;
            constexpr int MAXT = 20;
            __syncthreads();
            { const float* rw = args.in[I_RW] + (size_t)layer * D * NE;
              for (int i = tid; i < (D / 4) * NE; i += NTHR) { const int k4 = (i >> 5) * 4, e = i & 31;
                  *(LAS f32x4*)(WrT + e * WS_ + k4) = (f32x4){rw[(k4 + 0) * NE + e], rw[(k4 + 1) * NE + e], rw[(k4 + 2) * NE + e], rw[(k4 + 3) * NE + e]}; } }
            if (tid < 64) LCNT[tid] = 0;
            for (int i = tid; i < 8 * MAXT * 4; i += NTHR) PREC[i] = -1;
            __syncthreads();
            const float* rb = args.in[I_RB] + layer * NE;
            const int myE = lane >> 1; const float myB = rb[myE];
            const int TPW = (((nrows + NGW - 1) / NGW) + 1) & ~1;
            int curb = -1; f32x4 gs[4], sh[4];
            for (int ti = 0; ti < TPW; ti += 2) {
                const int r0 = gw * TPW + ti, r1 = r0 + 1; if (r0 >= nrows) break;
                const bool ok1 = r1 < nrows; const int r1c = ok1 ? r1 : r0;
                f32x4 h0[4], h1[4], v0[4], v1[4];
                load_vec_bf(XB + (size_t)r0 * D, lane, v0);
                load_vec_bf(XB + (size_t)r1c * D, lane, v1);
                { const int b = mod_row(r0); if (b != curb) { const float* mr = mo + (size_t)b * MODW; load_vec(mr + 4 * D, lane, gs); load_vec(mr + 3 * D, lane, sh); curb = b; } }
                norm_mod_store(v0, gs, sh, hA + (size_t)r0 * D, lane, h0);
                { const int b = mod_row(r1c); if (b != curb) { const float* mr = mo + (size_t)b * MODW; load_vec(mr + 4 * D, lane, gs); load_vec(mr + 3 * D, lane, sh); curb = b; } }
                norm_mod_store(v1, gs, sh, hA + (size_t)r1c * D, lane, h1);
                float p0[32], p1[32];
                asm volatile("" ::: "memory");
                { f32x2 hp[4][4];
#pragma unroll
                  for (int j = 0; j < 4; ++j)
#pragma unroll
                      for (int c = 0; c < 4; ++c) hp[j][c] = (f32x2){h0[j][c], h1[j][c]};
                  f32x4 wa[8], wb[8];
                  const LAS float* wl = WrT + 4 * lane;
#define RT_LOAD(W, E) do { _Pragma("unroll") for (int q = 0; q < 8; ++q) W[q] = *(const LAS f32x4*)(wl + ((E) + (q >> 2)) * WS_ + 256 * (q & 3)); } while (0)
#define RT_FMA(W, E) do { _Pragma("unroll") for (int x = 0; x < 2; ++x) { f32x2 a = {0.f, 0.f}, b = {0.f, 0.f}; \
                      _Pragma("unroll") for (int j = 0; j < 4; ++j) { const f32x4 w = W[x * 4 + j]; \
                          a = __builtin_elementwise_fma(hp[j][0], (f32x2){w[0], w[0]}, a); b = __builtin_elementwise_fma(hp[j][1], (f32x2){w[1], w[1]}, b); \
                          a = __builtin_elementwise_fma(hp[j][2], (f32x2){w[2], w[2]}, a); b = __builtin_elementwise_fma(hp[j][3], (f32x2){w[3], w[3]}, b); } \
                      a = a + b; p0[(E) + x] = a.x; p1[(E) + x] = a.y; } } while (0)
                  RT_LOAD(wa, 0);
#pragma unroll
                  for (int e = 0; e < 32; e += 4) {
                      RT_LOAD(wb, e + 2); __builtin_amdgcn_sched_barrier(0); RT_FMA(wa, e); __builtin_amdgcn_sched_barrier(0);
                      if (e + 4 < 32) RT_LOAD(wa, e + 4); __builtin_amdgcn_sched_barrier(0); RT_FMA(wb, e + 2); __builtin_amdgcn_sched_barrier(0);
                  }
#undef RT_LOAD
#undef RT_FMA
                }
                route_reduce(p0, lane); route_reduce(p1, lane);
                float sv0[4], sv1[4]; int si0[4], si1[4];
                route_top4(p0[0] + myB, myE, sv0, si0); route_top4(p1[0] + myB, myE, sv1, si1);
                if (lane < 8) { const bool t1 = lane >= 4; const int k = lane & 3;
                    const float s0_ = t1 ? sv1[0] : sv0[0], s1_ = t1 ? sv1[1] : sv0[1], s2_ = t1 ? sv1[2] : sv0[2], s3_ = t1 ? sv1[3] : sv0[3];
                    const int i0_ = t1 ? si1[0] : si0[0], i1_ = t1 ? si1[1] : si0[1], i2_ = t1 ? si1[2] : si0[2], i3_ = t1 ? si1[3] : si0[3];
                    const float e1 = __expf(s1_ - s0_), e2 = __expf(s2_ - s0_), e3 = __expf(s3_ - s0_); const float inv = 1.0f / (1.0f + e1 + e2 + e3);
                    const int e = k == 0 ? i0_ : (k == 1 ? i1_ : (k == 2 ? i2_ : i3_)); const float gt = (k == 0 ? 1.0f : (k == 1 ? e1 : (k == 2 ? e2 : e3))) * inv;
                    if (!t1 || ok1) { const int r = t1 ? r1 : r0; const int rank = __hip_atomic_fetch_add(LCNT + e, 1, __ATOMIC_RELAXED, __HIP_MEMORY_SCOPE_WORKGROUP);
                        top_e[r * 4 + k] = e; pgate[r * 4 + k] = gt; PREC[(wave * MAXT + ti + (t1 ? 1 : 0)) * 4 + k] = e | (rank << 8); } }
            }
            __syncthreads();
            if (tid < 32) LCNT[32 + tid] = (int)__hip_atomic_fetch_add(cnt + tid * 64, (unsigned)LCNT[tid], RLX_AGENT);
            __syncthreads();
            for (int i = tid; i < 8 * MAXT * 4; i += NTHR) { const int rec = PREC[i]; if (rec >= 0) { const int e = rec & 255, rank = rec >> 8, w = i / (MAXT * 4), ti = (i / 4) % MAXT, k = i & 3;
                const int r = (bid * NWAVES + w) * TPW + ti; const int pos = LCNT[32 + e] + rank; ppos[r * 4 + k] = pos; elist[(size_t)e * NTOK + pos] = r; } }
        }
        SEAMK(pb + 5, 11);
        LAS int* PADS = (LAS int*)(lds + LDS_BYTES - 4096);
        LAS unsigned char* TE = (LAS unsigned char*)(PADS + 128);
        if (IN(pb + 7) || IN(pb + 8) || IN(pb + 9)) {
            __syncthreads();
            if (tid < 32) PADS[64 + tid] = (int)__hip_atomic_load(cnt + tid * 64, RLX_AGENT);
            __syncthreads();
            if (tid < 64) {
                const int nt = lane < 32 ? (PADS[64 + lane] + 255) >> 8 : 0; int inc = nt;
#pragma unroll
                for (int o = 1; o < 32; o <<= 1) { const int v = __shfl_up(inc, o); if (lane >= o) inc += v; }
                if (lane < 32) PADS[lane] = (inc - nt) << 8; if (lane == 31) PADS[32] = inc << 8;
            }
            __syncthreads();
            { const int ntile = PADS[32] >> 8; for (int t = tid; t < ntile; t += NTHR) { int e = 0;
#pragma unroll
                  for (int st = 16; st >= 1; st >>= 1) if (PADS[e + st] <= (t << 8)) e += st;
                  TE[t] = (unsigned char)e; } }
            __syncthreads();
        }
        if (EN_GEMM && IN(pb + 7)) {
            const int ntile = PADS[32] >> 8;
            LAS int* ROWS = (LAS int*)(lds + 131072);
            { Unit uu; for (int ui = 0; xcd_unit(ui, G, bid, ntile, 8, uu.pm, uu.pn); ++ui) { if (tid < 256) { const int e = TE[uu.pm]; const int pos = uu.pm * 256 - PADS[e] + tid;
                  ROWS[ui * 256 + tid] = pos < PADS[64 + e] ? elist[(size_t)e * NTOK + pos] : 0; } } }
            __syncthreads();
            const MoeGatherSched S{hA, Wgu_t + (size_t)layer * NE * NGU * D, TE, ROWS, ntile, 8, NGU, G, bid};
            const EpiSwiglu E{AB, args.in[I_BGU] + (size_t)layer * NE * NGU};
            run_gemm_gather(lds, S, E);
        }
        SEAMK(pb + 7, 12);
        if (EN_GEMM && IN(pb + 8)) {
            const int ntile = PADS[32] >> 8;
            const MoeSched S{AB, Wdn_t + (size_t)layer * NE * D * D, TE, ntile, 4, D, G, bid};
            const EpiBiasBf16 E{XS, D, args.in[I_BDN] + (size_t)layer * NE * D, D};
            run_gemm(lds, S, E);
        }
        SEAMK(pb + 8, 13);
        if (EN_MISC && IN(pb + 9)) {
            const bool has_next = layer + 1 < DEPTH;
            const float* mo_n = modf + (size_t)(layer + 1) * NMODROW * MODW; const float* g1n = args.in[I_N1G] + (has_next ? (layer + 1) * D : 0);
            const int nnext = (layer + 1 < 3) ? NTOK : NLAT;
            const int TPW = (nrows + NGW - 1) / NGW;
            int curb = -1; f32x4 gm[4], gsn[4], shn[4];
            for (int ti = 0; ti < TPW; ++ti) {
                const int r = gw * TPW + ti; if (r >= nrows) break;
                bf16_t* xr = XB + (size_t)r * D;
                int dest[4]; float gt[4];
#pragma unroll
                for (int k = 0; k < 4; ++k) { dest[k] = PADS[top_e[r * 4 + k]] + ppos[r * 4 + k]; gt[k] = pgate[r * 4 + k]; }
                u32x2 yw[4][4]; f32x4 v[4], h[4];
#pragma unroll
                for (int k = 0; k < 4; ++k) { const u32x2* yr = (const u32x2*)(XS + (size_t)dest[k] * D);
#pragma unroll
                    for (int j = 0; j < 4; ++j) yw[k][j] = yr[lane + 64 * j]; }
                load_vec_bf(xr, lane, v);
                const int b = mod_row(r);
                if (b != curb) { load_vec(mo + (size_t)b * MODW + 5 * D, lane, gm); if (has_next) { const float* mn = mo_n + (size_t)b * MODW; load_vec(mn + D, lane, gsn); load_vec(mn, lane, shn); } curb = b; }
#pragma unroll
                for (int j = 0; j < 4; ++j) { f32x4 y = (f32x4){0.f, 0.f, 0.f, 0.f};
#pragma unroll
                    for (int k = 0; k < 4; ++k) { const u32x2 w = yw[k][j]; y[0] += gt[k] * bflo(w.x); y[1] += gt[k] * bfhi(w.x); y[2] += gt[k] * bflo(w.y); y[3] += gt[k] * bfhi(w.y); }
                    v[j] = v[j] + gm[j] * y;
                    if (layer == DEPTH - 1) ((f32x4*)(out + (size_t)r * D))[lane + 64 * j] = v[j];
                    else { u32x2 w; w.x = pk2(v[j][0], v[j][1]); w.y = pk2(v[j][2], v[j][3]); ((u32x2*)xr)[lane + 64 * j] = w; } }
                if (has_next && r < nnext) norm_mod_store(v, gsn, shn, hA + (size_t)r * D, lane, h);
            }
        }
        SEAMK(pb + 9, 14);
}

__global__ void __launch_bounds__(NTHR, 2) fwd(Args args) {
    extern __shared__ __attribute__((aligned(16))) unsigned char lds_raw[];
    LAS unsigned char* lds = (LAS unsigned char*)lds_raw;
    const int tid = threadIdx.x, lane = tid & 63, wave = __builtin_amdgcn_readfirstlane(tid >> 6);
    const int G = gridDim.x, bid = blockIdx.x;
    const int gw = bid * NWAVES + wave, NGW = G * NWAVES;
    unsigned char* ws = args.ws;
    gu32* ctl = (gu32*)(ws + WS_CTL);
    volatile LAS unsigned* MISC = (volatile LAS unsigned*)(lds + MISC_OFF);
    if (tid < 64) MISC[tid] = 0u;
    __syncthreads();
    XcdBarrier bar; bar.bar = (unsigned*)ctl + CW_BAR; bar.x = 0; bar.st = MISC + 8;
    const int lo = args.ph_lo, hi = args.ph_hi;
    if (hi - lo > 1) bar = xcd_barrier_post((unsigned*)ctl + CW_BAR, MISC + 8);

    KLOCALS

    if (EN_PRO && IN(0)) {
        {
            LAS float* scr = (LAS float*)(lds + wave * 8448);
            constexpr int IT_QKV = 16 * (NQKV / 32), IT_SQ = 16 * (D / 32), IT_IN = 16 * (NHY / 32), IT_GU = 16 * (NGU / 32);
            constexpr int N0 = 2 * IT_QKV, N1 = N0 + 2 * IT_SQ, N2 = N1 + 2 * IT_IN, N3 = N2 + 2 * IT_SQ, N4 = N3 + 128 * IT_GU, N5 = N4 + 128 * IT_SQ;
            for (int it = gw; it < N5; it += NGW) {
                if (it < N0) { const int mtx = it / IT_QKV, r = it % IT_QKV; transpose_item<1>(args.in[I_WQKV] + (size_t)mtx * D * NQKV, NQKV, Wqkv_t + (size_t)mtx * NQKV * D, scr, r, lane); }
                else if (it < N1) { const int q = it - N0, mtx = q / IT_SQ, r = q % IT_SQ; transpose_item<0>(args.in[I_WO] + (size_t)mtx * D * D, D, Wo_t + (size_t)mtx * D * D, scr, r, lane); }
                else if (it < N2) { const int q = it - N1, mtx = q / IT_IN, r = q % IT_IN; transpose_item<0>(args.in[I_HWIN] + (size_t)mtx * D * NHY, NHY, Win_t + (size_t)mtx * NHY * D, scr, r, lane); }
                else if (it < N3) { const int q = it - N2, mtx = q / IT_SQ, r = q % IT_SQ; transpose_item<0>(args.in[I_HWOUT] + (size_t)mtx * D * D, D, Wout_t + (size_t)mtx * D * D, scr, r, lane); }
                else if (it < N4) { const int q = it - N3, mtx = q / IT_GU, r = q % IT_GU; transpose_item<2>(args.in[I_WGU] + (size_t)mtx * D * NGU, NGU, Wgu_t + (size_t)mtx * NGU * D, scr, r, lane); }
                else { const int q = it - N4, mtx = q / IT_SQ, r = q % IT_SQ; transpose_item<0>(args.in[I_WDN] + (size_t)mtx * D * D, D, Wdn_t + (size_t)mtx * D * D, scr, r, lane); }
            }
        }
        __syncthreads();
        {
            LAS float* S = (LAS float*)lds;
            for (int u = bid; u < 4 * 12 * 8; u += G) {
                const int kc = u & 7, cc = (u >> 3) % 12, layer = u / 96;
                __syncthreads();
                for (int i = tid; i < 128 * 20; i += NTHR) { const int k = i / 20, r = i % 20; float v = 0.f;
                    if (r < NMODROW) { const float cv = r < NB ? c_in[r * D + kc * 128 + k] : cctx_in[kc * 128 + k]; v = cv / (1.0f + __expf(-cv)); }
                    S[i] = v; }
                __syncthreads();
                const int col = cc * 512 + tid;
                const float* wp = args.in[I_WMOD] + ((size_t)layer * D + kc * 128) * MODW + col;
                float acc[20];
#pragma unroll
                for (int r = 0; r < 20; ++r) acc[r] = 0.f;
                for (int k = 0; k < 128; ++k) { const float w = wp[(size_t)k * MODW];
#pragma unroll
                    for (int q = 0; q < 5; ++q) { const f32x4 s = *(const LAS f32x4*)(S + k * 20 + 4 * q);
                        acc[4 * q] += s[0] * w; acc[4 * q + 1] += s[1] * w; acc[4 * q + 2] += s[2] * w; acc[4 * q + 3] += s[3] * w; } }
#pragma unroll
                for (int r = 0; r < NMODROW; ++r) modp[((size_t)(kc * 4 + layer) * NMODROW + r) * MODW + col] = acc[r];
            }
        }
        for (int i = bid * NTHR + tid; i < SEQ * 32; i += G * NTHR) {
            const int t = i >> 5, j = i & 31, fi = j & 15; const int pos = (j >> 4) == 0 ? (t >> 6) : (t & 63);
            const float inv = powf(10000.0f, -(float)fi / 16.0f); const float ang = (float)pos * inv;
            cosT[i] = cosf(ang); sinT[i] = sinf(ang);
        }
        {
            __syncthreads();
            LAS float* Z = (LAS float*)lds;
            LAS float* A1 = Z + 8 * 36;
            for (int u = bid; u < 256 + 256 + 32; u += G) {
                const int combo = u < 256 ? 0 : (u < 512 ? 1 : 2); const int ub = combo == 0 ? u : (combo == 1 ? u - 256 : u - 512);
                const int j = combo == 1 ? 1 : 0, Lf = combo == 2 ? CL : SEQ;
                const int tl = tid >> 6, o = tid & 63, t = ub * 8 + tl;
                __syncthreads();
                if (o < 33) { float z;
                    const float tt = (float)t / (float)(Lf - 1), w = 6.283185307179586f * (float)t / (float)Lf;
                    if (o == 0) z = tt; else { const int b = (o - 1) & 15; const float f = 1e-4f + (float)b * ((15.0f - 1e-4f) / 15.0f); z = o <= 16 ? cosf(f * w) : -sinf(f * w); }
                    Z[tl * 36 + o] = z; }
                __syncthreads();
                const float sf = args.in[I_HSF][j * 64 + o];
                { const float* w1 = args.in[I_HW1] + (size_t)j * 33 * 64; float a = args.in[I_HB1][j * 64 + o];
                  for (int i = 0; i < 33; ++i) a += Z[tl * 36 + i] * w1[i * 64 + o];
                  A1[tl * 64 + o] = sinf(sf * a); }
                __syncthreads();
                { const float* w2 = args.in[I_HW2] + (size_t)j * 64 * 64; float a = args.in[I_HB2][j * 64 + o];
                  for (int i = 0; i < 64; ++i) a += A1[tl * 64 + i] * w2[i * 64 + o];
                  a2tab[((size_t)combo * SEQ + t) * 64 + o] = sinf(sf * a); }
            }
        }
    }
    SEAMK(0, 0);

    if (EN_PRO && IN(1)) {
        for (int i = bid * NTHR + tid; i < DEPTH * NMODROW * MODW; i += G * NTHR) {
            const int layer = i / (NMODROW * MODW), rem = i % (NMODROW * MODW), col = rem % MODW; float s = args.in[I_BMOD][layer * MODW + col];
#pragma unroll
            for (int kc = 0; kc < 8; ++kc) s += modp[(size_t)(kc * 4 + layer) * NMODROW * MODW + rem];
            const int chunk = col >> 10, k = col & (D - 1);
            if (chunk == 1) s = args.in[I_N1G][layer * D + k] * (1.0f + s); else if (chunk == 4) s = args.in[I_N2G][layer * D + k] * (1.0f + s);
            modf[i] = s;
        }
        {
            LAS float* W3 = (LAS float*)lds;
            LAS float* RED = W3 + 512;
            LAS float* NRM = RED + 32;
            LAS float* HF = NRM + 4;
            for (int u = bid; u < 3 * 256; u += G) {
                const int combo = u >> 8, cg = u & 255; const int j = combo == 1 ? 1 : 0, Lf = combo == 2 ? CL : SEQ; const int c0 = cg * 4;
                LAS float* HB = HF + 4 * Lf;
                __syncthreads();
                { const int i = tid >> 3, q = tid & 7; const int col = (q >> 2) * 1024 + c0 + (q & 3);
                  W3[i * 8 + q] = args.in[I_HW3][((size_t)j * 64 + i) * 2048 + col]; }
                __syncthreads();
                float b3v[8], dec[4], asum[4] = {0.f, 0.f, 0.f, 0.f};
#pragma unroll
                for (int q = 0; q < 8; ++q) b3v[q] = args.in[I_HB3][j * 2048 + (q >> 2) * 1024 + c0 + (q & 3)];
#pragma unroll
                for (int ch = 0; ch < 4; ++ch) dec[ch] = 3.0701134573253945f + (float)(c0 + ch) * ((15.350567286626972f - 3.0701134573253945f) / 1023.0f);
                for (int t = tid; t < Lf; t += NTHR) {
                    asm volatile("" ::: "memory");
                    const float* ar = a2tab + ((size_t)combo * SEQ + t) * 64; float d[8];
#pragma unroll
                    for (int q = 0; q < 8; ++q) d[q] = b3v[q];
#pragma unroll
                    for (int i4 = 0; i4 < 16; ++i4) { const f32x4 a = *(const f32x4*)(ar + 4 * i4); asm volatile("" ::: "memory");
#pragma unroll
                        for (int e = 0; e < 4; ++e) { const f32x4 w0 = *(const LAS f32x4*)(W3 + (4 * i4 + e) * 8), w1 = *(const LAS f32x4*)(W3 + (4 * i4 + e) * 8 + 4);
                            d[0] += a[e] * w0[0]; d[1] += a[e] * w0[1]; d[2] += a[e] * w0[2]; d[3] += a[e] * w0[3]; d[4] += a[e] * w1[0]; d[5] += a[e] * w1[1]; d[6] += a[e] * w1[2]; d[7] += a[e] * w1[3]; } }
                    const float tt = (float)t / (float)(Lf - 1);
#pragma unroll
                    for (int ch = 0; ch < 4; ++ch) { const float dk = __expf(-tt * dec[ch]); const float f = d[ch] * dk, bb = d[4 + ch] * dk;
                        HF[ch * Lf + t] = f; HB[ch * Lf + t] = bb; asum[ch] += fabsf(f) + (t >= 1 ? fabsf(bb) : 0.f); }
                }
#pragma unroll
                for (int ch = 0; ch < 4; ++ch) { const float s = wave_sum(asum[ch]); if (lane == 0) RED[wave * 4 + ch] = s; }
                __syncthreads();
                if (tid < 4) { float s = 0.f; for (int w = 0; w < 8; ++w) s += RED[w * 4 + tid]; NRM[tid] = 1.0f / (s + EPS); }
                __syncthreads();
                const int P = 2 * Lf + 8, PC8 = P / 8;
                bf16_t* FI = (bf16_t*)(ws + (combo == 0 ? WS_FI0 : (combo == 1 ? WS_FI1 : WS_FI2)));
                for (int q = tid; q < 4 * 8 * PC8; q += NTHR) {
                    const int ch = q / (8 * PC8), r = q % (8 * PC8), cidx = r / PC8, x0 = (r % PC8) * 8;
                    const float nr = NRM[ch], db = args.in[I_HDB][j * 1024 + c0 + ch]; float v[8];
#pragma unroll
                    for (int e = 0; e < 8; ++e) { const int m = Lf - (x0 + e) + cidx; const int am = m < 0 ? -m : m; float g = 0.f;
                        if (am <= Lf - 1) { g = (m >= 0 ? HF[ch * Lf + am] : HB[ch * Lf + am]) * nr; if (m == 0) g += db; }
                        v[e] = g; }
                    u32x4 o; o.x = pk2(v[0], v[1]); o.y = pk2(v[2], v[3]); o.z = pk2(v[4], v[5]); o.w = pk2(v[6], v[7]);
                    *(u32x4*)(FI + ((size_t)((c0 + ch) * 8 + cidx)) * P + x0) = o;
                }
            }
        }
    }
    SEAMK(1, 1);

    if (IN(2)) {
        const float* mo = modf;
        const int TPW = (NTOK + NGW - 1) / NGW;
        int curb = -1; f32x4 gs[4], sh[4];
        for (int ti = 0; ti < TPW; ++ti) {
            const int r = gw * TPW + ti; if (r >= NTOK) break;
            const float* src = r < NLAT ? x_in + (size_t)r * D : ctx_in + (size_t)(r - NLAT) * D;
            f32x4 v[4], h[4]; load_vec(src, lane, v);
            const int b = mod_row(r); if (b != curb) { const float* mr = mo + (size_t)b * MODW; load_vec(mr + D, lane, gs); load_vec(mr, lane, sh); curb = b; }
            norm_mod_store(v, gs, sh, hA + (size_t)r * D, lane, h);
        }
    }
    SEAMK(2, 2);

    layer_body<0>(args, lds, bar, tid, lane, wave, G, bid, lo, hi);
    layer_body<1>(args, lds, bar, tid, lane, wave, G, bid, lo, hi);
    layer_body<2>(args, lds, bar, tid, lane, wave, G, bid, lo, hi);
    layer_body<3>(args, lds, bar, tid, lane, wave, G, bid, lo, hi);
#undef IN
#undef SEAM
}

extern "C" void kernel_launch(void* const* d_in, const int* in_sizes, int n_in, void* d_out, int out_size, void* d_ws, size_t ws_size, hipStream_t stream) {
    static int grid = 0;
    if (grid == 0) {
        if (n_in != 32 || out_size != NLAT * D || ws_size < WS_END) { fprintf(stderr, "kernel_launch: unexpected problem (n_in %d, out %d, ws %zu)\n", n_in, out_size, ws_size); grid = -1; return; }
        int dev = 0, cus = 0, per_cu = 0;
        if (hipGetDevice(&dev) != hipSuccess || hipDeviceGetAttribute(&cus, hipDeviceAttributeMultiprocessorCount, dev) != hipSuccess) { grid = -1; return; }
        if (hipFuncSetAttribute((const void*)fwd, hipFuncAttributeMaxDynamicSharedMemorySize, LDS_BYTES) != hipSuccess) { fprintf(stderr, "kernel_launch: hipFuncSetAttribute failed\n"); grid = -1; return; }
        if (hipOccupancyMaxActiveBlocksPerMultiprocessor(&per_cu, (const void*)fwd, NTHR, LDS_BYTES) != hipSuccess || per_cu < 1) fprintf(stderr, "kernel_launch: occupancy query says %d\n", per_cu);
        (void)hipGetLastError();
        grid = cus;
    }
    if (grid < 0) return;
    (void)hipMemsetAsync((char*)d_ws + WS_CTL, 0, CTL_ZERO_BYTES, stream);
    Args a{};
    for (int i = 0; i < 32; ++i) a.in[i] = (const float*)d_in[i];
    a.out = (float*)d_out; a.ws = (unsigned char*)d_ws;
    constexpr int NPH = 3 + 10 * DEPTH;
#if MK_ONE_LAUNCH
    a.ph_lo = 0; a.ph_hi = NPH;
    hipLaunchKernelGGL(fwd, dim3(grid), dim3(NTHR), LDS_BYTES, stream, a);
#else
    for (int p = 0; p < NPH; ++p) {
        if (p >= 3) { const int layer = (p - 3) / 10, loc = (p - 3) % 10; if ((layer & 1) == 0 && (loc == 3 || loc == 4)) continue; }
        a.ph_lo = p; a.ph_hi = p + 1;
        hipLaunchKernelGGL(fwd, dim3(grid), dim3(NTHR), LDS_BYTES, stream, a);
    }
#endif
}
```

```cpp
#include <hip/hip_runtime.h>
#include <cstdio>
#include <cstdint>
#include <cmath>
#include <hip/hip_bf16.h>

#ifndef EN_PRO
#define EN_PRO 1
#endif
#ifndef EN_ATT
#define EN_ATT 1
#endif
#ifndef EN_CONV
#define EN_CONV 1
#endif
#ifndef EN_ROUTER
#define EN_ROUTER 1
#endif
#ifndef EN_GEMM
#define EN_GEMM 1
#endif
#ifndef EN_MISC
#define EN_MISC 1
#endif
#ifndef MK_ONE_LAUNCH
#define MK_ONE_LAUNCH 1
#endif

#define GAS __attribute__((address_space(1)))
#define LAS __attribute__((address_space(3)))
typedef unsigned short bf16_t;
typedef short bf16x8 __attribute__((ext_vector_type(8)));
typedef float f32x4 __attribute__((ext_vector_type(4)));
typedef float f32x2 __attribute__((ext_vector_type(2)));
typedef unsigned u32x4 __attribute__((ext_vector_type(4)));
typedef unsigned u32x2 __attribute__((ext_vector_type(2)));
typedef GAS unsigned gu32;
typedef float f32x16 __attribute__((ext_vector_type(16)));

constexpr int D = 1024, NB = 16, SEQ = 2048, CL = 256, KVL = SEQ + CL;
constexpr int NLAT = NB * SEQ, NCTX = NB * CL, NTOK = NLAT + NCTX;
constexpr int NE = 32, TOPK = 4, DEPTH = 4;
constexpr int MODW = 6 * D, NMODROW = NB + 1;
constexpr int NQKV = 1536, NHY = 3072, NGU = 2048;
constexpr float EPS = 1e-6f;
constexpr float C2 = 0.125f * 1.4426950408889634f;
constexpr int NWAVES = 8, NTHR = 512;
constexpr int NPADROWS = 155648;
constexpr int MAXTILES = NPADROWS / 256;

constexpr size_t MiB = 1u << 20;
constexpr size_t WS_CTL = 0, CTL_ZERO_BYTES = 1 * MiB;
constexpr size_t WS_MODP = 2 * MiB;
constexpr size_t WS_MOD = 16 * MiB;
constexpr size_t WS_ROPE = 18 * MiB;
constexpr size_t WS_A2 = 19 * MiB;
constexpr size_t WS_PAIR = 21 * MiB;
constexpr size_t WS_CTX = 24 * MiB;
constexpr size_t WS_FI = 40 * MiB;
constexpr int FP_L = 2 * SEQ + 8, FP_C = 2 * CL + 8;
constexpr size_t FI_L_BYTES = (size_t)1024 * 8 * FP_L * 2, FI_C_BYTES = (size_t)1024 * 8 * FP_C * 2;
constexpr size_t WS_FI0 = WS_FI, WS_FI1 = WS_FI0 + 65 * MiB, WS_FI2 = WS_FI1 + 65 * MiB;
static_assert(FI_L_BYTES <= 65 * MiB && WS_FI2 + FI_C_BYTES <= 180 * MiB, "filter map");
constexpr size_t WS_WQKV = 180 * MiB, WS_WO = 186 * MiB, WS_WIN = 190 * MiB, WS_WOUT = 202 * MiB, WS_WGU = 206 * MiB, WS_WDN = 718 * MiB;
constexpr size_t WS_HA = 974 * MiB;
constexpr size_t WS_Q = 1046 * MiB;
constexpr size_t WS_K = 1118 * MiB, WS_V = 1136 * MiB;
constexpr size_t WS_UPRE = 1154 * MiB;
constexpr size_t WS_WC = 1370 * MiB;
constexpr size_t WS_YC = 1442 * MiB;
constexpr size_t WS_XS = 1514 * MiB;
constexpr size_t WS_AB = 1818 * MiB;
constexpr size_t WS_ELIST = 2122 * MiB;
constexpr size_t WS_XB = 2128 * MiB;
constexpr size_t WS_END = 2200 * MiB;
constexpr size_t WC_CTX_OFF = (size_t)1024 * 16 * 2048;
constexpr int CW_TMO = 0, CW_BAR = 4096, CW_CNT = 16384;

constexpr int LDS_BYTES = 160 * 1024;
constexpr int MISC_OFF = LDS_BYTES - 256;

#define RLX_AGENT __ATOMIC_RELAXED, __HIP_MEMORY_SCOPE_AGENT
#define LDS_WAIT() asm volatile("s_waitcnt lgkmcnt(0)" ::: "memory")
#define VM_WAIT() asm volatile("s_waitcnt vmcnt(0)" ::: "memory")
__device__ __forceinline__ unsigned f2bf(float f) { unsigned u = __builtin_bit_cast(unsigned, f); return (u + 0x7fffu + ((u >> 16) & 1u)) >> 16; }
typedef __bf16 bf16x2_t __attribute__((ext_vector_type(2)));
__device__ __forceinline__ unsigned pk2(float lo, float hi) { const f32x2 v = {lo, hi}; const bf16x2_t b = __builtin_convertvector(v, bf16x2_t); return __builtin_bit_cast(unsigned, b); }
__device__ __forceinline__ float bf2f(unsigned h) { return __builtin_bit_cast(float, h << 16); }
__device__ __forceinline__ float bflo(unsigned w) { return __builtin_bit_cast(float, w << 16); }
__device__ __forceinline__ float bfhi(unsigned w) { return __builtin_bit_cast(float, w & 0xffff0000u); }
__device__ __forceinline__ float wave_sum(float v) {
#pragma unroll
    for (int o = 1; o < 64; o <<= 1) v += __shfl_xor(v, o);
    return v;
}

#define XB_TMO      128
#define XB_XCNT(j)  (256  + 64 * (j))
#define XB_XSUB(j)  (1280 + 64 * (j))
#define XB_XGEN(j)  (2304 + 64 * (j))
#define XB_TOP      3328
#define XB_TOPGEN   3392
#define XCD_BAR_WORDS 3456
#define XB_SPIN_CAP (1u << 22)
__device__ __forceinline__ unsigned xb_ld(unsigned* p)              { return __hip_atomic_load(p, __ATOMIC_RELAXED, __HIP_MEMORY_SCOPE_AGENT); }
__device__ __forceinline__ unsigned xb_add(unsigned* p, unsigned v) { return __hip_atomic_fetch_add(p, v, __ATOMIC_RELAXED, __HIP_MEMORY_SCOPE_AGENT); }
__device__ __forceinline__ unsigned xb_xcc_id() { return (unsigned)__builtin_amdgcn_s_getreg((3 << 11) | 20) & 0xFu; }
#define XB_SPIN(cond, bar) do { unsigned _sp = 0; while (cond) { __builtin_amdgcn_s_sleep(1); \
    if ((++_sp & 255u) == 0u) { if (xb_ld(&(bar)[XB_TMO])) break; if (_sp > XB_SPIN_CAP) { atomicAdd(&(bar)[XB_TMO], 1u); break; } } } } while (0)
struct XcdBarrier { unsigned* bar; unsigned x; volatile LAS unsigned* st; };
__device__ __forceinline__ XcdBarrier xcd_barrier_post(unsigned* bar, volatile LAS unsigned* st) {
    XcdBarrier b; b.bar = bar; b.x = xb_xcc_id(); b.st = st;
    if (threadIdx.x == 0) (void)xb_add(&bar[XB_XCNT(b.x)], 1u);
    return b;
}
__device__ __forceinline__ void xcd_barrier_complete(unsigned* bar, unsigned x, unsigned& nloc, unsigned& nx) {
    const unsigned G = gridDim.x * gridDim.y * gridDim.z;
    unsigned sum, cnt, mine, sp = 0u;
    for (;;) {
        sum = 0u; cnt = 0u; mine = 0u;
#pragma unroll
        for (unsigned j = 0; j < 16; ++j) { const unsigned c = xb_ld(&bar[XB_XCNT(j)]); sum += c; cnt += (c > 0u) ? 1u : 0u; mine = (j == x) ? c : mine; }
        if (sum == G) break;
        __builtin_amdgcn_s_sleep(1);
        if ((++sp & 255u) == 0u) { if (xb_ld(&bar[XB_TMO])) break; if (sp > XB_SPIN_CAP) { atomicAdd(&bar[XB_TMO], 1u); break; } }
    }
    nloc = mine > 0u ? mine : 1u; nx = cnt > 0u ? cnt : 1u;
}
__device__ __forceinline__ void xcd_barrier(const XcdBarrier& b) {
    asm volatile("s_waitcnt vmcnt(0)" ::: "memory");
    __syncthreads();
    if (threadIdx.x == 0) {
        unsigned* bar = b.bar;
        __builtin_amdgcn_s_waitcnt(0);
        unsigned nloc = b.st[0], nx = b.st[1];
        if (nloc == 0u) { xcd_barrier_complete(bar, b.x, nloc, nx); b.st[0] = nloc; b.st[1] = nx; }
        const unsigned old = xb_add(&bar[XB_XSUB(b.x)], 1u);
        const unsigned gen = old / nloc;
        if (old + 1u == (gen + 1u) * nloc) {
            __builtin_amdgcn_fence(__ATOMIC_RELEASE, "agent");
            asm volatile("s_waitcnt vmcnt(0)" ::: "memory");
            const unsigned og = xb_add(&bar[XB_TOP], 1u);
            const unsigned tg = og / nx;
            if (og + 1u == (tg + 1u) * nx) xb_add(&bar[XB_TOPGEN], 1u);
            else XB_SPIN(xb_ld(&bar[XB_TOPGEN]) == tg, bar);
            __builtin_amdgcn_fence(__ATOMIC_ACQUIRE, "agent");
            xb_add(&bar[XB_XGEN(b.x)], 1u);
            asm volatile("s_waitcnt vmcnt(0)" ::: "memory");
        } else {
            XB_SPIN(xb_ld(&bar[XB_XGEN(b.x)]) == gen, bar);
            __builtin_amdgcn_fence(__ATOMIC_ACQUIRE, "agent");
            asm volatile("s_waitcnt vmcnt(0)" ::: "memory");
        }
    }
    __syncthreads();
}

struct Args { const float* in[32]; float* out; unsigned char* ws; int ph_lo, ph_hi; };
struct Ctx {
    LAS unsigned char* lds;
    int tid, lane, wave, G, bid;
    const float* const* in;
};
enum { I_X = 0, I_C, I_CTX, I_CCTX, I_WMOD, I_BMOD, I_N1G, I_N2G, I_WQKV, I_QG, I_KG, I_WO, I_HWIN, I_HBIN, I_HCW, I_HCB, I_HW1, I_HB1, I_HW2, I_HB2, I_HW3, I_HB3,
       I_HSF, I_HDB, I_HWOUT, I_HBOUT, I_RW, I_RB, I_WGU, I_BGU, I_WDN, I_BDN };

__device__ __forceinline__ int mod_row(int r) { return r < NLAT ? (r >> 11) : NB; }

__device__ __forceinline__ void gemm_unit_simple(const bf16_t* At, const bf16_t* Bt, f32x4 (&acc)[2][2][4][2], int wr, int wc, int fr, int fq) {
    constexpr int K = D;
#pragma unroll
    for (int a = 0; a < 2; ++a)
#pragma unroll
        for (int b = 0; b < 2; ++b)
#pragma unroll
            for (int m = 0; m < 4; ++m)
#pragma unroll
                for (int n = 0; n < 2; ++n) acc[a][b][m][n] = (f32x4){0.f, 0.f, 0.f, 0.f};
    const bf16_t* ap = At + (size_t)(wr * 64 + fr) * K + fq * 8;
    const bf16_t* bp = Bt + (size_t)(wc * 32 + fr) * K + fq * 8;
    for (int k0 = 0; k0 < K; k0 += 32) {
        bf16x8 bfr[2][2];
#pragma unroll
        for (int bj = 0; bj < 2; ++bj)
#pragma unroll
            for (int n = 0; n < 2; ++n) bfr[bj][n] = *(const bf16x8*)(bp + (size_t)(bj * 128 + n * 16) * K + k0);
#pragma unroll
        for (int ai = 0; ai < 2; ++ai)
#pragma unroll
            for (int m = 0; m < 4; ++m) {
                const bf16x8 afr = *(const bf16x8*)(ap + (size_t)(ai * 128 + m * 16) * K + k0);
#pragma unroll
                for (int bj = 0; bj < 2; ++bj)
#pragma unroll
                    for (int n = 0; n < 2; ++n) acc[ai][bj][m][n] = __builtin_amdgcn_mfma_f32_16x16x32_bf16(bfr[bj][n], afr, acc[ai][bj][m][n], 0, 0, 0);
            }
    }
}


struct Unit { int pm, pn, e; };
namespace pg8 {
constexpr int BM = 256, BK = 64, HALF = 128, HTB = HALF * BK * 2, STAGE_BYTES = 8 * HTB;
__device__ __forceinline__ int lds_byte(int r, int c) { const int st = (r >> 4) * 2 + (c >> 5), rr = r & 15, cc = c & 31, ob = rr * 64 + cc * 2; return st * 1024 + (ob ^ (((ob >> 9) & 1) << 5)); }
__device__ __forceinline__ void stage_rc(int b, int& R, int& C) { const int st = b / 1024, sb = b % 1024, swz = sb ^ (((sb >> 9) & 1) << 5); R = (st >> 1) * 16 + swz / 64; C = (st & 1) * 32 + (swz % 64) / 2; }
template <class Epi, class Sched, bool GATHER = false>
__device__ __forceinline__ void gemm_phase(LAS unsigned char* lds, const Sched& S, const Epi& E) {
    constexpr int K = D, nt = K / BK;
    const int tid = threadIdx.x, wid = __builtin_amdgcn_readfirstlane(tid >> 6), lane = tid & 63, wr = wid >> 2, wc = wid & 3, fr = lane & 15, fq = lane >> 4;
    unsigned voffA[2];
#pragma unroll
    for (int i = 0; i < 2; ++i) { int R, C; stage_rc(tid * 16 + i * 8192, R, C); voffA[i] = (unsigned)(R * K + C) * 2u; }
    const size_t kstep = (size_t)(BK * 2);
    const size_t hstep = (size_t)HALF * K * 2;
    const unsigned ldsw = (unsigned)wid * 1024u;
    const int aoff = lds_byte(wr * 64 + fr, fq * 8), boff = lds_byte(wc * 32 + fr, fq * 8);
#define PG8_SA(b, h) (((b) * 2 + (h)) * HTB)
#define PG8_SB(b, h) ((4 + (b) * 2 + (h)) * HTB)
#define PG8_STAGE(bufoff, gbase, voff) do { _Pragma("unroll") for (int _i = 0; _i < 2; ++_i) \
        __builtin_amdgcn_global_load_lds((const unsigned*)((const char*)(gbase) + (voff)[_i]), (LAS unsigned*)(lds + (bufoff) + ldsw + _i * 8192), 16, 0, 0); } while (0)
#define PG8_LDA(dst, b, h) do { _Pragma("unroll") for (int m = 0; m < 4; ++m) _Pragma("unroll") for (int k = 0; k < 2; ++k) dst[m][k] = *(const LAS bf16x8*)(lds + PG8_SA(b, h) + aoff + m * 2048 + k * 1024); } while (0)
#define PG8_LDB(dst, b, h) do { _Pragma("unroll") for (int n = 0; n < 2; ++n) _Pragma("unroll") for (int k = 0; k < 2; ++k) dst[n][k] = *(const LAS bf16x8*)(lds + PG8_SB(b, h) + boff + n * 2048 + k * 1024); } while (0)
#define PG8_MMA(ai, bj, At, Bt) do { __builtin_amdgcn_s_setprio(1); _Pragma("unroll") for (int m = 0; m < 4; ++m) _Pragma("unroll") for (int n = 0; n < 2; ++n) _Pragma("unroll") for (int k = 0; k < 2; ++k) \
        acc[ai][bj][m][n] = __builtin_amdgcn_mfma_f32_16x16x32_bf16(Bt[n][k], At[m][k], acc[ai][bj][m][n], 0, 0, 0); __builtin_amdgcn_s_setprio(0); } while (0)
#define PG8_WAIT_V(n) asm volatile("s_waitcnt vmcnt(" #n ")" ::: "memory")
#define PG8_WAIT_L(n) asm volatile("s_waitcnt lgkmcnt(" #n ")" ::: "memory")
#define PG8_BAR __builtin_amdgcn_s_barrier()
#define PG8_SCHED __builtin_amdgcn_sched_barrier(0)
    unsigned vA[2][2], vN[2][2]; unsigned gR[2], gC[2];
    const char* gA = nullptr;
    if constexpr (GATHER) {
        gA = S.a_base();
#pragma unroll
        for (int i = 0; i < 2; ++i) { gR[i] = voffA[i] / (unsigned)(K * 2); gC[i] = voffA[i] % (unsigned)(K * 2); }
        const LAS int* rw = S.rows(0);
#pragma unroll
        for (int h = 0; h < 2; ++h)
#pragma unroll
            for (int i = 0; i < 2; ++i) { vA[h][i] = (unsigned)rw[h * HALF + gR[i]] * (unsigned)(K * 2) + gC[i]; vN[h][i] = vA[h][i]; }
    }
#define PG8_STAGEA(bufoff, P, V, kt, h) do { if constexpr (GATHER) PG8_STAGE(bufoff, gA + (size_t)(kt) * kstep, V[h]); else PG8_STAGE(bufoff, (P) + (size_t)(kt) * kstep + (size_t)(h) * hstep, voffA); } while (0)
    Unit cur, nxt; int ui = 0;
    if (!S.next(0, cur)) return;
    f32x4 acc[2][2][4][2];
#pragma unroll
    for (int a = 0; a < 2; ++a)
#pragma unroll
        for (int b = 0; b < 2; ++b)
#pragma unroll
            for (int m = 0; m < 4; ++m)
#pragma unroll
                for (int n = 0; n < 2; ++n) acc[a][b][m][n] = (f32x4){0.f, 0.f, 0.f, 0.f};
    bf16x8 At[4][2], B0[2][2], B1[2][2];
    const char* cA = nullptr; if constexpr (!GATHER) cA = S.a_ptr(cur);
    const char* cB = S.b_ptr(cur);
    PG8_STAGE(PG8_SB(0, 0), cB, voffA); PG8_STAGE(PG8_SB(0, 1), cB + hstep, voffA); PG8_STAGEA(PG8_SA(0, 0), cA, vA, 0, 0); PG8_STAGEA(PG8_SA(0, 1), cA, vA, 0, 1);
    if (wr == 1) PG8_BAR;
    PG8_WAIT_V(2); PG8_BAR;
    PG8_STAGE(PG8_SB(1, 0), cB + kstep, voffA); PG8_STAGEA(PG8_SA(1, 0), cA, vA, 1, 0); PG8_STAGE(PG8_SB(1, 1), cB + hstep + kstep, voffA);
    PG8_WAIT_V(6); PG8_BAR;
    for (;;) {
        const bool has_next = S.next(ui + 1, nxt);
        const char* nA = cA; if constexpr (!GATHER) { if (has_next) nA = S.a_ptr(nxt); }
        const char* nB = has_next ? S.b_ptr(nxt) : cB;
        if constexpr (GATHER) { if (has_next) { const LAS int* rw = S.rows(ui + 1);
#pragma unroll
            for (int h = 0; h < 2; ++h)
#pragma unroll
                for (int i = 0; i < 2; ++i) vN[h][i] = (unsigned)rw[h * HALF + gR[i]] * (unsigned)(K * 2) + gC[i]; } }
        for (int t = 0; t < nt; t += 2) {
            const bool last = (t == nt - 2);
            const char* b2 = last ? nB : cB + (size_t)(t + 2) * kstep; const char* b3 = b2 + kstep;
            const char* pX = last ? nA : cA; const int kX = last ? 0 : t + 2;
            unsigned vX[2][2];
#pragma unroll
            for (int h = 0; h < 2; ++h)
#pragma unroll
                for (int i = 0; i < 2; ++i) vX[h][i] = last ? vN[h][i] : vA[h][i];
            PG8_LDB(B0, 0, 0); PG8_LDB(B1, 0, 1); PG8_SCHED; PG8_LDA(At, 0, 0); PG8_STAGEA(PG8_SA(1, 1), cA, vA, t + 1, 1);
            PG8_WAIT_V(8); PG8_WAIT_L(0); PG8_BAR; PG8_MMA(0, 0, At, B0); PG8_MMA(0, 1, At, B1); PG8_BAR; PG8_SCHED;
            PG8_LDA(At, 0, 1); PG8_STAGE(PG8_SB(0, 0), b2, voffA); PG8_STAGE(PG8_SB(0, 1), b2 + hstep, voffA); PG8_STAGEA(PG8_SA(0, 0), pX, vX, kX, 0);
            PG8_WAIT_V(8); PG8_WAIT_L(0); PG8_BAR; PG8_MMA(1, 0, At, B0); PG8_MMA(1, 1, At, B1); PG8_BAR; PG8_SCHED;
            PG8_LDB(B0, 1, 0); PG8_LDB(B1, 1, 1); PG8_SCHED; PG8_LDA(At, 1, 0); PG8_STAGEA(PG8_SA(0, 1), pX, vX, kX, 1);
            PG8_WAIT_V(8); PG8_WAIT_L(0); PG8_BAR; PG8_MMA(0, 0, At, B0); PG8_MMA(0, 1, At, B1); PG8_BAR; PG8_SCHED;
            PG8_LDA(At, 1, 1); PG8_STAGE(PG8_SB(1, 0), b3, voffA); PG8_STAGE(PG8_SB(1, 1), b3 + hstep, voffA); PG8_STAGEA(PG8_SA(1, 0), pX, vX, kX + 1, 0);
            PG8_WAIT_V(8); PG8_WAIT_L(0); PG8_BAR; PG8_MMA(1, 0, At, B0); PG8_MMA(1, 1, At, B1); PG8_BAR; PG8_SCHED;
        }
        if (wr == 0) PG8_BAR;
        E(acc, cur, wr, wc, fr, fq);
        if (!has_next) break;
#pragma unroll
        for (int a = 0; a < 2; ++a)
#pragma unroll
            for (int b = 0; b < 2; ++b)
#pragma unroll
                for (int m = 0; m < 4; ++m)
#pragma unroll
                    for (int n = 0; n < 2; ++n) acc[a][b][m][n] = (f32x4){0.f, 0.f, 0.f, 0.f};
        cur = nxt; cA = nA; cB = nB; ++ui;
        if constexpr (GATHER) {
#pragma unroll
            for (int h = 0; h < 2; ++h)
#pragma unroll
                for (int i = 0; i < 2; ++i) vA[h][i] = vN[h][i]; }
        if (wr == 1) PG8_BAR;
    }
    PG8_WAIT_V(0);
    PG8_BAR;
#undef PG8_SA
#undef PG8_SB
#undef PG8_STAGE
#undef PG8_STAGEA
#undef PG8_LDA
#undef PG8_LDB
#undef PG8_MMA
#undef PG8_WAIT_V
#undef PG8_WAIT_L
#undef PG8_BAR
#undef PG8_SCHED
}
}

template <class Epi, class Sched>
__device__ __forceinline__ void gemm_phase_simple(const Sched& S, const Epi& E) {
    const int tid = threadIdx.x, wid = __builtin_amdgcn_readfirstlane(tid >> 6), lane = tid & 63, wr = wid >> 2, wc = wid & 3, fr = lane & 15, fq = lane >> 4;
    Unit u;
    for (int i = 0; S.next(i, u); ++i) { f32x4 acc[2][2][4][2];
        gemm_unit_simple((const bf16_t*)S.a_ptr(u), (const bf16_t*)S.b_ptr(u), acc, wr, wc, fr, fq);
        E(acc, u, wr, wc, fr, fq); }
}
#ifndef FAST_GEMM
#define FAST_GEMM 1
#endif
template <class Epi, class Sched>
__device__ __forceinline__ void run_gemm(LAS unsigned char* lds, const Sched& S, const Epi& E) {
#if FAST_GEMM
    pg8::gemm_phase<Epi, Sched, false>(lds, S, E);
#else
    gemm_phase_simple<Epi, Sched>(S, E);
#endif
}
template <class Epi, class Sched>
__device__ __forceinline__ void run_gemm_gather(LAS unsigned char* lds, const Sched& S, const Epi& E) { pg8::gemm_phase<Epi, Sched, true>(lds, S, E); }
__device__ __forceinline__ bool xcd_unit(int i, int G, int c, int nM, int nN, int& pm, int& pn) {
    const int x = c & 7, s = c >> 3, nS = G >> 3;
    const int r0 = (nM * x) >> 3, r1 = (nM * (x + 1)) >> 3;
    const int q = i * nS + s; if (q >= (r1 - r0) * nN) return false;
    const int rr = q / nN; pm = r0 + rr; pn = q - rr * nN; return true;
}
struct DenseSched {
    const bf16_t* A; const bf16_t* Bt; int nM, nN, G, c;
    __device__ __forceinline__ bool next(int i, Unit& u) const { u.e = 0; return xcd_unit(i, G, c, nM, nN, u.pm, u.pn); }
    __device__ __forceinline__ const char* a_ptr(const Unit& u) const { return (const char*)(A + (size_t)u.pm * 256 * D); }
    __device__ __forceinline__ const char* b_ptr(const Unit& u) const { return (const char*)(Bt + (size_t)u.pn * 256 * D); }
};
struct QkvSched {
    const bf16_t* A; const bf16_t* Bt; int live, G, c;
    __device__ __forceinline__ bool next(int i, Unit& u) const { u.e = 0;
        if (live) return xcd_unit(i, G, c, 144, 6, u.pm, u.pn);
        const int x = c & 7, s = c >> 3, nS = G >> 3; const int nlat = 16 * 6; const int q = i * nS + s;
        if (q < nlat) { const int rr = q / 6; u.pm = 16 * x + rr; u.pn = q - rr * 6; return true; }
        const int q2 = q - nlat; if (q2 >= 4) return false; const int t = x * 4 + q2; u.pm = 128 + (t >> 1); u.pn = 4 + (t & 1); return true; }
    __device__ __forceinline__ const char* a_ptr(const Unit& u) const { return (const char*)(A + (size_t)u.pm * 256 * D); }
    __device__ __forceinline__ const char* b_ptr(const Unit& u) const { return (const char*)(Bt + (size_t)u.pn * 256 * D); }
};
struct MoeSched {
    const bf16_t* A; const bf16_t* Bt  ; const LAS unsigned char* TE; int nM, nN, N, G, c;
    __device__ __forceinline__ bool next(int i, Unit& u) const { if (!xcd_unit(i, G, c, nM, nN, u.pm, u.pn)) return false; u.e = TE[u.pm]; return true; }
    __device__ __forceinline__ const char* a_ptr(const Unit& u) const { return (const char*)(A + (size_t)u.pm * 256 * D); }
    __device__ __forceinline__ const char* b_ptr(const Unit& u) const { return (const char*)(Bt + ((size_t)u.e * N + (size_t)u.pn * 256) * D); }
};
struct MoeGatherSched {
    const bf16_t* A; const bf16_t* Bt; const LAS unsigned char* TE; const LAS int* ROWS; int nM, nN, N, G, c;
    __device__ __forceinline__ bool next(int i, Unit& u) const { if (!xcd_unit(i, G, c, nM, nN, u.pm, u.pn)) return false; u.e = TE[u.pm]; return true; }
    __device__ __forceinline__ const char* a_base() const { return (const char*)A; }
    __device__ __forceinline__ const LAS int* rows(int ui) const { return ROWS + ui * 256; }
    __device__ __forceinline__ const char* a_ptr(const Unit& u) const { return (const char*)A; }
    __device__ __forceinline__ const char* b_ptr(const Unit& u) const { return (const char*)(Bt + ((size_t)u.e * N + (size_t)u.pn * 256) * D); }
};

struct EpiQKV {
    bf16_t *Q, *Kb, *Vb; const float *qg, *kg, *cosT, *sinT;
    __device__ __forceinline__ void operator()(const f32x4 (&acc)[2][2][4][2], const Unit& uu, int wr, int wc, int fr, int fq) const {
        const int pm = uu.pm, pn = uu.pn;
        const int kind = pn < 4 ? 0 : (pn == 4 ? 1 : 2);
        const float* gain = kind == 0 ? qg : kg;
        f32x4 gv[2][2];
#pragma unroll
        for (int bj = 0; bj < 2; ++bj)
#pragma unroll
            for (int n = 0; n < 2; ++n) gv[bj][n] = *(const f32x4*)(gain + 32 * bj + 16 * n + 4 * fq);
#pragma unroll
        for (int ai = 0; ai < 2; ++ai)
#pragma unroll
            for (int m = 0; m < 4; ++m) {
                const int r = pm * 256 + ai * 128 + wr * 64 + m * 16 + fr;
                const bool lat = r < NLAT;
                const int b = lat ? (r >> 11) : ((r - NLAT) >> 8);
                const int pos = lat ? (r & (SEQ - 1)) : (SEQ + ((r - NLAT) & (CL - 1)));
                f32x4 v[2][2];
#pragma unroll
                for (int bj = 0; bj < 2; ++bj)
#pragma unroll
                    for (int n = 0; n < 2; ++n) v[bj][n] = acc[ai][bj][m][n];
                if (kind != 2) {
                    float ss = 0.f;
#pragma unroll
                    for (int bj = 0; bj < 2; ++bj)
#pragma unroll
                        for (int n = 0; n < 2; ++n) ss += (v[bj][n][0] * v[bj][n][0] + v[bj][n][1] * v[bj][n][1]) + (v[bj][n][2] * v[bj][n][2] + v[bj][n][3] * v[bj][n][3]);
                    ss += __shfl_xor(ss, 16); ss += __shfl_xor(ss, 32);
                    const float rinv = 1.0f / sqrtf(ss * (1.0f / 64.0f) + EPS);
#pragma unroll
                    for (int bj = 0; bj < 2; ++bj)
#pragma unroll
                        for (int n = 0; n < 2; ++n) v[bj][n] = v[bj][n] * rinv * gv[bj][n];
                    if (lat) {
#pragma unroll
                        for (int bj = 0; bj < 2; ++bj) {
                            const f32x4 cs = *(const f32x4*)(cosT + pos * 32 + bj * 16 + 4 * fq), sn = *(const f32x4*)(sinT + pos * 32 + bj * 16 + 4 * fq);
                            const f32x4 x1 = v[bj][0], x2 = v[bj][1];
                            v[bj][0] = x1 * cs - x2 * sn; v[bj][1] = x2 * cs + x1 * sn;
                        }
                    }
                    if (kind == 0) {
#pragma unroll
                        for (int bj = 0; bj < 2; ++bj)
#pragma unroll
                            for (int n = 0; n < 2; ++n) v[bj][n] = v[bj][n] * C2;
                    }
                }
                bf16_t* dst = kind == 0 ? Q + (size_t)r * D + pn * 256 + wc * 64
                                        : (kind == 1 ? Kb : Vb) + ((size_t)b * KVL + pos) * 256 + wc * 64;
#pragma unroll
                for (int bj = 0; bj < 2; ++bj) { u32x4 w; w.x = pk2(v[bj][0][0], v[bj][0][1]); w.y = pk2(v[bj][0][2], v[bj][0][3]); w.z = pk2(v[bj][1][0], v[bj][1][1]); w.w = pk2(v[bj][1][2], v[bj][1][3]);
                    *(u32x4*)(dst + 32 * bj + 8 * fq) = w; }
            }
    }
};
struct EpiBiasBf16 {
    bf16_t* O; int ldc; const float* bias0; int estride;
    __device__ __forceinline__ void operator()(const f32x4 (&acc)[2][2][4][2], const Unit& uu, int wr, int wc, int fr, int fq) const {
        const int row0 = uu.pm * 256, col0t = uu.pn * 256;
#pragma unroll
        for (int bj = 0; bj < 2; ++bj) {
            const int c = col0t + bj * 128 + wc * 32 + 8 * fq;
            const float* bp = bias0 + (size_t)uu.e * estride + c; const f32x4 b0 = *(const f32x4*)bp, b1 = *(const f32x4*)(bp + 4);
#pragma unroll
            for (int ai = 0; ai < 2; ++ai)
#pragma unroll
                for (int m = 0; m < 4; ++m) { const int r = row0 + ai * 128 + wr * 64 + m * 16 + fr; const f32x4 v0 = acc[ai][bj][m][0] + b0, v1 = acc[ai][bj][m][1] + b1;
                    u32x4 w; w.x = pk2(v0[0], v0[1]); w.y = pk2(v0[2], v0[3]); w.z = pk2(v1[0], v1[1]); w.w = pk2(v1[2], v1[3]); *(u32x4*)(O + (size_t)r * ldc + c) = w; }
        }
    }
};
template <bool SRC32> struct EpiResid {
    const float *srcL, *srcC; bf16_t* XB; const float* gate  ; const float* bias;
    __device__ __forceinline__ void operator()(f32x4 (&acc)[2][2][4][2], const Unit& uu, int wr, int wc, int fr, int fq) const {
        const int row0 = uu.pm * 256, col0t = uu.pn * 256;
        const float* gp0 = gate + (size_t)mod_row(row0) * MODW;
        const float* sb = row0 < NLAT ? srcL + (size_t)row0 * D : srcC + (size_t)(row0 - NLAT) * D;
        bf16_t* xb = XB + (size_t)row0 * D;
#pragma unroll
        for (int bj = 0; bj < 2; ++bj) {
            const int c = col0t + bj * 128 + wc * 32 + 8 * fq;
            const f32x4 g0 = *(const f32x4*)(gp0 + c), g1 = *(const f32x4*)(gp0 + c + 4);
            f32x4 b0 = (f32x4){0.f, 0.f, 0.f, 0.f}, b1 = b0; if (bias) { b0 = *(const f32x4*)(bias + c); b1 = *(const f32x4*)(bias + c + 4); }
#pragma unroll
            for (int ai = 0; ai < 2; ++ai) {
                f32x4 x0[4], x1[4];
#pragma unroll
                for (int m = 0; m < 4; ++m) { const size_t ro = (size_t)(ai * 128 + wr * 64 + m * 16 + fr) * D + c;
                    if constexpr (SRC32) { x0[m] = *(const f32x4*)(sb + ro); x1[m] = *(const f32x4*)(sb + ro + 4); }
                    else { const u32x4 w = *(const u32x4*)(xb + ro); x0[m] = (f32x4){bflo(w.x), bfhi(w.x), bflo(w.y), bfhi(w.y)}; x1[m] = (f32x4){bflo(w.z), bfhi(w.z), bflo(w.w), bfhi(w.w)}; } }
#pragma unroll
                for (int m = 0; m < 4; ++m) { const size_t ro = (size_t)(ai * 128 + wr * 64 + m * 16 + fr) * D + c;
                    const f32x4 y0 = x0[m] + g0 * (acc[ai][bj][m][0] + b0), y1 = x1[m] + g1 * (acc[ai][bj][m][1] + b1);
                    u32x4 w; w.x = pk2(y0[0], y0[1]); w.y = pk2(y0[2], y0[3]); w.z = pk2(y1[0], y1[1]); w.w = pk2(y1[2], y1[3]); *(u32x4*)(xb + ro) = w; }
                asm volatile("" ::: "memory");
            }
        }
    }
};
struct EpiSwiglu {
    bf16_t* O; const float* bgu0  ;
    __device__ __forceinline__ void operator()(const f32x4 (&acc)[2][2][4][2], const Unit& uu, int wr, int wc, int fr, int fq) const {
        const int row0 = uu.pm * 256, pn = uu.pn; const float* bgu = bgu0 + (size_t)uu.e * NGU;
        const int f = pn * 128 + wc * 32 + 8 * fq;
        f32x4 bg[2], bu[2];
#pragma unroll
        for (int n = 0; n < 2; ++n) { const f32x4 q0 = *(const f32x4*)(bgu + 2 * (f + 4 * n)), q1 = *(const f32x4*)(bgu + 2 * (f + 4 * n) + 4);
            bg[n] = (f32x4){q0[0], q0[2], q1[0], q1[2]}; bu[n] = (f32x4){q0[1], q0[3], q1[1], q1[3]}; }
#pragma unroll
        for (int ai = 0; ai < 2; ++ai)
#pragma unroll
            for (int m = 0; m < 4; ++m) { const int r = row0 + ai * 128 + wr * 64 + m * 16 + fr; float o[8];
#pragma unroll
                for (int n = 0; n < 2; ++n) { const f32x4 gg = acc[ai][0][m][n] + bg[n], uq = acc[ai][1][m][n] + bu[n];
#pragma unroll
                    for (int p = 0; p < 2; ++p) {
                        f32x2 g2 = {fminf(gg[2 * p], 7.0f), fminf(gg[2 * p + 1], 7.0f)};
                        f32x2 u2 = {__builtin_amdgcn_fmed3f(uq[2 * p], -7.0f, 7.0f), __builtin_amdgcn_fmed3f(uq[2 * p + 1], -7.0f, 7.0f)};
                        const f32x2 z = g2 * (-2.4554669595930157f);
                        f32x2 e2 = {__builtin_amdgcn_exp2f(z.x), __builtin_amdgcn_exp2f(z.y)};
                        e2 = e2 + 1.0f;
                        const f32x2 r2 = {__builtin_amdgcn_rcpf(e2.x), __builtin_amdgcn_rcpf(e2.y)};
                        const f32x2 o2 = ((u2 + 1.0f) * g2) * r2;
                        o[4 * n + 2 * p] = o2.x; o[4 * n + 2 * p + 1] = o2.y; } }
                u32x4 w; w.x = pk2(o[0], o[1]); w.y = pk2(o[2], o[3]); w.z = pk2(o[4], o[5]); w.w = pk2(o[6], o[7]); *(u32x4*)(O + (size_t)r * D + f) = w; }
    }
};

__device__ __forceinline__ int slot32(int cg) { return (((cg >> 2) & 1) << 4) + ((cg >> 3) << 2) + (cg & 3); }
template <int MODE> __device__ __forceinline__ int wrow_map(int n) {
    if (MODE == 0) return (n & ~31) + slot32(n & 31);
    if (MODE == 1) { const int pn = n >> 8, wc = (n >> 6) & 3, bj = (n >> 5) & 1, j = n & 31;
        return (pn << 8) + (bj << 7) + (wc << 5) + (pn < 5 ? j : slot32(j)); }
    { const int f = n >> 1, pn = f >> 7, fo = f & 127; return (pn << 8) + ((n & 1) << 7) + (fo & ~31) + slot32(fo & 31); }
}
template <int MODE> __device__ __forceinline__ void transpose_item(const float* W, int N, bf16_t* WT, LAS float* scr, int item, int lane) {
    constexpr int K = D;
    const int nblk = N / 32, kb = item / nblk, nb = item % nblk, k0 = 64 * kb, n0 = 32 * nb;
#pragma unroll 8
    for (int i = 0; i < 32; ++i) { const int kk = 2 * i + (lane >> 5); scr[kk * 33 + (lane & 31)] = __builtin_nontemporal_load(W + (size_t)(k0 + kk) * N + n0 + (lane & 31)); }
    LDS_WAIT(); asm volatile("" ::: "memory");
    const int c = lane & 7;
#pragma unroll
    for (int j = 0; j < 4; ++j) { const int n = (lane >> 3) + 8 * j; const LAS float* s = scr + (8 * c) * 33 + n;
        u32x4 o; o.x = pk2(s[0 * 33], s[1 * 33]); o.y = pk2(s[2 * 33], s[3 * 33]); o.z = pk2(s[4 * 33], s[5 * 33]); o.w = pk2(s[6 * 33], s[7 * 33]);
        __builtin_nontemporal_store(o, (u32x4*)(WT + (size_t)wrow_map<MODE>(n0 + n) * K + k0 + 8 * c)); }
    LDS_WAIT(); asm volatile("" ::: "memory");
}

__device__ __forceinline__ void norm_mod_store(const f32x4 (&v)[4], const f32x4 (&gs)[4], const f32x4 (&sh)[4], bf16_t* dst, int lane, f32x4 (&h)[4]) {
    float ss = 0.f;
#pragma unroll
    for (int j = 0; j < 4; ++j) ss += (v[j][0] * v[j][0] + v[j][1] * v[j][1]) + (v[j][2] * v[j][2] + v[j][3] * v[j][3]);
    ss = wave_sum(ss);
    const float rinv = __builtin_amdgcn_rsqf(ss * (1.0f / D) + EPS);
#pragma unroll
    for (int j = 0; j < 4; ++j) {
        h[j] = (v[j] * rinv) * gs[j] + sh[j];
        u32x2 w; w.x = pk2(h[j][0], h[j][1]); w.y = pk2(h[j][2], h[j][3]);
        ((u32x2*)dst)[lane + 64 * j] = w;
    }
}
__device__ __forceinline__ void load_vec_bf(const bf16_t* p, int lane, f32x4 (&v)[4]) {
#pragma unroll
    for (int j = 0; j < 4; ++j) { const u32x2 w = ((const u32x2*)p)[lane + 64 * j]; v[j] = (f32x4){bflo(w.x), bfhi(w.x), bflo(w.y), bfhi(w.y)}; }
}
__device__ __forceinline__ void load_vec(const float* p, int lane, f32x4 (&v)[4]) {
#pragma unroll
    for (int j = 0; j < 4; ++j) v[j] = ((const f32x4*)p)[lane + 64 * j];
}


namespace attn_body {
using bf16=__hip_bfloat16;
using bf16x8=__attribute__((ext_vector_type(8)))short;
using s16x4=__attribute__((ext_vector_type(4)))short;
using f32x16=__attribute__((ext_vector_type(16)))float;
using u32x4=__attribute__((ext_vector_type(4)))unsigned;
constexpr int D=64,DM=1024,KVP=256;
constexpr int NW=8,QBLK=32,QB=QBLK*NW,KVBLK=64;
__device__ __forceinline__ int crow(int r,int hi){return (r&3)+8*(r>>2)+4*hi;}
#define SBAR() __builtin_amdgcn_sched_barrier(0)
__device__ __forceinline__ void cmask(f32x16&p0,f32x16&p1,int jb,int qrel,int hi){
  const float NEG=-INFINITY; int kb=64*jb+4*hi;
  #pragma unroll
  for(int r=0;r<16;++r){int kv=kb+(r&3)+8*(r>>2); if(kv>qrel)p0[r]=NEG; if(kv+32>qrel)p1[r]=NEG;}
}

constexpr int NSLOT=3, SLOTB=8192;
constexpr int LDS_K=0, LDS_V=NSLOT*SLOTB, LDS_WS=2*NSLOT*SLOTB, LDS_OST=LDS_WS+NW*64*4, LDS_BYTES=LDS_OST+NW*4096;
constexpr float C2=0.125f*1.4426950408889634f;
__device__ __forceinline__ void glds16(const void*gsrc,unsigned lds_dst){unsigned keep;
  asm volatile("s_mov_b32 %0, m0\n\ts_mov_b32 m0, %2\n\ts_nop 0\n\tglobal_load_lds_dwordx4 %1, off\n\ts_mov_b32 m0, %0":"=&s"(keep):"v"(gsrc),"s"(lds_dst):"memory");}
__device__ __forceinline__ float max3f(float a,float b,float c){float r;asm("v_max3_f32 %0, %1, %2, %3":"=v"(r):"v"(a),"v"(b),"v"(c));return r;}
__device__ __forceinline__ float max2f(float a,float b){float r;asm("v_max_f32_e32 %0, %1, %2":"=v"(r):"v"(a),"v"(b));return r;}
__device__ __forceinline__ float fadd_s(float a,float b){float r;asm("v_add_f32_e32 %0, %1, %2":"=v"(r):"v"(a),"v"(b));return r;}
__device__ __forceinline__ float fsub_s(float a,float b){float r;asm("v_sub_f32_e32 %0, %1, %2":"=v"(r):"v"(a),"v"(b));return r;}
typedef float f32x2_t __attribute__((ext_vector_type(2))); typedef __bf16 bf16x2_t __attribute__((ext_vector_type(2)));
__device__ __forceinline__ unsigned cvtpk_s(float lo,float hi){f32x2_t v={lo,hi};bf16x2_t b=__builtin_convertvector(v,bf16x2_t);return __builtin_bit_cast(unsigned,b);}
#define WAIT_BAR(N) asm volatile("s_waitcnt vmcnt(" #N ") lgkmcnt(0)\n\ts_barrier":::"memory")

__device__ __forceinline__ void qkt(f32x16&p0,f32x16&p1,const char*Kslot,const bf16x8*qr,const f32x16&negm,int r32,int hi){
  const char*kb=Kslot+hi*1024+r32*16;
  #pragma unroll
  for(int d0=0;d0<4;++d0){
    const bf16x8 b0=*reinterpret_cast<const bf16x8*>(kb+d0*2048);
    const bf16x8 b1=*reinterpret_cast<const bf16x8*>(kb+d0*2048+512);
    if(d0==0){p0=__builtin_amdgcn_mfma_f32_32x32x16_bf16(b0,qr[0],negm,0,0,0);p1=__builtin_amdgcn_mfma_f32_32x32x16_bf16(b1,qr[0],negm,0,0,0);}
    else{p0=__builtin_amdgcn_mfma_f32_32x32x16_bf16(b0,qr[d0],p0,0,0,0);p1=__builtin_amdgcn_mfma_f32_32x32x16_bf16(b1,qr[d0],p1,0,0,0);}}
}
typedef __attribute__((address_space(3))) const char* lds_cptr;
typedef short v4i16_t __attribute__((ext_vector_type(4)));
__device__ __forceinline__ void kload8(bf16x8*kf,lds_cptr kp){
  kf[0]=*(const __attribute__((address_space(3))) bf16x8*)(kp);      kf[1]=*(const __attribute__((address_space(3))) bf16x8*)(kp+512);
  kf[2]=*(const __attribute__((address_space(3))) bf16x8*)(kp+2048); kf[3]=*(const __attribute__((address_space(3))) bf16x8*)(kp+2560);
  kf[4]=*(const __attribute__((address_space(3))) bf16x8*)(kp+4096); kf[5]=*(const __attribute__((address_space(3))) bf16x8*)(kp+4608);
  kf[6]=*(const __attribute__((address_space(3))) bf16x8*)(kp+6144); kf[7]=*(const __attribute__((address_space(3))) bf16x8*)(kp+6656);
}
__device__ __forceinline__ void kload2(bf16x8*kf,lds_cptr kp,int j){ kf[2*j]=*(const __attribute__((address_space(3))) bf16x8*)(kp+j*2048); kf[2*j+1]=*(const __attribute__((address_space(3))) bf16x8*)(kp+j*2048+512); }
__device__ __forceinline__ s16x4 vtr(lds_cptr p){ return __builtin_bit_cast(s16x4,__builtin_amdgcn_ds_read_tr16_b64_v4i16((__attribute__((address_space(3))) v4i16_t*)p)); }
__device__ __forceinline__ float rowmax(const f32x16&p0,const f32x16&p1){
  float a=max3f(p0[0],p0[1],p1[0]),b=max3f(p0[2],p0[3],p1[1]);a=max3f(a,p1[2],p1[3]);
  #pragma unroll
  for(int r=4;r<16;r+=4){a=max3f(a,p0[r],p0[r+1]);b=max3f(b,p0[r+2],p0[r+3]);a=max3f(a,p1[r],p1[r+1]);b=max3f(b,p1[r+2],p1[r+3]);}
  const float m=max2f(a,b);
  auto rr=__builtin_amdgcn_permlane32_swap(__float_as_uint(m),__float_as_uint(m),false,false);
  return max2f(__uint_as_float(rr[0]),__uint_as_float(rr[1]));
}
__device__ __forceinline__ void pv(f32x16*o,int vb,bf16x8 pa0,bf16x8 pa1,bf16x8 pa2,bf16x8 pa3){
  #pragma unroll
  for(int d0=0;d0<2;++d0){s16x4 lo[4],hi[4];
    #pragma unroll
    for(int ks=0;ks<4;++ks){
      asm volatile("ds_read_b64_tr_b16 %0,%1 offset:%c2":"=&v"(lo[ks]):"v"(vb),"i"(d0*4096+ks*1024):"memory");
      asm volatile("ds_read_b64_tr_b16 %0,%1 offset:%c2":"=&v"(hi[ks]):"v"(vb),"i"(d0*4096+ks*1024+512):"memory");}
    asm volatile("s_waitcnt lgkmcnt(0)":::"memory");SBAR();
    #define PK(k) (bf16x8){lo[k][0],lo[k][1],lo[k][2],lo[k][3],hi[k][0],hi[k][1],hi[k][2],hi[k][3]}
    o[d0]=__builtin_amdgcn_mfma_f32_32x32x16_bf16(pa0,PK(0),o[d0],0,0,0);
    o[d0]=__builtin_amdgcn_mfma_f32_32x32x16_bf16(pa1,PK(1),o[d0],0,0,0);
    o[d0]=__builtin_amdgcn_mfma_f32_32x32x16_bf16(pa2,PK(2),o[d0],0,0,0);
    o[d0]=__builtin_amdgcn_mfma_f32_32x32x16_bf16(pa3,PK(3),o[d0],0,0,0);
    #undef PK
  }
}

#ifndef ATTN_STORE16
#define ATTN_STORE16(p,v) (*(u32x4*)(p)=(v))
#endif
template<int THRL> __device__ __forceinline__ void attn_unit(const bf16*Qu,const bf16*__restrict__ Kh,const bf16*__restrict__ Vh,bf16*Ou,const int NT,char*shm){
  const int tid=threadIdx.x,lane=tid&63,r32=lane&31,hi=lane>>5; const int wid=__builtin_amdgcn_readfirstlane(tid>>6);
  const bf16*Qw=Qu+(long)(wid*QBLK)*DM;
  const unsigned lds0=(unsigned)(uintptr_t)shm;
  float*wsf=(float*)(shm+LDS_WS)+wid*64;
  const bf16*ksrc=Kh+(long)lane*KVP+wid*8;
  const bf16*vsrc=Vh+(long)(16*(wid&3)+(lane>>2))*KVP+(wid>>2)*32+(lane&3)*8;
  const unsigned kdst=lds0+LDS_K+wid*1024, vdst=lds0+LDS_V+wid*1024;
  #define DMA_K(t,slot) glds16(ksrc+(long)(t)*KVBLK*KVP,(unsigned)__builtin_amdgcn_readfirstlane(kdst+(slot)))
  #define DMA_V(t,slot) glds16(vsrc+(long)(t)*KVBLK*KVP,(unsigned)__builtin_amdgcn_readfirstlane(vdst+(slot)))
  const int vb0=(int)(lds0+LDS_V)+((lane>>4)&1)*32+(lane&3)*8+(4*hi+((lane&15)>>2))*64;
  const char*Kbase=shm+LDS_K; bf16x8 kf[8];
  const lds_cptr shm3=(lds_cptr)shm; const lds_cptr kp0=shm3+LDS_K+hi*1024+r32*16; const lds_cptr vp0=shm3+LDS_V+((lane>>4)&1)*32+(lane&3)*8+(4*hi+((lane&15)>>2))*64;
  DMA_K(0,0);DMA_V(0,0);DMA_K(1,SLOTB);
  bf16x8 qr[4];
  #pragma unroll
  for(int d0=0;d0<4;++d0)qr[d0]=*reinterpret_cast<const bf16x8*>(&Qw[(long)r32*DM+d0*16+hi*8]);
  float mhat=0.f,l_reg=0.f;f32x16 o[2];o[0]=f32x16{};o[1]=f32x16{};f32x16 negm=f32x16{};asm volatile("":"+v"(negm));
  #define CMASK(P0,P1,t) do{}while(0)
  bool resc=false;
  #define START(P0,P1) do{ const float rm=rowmax(P0,P1); resc=false; \
    { const float dl=rm; mhat=fadd_s(mhat,dl); \
      _Pragma("unroll") for(int r=0;r<16;++r){P0[r]=fsub_s(P0[r],dl);P1[r]=fsub_s(P1[r],dl);} \
      _Pragma("unroll") for(int r=0;r<16;++r)negm[r]=-mhat; asm volatile("":"+v"(negm)); } \
    _Pragma("unroll") for(int r=0;r<16;++r)P0[r]=__builtin_amdgcn_exp2f(P0[r]); }while(0)
  #define RESC() do{ if(resc){ asm volatile("s_waitcnt lgkmcnt(0)":::"memory"); \
      _Pragma("unroll") for(int d_=0;d_<2;++d_) _Pragma("unroll") for(int r=0;r<16;++r)o[d_][r]*=wsf[crow(r,hi)]; } }while(0)
  f32x16 pA0,pA1,pB0,pB1;
  int sl_prev=0,sl_cur=0,sl_next=SLOTB;
  #define ROT() do{sl_prev=sl_cur;sl_cur=sl_next;sl_next=(sl_next==(NSLOT-1)*SLOTB)?0:sl_next+SLOTB;}while(0)
  DMA_K(2,2*SLOTB);
  WAIT_BAR(3);
  qkt(pA0,pA1,Kbase,qr,negm,r32,hi);asm volatile("s_nop 15\n\ts_nop 7":"+v"(pA0),"+v"(pA1));CMASK(pA0,pA1,0);
  START(pA0,pA1);
  _Pragma("unroll") for(int r=0;r<16;++r)pA1[r]=__builtin_amdgcn_exp2f(pA1[r]);
  WAIT_BAR(0);
  DMA_K(3,0);DMA_V(1,SLOTB);
  ROT();
  kload8(kf,kp0+sl_cur);
  WAIT_BAR(2);
  s16x4 vlo[8],vhi[8]; u32x4 pw0,pw1,pw2,pw3;
  #define PKW(P,B) cvtpk_s(P[B],P[B+1])
  #define PAF(k) __builtin_bit_cast(bf16x8,pw##k)
  #define VFR(i) (bf16x8){vlo[i][0],vlo[i][1],vlo[i][2],vlo[i][3],vhi[i][0],vhi[i][1],vhi[i][2],vhi[i][3]}
  #define PIN(x) asm volatile("":"+v"(x))
  #define MX3(a,b,c) __builtin_fmaxf(__builtin_fmaxf((a),(b)),(c))
  #define GAPA(MF,A0,A1,A2,A3,W0,W1,PW) do{ MF; sacc+=A0; sacc+=A1; sacc+=A2; sacc+=A3; PIN(sacc); W0; W1; PIN(PW); SBAR(); }while(0)
  #define EX(v) __builtin_amdgcn_exp2f(v)
  #define GAPB(MF,X,B) do{ MF; X[B]=EX(X[B]); X[B+1]=EX(X[B+1]); X[B+2]=EX(X[B+2]); X[B+3]=EX(X[B+3]); PIN(X); SBAR(); }while(0)
  #define VRD(i) do{ vlo[i]=vtr(vp_+(((i)>>2)*4096+((i)&3)*1024)); vhi[i]=vtr(vp_+(((i)>>2)*4096+((i)&3)*1024+512)); }while(0)
  #define KRD(G,j) do{ if(G){ kload2(kf,kp0+sl_next,j); SBAR(); } }while(0)
  #define STEP(C0,C1,P0,P1,t,GK,GV,GL) do{ SBAR(); \
    const lds_cptr vp_=vp0+sl_prev; \
    VRD(0); SBAR(); float sacc=(P0[0]+P0[1]); \
    GAPA(C0=__builtin_amdgcn_mfma_f32_32x32x16_bf16(kf[0],qr[0],negm,0,0,0), P0[2],P0[3],P0[4],P0[5],     pw0[0]=PKW(P0,0), pw0[1]=PKW(P0,2), pw0); \
    VRD(4); SBAR(); GAPA(C1=__builtin_amdgcn_mfma_f32_32x32x16_bf16(kf[1],qr[0],negm,0,0,0), P0[6],P0[7],P0[8],P0[9],     pw0[2]=PKW(P0,4), pw0[3]=PKW(P0,6), pw0); \
    VRD(1); SBAR(); GAPA(C0=__builtin_amdgcn_mfma_f32_32x32x16_bf16(kf[2],qr[1],C0,0,0,0),   P0[10],P0[11],P0[12],P0[13], pw1[0]=PKW(P0,8), pw1[1]=PKW(P0,10), pw1); \
    VRD(5); SBAR(); GAPA(C1=__builtin_amdgcn_mfma_f32_32x32x16_bf16(kf[3],qr[1],C1,0,0,0),   P0[14],P0[15],P1[0],P1[1],   pw1[2]=PKW(P0,12),pw1[3]=PKW(P0,14), pw1); \
    VRD(2); SBAR(); GAPA(C0=__builtin_amdgcn_mfma_f32_32x32x16_bf16(kf[4],qr[2],C0,0,0,0),   P1[2],P1[3],P1[4],P1[5],     pw2[0]=PKW(P1,0), pw2[1]=PKW(P1,2), pw2); \
    VRD(6); SBAR(); GAPA(C1=__builtin_amdgcn_mfma_f32_32x32x16_bf16(kf[5],qr[2],C1,0,0,0),   P1[6],P1[7],P1[8],P1[9],     pw2[2]=PKW(P1,4), pw2[3]=PKW(P1,6), pw2); \
    VRD(3); SBAR(); GAPA(C0=__builtin_amdgcn_mfma_f32_32x32x16_bf16(kf[6],qr[3],C0,0,0,0),   P1[10],P1[11],P1[12],P1[13], pw3[0]=PKW(P1,8), pw3[1]=PKW(P1,10), pw3); \
    VRD(7); SBAR(); GAPA(C1=__builtin_amdgcn_mfma_f32_32x32x16_bf16(kf[7],qr[3],C1,0,0,0),   P1[14],P1[15],0.f,0.f,       pw3[2]=PKW(P1,12),pw3[3]=PKW(P1,14), pw3); \
    l_reg+=sacc; \
    if(GK){DMA_K((t)+3,sl_cur);} if(GV){DMA_V((t)+1,sl_next);} \
    CMASK(C0,C1,t); \
    { float a=MX3(C0[0],C0[1],C1[0]),b=MX3(C0[2],C0[3],C1[1]); a=MX3(a,C1[2],C1[3]); \
      _Pragma("unroll") for(int r=4;r<16;r+=4){a=MX3(a,C0[r],C0[r+1]);b=MX3(b,C0[r+2],C0[r+3]);a=MX3(a,C1[r],C1[r+1]);b=MX3(b,C1[r+2],C1[r+3]);} \
      float rm=__builtin_fmaxf(a,b); { auto rr=__builtin_amdgcn_permlane32_swap(__float_as_uint(rm),__float_as_uint(rm),false,false); rm=__builtin_fmaxf(__uint_as_float(rr[0]),__uint_as_float(rr[1])); } \
      resc=false; \
      if(__builtin_expect(__any(rm>(float)THRL),0)){ const float dl=__builtin_fmaxf(rm,0.f); mhat+=dl; \
        _Pragma("unroll") for(int r=0;r<16;++r){C0[r]-=dl;C1[r]-=dl;} \
        _Pragma("unroll") for(int r=0;r<16;++r)negm[r]=-mhat; asm volatile("":"+v"(negm)); \
        const float f=__builtin_amdgcn_exp2f(-dl); l_reg*=f; if(hi==0)wsf[r32]=f; resc=true; } } \
    SBAR(); \
    GAPB(o[0]=__builtin_amdgcn_mfma_f32_32x32x16_bf16(PAF(0),VFR(0),o[0],0,0,0), C0,0); \
    GAPB(o[1]=__builtin_amdgcn_mfma_f32_32x32x16_bf16(PAF(0),VFR(4),o[1],0,0,0), C0,4); \
    KRD(GL,0); GAPB(o[0]=__builtin_amdgcn_mfma_f32_32x32x16_bf16(PAF(1),VFR(1),o[0],0,0,0), C0,8); \
    KRD(GL,1); GAPB(o[1]=__builtin_amdgcn_mfma_f32_32x32x16_bf16(PAF(1),VFR(5),o[1],0,0,0), C0,12); \
    KRD(GL,2); GAPB(o[0]=__builtin_amdgcn_mfma_f32_32x32x16_bf16(PAF(2),VFR(2),o[0],0,0,0), C1,0); \
    KRD(GL,3); GAPB(o[1]=__builtin_amdgcn_mfma_f32_32x32x16_bf16(PAF(2),VFR(6),o[1],0,0,0), C1,4); \
    GAPB(o[0]=__builtin_amdgcn_mfma_f32_32x32x16_bf16(PAF(3),VFR(3),o[0],0,0,0), C1,8); \
    GAPB(o[1]=__builtin_amdgcn_mfma_f32_32x32x16_bf16(PAF(3),VFR(7),o[1],0,0,0), C1,12); \
    }while(0)
  int t=1;
  #undef CMASK
  #define CMASK(P0,P1,t) do{}while(0)
  for(;t+5<NT;t+=2){
    STEP(pB0,pB1,pA0,pA1,t,true,true,true);     WAIT_BAR(2); RESC(); ROT();
    STEP(pA0,pA1,pB0,pB1,t+1,true,true,true);   WAIT_BAR(2); RESC(); ROT();
  }
  #undef CMASK
  #define CMASK(P0,P1,t) do{}while(0)
  #define ENDW(tt) do{ if((tt)+3<NT){WAIT_BAR(2);} else if((tt)+2<NT){WAIT_BAR(1);} else {WAIT_BAR(0);} }while(0)
  for(;t+1<NT;t+=2){
    STEP(pB0,pB1,pA0,pA1,t,(t+3<NT),(t+1<NT),(t+1<NT));       ENDW(t);   RESC(); ROT();
    STEP(pA0,pA1,pB0,pB1,t+1,(t+4<NT),(t+2<NT),(t+2<NT));     ENDW(t+1); RESC(); ROT();
  }
  STEP(pB0,pB1,pA0,pA1,NT-1,false,false,false); RESC();
  { float sacc=pB0[0]+pB0[1]; _Pragma("unroll") for(int r=2;r<16;++r)sacc+=pB0[r]; _Pragma("unroll") for(int r=0;r<16;++r)sacc+=pB1[r]; l_reg+=sacc;
    pw0=(u32x4){PKW(pB0,0),PKW(pB0,2),PKW(pB0,4),PKW(pB0,6)};pw1=(u32x4){PKW(pB0,8),PKW(pB0,10),PKW(pB0,12),PKW(pB0,14)};pw2=(u32x4){PKW(pB1,0),PKW(pB1,2),PKW(pB1,4),PKW(pB1,6)};pw3=(u32x4){PKW(pB1,8),PKW(pB1,10),PKW(pB1,12),PKW(pB1,14)};
    SBAR(); pv(o,vb0+sl_cur,PAF(0),PAF(1),PAF(2),PAF(3)); }
  #undef PKW
  #undef PAF
  #undef VFR
  #undef PIN
  #undef MX3
  #undef GAPA
  #undef GAPB
  #undef EX
  #undef VRD
  #undef KRD
  #undef STEP
  #undef ENDW
  {auto rr=__builtin_amdgcn_permlane32_swap(__float_as_uint(l_reg),__float_as_uint(l_reg),false,false);l_reg=__uint_as_float(rr[0])+__uint_as_float(rr[1]);}
  if(hi==0)wsf[32+r32]=l_reg;asm volatile("s_waitcnt lgkmcnt(0)":::"memory");
  float rli[16];
  #pragma unroll
  for(int r=0;r<16;++r)rli[r]=__builtin_amdgcn_rcpf(wsf[32+crow(r,hi)]);
  bf16*Ow=Ou+(long)(wid*QBLK)*DM;
  { bf16*stg=(bf16*)(shm+LDS_OST)+wid*2048;
    #pragma unroll
    for(int r=0;r<16;++r){const int orow=crow(r,hi);
      #pragma unroll
      for(int d0=0;d0<2;++d0)stg[orow*64+d0*32+r32]=__float2bfloat16(o[d0][r]*rli[r]);}
    asm volatile("s_waitcnt lgkmcnt(0)":::"memory");
    #pragma unroll
    for(int i=0;i<4;++i){const int row=i*8+(lane>>3),ch=lane&7; const u32x4 v=*(const u32x4*)(stg+row*64+ch*8); ATTN_STORE16(Ow+(long)row*DM+ch*8,v);} }
  asm volatile("s_waitcnt lgkmcnt(0)\n\ts_barrier":::"memory");
  #undef DMA_K
  #undef DMA_V
  #undef CMASK
  #undef START
  #undef RESC
  #undef ROT
}
constexpr int ATTN_LDS_BYTES=LDS_BYTES;
#undef SBAR
#undef WAIT_BAR
}

template <int LF>
__device__ __forceinline__ void conv_channel(LAS unsigned char* lds, const bf16_t* FIc, const bf16_t* wsrc, bf16_t* ydst, int tid, int lane, int wv) {
    constexpr int IPW = LF / 256, NBK = LF / 32, P = 2 * LF + 8, WSTR = LF + 8;
    LAS unsigned char* FIL = lds; LAS unsigned char* WL = lds + ((8 * P * 2 + 255) & ~255);
    __syncthreads();
    { const u32x4* fs = (const u32x4*)FIc; for (int i = tid; i < 8 * P * 2 / 16; i += NTHR) ((LAS u32x4*)FIL)[i] = fs[i]; }
    for (int i = tid; i < NB * (LF / 8); i += NTHR) { const int b = i / (LF / 8), ch = i % (LF / 8); *(LAS u32x4*)(WL + b * (WSTR * 2) + ch * 16) = *(const u32x4*)(wsrc + (size_t)b * LF + ch * 8); }
    __syncthreads();
    f32x4 acc[IPW][2]; bf16x8 Bw[IPW];
#pragma unroll
    for (int ii = 0; ii < IPW; ++ii) { acc[ii][0] = (f32x4){0.f, 0.f, 0.f, 0.f}; acc[ii][1] = (f32x4){0.f, 0.f, 0.f, 0.f}; Bw[ii] = (bf16x8){0, 0, 0, 0, 0, 0, 0, 0}; }
    const int rr = lane & 15, q = lane >> 4;
    const int aBase = (rr & 7) * (P * 2) + 2 * (LF - (rr - (rr & 7)) + 8 * q);
    const int bBase = rr * (WSTR * 2) + 16 * q;
#define CONV_STEPS(CHECK) do { _Pragma("unroll") for (int dd = 0; dd < IPW; ++dd) { \
        const int delta = IPW * d + dd; \
        const bf16x8 a0 = *(const LAS bf16x8*)(FIL + aBase - 64 * delta), a1 = *(const LAS bf16x8*)(FIL + aBase - 64 * delta - 32); \
        const int jn = IPW * (wv - d) - dd; \
        if (!(CHECK) || (jn >= 0 && jn < NBK)) Bw[(IPW - dd) % IPW] = *(const LAS bf16x8*)(WL + bBase + 64 * jn); \
        _Pragma("unroll") for (int ii = 0; ii < IPW; ++ii) { const int j = IPW * (wv - d) + ii - dd; \
            if (!(CHECK) || (j >= 0 && j < NBK)) { \
                acc[ii][0] = __builtin_amdgcn_mfma_f32_16x16x32_bf16(a0, Bw[(ii - dd + IPW) % IPW], acc[ii][0], 0, 0, 0); \
                acc[ii][1] = __builtin_amdgcn_mfma_f32_16x16x32_bf16(a1, Bw[(ii - dd + IPW) % IPW], acc[ii][1], 0, 0, 0); } } } } while (0)
    { const int d = wv - 8; CONV_STEPS(true); }
    for (int d = wv - 7; d < wv; ++d) { CONV_STEPS(false); }
    { const int d = wv; CONV_STEPS(true); }
#undef CONV_STEPS
#pragma unroll
    for (int ii = 0; ii < IPW; ++ii)
#pragma unroll
        for (int h = 0; h < 2; ++h) { u32x2 w; w.x = pk2(acc[ii][h][0], acc[ii][h][1]); w.y = pk2(acc[ii][h][2], acc[ii][h][3]);
            *(u32x2*)(ydst + (size_t)rr * LF + 32 * (IPW * wv + ii) + 16 * h + 4 * q) = w; }
}


__device__ __forceinline__ void route_reduce(float (&p)[32], int lane) {
#pragma unroll
    for (int i = 0; i < 16; ++i) { const bool up = (lane & 32) != 0; const float send = up ? p[i] : p[i + 16], keep = up ? p[i + 16] : p[i]; p[i] = keep + __shfl_xor(send, 32); }
#pragma unroll
    for (int i = 0; i < 8; ++i) { const bool up = (lane & 16) != 0; const float send = up ? p[i] : p[i + 8], keep = up ? p[i + 8] : p[i]; p[i] = keep + __shfl_xor(send, 16); }
#pragma unroll
    for (int i = 0; i < 4; ++i) { const bool up = (lane & 8) != 0; const float send = up ? p[i] : p[i + 4], keep = up ? p[i + 4] : p[i]; p[i] = keep + __shfl_xor(send, 8); }
#pragma unroll
    for (int i = 0; i < 2; ++i) { const bool up = (lane & 4) != 0; const float send = up ? p[i] : p[i + 2], keep = up ? p[i + 2] : p[i]; p[i] = keep + __shfl_xor(send, 4); }
    { const bool up = (lane & 2) != 0; const float send = up ? p[0] : p[1], keep = up ? p[1] : p[0]; p[0] = keep + __shfl_xor(send, 2); }
    p[0] += __shfl_xor(p[0], 1);
}
__device__ __forceinline__ void route_top4(float val, int myE, float (&sv)[4], int (&si)[4]) {
    int rank = 0;
#pragma unroll
    for (int e = 0; e < 32; ++e) { const float o = __builtin_bit_cast(float, __builtin_amdgcn_readlane(__builtin_bit_cast(int, val), 2 * e)); rank += (o > val || (o == val && e < myE)) ? 1 : 0; }
#pragma unroll
    for (int k = 0; k < 4; ++k) { const unsigned long long m = __ballot(rank == k); const int src = __builtin_ctzll(m);
        si[k] = src >> 1; sv[k] = __builtin_bit_cast(float, __builtin_amdgcn_readlane(__builtin_bit_cast(int, val), src)); }
}
#define IN(k) (lo <= (k) && (k) < hi)
#define SEAM(k) do { if (IN(k) && IN((k) + 1)) xcd_barrier(bar); } while (0)
#define SEAMK(k, kind) SEAM(k)
#define KLOCALS \
    const float* x_in = args.in[I_X]; const float* c_in = args.in[I_C]; const float* ctx_in = args.in[I_CTX]; const float* cctx_in = args.in[I_CCTX]; \
    float* out = args.out; \
    float* modp = (float*)(ws + WS_MODP); float* modf = (float*)(ws + WS_MOD); \
    float* cosT = (float*)(ws + WS_ROPE); float* sinT = cosT + SEQ * 32; \
    float* a2tab = (float*)(ws + WS_A2); \
    int* top_e = (int*)(ws + WS_PAIR); int* ppos = top_e + NTOK * 4; float* pgate = (float*)(ppos + NTOK * 4); int* pdest = (int*)(pgate + NTOK * 4); \
    bf16_t* XB = (bf16_t*)(ws + WS_XB); \
    bf16_t* Wqkv_t = (bf16_t*)(ws + WS_WQKV); bf16_t* Wo_t = (bf16_t*)(ws + WS_WO); bf16_t* Win_t = (bf16_t*)(ws + WS_WIN); bf16_t* Wout_t = (bf16_t*)(ws + WS_WOUT); \
    bf16_t* Wgu_t = (bf16_t*)(ws + WS_WGU); bf16_t* Wdn_t = (bf16_t*)(ws + WS_WDN); \
    bf16_t* hA = (bf16_t*)(ws + WS_HA); bf16_t* Qb = (bf16_t*)(ws + WS_Q); bf16_t* Kb = (bf16_t*)(ws + WS_K); bf16_t* Vb = (bf16_t*)(ws + WS_V); \
    bf16_t* Upre = (bf16_t*)(ws + WS_UPRE); bf16_t* Wc = (bf16_t*)(ws + WS_WC); bf16_t* Yc = (bf16_t*)(ws + WS_YC); \
    bf16_t* XS = (bf16_t*)(ws + WS_XS); bf16_t* AB = (bf16_t*)(ws + WS_AB); int* elist = (int*)(ws + WS_ELIST); \
    const int wr = wave >> 2, wc = wave & 3, fr = lane & 15, fq = lane >> 4;
template <int layer> __device__ __forceinline__ void layer_body(const Args& args, LAS unsigned char* lds, const XcdBarrier& bar, const int tid, const int lane, const int wave, const int G, const int bid, const int lo, const int hi) {
    const int gw = bid * NWAVES + wave, NGW = G * NWAVES;
    unsigned char* ws = args.ws;
    gu32* ctl = (gu32*)(ws + WS_CTL);
    KLOCALS
        const int pb = 3 + 10 * layer;
        const int jm = layer >> 1;
        const bool ctx_live = layer < 2;
        const int nrows = ctx_live ? NTOK : NLAT;
        const float* mo = modf + (size_t)layer * NMODROW * MODW;

        if ((layer & 1) == 0) {
            if (EN_GEMM && IN(pb + 0)) {
                EpiQKV E{Qb, Kb, Vb, args.in[I_QG] + jm * 64, args.in[I_KG] + jm * 64, cosT, sinT};
                const bf16_t* Wt = Wqkv_t + (size_t)jm * NQKV * D;
                const QkvSched S{hA, Wt, ctx_live ? 1 : 0, G, bid};
                run_gemm(lds, S, E);
            }
            SEAMK(pb + 0, 3);
            if (EN_ATT && IN(pb + 1)) {
                typedef attn_body::bf16 abf;
                const int x = bid & 7, sl = bid >> 3, nS = G >> 3;
                for (int q = sl; q < 256; q += nS) {
                    const int b = 2 * x + (q >> 7), kvh = (q >> 5) & 3, head = 4 * kvh + ((q >> 3) & 3), qb = q & 7;
                    abf* Qu = (abf*)(Qb + ((size_t)b * SEQ + qb * 256) * D + head * 64);
                    attn_body::attn_unit<8>(Qu, (const abf*)(Kb + (size_t)b * KVL * 256 + kvh * 64), (const abf*)(Vb + (size_t)b * KVL * 256 + kvh * 64), Qu, KVL / 64, (char*)lds);
                }
                if (ctx_live) for (int q = sl; q < 32; q += nS) {
                    const int b = 2 * x + (q >> 4), head = q & 15, kvh = head >> 2;
                    abf* Qu = (abf*)(Qb + ((size_t)NLAT + b * CL) * D + head * 64);
                    attn_body::attn_unit<8>(Qu, (const abf*)(Kb + ((size_t)b * KVL + SEQ) * 256 + kvh * 64), (const abf*)(Vb + ((size_t)b * KVL + SEQ) * 256 + kvh * 64), Qu, CL / 64, (char*)lds);
                }
            }
            SEAMK(pb + 1, 4);
            if (EN_GEMM && IN(pb + 2)) {
                EpiResid<layer == 0> E{x_in, ctx_in, XB, mo + 2 * D, nullptr};
                const bf16_t* Wt = Wo_t + (size_t)jm * D * D;
                const DenseSched S{Qb, Wt, nrows / 256, 4, G, bid};
                run_gemm(lds, S, E);
            }
            SEAMK(pb + 2, 5);
        } else {
            const float* cw = args.in[I_HCW] + (size_t)jm * 3 * NHY; const float* cb = args.in[I_HCB] + (size_t)jm * NHY;
            if (EN_GEMM && IN(pb + 0)) {
                EpiBiasBf16 E{Upre, NHY, args.in[I_HBIN] + (size_t)jm * NHY, 0};
                const bf16_t* Wt = Win_t + (size_t)jm * NHY * D;
                const DenseSched S{hA, Wt, nrows / 256, 12, G, bid};
                run_gemm(lds, S, E);
            }
            SEAMK(pb + 0, 6);
            if (EN_MISC && IN(pb + 1)) {
                LAS unsigned char* T = lds;
                const int nlat_u = NB * 16 * 4, nctx_u = ctx_live ? NB * 2 * 4 : 0;
                const int hw = tid >> 5, l32 = tid & 31;
                for (int u = bid; u < nlat_u + nctx_u; u += G) {
                    int b, s0, c0, Ls, rowb; bf16_t* dstb;
                    if (u < nlat_u) { b = u >> 6; s0 = ((u >> 2) & 15) * 128; c0 = (u & 3) * 256; Ls = SEQ; rowb = b * SEQ; dstb = Wc; }
                    else { const int q = u - nlat_u; b = q >> 3; s0 = ((q >> 2) & 1) * 128; c0 = (q & 3) * 256; Ls = CL; rowb = NLAT + b * CL; dstb = Wc + WC_CTX_OFF; }
                    const int cc = c0 + 8 * l32, sb = s0 + 8 * hw;
                    u32x4 ra[10], rv[10];
#pragma unroll
                    for (int i = 0; i < 10; ++i) { const int sp = sb + i - 1;
                        if (sp >= 0 && sp < Ls) { const bf16_t* ur = Upre + (size_t)(rowb + sp) * NHY + cc; ra[i] = *(const u32x4*)(ur + D); rv[i] = *(const u32x4*)(ur + 2 * D); }
                        else { ra[i] = (u32x4){0u, 0u, 0u, 0u}; rv[i] = (u32x4){0u, 0u, 0u, 0u}; } }
                    f32x4 w1[3][2], w2[3][2], b1[2], b2[2];
#pragma unroll
                    for (int tap = 0; tap < 3; ++tap)
#pragma unroll
                        for (int hh = 0; hh < 2; ++hh) { w1[tap][hh] = *(const f32x4*)(cw + tap * NHY + D + cc + 4 * hh); w2[tap][hh] = *(const f32x4*)(cw + tap * NHY + 2 * D + cc + 4 * hh); }
#pragma unroll
                    for (int hh = 0; hh < 2; ++hh) { b1[hh] = *(const f32x4*)(cb + D + cc + 4 * hh); b2[hh] = *(const f32x4*)(cb + 2 * D + cc + 4 * hh); }
                    unsigned op[8][4];
#pragma unroll
                    for (int sp = 0; sp < 4; ++sp) {
                        float pr[2][8];
#pragma unroll
                        for (int o = 0; o < 2; ++o) { const int si = 2 * sp + o;
                            f32x4 x1[2] = {b1[0], b1[1]}, vv[2] = {b2[0], b2[1]};
#pragma unroll
                            for (int tap = 0; tap < 3; ++tap) { const u32x4 a = ra[si + tap], q = rv[si + tap];
                                x1[0] += (f32x4){bflo(a.x), bfhi(a.x), bflo(a.y), bfhi(a.y)} * w1[tap][0]; x1[1] += (f32x4){bflo(a.z), bfhi(a.z), bflo(a.w), bfhi(a.w)} * w1[tap][1];
                                vv[0] += (f32x4){bflo(q.x), bfhi(q.x), bflo(q.y), bfhi(q.y)} * w2[tap][0]; vv[1] += (f32x4){bflo(q.z), bfhi(q.z), bflo(q.w), bfhi(q.w)} * w2[tap][1]; }
                            const f32x4 p0 = x1[0] * vv[0], p1 = x1[1] * vv[1];
                            pr[o][0] = p0[0]; pr[o][1] = p0[1]; pr[o][2] = p0[2]; pr[o][3] = p0[3]; pr[o][4] = p1[0]; pr[o][5] = p1[1]; pr[o][6] = p1[2]; pr[o][7] = p1[3]; }
#pragma unroll
                        for (int c = 0; c < 8; ++c) op[c][sp] = pk2(pr[0][c], pr[1][c]);
                    }
                    __syncthreads();
#pragma unroll
                    for (int c = 0; c < 8; ++c) { const int ch = 8 * l32 + c; *(LAS u32x4*)(T + ch * 256 + ((hw ^ (l32 & 15)) * 16)) = (u32x4){op[c][0], op[c][1], op[c][2], op[c][3]}; }
                    __syncthreads();
#pragma unroll
                    for (int i = 0; i < 8; ++i) { const int c = i * 32 + (tid >> 4), ch = tid & 15;
                        *(u32x4*)(dstb + ((size_t)(c0 + c) * NB + b) * Ls + s0 + ch * 8) = *(const LAS u32x4*)(T + c * 256 + ((ch ^ ((c >> 3) & 15)) * 16)); }
                }
            }
            SEAMK(pb + 1, 7);
            if (EN_CONV && IN(pb + 2)) {
                const int nlat_u = 1024, nctx_u = ctx_live ? 1024 : 0;
                for (int u = bid; u < nlat_u + nctx_u; u += G) {
                    if (u < nlat_u) { const int c = u; conv_channel<SEQ>(lds, (const bf16_t*)(ws + (jm == 0 ? WS_FI0 : WS_FI1)) + (size_t)c * 8 * FP_L, Wc + (size_t)c * NB * SEQ, Yc + (size_t)c * NB * SEQ, tid, lane, wave); }
                    else { const int c = u - nlat_u; conv_channel<CL>(lds, (const bf16_t*)(ws + WS_FI2) + (size_t)c * 8 * FP_C, Wc + WC_CTX_OFF + (size_t)c * NB * CL, Yc + WC_CTX_OFF + (size_t)c * NB * CL, tid, lane, wave); }
                }
            }
            SEAMK(pb + 2, 8);
            if (EN_MISC && IN(pb + 3)) {
                LAS unsigned char* T = lds;
                const int nlat_u = NB * 16 * 4, nctx_u = ctx_live ? NB * 2 * 4 : 0;
                const int hw = tid >> 5, l32 = tid & 31;
                for (int u = bid; u < nlat_u + nctx_u; u += G) {
                    int b, s0, c0, Ls, rowb; const bf16_t* srcb;
                    if (u < nlat_u) { b = u >> 6; s0 = ((u >> 2) & 15) * 128; c0 = (u & 3) * 256; Ls = SEQ; rowb = b * SEQ; srcb = Yc; }
                    else { const int q = u - nlat_u; b = q >> 3; s0 = ((q >> 2) & 1) * 128; c0 = (q & 3) * 256; Ls = CL; rowb = NLAT + b * CL; srcb = Yc + WC_CTX_OFF; }
                    __syncthreads();
#pragma unroll
                    for (int i = 0; i < 8; ++i) { const int c = i * 32 + (tid >> 4), ch = tid & 15;
                        *(LAS u32x4*)(T + c * 256 + ((ch ^ ((c >> 3) & 15)) * 16)) = *(const u32x4*)(srcb + ((size_t)(c0 + c) * NB + b) * Ls + s0 + ch * 8); }
                    const int cc = c0 + 8 * l32, sb = s0 + 8 * hw;
                    u32x4 ra[10];
#pragma unroll
                    for (int i = 0; i < 10; ++i) { const int sp = sb + i - 1;
                        if (sp >= 0 && sp < Ls) ra[i] = *(const u32x4*)(Upre + (size_t)(rowb + sp) * NHY + cc); else ra[i] = (u32x4){0u, 0u, 0u, 0u}; }
                    f32x4 w0[3][2], b0[2];
#pragma unroll
                    for (int tap = 0; tap < 3; ++tap)
#pragma unroll
                        for (int hh = 0; hh < 2; ++hh) w0[tap][hh] = *(const f32x4*)(cw + tap * NHY + cc + 4 * hh);
#pragma unroll
                    for (int hh = 0; hh < 2; ++hh) b0[hh] = *(const f32x4*)(cb + cc + 4 * hh);
                    __syncthreads();
                    u32x4 yv[8];
#pragma unroll
                    for (int c = 0; c < 8; ++c) yv[c] = *(const LAS u32x4*)(T + (8 * l32 + c) * 256 + ((hw ^ (l32 & 15)) * 16));
#pragma unroll
                    for (int si = 0; si < 8; ++si) {
                        f32x4 x0[2] = {b0[0], b0[1]};
#pragma unroll
                        for (int tap = 0; tap < 3; ++tap) { const u32x4 a = ra[si + tap];
                            x0[0] += (f32x4){bflo(a.x), bfhi(a.x), bflo(a.y), bfhi(a.y)} * w0[tap][0]; x0[1] += (f32x4){bflo(a.z), bfhi(a.z), bflo(a.w), bfhi(a.w)} * w0[tap][1]; }
                        float yy[8];
#pragma unroll
                        for (int c = 0; c < 8; ++c) { const unsigned wd = yv[c][si >> 1]; yy[c] = (si & 1) ? bfhi(wd) : bflo(wd); }
                        u32x4 o; o.x = pk2(x0[0][0] * yy[0], x0[0][1] * yy[1]); o.y = pk2(x0[0][2] * yy[2], x0[0][3] * yy[3]); o.z = pk2(x0[1][0] * yy[4], x0[1][1] * yy[5]); o.w = pk2(x0[1][2] * yy[6], x0[1][3] * yy[7]);
                        *(u32x4*)(hA + (size_t)(rowb + sb + si) * D + cc) = o;
                    }
                }
            }
            SEAMK(pb + 3, 9);
            if (EN_GEMM && IN(pb + 4)) {
                EpiResid<layer == 0> E{x_in, ctx_in, XB, mo + 2 * D, args.in[I_HBOUT] + (size_t)jm * D};
                const bf16_t* Wt = Wout_t + (size_t)jm * D * D;
                const DenseSched S{hA, Wt, nrows / 256, 4, G, bid};
                run_gemm(lds, S, E);
            }
            SEAMK(pb + 4, 10);
        }

        gu32* cnt = ctl + CW_CNT + layer * 32 * 64;
        if (EN_ROUTER && IN(pb + 5)) {
            constexpr int WSTR = D + 8, MAXT = 20;
            LAS bf16_t* WT = (LAS bf16_t*)lds;
            LAS float* CB = (LAS float*)(lds + 2 * 32 * WSTR * 2);
            LAS float* CRED = CB + 32;
            LAS int* LCNT = (LAS int*)(CRED + 512);
            LAS int* PREC = LCNT + 64;
            LAS float* RINV = (LAS float*)(PREC + 8 * MAXT * 4);
            __syncthreads();
            if (tid < 64) LCNT[tid] = 0;
            for (int i = tid; i < 8 * MAXT * 4; i += NTHR) PREC[i] = -1;
            const int TPW = (((nrows + NGW - 1) / NGW) + 1) & ~1;
            const int rf = gw * TPW; const int nval = rf >= nrows ? 0 : (nrows - rf < TPW ? nrows - rf : TPW);
            { int curb = -1; f32x4 gs[4], sh[4];
              for (int ti = 0; ti < nval; ++ti) { const int r = rf + ti; f32x4 v[4]; load_vec_bf(XB + (size_t)r * D, lane, v);
                  const int bq = mod_row(r); if (bq != curb) { const float* mr = mo + (size_t)bq * MODW; load_vec(mr + 4 * D, lane, gs); load_vec(mr + 3 * D, lane, sh); curb = bq; }
                  float ss = 0.f;
#pragma unroll
                  for (int j = 0; j < 4; ++j) ss += (v[j][0] * v[j][0] + v[j][1] * v[j][1]) + (v[j][2] * v[j][2] + v[j][3] * v[j][3]);
                  ss = wave_sum(ss); const float rinv = __builtin_amdgcn_rsqf(ss * (1.0f / D) + EPS);
                  if (lane == 0) RINV[wave * MAXT + ti] = rinv;
#pragma unroll
                  for (int j = 0; j < 4; ++j) { const f32x4 h = (v[j] * rinv) * gs[j] + sh[j]; u32x2 w; w.x = pk2(h[0], h[1]); w.y = pk2(h[2], h[3]); ((u32x2*)(hA + (size_t)r * D))[lane + 64 * j] = w; } } }
            const int rb0 = bid * NWAVES * TPW; const int rb1 = (rb0 + NWAVES * TPW < nrows ? rb0 + NWAVES * TPW : nrows) - 1;
            const int bb0 = rb0 < nrows ? mod_row(rb0) : 1, bb1 = rb0 < nrows ? mod_row(rb1) : 0;
            const float* rw = args.in[I_RW] + (size_t)layer * D * NE; const float* rbias = args.in[I_RB] + layer * NE;
            for (int bq = bb0; bq <= bb1; ++bq) {
                __syncthreads();
                { const float* gsb = mo + (size_t)bq * MODW + 4 * D; const float* shb = mo + (size_t)bq * MODW + 3 * D;
                  const int e = tid & 31; float cpart = 0.f;
                  for (int jj = 0; jj < 8; ++jj) { const int k0 = 8 * ((tid >> 5) + 16 * jj);
                      const f32x4 g0 = *(const f32x4*)(gsb + k0), g1 = *(const f32x4*)(gsb + k0 + 4), s0 = *(const f32x4*)(shb + k0), s1 = *(const f32x4*)(shb + k0 + 4);
                      float wv[8];
#pragma unroll
                      for (int q = 0; q < 8; ++q) wv[q] = rw[(size_t)(k0 + q) * NE + e];
                      float pv[8]; unsigned hw[4], lw[4];
#pragma unroll
                      for (int q = 0; q < 4; ++q) { pv[q] = g0[q] * wv[q]; pv[4 + q] = g1[q] * wv[4 + q]; cpart += s0[q] * wv[q] + s1[q] * wv[4 + q]; }
#pragma unroll
                      for (int q = 0; q < 4; ++q) { hw[q] = pk2(pv[2 * q], pv[2 * q + 1]); lw[q] = pk2(pv[2 * q] - bflo(hw[q]), pv[2 * q + 1] - bfhi(hw[q])); }
                      *(LAS u32x4*)(WT + (size_t)e * WSTR + k0) = (u32x4){hw[0], hw[1], hw[2], hw[3]};
                      *(LAS u32x4*)(WT + (size_t)(32 + e) * WSTR + k0) = (u32x4){lw[0], lw[1], lw[2], lw[3]}; }
                  CRED[(tid >> 5) * 32 + e] = cpart; }
                __syncthreads();
                if (tid < 32) { float c = rbias[tid];
#pragma unroll
                    for (int q = 0; q < 16; ++q) c += CRED[q * 32 + tid];
                    CB[tid] = c; }
                __syncthreads();
                if (nval > 0 && mod_row(rf) <= bq && bq <= mod_row(rf + nval - 1)) {
                    const int e = lane & 31, kh = lane >> 5; const int trow = rf + (e < nval ? e : nval - 1);
                    const bf16_t* ap = XB + (size_t)trow * D + 8 * kh;
                    const LAS bf16_t* bhp = WT + (size_t)e * WSTR + 8 * kh; const LAS bf16_t* blp = bhp + 32 * WSTR;
                    f32x16 acc;
#pragma unroll
                    for (int q = 0; q < 16; ++q) acc[q] = 0.f;
#pragma unroll 8
                    for (int ks = 0; ks < D / 16; ++ks) { const bf16x8 af = *(const bf16x8*)(ap + 16 * ks);
                        acc = __builtin_amdgcn_mfma_f32_32x32x16_bf16(af, *(const LAS bf16x8*)(bhp + 16 * ks), acc, 0, 0, 0);
                        acc = __builtin_amdgcn_mfma_f32_32x32x16_bf16(af, *(const LAS bf16x8*)(blp + 16 * ks), acc, 0, 0, 0); }
                    const float cbe = CB[e];
#pragma unroll
                    for (int t = 0; t < MAXT; ++t) { if (t < nval && mod_row(rf + t) == bq) {
                        constexpr int dummy = 0; (void)dummy;
                        const int hf = (t >> 2) & 1; const float val = RINV[wave * MAXT + t] * acc[(t & 3) + 4 * (t >> 3)] + cbe;
                        int rank = 0;
#pragma unroll
                        for (int e2 = 0; e2 < 32; ++e2) { const float o = __builtin_bit_cast(float, __builtin_amdgcn_readlane(__builtin_bit_cast(int, val), 32 * hf + e2)); rank += (o > val || (o == val && e2 < e)) ? 1 : 0; }
                        float sv[4]; int si[4]; const unsigned long long hm = hf ? 0xFFFFFFFF00000000ull : 0x00000000FFFFFFFFull;
#pragma unroll
                        for (int k = 0; k < 4; ++k) { const unsigned long long m = __ballot(rank == k) & hm; const int src = __builtin_ctzll(m); si[k] = src & 31; sv[k] = __builtin_bit_cast(float, __builtin_amdgcn_readlane(__builtin_bit_cast(int, val), src)); }
                        if (lane < 4) { const int k = lane; const float e1 = __expf(sv[1] - sv[0]), e2 = __expf(sv[2] - sv[0]), e3 = __expf(sv[3] - sv[0]); const float inv = 1.0f / (1.0f + e1 + e2 + e3);
                            const int ex = k == 0 ? si[0] : (k == 1 ? si[1] : (k == 2 ? si[2] : si[3])); const float gt = (k == 0 ? 1.0f : (k == 1 ? e1 : (k == 2 ? e2 : e3))) * inv;
                            const int r = rf + t; const int rk = __hip_atomic_fetch_add(LCNT + ex, 1, __ATOMIC_RELAXED, __HIP_MEMORY_SCOPE_WORKGROUP);
                            top_e[r * 4 + k] = ex; pgate[r * 4 + k] = gt; PREC[(wave * MAXT + t) * 4 + k] = ex | (rk << 8); } } }
                }
            }
            __syncthreads();
            if (tid < 32) LCNT[32 + tid] = (int)__hip_atomic_fetch_add(cnt + tid * 64, (unsigned)LCNT[tid], RLX_AGENT);
            __syncthreads();
            for (int i = tid; i < 8 * MAXT * 4; i += NTHR) { const int rec = PREC[i]; if (rec >= 0) { const int e = rec & 255, rank = rec >> 8, w = i / (MAXT * 4), ti = (i / 4) % MAXT, k = i & 3;
                const int r = (bid * NWAVES + w) * TPW + ti; const int pos = LCNT[32 + e] + rank; ppos[r * 4 + k] = pos; elist[(size_t)e * NTOK + pos] = r; } }
        }
        SEAMK(pb + 5, 11);
        LAS int* PADS = (LAS int*)(lds + LDS_BYTES - 4096);
        LAS unsigned char* TE = (LAS unsigned char*)(PADS + 128);
        if (IN(pb + 7) || IN(pb + 8) || IN(pb + 9)) {
            __syncthreads();
            if (tid < 32) PADS[64 + tid] = (int)__hip_atomic_load(cnt + tid * 64, RLX_AGENT);
            __syncthreads();
            if (tid < 64) {
                const int nt = lane < 32 ? (PADS[64 + lane] + 255) >> 8 : 0; int inc = nt;
#pragma unroll
                for (int o = 1; o < 32; o <<= 1) { const int v = __shfl_up(inc, o); if (lane >= o) inc += v; }
                if (lane < 32) PADS[lane] = (inc - nt) << 8; if (lane == 31) PADS[32] = inc << 8;
            }
            __syncthreads();
            { const int ntile = PADS[32] >> 8; for (int t = tid; t < ntile; t += NTHR) { int e = 0;
#pragma unroll
                  for (int st = 16; st >= 1; st >>= 1) if (PADS[e + st] <= (t << 8)) e += st;
                  TE[t] = (unsigned char)e; } }
            __syncthreads();
        }
        if (EN_GEMM && IN(pb + 7)) {
            const int ntile = PADS[32] >> 8;
            LAS int* ROWS = (LAS int*)(lds + 131072);
            { Unit uu; for (int ui = 0; xcd_unit(ui, G, bid, ntile, 8, uu.pm, uu.pn); ++ui) { if (tid < 256) { const int e = TE[uu.pm]; const int pos = uu.pm * 256 - PADS[e] + tid;
                  ROWS[ui * 256 + tid] = pos < PADS[64 + e] ? elist[(size_t)e * NTOK + pos] : 0; } } }
            __syncthreads();
            const MoeGatherSched S{hA, Wgu_t + (size_t)layer * NE * NGU * D, TE, ROWS, ntile, 8, NGU, G, bid};
            const EpiSwiglu E{AB, args.in[I_BGU] + (size_t)layer * NE * NGU};
            run_gemm_gather(lds, S, E);
        }
        SEAMK(pb + 7, 12);
        if (EN_GEMM && IN(pb + 8)) {
            const int ntile = PADS[32] >> 8;
            const MoeSched S{AB, Wdn_t + (size_t)layer * NE * D * D, TE, ntile, 4, D, G, bid};
            const EpiBiasBf16 E{XS, D, args.in[I_BDN] + (size_t)layer * NE * D, D};
            run_gemm(lds, S, E);
        }
        SEAMK(pb + 8, 13);
        if (EN_MISC && IN(pb + 9)) {
            const bool has_next = layer + 1 < DEPTH;
            const float* mo_n = modf + (size_t)(layer + 1) * NMODROW * MODW; const float* g1n = args.in[I_N1G] + (has_next ? (layer + 1) * D : 0);
            const int nnext = (layer + 1 < 3) ? NTOK : NLAT;
            const int TPW = (nrows + NGW - 1) / NGW;
            int curb = -1; f32x4 gm[4], gsn[4], shn[4];
            for (int ti = 0; ti < TPW; ++ti) {
                const int r = gw * TPW + ti; if (r >= nrows) break;
                bf16_t* xr = XB + (size_t)r * D;
                int dest[4]; float gt[4];
#pragma unroll
                for (int k = 0; k < 4; ++k) { dest[k] = PADS[top_e[r * 4 + k]] + ppos[r * 4 + k]; gt[k] = pgate[r * 4 + k]; }
                u32x2 yw[4][4]; f32x4 v[4], h[4];
#pragma unroll
                for (int k = 0; k < 4; ++k) { const u32x2* yr = (const u32x2*)(XS + (size_t)dest[k] * D);
#pragma unroll
                    for (int j = 0; j < 4; ++j) yw[k][j] = yr[lane + 64 * j]; }
                load_vec_bf(xr, lane, v);
                const int b = mod_row(r);
                if (b != curb) { load_vec(mo + (size_t)b * MODW + 5 * D, lane, gm); if (has_next) { const float* mn = mo_n + (size_t)b * MODW; load_vec(mn + D, lane, gsn); load_vec(mn, lane, shn); } curb = b; }
#pragma unroll
                for (int j = 0; j < 4; ++j) { f32x4 y = (f32x4){0.f, 0.f, 0.f, 0.f};
#pragma unroll
                    for (int k = 0; k < 4; ++k) { const u32x2 w = yw[k][j]; y[0] += gt[k] * bflo(w.x); y[1] += gt[k] * bfhi(w.x); y[2] += gt[k] * bflo(w.y); y[3] += gt[k] * bfhi(w.y); }
                    v[j] = v[j] + gm[j] * y;
                    if (layer == DEPTH - 1) ((f32x4*)(out + (size_t)r * D))[lane + 64 * j] = v[j];
                    else { u32x2 w; w.x = pk2(v[j][0], v[j][1]); w.y = pk2(v[j][2], v[j][3]); ((u32x2*)xr)[lane + 64 * j] = w; } }
                if (has_next && r < nnext) norm_mod_store(v, gsn, shn, hA + (size_t)r * D, lane, h);
            }
        }
        SEAMK(pb + 9, 14);
}

__global__ void __launch_bounds__(NTHR, 2) fwd(Args args) {
    extern __shared__ __attribute__((aligned(16))) unsigned char lds_raw[];
    LAS unsigned char* lds = (LAS unsigned char*)lds_raw;
    const int tid = threadIdx.x, lane = tid & 63, wave = __builtin_amdgcn_readfirstlane(tid >> 6);
    const int G = gridDim.x, bid = blockIdx.x;
    const int gw = bid * NWAVES + wave, NGW = G * NWAVES;
    unsigned char* ws = args.ws;
    gu32* ctl = (gu32*)(ws + WS_CTL);
    volatile LAS unsigned* MISC = (volatile LAS unsigned*)(lds + MISC_OFF);
    if (tid < 64) MISC[tid] = 0u;
    __syncthreads();
    XcdBarrier bar; bar.bar = (unsigned*)ctl + CW_BAR; bar.x = 0; bar.st = MISC + 8;
    const int lo = args.ph_lo, hi = args.ph_hi;
    if (hi - lo > 1) bar = xcd_barrier_post((unsigned*)ctl + CW_BAR, MISC + 8);

    KLOCALS

    if (EN_PRO && IN(0)) {
        {
            LAS float* scr = (LAS float*)(lds + wave * 8448);
            constexpr int IT_QKV = 16 * (NQKV / 32), IT_SQ = 16 * (D / 32), IT_IN = 16 * (NHY / 32), IT_GU = 16 * (NGU / 32);
            constexpr int N0 = 2 * IT_QKV, N1 = N0 + 2 * IT_SQ, N2 = N1 + 2 * IT_IN, N3 = N2 + 2 * IT_SQ, N4 = N3 + 128 * IT_GU, N5 = N4 + 128 * IT_SQ;
            for (int it = gw; it < N5; it += NGW) {
                if (it < N0) { const int mtx = it / IT_QKV, r = it % IT_QKV; transpose_item<1>(args.in[I_WQKV] + (size_t)mtx * D * NQKV, NQKV, Wqkv_t + (size_t)mtx * NQKV * D, scr, r, lane); }
                else if (it < N1) { const int q = it - N0, mtx = q / IT_SQ, r = q % IT_SQ; transpose_item<0>(args.in[I_WO] + (size_t)mtx * D * D, D, Wo_t + (size_t)mtx * D * D, scr, r, lane); }
                else if (it < N2) { const int q = it - N1, mtx = q / IT_IN, r = q % IT_IN; transpose_item<0>(args.in[I_HWIN] + (size_t)mtx * D * NHY, NHY, Win_t + (size_t)mtx * NHY * D, scr, r, lane); }
                else if (it < N3) { const int q = it - N2, mtx = q / IT_SQ, r = q % IT_SQ; transpose_item<0>(args.in[I_HWOUT] + (size_t)mtx * D * D, D, Wout_t + (size_t)mtx * D * D, scr, r, lane); }
                else if (it < N4) { const int q = it - N3, mtx = q / IT_GU, r = q % IT_GU; transpose_item<2>(args.in[I_WGU] + (size_t)mtx * D * NGU, NGU, Wgu_t + (size_t)mtx * NGU * D, scr, r, lane); }
                else { const int q = it - N4, mtx = q / IT_SQ, r = q % IT_SQ; transpose_item<0>(args.in[I_WDN] + (size_t)mtx * D * D, D, Wdn_t + (size_t)mtx * D * D, scr, r, lane); }
            }
        }
        __syncthreads();
        {
            LAS float* S = (LAS float*)lds;
            for (int u = bid; u < 4 * 12 * 8; u += G) {
                const int kc = u & 7, cc = (u >> 3) % 12, layer = u / 96;
                __syncthreads();
                for (int i = tid; i < 128 * 20; i += NTHR) { const int k = i / 20, r = i % 20; float v = 0.f;
                    if (r < NMODROW) { const float cv = r < NB ? c_in[r * D + kc * 128 + k] : cctx_in[kc * 128 + k]; v = cv / (1.0f + __expf(-cv)); }
                    S[i] = v; }
                __syncthreads();
                const int col = cc * 512 + tid;
                const float* wp = args.in[I_WMOD] + ((size_t)layer * D + kc * 128) * MODW + col;
                float acc[20];
#pragma unroll
                for (int r = 0; r < 20; ++r) acc[r] = 0.f;
                for (int k = 0; k < 128; ++k) { const float w = wp[(size_t)k * MODW];
#pragma unroll
                    for (int q = 0; q < 5; ++q) { const f32x4 s = *(const LAS f32x4*)(S + k * 20 + 4 * q);
                        acc[4 * q] += s[0] * w; acc[4 * q + 1] += s[1] * w; acc[4 * q + 2] += s[2] * w; acc[4 * q + 3] += s[3] * w; } }
#pragma unroll
                for (int r = 0; r < NMODROW; ++r) modp[((size_t)(kc * 4 + layer) * NMODROW + r) * MODW + col] = acc[r];
            }
        }
        for (int i = bid * NTHR + tid; i < SEQ * 32; i += G * NTHR) {
            const int t = i >> 5, j = i & 31, fi = j & 15; const int pos = (j >> 4) == 0 ? (t >> 6) : (t & 63);
            const float inv = powf(10000.0f, -(float)fi / 16.0f); const float ang = (float)pos * inv;
            cosT[i] = cosf(ang); sinT[i] = sinf(ang);
        }
        {
            __syncthreads();
            LAS float* Z = (LAS float*)lds;
            LAS float* A1 = Z + 8 * 36;
            for (int u = bid; u < 256 + 256 + 32; u += G) {
                const int combo = u < 256 ? 0 : (u < 512 ? 1 : 2); const int ub = combo == 0 ? u : (combo == 1 ? u - 256 : u - 512);
                const int j = combo == 1 ? 1 : 0, Lf = combo == 2 ? CL : SEQ;
                const int tl = tid >> 6, o = tid & 63, t = ub * 8 + tl;
                __syncthreads();
                if (o < 33) { float z;
                    const float tt = (float)t / (float)(Lf - 1), w = 6.283185307179586f * (float)t / (float)Lf;
                    if (o == 0) z = tt; else { const int b = (o - 1) & 15; const float f = 1e-4f + (float)b * ((15.0f - 1e-4f) / 15.0f); z = o <= 16 ? cosf(f * w) : -sinf(f * w); }
                    Z[tl * 36 + o] = z; }
                __syncthreads();
                const float sf = args.in[I_HSF][j * 64 + o];
                { const float* w1 = args.in[I_HW1] + (size_t)j * 33 * 64; float a = args.in[I_HB1][j * 64 + o];
                  for (int i = 0; i < 33; ++i) a += Z[tl * 36 + i] * w1[i * 64 + o];
                  A1[tl * 64 + o] = sinf(sf * a); }
                __syncthreads();
                { const float* w2 = args.in[I_HW2] + (size_t)j * 64 * 64; float a = args.in[I_HB2][j * 64 + o];
                  for (int i = 0; i < 64; ++i) a += A1[tl * 64 + i] * w2[i * 64 + o];
                  a2tab[((size_t)combo * SEQ + t) * 64 + o] = sinf(sf * a); }
            }
        }
    }
    SEAMK(0, 0);

    if (EN_PRO && IN(1)) {
        for (int i = bid * NTHR + tid; i < DEPTH * NMODROW * MODW; i += G * NTHR) {
            const int layer = i / (NMODROW * MODW), rem = i % (NMODROW * MODW), col = rem % MODW; float s = args.in[I_BMOD][layer * MODW + col];
#pragma unroll
            for (int kc = 0; kc < 8; ++kc) s += modp[(size_t)(kc * 4 + layer) * NMODROW * MODW + rem];
            const int chunk = col >> 10, k = col & (D - 1);
            if (chunk == 1) s = args.in[I_N1G][layer * D + k] * (1.0f + s); else if (chunk == 4) s = args.in[I_N2G][layer * D + k] * (1.0f + s);
            modf[i] = s;
        }
        {
            LAS float* W3 = (LAS float*)lds;
            LAS float* RED = W3 + 512;
            LAS float* NRM = RED + 32;
            LAS float* HF = NRM + 4;
            for (int u = bid; u < 3 * 256; u += G) {
                const int combo = u >> 8, cg = u & 255; const int j = combo == 1 ? 1 : 0, Lf = combo == 2 ? CL : SEQ; const int c0 = cg * 4;
                LAS float* HB = HF + 4 * Lf;
                __syncthreads();
                { const int i = tid >> 3, q = tid & 7; const int col = (q >> 2) * 1024 + c0 + (q & 3);
                  W3[i * 8 + q] = args.in[I_HW3][((size_t)j * 64 + i) * 2048 + col]; }
                __syncthreads();
                float b3v[8], dec[4], asum[4] = {0.f, 0.f, 0.f, 0.f};
#pragma unroll
                for (int q = 0; q < 8; ++q) b3v[q] = args.in[I_HB3][j * 2048 + (q >> 2) * 1024 + c0 + (q & 3)];
#pragma unroll
                for (int ch = 0; ch < 4; ++ch) dec[ch] = 3.0701134573253945f + (float)(c0 + ch) * ((15.350567286626972f - 3.0701134573253945f) / 1023.0f);
                for (int t = tid; t < Lf; t += NTHR) {
                    asm volatile("" ::: "memory");
                    const float* ar = a2tab + ((size_t)combo * SEQ + t) * 64; float d[8];
#pragma unroll
                    for (int q = 0; q < 8; ++q) d[q] = b3v[q];
#pragma unroll
                    for (int i4 = 0; i4 < 16; ++i4) { const f32x4 a = *(const f32x4*)(ar + 4 * i4); asm volatile("" ::: "memory");
#pragma unroll
                        for (int e = 0; e < 4; ++e) { const f32x4 w0 = *(const LAS f32x4*)(W3 + (4 * i4 + e) * 8), w1 = *(const LAS f32x4*)(W3 + (4 * i4 + e) * 8 + 4);
                            d[0] += a[e] * w0[0]; d[1] += a[e] * w0[1]; d[2] += a[e] * w0[2]; d[3] += a[e] * w0[3]; d[4] += a[e] * w1[0]; d[5] += a[e] * w1[1]; d[6] += a[e] * w1[2]; d[7] += a[e] * w1[3]; } }
                    const float tt = (float)t / (float)(Lf - 1);
#pragma unroll
                    for (int ch = 0; ch < 4; ++ch) { const float dk = __expf(-tt * dec[ch]); const float f = d[ch] * dk, bb = d[4 + ch] * dk;
                        HF[ch * Lf + t] = f; HB[ch * Lf + t] = bb; asum[ch] += fabsf(f) + (t >= 1 ? fabsf(bb) : 0.f); }
                }
#pragma unroll
                for (int ch = 0; ch < 4; ++ch) { const float s = wave_sum(asum[ch]); if (lane == 0) RED[wave * 4 + ch] = s; }
                __syncthreads();
                if (tid < 4) { float s = 0.f; for (int w = 0; w < 8; ++w) s += RED[w * 4 + tid]; NRM[tid] = 1.0f / (s + EPS); }
                __syncthreads();
                const int P = 2 * Lf + 8, PC8 = P / 8;
                bf16_t* FI = (bf16_t*)(ws + (combo == 0 ? WS_FI0 : (combo == 1 ? WS_FI1 : WS_FI2)));
                for (int q = tid; q < 4 * 8 * PC8; q += NTHR) {
                    const int ch = q / (8 * PC8), r = q % (8 * PC8), cidx = r / PC8, x0 = (r % PC8) * 8;
                    const float nr = NRM[ch], db = args.in[I_HDB][j * 1024 + c0 + ch]; float v[8];
#pragma unroll
                    for (int e = 0; e < 8; ++e) { const int m = Lf - (x0 + e) + cidx; const int am = m < 0 ? -m : m; float g = 0.f;
                        if (am <= Lf - 1) { g = (m >= 0 ? HF[ch * Lf + am] : HB[ch * Lf + am]) * nr; if (m == 0) g += db; }
                        v[e] = g; }
                    u32x4 o; o.x = pk2(v[0], v[1]); o.y = pk2(v[2], v[3]); o.z = pk2(v[4], v[5]); o.w = pk2(v[6], v[7]);
                    *(u32x4*)(FI + ((size_t)((c0 + ch) * 8 + cidx)) * P + x0) = o;
                }
            }
        }
    }
    SEAMK(1, 1);

    if (IN(2)) {
        const float* mo = modf;
        const int TPW = (NTOK + NGW - 1) / NGW;
        int curb = -1; f32x4 gs[4], sh[4];
        for (int ti = 0; ti < TPW; ++ti) {
            const int r = gw * TPW + ti; if (r >= NTOK) break;
            const float* src = r < NLAT ? x_in + (size_t)r * D : ctx_in + (size_t)(r - NLAT) * D;
            f32x4 v[4], h[4]; load_vec(src, lane, v);
            const int b = mod_row(r); if (b != curb) { const float* mr = mo + (size_t)b * MODW; load_vec(mr + D, lane, gs); load_vec(mr, lane, sh); curb = b; }
            norm_mod_store(v, gs, sh, hA + (size_t)r * D, lane, h);
        }
    }
    SEAMK(2, 2);

    layer_body<0>(args, lds, bar, tid, lane, wave, G, bid, lo, hi);
    layer_body<1>(args, lds, bar, tid, lane, wave, G, bid, lo, hi);
    layer_body<2>(args, lds, bar, tid, lane, wave, G, bid, lo, hi);
    layer_body<3>(args, lds, bar, tid, lane, wave, G, bid, lo, hi);
#undef IN
#undef SEAM
}

extern "C" void kernel_launch(void* const* d_in, const int* in_sizes, int n_in, void* d_out, int out_size, void* d_ws, size_t ws_size, hipStream_t stream) {
    static int grid = 0;
    if (grid == 0) {
        if (n_in != 32 || out_size != NLAT * D || ws_size < WS_END) { fprintf(stderr, "kernel_launch: unexpected problem (n_in %d, out %d, ws %zu)\n", n_in, out_size, ws_size); grid = -1; return; }
        int dev = 0, cus = 0, per_cu = 0;
        if (hipGetDevice(&dev) != hipSuccess || hipDeviceGetAttribute(&cus, hipDeviceAttributeMultiprocessorCount, dev) != hipSuccess) { grid = -1; return; }
        if (hipFuncSetAttribute((const void*)fwd, hipFuncAttributeMaxDynamicSharedMemorySize, LDS_BYTES) != hipSuccess) { fprintf(stderr, "kernel_launch: hipFuncSetAttribute failed\n"); grid = -1; return; }
        if (hipOccupancyMaxActiveBlocksPerMultiprocessor(&per_cu, (const void*)fwd, NTHR, LDS_BYTES) != hipSuccess || per_cu < 1) fprintf(stderr, "kernel_launch: occupancy query says %d\n", per_cu);
        (void)hipGetLastError();
        grid = cus;
    }
    if (grid < 0) return;
    (void)hipMemsetAsync((char*)d_ws + WS_CTL, 0, CTL_ZERO_BYTES, stream);
    Args a{};
    for (int i = 0; i < 32; ++i) a.in[i] = (const float*)d_in[i];
    a.out = (float*)d_out; a.ws = (unsigned char*)d_ws;
    constexpr int NPH = 3 + 10 * DEPTH;
#if MK_ONE_LAUNCH
    a.ph_lo = 0; a.ph_hi = NPH;
    hipLaunchKernelGGL(fwd, dim3(grid), dim3(NTHR), LDS_BYTES, stream, a);
#else
    for (int p = 0; p < NPH; ++p) {
        if (p >= 3) { const int layer = (p - 3) / 10, loc = (p - 3) % 10; if ((layer & 1) == 0 && (loc == 3 || loc == 4)) continue; }
        a.ph_lo = p; a.ph_hi = p + 1;
        hipLaunchKernelGGL(fwd, dim3(grid), dim3(NTHR), LDS_BYTES, stream, a);
    }
#endif
}
```

```cpp
#include <hip/hip_runtime.h>
#include <cstdio>
#include <cstdint>
#include <cmath>
#include <hip/hip_bf16.h>

#ifndef EN_PRO
#define EN_PRO 1
#endif
#ifndef EN_ATT
#define EN_ATT 1
#endif
#ifndef EN_CONV
#define EN_CONV 1
#endif
#ifndef EN_ROUTER
#define EN_ROUTER 1
#endif
#ifndef EN_GEMM
#define EN_GEMM 1
#endif
#ifndef EN_MISC
#define EN_MISC 1
#endif
#ifndef MK_ONE_LAUNCH
#define MK_ONE_LAUNCH 1
#endif

#define GAS __attribute__((address_space(1)))
#define LAS __attribute__((address_space(3)))
typedef unsigned short bf16_t;
typedef short bf16x8 __attribute__((ext_vector_type(8)));
typedef float f32x4 __attribute__((ext_vector_type(4)));
typedef float f32x2 __attribute__((ext_vector_type(2)));
typedef unsigned u32x4 __attribute__((ext_vector_type(4)));
typedef unsigned u32x2 __attribute__((ext_vector_type(2)));
typedef GAS unsigned gu32;
typedef float f32x16 __attribute__((ext_vector_type(16)));

constexpr int D = 1024, NB = 16, SEQ = 2048, CL = 256, KVL = SEQ + CL;
constexpr int NLAT = NB * SEQ, NCTX = NB * CL, NTOK = NLAT + NCTX;
constexpr int NE = 32, TOPK = 4, DEPTH = 4;
constexpr int MODW = 6 * D, NMODROW = NB + 1;
constexpr int NQKV = 1536, NHY = 3072, NGU = 2048;
constexpr float EPS = 1e-6f;
constexpr float C2 = 0.125f * 1.4426950408889634f;
constexpr int NWAVES = 8, NTHR = 512;
constexpr int NPADROWS = 155648;
constexpr int MAXTILES = NPADROWS / 256;

constexpr size_t MiB = 1u << 20;
constexpr size_t WS_CTL = 0, CTL_ZERO_BYTES = 1 * MiB;
constexpr size_t WS_MODP = 2 * MiB;
constexpr size_t WS_MOD = 16 * MiB;
constexpr size_t WS_ROPE = 18 * MiB;
constexpr size_t WS_A2 = 19 * MiB;
constexpr size_t WS_PAIR = 21 * MiB;
constexpr size_t WS_CTX = 24 * MiB;
constexpr size_t WS_FI = 40 * MiB;
constexpr int FP_L = 2 * SEQ + 8, FP_C = 2 * CL + 8;
constexpr size_t FI_L_BYTES = (size_t)1024 * 8 * FP_L * 2, FI_C_BYTES = (size_t)1024 * 8 * FP_C * 2;
constexpr size_t WS_FI0 = WS_FI, WS_FI1 = WS_FI0 + 65 * MiB, WS_FI2 = WS_FI1 + 65 * MiB;
static_assert(FI_L_BYTES <= 65 * MiB && WS_FI2 + FI_C_BYTES <= 180 * MiB, "filter map");
constexpr size_t WS_WQKV = 180 * MiB, WS_WO = 186 * MiB, WS_WIN = 190 * MiB, WS_WOUT = 202 * MiB, WS_WGU = 206 * MiB, WS_WDN = 718 * MiB;
constexpr size_t WS_HA = 974 * MiB;
constexpr size_t WS_Q = 1046 * MiB;
constexpr size_t WS_K = 1118 * MiB, WS_V = 1136 * MiB;
constexpr size_t WS_UPRE = 1154 * MiB;
constexpr size_t WS_WC = 1370 * MiB;
constexpr size_t WS_YC = 1442 * MiB;
constexpr size_t WS_XS = 1514 * MiB;
constexpr size_t WS_AB = 1818 * MiB;
constexpr size_t WS_ELIST = 2122 * MiB;
constexpr size_t WS_XB = 2128 * MiB;
constexpr size_t WS_END = 2200 * MiB;
constexpr size_t WC_CTX_OFF = (size_t)1024 * 16 * 2048;
constexpr int CW_TMO = 0, CW_BAR = 4096, CW_CNT = 16384;

constexpr int LDS_BYTES = 160 * 1024;
constexpr int MISC_OFF = LDS_BYTES - 256;

#define RLX_AGENT __ATOMIC_RELAXED, __HIP_MEMORY_SCOPE_AGENT
#define LDS_WAIT() asm volatile("s_waitcnt lgkmcnt(0)" ::: "memory")
#define VM_WAIT() asm volatile("s_waitcnt vmcnt(0)" ::: "memory")
__device__ __forceinline__ unsigned f2bf(float f) { unsigned u = __builtin_bit_cast(unsigned, f); return (u + 0x7fffu + ((u >> 16) & 1u)) >> 16; }
typedef __bf16 bf16x2_t __attribute__((ext_vector_type(2)));
__device__ __forceinline__ unsigned pk2(float lo, float hi) { const f32x2 v = {lo, hi}; const bf16x2_t b = __builtin_convertvector(v, bf16x2_t); return __builtin_bit_cast(unsigned, b); }
__device__ __forceinline__ float bf2f(unsigned h) { return __builtin_bit_cast(float, h << 16); }
__device__ __forceinline__ float bflo(unsigned w) { return __builtin_bit_cast(float, w << 16); }
__device__ __forceinline__ float bfhi(unsigned w) { return __builtin_bit_cast(float, w & 0xffff0000u); }
__device__ __forceinline__ float wave_sum(float v) {
#pragma unroll
    for (int o = 1; o < 64; o <<= 1) v += __shfl_xor(v, o);
    return v;
}

#define XB_TMO      128
#define XB_XCNT(j)  (256  + 64 * (j))
#define XB_XSUB(j)  (1280 + 64 * (j))
#define XB_XGEN(j)  (2304 + 64 * (j))
#define XB_TOP      3328
#define XB_TOPGEN   3392
#define XCD_BAR_WORDS 3456
#define XB_SPIN_CAP (1u << 22)
__device__ __forceinline__ unsigned xb_ld(unsigned* p)              { return __hip_atomic_load(p, __ATOMIC_RELAXED, __HIP_MEMORY_SCOPE_AGENT); }
__device__ __forceinline__ unsigned xb_add(unsigned* p, unsigned v) { return __hip_atomic_fetch_add(p, v, __ATOMIC_RELAXED, __HIP_MEMORY_SCOPE_AGENT); }
__device__ __forceinline__ unsigned xb_xcc_id() { return (unsigned)__builtin_amdgcn_s_getreg((3 << 11) | 20) & 0xFu; }
#define XB_SPIN(cond, bar) do { unsigned _sp = 0; while (cond) { __builtin_amdgcn_s_sleep(1); \
    if ((++_sp & 255u) == 0u) { if (xb_ld(&(bar)[XB_TMO])) break; if (_sp > XB_SPIN_CAP) { atomicAdd(&(bar)[XB_TMO], 1u); break; } } } } while (0)
struct XcdBarrier { unsigned* bar; unsigned x; volatile LAS unsigned* st; };
__device__ __forceinline__ XcdBarrier xcd_barrier_post(unsigned* bar, volatile LAS unsigned* st) {
    XcdBarrier b; b.bar = bar; b.x = xb_xcc_id(); b.st = st;
    if (threadIdx.x == 0) (void)xb_add(&bar[XB_XCNT(b.x)], 1u);
    return b;
}
__device__ __forceinline__ void xcd_barrier_complete(unsigned* bar, unsigned x, unsigned& nloc, unsigned& nx) {
    const unsigned G = gridDim.x * gridDim.y * gridDim.z;
    unsigned sum, cnt, mine, sp = 0u;
    for (;;) {
        sum = 0u; cnt = 0u; mine = 0u;
#pragma unroll
        for (unsigned j = 0; j < 16; ++j) { const unsigned c = xb_ld(&bar[XB_XCNT(j)]); sum += c; cnt += (c > 0u) ? 1u : 0u; mine = (j == x) ? c : mine; }
        if (sum == G) break;
        __builtin_amdgcn_s_sleep(1);
        if ((++sp & 255u) == 0u) { if (xb_ld(&bar[XB_TMO])) break; if (sp > XB_SPIN_CAP) { atomicAdd(&bar[XB_TMO], 1u); break; } }
    }
    nloc = mine > 0u ? mine : 1u; nx = cnt > 0u ? cnt : 1u;
}
__device__ __forceinline__ void xcd_barrier(const XcdBarrier& b) {
    asm volatile("s_waitcnt vmcnt(0)" ::: "memory");
    __syncthreads();
    if (threadIdx.x == 0) {
        unsigned* bar = b.bar;
        __builtin_amdgcn_s_waitcnt(0);
        unsigned nloc = b.st[0], nx = b.st[1];
        if (nloc == 0u) { xcd_barrier_complete(bar, b.x, nloc, nx); b.st[0] = nloc; b.st[1] = nx; }
        const unsigned old = xb_add(&bar[XB_XSUB(b.x)], 1u);
        const unsigned gen = old / nloc;
        if (old + 1u == (gen + 1u) * nloc) {
            __builtin_amdgcn_fence(__ATOMIC_RELEASE, "agent");
            asm volatile("s_waitcnt vmcnt(0)" ::: "memory");
            const unsigned og = xb_add(&bar[XB_TOP], 1u);
            const unsigned tg = og / nx;
            if (og + 1u == (tg + 1u) * nx) xb_add(&bar[XB_TOPGEN], 1u);
            else XB_SPIN(xb_ld(&bar[XB_TOPGEN]) == tg, bar);
            __builtin_amdgcn_fence(__ATOMIC_ACQUIRE, "agent");
            xb_add(&bar[XB_XGEN(b.x)], 1u);
            asm volatile("s_waitcnt vmcnt(0)" ::: "memory");
        } else {
            XB_SPIN(xb_ld(&bar[XB_XGEN(b.x)]) == gen, bar);
            __builtin_amdgcn_fence(__ATOMIC_ACQUIRE, "agent");
            asm volatile("s_waitcnt vmcnt(0)" ::: "memory");
        }
    }
    __syncthreads();
}

struct Args { const float* in[32]; float* out; unsigned char* ws; int ph_lo, ph_hi; };
struct Ctx {
    LAS unsigned char* lds;
    int tid, lane, wave, G, bid;
    const float* const* in;
};
enum { I_X = 0, I_C, I_CTX, I_CCTX, I_WMOD, I_BMOD, I_N1G, I_N2G, I_WQKV, I_QG, I_KG, I_WO, I_HWIN, I_HBIN, I_HCW, I_HCB, I_HW1, I_HB1, I_HW2, I_HB2, I_HW3, I_HB3,
       I_HSF, I_HDB, I_HWOUT, I_HBOUT, I_RW, I_RB, I_WGU, I_BGU, I_WDN, I_BDN };

__device__ __forceinline__ int mod_row(int r) { return r < NLAT ? (r >> 11) : NB; }

__device__ __forceinline__ void gemm_unit_simple(const bf16_t* At, const bf16_t* Bt, f32x4 (&acc)[2][2][4][2], int wr, int wc, int fr, int fq) {
    constexpr int K = D;
#pragma unroll
    for (int a = 0; a < 2; ++a)
#pragma unroll
        for (int b = 0; b < 2; ++b)
#pragma unroll
            for (int m = 0; m < 4; ++m)
#pragma unroll
                for (int n = 0; n < 2; ++n) acc[a][b][m][n] = (f32x4){0.f, 0.f, 0.f, 0.f};
    const bf16_t* ap = At + (size_t)(wr * 64 + fr) * K + fq * 8;
    const bf16_t* bp = Bt + (size_t)(wc * 32 + fr) * K + fq * 8;
    for (int k0 = 0; k0 < K; k0 += 32) {
        bf16x8 bfr[2][2];
#pragma unroll
        for (int bj = 0; bj < 2; ++bj)
#pragma unroll
            for (int n = 0; n < 2; ++n) bfr[bj][n] = *(const bf16x8*)(bp + (size_t)(bj * 128 + n * 16) * K + k0);
#pragma unroll
        for (int ai = 0; ai < 2; ++ai)
#pragma unroll
            for (int m = 0; m < 4; ++m) {
                const bf16x8 afr = *(const bf16x8*)(ap + (size_t)(ai * 128 + m * 16) * K + k0);
#pragma unroll
                for (int bj = 0; bj < 2; ++bj)
#pragma unroll
                    for (int n = 0; n < 2; ++n) acc[ai][bj][m][n] = __builtin_amdgcn_mfma_f32_16x16x32_bf16(bfr[bj][n], afr, acc[ai][bj][m][n], 0, 0, 0);
            }
    }
}


struct Unit { int pm, pn, e; };
namespace pg8 {
constexpr int BM = 256, BK = 64, HALF = 128, HTB = HALF * BK * 2, STAGE_BYTES = 8 * HTB;
__device__ __forceinline__ int lds_byte(int r, int c) { const int st = (r >> 4) * 2 + (c >> 5), rr = r & 15, cc = c & 31, ob = rr * 64 + cc * 2; return st * 1024 + (ob ^ (((ob >> 9) & 1) << 5)); }
__device__ __forceinline__ void stage_rc(int b, int& R, int& C) { const int st = b / 1024, sb = b % 1024, swz = sb ^ (((sb >> 9) & 1) << 5); R = (st >> 1) * 16 + swz / 64; C = (st & 1) * 32 + (swz % 64) / 2; }
template <class Epi, class Sched, bool GATHER = false>
__device__ __forceinline__ void gemm_phase(LAS unsigned char* lds, const Sched& S, const Epi& E) {
    constexpr int K = D, nt = K / BK;
    const int tid = threadIdx.x, wid = __builtin_amdgcn_readfirstlane(tid >> 6), lane = tid & 63, wr = wid >> 2, wc = wid & 3, fr = lane & 15, fq = lane >> 4;
    unsigned voffA[2];
#pragma unroll
    for (int i = 0; i < 2; ++i) { int R, C; stage_rc(tid * 16 + i * 8192, R, C); voffA[i] = (unsigned)(R * K + C) * 2u; }
    const size_t kstep = (size_t)(BK * 2);
    const size_t hstep = (size_t)HALF * K * 2;
    const unsigned ldsw = (unsigned)wid * 1024u;
    const int aoff = lds_byte(wr * 64 + fr, fq * 8), boff = lds_byte(wc * 32 + fr, fq * 8);
#define PG8_SA(b, h) (((b) * 2 + (h)) * HTB)
#define PG8_SB(b, h) ((4 + (b) * 2 + (h)) * HTB)
#define PG8_STAGE(bufoff, gbase, voff) do { _Pragma("unroll") for (int _i = 0; _i < 2; ++_i) \
        __builtin_amdgcn_global_load_lds((const unsigned*)((const char*)(gbase) + (voff)[_i]), (LAS unsigned*)(lds + (bufoff) + ldsw + _i * 8192), 16, 0, 0); } while (0)
#define PG8_LDA(dst, b, h) do { _Pragma("unroll") for (int m = 0; m < 4; ++m) _Pragma("unroll") for (int k = 0; k < 2; ++k) dst[m][k] = *(const LAS bf16x8*)(lds + PG8_SA(b, h) + aoff + m * 2048 + k * 1024); } while (0)
#define PG8_LDB(dst, b, h) do { _Pragma("unroll") for (int n = 0; n < 2; ++n) _Pragma("unroll") for (int k = 0; k < 2; ++k) dst[n][k] = *(const LAS bf16x8*)(lds + PG8_SB(b, h) + boff + n * 2048 + k * 1024); } while (0)
#define PG8_MMA(ai, bj, At, Bt) do { __builtin_amdgcn_s_setprio(1); _Pragma("unroll") for (int m = 0; m < 4; ++m) _Pragma("unroll") for (int n = 0; n < 2; ++n) _Pragma("unroll") for (int k = 0; k < 2; ++k) \
        acc[ai][bj][m][n] = __builtin_amdgcn_mfma_f32_16x16x32_bf16(Bt[n][k], At[m][k], acc[ai][bj][m][n], 0, 0, 0); __builtin_amdgcn_s_setprio(0); } while (0)
#define PG8_WAIT_V(n) asm volatile("s_waitcnt vmcnt(" #n ")" ::: "memory")
#define PG8_WAIT_L(n) asm volatile("s_waitcnt lgkmcnt(" #n ")" ::: "memory")
#define PG8_BAR __builtin_amdgcn_s_barrier()
#define PG8_SCHED __builtin_amdgcn_sched_barrier(0)
    unsigned vA[2][2], vN[2][2]; unsigned gR[2], gC[2];
    const char* gA = nullptr;
    if constexpr (GATHER) {
        gA = S.a_base();
#pragma unroll
        for (int i = 0; i < 2; ++i) { gR[i] = voffA[i] / (unsigned)(K * 2); gC[i] = voffA[i] % (unsigned)(K * 2); }
        const LAS int* rw = S.rows(0);
#pragma unroll
        for (int h = 0; h < 2; ++h)
#pragma unroll
            for (int i = 0; i < 2; ++i) { vA[h][i] = (unsigned)rw[h * HALF + gR[i]] * (unsigned)(K * 2) + gC[i]; vN[h][i] = vA[h][i]; }
    }
#define PG8_STAGEA(bufoff, P, V, kt, h) do { if constexpr (GATHER) PG8_STAGE(bufoff, gA + (size_t)(kt) * kstep, V[h]); else PG8_STAGE(bufoff, (P) + (size_t)(kt) * kstep + (size_t)(h) * hstep, voffA); } while (0)
    Unit cur, nxt; int ui = 0;
    if (!S.next(0, cur)) return;
    f32x4 acc[2][2][4][2];
#pragma unroll
    for (int a = 0; a < 2; ++a)
#pragma unroll
        for (int b = 0; b < 2; ++b)
#pragma unroll
            for (int m = 0; m < 4; ++m)
#pragma unroll
                for (int n = 0; n < 2; ++n) acc[a][b][m][n] = (f32x4){0.f, 0.f, 0.f, 0.f};
    bf16x8 At[4][2], B0[2][2], B1[2][2];
    const char* cA = nullptr; if constexpr (!GATHER) cA = S.a_ptr(cur);
    const char* cB = S.b_ptr(cur);
    PG8_STAGE(PG8_SB(0, 0), cB, voffA); PG8_STAGE(PG8_SB(0, 1), cB + hstep, voffA); PG8_STAGEA(PG8_SA(0, 0), cA, vA, 0, 0); PG8_STAGEA(PG8_SA(0, 1), cA, vA, 0, 1);
    if (wr == 1) PG8_BAR;
    PG8_WAIT_V(2); PG8_BAR;
    PG8_STAGE(PG8_SB(1, 0), cB + kstep, voffA); PG8_STAGEA(PG8_SA(1, 0), cA, vA, 1, 0); PG8_STAGE(PG8_SB(1, 1), cB + hstep + kstep, voffA);
    PG8_WAIT_V(6); PG8_BAR;
    for (;;) {
        const bool has_next = S.next(ui + 1, nxt);
        const char* nA = cA; if constexpr (!GATHER) { if (has_next) nA = S.a_ptr(nxt); }
        const char* nB = has_next ? S.b_ptr(nxt) : cB;
        if constexpr (GATHER) { if (has_next) { const LAS int* rw = S.rows(ui + 1);
#pragma unroll
            for (int h = 0; h < 2; ++h)
#pragma unroll
                for (int i = 0; i < 2; ++i) vN[h][i] = (unsigned)rw[h * HALF + gR[i]] * (unsigned)(K * 2) + gC[i]; } }
        for (int t = 0; t < nt; t += 2) {
            const bool last = (t == nt - 2);
            const char* b2 = last ? nB : cB + (size_t)(t + 2) * kstep; const char* b3 = b2 + kstep;
            const char* pX = last ? nA : cA; const int kX = last ? 0 : t + 2;
            unsigned vX[2][2];
#pragma unroll
            for (int h = 0; h < 2; ++h)
#pragma unroll
                for (int i = 0; i < 2; ++i) vX[h][i] = last ? vN[h][i] : vA[h][i];
            PG8_LDB(B0, 0, 0); PG8_LDB(B1, 0, 1); PG8_SCHED; PG8_LDA(At, 0, 0); PG8_STAGEA(PG8_SA(1, 1), cA, vA, t + 1, 1);
            PG8_WAIT_V(8); PG8_WAIT_L(0); PG8_BAR; PG8_MMA(0, 0, At, B0); PG8_MMA(0, 1, At, B1); PG8_BAR; PG8_SCHED;
            PG8_LDA(At, 0, 1); PG8_STAGE(PG8_SB(0, 0), b2, voffA); PG8_STAGE(PG8_SB(0, 1), b2 + hstep, voffA); PG8_STAGEA(PG8_SA(0, 0), pX, vX, kX, 0);
            PG8_WAIT_V(8); PG8_WAIT_L(0); PG8_BAR; PG8_MMA(1, 0, At, B0); PG8_MMA(1, 1, At, B1); PG8_BAR; PG8_SCHED;
            PG8_LDB(B0, 1, 0); PG8_LDB(B1, 1, 1); PG8_SCHED; PG8_LDA(At, 1, 0); PG8_STAGEA(PG8_SA(0, 1), pX, vX, kX, 1);
            PG8_WAIT_V(8); PG8_WAIT_L(0); PG8_BAR; PG8_MMA(0, 0, At, B0); PG8_MMA(0, 1, At, B1); PG8_BAR; PG8_SCHED;
            PG8_LDA(At, 1, 1); PG8_STAGE(PG8_SB(1, 0), b3, voffA); PG8_STAGE(PG8_SB(1, 1), b3 + hstep, voffA); PG8_STAGEA(PG8_SA(1, 0), pX, vX, kX + 1, 0);
            PG8_WAIT_V(8); PG8_WAIT_L(0); PG8_BAR; PG8_MMA(1, 0, At, B0); PG8_MMA(1, 1, At, B1); PG8_BAR; PG8_SCHED;
        }
        if (wr == 0) PG8_BAR;
        E(acc, cur, wr, wc, fr, fq);
        if (!has_next) break;
#pragma unroll
        for (int a = 0; a < 2; ++a)
#pragma unroll
            for (int b = 0; b < 2; ++b)
#pragma unroll
                for (int m = 0; m < 4; ++m)
#pragma unroll
                    for (int n = 0; n < 2; ++n) acc[a][b][m][n] = (f32x4){0.f, 0.f, 0.f, 0.f};
        cur = nxt; cA = nA; cB = nB; ++ui;
        if constexpr (GATHER) {
#pragma unroll
            for (int h = 0; h < 2; ++h)
#pragma unroll
                for (int i = 0; i < 2; ++i) vA[h][i] = vN[h][i]; }
        if (wr == 1) PG8_BAR;
    }
    PG8_WAIT_V(0);
    PG8_BAR;
#undef PG8_SA
#undef PG8_SB
#undef PG8_STAGE
#undef PG8_STAGEA
#undef PG8_LDA
#undef PG8_LDB
#undef PG8_MMA
#undef PG8_WAIT_V
#undef PG8_WAIT_L
#undef PG8_BAR
#undef PG8_SCHED
}
}

template <class Epi, class Sched>
__device__ __forceinline__ void gemm_phase_simple(const Sched& S, const Epi& E) {
    const int tid = threadIdx.x, wid = __builtin_amdgcn_readfirstlane(tid >> 6), lane = tid & 63, wr = wid >> 2, wc = wid & 3, fr = lane & 15, fq = lane >> 4;
    Unit u;
    for (int i = 0; S.next(i, u); ++i) { f32x4 acc[2][2][4][2];
        gemm_unit_simple((const bf16_t*)S.a_ptr(u), (const bf16_t*)S.b_ptr(u), acc, wr, wc, fr, fq);
        E(acc, u, wr, wc, fr, fq); }
}
#ifndef FAST_GEMM
#define FAST_GEMM 1
#endif
template <class Epi, class Sched>
__device__ __forceinline__ void run_gemm(LAS unsigned char* lds, const Sched& S, const Epi& E) {
#if FAST_GEMM
    pg8::gemm_phase<Epi, Sched, false>(lds, S, E);
#else
    gemm_phase_simple<Epi, Sched>(S, E);
#endif
}
template <class Epi, class Sched>
__device__ __forceinline__ void run_gemm_gather(LAS unsigned char* lds, const Sched& S, const Epi& E) { pg8::gemm_phase<Epi, Sched, true>(lds, S, E); }
__device__ __forceinline__ bool xcd_unit(int i, int G, int c, int nM, int nN, int& pm, int& pn) {
    const int x = c & 7, s = c >> 3, nS = G >> 3;
    const int r0 = (nM * x) >> 3, r1 = (nM * (x + 1)) >> 3;
    const int q = i * nS + s; if (q >= (r1 - r0) * nN) return false;
    const int rr = q / nN; pm = r0 + rr; pn = q - rr * nN; return true;
}
struct DenseSched {
    const bf16_t* A; const bf16_t* Bt; int nM, nN, G, c;
    __device__ __forceinline__ bool next(int i, Unit& u) const { u.e = 0; return xcd_unit(i, G, c, nM, nN, u.pm, u.pn); }
    __device__ __forceinline__ const char* a_ptr(const Unit& u) const { return (const char*)(A + (size_t)u.pm * 256 * D); }
    __device__ __forceinline__ const char* b_ptr(const Unit& u) const { return (const char*)(Bt + (size_t)u.pn * 256 * D); }
};
struct QkvSched {
    const bf16_t* A; const bf16_t* Bt; int live, G, c;
    __device__ __forceinline__ bool next(int i, Unit& u) const { u.e = 0;
        if (live) return xcd_unit(i, G, c, 144, 6, u.pm, u.pn);
        const int x = c & 7, s = c >> 3, nS = G >> 3; const int nlat = 16 * 6; const int q = i * nS + s;
        if (q < nlat) { const int rr = q / 6; u.pm = 16 * x + rr; u.pn = q - rr * 6; return true; }
        const int q2 = q - nlat; if (q2 >= 4) return false; const int t = x * 4 + q2; u.pm = 128 + (t >> 1); u.pn = 4 + (t & 1); return true; }
    __device__ __forceinline__ const char* a_ptr(const Unit& u) const { return (const char*)(A + (size_t)u.pm * 256 * D); }
    __device__ __forceinline__ const char* b_ptr(const Unit& u) const { return (const char*)(Bt + (size_t)u.pn * 256 * D); }
};
struct MoeSched {
    const bf16_t* A; const bf16_t* Bt  ; const LAS unsigned char* TE; int nM, nN, N, G, c;
    __device__ __forceinline__ bool next(int i, Unit& u) const { if (!xcd_unit(i, G, c, nM, nN, u.pm, u.pn)) return false; u.e = TE[u.pm]; return true; }
    __device__ __forceinline__ const char* a_ptr(const Unit& u) const { return (const char*)(A + (size_t)u.pm * 256 * D); }
    __device__ __forceinline__ const char* b_ptr(const Unit& u) const { return (const char*)(Bt + ((size_t)u.e * N + (size_t)u.pn * 256) * D); }
};
struct MoeGatherSched {
    const bf16_t* A; const bf16_t* Bt; const LAS unsigned char* TE; const LAS int* ROWS; int nM, nN, N, G, c;
    __device__ __forceinline__ bool next(int i, Unit& u) const { if (!xcd_unit(i, G, c, nM, nN, u.pm, u.pn)) return false; u.e = TE[u.pm]; return true; }
    __device__ __forceinline__ const char* a_base() const { return (const char*)A; }
    __device__ __forceinline__ const LAS int* rows(int ui) const { return ROWS + ui * 256; }
    __device__ __forceinline__ const char* a_ptr(const Unit& u) const { return (const char*)A; }
    __device__ __forceinline__ const char* b_ptr(const Unit& u) const { return (const char*)(Bt + ((size_t)u.e * N + (size_t)u.pn * 256) * D); }
};

struct EpiQKV {
    bf16_t *Q, *Kb, *Vb; const float *qg, *kg, *cosT, *sinT;
    __device__ __forceinline__ void operator()(const f32x4 (&acc)[2][2][4][2], const Unit& uu, int wr, int wc, int fr, int fq) const {
        const int pm = uu.pm, pn = uu.pn;
        const int kind = pn < 4 ? 0 : (pn == 4 ? 1 : 2);
        const float* gain = kind == 0 ? qg : kg;
        f32x4 gv[2][2];
#pragma unroll
        for (int bj = 0; bj < 2; ++bj)
#pragma unroll
            for (int n = 0; n < 2; ++n) gv[bj][n] = *(const f32x4*)(gain + 32 * bj + 16 * n + 4 * fq);
#pragma unroll
        for (int ai = 0; ai < 2; ++ai)
#pragma unroll
            for (int m = 0; m < 4; ++m) {
                const int r = pm * 256 + ai * 128 + wr * 64 + m * 16 + fr;
                const bool lat = r < NLAT;
                const int b = lat ? (r >> 11) : ((r - NLAT) >> 8);
                const int pos = lat ? (r & (SEQ - 1)) : (SEQ + ((r - NLAT) & (CL - 1)));
                f32x4 v[2][2];
#pragma unroll
                for (int bj = 0; bj < 2; ++bj)
#pragma unroll
                    for (int n = 0; n < 2; ++n) v[bj][n] = acc[ai][bj][m][n];
                if (kind != 2) {
                    float ss = 0.f;
#pragma unroll
                    for (int bj = 0; bj < 2; ++bj)
#pragma unroll
                        for (int n = 0; n < 2; ++n) ss += (v[bj][n][0] * v[bj][n][0] + v[bj][n][1] * v[bj][n][1]) + (v[bj][n][2] * v[bj][n][2] + v[bj][n][3] * v[bj][n][3]);
                    ss += __shfl_xor(ss, 16); ss += __shfl_xor(ss, 32);
                    const float rinv = 1.0f / sqrtf(ss * (1.0f / 64.0f) + EPS);
#pragma unroll
                    for (int bj = 0; bj < 2; ++bj)
#pragma unroll
                        for (int n = 0; n < 2; ++n) v[bj][n] = v[bj][n] * rinv * gv[bj][n];
                    if (lat) {
#pragma unroll
                        for (int bj = 0; bj < 2; ++bj) {
                            const f32x4 cs = *(const f32x4*)(cosT + pos * 32 + bj * 16 + 4 * fq), sn = *(const f32x4*)(sinT + pos * 32 + bj * 16 + 4 * fq);
                            const f32x4 x1 = v[bj][0], x2 = v[bj][1];
                            v[bj][0] = x1 * cs - x2 * sn; v[bj][1] = x2 * cs + x1 * sn;
                        }
                    }
                    if (kind == 0) {
#pragma unroll
                        for (int bj = 0; bj < 2; ++bj)
#pragma unroll
                            for (int n = 0; n < 2; ++n) v[bj][n] = v[bj][n] * C2;
                    }
                }
                bf16_t* dst = kind == 0 ? Q + (size_t)r * D + pn * 256 + wc * 64
                                        : (kind == 1 ? Kb : Vb) + ((size_t)b * KVL + pos) * 256 + wc * 64;
#pragma unroll
                for (int bj = 0; bj < 2; ++bj) { u32x4 w; w.x = pk2(v[bj][0][0], v[bj][0][1]); w.y = pk2(v[bj][0][2], v[bj][0][3]); w.z = pk2(v[bj][1][0], v[bj][1][1]); w.w = pk2(v[bj][1][2], v[bj][1][3]);
                    *(u32x4*)(dst + 32 * bj + 8 * fq) = w; }
            }
    }
};
struct EpiBiasBf16 {
    bf16_t* O; int ldc; const float* bias0; int estride;
    __device__ __forceinline__ void operator()(const f32x4 (&acc)[2][2][4][2], const Unit& uu, int wr, int wc, int fr, int fq) const {
        const int row0 = uu.pm * 256, col0t = uu.pn * 256;
#pragma unroll
        for (int bj = 0; bj < 2; ++bj) {
            const int c = col0t + bj * 128 + wc * 32 + 8 * fq;
            const float* bp = bias0 + (size_t)uu.e * estride + c; const f32x4 b0 = *(const f32x4*)bp, b1 = *(const f32x4*)(bp + 4);
#pragma unroll
            for (int ai = 0; ai < 2; ++ai)
#pragma unroll
                for (int m = 0; m < 4; ++m) { const int r = row0 + ai * 128 + wr * 64 + m * 16 + fr; const f32x4 v0 = acc[ai][bj][m][0] + b0, v1 = acc[ai][bj][m][1] + b1;
                    u32x4 w; w.x = pk2(v0[0], v0[1]); w.y = pk2(v0[2], v0[3]); w.z = pk2(v1[0], v1[1]); w.w = pk2(v1[2], v1[3]); *(u32x4*)(O + (size_t)r * ldc + c) = w; }
        }
    }
};
template <bool SRC32> struct EpiResid {
    const float *srcL, *srcC; bf16_t* XB; const float* gate  ; const float* bias;
    __device__ __forceinline__ void operator()(f32x4 (&acc)[2][2][4][2], const Unit& uu, int wr, int wc, int fr, int fq) const {
        const int row0 = uu.pm * 256, col0t = uu.pn * 256;
        const float* gp0 = gate + (size_t)mod_row(row0) * MODW;
        const float* sb = row0 < NLAT ? srcL + (size_t)row0 * D : srcC + (size_t)(row0 - NLAT) * D;
        bf16_t* xb = XB + (size_t)row0 * D;
#pragma unroll
        for (int bj = 0; bj < 2; ++bj) {
            const int c = col0t + bj * 128 + wc * 32 + 8 * fq;
            const f32x4 g0 = *(const f32x4*)(gp0 + c), g1 = *(const f32x4*)(gp0 + c + 4);
            f32x4 b0 = (f32x4){0.f, 0.f, 0.f, 0.f}, b1 = b0; if (bias) { b0 = *(const f32x4*)(bias + c); b1 = *(const f32x4*)(bias + c + 4); }
#pragma unroll
            for (int ai = 0; ai < 2; ++ai) {
                f32x4 x0[4], x1[4];
#pragma unroll
                for (int m = 0; m < 4; ++m) { const size_t ro = (size_t)(ai * 128 + wr * 64 + m * 16 + fr) * D + c;
                    if constexpr (SRC32) { x0[m] = *(const f32x4*)(sb + ro); x1[m] = *(const f32x4*)(sb + ro + 4); }
                    else { const u32x4 w = *(const u32x4*)(xb + ro); x0[m] = (f32x4){bflo(w.x), bfhi(w.x), bflo(w.y), bfhi(w.y)}; x1[m] = (f32x4){bflo(w.z), bfhi(w.z), bflo(w.w), bfhi(w.w)}; } }
#pragma unroll
                for (int m = 0; m < 4; ++m) { const size_t ro = (size_t)(ai * 128 + wr * 64 + m * 16 + fr) * D + c;
                    const f32x4 y0 = x0[m] + g0 * (acc[ai][bj][m][0] + b0), y1 = x1[m] + g1 * (acc[ai][bj][m][1] + b1);
                    u32x4 w; w.x = pk2(y0[0], y0[1]); w.y = pk2(y0[2], y0[3]); w.z = pk2(y1[0], y1[1]); w.w = pk2(y1[2], y1[3]); *(u32x4*)(xb + ro) = w; }
                asm volatile("" ::: "memory");
            }
        }
    }
};
struct EpiSwiglu {
    bf16_t* O; const float* bgu0  ;
    __device__ __forceinline__ void operator()(const f32x4 (&acc)[2][2][4][2], const Unit& uu, int wr, int wc, int fr, int fq) const {
        const int row0 = uu.pm * 256, pn = uu.pn; const float* bgu = bgu0 + (size_t)uu.e * NGU;
        const int f = pn * 128 + wc * 32 + 8 * fq;
        f32x4 bg[2], bu[2];
#pragma unroll
        for (int n = 0; n < 2; ++n) { const f32x4 q0 = *(const f32x4*)(bgu + 2 * (f + 4 * n)), q1 = *(const f32x4*)(bgu + 2 * (f + 4 * n) + 4);
            bg[n] = (f32x4){q0[0], q0[2], q1[0], q1[2]}; bu[n] = (f32x4){q0[1], q0[3], q1[1], q1[3]}; }
#pragma unroll
        for (int ai = 0; ai < 2; ++ai)
#pragma unroll
            for (int m = 0; m < 4; ++m) { const int r = row0 + ai * 128 + wr * 64 + m * 16 + fr; float o[8];
#pragma unroll
                for (int n = 0; n < 2; ++n) { const f32x4 gg = acc[ai][0][m][n] + bg[n], uq = acc[ai][1][m][n] + bu[n];
#pragma unroll
                    for (int p = 0; p < 2; ++p) {
                        f32x2 g2 = {fminf(gg[2 * p], 7.0f), fminf(gg[2 * p + 1], 7.0f)};
                        f32x2 u2 = {__builtin_amdgcn_fmed3f(uq[2 * p], -7.0f, 7.0f), __builtin_amdgcn_fmed3f(uq[2 * p + 1], -7.0f, 7.0f)};
                        const f32x2 z = g2 * (-2.4554669595930157f);
                        f32x2 e2 = {__builtin_amdgcn_exp2f(z.x), __builtin_amdgcn_exp2f(z.y)};
                        e2 = e2 + 1.0f;
                        const f32x2 r2 = {__builtin_amdgcn_rcpf(e2.x), __builtin_amdgcn_rcpf(e2.y)};
                        const f32x2 o2 = ((u2 + 1.0f) * g2) * r2;
                        o[4 * n + 2 * p] = o2.x; o[4 * n + 2 * p + 1] = o2.y; } }
                u32x4 w; w.x = pk2(o[0], o[1]); w.y = pk2(o[2], o[3]); w.z = pk2(o[4], o[5]); w.w = pk2(o[6], o[7]); *(u32x4*)(O + (size_t)r * D + f) = w; }
    }
};

__device__ __forceinline__ int slot32(int cg) { return (((cg >> 2) & 1) << 4) + ((cg >> 3) << 2) + (cg & 3); }
template <int MODE> __device__ __forceinline__ int wrow_map(int n) {
    if (MODE == 0) return (n & ~31) + slot32(n & 31);
    if (MODE == 1) { const int pn = n >> 8, wc = (n >> 6) & 3, bj = (n >> 5) & 1, j = n & 31;
        return (pn << 8) + (bj << 7) + (wc << 5) + (pn < 5 ? j : slot32(j)); }
    { const int f = n >> 1, pn = f >> 7, fo = f & 127; return (pn << 8) + ((n & 1) << 7) + (fo & ~31) + slot32(fo & 31); }
}
template <int MODE> __device__ __forceinline__ void transpose_item(const float* W, int N, bf16_t* WT, LAS float* scr, int item, int lane) {
    constexpr int K = D;
    const int nblk = N / 32, kb = item / nblk, nb = item % nblk, k0 = 64 * kb, n0 = 32 * nb;
#pragma unroll 8
    for (int i = 0; i < 32; ++i) { const int kk = 2 * i + (lane >> 5); scr[kk * 33 + (lane & 31)] = __builtin_nontemporal_load(W + (size_t)(k0 + kk) * N + n0 + (lane & 31)); }
    LDS_WAIT(); asm volatile("" ::: "memory");
    const int c = lane & 7;
#pragma unroll
    for (int j = 0; j < 4; ++j) { const int n = (lane >> 3) + 8 * j; const LAS float* s = scr + (8 * c) * 33 + n;
        u32x4 o; o.x = pk2(s[0 * 33], s[1 * 33]); o.y = pk2(s[2 * 33], s[3 * 33]); o.z = pk2(s[4 * 33], s[5 * 33]); o.w = pk2(s[6 * 33], s[7 * 33]);
        __builtin_nontemporal_store(o, (u32x4*)(WT + (size_t)wrow_map<MODE>(n0 + n) * K + k0 + 8 * c)); }
    LDS_WAIT(); asm volatile("" ::: "memory");
}

__device__ __forceinline__ void norm_mod_store(const f32x4 (&v)[4], const f32x4 (&gs)[4], const f32x4 (&sh)[4], bf16_t* dst, int lane, f32x4 (&h)[4]) {
    float ss = 0.f;
#pragma unroll
    for (int j = 0; j < 4; ++j) ss += (v[j][0] * v[j][0] + v[j][1] * v[j][1]) + (v[j][2] * v[j][2] + v[j][3] * v[j][3]);
    ss = wave_sum(ss);
    const float rinv = __builtin_amdgcn_rsqf(ss * (1.0f / D) + EPS);
#pragma unroll
    for (int j = 0; j < 4; ++j) {
        h[j] = (v[j] * rinv) * gs[j] + sh[j];
        u32x2 w; w.x = pk2(h[j][0], h[j][1]); w.y = pk2(h[j][2], h[j][3]);
        ((u32x2*)dst)[lane + 64 * j] = w;
    }
}
__device__ __forceinline__ void load_vec_bf(const bf16_t* p, int lane, f32x4 (&v)[4]) {
#pragma unroll
    for (int j = 0; j < 4; ++j) { const u32x2 w = ((const u32x2*)p)[lane + 64 * j]; v[j] = (f32x4){bflo(w.x), bfhi(w.x), bflo(w.y), bfhi(w.y)}; }
}
__device__ __forceinline__ void load_vec(const float* p, int lane, f32x4 (&v)[4]) {
#pragma unroll
    for (int j = 0; j < 4; ++j) v[j] = ((const f32x4*)p)[lane + 64 * j];
}


namespace attn_body {
using bf16=__hip_bfloat16;
using bf16x8=__attribute__((ext_vector_type(8)))short;
using s16x4=__attribute__((ext_vector_type(4)))short;
using f32x16=__attribute__((ext_vector_type(16)))float;
using u32x4=__attribute__((ext_vector_type(4)))unsigned;
constexpr int D=64,DM=1024,KVP=256;
constexpr int NW=8,QBLK=32,QB=QBLK*NW,KVBLK=64;
__device__ __forceinline__ int crow(int r,int hi){return (r&3)+8*(r>>2)+4*hi;}
#define SBAR() __builtin_amdgcn_sched_barrier(0)
__device__ __forceinline__ void cmask(f32x16&p0,f32x16&p1,int jb,int qrel,int hi){
  const float NEG=-INFINITY; int kb=64*jb+4*hi;
  #pragma unroll
  for(int r=0;r<16;++r){int kv=kb+(r&3)+8*(r>>2); if(kv>qrel)p0[r]=NEG; if(kv+32>qrel)p1[r]=NEG;}
}

constexpr int NSLOT=3, SLOTB=8192;
constexpr int LDS_K=0, LDS_V=NSLOT*SLOTB, LDS_WS=2*NSLOT*SLOTB, LDS_OST=LDS_WS+NW*64*4, LDS_BYTES=LDS_OST+NW*4096;
constexpr float C2=0.125f*1.4426950408889634f;
__device__ __forceinline__ void glds16(const void*gsrc,unsigned lds_dst){unsigned keep;
  asm volatile("s_mov_b32 %0, m0\n\ts_mov_b32 m0, %2\n\ts_nop 0\n\tglobal_load_lds_dwordx4 %1, off\n\ts_mov_b32 m0, %0":"=&s"(keep):"v"(gsrc),"s"(lds_dst):"memory");}
__device__ __forceinline__ float max3f(float a,float b,float c){float r;asm("v_max3_f32 %0, %1, %2, %3":"=v"(r):"v"(a),"v"(b),"v"(c));return r;}
__device__ __forceinline__ float max2f(float a,float b){float r;asm("v_max_f32_e32 %0, %1, %2":"=v"(r):"v"(a),"v"(b));return r;}
__device__ __forceinline__ float fadd_s(float a,float b){float r;asm("v_add_f32_e32 %0, %1, %2":"=v"(r):"v"(a),"v"(b));return r;}
__device__ __forceinline__ float fsub_s(float a,float b){float r;asm("v_sub_f32_e32 %0, %1, %2":"=v"(r):"v"(a),"v"(b));return r;}
typedef float f32x2_t __attribute__((ext_vector_type(2))); typedef __bf16 bf16x2_t __attribute__((ext_vector_type(2)));
__device__ __forceinline__ unsigned cvtpk_s(float lo,float hi){f32x2_t v={lo,hi};bf16x2_t b=__builtin_convertvector(v,bf16x2_t);return __builtin_bit_cast(unsigned,b);}
#define WAIT_BAR(N) asm volatile("s_waitcnt vmcnt(" #N ") lgkmcnt(0)\n\ts_barrier":::"memory")

__device__ __forceinline__ void qkt(f32x16&p0,f32x16&p1,const char*Kslot,const bf16x8*qr,const f32x16&negm,int r32,int hi){
  const char*kb=Kslot+hi*1024+r32*16;
  #pragma unroll
  for(int d0=0;d0<4;++d0){
    const bf16x8 b0=*reinterpret_cast<const bf16x8*>(kb+d0*2048);
    const bf16x8 b1=*reinterpret_cast<const bf16x8*>(kb+d0*2048+512);
    if(d0==0){p0=__builtin_amdgcn_mfma_f32_32x32x16_bf16(b0,qr[0],negm,0,0,0);p1=__builtin_amdgcn_mfma_f32_32x32x16_bf16(b1,qr[0],negm,0,0,0);}
    else{p0=__builtin_amdgcn_mfma_f32_32x32x16_bf16(b0,qr[d0],p0,0,0,0);p1=__builtin_amdgcn_mfma_f32_32x32x16_bf16(b1,qr[d0],p1,0,0,0);}}
}
typedef __attribute__((address_space(3))) const char* lds_cptr;
typedef short v4i16_t __attribute__((ext_vector_type(4)));
__device__ __forceinline__ void kload8(bf16x8*kf,lds_cptr kp){
  kf[0]=*(const __attribute__((address_space(3))) bf16x8*)(kp);      kf[1]=*(const __attribute__((address_space(3))) bf16x8*)(kp+512);
  kf[2]=*(const __attribute__((address_space(3))) bf16x8*)(kp+2048); kf[3]=*(const __attribute__((address_space(3))) bf16x8*)(kp+2560);
  kf[4]=*(const __attribute__((address_space(3))) bf16x8*)(kp+4096); kf[5]=*(const __attribute__((address_space(3))) bf16x8*)(kp+4608);
  kf[6]=*(const __attribute__((address_space(3))) bf16x8*)(kp+6144); kf[7]=*(const __attribute__((address_space(3))) bf16x8*)(kp+6656);
}
__device__ __forceinline__ void kload2(bf16x8*kf,lds_cptr kp,int j){ kf[2*j]=*(const __attribute__((address_space(3))) bf16x8*)(kp+j*2048); kf[2*j+1]=*(const __attribute__((address_space(3))) bf16x8*)(kp+j*2048+512); }
__device__ __forceinline__ s16x4 vtr(lds_cptr p){ return __builtin_bit_cast(s16x4,__builtin_amdgcn_ds_read_tr16_b64_v4i16((__attribute__((address_space(3))) v4i16_t*)p)); }
__device__ __forceinline__ float rowmax(const f32x16&p0,const f32x16&p1){
  float a=max3f(p0[0],p0[1],p1[0]),b=max3f(p0[2],p0[3],p1[1]);a=max3f(a,p1[2],p1[3]);
  #pragma unroll
  for(int r=4;r<16;r+=4){a=max3f(a,p0[r],p0[r+1]);b=max3f(b,p0[r+2],p0[r+3]);a=max3f(a,p1[r],p1[r+1]);b=max3f(b,p1[r+2],p1[r+3]);}
  const float m=max2f(a,b);
  auto rr=__builtin_amdgcn_permlane32_swap(__float_as_uint(m),__float_as_uint(m),false,false);
  return max2f(__uint_as_float(rr[0]),__uint_as_float(rr[1]));
}
__device__ __forceinline__ void pv(f32x16*o,int vb,bf16x8 pa0,bf16x8 pa1,bf16x8 pa2,bf16x8 pa3){
  #pragma unroll
  for(int d0=0;d0<2;++d0){s16x4 lo[4],hi[4];
    #pragma unroll
    for(int ks=0;ks<4;++ks){
      asm volatile("ds_read_b64_tr_b16 %0,%1 offset:%c2":"=&v"(lo[ks]):"v"(vb),"i"(d0*4096+ks*1024):"memory");
      asm volatile("ds_read_b64_tr_b16 %0,%1 offset:%c2":"=&v"(hi[ks]):"v"(vb),"i"(d0*4096+ks*1024+512):"memory");}
    asm volatile("s_waitcnt lgkmcnt(0)":::"memory");SBAR();
    #define PK(k) (bf16x8){lo[k][0],lo[k][1],lo[k][2],lo[k][3],hi[k][0],hi[k][1],hi[k][2],hi[k][3]}
    o[d0]=__builtin_amdgcn_mfma_f32_32x32x16_bf16(pa0,PK(0),o[d0],0,0,0);
    o[d0]=__builtin_amdgcn_mfma_f32_32x32x16_bf16(pa1,PK(1),o[d0],0,0,0);
    o[d0]=__builtin_amdgcn_mfma_f32_32x32x16_bf16(pa2,PK(2),o[d0],0,0,0);
    o[d0]=__builtin_amdgcn_mfma_f32_32x32x16_bf16(pa3,PK(3),o[d0],0,0,0);
    #undef PK
  }
}

#ifndef ATTN_STORE16
#define ATTN_STORE16(p,v) (*(u32x4*)(p)=(v))
#endif
template<int THRL> __device__ __forceinline__ void attn_unit(const bf16*Qu,const bf16*__restrict__ Kh,const bf16*__restrict__ Vh,bf16*Ou,const int NT,char*shm){
  const int tid=threadIdx.x,lane=tid&63,r32=lane&31,hi=lane>>5; const int wid=__builtin_amdgcn_readfirstlane(tid>>6);
  const bf16*Qw=Qu+(long)(wid*QBLK)*DM;
  const unsigned lds0=(unsigned)(uintptr_t)shm;
  float*wsf=(float*)(shm+LDS_WS)+wid*64;
  const bf16*ksrc=Kh+(long)lane*KVP+wid*8;
  const bf16*vsrc=Vh+(long)(16*(wid&3)+(lane>>2))*KVP+(wid>>2)*32+(lane&3)*8;
  const unsigned kdst=lds0+LDS_K+wid*1024, vdst=lds0+LDS_V+wid*1024;
  #define DMA_K(t,slot) glds16(ksrc+(long)(t)*KVBLK*KVP,(unsigned)__builtin_amdgcn_readfirstlane(kdst+(slot)))
  #define DMA_V(t,slot) glds16(vsrc+(long)(t)*KVBLK*KVP,(unsigned)__builtin_amdgcn_readfirstlane(vdst+(slot)))
  const int vb0=(int)(lds0+LDS_V)+((lane>>4)&1)*32+(lane&3)*8+(4*hi+((lane&15)>>2))*64;
  const char*Kbase=shm+LDS_K; bf16x8 kf[8];
  const lds_cptr shm3=(lds_cptr)shm; const lds_cptr kp0=shm3+LDS_K+hi*1024+r32*16; const lds_cptr vp0=shm3+LDS_V+((lane>>4)&1)*32+(lane&3)*8+(4*hi+((lane&15)>>2))*64;
  DMA_K(0,0);DMA_V(0,0);DMA_K(1,SLOTB);
  bf16x8 qr[4];
  #pragma unroll
  for(int d0=0;d0<4;++d0)qr[d0]=*reinterpret_cast<const bf16x8*>(&Qw[(long)r32*DM+d0*16+hi*8]);
  float mhat=0.f,l_reg=0.f;f32x16 o[2];o[0]=f32x16{};o[1]=f32x16{};f32x16 negm=f32x16{};asm volatile("":"+v"(negm));
  #define CMASK(P0,P1,t) do{}while(0)
  bool resc=false;
  #define START(P0,P1) do{ const float rm=rowmax(P0,P1); resc=false; \
    { const float dl=rm; mhat=fadd_s(mhat,dl); \
      _Pragma("unroll") for(int r=0;r<16;++r){P0[r]=fsub_s(P0[r],dl);P1[r]=fsub_s(P1[r],dl);} \
      _Pragma("unroll") for(int r=0;r<16;++r)negm[r]=-mhat; asm volatile("":"+v"(negm)); } \
    _Pragma("unroll") for(int r=0;r<16;++r)P0[r]=__builtin_amdgcn_exp2f(P0[r]); }while(0)
  #define RESC() do{ if(resc){ asm volatile("s_waitcnt lgkmcnt(0)":::"memory"); \
      _Pragma("unroll") for(int d_=0;d_<2;++d_) _Pragma("unroll") for(int r=0;r<16;++r)o[d_][r]*=wsf[crow(r,hi)]; } }while(0)
  f32x16 pA0,pA1,pB0,pB1;
  int sl_prev=0,sl_cur=0,sl_next=SLOTB;
  #define ROT() do{sl_prev=sl_cur;sl_cur=sl_next;sl_next=(sl_next==(NSLOT-1)*SLOTB)?0:sl_next+SLOTB;}while(0)
  DMA_K(2,2*SLOTB);
  WAIT_BAR(3);
  qkt(pA0,pA1,Kbase,qr,negm,r32,hi);asm volatile("s_nop 15\n\ts_nop 7":"+v"(pA0),"+v"(pA1));CMASK(pA0,pA1,0);
  START(pA0,pA1);
  _Pragma("unroll") for(int r=0;r<16;++r)pA1[r]=__builtin_amdgcn_exp2f(pA1[r]);
  WAIT_BAR(0);
  DMA_K(3,0);DMA_V(1,SLOTB);
  ROT();
  kload8(kf,kp0+sl_cur);
  WAIT_BAR(2);
  s16x4 vlo[8],vhi[8]; u32x4 pw0,pw1,pw2,pw3;
  #define PKW(P,B) cvtpk_s(P[B],P[B+1])
  #define PAF(k) __builtin_bit_cast(bf16x8,pw##k)
  #define VFR(i) (bf16x8){vlo[i][0],vlo[i][1],vlo[i][2],vlo[i][3],vhi[i][0],vhi[i][1],vhi[i][2],vhi[i][3]}
  #define PIN(x) asm volatile("":"+v"(x))
  #define MX3(a,b,c) __builtin_fmaxf(__builtin_fmaxf((a),(b)),(c))
  #define GAPA(MF,A0,A1,A2,A3,W0,W1,PW) do{ MF; sacc+=A0; sacc+=A1; sacc+=A2; sacc+=A3; PIN(sacc); W0; W1; PIN(PW); SBAR(); }while(0)
  #define EX(v) __builtin_amdgcn_exp2f(v)
  #define GAPB(MF,X,B) do{ MF; X[B]=EX(X[B]); X[B+1]=EX(X[B+1]); X[B+2]=EX(X[B+2]); X[B+3]=EX(X[B+3]); PIN(X); SBAR(); }while(0)
  #define VRD(i) do{ vlo[i]=vtr(vp_+(((i)>>2)*4096+((i)&3)*1024)); vhi[i]=vtr(vp_+(((i)>>2)*4096+((i)&3)*1024+512)); }while(0)
  #define KRD(G,j) do{ if(G){ kload2(kf,kp0+sl_next,j); SBAR(); } }while(0)
  #define STEP(C0,C1,P0,P1,t,GK,GV,GL) do{ SBAR(); \
    const lds_cptr vp_=vp0+sl_prev; \
    VRD(0); SBAR(); float sacc=(P0[0]+P0[1]); \
    GAPA(C0=__builtin_amdgcn_mfma_f32_32x32x16_bf16(kf[0],qr[0],negm,0,0,0), P0[2],P0[3],P0[4],P0[5],     pw0[0]=PKW(P0,0), pw0[1]=PKW(P0,2), pw0); \
    VRD(4); SBAR(); GAPA(C1=__builtin_amdgcn_mfma_f32_32x32x16_bf16(kf[1],qr[0],negm,0,0,0), P0[6],P0[7],P0[8],P0[9],     pw0[2]=PKW(P0,4), pw0[3]=PKW(P0,6), pw0); \
    VRD(1); SBAR(); GAPA(C0=__builtin_amdgcn_mfma_f32_32x32x16_bf16(kf[2],qr[1],C0,0,0,0),   P0[10],P0[11],P0[12],P0[13], pw1[0]=PKW(P0,8), pw1[1]=PKW(P0,10), pw1); \
    VRD(5); SBAR(); GAPA(C1=__builtin_amdgcn_mfma_f32_32x32x16_bf16(kf[3],qr[1],C1,0,0,0),   P0[14],P0[15],P1[0],P1[1],   pw1[2]=PKW(P0,12),pw1[3]=PKW(P0,14), pw1); \
    VRD(2); SBAR(); GAPA(C0=__builtin_amdgcn_mfma_f32_32x32x16_bf16(kf[4],qr[2],C0,0,0,0),   P1[2],P1[3],P1[4],P1[5],     pw2[0]=PKW(P1,0), pw2[1]=PKW(P1,2), pw2); \
    VRD(6); SBAR(); GAPA(C1=__builtin_amdgcn_mfma_f32_32x32x16_bf16(kf[5],qr[2],C1,0,0,0),   P1[6],P1[7],P1[8],P1[9],     pw2[2]=PKW(P1,4), pw2[3]=PKW(P1,6), pw2); \
    VRD(3); SBAR(); GAPA(C0=__builtin_amdgcn_mfma_f32_32x32x16_bf16(kf[6],qr[3],C0,0,0,0),   P1[10],P1[11],P1[12],P1[13], pw3[0]=PKW(P1,8), pw3[1]=PKW(P1,10), pw3); \
    VRD(7); SBAR(); GAPA(C1=__builtin_amdgcn_mfma_f32_32x32x16_bf16(kf[7],qr[3],C1,0,0,0),   P1[14],P1[15],0.f,0.f,       pw3[2]=PKW(P1,12),pw3[3]=PKW(P1,14), pw3); \
    l_reg+=sacc; \
    if(GK){DMA_K((t)+3,sl_cur);} if(GV){DMA_V((t)+1,sl_next);} \
    CMASK(C0,C1,t); \
    { float a=MX3(C0[0],C0[1],C1[0]),b=MX3(C0[2],C0[3],C1[1]); a=MX3(a,C1[2],C1[3]); \
      _Pragma("unroll") for(int r=4;r<16;r+=4){a=MX3(a,C0[r],C0[r+1]);b=MX3(b,C0[r+2],C0[r+3]);a=MX3(a,C1[r],C1[r+1]);b=MX3(b,C1[r+2],C1[r+3]);} \
      float rm=__builtin_fmaxf(a,b); { auto rr=__builtin_amdgcn_permlane32_swap(__float_as_uint(rm),__float_as_uint(rm),false,false); rm=__builtin_fmaxf(__uint_as_float(rr[0]),__uint_as_float(rr[1])); } \
      resc=false; \
      if(__builtin_expect(__any(rm>(float)THRL),0)){ const float dl=__builtin_fmaxf(rm,0.f); mhat+=dl; \
        _Pragma("unroll") for(int r=0;r<16;++r){C0[r]-=dl;C1[r]-=dl;} \
        _Pragma("unroll") for(int r=0;r<16;++r)negm[r]=-mhat; asm volatile("":"+v"(negm)); \
        const float f=__builtin_amdgcn_exp2f(-dl); l_reg*=f; if(hi==0)wsf[r32]=f; resc=true; } } \
    SBAR(); \
    GAPB(o[0]=__builtin_amdgcn_mfma_f32_32x32x16_bf16(PAF(0),VFR(0),o[0],0,0,0), C0,0); \
    GAPB(o[1]=__builtin_amdgcn_mfma_f32_32x32x16_bf16(PAF(0),VFR(4),o[1],0,0,0), C0,4); \
    KRD(GL,0); GAPB(o[0]=__builtin_amdgcn_mfma_f32_32x32x16_bf16(PAF(1),VFR(1),o[0],0,0,0), C0,8); \
    KRD(GL,1); GAPB(o[1]=__builtin_amdgcn_mfma_f32_32x32x16_bf16(PAF(1),VFR(5),o[1],0,0,0), C0,12); \
    KRD(GL,2); GAPB(o[0]=__builtin_amdgcn_mfma_f32_32x32x16_bf16(PAF(2),VFR(2),o[0],0,0,0), C1,0); \
    KRD(GL,3); GAPB(o[1]=__builtin_amdgcn_mfma_f32_32x32x16_bf16(PAF(2),VFR(6),o[1],0,0,0), C1,4); \
    GAPB(o[0]=__builtin_amdgcn_mfma_f32_32x32x16_bf16(PAF(3),VFR(3),o[0],0,0,0), C1,8); \
    GAPB(o[1]=__builtin_amdgcn_mfma_f32_32x32x16_bf16(PAF(3),VFR(7),o[1],0,0,0), C1,12); \
    }while(0)
  int t=1;
  #undef CMASK
  #define CMASK(P0,P1,t) do{}while(0)
  for(;t+5<NT;t+=2){
    STEP(pB0,pB1,pA0,pA1,t,true,true,true);     WAIT_BAR(2); RESC(); ROT();
    STEP(pA0,pA1,pB0,pB1,t+1,true,true,true);   WAIT_BAR(2); RESC(); ROT();
  }
  #undef CMASK
  #define CMASK(P0,P1,t) do{}while(0)
  #define ENDW(tt) do{ if((tt)+3<NT){WAIT_BAR(2);} else if((tt)+2<NT){WAIT_BAR(1);} else {WAIT_BAR(0);} }while(0)
  for(;t+1<NT;t+=2){
    STEP(pB0,pB1,pA0,pA1,t,(t+3<NT),(t+1<NT),(t+1<NT));       ENDW(t);   RESC(); ROT();
    STEP(pA0,pA1,pB0,pB1,t+1,(t+4<NT),(t+2<NT),(t+2<NT));     ENDW(t+1); RESC(); ROT();
  }
  STEP(pB0,pB1,pA0,pA1,NT-1,false,false,false); RESC();
  { float sacc=pB0[0]+pB0[1]; _Pragma("unroll") for(int r=2;r<16;++r)sacc+=pB0[r]; _Pragma("unroll") for(int r=0;r<16;++r)sacc+=pB1[r]; l_reg+=sacc;
    pw0=(u32x4){PKW(pB0,0),PKW(pB0,2),PKW(pB0,4),PKW(pB0,6)};pw1=(u32x4){PKW(pB0,8),PKW(pB0,10),PKW(pB0,12),PKW(pB0,14)};pw2=(u32x4){PKW(pB1,0),PKW(pB1,2),PKW(pB1,4),PKW(pB1,6)};pw3=(u32x4){PKW(pB1,8),PKW(pB1,10),PKW(pB1,12),PKW(pB1,14)};
    SBAR(); pv(o,vb0+sl_cur,PAF(0),PAF(1),PAF(2),PAF(3)); }
  #undef PKW
  #undef PAF
  #undef VFR
  #undef PIN
  #undef MX3
  #undef GAPA
  #undef GAPB
  #undef EX
  #undef VRD
  #undef KRD
  #undef STEP
  #undef ENDW
  {auto rr=__builtin_amdgcn_permlane32_swap(__float_as_uint(l_reg),__float_as_uint(l_reg),false,false);l_reg=__uint_as_float(rr[0])+__uint_as_float(rr[1]);}
  if(hi==0)wsf[32+r32]=l_reg;asm volatile("s_waitcnt lgkmcnt(0)":::"memory");
  float rli[16];
  #pragma unroll
  for(int r=0;r<16;++r)rli[r]=__builtin_amdgcn_rcpf(wsf[32+crow(r,hi)]);
  bf16*Ow=Ou+(long)(wid*QBLK)*DM;
  { bf16*stg=(bf16*)(shm+LDS_OST)+wid*2048;
    #pragma unroll
    for(int r=0;r<16;++r){const int orow=crow(r,hi);
      #pragma unroll
      for(int d0=0;d0<2;++d0)stg[orow*64+d0*32+r32]=__float2bfloat16(o[d0][r]*rli[r]);}
    asm volatile("s_waitcnt lgkmcnt(0)":::"memory");
    #pragma unroll
    for(int i=0;i<4;++i){const int row=i*8+(lane>>3),ch=lane&7; const u32x4 v=*(const u32x4*)(stg+row*64+ch*8); ATTN_STORE16(Ow+(long)row*DM+ch*8,v);} }
  asm volatile("s_waitcnt lgkmcnt(0)\n\ts_barrier":::"memory");
  #undef DMA_K
  #undef DMA_V
  #undef CMASK
  #undef START
  #undef RESC
  #undef ROT
}
constexpr int ATTN_LDS_BYTES=LDS_BYTES;
#undef SBAR
#undef WAIT_BAR
}

template <int LF>
__device__ __forceinline__ void conv_channel(LAS unsigned char* lds, const bf16_t* FIc, const bf16_t* wsrc, bf16_t* ydst, int tid, int lane, int wv) {
    constexpr int IPW = LF / 256, NBK = LF / 32, P = 2 * LF + 8, WSTR = LF + 8;
    LAS unsigned char* FIL = lds; LAS unsigned char* WL = lds + ((8 * P * 2 + 255) & ~255);
    __syncthreads();
    { const u32x4* fs = (const u32x4*)FIc; for (int i = tid; i < 8 * P * 2 / 16; i += NTHR) ((LAS u32x4*)FIL)[i] = fs[i]; }
    for (int i = tid; i < NB * (LF / 8); i += NTHR) { const int b = i / (LF / 8), ch = i % (LF / 8); *(LAS u32x4*)(WL + b * (WSTR * 2) + ch * 16) = *(const u32x4*)(wsrc + (size_t)b * LF + ch * 8); }
    __syncthreads();
    f32x4 acc[IPW][2]; bf16x8 Bw[IPW];
#pragma unroll
    for (int ii = 0; ii < IPW; ++ii) { acc[ii][0] = (f32x4){0.f, 0.f, 0.f, 0.f}; acc[ii][1] = (f32x4){0.f, 0.f, 0.f, 0.f}; Bw[ii] = (bf16x8){0, 0, 0, 0, 0, 0, 0, 0}; }
    const int rr = lane & 15, q = lane >> 4;
    const int aBase = (rr & 7) * (P * 2) + 2 * (LF - (rr - (rr & 7)) + 8 * q);
    const int bBase = rr * (WSTR * 2) + 16 * q;
#define CONV_STEPS(CHECK) do { _Pragma("unroll") for (int dd = 0; dd < IPW; ++dd) { \
        const int delta = IPW * d + dd; \
        const bf16x8 a0 = *(const LAS bf16x8*)(FIL + aBase - 64 * delta), a1 = *(const LAS bf16x8*)(FIL + aBase - 64 * delta - 32); \
        const int jn = IPW * (wv - d) - dd; \
        if (!(CHECK) || (jn >= 0 && jn < NBK)) Bw[(IPW - dd) % IPW] = *(const LAS bf16x8*)(WL + bBase + 64 * jn); \
        _Pragma("unroll") for (int ii = 0; ii < IPW; ++ii) { const int j = IPW * (wv - d) + ii - dd; \
            if (!(CHECK) || (j >= 0 && j < NBK)) { \
                acc[ii][0] = __builtin_amdgcn_mfma_f32_16x16x32_bf16(a0, Bw[(ii - dd + IPW) % IPW], acc[ii][0], 0, 0, 0); \
                acc[ii][1] = __builtin_amdgcn_mfma_f32_16x16x32_bf16(a1, Bw[(ii - dd + IPW) % IPW], acc[ii][1], 0, 0, 0); } } } } while (0)
    { const int d = wv - 8; CONV_STEPS(true); }
    for (int d = wv - 7; d < wv; ++d) { CONV_STEPS(false); }
    { const int d = wv; CONV_STEPS(true); }
#undef CONV_STEPS
#pragma unroll
    for (int ii = 0; ii < IPW; ++ii)
#pragma unroll
        for (int h = 0; h < 2; ++h) { u32x2 w; w.x = pk2(acc[ii][h][0], acc[ii][h][1]); w.y = pk2(acc[ii][h][2], acc[ii][h][3]);
            *(u32x2*)(ydst + (size_t)rr * LF + 32 * (IPW * wv + ii) + 16 * h + 4 * q) = w; }
}


__device__ __forceinline__ void route_reduce(float (&p)[32], int lane) {
#pragma unroll
    for (int i = 0; i < 16; ++i) { const bool up = (lane & 32) != 0; const float send = up ? p[i] : p[i + 16], keep = up ? p[i + 16] : p[i]; p[i] = keep + __shfl_xor(send, 32); }
#pragma unroll
    for (int i = 0; i < 8; ++i) { const bool up = (lane & 16) != 0; const float send = up ? p[i] : p[i + 8], keep = up ? p[i + 8] : p[i]; p[i] = keep + __shfl_xor(send, 16); }
#pragma unroll
    for (int i = 0; i < 4; ++i) { const bool up = (lane & 8) != 0; const float send = up ? p[i] : p[i + 4], keep = up ? p[i + 4] : p[i]; p[i] = keep + __shfl_xor(send, 8); }
#pragma unroll
    for (int i = 0; i < 2; ++i) { const bool up = (lane & 4) != 0; const float send = up ? p[i] : p[i + 2], keep = up ? p[i + 2] : p[i]; p[i] = keep + __shfl_xor(send, 4); }
    { const bool up = (lane & 2) != 0; const float send = up ? p[0] : p[1], keep = up ? p[1] : p[0]; p[0] = keep + __shfl_xor(send, 2); }
    p[0] += __shfl_xor(p[0], 1);
}
__device__ __forceinline__ void route_top4(float val, int myE, float (&sv)[4], int (&si)[4]) {
    int rank = 0;
#pragma unroll
    for (int e = 0; e < 32; ++e) { const float o = __builtin_bit_cast(float, __builtin_amdgcn_readlane(__builtin_bit_cast(int, val), 2 * e)); rank += (o > val || (o == val && e < myE)) ? 1 : 0; }
#pragma unroll
    for (int k = 0; k < 4; ++k) { const unsigned long long m = __ballot(rank == k); const int src = __builtin_ctzll(m);
        si[k] = src >> 1; sv[k] = __builtin_bit_cast(float, __builtin_amdgcn_readlane(__builtin_bit_cast(int, val), src)); }
}
#define IN(k) (lo <= (k) && (k) < hi)
#define SEAM(k) do { if (IN(k) && IN((k) + 1)) xcd_barrier(bar); } while (0)
#define SEAMK(k, kind) SEAM(k)
#define KLOCALS \
    const float* x_in = args.in[I_X]; const float* c_in = args.in[I_C]; const float* ctx_in = args.in[I_CTX]; const float* cctx_in = args.in[I_CCTX]; \
    float* out = args.out; \
    float* modp = (float*)(ws + WS_MODP); float* modf = (float*)(ws + WS_MOD); \
    float* cosT = (float*)(ws + WS_ROPE); float* sinT = cosT + SEQ * 32; \
    float* a2tab = (float*)(ws + WS_A2); \
    int* top_e = (int*)(ws + WS_PAIR); int* ppos = top_e + NTOK * 4; float* pgate = (float*)(ppos + NTOK * 4); int* pdest = (int*)(pgate + NTOK * 4); \
    bf16_t* XB = (bf16_t*)(ws + WS_XB); \
    bf16_t* Wqkv_t = (bf16_t*)(ws + WS_WQKV); bf16_t* Wo_t = (bf16_t*)(ws + WS_WO); bf16_t* Win_t = (bf16_t*)(ws + WS_WIN); bf16_t* Wout_t = (bf16_t*)(ws + WS_WOUT); \
    bf16_t* Wgu_t = (bf16_t*)(ws + WS_WGU); bf16_t* Wdn_t = (bf16_t*)(ws + WS_WDN); \
    bf16_t* hA = (bf16_t*)(ws + WS_HA); bf16_t* Qb = (bf16_t*)(ws + WS_Q); bf16_t* Kb = (bf16_t*)(ws + WS_K); bf16_t* Vb = (bf16_t*)(ws + WS_V); \
    bf16_t* Upre = (bf16_t*)(ws + WS_UPRE); bf16_t* Wc = (bf16_t*)(ws + WS_WC); bf16_t* Yc = (bf16_t*)(ws + WS_YC); \
    bf16_t* XS = (bf16_t*)(ws + WS_XS); bf16_t* AB = (bf16_t*)(ws + WS_AB); int* elist = (int*)(ws + WS_ELIST); \
    const int wr = wave >> 2, wc = wave & 3, fr = lane & 15, fq = lane >> 4;
template <int layer> __device__ __forceinline__ void layer_body(const Args& args, LAS unsigned char* lds, const XcdBarrier& bar, const int tid, const int lane, const int wave, const int G, const int bid, const int lo, const int hi) {
    const int gw = bid * NWAVES + wave, NGW = G * NWAVES;
    unsigned char* ws = args.ws;
    gu32* ctl = (gu32*)(ws + WS_CTL);
    KLOCALS
        const int pb = 3 + 10 * layer;
        const int jm = layer >> 1;
        const bool ctx_live = layer < 2;
        const int nrows = ctx_live ? NTOK : NLAT;
        const float* mo = modf + (size_t)layer * NMODROW * MODW;

        if ((layer & 1) == 0) {
            if (EN_GEMM && IN(pb + 0)) {
                EpiQKV E{Qb, Kb, Vb, args.in[I_QG] + jm * 64, args.in[I_KG] + jm * 64, cosT, sinT};
                const bf16_t* Wt = Wqkv_t + (size_t)jm * NQKV * D;
                const QkvSched S{hA, Wt, ctx_live ? 1 : 0, G, bid};
                run_gemm(lds, S, E);
            }
            SEAMK(pb + 0, 3);
            if (EN_ATT && IN(pb + 1)) {
                typedef attn_body::bf16 abf;
                const int x = bid & 7, sl = bid >> 3, nS = G >> 3;
                for (int q = sl; q < 256; q += nS) {
                    const int b = 2 * x + (q >> 7), kvh = (q >> 5) & 3, head = 4 * kvh + ((q >> 3) & 3), qb = q & 7;
                    abf* Qu = (abf*)(Qb + ((size_t)b * SEQ + qb * 256) * D + head * 64);
                    attn_body::attn_unit<8>(Qu, (const abf*)(Kb + (size_t)b * KVL * 256 + kvh * 64), (const abf*)(Vb + (size_t)b * KVL * 256 + kvh * 64), Qu, KVL / 64, (char*)lds);
                }
                if (ctx_live) for (int q = sl; q < 32; q += nS) {
                    const int b = 2 * x + (q >> 4), head = q & 15, kvh = head >> 2;
                    abf* Qu = (abf*)(Qb + ((size_t)NLAT + b * CL) * D + head * 64);
                    attn_body::attn_unit<8>(Qu, (const abf*)(Kb + ((size_t)b * KVL + SEQ) * 256 + kvh * 64), (const abf*)(Vb + ((size_t)b * KVL + SEQ) * 256 + kvh * 64), Qu, CL / 64, (char*)lds);
                }
            }
            SEAMK(pb + 1, 4);
            if (EN_GEMM && IN(pb + 2)) {
                EpiResid<layer == 0> E{x_in, ctx_in, XB, mo + 2 * D, nullptr};
                const bf16_t* Wt = Wo_t + (size_t)jm * D * D;
                const DenseSched S{Qb, Wt, nrows / 256, 4, G, bid};
                run_gemm(lds, S, E);
            }
            SEAMK(pb + 2, 5);
        } else {
            const float* cw = args.in[I_HCW] + (size_t)jm * 3 * NHY; const float* cb = args.in[I_HCB] + (size_t)jm * NHY;
            if (EN_GEMM && IN(pb + 0)) {
                EpiBiasBf16 E{Upre, NHY, args.in[I_HBIN] + (size_t)jm * NHY, 0};
                const bf16_t* Wt = Win_t + (size_t)jm * NHY * D;
                const DenseSched S{hA, Wt, nrows / 256, 12, G, bid};
                run_gemm(lds, S, E);
            }
            SEAMK(pb + 0, 6);
            if (EN_MISC && IN(pb + 1)) {
                LAS unsigned char* T = lds;
                const int nlat_u = NB * 16 * 4, nctx_u = ctx_live ? NB * 2 * 4 : 0;
                const int hw = tid >> 5, l32 = tid & 31;
                for (int u = bid; u < nlat_u + nctx_u; u += G) {
                    int b, s0, c0, Ls, rowb; bf16_t* dstb;
                    if (u < nlat_u) { b = u >> 6; s0 = ((u >> 2) & 15) * 128; c0 = (u & 3) * 256; Ls = SEQ; rowb = b * SEQ; dstb = Wc; }
                    else { const int q = u - nlat_u; b = q >> 3; s0 = ((q >> 2) & 1) * 128; c0 = (q & 3) * 256; Ls = CL; rowb = NLAT + b * CL; dstb = Wc + WC_CTX_OFF; }
                    const int cc = c0 + 8 * l32, sb = s0 + 8 * hw;
                    u32x4 ra[10], rv[10];
#pragma unroll
                    for (int i = 0; i < 10; ++i) { const int sp = sb + i - 1;
                        if (sp >= 0 && sp < Ls) { const bf16_t* ur = Upre + (size_t)(rowb + sp) * NHY + cc; ra[i] = *(const u32x4*)(ur + D); rv[i] = *(const u32x4*)(ur + 2 * D); }
                        else { ra[i] = (u32x4){0u, 0u, 0u, 0u}; rv[i] = (u32x4){0u, 0u, 0u, 0u}; } }
                    f32x4 w1[3][2], w2[3][2], b1[2], b2[2];
#pragma unroll
                    for (int tap = 0; tap < 3; ++tap)
#pragma unroll
                        for (int hh = 0; hh < 2; ++hh) { w1[tap][hh] = *(const f32x4*)(cw + tap * NHY + D + cc + 4 * hh); w2[tap][hh] = *(const f32x4*)(cw + tap * NHY + 2 * D + cc + 4 * hh); }
#pragma unroll
                    for (int hh = 0; hh < 2; ++hh) { b1[hh] = *(const f32x4*)(cb + D + cc + 4 * hh); b2[hh] = *(const f32x4*)(cb + 2 * D + cc + 4 * hh); }
                    unsigned op[8][4];
#pragma unroll
                    for (int sp = 0; sp < 4; ++sp) {
                        float pr[2][8];
#pragma unroll
                        for (int o = 0; o < 2; ++o) { const int si = 2 * sp + o;
                            f32x4 x1[2] = {b1[0], b1[1]}, vv[2] = {b2[0], b2[1]};
#pragma unroll
                            for (int tap = 0; tap < 3; ++tap) { const u32x4 a = ra[si + tap], q = rv[si + tap];
                                x1[0] += (f32x4){bflo(a.x), bfhi(a.x), bflo(a.y), bfhi(a.y)} * w1[tap][0]; x1[1] += (f32x4){bflo(a.z), bfhi(a.z), bflo(a.w), bfhi(a.w)} * w1[tap][1];
                                vv[0] += (f32x4){bflo(q.x), bfhi(q.x), bflo(q.y), bfhi(q.y)} * w2[tap][0]; vv[1] += (f32x4){bflo(q.z), bfhi(q.z), bflo(q.w), bfhi(q.w)} * w2[tap][1]; }
                            const f32x4 p0 = x1[0] * vv[0], p1 = x1[1] * vv[1];
                            pr[o][0] = p0[0]; pr[o][1] = p0[1]; pr[o][2] = p0[2]; pr[o][3] = p0[3]; pr[o][4] = p1[0]; pr[o][5] = p1[1]; pr[o][6] = p1[2]; pr[o][7] = p1[3]; }
#pragma unroll
                        for (int c = 0; c < 8; ++c) op[c][sp] = pk2(pr[0][c], pr[1][c]);
                    }
                    __syncthreads();
#pragma unroll
                    for (int c = 0; c < 8; ++c) { const int ch = 8 * l32 + c; *(LAS u32x4*)(T + ch * 256 + ((hw ^ (l32 & 15)) * 16)) = (u32x4){op[c][0], op[c][1], op[c][2], op[c][3]}; }
                    __syncthreads();
#pragma unroll
                    for (int i = 0; i < 8; ++i) { const int c = i * 32 + (tid >> 4), ch = tid & 15;
                        *(u32x4*)(dstb + ((size_t)(c0 + c) * NB + b) * Ls + s0 + ch * 8) = *(const LAS u32x4*)(T + c * 256 + ((ch ^ ((c >> 3) & 15)) * 16)); }
                }
            }
            SEAMK(pb + 1, 7);
            if (EN_CONV && IN(pb + 2)) {
                const int nlat_u = 1024, nctx_u = ctx_live ? 1024 : 0;
                for (int u = bid; u < nlat_u + nctx_u; u += G) {
                    if (u < nlat_u) { const int c = u; conv_channel<SEQ>(lds, (const bf16_t*)(ws + (jm == 0 ? WS_FI0 : WS_FI1)) + (size_t)c * 8 * FP_L, Wc + (size_t)c * NB * SEQ, Yc + (size_t)c * NB * SEQ, tid, lane, wave); }
                    else { const int c = u - nlat_u; conv_channel<CL>(lds, (const bf16_t*)(ws + WS_FI2) + (size_t)c * 8 * FP_C, Wc + WC_CTX_OFF + (size_t)c * NB * CL, Yc + WC_CTX_OFF + (size_t)c * NB * CL, tid, lane, wave); }
                }
            }
            SEAMK(pb + 2, 8);
            if (EN_MISC && IN(pb + 3)) {
                LAS unsigned char* T = lds;
                const int nlat_u = NB * 16 * 4, nctx_u = ctx_live ? NB * 2 * 4 : 0;
                const int hw = tid >> 5, l32 = tid & 31;
                for (int u = bid; u < nlat_u + nctx_u; u += G) {
                    int b, s0, c0, Ls, rowb; const bf16_t* srcb;
                    if (u < nlat_u) { b = u >> 6; s0 = ((u >> 2) & 15) * 128; c0 = (u & 3) * 256; Ls = SEQ; rowb = b * SEQ; srcb = Yc; }
                    else { const int q = u - nlat_u; b = q >> 3; s0 = ((q >> 2) & 1) * 128; c0 = (q & 3) * 256; Ls = CL; rowb = NLAT + b * CL; srcb = Yc + WC_CTX_OFF; }
                    __syncthreads();
#pragma unroll
                    for (int i = 0; i < 8; ++i) { const int c = i * 32 + (tid >> 4), ch = tid & 15;
                        *(LAS u32x4*)(T + c * 256 + ((ch ^ ((c >> 3) & 15)) * 16)) = *(const u32x4*)(srcb + ((size_t)(c0 + c) * NB + b) * Ls + s0 + ch * 8); }
                    const int cc = c0 + 8 * l32, sb = s0 + 8 * hw;
                    u32x4 ra[10];
#pragma unroll
                    for (int i = 0; i < 10; ++i) { const int sp = sb + i - 1;
                        if (sp >= 0 && sp < Ls) ra[i] = *(const u32x4*)(Upre + (size_t)(rowb + sp) * NHY + cc); else ra[i] = (u32x4){0u, 0u, 0u, 0u}; }
                    f32x4 w0[3][2], b0[2];
#pragma unroll
                    for (int tap = 0; tap < 3; ++tap)
#pragma unroll
                        for (int hh = 0; hh < 2; ++hh) w0[tap][hh] = *(const f32x4*)(cw + tap * NHY + cc + 4 * hh);
#pragma unroll
                    for (int hh = 0; hh < 2; ++hh) b0[hh] = *(const f32x4*)(cb + cc + 4 * hh);
                    __syncthreads();
                    u32x4 yv[8];
#pragma unroll
                    for (int c = 0; c < 8; ++c) yv[c] = *(const LAS u32x4*)(T + (8 * l32 + c) * 256 + ((hw ^ (l32 & 15)) * 16));
#pragma unroll
                    for (int si = 0; si < 8; ++si) {
                        f32x4 x0[2] = {b0[0], b0[1]};
#pragma unroll
                        for (int tap = 0; tap < 3; ++tap) { const u32x4 a = ra[si + tap];
                            x0[0] += (f32x4){bflo(a.x), bfhi(a.x), bflo(a.y), bfhi(a.y)} * w0[tap][0]; x0[1] += (f32x4){bflo(a.z), bfhi(a.z), bflo(a.w), bfhi(a.w)} * w0[tap][1]; }
                        float yy[8];
#pragma unroll
                        for (int c = 0; c < 8; ++c) { const unsigned wd = yv[c][si >> 1]; yy[c] = (si & 1) ? bfhi(wd) : bflo(wd); }
                        u32x4 o; o.x = pk2(x0[0][0] * yy[0], x0[0][1] * yy[1]); o.y = pk2(x0[0][2] * yy[2], x0[0][3] * yy[3]); o.z = pk2(x0[1][0] * yy[4], x0[1][1] * yy[5]); o.w = pk2(x0[1][2] * yy[6], x0[1][3] * yy[7]);
                        *(u32x4*)(hA + (size_t)(rowb + sb + si) * D + cc) = o;
                    }
                }
            }
            SEAMK(pb + 3, 9);
            if (EN_GEMM && IN(pb + 4)) {
                EpiResid<layer == 0> E{x_in, ctx_in, XB, mo + 2 * D, args.in[I_HBOUT] + (size_t)jm * D};
                const bf16_t* Wt = Wout_t + (size_t)jm * D * D;
                const DenseSched S{hA, Wt, nrows / 256, 4, G, bid};
                run_gemm(lds, S, E);
            }
            SEAMK(pb + 4, 10);
        }

        gu32* cnt = ctl + CW_CNT + layer * 32 * 64;
        if (EN_ROUTER && IN(pb + 5)) {
            constexpr int WSTR = D + 8, MAXT = 20;
            LAS bf16_t* WT = (LAS bf16_t*)lds;
            LAS float* CB = (LAS float*)(lds + 2 * 32 * WSTR * 2);
            LAS float* CRED = CB + 32;
            LAS int* LCNT = (LAS int*)(CRED + 512);
            LAS int* PREC = LCNT + 64;
            LAS float* RINV = (LAS float*)(PREC + 8 * MAXT * 4);
            __syncthreads();
            if (tid < 64) LCNT[tid] = 0;
            for (int i = tid; i < 8 * MAXT * 4; i += NTHR) PREC[i] = -1;
            const int TPW = (((nrows + NGW - 1) / NGW) + 1) & ~1;
            const int rf = gw * TPW; const int nval = rf >= nrows ? 0 : (nrows - rf < TPW ? nrows - rf : TPW);
            { int curb = -1; f32x4 gs[4], sh[4]; u32x2 wv_[4];
              if (nval > 0) {
#pragma unroll
                  for (int j = 0; j < 4; ++j) wv_[j] = ((const u32x2*)(XB + (size_t)rf * D))[lane + 64 * j]; }
              for (int ti = 0; ti < nval; ++ti) { const int r = rf + ti; f32x4 v[4];
#pragma unroll
                  for (int j = 0; j < 4; ++j) v[j] = (f32x4){bflo(wv_[j].x), bfhi(wv_[j].x), bflo(wv_[j].y), bfhi(wv_[j].y)};
                  if (ti + 1 < nval) {
#pragma unroll
                      for (int j = 0; j < 4; ++j) wv_[j] = ((const u32x2*)(XB + (size_t)(r + 1) * D))[lane + 64 * j]; }
                  const int bq = mod_row(r); if (bq != curb) { const float* mr = mo + (size_t)bq * MODW; load_vec(mr + 4 * D, lane, gs); load_vec(mr + 3 * D, lane, sh); curb = bq; }
                  float ss = 0.f;
#pragma unroll
                  for (int j = 0; j < 4; ++j) ss += (v[j][0] * v[j][0] + v[j][1] * v[j][1]) + (v[j][2] * v[j][2] + v[j][3] * v[j][3]);
                  ss = wave_sum(ss); const float rinv = __builtin_amdgcn_rsqf(ss * (1.0f / D) + EPS);
                  if (lane == 0) RINV[wave * MAXT + ti] = rinv;
#pragma unroll
                  for (int j = 0; j < 4; ++j) { const f32x4 h = (v[j] * rinv) * gs[j] + sh[j]; u32x2 w; w.x = pk2(h[0], h[1]); w.y = pk2(h[2], h[3]); ((u32x2*)(hA + (size_t)r * D))[lane + 64 * j] = w; } } }
            const int rb0 = bid * NWAVES * TPW; const int rb1 = (rb0 + NWAVES * TPW < nrows ? rb0 + NWAVES * TPW : nrows) - 1;
            const int bb0 = rb0 < nrows ? mod_row(rb0) : 1, bb1 = rb0 < nrows ? mod_row(rb1) : 0;
            const float* rw = args.in[I_RW] + (size_t)layer * D * NE; const float* rbias = args.in[I_RB] + layer * NE;
            for (int bq = bb0; bq <= bb1; ++bq) {
                __syncthreads();
                { const float* gsb = mo + (size_t)bq * MODW + 4 * D; const float* shb = mo + (size_t)bq * MODW + 3 * D;
                  const int e = tid & 31; float cpart = 0.f;
#pragma unroll 4
                  for (int jj = 0; jj < 8; ++jj) { const int k0 = 8 * ((tid >> 5) + 16 * jj);
                      const f32x4 g0 = *(const f32x4*)(gsb + k0), g1 = *(const f32x4*)(gsb + k0 + 4), s0 = *(const f32x4*)(shb + k0), s1 = *(const f32x4*)(shb + k0 + 4);
                      float wv[8];
#pragma unroll
                      for (int q = 0; q < 8; ++q) wv[q] = rw[(size_t)(k0 + q) * NE + e];
                      float pv[8]; unsigned hw[4], lw[4];
#pragma unroll
                      for (int q = 0; q < 4; ++q) { pv[q] = g0[q] * wv[q]; pv[4 + q] = g1[q] * wv[4 + q]; cpart += s0[q] * wv[q] + s1[q] * wv[4 + q]; }
#pragma unroll
                      for (int q = 0; q < 4; ++q) { hw[q] = pk2(pv[2 * q], pv[2 * q + 1]); lw[q] = pk2(pv[2 * q] - bflo(hw[q]), pv[2 * q + 1] - bfhi(hw[q])); }
                      *(LAS u32x4*)(WT + (size_t)e * WSTR + k0) = (u32x4){hw[0], hw[1], hw[2], hw[3]};
                      *(LAS u32x4*)(WT + (size_t)(32 + e) * WSTR + k0) = (u32x4){lw[0], lw[1], lw[2], lw[3]}; }
                  CRED[(tid >> 5) * 32 + e] = cpart; }
                __syncthreads();
                if (tid < 32) { float c = rbias[tid];
#pragma unroll
                    for (int q = 0; q < 16; ++q) c += CRED[q * 32 + tid];
                    CB[tid] = c; }
                __syncthreads();
                if (nval > 0 && mod_row(rf) <= bq && bq <= mod_row(rf + nval - 1)) {
                    const int e = lane & 31, kh = lane >> 5; const int trow = rf + (e < nval ? e : nval - 1);
                    const bf16_t* ap = XB + (size_t)trow * D + 8 * kh;
                    const LAS bf16_t* bhp = WT + (size_t)e * WSTR + 8 * kh; const LAS bf16_t* blp = bhp + 32 * WSTR;
                    f32x16 acc;
#pragma unroll
                    for (int q = 0; q < 16; ++q) acc[q] = 0.f;
#pragma unroll 8
                    for (int ks = 0; ks < D / 16; ++ks) { const bf16x8 af = *(const bf16x8*)(ap + 16 * ks);
                        acc = __builtin_amdgcn_mfma_f32_32x32x16_bf16(af, *(const LAS bf16x8*)(bhp + 16 * ks), acc, 0, 0, 0);
                        acc = __builtin_amdgcn_mfma_f32_32x32x16_bf16(af, *(const LAS bf16x8*)(blp + 16 * ks), acc, 0, 0, 0); }
                    const float cbe = CB[e];
                    const int hf = lane >> 5;
#pragma unroll
                    for (int r = 0; r < 10; ++r) { const int tA = (r & 3) + 8 * (r >> 2), tB = tA + 4;
                        const bool okA = tA < nval && mod_row(rf + tA) == bq, okB = tB < nval && mod_row(rf + (tB < MAXT ? tB : 0)) == bq;
                        if (okA || okB) {
                            const int tmine = hf ? (tB < MAXT ? tB : MAXT - 1) : tA;
                            float val = RINV[wave * MAXT + tmine] * acc[r] + cbe;
                            float sv[4]; int si[4];
#pragma unroll
                            for (int k = 0; k < 4; ++k) {
                                int x = __builtin_bit_cast(int, val); float m = val;
                                m = fmaxf(m, __builtin_bit_cast(float, __builtin_amdgcn_update_dpp(x, x, 0xB1, 0xF, 0xF, false))); x = __builtin_bit_cast(int, m);
                                m = fmaxf(m, __builtin_bit_cast(float, __builtin_amdgcn_update_dpp(x, x, 0x4E, 0xF, 0xF, false))); x = __builtin_bit_cast(int, m);
                                m = fmaxf(m, __builtin_bit_cast(float, __builtin_amdgcn_update_dpp(x, x, 0x124, 0xF, 0xF, false))); x = __builtin_bit_cast(int, m);
                                m = fmaxf(m, __builtin_bit_cast(float, __builtin_amdgcn_update_dpp(x, x, 0x128, 0xF, 0xF, false)));
                                m = fmaxf(m, __shfl_xor(m, 16));
                                const unsigned long long mk = __ballot(val == m);
                                const int wlo = __builtin_ctz((unsigned)mk | 0x80000000u), whi = __builtin_ctz((unsigned)(mk >> 32) | 0x80000000u);
                                const int win = hf ? whi : wlo;
                                sv[k] = m; si[k] = win; if ((lane & 31) == win) val = -INFINITY; }
                            if ((lane & 31) < 4 && (hf ? okB : okA)) { const int k = lane & 31; const float e1 = __expf(sv[1] - sv[0]), e2 = __expf(sv[2] - sv[0]), e3 = __expf(sv[3] - sv[0]); const float inv = 1.0f / (1.0f + e1 + e2 + e3);
                                const int ex = k == 0 ? si[0] : (k == 1 ? si[1] : (k == 2 ? si[2] : si[3])); const float gt = (k == 0 ? 1.0f : (k == 1 ? e1 : (k == 2 ? e2 : e3))) * inv;
                                const int tt = hf ? tB : tA; const int rr = rf + tt; const int rk = __hip_atomic_fetch_add(LCNT + ex, 1, __ATOMIC_RELAXED, __HIP_MEMORY_SCOPE_WORKGROUP);
                                top_e[rr * 4 + k] = ex; pgate[rr * 4 + k] = gt; PREC[(wave * MAXT + tt) * 4 + k] = ex | (rk << 8); } } }
                }
            }
            __syncthreads();
            if (tid < 32) LCNT[32 + tid] = (int)__hip_atomic_fetch_add(cnt + tid * 64, (unsigned)LCNT[tid], RLX_AGENT);
            __syncthreads();
            for (int i = tid; i < 8 * MAXT * 4; i += NTHR) { const int rec = PREC[i]; if (rec >= 0) { const int e = rec & 255, rank = rec >> 8, w = i / (MAXT * 4), ti = (i / 4) % MAXT, k = i & 3;
                const int r = (bid * NWAVES + w) * TPW + ti; const int pos = LCNT[32 + e] + rank; ppos[r * 4 + k] = pos; elist[(size_t)e * NTOK + pos] = r; } }
        }
        SEAMK(pb + 5, 11);
        LAS int* PADS = (LAS int*)(lds + LDS_BYTES - 4096);
        LAS unsigned char* TE = (LAS unsigned char*)(PADS + 128);
        if (IN(pb + 7) || IN(pb + 8) || IN(pb + 9)) {
            __syncthreads();
            if (tid < 32) PADS[64 + tid] = (int)__hip_atomic_load(cnt + tid * 64, RLX_AGENT);
            __syncthreads();
            if (tid < 64) {
                const int nt = lane < 32 ? (PADS[64 + lane] + 255) >> 8 : 0; int inc = nt;
#pragma unroll
                for (int o = 1; o < 32; o <<= 1) { const int v = __shfl_up(inc, o); if (lane >= o) inc += v; }
                if (lane < 32) PADS[lane] = (inc - nt) << 8; if (lane == 31) PADS[32] = inc << 8;
            }
            __syncthreads();
            { const int ntile = PADS[32] >> 8; for (int t = tid; t < ntile; t += NTHR) { int e = 0;
#pragma unroll
                  for (int st = 16; st >= 1; st >>= 1) if (PADS[e + st] <= (t << 8)) e += st;
                  TE[t] = (unsigned char)e; } }
            __syncthreads();
        }
        if (EN_GEMM && IN(pb + 7)) {
            const int ntile = PADS[32] >> 8;
            LAS int* ROWS = (LAS int*)(lds + 131072);
            { Unit uu; for (int ui = 0; xcd_unit(ui, G, bid, ntile, 8, uu.pm, uu.pn); ++ui) { if (tid < 256) { const int e = TE[uu.pm]; const int pos = uu.pm * 256 - PADS[e] + tid;
                  ROWS[ui * 256 + tid] = pos < PADS[64 + e] ? elist[(size_t)e * NTOK + pos] : 0; } } }
            __syncthreads();
            const MoeGatherSched S{hA, Wgu_t + (size_t)layer * NE * NGU * D, TE, ROWS, ntile, 8, NGU, G, bid};
            const EpiSwiglu E{AB, args.in[I_BGU] + (size_t)layer * NE * NGU};
            run_gemm_gather(lds, S, E);
        }
        SEAMK(pb + 7, 12);
        if (EN_GEMM && IN(pb + 8)) {
            const int ntile = PADS[32] >> 8;
            const MoeSched S{AB, Wdn_t + (size_t)layer * NE * D * D, TE, ntile, 4, D, G, bid};
            const EpiBiasBf16 E{XS, D, args.in[I_BDN] + (size_t)layer * NE * D, D};
            run_gemm(lds, S, E);
        }
        SEAMK(pb + 8, 13);
        if (EN_MISC && IN(pb + 9)) {
            const bool has_next = layer + 1 < DEPTH;
            const float* mo_n = modf + (size_t)(layer + 1) * NMODROW * MODW; const float* g1n = args.in[I_N1G] + (has_next ? (layer + 1) * D : 0);
            const int nnext = (layer + 1 < 3) ? NTOK : NLAT;
            const int TPW = (nrows + NGW - 1) / NGW;
            int curb = -1; f32x4 gm[4], gsn[4], shn[4];
            for (int ti = 0; ti < TPW; ++ti) {
                const int r = gw * TPW + ti; if (r >= nrows) break;
                bf16_t* xr = XB + (size_t)r * D;
                int dest[4]; float gt[4];
#pragma unroll
                for (int k = 0; k < 4; ++k) { dest[k] = PADS[top_e[r * 4 + k]] + ppos[r * 4 + k]; gt[k] = pgate[r * 4 + k]; }
                u32x2 yw[4][4]; f32x4 v[4], h[4];
#pragma unroll
                for (int k = 0; k < 4; ++k) { const u32x2* yr = (const u32x2*)(XS + (size_t)dest[k] * D);
#pragma unroll
                    for (int j = 0; j < 4; ++j) yw[k][j] = yr[lane + 64 * j]; }
                load_vec_bf(xr, lane, v);
                const int b = mod_row(r);
                if (b != curb) { load_vec(mo + (size_t)b * MODW + 5 * D, lane, gm); if (has_next) { const float* mn = mo_n + (size_t)b * MODW; load_vec(mn + D, lane, gsn); load_vec(mn, lane, shn); } curb = b; }
#pragma unroll
                for (int j = 0; j < 4; ++j) { f32x4 y = (f32x4){0.f, 0.f, 0.f, 0.f};
#pragma unroll
                    for (int k = 0; k < 4; ++k) { const u32x2 w = yw[k][j]; y[0] += gt[k] * bflo(w.x); y[1] += gt[k] * bfhi(w.x); y[2] += gt[k] * bflo(w.y); y[3] += gt[k] * bfhi(w.y); }
                    v[j] = v[j] + gm[j] * y;
                    if (layer == DEPTH - 1) ((f32x4*)(out + (size_t)r * D))[lane + 64 * j] = v[j];
                    else { u32x2 w; w.x = pk2(v[j][0], v[j][1]); w.y = pk2(v[j][2], v[j][3]); ((u32x2*)xr)[lane + 64 * j] = w; } }
                if (has_next && r < nnext) norm_mod_store(v, gsn, shn, hA + (size_t)r * D, lane, h);
            }
        }
        SEAMK(pb + 9, 14);
}

__global__ void __launch_bounds__(NTHR, 2) fwd(Args args) {
    extern __shared__ __attribute__((aligned(16))) unsigned char lds_raw[];
    LAS unsigned char* lds = (LAS unsigned char*)lds_raw;
    const int tid = threadIdx.x, lane = tid & 63, wave = __builtin_amdgcn_readfirstlane(tid >> 6);
    const int G = gridDim.x, bid = blockIdx.x;
    const int gw = bid * NWAVES + wave, NGW = G * NWAVES;
    unsigned char* ws = args.ws;
    gu32* ctl = (gu32*)(ws + WS_CTL);
    volatile LAS unsigned* MISC = (volatile LAS unsigned*)(lds + MISC_OFF);
    if (tid < 64) MISC[tid] = 0u;
    __syncthreads();
    XcdBarrier bar; bar.bar = (unsigned*)ctl + CW_BAR; bar.x = 0; bar.st = MISC + 8;
    const int lo = args.ph_lo, hi = args.ph_hi;
    if (hi - lo > 1) bar = xcd_barrier_post((unsigned*)ctl + CW_BAR, MISC + 8);

    KLOCALS

    if (EN_PRO && IN(0)) {
        {
            LAS float* scr = (LAS float*)(lds + wave * 8448);
            constexpr int IT_QKV = 16 * (NQKV / 32), IT_SQ = 16 * (D / 32), IT_IN = 16 * (NHY / 32), IT_GU = 16 * (NGU / 32);
            constexpr int N0 = 2 * IT_QKV, N1 = N0 + 2 * IT_SQ, N2 = N1 + 2 * IT_IN, N3 = N2 + 2 * IT_SQ, N4 = N3 + 128 * IT_GU, N5 = N4 + 128 * IT_SQ;
            for (int it = gw; it < N5; it += NGW) {
                if (it < N0) { const int mtx = it / IT_QKV, r = it % IT_QKV; transpose_item<1>(args.in[I_WQKV] + (size_t)mtx * D * NQKV, NQKV, Wqkv_t + (size_t)mtx * NQKV * D, scr, r, lane); }
                else if (it < N1) { const int q = it - N0, mtx = q / IT_SQ, r = q % IT_SQ; transpose_item<0>(args.in[I_WO] + (size_t)mtx * D * D, D, Wo_t + (size_t)mtx * D * D, scr, r, lane); }
                else if (it < N2) { const int q = it - N1, mtx = q / IT_IN, r = q % IT_IN; transpose_item<0>(args.in[I_HWIN] + (size_t)mtx * D * NHY, NHY, Win_t + (size_t)mtx * NHY * D, scr, r, lane); }
                else if (it < N3) { const int q = it - N2, mtx = q / IT_SQ, r = q % IT_SQ; transpose_item<0>(args.in[I_HWOUT] + (size_t)mtx * D * D, D, Wout_t + (size_t)mtx * D * D, scr, r, lane); }
                else if (it < N4) { const int q = it - N3, mtx = q / IT_GU, r = q % IT_GU; transpose_item<2>(args.in[I_WGU] + (size_t)mtx * D * NGU, NGU, Wgu_t + (size_t)mtx * NGU * D, scr, r, lane); }
                else { const int q = it - N4, mtx = q / IT_SQ, r = q % IT_SQ; transpose_item<0>(args.in[I_WDN] + (size_t)mtx * D * D, D, Wdn_t + (size_t)mtx * D * D, scr, r, lane); }
            }
        }
        __syncthreads();
        {
            LAS float* S = (LAS float*)lds;
            for (int u = bid; u < 4 * 12 * 8; u += G) {
                const int kc = u & 7, cc = (u >> 3) % 12, layer = u / 96;
                __syncthreads();
                for (int i = tid; i < 128 * 20; i += NTHR) { const int k = i / 20, r = i % 20; float v = 0.f;
                    if (r < NMODROW) { const float cv = r < NB ? c_in[r * D + kc * 128 + k] : cctx_in[kc * 128 + k]; v = cv / (1.0f + __expf(-cv)); }
                    S[i] = v; }
                __syncthreads();
                const int col = cc * 512 + tid;
                const float* wp = args.in[I_WMOD] + ((size_t)layer * D + kc * 128) * MODW + col;
                float acc[20];
#pragma unroll
                for (int r = 0; r < 20; ++r) acc[r] = 0.f;
                for (int k = 0; k < 128; ++k) { const float w = wp[(size_t)k * MODW];
#pragma unroll
                    for (int q = 0; q < 5; ++q) { const f32x4 s = *(const LAS f32x4*)(S + k * 20 + 4 * q);
                        acc[4 * q] += s[0] * w; acc[4 * q + 1] += s[1] * w; acc[4 * q + 2] += s[2] * w; acc[4 * q + 3] += s[3] * w; } }
#pragma unroll
                for (int r = 0; r < NMODROW; ++r) modp[((size_t)(kc * 4 + layer) * NMODROW + r) * MODW + col] = acc[r];
            }
        }
        for (int i = bid * NTHR + tid; i < SEQ * 32; i += G * NTHR) {
            const int t = i >> 5, j = i & 31, fi = j & 15; const int pos = (j >> 4) == 0 ? (t >> 6) : (t & 63);
            const float inv = powf(10000.0f, -(float)fi / 16.0f); const float ang = (float)pos * inv;
            cosT[i] = cosf(ang); sinT[i] = sinf(ang);
        }
        {
            __syncthreads();
            LAS float* Z = (LAS float*)lds;
            LAS float* A1 = Z + 8 * 36;
            for (int u = bid; u < 256 + 256 + 32; u += G) {
                const int combo = u < 256 ? 0 : (u < 512 ? 1 : 2); const int ub = combo == 0 ? u : (combo == 1 ? u - 256 : u - 512);
                const int j = combo == 1 ? 1 : 0, Lf = combo == 2 ? CL : SEQ;
                const int tl = tid >> 6, o = tid & 63, t = ub * 8 + tl;
                __syncthreads();
                if (o < 33) { float z;
                    const float tt = (float)t / (float)(Lf - 1), w = 6.283185307179586f * (float)t / (float)Lf;
                    if (o == 0) z = tt; else { const int b = (o - 1) & 15; const float f = 1e-4f + (float)b * ((15.0f - 1e-4f) / 15.0f); z = o <= 16 ? cosf(f * w) : -sinf(f * w); }
                    Z[tl * 36 + o] = z; }
                __syncthreads();
                const float sf = args.in[I_HSF][j * 64 + o];
                { const float* w1 = args.in[I_HW1] + (size_t)j * 33 * 64; float a = args.in[I_HB1][j * 64 + o];
                  for (int i = 0; i < 33; ++i) a += Z[tl * 36 + i] * w1[i * 64 + o];
                  A1[tl * 64 + o] = sinf(sf * a); }
                __syncthreads();
                { const float* w2 = args.in[I_HW2] + (size_t)j * 64 * 64; float a = args.in[I_HB2][j * 64 + o];
                  for (int i = 0; i < 64; ++i) a += A1[tl * 64 + i] * w2[i * 64 + o];
                  a2tab[((size_t)combo * SEQ + t) * 64 + o] = sinf(sf * a); }
            }
        }
    }
    SEAMK(0, 0);

    if (EN_PRO && IN(1)) {
        for (int i = bid * NTHR + tid; i < DEPTH * NMODROW * MODW; i += G * NTHR) {
            const int layer = i / (NMODROW * MODW), rem = i % (NMODROW * MODW), col = rem % MODW; float s = args.in[I_BMOD][layer * MODW + col];
#pragma unroll
            for (int kc = 0; kc < 8; ++kc) s += modp[(size_t)(kc * 4 + layer) * NMODROW * MODW + rem];
            const int chunk = col >> 10, k = col & (D - 1);
            if (chunk == 1) s = args.in[I_N1G][layer * D + k] * (1.0f + s); else if (chunk == 4) s = args.in[I_N2G][layer * D + k] * (1.0f + s);
            modf[i] = s;
        }
        {
            LAS float* W3 = (LAS float*)lds;
            LAS float* RED = W3 + 512;
            LAS float* NRM = RED + 32;
            LAS float* HF = NRM + 4;
            for (int u = bid; u < 3 * 256; u += G) {
                const int combo = u >> 8, cg = u & 255; const int j = combo == 1 ? 1 : 0, Lf = combo == 2 ? CL : SEQ; const int c0 = cg * 4;
                LAS float* HB = HF + 4 * Lf;
                __syncthreads();
                { const int i = tid >> 3, q = tid & 7; const int col = (q >> 2) * 1024 + c0 + (q & 3);
                  W3[i * 8 + q] = args.in[I_HW3][((size_t)j * 64 + i) * 2048 + col]; }
                __syncthreads();
                float b3v[8], dec[4], asum[4] = {0.f, 0.f, 0.f, 0.f};
#pragma unroll
                for (int q = 0; q < 8; ++q) b3v[q] = args.in[I_HB3][j * 2048 + (q >> 2) * 1024 + c0 + (q & 3)];
#pragma unroll
                for (int ch = 0; ch < 4; ++ch) dec[ch] = 3.0701134573253945f + (float)(c0 + ch) * ((15.350567286626972f - 3.0701134573253945f) / 1023.0f);
                for (int t = tid; t < Lf; t += NTHR) {
                    asm volatile("" ::: "memory");
                    const float* ar = a2tab + ((size_t)combo * SEQ + t) * 64; float d[8];
#pragma unroll
                    for (int q = 0; q < 8; ++q) d[q] = b3v[q];
#pragma unroll
                    for (int i4 = 0; i4 < 16; ++i4) { const f32x4 a = *(const f32x4*)(ar + 4 * i4); asm volatile("" ::: "memory");
#pragma unroll
                        for (int e = 0; e < 4; ++e) { const f32x4 w0 = *(const LAS f32x4*)(W3 + (4 * i4 + e) * 8), w1 = *(const LAS f32x4*)(W3 + (4 * i4 + e) * 8 + 4);
                            d[0] += a[e] * w0[0]; d[1] += a[e] * w0[1]; d[2] += a[e] * w0[2]; d[3] += a[e] * w0[3]; d[4] += a[e] * w1[0]; d[5] += a[e] * w1[1]; d[6] += a[e] * w1[2]; d[7] += a[e] * w1[3]; } }
                    const float tt = (float)t / (float)(Lf - 1);
#pragma unroll
                    for (int ch = 0; ch < 4; ++ch) { const float dk = __expf(-tt * dec[ch]); const float f = d[ch] * dk, bb = d[4 + ch] * dk;
                        HF[ch * Lf + t] = f; HB[ch * Lf + t] = bb; asum[ch] += fabsf(f) + (t >= 1 ? fabsf(bb) : 0.f); }
                }
#pragma unroll
                for (int ch = 0; ch < 4; ++ch) { const float s = wave_sum(asum[ch]); if (lane == 0) RED[wave * 4 + ch] = s; }
                __syncthreads();
                if (tid < 4) { float s = 0.f; for (int w = 0; w < 8; ++w) s += RED[w * 4 + tid]; NRM[tid] = 1.0f / (s + EPS); }
                __syncthreads();
                const int P = 2 * Lf + 8, PC8 = P / 8;
                bf16_t* FI = (bf16_t*)(ws + (combo == 0 ? WS_FI0 : (combo == 1 ? WS_FI1 : WS_FI2)));
                for (int q = tid; q < 4 * 8 * PC8; q += NTHR) {
                    const int ch = q / (8 * PC8), r = q % (8 * PC8), cidx = r / PC8, x0 = (r % PC8) * 8;
                    const float nr = NRM[ch], db = args.in[I_HDB][j * 1024 + c0 + ch]; float v[8];
#pragma unroll
                    for (int e = 0; e < 8; ++e) { const int m = Lf - (x0 + e) + cidx; const int am = m < 0 ? -m : m; float g = 0.f;
                        if (am <= Lf - 1) { g = (m >= 0 ? HF[ch * Lf + am] : HB[ch * Lf + am]) * nr; if (m == 0) g += db; }
                        v[e] = g; }
                    u32x4 o; o.x = pk2(v[0], v[1]); o.y = pk2(v[2], v[3]); o.z = pk2(v[4], v[5]); o.w = pk2(v[6], v[7]);
                    *(u32x4*)(FI + ((size_t)((c0 + ch) * 8 + cidx)) * P + x0) = o;
                }
            }
        }
    }
    SEAMK(1, 1);

    if (IN(2)) {
        const float* mo = modf;
        const int TPW = (NTOK + NGW - 1) / NGW;
        int curb = -1; f32x4 gs[4], sh[4];
        for (int ti = 0; ti < TPW; ++ti) {
            const int r = gw * TPW + ti; if (r >= NTOK) break;
            const float* src = r < NLAT ? x_in + (size_t)r * D : ctx_in + (size_t)(r - NLAT) * D;
            f32x4 v[4], h[4]; load_vec(src, lane, v);
            const int b = mod_row(r); if (b != curb) { const float* mr = mo + (size_t)b * MODW; load_vec(mr + D, lane, gs); load_vec(mr, lane, sh); curb = b; }
            norm_mod_store(v, gs, sh, hA + (size_t)r * D, lane, h);
        }
    }
    SEAMK(2, 2);

    layer_body<0>(args, lds, bar, tid, lane, wave, G, bid, lo, hi);
    layer_body<1>(args, lds, bar, tid, lane, wave, G, bid, lo, hi);
    layer_body<2>(args, lds, bar, tid, lane, wave, G, bid, lo, hi);
    layer_body<3>(args, lds, bar, tid, lane, wave, G, bid, lo, hi);
#undef IN
#undef SEAM
}

extern "C" void kernel_launch(void* const* d_in, const int* in_sizes, int n_in, void* d_out, int out_size, void* d_ws, size_t ws_size, hipStream_t stream) {
    static int grid = 0;
    if (grid == 0) {
        if (n_in != 32 || out_size != NLAT * D || ws_size < WS_END) { fprintf(stderr, "kernel_launch: unexpected problem (n_in %d, out %d, ws %zu)\n", n_in, out_size, ws_size); grid = -1; return; }
        int dev = 0, cus = 0, per_cu = 0;
        if (hipGetDevice(&dev) != hipSuccess || hipDeviceGetAttribute(&cus, hipDeviceAttributeMultiprocessorCount, dev) != hipSuccess) { grid = -1; return; }
        if (hipFuncSetAttribute((const void*)fwd, hipFuncAttributeMaxDynamicSharedMemorySize, LDS_BYTES) != hipSuccess) { fprintf(stderr, "kernel_launch: hipFuncSetAttribute failed\n"); grid = -1; return; }
        if (hipOccupancyMaxActiveBlocksPerMultiprocessor(&per_cu, (const void*)fwd, NTHR, LDS_BYTES) != hipSuccess || per_cu < 1) fprintf(stderr, "kernel_launch: occupancy query says %d\n", per_cu);
        (void)hipGetLastError();
        grid = cus;
    }
    if (grid < 0) return;
    (void)hipMemsetAsync((char*)d_ws + WS_CTL, 0, CTL_ZERO_BYTES, stream);
    Args a{};
    for (int i = 0; i < 32; ++i) a.in[i] = (const float*)d_in[i];
    a.out = (float*)d_out; a.ws = (unsigned char*)d_ws;
    constexpr int NPH = 3 + 10 * DEPTH;
#if MK_ONE_LAUNCH
    a.ph_lo = 0; a.ph_hi = NPH;
    hipLaunchKernelGGL(fwd, dim3(grid), dim3(NTHR), LDS_BYTES, stream, a);
#else
    for (int p = 0; p < NPH; ++p) {
        if (p >= 3) { const int layer = (p - 3) / 10, loc = (p - 3) % 10; if ((layer & 1) == 0 && (loc == 3 || loc == 4)) continue; }
        a.ph_lo = p; a.ph_hi = p + 1;
        hipLaunchKernelGGL(fwd, dim3(grid), dim3(NTHR), LDS_BYTES, stream, a);
    }
#endif
}
```

```cpp
#include <hip/hip_runtime.h>
#include <cstdio>
#include <cstdint>
#include <cmath>
#include <hip/hip_bf16.h>

#ifndef EN_PRO
#define EN_PRO 1
#endif
#ifndef EN_ATT
#define EN_ATT 1
#endif
#ifndef EN_CONV
#define EN_CONV 1
#endif
#ifndef EN_ROUTER
#define EN_ROUTER 1
#endif
#ifndef EN_GEMM
#define EN_GEMM 1
#endif
#ifndef EN_MISC
#define EN_MISC 1
#endif
#ifndef MK_ONE_LAUNCH
#define MK_ONE_LAUNCH 1
#endif

#define GAS __attribute__((address_space(1)))
#define LAS __attribute__((address_space(3)))
typedef unsigned short bf16_t;
typedef short bf16x8 __attribute__((ext_vector_type(8)));
typedef float f32x4 __attribute__((ext_vector_type(4)));
typedef float f32x2 __attribute__((ext_vector_type(2)));
typedef unsigned u32x4 __attribute__((ext_vector_type(4)));
typedef unsigned u32x2 __attribute__((ext_vector_type(2)));
typedef GAS unsigned gu32;
typedef float f32x16 __attribute__((ext_vector_type(16)));

constexpr int D = 1024, NB = 16, SEQ = 2048, CL = 256, KVL = SEQ + CL;
constexpr int NLAT = NB * SEQ, NCTX = NB * CL, NTOK = NLAT + NCTX;
constexpr int NE = 32, TOPK = 4, DEPTH = 4;
constexpr int MODW = 6 * D, NMODROW = NB + 1;
constexpr int NQKV = 1536, NHY = 3072, NGU = 2048;
constexpr float EPS = 1e-6f;
constexpr float C2 = 0.125f * 1.4426950408889634f;
constexpr int NWAVES = 8, NTHR = 512;
constexpr int NPADROWS = 155648;
constexpr int MAXTILES = NPADROWS / 256;

constexpr size_t MiB = 1u << 20;
constexpr size_t WS_CTL = 0, CTL_ZERO_BYTES = 1 * MiB;
constexpr size_t WS_MODP = 2 * MiB;
constexpr size_t WS_MOD = 16 * MiB;
constexpr size_t WS_ROPE = 18 * MiB;
constexpr size_t WS_A2 = 19 * MiB;
constexpr size_t WS_PAIR = 21 * MiB;
constexpr size_t WS_CTX = 24 * MiB;
constexpr size_t WS_FI = 40 * MiB;
constexpr int FP_L = 2 * SEQ + 8, FP_C = 2 * CL + 8;
constexpr size_t FI_L_BYTES = (size_t)1024 * 8 * FP_L * 2, FI_C_BYTES = (size_t)1024 * 8 * FP_C * 2;
constexpr size_t WS_FI0 = WS_FI, WS_FI1 = WS_FI0 + 65 * MiB, WS_FI2 = WS_FI1 + 65 * MiB;
static_assert(FI_L_BYTES <= 65 * MiB && WS_FI2 + FI_C_BYTES <= 180 * MiB, "filter map");
constexpr size_t WS_WQKV = 180 * MiB, WS_WO = 186 * MiB, WS_WIN = 190 * MiB, WS_WOUT = 202 * MiB, WS_WGU = 206 * MiB, WS_WDN = 718 * MiB;
constexpr size_t WS_HA = 974 * MiB;
constexpr size_t WS_Q = 1046 * MiB;
constexpr size_t WS_K = 1118 * MiB, WS_V = 1136 * MiB;
constexpr size_t WS_UPRE = 1154 * MiB;
constexpr size_t WS_WC = 1370 * MiB;
constexpr size_t WS_YC = 1442 * MiB;
constexpr size_t WS_XS = 1514 * MiB;
constexpr size_t WS_AB = 1818 * MiB;
constexpr size_t WS_ELIST = 2122 * MiB;
constexpr size_t WS_XB = 2128 * MiB;
constexpr size_t WS_END = 2200 * MiB;
constexpr size_t WC_CTX_OFF = (size_t)1024 * 16 * 2048;
constexpr int CW_TMO = 0, CW_BAR = 4096, CW_CNT = 16384;

constexpr int LDS_BYTES = 160 * 1024;
constexpr int MISC_OFF = LDS_BYTES - 256;

#define RLX_AGENT __ATOMIC_RELAXED, __HIP_MEMORY_SCOPE_AGENT
#define LDS_WAIT() asm volatile("s_waitcnt lgkmcnt(0)" ::: "memory")
#define VM_WAIT() asm volatile("s_waitcnt vmcnt(0)" ::: "memory")
__device__ __forceinline__ unsigned f2bf(float f) { unsigned u = __builtin_bit_cast(unsigned, f); return (u + 0x7fffu + ((u >> 16) & 1u)) >> 16; }
typedef __bf16 bf16x2_t __attribute__((ext_vector_type(2)));
__device__ __forceinline__ unsigned pk2(float lo, float hi) { const f32x2 v = {lo, hi}; const bf16x2_t b = __builtin_convertvector(v, bf16x2_t); return __builtin_bit_cast(unsigned, b); }
__device__ __forceinline__ float bf2f(unsigned h) { return __builtin_bit_cast(float, h << 16); }
__device__ __forceinline__ float bflo(unsigned w) { return __builtin_bit_cast(float, w << 16); }
__device__ __forceinline__ float bfhi(unsigned w) { return __builtin_bit_cast(float, w & 0xffff0000u); }
__device__ __forceinline__ float wave_sum(float v) {
#pragma unroll
    for (int o = 1; o < 64; o <<= 1) v += __shfl_xor(v, o);
    return v;
}

#define XB_TMO      128
#define XB_XCNT(j)  (256  + 64 * (j))
#define XB_XSUB(j)  (1280 + 64 * (j))
#define XB_XGEN(j)  (2304 + 64 * (j))
#define XB_TOP      3328
#define XB_TOPGEN   3392
#define XCD_BAR_WORDS 3456
#define XB_SPIN_CAP (1u << 22)
__device__ __forceinline__ unsigned xb_ld(unsigned* p)              { return __hip_atomic_load(p, __ATOMIC_RELAXED, __HIP_MEMORY_SCOPE_AGENT); }
__device__ __forceinline__ unsigned xb_add(unsigned* p, unsigned v) { return __hip_atomic_fetch_add(p, v, __ATOMIC_RELAXED, __HIP_MEMORY_SCOPE_AGENT); }
__device__ __forceinline__ unsigned xb_xcc_id() { return (unsigned)__builtin_amdgcn_s_getreg((3 << 11) | 20) & 0xFu; }
#define XB_SPIN(cond, bar) do { unsigned _sp = 0; while (cond) { __builtin_amdgcn_s_sleep(1); \
    if ((++_sp & 255u) == 0u) { if (xb_ld(&(bar)[XB_TMO])) break; if (_sp > XB_SPIN_CAP) { atomicAdd(&(bar)[XB_TMO], 1u); break; } } } } while (0)
struct XcdBarrier { unsigned* bar; unsigned x; volatile LAS unsigned* st; };
__device__ __forceinline__ XcdBarrier xcd_barrier_post(unsigned* bar, volatile LAS unsigned* st) {
    XcdBarrier b; b.bar = bar; b.x = xb_xcc_id(); b.st = st;
    if (threadIdx.x == 0) (void)xb_add(&bar[XB_XCNT(b.x)], 1u);
    return b;
}
__device__ __forceinline__ void xcd_barrier_complete(unsigned* bar, unsigned x, unsigned& nloc, unsigned& nx) {
    const unsigned G = gridDim.x * gridDim.y * gridDim.z;
    unsigned sum, cnt, mine, sp = 0u;
    for (;;) {
        sum = 0u; cnt = 0u; mine = 0u;
#pragma unroll
        for (unsigned j = 0; j < 16; ++j) { const unsigned c = xb_ld(&bar[XB_XCNT(j)]); sum += c; cnt += (c > 0u) ? 1u : 0u; mine = (j == x) ? c : mine; }
        if (sum == G) break;
        __builtin_amdgcn_s_sleep(1);
        if ((++sp & 255u) == 0u) { if (xb_ld(&bar[XB_TMO])) break; if (sp > XB_SPIN_CAP) { atomicAdd(&bar[XB_TMO], 1u); break; } }
    }
    nloc = mine > 0u ? mine : 1u; nx = cnt > 0u ? cnt : 1u;
}
__device__ __forceinline__ void xcd_barrier(const XcdBarrier& b) {
    asm volatile("s_waitcnt vmcnt(0)" ::: "memory");
    __syncthreads();
    if (threadIdx.x == 0) {
        unsigned* bar = b.bar;
        __builtin_amdgcn_s_waitcnt(0);
        unsigned nloc = b.st[0], nx = b.st[1];
        if (nloc == 0u) { xcd_barrier_complete(bar, b.x, nloc, nx); b.st[0] = nloc; b.st[1] = nx; }
        const unsigned old = xb_add(&bar[XB_XSUB(b.x)], 1u);
        const unsigned gen = old / nloc;
        if (old + 1u == (gen + 1u) * nloc) {
            __builtin_amdgcn_fence(__ATOMIC_RELEASE, "agent");
            asm volatile("s_waitcnt vmcnt(0)" ::: "memory");
            const unsigned og = xb_add(&bar[XB_TOP], 1u);
            const unsigned tg = og / nx;
            if (og + 1u == (tg + 1u) * nx) xb_add(&bar[XB_TOPGEN], 1u);
            else XB_SPIN(xb_ld(&bar[XB_TOPGEN]) == tg, bar);
            __builtin_amdgcn_fence(__ATOMIC_ACQUIRE, "agent");
            xb_add(&bar[XB_XGEN(b.x)], 1u);
            asm volatile("s_waitcnt vmcnt(0)" ::: "memory");
        } else {
            XB_SPIN(xb_ld(&bar[XB_XGEN(b.x)]) == gen, bar);
            __builtin_amdgcn_fence(__ATOMIC_ACQUIRE, "agent");
            asm volatile("s_waitcnt vmcnt(0)" ::: "memory");
        }
    }
    __syncthreads();
}

struct Args { const float* in[32]; float* out; unsigned char* ws; int ph_lo, ph_hi; };
struct Ctx {
    LAS unsigned char* lds;
    int tid, lane, wave, G, bid;
    const float* const* in;
};
enum { I_X = 0, I_C, I_CTX, I_CCTX, I_WMOD, I_BMOD, I_N1G, I_N2G, I_WQKV, I_QG, I_KG, I_WO, I_HWIN, I_HBIN, I_HCW, I_HCB, I_HW1, I_HB1, I_HW2, I_HB2, I_HW3, I_HB3,
       I_HSF, I_HDB, I_HWOUT, I_HBOUT, I_RW, I_RB, I_WGU, I_BGU, I_WDN, I_BDN };

__device__ __forceinline__ int mod_row(int r) { return r < NLAT ? (r >> 11) : NB; }

__device__ __forceinline__ void gemm_unit_simple(const bf16_t* At, const bf16_t* Bt, f32x4 (&acc)[2][2][4][2], int wr, int wc, int fr, int fq) {
    constexpr int K = D;
#pragma unroll
    for (int a = 0; a < 2; ++a)
#pragma unroll
        for (int b = 0; b < 2; ++b)
#pragma unroll
            for (int m = 0; m < 4; ++m)
#pragma unroll
                for (int n = 0; n < 2; ++n) acc[a][b][m][n] = (f32x4){0.f, 0.f, 0.f, 0.f};
    const bf16_t* ap = At + (size_t)(wr * 64 + fr) * K + fq * 8;
    const bf16_t* bp = Bt + (size_t)(wc * 32 + fr) * K + fq * 8;
    for (int k0 = 0; k0 < K; k0 += 32) {
        bf16x8 bfr[2][2];
#pragma unroll
        for (int bj = 0; bj < 2; ++bj)
#pragma unroll
            for (int n = 0; n < 2; ++n) bfr[bj][n] = *(const bf16x8*)(bp + (size_t)(bj * 128 + n * 16) * K + k0);
#pragma unroll
        for (int ai = 0; ai < 2; ++ai)
#pragma unroll
            for (int m = 0; m < 4; ++m) {
                const bf16x8 afr = *(const bf16x8*)(ap + (size_t)(ai * 128 + m * 16) * K + k0);
#pragma unroll
                for (int bj = 0; bj < 2; ++bj)
#pragma unroll
                    for (int n = 0; n < 2; ++n) acc[ai][bj][m][n] = __builtin_amdgcn_mfma_f32_16x16x32_bf16(bfr[bj][n], afr, acc[ai][bj][m][n], 0, 0, 0);
            }
    }
}


struct Unit { int pm, pn, e; };
namespace pg8 {
constexpr int BM = 256, BK = 64, HALF = 128, HTB = HALF * BK * 2, STAGE_BYTES = 8 * HTB;
__device__ __forceinline__ int lds_byte(int r, int c) { const int st = (r >> 4) * 2 + (c >> 5), rr = r & 15, cc = c & 31, ob = rr * 64 + cc * 2; return st * 1024 + (ob ^ (((ob >> 9) & 1) << 5)); }
__device__ __forceinline__ void stage_rc(int b, int& R, int& C) { const int st = b / 1024, sb = b % 1024, swz = sb ^ (((sb >> 9) & 1) << 5); R = (st >> 1) * 16 + swz / 64; C = (st & 1) * 32 + (swz % 64) / 2; }
template <class Epi, class Sched, bool GATHER = false>
__device__ __forceinline__ void gemm_phase(LAS unsigned char* lds, const Sched& S, const Epi& E) {
    constexpr int K = D, nt = K / BK;
    const int tid = threadIdx.x, wid = __builtin_amdgcn_readfirstlane(tid >> 6), lane = tid & 63, wr = wid >> 2, wc = wid & 3, fr = lane & 15, fq = lane >> 4;
    unsigned voffA[2];
#pragma unroll
    for (int i = 0; i < 2; ++i) { int R, C; stage_rc(tid * 16 + i * 8192, R, C); voffA[i] = (unsigned)(R * K + C) * 2u; }
    const size_t kstep = (size_t)(BK * 2);
    const size_t hstep = (size_t)HALF * K * 2;
    const unsigned ldsw = (unsigned)wid * 1024u;
    const int aoff = lds_byte(wr * 64 + fr, fq * 8), boff = lds_byte(wc * 32 + fr, fq * 8);
#define PG8_SA(b, h) (((b) * 2 + (h)) * HTB)
#define PG8_SB(b, h) ((4 + (b) * 2 + (h)) * HTB)
#define PG8_STAGE(bufoff, gbase, voff) do { _Pragma("unroll") for (int _i = 0; _i < 2; ++_i) \
        __builtin_amdgcn_global_load_lds((const unsigned*)((const char*)(gbase) + (voff)[_i]), (LAS unsigned*)(lds + (bufoff) + ldsw + _i * 8192), 16, 0, 0); } while (0)
#define PG8_LDA(dst, b, h) do { _Pragma("unroll") for (int m = 0; m < 4; ++m) _Pragma("unroll") for (int k = 0; k < 2; ++k) dst[m][k] = *(const LAS bf16x8*)(lds + PG8_SA(b, h) + aoff + m * 2048 + k * 1024); } while (0)
#define PG8_LDB(dst, b, h) do { _Pragma("unroll") for (int n = 0; n < 2; ++n) _Pragma("unroll") for (int k = 0; k < 2; ++k) dst[n][k] = *(const LAS bf16x8*)(lds + PG8_SB(b, h) + boff + n * 2048 + k * 1024); } while (0)
#define PG8_MMA(ai, bj, At, Bt) do { __builtin_amdgcn_s_setprio(1); _Pragma("unroll") for (int m = 0; m < 4; ++m) _Pragma("unroll") for (int n = 0; n < 2; ++n) _Pragma("unroll") for (int k = 0; k < 2; ++k) \
        acc[ai][bj][m][n] = __builtin_amdgcn_mfma_f32_16x16x32_bf16(Bt[n][k], At[m][k], acc[ai][bj][m][n], 0, 0, 0); __builtin_amdgcn_s_setprio(0); } while (0)
#define PG8_WAIT_V(n) asm volatile("s_waitcnt vmcnt(" #n ")" ::: "memory")
#define PG8_WAIT_L(n) asm volatile("s_waitcnt lgkmcnt(" #n ")" ::: "memory")
#define PG8_BAR __builtin_amdgcn_s_barrier()
#define PG8_SCHED __builtin_amdgcn_sched_barrier(0)
    unsigned vA[2][2], vN[2][2]; unsigned gR[2], gC[2];
    const char* gA = nullptr;
    if constexpr (GATHER) {
        gA = S.a_base();
#pragma unroll
        for (int i = 0; i < 2; ++i) { gR[i] = voffA[i] / (unsigned)(K * 2); gC[i] = voffA[i] % (unsigned)(K * 2); }
        const LAS int* rw = S.rows(0);
#pragma unroll
        for (int h = 0; h < 2; ++h)
#pragma unroll
            for (int i = 0; i < 2; ++i) { vA[h][i] = (unsigned)rw[h * HALF + gR[i]] * (unsigned)(K * 2) + gC[i]; vN[h][i] = vA[h][i]; }
    }
#define PG8_STAGEA(bufoff, P, V, kt, h) do { if constexpr (GATHER) PG8_STAGE(bufoff, gA + (size_t)(kt) * kstep, V[h]); else PG8_STAGE(bufoff, (P) + (size_t)(kt) * kstep + (size_t)(h) * hstep, voffA); } while (0)
    Unit cur, nxt; int ui = 0;
    if (!S.next(0, cur)) return;
    f32x4 acc[2][2][4][2];
#pragma unroll
    for (int a = 0; a < 2; ++a)
#pragma unroll
        for (int b = 0; b < 2; ++b)
#pragma unroll
            for (int m = 0; m < 4; ++m)
#pragma unroll
                for (int n = 0; n < 2; ++n) acc[a][b][m][n] = (f32x4){0.f, 0.f, 0.f, 0.f};
    bf16x8 At[4][2], B0[2][2], B1[2][2];
    const char* cA = nullptr; if constexpr (!GATHER) cA = S.a_ptr(cur);
    const char* cB = S.b_ptr(cur);
    PG8_STAGE(PG8_SB(0, 0), cB, voffA); PG8_STAGE(PG8_SB(0, 1), cB + hstep, voffA); PG8_STAGEA(PG8_SA(0, 0), cA, vA, 0, 0); PG8_STAGEA(PG8_SA(0, 1), cA, vA, 0, 1);
    if (wr == 1) PG8_BAR;
    PG8_WAIT_V(2); PG8_BAR;
    PG8_STAGE(PG8_SB(1, 0), cB + kstep, voffA); PG8_STAGEA(PG8_SA(1, 0), cA, vA, 1, 0); PG8_STAGE(PG8_SB(1, 1), cB + hstep + kstep, voffA);
    PG8_WAIT_V(6); PG8_BAR;
    for (;;) {
        const bool has_next = S.next(ui + 1, nxt);
        const char* nA = cA; if constexpr (!GATHER) { if (has_next) nA = S.a_ptr(nxt); }
        const char* nB = has_next ? S.b_ptr(nxt) : cB;
        if constexpr (GATHER) { if (has_next) { const LAS int* rw = S.rows(ui + 1);
#pragma unroll
            for (int h = 0; h < 2; ++h)
#pragma unroll
                for (int i = 0; i < 2; ++i) vN[h][i] = (unsigned)rw[h * HALF + gR[i]] * (unsigned)(K * 2) + gC[i]; } }
        for (int t = 0; t < nt; t += 2) {
            const bool last = (t == nt - 2);
            const char* b2 = last ? nB : cB + (size_t)(t + 2) * kstep; const char* b3 = b2 + kstep;
            const char* pX = last ? nA : cA; const int kX = last ? 0 : t + 2;
            unsigned vX[2][2];
#pragma unroll
            for (int h = 0; h < 2; ++h)
#pragma unroll
                for (int i = 0; i < 2; ++i) vX[h][i] = last ? vN[h][i] : vA[h][i];
            PG8_LDB(B0, 0, 0); PG8_LDB(B1, 0, 1); PG8_SCHED; PG8_LDA(At, 0, 0); PG8_STAGEA(PG8_SA(1, 1), cA, vA, t + 1, 1);
            PG8_WAIT_V(8); PG8_WAIT_L(0); PG8_BAR; PG8_MMA(0, 0, At, B0); PG8_MMA(0, 1, At, B1); PG8_BAR; PG8_SCHED;
            PG8_LDA(At, 0, 1); PG8_STAGE(PG8_SB(0, 0), b2, voffA); PG8_STAGE(PG8_SB(0, 1), b2 + hstep, voffA); PG8_STAGEA(PG8_SA(0, 0), pX, vX, kX, 0);
            PG8_WAIT_V(8); PG8_WAIT_L(0); PG8_BAR; PG8_MMA(1, 0, At, B0); PG8_MMA(1, 1, At, B1); PG8_BAR; PG8_SCHED;
            PG8_LDB(B0, 1, 0); PG8_LDB(B1, 1, 1); PG8_SCHED; PG8_LDA(At, 1, 0); PG8_STAGEA(PG8_SA(0, 1), pX, vX, kX, 1);
            PG8_WAIT_V(8); PG8_WAIT_L(0); PG8_BAR; PG8_MMA(0, 0, At, B0); PG8_MMA(0, 1, At, B1); PG8_BAR; PG8_SCHED;
            PG8_LDA(At, 1, 1); PG8_STAGE(PG8_SB(1, 0), b3, voffA); PG8_STAGE(PG8_SB(1, 1), b3 + hstep, voffA); PG8_STAGEA(PG8_SA(1, 0), pX, vX, kX + 1, 0);
            PG8_WAIT_V(8); PG8_WAIT_L(0); PG8_BAR; PG8_MMA(1, 0, At, B0); PG8_MMA(1, 1, At, B1); PG8_BAR; PG8_SCHED;
        }
        if (wr == 0) PG8_BAR;
        E(acc, cur, wr, wc, fr, fq);
        if (!has_next) break;
#pragma unroll
        for (int a = 0; a < 2; ++a)
#pragma unroll
            for (int b = 0; b < 2; ++b)
#pragma unroll
                for (int m = 0; m < 4; ++m)
#pragma unroll
                    for (int n = 0; n < 2; ++n) acc[a][b][m][n] = (f32x4){0.f, 0.f, 0.f, 0.f};
        cur = nxt; cA = nA; cB = nB; ++ui;
        if constexpr (GATHER) {
#pragma unroll
            for (int h = 0; h < 2; ++h)
#pragma unroll
                for (int i = 0; i < 2; ++i) vA[h][i] = vN[h][i]; }
        if (wr == 1) PG8_BAR;
    }
    PG8_WAIT_V(0);
    PG8_BAR;
#undef PG8_SA
#undef PG8_SB
#undef PG8_STAGE
#undef PG8_STAGEA
#undef PG8_LDA
#undef PG8_LDB
#undef PG8_MMA
#undef PG8_WAIT_V
#undef PG8_WAIT_L
#undef PG8_BAR
#undef PG8_SCHED
}
}

template <class Epi, class Sched>
__device__ __forceinline__ void gemm_phase_simple(const Sched& S, const Epi& E) {
    const int tid = threadIdx.x, wid = __builtin_amdgcn_readfirstlane(tid >> 6), lane = tid & 63, wr = wid >> 2, wc = wid & 3, fr = lane & 15, fq = lane >> 4;
    Unit u;
    for (int i = 0; S.next(i, u); ++i) { f32x4 acc[2][2][4][2];
        gemm_unit_simple((const bf16_t*)S.a_ptr(u), (const bf16_t*)S.b_ptr(u), acc, wr, wc, fr, fq);
        E(acc, u, wr, wc, fr, fq); }
}
#ifndef FAST_GEMM
#define FAST_GEMM 1
#endif
template <class Epi, class Sched>
__device__ __forceinline__ void run_gemm(LAS unsigned char* lds, const Sched& S, const Epi& E) {
#if FAST_GEMM
    pg8::gemm_phase<Epi, Sched, false>(lds, S, E);
#else
    gemm_phase_simple<Epi, Sched>(S, E);
#endif
}
template <class Epi, class Sched>
__device__ __forceinline__ void run_gemm_gather(LAS unsigned char* lds, const Sched& S, const Epi& E) { pg8::gemm_phase<Epi, Sched, true>(lds, S, E); }
__device__ __forceinline__ bool xcd_unit(int i, int G, int c, int nM, int nN, int& pm, int& pn) {
    const int x = c & 7, s = c >> 3, nS = G >> 3;
    const int r0 = (nM * x) >> 3, r1 = (nM * (x + 1)) >> 3;
    const int q = i * nS + s; if (q >= (r1 - r0) * nN) return false;
    const int rr = q / nN; pm = r0 + rr; pn = q - rr * nN; return true;
}
struct DenseSched {
    const bf16_t* A; const bf16_t* Bt; int nM, nN, G, c;
    __device__ __forceinline__ bool next(int i, Unit& u) const { u.e = 0; return xcd_unit(i, G, c, nM, nN, u.pm, u.pn); }
    __device__ __forceinline__ const char* a_ptr(const Unit& u) const { return (const char*)(A + (size_t)u.pm * 256 * D); }
    __device__ __forceinline__ const char* b_ptr(const Unit& u) const { return (const char*)(Bt + (size_t)u.pn * 256 * D); }
};
struct QkvSched {
    const bf16_t* A; const bf16_t* Bt; int live, G, c;
    __device__ __forceinline__ bool next(int i, Unit& u) const { u.e = 0;
        if (live) return xcd_unit(i, G, c, 144, 6, u.pm, u.pn);
        const int x = c & 7, s = c >> 3, nS = G >> 3; const int nlat = 16 * 6; const int q = i * nS + s;
        if (q < nlat) { const int rr = q / 6; u.pm = 16 * x + rr; u.pn = q - rr * 6; return true; }
        const int q2 = q - nlat; if (q2 >= 4) return false; const int t = x * 4 + q2; u.pm = 128 + (t >> 1); u.pn = 4 + (t & 1); return true; }
    __device__ __forceinline__ const char* a_ptr(const Unit& u) const { return (const char*)(A + (size_t)u.pm * 256 * D); }
    __device__ __forceinline__ const char* b_ptr(const Unit& u) const { return (const char*)(Bt + (size_t)u.pn * 256 * D); }
};
struct MoeSched {
    const bf16_t* A; const bf16_t* Bt  ; const LAS unsigned char* TE; int nM, nN, N, G, c;
    __device__ __forceinline__ bool next(int i, Unit& u) const { if (!xcd_unit(i, G, c, nM, nN, u.pm, u.pn)) return false; u.e = TE[u.pm]; return true; }
    __device__ __forceinline__ const char* a_ptr(const Unit& u) const { return (const char*)(A + (size_t)u.pm * 256 * D); }
    __device__ __forceinline__ const char* b_ptr(const Unit& u) const { return (const char*)(Bt + ((size_t)u.e * N + (size_t)u.pn * 256) * D); }
};
struct MoeGatherSched {
    const bf16_t* A; const bf16_t* Bt; const LAS unsigned char* TE; const LAS int* ROWS; int nM, nN, N, G, c;
    __device__ __forceinline__ bool next(int i, Unit& u) const { if (!xcd_unit(i, G, c, nM, nN, u.pm, u.pn)) return false; u.e = TE[u.pm]; return true; }
    __device__ __forceinline__ const char* a_base() const { return (const char*)A; }
    __device__ __forceinline__ const LAS int* rows(int ui) const { return ROWS + ui * 256; }
    __device__ __forceinline__ const char* a_ptr(const Unit& u) const { return (const char*)A; }
    __device__ __forceinline__ const char* b_ptr(const Unit& u) const { return (const char*)(Bt + ((size_t)u.e * N + (size_t)u.pn * 256) * D); }
};

struct EpiQKV {
    bf16_t *Q, *Kb, *Vb; const float *qg, *kg, *cosT, *sinT;
    __device__ __forceinline__ void operator()(const f32x4 (&acc)[2][2][4][2], const Unit& uu, int wr, int wc, int fr, int fq) const {
        const int pm = uu.pm, pn = uu.pn;
        const int kind = pn < 4 ? 0 : (pn == 4 ? 1 : 2);
        const float* gain = kind == 0 ? qg : kg;
        f32x4 gv[2][2];
#pragma unroll
        for (int bj = 0; bj < 2; ++bj)
#pragma unroll
            for (int n = 0; n < 2; ++n) gv[bj][n] = *(const f32x4*)(gain + 32 * bj + 16 * n + 4 * fq);
#pragma unroll
        for (int ai = 0; ai < 2; ++ai)
#pragma unroll
            for (int m = 0; m < 4; ++m) {
                const int r = pm * 256 + ai * 128 + wr * 64 + m * 16 + fr;
                const bool lat = r < NLAT;
                const int b = lat ? (r >> 11) : ((r - NLAT) >> 8);
                const int pos = lat ? (r & (SEQ - 1)) : (SEQ + ((r - NLAT) & (CL - 1)));
                f32x4 v[2][2];
#pragma unroll
                for (int bj = 0; bj < 2; ++bj)
#pragma unroll
                    for (int n = 0; n < 2; ++n) v[bj][n] = acc[ai][bj][m][n];
                if (kind != 2) {
                    float ss = 0.f;
#pragma unroll
                    for (int bj = 0; bj < 2; ++bj)
#pragma unroll
                        for (int n = 0; n < 2; ++n) ss += (v[bj][n][0] * v[bj][n][0] + v[bj][n][1] * v[bj][n][1]) + (v[bj][n][2] * v[bj][n][2] + v[bj][n][3] * v[bj][n][3]);
                    ss += __shfl_xor(ss, 16); ss += __shfl_xor(ss, 32);
                    const float rinv = 1.0f / sqrtf(ss * (1.0f / 64.0f) + EPS);
#pragma unroll
                    for (int bj = 0; bj < 2; ++bj)
#pragma unroll
                        for (int n = 0; n < 2; ++n) v[bj][n] = v[bj][n] * rinv * gv[bj][n];
                    if (lat) {
#pragma unroll
                        for (int bj = 0; bj < 2; ++bj) {
                            const f32x4 cs = *(const f32x4*)(cosT + pos * 32 + bj * 16 + 4 * fq), sn = *(const f32x4*)(sinT + pos * 32 + bj * 16 + 4 * fq);
                            const f32x4 x1 = v[bj][0], x2 = v[bj][1];
                            v[bj][0] = x1 * cs - x2 * sn; v[bj][1] = x2 * cs + x1 * sn;
                        }
                    }
                    if (kind == 0) {
#pragma unroll
                        for (int bj = 0; bj < 2; ++bj)
#pragma unroll
                            for (int n = 0; n < 2; ++n) v[bj][n] = v[bj][n] * C2;
                    }
                }
                bf16_t* dst = kind == 0 ? Q + (size_t)r * D + pn * 256 + wc * 64
                                        : (kind == 1 ? Kb : Vb) + ((size_t)b * KVL + pos) * 256 + wc * 64;
#pragma unroll
                for (int bj = 0; bj < 2; ++bj) { u32x4 w; w.x = pk2(v[bj][0][0], v[bj][0][1]); w.y = pk2(v[bj][0][2], v[bj][0][3]); w.z = pk2(v[bj][1][0], v[bj][1][1]); w.w = pk2(v[bj][1][2], v[bj][1][3]);
                    *(u32x4*)(dst + 32 * bj + 8 * fq) = w; }
            }
    }
};
struct EpiBiasBf16 {
    bf16_t* O; int ldc; const float* bias0; int estride;
    __device__ __forceinline__ void operator()(const f32x4 (&acc)[2][2][4][2], const Unit& uu, int wr, int wc, int fr, int fq) const {
        const int row0 = uu.pm * 256, col0t = uu.pn * 256;
#pragma unroll
        for (int bj = 0; bj < 2; ++bj) {
            const int c = col0t + bj * 128 + wc * 32 + 8 * fq;
            const float* bp = bias0 + (size_t)uu.e * estride + c; const f32x4 b0 = *(const f32x4*)bp, b1 = *(const f32x4*)(bp + 4);
#pragma unroll
            for (int ai = 0; ai < 2; ++ai)
#pragma unroll
                for (int m = 0; m < 4; ++m) { const int r = row0 + ai * 128 + wr * 64 + m * 16 + fr; const f32x4 v0 = acc[ai][bj][m][0] + b0, v1 = acc[ai][bj][m][1] + b1;
                    u32x4 w; w.x = pk2(v0[0], v0[1]); w.y = pk2(v0[2], v0[3]); w.z = pk2(v1[0], v1[1]); w.w = pk2(v1[2], v1[3]); *(u32x4*)(O + (size_t)r * ldc + c) = w; }
        }
    }
};
template <bool SRC32> struct EpiResid {
    const float *srcL, *srcC; bf16_t* XB; const float* gate  ; const float* bias;
    __device__ __forceinline__ void operator()(f32x4 (&acc)[2][2][4][2], const Unit& uu, int wr, int wc, int fr, int fq) const {
        const int row0 = uu.pm * 256, col0t = uu.pn * 256;
        const float* gp0 = gate + (size_t)mod_row(row0) * MODW;
        const float* sb = row0 < NLAT ? srcL + (size_t)row0 * D : srcC + (size_t)(row0 - NLAT) * D;
        bf16_t* xb = XB + (size_t)row0 * D;
#pragma unroll
        for (int bj = 0; bj < 2; ++bj) {
            const int c = col0t + bj * 128 + wc * 32 + 8 * fq;
            const f32x4 g0 = *(const f32x4*)(gp0 + c), g1 = *(const f32x4*)(gp0 + c + 4);
            f32x4 b0 = (f32x4){0.f, 0.f, 0.f, 0.f}, b1 = b0; if (bias) { b0 = *(const f32x4*)(bias + c); b1 = *(const f32x4*)(bias + c + 4); }
#pragma unroll
            for (int ai = 0; ai < 2; ++ai) {
                f32x4 x0[4], x1[4];
#pragma unroll
                for (int m = 0; m < 4; ++m) { const size_t ro = (size_t)(ai * 128 + wr * 64 + m * 16 + fr) * D + c;
                    if constexpr (SRC32) { x0[m] = *(const f32x4*)(sb + ro); x1[m] = *(const f32x4*)(sb + ro + 4); }
                    else { const u32x4 w = *(const u32x4*)(xb + ro); x0[m] = (f32x4){bflo(w.x), bfhi(w.x), bflo(w.y), bfhi(w.y)}; x1[m] = (f32x4){bflo(w.z), bfhi(w.z), bflo(w.w), bfhi(w.w)}; } }
#pragma unroll
                for (int m = 0; m < 4; ++m) { const size_t ro = (size_t)(ai * 128 + wr * 64 + m * 16 + fr) * D + c;
                    const f32x4 y0 = x0[m] + g0 * (acc[ai][bj][m][0] + b0), y1 = x1[m] + g1 * (acc[ai][bj][m][1] + b1);
                    u32x4 w; w.x = pk2(y0[0], y0[1]); w.y = pk2(y0[2], y0[3]); w.z = pk2(y1[0], y1[1]); w.w = pk2(y1[2], y1[3]); *(u32x4*)(xb + ro) = w; }
                asm volatile("" ::: "memory");
            }
        }
    }
};
struct EpiSwiglu {
    bf16_t* O; const float* bgu0  ;
    __device__ __forceinline__ void operator()(const f32x4 (&acc)[2][2][4][2], const Unit& uu, int wr, int wc, int fr, int fq) const {
        const int row0 = uu.pm * 256, pn = uu.pn; const float* bgu = bgu0 + (size_t)uu.e * NGU;
        const int f = pn * 128 + wc * 32 + 8 * fq;
        f32x4 bg[2], bu[2];
#pragma unroll
        for (int n = 0; n < 2; ++n) { const f32x4 q0 = *(const f32x4*)(bgu + 2 * (f + 4 * n)), q1 = *(const f32x4*)(bgu + 2 * (f + 4 * n) + 4);
            bg[n] = (f32x4){q0[0], q0[2], q1[0], q1[2]}; bu[n] = (f32x4){q0[1], q0[3], q1[1], q1[3]}; }
#pragma unroll
        for (int ai = 0; ai < 2; ++ai)
#pragma unroll
            for (int m = 0; m < 4; ++m) { const int r = row0 + ai * 128 + wr * 64 + m * 16 + fr; float o[8];
#pragma unroll
                for (int n = 0; n < 2; ++n) { const f32x4 gg = acc[ai][0][m][n] + bg[n], uq = acc[ai][1][m][n] + bu[n];
#pragma unroll
                    for (int p = 0; p < 2; ++p) {
                        f32x2 g2 = {fminf(gg[2 * p], 7.0f), fminf(gg[2 * p + 1], 7.0f)};
                        f32x2 u2 = {__builtin_amdgcn_fmed3f(uq[2 * p], -7.0f, 7.0f), __builtin_amdgcn_fmed3f(uq[2 * p + 1], -7.0f, 7.0f)};
                        const f32x2 z = g2 * (-2.4554669595930157f);
                        f32x2 e2 = {__builtin_amdgcn_exp2f(z.x), __builtin_amdgcn_exp2f(z.y)};
                        e2 = e2 + 1.0f;
                        const f32x2 r2 = {__builtin_amdgcn_rcpf(e2.x), __builtin_amdgcn_rcpf(e2.y)};
                        const f32x2 o2 = ((u2 + 1.0f) * g2) * r2;
                        o[4 * n + 2 * p] = o2.x; o[4 * n + 2 * p + 1] = o2.y; } }
                u32x4 w; w.x = pk2(o[0], o[1]); w.y = pk2(o[2], o[3]); w.z = pk2(o[4], o[5]); w.w = pk2(o[6], o[7]); *(u32x4*)(O + (size_t)r * D + f) = w; }
    }
};

__device__ __forceinline__ int slot32(int cg) { return (((cg >> 2) & 1) << 4) + ((cg >> 3) << 2) + (cg & 3); }
template <int MODE> __device__ __forceinline__ int wrow_map(int n) {
    if (MODE == 0) return (n & ~31) + slot32(n & 31);
    if (MODE == 1) { const int pn = n >> 8, wc = (n >> 6) & 3, bj = (n >> 5) & 1, j = n & 31;
        return (pn << 8) + (bj << 7) + (wc << 5) + (pn < 5 ? j : slot32(j)); }
    { const int f = n >> 1, pn = f >> 7, fo = f & 127; return (pn << 8) + ((n & 1) << 7) + (fo & ~31) + slot32(fo & 31); }
}
template <int MODE> __device__ __forceinline__ void transpose_item(const float* W, int N, bf16_t* WT, LAS float* scr, int item, int lane) {
    constexpr int K = D;
    const int nblk = N / 32, kb = item / nblk, nb = item % nblk, k0 = 64 * kb, n0 = 32 * nb;
#pragma unroll 8
    for (int i = 0; i < 32; ++i) { const int kk = 2 * i + (lane >> 5); scr[kk * 33 + (lane & 31)] = __builtin_nontemporal_load(W + (size_t)(k0 + kk) * N + n0 + (lane & 31)); }
    LDS_WAIT(); asm volatile("" ::: "memory");
    const int c = lane & 7;
#pragma unroll
    for (int j = 0; j < 4; ++j) { const int n = (lane >> 3) + 8 * j; const LAS float* s = scr + (8 * c) * 33 + n;
        u32x4 o; o.x = pk2(s[0 * 33], s[1 * 33]); o.y = pk2(s[2 * 33], s[3 * 33]); o.z = pk2(s[4 * 33], s[5 * 33]); o.w = pk2(s[6 * 33], s[7 * 33]);
        __builtin_nontemporal_store(o, (u32x4*)(WT + (size_t)wrow_map<MODE>(n0 + n) * K + k0 + 8 * c)); }
    LDS_WAIT(); asm volatile("" ::: "memory");
}

__device__ __forceinline__ void norm_mod_store(const f32x4 (&v)[4], const f32x4 (&gs)[4], const f32x4 (&sh)[4], bf16_t* dst, int lane, f32x4 (&h)[4]) {
    float ss = 0.f;
#pragma unroll
    for (int j = 0; j < 4; ++j) ss += (v[j][0] * v[j][0] + v[j][1] * v[j][1]) + (v[j][2] * v[j][2] + v[j][3] * v[j][3]);
    ss = wave_sum(ss);
    const float rinv = __builtin_amdgcn_rsqf(ss * (1.0f / D) + EPS);
#pragma unroll
    for (int j = 0; j < 4; ++j) {
        h[j] = (v[j] * rinv) * gs[j] + sh[j];
        u32x2 w; w.x = pk2(h[j][0], h[j][1]); w.y = pk2(h[j][2], h[j][3]);
        ((u32x2*)dst)[lane + 64 * j] = w;
    }
}
__device__ __forceinline__ void load_vec_bf(const bf16_t* p, int lane, f32x4 (&v)[4]) {
#pragma unroll
    for (int j = 0; j < 4; ++j) { const u32x2 w = ((const u32x2*)p)[lane + 64 * j]; v[j] = (f32x4){bflo(w.x), bfhi(w.x), bflo(w.y), bfhi(w.y)}; }
}
__device__ __forceinline__ void load_vec(const float* p, int lane, f32x4 (&v)[4]) {
#pragma unroll
    for (int j = 0; j < 4; ++j) v[j] = ((const f32x4*)p)[lane + 64 * j];
}


namespace attn_body {
using bf16=__hip_bfloat16;
using bf16x8=__attribute__((ext_vector_type(8)))short;
using s16x4=__attribute__((ext_vector_type(4)))short;
using f32x16=__attribute__((ext_vector_type(16)))float;
using u32x4=__attribute__((ext_vector_type(4)))unsigned;
constexpr int D=64,DM=1024,KVP=256;
constexpr int NW=8,QBLK=32,QB=QBLK*NW,KVBLK=64;
__device__ __forceinline__ int crow(int r,int hi){return (r&3)+8*(r>>2)+4*hi;}
#define SBAR() __builtin_amdgcn_sched_barrier(0)
__device__ __forceinline__ void cmask(f32x16&p0,f32x16&p1,int jb,int qrel,int hi){
  const float NEG=-INFINITY; int kb=64*jb+4*hi;
  #pragma unroll
  for(int r=0;r<16;++r){int kv=kb+(r&3)+8*(r>>2); if(kv>qrel)p0[r]=NEG; if(kv+32>qrel)p1[r]=NEG;}
}

constexpr int NSLOT=3, SLOTB=8192;
constexpr int LDS_K=0, LDS_V=NSLOT*SLOTB, LDS_WS=2*NSLOT*SLOTB, LDS_OST=LDS_WS+NW*64*4, LDS_BYTES=LDS_OST+NW*4096;
constexpr float C2=0.125f*1.4426950408889634f;
__device__ __forceinline__ void glds16(const void*gsrc,unsigned lds_dst){unsigned keep;
  asm volatile("s_mov_b32 %0, m0\n\ts_mov_b32 m0, %2\n\ts_nop 0\n\tglobal_load_lds_dwordx4 %1, off\n\ts_mov_b32 m0, %0":"=&s"(keep):"v"(gsrc),"s"(lds_dst):"memory");}
__device__ __forceinline__ float max3f(float a,float b,float c){float r;asm("v_max3_f32 %0, %1, %2, %3":"=v"(r):"v"(a),"v"(b),"v"(c));return r;}
__device__ __forceinline__ float max2f(float a,float b){float r;asm("v_max_f32_e32 %0, %1, %2":"=v"(r):"v"(a),"v"(b));return r;}
__device__ __forceinline__ float fadd_s(float a,float b){float r;asm("v_add_f32_e32 %0, %1, %2":"=v"(r):"v"(a),"v"(b));return r;}
__device__ __forceinline__ float fsub_s(float a,float b){float r;asm("v_sub_f32_e32 %0, %1, %2":"=v"(r):"v"(a),"v"(b));return r;}
typedef float f32x2_t __attribute__((ext_vector_type(2))); typedef __bf16 bf16x2_t __attribute__((ext_vector_type(2)));
__device__ __forceinline__ unsigned cvtpk_s(float lo,float hi){f32x2_t v={lo,hi};bf16x2_t b=__builtin_convertvector(v,bf16x2_t);return __builtin_bit_cast(unsigned,b);}
#define WAIT_BAR(N) asm volatile("s_waitcnt vmcnt(" #N ") lgkmcnt(0)\n\ts_barrier":::"memory")

__device__ __forceinline__ void qkt(f32x16&p0,f32x16&p1,const char*Kslot,const bf16x8*qr,const f32x16&negm,int r32,int hi){
  const char*kb=Kslot+hi*1024+r32*16;
  #pragma unroll
  for(int d0=0;d0<4;++d0){
    const bf16x8 b0=*reinterpret_cast<const bf16x8*>(kb+d0*2048);
    const bf16x8 b1=*reinterpret_cast<const bf16x8*>(kb+d0*2048+512);
    if(d0==0){p0=__builtin_amdgcn_mfma_f32_32x32x16_bf16(b0,qr[0],negm,0,0,0);p1=__builtin_amdgcn_mfma_f32_32x32x16_bf16(b1,qr[0],negm,0,0,0);}
    else{p0=__builtin_amdgcn_mfma_f32_32x32x16_bf16(b0,qr[d0],p0,0,0,0);p1=__builtin_amdgcn_mfma_f32_32x32x16_bf16(b1,qr[d0],p1,0,0,0);}}
}
typedef __attribute__((address_space(3))) const char* lds_cptr;
typedef short v4i16_t __attribute__((ext_vector_type(4)));
__device__ __forceinline__ void kload8(bf16x8*kf,lds_cptr kp){
  kf[0]=*(const __attribute__((address_space(3))) bf16x8*)(kp);      kf[1]=*(const __attribute__((address_space(3))) bf16x8*)(kp+512);
  kf[2]=*(const __attribute__((address_space(3))) bf16x8*)(kp+2048); kf[3]=*(const __attribute__((address_space(3))) bf16x8*)(kp+2560);
  kf[4]=*(const __attribute__((address_space(3))) bf16x8*)(kp+4096); kf[5]=*(const __attribute__((address_space(3))) bf16x8*)(kp+4608);
  kf[6]=*(const __attribute__((address_space(3))) bf16x8*)(kp+6144); kf[7]=*(const __attribute__((address_space(3))) bf16x8*)(kp+6656);
}
__device__ __forceinline__ void kload2(bf16x8*kf,lds_cptr kp,int j){ kf[2*j]=*(const __attribute__((address_space(3))) bf16x8*)(kp+j*2048); kf[2*j+1]=*(const __attribute__((address_space(3))) bf16x8*)(kp+j*2048+512); }
__device__ __forceinline__ s16x4 vtr(lds_cptr p){ return __builtin_bit_cast(s16x4,__builtin_amdgcn_ds_read_tr16_b64_v4i16((__attribute__((address_space(3))) v4i16_t*)p)); }
__device__ __forceinline__ float rowmax(const f32x16&p0,const f32x16&p1){
  float a=max3f(p0[0],p0[1],p1[0]),b=max3f(p0[2],p0[3],p1[1]);a=max3f(a,p1[2],p1[3]);
  #pragma unroll
  for(int r=4;r<16;r+=4){a=max3f(a,p0[r],p0[r+1]);b=max3f(b,p0[r+2],p0[r+3]);a=max3f(a,p1[r],p1[r+1]);b=max3f(b,p1[r+2],p1[r+3]);}
  const float m=max2f(a,b);
  auto rr=__builtin_amdgcn_permlane32_swap(__float_as_uint(m),__float_as_uint(m),false,false);
  return max2f(__uint_as_float(rr[0]),__uint_as_float(rr[1]));
}
__device__ __forceinline__ void pv(f32x16*o,int vb,bf16x8 pa0,bf16x8 pa1,bf16x8 pa2,bf16x8 pa3){
  #pragma unroll
  for(int d0=0;d0<2;++d0){s16x4 lo[4],hi[4];
    #pragma unroll
    for(int ks=0;ks<4;++ks){
      asm volatile("ds_read_b64_tr_b16 %0,%1 offset:%c2":"=&v"(lo[ks]):"v"(vb),"i"(d0*4096+ks*1024):"memory");
      asm volatile("ds_read_b64_tr_b16 %0,%1 offset:%c2":"=&v"(hi[ks]):"v"(vb),"i"(d0*4096+ks*1024+512):"memory");}
    asm volatile("s_waitcnt lgkmcnt(0)":::"memory");SBAR();
    #define PK(k) (bf16x8){lo[k][0],lo[k][1],lo[k][2],lo[k][3],hi[k][0],hi[k][1],hi[k][2],hi[k][3]}
    o[d0]=__builtin_amdgcn_mfma_f32_32x32x16_bf16(pa0,PK(0),o[d0],0,0,0);
    o[d0]=__builtin_amdgcn_mfma_f32_32x32x16_bf16(pa1,PK(1),o[d0],0,0,0);
    o[d0]=__builtin_amdgcn_mfma_f32_32x32x16_bf16(pa2,PK(2),o[d0],0,0,0);
    o[d0]=__builtin_amdgcn_mfma_f32_32x32x16_bf16(pa3,PK(3),o[d0],0,0,0);
    #undef PK
  }
}

#ifndef ATTN_STORE16
#define ATTN_STORE16(p,v) (*(u32x4*)(p)=(v))
#endif
template<int THRL> __device__ __forceinline__ void attn_unit(const bf16*Qu,const bf16*__restrict__ Kh,const bf16*__restrict__ Vh,bf16*Ou,const int NT,char*shm){
  const int tid=threadIdx.x,lane=tid&63,r32=lane&31,hi=lane>>5; const int wid=__builtin_amdgcn_readfirstlane(tid>>6);
  const bf16*Qw=Qu+(long)(wid*QBLK)*DM;
  const unsigned lds0=(unsigned)(uintptr_t)shm;
  float*wsf=(float*)(shm+LDS_WS)+wid*64;
  const bf16*ksrc=Kh+(long)lane*KVP+wid*8;
  const bf16*vsrc=Vh+(long)(16*(wid&3)+(lane>>2))*KVP+(wid>>2)*32+(lane&3)*8;
  const unsigned kdst=lds0+LDS_K+wid*1024, vdst=lds0+LDS_V+wid*1024;
  #define DMA_K(t,slot) glds16(ksrc+(long)(t)*KVBLK*KVP,(unsigned)__builtin_amdgcn_readfirstlane(kdst+(slot)))
  #define DMA_V(t,slot) glds16(vsrc+(long)(t)*KVBLK*KVP,(unsigned)__builtin_amdgcn_readfirstlane(vdst+(slot)))
  const int vb0=(int)(lds0+LDS_V)+((lane>>4)&1)*32+(lane&3)*8+(4*hi+((lane&15)>>2))*64;
  const char*Kbase=shm+LDS_K; bf16x8 kf[8];
  const lds_cptr shm3=(lds_cptr)shm; const lds_cptr kp0=shm3+LDS_K+hi*1024+r32*16; const lds_cptr vp0=shm3+LDS_V+((lane>>4)&1)*32+(lane&3)*8+(4*hi+((lane&15)>>2))*64;
  DMA_K(0,0);DMA_V(0,0);DMA_K(1,SLOTB);
  bf16x8 qr[4];
  #pragma unroll
  for(int d0=0;d0<4;++d0)qr[d0]=*reinterpret_cast<const bf16x8*>(&Qw[(long)r32*DM+d0*16+hi*8]);
  float mhat=0.f,l_reg=0.f;f32x16 o[2];o[0]=f32x16{};o[1]=f32x16{};f32x16 negm=f32x16{};asm volatile("":"+v"(negm));
  #define CMASK(P0,P1,t) do{}while(0)
  bool resc=false;
  #define START(P0,P1) do{ const float rm=rowmax(P0,P1); resc=false; \
    { const float dl=rm; mhat=fadd_s(mhat,dl); \
      _Pragma("unroll") for(int r=0;r<16;++r){P0[r]=fsub_s(P0[r],dl);P1[r]=fsub_s(P1[r],dl);} \
      _Pragma("unroll") for(int r=0;r<16;++r)negm[r]=-mhat; asm volatile("":"+v"(negm)); } \
    _Pragma("unroll") for(int r=0;r<16;++r)P0[r]=__builtin_amdgcn_exp2f(P0[r]); }while(0)
  #define RESC() do{ if(resc){ asm volatile("s_waitcnt lgkmcnt(0)":::"memory"); \
      _Pragma("unroll") for(int d_=0;d_<2;++d_) _Pragma("unroll") for(int r=0;r<16;++r)o[d_][r]*=wsf[crow(r,hi)]; } }while(0)
  f32x16 pA0,pA1,pB0,pB1;
  int sl_prev=0,sl_cur=0,sl_next=SLOTB;
  #define ROT() do{sl_prev=sl_cur;sl_cur=sl_next;sl_next=(sl_next==(NSLOT-1)*SLOTB)?0:sl_next+SLOTB;}while(0)
  DMA_K(2,2*SLOTB);
  WAIT_BAR(3);
  qkt(pA0,pA1,Kbase,qr,negm,r32,hi);asm volatile("s_nop 15\n\ts_nop 7":"+v"(pA0),"+v"(pA1));CMASK(pA0,pA1,0);
  START(pA0,pA1);
  _Pragma("unroll") for(int r=0;r<16;++r)pA1[r]=__builtin_amdgcn_exp2f(pA1[r]);
  WAIT_BAR(0);
  DMA_K(3,0);DMA_V(1,SLOTB);
  ROT();
  kload8(kf,kp0+sl_cur);
  WAIT_BAR(2);
  s16x4 vlo[8],vhi[8]; u32x4 pw0,pw1,pw2,pw3;
  #define PKW(P,B) cvtpk_s(P[B],P[B+1])
  #define PAF(k) __builtin_bit_cast(bf16x8,pw##k)
  #define VFR(i) (bf16x8){vlo[i][0],vlo[i][1],vlo[i][2],vlo[i][3],vhi[i][0],vhi[i][1],vhi[i][2],vhi[i][3]}
  #define PIN(x) asm volatile("":"+v"(x))
  #define MX3(a,b,c) __builtin_fmaxf(__builtin_fmaxf((a),(b)),(c))
  #define GAPA(MF,A0,A1,A2,A3,W0,W1,PW) do{ MF; sacc+=A0; sacc+=A1; sacc+=A2; sacc+=A3; PIN(sacc); W0; W1; PIN(PW); SBAR(); }while(0)
  #define EX(v) __builtin_amdgcn_exp2f(v)
  #define GAPB(MF,X,B) do{ MF; X[B]=EX(X[B]); X[B+1]=EX(X[B+1]); X[B+2]=EX(X[B+2]); X[B+3]=EX(X[B+3]); PIN(X); SBAR(); }while(0)
  #define VRD(i) do{ vlo[i]=vtr(vp_+(((i)>>2)*4096+((i)&3)*1024)); vhi[i]=vtr(vp_+(((i)>>2)*4096+((i)&3)*1024+512)); }while(0)
  #define KRD(G,j) do{ if(G){ kload2(kf,kp0+sl_next,j); SBAR(); } }while(0)
  #define STEP(C0,C1,P0,P1,t,GK,GV,GL) do{ SBAR(); \
    const lds_cptr vp_=vp0+sl_prev; \
    VRD(0); SBAR(); float sacc=(P0[0]+P0[1]); \
    GAPA(C0=__builtin_amdgcn_mfma_f32_32x32x16_bf16(kf[0],qr[0],negm,0,0,0), P0[2],P0[3],P0[4],P0[5],     pw0[0]=PKW(P0,0), pw0[1]=PKW(P0,2), pw0); \
    VRD(4); SBAR(); GAPA(C1=__builtin_amdgcn_mfma_f32_32x32x16_bf16(kf[1],qr[0],negm,0,0,0), P0[6],P0[7],P0[8],P0[9],     pw0[2]=PKW(P0,4), pw0[3]=PKW(P0,6), pw0); \
    VRD(1); SBAR(); GAPA(C0=__builtin_amdgcn_mfma_f32_32x32x16_bf16(kf[2],qr[1],C0,0,0,0),   P0[10],P0[11],P0[12],P0[13], pw1[0]=PKW(P0,8), pw1[1]=PKW(P0,10), pw1); \
    VRD(5); SBAR(); GAPA(C1=__builtin_amdgcn_mfma_f32_32x32x16_bf16(kf[3],qr[1],C1,0,0,0),   P0[14],P0[15],P1[0],P1[1],   pw1[2]=PKW(P0,12),pw1[3]=PKW(P0,14), pw1); \
    VRD(2); SBAR(); GAPA(C0=__builtin_amdgcn_mfma_f32_32x32x16_bf16(kf[4],qr[2],C0,0,0,0),   P1[2],P1[3],P1[4],P1[5],     pw2[0]=PKW(P1,0), pw2[1]=PKW(P1,2), pw2); \
    VRD(6); SBAR(); GAPA(C1=__builtin_amdgcn_mfma_f32_32x32x16_bf16(kf[5],qr[2],C1,0,0,0),   P1[6],P1[7],P1[8],P1[9],     pw2[2]=PKW(P1,4), pw2[3]=PKW(P1,6), pw2); \
    VRD(3); SBAR(); GAPA(C0=__builtin_amdgcn_mfma_f32_32x32x16_bf16(kf[6],qr[3],C0,0,0,0),   P1[10],P1[11],P1[12],P1[13], pw3[0]=PKW(P1,8), pw3[1]=PKW(P1,10), pw3); \
    VRD(7); SBAR(); GAPA(C1=__builtin_amdgcn_mfma_f32_32x32x16_bf16(kf[7],qr[3],C1,0,0,0),   P1[14],P1[15],0.f,0.f,       pw3[2]=PKW(P1,12),pw3[3]=PKW(P1,14), pw3); \
    l_reg+=sacc; \
    if(GK){DMA_K((t)+3,sl_cur);} if(GV){DMA_V((t)+1,sl_next);} \
    CMASK(C0,C1,t); \
    { float a=MX3(C0[0],C0[1],C1[0]),b=MX3(C0[2],C0[3],C1[1]); a=MX3(a,C1[2],C1[3]); \
      _Pragma("unroll") for(int r=4;r<16;r+=4){a=MX3(a,C0[r],C0[r+1]);b=MX3(b,C0[r+2],C0[r+3]);a=MX3(a,C1[r],C1[r+1]);b=MX3(b,C1[r+2],C1[r+3]);} \
      float rm=__builtin_fmaxf(a,b); { auto rr=__builtin_amdgcn_permlane32_swap(__float_as_uint(rm),__float_as_uint(rm),false,false); rm=__builtin_fmaxf(__uint_as_float(rr[0]),__uint_as_float(rr[1])); } \
      resc=false; \
      if(__builtin_expect(__any(rm>(float)THRL),0)){ const float dl=__builtin_fmaxf(rm,0.f); mhat+=dl; \
        _Pragma("unroll") for(int r=0;r<16;++r){C0[r]-=dl;C1[r]-=dl;} \
        _Pragma("unroll") for(int r=0;r<16;++r)negm[r]=-mhat; asm volatile("":"+v"(negm)); \
        const float f=__builtin_amdgcn_exp2f(-dl); l_reg*=f; if(hi==0)wsf[r32]=f; resc=true; } } \
    SBAR(); \
    GAPB(o[0]=__builtin_amdgcn_mfma_f32_32x32x16_bf16(PAF(0),VFR(0),o[0],0,0,0), C0,0); \
    GAPB(o[1]=__builtin_amdgcn_mfma_f32_32x32x16_bf16(PAF(0),VFR(4),o[1],0,0,0), C0,4); \
    KRD(GL,0); GAPB(o[0]=__builtin_amdgcn_mfma_f32_32x32x16_bf16(PAF(1),VFR(1),o[0],0,0,0), C0,8); \
    KRD(GL,1); GAPB(o[1]=__builtin_amdgcn_mfma_f32_32x32x16_bf16(PAF(1),VFR(5),o[1],0,0,0), C0,12); \
    KRD(GL,2); GAPB(o[0]=__builtin_amdgcn_mfma_f32_32x32x16_bf16(PAF(2),VFR(2),o[0],0,0,0), C1,0); \
    KRD(GL,3); GAPB(o[1]=__builtin_amdgcn_mfma_f32_32x32x16_bf16(PAF(2),VFR(6),o[1],0,0,0), C1,4); \
    GAPB(o[0]=__builtin_amdgcn_mfma_f32_32x32x16_bf16(PAF(3),VFR(3),o[0],0,0,0), C1,8); \
    GAPB(o[1]=__builtin_amdgcn_mfma_f32_32x32x16_bf16(PAF(3),VFR(7),o[1],0,0,0), C1,12); \
    }while(0)
  int t=1;
  #undef CMASK
  #define CMASK(P0,P1,t) do{}while(0)
  for(;t+5<NT;t+=2){
    STEP(pB0,pB1,pA0,pA1,t,true,true,true);     WAIT_BAR(2); RESC(); ROT();
    STEP(pA0,pA1,pB0,pB1,t+1,true,true,true);   WAIT_BAR(2); RESC(); ROT();
  }
  #undef CMASK
  #define CMASK(P0,P1,t) do{}while(0)
  #define ENDW(tt) do{ if((tt)+3<NT){WAIT_BAR(2);} else if((tt)+2<NT){WAIT_BAR(1);} else {WAIT_BAR(0);} }while(0)
  for(;t+1<NT;t+=2){
    STEP(pB0,pB1,pA0,pA1,t,(t+3<NT),(t+1<NT),(t+1<NT));       ENDW(t);   RESC(); ROT();
    STEP(pA0,pA1,pB0,pB1,t+1,(t+4<NT),(t+2<NT),(t+2<NT));     ENDW(t+1); RESC(); ROT();
  }
  STEP(pB0,pB1,pA0,pA1,NT-1,false,false,false); RESC();
  { float sacc=pB0[0]+pB0[1]; _Pragma("unroll") for(int r=2;r<16;++r)sacc+=pB0[r]; _Pragma("unroll") for(int r=0;r<16;++r)sacc+=pB1[r]; l_reg+=sacc;
    pw0=(u32x4){PKW(pB0,0),PKW(pB0,2),PKW(pB0,4),PKW(pB0,6)};pw1=(u32x4){PKW(pB0,8),PKW(pB0,10),PKW(pB0,12),PKW(pB0,14)};pw2=(u32x4){PKW(pB1,0),PKW(pB1,2),PKW(pB1,4),PKW(pB1,6)};pw3=(u32x4){PKW(pB1,8),PKW(pB1,10),PKW(pB1,12),PKW(pB1,14)};
    SBAR(); pv(o,vb0+sl_cur,PAF(0),PAF(1),PAF(2),PAF(3)); }
  #undef PKW
  #undef PAF
  #undef VFR
  #undef PIN
  #undef MX3
  #undef GAPA
  #undef GAPB
  #undef EX
  #undef VRD
  #undef KRD
  #undef STEP
  #undef ENDW
  {auto rr=__builtin_amdgcn_permlane32_swap(__float_as_uint(l_reg),__float_as_uint(l_reg),false,false);l_reg=__uint_as_float(rr[0])+__uint_as_float(rr[1]);}
  if(hi==0)wsf[32+r32]=l_reg;asm volatile("s_waitcnt lgkmcnt(0)":::"memory");
  float rli[16];
  #pragma unroll
  for(int r=0;r<16;++r)rli[r]=__builtin_amdgcn_rcpf(wsf[32+crow(r,hi)]);
  bf16*Ow=Ou+(long)(wid*QBLK)*DM;
  { bf16*stg=(bf16*)(shm+LDS_OST)+wid*2048;
    #pragma unroll
    for(int r=0;r<16;++r){const int orow=crow(r,hi);
      #pragma unroll
      for(int d0=0;d0<2;++d0)stg[orow*64+d0*32+r32]=__float2bfloat16(o[d0][r]*rli[r]);}
    asm volatile("s_waitcnt lgkmcnt(0)":::"memory");
    #pragma unroll
    for(int i=0;i<4;++i){const int row=i*8+(lane>>3),ch=lane&7; const u32x4 v=*(const u32x4*)(stg+row*64+ch*8); ATTN_STORE16(Ow+(long)row*DM+ch*8,v);} }
  asm volatile("s_waitcnt lgkmcnt(0)\n\ts_barrier":::"memory");
  #undef DMA_K
  #undef DMA_V
  #undef CMASK
  #undef START
  #undef RESC
  #undef ROT
}
constexpr int ATTN_LDS_BYTES=LDS_BYTES;
#undef SBAR
#undef WAIT_BAR
}

template <int LF>
__device__ __forceinline__ void conv_channel(LAS unsigned char* lds, const bf16_t* FIc, const bf16_t* wsrc, bf16_t* ydst, int tid, int lane, int wv) {
    constexpr int IPW = LF / 256, NBK = LF / 32, P = 2 * LF + 8, WSTR = LF + 8;
    LAS unsigned char* FIL = lds; LAS unsigned char* WL = lds + ((8 * P * 2 + 255) & ~255);
    __syncthreads();
    { const u32x4* fs = (const u32x4*)FIc; for (int i = tid; i < 8 * P * 2 / 16; i += NTHR) ((LAS u32x4*)FIL)[i] = fs[i]; }
    for (int i = tid; i < NB * (LF / 8); i += NTHR) { const int b = i / (LF / 8), ch = i % (LF / 8); *(LAS u32x4*)(WL + b * (WSTR * 2) + ch * 16) = *(const u32x4*)(wsrc + (size_t)b * LF + ch * 8); }
    __syncthreads();
    f32x4 acc[IPW][2]; bf16x8 Bw[IPW];
#pragma unroll
    for (int ii = 0; ii < IPW; ++ii) { acc[ii][0] = (f32x4){0.f, 0.f, 0.f, 0.f}; acc[ii][1] = (f32x4){0.f, 0.f, 0.f, 0.f}; Bw[ii] = (bf16x8){0, 0, 0, 0, 0, 0, 0, 0}; }
    const int rr = lane & 15, q = lane >> 4;
    const int aBase = (rr & 7) * (P * 2) + 2 * (LF - (rr - (rr & 7)) + 8 * q);
    const int bBase = rr * (WSTR * 2) + 16 * q;
#define CONV_STEPS(CHECK) do { _Pragma("unroll") for (int dd = 0; dd < IPW; ++dd) { \
        const int delta = IPW * d + dd; \
        const bf16x8 a0 = *(const LAS bf16x8*)(FIL + aBase - 64 * delta), a1 = *(const LAS bf16x8*)(FIL + aBase - 64 * delta - 32); \
        const int jn = IPW * (wv - d) - dd; \
        if (!(CHECK) || (jn >= 0 && jn < NBK)) Bw[(IPW - dd) % IPW] = *(const LAS bf16x8*)(WL + bBase + 64 * jn); \
        _Pragma("unroll") for (int ii = 0; ii < IPW; ++ii) { const int j = IPW * (wv - d) + ii - dd; \
            if (!(CHECK) || (j >= 0 && j < NBK)) { \
                acc[ii][0] = __builtin_amdgcn_mfma_f32_16x16x32_bf16(a0, Bw[(ii - dd + IPW) % IPW], acc[ii][0], 0, 0, 0); \
                acc[ii][1] = __builtin_amdgcn_mfma_f32_16x16x32_bf16(a1, Bw[(ii - dd + IPW) % IPW], acc[ii][1], 0, 0, 0); } } } } while (0)
    { const int d = wv - 8; CONV_STEPS(true); }
    for (int d = wv - 7; d < wv; ++d) { CONV_STEPS(false); }
    { const int d = wv; CONV_STEPS(true); }
#undef CONV_STEPS
#pragma unroll
    for (int ii = 0; ii < IPW; ++ii)
#pragma unroll
        for (int h = 0; h < 2; ++h) { u32x2 w; w.x = pk2(acc[ii][h][0], acc[ii][h][1]); w.y = pk2(acc[ii][h][2], acc[ii][h][3]);
            *(u32x2*)(ydst + (size_t)rr * LF + 32 * (IPW * wv + ii) + 16 * h + 4 * q) = w; }
}


__device__ __forceinline__ void route_reduce(float (&p)[32], int lane) {
#pragma unroll
    for (int i = 0; i < 16; ++i) { const bool up = (lane & 32) != 0; const float send = up ? p[i] : p[i + 16], keep = up ? p[i + 16] : p[i]; p[i] = keep + __shfl_xor(send, 32); }
#pragma unroll
    for (int i = 0; i < 8; ++i) { const bool up = (lane & 16) != 0; const float send = up ? p[i] : p[i + 8], keep = up ? p[i + 8] : p[i]; p[i] = keep + __shfl_xor(send, 16); }
#pragma unroll
    for (int i = 0; i < 4; ++i) { const bool up = (lane & 8) != 0; const float send = up ? p[i] : p[i + 4], keep = up ? p[i + 4] : p[i]; p[i] = keep + __shfl_xor(send, 8); }
#pragma unroll
    for (int i = 0; i < 2; ++i) { const bool up = (lane & 4) != 0; const float send = up ? p[i] : p[i + 2], keep = up ? p[i + 2] : p[i]; p[i] = keep + __shfl_xor(send, 4); }
    { const bool up = (lane & 2) != 0; const float send = up ? p[0] : p[1], keep = up ? p[1] : p[0]; p[0] = keep + __shfl_xor(send, 2); }
    p[0] += __shfl_xor(p[0], 1);
}
__device__ __forceinline__ void route_top4(float val, int myE, float (&sv)[4], int (&si)[4]) {
    int rank = 0;
#pragma unroll
    for (int e = 0; e < 32; ++e) { const float o = __builtin_bit_cast(float, __builtin_amdgcn_readlane(__builtin_bit_cast(int, val), 2 * e)); rank += (o > val || (o == val && e < myE)) ? 1 : 0; }
#pragma unroll
    for (int k = 0; k < 4; ++k) { const unsigned long long m = __ballot(rank == k); const int src = __builtin_ctzll(m);
        si[k] = src >> 1; sv[k] = __builtin_bit_cast(float, __builtin_amdgcn_readlane(__builtin_bit_cast(int, val), src)); }
}
#define IN(k) (lo <= (k) && (k) < hi)
#define SEAM(k) do { if (IN(k) && IN((k) + 1)) xcd_barrier(bar); } while (0)
#define SEAMK(k, kind) SEAM(k)
#define KLOCALS \
    const float* x_in = args.in[I_X]; const float* c_in = args.in[I_C]; const float* ctx_in = args.in[I_CTX]; const float* cctx_in = args.in[I_CCTX]; \
    float* out = args.out; \
    float* modp = (float*)(ws + WS_MODP); float* modf = (float*)(ws + WS_MOD); \
    float* cosT = (float*)(ws + WS_ROPE); float* sinT = cosT + SEQ * 32; \
    float* a2tab = (float*)(ws + WS_A2); \
    int* top_e = (int*)(ws + WS_PAIR); int* ppos = top_e + NTOK * 4; float* pgate = (float*)(ppos + NTOK * 4); int* pdest = (int*)(pgate + NTOK * 4); \
    bf16_t* XB = (bf16_t*)(ws + WS_XB); \
    bf16_t* Wqkv_t = (bf16_t*)(ws + WS_WQKV); bf16_t* Wo_t = (bf16_t*)(ws + WS_WO); bf16_t* Win_t = (bf16_t*)(ws + WS_WIN); bf16_t* Wout_t = (bf16_t*)(ws + WS_WOUT); \
    bf16_t* Wgu_t = (bf16_t*)(ws + WS_WGU); bf16_t* Wdn_t = (bf16_t*)(ws + WS_WDN); \
    bf16_t* hA = (bf16_t*)(ws + WS_HA); bf16_t* Qb = (bf16_t*)(ws + WS_Q); bf16_t* Kb = (bf16_t*)(ws + WS_K); bf16_t* Vb = (bf16_t*)(ws + WS_V); \
    bf16_t* Upre = (bf16_t*)(ws + WS_UPRE); bf16_t* Wc = (bf16_t*)(ws + WS_WC); bf16_t* Yc = (bf16_t*)(ws + WS_YC); \
    bf16_t* XS = (bf16_t*)(ws + WS_XS); bf16_t* AB = (bf16_t*)(ws + WS_AB); int* elist = (int*)(ws + WS_ELIST); \
    const int wr = wave >> 2, wc = wave & 3, fr = lane & 15, fq = lane >> 4;
template <int layer> __device__ __forceinline__ void layer_body(const Args& args, LAS unsigned char* lds, const XcdBarrier& bar, const int tid, const int lane, const int wave, const int G, const int bid, const int lo, const int hi) {
    const int gw = bid * NWAVES + wave, NGW = G * NWAVES;
    unsigned char* ws = args.ws;
    gu32* ctl = (gu32*)(ws + WS_CTL);
    KLOCALS
        const int pb = 3 + 10 * layer;
        const int jm = layer >> 1;
        const bool ctx_live = layer < 2;
        const int nrows = ctx_live ? NTOK : NLAT;
        const float* mo = modf + (size_t)layer * NMODROW * MODW;

        if ((layer & 1) == 0) {
            if (EN_GEMM && IN(pb + 0)) {
                EpiQKV E{Qb, Kb, Vb, args.in[I_QG] + jm * 64, args.in[I_KG] + jm * 64, cosT, sinT};
                const bf16_t* Wt = Wqkv_t + (size_t)jm * NQKV * D;
                const QkvSched S{hA, Wt, ctx_live ? 1 : 0, G, bid};
                run_gemm(lds, S, E);
            }
            SEAMK(pb + 0, 3);
            if (EN_ATT && IN(pb + 1)) {
                typedef attn_body::bf16 abf;
                const int x = bid & 7, sl = bid >> 3, nS = G >> 3;
                for (int q = sl; q < 256; q += nS) {
                    const int b = 2 * x + (q >> 7), kvh = (q >> 5) & 3, head = 4 * kvh + ((q >> 3) & 3), qb = q & 7;
                    abf* Qu = (abf*)(Qb + ((size_t)b * SEQ + qb * 256) * D + head * 64);
                    attn_body::attn_unit<8>(Qu, (const abf*)(Kb + (size_t)b * KVL * 256 + kvh * 64), (const abf*)(Vb + (size_t)b * KVL * 256 + kvh * 64), Qu, KVL / 64, (char*)lds);
                }
                if (ctx_live) for (int q = sl; q < 32; q += nS) {
                    const int b = 2 * x + (q >> 4), head = q & 15, kvh = head >> 2;
                    abf* Qu = (abf*)(Qb + ((size_t)NLAT + b * CL) * D + head * 64);
                    attn_body::attn_unit<8>(Qu, (const abf*)(Kb + ((size_t)b * KVL + SEQ) * 256 + kvh * 64), (const abf*)(Vb + ((size_t)b * KVL + SEQ) * 256 + kvh * 64), Qu, CL / 64, (char*)lds);
                }
            }
            SEAMK(pb + 1, 4);
            if (EN_GEMM && IN(pb + 2)) {
                EpiResid<layer == 0> E{x_in, ctx_in, XB, mo + 2 * D, nullptr};
                const bf16_t* Wt = Wo_t + (size_t)jm * D * D;
                const DenseSched S{Qb, Wt, nrows / 256, 4, G, bid};
                run_gemm(lds, S, E);
            }
            SEAMK(pb + 2, 5);
        } else {
            const float* cw = args.in[I_HCW] + (size_t)jm * 3 * NHY; const float* cb = args.in[I_HCB] + (size_t)jm * NHY;
            if (EN_GEMM && IN(pb + 0)) {
                EpiBiasBf16 E{Upre, NHY, args.in[I_HBIN] + (size_t)jm * NHY, 0};
                const bf16_t* Wt = Win_t + (size_t)jm * NHY * D;
                const DenseSched S{hA, Wt, nrows / 256, 12, G, bid};
                run_gemm(lds, S, E);
            }
            SEAMK(pb + 0, 6);
            if (EN_MISC && IN(pb + 1)) {
                LAS unsigned char* T = lds;
                const int nlat_u = NB * 16 * 4, nctx_u = ctx_live ? NB * 2 * 4 : 0;
                const int hw = tid >> 5, l32 = tid & 31;
                for (int u = bid; u < nlat_u + nctx_u; u += G) {
                    int b, s0, c0, Ls, rowb; bf16_t* dstb;
                    if (u < nlat_u) { b = u >> 6; s0 = ((u >> 2) & 15) * 128; c0 = (u & 3) * 256; Ls = SEQ; rowb = b * SEQ; dstb = Wc; }
                    else { const int q = u - nlat_u; b = q >> 3; s0 = ((q >> 2) & 1) * 128; c0 = (q & 3) * 256; Ls = CL; rowb = NLAT + b * CL; dstb = Wc + WC_CTX_OFF; }
                    const int cc = c0 + 8 * l32, sb = s0 + 8 * hw;
                    u32x4 ra[10], rv[10];
#pragma unroll
                    for (int i = 0; i < 10; ++i) { const int sp = sb + i - 1;
                        if (sp >= 0 && sp < Ls) { const bf16_t* ur = Upre + (size_t)(rowb + sp) * NHY + cc; ra[i] = *(const u32x4*)(ur + D); rv[i] = *(const u32x4*)(ur + 2 * D); }
                        else { ra[i] = (u32x4){0u, 0u, 0u, 0u}; rv[i] = (u32x4){0u, 0u, 0u, 0u}; } }
                    f32x4 w1[3][2], w2[3][2], b1[2], b2[2];
#pragma unroll
                    for (int tap = 0; tap < 3; ++tap)
#pragma unroll
                        for (int hh = 0; hh < 2; ++hh) { w1[tap][hh] = *(const f32x4*)(cw + tap * NHY + D + cc + 4 * hh); w2[tap][hh] = *(const f32x4*)(cw + tap * NHY + 2 * D + cc + 4 * hh); }
#pragma unroll
                    for (int hh = 0; hh < 2; ++hh) { b1[hh] = *(const f32x4*)(cb + D + cc + 4 * hh); b2[hh] = *(const f32x4*)(cb + 2 * D + cc + 4 * hh); }
                    unsigned op[8][4];
#pragma unroll
                    for (int sp = 0; sp < 4; ++sp) {
                        float pr[2][8];
#pragma unroll
                        for (int o = 0; o < 2; ++o) { const int si = 2 * sp + o;
                            f32x4 x1[2] = {b1[0], b1[1]}, vv[2] = {b2[0], b2[1]};
#pragma unroll
                            for (int tap = 0; tap < 3; ++tap) { const u32x4 a = ra[si + tap], q = rv[si + tap];
                                x1[0] += (f32x4){bflo(a.x), bfhi(a.x), bflo(a.y), bfhi(a.y)} * w1[tap][0]; x1[1] += (f32x4){bflo(a.z), bfhi(a.z), bflo(a.w), bfhi(a.w)} * w1[tap][1];
                                vv[0] += (f32x4){bflo(q.x), bfhi(q.x), bflo(q.y), bfhi(q.y)} * w2[tap][0]; vv[1] += (f32x4){bflo(q.z), bfhi(q.z), bflo(q.w), bfhi(q.w)} * w2[tap][1]; }
                            const f32x4 p0 = x1[0] * vv[0], p1 = x1[1] * vv[1];
                            pr[o][0] = p0[0]; pr[o][1] = p0[1]; pr[o][2] = p0[2]; pr[o][3] = p0[3]; pr[o][4] = p1[0]; pr[o][5] = p1[1]; pr[o][6] = p1[2]; pr[o][7] = p1[3]; }
#pragma unroll
                        for (int c = 0; c < 8; ++c) op[c][sp] = pk2(pr[0][c], pr[1][c]);
                    }
                    __syncthreads();
#pragma unroll
                    for (int c = 0; c < 8; ++c) { const int ch = 8 * l32 + c; *(LAS u32x4*)(T + ch * 256 + ((hw ^ (l32 & 15)) * 16)) = (u32x4){op[c][0], op[c][1], op[c][2], op[c][3]}; }
                    __syncthreads();
#pragma unroll
                    for (int i = 0; i < 8; ++i) { const int c = i * 32 + (tid >> 4), ch = tid & 15;
                        *(u32x4*)(dstb + ((size_t)(c0 + c) * NB + b) * Ls + s0 + ch * 8) = *(const LAS u32x4*)(T + c * 256 + ((ch ^ ((c >> 3) & 15)) * 16)); }
                }
            }
            SEAMK(pb + 1, 7);
            if (EN_CONV && IN(pb + 2)) {
                const int nlat_u = 1024, nctx_u = ctx_live ? 1024 : 0;
                for (int u = bid; u < nlat_u + nctx_u; u += G) {
                    if (u < nlat_u) { const int c = u; conv_channel<SEQ>(lds, (const bf16_t*)(ws + (jm == 0 ? WS_FI0 : WS_FI1)) + (size_t)c * 8 * FP_L, Wc + (size_t)c * NB * SEQ, Yc + (size_t)c * NB * SEQ, tid, lane, wave); }
                    else { const int c = u - nlat_u; conv_channel<CL>(lds, (const bf16_t*)(ws + WS_FI2) + (size_t)c * 8 * FP_C, Wc + WC_CTX_OFF + (size_t)c * NB * CL, Yc + WC_CTX_OFF + (size_t)c * NB * CL, tid, lane, wave); }
                }
            }
            SEAMK(pb + 2, 8);
            if (EN_MISC && IN(pb + 3)) {
                LAS unsigned char* T = lds;
                const int nlat_u = NB * 16 * 4, nctx_u = ctx_live ? NB * 2 * 4 : 0;
                const int hw = tid >> 5, l32 = tid & 31;
                for (int u = bid; u < nlat_u + nctx_u; u += G) {
                    int b, s0, c0, Ls, rowb; const bf16_t* srcb;
                    if (u < nlat_u) { b = u >> 6; s0 = ((u >> 2) & 15) * 128; c0 = (u & 3) * 256; Ls = SEQ; rowb = b * SEQ; srcb = Yc; }
                    else { const int q = u - nlat_u; b = q >> 3; s0 = ((q >> 2) & 1) * 128; c0 = (q & 3) * 256; Ls = CL; rowb = NLAT + b * CL; srcb = Yc + WC_CTX_OFF; }
                    __syncthreads();
#pragma unroll
                    for (int i = 0; i < 8; ++i) { const int c = i * 32 + (tid >> 4), ch = tid & 15;
                        *(LAS u32x4*)(T + c * 256 + ((ch ^ ((c >> 3) & 15)) * 16)) = *(const u32x4*)(srcb + ((size_t)(c0 + c) * NB + b) * Ls + s0 + ch * 8); }
                    const int cc = c0 + 8 * l32, sb = s0 + 8 * hw;
                    u32x4 ra[10];
#pragma unroll
                    for (int i = 0; i < 10; ++i) { const int sp = sb + i - 1;
                        if (sp >= 0 && sp < Ls) ra[i] = *(const u32x4*)(Upre + (size_t)(rowb + sp) * NHY + cc); else ra[i] = (u32x4){0u, 0u, 0u, 0u}; }
                    f32x4 w0[3][2], b0[2];
#pragma unroll
                    for (int tap = 0; tap < 3; ++tap)
#pragma unroll
                        for (int hh = 0; hh < 2; ++hh) w0[tap][hh] = *(const f32x4*)(cw + tap * NHY + cc + 4 * hh);
#pragma unroll
                    for (int hh = 0; hh < 2; ++hh) b0[hh] = *(const f32x4*)(cb + cc + 4 * hh);
                    __syncthreads();
                    u32x4 yv[8];
#pragma unroll
                    for (int c = 0; c < 8; ++c) yv[c] = *(const LAS u32x4*)(T + (8 * l32 + c) * 256 + ((hw ^ (l32 & 15)) * 16));
#pragma unroll
                    for (int si = 0; si < 8; ++si) {
                        f32x4 x0[2] = {b0[0], b0[1]};
#pragma unroll
                        for (int tap = 0; tap < 3; ++tap) { const u32x4 a = ra[si + tap];
                            x0[0] += (f32x4){bflo(a.x), bfhi(a.x), bflo(a.y), bfhi(a.y)} * w0[tap][0]; x0[1] += (f32x4){bflo(a.z), bfhi(a.z), bflo(a.w), bfhi(a.w)} * w0[tap][1]; }
                        float yy[8];
#pragma unroll
                        for (int c = 0; c < 8; ++c) { const unsigned wd = yv[c][si >> 1]; yy[c] = (si & 1) ? bfhi(wd) : bflo(wd); }
                        u32x4 o; o.x = pk2(x0[0][0] * yy[0], x0[0][1] * yy[1]); o.y = pk2(x0[0][2] * yy[2], x0[0][3] * yy[3]); o.z = pk2(x0[1][0] * yy[4], x0[1][1] * yy[5]); o.w = pk2(x0[1][2] * yy[6], x0[1][3] * yy[7]);
                        *(u32x4*)(hA + (size_t)(rowb + sb + si) * D + cc) = o;
                    }
                }
            }
            SEAMK(pb + 3, 9);
            if (EN_GEMM && IN(pb + 4)) {
                EpiResid<layer == 0> E{x_in, ctx_in, XB, mo + 2 * D, args.in[I_HBOUT] + (size_t)jm * D};
                const bf16_t* Wt = Wout_t + (size_t)jm * D * D;
                const DenseSched S{hA, Wt, nrows / 256, 4, G, bid};
                run_gemm(lds, S, E);
            }
            SEAMK(pb + 4, 10);
        }

        gu32* cnt = ctl + CW_CNT + layer * 32 * 64;
        if (EN_ROUTER && IN(pb + 5)) {
            constexpr int WSTR = D + 8, MAXT = 20;
            LAS bf16_t* WT = (LAS bf16_t*)lds;
            LAS float* CB = (LAS float*)(lds + 2 * 32 * WSTR * 2);
            LAS float* CRED = CB + 32;
            LAS int* LCNT = (LAS int*)(CRED + 512);
            LAS int* PREC = LCNT + 64;
            LAS float* RINV = (LAS float*)(PREC + 8 * MAXT * 4);
            __syncthreads();
            if (tid < 64) LCNT[tid] = 0;
            for (int i = tid; i < 8 * MAXT * 4; i += NTHR) PREC[i] = -1;
            const int TPW = (((nrows + NGW - 1) / NGW) + 1) & ~1;
            const int rf = gw * TPW; const int nval = rf >= nrows ? 0 : (nrows - rf < TPW ? nrows - rf : TPW);
            { int curb = -1; f32x4 gs[4], sh[4]; u32x2 wv_[4];
              if (nval > 0) {
#pragma unroll
                  for (int j = 0; j < 4; ++j) wv_[j] = ((const u32x2*)(XB + (size_t)rf * D))[lane + 64 * j]; }
              for (int ti = 0; ti < nval; ++ti) { const int r = rf + ti; f32x4 v[4];
#pragma unroll
                  for (int j = 0; j < 4; ++j) v[j] = (f32x4){bflo(wv_[j].x), bfhi(wv_[j].x), bflo(wv_[j].y), bfhi(wv_[j].y)};
                  if (ti + 1 < nval) {
#pragma unroll
                      for (int j = 0; j < 4; ++j) wv_[j] = ((const u32x2*)(XB + (size_t)(r + 1) * D))[lane + 64 * j]; }
                  const int bq = mod_row(r); if (bq != curb) { const float* mr = mo + (size_t)bq * MODW; load_vec(mr + 4 * D, lane, gs); load_vec(mr + 3 * D, lane, sh); curb = bq; }
                  float ss = 0.f;
#pragma unroll
                  for (int j = 0; j < 4; ++j) ss += (v[j][0] * v[j][0] + v[j][1] * v[j][1]) + (v[j][2] * v[j][2] + v[j][3] * v[j][3]);
                  ss = wave_sum(ss); const float rinv = __builtin_amdgcn_rsqf(ss * (1.0f / D) + EPS);
                  if (lane == 0) RINV[wave * MAXT + ti] = rinv;
#pragma unroll
                  for (int j = 0; j < 4; ++j) { const f32x4 h = (v[j] * rinv) * gs[j] + sh[j]; u32x2 w; w.x = pk2(h[0], h[1]); w.y = pk2(h[2], h[3]); ((u32x2*)(hA + (size_t)r * D))[lane + 64 * j] = w; } } }
            const int rb0 = bid * NWAVES * TPW; const int rb1 = (rb0 + NWAVES * TPW < nrows ? rb0 + NWAVES * TPW : nrows) - 1;
            const int bb0 = rb0 < nrows ? mod_row(rb0) : 1, bb1 = rb0 < nrows ? mod_row(rb1) : 0;
            const float* rw = args.in[I_RW] + (size_t)layer * D * NE; const float* rbias = args.in[I_RB] + layer * NE;
            for (int bq = bb0; bq <= bb1; ++bq) {
                __syncthreads();
                { const float* gsb = mo + (size_t)bq * MODW + 4 * D; const float* shb = mo + (size_t)bq * MODW + 3 * D;
                  const int e = tid & 31; float cpart = 0.f;
#pragma unroll 4
                  for (int jj = 0; jj < 8; ++jj) { const int k0 = 8 * ((tid >> 5) + 16 * jj);
                      const f32x4 g0 = *(const f32x4*)(gsb + k0), g1 = *(const f32x4*)(gsb + k0 + 4), s0 = *(const f32x4*)(shb + k0), s1 = *(const f32x4*)(shb + k0 + 4);
                      float wv[8];
#pragma unroll
                      for (int q = 0; q < 8; ++q) wv[q] = rw[(size_t)(k0 + q) * NE + e];
                      float pv[8]; unsigned hw[4], lw[4];
#pragma unroll
                      for (int q = 0; q < 4; ++q) { pv[q] = g0[q] * wv[q]; pv[4 + q] = g1[q] * wv[4 + q]; cpart += s0[q] * wv[q] + s1[q] * wv[4 + q]; }
#pragma unroll
                      for (int q = 0; q < 4; ++q) { hw[q] = pk2(pv[2 * q], pv[2 * q + 1]); lw[q] = pk2(pv[2 * q] - bflo(hw[q]), pv[2 * q + 1] - bfhi(hw[q])); }
                      *(LAS u32x4*)(WT + (size_t)e * WSTR + k0) = (u32x4){hw[0], hw[1], hw[2], hw[3]};
                      *(LAS u32x4*)(WT + (size_t)(32 + e) * WSTR + k0) = (u32x4){lw[0], lw[1], lw[2], lw[3]}; }
                  CRED[(tid >> 5) * 32 + e] = cpart; }
                __syncthreads();
                if (tid < 32) { float c = rbias[tid];
#pragma unroll
                    for (int q = 0; q < 16; ++q) c += CRED[q * 32 + tid];
                    CB[tid] = c; }
                __syncthreads();
                if (nval > 0 && mod_row(rf) <= bq && bq <= mod_row(rf + nval - 1)) {
                    const int e = lane & 31, kh = lane >> 5; const int trow = rf + (e < nval ? e : nval - 1);
                    const bf16_t* ap = XB + (size_t)trow * D + 8 * kh;
                    const LAS bf16_t* bhp = WT + (size_t)e * WSTR + 8 * kh; const LAS bf16_t* blp = bhp + 32 * WSTR;
                    f32x16 acc;
#pragma unroll
                    for (int q = 0; q < 16; ++q) acc[q] = 0.f;
#pragma unroll 8
                    for (int ks = 0; ks < D / 16; ++ks) { const bf16x8 af = *(const bf16x8*)(ap + 16 * ks);
                        acc = __builtin_amdgcn_mfma_f32_32x32x16_bf16(af, *(const LAS bf16x8*)(bhp + 16 * ks), acc, 0, 0, 0);
                        acc = __builtin_amdgcn_mfma_f32_32x32x16_bf16(af, *(const LAS bf16x8*)(blp + 16 * ks), acc, 0, 0, 0); }
                    const float cbe = CB[e];
                    const int hf = lane >> 5;
#pragma unroll
                    for (int r = 0; r < 10; ++r) { const int tA = (r & 3) + 8 * (r >> 2), tB = tA + 4;
                        const bool okA = tA < nval && mod_row(rf + tA) == bq, okB = tB < nval && mod_row(rf + (tB < MAXT ? tB : 0)) == bq;
                        if (okA || okB) {
                            const int tmine = hf ? (tB < MAXT ? tB : MAXT - 1) : tA;
                            float val = RINV[wave * MAXT + tmine] * acc[r] + cbe;
                            float sv[4]; int si[4];
#pragma unroll
                            for (int k = 0; k < 4; ++k) {
                                int x = __builtin_bit_cast(int, val); float m = val;
                                m = fmaxf(m, __builtin_bit_cast(float, __builtin_amdgcn_update_dpp(x, x, 0xB1, 0xF, 0xF, false))); x = __builtin_bit_cast(int, m);
                                m = fmaxf(m, __builtin_bit_cast(float, __builtin_amdgcn_update_dpp(x, x, 0x4E, 0xF, 0xF, false))); x = __builtin_bit_cast(int, m);
                                m = fmaxf(m, __builtin_bit_cast(float, __builtin_amdgcn_update_dpp(x, x, 0x124, 0xF, 0xF, false))); x = __builtin_bit_cast(int, m);
                                m = fmaxf(m, __builtin_bit_cast(float, __builtin_amdgcn_update_dpp(x, x, 0x128, 0xF, 0xF, false)));
                                m = fmaxf(m, __shfl_xor(m, 16));
                                const unsigned long long mk = __ballot(val == m);
                                const int wlo = __builtin_ctz((unsigned)mk | 0x80000000u), whi = __builtin_ctz((unsigned)(mk >> 32) | 0x80000000u);
                                const int win = hf ? whi : wlo;
                                sv[k] = m; si[k] = win; if ((lane & 31) == win) val = -INFINITY; }
                            if ((lane & 31) < 4 && (hf ? okB : okA)) { const int k = lane & 31; const float e1 = __expf(sv[1] - sv[0]), e2 = __expf(sv[2] - sv[0]), e3 = __expf(sv[3] - sv[0]); const float inv = 1.0f / (1.0f + e1 + e2 + e3);
                                const int ex = k == 0 ? si[0] : (k == 1 ? si[1] : (k == 2 ? si[2] : si[3])); const float gt = (k == 0 ? 1.0f : (k == 1 ? e1 : (k == 2 ? e2 : e3))) * inv;
                                const int tt = hf ? tB : tA; const int rr = rf + tt; const int rk = __hip_atomic_fetch_add(LCNT + ex, 1, __ATOMIC_RELAXED, __HIP_MEMORY_SCOPE_WORKGROUP);
                                top_e[rr * 4 + k] = ex; pgate[rr * 4 + k] = gt; PREC[(wave * MAXT + tt) * 4 + k] = ex | (rk << 8); } } }
                }
            }
            __syncthreads();
            if (tid < 32) LCNT[32 + tid] = (int)__hip_atomic_fetch_add(cnt + tid * 64, (unsigned)LCNT[tid], RLX_AGENT);
            __syncthreads();
            for (int i = tid; i < 8 * MAXT * 4; i += NTHR) { const int rec = PREC[i]; if (rec >= 0) { const int e = rec & 255, rank = rec >> 8, w = i / (MAXT * 4), ti = (i / 4) % MAXT, k = i & 3;
                const int r = (bid * NWAVES + w) * TPW + ti; const int pos = LCNT[32 + e] + rank; ppos[r * 4 + k] = pos; elist[(size_t)e * NTOK + pos] = r; } }
        }
        SEAMK(pb + 5, 11);
        LAS int* PADS = (LAS int*)(lds + LDS_BYTES - 4096);
        LAS unsigned char* TE = (LAS unsigned char*)(PADS + 128);
        if (IN(pb + 7) || IN(pb + 8) || IN(pb + 9)) {
            __syncthreads();
            if (tid < 32) PADS[64 + tid] = (int)__hip_atomic_load(cnt + tid * 64, RLX_AGENT);
            __syncthreads();
            if (tid < 64) {
                const int nt = lane < 32 ? (PADS[64 + lane] + 255) >> 8 : 0; int inc = nt;
#pragma unroll
                for (int o = 1; o < 32; o <<= 1) { const int v = __shfl_up(inc, o); if (lane >= o) inc += v; }
                if (lane < 32) PADS[lane] = (inc - nt) << 8; if (lane == 31) PADS[32] = inc << 8;
            }
            __syncthreads();
            { const int ntile = PADS[32] >> 8; for (int t = tid; t < ntile; t += NTHR) { int e = 0;
#pragma unroll
                  for (int st = 16; st >= 1; st >>= 1) if (PADS[e + st] <= (t << 8)) e += st;
                  TE[t] = (unsigned char)e; } }
            __syncthreads();
        }
        if (EN_GEMM && IN(pb + 7)) {
            const int ntile = PADS[32] >> 8;
            LAS int* ROWS = (LAS int*)(lds + 131072);
            { Unit uu; for (int ui = 0; xcd_unit(ui, G, bid, ntile, 8, uu.pm, uu.pn); ++ui) { if (tid < 256) { const int e = TE[uu.pm]; const int pos = uu.pm * 256 - PADS[e] + tid;
                  ROWS[ui * 256 + tid] = pos < PADS[64 + e] ? elist[(size_t)e * NTOK + pos] : 0; } } }
            __syncthreads();
            const MoeGatherSched S{hA, Wgu_t + (size_t)layer * NE * NGU * D, TE, ROWS, ntile, 8, NGU, G, bid};
            const EpiSwiglu E{AB, args.in[I_BGU] + (size_t)layer * NE * NGU};
            run_gemm_gather(lds, S, E);
        }
        SEAMK(pb + 7, 12);
        if (EN_GEMM && IN(pb + 8)) {
            const int ntile = PADS[32] >> 8;
            const MoeSched S{AB, Wdn_t + (size_t)layer * NE * D * D, TE, ntile, 4, D, G, bid};
            const EpiBiasBf16 E{XS, D, args.in[I_BDN] + (size_t)layer * NE * D, D};
            run_gemm(lds, S, E);
        }
        SEAMK(pb + 8, 13);
        if (EN_MISC && IN(pb + 9)) {
            const bool has_next = layer + 1 < DEPTH;
            const float* mo_n = modf + (size_t)(layer + 1) * NMODROW * MODW; const float* g1n = args.in[I_N1G] + (has_next ? (layer + 1) * D : 0);
            const int nnext = (layer + 1 < 3) ? NTOK : NLAT;
            const int TPW = (nrows + NGW - 1) / NGW;
            int curb = -1; f32x4 gm[4], gsn[4], shn[4];
            for (int ti = 0; ti < TPW; ++ti) {
                const int r = gw * TPW + ti; if (r >= nrows) break;
                bf16_t* xr = XB + (size_t)r * D;
                int dest[4]; float gt[4];
#pragma unroll
                for (int k = 0; k < 4; ++k) { dest[k] = PADS[top_e[r * 4 + k]] + ppos[r * 4 + k]; gt[k] = pgate[r * 4 + k]; }
                u32x2 yw[4][4]; f32x4 v[4], h[4];
#pragma unroll
                for (int k = 0; k < 4; ++k) { const u32x2* yr = (const u32x2*)(XS + (size_t)dest[k] * D);
#pragma unroll
                    for (int j = 0; j < 4; ++j) yw[k][j] = yr[lane + 64 * j]; }
                load_vec_bf(xr, lane, v);
                const int b = mod_row(r);
                if (b != curb) { load_vec(mo + (size_t)b * MODW + 5 * D, lane, gm); if (has_next) { const float* mn = mo_n + (size_t)b * MODW; load_vec(mn + D, lane, gsn); load_vec(mn, lane, shn); } curb = b; }
#pragma unroll
                for (int j = 0; j < 4; ++j) { f32x4 y = (f32x4){0.f, 0.f, 0.f, 0.f};
#pragma unroll
                    for (int k = 0; k < 4; ++k) { const u32x2 w = yw[k][j]; y[0] += gt[k] * bflo(w.x); y[1] += gt[k] * bfhi(w.x); y[2] += gt[k] * bflo(w.y); y[3] += gt[k] * bfhi(w.y); }
                    v[j] = v[j] + gm[j] * y;
                    if (layer == DEPTH - 1) ((f32x4*)(out + (size_t)r * D))[lane + 64 * j] = v[j];
                    else { u32x2 w; w.x = pk2(v[j][0], v[j][1]); w.y = pk2(v[j][2], v[j][3]); ((u32x2*)xr)[lane + 64 * j] = w; } }
                if (has_next && r < nnext) norm_mod_store(v, gsn, shn, hA + (size_t)r * D, lane, h);
            }
        }
        SEAMK(pb + 9, 14);
}

__global__ void __launch_bounds__(NTHR, 2) fwd(Args args) {
    extern __shared__ __attribute__((aligned(16))) unsigned char lds_raw[];
    LAS unsigned char* lds = (LAS unsigned char*)lds_raw;
    const int tid = threadIdx.x, lane = tid & 63, wave = __builtin_amdgcn_readfirstlane(tid >> 6);
    const int G = gridDim.x, bid = blockIdx.x;
    const int gw = bid * NWAVES + wave, NGW = G * NWAVES;
    unsigned char* ws = args.ws;
    gu32* ctl = (gu32*)(ws + WS_CTL);
    volatile LAS unsigned* MISC = (volatile LAS unsigned*)(lds + MISC_OFF);
    if (tid < 64) MISC[tid] = 0u;
    __syncthreads();
    XcdBarrier bar; bar.bar = (unsigned*)ctl + CW_BAR; bar.x = 0; bar.st = MISC + 8;
    const int lo = args.ph_lo, hi = args.ph_hi;
    if (hi - lo > 1) bar = xcd_barrier_post((unsigned*)ctl + CW_BAR, MISC + 8);

    KLOCALS

    if (EN_PRO && IN(0)) {
        {
            LAS float* scr = (LAS float*)(lds + wave * 8448);
            constexpr int IT_QKV = 16 * (NQKV / 32), IT_SQ = 16 * (D / 32), IT_IN = 16 * (NHY / 32), IT_GU = 16 * (NGU / 32);
            constexpr int N0 = 2 * IT_QKV, N1 = N0 + 2 * IT_SQ, N2 = N1 + 2 * IT_IN, N3 = N2 + 2 * IT_SQ, N4 = N3 + 128 * IT_GU, N5 = N4 + 128 * IT_SQ;
            for (int it = gw; it < N5; it += NGW) {
                if (it < N0) { const int mtx = it / IT_QKV, r = it % IT_QKV; transpose_item<1>(args.in[I_WQKV] + (size_t)mtx * D * NQKV, NQKV, Wqkv_t + (size_t)mtx * NQKV * D, scr, r, lane); }
                else if (it < N1) { const int q = it - N0, mtx = q / IT_SQ, r = q % IT_SQ; transpose_item<0>(args.in[I_WO] + (size_t)mtx * D * D, D, Wo_t + (size_t)mtx * D * D, scr, r, lane); }
                else if (it < N2) { const int q = it - N1, mtx = q / IT_IN, r = q % IT_IN; transpose_item<0>(args.in[I_HWIN] + (size_t)mtx * D * NHY, NHY, Win_t + (size_t)mtx * NHY * D, scr, r, lane); }
                else if (it < N3) { const int q = it - N2, mtx = q / IT_SQ, r = q % IT_SQ; transpose_item<0>(args.in[I_HWOUT] + (size_t)mtx * D * D, D, Wout_t + (size_t)mtx * D * D, scr, r, lane); }
                else if (it < N4) { const int q = it - N3, mtx = q / IT_GU, r = q % IT_GU; transpose_item<2>(args.in[I_WGU] + (size_t)mtx * D * NGU, NGU, Wgu_t + (size_t)mtx * NGU * D, scr, r, lane); }
                else { const int q = it - N4, mtx = q / IT_SQ, r = q % IT_SQ; transpose_item<0>(args.in[I_WDN] + (size_t)mtx * D * D, D, Wdn_t + (size_t)mtx * D * D, scr, r, lane); }
            }
        }
        __syncthreads();
        {
            LAS float* S = (LAS float*)lds;
            for (int u = bid; u < 4 * 12 * 8; u += G) {
                const int kc = u & 7, cc = (u >> 3) % 12, layer = u / 96;
                __syncthreads();
                for (int i = tid; i < 128 * 20; i += NTHR) { const int k = i / 20, r = i % 20; float v = 0.f;
                    if (r < NMODROW) { const float cv = r < NB ? c_in[r * D + kc * 128 + k] : cctx_in[kc * 128 + k]; v = cv / (1.0f + __expf(-cv)); }
                    S[i] = v; }
                __syncthreads();
                const int col = cc * 512 + tid;
                const float* wp = args.in[I_WMOD] + ((size_t)layer * D + kc * 128) * MODW + col;
                float acc[20];
#pragma unroll
                for (int r = 0; r < 20; ++r) acc[r] = 0.f;
                for (int k = 0; k < 128; ++k) { const float w = wp[(size_t)k * MODW];
#pragma unroll
                    for (int q = 0; q < 5; ++q) { const f32x4 s = *(const LAS f32x4*)(S + k * 20 + 4 * q);
                        acc[4 * q] += s[0] * w; acc[4 * q + 1] += s[1] * w; acc[4 * q + 2] += s[2] * w; acc[4 * q + 3] += s[3] * w; } }
#pragma unroll
                for (int r = 0; r < NMODROW; ++r) modp[((size_t)(kc * 4 + layer) * NMODROW + r) * MODW + col] = acc[r];
            }
        }
        for (int i = bid * NTHR + tid; i < SEQ * 32; i += G * NTHR) {
            const int t = i >> 5, j = i & 31, fi = j & 15; const int pos = (j >> 4) == 0 ? (t >> 6) : (t & 63);
            const float inv = powf(10000.0f, -(float)fi / 16.0f); const float ang = (float)pos * inv;
            cosT[i] = cosf(ang); sinT[i] = sinf(ang);
        }
        {
            __syncthreads();
            LAS float* Z = (LAS float*)lds;
            LAS float* A1 = Z + 8 * 36;
            for (int u = bid; u < 256 + 256 + 32; u += G) {
                const int combo = u < 256 ? 0 : (u < 512 ? 1 : 2); const int ub = combo == 0 ? u : (combo == 1 ? u - 256 : u - 512);
                const int j = combo == 1 ? 1 : 0, Lf = combo == 2 ? CL : SEQ;
                const int tl = tid >> 6, o = tid & 63, t = ub * 8 + tl;
                __syncthreads();
                if (o < 33) { float z;
                    const float tt = (float)t / (float)(Lf - 1), w = 6.283185307179586f * (float)t / (float)Lf;
                    if (o == 0) z = tt; else { const int b = (o - 1) & 15; const float f = 1e-4f + (float)b * ((15.0f - 1e-4f) / 15.0f); z = o <= 16 ? cosf(f * w) : -sinf(f * w); }
                    Z[tl * 36 + o] = z; }
                __syncthreads();
                const float sf = args.in[I_HSF][j * 64 + o];
                { const float* w1 = args.in[I_HW1] + (size_t)j * 33 * 64; float a = args.in[I_HB1][j * 64 + o];
                  for (int i = 0; i < 33; ++i) a += Z[tl * 36 + i] * w1[i * 64 + o];
                  A1[tl * 64 + o] = sinf(sf * a); }
                __syncthreads();
                { const float* w2 = args.in[I_HW2] + (size_t)j * 64 * 64; float a = args.in[I_HB2][j * 64 + o];
                  for (int i = 0; i < 64; ++i) a += A1[tl * 64 + i] * w2[i * 64 + o];
                  a2tab[((size_t)combo * SEQ + t) * 64 + o] = sinf(sf * a); }
            }
        }
    }
    SEAMK(0, 0);

    if (EN_PRO && IN(1)) {
        for (int i = bid * NTHR + tid; i < DEPTH * NMODROW * MODW; i += G * NTHR) {
            const int layer = i / (NMODROW * MODW), rem = i % (NMODROW * MODW), col = rem % MODW; float s = args.in[I_BMOD][layer * MODW + col];
#pragma unroll
            for (int kc = 0; kc < 8; ++kc) s += modp[(size_t)(kc * 4 + layer) * NMODROW * MODW + rem];
            const int chunk = col >> 10, k = col & (D - 1);
            if (chunk == 1) s = args.in[I_N1G][layer * D + k] * (1.0f + s); else if (chunk == 4) s = args.in[I_N2G][layer * D + k] * (1.0f + s);
            modf[i] = s;
        }
        {
            LAS float* W3 = (LAS float*)lds;
            LAS float* RED = W3 + 512;
            LAS float* NRM = RED + 32;
            LAS float* HF = NRM + 4;
            for (int u = bid; u < 3 * 256; u += G) {
                const int combo = u >> 8, cg = u & 255; const int j = combo == 1 ? 1 : 0, Lf = combo == 2 ? CL : SEQ; const int c0 = cg * 4;
                LAS float* HB = HF + 4 * Lf;
                __syncthreads();
                { const int i = tid >> 3, q = tid & 7; const int col = (q >> 2) * 1024 + c0 + (q & 3);
                  W3[i * 8 + q] = args.in[I_HW3][((size_t)j * 64 + i) * 2048 + col]; }
                __syncthreads();
                float b3v[8], dec[4], asum[4] = {0.f, 0.f, 0.f, 0.f};
#pragma unroll
                for (int q = 0; q < 8; ++q) b3v[q] = args.in[I_HB3][j * 2048 + (q >> 2) * 1024 + c0 + (q & 3)];
#pragma unroll
                for (int ch = 0; ch < 4; ++ch) dec[ch] = 3.0701134573253945f + (float)(c0 + ch) * ((15.350567286626972f - 3.0701134573253945f) / 1023.0f);
                for (int t = tid; t < Lf; t += NTHR) {
                    asm volatile("" ::: "memory");
                    const float* ar = a2tab + ((size_t)combo * SEQ + t) * 64; float d[8];
#pragma unroll
                    for (int q = 0; q < 8; ++q) d[q] = b3v[q];
#pragma unroll
                    for (int i4 = 0; i4 < 16; ++i4) { const f32x4 a = *(const f32x4*)(ar + 4 * i4); asm volatile("" ::: "memory");
#pragma unroll
                        for (int e = 0; e < 4; ++e) { const f32x4 w0 = *(const LAS f32x4*)(W3 + (4 * i4 + e) * 8), w1 = *(const LAS f32x4*)(W3 + (4 * i4 + e) * 8 + 4);
                            d[0] += a[e] * w0[0]; d[1] += a[e] * w0[1]; d[2] += a[e] * w0[2]; d[3] += a[e] * w0[3]; d[4] += a[e] * w1[0]; d[5] += a[e] * w1[1]; d[6] += a[e] * w1[2]; d[7] += a[e] * w1[3]; } }
                    const float tt = (float)t / (float)(Lf - 1);
#pragma unroll
                    for (int ch = 0; ch < 4; ++ch) { const float dk = __expf(-tt * dec[ch]); const float f = d[ch] * dk, bb = d[4 + ch] * dk;
                        HF[ch * Lf + t] = f; HB[ch * Lf + t] = bb; asum[ch] += fabsf(f) + (t >= 1 ? fabsf(bb) : 0.f); }
                }
#pragma unroll
                for (int ch = 0; ch < 4; ++ch) { const float s = wave_sum(asum[ch]); if (lane == 0) RED[wave * 4 + ch] = s; }
                __syncthreads();
                if (tid < 4) { float s = 0.f; for (int w = 0; w < 8; ++w) s += RED[w * 4 + tid]; NRM[tid] = 1.0f / (s + EPS); }
                __syncthreads();
                const int P = 2 * Lf + 8, PC8 = P / 8;
                bf16_t* FI = (bf16_t*)(ws + (combo == 0 ? WS_FI0 : (combo == 1 ? WS_FI1 : WS_FI2)));
                for (int q = tid; q < 4 * 8 * PC8; q += NTHR) {
                    const int ch = q / (8 * PC8), r = q % (8 * PC8), cidx = r / PC8, x0 = (r % PC8) * 8;
                    const float nr = NRM[ch], db = args.in[I_HDB][j * 1024 + c0 + ch]; float v[8];
#pragma unroll
                    for (int e = 0; e < 8; ++e) { const int m = Lf - (x0 + e) + cidx; const int am = m < 0 ? -m : m; float g = 0.f;
                        if (am <= Lf - 1) { g = (m >= 0 ? HF[ch * Lf + am] : HB[ch * Lf + am]) * nr; if (m == 0) g += db; }
                        v[e] = g; }
                    u32x4 o; o.x = pk2(v[0], v[1]); o.y = pk2(v[2], v[3]); o.z = pk2(v[4], v[5]); o.w = pk2(v[6], v[7]);
                    *(u32x4*)(FI + ((size_t)((c0 + ch) * 8 + cidx)) * P + x0) = o;
                }
            }
        }
    }
    SEAMK(1, 1);

    if (IN(2)) {
        const float* mo = modf;
        const int TPW = (NTOK + NGW - 1) / NGW;
        int curb = -1; f32x4 gs[4], sh[4];
        for (int ti = 0; ti < TPW; ++ti) {
            const int r = gw * TPW + ti; if (r >= NTOK) break;
            const float* src = r < NLAT ? x_in + (size_t)r * D : ctx_in + (size_t)(r - NLAT) * D;
            f32x4 v[4], h[4]; load_vec(src, lane, v);
            const int b = mod_row(r); if (b != curb) { const float* mr = mo + (size_t)b * MODW; load_vec(mr + D, lane, gs); load_vec(mr, lane, sh); curb = b; }
            norm_mod_store(v, gs, sh, hA + (size_t)r * D, lane, h);
        }
    }
    SEAMK(2, 2);

    layer_body<0>(args, lds, bar, tid, lane, wave, G, bid, lo, hi);
    layer_body<1>(args, lds, bar, tid, lane, wave, G, bid, lo, hi);
    layer_body<2>(args, lds, bar, tid, lane, wave, G, bid, lo, hi);
    layer_body<3>(args, lds, bar, tid, lane, wave, G, bid, lo, hi);
#undef IN
#undef SEAM
}

extern "C" void kernel_launch(void* const* d_in, const int* in_sizes, int n_in, void* d_out, int out_size, void* d_ws, size_t ws_size, hipStream_t stream) {
    static int grid = 0;
    if (grid == 0) {
        if (n_in != 32 || out_size != NLAT * D || ws_size < WS_END) { fprintf(stderr, "kernel_launch: unexpected problem (n_in %d, out %d, ws %zu)\n", n_in, out_size, ws_size); grid = -1; return; }
        int dev = 0, cus = 0, per_cu = 0;
        if (hipGetDevice(&dev) != hipSuccess || hipDeviceGetAttribute(&cus, hipDeviceAttributeMultiprocessorCount, dev) != hipSuccess) { grid = -1; return; }
        if (hipFuncSetAttribute((const void*)fwd, hipFuncAttributeMaxDynamicSharedMemorySize, LDS_BYTES) != hipSuccess) { fprintf(stderr, "kernel_launch: hipFuncSetAttribute failed\n"); grid = -1; return; }
        if (hipOccupancyMaxActiveBlocksPerMultiprocessor(&per_cu, (const void*)fwd, NTHR, LDS_BYTES) != hipSuccess || per_cu < 1) fprintf(stderr, "kernel_launch: occupancy query says %d\n", per_cu);
        (void)hipGetLastError();
        if (cus < 256) { fprintf(stderr, "kernel_launch: built for the 256-CU MI355X (unit orders, per-wave row counts); found %d CUs; nothing launched\n", cus); grid = -1; return; }
        grid = 256;
    }
    if (grid < 0) return;
    (void)hipMemsetAsync((char*)d_ws + WS_CTL, 0, CTL_ZERO_BYTES, stream);
    Args a{};
    for (int i = 0; i < 32; ++i) a.in[i] = (const float*)d_in[i];
    a.out = (float*)d_out; a.ws = (unsigned char*)d_ws;
    constexpr int NPH = 3 + 10 * DEPTH;
#if MK_ONE_LAUNCH
    a.ph_lo = 0; a.ph_hi = NPH;
    hipLaunchKernelGGL(fwd, dim3(grid), dim3(NTHR), LDS_BYTES, stream, a);
#else
    for (int p = 0; p < NPH; ++p) {
        if (p >= 3) { const int layer = (p - 3) / 10, loc = (p - 3) % 10; if ((layer & 1) == 0 && (loc == 3 || loc == 4)) continue; }
        a.ph_lo = p; a.ph_hi = p + 1;
        hipLaunchKernelGGL(fwd, dim3(grid), dim3(NTHR), LDS_BYTES, stream, a);
    }
#endif
}
```

```cpp
#include <hip/hip_runtime.h>
#include <cstdio>
#include <cstdint>
#include <cmath>
#include <hip/hip_bf16.h>

#ifndef EN_PRO
#define EN_PRO 1
#endif
#ifndef EN_ATT
#define EN_ATT 1
#endif
#ifndef EN_CONV
#define EN_CONV 1
#endif
#ifndef EN_ROUTER
#define EN_ROUTER 1
#endif
#ifndef EN_GEMM
#define EN_GEMM 1
#endif
#ifndef EN_MISC
#define EN_MISC 1
#endif
#ifndef MK_ONE_LAUNCH
#define MK_ONE_LAUNCH 1
#endif

#define GAS __attribute__((address_space(1)))
#define LAS __attribute__((address_space(3)))
typedef unsigned short bf16_t;
typedef short bf16x8 __attribute__((ext_vector_type(8)));
typedef float f32x4 __attribute__((ext_vector_type(4)));
typedef float f32x2 __attribute__((ext_vector_type(2)));
typedef unsigned u32x4 __attribute__((ext_vector_type(4)));
typedef unsigned u32x2 __attribute__((ext_vector_type(2)));
typedef GAS unsigned gu32;
typedef float f32x16 __attribute__((ext_vector_type(16)));

constexpr int D = 1024, NB = 16, SEQ = 2048, CL = 256, KVL = SEQ + CL;
constexpr int NLAT = NB * SEQ, NCTX = NB * CL, NTOK = NLAT + NCTX;
constexpr int NE = 32, TOPK = 4, DEPTH = 4;
constexpr int MODW = 6 * D, NMODROW = NB + 1;
constexpr int NQKV = 1536, NHY = 3072, NGU = 2048;
constexpr float EPS = 1e-6f;
constexpr float C2 = 0.125f * 1.4426950408889634f;
constexpr int NWAVES = 8, NTHR = 512;
constexpr int NPADROWS = 155648;
constexpr int MAXTILES = NPADROWS / 256;

constexpr size_t MiB = 1u << 20;
constexpr size_t WS_CTL = 0, CTL_ZERO_BYTES = 1 * MiB;
constexpr size_t WS_MODP = 2 * MiB;
constexpr size_t WS_MOD = 16 * MiB;
constexpr size_t WS_ROPE = 18 * MiB;
constexpr size_t WS_A2 = 19 * MiB;
constexpr size_t WS_PAIR = 21 * MiB;
constexpr size_t WS_CTX = 24 * MiB;
constexpr size_t WS_FI = 40 * MiB;
constexpr int FP_L = 2 * SEQ + 8, FP_C = 2 * CL + 8;
constexpr size_t FI_L_BYTES = (size_t)1024 * 8 * FP_L * 2, FI_C_BYTES = (size_t)1024 * 8 * FP_C * 2;
constexpr size_t WS_FI0 = WS_FI, WS_FI1 = WS_FI0 + 65 * MiB, WS_FI2 = WS_FI1 + 65 * MiB;
static_assert(FI_L_BYTES <= 65 * MiB && WS_FI2 + FI_C_BYTES <= 180 * MiB, "filter map");
constexpr size_t WS_WQKV = 180 * MiB, WS_WO = 186 * MiB, WS_WIN = 190 * MiB, WS_WOUT = 202 * MiB, WS_WGU = 206 * MiB, WS_WDN = 718 * MiB;
constexpr size_t WS_HA = 974 * MiB;
constexpr size_t WS_Q = 1046 * MiB;
constexpr size_t WS_K = 1118 * MiB, WS_V = 1136 * MiB;
constexpr size_t WS_UPRE = 1154 * MiB;
constexpr size_t WS_WC = 1370 * MiB;
constexpr size_t WS_YC = 1442 * MiB;
constexpr size_t WS_XS = 1514 * MiB;
constexpr size_t WS_AB = 1818 * MiB;
constexpr size_t WS_ELIST = 2122 * MiB;
constexpr size_t WS_XB = 2128 * MiB;
constexpr size_t WS_END = 2200 * MiB;
constexpr size_t WC_CTX_OFF = (size_t)1024 * 16 * 2048;
constexpr int CW_TMO = 0, CW_BAR = 4096, CW_CNT = 16384;

constexpr int LDS_BYTES = 160 * 1024;
constexpr int MISC_OFF = LDS_BYTES - 256;

#define RLX_AGENT __ATOMIC_RELAXED, __HIP_MEMORY_SCOPE_AGENT
#define LDS_WAIT() asm volatile("s_waitcnt lgkmcnt(0)" ::: "memory")
#define VM_WAIT() asm volatile("s_waitcnt vmcnt(0)" ::: "memory")
__device__ __forceinline__ unsigned f2bf(float f) { unsigned u = __builtin_bit_cast(unsigned, f); return (u + 0x7fffu + ((u >> 16) & 1u)) >> 16; }
typedef __bf16 bf16x2_t __attribute__((ext_vector_type(2)));
__device__ __forceinline__ unsigned pk2(float lo, float hi) { const f32x2 v = {lo, hi}; const bf16x2_t b = __builtin_convertvector(v, bf16x2_t); return __builtin_bit_cast(unsigned, b); }
__device__ __forceinline__ float bf2f(unsigned h) { return __builtin_bit_cast(float, h << 16); }
__device__ __forceinline__ float bflo(unsigned w) { return __builtin_bit_cast(float, w << 16); }
__device__ __forceinline__ float bfhi(unsigned w) { return __builtin_bit_cast(float, w & 0xffff0000u); }
__device__ __forceinline__ float wave_sum(float v) {
#pragma unroll
    for (int o = 1; o < 64; o <<= 1) v += __shfl_xor(v, o);
    return v;
}

#define XB_TMO      128
#define XB_XCNT(j)  (256  + 64 * (j))
#define XB_XSUB(j)  (1280 + 64 * (j))
#define XB_XGEN(j)  (2304 + 64 * (j))
#define XB_TOP      3328
#define XB_TOPGEN   3392
#define XCD_BAR_WORDS 3456
#define XB_SPIN_CAP (1u << 22)
__device__ __forceinline__ unsigned xb_ld(unsigned* p)              { return __hip_atomic_load(p, __ATOMIC_RELAXED, __HIP_MEMORY_SCOPE_AGENT); }
__device__ __forceinline__ unsigned xb_add(unsigned* p, unsigned v) { return __hip_atomic_fetch_add(p, v, __ATOMIC_RELAXED, __HIP_MEMORY_SCOPE_AGENT); }
__device__ __forceinline__ unsigned xb_xcc_id() { return (unsigned)__builtin_amdgcn_s_getreg((3 << 11) | 20) & 0xFu; }
#define XB_SPIN(cond, bar) do { unsigned _sp = 0; while (cond) { __builtin_amdgcn_s_sleep(1); \
    if ((++_sp & 255u) == 0u) { if (xb_ld(&(bar)[XB_TMO])) break; if (_sp > XB_SPIN_CAP) { atomicAdd(&(bar)[XB_TMO], 1u); break; } } } } while (0)
struct XcdBarrier { unsigned* bar; unsigned x; volatile LAS unsigned* st; };
__device__ __forceinline__ XcdBarrier xcd_barrier_post(unsigned* bar, volatile LAS unsigned* st) {
    XcdBarrier b; b.bar = bar; b.x = xb_xcc_id(); b.st = st;
    if (threadIdx.x == 0) (void)xb_add(&bar[XB_XCNT(b.x)], 1u);
    return b;
}
__device__ __forceinline__ void xcd_barrier_complete(unsigned* bar, unsigned x, unsigned& nloc, unsigned& nx) {
    const unsigned G = gridDim.x * gridDim.y * gridDim.z;
    unsigned sum, cnt, mine, sp = 0u;
    for (;;) {
        sum = 0u; cnt = 0u; mine = 0u;
#pragma unroll
        for (unsigned j = 0; j < 16; ++j) { const unsigned c = xb_ld(&bar[XB_XCNT(j)]); sum += c; cnt += (c > 0u) ? 1u : 0u; mine = (j == x) ? c : mine; }
        if (sum == G) break;
        __builtin_amdgcn_s_sleep(1);
        if ((++sp & 255u) == 0u) { if (xb_ld(&bar[XB_TMO])) break; if (sp > XB_SPIN_CAP) { atomicAdd(&bar[XB_TMO], 1u); break; } }
    }
    nloc = mine > 0u ? mine : 1u; nx = cnt > 0u ? cnt : 1u;
}
__device__ __forceinline__ void xcd_barrier(const XcdBarrier& b) {
    asm volatile("s_waitcnt vmcnt(0)" ::: "memory");
    __syncthreads();
    if (threadIdx.x == 0) {
        unsigned* bar = b.bar;
        __builtin_amdgcn_s_waitcnt(0);
        unsigned nloc = b.st[0], nx = b.st[1];
        if (nloc == 0u) { xcd_barrier_complete(bar, b.x, nloc, nx); b.st[0] = nloc; b.st[1] = nx; }
        const unsigned old = xb_add(&bar[XB_XSUB(b.x)], 1u);
        const unsigned gen = old / nloc;
        if (old + 1u == (gen + 1u) * nloc) {
            __builtin_amdgcn_fence(__ATOMIC_RELEASE, "agent");
            asm volatile("s_waitcnt vmcnt(0)" ::: "memory");
            const unsigned og = xb_add(&bar[XB_TOP], 1u);
            const unsigned tg = og / nx;
            if (og + 1u == (tg + 1u) * nx) xb_add(&bar[XB_TOPGEN], 1u);
            else XB_SPIN(xb_ld(&bar[XB_TOPGEN]) == tg, bar);
            __builtin_amdgcn_fence(__ATOMIC_ACQUIRE, "agent");
            xb_add(&bar[XB_XGEN(b.x)], 1u);
            asm volatile("s_waitcnt vmcnt(0)" ::: "memory");
        } else {
            XB_SPIN(xb_ld(&bar[XB_XGEN(b.x)]) == gen, bar);
            __builtin_amdgcn_fence(__ATOMIC_ACQUIRE, "agent");
            asm volatile("s_waitcnt vmcnt(0)" ::: "memory");
        }
    }
    __syncthreads();
}

struct Args { const float* in[32]; float* out; unsigned char* ws; int ph_lo, ph_hi; };
struct Ctx {
    LAS unsigned char* lds;
    int tid, lane, wave, G, bid;
    const float* const* in;
};
enum { I_X = 0, I_C, I_CTX, I_CCTX, I_WMOD, I_BMOD, I_N1G, I_N2G, I_WQKV, I_QG, I_KG, I_WO, I_HWIN, I_HBIN, I_HCW, I_HCB, I_HW1, I_HB1, I_HW2, I_HB2, I_HW3, I_HB3,
       I_HSF, I_HDB, I_HWOUT, I_HBOUT, I_RW, I_RB, I_WGU, I_BGU, I_WDN, I_BDN };

__device__ __forceinline__ int mod_row(int r) { return r < NLAT ? (r >> 11) : NB; }

__device__ __forceinline__ void gemm_unit_simple(const bf16_t* At, const bf16_t* Bt, f32x4 (&acc)[2][2][4][2], int wr, int wc, int fr, int fq) {
    constexpr int K = D;
#pragma unroll
    for (int a = 0; a < 2; ++a)
#pragma unroll
        for (int b = 0; b < 2; ++b)
#pragma unroll
            for (int m = 0; m < 4; ++m)
#pragma unroll
                for (int n = 0; n < 2; ++n) acc[a][b][m][n] = (f32x4){0.f, 0.f, 0.f, 0.f};
    const bf16_t* ap = At + (size_t)(wr * 64 + fr) * K + fq * 8;
    const bf16_t* bp = Bt + (size_t)(wc * 32 + fr) * K + fq * 8;
    for (int k0 = 0; k0 < K; k0 += 32) {
        bf16x8 bfr[2][2];
#pragma unroll
        for (int bj = 0; bj < 2; ++bj)
#pragma unroll
            for (int n = 0; n < 2; ++n) bfr[bj][n] = *(const bf16x8*)(bp + (size_t)(bj * 128 + n * 16) * K + k0);
#pragma unroll
        for (int ai = 0; ai < 2; ++ai)
#pragma unroll
            for (int m = 0; m < 4; ++m) {
                const bf16x8 afr = *(const bf16x8*)(ap + (size_t)(ai * 128 + m * 16) * K + k0);
#pragma unroll
                for (int bj = 0; bj < 2; ++bj)
#pragma unroll
                    for (int n = 0; n < 2; ++n) acc[ai][bj][m][n] = __builtin_amdgcn_mfma_f32_16x16x32_bf16(bfr[bj][n], afr, acc[ai][bj][m][n], 0, 0, 0);
            }
    }
}


struct Unit { int pm, pn, e; };
namespace pg8 {
constexpr int BM = 256, BK = 64, HALF = 128, HTB = HALF * BK * 2, STAGE_BYTES = 8 * HTB;
__device__ __forceinline__ int lds_byte(int r, int c) { const int st = (r >> 4) * 2 + (c >> 5), rr = r & 15, cc = c & 31, ob = rr * 64 + cc * 2; return st * 1024 + (ob ^ (((ob >> 9) & 1) << 5)); }
__device__ __forceinline__ void stage_rc(int b, int& R, int& C) { const int st = b / 1024, sb = b % 1024, swz = sb ^ (((sb >> 9) & 1) << 5); R = (st >> 1) * 16 + swz / 64; C = (st & 1) * 32 + (swz % 64) / 2; }
template <class Epi, class Sched, bool GATHER = false>
__device__ __forceinline__ void gemm_phase(LAS unsigned char* lds, const Sched& S, const Epi& E) {
    constexpr int K = D, nt = K / BK;
    const int tid = threadIdx.x, wid = __builtin_amdgcn_readfirstlane(tid >> 6), lane = tid & 63, wr = wid >> 2, wc = wid & 3, fr = lane & 15, fq = lane >> 4;
    unsigned voffA[2];
#pragma unroll
    for (int i = 0; i < 2; ++i) { int R, C; stage_rc(tid * 16 + i * 8192, R, C); voffA[i] = (unsigned)(R * K + C) * 2u; }
    const size_t kstep = (size_t)(BK * 2);
    const size_t hstep = (size_t)HALF * K * 2;
    const unsigned ldsw = (unsigned)wid * 1024u;
    const int aoff = lds_byte(wr * 64 + fr, fq * 8), boff = lds_byte(wc * 32 + fr, fq * 8);
#define PG8_SA(b, h) (((b) * 2 + (h)) * HTB)
#define PG8_SB(b, h) ((4 + (b) * 2 + (h)) * HTB)
#define PG8_STAGE(bufoff, gbase, voff) do { _Pragma("unroll") for (int _i = 0; _i < 2; ++_i) \
        __builtin_amdgcn_global_load_lds((const unsigned*)((const char*)(gbase) + (voff)[_i]), (LAS unsigned*)(lds + (bufoff) + ldsw + _i * 8192), 16, 0, 0); } while (0)
#define PG8_LDA(dst, b, h) do { _Pragma("unroll") for (int m = 0; m < 4; ++m) _Pragma("unroll") for (int k = 0; k < 2; ++k) dst[m][k] = *(const LAS bf16x8*)(lds + PG8_SA(b, h) + aoff + m * 2048 + k * 1024); } while (0)
#define PG8_LDB(dst, b, h) do { _Pragma("unroll") for (int n = 0; n < 2; ++n) _Pragma("unroll") for (int k = 0; k < 2; ++k) dst[n][k] = *(const LAS bf16x8*)(lds + PG8_SB(b, h) + boff + n * 2048 + k * 1024); } while (0)
#define PG8_MMA(ai, bj, At, Bt) do { __builtin_amdgcn_s_setprio(1); _Pragma("unroll") for (int m = 0; m < 4; ++m) _Pragma("unroll") for (int n = 0; n < 2; ++n) _Pragma("unroll") for (int k = 0; k < 2; ++k) \
        acc[ai][bj][m][n] = __builtin_amdgcn_mfma_f32_16x16x32_bf16(Bt[n][k], At[m][k], acc[ai][bj][m][n], 0, 0, 0); __builtin_amdgcn_s_setprio(0); } while (0)
#define PG8_WAIT_V(n) asm volatile("s_waitcnt vmcnt(" #n ")" ::: "memory")
#define PG8_WAIT_L(n) asm volatile("s_waitcnt lgkmcnt(" #n ")" ::: "memory")
#define PG8_BAR __builtin_amdgcn_s_barrier()
#define PG8_SCHED __builtin_amdgcn_sched_barrier(0)
    unsigned vA[2][2], vN[2][2]; unsigned gR[2], gC[2];
    const char* gA = nullptr;
    if constexpr (GATHER) {
        gA = S.a_base();
#pragma unroll
        for (int i = 0; i < 2; ++i) { gR[i] = voffA[i] / (unsigned)(K * 2); gC[i] = voffA[i] % (unsigned)(K * 2); }
        const LAS int* rw = S.rows(0);
#pragma unroll
        for (int h = 0; h < 2; ++h)
#pragma unroll
            for (int i = 0; i < 2; ++i) { vA[h][i] = (unsigned)rw[h * HALF + gR[i]] * (unsigned)(K * 2) + gC[i]; vN[h][i] = vA[h][i]; }
    }
#define PG8_STAGEA(bufoff, P, V, kt, h) do { if constexpr (GATHER) PG8_STAGE(bufoff, gA + (size_t)(kt) * kstep, V[h]); else PG8_STAGE(bufoff, (P) + (size_t)(kt) * kstep + (size_t)(h) * hstep, voffA); } while (0)
    Unit cur, nxt; int ui = 0;
    if (!S.next(0, cur)) return;
    f32x4 acc[2][2][4][2];
#pragma unroll
    for (int a = 0; a < 2; ++a)
#pragma unroll
        for (int b = 0; b < 2; ++b)
#pragma unroll
            for (int m = 0; m < 4; ++m)
#pragma unroll
                for (int n = 0; n < 2; ++n) acc[a][b][m][n] = (f32x4){0.f, 0.f, 0.f, 0.f};
    bf16x8 At[4][2], B0[2][2], B1[2][2];
    const char* cA = nullptr; if constexpr (!GATHER) cA = S.a_ptr(cur);
    const char* cB = S.b_ptr(cur);
    PG8_STAGE(PG8_SB(0, 0), cB, voffA); PG8_STAGE(PG8_SB(0, 1), cB + hstep, voffA); PG8_STAGEA(PG8_SA(0, 0), cA, vA, 0, 0); PG8_STAGEA(PG8_SA(0, 1), cA, vA, 0, 1);
    if (wr == 1) PG8_BAR;
    PG8_WAIT_V(2); PG8_BAR;
    PG8_STAGE(PG8_SB(1, 0), cB + kstep, voffA); PG8_STAGEA(PG8_SA(1, 0), cA, vA, 1, 0); PG8_STAGE(PG8_SB(1, 1), cB + hstep + kstep, voffA);
    PG8_WAIT_V(6); PG8_BAR;
    for (;;) {
        const bool has_next = S.next(ui + 1, nxt);
        const char* nA = cA; if constexpr (!GATHER) { if (has_next) nA = S.a_ptr(nxt); }
        const char* nB = has_next ? S.b_ptr(nxt) : cB;
        if constexpr (GATHER) { if (has_next) { const LAS int* rw = S.rows(ui + 1);
#pragma unroll
            for (int h = 0; h < 2; ++h)
#pragma unroll
                for (int i = 0; i < 2; ++i) vN[h][i] = (unsigned)rw[h * HALF + gR[i]] * (unsigned)(K * 2) + gC[i]; } }
        for (int t = 0; t < nt; t += 2) {
            const bool last = (t == nt - 2);
            const char* b2 = last ? nB : cB + (size_t)(t + 2) * kstep; const char* b3 = b2 + kstep;
            const char* pX = last ? nA : cA; const int kX = last ? 0 : t + 2;
            unsigned vX[2][2];
#pragma unroll
            for (int h = 0; h < 2; ++h)
#pragma unroll
                for (int i = 0; i < 2; ++i) vX[h][i] = last ? vN[h][i] : vA[h][i];
            PG8_LDB(B0, 0, 0); PG8_LDB(B1, 0, 1); PG8_SCHED; PG8_LDA(At, 0, 0); PG8_STAGEA(PG8_SA(1, 1), cA, vA, t + 1, 1);
            PG8_WAIT_V(8); PG8_WAIT_L(0); PG8_BAR; PG8_MMA(0, 0, At, B0); PG8_MMA(0, 1, At, B1); PG8_BAR; PG8_SCHED;
            PG8_LDA(At, 0, 1); PG8_STAGE(PG8_SB(0, 0), b2, voffA); PG8_STAGE(PG8_SB(0, 1), b2 + hstep, voffA); PG8_STAGEA(PG8_SA(0, 0), pX, vX, kX, 0);
            PG8_WAIT_V(8); PG8_WAIT_L(0); PG8_BAR; PG8_MMA(1, 0, At, B0); PG8_MMA(1, 1, At, B1); PG8_BAR; PG8_SCHED;
            PG8_LDB(B0, 1, 0); PG8_LDB(B1, 1, 1); PG8_SCHED; PG8_LDA(At, 1, 0); PG8_STAGEA(PG8_SA(0, 1), pX, vX, kX, 1);
            PG8_WAIT_V(8); PG8_WAIT_L(0); PG8_BAR; PG8_MMA(0, 0, At, B0); PG8_MMA(0, 1, At, B1); PG8_BAR; PG8_SCHED;
            PG8_LDA(At, 1, 1); PG8_STAGE(PG8_SB(1, 0), b3, voffA); PG8_STAGE(PG8_SB(1, 1), b3 + hstep, voffA); PG8_STAGEA(PG8_SA(1, 0), pX, vX, kX + 1, 0);
            PG8_WAIT_V(8); PG8_WAIT_L(0); PG8_BAR; PG8_MMA(1, 0, At, B0); PG8_MMA(1, 1, At, B1); PG8_BAR; PG8_SCHED;
        }
        if (wr == 0) PG8_BAR;
        E(acc, cur, wr, wc, fr, fq);
        if (!has_next) break;
#pragma unroll
        for (int a = 0; a < 2; ++a)
#pragma unroll
            for (int b = 0; b < 2; ++b)
#pragma unroll
                for (int m = 0; m < 4; ++m)
#pragma unroll
                    for (int n = 0; n < 2; ++n) acc[a][b][m][n] = (f32x4){0.f, 0.f, 0.f, 0.f};
        cur = nxt; cA = nA; cB = nB; ++ui;
        if constexpr (GATHER) {
#pragma unroll
            for (int h = 0; h < 2; ++h)
#pragma unroll
                for (int i = 0; i < 2; ++i) vA[h][i] = vN[h][i]; }
        if (wr == 1) PG8_BAR;
    }
    PG8_WAIT_V(0);
    PG8_BAR;
#undef PG8_SA
#undef PG8_SB
#undef PG8_STAGE
#undef PG8_STAGEA
#undef PG8_LDA
#undef PG8_LDB
#undef PG8_MMA
#undef PG8_WAIT_V
#undef PG8_WAIT_L
#undef PG8_BAR
#undef PG8_SCHED
}
}

template <class Epi, class Sched>
__device__ __forceinline__ void gemm_phase_simple(const Sched& S, const Epi& E) {
    const int tid = threadIdx.x, wid = __builtin_amdgcn_readfirstlane(tid >> 6), lane = tid & 63, wr = wid >> 2, wc = wid & 3, fr = lane & 15, fq = lane >> 4;
    Unit u;
    for (int i = 0; S.next(i, u); ++i) { f32x4 acc[2][2][4][2];
        gemm_unit_simple((const bf16_t*)S.a_ptr(u), (const bf16_t*)S.b_ptr(u), acc, wr, wc, fr, fq);
        E(acc, u, wr, wc, fr, fq); }
}
#ifndef FAST_GEMM
#define FAST_GEMM 1
#endif
template <class Epi, class Sched>
__device__ __forceinline__ void run_gemm(LAS unsigned char* lds, const Sched& S, const Epi& E) {
#if FAST_GEMM
    pg8::gemm_phase<Epi, Sched, false>(lds, S, E);
#else
    gemm_phase_simple<Epi, Sched>(S, E);
#endif
}
template <class Epi, class Sched>
__device__ __forceinline__ void run_gemm_gather(LAS unsigned char* lds, const Sched& S, const Epi& E) { pg8::gemm_phase<Epi, Sched, true>(lds, S, E); }
__device__ __forceinline__ bool xcd_unit(int i, int G, int c, int nM, int nN, int& pm, int& pn) {
    const int x = c & 7, s = c >> 3, nS = G >> 3;
    const int r0 = (nM * x) >> 3, r1 = (nM * (x + 1)) >> 3;
    const int q = i * nS + s; if (q >= (r1 - r0) * nN) return false;
    const int rr = q / nN; pm = r0 + rr; pn = q - rr * nN; return true;
}
struct DenseSched {
    const bf16_t* A; const bf16_t* Bt; int nM, nN, G, c;
    __device__ __forceinline__ bool next(int i, Unit& u) const { u.e = 0; return xcd_unit(i, G, c, nM, nN, u.pm, u.pn); }
    __device__ __forceinline__ const char* a_ptr(const Unit& u) const { return (const char*)(A + (size_t)u.pm * 256 * D); }
    __device__ __forceinline__ const char* b_ptr(const Unit& u) const { return (const char*)(Bt + (size_t)u.pn * 256 * D); }
};
struct QkvSched {
    const bf16_t* A; const bf16_t* Bt; int live, G, c;
    __device__ __forceinline__ bool next(int i, Unit& u) const { u.e = 0;
        if (live) return xcd_unit(i, G, c, 144, 6, u.pm, u.pn);
        const int x = c & 7, s = c >> 3, nS = G >> 3; const int nlat = 16 * 6; const int q = i * nS + s;
        if (q < nlat) { const int rr = q / 6; u.pm = 16 * x + rr; u.pn = q - rr * 6; return true; }
        const int q2 = q - nlat; if (q2 >= 4) return false; const int t = x * 4 + q2; u.pm = 128 + (t >> 1); u.pn = 4 + (t & 1); return true; }
    __device__ __forceinline__ const char* a_ptr(const Unit& u) const { return (const char*)(A + (size_t)u.pm * 256 * D); }
    __device__ __forceinline__ const char* b_ptr(const Unit& u) const { return (const char*)(Bt + (size_t)u.pn * 256 * D); }
};
struct MoeSched {
    const bf16_t* A; const bf16_t* Bt  ; const LAS unsigned char* TE; int nM, nN, N, G, c;
    __device__ __forceinline__ bool next(int i, Unit& u) const { if (!xcd_unit(i, G, c, nM, nN, u.pm, u.pn)) return false; u.e = TE[u.pm]; return true; }
    __device__ __forceinline__ const char* a_ptr(const Unit& u) const { return (const char*)(A + (size_t)u.pm * 256 * D); }
    __device__ __forceinline__ const char* b_ptr(const Unit& u) const { return (const char*)(Bt + ((size_t)u.e * N + (size_t)u.pn * 256) * D); }
};
struct MoeGatherSched {
    const bf16_t* A; const bf16_t* Bt; const LAS unsigned char* TE; const LAS int* ROWS; int nM, nN, N, G, c;
    __device__ __forceinline__ bool next(int i, Unit& u) const { if (!xcd_unit(i, G, c, nM, nN, u.pm, u.pn)) return false; u.e = TE[u.pm]; return true; }
    __device__ __forceinline__ const char* a_base() const { return (const char*)A; }
    __device__ __forceinline__ const LAS int* rows(int ui) const { return ROWS + ui * 256; }
    __device__ __forceinline__ const char* a_ptr(const Unit& u) const { return (const char*)A; }
    __device__ __forceinline__ const char* b_ptr(const Unit& u) const { return (const char*)(Bt + ((size_t)u.e * N + (size_t)u.pn * 256) * D); }
};

struct EpiQKV {
    bf16_t *Q, *Kb, *Vb; const float *qg, *kg, *cosT, *sinT;
    __device__ __forceinline__ void operator()(const f32x4 (&acc)[2][2][4][2], const Unit& uu, int wr, int wc, int fr, int fq) const {
        const int pm = uu.pm, pn = uu.pn;
        const int kind = pn < 4 ? 0 : (pn == 4 ? 1 : 2);
        const float* gain = kind == 0 ? qg : kg;
        f32x4 gv[2][2];
#pragma unroll
        for (int bj = 0; bj < 2; ++bj)
#pragma unroll
            for (int n = 0; n < 2; ++n) gv[bj][n] = *(const f32x4*)(gain + 32 * bj + 16 * n + 4 * fq);
#pragma unroll
        for (int ai = 0; ai < 2; ++ai)
#pragma unroll
            for (int m = 0; m < 4; ++m) {
                const int r = pm * 256 + ai * 128 + wr * 64 + m * 16 + fr;
                const bool lat = r < NLAT;
                const int b = lat ? (r >> 11) : ((r - NLAT) >> 8);
                const int pos = lat ? (r & (SEQ - 1)) : (SEQ + ((r - NLAT) & (CL - 1)));
                f32x4 v[2][2];
#pragma unroll
                for (int bj = 0; bj < 2; ++bj)
#pragma unroll
                    for (int n = 0; n < 2; ++n) v[bj][n] = acc[ai][bj][m][n];
                if (kind != 2) {
                    float ss = 0.f;
#pragma unroll
                    for (int bj = 0; bj < 2; ++bj)
#pragma unroll
                        for (int n = 0; n < 2; ++n) ss += (v[bj][n][0] * v[bj][n][0] + v[bj][n][1] * v[bj][n][1]) + (v[bj][n][2] * v[bj][n][2] + v[bj][n][3] * v[bj][n][3]);
                    ss += __shfl_xor(ss, 16); ss += __shfl_xor(ss, 32);
                    const float rinv = 1.0f / sqrtf(ss * (1.0f / 64.0f) + EPS);
#pragma unroll
                    for (int bj = 0; bj < 2; ++bj)
#pragma unroll
                        for (int n = 0; n < 2; ++n) v[bj][n] = v[bj][n] * rinv * gv[bj][n];
                    if (lat) {
#pragma unroll
                        for (int bj = 0; bj < 2; ++bj) {
                            const f32x4 cs = *(const f32x4*)(cosT + pos * 32 + bj * 16 + 4 * fq), sn = *(const f32x4*)(sinT + pos * 32 + bj * 16 + 4 * fq);
                            const f32x4 x1 = v[bj][0], x2 = v[bj][1];
                            v[bj][0] = x1 * cs - x2 * sn; v[bj][1] = x2 * cs + x1 * sn;
                        }
                    }
                    if (kind == 0) {
#pragma unroll
                        for (int bj = 0; bj < 2; ++bj)
#pragma unroll
                            for (int n = 0; n < 2; ++n) v[bj][n] = v[bj][n] * C2;
                    }
                }
                bf16_t* dst = kind == 0 ? Q + (size_t)r * D + pn * 256 + wc * 64
                                        : (kind == 1 ? Kb : Vb) + ((size_t)b * KVL + pos) * 256 + wc * 64;
#pragma unroll
                for (int bj = 0; bj < 2; ++bj) { u32x4 w; w.x = pk2(v[bj][0][0], v[bj][0][1]); w.y = pk2(v[bj][0][2], v[bj][0][3]); w.z = pk2(v[bj][1][0], v[bj][1][1]); w.w = pk2(v[bj][1][2], v[bj][1][3]);
                    *(u32x4*)(dst + 32 * bj + 8 * fq) = w; }
            }
    }
};
struct EpiBiasBf16 {
    bf16_t* O; int ldc; const float* bias0; int estride;
    __device__ __forceinline__ void operator()(const f32x4 (&acc)[2][2][4][2], const Unit& uu, int wr, int wc, int fr, int fq) const {
        const int row0 = uu.pm * 256, col0t = uu.pn * 256;
#pragma unroll
        for (int bj = 0; bj < 2; ++bj) {
            const int c = col0t + bj * 128 + wc * 32 + 8 * fq;
            const float* bp = bias0 + (size_t)uu.e * estride + c; const f32x4 b0 = *(const f32x4*)bp, b1 = *(const f32x4*)(bp + 4);
#pragma unroll
            for (int ai = 0; ai < 2; ++ai)
#pragma unroll
                for (int m = 0; m < 4; ++m) { const int r = row0 + ai * 128 + wr * 64 + m * 16 + fr; const f32x4 v0 = acc[ai][bj][m][0] + b0, v1 = acc[ai][bj][m][1] + b1;
                    u32x4 w; w.x = pk2(v0[0], v0[1]); w.y = pk2(v0[2], v0[3]); w.z = pk2(v1[0], v1[1]); w.w = pk2(v1[2], v1[3]); *(u32x4*)(O + (size_t)r * ldc + c) = w; }
        }
    }
};
template <bool SRC32> struct EpiResid {
    const float *srcL, *srcC; bf16_t* XB; const float* gate  ; const float* bias;
    __device__ __forceinline__ void operator()(f32x4 (&acc)[2][2][4][2], const Unit& uu, int wr, int wc, int fr, int fq) const {
        const int row0 = uu.pm * 256, col0t = uu.pn * 256;
        const float* gp0 = gate + (size_t)mod_row(row0) * MODW;
        const float* sb = row0 < NLAT ? srcL + (size_t)row0 * D : srcC + (size_t)(row0 - NLAT) * D;
        bf16_t* xb = XB + (size_t)row0 * D;
#pragma unroll
        for (int bj = 0; bj < 2; ++bj) {
            const int c = col0t + bj * 128 + wc * 32 + 8 * fq;
            const f32x4 g0 = *(const f32x4*)(gp0 + c), g1 = *(const f32x4*)(gp0 + c + 4);
            f32x4 b0 = (f32x4){0.f, 0.f, 0.f, 0.f}, b1 = b0; if (bias) { b0 = *(const f32x4*)(bias + c); b1 = *(const f32x4*)(bias + c + 4); }
#pragma unroll
            for (int ai = 0; ai < 2; ++ai) {
                f32x4 x0[4], x1[4];
#pragma unroll
                for (int m = 0; m < 4; ++m) { const size_t ro = (size_t)(ai * 128 + wr * 64 + m * 16 + fr) * D + c;
                    if constexpr (SRC32) { x0[m] = *(const f32x4*)(sb + ro); x1[m] = *(const f32x4*)(sb + ro + 4); }
                    else { const u32x4 w = *(const u32x4*)(xb + ro); x0[m] = (f32x4){bflo(w.x), bfhi(w.x), bflo(w.y), bfhi(w.y)}; x1[m] = (f32x4){bflo(w.z), bfhi(w.z), bflo(w.w), bfhi(w.w)}; } }
#pragma unroll
                for (int m = 0; m < 4; ++m) { const size_t ro = (size_t)(ai * 128 + wr * 64 + m * 16 + fr) * D + c;
                    const f32x4 y0 = x0[m] + g0 * (acc[ai][bj][m][0] + b0), y1 = x1[m] + g1 * (acc[ai][bj][m][1] + b1);
                    u32x4 w; w.x = pk2(y0[0], y0[1]); w.y = pk2(y0[2], y0[3]); w.z = pk2(y1[0], y1[1]); w.w = pk2(y1[2], y1[3]); *(u32x4*)(xb + ro) = w; }
                asm volatile("" ::: "memory");
            }
        }
    }
};
struct EpiSwiglu {
    bf16_t* O; const float* bgu0  ;
    __device__ __forceinline__ void operator()(const f32x4 (&acc)[2][2][4][2], const Unit& uu, int wr, int wc, int fr, int fq) const {
        const int row0 = uu.pm * 256, pn = uu.pn; const float* bgu = bgu0 + (size_t)uu.e * NGU;
        const int f = pn * 128 + wc * 32 + 8 * fq;
        f32x4 bg[2], bu[2];
#pragma unroll
        for (int n = 0; n < 2; ++n) { const f32x4 q0 = *(const f32x4*)(bgu + 2 * (f + 4 * n)), q1 = *(const f32x4*)(bgu + 2 * (f + 4 * n) + 4);
            bg[n] = (f32x4){q0[0], q0[2], q1[0], q1[2]}; bu[n] = (f32x4){q0[1], q0[3], q1[1], q1[3]}; }
#pragma unroll
        for (int ai = 0; ai < 2; ++ai)
#pragma unroll
            for (int m = 0; m < 4; ++m) { const int r = row0 + ai * 128 + wr * 64 + m * 16 + fr; float o[8];
#pragma unroll
                for (int n = 0; n < 2; ++n) { const f32x4 gg = acc[ai][0][m][n] + bg[n], uq = acc[ai][1][m][n] + bu[n];
#pragma unroll
                    for (int p = 0; p < 2; ++p) {
                        f32x2 g2 = {fminf(gg[2 * p], 7.0f), fminf(gg[2 * p + 1], 7.0f)};
                        f32x2 u2 = {__builtin_amdgcn_fmed3f(uq[2 * p], -7.0f, 7.0f), __builtin_amdgcn_fmed3f(uq[2 * p + 1], -7.0f, 7.0f)};
                        const f32x2 z = g2 * (-2.4554669595930157f);
                        f32x2 e2 = {__builtin_amdgcn_exp2f(z.x), __builtin_amdgcn_exp2f(z.y)};
                        e2 = e2 + 1.0f;
                        const f32x2 r2 = {__builtin_amdgcn_rcpf(e2.x), __builtin_amdgcn_rcpf(e2.y)};
                        const f32x2 o2 = ((u2 + 1.0f) * g2) * r2;
                        o[4 * n + 2 * p] = o2.x; o[4 * n + 2 * p + 1] = o2.y; } }
                u32x4 w; w.x = pk2(o[0], o[1]); w.y = pk2(o[2], o[3]); w.z = pk2(o[4], o[5]); w.w = pk2(o[6], o[7]); *(u32x4*)(O + (size_t)r * D + f) = w; }
    }
};

__device__ __forceinline__ int slot32(int cg) { return (((cg >> 2) & 1) << 4) + ((cg >> 3) << 2) + (cg & 3); }
template <int MODE> __device__ __forceinline__ int wrow_map(int n) {
    if (MODE == 0) return (n & ~31) + slot32(n & 31);
    if (MODE == 1) { const int pn = n >> 8, wc = (n >> 6) & 3, bj = (n >> 5) & 1, j = n & 31;
        return (pn << 8) + (bj << 7) + (wc << 5) + (pn < 5 ? j : slot32(j)); }
    { const int f = n >> 1, pn = f >> 7, fo = f & 127; return (pn << 8) + ((n & 1) << 7) + (fo & ~31) + slot32(fo & 31); }
}
template <int MODE> __device__ __forceinline__ void transpose_item(const float* W, int N, bf16_t* WT, LAS float* scr, int item, int lane) {
    constexpr int K = D;
    const int nblk = N / 32, kb = item / nblk, nb = item % nblk, k0 = 64 * kb, n0 = 32 * nb;
#pragma unroll 8
    for (int i = 0; i < 32; ++i) { const int kk = 2 * i + (lane >> 5); scr[kk * 33 + (lane & 31)] = __builtin_nontemporal_load(W + (size_t)(k0 + kk) * N + n0 + (lane & 31)); }
    LDS_WAIT(); asm volatile("" ::: "memory");
    const int c = lane & 7;
#pragma unroll
    for (int j = 0; j < 4; ++j) { const int n = (lane >> 3) + 8 * j; const LAS float* s = scr + (8 * c) * 33 + n;
        u32x4 o; o.x = pk2(s[0 * 33], s[1 * 33]); o.y = pk2(s[2 * 33], s[3 * 33]); o.z = pk2(s[4 * 33], s[5 * 33]); o.w = pk2(s[6 * 33], s[7 * 33]);
        __builtin_nontemporal_store(o, (u32x4*)(WT + (size_t)wrow_map<MODE>(n0 + n) * K + k0 + 8 * c)); }
    LDS_WAIT(); asm volatile("" ::: "memory");
}

__device__ __forceinline__ void norm_mod_store(const f32x4 (&v)[4], const f32x4 (&gs)[4], const f32x4 (&sh)[4], bf16_t* dst, int lane, f32x4 (&h)[4]) {
    float ss = 0.f;
#pragma unroll
    for (int j = 0; j < 4; ++j) ss += (v[j][0] * v[j][0] + v[j][1] * v[j][1]) + (v[j][2] * v[j][2] + v[j][3] * v[j][3]);
    ss = wave_sum(ss);
    const float rinv = __builtin_amdgcn_rsqf(ss * (1.0f / D) + EPS);
#pragma unroll
    for (int j = 0; j < 4; ++j) {
        h[j] = (v[j] * rinv) * gs[j] + sh[j];
        u32x2 w; w.x = pk2(h[j][0], h[j][1]); w.y = pk2(h[j][2], h[j][3]);
        ((u32x2*)dst)[lane + 64 * j] = w;
    }
}
__device__ __forceinline__ void load_vec_bf(const bf16_t* p, int lane, f32x4 (&v)[4]) {
#pragma unroll
    for (int j = 0; j < 4; ++j) { const u32x2 w = ((const u32x2*)p)[lane + 64 * j]; v[j] = (f32x4){bflo(w.x), bfhi(w.x), bflo(w.y), bfhi(w.y)}; }
}
__device__ __forceinline__ void load_vec(const float* p, int lane, f32x4 (&v)[4]) {
#pragma unroll
    for (int j = 0; j < 4; ++j) v[j] = ((const f32x4*)p)[lane + 64 * j];
}


namespace attn_body {
using bf16=__hip_bfloat16;
using bf16x8=__attribute__((ext_vector_type(8)))short;
using s16x4=__attribute__((ext_vector_type(4)))short;
using f32x16=__attribute__((ext_vector_type(16)))float;
using u32x4=__attribute__((ext_vector_type(4)))unsigned;
constexpr int D=64,DM=1024,KVP=256;
constexpr int NW=8,QBLK=32,QB=QBLK*NW,KVBLK=64;
__device__ __forceinline__ int crow(int r,int hi){return (r&3)+8*(r>>2)+4*hi;}
#define SBAR() __builtin_amdgcn_sched_barrier(0)
__device__ __forceinline__ void cmask(f32x16&p0,f32x16&p1,int jb,int qrel,int hi){
  const float NEG=-INFINITY; int kb=64*jb+4*hi;
  #pragma unroll
  for(int r=0;r<16;++r){int kv=kb+(r&3)+8*(r>>2); if(kv>qrel)p0[r]=NEG; if(kv+32>qrel)p1[r]=NEG;}
}

constexpr int NSLOT=3, SLOTB=8192;
constexpr int LDS_K=0, LDS_V=NSLOT*SLOTB, LDS_WS=2*NSLOT*SLOTB, LDS_OST=LDS_WS+NW*64*4, LDS_BYTES=LDS_OST+NW*4096;
constexpr float C2=0.125f*1.4426950408889634f;
__device__ __forceinline__ void glds16(const void*gsrc,unsigned lds_dst){unsigned keep;
  asm volatile("s_mov_b32 %0, m0\n\ts_mov_b32 m0, %2\n\ts_nop 0\n\tglobal_load_lds_dwordx4 %1, off\n\ts_mov_b32 m0, %0":"=&s"(keep):"v"(gsrc),"s"(lds_dst):"memory");}
__device__ __forceinline__ float max3f(float a,float b,float c){float r;asm("v_max3_f32 %0, %1, %2, %3":"=v"(r):"v"(a),"v"(b),"v"(c));return r;}
__device__ __forceinline__ float max2f(float a,float b){float r;asm("v_max_f32_e32 %0, %1, %2":"=v"(r):"v"(a),"v"(b));return r;}
__device__ __forceinline__ float fadd_s(float a,float b){float r;asm("v_add_f32_e32 %0, %1, %2":"=v"(r):"v"(a),"v"(b));return r;}
__device__ __forceinline__ float fsub_s(float a,float b){float r;asm("v_sub_f32_e32 %0, %1, %2":"=v"(r):"v"(a),"v"(b));return r;}
typedef float f32x2_t __attribute__((ext_vector_type(2))); typedef __bf16 bf16x2_t __attribute__((ext_vector_type(2)));
__device__ __forceinline__ unsigned cvtpk_s(float lo,float hi){f32x2_t v={lo,hi};bf16x2_t b=__builtin_convertvector(v,bf16x2_t);return __builtin_bit_cast(unsigned,b);}
#define WAIT_BAR(N) asm volatile("s_waitcnt vmcnt(" #N ") lgkmcnt(0)\n\ts_barrier":::"memory")

__device__ __forceinline__ void qkt(f32x16&p0,f32x16&p1,const char*Kslot,const bf16x8*qr,const f32x16&negm,int r32,int hi){
  const char*kb=Kslot+hi*1024+r32*16;
  #pragma unroll
  for(int d0=0;d0<4;++d0){
    const bf16x8 b0=*reinterpret_cast<const bf16x8*>(kb+d0*2048);
    const bf16x8 b1=*reinterpret_cast<const bf16x8*>(kb+d0*2048+512);
    if(d0==0){p0=__builtin_amdgcn_mfma_f32_32x32x16_bf16(b0,qr[0],negm,0,0,0);p1=__builtin_amdgcn_mfma_f32_32x32x16_bf16(b1,qr[0],negm,0,0,0);}
    else{p0=__builtin_amdgcn_mfma_f32_32x32x16_bf16(b0,qr[d0],p0,0,0,0);p1=__builtin_amdgcn_mfma_f32_32x32x16_bf16(b1,qr[d0],p1,0,0,0);}}
}
typedef __attribute__((address_space(3))) const char* lds_cptr;
typedef short v4i16_t __attribute__((ext_vector_type(4)));
__device__ __forceinline__ void kload8(bf16x8*kf,lds_cptr kp){
  kf[0]=*(const __attribute__((address_space(3))) bf16x8*)(kp);      kf[1]=*(const __attribute__((address_space(3))) bf16x8*)(kp+512);
  kf[2]=*(const __attribute__((address_space(3))) bf16x8*)(kp+2048); kf[3]=*(const __attribute__((address_space(3))) bf16x8*)(kp+2560);
  kf[4]=*(const __attribute__((address_space(3))) bf16x8*)(kp+4096); kf[5]=*(const __attribute__((address_space(3))) bf16x8*)(kp+4608);
  kf[6]=*(const __attribute__((address_space(3))) bf16x8*)(kp+6144); kf[7]=*(const __attribute__((address_space(3))) bf16x8*)(kp+6656);
}
__device__ __forceinline__ void kload2(bf16x8*kf,lds_cptr kp,int j){ kf[2*j]=*(const __attribute__((address_space(3))) bf16x8*)(kp+j*2048); kf[2*j+1]=*(const __attribute__((address_space(3))) bf16x8*)(kp+j*2048+512); }
__device__ __forceinline__ s16x4 vtr(lds_cptr p){ return __builtin_bit_cast(s16x4,__builtin_amdgcn_ds_read_tr16_b64_v4i16((__attribute__((address_space(3))) v4i16_t*)p)); }
__device__ __forceinline__ float rowmax(const f32x16&p0,const f32x16&p1){
  float a=max3f(p0[0],p0[1],p1[0]),b=max3f(p0[2],p0[3],p1[1]);a=max3f(a,p1[2],p1[3]);
  #pragma unroll
  for(int r=4;r<16;r+=4){a=max3f(a,p0[r],p0[r+1]);b=max3f(b,p0[r+2],p0[r+3]);a=max3f(a,p1[r],p1[r+1]);b=max3f(b,p1[r+2],p1[r+3]);}
  const float m=max2f(a,b);
  auto rr=__builtin_amdgcn_permlane32_swap(__float_as_uint(m),__float_as_uint(m),false,false);
  return max2f(__uint_as_float(rr[0]),__uint_as_float(rr[1]));
}
__device__ __forceinline__ void pv(f32x16*o,int vb,bf16x8 pa0,bf16x8 pa1,bf16x8 pa2,bf16x8 pa3){
  #pragma unroll
  for(int d0=0;d0<2;++d0){s16x4 lo[4],hi[4];
    #pragma unroll
    for(int ks=0;ks<4;++ks){
      asm volatile("ds_read_b64_tr_b16 %0,%1 offset:%c2":"=&v"(lo[ks]):"v"(vb),"i"(d0*4096+ks*1024):"memory");
      asm volatile("ds_read_b64_tr_b16 %0,%1 offset:%c2":"=&v"(hi[ks]):"v"(vb),"i"(d0*4096+ks*1024+512):"memory");}
    asm volatile("s_waitcnt lgkmcnt(0)":::"memory");SBAR();
    #define PK(k) (bf16x8){lo[k][0],lo[k][1],lo[k][2],lo[k][3],hi[k][0],hi[k][1],hi[k][2],hi[k][3]}
    o[d0]=__builtin_amdgcn_mfma_f32_32x32x16_bf16(pa0,PK(0),o[d0],0,0,0);
    o[d0]=__builtin_amdgcn_mfma_f32_32x32x16_bf16(pa1,PK(1),o[d0],0,0,0);
    o[d0]=__builtin_amdgcn_mfma_f32_32x32x16_bf16(pa2,PK(2),o[d0],0,0,0);
    o[d0]=__builtin_amdgcn_mfma_f32_32x32x16_bf16(pa3,PK(3),o[d0],0,0,0);
    #undef PK
  }
}

#ifndef ATTN_STORE16
#define ATTN_STORE16(p,v) (*(u32x4*)(p)=(v))
#endif
template<int THRL> __device__ __forceinline__ void attn_unit(const bf16*Qu,const bf16*__restrict__ Kh,const bf16*__restrict__ Vh,bf16*Ou,const int NT,char*shm){
  const int tid=threadIdx.x,lane=tid&63,r32=lane&31,hi=lane>>5; const int wid=__builtin_amdgcn_readfirstlane(tid>>6);
  const bf16*Qw=Qu+(long)(wid*QBLK)*DM;
  const unsigned lds0=(unsigned)(uintptr_t)shm;
  float*wsf=(float*)(shm+LDS_WS)+wid*64;
  const bf16*ksrc=Kh+(long)lane*KVP+wid*8;
  const bf16*vsrc=Vh+(long)(16*(wid&3)+(lane>>2))*KVP+(wid>>2)*32+(lane&3)*8;
  const unsigned kdst=lds0+LDS_K+wid*1024, vdst=lds0+LDS_V+wid*1024;
  #define DMA_K(t,slot) glds16(ksrc+(long)(t)*KVBLK*KVP,(unsigned)__builtin_amdgcn_readfirstlane(kdst+(slot)))
  #define DMA_V(t,slot) glds16(vsrc+(long)(t)*KVBLK*KVP,(unsigned)__builtin_amdgcn_readfirstlane(vdst+(slot)))
  const int vb0=(int)(lds0+LDS_V)+((lane>>4)&1)*32+(lane&3)*8+(4*hi+((lane&15)>>2))*64;
  const char*Kbase=shm+LDS_K; bf16x8 kf[8];
  const lds_cptr shm3=(lds_cptr)shm; const lds_cptr kp0=shm3+LDS_K+hi*1024+r32*16; const lds_cptr vp0=shm3+LDS_V+((lane>>4)&1)*32+(lane&3)*8+(4*hi+((lane&15)>>2))*64;
  DMA_K(0,0);DMA_V(0,0);DMA_K(1,SLOTB);
  bf16x8 qr[4];
  #pragma unroll
  for(int d0=0;d0<4;++d0)qr[d0]=*reinterpret_cast<const bf16x8*>(&Qw[(long)r32*DM+d0*16+hi*8]);
  float mhat=0.f,l_reg=0.f;f32x16 o[2];o[0]=f32x16{};o[1]=f32x16{};f32x16 negm=f32x16{};asm volatile("":"+v"(negm));
  #define CMASK(P0,P1,t) do{}while(0)
  bool resc=false;
  #define START(P0,P1) do{ const float rm=rowmax(P0,P1); resc=false; \
    { const float dl=rm; mhat=fadd_s(mhat,dl); \
      _Pragma("unroll") for(int r=0;r<16;++r){P0[r]=fsub_s(P0[r],dl);P1[r]=fsub_s(P1[r],dl);} \
      _Pragma("unroll") for(int r=0;r<16;++r)negm[r]=-mhat; asm volatile("":"+v"(negm)); } \
    _Pragma("unroll") for(int r=0;r<16;++r)P0[r]=__builtin_amdgcn_exp2f(P0[r]); }while(0)
  #define RESC() do{ if(resc){ asm volatile("s_waitcnt lgkmcnt(0)":::"memory"); \
      _Pragma("unroll") for(int d_=0;d_<2;++d_) _Pragma("unroll") for(int r=0;r<16;++r)o[d_][r]*=wsf[crow(r,hi)]; } }while(0)
  f32x16 pA0,pA1,pB0,pB1;
  int sl_prev=0,sl_cur=0,sl_next=SLOTB;
  #define ROT() do{sl_prev=sl_cur;sl_cur=sl_next;sl_next=(sl_next==(NSLOT-1)*SLOTB)?0:sl_next+SLOTB;}while(0)
  DMA_K(2,2*SLOTB);
  WAIT_BAR(3);
  qkt(pA0,pA1,Kbase,qr,negm,r32,hi);asm volatile("s_nop 15\n\ts_nop 7":"+v"(pA0),"+v"(pA1));CMASK(pA0,pA1,0);
  START(pA0,pA1);
  _Pragma("unroll") for(int r=0;r<16;++r)pA1[r]=__builtin_amdgcn_exp2f(pA1[r]);
  WAIT_BAR(0);
  DMA_K(3,0);DMA_V(1,SLOTB);
  ROT();
  kload8(kf,kp0+sl_cur);
  WAIT_BAR(2);
  s16x4 vlo[8],vhi[8]; u32x4 pw0,pw1,pw2,pw3;
  #define PKW(P,B) cvtpk_s(P[B],P[B+1])
  #define PAF(k) __builtin_bit_cast(bf16x8,pw##k)
  #define VFR(i) (bf16x8){vlo[i][0],vlo[i][1],vlo[i][2],vlo[i][3],vhi[i][0],vhi[i][1],vhi[i][2],vhi[i][3]}
  #define PIN(x) asm volatile("":"+v"(x))
  #define MX3(a,b,c) __builtin_fmaxf(__builtin_fmaxf((a),(b)),(c))
  #define GAPA(MF,A0,A1,A2,A3,W0,W1,PW) do{ MF; sacc+=A0; sacc+=A1; sacc+=A2; sacc+=A3; PIN(sacc); W0; W1; PIN(PW); SBAR(); }while(0)
  #define EX(v) __builtin_amdgcn_exp2f(v)
  #define GAPB(MF,X,B) do{ MF; X[B]=EX(X[B]); X[B+1]=EX(X[B+1]); X[B+2]=EX(X[B+2]); X[B+3]=EX(X[B+3]); PIN(X); SBAR(); }while(0)
  #define VRD(i) do{ vlo[i]=vtr(vp_+(((i)>>2)*4096+((i)&3)*1024)); vhi[i]=vtr(vp_+(((i)>>2)*4096+((i)&3)*1024+512)); }while(0)
  #define KRD(G,j) do{ if(G){ kload2(kf,kp0+sl_next,j); SBAR(); } }while(0)
  #define STEP(C0,C1,P0,P1,t,GK,GV,GL) do{ SBAR(); \
    const lds_cptr vp_=vp0+sl_prev; \
    VRD(0); SBAR(); float sacc=(P0[0]+P0[1]); \
    GAPA(C0=__builtin_amdgcn_mfma_f32_32x32x16_bf16(kf[0],qr[0],negm,0,0,0), P0[2],P0[3],P0[4],P0[5],     pw0[0]=PKW(P0,0), pw0[1]=PKW(P0,2), pw0); \
    VRD(4); SBAR(); GAPA(C1=__builtin_amdgcn_mfma_f32_32x32x16_bf16(kf[1],qr[0],negm,0,0,0), P0[6],P0[7],P0[8],P0[9],     pw0[2]=PKW(P0,4), pw0[3]=PKW(P0,6), pw0); \
    VRD(1); SBAR(); GAPA(C0=__builtin_amdgcn_mfma_f32_32x32x16_bf16(kf[2],qr[1],C0,0,0,0),   P0[10],P0[11],P0[12],P0[13], pw1[0]=PKW(P0,8), pw1[1]=PKW(P0,10), pw1); \
    VRD(5); SBAR(); GAPA(C1=__builtin_amdgcn_mfma_f32_32x32x16_bf16(kf[3],qr[1],C1,0,0,0),   P0[14],P0[15],P1[0],P1[1],   pw1[2]=PKW(P0,12),pw1[3]=PKW(P0,14), pw1); \
    VRD(2); SBAR(); GAPA(C0=__builtin_amdgcn_mfma_f32_32x32x16_bf16(kf[4],qr[2],C0,0,0,0),   P1[2],P1[3],P1[4],P1[5],     pw2[0]=PKW(P1,0), pw2[1]=PKW(P1,2), pw2); \
    VRD(6); SBAR(); GAPA(C1=__builtin_amdgcn_mfma_f32_32x32x16_bf16(kf[5],qr[2],C1,0,0,0),   P1[6],P1[7],P1[8],P1[9],     pw2[2]=PKW(P1,4), pw2[3]=PKW(P1,6), pw2); \
    VRD(3); SBAR(); GAPA(C0=__builtin_amdgcn_mfma_f32_32x32x16_bf16(kf[6],qr[3],C0,0,0,0),   P1[10],P1[11],P1[12],P1[13], pw3[0]=PKW(P1,8), pw3[1]=PKW(P1,10), pw3); \
    VRD(7); SBAR(); GAPA(C1=__builtin_amdgcn_mfma_f32_32x32x16_bf16(kf[7],qr[3],C1,0,0,0),   P1[14],P1[15],0.f,0.f,       pw3[2]=PKW(P1,12),pw3[3]=PKW(P1,14), pw3); \
    l_reg+=sacc; \
    if(GK){DMA_K((t)+3,sl_cur);} if(GV){DMA_V((t)+1,sl_next);} \
    CMASK(C0,C1,t); \
    { float a=MX3(C0[0],C0[1],C1[0]),b=MX3(C0[2],C0[3],C1[1]); a=MX3(a,C1[2],C1[3]); \
      _Pragma("unroll") for(int r=4;r<16;r+=4){a=MX3(a,C0[r],C0[r+1]);b=MX3(b,C0[r+2],C0[r+3]);a=MX3(a,C1[r],C1[r+1]);b=MX3(b,C1[r+2],C1[r+3]);} \
      float rm=__builtin_fmaxf(a,b); { auto rr=__builtin_amdgcn_permlane32_swap(__float_as_uint(rm),__float_as_uint(rm),false,false); rm=__builtin_fmaxf(__uint_as_float(rr[0]),__uint_as_float(rr[1])); } \
      resc=false; \
      if(__builtin_expect(__any(rm>(float)THRL),0)){ const float dl=__builtin_fmaxf(rm,0.f); mhat+=dl; \
        _Pragma("unroll") for(int r=0;r<16;++r){C0[r]-=dl;C1[r]-=dl;} \
        _Pragma("unroll") for(int r=0;r<16;++r)negm[r]=-mhat; asm volatile("":"+v"(negm)); \
        const float f=__builtin_amdgcn_exp2f(-dl); l_reg*=f; if(hi==0)wsf[r32]=f; resc=true; } } \
    SBAR(); \
    GAPB(o[0]=__builtin_amdgcn_mfma_f32_32x32x16_bf16(PAF(0),VFR(0),o[0],0,0,0), C0,0); \
    GAPB(o[1]=__builtin_amdgcn_mfma_f32_32x32x16_bf16(PAF(0),VFR(4),o[1],0,0,0), C0,4); \
    KRD(GL,0); GAPB(o[0]=__builtin_amdgcn_mfma_f32_32x32x16_bf16(PAF(1),VFR(1),o[0],0,0,0), C0,8); \
    KRD(GL,1); GAPB(o[1]=__builtin_amdgcn_mfma_f32_32x32x16_bf16(PAF(1),VFR(5),o[1],0,0,0), C0,12); \
    KRD(GL,2); GAPB(o[0]=__builtin_amdgcn_mfma_f32_32x32x16_bf16(PAF(2),VFR(2),o[0],0,0,0), C1,0); \
    KRD(GL,3); GAPB(o[1]=__builtin_amdgcn_mfma_f32_32x32x16_bf16(PAF(2),VFR(6),o[1],0,0,0), C1,4); \
    GAPB(o[0]=__builtin_amdgcn_mfma_f32_32x32x16_bf16(PAF(3),VFR(3),o[0],0,0,0), C1,8); \
    GAPB(o[1]=__builtin_amdgcn_mfma_f32_32x32x16_bf16(PAF(3),VFR(7),o[1],0,0,0), C1,12); \
    }while(0)
  int t=1;
  #undef CMASK
  #define CMASK(P0,P1,t) do{}while(0)
  for(;t+5<NT;t+=2){
    STEP(pB0,pB1,pA0,pA1,t,true,true,true);     WAIT_BAR(2); RESC(); ROT();
    STEP(pA0,pA1,pB0,pB1,t+1,true,true,true);   WAIT_BAR(2); RESC(); ROT();
  }
  #undef CMASK
  #define CMASK(P0,P1,t) do{}while(0)
  #define ENDW(tt) do{ if((tt)+3<NT){WAIT_BAR(2);} else if((tt)+2<NT){WAIT_BAR(1);} else {WAIT_BAR(0);} }while(0)
  for(;t+1<NT;t+=2){
    STEP(pB0,pB1,pA0,pA1,t,(t+3<NT),(t+1<NT),(t+1<NT));       ENDW(t);   RESC(); ROT();
    STEP(pA0,pA1,pB0,pB1,t+1,(t+4<NT),(t+2<NT),(t+2<NT));     ENDW(t+1); RESC(); ROT();
  }
  STEP(pB0,pB1,pA0,pA1,NT-1,false,false,false); RESC();
  { float sacc=pB0[0]+pB0[1]; _Pragma("unroll") for(int r=2;r<16;++r)sacc+=pB0[r]; _Pragma("unroll") for(int r=0;r<16;++r)sacc+=pB1[r]; l_reg+=sacc;
    pw0=(u32x4){PKW(pB0,0),PKW(pB0,2),PKW(pB0,4),PKW(pB0,6)};pw1=(u32x4){PKW(pB0,8),PKW(pB0,10),PKW(pB0,12),PKW(pB0,14)};pw2=(u32x4){PKW(pB1,0),PKW(pB1,2),PKW(pB1,4),PKW(pB1,6)};pw3=(u32x4){PKW(pB1,8),PKW(pB1,10),PKW(pB1,12),PKW(pB1,14)};
    SBAR(); pv(o,vb0+sl_cur,PAF(0),PAF(1),PAF(2),PAF(3)); }
  #undef PKW
  #undef PAF
  #undef VFR
  #undef PIN
  #undef MX3
  #undef GAPA
  #undef GAPB
  #undef EX
  #undef VRD
  #undef KRD
  #undef STEP
  #undef ENDW
  {auto rr=__builtin_amdgcn_permlane32_swap(__float_as_uint(l_reg),__float_as_uint(l_reg),false,false);l_reg=__uint_as_float(rr[0])+__uint_as_float(rr[1]);}
  if(hi==0)wsf[32+r32]=l_reg;asm volatile("s_waitcnt lgkmcnt(0)":::"memory");
  float rli[16];
  #pragma unroll
  for(int r=0;r<16;++r)rli[r]=__builtin_amdgcn_rcpf(wsf[32+crow(r,hi)]);
  bf16*Ow=Ou+(long)(wid*QBLK)*DM;
  { bf16*stg=(bf16*)(shm+LDS_OST)+wid*2048;
    #pragma unroll
    for(int r=0;r<16;++r){const int orow=crow(r,hi);
      #pragma unroll
      for(int d0=0;d0<2;++d0)stg[orow*64+d0*32+r32]=__float2bfloat16(o[d0][r]*rli[r]);}
    asm volatile("s_waitcnt lgkmcnt(0)":::"memory");
    #pragma unroll
    for(int i=0;i<4;++i){const int row=i*8+(lane>>3),ch=lane&7; const u32x4 v=*(const u32x4*)(stg+row*64+ch*8); ATTN_STORE16(Ow+(long)row*DM+ch*8,v);} }
  asm volatile("s_waitcnt lgkmcnt(0)\n\ts_barrier":::"memory");
  #undef DMA_K
  #undef DMA_V
  #undef CMASK
  #undef START
  #undef RESC
  #undef ROT
}
constexpr int ATTN_LDS_BYTES=LDS_BYTES;
#undef SBAR
#undef WAIT_BAR
}

template <int LF> struct ConvRegs { static constexpr int P = 2 * LF + 8, NFC = 8 * P * 2 / 16, NF = (NFC + NTHR - 1) / NTHR, NW = NB * (LF / 8) / NTHR; u32x4 f[NF]; u32x4 w[NW]; };
template <int LF>
__device__ __forceinline__ void conv_issue(ConvRegs<LF>& R, const bf16_t* FIc, const bf16_t* wsrc, int tid) {
    const u32x4* fs = (const u32x4*)FIc;
#pragma unroll
    for (int k = 0; k < ConvRegs<LF>::NF; ++k) { const int i = tid + k * NTHR; R.f[k] = i < ConvRegs<LF>::NFC ? fs[i] : (u32x4){0u, 0u, 0u, 0u}; }
#pragma unroll
    for (int k = 0; k < ConvRegs<LF>::NW; ++k) { const int i = tid + k * NTHR; const int b = i / (LF / 8), ch = i % (LF / 8); R.w[k] = *(const u32x4*)(wsrc + (size_t)b * LF + ch * 8); }
}
template <int LF>
__device__ __forceinline__ void conv_commit(const ConvRegs<LF>& R, LAS unsigned char* lds, int tid) {
    constexpr int P = 2 * LF + 8, WSTR = LF + 8;
    LAS unsigned char* FIL = lds; LAS unsigned char* WL = lds + ((8 * P * 2 + 255) & ~255);
#pragma unroll
    for (int k = 0; k < ConvRegs<LF>::NF; ++k) { const int i = tid + k * NTHR; if (i < ConvRegs<LF>::NFC) ((LAS u32x4*)FIL)[i] = R.f[k]; }
#pragma unroll
    for (int k = 0; k < ConvRegs<LF>::NW; ++k) { const int i = tid + k * NTHR; const int b = i / (LF / 8), ch = i % (LF / 8); *(LAS u32x4*)(WL + b * (WSTR * 2) + ch * 16) = R.w[k]; }
}
template <int LF>
__device__ __forceinline__ void conv_compute(LAS unsigned char* lds, bf16_t* ydst, int lane, int wv) {
    constexpr int IPW = LF / 256, NBK = LF / 32, P = 2 * LF + 8, WSTR = LF + 8;
    LAS unsigned char* FIL = lds; LAS unsigned char* WL = lds + ((8 * P * 2 + 255) & ~255);
    f32x4 acc[IPW][2]; bf16x8 Bw[IPW];
#pragma unroll
    for (int ii = 0; ii < IPW; ++ii) { acc[ii][0] = (f32x4){0.f, 0.f, 0.f, 0.f}; acc[ii][1] = (f32x4){0.f, 0.f, 0.f, 0.f}; Bw[ii] = (bf16x8){0, 0, 0, 0, 0, 0, 0, 0}; }
    const int rr = lane & 15, q = lane >> 4;
    const int aBase = (rr & 7) * (P * 2) + 2 * (LF - (rr - (rr & 7)) + 8 * q);
    const int bBase = rr * (WSTR * 2) + 16 * q;
#define CONV_STEPS(CHECK) do { _Pragma("unroll") for (int dd = 0; dd < IPW; ++dd) { \
        const int delta = IPW * d + dd; \
        const bf16x8 a0 = *(const LAS bf16x8*)(FIL + aBase - 64 * delta), a1 = *(const LAS bf16x8*)(FIL + aBase - 64 * delta - 32); \
        const int jn = IPW * (wv - d) - dd; \
        if (!(CHECK) || (jn >= 0 && jn < NBK)) Bw[(IPW - dd) % IPW] = *(const LAS bf16x8*)(WL + bBase + 64 * jn); \
        _Pragma("unroll") for (int ii = 0; ii < IPW; ++ii) { const int j = IPW * (wv - d) + ii - dd; \
            if (!(CHECK) || (j >= 0 && j < NBK)) { \
                acc[ii][0] = __builtin_amdgcn_mfma_f32_16x16x32_bf16(a0, Bw[(ii - dd + IPW) % IPW], acc[ii][0], 0, 0, 0); \
                acc[ii][1] = __builtin_amdgcn_mfma_f32_16x16x32_bf16(a1, Bw[(ii - dd + IPW) % IPW], acc[ii][1], 0, 0, 0); } } } } while (0)
    { const int d = wv - 8; CONV_STEPS(true); }
    for (int d = wv - 7; d < wv; ++d) { CONV_STEPS(false); }
    { const int d = wv; CONV_STEPS(true); }
#undef CONV_STEPS
#pragma unroll
    for (int ii = 0; ii < IPW; ++ii)
#pragma unroll
        for (int h = 0; h < 2; ++h) { u32x2 w; w.x = pk2(acc[ii][h][0], acc[ii][h][1]); w.y = pk2(acc[ii][h][2], acc[ii][h][3]);
            *(u32x2*)(ydst + (size_t)rr * LF + 32 * (IPW * wv + ii) + 16 * h + 4 * q) = w; }
}


__device__ __forceinline__ void route_reduce(float (&p)[32], int lane) {
#pragma unroll
    for (int i = 0; i < 16; ++i) { const bool up = (lane & 32) != 0; const float send = up ? p[i] : p[i + 16], keep = up ? p[i + 16] : p[i]; p[i] = keep + __shfl_xor(send, 32); }
#pragma unroll
    for (int i = 0; i < 8; ++i) { const bool up = (lane & 16) != 0; const float send = up ? p[i] : p[i + 8], keep = up ? p[i + 8] : p[i]; p[i] = keep + __shfl_xor(send, 16); }
#pragma unroll
    for (int i = 0; i < 4; ++i) { const bool up = (lane & 8) != 0; const float send = up ? p[i] : p[i + 4], keep = up ? p[i + 4] : p[i]; p[i] = keep + __shfl_xor(send, 8); }
#pragma unroll
    for (int i = 0; i < 2; ++i) { const bool up = (lane & 4) != 0; const float send = up ? p[i] : p[i + 2], keep = up ? p[i + 2] : p[i]; p[i] = keep + __shfl_xor(send, 4); }
    { const bool up = (lane & 2) != 0; const float send = up ? p[0] : p[1], keep = up ? p[1] : p[0]; p[0] = keep + __shfl_xor(send, 2); }
    p[0] += __shfl_xor(p[0], 1);
}
__device__ __forceinline__ void route_top4(float val, int myE, float (&sv)[4], int (&si)[4]) {
    int rank = 0;
#pragma unroll
    for (int e = 0; e < 32; ++e) { const float o = __builtin_bit_cast(float, __builtin_amdgcn_readlane(__builtin_bit_cast(int, val), 2 * e)); rank += (o > val || (o == val && e < myE)) ? 1 : 0; }
#pragma unroll
    for (int k = 0; k < 4; ++k) { const unsigned long long m = __ballot(rank == k); const int src = __builtin_ctzll(m);
        si[k] = src >> 1; sv[k] = __builtin_bit_cast(float, __builtin_amdgcn_readlane(__builtin_bit_cast(int, val), src)); }
}
#define IN(k) (lo <= (k) && (k) < hi)
#define SEAM(k) do { if (IN(k) && IN((k) + 1)) xcd_barrier(bar); } while (0)
#define SEAMK(k, kind) SEAM(k)
#define KLOCALS \
    const float* x_in = args.in[I_X]; const float* c_in = args.in[I_C]; const float* ctx_in = args.in[I_CTX]; const float* cctx_in = args.in[I_CCTX]; \
    float* out = args.out; \
    float* modp = (float*)(ws + WS_MODP); float* modf = (float*)(ws + WS_MOD); \
    float* cosT = (float*)(ws + WS_ROPE); float* sinT = cosT + SEQ * 32; \
    float* a2tab = (float*)(ws + WS_A2); \
    int* top_e = (int*)(ws + WS_PAIR); int* ppos = top_e + NTOK * 4; float* pgate = (float*)(ppos + NTOK * 4); int* pdest = (int*)(pgate + NTOK * 4); \
    bf16_t* XB = (bf16_t*)(ws + WS_XB); \
    bf16_t* Wqkv_t = (bf16_t*)(ws + WS_WQKV); bf16_t* Wo_t = (bf16_t*)(ws + WS_WO); bf16_t* Win_t = (bf16_t*)(ws + WS_WIN); bf16_t* Wout_t = (bf16_t*)(ws + WS_WOUT); \
    bf16_t* Wgu_t = (bf16_t*)(ws + WS_WGU); bf16_t* Wdn_t = (bf16_t*)(ws + WS_WDN); \
    bf16_t* hA = (bf16_t*)(ws + WS_HA); bf16_t* Qb = (bf16_t*)(ws + WS_Q); bf16_t* Kb = (bf16_t*)(ws + WS_K); bf16_t* Vb = (bf16_t*)(ws + WS_V); \
    bf16_t* Upre = (bf16_t*)(ws + WS_UPRE); bf16_t* Wc = (bf16_t*)(ws + WS_WC); bf16_t* Yc = (bf16_t*)(ws + WS_YC); \
    bf16_t* XS = (bf16_t*)(ws + WS_XS); bf16_t* AB = (bf16_t*)(ws + WS_AB); int* elist = (int*)(ws + WS_ELIST); \
    const int wr = wave >> 2, wc = wave & 3, fr = lane & 15, fq = lane >> 4;
template <int layer> __device__ __forceinline__ void layer_body(const Args& args, LAS unsigned char* lds, const XcdBarrier& bar, const int tid, const int lane, const int wave, const int G, const int bid, const int lo, const int hi) {
    const int gw = bid * NWAVES + wave, NGW = G * NWAVES;
    unsigned char* ws = args.ws;
    gu32* ctl = (gu32*)(ws + WS_CTL);
    KLOCALS
        const int pb = 3 + 10 * layer;
        const int jm = layer >> 1;
        const bool ctx_live = layer < 2;
        const int nrows = ctx_live ? NTOK : NLAT;
        const float* mo = modf + (size_t)layer * NMODROW * MODW;

        if ((layer & 1) == 0) {
            if (EN_GEMM && IN(pb + 0)) {
                EpiQKV E{Qb, Kb, Vb, args.in[I_QG] + jm * 64, args.in[I_KG] + jm * 64, cosT, sinT};
                const bf16_t* Wt = Wqkv_t + (size_t)jm * NQKV * D;
                const QkvSched S{hA, Wt, ctx_live ? 1 : 0, G, bid};
                run_gemm(lds, S, E);
            }
            SEAMK(pb + 0, 3);
            if (EN_ATT && IN(pb + 1)) {
                typedef attn_body::bf16 abf;
                const int x = bid & 7, sl = bid >> 3, nS = G >> 3;
                for (int q = sl; q < 256; q += nS) {
                    const int b = 2 * x + (q >> 7), kvh = (q >> 5) & 3, head = 4 * kvh + ((q >> 3) & 3), qb = q & 7;
                    abf* Qu = (abf*)(Qb + ((size_t)b * SEQ + qb * 256) * D + head * 64);
                    attn_body::attn_unit<8>(Qu, (const abf*)(Kb + (size_t)b * KVL * 256 + kvh * 64), (const abf*)(Vb + (size_t)b * KVL * 256 + kvh * 64), Qu, KVL / 64, (char*)lds);
                }
                if (ctx_live) for (int q = sl; q < 32; q += nS) {
                    const int b = 2 * x + (q >> 4), head = q & 15, kvh = head >> 2;
                    abf* Qu = (abf*)(Qb + ((size_t)NLAT + b * CL) * D + head * 64);
                    attn_body::attn_unit<8>(Qu, (const abf*)(Kb + ((size_t)b * KVL + SEQ) * 256 + kvh * 64), (const abf*)(Vb + ((size_t)b * KVL + SEQ) * 256 + kvh * 64), Qu, CL / 64, (char*)lds);
                }
            }
            SEAMK(pb + 1, 4);
            if (EN_GEMM && IN(pb + 2)) {
                EpiResid<layer == 0> E{x_in, ctx_in, XB, mo + 2 * D, nullptr};
                const bf16_t* Wt = Wo_t + (size_t)jm * D * D;
                const DenseSched S{Qb, Wt, nrows / 256, 4, G, bid};
                run_gemm(lds, S, E);
            }
            SEAMK(pb + 2, 5);
        } else {
            const float* cw = args.in[I_HCW] + (size_t)jm * 3 * NHY; const float* cb = args.in[I_HCB] + (size_t)jm * NHY;
            if (EN_GEMM && IN(pb + 0)) {
                EpiBiasBf16 E{Upre, NHY, args.in[I_HBIN] + (size_t)jm * NHY, 0};
                const bf16_t* Wt = Win_t + (size_t)jm * NHY * D;
                const DenseSched S{hA, Wt, nrows / 256, 12, G, bid};
                run_gemm(lds, S, E);
            }
            SEAMK(pb + 0, 6);
            if (EN_MISC && IN(pb + 1)) {
                LAS unsigned char* T = lds;
                const int nlat_u = NB * 16 * 4, nctx_u = ctx_live ? NB * 2 * 4 : 0;
                const int hw = tid >> 5, l32 = tid & 31;
                for (int u = bid; u < nlat_u + nctx_u; u += G) {
                    int b, s0, c0, Ls, rowb; bf16_t* dstb;
                    if (u < nlat_u) { b = u >> 6; s0 = ((u >> 2) & 15) * 128; c0 = (u & 3) * 256; Ls = SEQ; rowb = b * SEQ; dstb = Wc; }
                    else { const int q = u - nlat_u; b = q >> 3; s0 = ((q >> 2) & 1) * 128; c0 = (q & 3) * 256; Ls = CL; rowb = NLAT + b * CL; dstb = Wc + WC_CTX_OFF; }
                    const int cc = c0 + 8 * l32, sb = s0 + 8 * hw;
                    u32x4 ra[10], rv[10];
#pragma unroll
                    for (int i = 0; i < 10; ++i) { const int sp = sb + i - 1;
                        if (sp >= 0 && sp < Ls) { const bf16_t* ur = Upre + (size_t)(rowb + sp) * NHY + cc; ra[i] = *(const u32x4*)(ur + D); rv[i] = *(const u32x4*)(ur + 2 * D); }
                        else { ra[i] = (u32x4){0u, 0u, 0u, 0u}; rv[i] = (u32x4){0u, 0u, 0u, 0u}; } }
                    f32x4 w1[3][2], w2[3][2], b1[2], b2[2];
#pragma unroll
                    for (int tap = 0; tap < 3; ++tap)
#pragma unroll
                        for (int hh = 0; hh < 2; ++hh) { w1[tap][hh] = *(const f32x4*)(cw + tap * NHY + D + cc + 4 * hh); w2[tap][hh] = *(const f32x4*)(cw + tap * NHY + 2 * D + cc + 4 * hh); }
#pragma unroll
                    for (int hh = 0; hh < 2; ++hh) { b1[hh] = *(const f32x4*)(cb + D + cc + 4 * hh); b2[hh] = *(const f32x4*)(cb + 2 * D + cc + 4 * hh); }
                    unsigned op[8][4];
#pragma unroll
                    for (int sp = 0; sp < 4; ++sp) {
                        float pr[2][8];
#pragma unroll
                        for (int o = 0; o < 2; ++o) { const int si = 2 * sp + o;
                            f32x4 x1[2] = {b1[0], b1[1]}, vv[2] = {b2[0], b2[1]};
#pragma unroll
                            for (int tap = 0; tap < 3; ++tap) { const u32x4 a = ra[si + tap], q = rv[si + tap];
                                x1[0] += (f32x4){bflo(a.x), bfhi(a.x), bflo(a.y), bfhi(a.y)} * w1[tap][0]; x1[1] += (f32x4){bflo(a.z), bfhi(a.z), bflo(a.w), bfhi(a.w)} * w1[tap][1];
                                vv[0] += (f32x4){bflo(q.x), bfhi(q.x), bflo(q.y), bfhi(q.y)} * w2[tap][0]; vv[1] += (f32x4){bflo(q.z), bfhi(q.z), bflo(q.w), bfhi(q.w)} * w2[tap][1]; }
                            const f32x4 p0 = x1[0] * vv[0], p1 = x1[1] * vv[1];
                            pr[o][0] = p0[0]; pr[o][1] = p0[1]; pr[o][2] = p0[2]; pr[o][3] = p0[3]; pr[o][4] = p1[0]; pr[o][5] = p1[1]; pr[o][6] = p1[2]; pr[o][7] = p1[3]; }
#pragma unroll
                        for (int c = 0; c < 8; ++c) op[c][sp] = pk2(pr[0][c], pr[1][c]);
                    }
                    __syncthreads();
#pragma unroll
                    for (int c = 0; c < 8; ++c) { const int ch = 8 * l32 + c; *(LAS u32x4*)(T + ch * 256 + ((hw ^ (l32 & 15)) * 16)) = (u32x4){op[c][0], op[c][1], op[c][2], op[c][3]}; }
                    __syncthreads();
#pragma unroll
                    for (int i = 0; i < 8; ++i) { const int c = i * 32 + (tid >> 4), ch = tid & 15;
                        *(u32x4*)(dstb + ((size_t)(c0 + c) * NB + b) * Ls + s0 + ch * 8) = *(const LAS u32x4*)(T + c * 256 + ((ch ^ ((c >> 3) & 15)) * 16)); }
                }
            }
            SEAMK(pb + 1, 7);
            if (EN_CONV && IN(pb + 2)) {
                { const bf16_t* FIb = (const bf16_t*)(ws + (jm == 0 ? WS_FI0 : WS_FI1));
                  ConvRegs<SEQ> R; int c = bid;
                  if (c < 1024) conv_issue<SEQ>(R, FIb + (size_t)c * 8 * FP_L, Wc + (size_t)c * NB * SEQ, tid);
                  for (; c < 1024; c += G) {
                      __syncthreads();
                      conv_commit<SEQ>(R, lds, tid);
                      __syncthreads();
                      if (c + G < 1024) conv_issue<SEQ>(R, FIb + (size_t)(c + G) * 8 * FP_L, Wc + (size_t)(c + G) * NB * SEQ, tid);
                      conv_compute<SEQ>(lds, Yc + (size_t)c * NB * SEQ, lane, wave);
                  } }
                if (ctx_live) for (int c = bid; c < 1024; c += G) {
                    ConvRegs<CL> R; conv_issue<CL>(R, (const bf16_t*)(ws + WS_FI2) + (size_t)c * 8 * FP_C, Wc + WC_CTX_OFF + (size_t)c * NB * CL, tid);
                    __syncthreads(); conv_commit<CL>(R, lds, tid); __syncthreads();
                    conv_compute<CL>(lds, Yc + WC_CTX_OFF + (size_t)c * NB * CL, lane, wave);
                }
            }
            SEAMK(pb + 2, 8);
            if (EN_MISC && IN(pb + 3)) {
                LAS unsigned char* T = lds;
                const int nlat_u = NB * 16 * 4, nctx_u = ctx_live ? NB * 2 * 4 : 0;
                const int hw = tid >> 5, l32 = tid & 31;
                for (int u = bid; u < nlat_u + nctx_u; u += G) {
                    int b, s0, c0, Ls, rowb; const bf16_t* srcb;
                    if (u < nlat_u) { b = u >> 6; s0 = ((u >> 2) & 15) * 128; c0 = (u & 3) * 256; Ls = SEQ; rowb = b * SEQ; srcb = Yc; }
                    else { const int q = u - nlat_u; b = q >> 3; s0 = ((q >> 2) & 1) * 128; c0 = (q & 3) * 256; Ls = CL; rowb = NLAT + b * CL; srcb = Yc + WC_CTX_OFF; }
                    __syncthreads();
#pragma unroll
                    for (int i = 0; i < 8; ++i) { const int c = i * 32 + (tid >> 4), ch = tid & 15;
                        *(LAS u32x4*)(T + c * 256 + ((ch ^ ((c >> 3) & 15)) * 16)) = *(const u32x4*)(srcb + ((size_t)(c0 + c) * NB + b) * Ls + s0 + ch * 8); }
                    const int cc = c0 + 8 * l32, sb = s0 + 8 * hw;
                    u32x4 ra[10];
#pragma unroll
                    for (int i = 0; i < 10; ++i) { const int sp = sb + i - 1;
                        if (sp >= 0 && sp < Ls) ra[i] = *(const u32x4*)(Upre + (size_t)(rowb + sp) * NHY + cc); else ra[i] = (u32x4){0u, 0u, 0u, 0u}; }
                    f32x4 w0[3][2], b0[2];
#pragma unroll
                    for (int tap = 0; tap < 3; ++tap)
#pragma unroll
                        for (int hh = 0; hh < 2; ++hh) w0[tap][hh] = *(const f32x4*)(cw + tap * NHY + cc + 4 * hh);
#pragma unroll
                    for (int hh = 0; hh < 2; ++hh) b0[hh] = *(const f32x4*)(cb + cc + 4 * hh);
                    __syncthreads();
                    u32x4 yv[8];
#pragma unroll
                    for (int c = 0; c < 8; ++c) yv[c] = *(const LAS u32x4*)(T + (8 * l32 + c) * 256 + ((hw ^ (l32 & 15)) * 16));
#pragma unroll
                    for (int si = 0; si < 8; ++si) {
                        f32x4 x0[2] = {b0[0], b0[1]};
#pragma unroll
                        for (int tap = 0; tap < 3; ++tap) { const u32x4 a = ra[si + tap];
                            x0[0] += (f32x4){bflo(a.x), bfhi(a.x), bflo(a.y), bfhi(a.y)} * w0[tap][0]; x0[1] += (f32x4){bflo(a.z), bfhi(a.z), bflo(a.w), bfhi(a.w)} * w0[tap][1]; }
                        float yy[8];
#pragma unroll
                        for (int c = 0; c < 8; ++c) { const unsigned wd = yv[c][si >> 1]; yy[c] = (si & 1) ? bfhi(wd) : bflo(wd); }
                        u32x4 o; o.x = pk2(x0[0][0] * yy[0], x0[0][1] * yy[1]); o.y = pk2(x0[0][2] * yy[2], x0[0][3] * yy[3]); o.z = pk2(x0[1][0] * yy[4], x0[1][1] * yy[5]); o.w = pk2(x0[1][2] * yy[6], x0[1][3] * yy[7]);
                        *(u32x4*)(hA + (size_t)(rowb + sb + si) * D + cc) = o;
                    }
                }
            }
            SEAMK(pb + 3, 9);
            if (EN_GEMM && IN(pb + 4)) {
                EpiResid<layer == 0> E{x_in, ctx_in, XB, mo + 2 * D, args.in[I_HBOUT] + (size_t)jm * D};
                const bf16_t* Wt = Wout_t + (size_t)jm * D * D;
                const DenseSched S{hA, Wt, nrows / 256, 4, G, bid};
                run_gemm(lds, S, E);
            }
            SEAMK(pb + 4, 10);
        }

        gu32* cnt = ctl + CW_CNT + layer * 32 * 64;
        if (EN_ROUTER && IN(pb + 5)) {
            constexpr int WSTR = D + 8, MAXT = 20;
            LAS bf16_t* WT = (LAS bf16_t*)lds;
            LAS float* CB = (LAS float*)(lds + 2 * 32 * WSTR * 2);
            LAS float* CRED = CB + 32;
            LAS int* LCNT = (LAS int*)(CRED + 512);
            LAS int* PREC = LCNT + 64;
            LAS float* RINV = (LAS float*)(PREC + 8 * MAXT * 4);
            __syncthreads();
            if (tid < 64) LCNT[tid] = 0;
            for (int i = tid; i < 8 * MAXT * 4; i += NTHR) PREC[i] = -1;
            const int TPW = (((nrows + NGW - 1) / NGW) + 1) & ~1;
            const int rf = gw * TPW; const int nval = rf >= nrows ? 0 : (nrows - rf < TPW ? nrows - rf : TPW);
            { int curb = -1; f32x4 gs[4], sh[4]; u32x2 wv_[4];
              if (nval > 0) {
#pragma unroll
                  for (int j = 0; j < 4; ++j) wv_[j] = ((const u32x2*)(XB + (size_t)rf * D))[lane + 64 * j]; }
              for (int ti = 0; ti < nval; ++ti) { const int r = rf + ti; f32x4 v[4];
#pragma unroll
                  for (int j = 0; j < 4; ++j) v[j] = (f32x4){bflo(wv_[j].x), bfhi(wv_[j].x), bflo(wv_[j].y), bfhi(wv_[j].y)};
                  if (ti + 1 < nval) {
#pragma unroll
                      for (int j = 0; j < 4; ++j) wv_[j] = ((const u32x2*)(XB + (size_t)(r + 1) * D))[lane + 64 * j]; }
                  const int bq = mod_row(r); if (bq != curb) { const float* mr = mo + (size_t)bq * MODW; load_vec(mr + 4 * D, lane, gs); load_vec(mr + 3 * D, lane, sh); curb = bq; }
                  float ss = 0.f;
#pragma unroll
                  for (int j = 0; j < 4; ++j) ss += (v[j][0] * v[j][0] + v[j][1] * v[j][1]) + (v[j][2] * v[j][2] + v[j][3] * v[j][3]);
                  ss = wave_sum(ss); const float rinv = __builtin_amdgcn_rsqf(ss * (1.0f / D) + EPS);
                  if (lane == 0) RINV[wave * MAXT + ti] = rinv;
#pragma unroll
                  for (int j = 0; j < 4; ++j) { const f32x4 h = (v[j] * rinv) * gs[j] + sh[j]; u32x2 w; w.x = pk2(h[0], h[1]); w.y = pk2(h[2], h[3]); ((u32x2*)(hA + (size_t)r * D))[lane + 64 * j] = w; } } }
            const int rb0 = bid * NWAVES * TPW; const int rb1 = (rb0 + NWAVES * TPW < nrows ? rb0 + NWAVES * TPW : nrows) - 1;
            const int bb0 = rb0 < nrows ? mod_row(rb0) : 1, bb1 = rb0 < nrows ? mod_row(rb1) : 0;
            const float* rw = args.in[I_RW] + (size_t)layer * D * NE; const float* rbias = args.in[I_RB] + layer * NE;
            for (int bq = bb0; bq <= bb1; ++bq) {
                __syncthreads();
                { const float* gsb = mo + (size_t)bq * MODW + 4 * D; const float* shb = mo + (size_t)bq * MODW + 3 * D;
                  const int e = tid & 31; float cpart = 0.f;
#pragma unroll 4
                  for (int jj = 0; jj < 8; ++jj) { const int k0 = 8 * ((tid >> 5) + 16 * jj);
                      const f32x4 g0 = *(const f32x4*)(gsb + k0), g1 = *(const f32x4*)(gsb + k0 + 4), s0 = *(const f32x4*)(shb + k0), s1 = *(const f32x4*)(shb + k0 + 4);
                      float wv[8];
#pragma unroll
                      for (int q = 0; q < 8; ++q) wv[q] = rw[(size_t)(k0 + q) * NE + e];
                      float pv[8]; unsigned hw[4], lw[4];
#pragma unroll
                      for (int q = 0; q < 4; ++q) { pv[q] = g0[q] * wv[q]; pv[4 + q] = g1[q] * wv[4 + q]; cpart += s0[q] * wv[q] + s1[q] * wv[4 + q]; }
#pragma unroll
                      for (int q = 0; q < 4; ++q) { hw[q] = pk2(pv[2 * q], pv[2 * q + 1]); lw[q] = pk2(pv[2 * q] - bflo(hw[q]), pv[2 * q + 1] - bfhi(hw[q])); }
                      *(LAS u32x4*)(WT + (size_t)e * WSTR + k0) = (u32x4){hw[0], hw[1], hw[2], hw[3]};
                      *(LAS u32x4*)(WT + (size_t)(32 + e) * WSTR + k0) = (u32x4){lw[0], lw[1], lw[2], lw[3]}; }
                  CRED[(tid >> 5) * 32 + e] = cpart; }
                __syncthreads();
                if (tid < 32) { float c = rbias[tid];
#pragma unroll
                    for (int q = 0; q < 16; ++q) c += CRED[q * 32 + tid];
                    CB[tid] = c; }
                __syncthreads();
                if (nval > 0 && mod_row(rf) <= bq && bq <= mod_row(rf + nval - 1)) {
                    const int e = lane & 31, kh = lane >> 5; const int trow = rf + (e < nval ? e : nval - 1);
                    const bf16_t* ap = XB + (size_t)trow * D + 8 * kh;
                    const LAS bf16_t* bhp = WT + (size_t)e * WSTR + 8 * kh; const LAS bf16_t* blp = bhp + 32 * WSTR;
                    f32x16 acc;
#pragma unroll
                    for (int q = 0; q < 16; ++q) acc[q] = 0.f;
#pragma unroll 8
                    for (int ks = 0; ks < D / 16; ++ks) { const bf16x8 af = *(const bf16x8*)(ap + 16 * ks);
                        acc = __builtin_amdgcn_mfma_f32_32x32x16_bf16(af, *(const LAS bf16x8*)(bhp + 16 * ks), acc, 0, 0, 0);
                        acc = __builtin_amdgcn_mfma_f32_32x32x16_bf16(af, *(const LAS bf16x8*)(blp + 16 * ks), acc, 0, 0, 0); }
                    const float cbe = CB[e];
                    const int hf = lane >> 5;
#pragma unroll
                    for (int r = 0; r < 10; ++r) { const int tA = (r & 3) + 8 * (r >> 2), tB = tA + 4;
                        const bool okA = tA < nval && mod_row(rf + tA) == bq, okB = tB < nval && mod_row(rf + (tB < MAXT ? tB : 0)) == bq;
                        if (okA || okB) {
                            const int tmine = hf ? (tB < MAXT ? tB : MAXT - 1) : tA;
                            float val = RINV[wave * MAXT + tmine] * acc[r] + cbe;
                            float sv[4]; int si[4];
#pragma unroll
                            for (int k = 0; k < 4; ++k) {
                                int x = __builtin_bit_cast(int, val); float m = val;
                                m = fmaxf(m, __builtin_bit_cast(float, __builtin_amdgcn_update_dpp(x, x, 0xB1, 0xF, 0xF, false))); x = __builtin_bit_cast(int, m);
                                m = fmaxf(m, __builtin_bit_cast(float, __builtin_amdgcn_update_dpp(x, x, 0x4E, 0xF, 0xF, false))); x = __builtin_bit_cast(int, m);
                                m = fmaxf(m, __builtin_bit_cast(float, __builtin_amdgcn_update_dpp(x, x, 0x124, 0xF, 0xF, false))); x = __builtin_bit_cast(int, m);
                                m = fmaxf(m, __builtin_bit_cast(float, __builtin_amdgcn_update_dpp(x, x, 0x128, 0xF, 0xF, false)));
                                m = fmaxf(m, __shfl_xor(m, 16));
                                const unsigned long long mk = __ballot(val == m);
                                const int wlo = __builtin_ctz((unsigned)mk | 0x80000000u), whi = __builtin_ctz((unsigned)(mk >> 32) | 0x80000000u);
                                const int win = hf ? whi : wlo;
                                sv[k] = m; si[k] = win; if ((lane & 31) == win) val = -INFINITY; }
                            if ((lane & 31) < 4 && (hf ? okB : okA)) { const int k = lane & 31; const float e1 = __expf(sv[1] - sv[0]), e2 = __expf(sv[2] - sv[0]), e3 = __expf(sv[3] - sv[0]); const float inv = 1.0f / (1.0f + e1 + e2 + e3);
                                const int ex = k == 0 ? si[0] : (k == 1 ? si[1] : (k == 2 ? si[2] : si[3])); const float gt = (k == 0 ? 1.0f : (k == 1 ? e1 : (k == 2 ? e2 : e3))) * inv;
                                const int tt = hf ? tB : tA; const int rr = rf + tt; const int rk = __hip_atomic_fetch_add(LCNT + ex, 1, __ATOMIC_RELAXED, __HIP_MEMORY_SCOPE_WORKGROUP);
                                top_e[rr * 4 + k] = ex; pgate[rr * 4 + k] = gt; PREC[(wave * MAXT + tt) * 4 + k] = ex | (rk << 8); } } }
                }
            }
            __syncthreads();
            if (tid < 32) LCNT[32 + tid] = (int)__hip_atomic_fetch_add(cnt + tid * 64, (unsigned)LCNT[tid], RLX_AGENT);
            __syncthreads();
            for (int i = tid; i < 8 * MAXT * 4; i += NTHR) { const int rec = PREC[i]; if (rec >= 0) { const int e = rec & 255, rank = rec >> 8, w = i / (MAXT * 4), ti = (i / 4) % MAXT, k = i & 3;
                const int r = (bid * NWAVES + w) * TPW + ti; const int pos = LCNT[32 + e] + rank; ppos[r * 4 + k] = pos; elist[(size_t)e * NTOK + pos] = r; } }
        }
        SEAMK(pb + 5, 11);
        LAS int* PADS = (LAS int*)(lds + LDS_BYTES - 4096);
        LAS unsigned char* TE = (LAS unsigned char*)(PADS + 128);
        if (IN(pb + 7) || IN(pb + 8) || IN(pb + 9)) {
            __syncthreads();
            if (tid < 32) PADS[64 + tid] = (int)__hip_atomic_load(cnt + tid * 64, RLX_AGENT);
            __syncthreads();
            if (tid < 64) {
                const int nt = lane < 32 ? (PADS[64 + lane] + 255) >> 8 : 0; int inc = nt;
#pragma unroll
                for (int o = 1; o < 32; o <<= 1) { const int v = __shfl_up(inc, o); if (lane >= o) inc += v; }
                if (lane < 32) PADS[lane] = (inc - nt) << 8; if (lane == 31) PADS[32] = inc << 8;
            }
            __syncthreads();
            { const int ntile = PADS[32] >> 8; for (int t = tid; t < ntile; t += NTHR) { int e = 0;
#pragma unroll
                  for (int st = 16; st >= 1; st >>= 1) if (PADS[e + st] <= (t << 8)) e += st;
                  TE[t] = (unsigned char)e; } }
            __syncthreads();
        }
        if (EN_GEMM && IN(pb + 7)) {
            const int ntile = PADS[32] >> 8;
            LAS int* ROWS = (LAS int*)(lds + 131072);
            { Unit uu; for (int ui = 0; xcd_unit(ui, G, bid, ntile, 8, uu.pm, uu.pn); ++ui) { if (tid < 256) { const int e = TE[uu.pm]; const int pos = uu.pm * 256 - PADS[e] + tid;
                  ROWS[ui * 256 + tid] = pos < PADS[64 + e] ? elist[(size_t)e * NTOK + pos] : 0; } } }
            __syncthreads();
            const MoeGatherSched S{hA, Wgu_t + (size_t)layer * NE * NGU * D, TE, ROWS, ntile, 8, NGU, G, bid};
            const EpiSwiglu E{AB, args.in[I_BGU] + (size_t)layer * NE * NGU};
            run_gemm_gather(lds, S, E);
        }
        SEAMK(pb + 7, 12);
        if (EN_GEMM && IN(pb + 8)) {
            const int ntile = PADS[32] >> 8;
            const MoeSched S{AB, Wdn_t + (size_t)layer * NE * D * D, TE, ntile, 4, D, G, bid};
            const EpiBiasBf16 E{XS, D, args.in[I_BDN] + (size_t)layer * NE * D, D};
            run_gemm(lds, S, E);
        }
        SEAMK(pb + 8, 13);
        if (EN_MISC && IN(pb + 9)) {
            const bool has_next = layer + 1 < DEPTH;
            const float* mo_n = modf + (size_t)(layer + 1) * NMODROW * MODW; const float* g1n = args.in[I_N1G] + (has_next ? (layer + 1) * D : 0);
            const int nnext = (layer + 1 < 3) ? NTOK : NLAT;
            const int TPW = (nrows + NGW - 1) / NGW;
            int curb = -1; f32x4 gm[4], gsn[4], shn[4];
            for (int ti = 0; ti < TPW; ++ti) {
                const int r = gw * TPW + ti; if (r >= nrows) break;
                bf16_t* xr = XB + (size_t)r * D;
                int dest[4]; float gt[4];
#pragma unroll
                for (int k = 0; k < 4; ++k) { dest[k] = PADS[top_e[r * 4 + k]] + ppos[r * 4 + k]; gt[k] = pgate[r * 4 + k]; }
                u32x2 yw[4][4]; f32x4 v[4], h[4];
#pragma unroll
                for (int k = 0; k < 4; ++k) { const u32x2* yr = (const u32x2*)(XS + (size_t)dest[k] * D);
#pragma unroll
                    for (int j = 0; j < 4; ++j) yw[k][j] = yr[lane + 64 * j]; }
                load_vec_bf(xr, lane, v);
                const int b = mod_row(r);
                if (b != curb) { load_vec(mo + (size_t)b * MODW + 5 * D, lane, gm); if (has_next) { const float* mn = mo_n + (size_t)b * MODW; load_vec(mn + D, lane, gsn); load_vec(mn, lane, shn); } curb = b; }
#pragma unroll
                for (int j = 0; j < 4; ++j) { f32x4 y = (f32x4){0.f, 0.f, 0.f, 0.f};
#pragma unroll
                    for (int k = 0; k < 4; ++k) { const u32x2 w = yw[k][j]; y[0] += gt[k] * bflo(w.x); y[1] += gt[k] * bfhi(w.x); y[2] += gt[k] * bflo(w.y); y[3] += gt[k] * bfhi(w.y); }
                    v[j] = v[j] + gm[j] * y;
                    if (layer == DEPTH - 1) ((f32x4*)(out + (size_t)r * D))[lane + 64 * j] = v[j];
                    else { u32x2 w; w.x = pk2(v[j][0], v[j][1]); w.y = pk2(v[j][2], v[j][3]); ((u32x2*)xr)[lane + 64 * j] = w; } }
                if (has_next && r < nnext) norm_mod_store(v, gsn, shn, hA + (size_t)r * D, lane, h);
            }
        }
        SEAMK(pb + 9, 14);
}

__global__ void __launch_bounds__(NTHR, 2) fwd(Args args) {
    extern __shared__ __attribute__((aligned(16))) unsigned char lds_raw[];
    LAS unsigned char* lds = (LAS unsigned char*)lds_raw;
    const int tid = threadIdx.x, lane = tid & 63, wave = __builtin_amdgcn_readfirstlane(tid >> 6);
    const int G = gridDim.x, bid = blockIdx.x;
    const int gw = bid * NWAVES + wave, NGW = G * NWAVES;
    unsigned char* ws = args.ws;
    gu32* ctl = (gu32*)(ws + WS_CTL);
    volatile LAS unsigned* MISC = (volatile LAS unsigned*)(lds + MISC_OFF);
    if (tid < 64) MISC[tid] = 0u;
    __syncthreads();
    XcdBarrier bar; bar.bar = (unsigned*)ctl + CW_BAR; bar.x = 0; bar.st = MISC + 8;
    const int lo = args.ph_lo, hi = args.ph_hi;
    if (hi - lo > 1) bar = xcd_barrier_post((unsigned*)ctl + CW_BAR, MISC + 8);

    KLOCALS

    if (EN_PRO && IN(0)) {
        {
            LAS float* scr = (LAS float*)(lds + wave * 8448);
            constexpr int IT_QKV = 16 * (NQKV / 32), IT_SQ = 16 * (D / 32), IT_IN = 16 * (NHY / 32), IT_GU = 16 * (NGU / 32);
            constexpr int N0 = 2 * IT_QKV, N1 = N0 + 2 * IT_SQ, N2 = N1 + 2 * IT_IN, N3 = N2 + 2 * IT_SQ, N4 = N3 + 128 * IT_GU, N5 = N4 + 128 * IT_SQ;
            for (int it = gw; it < N5; it += NGW) {
                if (it < N0) { const int mtx = it / IT_QKV, r = it % IT_QKV; transpose_item<1>(args.in[I_WQKV] + (size_t)mtx * D * NQKV, NQKV, Wqkv_t + (size_t)mtx * NQKV * D, scr, r, lane); }
                else if (it < N1) { const int q = it - N0, mtx = q / IT_SQ, r = q % IT_SQ; transpose_item<0>(args.in[I_WO] + (size_t)mtx * D * D, D, Wo_t + (size_t)mtx * D * D, scr, r, lane); }
                else if (it < N2) { const int q = it - N1, mtx = q / IT_IN, r = q % IT_IN; transpose_item<0>(args.in[I_HWIN] + (size_t)mtx * D * NHY, NHY, Win_t + (size_t)mtx * NHY * D, scr, r, lane); }
                else if (it < N3) { const int q = it - N2, mtx = q / IT_SQ, r = q % IT_SQ; transpose_item<0>(args.in[I_HWOUT] + (size_t)mtx * D * D, D, Wout_t + (size_t)mtx * D * D, scr, r, lane); }
                else if (it < N4) { const int q = it - N3, mtx = q / IT_GU, r = q % IT_GU; transpose_item<2>(args.in[I_WGU] + (size_t)mtx * D * NGU, NGU, Wgu_t + (size_t)mtx * NGU * D, scr, r, lane); }
                else { const int q = it - N4, mtx = q / IT_SQ, r = q % IT_SQ; transpose_item<0>(args.in[I_WDN] + (size_t)mtx * D * D, D, Wdn_t + (size_t)mtx * D * D, scr, r, lane); }
            }
        }
        __syncthreads();
        {
            LAS float* S = (LAS float*)lds;
            for (int u = bid; u < 4 * 12 * 8; u += G) {
                const int kc = u & 7, cc = (u >> 3) % 12, layer = u / 96;
                __syncthreads();
                for (int i = tid; i < 128 * 20; i += NTHR) { const int k = i / 20, r = i % 20; float v = 0.f;
                    if (r < NMODROW) { const float cv = r < NB ? c_in[r * D + kc * 128 + k] : cctx_in[kc * 128 + k]; v = cv / (1.0f + __expf(-cv)); }
                    S[i] = v; }
                __syncthreads();
                const int col = cc * 512 + tid;
                const float* wp = args.in[I_WMOD] + ((size_t)layer * D + kc * 128) * MODW + col;
                float acc[20];
#pragma unroll
                for (int r = 0; r < 20; ++r) acc[r] = 0.f;
                for (int k = 0; k < 128; ++k) { const float w = wp[(size_t)k * MODW];
#pragma unroll
                    for (int q = 0; q < 5; ++q) { const f32x4 s = *(const LAS f32x4*)(S + k * 20 + 4 * q);
                        acc[4 * q] += s[0] * w; acc[4 * q + 1] += s[1] * w; acc[4 * q + 2] += s[2] * w; acc[4 * q + 3] += s[3] * w; } }
#pragma unroll
                for (int r = 0; r < NMODROW; ++r) modp[((size_t)(kc * 4 + layer) * NMODROW + r) * MODW + col] = acc[r];
            }
        }
        for (int i = bid * NTHR + tid; i < SEQ * 32; i += G * NTHR) {
            const int t = i >> 5, j = i & 31, fi = j & 15; const int pos = (j >> 4) == 0 ? (t >> 6) : (t & 63);
            const float inv = powf(10000.0f, -(float)fi / 16.0f); const float ang = (float)pos * inv;
            cosT[i] = cosf(ang); sinT[i] = sinf(ang);
        }
        {
            __syncthreads();
            LAS float* Z = (LAS float*)lds;
            LAS float* A1 = Z + 8 * 36;
            for (int u = bid; u < 256 + 256 + 32; u += G) {
                const int combo = u < 256 ? 0 : (u < 512 ? 1 : 2); const int ub = combo == 0 ? u : (combo == 1 ? u - 256 : u - 512);
                const int j = combo == 1 ? 1 : 0, Lf = combo == 2 ? CL : SEQ;
                const int tl = tid >> 6, o = tid & 63, t = ub * 8 + tl;
                __syncthreads();
                if (o < 33) { float z;
                    const float tt = (float)t / (float)(Lf - 1), w = 6.283185307179586f * (float)t / (float)Lf;
                    if (o == 0) z = tt; else { const int b = (o - 1) & 15; const float f = 1e-4f + (float)b * ((15.0f - 1e-4f) / 15.0f); z = o <= 16 ? cosf(f * w) : -sinf(f * w); }
                    Z[tl * 36 + o] = z; }
                __syncthreads();
                const float sf = args.in[I_HSF][j * 64 + o];
                { const float* w1 = args.in[I_HW1] + (size_t)j * 33 * 64; float a = args.in[I_HB1][j * 64 + o];
                  for (int i = 0; i < 33; ++i) a += Z[tl * 36 + i] * w1[i * 64 + o];
                  A1[tl * 64 + o] = sinf(sf * a); }
                __syncthreads();
                { const float* w2 = args.in[I_HW2] + (size_t)j * 64 * 64; float a = args.in[I_HB2][j * 64 + o];
                  for (int i = 0; i < 64; ++i) a += A1[tl * 64 + i] * w2[i * 64 + o];
                  a2tab[((size_t)combo * SEQ + t) * 64 + o] = sinf(sf * a); }
            }
        }
    }
    SEAMK(0, 0);

    if (EN_PRO && IN(1)) {
        for (int i = bid * NTHR + tid; i < DEPTH * NMODROW * MODW; i += G * NTHR) {
            const int layer = i / (NMODROW * MODW), rem = i % (NMODROW * MODW), col = rem % MODW; float s = args.in[I_BMOD][layer * MODW + col];
#pragma unroll
            for (int kc = 0; kc < 8; ++kc) s += modp[(size_t)(kc * 4 + layer) * NMODROW * MODW + rem];
            const int chunk = col >> 10, k = col & (D - 1);
            if (chunk == 1) s = args.in[I_N1G][layer * D + k] * (1.0f + s); else if (chunk == 4) s = args.in[I_N2G][layer * D + k] * (1.0f + s);
            modf[i] = s;
        }
        {
            LAS float* W3 = (LAS float*)lds;
            LAS float* RED = W3 + 512;
            LAS float* NRM = RED + 32;
            LAS float* HF = NRM + 4;
            for (int u = bid; u < 3 * 256; u += G) {
                const int combo = u >> 8, cg = u & 255; const int j = combo == 1 ? 1 : 0, Lf = combo == 2 ? CL : SEQ; const int c0 = cg * 4;
                LAS float* HB = HF + 4 * Lf;
                __syncthreads();
                { const int i = tid >> 3, q = tid & 7; const int col = (q >> 2) * 1024 + c0 + (q & 3);
                  W3[i * 8 + q] = args.in[I_HW3][((size_t)j * 64 + i) * 2048 + col]; }
                __syncthreads();
                float b3v[8], dec[4], asum[4] = {0.f, 0.f, 0.f, 0.f};
#pragma unroll
                for (int q = 0; q < 8; ++q) b3v[q] = args.in[I_HB3][j * 2048 + (q >> 2) * 1024 + c0 + (q & 3)];
#pragma unroll
                for (int ch = 0; ch < 4; ++ch) dec[ch] = 3.0701134573253945f + (float)(c0 + ch) * ((15.350567286626972f - 3.0701134573253945f) / 1023.0f);
                for (int t = tid; t < Lf; t += NTHR) {
                    asm volatile("" ::: "memory");
                    const float* ar = a2tab + ((size_t)combo * SEQ + t) * 64; float d[8];
#pragma unroll
                    for (int q = 0; q < 8; ++q) d[q] = b3v[q];
#pragma unroll
                    for (int i4 = 0; i4 < 16; ++i4) { const f32x4 a = *(const f32x4*)(ar + 4 * i4); asm volatile("" ::: "memory");
#pragma unroll
                        for (int e = 0; e < 4; ++e) { const f32x4 w0 = *(const LAS f32x4*)(W3 + (4 * i4 + e) * 8), w1 = *(const LAS f32x4*)(W3 + (4 * i4 + e) * 8 + 4);
                            d[0] += a[e] * w0[0]; d[1] += a[e] * w0[1]; d[2] += a[e] * w0[2]; d[3] += a[e] * w0[3]; d[4] += a[e] * w1[0]; d[5] += a[e] * w1[1]; d[6] += a[e] * w1[2]; d[7] += a[e] * w1[3]; } }
                    const float tt = (float)t / (float)(Lf - 1);
#pragma unroll
                    for (int ch = 0; ch < 4; ++ch) { const float dk = __expf(-tt * dec[ch]); const float f = d[ch] * dk, bb = d[4 + ch] * dk;
                        HF[ch * Lf + t] = f; HB[ch * Lf + t] = bb; asum[ch] += fabsf(f) + (t >= 1 ? fabsf(bb) : 0.f); }
                }
#pragma unroll
                for (int ch = 0; ch < 4; ++ch) { const float s = wave_sum(asum[ch]); if (lane == 0) RED[wave * 4 + ch] = s; }
                __syncthreads();
                if (tid < 4) { float s = 0.f; for (int w = 0; w < 8; ++w) s += RED[w * 4 + tid]; NRM[tid] = 1.0f / (s + EPS); }
                __syncthreads();
                const int P = 2 * Lf + 8, PC8 = P / 8;
                bf16_t* FI = (bf16_t*)(ws + (combo == 0 ? WS_FI0 : (combo == 1 ? WS_FI1 : WS_FI2)));
                for (int q = tid; q < 4 * 8 * PC8; q += NTHR) {
                    const int ch = q / (8 * PC8), r = q % (8 * PC8), cidx = r / PC8, x0 = (r % PC8) * 8;
                    const float nr = NRM[ch], db = args.in[I_HDB][j * 1024 + c0 + ch]; float v[8];
#pragma unroll
                    for (int e = 0; e < 8; ++e) { const int m = Lf - (x0 + e) + cidx; const int am = m < 0 ? -m : m; float g = 0.f;
                        if (am <= Lf - 1) { g = (m >= 0 ? HF[ch * Lf + am] : HB[ch * Lf + am]) * nr; if (m == 0) g += db; }
                        v[e] = g; }
                    u32x4 o; o.x = pk2(v[0], v[1]); o.y = pk2(v[2], v[3]); o.z = pk2(v[4], v[5]); o.w = pk2(v[6], v[7]);
                    *(u32x4*)(FI + ((size_t)((c0 + ch) * 8 + cidx)) * P + x0) = o;
                }
            }
        }
    }
    SEAMK(1, 1);

    if (IN(2)) {
        const float* mo = modf;
        const int TPW = (NTOK + NGW - 1) / NGW;
        int curb = -1; f32x4 gs[4], sh[4];
        for (int ti = 0; ti < TPW; ++ti) {
            const int r = gw * TPW + ti; if (r >= NTOK) break;
            const float* src = r < NLAT ? x_in + (size_t)r * D : ctx_in + (size_t)(r - NLAT) * D;
            f32x4 v[4], h[4]; load_vec(src, lane, v);
            const int b = mod_row(r); if (b != curb) { const float* mr = mo + (size_t)b * MODW; load_vec(mr + D, lane, gs); load_vec(mr, lane, sh); curb = b; }
            norm_mod_store(v, gs, sh, hA + (size_t)r * D, lane, h);
        }
    }
    SEAMK(2, 2);

    layer_body<0>(args, lds, bar, tid, lane, wave, G, bid, lo, hi);
    layer_body<1>(args, lds, bar, tid, lane, wave, G, bid, lo, hi);
    layer_body<2>(args, lds, bar, tid, lane, wave, G, bid, lo, hi);
    layer_body<3>(args, lds, bar, tid, lane, wave, G, bid, lo, hi);
#undef IN
#undef SEAM
}

extern "C" void kernel_launch(void* const* d_in, const int* in_sizes, int n_in, void* d_out, int out_size, void* d_ws, size_t ws_size, hipStream_t stream) {
    static int grid = 0;
    if (grid == 0) {
        if (n_in != 32 || out_size != NLAT * D || ws_size < WS_END) { fprintf(stderr, "kernel_launch: unexpected problem (n_in %d, out %d, ws %zu)\n", n_in, out_size, ws_size); grid = -1; return; }
        int dev = 0, cus = 0, per_cu = 0;
        if (hipGetDevice(&dev) != hipSuccess || hipDeviceGetAttribute(&cus, hipDeviceAttributeMultiprocessorCount, dev) != hipSuccess) { grid = -1; return; }
        if (hipFuncSetAttribute((const void*)fwd, hipFuncAttributeMaxDynamicSharedMemorySize, LDS_BYTES) != hipSuccess) { fprintf(stderr, "kernel_launch: hipFuncSetAttribute failed\n"); grid = -1; return; }
        if (hipOccupancyMaxActiveBlocksPerMultiprocessor(&per_cu, (const void*)fwd, NTHR, LDS_BYTES) != hipSuccess || per_cu < 1) fprintf(stderr, "kernel_launch: occupancy query says %d\n", per_cu);
        (void)hipGetLastError();
        if (cus < 256) { fprintf(stderr, "kernel_launch: built for the 256-CU MI355X (unit orders, per-wave row counts); found %d CUs; nothing launched\n", cus); grid = -1; return; }
        grid = 256;
    }
    if (grid < 0) return;
    (void)hipMemsetAsync((char*)d_ws + WS_CTL, 0, CTL_ZERO_BYTES, stream);
    Args a{};
    for (int i = 0; i < 32; ++i) a.in[i] = (const float*)d_in[i];
    a.out = (float*)d_out; a.ws = (unsigned char*)d_ws;
    constexpr int NPH = 3 + 10 * DEPTH;
#if MK_ONE_LAUNCH
    a.ph_lo = 0; a.ph_hi = NPH;
    hipLaunchKernelGGL(fwd, dim3(grid), dim3(NTHR), LDS_BYTES, stream, a);
#else
    for (int p = 0; p < NPH; ++p) {
        if (p >= 3) { const int layer = (p - 3) / 10, loc = (p - 3) % 10; if ((layer & 1) == 0 && (loc == 3 || loc == 4)) continue; }
        a.ph_lo = p; a.ph_hi = p + 1;
        hipLaunchKernelGGL(fwd, dim3(grid), dim3(NTHR), LDS_BYTES, stream, a);
    }
#endif
}
```

```cpp
#include <hip/hip_runtime.h>
#include <cstdio>
#include <cstdint>
#include <cmath>
#include <hip/hip_bf16.h>

#ifndef EN_PRO
#define EN_PRO 1
#endif
#ifndef EN_ATT
#define EN_ATT 1
#endif
#ifndef EN_CONV
#define EN_CONV 1
#endif
#ifndef EN_ROUTER
#define EN_ROUTER 1
#endif
#ifndef EN_GEMM
#define EN_GEMM 1
#endif
#ifndef EN_MISC
#define EN_MISC 1
#endif
#ifndef MK_ONE_LAUNCH
#define MK_ONE_LAUNCH 1
#endif

#define GAS __attribute__((address_space(1)))
#define LAS __attribute__((address_space(3)))
typedef unsigned short bf16_t;
typedef short bf16x8 __attribute__((ext_vector_type(8)));
typedef float f32x4 __attribute__((ext_vector_type(4)));
typedef float f32x2 __attribute__((ext_vector_type(2)));
typedef unsigned u32x4 __attribute__((ext_vector_type(4)));
typedef unsigned u32x2 __attribute__((ext_vector_type(2)));
typedef GAS unsigned gu32;
typedef float f32x16 __attribute__((ext_vector_type(16)));

constexpr int D = 1024, NB = 16, SEQ = 2048, CL = 256, KVL = SEQ + CL;
constexpr int NLAT = NB * SEQ, NCTX = NB * CL, NTOK = NLAT + NCTX;
constexpr int NE = 32, TOPK = 4, DEPTH = 4;
constexpr int MODW = 6 * D, NMODROW = NB + 1;
constexpr int NQKV = 1536, NHY = 3072, NGU = 2048;
constexpr float EPS = 1e-6f;
constexpr float C2 = 0.125f * 1.4426950408889634f;
constexpr int NWAVES = 8, NTHR = 512;
constexpr int NPADROWS = 155648;
constexpr int MAXTILES = NPADROWS / 256;

constexpr size_t MiB = 1u << 20;
constexpr size_t WS_CTL = 0, CTL_ZERO_BYTES = 1 * MiB;
constexpr size_t WS_MODP = 2 * MiB;
constexpr size_t WS_MOD = 16 * MiB;
constexpr size_t WS_ROPE = 18 * MiB;
constexpr size_t WS_A2 = 19 * MiB;
constexpr size_t WS_PAIR = 21 * MiB;
constexpr size_t WS_CTX = 24 * MiB;
constexpr size_t WS_FI = 40 * MiB;
constexpr int FP_L = 2 * SEQ + 8, FP_C = 2 * CL + 8;
constexpr size_t FI_L_BYTES = (size_t)1024 * 8 * FP_L * 2, FI_C_BYTES = (size_t)1024 * 8 * FP_C * 2;
constexpr size_t WS_FI0 = WS_FI, WS_FI1 = WS_FI0 + 65 * MiB, WS_FI2 = WS_FI1 + 65 * MiB;
static_assert(FI_L_BYTES <= 65 * MiB && WS_FI2 + FI_C_BYTES <= 180 * MiB, "filter map");
constexpr size_t WS_WQKV = 180 * MiB, WS_WO = 186 * MiB, WS_WIN = 190 * MiB, WS_WOUT = 202 * MiB, WS_WGU = 206 * MiB, WS_WDN = 718 * MiB;
constexpr size_t WS_HA = 974 * MiB;
constexpr size_t WS_Q = 1046 * MiB;
constexpr size_t WS_K = 1118 * MiB, WS_V = 1136 * MiB;
constexpr size_t WS_UPRE = 1154 * MiB;
constexpr size_t WS_WC = 1370 * MiB;
constexpr size_t WS_YC = 1442 * MiB;
constexpr size_t WS_XS = 1514 * MiB;
constexpr size_t WS_AB = 1818 * MiB;
constexpr size_t WS_ELIST = 2122 * MiB;
constexpr size_t WS_XB = 2128 * MiB;
constexpr size_t WS_END = 2200 * MiB;
constexpr size_t WC_CTX_OFF = (size_t)1024 * 16 * 2048;
constexpr int CW_TMO = 0, CW_BAR = 4096, CW_CNT = 16384;

constexpr int LDS_BYTES = 160 * 1024;
constexpr int MISC_OFF = LDS_BYTES - 256;

#define RLX_AGENT __ATOMIC_RELAXED, __HIP_MEMORY_SCOPE_AGENT
#define LDS_WAIT() asm volatile("s_waitcnt lgkmcnt(0)" ::: "memory")
#define VM_WAIT() asm volatile("s_waitcnt vmcnt(0)" ::: "memory")
__device__ __forceinline__ unsigned f2bf(float f) { unsigned u = __builtin_bit_cast(unsigned, f); return (u + 0x7fffu + ((u >> 16) & 1u)) >> 16; }
typedef __bf16 bf16x2_t __attribute__((ext_vector_type(2)));
__device__ __forceinline__ unsigned pk2(float lo, float hi) { const f32x2 v = {lo, hi}; const bf16x2_t b = __builtin_convertvector(v, bf16x2_t); return __builtin_bit_cast(unsigned, b); }
__device__ __forceinline__ float bf2f(unsigned h) { return __builtin_bit_cast(float, h << 16); }
__device__ __forceinline__ float bflo(unsigned w) { return __builtin_bit_cast(float, w << 16); }
__device__ __forceinline__ float bfhi(unsigned w) { return __builtin_bit_cast(float, w & 0xffff0000u); }
__device__ __forceinline__ float wave_sum(float v) {
#pragma unroll
    for (int o = 1; o < 64; o <<= 1) v += __shfl_xor(v, o);
    return v;
}

#define XB_TMO      128
#define XB_XCNT(j)  (256  + 64 * (j))
#define XB_XSUB(j)  (1280 + 64 * (j))
#define XB_XGEN(j)  (2304 + 64 * (j))
#define XB_TOP      3328
#define XB_TOPGEN   3392
#define XCD_BAR_WORDS 3456
#define XB_SPIN_CAP (1u << 22)
__device__ __forceinline__ unsigned xb_ld(unsigned* p)              { return __hip_atomic_load(p, __ATOMIC_RELAXED, __HIP_MEMORY_SCOPE_AGENT); }
__device__ __forceinline__ unsigned xb_add(unsigned* p, unsigned v) { return __hip_atomic_fetch_add(p, v, __ATOMIC_RELAXED, __HIP_MEMORY_SCOPE_AGENT); }
__device__ __forceinline__ unsigned xb_xcc_id() { return (unsigned)__builtin_amdgcn_s_getreg((3 << 11) | 20) & 0xFu; }
#define XB_SPIN(cond, bar) do { unsigned _sp = 0; while (cond) { __builtin_amdgcn_s_sleep(1); \
    if ((++_sp & 255u) == 0u) { if (xb_ld(&(bar)[XB_TMO])) break; if (_sp > XB_SPIN_CAP) { atomicAdd(&(bar)[XB_TMO], 1u); break; } } } } while (0)
struct XcdBarrier { unsigned* bar; unsigned x; volatile LAS unsigned* st; };
__device__ __forceinline__ XcdBarrier xcd_barrier_post(unsigned* bar, volatile LAS unsigned* st) {
    XcdBarrier b; b.bar = bar; b.x = xb_xcc_id(); b.st = st;
    if (threadIdx.x == 0) (void)xb_add(&bar[XB_XCNT(b.x)], 1u);
    return b;
}
__device__ __forceinline__ void xcd_barrier_complete(unsigned* bar, unsigned x, unsigned& nloc, unsigned& nx) {
    const unsigned G = gridDim.x * gridDim.y * gridDim.z;
    unsigned sum, cnt, mine, sp = 0u;
    for (;;) {
        sum = 0u; cnt = 0u; mine = 0u;
#pragma unroll
        for (unsigned j = 0; j < 16; ++j) { const unsigned c = xb_ld(&bar[XB_XCNT(j)]); sum += c; cnt += (c > 0u) ? 1u : 0u; mine = (j == x) ? c : mine; }
        if (sum == G) break;
        __builtin_amdgcn_s_sleep(1);
        if ((++sp & 255u) == 0u) { if (xb_ld(&bar[XB_TMO])) break; if (sp > XB_SPIN_CAP) { atomicAdd(&bar[XB_TMO], 1u); break; } }
    }
    nloc = mine > 0u ? mine : 1u; nx = cnt > 0u ? cnt : 1u;
}
__device__ __forceinline__ void xcd_barrier(const XcdBarrier& b) {
    asm volatile("s_waitcnt vmcnt(0)" ::: "memory");
    __syncthreads();
    if (threadIdx.x == 0) {
        unsigned* bar = b.bar;
        __builtin_amdgcn_s_waitcnt(0);
        unsigned nloc = b.st[0], nx = b.st[1];
        if (nloc == 0u) { xcd_barrier_complete(bar, b.x, nloc, nx); b.st[0] = nloc; b.st[1] = nx; }
        const unsigned old = xb_add(&bar[XB_XSUB(b.x)], 1u);
        const unsigned gen = old / nloc;
        if (old + 1u == (gen + 1u) * nloc) {
            __builtin_amdgcn_fence(__ATOMIC_RELEASE, "agent");
            asm volatile("s_waitcnt vmcnt(0)" ::: "memory");
            const unsigned og = xb_add(&bar[XB_TOP], 1u);
            const unsigned tg = og / nx;
            if (og + 1u == (tg + 1u) * nx) xb_add(&bar[XB_TOPGEN], 1u);
            else XB_SPIN(xb_ld(&bar[XB_TOPGEN]) == tg, bar);
            __builtin_amdgcn_fence(__ATOMIC_ACQUIRE, "agent");
            xb_add(&bar[XB_XGEN(b.x)], 1u);
            asm volatile("s_waitcnt vmcnt(0)" ::: "memory");
        } else {
            XB_SPIN(xb_ld(&bar[XB_XGEN(b.x)]) == gen, bar);
            __builtin_amdgcn_fence(__ATOMIC_ACQUIRE, "agent");
            asm volatile("s_waitcnt vmcnt(0)" ::: "memory");
        }
    }
    __syncthreads();
}

struct Args { const float* in[32]; float* out; unsigned char* ws; int ph_lo, ph_hi; };
struct Ctx {
    LAS unsigned char* lds;
    int tid, lane, wave, G, bid;
    const float* const* in;
};
enum { I_X = 0, I_C, I_CTX, I_CCTX, I_WMOD, I_BMOD, I_N1G, I_N2G, I_WQKV, I_QG, I_KG, I_WO, I_HWIN, I_HBIN, I_HCW, I_HCB, I_HW1, I_HB1, I_HW2, I_HB2, I_HW3, I_HB3,
       I_HSF, I_HDB, I_HWOUT, I_HBOUT, I_RW, I_RB, I_WGU, I_BGU, I_WDN, I_BDN };

__device__ __forceinline__ int mod_row(int r) { return r < NLAT ? (r >> 11) : NB; }

__device__ __forceinline__ void gemm_unit_simple(const bf16_t* At, const bf16_t* Bt, f32x4 (&acc)[2][2][4][2], int wr, int wc, int fr, int fq) {
    constexpr int K = D;
#pragma unroll
    for (int a = 0; a < 2; ++a)
#pragma unroll
        for (int b = 0; b < 2; ++b)
#pragma unroll
            for (int m = 0; m < 4; ++m)
#pragma unroll
                for (int n = 0; n < 2; ++n) acc[a][b][m][n] = (f32x4){0.f, 0.f, 0.f, 0.f};
    const bf16_t* ap = At + (size_t)(wr * 64 + fr) * K + fq * 8;
    const bf16_t* bp = Bt + (size_t)(wc * 32 + fr) * K + fq * 8;
    for (int k0 = 0; k0 < K; k0 += 32) {
        bf16x8 bfr[2][2];
#pragma unroll
        for (int bj = 0; bj < 2; ++bj)
#pragma unroll
            for (int n = 0; n < 2; ++n) bfr[bj][n] = *(const bf16x8*)(bp + (size_t)(bj * 128 + n * 16) * K + k0);
#pragma unroll
        for (int ai = 0; ai < 2; ++ai)
#pragma unroll
            for (int m = 0; m < 4; ++m) {
                const bf16x8 afr = *(const bf16x8*)(ap + (size_t)(ai * 128 + m * 16) * K + k0);
#pragma unroll
                for (int bj = 0; bj < 2; ++bj)
#pragma unroll
                    for (int n = 0; n < 2; ++n) acc[ai][bj][m][n] = __builtin_amdgcn_mfma_f32_16x16x32_bf16(bfr[bj][n], afr, acc[ai][bj][m][n], 0, 0, 0);
            }
    }
}


struct Unit { int pm, pn, e; };
namespace pg8 {
constexpr int BM = 256, BK = 64, HALF = 128, HTB = HALF * BK * 2, STAGE_BYTES = 8 * HTB;
__device__ __forceinline__ int lds_byte(int r, int c) { const int st = (r >> 4) * 2 + (c >> 5), rr = r & 15, cc = c & 31, ob = rr * 64 + cc * 2; return st * 1024 + (ob ^ (((ob >> 9) & 1) << 5)); }
__device__ __forceinline__ void stage_rc(int b, int& R, int& C) { const int st = b / 1024, sb = b % 1024, swz = sb ^ (((sb >> 9) & 1) << 5); R = (st >> 1) * 16 + swz / 64; C = (st & 1) * 32 + (swz % 64) / 2; }
template <class Epi, class Sched, bool GATHER = false>
__device__ __forceinline__ void gemm_phase(LAS unsigned char* lds, const Sched& S, const Epi& E) {
    constexpr int K = D, nt = K / BK;
    const int tid = threadIdx.x, wid = __builtin_amdgcn_readfirstlane(tid >> 6), lane = tid & 63, wr = wid >> 2, wc = wid & 3, fr = lane & 15, fq = lane >> 4;
    unsigned voffA[2];
#pragma unroll
    for (int i = 0; i < 2; ++i) { int R, C; stage_rc(tid * 16 + i * 8192, R, C); voffA[i] = (unsigned)(R * K + C) * 2u; }
    const size_t kstep = (size_t)(BK * 2);
    const size_t hstep = (size_t)HALF * K * 2;
    const unsigned ldsw = (unsigned)wid * 1024u;
    const int aoff = lds_byte(wr * 64 + fr, fq * 8), boff = lds_byte(wc * 32 + fr, fq * 8);
#define PG8_SA(b, h) (((b) * 2 + (h)) * HTB)
#define PG8_SB(b, h) ((4 + (b) * 2 + (h)) * HTB)
#define PG8_STAGE(bufoff, gbase, voff) do { _Pragma("unroll") for (int _i = 0; _i < 2; ++_i) \
        __builtin_amdgcn_global_load_lds((const unsigned*)((const char*)(gbase) + (voff)[_i]), (LAS unsigned*)(lds + (bufoff) + ldsw + _i * 8192), 16, 0, 0); } while (0)
#define PG8_LDA(dst, b, h) do { _Pragma("unroll") for (int m = 0; m < 4; ++m) _Pragma("unroll") for (int k = 0; k < 2; ++k) dst[m][k] = *(const LAS bf16x8*)(lds + PG8_SA(b, h) + aoff + m * 2048 + k * 1024); } while (0)
#define PG8_LDB(dst, b, h) do { _Pragma("unroll") for (int n = 0; n < 2; ++n) _Pragma("unroll") for (int k = 0; k < 2; ++k) dst[n][k] = *(const LAS bf16x8*)(lds + PG8_SB(b, h) + boff + n * 2048 + k * 1024); } while (0)
#define PG8_MMA(ai, bj, At, Bt) do { __builtin_amdgcn_s_setprio(1); _Pragma("unroll") for (int m = 0; m < 4; ++m) _Pragma("unroll") for (int n = 0; n < 2; ++n) _Pragma("unroll") for (int k = 0; k < 2; ++k) \
        acc[ai][bj][m][n] = __builtin_amdgcn_mfma_f32_16x16x32_bf16(Bt[n][k], At[m][k], acc[ai][bj][m][n], 0, 0, 0); __builtin_amdgcn_s_setprio(0); } while (0)
#define PG8_WAIT_V(n) asm volatile("s_waitcnt vmcnt(" #n ")" ::: "memory")
#define PG8_WAIT_L(n) asm volatile("s_waitcnt lgkmcnt(" #n ")" ::: "memory")
#define PG8_BAR __builtin_amdgcn_s_barrier()
#define PG8_SCHED __builtin_amdgcn_sched_barrier(0)
    unsigned vA[2][2], vN[2][2]; unsigned gR[2], gC[2];
    const char* gA = nullptr;
    if constexpr (GATHER) {
        gA = S.a_base();
#pragma unroll
        for (int i = 0; i < 2; ++i) { gR[i] = voffA[i] / (unsigned)(K * 2); gC[i] = voffA[i] % (unsigned)(K * 2); }
        const LAS int* rw = S.rows(0);
#pragma unroll
        for (int h = 0; h < 2; ++h)
#pragma unroll
            for (int i = 0; i < 2; ++i) { vA[h][i] = (unsigned)rw[h * HALF + gR[i]] * (unsigned)(K * 2) + gC[i]; vN[h][i] = vA[h][i]; }
    }
#define PG8_STAGEA(bufoff, P, V, kt, h) do { if constexpr (GATHER) PG8_STAGE(bufoff, gA + (size_t)(kt) * kstep, V[h]); else PG8_STAGE(bufoff, (P) + (size_t)(kt) * kstep + (size_t)(h) * hstep, voffA); } while (0)
    Unit cur, nxt; int ui = 0;
    if (!S.next(0, cur)) return;
    f32x4 acc[2][2][4][2];
#pragma unroll
    for (int a = 0; a < 2; ++a)
#pragma unroll
        for (int b = 0; b < 2; ++b)
#pragma unroll
            for (int m = 0; m < 4; ++m)
#pragma unroll
                for (int n = 0; n < 2; ++n) acc[a][b][m][n] = (f32x4){0.f, 0.f, 0.f, 0.f};
    bf16x8 At[4][2], B0[2][2], B1[2][2];
    const char* cA = nullptr; if constexpr (!GATHER) cA = S.a_ptr(cur);
    const char* cB = S.b_ptr(cur);
    PG8_STAGE(PG8_SB(0, 0), cB, voffA); PG8_STAGE(PG8_SB(0, 1), cB + hstep, voffA); PG8_STAGEA(PG8_SA(0, 0), cA, vA, 0, 0); PG8_STAGEA(PG8_SA(0, 1), cA, vA, 0, 1);
    if (wr == 1) PG8_BAR;
    PG8_WAIT_V(2); PG8_BAR;
    PG8_STAGE(PG8_SB(1, 0), cB + kstep, voffA); PG8_STAGEA(PG8_SA(1, 0), cA, vA, 1, 0); PG8_STAGE(PG8_SB(1, 1), cB + hstep + kstep, voffA);
    PG8_WAIT_V(6); PG8_BAR;
    for (;;) {
        const bool has_next = S.next(ui + 1, nxt);
        const char* nA = cA; if constexpr (!GATHER) { if (has_next) nA = S.a_ptr(nxt); }
        const char* nB = has_next ? S.b_ptr(nxt) : cB;
        if constexpr (GATHER) { if (has_next) { const LAS int* rw = S.rows(ui + 1);
#pragma unroll
            for (int h = 0; h < 2; ++h)
#pragma unroll
                for (int i = 0; i < 2; ++i) vN[h][i] = (unsigned)rw[h * HALF + gR[i]] * (unsigned)(K * 2) + gC[i]; } }
        for (int t = 0; t < nt; t += 2) {
            const bool last = (t == nt - 2);
            const char* b2 = last ? nB : cB + (size_t)(t + 2) * kstep; const char* b3 = b2 + kstep;
            const char* pX = last ? nA : cA; const int kX = last ? 0 : t + 2;
            unsigned vX[2][2];
#pragma unroll
            for (int h = 0; h < 2; ++h)
#pragma unroll
                for (int i = 0; i < 2; ++i) vX[h][i] = last ? vN[h][i] : vA[h][i];
            PG8_LDB(B0, 0, 0); PG8_LDB(B1, 0, 1); PG8_SCHED; PG8_LDA(At, 0, 0); PG8_STAGEA(PG8_SA(1, 1), cA, vA, t + 1, 1);
            PG8_WAIT_V(8); PG8_WAIT_L(0); PG8_BAR; PG8_MMA(0, 0, At, B0); PG8_MMA(0, 1, At, B1); PG8_BAR; PG8_SCHED;
            PG8_LDA(At, 0, 1); PG8_STAGE(PG8_SB(0, 0), b2, voffA); PG8_STAGE(PG8_SB(0, 1), b2 + hstep, voffA); PG8_STAGEA(PG8_SA(0, 0), pX, vX, kX, 0);
            PG8_WAIT_V(8); PG8_WAIT_L(0); PG8_BAR; PG8_MMA(1, 0, At, B0); PG8_MMA(1, 1, At, B1); PG8_BAR; PG8_SCHED;
            PG8_LDB(B0, 1, 0); PG8_LDB(B1, 1, 1); PG8_SCHED; PG8_LDA(At, 1, 0); PG8_STAGEA(PG8_SA(0, 1), pX, vX, kX, 1);
            PG8_WAIT_V(8); PG8_WAIT_L(0); PG8_BAR; PG8_MMA(0, 0, At, B0); PG8_MMA(0, 1, At, B1); PG8_BAR; PG8_SCHED;
            PG8_LDA(At, 1, 1); PG8_STAGE(PG8_SB(1, 0), b3, voffA); PG8_STAGE(PG8_SB(1, 1), b3 + hstep, voffA); PG8_STAGEA(PG8_SA(1, 0), pX, vX, kX + 1, 0);
            PG8_WAIT_V(8); PG8_WAIT_L(0); PG8_BAR; PG8_MMA(1, 0, At, B0); PG8_MMA(1, 1, At, B1); PG8_BAR; PG8_SCHED;
        }
        if (wr == 0) PG8_BAR;
        E(acc, cur, wr, wc, fr, fq);
        if (!has_next) break;
#pragma unroll
        for (int a = 0; a < 2; ++a)
#pragma unroll
            for (int b = 0; b < 2; ++b)
#pragma unroll
                for (int m = 0; m < 4; ++m)
#pragma unroll
                    for (int n = 0; n < 2; ++n) acc[a][b][m][n] = (f32x4){0.f, 0.f, 0.f, 0.f};
        cur = nxt; cA = nA; cB = nB; ++ui;
        if constexpr (GATHER) {
#pragma unroll
            for (int h = 0; h < 2; ++h)
#pragma unroll
                for (int i = 0; i < 2; ++i) vA[h][i] = vN[h][i]; }
        if (wr == 1) PG8_BAR;
    }
    PG8_WAIT_V(0);
    PG8_BAR;
#undef PG8_SA
#undef PG8_SB
#undef PG8_STAGE
#undef PG8_STAGEA
#undef PG8_LDA
#undef PG8_LDB
#undef PG8_MMA
#undef PG8_WAIT_V
#undef PG8_WAIT_L
#undef PG8_BAR
#undef PG8_SCHED
}
}

template <class Epi, class Sched>
__device__ __forceinline__ void gemm_phase_simple(const Sched& S, const Epi& E) {
    const int tid = threadIdx.x, wid = __builtin_amdgcn_readfirstlane(tid >> 6), lane = tid & 63, wr = wid >> 2, wc = wid & 3, fr = lane & 15, fq = lane >> 4;
    Unit u;
    for (int i = 0; S.next(i, u); ++i) { f32x4 acc[2][2][4][2];
        gemm_unit_simple((const bf16_t*)S.a_ptr(u), (const bf16_t*)S.b_ptr(u), acc, wr, wc, fr, fq);
        E(acc, u, wr, wc, fr, fq); }
}
#ifndef FAST_GEMM
#define FAST_GEMM 1
#endif
template <class Epi, class Sched>
__device__ __forceinline__ void run_gemm(LAS unsigned char* lds, const Sched& S, const Epi& E) {
#if FAST_GEMM
    pg8::gemm_phase<Epi, Sched, false>(lds, S, E);
#else
    gemm_phase_simple<Epi, Sched>(S, E);
#endif
}
template <class Epi, class Sched>
__device__ __forceinline__ void run_gemm_gather(LAS unsigned char* lds, const Sched& S, const Epi& E) { pg8::gemm_phase<Epi, Sched, true>(lds, S, E); }
__device__ __forceinline__ bool xcd_unit(int i, int G, int c, int nM, int nN, int& pm, int& pn) {
    const int x = c & 7, s = c >> 3, nS = G >> 3;
    const int r0 = (nM * x) >> 3, r1 = (nM * (x + 1)) >> 3;
    const int q = i * nS + s; if (q >= (r1 - r0) * nN) return false;
    const int rr = q / nN; pm = r0 + rr; pn = q - rr * nN; return true;
}
struct DenseSched {
    const bf16_t* A; const bf16_t* Bt; int nM, nN, G, c;
    __device__ __forceinline__ bool next(int i, Unit& u) const { u.e = 0; return xcd_unit(i, G, c, nM, nN, u.pm, u.pn); }
    __device__ __forceinline__ const char* a_ptr(const Unit& u) const { return (const char*)(A + (size_t)u.pm * 256 * D); }
    __device__ __forceinline__ const char* b_ptr(const Unit& u) const { return (const char*)(Bt + (size_t)u.pn * 256 * D); }
};
struct QkvSched {
    const bf16_t* A; const bf16_t* Bt; int live, G, c;
    __device__ __forceinline__ bool next(int i, Unit& u) const { u.e = 0;
        if (live) return xcd_unit(i, G, c, 144, 6, u.pm, u.pn);
        const int x = c & 7, s = c >> 3, nS = G >> 3; const int nlat = 16 * 6; const int q = i * nS + s;
        if (q < nlat) { const int rr = q / 6; u.pm = 16 * x + rr; u.pn = q - rr * 6; return true; }
        const int q2 = q - nlat; if (q2 >= 4) return false; const int t = x * 4 + q2; u.pm = 128 + (t >> 1); u.pn = 4 + (t & 1); return true; }
    __device__ __forceinline__ const char* a_ptr(const Unit& u) const { return (const char*)(A + (size_t)u.pm * 256 * D); }
    __device__ __forceinline__ const char* b_ptr(const Unit& u) const { return (const char*)(Bt + (size_t)u.pn * 256 * D); }
};
struct MoeSched {
    const bf16_t* A; const bf16_t* Bt  ; const LAS unsigned char* TE; int nM, nN, N, G, c;
    __device__ __forceinline__ bool next(int i, Unit& u) const { if (!xcd_unit(i, G, c, nM, nN, u.pm, u.pn)) return false; u.e = TE[u.pm]; return true; }
    __device__ __forceinline__ const char* a_ptr(const Unit& u) const { return (const char*)(A + (size_t)u.pm * 256 * D); }
    __device__ __forceinline__ const char* b_ptr(const Unit& u) const { return (const char*)(Bt + ((size_t)u.e * N + (size_t)u.pn * 256) * D); }
};
struct WinTSched {
    const bf16_t* Wt  ; const bf16_t* X  ; int nTok, G, c;
    __device__ __forceinline__ bool next(int i, Unit& u) const { u.e = 0; int tok, ch; if (!xcd_unit(i, G, c, nTok, 12, tok, ch)) return false; u.pm = ch; u.pn = tok; return true; }
    __device__ __forceinline__ const char* a_ptr(const Unit& u) const { return (const char*)(Wt + (size_t)u.pm * 256 * D); }
    __device__ __forceinline__ const char* b_ptr(const Unit& u) const { return (const char*)(X + (size_t)u.pn * 256 * D); }
};
struct MoeGatherSched {
    const bf16_t* A; const bf16_t* Bt; const LAS unsigned char* TE; const LAS int* ROWS; int nM, nN, N, G, c;
    __device__ __forceinline__ bool next(int i, Unit& u) const { if (!xcd_unit(i, G, c, nM, nN, u.pm, u.pn)) return false; u.e = TE[u.pm]; return true; }
    __device__ __forceinline__ const char* a_base() const { return (const char*)A; }
    __device__ __forceinline__ const LAS int* rows(int ui) const { return ROWS + ui * 256; }
    __device__ __forceinline__ const char* a_ptr(const Unit& u) const { return (const char*)A; }
    __device__ __forceinline__ const char* b_ptr(const Unit& u) const { return (const char*)(Bt + ((size_t)u.e * N + (size_t)u.pn * 256) * D); }
};

struct EpiQKV {
    bf16_t *Q, *Kb, *Vb; const float *qg, *kg, *cosT, *sinT;
    __device__ __forceinline__ void operator()(const f32x4 (&acc)[2][2][4][2], const Unit& uu, int wr, int wc, int fr, int fq) const {
        const int pm = uu.pm, pn = uu.pn;
        const int kind = pn < 4 ? 0 : (pn == 4 ? 1 : 2);
        const float* gain = kind == 0 ? qg : kg;
        f32x4 gv[2][2];
#pragma unroll
        for (int bj = 0; bj < 2; ++bj)
#pragma unroll
            for (int n = 0; n < 2; ++n) gv[bj][n] = *(const f32x4*)(gain + 32 * bj + 16 * n + 4 * fq);
#pragma unroll
        for (int ai = 0; ai < 2; ++ai)
#pragma unroll
            for (int m = 0; m < 4; ++m) {
                const int r = pm * 256 + ai * 128 + wr * 64 + m * 16 + fr;
                const bool lat = r < NLAT;
                const int b = lat ? (r >> 11) : ((r - NLAT) >> 8);
                const int pos = lat ? (r & (SEQ - 1)) : (SEQ + ((r - NLAT) & (CL - 1)));
                f32x4 v[2][2];
#pragma unroll
                for (int bj = 0; bj < 2; ++bj)
#pragma unroll
                    for (int n = 0; n < 2; ++n) v[bj][n] = acc[ai][bj][m][n];
                if (kind != 2) {
                    float ss = 0.f;
#pragma unroll
                    for (int bj = 0; bj < 2; ++bj)
#pragma unroll
                        for (int n = 0; n < 2; ++n) ss += (v[bj][n][0] * v[bj][n][0] + v[bj][n][1] * v[bj][n][1]) + (v[bj][n][2] * v[bj][n][2] + v[bj][n][3] * v[bj][n][3]);
                    ss += __shfl_xor(ss, 16); ss += __shfl_xor(ss, 32);
                    const float rinv = 1.0f / sqrtf(ss * (1.0f / 64.0f) + EPS);
#pragma unroll
                    for (int bj = 0; bj < 2; ++bj)
#pragma unroll
                        for (int n = 0; n < 2; ++n) v[bj][n] = v[bj][n] * rinv * gv[bj][n];
                    if (lat) {
#pragma unroll
                        for (int bj = 0; bj < 2; ++bj) {
                            const f32x4 cs = *(const f32x4*)(cosT + pos * 32 + bj * 16 + 4 * fq), sn = *(const f32x4*)(sinT + pos * 32 + bj * 16 + 4 * fq);
                            const f32x4 x1 = v[bj][0], x2 = v[bj][1];
                            v[bj][0] = x1 * cs - x2 * sn; v[bj][1] = x2 * cs + x1 * sn;
                        }
                    }
                    if (kind == 0) {
#pragma unroll
                        for (int bj = 0; bj < 2; ++bj)
#pragma unroll
                            for (int n = 0; n < 2; ++n) v[bj][n] = v[bj][n] * C2;
                    }
                }
                bf16_t* dst = kind == 0 ? Q + (size_t)r * D + pn * 256 + wc * 64
                                        : (kind == 1 ? Kb : Vb) + ((size_t)b * KVL + pos) * 256 + wc * 64;
#pragma unroll
                for (int bj = 0; bj < 2; ++bj) { u32x4 w; w.x = pk2(v[bj][0][0], v[bj][0][1]); w.y = pk2(v[bj][0][2], v[bj][0][3]); w.z = pk2(v[bj][1][0], v[bj][1][1]); w.w = pk2(v[bj][1][2], v[bj][1][3]);
                    *(u32x4*)(dst + 32 * bj + 8 * fq) = w; }
            }
    }
};
struct EpiBiasBf16 {
    bf16_t* O; int ldc; const float* bias0; int estride;
    __device__ __forceinline__ void operator()(const f32x4 (&acc)[2][2][4][2], const Unit& uu, int wr, int wc, int fr, int fq) const {
        const int row0 = uu.pm * 256, col0t = uu.pn * 256;
#pragma unroll
        for (int bj = 0; bj < 2; ++bj) {
            const int c = col0t + bj * 128 + wc * 32 + 8 * fq;
            const float* bp = bias0 + (size_t)uu.e * estride + c; const f32x4 b0 = *(const f32x4*)bp, b1 = *(const f32x4*)(bp + 4);
#pragma unroll
            for (int ai = 0; ai < 2; ++ai)
#pragma unroll
                for (int m = 0; m < 4; ++m) { const int r = row0 + ai * 128 + wr * 64 + m * 16 + fr; const f32x4 v0 = acc[ai][bj][m][0] + b0, v1 = acc[ai][bj][m][1] + b1;
                    u32x4 w; w.x = pk2(v0[0], v0[1]); w.y = pk2(v0[2], v0[3]); w.z = pk2(v1[0], v1[1]); w.w = pk2(v1[2], v1[3]); *(u32x4*)(O + (size_t)r * ldc + c) = w; }
        }
    }
};
struct EpiRowBiasBf16 {
    bf16_t* O; int ldc; const float* bias;
    __device__ __forceinline__ void operator()(const f32x4 (&acc)[2][2][4][2], const Unit& uu, int wr, int wc, int fr, int fq) const {
        const int row0 = uu.pm * 256, col0t = uu.pn * 256;
#pragma unroll
        for (int ai = 0; ai < 2; ++ai)
#pragma unroll
            for (int m = 0; m < 4; ++m) { const int r = row0 + ai * 128 + wr * 64 + m * 16 + fr; const float bv = bias[r]; bf16_t* op = O + (size_t)r * ldc + col0t + wc * 32 + 8 * fq;
#pragma unroll
                for (int bj = 0; bj < 2; ++bj) { const f32x4 v0 = acc[ai][bj][m][0] + bv, v1 = acc[ai][bj][m][1] + bv;
                    u32x4 w; w.x = pk2(v0[0], v0[1]); w.y = pk2(v0[2], v0[3]); w.z = pk2(v1[0], v1[1]); w.w = pk2(v1[2], v1[3]); *(u32x4*)(op + bj * 128) = w; } }
    }
};
template <bool SRC32> struct EpiResid {
    const float *srcL, *srcC; bf16_t* XB; const float* gate  ; const float* bias;
    __device__ __forceinline__ void operator()(f32x4 (&acc)[2][2][4][2], const Unit& uu, int wr, int wc, int fr, int fq) const {
        const int row0 = uu.pm * 256, col0t = uu.pn * 256;
        const float* gp0 = gate + (size_t)mod_row(row0) * MODW;
        const float* sb = row0 < NLAT ? srcL + (size_t)row0 * D : srcC + (size_t)(row0 - NLAT) * D;
        bf16_t* xb = XB + (size_t)row0 * D;
#pragma unroll
        for (int bj = 0; bj < 2; ++bj) {
            const int c = col0t + bj * 128 + wc * 32 + 8 * fq;
            const f32x4 g0 = *(const f32x4*)(gp0 + c), g1 = *(const f32x4*)(gp0 + c + 4);
            f32x4 b0 = (f32x4){0.f, 0.f, 0.f, 0.f}, b1 = b0; if (bias) { b0 = *(const f32x4*)(bias + c); b1 = *(const f32x4*)(bias + c + 4); }
#pragma unroll
            for (int ai = 0; ai < 2; ++ai) {
                f32x4 x0[4], x1[4];
#pragma unroll
                for (int m = 0; m < 4; ++m) { const size_t ro = (size_t)(ai * 128 + wr * 64 + m * 16 + fr) * D + c;
                    if constexpr (SRC32) { x0[m] = *(const f32x4*)(sb + ro); x1[m] = *(const f32x4*)(sb + ro + 4); }
                    else { const u32x4 w = *(const u32x4*)(xb + ro); x0[m] = (f32x4){bflo(w.x), bfhi(w.x), bflo(w.y), bfhi(w.y)}; x1[m] = (f32x4){bflo(w.z), bfhi(w.z), bflo(w.w), bfhi(w.w)}; } }
#pragma unroll
                for (int m = 0; m < 4; ++m) { const size_t ro = (size_t)(ai * 128 + wr * 64 + m * 16 + fr) * D + c;
                    const f32x4 y0 = x0[m] + g0 * (acc[ai][bj][m][0] + b0), y1 = x1[m] + g1 * (acc[ai][bj][m][1] + b1);
                    u32x4 w; w.x = pk2(y0[0], y0[1]); w.y = pk2(y0[2], y0[3]); w.z = pk2(y1[0], y1[1]); w.w = pk2(y1[2], y1[3]); *(u32x4*)(xb + ro) = w; }
                asm volatile("" ::: "memory");
            }
        }
    }
};
struct EpiSwiglu {
    bf16_t* O; const float* bgu0  ;
    __device__ __forceinline__ void operator()(const f32x4 (&acc)[2][2][4][2], const Unit& uu, int wr, int wc, int fr, int fq) const {
        const int row0 = uu.pm * 256, pn = uu.pn; const float* bgu = bgu0 + (size_t)uu.e * NGU;
        const int f = pn * 128 + wc * 32 + 8 * fq;
        f32x4 bg[2], bu[2];
#pragma unroll
        for (int n = 0; n < 2; ++n) { const f32x4 q0 = *(const f32x4*)(bgu + 2 * (f + 4 * n)), q1 = *(const f32x4*)(bgu + 2 * (f + 4 * n) + 4);
            bg[n] = (f32x4){q0[0], q0[2], q1[0], q1[2]}; bu[n] = (f32x4){q0[1], q0[3], q1[1], q1[3]}; }
#pragma unroll
        for (int ai = 0; ai < 2; ++ai)
#pragma unroll
            for (int m = 0; m < 4; ++m) { const int r = row0 + ai * 128 + wr * 64 + m * 16 + fr; float o[8];
#pragma unroll
                for (int n = 0; n < 2; ++n) { const f32x4 gg = acc[ai][0][m][n] + bg[n], uq = acc[ai][1][m][n] + bu[n];
#pragma unroll
                    for (int p = 0; p < 2; ++p) {
                        f32x2 g2 = {fminf(gg[2 * p], 7.0f), fminf(gg[2 * p + 1], 7.0f)};
                        f32x2 u2 = {__builtin_amdgcn_fmed3f(uq[2 * p], -7.0f, 7.0f), __builtin_amdgcn_fmed3f(uq[2 * p + 1], -7.0f, 7.0f)};
                        const f32x2 z = g2 * (-2.4554669595930157f);
                        f32x2 e2 = {__builtin_amdgcn_exp2f(z.x), __builtin_amdgcn_exp2f(z.y)};
                        e2 = e2 + 1.0f;
                        const f32x2 r2 = {__builtin_amdgcn_rcpf(e2.x), __builtin_amdgcn_rcpf(e2.y)};
                        const f32x2 o2 = ((u2 + 1.0f) * g2) * r2;
                        o[4 * n + 2 * p] = o2.x; o[4 * n + 2 * p + 1] = o2.y; } }
                u32x4 w; w.x = pk2(o[0], o[1]); w.y = pk2(o[2], o[3]); w.z = pk2(o[4], o[5]); w.w = pk2(o[6], o[7]); *(u32x4*)(O + (size_t)r * D + f) = w; }
    }
};

__device__ __forceinline__ int slot32(int cg) { return (((cg >> 2) & 1) << 4) + ((cg >> 3) << 2) + (cg & 3); }
template <int MODE> __device__ __forceinline__ int wrow_map(int n) {
    if (MODE == 3) return n;
    if (MODE == 0) return (n & ~31) + slot32(n & 31);
    if (MODE == 1) { const int pn = n >> 8, wc = (n >> 6) & 3, bj = (n >> 5) & 1, j = n & 31;
        return (pn << 8) + (bj << 7) + (wc << 5) + (pn < 5 ? j : slot32(j)); }
    { const int f = n >> 1, pn = f >> 7, fo = f & 127; return (pn << 8) + ((n & 1) << 7) + (fo & ~31) + slot32(fo & 31); }
}
template <int MODE> __device__ __forceinline__ void transpose_item(const float* W, int N, bf16_t* WT, LAS float* scr, int item, int lane) {
    constexpr int K = D;
    const int nblk = N / 32, kb = item / nblk, nb = item % nblk, k0 = 64 * kb, n0 = 32 * nb;
#pragma unroll 8
    for (int i = 0; i < 32; ++i) { const int kk = 2 * i + (lane >> 5); scr[kk * 33 + (lane & 31)] = __builtin_nontemporal_load(W + (size_t)(k0 + kk) * N + n0 + (lane & 31)); }
    LDS_WAIT(); asm volatile("" ::: "memory");
    const int c = lane & 7;
#pragma unroll
    for (int j = 0; j < 4; ++j) { const int n = (lane >> 3) + 8 * j; const LAS float* s = scr + (8 * c) * 33 + n;
        u32x4 o; o.x = pk2(s[0 * 33], s[1 * 33]); o.y = pk2(s[2 * 33], s[3 * 33]); o.z = pk2(s[4 * 33], s[5 * 33]); o.w = pk2(s[6 * 33], s[7 * 33]);
        __builtin_nontemporal_store(o, (u32x4*)(WT + (size_t)wrow_map<MODE>(n0 + n) * K + k0 + 8 * c)); }
    LDS_WAIT(); asm volatile("" ::: "memory");
}

__device__ __forceinline__ void norm_mod_store(const f32x4 (&v)[4], const f32x4 (&gs)[4], const f32x4 (&sh)[4], bf16_t* dst, int lane, f32x4 (&h)[4]) {
    float ss = 0.f;
#pragma unroll
    for (int j = 0; j < 4; ++j) ss += (v[j][0] * v[j][0] + v[j][1] * v[j][1]) + (v[j][2] * v[j][2] + v[j][3] * v[j][3]);
    ss = wave_sum(ss);
    const float rinv = __builtin_amdgcn_rsqf(ss * (1.0f / D) + EPS);
#pragma unroll
    for (int j = 0; j < 4; ++j) {
        h[j] = (v[j] * rinv) * gs[j] + sh[j];
        u32x2 w; w.x = pk2(h[j][0], h[j][1]); w.y = pk2(h[j][2], h[j][3]);
        ((u32x2*)dst)[lane + 64 * j] = w;
    }
}
__device__ __forceinline__ void load_vec_bf(const bf16_t* p, int lane, f32x4 (&v)[4]) {
#pragma unroll
    for (int j = 0; j < 4; ++j) { const u32x2 w = ((const u32x2*)p)[lane + 64 * j]; v[j] = (f32x4){bflo(w.x), bfhi(w.x), bflo(w.y), bfhi(w.y)}; }
}
__device__ __forceinline__ void load_vec(const float* p, int lane, f32x4 (&v)[4]) {
#pragma unroll
    for (int j = 0; j < 4; ++j) v[j] = ((const f32x4*)p)[lane + 64 * j];
}


namespace attn_body {
using bf16=__hip_bfloat16;
using bf16x8=__attribute__((ext_vector_type(8)))short;
using s16x4=__attribute__((ext_vector_type(4)))short;
using f32x16=__attribute__((ext_vector_type(16)))float;
using u32x4=__attribute__((ext_vector_type(4)))unsigned;
constexpr int D=64,DM=1024,KVP=256;
constexpr int NW=8,QBLK=32,QB=QBLK*NW,KVBLK=64;
__device__ __forceinline__ int crow(int r,int hi){return (r&3)+8*(r>>2)+4*hi;}
#define SBAR() __builtin_amdgcn_sched_barrier(0)
__device__ __forceinline__ void cmask(f32x16&p0,f32x16&p1,int jb,int qrel,int hi){
  const float NEG=-INFINITY; int kb=64*jb+4*hi;
  #pragma unroll
  for(int r=0;r<16;++r){int kv=kb+(r&3)+8*(r>>2); if(kv>qrel)p0[r]=NEG; if(kv+32>qrel)p1[r]=NEG;}
}

constexpr int NSLOT=3, SLOTB=8192;
constexpr int LDS_K=0, LDS_V=NSLOT*SLOTB, LDS_WS=2*NSLOT*SLOTB, LDS_OST=LDS_WS+NW*64*4, LDS_BYTES=LDS_OST+NW*4096;
constexpr float C2=0.125f*1.4426950408889634f;
__device__ __forceinline__ void glds16(const void*gsrc,unsigned lds_dst){unsigned keep;
  asm volatile("s_mov_b32 %0, m0\n\ts_mov_b32 m0, %2\n\ts_nop 0\n\tglobal_load_lds_dwordx4 %1, off\n\ts_mov_b32 m0, %0":"=&s"(keep):"v"(gsrc),"s"(lds_dst):"memory");}
__device__ __forceinline__ float max3f(float a,float b,float c){float r;asm("v_max3_f32 %0, %1, %2, %3":"=v"(r):"v"(a),"v"(b),"v"(c));return r;}
__device__ __forceinline__ float max2f(float a,float b){float r;asm("v_max_f32_e32 %0, %1, %2":"=v"(r):"v"(a),"v"(b));return r;}
__device__ __forceinline__ float fadd_s(float a,float b){float r;asm("v_add_f32_e32 %0, %1, %2":"=v"(r):"v"(a),"v"(b));return r;}
__device__ __forceinline__ float fsub_s(float a,float b){float r;asm("v_sub_f32_e32 %0, %1, %2":"=v"(r):"v"(a),"v"(b));return r;}
typedef float f32x2_t __attribute__((ext_vector_type(2))); typedef __bf16 bf16x2_t __attribute__((ext_vector_type(2)));
__device__ __forceinline__ unsigned cvtpk_s(float lo,float hi){f32x2_t v={lo,hi};bf16x2_t b=__builtin_convertvector(v,bf16x2_t);return __builtin_bit_cast(unsigned,b);}
#define WAIT_BAR(N) asm volatile("s_waitcnt vmcnt(" #N ") lgkmcnt(0)\n\ts_barrier":::"memory")

__device__ __forceinline__ void qkt(f32x16&p0,f32x16&p1,const char*Kslot,const bf16x8*qr,const f32x16&negm,int r32,int hi){
  const char*kb=Kslot+hi*1024+r32*16;
  #pragma unroll
  for(int d0=0;d0<4;++d0){
    const bf16x8 b0=*reinterpret_cast<const bf16x8*>(kb+d0*2048);
    const bf16x8 b1=*reinterpret_cast<const bf16x8*>(kb+d0*2048+512);
    if(d0==0){p0=__builtin_amdgcn_mfma_f32_32x32x16_bf16(b0,qr[0],negm,0,0,0);p1=__builtin_amdgcn_mfma_f32_32x32x16_bf16(b1,qr[0],negm,0,0,0);}
    else{p0=__builtin_amdgcn_mfma_f32_32x32x16_bf16(b0,qr[d0],p0,0,0,0);p1=__builtin_amdgcn_mfma_f32_32x32x16_bf16(b1,qr[d0],p1,0,0,0);}}
}
typedef __attribute__((address_space(3))) const char* lds_cptr;
typedef short v4i16_t __attribute__((ext_vector_type(4)));
__device__ __forceinline__ void kload8(bf16x8*kf,lds_cptr kp){
  kf[0]=*(const __attribute__((address_space(3))) bf16x8*)(kp);      kf[1]=*(const __attribute__((address_space(3))) bf16x8*)(kp+512);
  kf[2]=*(const __attribute__((address_space(3))) bf16x8*)(kp+2048); kf[3]=*(const __attribute__((address_space(3))) bf16x8*)(kp+2560);
  kf[4]=*(const __attribute__((address_space(3))) bf16x8*)(kp+4096); kf[5]=*(const __attribute__((address_space(3))) bf16x8*)(kp+4608);
  kf[6]=*(const __attribute__((address_space(3))) bf16x8*)(kp+6144); kf[7]=*(const __attribute__((address_space(3))) bf16x8*)(kp+6656);
}
__device__ __forceinline__ void kload2(bf16x8*kf,lds_cptr kp,int j){ kf[2*j]=*(const __attribute__((address_space(3))) bf16x8*)(kp+j*2048); kf[2*j+1]=*(const __attribute__((address_space(3))) bf16x8*)(kp+j*2048+512); }
__device__ __forceinline__ s16x4 vtr(lds_cptr p){ return __builtin_bit_cast(s16x4,__builtin_amdgcn_ds_read_tr16_b64_v4i16((__attribute__((address_space(3))) v4i16_t*)p)); }
__device__ __forceinline__ float rowmax(const f32x16&p0,const f32x16&p1){
  float a=max3f(p0[0],p0[1],p1[0]),b=max3f(p0[2],p0[3],p1[1]);a=max3f(a,p1[2],p1[3]);
  #pragma unroll
  for(int r=4;r<16;r+=4){a=max3f(a,p0[r],p0[r+1]);b=max3f(b,p0[r+2],p0[r+3]);a=max3f(a,p1[r],p1[r+1]);b=max3f(b,p1[r+2],p1[r+3]);}
  const float m=max2f(a,b);
  auto rr=__builtin_amdgcn_permlane32_swap(__float_as_uint(m),__float_as_uint(m),false,false);
  return max2f(__uint_as_float(rr[0]),__uint_as_float(rr[1]));
}
__device__ __forceinline__ void pv(f32x16*o,int vb,bf16x8 pa0,bf16x8 pa1,bf16x8 pa2,bf16x8 pa3){
  #pragma unroll
  for(int d0=0;d0<2;++d0){s16x4 lo[4],hi[4];
    #pragma unroll
    for(int ks=0;ks<4;++ks){
      asm volatile("ds_read_b64_tr_b16 %0,%1 offset:%c2":"=&v"(lo[ks]):"v"(vb),"i"(d0*4096+ks*1024):"memory");
      asm volatile("ds_read_b64_tr_b16 %0,%1 offset:%c2":"=&v"(hi[ks]):"v"(vb),"i"(d0*4096+ks*1024+512):"memory");}
    asm volatile("s_waitcnt lgkmcnt(0)":::"memory");SBAR();
    #define PK(k) (bf16x8){lo[k][0],lo[k][1],lo[k][2],lo[k][3],hi[k][0],hi[k][1],hi[k][2],hi[k][3]}
    o[d0]=__builtin_amdgcn_mfma_f32_32x32x16_bf16(pa0,PK(0),o[d0],0,0,0);
    o[d0]=__builtin_amdgcn_mfma_f32_32x32x16_bf16(pa1,PK(1),o[d0],0,0,0);
    o[d0]=__builtin_amdgcn_mfma_f32_32x32x16_bf16(pa2,PK(2),o[d0],0,0,0);
    o[d0]=__builtin_amdgcn_mfma_f32_32x32x16_bf16(pa3,PK(3),o[d0],0,0,0);
    #undef PK
  }
}

#ifndef ATTN_STORE16
#define ATTN_STORE16(p,v) (*(u32x4*)(p)=(v))
#endif
template<int THRL> __device__ __forceinline__ void attn_unit(const bf16*Qu,const bf16*__restrict__ Kh,const bf16*__restrict__ Vh,bf16*Ou,const int NT,char*shm){
  const int tid=threadIdx.x,lane=tid&63,r32=lane&31,hi=lane>>5; const int wid=__builtin_amdgcn_readfirstlane(tid>>6);
  const bf16*Qw=Qu+(long)(wid*QBLK)*DM;
  const unsigned lds0=(unsigned)(uintptr_t)shm;
  float*wsf=(float*)(shm+LDS_WS)+wid*64;
  const bf16*ksrc=Kh+(long)lane*KVP+wid*8;
  const bf16*vsrc=Vh+(long)(16*(wid&3)+(lane>>2))*KVP+(wid>>2)*32+(lane&3)*8;
  const unsigned kdst=lds0+LDS_K+wid*1024, vdst=lds0+LDS_V+wid*1024;
  #define DMA_K(t,slot) glds16(ksrc+(long)(t)*KVBLK*KVP,(unsigned)__builtin_amdgcn_readfirstlane(kdst+(slot)))
  #define DMA_V(t,slot) glds16(vsrc+(long)(t)*KVBLK*KVP,(unsigned)__builtin_amdgcn_readfirstlane(vdst+(slot)))
  const int vb0=(int)(lds0+LDS_V)+((lane>>4)&1)*32+(lane&3)*8+(4*hi+((lane&15)>>2))*64;
  const char*Kbase=shm+LDS_K; bf16x8 kf[8];
  const lds_cptr shm3=(lds_cptr)shm; const lds_cptr kp0=shm3+LDS_K+hi*1024+r32*16; const lds_cptr vp0=shm3+LDS_V+((lane>>4)&1)*32+(lane&3)*8+(4*hi+((lane&15)>>2))*64;
  DMA_K(0,0);DMA_V(0,0);DMA_K(1,SLOTB);
  bf16x8 qr[4];
  #pragma unroll
  for(int d0=0;d0<4;++d0)qr[d0]=*reinterpret_cast<const bf16x8*>(&Qw[(long)r32*DM+d0*16+hi*8]);
  float mhat=0.f,l_reg=0.f;f32x16 o[2];o[0]=f32x16{};o[1]=f32x16{};f32x16 negm=f32x16{};asm volatile("":"+v"(negm));
  #define CMASK(P0,P1,t) do{}while(0)
  bool resc=false;
  #define START(P0,P1) do{ const float rm=rowmax(P0,P1); resc=false; \
    { const float dl=rm; mhat=fadd_s(mhat,dl); \
      _Pragma("unroll") for(int r=0;r<16;++r){P0[r]=fsub_s(P0[r],dl);P1[r]=fsub_s(P1[r],dl);} \
      _Pragma("unroll") for(int r=0;r<16;++r)negm[r]=-mhat; asm volatile("":"+v"(negm)); } \
    _Pragma("unroll") for(int r=0;r<16;++r)P0[r]=__builtin_amdgcn_exp2f(P0[r]); }while(0)
  #define RESC() do{ if(resc){ asm volatile("s_waitcnt lgkmcnt(0)":::"memory"); \
      _Pragma("unroll") for(int d_=0;d_<2;++d_) _Pragma("unroll") for(int r=0;r<16;++r)o[d_][r]*=wsf[crow(r,hi)]; } }while(0)
  f32x16 pA0,pA1,pB0,pB1;
  int sl_prev=0,sl_cur=0,sl_next=SLOTB;
  #define ROT() do{sl_prev=sl_cur;sl_cur=sl_next;sl_next=(sl_next==(NSLOT-1)*SLOTB)?0:sl_next+SLOTB;}while(0)
  DMA_K(2,2*SLOTB);
  WAIT_BAR(3);
  qkt(pA0,pA1,Kbase,qr,negm,r32,hi);asm volatile("s_nop 15\n\ts_nop 7":"+v"(pA0),"+v"(pA1));CMASK(pA0,pA1,0);
  START(pA0,pA1);
  _Pragma("unroll") for(int r=0;r<16;++r)pA1[r]=__builtin_amdgcn_exp2f(pA1[r]);
  WAIT_BAR(0);
  DMA_K(3,0);DMA_V(1,SLOTB);
  ROT();
  kload8(kf,kp0+sl_cur);
  WAIT_BAR(2);
  s16x4 vlo[8],vhi[8]; u32x4 pw0,pw1,pw2,pw3;
  #define PKW(P,B) cvtpk_s(P[B],P[B+1])
  #define PAF(k) __builtin_bit_cast(bf16x8,pw##k)
  #define VFR(i) (bf16x8){vlo[i][0],vlo[i][1],vlo[i][2],vlo[i][3],vhi[i][0],vhi[i][1],vhi[i][2],vhi[i][3]}
  #define PIN(x) asm volatile("":"+v"(x))
  #define MX3(a,b,c) __builtin_fmaxf(__builtin_fmaxf((a),(b)),(c))
  #define GAPA(MF,A0,A1,A2,A3,W0,W1,PW) do{ MF; sacc+=A0; sacc+=A1; sacc+=A2; sacc+=A3; PIN(sacc); W0; W1; PIN(PW); SBAR(); }while(0)
  #define EX(v) __builtin_amdgcn_exp2f(v)
  #define GAPB(MF,X,B) do{ MF; X[B]=EX(X[B]); X[B+1]=EX(X[B+1]); X[B+2]=EX(X[B+2]); X[B+3]=EX(X[B+3]); PIN(X); SBAR(); }while(0)
  #define VRD(i) do{ vlo[i]=vtr(vp_+(((i)>>2)*4096+((i)&3)*1024)); vhi[i]=vtr(vp_+(((i)>>2)*4096+((i)&3)*1024+512)); }while(0)
  #define KRD(G,j) do{ if(G){ kload2(kf,kp0+sl_next,j); SBAR(); } }while(0)
  #define STEP(C0,C1,P0,P1,t,GK,GV,GL) do{ SBAR(); \
    const lds_cptr vp_=vp0+sl_prev; \
    VRD(0); SBAR(); float sacc=(P0[0]+P0[1]); \
    GAPA(C0=__builtin_amdgcn_mfma_f32_32x32x16_bf16(kf[0],qr[0],negm,0,0,0), P0[2],P0[3],P0[4],P0[5],     pw0[0]=PKW(P0,0), pw0[1]=PKW(P0,2), pw0); \
    VRD(4); SBAR(); GAPA(C1=__builtin_amdgcn_mfma_f32_32x32x16_bf16(kf[1],qr[0],negm,0,0,0), P0[6],P0[7],P0[8],P0[9],     pw0[2]=PKW(P0,4), pw0[3]=PKW(P0,6), pw0); \
    VRD(1); SBAR(); GAPA(C0=__builtin_amdgcn_mfma_f32_32x32x16_bf16(kf[2],qr[1],C0,0,0,0),   P0[10],P0[11],P0[12],P0[13], pw1[0]=PKW(P0,8), pw1[1]=PKW(P0,10), pw1); \
    VRD(5); SBAR(); GAPA(C1=__builtin_amdgcn_mfma_f32_32x32x16_bf16(kf[3],qr[1],C1,0,0,0),   P0[14],P0[15],P1[0],P1[1],   pw1[2]=PKW(P0,12),pw1[3]=PKW(P0,14), pw1); \
    VRD(2); SBAR(); GAPA(C0=__builtin_amdgcn_mfma_f32_32x32x16_bf16(kf[4],qr[2],C0,0,0,0),   P1[2],P1[3],P1[4],P1[5],     pw2[0]=PKW(P1,0), pw2[1]=PKW(P1,2), pw2); \
    VRD(6); SBAR(); GAPA(C1=__builtin_amdgcn_mfma_f32_32x32x16_bf16(kf[5],qr[2],C1,0,0,0),   P1[6],P1[7],P1[8],P1[9],     pw2[2]=PKW(P1,4), pw2[3]=PKW(P1,6), pw2); \
    VRD(3); SBAR(); GAPA(C0=__builtin_amdgcn_mfma_f32_32x32x16_bf16(kf[6],qr[3],C0,0,0,0),   P1[10],P1[11],P1[12],P1[13], pw3[0]=PKW(P1,8), pw3[1]=PKW(P1,10), pw3); \
    VRD(7); SBAR(); GAPA(C1=__builtin_amdgcn_mfma_f32_32x32x16_bf16(kf[7],qr[3],C1,0,0,0),   P1[14],P1[15],0.f,0.f,       pw3[2]=PKW(P1,12),pw3[3]=PKW(P1,14), pw3); \
    l_reg+=sacc; \
    if(GK){DMA_K((t)+3,sl_cur);} if(GV){DMA_V((t)+1,sl_next);} \
    CMASK(C0,C1,t); \
    { float a=MX3(C0[0],C0[1],C1[0]),b=MX3(C0[2],C0[3],C1[1]); a=MX3(a,C1[2],C1[3]); \
      _Pragma("unroll") for(int r=4;r<16;r+=4){a=MX3(a,C0[r],C0[r+1]);b=MX3(b,C0[r+2],C0[r+3]);a=MX3(a,C1[r],C1[r+1]);b=MX3(b,C1[r+2],C1[r+3]);} \
      float rm=__builtin_fmaxf(a,b); { auto rr=__builtin_amdgcn_permlane32_swap(__float_as_uint(rm),__float_as_uint(rm),false,false); rm=__builtin_fmaxf(__uint_as_float(rr[0]),__uint_as_float(rr[1])); } \
      resc=false; \
      if(__builtin_expect(__any(rm>(float)THRL),0)){ const float dl=__builtin_fmaxf(rm,0.f); mhat+=dl; \
        _Pragma("unroll") for(int r=0;r<16;++r){C0[r]-=dl;C1[r]-=dl;} \
        _Pragma("unroll") for(int r=0;r<16;++r)negm[r]=-mhat; asm volatile("":"+v"(negm)); \
        const float f=__builtin_amdgcn_exp2f(-dl); l_reg*=f; if(hi==0)wsf[r32]=f; resc=true; } } \
    SBAR(); \
    GAPB(o[0]=__builtin_amdgcn_mfma_f32_32x32x16_bf16(PAF(0),VFR(0),o[0],0,0,0), C0,0); \
    GAPB(o[1]=__builtin_amdgcn_mfma_f32_32x32x16_bf16(PAF(0),VFR(4),o[1],0,0,0), C0,4); \
    KRD(GL,0); GAPB(o[0]=__builtin_amdgcn_mfma_f32_32x32x16_bf16(PAF(1),VFR(1),o[0],0,0,0), C0,8); \
    KRD(GL,1); GAPB(o[1]=__builtin_amdgcn_mfma_f32_32x32x16_bf16(PAF(1),VFR(5),o[1],0,0,0), C0,12); \
    KRD(GL,2); GAPB(o[0]=__builtin_amdgcn_mfma_f32_32x32x16_bf16(PAF(2),VFR(2),o[0],0,0,0), C1,0); \
    KRD(GL,3); GAPB(o[1]=__builtin_amdgcn_mfma_f32_32x32x16_bf16(PAF(2),VFR(6),o[1],0,0,0), C1,4); \
    GAPB(o[0]=__builtin_amdgcn_mfma_f32_32x32x16_bf16(PAF(3),VFR(3),o[0],0,0,0), C1,8); \
    GAPB(o[1]=__builtin_amdgcn_mfma_f32_32x32x16_bf16(PAF(3),VFR(7),o[1],0,0,0), C1,12); \
    }while(0)
  int t=1;
  #undef CMASK
  #define CMASK(P0,P1,t) do{}while(0)
  for(;t+5<NT;t+=2){
    STEP(pB0,pB1,pA0,pA1,t,true,true,true);     WAIT_BAR(2); RESC(); ROT();
    STEP(pA0,pA1,pB0,pB1,t+1,true,true,true);   WAIT_BAR(2); RESC(); ROT();
  }
  #undef CMASK
  #define CMASK(P0,P1,t) do{}while(0)
  #define ENDW(tt) do{ if((tt)+3<NT){WAIT_BAR(2);} else if((tt)+2<NT){WAIT_BAR(1);} else {WAIT_BAR(0);} }while(0)
  for(;t+1<NT;t+=2){
    STEP(pB0,pB1,pA0,pA1,t,(t+3<NT),(t+1<NT),(t+1<NT));       ENDW(t);   RESC(); ROT();
    STEP(pA0,pA1,pB0,pB1,t+1,(t+4<NT),(t+2<NT),(t+2<NT));     ENDW(t+1); RESC(); ROT();
  }
  STEP(pB0,pB1,pA0,pA1,NT-1,false,false,false); RESC();
  { float sacc=pB0[0]+pB0[1]; _Pragma("unroll") for(int r=2;r<16;++r)sacc+=pB0[r]; _Pragma("unroll") for(int r=0;r<16;++r)sacc+=pB1[r]; l_reg+=sacc;
    pw0=(u32x4){PKW(pB0,0),PKW(pB0,2),PKW(pB0,4),PKW(pB0,6)};pw1=(u32x4){PKW(pB0,8),PKW(pB0,10),PKW(pB0,12),PKW(pB0,14)};pw2=(u32x4){PKW(pB1,0),PKW(pB1,2),PKW(pB1,4),PKW(pB1,6)};pw3=(u32x4){PKW(pB1,8),PKW(pB1,10),PKW(pB1,12),PKW(pB1,14)};
    SBAR(); pv(o,vb0+sl_cur,PAF(0),PAF(1),PAF(2),PAF(3)); }
  #undef PKW
  #undef PAF
  #undef VFR
  #undef PIN
  #undef MX3
  #undef GAPA
  #undef GAPB
  #undef EX
  #undef VRD
  #undef KRD
  #undef STEP
  #undef ENDW
  {auto rr=__builtin_amdgcn_permlane32_swap(__float_as_uint(l_reg),__float_as_uint(l_reg),false,false);l_reg=__uint_as_float(rr[0])+__uint_as_float(rr[1]);}
  if(hi==0)wsf[32+r32]=l_reg;asm volatile("s_waitcnt lgkmcnt(0)":::"memory");
  float rli[16];
  #pragma unroll
  for(int r=0;r<16;++r)rli[r]=__builtin_amdgcn_rcpf(wsf[32+crow(r,hi)]);
  bf16*Ow=Ou+(long)(wid*QBLK)*DM;
  { bf16*stg=(bf16*)(shm+LDS_OST)+wid*2048;
    #pragma unroll
    for(int r=0;r<16;++r){const int orow=crow(r,hi);
      #pragma unroll
      for(int d0=0;d0<2;++d0)stg[orow*64+d0*32+r32]=__float2bfloat16(o[d0][r]*rli[r]);}
    asm volatile("s_waitcnt lgkmcnt(0)":::"memory");
    #pragma unroll
    for(int i=0;i<4;++i){const int row=i*8+(lane>>3),ch=lane&7; const u32x4 v=*(const u32x4*)(stg+row*64+ch*8); ATTN_STORE16(Ow+(long)row*DM+ch*8,v);} }
  asm volatile("s_waitcnt lgkmcnt(0)\n\ts_barrier":::"memory");
  #undef DMA_K
  #undef DMA_V
  #undef CMASK
  #undef START
  #undef RESC
  #undef ROT
}
constexpr int ATTN_LDS_BYTES=LDS_BYTES;
#undef SBAR
#undef WAIT_BAR
}

template <int LF> struct ConvRegs { static constexpr int P = 2 * LF + 8, NFC = 8 * P * 2 / 16, NF = (NFC + NTHR - 1) / NTHR, NW = NB * (LF / 8) / NTHR; u32x4 f[NF]; u32x4 x1[NW]; u32x4 v[NW]; };
template <int LF>
__device__ __forceinline__ void conv_issue(ConvRegs<LF>& R, const bf16_t* FIc, const bf16_t* x1src, const bf16_t* vsrc, int tid) {
    const u32x4* fs = (const u32x4*)FIc;
#pragma unroll
    for (int k = 0; k < ConvRegs<LF>::NF; ++k) { const int i = tid + k * NTHR; R.f[k] = i < ConvRegs<LF>::NFC ? fs[i] : (u32x4){0u, 0u, 0u, 0u}; }
#pragma unroll
    for (int k = 0; k < ConvRegs<LF>::NW; ++k) { const int i = tid + k * NTHR; R.x1[k] = *(const u32x4*)(x1src + (size_t)i * 8); R.v[k] = *(const u32x4*)(vsrc + (size_t)i * 8); }
}
__device__ __forceinline__ void unpack8(const u32x4 w, float (&x)[8]) { x[0] = bflo(w.x); x[1] = bfhi(w.x); x[2] = bflo(w.y); x[3] = bfhi(w.y); x[4] = bflo(w.z); x[5] = bfhi(w.z); x[6] = bflo(w.w); x[7] = bfhi(w.w); }
template <int LF>
__device__ __forceinline__ void conv_commit(const ConvRegs<LF>& R, LAS unsigned char* lds, const float (&cw8)[8], int tid, int lane, int wave) {
    constexpr int P = 2 * LF + 8, WSTR = LF + 8, NW = ConvRegs<LF>::NW, CPR = LF / 8;
    LAS unsigned char* FIL = lds; LAS unsigned char* WL = lds + ((8 * P * 2 + 255) & ~255);
    LAS unsigned* EDGE = (LAS unsigned*)(lds + 144 * 1024);
#pragma unroll
    for (int k = 0; k < ConvRegs<LF>::NF; ++k) { const int i = tid + k * NTHR; if (i < ConvRegs<LF>::NFC) ((LAS u32x4*)FIL)[i] = R.f[k]; }
    if (lane == 0 || lane == 63) {
#pragma unroll
        for (int k = 0; k < NW; ++k) EDGE[(wave * NW + k) * 2 + (lane == 63)] = lane == 0 ? ((R.x1[k].x & 0xffffu) | (R.v[k].x << 16)) : ((R.x1[k].w >> 16) | (R.v[k].w & 0xffff0000u)); }
    __syncthreads();
#pragma unroll
    for (int k = 0; k < NW; ++k) { const int i = tid + k * NTHR; const int b = i / CPR, ch = i % CPR;
        float x[8], y[8]; unpack8(R.x1[k], x); unpack8(R.v[k], y);
        float xp = __shfl_up(x[7], 1), yp = __shfl_up(y[7], 1), xn = __shfl_down(x[0], 1), yn = __shfl_down(y[0], 1);
        if (lane == 0 && wave > 0) { const unsigned e = EDGE[((wave - 1) * NW + k) * 2 + 1]; xp = bflo(e); yp = bfhi(e); }
        if (lane == 63 && wave < NWAVES - 1) { const unsigned e = EDGE[((wave + 1) * NW + k) * 2 + 0]; xn = bflo(e); yn = bfhi(e); }
        if (ch == 0) { xp = 0.f; yp = 0.f; } if (ch == CPR - 1) { xn = 0.f; yn = 0.f; }
        float o[8];
#pragma unroll
        for (int j = 0; j < 8; ++j) { const float xa = j == 0 ? xp : x[j - 1], xb = j == 7 ? xn : x[j + 1], ya = j == 0 ? yp : y[j - 1], yb = j == 7 ? yn : y[j + 1];
            const float sx = cw8[3] + cw8[0] * xa + cw8[1] * x[j] + cw8[2] * xb, sy = cw8[7] + cw8[4] * ya + cw8[5] * y[j] + cw8[6] * yb; o[j] = sx * sy; }
        u32x4 w; w.x = pk2(o[0], o[1]); w.y = pk2(o[2], o[3]); w.z = pk2(o[4], o[5]); w.w = pk2(o[6], o[7]);
        *(LAS u32x4*)(WL + b * (WSTR * 2) + ch * 16) = w; }
}
template <int LF>
__device__ __forceinline__ void conv_compute(LAS unsigned char* lds, bf16_t* ydst, int lane, int wv) {
    constexpr int IPW = LF / 256, NBK = LF / 32, P = 2 * LF + 8, WSTR = LF + 8;
    LAS unsigned char* FIL = lds; LAS unsigned char* WL = lds + ((8 * P * 2 + 255) & ~255);
    f32x4 acc[IPW][2]; bf16x8 Bw[IPW];
#pragma unroll
    for (int ii = 0; ii < IPW; ++ii) { acc[ii][0] = (f32x4){0.f, 0.f, 0.f, 0.f}; acc[ii][1] = (f32x4){0.f, 0.f, 0.f, 0.f}; Bw[ii] = (bf16x8){0, 0, 0, 0, 0, 0, 0, 0}; }
    const int rr = lane & 15, q = lane >> 4;
    const int aBase = (rr & 7) * (P * 2) + 2 * (LF - (rr - (rr & 7)) + 8 * q);
    const int bBase = rr * (WSTR * 2) + 16 * q;
#define CONV_STEPS(CHECK) do { _Pragma("unroll") for (int dd = 0; dd < IPW; ++dd) { \
        const int delta = IPW * d + dd; \
        const bf16x8 a0 = *(const LAS bf16x8*)(FIL + aBase - 64 * delta), a1 = *(const LAS bf16x8*)(FIL + aBase - 64 * delta - 32); \
        const int jn = IPW * (wv - d) - dd; \
        if (!(CHECK) || (jn >= 0 && jn < NBK)) Bw[(IPW - dd) % IPW] = *(const LAS bf16x8*)(WL + bBase + 64 * jn); \
        _Pragma("unroll") for (int ii = 0; ii < IPW; ++ii) { const int j = IPW * (wv - d) + ii - dd; \
            if (!(CHECK) || (j >= 0 && j < NBK)) { \
                acc[ii][0] = __builtin_amdgcn_mfma_f32_16x16x32_bf16(a0, Bw[(ii - dd + IPW) % IPW], acc[ii][0], 0, 0, 0); \
                acc[ii][1] = __builtin_amdgcn_mfma_f32_16x16x32_bf16(a1, Bw[(ii - dd + IPW) % IPW], acc[ii][1], 0, 0, 0); } } } } while (0)
    { const int d = wv - 8; CONV_STEPS(true); }
    for (int d = wv - 7; d < wv; ++d) { CONV_STEPS(false); }
    { const int d = wv; CONV_STEPS(true); }
#undef CONV_STEPS
#pragma unroll
    for (int ii = 0; ii < IPW; ++ii)
#pragma unroll
        for (int h = 0; h < 2; ++h) { u32x2 w; w.x = pk2(acc[ii][h][0], acc[ii][h][1]); w.y = pk2(acc[ii][h][2], acc[ii][h][3]);
            *(u32x2*)(ydst + (size_t)rr * LF + 32 * (IPW * wv + ii) + 16 * h + 4 * q) = w; }
}


__device__ __forceinline__ void route_reduce(float (&p)[32], int lane) {
#pragma unroll
    for (int i = 0; i < 16; ++i) { const bool up = (lane & 32) != 0; const float send = up ? p[i] : p[i + 16], keep = up ? p[i + 16] : p[i]; p[i] = keep + __shfl_xor(send, 32); }
#pragma unroll
    for (int i = 0; i < 8; ++i) { const bool up = (lane & 16) != 0; const float send = up ? p[i] : p[i + 8], keep = up ? p[i + 8] : p[i]; p[i] = keep + __shfl_xor(send, 16); }
#pragma unroll
    for (int i = 0; i < 4; ++i) { const bool up = (lane & 8) != 0; const float send = up ? p[i] : p[i + 4], keep = up ? p[i + 4] : p[i]; p[i] = keep + __shfl_xor(send, 8); }
#pragma unroll
    for (int i = 0; i < 2; ++i) { const bool up = (lane & 4) != 0; const float send = up ? p[i] : p[i + 2], keep = up ? p[i + 2] : p[i]; p[i] = keep + __shfl_xor(send, 4); }
    { const bool up = (lane & 2) != 0; const float send = up ? p[0] : p[1], keep = up ? p[1] : p[0]; p[0] = keep + __shfl_xor(send, 2); }
    p[0] += __shfl_xor(p[0], 1);
}
__device__ __forceinline__ void route_top4(float val, int myE, float (&sv)[4], int (&si)[4]) {
    int rank = 0;
#pragma unroll
    for (int e = 0; e < 32; ++e) { const float o = __builtin_bit_cast(float, __builtin_amdgcn_readlane(__builtin_bit_cast(int, val), 2 * e)); rank += (o > val || (o == val && e < myE)) ? 1 : 0; }
#pragma unroll
    for (int k = 0; k < 4; ++k) { const unsigned long long m = __ballot(rank == k); const int src = __builtin_ctzll(m);
        si[k] = src >> 1; sv[k] = __builtin_bit_cast(float, __builtin_amdgcn_readlane(__builtin_bit_cast(int, val), src)); }
}
#define IN(k) (lo <= (k) && (k) < hi)
#define SEAM(k) do { if (IN(k) && IN((k) + 1)) xcd_barrier(bar); } while (0)
#define SEAMK(k, kind) SEAM(k)
#define KLOCALS \
    const float* x_in = args.in[I_X]; const float* c_in = args.in[I_C]; const float* ctx_in = args.in[I_CTX]; const float* cctx_in = args.in[I_CCTX]; \
    float* out = args.out; \
    float* modp = (float*)(ws + WS_MODP); float* modf = (float*)(ws + WS_MOD); \
    float* cosT = (float*)(ws + WS_ROPE); float* sinT = cosT + SEQ * 32; \
    float* a2tab = (float*)(ws + WS_A2); \
    int* top_e = (int*)(ws + WS_PAIR); int* ppos = top_e + NTOK * 4; float* pgate = (float*)(ppos + NTOK * 4); int* pdest = (int*)(pgate + NTOK * 4); \
    bf16_t* XB = (bf16_t*)(ws + WS_XB); \
    bf16_t* Wqkv_t = (bf16_t*)(ws + WS_WQKV); bf16_t* Wo_t = (bf16_t*)(ws + WS_WO); bf16_t* Win_t = (bf16_t*)(ws + WS_WIN); bf16_t* Wout_t = (bf16_t*)(ws + WS_WOUT); \
    bf16_t* Wgu_t = (bf16_t*)(ws + WS_WGU); bf16_t* Wdn_t = (bf16_t*)(ws + WS_WDN); \
    bf16_t* hA = (bf16_t*)(ws + WS_HA); bf16_t* Qb = (bf16_t*)(ws + WS_Q); bf16_t* Kb = (bf16_t*)(ws + WS_K); bf16_t* Vb = (bf16_t*)(ws + WS_V); \
    bf16_t* Upre = (bf16_t*)(ws + WS_UPRE); bf16_t* Wc = (bf16_t*)(ws + WS_WC); bf16_t* Yc = (bf16_t*)(ws + WS_YC); \
    bf16_t* XS = (bf16_t*)(ws + WS_XS); bf16_t* AB = (bf16_t*)(ws + WS_AB); int* elist = (int*)(ws + WS_ELIST); \
    const int wr = wave >> 2, wc = wave & 3, fr = lane & 15, fq = lane >> 4;
template <int layer> __device__ __forceinline__ void layer_body(const Args& args, LAS unsigned char* lds, const XcdBarrier& bar, const int tid, const int lane, const int wave, const int G, const int bid, const int lo, const int hi) {
    const int gw = bid * NWAVES + wave, NGW = G * NWAVES;
    unsigned char* ws = args.ws;
    gu32* ctl = (gu32*)(ws + WS_CTL);
    KLOCALS
        const int pb = 3 + 10 * layer;
        const int jm = layer >> 1;
        const bool ctx_live = layer < 2;
        const int nrows = ctx_live ? NTOK : NLAT;
        const float* mo = modf + (size_t)layer * NMODROW * MODW;

        if ((layer & 1) == 0) {
            if (EN_GEMM && IN(pb + 0)) {
                EpiQKV E{Qb, Kb, Vb, args.in[I_QG] + jm * 64, args.in[I_KG] + jm * 64, cosT, sinT};
                const bf16_t* Wt = Wqkv_t + (size_t)jm * NQKV * D;
                const QkvSched S{hA, Wt, ctx_live ? 1 : 0, G, bid};
                run_gemm(lds, S, E);
            }
            SEAMK(pb + 0, 3);
            if (EN_ATT && IN(pb + 1)) {
                typedef attn_body::bf16 abf;
                const int x = bid & 7, sl = bid >> 3, nS = G >> 3;
                for (int q = sl; q < 256; q += nS) {
                    const int b = 2 * x + (q >> 7), kvh = (q >> 5) & 3, head = 4 * kvh + ((q >> 3) & 3), qb = q & 7;
                    abf* Qu = (abf*)(Qb + ((size_t)b * SEQ + qb * 256) * D + head * 64);
                    attn_body::attn_unit<8>(Qu, (const abf*)(Kb + (size_t)b * KVL * 256 + kvh * 64), (const abf*)(Vb + (size_t)b * KVL * 256 + kvh * 64), Qu, KVL / 64, (char*)lds);
                }
                if (ctx_live) for (int q = sl; q < 32; q += nS) {
                    const int b = 2 * x + (q >> 4), head = q & 15, kvh = head >> 2;
                    abf* Qu = (abf*)(Qb + ((size_t)NLAT + b * CL) * D + head * 64);
                    attn_body::attn_unit<8>(Qu, (const abf*)(Kb + ((size_t)b * KVL + SEQ) * 256 + kvh * 64), (const abf*)(Vb + ((size_t)b * KVL + SEQ) * 256 + kvh * 64), Qu, CL / 64, (char*)lds);
                }
            }
            SEAMK(pb + 1, 4);
            if (EN_GEMM && IN(pb + 2)) {
                EpiResid<layer == 0> E{x_in, ctx_in, XB, mo + 2 * D, nullptr};
                const bf16_t* Wt = Wo_t + (size_t)jm * D * D;
                const DenseSched S{Qb, Wt, nrows / 256, 4, G, bid};
                run_gemm(lds, S, E);
            }
            SEAMK(pb + 2, 5);
        } else {
            const float* cw = args.in[I_HCW] + (size_t)jm * 3 * NHY; const float* cb = args.in[I_HCB] + (size_t)jm * NHY;
            if (EN_GEMM && IN(pb + 0)) {
                const EpiRowBiasBf16 E{Upre, NTOK, args.in[I_HBIN] + (size_t)jm * NHY};
                const WinTSched S{Win_t + (size_t)jm * NHY * D, hA, nrows / 256, G, bid};
                run_gemm(lds, S, E);
            }
            SEAMK(pb + 0, 6);
            if (EN_CONV && IN(pb + 2)) {
                const bf16_t* uT = Upre;
#define CONV_CW8(C) { cw[0 * NHY + D + (C)], cw[1 * NHY + D + (C)], cw[2 * NHY + D + (C)], cb[D + (C)], cw[0 * NHY + 2 * D + (C)], cw[1 * NHY + 2 * D + (C)], cw[2 * NHY + 2 * D + (C)], cb[2 * D + (C)] }
                { const bf16_t* FIb = (const bf16_t*)(ws + (jm == 0 ? WS_FI0 : WS_FI1));
                  ConvRegs<SEQ> R; int c = bid;
                  if (c < 1024) conv_issue<SEQ>(R, FIb + (size_t)c * 8 * FP_L, uT + (size_t)(D + c) * NTOK, uT + (size_t)(2 * D + c) * NTOK, tid);
                  for (; c < 1024; c += G) {
                      const float cw8[8] = CONV_CW8(c);
                      __syncthreads();
                      conv_commit<SEQ>(R, lds, cw8, tid, lane, wave);
                      __syncthreads();
                      if (c + G < 1024) conv_issue<SEQ>(R, FIb + (size_t)(c + G) * 8 * FP_L, uT + (size_t)(D + c + G) * NTOK, uT + (size_t)(2 * D + c + G) * NTOK, tid);
                      conv_compute<SEQ>(lds, Yc + (size_t)c * NB * SEQ, lane, wave);
                  } }
                if (ctx_live) for (int c = bid; c < 1024; c += G) {
                    const float cw8[8] = CONV_CW8(c);
                    ConvRegs<CL> R; conv_issue<CL>(R, (const bf16_t*)(ws + WS_FI2) + (size_t)c * 8 * FP_C, uT + (size_t)(D + c) * NTOK + NLAT, uT + (size_t)(2 * D + c) * NTOK + NLAT, tid);
                    __syncthreads(); conv_commit<CL>(R, lds, cw8, tid, lane, wave); __syncthreads();
                    conv_compute<CL>(lds, Yc + WC_CTX_OFF + (size_t)c * NB * CL, lane, wave);
                }
#undef CONV_CW8
            }
            SEAMK(pb + 2, 8);
            if (EN_MISC && IN(pb + 3)) {
                LAS unsigned char* T = lds;
                const bf16_t* uT = Upre;
                const int nlat_u = NB * 16 * 4, nctx_u = ctx_live ? NB * 2 * 4 : 0;
                const int hw = tid >> 5, l32 = tid & 31;
                for (int u = bid; u < nlat_u + nctx_u; u += G) {
                    int b, s0, c0, Ls, rowb; const bf16_t* srcb;
                    if (u < nlat_u) { b = u >> 6; s0 = ((u >> 2) & 15) * 128; c0 = (u & 3) * 256; Ls = SEQ; rowb = b * SEQ; srcb = Yc; }
                    else { const int q = u - nlat_u; b = q >> 3; s0 = ((q >> 2) & 1) * 128; c0 = (q & 3) * 256; Ls = CL; rowb = NLAT + b * CL; srcb = Yc + WC_CTX_OFF; }
                    __syncthreads();
                    { const int ch = tid & 15;
                      u32x4 yw[8], uw[8]; unsigned short ep[8], en[8]; float wq[8][4];
#pragma unroll
                      for (int i = 0; i < 8; ++i) { const int cg = c0 + i * 32 + (tid >> 4);
                          yw[i] = *(const u32x4*)(srcb + ((size_t)cg * NB + b) * Ls + s0 + ch * 8);
                          const bf16_t* up = uT + (size_t)cg * NTOK + rowb + s0 + ch * 8; uw[i] = *(const u32x4*)up; ep[i] = up[-1]; en[i] = up[8];
                          wq[i][0] = cw[0 * NHY + cg]; wq[i][1] = cw[1 * NHY + cg]; wq[i][2] = cw[2 * NHY + cg]; wq[i][3] = cb[cg]; }
#pragma unroll
                      for (int i = 0; i < 8; ++i) { const int c = i * 32 + (tid >> 4);
                          float x[8], y[8]; unpack8(uw[i], x); unpack8(yw[i], y);
                          float xp = __shfl_up(x[7], 1), xn = __shfl_down(x[0], 1);
                          if (ch == 0) xp = s0 > 0 ? bf2f(ep[i]) : 0.f;
                          if (ch == 15) xn = s0 + 128 < Ls ? bf2f(en[i]) : 0.f;
                          float o[8];
#pragma unroll
                          for (int j = 0; j < 8; ++j) { const float xa = j == 0 ? xp : x[j - 1], xb = j == 7 ? xn : x[j + 1]; o[j] = (wq[i][3] + wq[i][0] * xa + wq[i][1] * x[j] + wq[i][2] * xb) * y[j]; }
                          u32x4 w; w.x = pk2(o[0], o[1]); w.y = pk2(o[2], o[3]); w.z = pk2(o[4], o[5]); w.w = pk2(o[6], o[7]);
                          *(LAS u32x4*)(T + c * 256 + ((ch ^ ((c >> 3) & 15)) * 16)) = w; } }
                    __syncthreads();
                    const int cc = c0 + 8 * l32, sb = s0 + 8 * hw;
                    u32x4 zv[8];
#pragma unroll
                    for (int c = 0; c < 8; ++c) zv[c] = *(const LAS u32x4*)(T + (8 * l32 + c) * 256 + ((hw ^ (l32 & 15)) * 16));
#pragma unroll
                    for (int si = 0; si < 8; ++si) { unsigned hv[8];
#pragma unroll
                        for (int c = 0; c < 8; ++c) { const unsigned wd = zv[c][si >> 1]; hv[c] = (si & 1) ? (wd >> 16) : (wd & 0xffffu); }
                        u32x4 o; o.x = hv[0] | (hv[1] << 16); o.y = hv[2] | (hv[3] << 16); o.z = hv[4] | (hv[5] << 16); o.w = hv[6] | (hv[7] << 16);
                        *(u32x4*)(hA + (size_t)(rowb + sb + si) * D + cc) = o; }
                }
            }
            SEAMK(pb + 3, 9);
            if (EN_GEMM && IN(pb + 4)) {
                EpiResid<layer == 0> E{x_in, ctx_in, XB, mo + 2 * D, args.in[I_HBOUT] + (size_t)jm * D};
                const bf16_t* Wt = Wout_t + (size_t)jm * D * D;
                const DenseSched S{hA, Wt, nrows / 256, 4, G, bid};
                run_gemm(lds, S, E);
            }
            SEAMK(pb + 4, 10);
        }

        gu32* cnt = ctl + CW_CNT + layer * 32 * 64;
        if (EN_ROUTER && IN(pb + 5)) {
            constexpr int WSTR = D + 8, MAXT = 20;
            LAS bf16_t* WT = (LAS bf16_t*)lds;
            LAS float* CB = (LAS float*)(lds + 2 * 32 * WSTR * 2);
            LAS float* CRED = CB + 32;
            LAS int* LCNT = (LAS int*)(CRED + 512);
            LAS int* PREC = LCNT + 64;
            LAS float* RINV = (LAS float*)(PREC + 8 * MAXT * 4);
            __syncthreads();
            if (tid < 64) LCNT[tid] = 0;
            for (int i = tid; i < 8 * MAXT * 4; i += NTHR) PREC[i] = -1;
            const int TPW = (((nrows + NGW - 1) / NGW) + 1) & ~1;
            const int rf = gw * TPW; const int nval = rf >= nrows ? 0 : (nrows - rf < TPW ? nrows - rf : TPW);
            { int curb = -1; f32x4 gs[4], sh[4]; u32x2 wv_[4];
              if (nval > 0) {
#pragma unroll
                  for (int j = 0; j < 4; ++j) wv_[j] = ((const u32x2*)(XB + (size_t)rf * D))[lane + 64 * j]; }
              for (int ti = 0; ti < nval; ++ti) { const int r = rf + ti; f32x4 v[4];
#pragma unroll
                  for (int j = 0; j < 4; ++j) v[j] = (f32x4){bflo(wv_[j].x), bfhi(wv_[j].x), bflo(wv_[j].y), bfhi(wv_[j].y)};
                  if (ti + 1 < nval) {
#pragma unroll
                      for (int j = 0; j < 4; ++j) wv_[j] = ((const u32x2*)(XB + (size_t)(r + 1) * D))[lane + 64 * j]; }
                  const int bq = mod_row(r); if (bq != curb) { const float* mr = mo + (size_t)bq * MODW; load_vec(mr + 4 * D, lane, gs); load_vec(mr + 3 * D, lane, sh); curb = bq; }
                  float ss = 0.f;
#pragma unroll
                  for (int j = 0; j < 4; ++j) ss += (v[j][0] * v[j][0] + v[j][1] * v[j][1]) + (v[j][2] * v[j][2] + v[j][3] * v[j][3]);
                  ss = wave_sum(ss); const float rinv = __builtin_amdgcn_rsqf(ss * (1.0f / D) + EPS);
                  if (lane == 0) RINV[wave * MAXT + ti] = rinv;
#pragma unroll
                  for (int j = 0; j < 4; ++j) { const f32x4 h = (v[j] * rinv) * gs[j] + sh[j]; u32x2 w; w.x = pk2(h[0], h[1]); w.y = pk2(h[2], h[3]); ((u32x2*)(hA + (size_t)r * D))[lane + 64 * j] = w; } } }
            const int rb0 = bid * NWAVES * TPW; const int rb1 = (rb0 + NWAVES * TPW < nrows ? rb0 + NWAVES * TPW : nrows) - 1;
            const int bb0 = rb0 < nrows ? mod_row(rb0) : 1, bb1 = rb0 < nrows ? mod_row(rb1) : 0;
            const float* rw = args.in[I_RW] + (size_t)layer * D * NE; const float* rbias = args.in[I_RB] + layer * NE;
            for (int bq = bb0; bq <= bb1; ++bq) {
                __syncthreads();
                { const float* gsb = mo + (size_t)bq * MODW + 4 * D; const float* shb = mo + (size_t)bq * MODW + 3 * D;
                  const int e = tid & 31; float cpart = 0.f;
#pragma unroll 4
                  for (int jj = 0; jj < 8; ++jj) { const int k0 = 8 * ((tid >> 5) + 16 * jj);
                      const f32x4 g0 = *(const f32x4*)(gsb + k0), g1 = *(const f32x4*)(gsb + k0 + 4), s0 = *(const f32x4*)(shb + k0), s1 = *(const f32x4*)(shb + k0 + 4);
                      float wv[8];
#pragma unroll
                      for (int q = 0; q < 8; ++q) wv[q] = rw[(size_t)(k0 + q) * NE + e];
                      float pv[8]; unsigned hw[4], lw[4];
#pragma unroll
                      for (int q = 0; q < 4; ++q) { pv[q] = g0[q] * wv[q]; pv[4 + q] = g1[q] * wv[4 + q]; cpart += s0[q] * wv[q] + s1[q] * wv[4 + q]; }
#pragma unroll
                      for (int q = 0; q < 4; ++q) { hw[q] = pk2(pv[2 * q], pv[2 * q + 1]); lw[q] = pk2(pv[2 * q] - bflo(hw[q]), pv[2 * q + 1] - bfhi(hw[q])); }
                      *(LAS u32x4*)(WT + (size_t)e * WSTR + k0) = (u32x4){hw[0], hw[1], hw[2], hw[3]};
                      *(LAS u32x4*)(WT + (size_t)(32 + e) * WSTR + k0) = (u32x4){lw[0], lw[1], lw[2], lw[3]}; }
                  CRED[(tid >> 5) * 32 + e] = cpart; }
                __syncthreads();
                if (tid < 32) { float c = rbias[tid];
#pragma unroll
                    for (int q = 0; q < 16; ++q) c += CRED[q * 32 + tid];
                    CB[tid] = c; }
                __syncthreads();
                if (nval > 0 && mod_row(rf) <= bq && bq <= mod_row(rf + nval - 1)) {
                    const int e = lane & 31, kh = lane >> 5; const int trow = rf + (e < nval ? e : nval - 1);
                    const bf16_t* ap = XB + (size_t)trow * D + 8 * kh;
                    const LAS bf16_t* bhp = WT + (size_t)e * WSTR + 8 * kh; const LAS bf16_t* blp = bhp + 32 * WSTR;
                    f32x16 acc;
#pragma unroll
                    for (int q = 0; q < 16; ++q) acc[q] = 0.f;
#pragma unroll 8
                    for (int ks = 0; ks < D / 16; ++ks) { const bf16x8 af = *(const bf16x8*)(ap + 16 * ks);
                        acc = __builtin_amdgcn_mfma_f32_32x32x16_bf16(af, *(const LAS bf16x8*)(bhp + 16 * ks), acc, 0, 0, 0);
                        acc = __builtin_amdgcn_mfma_f32_32x32x16_bf16(af, *(const LAS bf16x8*)(blp + 16 * ks), acc, 0, 0, 0); }
                    const float cbe = CB[e];
                    const int hf = lane >> 5;
#pragma unroll
                    for (int r = 0; r < 10; ++r) { const int tA = (r & 3) + 8 * (r >> 2), tB = tA + 4;
                        const bool okA = tA < nval && mod_row(rf + tA) == bq, okB = tB < nval && mod_row(rf + (tB < MAXT ? tB : 0)) == bq;
                        if (okA || okB) {
                            const int tmine = hf ? (tB < MAXT ? tB : MAXT - 1) : tA;
                            float val = RINV[wave * MAXT + tmine] * acc[r] + cbe;
                            float sv[4]; int si[4];
#pragma unroll
                            for (int k = 0; k < 4; ++k) {
                                int x = __builtin_bit_cast(int, val); float m = val;
                                m = fmaxf(m, __builtin_bit_cast(float, __builtin_amdgcn_update_dpp(x, x, 0xB1, 0xF, 0xF, false))); x = __builtin_bit_cast(int, m);
                                m = fmaxf(m, __builtin_bit_cast(float, __builtin_amdgcn_update_dpp(x, x, 0x4E, 0xF, 0xF, false))); x = __builtin_bit_cast(int, m);
                                m = fmaxf(m, __builtin_bit_cast(float, __builtin_amdgcn_update_dpp(x, x, 0x124, 0xF, 0xF, false))); x = __builtin_bit_cast(int, m);
                                m = fmaxf(m, __builtin_bit_cast(float, __builtin_amdgcn_update_dpp(x, x, 0x128, 0xF, 0xF, false)));
                                m = fmaxf(m, __shfl_xor(m, 16));
                                const unsigned long long mk = __ballot(val == m);
                                const int wlo = __builtin_ctz((unsigned)mk | 0x80000000u), whi = __builtin_ctz((unsigned)(mk >> 32) | 0x80000000u);
                                const int win = hf ? whi : wlo;
                                sv[k] = m; si[k] = win; if ((lane & 31) == win) val = -INFINITY; }
                            if ((lane & 31) < 4 && (hf ? okB : okA)) { const int k = lane & 31; const float e1 = __expf(sv[1] - sv[0]), e2 = __expf(sv[2] - sv[0]), e3 = __expf(sv[3] - sv[0]); const float inv = 1.0f / (1.0f + e1 + e2 + e3);
                                const int ex = k == 0 ? si[0] : (k == 1 ? si[1] : (k == 2 ? si[2] : si[3])); const float gt = (k == 0 ? 1.0f : (k == 1 ? e1 : (k == 2 ? e2 : e3))) * inv;
                                const int tt = hf ? tB : tA; const int rr = rf + tt; const int rk = __hip_atomic_fetch_add(LCNT + ex, 1, __ATOMIC_RELAXED, __HIP_MEMORY_SCOPE_WORKGROUP);
                                top_e[rr * 4 + k] = ex; pgate[rr * 4 + k] = gt; PREC[(wave * MAXT + tt) * 4 + k] = ex | (rk << 8); } } }
                }
            }
            __syncthreads();
            if (tid < 32) LCNT[32 + tid] = (int)__hip_atomic_fetch_add(cnt + tid * 64, (unsigned)LCNT[tid], RLX_AGENT);
            __syncthreads();
            for (int i = tid; i < 8 * MAXT * 4; i += NTHR) { const int rec = PREC[i]; if (rec >= 0) { const int e = rec & 255, rank = rec >> 8, w = i / (MAXT * 4), ti = (i / 4) % MAXT, k = i & 3;
                const int r = (bid * NWAVES + w) * TPW + ti; const int pos = LCNT[32 + e] + rank; ppos[r * 4 + k] = pos; elist[(size_t)e * NTOK + pos] = r; } }
        }
        SEAMK(pb + 5, 11);
        LAS int* PADS = (LAS int*)(lds + LDS_BYTES - 4096);
        LAS unsigned char* TE = (LAS unsigned char*)(PADS + 128);
        if (IN(pb + 7) || IN(pb + 8) || IN(pb + 9)) {
            __syncthreads();
            if (tid < 32) PADS[64 + tid] = (int)__hip_atomic_load(cnt + tid * 64, RLX_AGENT);
            __syncthreads();
            if (tid < 64) {
                const int nt = lane < 32 ? (PADS[64 + lane] + 255) >> 8 : 0; int inc = nt;
#pragma unroll
                for (int o = 1; o < 32; o <<= 1) { const int v = __shfl_up(inc, o); if (lane >= o) inc += v; }
                if (lane < 32) PADS[lane] = (inc - nt) << 8; if (lane == 31) PADS[32] = inc << 8;
            }
            __syncthreads();
            { const int ntile = PADS[32] >> 8; for (int t = tid; t < ntile; t += NTHR) { int e = 0;
#pragma unroll
                  for (int st = 16; st >= 1; st >>= 1) if (PADS[e + st] <= (t << 8)) e += st;
                  TE[t] = (unsigned char)e; } }
            __syncthreads();
        }
        if (EN_GEMM && IN(pb + 7)) {
            const int ntile = PADS[32] >> 8;
            LAS int* ROWS = (LAS int*)(lds + 131072);
            { Unit uu; for (int ui = 0; xcd_unit(ui, G, bid, ntile, 8, uu.pm, uu.pn); ++ui) { if (tid < 256) { const int e = TE[uu.pm]; const int pos = uu.pm * 256 - PADS[e] + tid;
                  ROWS[ui * 256 + tid] = pos < PADS[64 + e] ? elist[(size_t)e * NTOK + pos] : 0; } } }
            __syncthreads();
            const MoeGatherSched S{hA, Wgu_t + (size_t)layer * NE * NGU * D, TE, ROWS, ntile, 8, NGU, G, bid};
            const EpiSwiglu E{AB, args.in[I_BGU] + (size_t)layer * NE * NGU};
            run_gemm_gather(lds, S, E);
        }
        SEAMK(pb + 7, 12);
        if (EN_GEMM && IN(pb + 8)) {
            const int ntile = PADS[32] >> 8;
            const MoeSched S{AB, Wdn_t + (size_t)layer * NE * D * D, TE, ntile, 4, D, G, bid};
            const EpiBiasBf16 E{XS, D, args.in[I_BDN] + (size_t)layer * NE * D, D};
            run_gemm(lds, S, E);
        }
        SEAMK(pb + 8, 13);
        if (EN_MISC && IN(pb + 9)) {
            const bool has_next = layer + 1 < DEPTH;
            const float* mo_n = modf + (size_t)(layer + 1) * NMODROW * MODW; const float* g1n = args.in[I_N1G] + (has_next ? (layer + 1) * D : 0);
            const int nnext = (layer + 1 < 3) ? NTOK : NLAT;
            const int TPW = (nrows + NGW - 1) / NGW;
            int curb = -1; f32x4 gm[4], gsn[4], shn[4];
            for (int ti = 0; ti < TPW; ++ti) {
                const int r = gw * TPW + ti; if (r >= nrows) break;
                bf16_t* xr = XB + (size_t)r * D;
                int dest[4]; float gt[4];
#pragma unroll
                for (int k = 0; k < 4; ++k) { dest[k] = PADS[top_e[r * 4 + k]] + ppos[r * 4 + k]; gt[k] = pgate[r * 4 + k]; }
                u32x2 yw[4][4]; f32x4 v[4], h[4];
#pragma unroll
                for (int k = 0; k < 4; ++k) { const u32x2* yr = (const u32x2*)(XS + (size_t)dest[k] * D);
#pragma unroll
                    for (int j = 0; j < 4; ++j) yw[k][j] = yr[lane + 64 * j]; }
                load_vec_bf(xr, lane, v);
                const int b = mod_row(r);
                if (b != curb) { load_vec(mo + (size_t)b * MODW + 5 * D, lane, gm); if (has_next) { const float* mn = mo_n + (size_t)b * MODW; load_vec(mn + D, lane, gsn); load_vec(mn, lane, shn); } curb = b; }
#pragma unroll
                for (int j = 0; j < 4; ++j) { f32x4 y = (f32x4){0.f, 0.f, 0.f, 0.f};
#pragma unroll
                    for (int k = 0; k < 4; ++k) { const u32x2 w = yw[k][j]; y[0] += gt[k] * bflo(w.x); y[1] += gt[k] * bfhi(w.x); y[2] += gt[k] * bflo(w.y); y[3] += gt[k] * bfhi(w.y); }
                    v[j] = v[j] + gm[j] * y;
                    if (layer == DEPTH - 1) ((f32x4*)(out + (size_t)r * D))[lane + 64 * j] = v[j];
                    else { u32x2 w; w.x = pk2(v[j][0], v[j][1]); w.y = pk2(v[j][2], v[j][3]); ((u32x2*)xr)[lane + 64 * j] = w; } }
                if (has_next && r < nnext) { const int rp = (layer & 1) == 0 ? (r & ~31) + slot32(r & 31) : r;
                    norm_mod_store(v, gsn, shn, hA + (size_t)rp * D, lane, h); }
            }
        }
        SEAMK(pb + 9, 14);
}

__global__ void __launch_bounds__(NTHR, 2) fwd(Args args) {
    extern __shared__ __attribute__((aligned(16))) unsigned char lds_raw[];
    LAS unsigned char* lds = (LAS unsigned char*)lds_raw;
    const int tid = threadIdx.x, lane = tid & 63, wave = __builtin_amdgcn_readfirstlane(tid >> 6);
    const int G = gridDim.x, bid = blockIdx.x;
    const int gw = bid * NWAVES + wave, NGW = G * NWAVES;
    unsigned char* ws = args.ws;
    gu32* ctl = (gu32*)(ws + WS_CTL);
    volatile LAS unsigned* MISC = (volatile LAS unsigned*)(lds + MISC_OFF);
    if (tid < 64) MISC[tid] = 0u;
    __syncthreads();
    XcdBarrier bar; bar.bar = (unsigned*)ctl + CW_BAR; bar.x = 0; bar.st = MISC + 8;
    const int lo = args.ph_lo, hi = args.ph_hi;
    if (hi - lo > 1) bar = xcd_barrier_post((unsigned*)ctl + CW_BAR, MISC + 8);

    KLOCALS

    if (EN_PRO && IN(0)) {
        {
            LAS float* scr = (LAS float*)(lds + wave * 8448);
            constexpr int IT_QKV = 16 * (NQKV / 32), IT_SQ = 16 * (D / 32), IT_IN = 16 * (NHY / 32), IT_GU = 16 * (NGU / 32);
            constexpr int N0 = 2 * IT_QKV, N1 = N0 + 2 * IT_SQ, N2 = N1 + 2 * IT_IN, N3 = N2 + 2 * IT_SQ, N4 = N3 + 128 * IT_GU, N5 = N4 + 128 * IT_SQ;
            for (int it = gw; it < N5; it += NGW) {
                if (it < N0) { const int mtx = it / IT_QKV, r = it % IT_QKV; transpose_item<1>(args.in[I_WQKV] + (size_t)mtx * D * NQKV, NQKV, Wqkv_t + (size_t)mtx * NQKV * D, scr, r, lane); }
                else if (it < N1) { const int q = it - N0, mtx = q / IT_SQ, r = q % IT_SQ; transpose_item<0>(args.in[I_WO] + (size_t)mtx * D * D, D, Wo_t + (size_t)mtx * D * D, scr, r, lane); }
                else if (it < N2) { const int q = it - N1, mtx = q / IT_IN, r = q % IT_IN; transpose_item<3>(args.in[I_HWIN] + (size_t)mtx * D * NHY, NHY, Win_t + (size_t)mtx * NHY * D, scr, r, lane); }
                else if (it < N3) { const int q = it - N2, mtx = q / IT_SQ, r = q % IT_SQ; transpose_item<0>(args.in[I_HWOUT] + (size_t)mtx * D * D, D, Wout_t + (size_t)mtx * D * D, scr, r, lane); }
                else if (it < N4) { const int q = it - N3, mtx = q / IT_GU, r = q % IT_GU; transpose_item<2>(args.in[I_WGU] + (size_t)mtx * D * NGU, NGU, Wgu_t + (size_t)mtx * NGU * D, scr, r, lane); }
                else { const int q = it - N4, mtx = q / IT_SQ, r = q % IT_SQ; transpose_item<0>(args.in[I_WDN] + (size_t)mtx * D * D, D, Wdn_t + (size_t)mtx * D * D, scr, r, lane); }
            }
        }
        __syncthreads();
        {
            LAS float* S = (LAS float*)lds;
            for (int u = bid; u < 4 * 12 * 8; u += G) {
                const int kc = u & 7, cc = (u >> 3) % 12, layer = u / 96;
                __syncthreads();
                for (int i = tid; i < 128 * 20; i += NTHR) { const int k = i / 20, r = i % 20; float v = 0.f;
                    if (r < NMODROW) { const float cv = r < NB ? c_in[r * D + kc * 128 + k] : cctx_in[kc * 128 + k]; v = cv / (1.0f + __expf(-cv)); }
                    S[i] = v; }
                __syncthreads();
                const int col = cc * 512 + tid;
                const float* wp = args.in[I_WMOD] + ((size_t)layer * D + kc * 128) * MODW + col;
                float acc[20];
#pragma unroll
                for (int r = 0; r < 20; ++r) acc[r] = 0.f;
                for (int k = 0; k < 128; ++k) { const float w = wp[(size_t)k * MODW];
#pragma unroll
                    for (int q = 0; q < 5; ++q) { const f32x4 s = *(const LAS f32x4*)(S + k * 20 + 4 * q);
                        acc[4 * q] += s[0] * w; acc[4 * q + 1] += s[1] * w; acc[4 * q + 2] += s[2] * w; acc[4 * q + 3] += s[3] * w; } }
#pragma unroll
                for (int r = 0; r < NMODROW; ++r) modp[((size_t)(kc * 4 + layer) * NMODROW + r) * MODW + col] = acc[r];
            }
        }
        for (int i = bid * NTHR + tid; i < SEQ * 32; i += G * NTHR) {
            const int t = i >> 5, j = i & 31, fi = j & 15; const int pos = (j >> 4) == 0 ? (t >> 6) : (t & 63);
            const float inv = powf(10000.0f, -(float)fi / 16.0f); const float ang = (float)pos * inv;
            cosT[i] = cosf(ang); sinT[i] = sinf(ang);
        }
        {
            __syncthreads();
            LAS float* Z = (LAS float*)lds;
            LAS float* A1 = Z + 8 * 36;
            for (int u = bid; u < 256 + 256 + 32; u += G) {
                const int combo = u < 256 ? 0 : (u < 512 ? 1 : 2); const int ub = combo == 0 ? u : (combo == 1 ? u - 256 : u - 512);
                const int j = combo == 1 ? 1 : 0, Lf = combo == 2 ? CL : SEQ;
                const int tl = tid >> 6, o = tid & 63, t = ub * 8 + tl;
                __syncthreads();
                if (o < 33) { float z;
                    const float tt = (float)t / (float)(Lf - 1), w = 6.283185307179586f * (float)t / (float)Lf;
                    if (o == 0) z = tt; else { const int b = (o - 1) & 15; const float f = 1e-4f + (float)b * ((15.0f - 1e-4f) / 15.0f); z = o <= 16 ? cosf(f * w) : -sinf(f * w); }
                    Z[tl * 36 + o] = z; }
                __syncthreads();
                const float sf = args.in[I_HSF][j * 64 + o];
                { const float* w1 = args.in[I_HW1] + (size_t)j * 33 * 64; float a = args.in[I_HB1][j * 64 + o];
                  for (int i = 0; i < 33; ++i) a += Z[tl * 36 + i] * w1[i * 64 + o];
                  A1[tl * 64 + o] = sinf(sf * a); }
                __syncthreads();
                { const float* w2 = args.in[I_HW2] + (size_t)j * 64 * 64; float a = args.in[I_HB2][j * 64 + o];
                  for (int i = 0; i < 64; ++i) a += A1[tl * 64 + i] * w2[i * 64 + o];
                  a2tab[((size_t)combo * SEQ + t) * 64 + o] = sinf(sf * a); }
            }
        }
    }
    SEAMK(0, 0);

    if (EN_PRO && IN(1)) {
        for (int i = bid * NTHR + tid; i < DEPTH * NMODROW * MODW; i += G * NTHR) {
            const int layer = i / (NMODROW * MODW), rem = i % (NMODROW * MODW), col = rem % MODW; float s = args.in[I_BMOD][layer * MODW + col];
#pragma unroll
            for (int kc = 0; kc < 8; ++kc) s += modp[(size_t)(kc * 4 + layer) * NMODROW * MODW + rem];
            const int chunk = col >> 10, k = col & (D - 1);
            if (chunk == 1) s = args.in[I_N1G][layer * D + k] * (1.0f + s); else if (chunk == 4) s = args.in[I_N2G][layer * D + k] * (1.0f + s);
            modf[i] = s;
        }
        {
            LAS float* W3 = (LAS float*)lds;
            LAS float* RED = W3 + 512;
            LAS float* NRM = RED + 32;
            LAS float* HF = NRM + 4;
            for (int u = bid; u < 3 * 256; u += G) {
                const int combo = u >> 8, cg = u & 255; const int j = combo == 1 ? 1 : 0, Lf = combo == 2 ? CL : SEQ; const int c0 = cg * 4;
                LAS float* HB = HF + 4 * Lf;
                __syncthreads();
                { const int i = tid >> 3, q = tid & 7; const int col = (q >> 2) * 1024 + c0 + (q & 3);
                  W3[i * 8 + q] = args.in[I_HW3][((size_t)j * 64 + i) * 2048 + col]; }
                __syncthreads();
                float b3v[8], dec[4], asum[4] = {0.f, 0.f, 0.f, 0.f};
#pragma unroll
                for (int q = 0; q < 8; ++q) b3v[q] = args.in[I_HB3][j * 2048 + (q >> 2) * 1024 + c0 + (q & 3)];
#pragma unroll
                for (int ch = 0; ch < 4; ++ch) dec[ch] = 3.0701134573253945f + (float)(c0 + ch) * ((15.350567286626972f - 3.0701134573253945f) / 1023.0f);
                for (int t = tid; t < Lf; t += NTHR) {
                    asm volatile("" ::: "memory");
                    const float* ar = a2tab + ((size_t)combo * SEQ + t) * 64; float d[8];
#pragma unroll
                    for (int q = 0; q < 8; ++q) d[q] = b3v[q];
#pragma unroll
                    for (int i4 = 0; i4 < 16; ++i4) { const f32x4 a = *(const f32x4*)(ar + 4 * i4); asm volatile("" ::: "memory");
#pragma unroll
                        for (int e = 0; e < 4; ++e) { const f32x4 w0 = *(const LAS f32x4*)(W3 + (4 * i4 + e) * 8), w1 = *(const LAS f32x4*)(W3 + (4 * i4 + e) * 8 + 4);
                            d[0] += a[e] * w0[0]; d[1] += a[e] * w0[1]; d[2] += a[e] * w0[2]; d[3] += a[e] * w0[3]; d[4] += a[e] * w1[0]; d[5] += a[e] * w1[1]; d[6] += a[e] * w1[2]; d[7] += a[e] * w1[3]; } }
                    const float tt = (float)t / (float)(Lf - 1);
#pragma unroll
                    for (int ch = 0; ch < 4; ++ch) { const float dk = __expf(-tt * dec[ch]); const float f = d[ch] * dk, bb = d[4 + ch] * dk;
                        HF[ch * Lf + t] = f; HB[ch * Lf + t] = bb; asum[ch] += fabsf(f) + (t >= 1 ? fabsf(bb) : 0.f); }
                }
#pragma unroll
                for (int ch = 0; ch < 4; ++ch) { const float s = wave_sum(asum[ch]); if (lane == 0) RED[wave * 4 + ch] = s; }
                __syncthreads();
                if (tid < 4) { float s = 0.f; for (int w = 0; w < 8; ++w) s += RED[w * 4 + tid]; NRM[tid] = 1.0f / (s + EPS); }
                __syncthreads();
                const int P = 2 * Lf + 8, PC8 = P / 8;
                bf16_t* FI = (bf16_t*)(ws + (combo == 0 ? WS_FI0 : (combo == 1 ? WS_FI1 : WS_FI2)));
                for (int q = tid; q < 4 * 8 * PC8; q += NTHR) {
                    const int ch = q / (8 * PC8), r = q % (8 * PC8), cidx = r / PC8, x0 = (r % PC8) * 8;
                    const float nr = NRM[ch], db = args.in[I_HDB][j * 1024 + c0 + ch]; float v[8];
#pragma unroll
                    for (int e = 0; e < 8; ++e) { const int m = Lf - (x0 + e) + cidx; const int am = m < 0 ? -m : m; float g = 0.f;
                        if (am <= Lf - 1) { g = (m >= 0 ? HF[ch * Lf + am] : HB[ch * Lf + am]) * nr; if (m == 0) g += db; }
                        v[e] = g; }
                    u32x4 o; o.x = pk2(v[0], v[1]); o.y = pk2(v[2], v[3]); o.z = pk2(v[4], v[5]); o.w = pk2(v[6], v[7]);
                    *(u32x4*)(FI + ((size_t)((c0 + ch) * 8 + cidx)) * P + x0) = o;
                }
            }
        }
    }
    SEAMK(1, 1);

    if (IN(2)) {
        const float* mo = modf;
        const int TPW = (NTOK + NGW - 1) / NGW;
        int curb = -1; f32x4 gs[4], sh[4];
        for (int ti = 0; ti < TPW; ++ti) {
            const int r = gw * TPW + ti; if (r >= NTOK) break;
            const float* src = r < NLAT ? x_in + (size_t)r * D : ctx_in + (size_t)(r - NLAT) * D;
            f32x4 v[4], h[4]; load_vec(src, lane, v);
            const int b = mod_row(r); if (b != curb) { const float* mr = mo + (size_t)b * MODW; load_vec(mr + D, lane, gs); load_vec(mr, lane, sh); curb = b; }
            norm_mod_store(v, gs, sh, hA + (size_t)r * D, lane, h);
        }
    }
    SEAMK(2, 2);

    layer_body<0>(args, lds, bar, tid, lane, wave, G, bid, lo, hi);
    layer_body<1>(args, lds, bar, tid, lane, wave, G, bid, lo, hi);
    layer_body<2>(args, lds, bar, tid, lane, wave, G, bid, lo, hi);
    layer_body<3>(args, lds, bar, tid, lane, wave, G, bid, lo, hi);
#undef IN
#undef SEAM
}

extern "C" void kernel_launch(void* const* d_in, const int* in_sizes, int n_in, void* d_out, int out_size, void* d_ws, size_t ws_size, hipStream_t stream) {
    static int grid = 0;
    if (grid == 0) {
        if (n_in != 32 || out_size != NLAT * D || ws_size < WS_END) { fprintf(stderr, "kernel_launch: unexpected problem (n_in %d, out %d, ws %zu)\n", n_in, out_size, ws_size); grid = -1; return; }
        int dev = 0, cus = 0, per_cu = 0;
        if (hipGetDevice(&dev) != hipSuccess || hipDeviceGetAttribute(&cus, hipDeviceAttributeMultiprocessorCount, dev) != hipSuccess) { grid = -1; return; }
        if (hipFuncSetAttribute((const void*)fwd, hipFuncAttributeMaxDynamicSharedMemorySize, LDS_BYTES) != hipSuccess) { fprintf(stderr, "kernel_launch: hipFuncSetAttribute failed\n"); grid = -1; return; }
        if (hipOccupancyMaxActiveBlocksPerMultiprocessor(&per_cu, (const void*)fwd, NTHR, LDS_BYTES) != hipSuccess || per_cu < 1) fprintf(stderr, "kernel_launch: occupancy query says %d\n", per_cu);
        (void)hipGetLastError();
        if (cus < 256) { fprintf(stderr, "kernel_launch: built for the 256-CU MI355X (unit orders, per-wave row counts); found %d CUs; nothing launched\n", cus); grid = -1; return; }
        grid = 256;
    }
    if (grid < 0) return;
    (void)hipMemsetAsync((char*)d_ws + WS_CTL, 0, CTL_ZERO_BYTES, stream);
    Args a{};
    for (int i = 0; i < 32; ++i) a.in[i] = (const float*)d_in[i];
    a.out = (float*)d_out; a.ws = (unsigned char*)d_ws;
    constexpr int NPH = 3 + 10 * DEPTH;
#if MK_ONE_LAUNCH
    a.ph_lo = 0; a.ph_hi = NPH;
    hipLaunchKernelGGL(fwd, dim3(grid), dim3(NTHR), LDS_BYTES, stream, a);
#else
    for (int p = 0; p < NPH; ++p) {
        if (p >= 3) { const int layer = (p - 3) / 10, loc = (p - 3) % 10; if ((layer & 1) == 0 && (loc == 3 || loc == 4)) continue; }
        a.ph_lo = p; a.ph_hi = p + 1;
        hipLaunchKernelGGL(fwd, dim3(grid), dim3(NTHR), LDS_BYTES, stream, a);
    }
#endif
}
```

```cpp
#include <hip/hip_runtime.h>
#include <cstdio>
#include <cstdint>
#include <cmath>
#include <hip/hip_bf16.h>

#ifndef EN_PRO
#define EN_PRO 1
#endif
#ifndef EN_ATT
#define EN_ATT 1
#endif
#ifndef EN_CONV
#define EN_CONV 1
#endif
#ifndef EN_ROUTER
#define EN_ROUTER 1
#endif
#ifndef EN_GEMM
#define EN_GEMM 1
#endif
#ifndef EN_MISC
#define EN_MISC 1
#endif
#ifndef MK_ONE_LAUNCH
#define MK_ONE_LAUNCH 1
#endif

#define GAS __attribute__((address_space(1)))
#define LAS __attribute__((address_space(3)))
typedef unsigned short bf16_t;
typedef short bf16x8 __attribute__((ext_vector_type(8)));
typedef float f32x4 __attribute__((ext_vector_type(4)));
typedef float f32x2 __attribute__((ext_vector_type(2)));
typedef unsigned u32x4 __attribute__((ext_vector_type(4)));
typedef unsigned u32x2 __attribute__((ext_vector_type(2)));
typedef GAS unsigned gu32;
typedef float f32x16 __attribute__((ext_vector_type(16)));

constexpr int D = 1024, NB = 16, SEQ = 2048, CL = 256, KVL = SEQ + CL;
constexpr int NLAT = NB * SEQ, NCTX = NB * CL, NTOK = NLAT + NCTX;
constexpr int NE = 32, TOPK = 4, DEPTH = 4;
constexpr int MODW = 6 * D, NMODROW = NB + 1;
constexpr int NQKV = 1536, NHY = 3072, NGU = 2048;
constexpr float EPS = 1e-6f;
constexpr float C2 = 0.125f * 1.4426950408889634f;
constexpr int NWAVES = 8, NTHR = 512;
constexpr int NPADROWS = 155648;
constexpr int MAXTILES = NPADROWS / 256;

constexpr size_t MiB = 1u << 20;
constexpr size_t WS_CTL = 0, CTL_ZERO_BYTES = 1 * MiB;
constexpr size_t WS_MODP = 2 * MiB;
constexpr size_t WS_MOD = 16 * MiB;
constexpr size_t WS_ROPE = 18 * MiB;
constexpr size_t WS_A2 = 19 * MiB;
constexpr size_t WS_PAIR = 21 * MiB;
constexpr size_t WS_CTX = 24 * MiB;
constexpr size_t WS_FI = 40 * MiB;
constexpr int FP_L = 2 * SEQ + 8, FP_C = 2 * CL + 8;
constexpr size_t FI_L_BYTES = (size_t)1024 * 8 * FP_L * 2, FI_C_BYTES = (size_t)1024 * 8 * FP_C * 2;
constexpr size_t WS_FI0 = WS_FI, WS_FI1 = WS_FI0 + 65 * MiB, WS_FI2 = WS_FI1 + 65 * MiB;
static_assert(FI_L_BYTES <= 65 * MiB && WS_FI2 + FI_C_BYTES <= 180 * MiB, "filter map");
constexpr size_t WS_WQKV = 180 * MiB, WS_WO = 186 * MiB, WS_WIN = 190 * MiB, WS_WOUT = 202 * MiB, WS_WGU = 206 * MiB, WS_WDN = 718 * MiB;
constexpr size_t WS_HA = 974 * MiB;
constexpr size_t WS_Q = 1046 * MiB;
constexpr size_t WS_K = 1118 * MiB, WS_V = 1136 * MiB;
constexpr size_t WS_UPRE = 1154 * MiB;
constexpr size_t WS_WC = 1370 * MiB;
constexpr size_t WS_YC = 1442 * MiB;
constexpr size_t WS_XS = 1514 * MiB;
constexpr size_t WS_AB = 1818 * MiB;
constexpr size_t WS_ELIST = 2122 * MiB;
constexpr size_t WS_XB = 2128 * MiB;
constexpr size_t WS_END = 2200 * MiB;
constexpr size_t WC_CTX_OFF = (size_t)1024 * 16 * 2048;
constexpr int CW_TMO = 0, CW_BAR = 4096, CW_CNT = 16384;

constexpr int LDS_BYTES = 160 * 1024;
constexpr int MISC_OFF = LDS_BYTES - 256;

#define RLX_AGENT __ATOMIC_RELAXED, __HIP_MEMORY_SCOPE_AGENT
#define LDS_WAIT() asm volatile("s_waitcnt lgkmcnt(0)" ::: "memory")
#define VM_WAIT() asm volatile("s_waitcnt vmcnt(0)" ::: "memory")
__device__ __forceinline__ unsigned f2bf(float f) { unsigned u = __builtin_bit_cast(unsigned, f); return (u + 0x7fffu + ((u >> 16) & 1u)) >> 16; }
typedef __bf16 bf16x2_t __attribute__((ext_vector_type(2)));
__device__ __forceinline__ unsigned pk2(float lo, float hi) { const f32x2 v = {lo, hi}; const bf16x2_t b = __builtin_convertvector(v, bf16x2_t); return __builtin_bit_cast(unsigned, b); }
__device__ __forceinline__ float bf2f(unsigned h) { return __builtin_bit_cast(float, h << 16); }
__device__ __forceinline__ float bflo(unsigned w) { return __builtin_bit_cast(float, w << 16); }
__device__ __forceinline__ float bfhi(unsigned w) { return __builtin_bit_cast(float, w & 0xffff0000u); }
__device__ __forceinline__ float wave_sum(float v) {
#pragma unroll
    for (int o = 1; o < 64; o <<= 1) v += __shfl_xor(v, o);
    return v;
}

#define XB_TMO      128
#define XB_XCNT(j)  (256  + 64 * (j))
#define XB_XSUB(j)  (1280 + 64 * (j))
#define XB_XGEN(j)  (2304 + 64 * (j))
#define XB_TOP      3328
#define XB_TOPGEN   3392
#define XCD_BAR_WORDS 3456
#define XB_SPIN_CAP (1u << 22)
__device__ __forceinline__ unsigned xb_ld(unsigned* p)              { return __hip_atomic_load(p, __ATOMIC_RELAXED, __HIP_MEMORY_SCOPE_AGENT); }
__device__ __forceinline__ unsigned xb_add(unsigned* p, unsigned v) { return __hip_atomic_fetch_add(p, v, __ATOMIC_RELAXED, __HIP_MEMORY_SCOPE_AGENT); }
__device__ __forceinline__ unsigned xb_xcc_id() { return (unsigned)__builtin_amdgcn_s_getreg((3 << 11) | 20) & 0xFu; }
#define XB_SPIN(cond, bar) do { unsigned _sp = 0; while (cond) { __builtin_amdgcn_s_sleep(1); \
    if ((++_sp & 255u) == 0u) { if (xb_ld(&(bar)[XB_TMO])) break; if (_sp > XB_SPIN_CAP) { atomicAdd(&(bar)[XB_TMO], 1u); break; } } } } while (0)
struct XcdBarrier { unsigned* bar; unsigned x; volatile LAS unsigned* st; };
__device__ __forceinline__ XcdBarrier xcd_barrier_post(unsigned* bar, volatile LAS unsigned* st) {
    XcdBarrier b; b.bar = bar; b.x = xb_xcc_id(); b.st = st;
    if (threadIdx.x == 0) (void)xb_add(&bar[XB_XCNT(b.x)], 1u);
    return b;
}
__device__ __forceinline__ void xcd_barrier_complete(unsigned* bar, unsigned x, unsigned& nloc, unsigned& nx) {
    const unsigned G = gridDim.x * gridDim.y * gridDim.z;
    unsigned sum, cnt, mine, sp = 0u;
    for (;;) {
        sum = 0u; cnt = 0u; mine = 0u;
#pragma unroll
        for (unsigned j = 0; j < 16; ++j) { const unsigned c = xb_ld(&bar[XB_XCNT(j)]); sum += c; cnt += (c > 0u) ? 1u : 0u; mine = (j == x) ? c : mine; }
        if (sum == G) break;
        __builtin_amdgcn_s_sleep(1);
        if ((++sp & 255u) == 0u) { if (xb_ld(&bar[XB_TMO])) break; if (sp > XB_SPIN_CAP) { atomicAdd(&bar[XB_TMO], 1u); break; } }
    }
    nloc = mine > 0u ? mine : 1u; nx = cnt > 0u ? cnt : 1u;
}
__device__ __forceinline__ void xcd_barrier(const XcdBarrier& b) {
    asm volatile("s_waitcnt vmcnt(0)" ::: "memory");
    __syncthreads();
    if (threadIdx.x == 0) {
        unsigned* bar = b.bar;
        __builtin_amdgcn_s_waitcnt(0);
        unsigned nloc = b.st[0], nx = b.st[1];
        if (nloc == 0u) { xcd_barrier_complete(bar, b.x, nloc, nx); b.st[0] = nloc; b.st[1] = nx; }
        const unsigned old = xb_add(&bar[XB_XSUB(b.x)], 1u);
        const unsigned gen = old / nloc;
        if (old + 1u == (gen + 1u) * nloc) {
            __builtin_amdgcn_fence(__ATOMIC_RELEASE, "agent");
            asm volatile("s_waitcnt vmcnt(0)" ::: "memory");
            const unsigned og = xb_add(&bar[XB_TOP], 1u);
            const unsigned tg = og / nx;
            if (og + 1u == (tg + 1u) * nx) xb_add(&bar[XB_TOPGEN], 1u);
            else XB_SPIN(xb_ld(&bar[XB_TOPGEN]) == tg, bar);
            __builtin_amdgcn_fence(__ATOMIC_ACQUIRE, "agent");
            xb_add(&bar[XB_XGEN(b.x)], 1u);
            asm volatile("s_waitcnt vmcnt(0)" ::: "memory");
        } else {
            XB_SPIN(xb_ld(&bar[XB_XGEN(b.x)]) == gen, bar);
            __builtin_amdgcn_fence(__ATOMIC_ACQUIRE, "agent");
            asm volatile("s_waitcnt vmcnt(0)" ::: "memory");
        }
    }
    __syncthreads();
}

struct Args { const float* in[32]; float* out; unsigned char* ws; int ph_lo, ph_hi; };
struct Ctx {
    LAS unsigned char* lds;
    int tid, lane, wave, G, bid;
    const float* const* in;
};
enum { I_X = 0, I_C, I_CTX, I_CCTX, I_WMOD, I_BMOD, I_N1G, I_N2G, I_WQKV, I_QG, I_KG, I_WO, I_HWIN, I_HBIN, I_HCW, I_HCB, I_HW1, I_HB1, I_HW2, I_HB2, I_HW3, I_HB3,
       I_HSF, I_HDB, I_HWOUT, I_HBOUT, I_RW, I_RB, I_WGU, I_BGU, I_WDN, I_BDN };

__device__ __forceinline__ int mod_row(int r) { return r < NLAT ? (r >> 11) : NB; }

__device__ __forceinline__ void gemm_unit_simple(const bf16_t* At, const bf16_t* Bt, f32x4 (&acc)[2][2][4][2], int wr, int wc, int fr, int fq) {
    constexpr int K = D;
#pragma unroll
    for (int a = 0; a < 2; ++a)
#pragma unroll
        for (int b = 0; b < 2; ++b)
#pragma unroll
            for (int m = 0; m < 4; ++m)
#pragma unroll
                for (int n = 0; n < 2; ++n) acc[a][b][m][n] = (f32x4){0.f, 0.f, 0.f, 0.f};
    const bf16_t* ap = At + (size_t)(wr * 64 + fr) * K + fq * 8;
    const bf16_t* bp = Bt + (size_t)(wc * 32 + fr) * K + fq * 8;
    for (int k0 = 0; k0 < K; k0 += 32) {
        bf16x8 bfr[2][2];
#pragma unroll
        for (int bj = 0; bj < 2; ++bj)
#pragma unroll
            for (int n = 0; n < 2; ++n) bfr[bj][n] = *(const bf16x8*)(bp + (size_t)(bj * 128 + n * 16) * K + k0);
#pragma unroll
        for (int ai = 0; ai < 2; ++ai)
#pragma unroll
            for (int m = 0; m < 4; ++m) {
                const bf16x8 afr = *(const bf16x8*)(ap + (size_t)(ai * 128 + m * 16) * K + k0);
#pragma unroll
                for (int bj = 0; bj < 2; ++bj)
#pragma unroll
                    for (int n = 0; n < 2; ++n) acc[ai][bj][m][n] = __builtin_amdgcn_mfma_f32_16x16x32_bf16(bfr[bj][n], afr, acc[ai][bj][m][n], 0, 0, 0);
            }
    }
}


struct Unit { int pm, pn, e; };
namespace pg8 {
constexpr int BM = 256, BK = 64, HALF = 128, HTB = HALF * BK * 2, STAGE_BYTES = 8 * HTB;
__device__ __forceinline__ int lds_byte(int r, int c) { const int st = (r >> 4) * 2 + (c >> 5), rr = r & 15, cc = c & 31, ob = rr * 64 + cc * 2; return st * 1024 + (ob ^ (((ob >> 9) & 1) << 5)); }
__device__ __forceinline__ void stage_rc(int b, int& R, int& C) { const int st = b / 1024, sb = b % 1024, swz = sb ^ (((sb >> 9) & 1) << 5); R = (st >> 1) * 16 + swz / 64; C = (st & 1) * 32 + (swz % 64) / 2; }
template <class Epi, class Sched, bool GATHER = false>
__device__ __forceinline__ void gemm_phase(LAS unsigned char* lds, const Sched& S, const Epi& E) {
    constexpr int K = D, nt = K / BK;
    const int tid = threadIdx.x, wid = __builtin_amdgcn_readfirstlane(tid >> 6), lane = tid & 63, wr = wid >> 2, wc = wid & 3, fr = lane & 15, fq = lane >> 4;
    unsigned voffA[2];
#pragma unroll
    for (int i = 0; i < 2; ++i) { int R, C; stage_rc(tid * 16 + i * 8192, R, C); voffA[i] = (unsigned)(R * K + C) * 2u; }
    const size_t kstep = (size_t)(BK * 2);
    const size_t hstep = (size_t)HALF * K * 2;
    const unsigned ldsw = (unsigned)wid * 1024u;
    const int aoff = lds_byte(wr * 64 + fr, fq * 8), boff = lds_byte(wc * 32 + fr, fq * 8);
#define PG8_SA(b, h) (((b) * 2 + (h)) * HTB)
#define PG8_SB(b, h) ((4 + (b) * 2 + (h)) * HTB)
#define PG8_STAGE(bufoff, gbase, voff) do { _Pragma("unroll") for (int _i = 0; _i < 2; ++_i) \
        __builtin_amdgcn_global_load_lds((const unsigned*)((const char*)(gbase) + (voff)[_i]), (LAS unsigned*)(lds + (bufoff) + ldsw + _i * 8192), 16, 0, 0); } while (0)
#define PG8_LDA(dst, b, h) do { _Pragma("unroll") for (int m = 0; m < 4; ++m) _Pragma("unroll") for (int k = 0; k < 2; ++k) dst[m][k] = *(const LAS bf16x8*)(lds + PG8_SA(b, h) + aoff + m * 2048 + k * 1024); } while (0)
#define PG8_LDB(dst, b, h) do { _Pragma("unroll") for (int n = 0; n < 2; ++n) _Pragma("unroll") for (int k = 0; k < 2; ++k) dst[n][k] = *(const LAS bf16x8*)(lds + PG8_SB(b, h) + boff + n * 2048 + k * 1024); } while (0)
#define PG8_MMA(ai, bj, At, Bt) do { __builtin_amdgcn_s_setprio(1); _Pragma("unroll") for (int m = 0; m < 4; ++m) _Pragma("unroll") for (int n = 0; n < 2; ++n) _Pragma("unroll") for (int k = 0; k < 2; ++k) \
        acc[ai][bj][m][n] = __builtin_amdgcn_mfma_f32_16x16x32_bf16(Bt[n][k], At[m][k], acc[ai][bj][m][n], 0, 0, 0); __builtin_amdgcn_s_setprio(0); } while (0)
#define PG8_WAIT_V(n) asm volatile("s_waitcnt vmcnt(" #n ")" ::: "memory")
#define PG8_WAIT_L(n) asm volatile("s_waitcnt lgkmcnt(" #n ")" ::: "memory")
#define PG8_BAR __builtin_amdgcn_s_barrier()
#define PG8_SCHED __builtin_amdgcn_sched_barrier(0)
    unsigned vA[2][2], vN[2][2]; unsigned gR[2], gC[2];
    const char* gA = nullptr;
    if constexpr (GATHER) {
        gA = S.a_base();
#pragma unroll
        for (int i = 0; i < 2; ++i) { gR[i] = voffA[i] / (unsigned)(K * 2); gC[i] = voffA[i] % (unsigned)(K * 2); }
        const LAS int* rw = S.rows(0);
#pragma unroll
        for (int h = 0; h < 2; ++h)
#pragma unroll
            for (int i = 0; i < 2; ++i) { vA[h][i] = (unsigned)rw[h * HALF + gR[i]] * (unsigned)(K * 2) + gC[i]; vN[h][i] = vA[h][i]; }
    }
#define PG8_STAGEA(bufoff, P, V, kt, h) do { if constexpr (GATHER) PG8_STAGE(bufoff, gA + (size_t)(kt) * kstep, V[h]); else PG8_STAGE(bufoff, (P) + (size_t)(kt) * kstep + (size_t)(h) * hstep, voffA); } while (0)
    Unit cur, nxt; int ui = 0;
    if (!S.next(0, cur)) return;
    f32x4 acc[2][2][4][2];
#pragma unroll
    for (int a = 0; a < 2; ++a)
#pragma unroll
        for (int b = 0; b < 2; ++b)
#pragma unroll
            for (int m = 0; m < 4; ++m)
#pragma unroll
                for (int n = 0; n < 2; ++n) acc[a][b][m][n] = (f32x4){0.f, 0.f, 0.f, 0.f};
    bf16x8 At[4][2], B0[2][2], B1[2][2];
    const char* cA = nullptr; if constexpr (!GATHER) cA = S.a_ptr(cur);
    const char* cB = S.b_ptr(cur);
    PG8_STAGE(PG8_SB(0, 0), cB, voffA); PG8_STAGE(PG8_SB(0, 1), cB + hstep, voffA); PG8_STAGEA(PG8_SA(0, 0), cA, vA, 0, 0); PG8_STAGEA(PG8_SA(0, 1), cA, vA, 0, 1);
    if (wr == 1) PG8_BAR;
    PG8_WAIT_V(2); PG8_BAR;
    PG8_STAGE(PG8_SB(1, 0), cB + kstep, voffA); PG8_STAGEA(PG8_SA(1, 0), cA, vA, 1, 0); PG8_STAGE(PG8_SB(1, 1), cB + hstep + kstep, voffA);
    PG8_WAIT_V(6); PG8_BAR;
    for (;;) {
        const bool has_next = S.next(ui + 1, nxt);
        const char* nA = cA; if constexpr (!GATHER) { if (has_next) nA = S.a_ptr(nxt); }
        const char* nB = has_next ? S.b_ptr(nxt) : cB;
        if constexpr (GATHER) { if (has_next) { const LAS int* rw = S.rows(ui + 1);
#pragma unroll
            for (int h = 0; h < 2; ++h)
#pragma unroll
                for (int i = 0; i < 2; ++i) vN[h][i] = (unsigned)rw[h * HALF + gR[i]] * (unsigned)(K * 2) + gC[i]; } }
        for (int t = 0; t < nt; t += 2) {
            const bool last = (t == nt - 2);
            const char* b2 = last ? nB : cB + (size_t)(t + 2) * kstep; const char* b3 = b2 + kstep;
            const char* pX = last ? nA : cA; const int kX = last ? 0 : t + 2;
            unsigned vX[2][2];
#pragma unroll
            for (int h = 0; h < 2; ++h)
#pragma unroll
                for (int i = 0; i < 2; ++i) vX[h][i] = last ? vN[h][i] : vA[h][i];
            PG8_LDB(B0, 0, 0); PG8_LDB(B1, 0, 1); PG8_SCHED; PG8_LDA(At, 0, 0); PG8_STAGEA(PG8_SA(1, 1), cA, vA, t + 1, 1);
            PG8_WAIT_V(8); PG8_WAIT_L(0); PG8_BAR; PG8_MMA(0, 0, At, B0); PG8_MMA(0, 1, At, B1); PG8_BAR; PG8_SCHED;
            PG8_LDA(At, 0, 1); PG8_STAGE(PG8_SB(0, 0), b2, voffA); PG8_STAGE(PG8_SB(0, 1), b2 + hstep, voffA); PG8_STAGEA(PG8_SA(0, 0), pX, vX, kX, 0);
            PG8_WAIT_V(8); PG8_WAIT_L(0); PG8_BAR; PG8_MMA(1, 0, At, B0); PG8_MMA(1, 1, At, B1); PG8_BAR; PG8_SCHED;
            PG8_LDB(B0, 1, 0); PG8_LDB(B1, 1, 1); PG8_SCHED; PG8_LDA(At, 1, 0); PG8_STAGEA(PG8_SA(0, 1), pX, vX, kX, 1);
            PG8_WAIT_V(8); PG8_WAIT_L(0); PG8_BAR; PG8_MMA(0, 0, At, B0); PG8_MMA(0, 1, At, B1); PG8_BAR; PG8_SCHED;
            PG8_LDA(At, 1, 1); PG8_STAGE(PG8_SB(1, 0), b3, voffA); PG8_STAGE(PG8_SB(1, 1), b3 + hstep, voffA); PG8_STAGEA(PG8_SA(1, 0), pX, vX, kX + 1, 0);
            PG8_WAIT_V(8); PG8_WAIT_L(0); PG8_BAR; PG8_MMA(1, 0, At, B0); PG8_MMA(1, 1, At, B1); PG8_BAR; PG8_SCHED;
        }
        if (wr == 0) PG8_BAR;
        E(acc, cur, wr, wc, fr, fq);
        if (!has_next) break;
#pragma unroll
        for (int a = 0; a < 2; ++a)
#pragma unroll
            for (int b = 0; b < 2; ++b)
#pragma unroll
                for (int m = 0; m < 4; ++m)
#pragma unroll
                    for (int n = 0; n < 2; ++n) acc[a][b][m][n] = (f32x4){0.f, 0.f, 0.f, 0.f};
        cur = nxt; cA = nA; cB = nB; ++ui;
        if constexpr (GATHER) {
#pragma unroll
            for (int h = 0; h < 2; ++h)
#pragma unroll
                for (int i = 0; i < 2; ++i) vA[h][i] = vN[h][i]; }
        if (wr == 1) PG8_BAR;
    }
    PG8_WAIT_V(0);
    PG8_BAR;
#undef PG8_SA
#undef PG8_SB
#undef PG8_STAGE
#undef PG8_STAGEA
#undef PG8_LDA
#undef PG8_LDB
#undef PG8_MMA
#undef PG8_WAIT_V
#undef PG8_WAIT_L
#undef PG8_BAR
#undef PG8_SCHED
}
}

template <class Epi, class Sched>
__device__ __forceinline__ void gemm_phase_simple(const Sched& S, const Epi& E) {
    const int tid = threadIdx.x, wid = __builtin_amdgcn_readfirstlane(tid >> 6), lane = tid & 63, wr = wid >> 2, wc = wid & 3, fr = lane & 15, fq = lane >> 4;
    Unit u;
    for (int i = 0; S.next(i, u); ++i) { f32x4 acc[2][2][4][2];
        gemm_unit_simple((const bf16_t*)S.a_ptr(u), (const bf16_t*)S.b_ptr(u), acc, wr, wc, fr, fq);
        E(acc, u, wr, wc, fr, fq); }
}
#ifndef FAST_GEMM
#define FAST_GEMM 1
#endif
template <class Epi, class Sched>
__device__ __forceinline__ void run_gemm(LAS unsigned char* lds, const Sched& S, const Epi& E) {
#if FAST_GEMM
    pg8::gemm_phase<Epi, Sched, false>(lds, S, E);
#else
    gemm_phase_simple<Epi, Sched>(S, E);
#endif
}
template <class Epi, class Sched>
__device__ __forceinline__ void run_gemm_gather(LAS unsigned char* lds, const Sched& S, const Epi& E) { pg8::gemm_phase<Epi, Sched, true>(lds, S, E); }
__device__ __forceinline__ bool xcd_unit(int i, int G, int c, int nM, int nN, int& pm, int& pn) {
    const int x = c & 7, s = c >> 3, nS = G >> 3;
    const int r0 = (nM * x) >> 3, r1 = (nM * (x + 1)) >> 3;
    const int q = i * nS + s; if (q >= (r1 - r0) * nN) return false;
    const int rr = q / nN; pm = r0 + rr; pn = q - rr * nN; return true;
}
struct DenseSched {
    const bf16_t* A; const bf16_t* Bt; int nM, nN, G, c;
    __device__ __forceinline__ bool next(int i, Unit& u) const { u.e = 0; return xcd_unit(i, G, c, nM, nN, u.pm, u.pn); }
    __device__ __forceinline__ const char* a_ptr(const Unit& u) const { return (const char*)(A + (size_t)u.pm * 256 * D); }
    __device__ __forceinline__ const char* b_ptr(const Unit& u) const { return (const char*)(Bt + (size_t)u.pn * 256 * D); }
};
struct QkvSched {
    const bf16_t* A; const bf16_t* Bt; int live, G, c;
    __device__ __forceinline__ bool next(int i, Unit& u) const { u.e = 0;
        if (live) return xcd_unit(i, G, c, 144, 6, u.pm, u.pn);
        const int x = c & 7, s = c >> 3, nS = G >> 3; const int nlat = 16 * 6; const int q = i * nS + s;
        if (q < nlat) { const int rr = q / 6; u.pm = 16 * x + rr; u.pn = q - rr * 6; return true; }
        const int q2 = q - nlat; if (q2 >= 4) return false; const int t = x * 4 + q2; u.pm = 128 + (t >> 1); u.pn = 4 + (t & 1); return true; }
    __device__ __forceinline__ const char* a_ptr(const Unit& u) const { return (const char*)(A + (size_t)u.pm * 256 * D); }
    __device__ __forceinline__ const char* b_ptr(const Unit& u) const { return (const char*)(Bt + (size_t)u.pn * 256 * D); }
};
struct MoeSched {
    const bf16_t* A; const bf16_t* Bt  ; const LAS unsigned char* TE; int nM, nN, N, G, c;
    __device__ __forceinline__ bool next(int i, Unit& u) const { if (!xcd_unit(i, G, c, nM, nN, u.pm, u.pn)) return false; u.e = TE[u.pm]; return true; }
    __device__ __forceinline__ const char* a_ptr(const Unit& u) const { return (const char*)(A + (size_t)u.pm * 256 * D); }
    __device__ __forceinline__ const char* b_ptr(const Unit& u) const { return (const char*)(Bt + ((size_t)u.e * N + (size_t)u.pn * 256) * D); }
};
struct WinTSched {
    const bf16_t* Wt  ; const bf16_t* X  ; int nTok, G, c;
    __device__ __forceinline__ bool next(int i, Unit& u) const { u.e = 0; int tok, ch; if (!xcd_unit(i, G, c, nTok, 12, tok, ch)) return false; u.pm = ch; u.pn = tok; return true; }
    __device__ __forceinline__ const char* a_ptr(const Unit& u) const { return (const char*)(Wt + (size_t)u.pm * 256 * D); }
    __device__ __forceinline__ const char* b_ptr(const Unit& u) const { return (const char*)(X + (size_t)u.pn * 256 * D); }
};
struct MoeGatherSched {
    const bf16_t* A; const bf16_t* Bt; const LAS unsigned char* TE; const LAS int* ROWS; int nM, nN, N, G, c;
    __device__ __forceinline__ bool next(int i, Unit& u) const { if (!xcd_unit(i, G, c, nM, nN, u.pm, u.pn)) return false; u.e = TE[u.pm]; return true; }
    __device__ __forceinline__ const char* a_base() const { return (const char*)A; }
    __device__ __forceinline__ const LAS int* rows(int ui) const { return ROWS + ui * 256; }
    __device__ __forceinline__ const char* a_ptr(const Unit& u) const { return (const char*)A; }
    __device__ __forceinline__ const char* b_ptr(const Unit& u) const { return (const char*)(Bt + ((size_t)u.e * N + (size_t)u.pn * 256) * D); }
};

struct EpiQKV {
    bf16_t *Q, *Kb, *Vb; const float *qg, *kg, *cosT, *sinT;
    __device__ __forceinline__ void operator()(const f32x4 (&acc)[2][2][4][2], const Unit& uu, int wr, int wc, int fr, int fq) const {
        const int pm = uu.pm, pn = uu.pn;
        const int kind = pn < 4 ? 0 : (pn == 4 ? 1 : 2);
        const float* gain = kind == 0 ? qg : kg;
        f32x4 gv[2][2];
#pragma unroll
        for (int bj = 0; bj < 2; ++bj)
#pragma unroll
            for (int n = 0; n < 2; ++n) gv[bj][n] = *(const f32x4*)(gain + 32 * bj + 16 * n + 4 * fq);
#pragma unroll
        for (int ai = 0; ai < 2; ++ai)
#pragma unroll
            for (int m = 0; m < 4; ++m) {
                const int r = pm * 256 + ai * 128 + wr * 64 + m * 16 + fr;
                const bool lat = r < NLAT;
                const int b = lat ? (r >> 11) : ((r - NLAT) >> 8);
                const int pos = lat ? (r & (SEQ - 1)) : (SEQ + ((r - NLAT) & (CL - 1)));
                f32x4 v[2][2];
#pragma unroll
                for (int bj = 0; bj < 2; ++bj)
#pragma unroll
                    for (int n = 0; n < 2; ++n) v[bj][n] = acc[ai][bj][m][n];
                if (kind != 2) {
                    float ss = 0.f;
#pragma unroll
                    for (int bj = 0; bj < 2; ++bj)
#pragma unroll
                        for (int n = 0; n < 2; ++n) ss += (v[bj][n][0] * v[bj][n][0] + v[bj][n][1] * v[bj][n][1]) + (v[bj][n][2] * v[bj][n][2] + v[bj][n][3] * v[bj][n][3]);
                    ss += __shfl_xor(ss, 16); ss += __shfl_xor(ss, 32);
                    const float rinv = 1.0f / sqrtf(ss * (1.0f / 64.0f) + EPS);
#pragma unroll
                    for (int bj = 0; bj < 2; ++bj)
#pragma unroll
                        for (int n = 0; n < 2; ++n) v[bj][n] = v[bj][n] * rinv * gv[bj][n];
                    if (lat) {
#pragma unroll
                        for (int bj = 0; bj < 2; ++bj) {
                            const f32x4 cs = *(const f32x4*)(cosT + pos * 32 + bj * 16 + 4 * fq), sn = *(const f32x4*)(sinT + pos * 32 + bj * 16 + 4 * fq);
                            const f32x4 x1 = v[bj][0], x2 = v[bj][1];
                            v[bj][0] = x1 * cs - x2 * sn; v[bj][1] = x2 * cs + x1 * sn;
                        }
                    }
                    if (kind == 0) {
#pragma unroll
                        for (int bj = 0; bj < 2; ++bj)
#pragma unroll
                            for (int n = 0; n < 2; ++n) v[bj][n] = v[bj][n] * C2;
                    }
                }
                bf16_t* dst = kind == 0 ? Q + (size_t)r * D + pn * 256 + wc * 64
                                        : (kind == 1 ? Kb : Vb) + ((size_t)b * KVL + pos) * 256 + wc * 64;
#pragma unroll
                for (int bj = 0; bj < 2; ++bj) { u32x4 w; w.x = pk2(v[bj][0][0], v[bj][0][1]); w.y = pk2(v[bj][0][2], v[bj][0][3]); w.z = pk2(v[bj][1][0], v[bj][1][1]); w.w = pk2(v[bj][1][2], v[bj][1][3]);
                    *(u32x4*)(dst + 32 * bj + 8 * fq) = w; }
            }
    }
};
struct EpiBiasBf16 {
    bf16_t* O; int ldc; const float* bias0; int estride;
    __device__ __forceinline__ void operator()(const f32x4 (&acc)[2][2][4][2], const Unit& uu, int wr, int wc, int fr, int fq) const {
        const int row0 = uu.pm * 256, col0t = uu.pn * 256;
#pragma unroll
        for (int bj = 0; bj < 2; ++bj) {
            const int c = col0t + bj * 128 + wc * 32 + 8 * fq;
            const float* bp = bias0 + (size_t)uu.e * estride + c; const f32x4 b0 = *(const f32x4*)bp, b1 = *(const f32x4*)(bp + 4);
#pragma unroll
            for (int ai = 0; ai < 2; ++ai)
#pragma unroll
                for (int m = 0; m < 4; ++m) { const int r = row0 + ai * 128 + wr * 64 + m * 16 + fr; const f32x4 v0 = acc[ai][bj][m][0] + b0, v1 = acc[ai][bj][m][1] + b1;
                    u32x4 w; w.x = pk2(v0[0], v0[1]); w.y = pk2(v0[2], v0[3]); w.z = pk2(v1[0], v1[1]); w.w = pk2(v1[2], v1[3]); *(u32x4*)(O + (size_t)r * ldc + c) = w; }
        }
    }
};
struct EpiRowBiasBf16 {
    bf16_t* O; int ldc; const float* bias;
    __device__ __forceinline__ void operator()(const f32x4 (&acc)[2][2][4][2], const Unit& uu, int wr, int wc, int fr, int fq) const {
        const int row0 = uu.pm * 256, col0t = uu.pn * 256;
#pragma unroll
        for (int ai = 0; ai < 2; ++ai)
#pragma unroll
            for (int m = 0; m < 4; ++m) { const int r = row0 + ai * 128 + wr * 64 + m * 16 + fr; const float bv = bias[r]; bf16_t* op = O + (size_t)r * ldc + col0t + wc * 32 + 8 * fq;
#pragma unroll
                for (int bj = 0; bj < 2; ++bj) { const f32x4 v0 = acc[ai][bj][m][0] + bv, v1 = acc[ai][bj][m][1] + bv;
                    u32x4 w; w.x = pk2(v0[0], v0[1]); w.y = pk2(v0[2], v0[3]); w.z = pk2(v1[0], v1[1]); w.w = pk2(v1[2], v1[3]); *(u32x4*)(op + bj * 128) = w; } }
    }
};
template <bool SRC32> struct EpiResid {
    const float *srcL, *srcC; bf16_t* XB; const float* gate  ; const float* bias;
    __device__ __forceinline__ void operator()(f32x4 (&acc)[2][2][4][2], const Unit& uu, int wr, int wc, int fr, int fq) const {
        const int row0 = uu.pm * 256, col0t = uu.pn * 256;
        const float* gp0 = gate + (size_t)mod_row(row0) * MODW;
        const float* sb = row0 < NLAT ? srcL + (size_t)row0 * D : srcC + (size_t)(row0 - NLAT) * D;
        bf16_t* xb = XB + (size_t)row0 * D;
#pragma unroll
        for (int bj = 0; bj < 2; ++bj) {
            const int c = col0t + bj * 128 + wc * 32 + 8 * fq;
            const f32x4 g0 = *(const f32x4*)(gp0 + c), g1 = *(const f32x4*)(gp0 + c + 4);
            f32x4 b0 = (f32x4){0.f, 0.f, 0.f, 0.f}, b1 = b0; if (bias) { b0 = *(const f32x4*)(bias + c); b1 = *(const f32x4*)(bias + c + 4); }
#pragma unroll
            for (int ai = 0; ai < 2; ++ai) {
                f32x4 x0[4], x1[4];
#pragma unroll
                for (int m = 0; m < 4; ++m) { const size_t ro = (size_t)(ai * 128 + wr * 64 + m * 16 + fr) * D + c;
                    if constexpr (SRC32) { x0[m] = *(const f32x4*)(sb + ro); x1[m] = *(const f32x4*)(sb + ro + 4); }
                    else { const u32x4 w = *(const u32x4*)(xb + ro); x0[m] = (f32x4){bflo(w.x), bfhi(w.x), bflo(w.y), bfhi(w.y)}; x1[m] = (f32x4){bflo(w.z), bfhi(w.z), bflo(w.w), bfhi(w.w)}; } }
#pragma unroll
                for (int m = 0; m < 4; ++m) { const size_t ro = (size_t)(ai * 128 + wr * 64 + m * 16 + fr) * D + c;
                    const f32x4 y0 = x0[m] + g0 * (acc[ai][bj][m][0] + b0), y1 = x1[m] + g1 * (acc[ai][bj][m][1] + b1);
                    u32x4 w; w.x = pk2(y0[0], y0[1]); w.y = pk2(y0[2], y0[3]); w.z = pk2(y1[0], y1[1]); w.w = pk2(y1[2], y1[3]); *(u32x4*)(xb + ro) = w; }
                asm volatile("" ::: "memory");
            }
        }
    }
};
struct EpiSwiglu {
    bf16_t* O; const float* bgu0  ;
    __device__ __forceinline__ void operator()(const f32x4 (&acc)[2][2][4][2], const Unit& uu, int wr, int wc, int fr, int fq) const {
        const int row0 = uu.pm * 256, pn = uu.pn; const float* bgu = bgu0 + (size_t)uu.e * NGU;
        const int f = pn * 128 + wc * 32 + 8 * fq;
        f32x4 bg[2], bu[2];
#pragma unroll
        for (int n = 0; n < 2; ++n) { const f32x4 q0 = *(const f32x4*)(bgu + 2 * (f + 4 * n)), q1 = *(const f32x4*)(bgu + 2 * (f + 4 * n) + 4);
            bg[n] = (f32x4){q0[0], q0[2], q1[0], q1[2]}; bu[n] = (f32x4){q0[1], q0[3], q1[1], q1[3]}; }
#pragma unroll
        for (int ai = 0; ai < 2; ++ai)
#pragma unroll
            for (int m = 0; m < 4; ++m) { const int r = row0 + ai * 128 + wr * 64 + m * 16 + fr; float o[8];
#pragma unroll
                for (int n = 0; n < 2; ++n) { const f32x4 gg = acc[ai][0][m][n] + bg[n], uq = acc[ai][1][m][n] + bu[n];
#pragma unroll
                    for (int p = 0; p < 2; ++p) {
                        f32x2 g2 = {fminf(gg[2 * p], 7.0f), fminf(gg[2 * p + 1], 7.0f)};
                        f32x2 u2 = {__builtin_amdgcn_fmed3f(uq[2 * p], -7.0f, 7.0f), __builtin_amdgcn_fmed3f(uq[2 * p + 1], -7.0f, 7.0f)};
                        const f32x2 z = g2 * (-2.4554669595930157f);
                        f32x2 e2 = {__builtin_amdgcn_exp2f(z.x), __builtin_amdgcn_exp2f(z.y)};
                        e2 = e2 + 1.0f;
                        const f32x2 r2 = {__builtin_amdgcn_rcpf(e2.x), __builtin_amdgcn_rcpf(e2.y)};
                        const f32x2 o2 = ((u2 + 1.0f) * g2) * r2;
                        o[4 * n + 2 * p] = o2.x; o[4 * n + 2 * p + 1] = o2.y; } }
                u32x4 w; w.x = pk2(o[0], o[1]); w.y = pk2(o[2], o[3]); w.z = pk2(o[4], o[5]); w.w = pk2(o[6], o[7]); *(u32x4*)(O + (size_t)r * D + f) = w; }
    }
};

__device__ __forceinline__ int slot32(int cg) { return (((cg >> 2) & 1) << 4) + ((cg >> 3) << 2) + (cg & 3); }
template <int MODE> __device__ __forceinline__ int wrow_map(int n) {
    if (MODE == 3) return n;
    if (MODE == 0) return (n & ~31) + slot32(n & 31);
    if (MODE == 1) { const int pn = n >> 8, wc = (n >> 6) & 3, bj = (n >> 5) & 1, j = n & 31;
        return (pn << 8) + (bj << 7) + (wc << 5) + (pn < 5 ? j : slot32(j)); }
    { const int f = n >> 1, pn = f >> 7, fo = f & 127; return (pn << 8) + ((n & 1) << 7) + (fo & ~31) + slot32(fo & 31); }
}
template <int MODE> __device__ __forceinline__ void transpose_item(const float* W, int N, bf16_t* WT, LAS float* scr, int item, int lane) {
    constexpr int K = D;
    const int nblk = N / 32, kb = item / nblk, nb = item % nblk, k0 = 64 * kb, n0 = 32 * nb;
#pragma unroll 8
    for (int i = 0; i < 32; ++i) { const int kk = 2 * i + (lane >> 5); scr[kk * 33 + (lane & 31)] = __builtin_nontemporal_load(W + (size_t)(k0 + kk) * N + n0 + (lane & 31)); }
    LDS_WAIT(); asm volatile("" ::: "memory");
    const int c = lane & 7;
#pragma unroll
    for (int j = 0; j < 4; ++j) { const int n = (lane >> 3) + 8 * j; const LAS float* s = scr + (8 * c) * 33 + n;
        u32x4 o; o.x = pk2(s[0 * 33], s[1 * 33]); o.y = pk2(s[2 * 33], s[3 * 33]); o.z = pk2(s[4 * 33], s[5 * 33]); o.w = pk2(s[6 * 33], s[7 * 33]);
        __builtin_nontemporal_store(o, (u32x4*)(WT + (size_t)wrow_map<MODE>(n0 + n) * K + k0 + 8 * c)); }
    LDS_WAIT(); asm volatile("" ::: "memory");
}

__device__ __forceinline__ void norm_mod_store(const f32x4 (&v)[4], const f32x4 (&gs)[4], const f32x4 (&sh)[4], bf16_t* dst, int lane, f32x4 (&h)[4]) {
    float ss = 0.f;
#pragma unroll
    for (int j = 0; j < 4; ++j) ss += (v[j][0] * v[j][0] + v[j][1] * v[j][1]) + (v[j][2] * v[j][2] + v[j][3] * v[j][3]);
    ss = wave_sum(ss);
    const float rinv = __builtin_amdgcn_rsqf(ss * (1.0f / D) + EPS);
#pragma unroll
    for (int j = 0; j < 4; ++j) {
        h[j] = (v[j] * rinv) * gs[j] + sh[j];
        u32x2 w; w.x = pk2(h[j][0], h[j][1]); w.y = pk2(h[j][2], h[j][3]);
        ((u32x2*)dst)[lane + 64 * j] = w;
    }
}
__device__ __forceinline__ void load_vec_bf(const bf16_t* p, int lane, f32x4 (&v)[4]) {
#pragma unroll
    for (int j = 0; j < 4; ++j) { const u32x2 w = ((const u32x2*)p)[lane + 64 * j]; v[j] = (f32x4){bflo(w.x), bfhi(w.x), bflo(w.y), bfhi(w.y)}; }
}
__device__ __forceinline__ void load_vec(const float* p, int lane, f32x4 (&v)[4]) {
#pragma unroll
    for (int j = 0; j < 4; ++j) v[j] = ((const f32x4*)p)[lane + 64 * j];
}


namespace attn_body {
using bf16=__hip_bfloat16;
using bf16x8=__attribute__((ext_vector_type(8)))short;
using s16x4=__attribute__((ext_vector_type(4)))short;
using f32x16=__attribute__((ext_vector_type(16)))float;
using u32x4=__attribute__((ext_vector_type(4)))unsigned;
constexpr int D=64,DM=1024,KVP=256;
constexpr int NW=8,QBLK=32,QB=QBLK*NW,KVBLK=64;
__device__ __forceinline__ int crow(int r,int hi){return (r&3)+8*(r>>2)+4*hi;}
#define SBAR() __builtin_amdgcn_sched_barrier(0)
__device__ __forceinline__ void cmask(f32x16&p0,f32x16&p1,int jb,int qrel,int hi){
  const float NEG=-INFINITY; int kb=64*jb+4*hi;
  #pragma unroll
  for(int r=0;r<16;++r){int kv=kb+(r&3)+8*(r>>2); if(kv>qrel)p0[r]=NEG; if(kv+32>qrel)p1[r]=NEG;}
}

constexpr int NSLOT=3, SLOTB=8192;
constexpr int LDS_K=0, LDS_V=NSLOT*SLOTB, LDS_WS=2*NSLOT*SLOTB, LDS_OST=LDS_WS+NW*64*4, LDS_BYTES=LDS_OST+NW*4096;
constexpr float C2=0.125f*1.4426950408889634f;
__device__ __forceinline__ void glds16(const void*gsrc,unsigned lds_dst){unsigned keep;
  asm volatile("s_mov_b32 %0, m0\n\ts_mov_b32 m0, %2\n\ts_nop 0\n\tglobal_load_lds_dwordx4 %1, off\n\ts_mov_b32 m0, %0":"=&s"(keep):"v"(gsrc),"s"(lds_dst):"memory");}
__device__ __forceinline__ float max3f(float a,float b,float c){float r;asm("v_max3_f32 %0, %1, %2, %3":"=v"(r):"v"(a),"v"(b),"v"(c));return r;}
__device__ __forceinline__ float max2f(float a,float b){float r;asm("v_max_f32_e32 %0, %1, %2":"=v"(r):"v"(a),"v"(b));return r;}
__device__ __forceinline__ float fadd_s(float a,float b){float r;asm("v_add_f32_e32 %0, %1, %2":"=v"(r):"v"(a),"v"(b));return r;}
__device__ __forceinline__ float fsub_s(float a,float b){float r;asm("v_sub_f32_e32 %0, %1, %2":"=v"(r):"v"(a),"v"(b));return r;}
typedef float f32x2_t __attribute__((ext_vector_type(2))); typedef __bf16 bf16x2_t __attribute__((ext_vector_type(2)));
__device__ __forceinline__ unsigned cvtpk_s(float lo,float hi){f32x2_t v={lo,hi};bf16x2_t b=__builtin_convertvector(v,bf16x2_t);return __builtin_bit_cast(unsigned,b);}
#define WAIT_BAR(N) asm volatile("s_waitcnt vmcnt(" #N ") lgkmcnt(0)\n\ts_barrier":::"memory")

__device__ __forceinline__ void qkt(f32x16&p0,f32x16&p1,const char*Kslot,const bf16x8*qr,const f32x16&negm,int r32,int hi){
  const char*kb=Kslot+hi*1024+r32*16;
  #pragma unroll
  for(int d0=0;d0<4;++d0){
    const bf16x8 b0=*reinterpret_cast<const bf16x8*>(kb+d0*2048);
    const bf16x8 b1=*reinterpret_cast<const bf16x8*>(kb+d0*2048+512);
    if(d0==0){p0=__builtin_amdgcn_mfma_f32_32x32x16_bf16(b0,qr[0],negm,0,0,0);p1=__builtin_amdgcn_mfma_f32_32x32x16_bf16(b1,qr[0],negm,0,0,0);}
    else{p0=__builtin_amdgcn_mfma_f32_32x32x16_bf16(b0,qr[d0],p0,0,0,0);p1=__builtin_amdgcn_mfma_f32_32x32x16_bf16(b1,qr[d0],p1,0,0,0);}}
}
typedef __attribute__((address_space(3))) const char* lds_cptr;
typedef short v4i16_t __attribute__((ext_vector_type(4)));
__device__ __forceinline__ void kload8(bf16x8*kf,lds_cptr kp){
  kf[0]=*(const __attribute__((address_space(3))) bf16x8*)(kp);      kf[1]=*(const __attribute__((address_space(3))) bf16x8*)(kp+512);
  kf[2]=*(const __attribute__((address_space(3))) bf16x8*)(kp+2048); kf[3]=*(const __attribute__((address_space(3))) bf16x8*)(kp+2560);
  kf[4]=*(const __attribute__((address_space(3))) bf16x8*)(kp+4096); kf[5]=*(const __attribute__((address_space(3))) bf16x8*)(kp+4608);
  kf[6]=*(const __attribute__((address_space(3))) bf16x8*)(kp+6144); kf[7]=*(const __attribute__((address_space(3))) bf16x8*)(kp+6656);
}
__device__ __forceinline__ void kload2(bf16x8*kf,lds_cptr kp,int j){ kf[2*j]=*(const __attribute__((address_space(3))) bf16x8*)(kp+j*2048); kf[2*j+1]=*(const __attribute__((address_space(3))) bf16x8*)(kp+j*2048+512); }
__device__ __forceinline__ s16x4 vtr(lds_cptr p){ return __builtin_bit_cast(s16x4,__builtin_amdgcn_ds_read_tr16_b64_v4i16((__attribute__((address_space(3))) v4i16_t*)p)); }
__device__ __forceinline__ float rowmax(const f32x16&p0,const f32x16&p1){
  float a=max3f(p0[0],p0[1],p1[0]),b=max3f(p0[2],p0[3],p1[1]);a=max3f(a,p1[2],p1[3]);
  #pragma unroll
  for(int r=4;r<16;r+=4){a=max3f(a,p0[r],p0[r+1]);b=max3f(b,p0[r+2],p0[r+3]);a=max3f(a,p1[r],p1[r+1]);b=max3f(b,p1[r+2],p1[r+3]);}
  const float m=max2f(a,b);
  auto rr=__builtin_amdgcn_permlane32_swap(__float_as_uint(m),__float_as_uint(m),false,false);
  return max2f(__uint_as_float(rr[0]),__uint_as_float(rr[1]));
}
__device__ __forceinline__ void pv(f32x16*o,int vb,bf16x8 pa0,bf16x8 pa1,bf16x8 pa2,bf16x8 pa3){
  #pragma unroll
  for(int d0=0;d0<2;++d0){s16x4 lo[4],hi[4];
    #pragma unroll
    for(int ks=0;ks<4;++ks){
      asm volatile("ds_read_b64_tr_b16 %0,%1 offset:%c2":"=&v"(lo[ks]):"v"(vb),"i"(d0*4096+ks*1024):"memory");
      asm volatile("ds_read_b64_tr_b16 %0,%1 offset:%c2":"=&v"(hi[ks]):"v"(vb),"i"(d0*4096+ks*1024+512):"memory");}
    asm volatile("s_waitcnt lgkmcnt(0)":::"memory");SBAR();
    #define PK(k) (bf16x8){lo[k][0],lo[k][1],lo[k][2],lo[k][3],hi[k][0],hi[k][1],hi[k][2],hi[k][3]}
    o[d0]=__builtin_amdgcn_mfma_f32_32x32x16_bf16(pa0,PK(0),o[d0],0,0,0);
    o[d0]=__builtin_amdgcn_mfma_f32_32x32x16_bf16(pa1,PK(1),o[d0],0,0,0);
    o[d0]=__builtin_amdgcn_mfma_f32_32x32x16_bf16(pa2,PK(2),o[d0],0,0,0);
    o[d0]=__builtin_amdgcn_mfma_f32_32x32x16_bf16(pa3,PK(3),o[d0],0,0,0);
    #undef PK
  }
}

#ifndef ATTN_STORE16
#define ATTN_STORE16(p,v) (*(u32x4*)(p)=(v))
#endif
template<int THRL> __device__ __forceinline__ void attn_unit(const bf16*Qu,const bf16*__restrict__ Kh,const bf16*__restrict__ Vh,bf16*Ou,const int NT,char*shm){
  const int tid=threadIdx.x,lane=tid&63,r32=lane&31,hi=lane>>5; const int wid=__builtin_amdgcn_readfirstlane(tid>>6);
  const bf16*Qw=Qu+(long)(wid*QBLK)*DM;
  const unsigned lds0=(unsigned)(uintptr_t)shm;
  float*wsf=(float*)(shm+LDS_WS)+wid*64;
  const bf16*ksrc=Kh+(long)lane*KVP+wid*8;
  const bf16*vsrc=Vh+(long)(16*(wid&3)+(lane>>2))*KVP+(wid>>2)*32+(lane&3)*8;
  const unsigned kdst=lds0+LDS_K+wid*1024, vdst=lds0+LDS_V+wid*1024;
  #define DMA_K(t,slot) glds16(ksrc+(long)(t)*KVBLK*KVP,(unsigned)__builtin_amdgcn_readfirstlane(kdst+(slot)))
  #define DMA_V(t,slot) glds16(vsrc+(long)(t)*KVBLK*KVP,(unsigned)__builtin_amdgcn_readfirstlane(vdst+(slot)))
  const int vb0=(int)(lds0+LDS_V)+((lane>>4)&1)*32+(lane&3)*8+(4*hi+((lane&15)>>2))*64;
  const char*Kbase=shm+LDS_K; bf16x8 kf[8];
  const lds_cptr shm3=(lds_cptr)shm; const lds_cptr kp0=shm3+LDS_K+hi*1024+r32*16; const lds_cptr vp0=shm3+LDS_V+((lane>>4)&1)*32+(lane&3)*8+(4*hi+((lane&15)>>2))*64;
  DMA_K(0,0);DMA_V(0,0);DMA_K(1,SLOTB);
  bf16x8 qr[4];
  #pragma unroll
  for(int d0=0;d0<4;++d0)qr[d0]=*reinterpret_cast<const bf16x8*>(&Qw[(long)r32*DM+d0*16+hi*8]);
  float mhat=0.f,l_reg=0.f;f32x16 o[2];o[0]=f32x16{};o[1]=f32x16{};f32x16 negm=f32x16{};asm volatile("":"+v"(negm));
  #define CMASK(P0,P1,t) do{}while(0)
  bool resc=false;
  #define START(P0,P1) do{ const float rm=rowmax(P0,P1); resc=false; \
    { const float dl=rm; mhat=fadd_s(mhat,dl); \
      _Pragma("unroll") for(int r=0;r<16;++r){P0[r]=fsub_s(P0[r],dl);P1[r]=fsub_s(P1[r],dl);} \
      _Pragma("unroll") for(int r=0;r<16;++r)negm[r]=-mhat; asm volatile("":"+v"(negm)); } \
    _Pragma("unroll") for(int r=0;r<16;++r)P0[r]=__builtin_amdgcn_exp2f(P0[r]); }while(0)
  #define RESC() do{ if(resc){ asm volatile("s_waitcnt lgkmcnt(0)":::"memory"); \
      _Pragma("unroll") for(int d_=0;d_<2;++d_) _Pragma("unroll") for(int r=0;r<16;++r)o[d_][r]*=wsf[crow(r,hi)]; } }while(0)
  f32x16 pA0,pA1,pB0,pB1;
  int sl_prev=0,sl_cur=0,sl_next=SLOTB;
  #define ROT() do{sl_prev=sl_cur;sl_cur=sl_next;sl_next=(sl_next==(NSLOT-1)*SLOTB)?0:sl_next+SLOTB;}while(0)
  DMA_K(2,2*SLOTB);
  WAIT_BAR(3);
  qkt(pA0,pA1,Kbase,qr,negm,r32,hi);asm volatile("s_nop 15\n\ts_nop 7":"+v"(pA0),"+v"(pA1));CMASK(pA0,pA1,0);
  START(pA0,pA1);
  _Pragma("unroll") for(int r=0;r<16;++r)pA1[r]=__builtin_amdgcn_exp2f(pA1[r]);
  WAIT_BAR(0);
  DMA_K(3,0);DMA_V(1,SLOTB);
  ROT();
  kload8(kf,kp0+sl_cur);
  WAIT_BAR(2);
  s16x4 vlo[8],vhi[8]; u32x4 pw0,pw1,pw2,pw3;
  #define PKW(P,B) cvtpk_s(P[B],P[B+1])
  #define PAF(k) __builtin_bit_cast(bf16x8,pw##k)
  #define VFR(i) (bf16x8){vlo[i][0],vlo[i][1],vlo[i][2],vlo[i][3],vhi[i][0],vhi[i][1],vhi[i][2],vhi[i][3]}
  #define PIN(x) asm volatile("":"+v"(x))
  #define MX3(a,b,c) __builtin_fmaxf(__builtin_fmaxf((a),(b)),(c))
  #define GAPA(MF,A0,A1,A2,A3,W0,W1,PW) do{ MF; sacc+=A0; sacc+=A1; sacc+=A2; sacc+=A3; PIN(sacc); W0; W1; PIN(PW); SBAR(); }while(0)
  #define EX(v) __builtin_amdgcn_exp2f(v)
  #define GAPB(MF,X,B) do{ MF; X[B]=EX(X[B]); X[B+1]=EX(X[B+1]); X[B+2]=EX(X[B+2]); X[B+3]=EX(X[B+3]); PIN(X); SBAR(); }while(0)
  #define VRD(i) do{ vlo[i]=vtr(vp_+(((i)>>2)*4096+((i)&3)*1024)); vhi[i]=vtr(vp_+(((i)>>2)*4096+((i)&3)*1024+512)); }while(0)
  #define KRD(G,j) do{ if(G){ kload2(kf,kp0+sl_next,j); SBAR(); } }while(0)
  #define STEP(C0,C1,P0,P1,t,GK,GV,GL) do{ SBAR(); \
    const lds_cptr vp_=vp0+sl_prev; \
    VRD(0); SBAR(); float sacc=(P0[0]+P0[1]); \
    GAPA(C0=__builtin_amdgcn_mfma_f32_32x32x16_bf16(kf[0],qr[0],negm,0,0,0), P0[2],P0[3],P0[4],P0[5],     pw0[0]=PKW(P0,0), pw0[1]=PKW(P0,2), pw0); \
    VRD(4); SBAR(); GAPA(C1=__builtin_amdgcn_mfma_f32_32x32x16_bf16(kf[1],qr[0],negm,0,0,0), P0[6],P0[7],P0[8],P0[9],     pw0[2]=PKW(P0,4), pw0[3]=PKW(P0,6), pw0); \
    VRD(1); SBAR(); GAPA(C0=__builtin_amdgcn_mfma_f32_32x32x16_bf16(kf[2],qr[1],C0,0,0,0),   P0[10],P0[11],P0[12],P0[13], pw1[0]=PKW(P0,8), pw1[1]=PKW(P0,10), pw1); \
    VRD(5); SBAR(); GAPA(C1=__builtin_amdgcn_mfma_f32_32x32x16_bf16(kf[3],qr[1],C1,0,0,0),   P0[14],P0[15],P1[0],P1[1],   pw1[2]=PKW(P0,12),pw1[3]=PKW(P0,14), pw1); \
    VRD(2); SBAR(); GAPA(C0=__builtin_amdgcn_mfma_f32_32x32x16_bf16(kf[4],qr[2],C0,0,0,0),   P1[2],P1[3],P1[4],P1[5],     pw2[0]=PKW(P1,0), pw2[1]=PKW(P1,2), pw2); \
    VRD(6); SBAR(); GAPA(C1=__builtin_amdgcn_mfma_f32_32x32x16_bf16(kf[5],qr[2],C1,0,0,0),   P1[6],P1[7],P1[8],P1[9],     pw2[2]=PKW(P1,4), pw2[3]=PKW(P1,6), pw2); \
    VRD(3); SBAR(); GAPA(C0=__builtin_amdgcn_mfma_f32_32x32x16_bf16(kf[6],qr[3],C0,0,0,0),   P1[10],P1[11],P1[12],P1[13], pw3[0]=PKW(P1,8), pw3[1]=PKW(P1,10), pw3); \
    VRD(7); SBAR(); GAPA(C1=__builtin_amdgcn_mfma_f32_32x32x16_bf16(kf[7],qr[3],C1,0,0,0),   P1[14],P1[15],0.f,0.f,       pw3[2]=PKW(P1,12),pw3[3]=PKW(P1,14), pw3); \
    l_reg+=sacc; \
    if(GK){DMA_K((t)+3,sl_cur);} if(GV){DMA_V((t)+1,sl_next);} \
    CMASK(C0,C1,t); \
    { float a=MX3(C0[0],C0[1],C1[0]),b=MX3(C0[2],C0[3],C1[1]); a=MX3(a,C1[2],C1[3]); \
      _Pragma("unroll") for(int r=4;r<16;r+=4){a=MX3(a,C0[r],C0[r+1]);b=MX3(b,C0[r+2],C0[r+3]);a=MX3(a,C1[r],C1[r+1]);b=MX3(b,C1[r+2],C1[r+3]);} \
      float rm=__builtin_fmaxf(a,b); { auto rr=__builtin_amdgcn_permlane32_swap(__float_as_uint(rm),__float_as_uint(rm),false,false); rm=__builtin_fmaxf(__uint_as_float(rr[0]),__uint_as_float(rr[1])); } \
      resc=false; \
      if(__builtin_expect(__any(rm>(float)THRL),0)){ const float dl=__builtin_fmaxf(rm,0.f); mhat+=dl; \
        _Pragma("unroll") for(int r=0;r<16;++r){C0[r]-=dl;C1[r]-=dl;} \
        _Pragma("unroll") for(int r=0;r<16;++r)negm[r]=-mhat; asm volatile("":"+v"(negm)); \
        const float f=__builtin_amdgcn_exp2f(-dl); l_reg*=f; if(hi==0)wsf[r32]=f; resc=true; } } \
    SBAR(); \
    GAPB(o[0]=__builtin_amdgcn_mfma_f32_32x32x16_bf16(PAF(0),VFR(0),o[0],0,0,0), C0,0); \
    GAPB(o[1]=__builtin_amdgcn_mfma_f32_32x32x16_bf16(PAF(0),VFR(4),o[1],0,0,0), C0,4); \
    KRD(GL,0); GAPB(o[0]=__builtin_amdgcn_mfma_f32_32x32x16_bf16(PAF(1),VFR(1),o[0],0,0,0), C0,8); \
    KRD(GL,1); GAPB(o[1]=__builtin_amdgcn_mfma_f32_32x32x16_bf16(PAF(1),VFR(5),o[1],0,0,0), C0,12); \
    KRD(GL,2); GAPB(o[0]=__builtin_amdgcn_mfma_f32_32x32x16_bf16(PAF(2),VFR(2),o[0],0,0,0), C1,0); \
    KRD(GL,3); GAPB(o[1]=__builtin_amdgcn_mfma_f32_32x32x16_bf16(PAF(2),VFR(6),o[1],0,0,0), C1,4); \
    GAPB(o[0]=__builtin_amdgcn_mfma_f32_32x32x16_bf16(PAF(3),VFR(3),o[0],0,0,0), C1,8); \
    GAPB(o[1]=__builtin_amdgcn_mfma_f32_32x32x16_bf16(PAF(3),VFR(7),o[1],0,0,0), C1,12); \
    }while(0)
  int t=1;
  #undef CMASK
  #define CMASK(P0,P1,t) do{}while(0)
  for(;t+5<NT;t+=2){
    STEP(pB0,pB1,pA0,pA1,t,true,true,true);     WAIT_BAR(2); RESC(); ROT();
    STEP(pA0,pA1,pB0,pB1,t+1,true,true,true);   WAIT_BAR(2); RESC(); ROT();
  }
  #undef CMASK
  #define CMASK(P0,P1,t) do{}while(0)
  #define ENDW(tt) do{ if((tt)+3<NT){WAIT_BAR(2);} else if((tt)+2<NT){WAIT_BAR(1);} else {WAIT_BAR(0);} }while(0)
  for(;t+1<NT;t+=2){
    STEP(pB0,pB1,pA0,pA1,t,(t+3<NT),(t+1<NT),(t+1<NT));       ENDW(t);   RESC(); ROT();
    STEP(pA0,pA1,pB0,pB1,t+1,(t+4<NT),(t+2<NT),(t+2<NT));     ENDW(t+1); RESC(); ROT();
  }
  STEP(pB0,pB1,pA0,pA1,NT-1,false,false,false); RESC();
  { float sacc=pB0[0]+pB0[1]; _Pragma("unroll") for(int r=2;r<16;++r)sacc+=pB0[r]; _Pragma("unroll") for(int r=0;r<16;++r)sacc+=pB1[r]; l_reg+=sacc;
    pw0=(u32x4){PKW(pB0,0),PKW(pB0,2),PKW(pB0,4),PKW(pB0,6)};pw1=(u32x4){PKW(pB0,8),PKW(pB0,10),PKW(pB0,12),PKW(pB0,14)};pw2=(u32x4){PKW(pB1,0),PKW(pB1,2),PKW(pB1,4),PKW(pB1,6)};pw3=(u32x4){PKW(pB1,8),PKW(pB1,10),PKW(pB1,12),PKW(pB1,14)};
    SBAR(); pv(o,vb0+sl_cur,PAF(0),PAF(1),PAF(2),PAF(3)); }
  #undef PKW
  #undef PAF
  #undef VFR
  #undef PIN
  #undef MX3
  #undef GAPA
  #undef GAPB
  #undef EX
  #undef VRD
  #undef KRD
  #undef STEP
  #undef ENDW
  {auto rr=__builtin_amdgcn_permlane32_swap(__float_as_uint(l_reg),__float_as_uint(l_reg),false,false);l_reg=__uint_as_float(rr[0])+__uint_as_float(rr[1]);}
  if(hi==0)wsf[32+r32]=l_reg;asm volatile("s_waitcnt lgkmcnt(0)":::"memory");
  float rli[16];
  #pragma unroll
  for(int r=0;r<16;++r)rli[r]=__builtin_amdgcn_rcpf(wsf[32+crow(r,hi)]);
  bf16*Ow=Ou+(long)(wid*QBLK)*DM;
  { bf16*stg=(bf16*)(shm+LDS_OST)+wid*2048;
    #pragma unroll
    for(int r=0;r<16;++r){const int orow=crow(r,hi);
      #pragma unroll
      for(int d0=0;d0<2;++d0)stg[orow*64+d0*32+r32]=__float2bfloat16(o[d0][r]*rli[r]);}
    asm volatile("s_waitcnt lgkmcnt(0)":::"memory");
    #pragma unroll
    for(int i=0;i<4;++i){const int row=i*8+(lane>>3),ch=lane&7; const u32x4 v=*(const u32x4*)(stg+row*64+ch*8); ATTN_STORE16(Ow+(long)row*DM+ch*8,v);} }
  asm volatile("s_waitcnt lgkmcnt(0)\n\ts_barrier":::"memory");
  #undef DMA_K
  #undef DMA_V
  #undef CMASK
  #undef START
  #undef RESC
  #undef ROT
}
constexpr int ATTN_LDS_BYTES=LDS_BYTES;
#undef SBAR
#undef WAIT_BAR
}

template <int LF> struct ConvRegs { static constexpr int P = 2 * LF + 8, NFC = P * 2 / 16  , NF = (NFC + NTHR - 1) / NTHR, NW = NB * (LF / 8) / NTHR; u32x4 f[NF]; u32x4 fp[NF]; u32x4 x1[NW]; u32x4 v[NW]; };
template <int LF>
__device__ __forceinline__ void conv_issue(ConvRegs<LF>& R, const bf16_t* FIc, const bf16_t* x1src, const bf16_t* vsrc, int tid) {
    const u32x4* fs = (const u32x4*)FIc;
#pragma unroll
    for (int k = 0; k < ConvRegs<LF>::NF; ++k) { const int i = tid + k * NTHR; const bool ok = i < ConvRegs<LF>::NFC; R.f[k] = ok ? fs[i] : (u32x4){0u, 0u, 0u, 0u}; R.fp[k] = (ok && i > 0) ? fs[i - 1] : (u32x4){0u, 0u, 0u, 0u}; }
#pragma unroll
    for (int k = 0; k < ConvRegs<LF>::NW; ++k) { const int i = tid + k * NTHR; R.x1[k] = *(const u32x4*)(x1src + (size_t)i * 8); R.v[k] = *(const u32x4*)(vsrc + (size_t)i * 8); }
}
__device__ __forceinline__ void unpack8(const u32x4 w, float (&x)[8]) { x[0] = bflo(w.x); x[1] = bfhi(w.x); x[2] = bflo(w.y); x[3] = bfhi(w.y); x[4] = bflo(w.z); x[5] = bfhi(w.z); x[6] = bflo(w.w); x[7] = bfhi(w.w); }
template <int LF>
__device__ __forceinline__ void conv_commit(const ConvRegs<LF>& R, LAS unsigned char* lds, const float (&cw8)[8], int tid, int lane, int wave) {
    constexpr int P = 2 * LF + 8, WSTR = LF + 8, NW = ConvRegs<LF>::NW, CPR = LF / 8;
    LAS unsigned char* FIL = lds; LAS unsigned char* WL = lds + ((8 * P * 2 + 255) & ~255);
    LAS unsigned* EDGE = (LAS unsigned*)(lds + 144 * 1024);
#pragma unroll
    for (int k = 0; k < ConvRegs<LF>::NF; ++k) { const int i = tid + k * NTHR; if (i < ConvRegs<LF>::NFC) {
        const unsigned cat[8] = {R.fp[k].x, R.fp[k].y, R.fp[k].z, R.fp[k].w, R.f[k].x, R.f[k].y, R.f[k].z, R.f[k].w};
#pragma unroll
        for (int c = 0; c < 8; ++c) { constexpr int dummy = 0; (void)dummy; const int q0 = (16 - 2 * c) >> 2; u32x4 o;
            if (c & 1) { o.x = __builtin_amdgcn_alignbyte(cat[q0 + 1], cat[q0], 2); o.y = __builtin_amdgcn_alignbyte(cat[q0 + 2], cat[q0 + 1], 2); o.z = __builtin_amdgcn_alignbyte(cat[q0 + 3], cat[q0 + 2], 2); o.w = __builtin_amdgcn_alignbyte(cat[q0 + 4], cat[q0 + 3], 2); }
            else { o.x = cat[q0]; o.y = cat[q0 + 1]; o.z = cat[q0 + 2]; o.w = cat[q0 + 3]; }
            *(LAS u32x4*)(FIL + c * (P * 2) + 16 * i) = o; } } }
    if (lane == 0 || lane == 63) {
#pragma unroll
        for (int k = 0; k < NW; ++k) EDGE[(wave * NW + k) * 2 + (lane == 63)] = lane == 0 ? ((R.x1[k].x & 0xffffu) | (R.v[k].x << 16)) : ((R.x1[k].w >> 16) | (R.v[k].w & 0xffff0000u)); }
    __syncthreads();
#pragma unroll
    for (int k = 0; k < NW; ++k) { const int i = tid + k * NTHR; const int b = i / CPR, ch = i % CPR;
        float x[8], y[8]; unpack8(R.x1[k], x); unpack8(R.v[k], y);
        float xp = __shfl_up(x[7], 1), yp = __shfl_up(y[7], 1), xn = __shfl_down(x[0], 1), yn = __shfl_down(y[0], 1);
        if (lane == 0 && wave > 0) { const unsigned e = EDGE[((wave - 1) * NW + k) * 2 + 1]; xp = bflo(e); yp = bfhi(e); }
        if (lane == 63 && wave < NWAVES - 1) { const unsigned e = EDGE[((wave + 1) * NW + k) * 2 + 0]; xn = bflo(e); yn = bfhi(e); }
        if (ch == 0) { xp = 0.f; yp = 0.f; } if (ch == CPR - 1) { xn = 0.f; yn = 0.f; }
        float o[8];
#pragma unroll
        for (int j = 0; j < 8; ++j) { const float xa = j == 0 ? xp : x[j - 1], xb = j == 7 ? xn : x[j + 1], ya = j == 0 ? yp : y[j - 1], yb = j == 7 ? yn : y[j + 1];
            const float sx = cw8[3] + cw8[0] * xa + cw8[1] * x[j] + cw8[2] * xb, sy = cw8[7] + cw8[4] * ya + cw8[5] * y[j] + cw8[6] * yb; o[j] = sx * sy; }
        u32x4 w; w.x = pk2(o[0], o[1]); w.y = pk2(o[2], o[3]); w.z = pk2(o[4], o[5]); w.w = pk2(o[6], o[7]);
        *(LAS u32x4*)(WL + b * (WSTR * 2) + ch * 16) = w; }
}
template <int LF>
__device__ __forceinline__ void conv_compute(LAS unsigned char* lds, bf16_t* ydst, int lane, int wv) {
    constexpr int IPW = LF / 256, NBK = LF / 32, P = 2 * LF + 8, WSTR = LF + 8;
    LAS unsigned char* FIL = lds; LAS unsigned char* WL = lds + ((8 * P * 2 + 255) & ~255);
    f32x4 acc[IPW][2]; bf16x8 Bw[IPW];
#pragma unroll
    for (int ii = 0; ii < IPW; ++ii) { acc[ii][0] = (f32x4){0.f, 0.f, 0.f, 0.f}; acc[ii][1] = (f32x4){0.f, 0.f, 0.f, 0.f}; Bw[ii] = (bf16x8){0, 0, 0, 0, 0, 0, 0, 0}; }
    const int rr = lane & 15, q = lane >> 4;
    const int aBase = (rr & 7) * (P * 2) + 2 * (LF - (rr - (rr & 7)) + 8 * q);
    const int bBase = rr * (WSTR * 2) + 16 * q;
#define CONV_STEPS(CHECK) do { _Pragma("unroll") for (int dd = 0; dd < IPW; ++dd) { \
        const int delta = IPW * d + dd; \
        const bf16x8 a0 = *(const LAS bf16x8*)(FIL + aBase - 64 * delta), a1 = *(const LAS bf16x8*)(FIL + aBase - 64 * delta - 32); \
        const int jn = IPW * (wv - d) - dd; \
        if (!(CHECK) || (jn >= 0 && jn < NBK)) Bw[(IPW - dd) % IPW] = *(const LAS bf16x8*)(WL + bBase + 64 * jn); \
        _Pragma("unroll") for (int ii = 0; ii < IPW; ++ii) { const int j = IPW * (wv - d) + ii - dd; \
            if (!(CHECK) || (j >= 0 && j < NBK)) { \
                acc[ii][0] = __builtin_amdgcn_mfma_f32_16x16x32_bf16(a0, Bw[(ii - dd + IPW) % IPW], acc[ii][0], 0, 0, 0); \
                acc[ii][1] = __builtin_amdgcn_mfma_f32_16x16x32_bf16(a1, Bw[(ii - dd + IPW) % IPW], acc[ii][1], 0, 0, 0); } } } } while (0)
    { const int d = wv - 8; CONV_STEPS(true); }
    for (int d = wv - 7; d < wv; ++d) { CONV_STEPS(false); }
    { const int d = wv; CONV_STEPS(true); }
#undef CONV_STEPS
#pragma unroll
    for (int ii = 0; ii < IPW; ++ii)
#pragma unroll
        for (int h = 0; h < 2; ++h) { u32x2 w; w.x = pk2(acc[ii][h][0], acc[ii][h][1]); w.y = pk2(acc[ii][h][2], acc[ii][h][3]);
            *(u32x2*)(ydst + (size_t)rr * LF + 32 * (IPW * wv + ii) + 16 * h + 4 * q) = w; }
}


__device__ __forceinline__ void route_reduce(float (&p)[32], int lane) {
#pragma unroll
    for (int i = 0; i < 16; ++i) { const bool up = (lane & 32) != 0; const float send = up ? p[i] : p[i + 16], keep = up ? p[i + 16] : p[i]; p[i] = keep + __shfl_xor(send, 32); }
#pragma unroll
    for (int i = 0; i < 8; ++i) { const bool up = (lane & 16) != 0; const float send = up ? p[i] : p[i + 8], keep = up ? p[i + 8] : p[i]; p[i] = keep + __shfl_xor(send, 16); }
#pragma unroll
    for (int i = 0; i < 4; ++i) { const bool up = (lane & 8) != 0; const float send = up ? p[i] : p[i + 4], keep = up ? p[i + 4] : p[i]; p[i] = keep + __shfl_xor(send, 8); }
#pragma unroll
    for (int i = 0; i < 2; ++i) { const bool up = (lane & 4) != 0; const float send = up ? p[i] : p[i + 2], keep = up ? p[i + 2] : p[i]; p[i] = keep + __shfl_xor(send, 4); }
    { const bool up = (lane & 2) != 0; const float send = up ? p[0] : p[1], keep = up ? p[1] : p[0]; p[0] = keep + __shfl_xor(send, 2); }
    p[0] += __shfl_xor(p[0], 1);
}
__device__ __forceinline__ void route_top4(float val, int myE, float (&sv)[4], int (&si)[4]) {
    int rank = 0;
#pragma unroll
    for (int e = 0; e < 32; ++e) { const float o = __builtin_bit_cast(float, __builtin_amdgcn_readlane(__builtin_bit_cast(int, val), 2 * e)); rank += (o > val || (o == val && e < myE)) ? 1 : 0; }
#pragma unroll
    for (int k = 0; k < 4; ++k) { const unsigned long long m = __ballot(rank == k); const int src = __builtin_ctzll(m);
        si[k] = src >> 1; sv[k] = __builtin_bit_cast(float, __builtin_amdgcn_readlane(__builtin_bit_cast(int, val), src)); }
}
#define IN(k) (lo <= (k) && (k) < hi)
#define SEAM(k) do { if (IN(k) && IN((k) + 1)) xcd_barrier(bar); } while (0)
#define SEAMK(k, kind) SEAM(k)
#define KLOCALS \
    const float* x_in = args.in[I_X]; const float* c_in = args.in[I_C]; const float* ctx_in = args.in[I_CTX]; const float* cctx_in = args.in[I_CCTX]; \
    float* out = args.out; \
    float* modp = (float*)(ws + WS_MODP); float* modf = (float*)(ws + WS_MOD); \
    float* cosT = (float*)(ws + WS_ROPE); float* sinT = cosT + SEQ * 32; \
    float* a2tab = (float*)(ws + WS_A2); \
    int* top_e = (int*)(ws + WS_PAIR); int* ppos = top_e + NTOK * 4; float* pgate = (float*)(ppos + NTOK * 4); int* pdest = (int*)(pgate + NTOK * 4); \
    bf16_t* XB = (bf16_t*)(ws + WS_XB); \
    bf16_t* Wqkv_t = (bf16_t*)(ws + WS_WQKV); bf16_t* Wo_t = (bf16_t*)(ws + WS_WO); bf16_t* Win_t = (bf16_t*)(ws + WS_WIN); bf16_t* Wout_t = (bf16_t*)(ws + WS_WOUT); \
    bf16_t* Wgu_t = (bf16_t*)(ws + WS_WGU); bf16_t* Wdn_t = (bf16_t*)(ws + WS_WDN); \
    bf16_t* hA = (bf16_t*)(ws + WS_HA); bf16_t* Qb = (bf16_t*)(ws + WS_Q); bf16_t* Kb = (bf16_t*)(ws + WS_K); bf16_t* Vb = (bf16_t*)(ws + WS_V); \
    bf16_t* Upre = (bf16_t*)(ws + WS_UPRE); bf16_t* Wc = (bf16_t*)(ws + WS_WC); bf16_t* Yc = (bf16_t*)(ws + WS_YC); \
    bf16_t* XS = (bf16_t*)(ws + WS_XS); bf16_t* AB = (bf16_t*)(ws + WS_AB); int* elist = (int*)(ws + WS_ELIST); \
    const int wr = wave >> 2, wc = wave & 3, fr = lane & 15, fq = lane >> 4;
template <int layer> __device__ __forceinline__ void layer_body(const Args& args, LAS unsigned char* lds, const XcdBarrier& bar, const int tid, const int lane, const int wave, const int G, const int bid, const int lo, const int hi) {
    const int gw = bid * NWAVES + wave, NGW = G * NWAVES;
    unsigned char* ws = args.ws;
    gu32* ctl = (gu32*)(ws + WS_CTL);
    KLOCALS
        const int pb = 3 + 10 * layer;
        const int jm = layer >> 1;
        const bool ctx_live = layer < 2;
        const int nrows = ctx_live ? NTOK : NLAT;
        const float* mo = modf + (size_t)layer * NMODROW * MODW;

        if ((layer & 1) == 0) {
            if (EN_GEMM && IN(pb + 0)) {
                EpiQKV E{Qb, Kb, Vb, args.in[I_QG] + jm * 64, args.in[I_KG] + jm * 64, cosT, sinT};
                const bf16_t* Wt = Wqkv_t + (size_t)jm * NQKV * D;
                const QkvSched S{hA, Wt, ctx_live ? 1 : 0, G, bid};
                run_gemm(lds, S, E);
            }
            SEAMK(pb + 0, 3);
            if (EN_ATT && IN(pb + 1)) {
                typedef attn_body::bf16 abf;
                const int x = bid & 7, sl = bid >> 3, nS = G >> 3;
                for (int q = sl; q < 256; q += nS) {
                    const int b = 2 * x + (q >> 7), kvh = (q >> 5) & 3, head = 4 * kvh + ((q >> 3) & 3), qb = q & 7;
                    abf* Qu = (abf*)(Qb + ((size_t)b * SEQ + qb * 256) * D + head * 64);
                    attn_body::attn_unit<8>(Qu, (const abf*)(Kb + (size_t)b * KVL * 256 + kvh * 64), (const abf*)(Vb + (size_t)b * KVL * 256 + kvh * 64), Qu, KVL / 64, (char*)lds);
                }
                if (ctx_live) for (int q = sl; q < 32; q += nS) {
                    const int b = 2 * x + (q >> 4), head = q & 15, kvh = head >> 2;
                    abf* Qu = (abf*)(Qb + ((size_t)NLAT + b * CL) * D + head * 64);
                    attn_body::attn_unit<8>(Qu, (const abf*)(Kb + ((size_t)b * KVL + SEQ) * 256 + kvh * 64), (const abf*)(Vb + ((size_t)b * KVL + SEQ) * 256 + kvh * 64), Qu, CL / 64, (char*)lds);
                }
            }
            SEAMK(pb + 1, 4);
            if (EN_GEMM && IN(pb + 2)) {
                EpiResid<layer == 0> E{x_in, ctx_in, XB, mo + 2 * D, nullptr};
                const bf16_t* Wt = Wo_t + (size_t)jm * D * D;
                const DenseSched S{Qb, Wt, nrows / 256, 4, G, bid};
                run_gemm(lds, S, E);
            }
            SEAMK(pb + 2, 5);
        } else {
            const float* cw = args.in[I_HCW] + (size_t)jm * 3 * NHY; const float* cb = args.in[I_HCB] + (size_t)jm * NHY;
            if (EN_GEMM && IN(pb + 0)) {
                const EpiRowBiasBf16 E{Upre, NTOK, args.in[I_HBIN] + (size_t)jm * NHY};
                const WinTSched S{Win_t + (size_t)jm * NHY * D, hA, nrows / 256, G, bid};
                run_gemm(lds, S, E);
            }
            SEAMK(pb + 0, 6);
            if (EN_CONV && IN(pb + 2)) {
                const bf16_t* uT = Upre;
#define CONV_CW8(C) { cw[0 * NHY + D + (C)], cw[1 * NHY + D + (C)], cw[2 * NHY + D + (C)], cb[D + (C)], cw[0 * NHY + 2 * D + (C)], cw[1 * NHY + 2 * D + (C)], cw[2 * NHY + 2 * D + (C)], cb[2 * D + (C)] }
                { const bf16_t* FIb = (const bf16_t*)(ws + (jm == 0 ? WS_FI0 : WS_FI1));
                  ConvRegs<SEQ> R; int c = bid;
                  if (c < 1024) conv_issue<SEQ>(R, FIb + (size_t)c * 8 * FP_L, uT + (size_t)(D + c) * NTOK, uT + (size_t)(2 * D + c) * NTOK, tid);
                  for (; c < 1024; c += G) {
                      const float cw8[8] = CONV_CW8(c);
                      __syncthreads();
                      conv_commit<SEQ>(R, lds, cw8, tid, lane, wave);
                      __syncthreads();
                      if (c + G < 1024) conv_issue<SEQ>(R, FIb + (size_t)(c + G) * 8 * FP_L, uT + (size_t)(D + c + G) * NTOK, uT + (size_t)(2 * D + c + G) * NTOK, tid);
                      conv_compute<SEQ>(lds, Yc + (size_t)c * NB * SEQ, lane, wave);
                  } }
                if (ctx_live) for (int c = bid; c < 1024; c += G) {
                    const float cw8[8] = CONV_CW8(c);
                    ConvRegs<CL> R; conv_issue<CL>(R, (const bf16_t*)(ws + WS_FI2) + (size_t)c * 8 * FP_C, uT + (size_t)(D + c) * NTOK + NLAT, uT + (size_t)(2 * D + c) * NTOK + NLAT, tid);
                    __syncthreads(); conv_commit<CL>(R, lds, cw8, tid, lane, wave); __syncthreads();
                    conv_compute<CL>(lds, Yc + WC_CTX_OFF + (size_t)c * NB * CL, lane, wave);
                }
#undef CONV_CW8
            }
            SEAMK(pb + 2, 8);
            if (EN_MISC && IN(pb + 3)) {
                LAS unsigned char* T = lds;
                const bf16_t* uT = Upre;
                const int nlat_u = NB * 16 * 4, nctx_u = ctx_live ? NB * 2 * 4 : 0;
                const int hw = tid >> 5, l32 = tid & 31;
                for (int u = bid; u < nlat_u + nctx_u; u += G) {
                    int b, s0, c0, Ls, rowb; const bf16_t* srcb;
                    if (u < nlat_u) { b = u >> 6; s0 = ((u >> 2) & 15) * 128; c0 = (u & 3) * 256; Ls = SEQ; rowb = b * SEQ; srcb = Yc; }
                    else { const int q = u - nlat_u; b = q >> 3; s0 = ((q >> 2) & 1) * 128; c0 = (q & 3) * 256; Ls = CL; rowb = NLAT + b * CL; srcb = Yc + WC_CTX_OFF; }
                    __syncthreads();
                    { const int ch = tid & 15;
                      u32x4 yw[8], uw[8]; unsigned short ep[8], en[8]; float wq[8][4];
#pragma unroll
                      for (int i = 0; i < 8; ++i) { const int cg = c0 + i * 32 + (tid >> 4);
                          yw[i] = *(const u32x4*)(srcb + ((size_t)cg * NB + b) * Ls + s0 + ch * 8);
                          const bf16_t* up = uT + (size_t)cg * NTOK + rowb + s0 + ch * 8; uw[i] = *(const u32x4*)up; ep[i] = up[-1]; en[i] = up[8];
                          wq[i][0] = cw[0 * NHY + cg]; wq[i][1] = cw[1 * NHY + cg]; wq[i][2] = cw[2 * NHY + cg]; wq[i][3] = cb[cg]; }
#pragma unroll
                      for (int i = 0; i < 8; ++i) { const int c = i * 32 + (tid >> 4);
                          float x[8], y[8]; unpack8(uw[i], x); unpack8(yw[i], y);
                          float xp = __shfl_up(x[7], 1), xn = __shfl_down(x[0], 1);
                          if (ch == 0) xp = s0 > 0 ? bf2f(ep[i]) : 0.f;
                          if (ch == 15) xn = s0 + 128 < Ls ? bf2f(en[i]) : 0.f;
                          float o[8];
#pragma unroll
                          for (int j = 0; j < 8; ++j) { const float xa = j == 0 ? xp : x[j - 1], xb = j == 7 ? xn : x[j + 1]; o[j] = (wq[i][3] + wq[i][0] * xa + wq[i][1] * x[j] + wq[i][2] * xb) * y[j]; }
                          u32x4 w; w.x = pk2(o[0], o[1]); w.y = pk2(o[2], o[3]); w.z = pk2(o[4], o[5]); w.w = pk2(o[6], o[7]);
                          *(LAS u32x4*)(T + c * 256 + ((ch ^ ((c >> 3) & 15)) * 16)) = w; } }
                    __syncthreads();
                    const int cc = c0 + 8 * l32, sb = s0 + 8 * hw;
                    u32x4 zv[8];
#pragma unroll
                    for (int c = 0; c < 8; ++c) zv[c] = *(const LAS u32x4*)(T + (8 * l32 + c) * 256 + ((hw ^ (l32 & 15)) * 16));
#pragma unroll
                    for (int si = 0; si < 8; ++si) { unsigned hv[8];
#pragma unroll
                        for (int c = 0; c < 8; ++c) { const unsigned wd = zv[c][si >> 1]; hv[c] = (si & 1) ? (wd >> 16) : (wd & 0xffffu); }
                        u32x4 o; o.x = hv[0] | (hv[1] << 16); o.y = hv[2] | (hv[3] << 16); o.z = hv[4] | (hv[5] << 16); o.w = hv[6] | (hv[7] << 16);
                        *(u32x4*)(hA + (size_t)(rowb + sb + si) * D + cc) = o; }
                }
            }
            SEAMK(pb + 3, 9);
            if (EN_GEMM && IN(pb + 4)) {
                EpiResid<layer == 0> E{x_in, ctx_in, XB, mo + 2 * D, args.in[I_HBOUT] + (size_t)jm * D};
                const bf16_t* Wt = Wout_t + (size_t)jm * D * D;
                const DenseSched S{hA, Wt, nrows / 256, 4, G, bid};
                run_gemm(lds, S, E);
            }
            SEAMK(pb + 4, 10);
        }

        gu32* cnt = ctl + CW_CNT + layer * 32 * 64;
        if (EN_ROUTER && IN(pb + 5)) {
            constexpr int WSTR = D + 8, MAXT = 20;
            LAS bf16_t* WT = (LAS bf16_t*)lds;
            LAS float* CB = (LAS float*)(lds + 2 * 32 * WSTR * 2);
            LAS float* CRED = CB + 32;
            LAS int* LCNT = (LAS int*)(CRED + 512);
            LAS int* PREC = LCNT + 64;
            LAS float* RINV = (LAS float*)(PREC + 8 * MAXT * 4);
            __syncthreads();
            if (tid < 64) LCNT[tid] = 0;
            for (int i = tid; i < 8 * MAXT * 4; i += NTHR) PREC[i] = -1;
            const int TPW = (((nrows + NGW - 1) / NGW) + 1) & ~1;
            const int rf = gw * TPW; const int nval = rf >= nrows ? 0 : (nrows - rf < TPW ? nrows - rf : TPW);
            { int curb = -1; f32x4 gs[4], sh[4]; u32x2 wv_[4];
              if (nval > 0) {
#pragma unroll
                  for (int j = 0; j < 4; ++j) wv_[j] = ((const u32x2*)(XB + (size_t)rf * D))[lane + 64 * j]; }
              for (int ti = 0; ti < nval; ++ti) { const int r = rf + ti; f32x4 v[4];
#pragma unroll
                  for (int j = 0; j < 4; ++j) v[j] = (f32x4){bflo(wv_[j].x), bfhi(wv_[j].x), bflo(wv_[j].y), bfhi(wv_[j].y)};
                  if (ti + 1 < nval) {
#pragma unroll
                      for (int j = 0; j < 4; ++j) wv_[j] = ((const u32x2*)(XB + (size_t)(r + 1) * D))[lane + 64 * j]; }
                  const int bq = mod_row(r); if (bq != curb) { const float* mr = mo + (size_t)bq * MODW; load_vec(mr + 4 * D, lane, gs); load_vec(mr + 3 * D, lane, sh); curb = bq; }
                  float ss = 0.f;
#pragma unroll
                  for (int j = 0; j < 4; ++j) ss += (v[j][0] * v[j][0] + v[j][1] * v[j][1]) + (v[j][2] * v[j][2] + v[j][3] * v[j][3]);
                  ss = wave_sum(ss); const float rinv = __builtin_amdgcn_rsqf(ss * (1.0f / D) + EPS);
                  if (lane == 0) RINV[wave * MAXT + ti] = rinv;
#pragma unroll
                  for (int j = 0; j < 4; ++j) { const f32x4 h = (v[j] * rinv) * gs[j] + sh[j]; u32x2 w; w.x = pk2(h[0], h[1]); w.y = pk2(h[2], h[3]); ((u32x2*)(hA + (size_t)r * D))[lane + 64 * j] = w; } } }
            const int rb0 = bid * NWAVES * TPW; const int rb1 = (rb0 + NWAVES * TPW < nrows ? rb0 + NWAVES * TPW : nrows) - 1;
            const int bb0 = rb0 < nrows ? mod_row(rb0) : 1, bb1 = rb0 < nrows ? mod_row(rb1) : 0;
            const float* rw = args.in[I_RW] + (size_t)layer * D * NE; const float* rbias = args.in[I_RB] + layer * NE;
            for (int bq = bb0; bq <= bb1; ++bq) {
                __syncthreads();
                { const float* gsb = mo + (size_t)bq * MODW + 4 * D; const float* shb = mo + (size_t)bq * MODW + 3 * D;
                  const int e = tid & 31; float cpart = 0.f;
#pragma unroll 4
                  for (int jj = 0; jj < 8; ++jj) { const int k0 = 8 * ((tid >> 5) + 16 * jj);
                      const f32x4 g0 = *(const f32x4*)(gsb + k0), g1 = *(const f32x4*)(gsb + k0 + 4), s0 = *(const f32x4*)(shb + k0), s1 = *(const f32x4*)(shb + k0 + 4);
                      float wv[8];
#pragma unroll
                      for (int q = 0; q < 8; ++q) wv[q] = rw[(size_t)(k0 + q) * NE + e];
                      float pv[8]; unsigned hw[4], lw[4];
#pragma unroll
                      for (int q = 0; q < 4; ++q) { pv[q] = g0[q] * wv[q]; pv[4 + q] = g1[q] * wv[4 + q]; cpart += s0[q] * wv[q] + s1[q] * wv[4 + q]; }
#pragma unroll
                      for (int q = 0; q < 4; ++q) { hw[q] = pk2(pv[2 * q], pv[2 * q + 1]); lw[q] = pk2(pv[2 * q] - bflo(hw[q]), pv[2 * q + 1] - bfhi(hw[q])); }
                      *(LAS u32x4*)(WT + (size_t)e * WSTR + k0) = (u32x4){hw[0], hw[1], hw[2], hw[3]};
                      *(LAS u32x4*)(WT + (size_t)(32 + e) * WSTR + k0) = (u32x4){lw[0], lw[1], lw[2], lw[3]}; }
                  CRED[(tid >> 5) * 32 + e] = cpart; }
                __syncthreads();
                if (tid < 32) { float c = rbias[tid];
#pragma unroll
                    for (int q = 0; q < 16; ++q) c += CRED[q * 32 + tid];
                    CB[tid] = c; }
                __syncthreads();
                if (nval > 0 && mod_row(rf) <= bq && bq <= mod_row(rf + nval - 1)) {
                    const int e = lane & 31, kh = lane >> 5; const int trow = rf + (e < nval ? e : nval - 1);
                    const bf16_t* ap = XB + (size_t)trow * D + 8 * kh;
                    const LAS bf16_t* bhp = WT + (size_t)e * WSTR + 8 * kh; const LAS bf16_t* blp = bhp + 32 * WSTR;
                    f32x16 acc;
#pragma unroll
                    for (int q = 0; q < 16; ++q) acc[q] = 0.f;
#pragma unroll 8
                    for (int ks = 0; ks < D / 16; ++ks) { const bf16x8 af = *(const bf16x8*)(ap + 16 * ks);
                        acc = __builtin_amdgcn_mfma_f32_32x32x16_bf16(af, *(const LAS bf16x8*)(bhp + 16 * ks), acc, 0, 0, 0);
                        acc = __builtin_amdgcn_mfma_f32_32x32x16_bf16(af, *(const LAS bf16x8*)(blp + 16 * ks), acc, 0, 0, 0); }
                    const float cbe = CB[e];
                    const int hf = lane >> 5;
#pragma unroll
                    for (int r = 0; r < 10; ++r) { const int tA = (r & 3) + 8 * (r >> 2), tB = tA + 4;
                        const bool okA = tA < nval && mod_row(rf + tA) == bq, okB = tB < nval && mod_row(rf + (tB < MAXT ? tB : 0)) == bq;
                        if (okA || okB) {
                            const int tmine = hf ? (tB < MAXT ? tB : MAXT - 1) : tA;
                            float val = RINV[wave * MAXT + tmine] * acc[r] + cbe;
                            float sv[4]; int si[4];
#pragma unroll
                            for (int k = 0; k < 4; ++k) {
                                int x = __builtin_bit_cast(int, val); float m = val;
                                m = fmaxf(m, __builtin_bit_cast(float, __builtin_amdgcn_update_dpp(x, x, 0xB1, 0xF, 0xF, false))); x = __builtin_bit_cast(int, m);
                                m = fmaxf(m, __builtin_bit_cast(float, __builtin_amdgcn_update_dpp(x, x, 0x4E, 0xF, 0xF, false))); x = __builtin_bit_cast(int, m);
                                m = fmaxf(m, __builtin_bit_cast(float, __builtin_amdgcn_update_dpp(x, x, 0x124, 0xF, 0xF, false))); x = __builtin_bit_cast(int, m);
                                m = fmaxf(m, __builtin_bit_cast(float, __builtin_amdgcn_update_dpp(x, x, 0x128, 0xF, 0xF, false)));
                                m = fmaxf(m, __shfl_xor(m, 16));
                                const unsigned long long mk = __ballot(val == m);
                                const int wlo = __builtin_ctz((unsigned)mk | 0x80000000u), whi = __builtin_ctz((unsigned)(mk >> 32) | 0x80000000u);
                                const int win = hf ? whi : wlo;
                                sv[k] = m; si[k] = win; if ((lane & 31) == win) val = -INFINITY; }
                            if ((lane & 31) < 4 && (hf ? okB : okA)) { const int k = lane & 31; const float e1 = __expf(sv[1] - sv[0]), e2 = __expf(sv[2] - sv[0]), e3 = __expf(sv[3] - sv[0]); const float inv = 1.0f / (1.0f + e1 + e2 + e3);
                                const int ex = k == 0 ? si[0] : (k == 1 ? si[1] : (k == 2 ? si[2] : si[3])); const float gt = (k == 0 ? 1.0f : (k == 1 ? e1 : (k == 2 ? e2 : e3))) * inv;
                                const int tt = hf ? tB : tA; const int rr = rf + tt; const int rk = __hip_atomic_fetch_add(LCNT + ex, 1, __ATOMIC_RELAXED, __HIP_MEMORY_SCOPE_WORKGROUP);
                                top_e[rr * 4 + k] = ex; pgate[rr * 4 + k] = gt; PREC[(wave * MAXT + tt) * 4 + k] = ex | (rk << 8); } } }
                }
            }
            __syncthreads();
            if (tid < 32) LCNT[32 + tid] = (int)__hip_atomic_fetch_add(cnt + tid * 64, (unsigned)LCNT[tid], RLX_AGENT);
            __syncthreads();
            for (int i = tid; i < 8 * MAXT * 4; i += NTHR) { const int rec = PREC[i]; if (rec >= 0) { const int e = rec & 255, rank = rec >> 8, w = i / (MAXT * 4), ti = (i / 4) % MAXT, k = i & 3;
                const int r = (bid * NWAVES + w) * TPW + ti; const int pos = LCNT[32 + e] + rank; ppos[r * 4 + k] = pos; elist[(size_t)e * NTOK + pos] = r; } }
        }
        SEAMK(pb + 5, 11);
        LAS int* PADS = (LAS int*)(lds + LDS_BYTES - 4096);
        LAS unsigned char* TE = (LAS unsigned char*)(PADS + 128);
        if (IN(pb + 7) || IN(pb + 8) || IN(pb + 9)) {
            __syncthreads();
            if (tid < 32) PADS[64 + tid] = (int)__hip_atomic_load(cnt + tid * 64, RLX_AGENT);
            __syncthreads();
            if (tid < 64) {
                const int nt = lane < 32 ? (PADS[64 + lane] + 255) >> 8 : 0; int inc = nt;
#pragma unroll
                for (int o = 1; o < 32; o <<= 1) { const int v = __shfl_up(inc, o); if (lane >= o) inc += v; }
                if (lane < 32) PADS[lane] = (inc - nt) << 8; if (lane == 31) PADS[32] = inc << 8;
            }
            __syncthreads();
            { const int ntile = PADS[32] >> 8; for (int t = tid; t < ntile; t += NTHR) { int e = 0;
#pragma unroll
                  for (int st = 16; st >= 1; st >>= 1) if (PADS[e + st] <= (t << 8)) e += st;
                  TE[t] = (unsigned char)e; } }
            __syncthreads();
        }
        if (EN_GEMM && IN(pb + 7)) {
            const int ntile = PADS[32] >> 8;
            LAS int* ROWS = (LAS int*)(lds + 131072);
            { Unit uu; for (int ui = 0; xcd_unit(ui, G, bid, ntile, 8, uu.pm, uu.pn); ++ui) { if (tid < 256) { const int e = TE[uu.pm]; const int pos = uu.pm * 256 - PADS[e] + tid;
                  ROWS[ui * 256 + tid] = pos < PADS[64 + e] ? elist[(size_t)e * NTOK + pos] : 0; } } }
            __syncthreads();
            const MoeGatherSched S{hA, Wgu_t + (size_t)layer * NE * NGU * D, TE, ROWS, ntile, 8, NGU, G, bid};
            const EpiSwiglu E{AB, args.in[I_BGU] + (size_t)layer * NE * NGU};
            run_gemm_gather(lds, S, E);
        }
        SEAMK(pb + 7, 12);
        if (EN_GEMM && IN(pb + 8)) {
            const int ntile = PADS[32] >> 8;
            const MoeSched S{AB, Wdn_t + (size_t)layer * NE * D * D, TE, ntile, 4, D, G, bid};
            const EpiBiasBf16 E{XS, D, args.in[I_BDN] + (size_t)layer * NE * D, D};
            run_gemm(lds, S, E);
        }
        SEAMK(pb + 8, 13);
        if (EN_MISC && IN(pb + 9)) {
            const bool has_next = layer + 1 < DEPTH;
            const float* mo_n = modf + (size_t)(layer + 1) * NMODROW * MODW; const float* g1n = args.in[I_N1G] + (has_next ? (layer + 1) * D : 0);
            const int nnext = (layer + 1 < 3) ? NTOK : NLAT;
            const int TPW = (nrows + NGW - 1) / NGW;
            int curb = -1; f32x4 gm[4], gsn[4], shn[4];
            for (int ti = 0; ti < TPW; ++ti) {
                const int r = gw * TPW + ti; if (r >= nrows) break;
                bf16_t* xr = XB + (size_t)r * D;
                int dest[4]; float gt[4];
#pragma unroll
                for (int k = 0; k < 4; ++k) { dest[k] = PADS[top_e[r * 4 + k]] + ppos[r * 4 + k]; gt[k] = pgate[r * 4 + k]; }
                u32x2 yw[4][4]; f32x4 v[4], h[4];
#pragma unroll
                for (int k = 0; k < 4; ++k) { const u32x2* yr = (const u32x2*)(XS + (size_t)dest[k] * D);
#pragma unroll
                    for (int j = 0; j < 4; ++j) yw[k][j] = yr[lane + 64 * j]; }
                load_vec_bf(xr, lane, v);
                const int b = mod_row(r);
                if (b != curb) { load_vec(mo + (size_t)b * MODW + 5 * D, lane, gm); if (has_next) { const float* mn = mo_n + (size_t)b * MODW; load_vec(mn + D, lane, gsn); load_vec(mn, lane, shn); } curb = b; }
#pragma unroll
                for (int j = 0; j < 4; ++j) { f32x4 y = (f32x4){0.f, 0.f, 0.f, 0.f};
#pragma unroll
                    for (int k = 0; k < 4; ++k) { const u32x2 w = yw[k][j]; y[0] += gt[k] * bflo(w.x); y[1] += gt[k] * bfhi(w.x); y[2] += gt[k] * bflo(w.y); y[3] += gt[k] * bfhi(w.y); }
                    v[j] = v[j] + gm[j] * y;
                    if (layer == DEPTH - 1) ((f32x4*)(out + (size_t)r * D))[lane + 64 * j] = v[j];
                    else { u32x2 w; w.x = pk2(v[j][0], v[j][1]); w.y = pk2(v[j][2], v[j][3]); ((u32x2*)xr)[lane + 64 * j] = w; } }
                if (has_next && r < nnext) { const int rp = (layer & 1) == 0 ? (r & ~31) + slot32(r & 31) : r;
                    norm_mod_store(v, gsn, shn, hA + (size_t)rp * D, lane, h); }
            }
        }
        SEAMK(pb + 9, 14);
}

__global__ void __launch_bounds__(NTHR, 2) fwd(Args args) {
    extern __shared__ __attribute__((aligned(16))) unsigned char lds_raw[];
    LAS unsigned char* lds = (LAS unsigned char*)lds_raw;
    const int tid = threadIdx.x, lane = tid & 63, wave = __builtin_amdgcn_readfirstlane(tid >> 6);
    const int G = gridDim.x, bid = blockIdx.x;
    const int gw = bid * NWAVES + wave, NGW = G * NWAVES;
    unsigned char* ws = args.ws;
    gu32* ctl = (gu32*)(ws + WS_CTL);
    volatile LAS unsigned* MISC = (volatile LAS unsigned*)(lds + MISC_OFF);
    if (tid < 64) MISC[tid] = 0u;
    __syncthreads();
    XcdBarrier bar; bar.bar = (unsigned*)ctl + CW_BAR; bar.x = 0; bar.st = MISC + 8;
    const int lo = args.ph_lo, hi = args.ph_hi;
    if (hi - lo > 1) bar = xcd_barrier_post((unsigned*)ctl + CW_BAR, MISC + 8);

    KLOCALS

    if (EN_PRO && IN(0)) {
        {
            LAS float* scr = (LAS float*)(lds + wave * 8448);
            constexpr int IT_QKV = 16 * (NQKV / 32), IT_SQ = 16 * (D / 32), IT_IN = 16 * (NHY / 32), IT_GU = 16 * (NGU / 32);
            constexpr int N0 = 2 * IT_QKV, N1 = N0 + 2 * IT_SQ, N2 = N1 + 2 * IT_IN, N3 = N2 + 2 * IT_SQ, N4 = N3 + 128 * IT_GU, N5 = N4 + 128 * IT_SQ;
            for (int it = gw; it < N5; it += NGW) {
                if (it < N0) { const int mtx = it / IT_QKV, r = it % IT_QKV; transpose_item<1>(args.in[I_WQKV] + (size_t)mtx * D * NQKV, NQKV, Wqkv_t + (size_t)mtx * NQKV * D, scr, r, lane); }
                else if (it < N1) { const int q = it - N0, mtx = q / IT_SQ, r = q % IT_SQ; transpose_item<0>(args.in[I_WO] + (size_t)mtx * D * D, D, Wo_t + (size_t)mtx * D * D, scr, r, lane); }
                else if (it < N2) { const int q = it - N1, mtx = q / IT_IN, r = q % IT_IN; transpose_item<3>(args.in[I_HWIN] + (size_t)mtx * D * NHY, NHY, Win_t + (size_t)mtx * NHY * D, scr, r, lane); }
                else if (it < N3) { const int q = it - N2, mtx = q / IT_SQ, r = q % IT_SQ; transpose_item<0>(args.in[I_HWOUT] + (size_t)mtx * D * D, D, Wout_t + (size_t)mtx * D * D, scr, r, lane); }
                else if (it < N4) { const int q = it - N3, mtx = q / IT_GU, r = q % IT_GU; transpose_item<2>(args.in[I_WGU] + (size_t)mtx * D * NGU, NGU, Wgu_t + (size_t)mtx * NGU * D, scr, r, lane); }
                else { const int q = it - N4, mtx = q / IT_SQ, r = q % IT_SQ; transpose_item<0>(args.in[I_WDN] + (size_t)mtx * D * D, D, Wdn_t + (size_t)mtx * D * D, scr, r, lane); }
            }
        }
        __syncthreads();
        {
            LAS float* S = (LAS float*)lds;
            for (int u = bid; u < 4 * 12 * 8; u += G) {
                const int kc = u & 7, cc = (u >> 3) % 12, layer = u / 96;
                __syncthreads();
                for (int i = tid; i < 128 * 20; i += NTHR) { const int k = i / 20, r = i % 20; float v = 0.f;
                    if (r < NMODROW) { const float cv = r < NB ? c_in[r * D + kc * 128 + k] : cctx_in[kc * 128 + k]; v = cv / (1.0f + __expf(-cv)); }
                    S[i] = v; }
                __syncthreads();
                const int col = cc * 512 + tid;
                const float* wp = args.in[I_WMOD] + ((size_t)layer * D + kc * 128) * MODW + col;
                float acc[20];
#pragma unroll
                for (int r = 0; r < 20; ++r) acc[r] = 0.f;
                for (int k = 0; k < 128; ++k) { const float w = wp[(size_t)k * MODW];
#pragma unroll
                    for (int q = 0; q < 5; ++q) { const f32x4 s = *(const LAS f32x4*)(S + k * 20 + 4 * q);
                        acc[4 * q] += s[0] * w; acc[4 * q + 1] += s[1] * w; acc[4 * q + 2] += s[2] * w; acc[4 * q + 3] += s[3] * w; } }
#pragma unroll
                for (int r = 0; r < NMODROW; ++r) modp[((size_t)(kc * 4 + layer) * NMODROW + r) * MODW + col] = acc[r];
            }
        }
        for (int i = bid * NTHR + tid; i < SEQ * 32; i += G * NTHR) {
            const int t = i >> 5, j = i & 31, fi = j & 15; const int pos = (j >> 4) == 0 ? (t >> 6) : (t & 63);
            const float inv = powf(10000.0f, -(float)fi / 16.0f); const float ang = (float)pos * inv;
            cosT[i] = cosf(ang); sinT[i] = sinf(ang);
        }
        {
            __syncthreads();
            LAS float* Z = (LAS float*)lds;
            LAS float* A1 = Z + 8 * 36;
            for (int u = bid; u < 256 + 256 + 32; u += G) {
                const int combo = u < 256 ? 0 : (u < 512 ? 1 : 2); const int ub = combo == 0 ? u : (combo == 1 ? u - 256 : u - 512);
                const int j = combo == 1 ? 1 : 0, Lf = combo == 2 ? CL : SEQ;
                const int tl = tid >> 6, o = tid & 63, t = ub * 8 + tl;
                __syncthreads();
                if (o < 33) { float z;
                    const float tt = (float)t / (float)(Lf - 1), w = 6.283185307179586f * (float)t / (float)Lf;
                    if (o == 0) z = tt; else { const int b = (o - 1) & 15; const float f = 1e-4f + (float)b * ((15.0f - 1e-4f) / 15.0f); z = o <= 16 ? cosf(f * w) : -sinf(f * w); }
                    Z[tl * 36 + o] = z; }
                __syncthreads();
                const float sf = args.in[I_HSF][j * 64 + o];
                { const float* w1 = args.in[I_HW1] + (size_t)j * 33 * 64; float a = args.in[I_HB1][j * 64 + o];
                  for (int i = 0; i < 33; ++i) a += Z[tl * 36 + i] * w1[i * 64 + o];
                  A1[tl * 64 + o] = sinf(sf * a); }
                __syncthreads();
                { const float* w2 = args.in[I_HW2] + (size_t)j * 64 * 64; float a = args.in[I_HB2][j * 64 + o];
                  for (int i = 0; i < 64; ++i) a += A1[tl * 64 + i] * w2[i * 64 + o];
                  a2tab[((size_t)combo * SEQ + t) * 64 + o] = sinf(sf * a); }
            }
        }
    }
    SEAMK(0, 0);

    if (EN_PRO && IN(1)) {
        for (int i = bid * NTHR + tid; i < DEPTH * NMODROW * MODW; i += G * NTHR) {
            const int layer = i / (NMODROW * MODW), rem = i % (NMODROW * MODW), col = rem % MODW; float s = args.in[I_BMOD][layer * MODW + col];
#pragma unroll
            for (int kc = 0; kc < 8; ++kc) s += modp[(size_t)(kc * 4 + layer) * NMODROW * MODW + rem];
            const int chunk = col >> 10, k = col & (D - 1);
            if (chunk == 1) s = args.in[I_N1G][layer * D + k] * (1.0f + s); else if (chunk == 4) s = args.in[I_N2G][layer * D + k] * (1.0f + s);
            modf[i] = s;
        }
        {
            LAS float* W3 = (LAS float*)lds;
            LAS float* RED = W3 + 512;
            LAS float* NRM = RED + 32;
            LAS float* HF = NRM + 4;
            for (int u = bid; u < 3 * 256; u += G) {
                const int combo = u >> 8, cg = u & 255; const int j = combo == 1 ? 1 : 0, Lf = combo == 2 ? CL : SEQ; const int c0 = cg * 4;
                LAS float* HB = HF + 4 * Lf;
                __syncthreads();
                { const int i = tid >> 3, q = tid & 7; const int col = (q >> 2) * 1024 + c0 + (q & 3);
                  W3[i * 8 + q] = args.in[I_HW3][((size_t)j * 64 + i) * 2048 + col]; }
                __syncthreads();
                float b3v[8], dec[4], asum[4] = {0.f, 0.f, 0.f, 0.f};
#pragma unroll
                for (int q = 0; q < 8; ++q) b3v[q] = args.in[I_HB3][j * 2048 + (q >> 2) * 1024 + c0 + (q & 3)];
#pragma unroll
                for (int ch = 0; ch < 4; ++ch) dec[ch] = 3.0701134573253945f + (float)(c0 + ch) * ((15.350567286626972f - 3.0701134573253945f) / 1023.0f);
                for (int t = tid; t < Lf; t += NTHR) {
                    asm volatile("" ::: "memory");
                    const float* ar = a2tab + ((size_t)combo * SEQ + t) * 64; float d[8];
#pragma unroll
                    for (int q = 0; q < 8; ++q) d[q] = b3v[q];
#pragma unroll
                    for (int i4 = 0; i4 < 16; ++i4) { const f32x4 a = *(const f32x4*)(ar + 4 * i4); asm volatile("" ::: "memory");
#pragma unroll
                        for (int e = 0; e < 4; ++e) { const f32x4 w0 = *(const LAS f32x4*)(W3 + (4 * i4 + e) * 8), w1 = *(const LAS f32x4*)(W3 + (4 * i4 + e) * 8 + 4);
                            d[0] += a[e] * w0[0]; d[1] += a[e] * w0[1]; d[2] += a[e] * w0[2]; d[3] += a[e] * w0[3]; d[4] += a[e] * w1[0]; d[5] += a[e] * w1[1]; d[6] += a[e] * w1[2]; d[7] += a[e] * w1[3]; } }
                    const float tt = (float)t / (float)(Lf - 1);
#pragma unroll
                    for (int ch = 0; ch < 4; ++ch) { const float dk = __expf(-tt * dec[ch]); const float f = d[ch] * dk, bb = d[4 + ch] * dk;
                        HF[ch * Lf + t] = f; HB[ch * Lf + t] = bb; asum[ch] += fabsf(f) + (t >= 1 ? fabsf(bb) : 0.f); }
                }
#pragma unroll
                for (int ch = 0; ch < 4; ++ch) { const float s = wave_sum(asum[ch]); if (lane == 0) RED[wave * 4 + ch] = s; }
                __syncthreads();
                if (tid < 4) { float s = 0.f; for (int w = 0; w < 8; ++w) s += RED[w * 4 + tid]; NRM[tid] = 1.0f / (s + EPS); }
                __syncthreads();
                const int P = 2 * Lf + 8, PC8 = P / 8;
                bf16_t* FI = (bf16_t*)(ws + (combo == 0 ? WS_FI0 : (combo == 1 ? WS_FI1 : WS_FI2)));
                for (int q = tid; q < 4 * PC8; q += NTHR) {
                    const int ch = q / PC8, cidx = 0, x0 = (q % PC8) * 8;
                    const float nr = NRM[ch], db = args.in[I_HDB][j * 1024 + c0 + ch]; float v[8];
#pragma unroll
                    for (int e = 0; e < 8; ++e) { const int m = Lf - (x0 + e) + cidx; const int am = m < 0 ? -m : m; float g = 0.f;
                        if (am <= Lf - 1) { g = (m >= 0 ? HF[ch * Lf + am] : HB[ch * Lf + am]) * nr; if (m == 0) g += db; }
                        v[e] = g; }
                    u32x4 o; o.x = pk2(v[0], v[1]); o.y = pk2(v[2], v[3]); o.z = pk2(v[4], v[5]); o.w = pk2(v[6], v[7]);
                    *(u32x4*)(FI + ((size_t)((c0 + ch) * 8 + cidx)) * P + x0) = o;
                }
            }
        }
    }
    SEAMK(1, 1);

    if (IN(2)) {
        const float* mo = modf;
        const int TPW = (NTOK + NGW - 1) / NGW;
        int curb = -1; f32x4 gs[4], sh[4];
        for (int ti = 0; ti < TPW; ++ti) {
            const int r = gw * TPW + ti; if (r >= NTOK) break;
            const float* src = r < NLAT ? x_in + (size_t)r * D : ctx_in + (size_t)(r - NLAT) * D;
            f32x4 v[4], h[4]; load_vec(src, lane, v);
            const int b = mod_row(r); if (b != curb) { const float* mr = mo + (size_t)b * MODW; load_vec(mr + D, lane, gs); load_vec(mr, lane, sh); curb = b; }
            norm_mod_store(v, gs, sh, hA + (size_t)r * D, lane, h);
        }
    }
    SEAMK(2, 2);

    layer_body<0>(args, lds, bar, tid, lane, wave, G, bid, lo, hi);
    layer_body<1>(args, lds, bar, tid, lane, wave, G, bid, lo, hi);
    layer_body<2>(args, lds, bar, tid, lane, wave, G, bid, lo, hi);
    layer_body<3>(args, lds, bar, tid, lane, wave, G, bid, lo, hi);
#undef IN
#undef SEAM
}

extern "C" void kernel_launch(void* const* d_in, const int* in_sizes, int n_in, void* d_out, int out_size, void* d_ws, size_t ws_size, hipStream_t stream) {
    static int grid = 0;
    if (grid == 0) {
        if (n_in != 32 || out_size != NLAT * D || ws_size < WS_END) { fprintf(stderr, "kernel_launch: unexpected problem (n_in %d, out %d, ws %zu)\n", n_in, out_size, ws_size); grid = -1; return; }
        int dev = 0, cus = 0, per_cu = 0;
        if (hipGetDevice(&dev) != hipSuccess || hipDeviceGetAttribute(&cus, hipDeviceAttributeMultiprocessorCount, dev) != hipSuccess) { grid = -1; return; }
        if (hipFuncSetAttribute((const void*)fwd, hipFuncAttributeMaxDynamicSharedMemorySize, LDS_BYTES) != hipSuccess) { fprintf(stderr, "kernel_launch: hipFuncSetAttribute failed\n"); grid = -1; return; }
        if (hipOccupancyMaxActiveBlocksPerMultiprocessor(&per_cu, (const void*)fwd, NTHR, LDS_BYTES) != hipSuccess || per_cu < 1) fprintf(stderr, "kernel_launch: occupancy query says %d\n", per_cu);
        (void)hipGetLastError();
        if (cus < 256) { fprintf(stderr, "kernel_launch: built for the 256-CU MI355X (unit orders, per-wave row counts); found %d CUs; nothing launched\n", cus); grid = -1; return; }
        grid = 256;
    }
    if (grid < 0) return;
    (void)hipMemsetAsync((char*)d_ws + WS_CTL, 0, CTL_ZERO_BYTES, stream);
    Args a{};
    for (int i = 0; i < 32; ++i) a.in[i] = (const float*)d_in[i];
    a.out = (float*)d_out; a.ws = (unsigned char*)d_ws;
    constexpr int NPH = 3 + 10 * DEPTH;
#if MK_ONE_LAUNCH
    a.ph_lo = 0; a.ph_hi = NPH;
    hipLaunchKernelGGL(fwd, dim3(grid), dim3(NTHR), LDS_BYTES, stream, a);
#else
    for (int p = 0; p < NPH; ++p) {
        if (p >= 3) { const int layer = (p - 3) / 10, loc = (p - 3) % 10; if ((layer & 1) == 0 && (loc == 3 || loc == 4)) continue; }
        a.ph_lo = p; a.ph_hi = p + 1;
        hipLaunchKernelGGL(fwd, dim3(grid), dim3(NTHR), LDS_BYTES, stream, a);
    }
#endif
}
```

```cpp
#include <hip/hip_runtime.h>
#include <cstdio>
#include <cstdint>
#include <cmath>
#include <hip/hip_bf16.h>

#ifndef EN_PRO
#define EN_PRO 1
#endif
#ifndef EN_ATT
#define EN_ATT 1
#endif
#ifndef EN_CONV
#define EN_CONV 1
#endif
#ifndef EN_ROUTER
#define EN_ROUTER 1
#endif
#ifndef EN_GEMM
#define EN_GEMM 1
#endif
#ifndef EN_MISC
#define EN_MISC 1
#endif
#ifndef MK_ONE_LAUNCH
#define MK_ONE_LAUNCH 1
#endif

#define GAS __attribute__((address_space(1)))
#define LAS __attribute__((address_space(3)))
typedef unsigned short bf16_t;
typedef short bf16x8 __attribute__((ext_vector_type(8)));
typedef float f32x4 __attribute__((ext_vector_type(4)));
typedef float f32x2 __attribute__((ext_vector_type(2)));
typedef unsigned u32x4 __attribute__((ext_vector_type(4)));
typedef unsigned u32x2 __attribute__((ext_vector_type(2)));
typedef GAS unsigned gu32;
typedef float f32x16 __attribute__((ext_vector_type(16)));

constexpr int D = 1024, NB = 16, SEQ = 2048, CL = 256, KVL = SEQ + CL;
constexpr int NLAT = NB * SEQ, NCTX = NB * CL, NTOK = NLAT + NCTX;
constexpr int NE = 32, TOPK = 4, DEPTH = 4;
static_assert(NTOK < 65536, "claim-list entries carry the token in 16 bits");
constexpr int MODW = 6 * D, NMODROW = NB + 1;
constexpr int NQKV = 1536, NHY = 3072, NGU = 2048;
constexpr float EPS = 1e-6f;
constexpr float C2 = 0.125f * 1.4426950408889634f;
constexpr int NWAVES = 8, NTHR = 512;
constexpr int NPADROWS = 155648;
constexpr int MAXTILES = NPADROWS / 256;

constexpr size_t MiB = 1u << 20;
constexpr size_t WS_CTL = 0, CTL_ZERO_BYTES = 1 * MiB;
constexpr size_t WS_MODP = 2 * MiB;
constexpr size_t WS_MOD = 16 * MiB;
constexpr size_t WS_ROPE = 18 * MiB;
constexpr size_t WS_A2 = 19 * MiB;
constexpr size_t WS_PAIR = 21 * MiB;
constexpr size_t WS_CTX = 24 * MiB;
constexpr size_t WS_FI = 40 * MiB;
constexpr int FP_L = 2 * SEQ + 8, FP_C = 2 * CL + 8;
constexpr size_t FI_L_BYTES = (size_t)1024 * 8 * FP_L * 2, FI_C_BYTES = (size_t)1024 * 8 * FP_C * 2;
constexpr size_t WS_FI0 = WS_FI, WS_FI1 = WS_FI0 + 65 * MiB, WS_FI2 = WS_FI1 + 65 * MiB;
static_assert(FI_L_BYTES <= 65 * MiB && WS_FI2 + FI_C_BYTES <= 180 * MiB, "filter map");
constexpr size_t WS_WQKV = 180 * MiB, WS_WO = 186 * MiB, WS_WIN = 190 * MiB, WS_WOUT = 202 * MiB, WS_WGU = 206 * MiB, WS_WDN = 718 * MiB;
constexpr size_t WS_HA = 974 * MiB;
constexpr size_t WS_Q = 1046 * MiB;
constexpr size_t WS_K = 1118 * MiB, WS_V = 1136 * MiB;
constexpr size_t WS_UPRE = 1154 * MiB;
constexpr size_t WS_WC = 1370 * MiB;
constexpr size_t WS_YC = 1442 * MiB;
constexpr size_t WS_WSC_QKV = WS_WC + 5 * MiB;
constexpr size_t WS_WSC_IN = WS_WC + 3 * MiB, WS_TSC = WS_WC + 4 * MiB;
constexpr size_t WS_WSC_GU = WS_WC, WS_WSC_DN = WS_WC + 2 * MiB;
constexpr size_t WS_XS = 1514 * MiB;
constexpr size_t WS_AB = 1818 * MiB;
constexpr size_t WS_ELIST = 2122 * MiB;
constexpr size_t WS_XB = 2128 * MiB;
constexpr size_t WS_END = 2200 * MiB;
constexpr size_t WC_CTX_OFF = (size_t)1024 * 16 * 2048;
constexpr int CW_TMO = 0, CW_BAR = 4096, CW_CNT = 16384;

constexpr int LDS_BYTES = 160 * 1024;
constexpr int MISC_OFF = LDS_BYTES - 256;

#define RLX_AGENT __ATOMIC_RELAXED, __HIP_MEMORY_SCOPE_AGENT
#define LDS_WAIT() asm volatile("s_waitcnt lgkmcnt(0)" ::: "memory")
#define VM_WAIT() asm volatile("s_waitcnt vmcnt(0)" ::: "memory")
__device__ __forceinline__ unsigned f2bf(float f) { unsigned u = __builtin_bit_cast(unsigned, f); return (u + 0x7fffu + ((u >> 16) & 1u)) >> 16; }
typedef __bf16 bf16x2_t __attribute__((ext_vector_type(2)));
__device__ __forceinline__ unsigned pk2(float lo, float hi) { const f32x2 v = {lo, hi}; const bf16x2_t b = __builtin_convertvector(v, bf16x2_t); return __builtin_bit_cast(unsigned, b); }
constexpr float F8_HS = 8.0f;
__device__ __forceinline__ unsigned pk4f8(float a, float b, float c, float d) {
    int w = 0; w = __builtin_amdgcn_cvt_pk_fp8_f32(__builtin_amdgcn_fmed3f(a, -448.f, 448.f), __builtin_amdgcn_fmed3f(b, -448.f, 448.f), w, false);
    w = __builtin_amdgcn_cvt_pk_fp8_f32(__builtin_amdgcn_fmed3f(c, -448.f, 448.f), __builtin_amdgcn_fmed3f(d, -448.f, 448.f), w, true); return (unsigned)w; }
__device__ __forceinline__ unsigned pk4f8u(float a, float b, float c, float d) {
    int w = 0; w = __builtin_amdgcn_cvt_pk_fp8_f32(a, b, w, false); w = __builtin_amdgcn_cvt_pk_fp8_f32(c, d, w, true); return (unsigned)w; }
__device__ __forceinline__ float bf2f(unsigned h) { return __builtin_bit_cast(float, h << 16); }
__device__ __forceinline__ float bflo(unsigned w) { return __builtin_bit_cast(float, w << 16); }
__device__ __forceinline__ float bfhi(unsigned w) { return __builtin_bit_cast(float, w & 0xffff0000u); }
#define DPPF(x, ctrl, rmask, bmask) __builtin_bit_cast(float, __builtin_amdgcn_update_dpp(0, __builtin_bit_cast(int, (x)), (ctrl), (rmask), (bmask), false))
__device__ __forceinline__ float wave_sum(float x) {
    float v = x + DPPF(x, 0x111, 0xf, 0xf); v += DPPF(x, 0x112, 0xf, 0xf); v += DPPF(x, 0x113, 0xf, 0xf);
    v += DPPF(v, 0x114, 0xf, 0xe); v += DPPF(v, 0x118, 0xf, 0xc); v += DPPF(v, 0x142, 0xa, 0xf); v += DPPF(v, 0x143, 0xc, 0xf);
    return __builtin_bit_cast(float, __builtin_amdgcn_readlane(__builtin_bit_cast(int, v), 63));
}
__device__ __forceinline__ float wave_max_nn(float x) {
    float v = fmaxf(x, DPPF(x, 0x111, 0xf, 0xf)); v = fmaxf(v, DPPF(x, 0x112, 0xf, 0xf)); v = fmaxf(v, DPPF(x, 0x113, 0xf, 0xf));
    v = fmaxf(v, DPPF(v, 0x114, 0xf, 0xe)); v = fmaxf(v, DPPF(v, 0x118, 0xf, 0xc)); v = fmaxf(v, DPPF(v, 0x142, 0xa, 0xf)); v = fmaxf(v, DPPF(v, 0x143, 0xc, 0xf));
    return __builtin_bit_cast(float, __builtin_amdgcn_readlane(__builtin_bit_cast(int, v), 63));
}

#define XB_TMO      128
#define XB_XCNT(j)  (256  + 64 * (j))
#define XB_XSUB(j)  (1280 + 64 * (j))
#define XB_XGEN(j)  (2304 + 64 * (j))
#define XB_TOP      3328
#define XB_TOPGEN   3392
#define XCD_BAR_WORDS 3456
#define XB_SPIN_CAP (1u << 22)
__device__ __forceinline__ unsigned xb_ld(unsigned* p)              { return __hip_atomic_load(p, __ATOMIC_RELAXED, __HIP_MEMORY_SCOPE_AGENT); }
__device__ __forceinline__ unsigned xb_add(unsigned* p, unsigned v) { return __hip_atomic_fetch_add(p, v, __ATOMIC_RELAXED, __HIP_MEMORY_SCOPE_AGENT); }
__device__ __forceinline__ unsigned xb_xcc_id() { return (unsigned)__builtin_amdgcn_s_getreg((3 << 11) | 20) & 0xFu; }
#define XB_SPIN(cond, bar) do { unsigned _sp = 0; while (cond) { __builtin_amdgcn_s_sleep(1); \
    if ((++_sp & 255u) == 0u) { if (xb_ld(&(bar)[XB_TMO])) break; if (_sp > XB_SPIN_CAP) { atomicAdd(&(bar)[XB_TMO], 1u); break; } } } } while (0)
struct XcdBarrier { unsigned* bar; unsigned x; volatile LAS unsigned* st; };
__device__ __forceinline__ XcdBarrier xcd_barrier_post(unsigned* bar, volatile LAS unsigned* st) {
    XcdBarrier b; b.bar = bar; b.x = xb_xcc_id(); b.st = st;
    if (threadIdx.x == 0) (void)xb_add(&bar[XB_XCNT(b.x)], 1u);
    return b;
}
__device__ __forceinline__ void xcd_barrier_complete(unsigned* bar, unsigned x, unsigned& nloc, unsigned& nx) {
    const unsigned G = gridDim.x * gridDim.y * gridDim.z;
    unsigned sum, cnt, mine, sp = 0u;
    for (;;) {
        sum = 0u; cnt = 0u; mine = 0u;
#pragma unroll
        for (unsigned j = 0; j < 16; ++j) { const unsigned c = xb_ld(&bar[XB_XCNT(j)]); sum += c; cnt += (c > 0u) ? 1u : 0u; mine = (j == x) ? c : mine; }
        if (sum == G) break;
        __builtin_amdgcn_s_sleep(1);
        if ((++sp & 255u) == 0u) { if (xb_ld(&bar[XB_TMO])) break; if (sp > XB_SPIN_CAP) { atomicAdd(&bar[XB_TMO], 1u); break; } }
    }
    nloc = mine > 0u ? mine : 1u; nx = cnt > 0u ? cnt : 1u;
}
__device__ __forceinline__ void xcd_barrier(const XcdBarrier& b) {
    asm volatile("s_waitcnt vmcnt(0)" ::: "memory");
    __syncthreads();
    if (threadIdx.x == 0) {
        unsigned* bar = b.bar;
        __builtin_amdgcn_s_waitcnt(0);
        unsigned nloc = b.st[0], nx = b.st[1];
        if (nloc == 0u) { xcd_barrier_complete(bar, b.x, nloc, nx); b.st[0] = nloc; b.st[1] = nx; }
        const unsigned old = xb_add(&bar[XB_XSUB(b.x)], 1u);
        const unsigned gen = old / nloc;
        if (old + 1u == (gen + 1u) * nloc) {
            __builtin_amdgcn_fence(__ATOMIC_RELEASE, "agent");
            asm volatile("s_waitcnt vmcnt(0)" ::: "memory");
            const unsigned og = xb_add(&bar[XB_TOP], 1u);
            const unsigned tg = og / nx;
            if (og + 1u == (tg + 1u) * nx) xb_add(&bar[XB_TOPGEN], 1u);
            else XB_SPIN(xb_ld(&bar[XB_TOPGEN]) == tg, bar);
            __builtin_amdgcn_fence(__ATOMIC_ACQUIRE, "agent");
            xb_add(&bar[XB_XGEN(b.x)], 1u);
            asm volatile("s_waitcnt vmcnt(0)" ::: "memory");
        } else {
            XB_SPIN(xb_ld(&bar[XB_XGEN(b.x)]) == gen, bar);
            __builtin_amdgcn_fence(__ATOMIC_ACQUIRE, "agent");
            asm volatile("s_waitcnt vmcnt(0)" ::: "memory");
        }
    }
    __syncthreads();
}

struct Args { const float* in[32]; float* out; unsigned char* ws; int ph_lo, ph_hi; };
struct Ctx {
    LAS unsigned char* lds;
    int tid, lane, wave, G, bid;
    const float* const* in;
};
enum { I_X = 0, I_C, I_CTX, I_CCTX, I_WMOD, I_BMOD, I_N1G, I_N2G, I_WQKV, I_QG, I_KG, I_WO, I_HWIN, I_HBIN, I_HCW, I_HCB, I_HW1, I_HB1, I_HW2, I_HB2, I_HW3, I_HB3,
       I_HSF, I_HDB, I_HWOUT, I_HBOUT, I_RW, I_RB, I_WGU, I_BGU, I_WDN, I_BDN };

__device__ __forceinline__ int mod_row(int r) { return r < NLAT ? (r >> 11) : NB; }

__device__ __forceinline__ void gemm_unit_simple(const bf16_t* At, const bf16_t* Bt, f32x4 (&acc)[2][2][4][2], int wr, int wc, int fr, int fq) {
    constexpr int K = D;
#pragma unroll
    for (int a = 0; a < 2; ++a)
#pragma unroll
        for (int b = 0; b < 2; ++b)
#pragma unroll
            for (int m = 0; m < 4; ++m)
#pragma unroll
                for (int n = 0; n < 2; ++n) acc[a][b][m][n] = (f32x4){0.f, 0.f, 0.f, 0.f};
    const bf16_t* ap = At + (size_t)(wr * 64 + fr) * K + fq * 8;
    const bf16_t* bp = Bt + (size_t)(wc * 32 + fr) * K + fq * 8;
    for (int k0 = 0; k0 < K; k0 += 32) {
        bf16x8 bfr[2][2];
#pragma unroll
        for (int bj = 0; bj < 2; ++bj)
#pragma unroll
            for (int n = 0; n < 2; ++n) bfr[bj][n] = *(const bf16x8*)(bp + (size_t)(bj * 128 + n * 16) * K + k0);
#pragma unroll
        for (int ai = 0; ai < 2; ++ai)
#pragma unroll
            for (int m = 0; m < 4; ++m) {
                const bf16x8 afr = *(const bf16x8*)(ap + (size_t)(ai * 128 + m * 16) * K + k0);
#pragma unroll
                for (int bj = 0; bj < 2; ++bj)
#pragma unroll
                    for (int n = 0; n < 2; ++n) acc[ai][bj][m][n] = __builtin_amdgcn_mfma_f32_16x16x32_bf16(bfr[bj][n], afr, acc[ai][bj][m][n], 0, 0, 0);
            }
    }
}


struct Unit { int pm, pn, e, ui; };
typedef int i32x8_t __attribute__((ext_vector_type(8)));
__device__ __forceinline__ i32x8_t cat8(const bf16x8 lo, const bf16x8 hi) { const u32x4 a = __builtin_bit_cast(u32x4, lo), b = __builtin_bit_cast(u32x4, hi); return (i32x8_t){(int)a.x, (int)a.y, (int)a.z, (int)a.w, (int)b.x, (int)b.y, (int)b.z, (int)b.w}; }
__device__ __forceinline__ void glds16s(const void* sbase, unsigned voff, unsigned lds_dst) { unsigned keep;
    asm volatile("s_mov_b32 %0, m0\n\ts_mov_b32 m0, %3\n\ts_nop 0\n\tglobal_load_lds_dwordx4 %1, %2\n\ts_mov_b32 m0, %0" : "=&s"(keep) : "v"(voff), "s"(sbase), "s"(lds_dst) : "memory"); }
__device__ __forceinline__ f32x4 zero4() { f32x2 a, b; asm volatile("v_mov_b64 %0, 0" : "=v"(a)); asm volatile("v_mov_b64 %0, 0" : "=v"(b)); return (f32x4){a.x, a.y, b.x, b.y}; }
namespace pg8 {
constexpr int BM = 256, BK = 64, HALF = 128, HTB = HALF * BK * 2, STAGE_BYTES = 8 * HTB;
__device__ __forceinline__ int lds_byte(int r, int c) { const int st = (r >> 4) * 2 + (c >> 5), rr = r & 15, cc = c & 31, ob = rr * 64 + cc * 2; return st * 1024 + (ob ^ (((ob >> 9) & 1) << 5)); }
__device__ __forceinline__ void stage_rc(int b, int& R, int& C) { const int st = b / 1024, sb = b % 1024, swz = sb ^ (((sb >> 9) & 1) << 5); R = (st >> 1) * 16 + swz / 64; C = (st & 1) * 32 + (swz % 64) / 2; }
constexpr int PRE_OFF = 155648;
template <class Epi, class Sched, bool GATHER = false, bool F8 = false, bool PRE = false>
__device__ __forceinline__ void gemm_phase(LAS unsigned char* lds, const Sched& S, const Epi& E) {
    constexpr int K = D, PITCH = F8 ? K : 2 * K  , nt = PITCH / (BK * 2);
    const int tid = threadIdx.x, wid = __builtin_amdgcn_readfirstlane(tid >> 6), lane = tid & 63, wr = wid >> 2, wc = wid & 3, fr = lane & 15, fq = lane >> 4;
    unsigned voffA[2];
#pragma unroll
    for (int i = 0; i < 2; ++i) { int R, C; stage_rc(tid * 16 + i * 8192, R, C); voffA[i] = (unsigned)(R * PITCH + C * 2); }
    const size_t kstep = (size_t)(BK * 2);
    const size_t hstep = (size_t)HALF * PITCH;
    const unsigned ldsw = (unsigned)wid * 1024u, ldsb = (unsigned)(size_t)lds + ldsw;
    const int aoff = lds_byte(wr * 64 + fr, fq * 8), boff = lds_byte(wc * 32 + fr, fq * 8);
#define PG8_SA(b, h) (((b) * 2 + (h)) * HTB)
#define PG8_SB(b, h) ((4 + (b) * 2 + (h)) * HTB)
#define PG8_STAGE(bufoff, gbase, voff) do { const char* _g = (const char*)(gbase); _Pragma("unroll") for (int _i = 0; _i < 2; ++_i) glds16s(_g, (voff)[_i], ldsb + (unsigned)((bufoff) + _i * 8192)); } while (0)
#define PG8_LDA(dst, b, h) do { _Pragma("unroll") for (int m = 0; m < 4; ++m) _Pragma("unroll") for (int k = 0; k < 2; ++k) dst[m][k] = *(const LAS bf16x8*)(lds + PG8_SA(b, h) + aoff + m * 2048 + k * 1024); } while (0)
#define PG8_LDB(dst, b, h) do { _Pragma("unroll") for (int n = 0; n < 2; ++n) _Pragma("unroll") for (int k = 0; k < 2; ++k) dst[n][k] = *(const LAS bf16x8*)(lds + PG8_SB(b, h) + boff + n * 2048 + k * 1024); } while (0)
#define PG8_MMA(ai, bj, At, Bt) do { __builtin_amdgcn_s_setprio(1); _Pragma("unroll") for (int m = 0; m < 4; ++m) _Pragma("unroll") for (int n = 0; n < 2; ++n) { \
        if constexpr (F8) acc[ai][bj][m][n] = __builtin_amdgcn_mfma_scale_f32_16x16x128_f8f6f4(cat8(Bt[n][0], Bt[n][1]), cat8(At[m][0], At[m][1]), acc[ai][bj][m][n], 0, 0, 0, 0, 0, 0); \
        else { _Pragma("unroll") for (int k = 0; k < 2; ++k) acc[ai][bj][m][n] = __builtin_amdgcn_mfma_f32_16x16x32_bf16(Bt[n][k], At[m][k], acc[ai][bj][m][n], 0, 0, 0); } } __builtin_amdgcn_s_setprio(0); } while (0)
#define PG8_WAIT_V(n) asm volatile("s_waitcnt vmcnt(" #n ")" ::: "memory")
#define PG8_WAIT_L(n) asm volatile("s_waitcnt lgkmcnt(" #n ")" ::: "memory")
#define PG8_BAR __builtin_amdgcn_s_barrier()
#define PG8_SCHED __builtin_amdgcn_sched_barrier(0)
    unsigned vA[2][2];
    const char* gA = nullptr;
    if constexpr (GATHER) {
        gA = S.a_base();
        const LAS int* rw = S.rows(0);
#pragma unroll
        for (int i = 0; i < 2; ++i) { int R, C; stage_rc(tid * 16 + i * 8192, R, C);
#pragma unroll
            for (int h = 0; h < 2; ++h) vA[h][i] = ((unsigned)rw[h * HALF + R] & (F8 ? 0xffffu : ~0u)) * (unsigned)PITCH + (unsigned)(C * 2); }
    }
#define PG8_STAGEA(bufoff, P, V, kt, h) do { if constexpr (GATHER) PG8_STAGE(bufoff, gA + (size_t)(kt) * kstep, V[h]); else PG8_STAGE(bufoff, (P) + (size_t)(kt) * kstep + (size_t)(h) * hstep, voffA); } while (0)
    Unit cur, nxt; int ui = 0;
    if (!S.next(0, cur)) return;
    if constexpr (PRE) { if (wid < 2) glds16s(E.pre_src(cur, wid), (unsigned)lane * 16u, (unsigned)(size_t)lds + (unsigned)(PRE_OFF + wid * 1024)); }
    f32x4 acc[2][2][4][2];
#pragma unroll
    for (int a = 0; a < 2; ++a)
#pragma unroll
        for (int b = 0; b < 2; ++b)
#pragma unroll
            for (int m = 0; m < 4; ++m)
#pragma unroll
                for (int n = 0; n < 2; ++n) acc[a][b][m][n] = zero4();
    bf16x8 At[4][2], B0[2][2], B1[2][2];
    const char* cA = nullptr; if constexpr (!GATHER) cA = S.a_ptr(cur);
    const char* cB = S.b_ptr(cur);
    PG8_STAGE(PG8_SB(0, 0), cB, voffA); PG8_STAGE(PG8_SB(0, 1), cB + hstep, voffA); PG8_STAGEA(PG8_SA(0, 0), cA, vA, 0, 0); PG8_STAGEA(PG8_SA(0, 1), cA, vA, 0, 1);
    if (wr == 1) PG8_BAR;
    PG8_WAIT_V(2); PG8_BAR;
    PG8_STAGE(PG8_SB(1, 0), cB + kstep, voffA); PG8_STAGEA(PG8_SA(1, 0), cA, vA, 1, 0); PG8_STAGE(PG8_SB(1, 1), cB + hstep + kstep, voffA);
    PG8_WAIT_V(6); PG8_BAR;
    for (;;) {
        const bool has_next = S.next(ui + 1, nxt);
        const char* nA = cA; if constexpr (!GATHER) { if (has_next) nA = S.a_ptr(nxt); }
        const char* nB = has_next ? S.b_ptr(nxt) : cB;
#pragma unroll 1
        for (int t = 0; t < nt; t += 2) {
            const bool last = (t == nt - 2);
            const char* b2 = last ? nB : cB + (size_t)(t + 2) * kstep; const char* b3 = b2 + kstep;
            const char* pX = last ? nA : cA; const int kX = last ? 0 : t + 2;
            PG8_LDB(B0, 0, 0); PG8_LDB(B1, 0, 1); PG8_SCHED; PG8_LDA(At, 0, 0); PG8_STAGEA(PG8_SA(1, 1), cA, vA, t + 1, 1);
            PG8_WAIT_V(8); PG8_WAIT_L(0); PG8_BAR; PG8_MMA(0, 0, At, B0); PG8_MMA(0, 1, At, B1); PG8_BAR; PG8_SCHED;
            if constexpr (GATHER) { if (last && has_next) {
                const LAS int* rw = S.rows(ui + 1); int tl = tid; asm volatile("" : "+v"(tl));
#pragma unroll
                for (int i = 0; i < 2; ++i) { int R, C; stage_rc(tl * 16 + i * 8192, R, C);
#pragma unroll
                    for (int h = 0; h < 2; ++h) vA[h][i] = ((unsigned)rw[h * HALF + R] & (F8 ? 0xffffu : ~0u)) * (unsigned)PITCH + (unsigned)(C * 2); } } }
            PG8_LDA(At, 0, 1); PG8_STAGE(PG8_SB(0, 0), b2, voffA); PG8_STAGE(PG8_SB(0, 1), b2 + hstep, voffA); PG8_STAGEA(PG8_SA(0, 0), pX, vA, kX, 0);
            PG8_WAIT_V(8); PG8_WAIT_L(0); PG8_BAR; PG8_MMA(1, 0, At, B0); PG8_MMA(1, 1, At, B1); PG8_BAR; PG8_SCHED;
            PG8_LDB(B0, 1, 0); PG8_LDB(B1, 1, 1); PG8_SCHED; PG8_LDA(At, 1, 0); PG8_STAGEA(PG8_SA(0, 1), pX, vA, kX, 1);
            PG8_WAIT_V(8); PG8_WAIT_L(0); PG8_BAR; PG8_MMA(0, 0, At, B0); PG8_MMA(0, 1, At, B1); PG8_BAR; PG8_SCHED;
            PG8_LDA(At, 1, 1); PG8_STAGE(PG8_SB(1, 0), b3, voffA); PG8_STAGE(PG8_SB(1, 1), b3 + hstep, voffA); PG8_STAGEA(PG8_SA(1, 0), pX, vA, kX + 1, 0);
            PG8_WAIT_V(8); PG8_WAIT_L(0); PG8_BAR; PG8_MMA(1, 0, At, B0); PG8_MMA(1, 1, At, B1); PG8_BAR; PG8_SCHED;
        }
        if (wr == 0) PG8_BAR;
        cur.ui = ui;
        if constexpr (F8) { int tl = tid; asm volatile("" : "+v"(tl)); E(acc, cur, wr, wc, tl & 15, (tl >> 4) & 3); }
        else E(acc, cur, wr, wc, fr, fq);
        if (!has_next) break;
#pragma unroll
        for (int a = 0; a < 2; ++a)
#pragma unroll
            for (int b = 0; b < 2; ++b)
#pragma unroll
                for (int m = 0; m < 4; ++m)
#pragma unroll
                    for (int n = 0; n < 2; ++n) acc[a][b][m][n] = zero4();
        cur = nxt; cA = nA; cB = nB; ++ui;
        if (wr == 1) PG8_BAR;
        if constexpr (PRE) { if (wid < 2) glds16s(E.pre_src(cur, wid), (unsigned)lane * 16u, (unsigned)(size_t)lds + (unsigned)(PRE_OFF + (ui & 1) * 2048 + wid * 1024)); }
    }
    PG8_WAIT_V(0);
    PG8_BAR;
#undef PG8_SA
#undef PG8_SB
#undef PG8_STAGE
#undef PG8_STAGEA
#undef PG8_LDA
#undef PG8_LDB
#undef PG8_MMA
#undef PG8_WAIT_V
#undef PG8_WAIT_L
#undef PG8_BAR
#undef PG8_SCHED
}
}

template <class Epi, class Sched>
__device__ __forceinline__ void gemm_phase_simple(const Sched& S, const Epi& E) {
    const int tid = threadIdx.x, wid = __builtin_amdgcn_readfirstlane(tid >> 6), lane = tid & 63, wr = wid >> 2, wc = wid & 3, fr = lane & 15, fq = lane >> 4;
    Unit u;
    for (int i = 0; S.next(i, u); ++i) { f32x4 acc[2][2][4][2];
        gemm_unit_simple((const bf16_t*)S.a_ptr(u), (const bf16_t*)S.b_ptr(u), acc, wr, wc, fr, fq);
        E(acc, u, wr, wc, fr, fq); }
}
#ifndef FAST_GEMM
#define FAST_GEMM 1
#endif
template <class Epi, class Sched>
__device__ __forceinline__ void run_gemm(LAS unsigned char* lds, const Sched& S, const Epi& E) {
#if FAST_GEMM
    pg8::gemm_phase<Epi, Sched, false>(lds, S, E);
#else
    gemm_phase_simple<Epi, Sched>(S, E);
#endif
}
template <class Epi, class Sched>
__device__ __forceinline__ void run_gemm_f8(LAS unsigned char* lds, const Sched& S, const Epi& E) { pg8::gemm_phase<Epi, Sched, false, true>(lds, S, E); }
template <class Epi, class Sched>
__device__ __forceinline__ void run_gemm_f8_pre(LAS unsigned char* lds, const Sched& S, const Epi& E) { pg8::gemm_phase<Epi, Sched, false, true, true>(lds, S, E); }
template <class Epi, class Sched>
__device__ __forceinline__ void run_gemm_gather_f8(LAS unsigned char* lds, const Sched& S, const Epi& E) { pg8::gemm_phase<Epi, Sched, true, true, true>(lds, S, E); }
template <class Epi, class Sched>
__device__ __forceinline__ void run_gemm_gather(LAS unsigned char* lds, const Sched& S, const Epi& E) { pg8::gemm_phase<Epi, Sched, true>(lds, S, E); }
__device__ __forceinline__ bool xcd_unit(int i, int G, int c, int nM, int nN, int& pm, int& pn) {
    const int x = c & 7, s = c >> 3, nS = G >> 3;
    const int r0 = (nM * x) >> 3, r1 = (nM * (x + 1)) >> 3;
    const int q = i * nS + s; if (q >= (r1 - r0) * nN) return false;
    const int rr = q / nN; pm = r0 + rr; pn = q - rr * nN; return true;
}
struct DenseSched {
    const bf16_t* A; const bf16_t* Bt; int nM, nN, G, c;
    __device__ __forceinline__ bool next(int i, Unit& u) const { u.e = 0; return xcd_unit(i, G, c, nM, nN, u.pm, u.pn); }
    __device__ __forceinline__ const char* a_ptr(const Unit& u) const { return (const char*)(A + (size_t)u.pm * 256 * D); }
    __device__ __forceinline__ const char* b_ptr(const Unit& u) const { return (const char*)(Bt + (size_t)u.pn * 256 * D); }
};
struct QkvSched {
    const char* A; const char* Bt; int es  ; int live, G, c;
    __device__ __forceinline__ bool next(int i, Unit& u) const { u.e = 0;
        if (live) return xcd_unit(i, G, c, 144, 6, u.pm, u.pn);
        const int x = c & 7, s = c >> 3, nS = G >> 3; const int nlat = 16 * 6; const int q = i * nS + s;
        if (q < nlat) { const int rr = q / 6; u.pm = 16 * x + rr; u.pn = q - rr * 6; return true; }
        const int q2 = q - nlat; if (q2 >= 4) return false; const int t = x * 4 + q2; u.pm = 128 + (t >> 1); u.pn = 4 + (t & 1); return true; }
    __device__ __forceinline__ const char* a_ptr(const Unit& u) const { return A + (size_t)u.pm * 256 * D * es; }
    __device__ __forceinline__ const char* b_ptr(const Unit& u) const { return Bt + (size_t)u.pn * 256 * D * es; }
};
struct MoeSched {
    const bf16_t* A; const bf16_t* Bt  ; const LAS unsigned char* TE; int nM, nN, N, G, c;
    __device__ __forceinline__ bool next(int i, Unit& u) const { if (!xcd_unit(i, G, c, nM, nN, u.pm, u.pn)) return false; u.e = TE[u.pm]; return true; }
    __device__ __forceinline__ const char* a_ptr(const Unit& u) const { return (const char*)(A + (size_t)u.pm * 256 * D); }
    __device__ __forceinline__ const char* b_ptr(const Unit& u) const { return (const char*)(Bt + ((size_t)u.e * N + (size_t)u.pn * 256) * D); }
};
struct MoeSchedF8 {
    const unsigned char* A; const unsigned char* Bt; const LAS unsigned char* TE; int nM, nN, N, G, c;
    __device__ __forceinline__ bool next(int i, Unit& u) const { if (!xcd_unit(i, G, c, nM, nN, u.pm, u.pn)) return false; u.e = __builtin_amdgcn_readfirstlane((int)TE[u.pm]); return true; }
    __device__ __forceinline__ const char* a_ptr(const Unit& u) const { return (const char*)(A + (size_t)u.pm * 256 * D); }
    __device__ __forceinline__ const char* b_ptr(const Unit& u) const { return (const char*)(Bt + ((size_t)u.e * N + (size_t)u.pn * 256) * D); }
};
struct MoeGatherSchedF8 {
    const unsigned char* A; const unsigned char* Bt; const LAS unsigned char* TE; const LAS int* ROWS; int nM, nN, N, G, c;
    __device__ __forceinline__ bool next(int i, Unit& u) const { if (!xcd_unit(i, G, c, nM, nN, u.pm, u.pn)) return false; u.e = __builtin_amdgcn_readfirstlane((int)TE[u.pm]); return true; }
    __device__ __forceinline__ const char* a_base() const { return (const char*)A; }
    __device__ __forceinline__ const LAS int* rows(int ui) const { return ROWS + ui * 256; }
    __device__ __forceinline__ const char* a_ptr(const Unit& u) const { return (const char*)A; }
    __device__ __forceinline__ const char* b_ptr(const Unit& u) const { return (const char*)(Bt + ((size_t)u.e * N + (size_t)u.pn * 256) * D); }
};
struct WinTSched {
    const bf16_t* Wt  ; const bf16_t* X  ; int nTok, G, c;
    __device__ __forceinline__ bool next(int i, Unit& u) const { u.e = 0; int tok, ch; if (!xcd_unit(i, G, c, nTok, 12, tok, ch)) return false; u.pm = ch; u.pn = tok; return true; }
    __device__ __forceinline__ const char* a_ptr(const Unit& u) const { return (const char*)(Wt + (size_t)u.pm * 256 * D); }
    __device__ __forceinline__ const char* b_ptr(const Unit& u) const { return (const char*)(X + (size_t)u.pn * 256 * D); }
};
struct WinTSchedF8 {
    const unsigned char* Wt; const unsigned char* X; int nTok, G, c;
    __device__ __forceinline__ bool next(int i, Unit& u) const { u.e = 0; int tok, ch; if (!xcd_unit(i, G, c, nTok, 12, tok, ch)) return false; u.pm = ch; u.pn = tok; return true; }
    __device__ __forceinline__ const char* a_ptr(const Unit& u) const { return (const char*)(Wt + (size_t)u.pm * 256 * D); }
    __device__ __forceinline__ const char* b_ptr(const Unit& u) const { return (const char*)(X + (size_t)u.pn * 256 * D); }
};
struct MoeGatherSched {
    const bf16_t* A; const bf16_t* Bt; const LAS unsigned char* TE; const LAS int* ROWS; int nM, nN, N, G, c;
    __device__ __forceinline__ bool next(int i, Unit& u) const { if (!xcd_unit(i, G, c, nM, nN, u.pm, u.pn)) return false; u.e = TE[u.pm]; return true; }
    __device__ __forceinline__ const char* a_base() const { return (const char*)A; }
    __device__ __forceinline__ const LAS int* rows(int ui) const { return ROWS + ui * 256; }
    __device__ __forceinline__ const char* a_ptr(const Unit& u) const { return (const char*)A; }
    __device__ __forceinline__ const char* b_ptr(const Unit& u) const { return (const char*)(Bt + ((size_t)u.e * N + (size_t)u.pn * 256) * D); }
};

struct EpiQKV {
    const float* cs  ; const float* ts  ;
    bf16_t *Q, *Kb, *Vb; const float *qg, *kg; const LAS float* ropeL;
    __device__ __forceinline__ void operator()(const f32x4 (&acc)[2][2][4][2], const Unit& uu, int wr, int wc, int fr, int fq) const {
        const int pm = uu.pm, pn = uu.pn;
        const int kind = pn < 4 ? 0 : (pn == 4 ? 1 : 2);
        const float* gain = kind == 0 ? qg : kg;
        f32x4 gv[2][2];
#pragma unroll
        for (int bj = 0; bj < 2; ++bj)
#pragma unroll
            for (int n = 0; n < 2; ++n) gv[bj][n] = *(const f32x4*)(gain + 32 * bj + 16 * n + 4 * fq);
        f32x4 cv[2][2];
#pragma unroll
        for (int bj = 0; bj < 2; ++bj)
#pragma unroll
            for (int n = 0; n < 2; ++n) cv[bj][n] = *(const f32x4*)(cs + pn * 256 + bj * 128 + wc * 32 + 16 * n + 4 * fq);
#pragma unroll
        for (int ai = 0; ai < 2; ++ai)
#pragma unroll
            for (int m = 0; m < 4; ++m) {
                const int r = pm * 256 + ai * 128 + wr * 64 + m * 16 + fr;
                const bool lat = r < NLAT;
                const int b = lat ? (r >> 11) : ((r - NLAT) >> 8);
                const int pos = lat ? (r & (SEQ - 1)) : (SEQ + ((r - NLAT) & (CL - 1)));
                const float tsv = ts[r];
                f32x4 v[2][2];
#pragma unroll
                for (int bj = 0; bj < 2; ++bj)
#pragma unroll
                    for (int n = 0; n < 2; ++n) v[bj][n] = acc[ai][bj][m][n] * (cv[bj][n] * tsv);
                if (kind != 2) {
                    float ss = 0.f;
#pragma unroll
                    for (int bj = 0; bj < 2; ++bj)
#pragma unroll
                        for (int n = 0; n < 2; ++n) ss += (v[bj][n][0] * v[bj][n][0] + v[bj][n][1] * v[bj][n][1]) + (v[bj][n][2] * v[bj][n][2] + v[bj][n][3] * v[bj][n][3]);
                    ss += __shfl_xor(ss, 16); ss += __shfl_xor(ss, 32);
                    const float rinv = __builtin_amdgcn_rsqf(ss * (1.0f / 64.0f) + EPS);
#pragma unroll
                    for (int bj = 0; bj < 2; ++bj)
#pragma unroll
                        for (int n = 0; n < 2; ++n) v[bj][n] = v[bj][n] * rinv * gv[bj][n];
                    if (lat) {
#pragma unroll
                        for (int bj = 0; bj < 2; ++bj) {
                            const int to = (bj == 0 ? (pos >> 6) * 16 : 1024 + (pos & 63) * 16) + 4 * fq;
                            const f32x4 cs = *(const LAS f32x4*)(ropeL + to), sn = *(const LAS f32x4*)(ropeL + to + (bj == 0 ? 512 : 1024));
                            const f32x4 x1 = v[bj][0], x2 = v[bj][1];
                            v[bj][0] = x1 * cs - x2 * sn; v[bj][1] = x2 * cs + x1 * sn;
                        }
                    }
                    if (kind == 0) {
#pragma unroll
                        for (int bj = 0; bj < 2; ++bj)
#pragma unroll
                            for (int n = 0; n < 2; ++n) v[bj][n] = v[bj][n] * C2;
                    }
                }
                bf16_t* dst = kind == 0 ? Q + (size_t)r * D + pn * 256 + wc * 64
                                        : (kind == 1 ? Kb : Vb) + ((size_t)b * KVL + pos) * 256 + wc * 64;
#pragma unroll
                for (int bj = 0; bj < 2; ++bj) { u32x4 w; w.x = pk2(v[bj][0][0], v[bj][0][1]); w.y = pk2(v[bj][0][2], v[bj][0][3]); w.z = pk2(v[bj][1][0], v[bj][1][1]); w.w = pk2(v[bj][1][2], v[bj][1][3]);
                    *(u32x4*)(dst + 32 * bj + 8 * fq) = w; }
            }
    }
};
struct EpiBiasBf16 {
    bf16_t* O; int ldc; const float* bias0; int estride;
    __device__ __forceinline__ void operator()(const f32x4 (&acc)[2][2][4][2], const Unit& uu, int wr, int wc, int fr, int fq) const {
        const int row0 = uu.pm * 256, col0t = uu.pn * 256;
#pragma unroll
        for (int bj = 0; bj < 2; ++bj) {
            const int c = col0t + bj * 128 + wc * 32 + 8 * fq;
            const float* bp = bias0 + (size_t)uu.e * estride + c; const f32x4 b0 = *(const f32x4*)bp, b1 = *(const f32x4*)(bp + 4);
#pragma unroll
            for (int ai = 0; ai < 2; ++ai)
#pragma unroll
                for (int m = 0; m < 4; ++m) { const int r = row0 + ai * 128 + wr * 64 + m * 16 + fr; const f32x4 v0 = acc[ai][bj][m][0] + b0, v1 = acc[ai][bj][m][1] + b1;
                    u32x4 w; w.x = pk2(v0[0], v0[1]); w.y = pk2(v0[2], v0[3]); w.z = pk2(v1[0], v1[1]); w.w = pk2(v1[2], v1[3]); *(u32x4*)(O + (size_t)r * ldc + c) = w; }
        }
    }
};
struct EpiScaleBiasBf16 {
    bf16_t* O; int ldc; const float* bias0; int estride; const float* cs0  ; float sc; const LAS float* PB  ;
    __device__ __forceinline__ const float* pre_src(const Unit& u, int w) const { return (w == 0 ? bias0 : cs0) + (size_t)u.e * estride + u.pn * 256; }
    __device__ __forceinline__ void operator()(const f32x4 (&acc)[2][2][4][2], const Unit& uu, int wr, int wc, int fr, int fq) const {
        const int row0 = uu.pm * 256, col0t = uu.pn * 256; const LAS float* pb = PB + (uu.ui & 1) * 512;
#pragma unroll
        for (int bj = 0; bj < 2; ++bj) {
            const int c = col0t + bj * 128 + wc * 32 + 8 * fq; const int cl = bj * 128 + wc * 32 + 8 * fq;
            const f32x4 b0 = *(const LAS f32x4*)(pb + cl), b1 = *(const LAS f32x4*)(pb + cl + 4);
            const f32x4 s0 = *(const LAS f32x4*)(pb + 256 + cl) * sc, s1 = *(const LAS f32x4*)(pb + 256 + cl + 4) * sc;
#pragma unroll
            for (int ai = 0; ai < 2; ++ai)
#pragma unroll
                for (int m = 0; m < 4; ++m) { const int r = row0 + ai * 128 + wr * 64 + m * 16 + fr; const f32x4 v0 = acc[ai][bj][m][0] * s0 + b0, v1 = acc[ai][bj][m][1] * s1 + b1;
                    u32x4 w; w.x = pk2(v0[0], v0[1]); w.y = pk2(v0[2], v0[3]); w.z = pk2(v1[0], v1[1]); w.w = pk2(v1[2], v1[3]); *(u32x4*)(O + (size_t)r * ldc + c) = w; }
        }
    }
};
struct EpiRowBiasBf16 {
    bf16_t* O; int ldc; const float* bias;
    __device__ __forceinline__ void operator()(const f32x4 (&acc)[2][2][4][2], const Unit& uu, int wr, int wc, int fr, int fq) const {
        const int row0 = uu.pm * 256, col0t = uu.pn * 256;
#pragma unroll
        for (int ai = 0; ai < 2; ++ai)
#pragma unroll
            for (int m = 0; m < 4; ++m) { const int r = row0 + ai * 128 + wr * 64 + m * 16 + fr; const float bv = bias[r]; bf16_t* op = O + (size_t)r * ldc + col0t + wc * 32 + 8 * fq;
#pragma unroll
                for (int bj = 0; bj < 2; ++bj) { const f32x4 v0 = acc[ai][bj][m][0] + bv, v1 = acc[ai][bj][m][1] + bv;
                    u32x4 w; w.x = pk2(v0[0], v0[1]); w.y = pk2(v0[2], v0[3]); w.z = pk2(v1[0], v1[1]); w.w = pk2(v1[2], v1[3]); *(u32x4*)(op + bj * 128) = w; } }
    }
};
struct EpiRowScaleBiasBf16 {
    bf16_t* O; int ldc; const float* bias; const float* rs; const float* cs;
    __device__ __forceinline__ void operator()(const f32x4 (&acc)[2][2][4][2], const Unit& uu, int wr, int wc, int fr, int fq) const {
        const int row0 = uu.pm * 256, col0t = uu.pn * 256;
        f32x4 c0[2], c1[2];
#pragma unroll
        for (int bj = 0; bj < 2; ++bj) { const float* cp = cs + col0t + bj * 128 + wc * 32 + 8 * fq; c0[bj] = *(const f32x4*)cp; c1[bj] = *(const f32x4*)(cp + 4); }
#pragma unroll
        for (int ai = 0; ai < 2; ++ai)
#pragma unroll
            for (int m = 0; m < 4; ++m) { const int r = row0 + ai * 128 + wr * 64 + m * 16 + fr; const float bv = bias[r], rv = rs[r]; bf16_t* op = O + (size_t)r * ldc + col0t + wc * 32 + 8 * fq;
#pragma unroll
                for (int bj = 0; bj < 2; ++bj) { const f32x4 v0 = acc[ai][bj][m][0] * (c0[bj] * rv) + bv, v1 = acc[ai][bj][m][1] * (c1[bj] * rv) + bv;
                    u32x4 w; w.x = pk2(v0[0], v0[1]); w.y = pk2(v0[2], v0[3]); w.z = pk2(v1[0], v1[1]); w.w = pk2(v1[2], v1[3]); *(u32x4*)(op + bj * 128) = w; } }
    }
};
template <bool SRC32> struct EpiResid {
    const float *srcL, *srcC; bf16_t* XB; const float* gate  ; const float* bias;
    __device__ __forceinline__ void operator()(f32x4 (&acc)[2][2][4][2], const Unit& uu, int wr, int wc, int fr, int fq) const {
        const int row0 = uu.pm * 256, col0t = uu.pn * 256;
        const float* gp0 = gate + (size_t)mod_row(row0) * MODW;
        const float* sb = row0 < NLAT ? srcL + (size_t)row0 * D : srcC + (size_t)(row0 - NLAT) * D;
        bf16_t* xb = XB + (size_t)row0 * D;
#pragma unroll
        for (int bj = 0; bj < 2; ++bj) {
            const int c = col0t + bj * 128 + wc * 32 + 8 * fq;
            const f32x4 g0 = *(const f32x4*)(gp0 + c), g1 = *(const f32x4*)(gp0 + c + 4);
            f32x4 b0 = (f32x4){0.f, 0.f, 0.f, 0.f}, b1 = b0; if (bias) { b0 = *(const f32x4*)(bias + c); b1 = *(const f32x4*)(bias + c + 4); }
#pragma unroll
            for (int ai = 0; ai < 2; ++ai) {
                f32x4 x0[4], x1[4];
#pragma unroll
                for (int m = 0; m < 4; ++m) { const size_t ro = (size_t)(ai * 128 + wr * 64 + m * 16 + fr) * D + c;
                    if constexpr (SRC32) { x0[m] = *(const f32x4*)(sb + ro); x1[m] = *(const f32x4*)(sb + ro + 4); }
                    else { const u32x4 w = *(const u32x4*)(xb + ro); x0[m] = (f32x4){bflo(w.x), bfhi(w.x), bflo(w.y), bfhi(w.y)}; x1[m] = (f32x4){bflo(w.z), bfhi(w.z), bflo(w.w), bfhi(w.w)}; } }
#pragma unroll
                for (int m = 0; m < 4; ++m) { const size_t ro = (size_t)(ai * 128 + wr * 64 + m * 16 + fr) * D + c;
                    const f32x4 y0 = x0[m] + g0 * (acc[ai][bj][m][0] + b0), y1 = x1[m] + g1 * (acc[ai][bj][m][1] + b1);
                    u32x4 w; w.x = pk2(y0[0], y0[1]); w.y = pk2(y0[2], y0[3]); w.z = pk2(y1[0], y1[1]); w.w = pk2(y1[2], y1[3]); *(u32x4*)(xb + ro) = w; }
                asm volatile("" ::: "memory");
            }
        }
    }
};
template <bool F8> struct EpiSwiglu {
    bf16_t* O; const float* bgu0  ; const float* cs0  ; const LAS int* ROWS  ; const LAS float* PB  ;
    __device__ __forceinline__ const float* pre_src(const Unit& u, int w) const { return (w == 0 ? bgu0 : cs0) + (size_t)u.e * NGU + u.pn * 256; }
    __device__ __forceinline__ void operator()(const f32x4 (&acc)[2][2][4][2], const Unit& uu, int wr, int wc, int fr, int fq) const {

        const int row0 = uu.pm * 256, pn = uu.pn; const float* bgu = bgu0 + (size_t)uu.e * NGU;
        const int f = pn * 128 + wc * 32 + 8 * fq;
        f32x4 bg[2], bu[2];
#pragma unroll
        for (int n = 0; n < 2; ++n) { f32x4 q0, q1;
            if constexpr (F8) { const LAS float* pb = PB + (uu.ui & 1) * 512 + 2 * (wc * 32 + 8 * fq + 4 * n); q0 = *(const LAS f32x4*)pb; q1 = *(const LAS f32x4*)(pb + 4); }
            else { q0 = *(const f32x4*)(bgu + 2 * (f + 4 * n)); q1 = *(const f32x4*)(bgu + 2 * (f + 4 * n) + 4); }
            bg[n] = (f32x4){q0[0], q0[2], q1[0], q1[2]}; bu[n] = (f32x4){q0[1], q0[3], q1[1], q1[3]}; }
        f32x4 cg[2], cu[2];
        if constexpr (F8) {
#pragma unroll
            for (int n = 0; n < 2; ++n) { const LAS float* pb = PB + (uu.ui & 1) * 512 + 256 + 2 * (wc * 32 + 8 * fq + 4 * n); const f32x4 q0 = *(const LAS f32x4*)pb, q1 = *(const LAS f32x4*)(pb + 4);
                cg[n] = (f32x4){q0[0], q0[2], q1[0], q1[2]}; cu[n] = (f32x4){q0[1], q0[3], q1[1], q1[3]}; } }
#pragma unroll
        for (int ai = 0; ai < 2; ++ai)
#pragma unroll
            for (int m = 0; m < 4; ++m) { const int r = row0 + ai * 128 + wr * 64 + m * 16 + fr; float o[8];
                float rs = 1.0f; if constexpr (F8) rs = __builtin_bit_cast(float, (unsigned)ROWS[uu.ui * 256 + ai * 128 + wr * 64 + m * 16 + fr] & 0xffff0000u);
#pragma unroll
                for (int n = 0; n < 2; ++n) { const f32x4 gg = F8 ? acc[ai][0][m][n] * (cg[n] * rs) + bg[n] : acc[ai][0][m][n] + bg[n], uq = F8 ? acc[ai][1][m][n] * (cu[n] * rs) + bu[n] : acc[ai][1][m][n] + bu[n];
#pragma unroll
                    for (int p = 0; p < 2; ++p) {
                        f32x2 g2 = {fminf(gg[2 * p], 7.0f), fminf(gg[2 * p + 1], 7.0f)};
                        f32x2 u2 = {__builtin_amdgcn_fmed3f(uq[2 * p], -7.0f, 7.0f), __builtin_amdgcn_fmed3f(uq[2 * p + 1], -7.0f, 7.0f)};
                        const f32x2 z = g2 * (-2.4554669595930157f);
                        f32x2 e2 = {__builtin_amdgcn_exp2f(z.x), __builtin_amdgcn_exp2f(z.y)};
                        e2 = e2 + 1.0f;
                        const f32x2 r2 = {__builtin_amdgcn_rcpf(e2.x), __builtin_amdgcn_rcpf(e2.y)};
                        const f32x2 o2 = F8 ? ((u2 * F8_HS + F8_HS) * g2) * r2 : ((u2 + 1.0f) * g2) * r2;
                        o[4 * n + 2 * p] = o2.x; o[4 * n + 2 * p + 1] = o2.y; } }
                if constexpr (F8) { u32x2 w; w.x = pk4f8u(o[0], o[1], o[2], o[3]); w.y = pk4f8u(o[4], o[5], o[6], o[7]);   *(u32x2*)((unsigned char*)O + (size_t)r * D + f) = w; }
                else { u32x4 w; w.x = pk2(o[0], o[1]); w.y = pk2(o[2], o[3]); w.z = pk2(o[4], o[5]); w.w = pk2(o[6], o[7]); *(u32x4*)(O + (size_t)r * D + f) = w; } }
    }
};

__device__ __forceinline__ int slot32(int cg) { return (((cg >> 2) & 1) << 4) + ((cg >> 3) << 2) + (cg & 3); }
template <int MODE> __device__ __forceinline__ int wrow_map(int n) {
    if (MODE == 3) return n;
    if (MODE == 0) return (n & ~31) + slot32(n & 31);
    if (MODE == 1) { const int pn = n >> 8, wc = (n >> 6) & 3, bj = (n >> 5) & 1, j = n & 31;
        return (pn << 8) + (bj << 7) + (wc << 5) + (pn < 5 ? j : slot32(j)); }
    { const int f = n >> 1, pn = f >> 7, fo = f & 127; return (pn << 8) + ((n & 1) << 7) + (fo & ~31) + slot32(fo & 31); }
}
template <int MODE> __device__ __forceinline__ void transpose_item(const float* W, int N, bf16_t* WT, LAS float* scr, int item, int lane) {
    constexpr int K = D;
    const int nblk = N / 32, kb = item / nblk, nb = item % nblk, k0 = 64 * kb, n0 = 32 * nb;
#pragma unroll 8
    for (int i = 0; i < 32; ++i) { const int kk = 2 * i + (lane >> 5); scr[kk * 33 + (lane & 31)] = __builtin_nontemporal_load(W + (size_t)(k0 + kk) * N + n0 + (lane & 31)); }
    LDS_WAIT(); asm volatile("" ::: "memory");
    const int c = lane & 7;
#pragma unroll
    for (int j = 0; j < 4; ++j) { const int n = (lane >> 3) + 8 * j; const LAS float* s = scr + (8 * c) * 33 + n;
        u32x4 o; o.x = pk2(s[0 * 33], s[1 * 33]); o.y = pk2(s[2 * 33], s[3 * 33]); o.z = pk2(s[4 * 33], s[5 * 33]); o.w = pk2(s[6 * 33], s[7 * 33]);
        __builtin_nontemporal_store(o, (u32x4*)(WT + (size_t)wrow_map<MODE>(n0 + n) * K + k0 + 8 * c)); }
    LDS_WAIT(); asm volatile("" ::: "memory");
}

template <int MODE, bool WROW_SC = false> __device__ __forceinline__ void convert_item_f8(const float* W, int N, unsigned char* WT, float* wsc, LAS float* scr, LAS unsigned* AM, int par, int nb, int tid) {
    constexpr int K = D;
    const int n0 = 32 * nb, c = tid & 31, kq = tid >> 5, lane = tid & 63, wv = tid >> 6;
    __syncthreads();
    float am = 0.f;
#pragma unroll 1
    for (int i0 = 0; i0 < 64; i0 += 32) { float v[32];
#pragma unroll
        for (int i = 0; i < 32; ++i) v[i] = __builtin_nontemporal_load(W + (size_t)(kq + 16 * (i0 + i)) * N + n0 + c);
#pragma unroll
        for (int i = 0; i < 32; ++i) { scr[(kq + 16 * (i0 + i)) * 33 + c] = v[i]; am = fmaxf(am, fabsf(v[i])); } }
    __hip_atomic_fetch_max(AM + par * 32 + c, __builtin_bit_cast(unsigned, am), __ATOMIC_RELAXED, __HIP_MEMORY_SCOPE_WORKGROUP);
    if (tid < 32) AM[(par ^ 1) * 32 + tid] = 0u;
    __syncthreads();
    if (tid < 32) wsc[WROW_SC ? wrow_map<MODE>(n0 + tid) : n0 + tid] = fmaxf(__builtin_bit_cast(float, AM[par * 32 + tid]), 1e-30f) * (1.0f / 448.0f);
    const int c4 = lane & 3, nn = lane >> 2;
#pragma unroll
    for (int j = 0; j < 2; ++j) { const int n = nn + 16 * j; const float sc = 448.0f / fmaxf(__builtin_bit_cast(float, AM[par * 32 + n]), 1e-30f);
#pragma unroll
        for (int sb = 0; sb < 2; ++sb) { const int k0 = 128 * wv + 64 * sb + 16 * c4; const LAS float* sp = scr + k0 * 33 + n; float x[16];
#pragma unroll
            for (int i = 0; i < 16; ++i) x[i] = sp[i * 33] * sc;
            u32x4 o; o.x = pk4f8(x[0], x[1], x[2], x[3]); o.y = pk4f8(x[4], x[5], x[6], x[7]); o.z = pk4f8(x[8], x[9], x[10], x[11]); o.w = pk4f8(x[12], x[13], x[14], x[15]);
            __builtin_nontemporal_store(o, (u32x4*)(WT + (size_t)wrow_map<MODE>(n0 + n) * K + k0)); } }
}

template <int MODE, bool WROW_SC> __device__ __forceinline__ void convert_item64_f8(const float* W, int N, unsigned char* WT, float* wsc, LAS float* MX, int par, int nb, int tid) {
    constexpr int K = D;
    const int lane = tid & 63, wv = tid >> 6, n = 64 * nb + lane;
    const float* src = W + (size_t)(128 * wv) * N + n;
    float x[128]; float am = 0.f;
#pragma unroll
    for (int i = 0; i < 128; ++i) x[i] = __builtin_nontemporal_load(src + (size_t)i * N);
#pragma unroll
    for (int i = 0; i < 128; ++i) am = fmaxf(am, fabsf(x[i]));
    MX[(par * 8 + wv) * 64 + lane] = am;
    LDS_WAIT(); __builtin_amdgcn_s_barrier();
    float amax = 1e-30f;
#pragma unroll
    for (int w = 0; w < 8; ++w) amax = fmaxf(amax, MX[(par * 8 + w) * 64 + lane]);
    const float sc = 448.0f * __builtin_amdgcn_rcpf(amax);
    const int wrow = wrow_map<MODE>(n);
    if (wv == 0) wsc[WROW_SC ? wrow : n] = amax * (1.0f / 448.0f);
    unsigned char* dst = WT + (size_t)wrow * K + 128 * wv;
#pragma unroll
    for (int j = 0; j < 8; ++j) { u32x4 o;
        o.x = pk4f8(x[16 * j + 0] * sc, x[16 * j + 1] * sc, x[16 * j + 2] * sc, x[16 * j + 3] * sc); o.y = pk4f8(x[16 * j + 4] * sc, x[16 * j + 5] * sc, x[16 * j + 6] * sc, x[16 * j + 7] * sc);
        o.z = pk4f8(x[16 * j + 8] * sc, x[16 * j + 9] * sc, x[16 * j + 10] * sc, x[16 * j + 11] * sc); o.w = pk4f8(x[16 * j + 12] * sc, x[16 * j + 13] * sc, x[16 * j + 14] * sc, x[16 * j + 15] * sc);
        *(u32x4*)(dst + 16 * j) = o; }
}

__device__ __forceinline__ void norm_mod_store(const f32x4 (&v)[4], const f32x4 (&gs)[4], const f32x4 (&sh)[4], bf16_t* dst, int lane, f32x4 (&h)[4]) {
    float ss = 0.f;
#pragma unroll
    for (int j = 0; j < 4; ++j) ss += (v[j][0] * v[j][0] + v[j][1] * v[j][1]) + (v[j][2] * v[j][2] + v[j][3] * v[j][3]);
    ss = wave_sum(ss);
    const float rinv = __builtin_amdgcn_rsqf(ss * (1.0f / D) + EPS);
#pragma unroll
    for (int j = 0; j < 4; ++j) {
        h[j] = (v[j] * rinv) * gs[j] + sh[j];
        u32x2 w; w.x = pk2(h[j][0], h[j][1]); w.y = pk2(h[j][2], h[j][3]);
        ((u32x2*)dst)[lane + 64 * j] = w;
    }
}
__device__ __forceinline__ void norm_mod_store_f8(const f32x4 (&v)[4], const f32x4 (&gs)[4], const f32x4 (&sh)[4], unsigned char* dst, float* isc, int lane) {
    float ss = 0.f;
#pragma unroll
    for (int j = 0; j < 4; ++j) ss += (v[j][0] * v[j][0] + v[j][1] * v[j][1]) + (v[j][2] * v[j][2] + v[j][3] * v[j][3]);
    ss = wave_sum(ss);
    const float rinv = __builtin_amdgcn_rsqf(ss * (1.0f / D) + EPS);
    f32x4 h[4]; float am = 0.f;
#pragma unroll
    for (int j = 0; j < 4; ++j) { h[j] = (v[j] * rinv) * gs[j] + sh[j]; am = fmaxf(fmaxf(am, fmaxf(fabsf(h[j][0]), fabsf(h[j][1]))), fmaxf(fabsf(h[j][2]), fabsf(h[j][3]))); }
    am = wave_max_nn(am);
    const unsigned sbits = __builtin_bit_cast(unsigned, 448.0f / fmaxf(am, 1e-20f)) & 0x7f800000u;
    const float scl = __builtin_bit_cast(float, sbits);
    if (lane == 0) *isc = __builtin_bit_cast(float, 0x7f000000u - sbits);
#pragma unroll
    for (int j = 0; j < 4; ++j) { const f32x4 q = h[j] * scl; ((unsigned*)dst)[lane + 64 * j] = pk4f8(q[0], q[1], q[2], q[3]); }
}
__device__ __forceinline__ void norm_mod_store_f8a(const f32x4 (&v)[4], const f32x4 (&gs)[4], const f32x4 (&sh)[4], unsigned char* dst, float* isc, int lane) {
    float ss = 0.f;
#pragma unroll
    for (int j = 0; j < 4; ++j) ss += (v[j][0] * v[j][0] + v[j][1] * v[j][1]) + (v[j][2] * v[j][2] + v[j][3] * v[j][3]);
    ss = wave_sum(ss);
    const float rinv = __builtin_amdgcn_rsqf(ss * (1.0f / D) + EPS);
    f32x4 h[4]; float am = 0.f;
#pragma unroll
    for (int j = 0; j < 4; ++j) { h[j] = (v[j] * rinv) * gs[j] + sh[j]; am = fmaxf(fmaxf(am, fmaxf(fabsf(h[j][0]), fabsf(h[j][1]))), fmaxf(fabsf(h[j][2]), fabsf(h[j][3]))); }
    am = wave_max_nn(am);
    const unsigned sbits = __builtin_bit_cast(unsigned, 448.0f / fmaxf(am, 1e-20f)) & 0x7f800000u;
    const float scl = __builtin_bit_cast(float, sbits);
    if (lane == 0) { const unsigned ib = 0x7f000000u - sbits; asm volatile("global_store_dword %0, %1, off" :: "v"(isc), "v"(ib) : "memory"); }
#pragma unroll
    for (int j = 0; j < 4; ++j) { const f32x4 q = h[j] * scl; unsigned* dp = (unsigned*)dst + lane + 64 * j; const unsigned pv8 = pk4f8(q[0], q[1], q[2], q[3]);
        asm volatile("global_store_dword %0, %1, off" :: "v"(dp), "v"(pv8) : "memory"); }
}
__device__ __forceinline__ void load_vec_bf(const bf16_t* p, int lane, f32x4 (&v)[4]) {
#pragma unroll
    for (int j = 0; j < 4; ++j) { const u32x2 w = ((const u32x2*)p)[lane + 64 * j]; v[j] = (f32x4){bflo(w.x), bfhi(w.x), bflo(w.y), bfhi(w.y)}; }
}
__device__ __forceinline__ void load_vec(const float* p, int lane, f32x4 (&v)[4]) {
#pragma unroll
    for (int j = 0; j < 4; ++j) v[j] = ((const f32x4*)p)[lane + 64 * j];
}


namespace attn_body {
using bf16=__hip_bfloat16;
using bf16x8=__attribute__((ext_vector_type(8)))short;
using s16x4=__attribute__((ext_vector_type(4)))short;
using f32x16=__attribute__((ext_vector_type(16)))float;
using u32x4=__attribute__((ext_vector_type(4)))unsigned;
constexpr int D=64,DM=1024,KVP=256;
constexpr int NW=8,QBLK=32,QB=QBLK*NW,KVBLK=64;
__device__ __forceinline__ int crow(int r,int hi){return (r&3)+8*(r>>2)+4*hi;}
#define SBAR() __builtin_amdgcn_sched_barrier(0)
__device__ __forceinline__ void cmask(f32x16&p0,f32x16&p1,int jb,int qrel,int hi){
  const float NEG=-INFINITY; int kb=64*jb+4*hi;
  #pragma unroll
  for(int r=0;r<16;++r){int kv=kb+(r&3)+8*(r>>2); if(kv>qrel)p0[r]=NEG; if(kv+32>qrel)p1[r]=NEG;}
}

constexpr int NSLOT=3, SLOTB=8192;
constexpr int LDS_K=0, LDS_V=NSLOT*SLOTB, LDS_WS=2*NSLOT*SLOTB, LDS_OST=LDS_WS+NW*64*4, LDS_BYTES=LDS_OST+NW*4096;
constexpr float C2=0.125f*1.4426950408889634f;
__device__ __forceinline__ void glds16(const void*gsrc,unsigned lds_dst){unsigned keep;
  asm volatile("s_mov_b32 %0, m0\n\ts_mov_b32 m0, %2\n\ts_nop 0\n\tglobal_load_lds_dwordx4 %1, off\n\ts_mov_b32 m0, %0":"=&s"(keep):"v"(gsrc),"s"(lds_dst):"memory");}
__device__ __forceinline__ float max3f(float a,float b,float c){float r;asm("v_max3_f32 %0, %1, %2, %3":"=v"(r):"v"(a),"v"(b),"v"(c));return r;}
__device__ __forceinline__ float max2f(float a,float b){float r;asm("v_max_f32_e32 %0, %1, %2":"=v"(r):"v"(a),"v"(b));return r;}
__device__ __forceinline__ float fadd_s(float a,float b){float r;asm("v_add_f32_e32 %0, %1, %2":"=v"(r):"v"(a),"v"(b));return r;}
__device__ __forceinline__ float fsub_s(float a,float b){float r;asm("v_sub_f32_e32 %0, %1, %2":"=v"(r):"v"(a),"v"(b));return r;}
typedef float f32x2_t __attribute__((ext_vector_type(2))); typedef __bf16 bf16x2_t __attribute__((ext_vector_type(2)));
__device__ __forceinline__ unsigned cvtpk_s(float lo,float hi){f32x2_t v={lo,hi};bf16x2_t b=__builtin_convertvector(v,bf16x2_t);return __builtin_bit_cast(unsigned,b);}
#define WAIT_BAR(N) asm volatile("s_waitcnt vmcnt(" #N ") lgkmcnt(0)\n\ts_barrier":::"memory")

__device__ __forceinline__ void qkt(f32x16&p0,f32x16&p1,const char*Kslot,const bf16x8*qr,const f32x16&negm,int r32,int hi){
  const char*kb=Kslot+hi*1024+r32*16;
  #pragma unroll
  for(int d0=0;d0<4;++d0){
    const bf16x8 b0=*reinterpret_cast<const bf16x8*>(kb+d0*2048);
    const bf16x8 b1=*reinterpret_cast<const bf16x8*>(kb+d0*2048+512);
    if(d0==0){p0=__builtin_amdgcn_mfma_f32_32x32x16_bf16(b0,qr[0],negm,0,0,0);p1=__builtin_amdgcn_mfma_f32_32x32x16_bf16(b1,qr[0],negm,0,0,0);}
    else{p0=__builtin_amdgcn_mfma_f32_32x32x16_bf16(b0,qr[d0],p0,0,0,0);p1=__builtin_amdgcn_mfma_f32_32x32x16_bf16(b1,qr[d0],p1,0,0,0);}}
}
typedef __attribute__((address_space(3))) const char* lds_cptr;
typedef short v4i16_t __attribute__((ext_vector_type(4)));
__device__ __forceinline__ void kload8(bf16x8*kf,lds_cptr kp){
  kf[0]=*(const __attribute__((address_space(3))) bf16x8*)(kp);      kf[1]=*(const __attribute__((address_space(3))) bf16x8*)(kp+512);
  kf[2]=*(const __attribute__((address_space(3))) bf16x8*)(kp+2048); kf[3]=*(const __attribute__((address_space(3))) bf16x8*)(kp+2560);
  kf[4]=*(const __attribute__((address_space(3))) bf16x8*)(kp+4096); kf[5]=*(const __attribute__((address_space(3))) bf16x8*)(kp+4608);
  kf[6]=*(const __attribute__((address_space(3))) bf16x8*)(kp+6144); kf[7]=*(const __attribute__((address_space(3))) bf16x8*)(kp+6656);
}
__device__ __forceinline__ void kload2(bf16x8*kf,lds_cptr kp,int j){ kf[2*j]=*(const __attribute__((address_space(3))) bf16x8*)(kp+j*2048); kf[2*j+1]=*(const __attribute__((address_space(3))) bf16x8*)(kp+j*2048+512); }
__device__ __forceinline__ s16x4 vtr(lds_cptr p){ return __builtin_bit_cast(s16x4,__builtin_amdgcn_ds_read_tr16_b64_v4i16((__attribute__((address_space(3))) v4i16_t*)p)); }
__device__ __forceinline__ float rowmax(const f32x16&p0,const f32x16&p1){
  float a=max3f(p0[0],p0[1],p1[0]),b=max3f(p0[2],p0[3],p1[1]);a=max3f(a,p1[2],p1[3]);
  #pragma unroll
  for(int r=4;r<16;r+=4){a=max3f(a,p0[r],p0[r+1]);b=max3f(b,p0[r+2],p0[r+3]);a=max3f(a,p1[r],p1[r+1]);b=max3f(b,p1[r+2],p1[r+3]);}
  const float m=max2f(a,b);
  auto rr=__builtin_amdgcn_permlane32_swap(__float_as_uint(m),__float_as_uint(m),false,false);
  return max2f(__uint_as_float(rr[0]),__uint_as_float(rr[1]));
}
__device__ __forceinline__ void pv(f32x16*o,int vb,bf16x8 pa0,bf16x8 pa1,bf16x8 pa2,bf16x8 pa3){
  #pragma unroll
  for(int d0=0;d0<2;++d0){s16x4 lo[4],hi[4];
    #pragma unroll
    for(int ks=0;ks<4;++ks){
      asm volatile("ds_read_b64_tr_b16 %0,%1 offset:%c2":"=&v"(lo[ks]):"v"(vb),"i"(d0*4096+ks*1024):"memory");
      asm volatile("ds_read_b64_tr_b16 %0,%1 offset:%c2":"=&v"(hi[ks]):"v"(vb),"i"(d0*4096+ks*1024+512):"memory");}
    asm volatile("s_waitcnt lgkmcnt(0)":::"memory");SBAR();
    #define PK(k) (bf16x8){lo[k][0],lo[k][1],lo[k][2],lo[k][3],hi[k][0],hi[k][1],hi[k][2],hi[k][3]}
    o[d0]=__builtin_amdgcn_mfma_f32_32x32x16_bf16(pa0,PK(0),o[d0],0,0,0);
    o[d0]=__builtin_amdgcn_mfma_f32_32x32x16_bf16(pa1,PK(1),o[d0],0,0,0);
    o[d0]=__builtin_amdgcn_mfma_f32_32x32x16_bf16(pa2,PK(2),o[d0],0,0,0);
    o[d0]=__builtin_amdgcn_mfma_f32_32x32x16_bf16(pa3,PK(3),o[d0],0,0,0);
    #undef PK
  }
}

#ifndef ATTN_STORE16
#define ATTN_STORE16(p,v) (*(u32x4*)(p)=(v))
#endif
template<int THRL,bool STATIC=false> __device__ __forceinline__ void attn_unit(const bf16*Qu,const bf16*__restrict__ Kh,const bf16*__restrict__ Vh,bf16*Ou,const int NT,char*shm,const float mb=0.f){
  const int tid=threadIdx.x,lane=tid&63,r32=lane&31,hi=lane>>5; const int wid=__builtin_amdgcn_readfirstlane(tid>>6);
  const bf16*Qw=Qu+(long)(wid*QBLK)*DM;
  const unsigned lds0=(unsigned)(uintptr_t)shm;
  float*wsf=(float*)(shm+LDS_WS)+wid*64;
  const bf16*ksrc=Kh+(long)lane*KVP+wid*8;
  const bf16*vsrc=Vh+(long)(16*(wid&3)+(lane>>2))*KVP+(wid>>2)*32+(lane&3)*8;
  const unsigned kdst=lds0+LDS_K+wid*1024, vdst=lds0+LDS_V+wid*1024;
  #define DMA_K(t,slot) glds16(ksrc+(long)(t)*KVBLK*KVP,(unsigned)__builtin_amdgcn_readfirstlane(kdst+(slot)))
  #define DMA_V(t,slot) glds16(vsrc+(long)(t)*KVBLK*KVP,(unsigned)__builtin_amdgcn_readfirstlane(vdst+(slot)))
  const int vb0=(int)(lds0+LDS_V)+((lane>>4)&1)*32+(lane&3)*8+(4*hi+((lane&15)>>2))*64;
  const char*Kbase=shm+LDS_K; bf16x8 kf[8];
  const lds_cptr shm3=(lds_cptr)shm; const lds_cptr kp0=shm3+LDS_K+hi*1024+r32*16; const lds_cptr vp0=shm3+LDS_V+((lane>>4)&1)*32+(lane&3)*8+(4*hi+((lane&15)>>2))*64;
  DMA_K(0,0);DMA_V(0,0);DMA_K(1,SLOTB);
  bf16x8 qr[4];
  #pragma unroll
  for(int d0=0;d0<4;++d0)qr[d0]=*reinterpret_cast<const bf16x8*>(&Qw[(long)r32*DM+d0*16+hi*8]);
  float mhat=0.f,l_reg=0.f;f32x16 o[2];o[0]=f32x16{};o[1]=f32x16{};f32x16 negm=f32x16{};
  if constexpr(STATIC){ _Pragma("unroll") for(int r=0;r<16;++r)negm[r]=-mb; }
  asm volatile("":"+v"(negm));
  #define CMASK(P0,P1,t) do{}while(0)
  bool resc=false;
  #define START(P0,P1) do{ resc=false; if constexpr(!STATIC){ const float rm=rowmax(P0,P1); \
    { const float dl=rm; mhat=fadd_s(mhat,dl); \
      _Pragma("unroll") for(int r=0;r<16;++r){P0[r]=fsub_s(P0[r],dl);P1[r]=fsub_s(P1[r],dl);} \
      _Pragma("unroll") for(int r=0;r<16;++r)negm[r]=-mhat; asm volatile("":"+v"(negm)); } } \
    _Pragma("unroll") for(int r=0;r<16;++r)P0[r]=__builtin_amdgcn_exp2f(P0[r]); }while(0)
  #define RESC() do{ if(resc){ asm volatile("s_waitcnt lgkmcnt(0)":::"memory"); \
      _Pragma("unroll") for(int d_=0;d_<2;++d_) _Pragma("unroll") for(int r=0;r<16;++r)o[d_][r]*=wsf[crow(r,hi)]; } }while(0)
  f32x16 pA0,pA1,pB0,pB1;
  int sl_prev=0,sl_cur=0,sl_next=SLOTB;
  #define ROT() do{sl_prev=sl_cur;sl_cur=sl_next;sl_next=(sl_next==(NSLOT-1)*SLOTB)?0:sl_next+SLOTB;}while(0)
  DMA_K(2,2*SLOTB);
  WAIT_BAR(3);
  qkt(pA0,pA1,Kbase,qr,negm,r32,hi);asm volatile("s_nop 15\n\ts_nop 7":"+v"(pA0),"+v"(pA1));CMASK(pA0,pA1,0);
  START(pA0,pA1);
  _Pragma("unroll") for(int r=0;r<16;++r)pA1[r]=__builtin_amdgcn_exp2f(pA1[r]);
  WAIT_BAR(0);
  DMA_K(3,0);DMA_V(1,SLOTB);
  ROT();
  kload8(kf,kp0+sl_cur);
  WAIT_BAR(2);
  s16x4 vlo[8],vhi[8]; u32x4 pw0,pw1,pw2,pw3;
  #define PKW(P,B) cvtpk_s(P[B],P[B+1])
  #define PAF(k) __builtin_bit_cast(bf16x8,pw##k)
  #define VFR(i) (bf16x8){vlo[i][0],vlo[i][1],vlo[i][2],vlo[i][3],vhi[i][0],vhi[i][1],vhi[i][2],vhi[i][3]}
  #define PIN(x) asm volatile("":"+v"(x))
  #define MX3(a,b,c) __builtin_fmaxf(__builtin_fmaxf((a),(b)),(c))
  #define GAPA(MF,A0,A1,A2,A3,W0,W1,PW) do{ MF; sacc+=A0; sacc+=A1; sacc+=A2; sacc+=A3; PIN(sacc); W0; W1; PIN(PW); SBAR(); }while(0)
  #define EX(v) __builtin_amdgcn_exp2f(v)
  #define GAPB(MF,X,B) do{ MF; X[B]=EX(X[B]); X[B+1]=EX(X[B+1]); X[B+2]=EX(X[B+2]); X[B+3]=EX(X[B+3]); PIN(X); SBAR(); }while(0)
  #define VRD(i) do{ vlo[i]=vtr(vp_+(((i)>>2)*4096+((i)&3)*1024)); vhi[i]=vtr(vp_+(((i)>>2)*4096+((i)&3)*1024+512)); }while(0)
  #define KRD(G,j) do{ if(G){ kload2(kf,kp0+sl_next,j); SBAR(); } }while(0)
  #define STEP(C0,C1,P0,P1,t,GK,GV,GL) do{ SBAR(); \
    const lds_cptr vp_=vp0+sl_prev; \
    VRD(0); SBAR(); float sacc=(P0[0]+P0[1]); \
    GAPA(C0=__builtin_amdgcn_mfma_f32_32x32x16_bf16(kf[0],qr[0],negm,0,0,0), P0[2],P0[3],P0[4],P0[5],     pw0[0]=PKW(P0,0), pw0[1]=PKW(P0,2), pw0); \
    VRD(4); SBAR(); GAPA(C1=__builtin_amdgcn_mfma_f32_32x32x16_bf16(kf[1],qr[0],negm,0,0,0), P0[6],P0[7],P0[8],P0[9],     pw0[2]=PKW(P0,4), pw0[3]=PKW(P0,6), pw0); \
    VRD(1); SBAR(); GAPA(C0=__builtin_amdgcn_mfma_f32_32x32x16_bf16(kf[2],qr[1],C0,0,0,0),   P0[10],P0[11],P0[12],P0[13], pw1[0]=PKW(P0,8), pw1[1]=PKW(P0,10), pw1); \
    VRD(5); SBAR(); GAPA(C1=__builtin_amdgcn_mfma_f32_32x32x16_bf16(kf[3],qr[1],C1,0,0,0),   P0[14],P0[15],P1[0],P1[1],   pw1[2]=PKW(P0,12),pw1[3]=PKW(P0,14), pw1); \
    VRD(2); SBAR(); GAPA(C0=__builtin_amdgcn_mfma_f32_32x32x16_bf16(kf[4],qr[2],C0,0,0,0),   P1[2],P1[3],P1[4],P1[5],     pw2[0]=PKW(P1,0), pw2[1]=PKW(P1,2), pw2); \
    VRD(6); SBAR(); GAPA(C1=__builtin_amdgcn_mfma_f32_32x32x16_bf16(kf[5],qr[2],C1,0,0,0),   P1[6],P1[7],P1[8],P1[9],     pw2[2]=PKW(P1,4), pw2[3]=PKW(P1,6), pw2); \
    VRD(3); SBAR(); GAPA(C0=__builtin_amdgcn_mfma_f32_32x32x16_bf16(kf[6],qr[3],C0,0,0,0),   P1[10],P1[11],P1[12],P1[13], pw3[0]=PKW(P1,8), pw3[1]=PKW(P1,10), pw3); \
    VRD(7); SBAR(); GAPA(C1=__builtin_amdgcn_mfma_f32_32x32x16_bf16(kf[7],qr[3],C1,0,0,0),   P1[14],P1[15],0.f,0.f,       pw3[2]=PKW(P1,12),pw3[3]=PKW(P1,14), pw3); \
    l_reg+=sacc; \
    if(GK){DMA_K((t)+3,sl_cur);} if(GV){DMA_V((t)+1,sl_next);} \
    CMASK(C0,C1,t); \
    resc=false; if constexpr(!STATIC) { float a=MX3(C0[0],C0[1],C1[0]),b=MX3(C0[2],C0[3],C1[1]); a=MX3(a,C1[2],C1[3]); \
      _Pragma("unroll") for(int r=4;r<16;r+=4){a=MX3(a,C0[r],C0[r+1]);b=MX3(b,C0[r+2],C0[r+3]);a=MX3(a,C1[r],C1[r+1]);b=MX3(b,C1[r+2],C1[r+3]);} \
      float rm=__builtin_fmaxf(a,b); { auto rr=__builtin_amdgcn_permlane32_swap(__float_as_uint(rm),__float_as_uint(rm),false,false); rm=__builtin_fmaxf(__uint_as_float(rr[0]),__uint_as_float(rr[1])); } \
      resc=false; \
      if(__builtin_expect(__any(rm>(float)THRL),0)){ const float dl=__builtin_fmaxf(rm,0.f); mhat+=dl; \
        _Pragma("unroll") for(int r=0;r<16;++r){C0[r]-=dl;C1[r]-=dl;} \
        _Pragma("unroll") for(int r=0;r<16;++r)negm[r]=-mhat; asm volatile("":"+v"(negm)); \
        const float f=__builtin_amdgcn_exp2f(-dl); l_reg*=f; if(hi==0)wsf[r32]=f; resc=true; } } \
    SBAR(); \
    GAPB(o[0]=__builtin_amdgcn_mfma_f32_32x32x16_bf16(PAF(0),VFR(0),o[0],0,0,0), C0,0); \
    GAPB(o[1]=__builtin_amdgcn_mfma_f32_32x32x16_bf16(PAF(0),VFR(4),o[1],0,0,0), C0,4); \
    KRD(GL,0); GAPB(o[0]=__builtin_amdgcn_mfma_f32_32x32x16_bf16(PAF(1),VFR(1),o[0],0,0,0), C0,8); \
    KRD(GL,1); GAPB(o[1]=__builtin_amdgcn_mfma_f32_32x32x16_bf16(PAF(1),VFR(5),o[1],0,0,0), C0,12); \
    KRD(GL,2); GAPB(o[0]=__builtin_amdgcn_mfma_f32_32x32x16_bf16(PAF(2),VFR(2),o[0],0,0,0), C1,0); \
    KRD(GL,3); GAPB(o[1]=__builtin_amdgcn_mfma_f32_32x32x16_bf16(PAF(2),VFR(6),o[1],0,0,0), C1,4); \
    GAPB(o[0]=__builtin_amdgcn_mfma_f32_32x32x16_bf16(PAF(3),VFR(3),o[0],0,0,0), C1,8); \
    GAPB(o[1]=__builtin_amdgcn_mfma_f32_32x32x16_bf16(PAF(3),VFR(7),o[1],0,0,0), C1,12); \
    }while(0)
  int t=1;
  #undef CMASK
  #define CMASK(P0,P1,t) do{}while(0)
  for(;t+5<NT;t+=2){
    STEP(pB0,pB1,pA0,pA1,t,true,true,true);     WAIT_BAR(2); RESC(); ROT();
    STEP(pA0,pA1,pB0,pB1,t+1,true,true,true);   WAIT_BAR(2); RESC(); ROT();
  }
  #undef CMASK
  #define CMASK(P0,P1,t) do{}while(0)
  #define ENDW(tt) do{ if((tt)+3<NT){WAIT_BAR(2);} else if((tt)+2<NT){WAIT_BAR(1);} else {WAIT_BAR(0);} }while(0)
  for(;t+1<NT;t+=2){
    STEP(pB0,pB1,pA0,pA1,t,(t+3<NT),(t+1<NT),(t+1<NT));       ENDW(t);   RESC(); ROT();
    STEP(pA0,pA1,pB0,pB1,t+1,(t+4<NT),(t+2<NT),(t+2<NT));     ENDW(t+1); RESC(); ROT();
  }
  STEP(pB0,pB1,pA0,pA1,NT-1,false,false,false); RESC();
  { float sacc=pB0[0]+pB0[1]; _Pragma("unroll") for(int r=2;r<16;++r)sacc+=pB0[r]; _Pragma("unroll") for(int r=0;r<16;++r)sacc+=pB1[r]; l_reg+=sacc;
    pw0=(u32x4){PKW(pB0,0),PKW(pB0,2),PKW(pB0,4),PKW(pB0,6)};pw1=(u32x4){PKW(pB0,8),PKW(pB0,10),PKW(pB0,12),PKW(pB0,14)};pw2=(u32x4){PKW(pB1,0),PKW(pB1,2),PKW(pB1,4),PKW(pB1,6)};pw3=(u32x4){PKW(pB1,8),PKW(pB1,10),PKW(pB1,12),PKW(pB1,14)};
    SBAR(); pv(o,vb0+sl_cur,PAF(0),PAF(1),PAF(2),PAF(3)); }
  #undef PKW
  #undef PAF
  #undef VFR
  #undef PIN
  #undef MX3
  #undef GAPA
  #undef GAPB
  #undef EX
  #undef VRD
  #undef KRD
  #undef STEP
  #undef ENDW
  {auto rr=__builtin_amdgcn_permlane32_swap(__float_as_uint(l_reg),__float_as_uint(l_reg),false,false);l_reg=__uint_as_float(rr[0])+__uint_as_float(rr[1]);}
  if(hi==0)wsf[32+r32]=l_reg;asm volatile("s_waitcnt lgkmcnt(0)":::"memory");
  float rli[16];
  #pragma unroll
  for(int r=0;r<16;++r)rli[r]=__builtin_amdgcn_rcpf(wsf[32+crow(r,hi)]);
  bf16*Ow=Ou+(long)(wid*QBLK)*DM;
  { bf16*stg=(bf16*)(shm+LDS_OST)+wid*2048;
    #pragma unroll
    for(int r=0;r<16;++r){const int orow=crow(r,hi);
      #pragma unroll
      for(int d0=0;d0<2;++d0)stg[orow*64+d0*32+r32]=__float2bfloat16(o[d0][r]*rli[r]);}
    asm volatile("s_waitcnt lgkmcnt(0)":::"memory");
    #pragma unroll
    for(int i=0;i<4;++i){const int row=i*8+(lane>>3),ch=lane&7; const u32x4 v=*(const u32x4*)(stg+row*64+ch*8); ATTN_STORE16(Ow+(long)row*DM+ch*8,v);} }
  asm volatile("s_waitcnt lgkmcnt(0)\n\ts_barrier":::"memory");
  #undef DMA_K
  #undef DMA_V
  #undef CMASK
  #undef START
  #undef RESC
  #undef ROT
}
constexpr int ATTN_LDS_BYTES=LDS_BYTES;
#undef SBAR
#undef WAIT_BAR
}

template <int LF> struct ConvRegs { static constexpr int P = 2 * LF + 8, NFC = P * 2 / 16  , NF = (NFC + NTHR - 1) / NTHR, NW = NB * (LF / 8) / NTHR; u32x4 f[NF]; u32x4 fp[NF]; u32x4 x1[NW]; u32x4 v[NW]; };
template <int LF>
__device__ __forceinline__ void conv_issue(ConvRegs<LF>& R, const bf16_t* FIc, const bf16_t* x1src, const bf16_t* vsrc, int tid) {
    const u32x4* fs = (const u32x4*)FIc;
#pragma unroll
    for (int k = 0; k < ConvRegs<LF>::NF; ++k) { const int i = tid + k * NTHR; const bool ok = i < ConvRegs<LF>::NFC; R.f[k] = ok ? fs[i] : (u32x4){0u, 0u, 0u, 0u}; R.fp[k] = (ok && i > 0) ? fs[i - 1] : (u32x4){0u, 0u, 0u, 0u}; }
#pragma unroll
    for (int k = 0; k < ConvRegs<LF>::NW; ++k) { const int i = tid + k * NTHR; R.x1[k] = *(const u32x4*)(x1src + (size_t)i * 8); R.v[k] = *(const u32x4*)(vsrc + (size_t)i * 8); }
}
__device__ __forceinline__ void unpack8(const u32x4 w, float (&x)[8]) { x[0] = bflo(w.x); x[1] = bfhi(w.x); x[2] = bflo(w.y); x[3] = bfhi(w.y); x[4] = bflo(w.z); x[5] = bfhi(w.z); x[6] = bflo(w.w); x[7] = bfhi(w.w); }
template <int LF>
__device__ __forceinline__ void conv_commit(const ConvRegs<LF>& R, LAS unsigned char* lds, const float (&cw8)[8], int tid, int lane, int wave) {
    constexpr int P = 2 * LF + 8, WSTR = LF + 8, NW = ConvRegs<LF>::NW, CPR = LF / 8;
    LAS unsigned char* FIL = lds; LAS unsigned char* WL = lds + ((8 * P * 2 + 255) & ~255);
    LAS unsigned* EDGE = (LAS unsigned*)(lds + 144 * 1024);
#pragma unroll
    for (int k = 0; k < ConvRegs<LF>::NF; ++k) { const int i = tid + k * NTHR; if (i < ConvRegs<LF>::NFC) {
        const unsigned cat[8] = {R.fp[k].x, R.fp[k].y, R.fp[k].z, R.fp[k].w, R.f[k].x, R.f[k].y, R.f[k].z, R.f[k].w};
#pragma unroll
        for (int c = 0; c < 8; ++c) { constexpr int dummy = 0; (void)dummy; const int q0 = (16 - 2 * c) >> 2; u32x4 o;
            if (c & 1) { o.x = __builtin_amdgcn_alignbyte(cat[q0 + 1], cat[q0], 2); o.y = __builtin_amdgcn_alignbyte(cat[q0 + 2], cat[q0 + 1], 2); o.z = __builtin_amdgcn_alignbyte(cat[q0 + 3], cat[q0 + 2], 2); o.w = __builtin_amdgcn_alignbyte(cat[q0 + 4], cat[q0 + 3], 2); }
            else { o.x = cat[q0]; o.y = cat[q0 + 1]; o.z = cat[q0 + 2]; o.w = cat[q0 + 3]; }
            *(LAS u32x4*)(FIL + c * (P * 2) + 16 * i) = o; } } }
    if (lane == 0 || lane == 63) {
#pragma unroll
        for (int k = 0; k < NW; ++k) EDGE[(wave * NW + k) * 2 + (lane == 63)] = lane == 0 ? ((R.x1[k].x & 0xffffu) | (R.v[k].x << 16)) : ((R.x1[k].w >> 16) | (R.v[k].w & 0xffff0000u)); }
    __syncthreads();
#pragma unroll
    for (int k = 0; k < NW; ++k) { const int i = tid + k * NTHR; const int b = i / CPR, ch = i % CPR;
        float x[8], y[8]; unpack8(R.x1[k], x); unpack8(R.v[k], y);
        float xp = __shfl_up(x[7], 1), yp = __shfl_up(y[7], 1), xn = __shfl_down(x[0], 1), yn = __shfl_down(y[0], 1);
        if (lane == 0 && wave > 0) { const unsigned e = EDGE[((wave - 1) * NW + k) * 2 + 1]; xp = bflo(e); yp = bfhi(e); }
        if (lane == 63 && wave < NWAVES - 1) { const unsigned e = EDGE[((wave + 1) * NW + k) * 2 + 0]; xn = bflo(e); yn = bfhi(e); }
        if (ch == 0) { xp = 0.f; yp = 0.f; } if (ch == CPR - 1) { xn = 0.f; yn = 0.f; }
        float o[8];
#pragma unroll
        for (int j = 0; j < 8; ++j) { const float xa = j == 0 ? xp : x[j - 1], xb = j == 7 ? xn : x[j + 1], ya = j == 0 ? yp : y[j - 1], yb = j == 7 ? yn : y[j + 1];
            const float sx = cw8[3] + cw8[0] * xa + cw8[1] * x[j] + cw8[2] * xb, sy = cw8[7] + cw8[4] * ya + cw8[5] * y[j] + cw8[6] * yb; o[j] = sx * sy; }
        u32x4 w; w.x = pk2(o[0], o[1]); w.y = pk2(o[2], o[3]); w.z = pk2(o[4], o[5]); w.w = pk2(o[6], o[7]);
        *(LAS u32x4*)(WL + b * (WSTR * 2) + ch * 16) = w; }
}
template <int LF>
__device__ __forceinline__ void conv_compute(LAS unsigned char* lds, bf16_t* ydst, int lane, int wv) {
    constexpr int IPW = LF / 256, NBK = LF / 32, P = 2 * LF + 8, WSTR = LF + 8;
    LAS unsigned char* FIL = lds; LAS unsigned char* WL = lds + ((8 * P * 2 + 255) & ~255);
    f32x4 acc[IPW][2]; bf16x8 Bw[IPW];
#pragma unroll
    for (int ii = 0; ii < IPW; ++ii) { acc[ii][0] = (f32x4){0.f, 0.f, 0.f, 0.f}; acc[ii][1] = (f32x4){0.f, 0.f, 0.f, 0.f}; Bw[ii] = (bf16x8){0, 0, 0, 0, 0, 0, 0, 0}; }
    const int rr = lane & 15, q = lane >> 4;
    const int aBase = (rr & 7) * (P * 2) + 2 * (LF - (rr - (rr & 7)) + 8 * q);
    const int bBase = rr * (WSTR * 2) + 16 * q;
#define CONV_STEPS(CHECK) do { _Pragma("unroll") for (int dd = 0; dd < IPW; ++dd) { \
        const int delta = IPW * d + dd; \
        const bf16x8 a0 = *(const LAS bf16x8*)(FIL + aBase - 64 * delta), a1 = *(const LAS bf16x8*)(FIL + aBase - 64 * delta - 32); \
        const int jn = IPW * (wv - d) - dd; \
        if (!(CHECK) || (jn >= 0 && jn < NBK)) Bw[(IPW - dd) % IPW] = *(const LAS bf16x8*)(WL + bBase + 64 * jn); \
        _Pragma("unroll") for (int ii = 0; ii < IPW; ++ii) { const int j = IPW * (wv - d) + ii - dd; \
            if (!(CHECK) || (j >= 0 && j < NBK)) { \
                acc[ii][0] = __builtin_amdgcn_mfma_f32_16x16x32_bf16(a0, Bw[(ii - dd + IPW) % IPW], acc[ii][0], 0, 0, 0); \
                acc[ii][1] = __builtin_amdgcn_mfma_f32_16x16x32_bf16(a1, Bw[(ii - dd + IPW) % IPW], acc[ii][1], 0, 0, 0); } } } } while (0)
    { const int d = wv - 8; CONV_STEPS(true); }
    for (int d = wv - 7; d < wv; ++d) { CONV_STEPS(false); }
    { const int d = wv; CONV_STEPS(true); }
#undef CONV_STEPS
#pragma unroll
    for (int ii = 0; ii < IPW; ++ii)
#pragma unroll
        for (int h = 0; h < 2; ++h) { u32x2 w; w.x = pk2(acc[ii][h][0], acc[ii][h][1]); w.y = pk2(acc[ii][h][2], acc[ii][h][3]);
            *(u32x2*)(ydst + (size_t)rr * LF + 32 * (IPW * wv + ii) + 16 * h + 4 * q) = w; }
}


__device__ __forceinline__ void route_reduce(float (&p)[32], int lane) {
#pragma unroll
    for (int i = 0; i < 16; ++i) { const bool up = (lane & 32) != 0; const float send = up ? p[i] : p[i + 16], keep = up ? p[i + 16] : p[i]; p[i] = keep + __shfl_xor(send, 32); }
#pragma unroll
    for (int i = 0; i < 8; ++i) { const bool up = (lane & 16) != 0; const float send = up ? p[i] : p[i + 8], keep = up ? p[i + 8] : p[i]; p[i] = keep + __shfl_xor(send, 16); }
#pragma unroll
    for (int i = 0; i < 4; ++i) { const bool up = (lane & 8) != 0; const float send = up ? p[i] : p[i + 4], keep = up ? p[i + 4] : p[i]; p[i] = keep + __shfl_xor(send, 8); }
#pragma unroll
    for (int i = 0; i < 2; ++i) { const bool up = (lane & 4) != 0; const float send = up ? p[i] : p[i + 2], keep = up ? p[i + 2] : p[i]; p[i] = keep + __shfl_xor(send, 4); }
    { const bool up = (lane & 2) != 0; const float send = up ? p[0] : p[1], keep = up ? p[1] : p[0]; p[0] = keep + __shfl_xor(send, 2); }
    p[0] += __shfl_xor(p[0], 1);
}
__device__ __forceinline__ void route_top4(float val, int myE, float (&sv)[4], int (&si)[4]) {
    int rank = 0;
#pragma unroll
    for (int e = 0; e < 32; ++e) { const float o = __builtin_bit_cast(float, __builtin_amdgcn_readlane(__builtin_bit_cast(int, val), 2 * e)); rank += (o > val || (o == val && e < myE)) ? 1 : 0; }
#pragma unroll
    for (int k = 0; k < 4; ++k) { const unsigned long long m = __ballot(rank == k); const int src = __builtin_ctzll(m);
        si[k] = src >> 1; sv[k] = __builtin_bit_cast(float, __builtin_amdgcn_readlane(__builtin_bit_cast(int, val), src)); }
}
#define IN(k) (lo <= (k) && (k) < hi)
#define SEAM(k) do { if (IN(k) && IN((k) + 1)) xcd_barrier(bar); } while (0)
#define SEAMK(k, kind) SEAM(k)
#define KLOCALS \
    const float* x_in = args.in[I_X]; const float* c_in = args.in[I_C]; const float* ctx_in = args.in[I_CTX]; const float* cctx_in = args.in[I_CCTX]; \
    float* out = args.out; \
    float* modp = (float*)(ws + WS_MODP); float* modf = (float*)(ws + WS_MOD); \
    float* cosT = (float*)(ws + WS_ROPE); float* sinT = cosT + SEQ * 32; \
    float* a2tab = (float*)(ws + WS_A2); \
    int* top_e = (int*)(ws + WS_PAIR); int* ppos = top_e + NTOK * 4; float* pgate = (float*)(ppos + NTOK * 4); int* pdest = (int*)(pgate + NTOK * 4); \
    bf16_t* XB = (bf16_t*)(ws + WS_XB); \
    bf16_t* Wqkv_t = (bf16_t*)(ws + WS_WQKV); bf16_t* Wo_t = (bf16_t*)(ws + WS_WO); bf16_t* Win_t = (bf16_t*)(ws + WS_WIN); bf16_t* Wout_t = (bf16_t*)(ws + WS_WOUT); \
    bf16_t* Wgu_t = (bf16_t*)(ws + WS_WGU); bf16_t* Wdn_t = (bf16_t*)(ws + WS_WDN); \
    bf16_t* hA = (bf16_t*)(ws + WS_HA); bf16_t* Qb = (bf16_t*)(ws + WS_Q); bf16_t* Kb = (bf16_t*)(ws + WS_K); bf16_t* Vb = (bf16_t*)(ws + WS_V); \
    bf16_t* Upre = (bf16_t*)(ws + WS_UPRE); float* wsc_gu = (float*)(ws + WS_WSC_GU); float* wsc_dn = (float*)(ws + WS_WSC_DN); float* wsc_in = (float*)(ws + WS_WSC_IN); float* wsc_qkv = (float*)(ws + WS_WSC_QKV); float* tsc = (float*)(ws + WS_TSC); bf16_t* Yc = (bf16_t*)(ws + WS_YC); \
    bf16_t* XS = (bf16_t*)(ws + WS_XS); bf16_t* AB = (bf16_t*)(ws + WS_AB); int* elist = (int*)(ws + WS_ELIST); \
    const int wr = wave >> 2, wc = wave & 3, fr = lane & 15, fq = lane >> 4;
template <int layer> __device__ __forceinline__ void layer_body(const Args& args, LAS unsigned char* lds, const XcdBarrier& bar, const int tid, const int lane, const int wave, const int G, const int bid, const int lo, const int hi) {
    const int gw = bid * NWAVES + wave, NGW = G * NWAVES;
    unsigned char* ws = args.ws;
    gu32* ctl = (gu32*)(ws + WS_CTL);
    KLOCALS
        const int pb = 3 + 10 * layer;
        const int jm = layer >> 1;
        const bool ctx_live = layer < 2;
        const int nrows = ctx_live ? NTOK : NLAT;
        const float* mo = modf + (size_t)layer * NMODROW * MODW;

        if ((layer & 1) == 0) {
            if (EN_GEMM && IN(pb + 0)) {
                LAS float* ropeL = (LAS float*)(lds + 131072);
                __syncthreads();
                for (int i = tid; i < 3072; i += NTHR) { float v;
                    if (i < 1024) { const int rr = (i & 511) >> 4, jf = i & 15; v = (i < 512 ? cosT : sinT)[(rr * 64) * 32 + jf]; }
                    else { const int q = i - 1024, cc2 = (q & 1023) >> 4, jf = q & 15; v = (q < 1024 ? cosT : sinT)[cc2 * 32 + 16 + jf]; }
                    ropeL[i] = v; }
                __syncthreads();
                EpiQKV E{wsc_qkv + (size_t)jm * NQKV, tsc, Qb, Kb, Vb, args.in[I_QG] + jm * 64, args.in[I_KG] + jm * 64, ropeL};
                const QkvSched S{(const char*)hA, (const char*)Wqkv_t + (size_t)jm * NQKV * D, 1, ctx_live ? 1 : 0, G, bid};
                run_gemm_f8(lds, S, E);
            }
            SEAMK(pb + 0, 3);
            if (EN_ATT && IN(pb + 1)) {
                typedef attn_body::bf16 abf;
                const int x = bid & 7, sl = bid >> 3, nS = G >> 3;
                float gqm = fabsf(args.in[I_QG][jm * 64 + lane]), gkm = fabsf(args.in[I_KG][jm * 64 + lane]);
#pragma unroll
                for (int o = 1; o < 64; o <<= 1) { gqm = fmaxf(gqm, __shfl_xor(gqm, o)); gkm = fmaxf(gkm, __shfl_xor(gkm, o)); }
                const float mbound = __builtin_bit_cast(float, __builtin_amdgcn_readfirstlane(__builtin_bit_cast(int, 64.0f * C2 * 1.03f * gqm * gkm)));
                const bool stat = mbound < 40.0f;
                for (int q = sl; q < 256; q += nS) {
                    const int b = 2 * x + (q >> 7), kvh = (q >> 5) & 3, head = 4 * kvh + ((q >> 3) & 3), qb = q & 7;
                    abf* Qu = (abf*)(Qb + ((size_t)b * SEQ + qb * 256) * D + head * 64);
                    const abf* Kp = (const abf*)(Kb + (size_t)b * KVL * 256 + kvh * 64); const abf* Vp = (const abf*)(Vb + (size_t)b * KVL * 256 + kvh * 64);
                    if (stat) attn_body::attn_unit<8, true>(Qu, Kp, Vp, Qu, KVL / 64, (char*)lds, mbound);
                    else attn_body::attn_unit<8, false>(Qu, Kp, Vp, Qu, KVL / 64, (char*)lds);
                }
                if (ctx_live) for (int q = sl; q < 32; q += nS) {
                    const int b = 2 * x + (q >> 4), head = q & 15, kvh = head >> 2;
                    abf* Qu = (abf*)(Qb + ((size_t)NLAT + b * CL) * D + head * 64);
                    attn_body::attn_unit<8>(Qu, (const abf*)(Kb + ((size_t)b * KVL + SEQ) * 256 + kvh * 64), (const abf*)(Vb + ((size_t)b * KVL + SEQ) * 256 + kvh * 64), Qu, CL / 64, (char*)lds);
                }
            }
            SEAMK(pb + 1, 4);
            if (EN_GEMM && IN(pb + 2)) {
                EpiResid<layer == 0> E{x_in, ctx_in, XB, mo + 2 * D, nullptr};
                const bf16_t* Wt = Wo_t + (size_t)jm * D * D;
                const DenseSched S{Qb, Wt, nrows / 256, 4, G, bid};
                run_gemm(lds, S, E);
            }
            SEAMK(pb + 2, 5);
        } else {
            const float* cw = args.in[I_HCW] + (size_t)jm * 3 * NHY; const float* cb = args.in[I_HCB] + (size_t)jm * NHY;
            if (EN_GEMM && IN(pb + 0)) {
                const EpiRowScaleBiasBf16 E{Upre, NTOK, args.in[I_HBIN] + (size_t)jm * NHY, wsc_in + (size_t)jm * NHY, tsc};
                const WinTSchedF8 S{(const unsigned char*)Win_t + (size_t)jm * NHY * D, (const unsigned char*)hA, nrows / 256, G, bid};
                run_gemm_f8(lds, S, E);
            }
            SEAMK(pb + 0, 6);
            if (EN_CONV && IN(pb + 2)) {
                const bf16_t* uT = Upre;
#define CONV_CW8(C) { cw[0 * NHY + D + (C)], cw[1 * NHY + D + (C)], cw[2 * NHY + D + (C)], cb[D + (C)], cw[0 * NHY + 2 * D + (C)], cw[1 * NHY + 2 * D + (C)], cw[2 * NHY + 2 * D + (C)], cb[2 * D + (C)] }
                { const bf16_t* FIb = (const bf16_t*)(ws + (jm == 0 ? WS_FI0 : WS_FI1));
                  ConvRegs<SEQ> R; int c = bid;
                  if (c < 1024) conv_issue<SEQ>(R, FIb + (size_t)c * 8 * FP_L, uT + (size_t)(D + c) * NTOK, uT + (size_t)(2 * D + c) * NTOK, tid);
                  for (; c < 1024; c += G) {
                      const float cw8[8] = CONV_CW8(c);
                      __syncthreads();
                      conv_commit<SEQ>(R, lds, cw8, tid, lane, wave);
                      __syncthreads();
                      if (c + G < 1024) conv_issue<SEQ>(R, FIb + (size_t)(c + G) * 8 * FP_L, uT + (size_t)(D + c + G) * NTOK, uT + (size_t)(2 * D + c + G) * NTOK, tid);
                      conv_compute<SEQ>(lds, Yc + (size_t)c * NB * SEQ, lane, wave);
                  } }
                if (ctx_live) for (int c = bid; c < 1024; c += G) {
                    const float cw8[8] = CONV_CW8(c);
                    ConvRegs<CL> R; conv_issue<CL>(R, (const bf16_t*)(ws + WS_FI2) + (size_t)c * 8 * FP_C, uT + (size_t)(D + c) * NTOK + NLAT, uT + (size_t)(2 * D + c) * NTOK + NLAT, tid);
                    __syncthreads(); conv_commit<CL>(R, lds, cw8, tid, lane, wave); __syncthreads();
                    conv_compute<CL>(lds, Yc + WC_CTX_OFF + (size_t)c * NB * CL, lane, wave);
                }
#undef CONV_CW8
            }
            SEAMK(pb + 2, 8);
            if (EN_MISC && IN(pb + 3)) {
                LAS unsigned char* T = lds;
                const bf16_t* uT = Upre;
                const int nlat_u = NB * 16 * 4, nctx_u = ctx_live ? NB * 2 * 4 : 0;
                const int hw = tid >> 5, l32 = tid & 31;
                for (int u = bid; u < nlat_u + nctx_u; u += G) {
                    int b, s0, c0, Ls, rowb; const bf16_t* srcb;
                    if (u < nlat_u) { b = u >> 6; s0 = ((u >> 2) & 15) * 128; c0 = (u & 3) * 256; Ls = SEQ; rowb = b * SEQ; srcb = Yc; }
                    else { const int q = u - nlat_u; b = q >> 3; s0 = ((q >> 2) & 1) * 128; c0 = (q & 3) * 256; Ls = CL; rowb = NLAT + b * CL; srcb = Yc + WC_CTX_OFF; }
                    __syncthreads();
                    { const int ch = tid & 15;
                      u32x4 yw[8], uw[8]; unsigned short ep[8], en[8]; float wq[8][4];
#pragma unroll
                      for (int i = 0; i < 8; ++i) { const int cg = c0 + i * 32 + (tid >> 4);
                          yw[i] = *(const u32x4*)(srcb + ((size_t)cg * NB + b) * Ls + s0 + ch * 8);
                          const bf16_t* up = uT + (size_t)cg * NTOK + rowb + s0 + ch * 8; uw[i] = *(const u32x4*)up; ep[i] = up[-1]; en[i] = up[8];
                          wq[i][0] = cw[0 * NHY + cg]; wq[i][1] = cw[1 * NHY + cg]; wq[i][2] = cw[2 * NHY + cg]; wq[i][3] = cb[cg]; }
#pragma unroll
                      for (int i = 0; i < 8; ++i) { const int c = i * 32 + (tid >> 4);
                          float x[8], y[8]; unpack8(uw[i], x); unpack8(yw[i], y);
                          float xp = __shfl_up(x[7], 1), xn = __shfl_down(x[0], 1);
                          if (ch == 0) xp = s0 > 0 ? bf2f(ep[i]) : 0.f;
                          if (ch == 15) xn = s0 + 128 < Ls ? bf2f(en[i]) : 0.f;
                          float o[8];
#pragma unroll
                          for (int j = 0; j < 8; ++j) { const float xa = j == 0 ? xp : x[j - 1], xb = j == 7 ? xn : x[j + 1]; o[j] = (wq[i][3] + wq[i][0] * xa + wq[i][1] * x[j] + wq[i][2] * xb) * y[j]; }
                          u32x4 w; w.x = pk2(o[0], o[1]); w.y = pk2(o[2], o[3]); w.z = pk2(o[4], o[5]); w.w = pk2(o[6], o[7]);
                          *(LAS u32x4*)(T + c * 256 + ((ch ^ ((c >> 3) & 15)) * 16)) = w; } }
                    __syncthreads();
                    const int cc = c0 + 8 * l32, sb = s0 + 8 * hw;
                    u32x4 zv[8];
#pragma unroll
                    for (int c = 0; c < 8; ++c) zv[c] = *(const LAS u32x4*)(T + (8 * l32 + c) * 256 + ((hw ^ (l32 & 15)) * 16));
#pragma unroll
                    for (int si = 0; si < 8; ++si) { unsigned hv[8];
#pragma unroll
                        for (int c = 0; c < 8; ++c) { const unsigned wd = zv[c][si >> 1]; hv[c] = (si & 1) ? (wd >> 16) : (wd & 0xffffu); }
                        u32x4 o; o.x = hv[0] | (hv[1] << 16); o.y = hv[2] | (hv[3] << 16); o.z = hv[4] | (hv[5] << 16); o.w = hv[6] | (hv[7] << 16);
                        *(u32x4*)(hA + (size_t)(rowb + sb + si) * D + cc) = o; }
                }
            }
            SEAMK(pb + 3, 9);
            if (EN_GEMM && IN(pb + 4)) {
                EpiResid<layer == 0> E{x_in, ctx_in, XB, mo + 2 * D, args.in[I_HBOUT] + (size_t)jm * D};
                const bf16_t* Wt = Wout_t + (size_t)jm * D * D;
                const DenseSched S{hA, Wt, nrows / 256, 4, G, bid};
                run_gemm(lds, S, E);
            }
            SEAMK(pb + 4, 10);
        }

        gu32* cnt = ctl + CW_CNT + layer * 32 * 64;
        if (EN_ROUTER && IN(pb + 5)) {
            constexpr int WSTR = D + 8, MAXT = 20;
            LAS bf16_t* WT = (LAS bf16_t*)lds;
            LAS float* CB = (LAS float*)(lds + 2 * 32 * WSTR * 2);
            LAS float* CRED = CB + 32;
            LAS int* LCNT = (LAS int*)(CRED + 512);
            LAS int* PREC = LCNT + 64;
            LAS float* RINV = (LAS float*)(PREC + 8 * MAXT * 4);
            LAS unsigned* SCLB = (LAS unsigned*)(RINV + 8 * MAXT);
            __syncthreads();
            if (tid < 64) LCNT[tid] = 0;
            for (int i = tid; i < 8 * MAXT * 4; i += NTHR) PREC[i] = -1;
            const int TPW = (((nrows + NGW - 1) / NGW) + 1) & ~1;
            const int rf = gw * TPW; const int nval = rf >= nrows ? 0 : (nrows - rf < TPW ? nrows - rf : TPW);
            { int curb = -1; f32x4 gs[4], sh[4]; u32x2 w0[4], w1[4], w2[4];
              auto ldrow = [&](u32x2 (&w)[4], int row) {
#pragma unroll
                  for (int j = 0; j < 4; ++j) w[j] = ((const u32x2*)(XB + (size_t)row * D))[lane + 64 * j]; };
              auto rowbody = [&](u32x2 (&w)[4], int ti) { const int r = rf + ti; f32x4 v[4];
#pragma unroll
                  for (int j = 0; j < 4; ++j) v[j] = (f32x4){bflo(w[j].x), bfhi(w[j].x), bflo(w[j].y), bfhi(w[j].y)};
                  if (ti + 3 < nval) ldrow(w, r + 3);
                  const int bq = mod_row(r);
                  if (bq != curb) { const float* mr = mo + (size_t)bq * MODW; load_vec(mr + 4 * D, lane, gs); load_vec(mr + 3 * D, lane, sh); curb = bq;
                      asm volatile("" : "+v"(gs[0]), "+v"(gs[1]), "+v"(gs[2]), "+v"(gs[3]), "+v"(sh[0]), "+v"(sh[1]), "+v"(sh[2]), "+v"(sh[3])); }
                  float ss = 0.f;
#pragma unroll
                  for (int j = 0; j < 4; ++j) ss += (v[j][0] * v[j][0] + v[j][1] * v[j][1]) + (v[j][2] * v[j][2] + v[j][3] * v[j][3]);
                  ss = wave_sum(ss); const float rinv = __builtin_amdgcn_rsqf(ss * (1.0f / D) + EPS);
                  f32x4 hq[4]; float am = 0.f;
#pragma unroll
                  for (int j = 0; j < 4; ++j) { hq[j] = (v[j] * rinv) * gs[j] + sh[j]; am = fmaxf(fmaxf(am, fmaxf(fabsf(hq[j][0]), fabsf(hq[j][1]))), fmaxf(fabsf(hq[j][2]), fabsf(hq[j][3]))); }
                  am = wave_max_nn(am);
                  const unsigned sbits = __builtin_bit_cast(unsigned, 448.0f / fmaxf(am, 1e-20f)) & 0x7f800000u;
                  const float scl = __builtin_bit_cast(float, sbits);
                  if (lane == 0) { RINV[wave * MAXT + ti] = rinv; SCLB[wave * MAXT + ti] = 0x7f000000u - sbits; }
#pragma unroll
                  for (int j = 0; j < 4; ++j) { const f32x4 h = hq[j] * scl; unsigned* dp = (unsigned*)((unsigned char*)hA + (size_t)r * D) + lane + 64 * j; const unsigned pv8 = pk4f8(h[0], h[1], h[2], h[3]);
                      asm volatile("global_store_dword %0, %1, off" :: "v"(dp), "v"(pv8) : "memory"); } };
              if (nval > 0) ldrow(w0, rf); if (nval > 1) ldrow(w1, rf + 1); if (nval > 2) ldrow(w2, rf + 2);
              for (int ti = 0; ti < nval; ti += 3) { rowbody(w0, ti); if (ti + 1 < nval) rowbody(w1, ti + 1); if (ti + 2 < nval) rowbody(w2, ti + 2); } }
            const int rb0 = bid * NWAVES * TPW; const int rb1 = (rb0 + NWAVES * TPW < nrows ? rb0 + NWAVES * TPW : nrows) - 1;
            const int bb0 = rb0 < nrows ? mod_row(rb0) : 1, bb1 = rb0 < nrows ? mod_row(rb1) : 0;
            const float* rw = args.in[I_RW] + (size_t)layer * D * NE; const float* rbias = args.in[I_RB] + layer * NE;
            for (int bq = bb0; bq <= bb1; ++bq) {
                __syncthreads();
                { const float* gsb = mo + (size_t)bq * MODW + 4 * D; const float* shb = mo + (size_t)bq * MODW + 3 * D;
                  const int e = tid & 31; float cpart = 0.f;
#pragma unroll 4
                  for (int jj = 0; jj < 8; ++jj) { const int k0 = 8 * ((tid >> 5) + 16 * jj);
                      const f32x4 g0 = *(const f32x4*)(gsb + k0), g1 = *(const f32x4*)(gsb + k0 + 4), s0 = *(const f32x4*)(shb + k0), s1 = *(const f32x4*)(shb + k0 + 4);
                      float wv[8];
#pragma unroll
                      for (int q = 0; q < 8; ++q) wv[q] = rw[(size_t)(k0 + q) * NE + e];
                      float pv[8]; unsigned hw[4], lw[4];
#pragma unroll
                      for (int q = 0; q < 4; ++q) { pv[q] = g0[q] * wv[q]; pv[4 + q] = g1[q] * wv[4 + q]; cpart += s0[q] * wv[q] + s1[q] * wv[4 + q]; }
#pragma unroll
                      for (int q = 0; q < 4; ++q) { hw[q] = pk2(pv[2 * q], pv[2 * q + 1]); lw[q] = pk2(pv[2 * q] - bflo(hw[q]), pv[2 * q + 1] - bfhi(hw[q])); }
                      *(LAS u32x4*)(WT + (size_t)e * WSTR + k0) = (u32x4){hw[0], hw[1], hw[2], hw[3]};
                      *(LAS u32x4*)(WT + (size_t)(32 + e) * WSTR + k0) = (u32x4){lw[0], lw[1], lw[2], lw[3]}; }
                  CRED[(tid >> 5) * 32 + e] = cpart; }
                __syncthreads();
                if (tid < 32) { float c = rbias[tid];
#pragma unroll
                    for (int q = 0; q < 16; ++q) c += CRED[q * 32 + tid];
                    CB[tid] = c; }
                __syncthreads();
                if (nval > 0 && mod_row(rf) <= bq && bq <= mod_row(rf + nval - 1)) {
                    const int e = lane & 31, kh = lane >> 5; const int trow = rf + (e < nval ? e : nval - 1);
                    const bf16_t* ap = XB + (size_t)trow * D + 8 * kh;
                    const LAS bf16_t* bhp = WT + (size_t)e * WSTR + 8 * kh; const LAS bf16_t* blp = bhp + 32 * WSTR;
                    f32x16 acc;
#pragma unroll
                    for (int q = 0; q < 16; ++q) acc[q] = 0.f;
                    bf16x8 a0[8], a1[8];
#pragma unroll
                    for (int i = 0; i < 8; ++i) a0[i] = *(const bf16x8*)(ap + 16 * i);
#pragma unroll 1
                    for (int kb = 0; kb < D / 16; kb += 16) {
#pragma unroll
                        for (int i = 0; i < 8; ++i) a1[i] = *(const bf16x8*)(ap + 16 * (kb + 8 + i));
#pragma unroll
                        for (int i = 0; i < 8; ++i) { acc = __builtin_amdgcn_mfma_f32_32x32x16_bf16(a0[i], *(const LAS bf16x8*)(bhp + 16 * (kb + i)), acc, 0, 0, 0);
                            acc = __builtin_amdgcn_mfma_f32_32x32x16_bf16(a0[i], *(const LAS bf16x8*)(blp + 16 * (kb + i)), acc, 0, 0, 0); }
                        if (kb + 16 < D / 16) {
#pragma unroll
                            for (int i = 0; i < 8; ++i) a0[i] = *(const bf16x8*)(ap + 16 * (kb + 16 + i)); }
#pragma unroll
                        for (int i = 0; i < 8; ++i) { acc = __builtin_amdgcn_mfma_f32_32x32x16_bf16(a1[i], *(const LAS bf16x8*)(bhp + 16 * (kb + 8 + i)), acc, 0, 0, 0);
                            acc = __builtin_amdgcn_mfma_f32_32x32x16_bf16(a1[i], *(const LAS bf16x8*)(blp + 16 * (kb + 8 + i)), acc, 0, 0, 0); } }
                    const float cbe = CB[e];
                    const int hf = lane >> 5;
#pragma unroll
                    for (int r = 0; r < 10; ++r) { const int tA = (r & 3) + 8 * (r >> 2), tB = tA + 4;
                        const bool okA = tA < nval && mod_row(rf + tA) == bq, okB = tB < nval && mod_row(rf + (tB < MAXT ? tB : 0)) == bq;
                        if (okA || okB) {
                            const int tmine = hf ? (tB < MAXT ? tB : MAXT - 1) : tA;
                            float val = RINV[wave * MAXT + tmine] * acc[r] + cbe;
                            float sv[4]; int si[4];
#pragma unroll
                            for (int k = 0; k < 4; ++k) {
                                int x = __builtin_bit_cast(int, val); float m = val;
                                m = fmaxf(m, __builtin_bit_cast(float, __builtin_amdgcn_update_dpp(x, x, 0xB1, 0xF, 0xF, false))); x = __builtin_bit_cast(int, m);
                                m = fmaxf(m, __builtin_bit_cast(float, __builtin_amdgcn_update_dpp(x, x, 0x4E, 0xF, 0xF, false))); x = __builtin_bit_cast(int, m);
                                m = fmaxf(m, __builtin_bit_cast(float, __builtin_amdgcn_update_dpp(x, x, 0x124, 0xF, 0xF, false))); x = __builtin_bit_cast(int, m);
                                m = fmaxf(m, __builtin_bit_cast(float, __builtin_amdgcn_update_dpp(x, x, 0x128, 0xF, 0xF, false)));
                                m = fmaxf(m, __shfl_xor(m, 16));
                                const unsigned long long mk = __ballot(val == m);
                                const int wlo = __builtin_ctz((unsigned)mk | 0x80000000u), whi = __builtin_ctz((unsigned)(mk >> 32) | 0x80000000u);
                                const int win = hf ? whi : wlo;
                                sv[k] = m; si[k] = win; if ((lane & 31) == win) val = -INFINITY; }
                            if ((lane & 31) < 4 && (hf ? okB : okA)) { const int k = lane & 31; const float e1 = __expf(sv[1] - sv[0]), e2 = __expf(sv[2] - sv[0]), e3 = __expf(sv[3] - sv[0]); const float inv = 1.0f / (1.0f + e1 + e2 + e3);
                                const int ex = k == 0 ? si[0] : (k == 1 ? si[1] : (k == 2 ? si[2] : si[3])); const float gt = (k == 0 ? 1.0f : (k == 1 ? e1 : (k == 2 ? e2 : e3))) * inv;
                                const int tt = hf ? tB : tA; const int rr = rf + tt; const int rk = __hip_atomic_fetch_add(LCNT + ex, 1, __ATOMIC_RELAXED, __HIP_MEMORY_SCOPE_WORKGROUP);
                                top_e[rr * 4 + k] = ex; pgate[rr * 4 + k] = gt; PREC[(wave * MAXT + tt) * 4 + k] = ex | (rk << 8); } } }
                }
            }
            __syncthreads();
            if (tid < 32) LCNT[32 + tid] = (int)__hip_atomic_fetch_add(cnt + tid * 64, (unsigned)LCNT[tid], RLX_AGENT);
            __syncthreads();
            for (int i = tid; i < 8 * MAXT * 4; i += NTHR) { const int rec = PREC[i]; if (rec >= 0) { const int e = rec & 255, rank = rec >> 8, w = i / (MAXT * 4), ti = (i / 4) % MAXT, k = i & 3;
                const int r = (bid * NWAVES + w) * TPW + ti; const int pos = LCNT[32 + e] + rank; ppos[r * 4 + k] = pos; elist[(size_t)e * NTOK + pos] = r | (int)SCLB[w * MAXT + ti]; } }
        }
        SEAMK(pb + 5, 11);
        LAS int* PADS = (LAS int*)(lds + LDS_BYTES - 4096);
        LAS unsigned char* TE = (LAS unsigned char*)(PADS + 128);
        if (IN(pb + 7) || IN(pb + 8) || IN(pb + 9)) {
            __syncthreads();
            if (tid < 32) PADS[64 + tid] = (int)__hip_atomic_load(cnt + tid * 64, RLX_AGENT);
            __syncthreads();
            if (tid < 64) {
                const int nt = lane < 32 ? (PADS[64 + lane] + 255) >> 8 : 0; int inc = nt;
#pragma unroll
                for (int o = 1; o < 32; o <<= 1) { const int v = __shfl_up(inc, o); if (lane >= o) inc += v; }
                if (lane < 32) PADS[lane] = (inc - nt) << 8; if (lane == 31) PADS[32] = inc << 8;
            }
            __syncthreads();
            { const int ntile = PADS[32] >> 8; for (int t = tid; t < ntile; t += NTHR) { int e = 0;
#pragma unroll
                  for (int st = 16; st >= 1; st >>= 1) if (PADS[e + st] <= (t << 8)) e += st;
                  TE[t] = (unsigned char)e; } }
            __syncthreads();
        }
        if (EN_GEMM && IN(pb + 7)) {
            const int ntile = PADS[32] >> 8;
            LAS int* ROWS = (LAS int*)(lds + 131072);
            { int nun = 0; { Unit uu; while (xcd_unit(nun, G, bid, ntile, 8, uu.pm, uu.pn)) ++nun; }
              int tokv[12];
#pragma unroll
              for (int k = 0; k < 12; ++k) { const int idx = tid + k * NTHR, ui = idx >> 8; tokv[k] = 0;
                  if (ui < nun) { Unit uu; (void)xcd_unit(ui, G, bid, ntile, 8, uu.pm, uu.pn); const int e = TE[uu.pm]; const int pos = uu.pm * 256 - PADS[e] + (idx & 255);
                      if (pos < PADS[64 + e]) tokv[k] = elist[(size_t)e * NTOK + pos]; } }
#pragma unroll
              for (int k = 0; k < 12; ++k) { const int idx = tid + k * NTHR; if ((idx >> 8) < nun) ROWS[idx] = tokv[k]; } }
            __syncthreads();
            const MoeGatherSchedF8 S{(const unsigned char*)hA, (const unsigned char*)Wgu_t + (size_t)layer * NE * NGU * D, TE, ROWS, ntile, 8, NGU, G, bid};
            const EpiSwiglu<true> E{AB, args.in[I_BGU] + (size_t)layer * NE * NGU, wsc_gu + (size_t)layer * NE * NGU, ROWS, (const LAS float*)(lds + pg8::PRE_OFF)};
            run_gemm_gather_f8(lds, S, E);
        }
        SEAMK(pb + 7, 12);
        if (EN_GEMM && IN(pb + 8)) {
            const int ntile = PADS[32] >> 8;
            const MoeSchedF8 S{(const unsigned char*)AB, (const unsigned char*)Wdn_t + (size_t)layer * NE * D * D, TE, ntile, 4, D, G, bid};
            const EpiScaleBiasBf16 E{XS, D, args.in[I_BDN] + (size_t)layer * NE * D, D, wsc_dn + (size_t)layer * NE * D, 1.0f / F8_HS, (const LAS float*)(lds + pg8::PRE_OFF)};
            run_gemm_f8_pre(lds, S, E);
        }
        SEAMK(pb + 8, 13);
        if (EN_MISC && IN(pb + 9)) {
            const bool has_next = layer + 1 < DEPTH;
            const float* mo_n = modf + (size_t)(layer + 1) * NMODROW * MODW; const float* g1n = args.in[I_N1G] + (has_next ? (layer + 1) * D : 0);
            const int nnext = (layer + 1 < 3) ? NTOK : NLAT;
            const int TPW = (nrows + NGW - 1) / NGW;
            const int r0 = gw * TPW; const int nrw = r0 >= nrows ? 0 : (nrows - r0 < TPW ? nrows - r0 : TPW);
            int curb = -1; f32x4 gm[4], gsn[4], shn[4];
            u32x2 yA[4][4], yB[4][4], xA[4], xB_[4]; float gA[4], gB[4]; int teA[4], ppA[4], teB[4], ppB[4]; float pgA[4], pgB[4];
            auto ld_idx = [&](int (&te)[4], int (&pp)[4], float (&pg)[4], int r) {
#pragma unroll
                for (int k = 0; k < 4; ++k) { te[k] = top_e[r * 4 + k]; pp[k] = ppos[r * 4 + k]; pg[k] = pgate[r * 4 + k]; } };
            auto issue = [&](u32x2 (&y)[4][4], u32x2 (&x)[4], float (&g)[4], const int (&te)[4], const int (&pp)[4], const float (&pg)[4], int r) {
#pragma unroll
                for (int k = 0; k < 4; ++k) { const int dest = PADS[te[k]] + pp[k]; g[k] = pg[k]; const u32x2* yr = (const u32x2*)(XS + (size_t)dest * D);
#pragma unroll
                    for (int j = 0; j < 4; ++j) y[k][j] = yr[lane + 64 * j]; }
#pragma unroll
                for (int j = 0; j < 4; ++j) x[j] = ((const u32x2*)(XB + (size_t)r * D))[lane + 64 * j]; };
            auto fin = [&](u32x2 (&y)[4][4], u32x2 (&x)[4], float (&g)[4], int ti) {
                const int r = r0 + ti;
                const int b = mod_row(r);
                if (b != curb) { load_vec(mo + (size_t)b * MODW + 5 * D, lane, gm); curb = b;
                    if (has_next) { const float* mn = mo_n + (size_t)b * MODW; load_vec(mn + D, lane, gsn); load_vec(mn, lane, shn);
                        asm volatile("" : "+v"(gsn[0]), "+v"(gsn[1]), "+v"(gsn[2]), "+v"(gsn[3]), "+v"(shn[0]), "+v"(shn[1]), "+v"(shn[2]), "+v"(shn[3])); }
                    asm volatile("" : "+v"(gm[0]), "+v"(gm[1]), "+v"(gm[2]), "+v"(gm[3])); }
                f32x4 v[4];
#pragma unroll
                for (int j = 0; j < 4; ++j) { f32x4 yy = (f32x4){0.f, 0.f, 0.f, 0.f};
#pragma unroll
                    for (int k = 0; k < 4; ++k) { const u32x2 w = y[k][j]; yy[0] += g[k] * bflo(w.x); yy[1] += g[k] * bfhi(w.x); yy[2] += g[k] * bflo(w.y); yy[3] += g[k] * bfhi(w.y); }
                    const f32x4 xv = (f32x4){bflo(x[j].x), bfhi(x[j].x), bflo(x[j].y), bfhi(x[j].y)};
                    v[j] = xv + gm[j] * yy;
                    if (layer == DEPTH - 1) { f32x4* op = (f32x4*)(out + (size_t)r * D) + lane + 64 * j; asm volatile("global_store_dwordx4 %0, %1, off\n\ts_nop 1" :: "v"(op), "v"(v[j]) : "memory"); }
                    else { u32x2 w; w.x = pk2(v[j][0], v[j][1]); w.y = pk2(v[j][2], v[j][3]); u32x2* op = (u32x2*)(XB + (size_t)r * D) + lane + 64 * j; asm volatile("global_store_dwordx2 %0, %1, off" :: "v"(op), "v"(w) : "memory"); } }
                if (has_next && r < nnext) { const int rp = (layer & 1) == 0 ? (r & ~31) + slot32(r & 31) : r;
                    norm_mod_store_f8a(v, gsn, shn, (unsigned char*)hA + (size_t)rp * D, tsc + r, lane); } };
            auto body = [&](u32x2 (&y)[4][4], u32x2 (&x)[4], float (&g)[4], int (&te)[4], int (&pp)[4], float (&pg)[4],
                            u32x2 (&yn)[4][4], u32x2 (&xn)[4], float (&gn)[4], int (&ten)[4], int (&ppn)[4], float (&pgn)[4], int ti) {
                if (ti + 1 < nrw) { issue(yn, xn, gn, ten, ppn, pgn, r0 + ti + 1); if (ti + 2 < nrw) ld_idx(te, pp, pg, r0 + ti + 2); fin(y, x, g, ti); asm volatile("; row with a successor" ::: "memory"); }
                else { fin(y, x, g, ti); asm volatile("; last row" ::: "memory"); } };
            if (nrw > 0) { ld_idx(teA, ppA, pgA, r0); issue(yA, xA, gA, teA, ppA, pgA, r0); if (nrw > 1) ld_idx(teB, ppB, pgB, r0 + 1); }
            for (int ti = 0; ti < nrw; ti += 2) { body(yA, xA, gA, teA, ppA, pgA, yB, xB_, gB, teB, ppB, pgB, ti); if (ti + 1 < nrw) body(yB, xB_, gB, teB, ppB, pgB, yA, xA, gA, teA, ppA, pgA, ti + 1); }
        }
        SEAMK(pb + 9, 14);
}

__global__ void __launch_bounds__(NTHR, 2) fwd(Args args) {
    extern __shared__ __attribute__((aligned(16))) unsigned char lds_raw[];
    LAS unsigned char* lds = (LAS unsigned char*)lds_raw;
    const int tid = threadIdx.x, lane = tid & 63, wave = __builtin_amdgcn_readfirstlane(tid >> 6);
    const int G = gridDim.x, bid = blockIdx.x;
    const int gw = bid * NWAVES + wave, NGW = G * NWAVES;
    unsigned char* ws = args.ws;
    gu32* ctl = (gu32*)(ws + WS_CTL);
    volatile LAS unsigned* MISC = (volatile LAS unsigned*)(lds + MISC_OFF);
    if (tid < 64) MISC[tid] = 0u;
    __syncthreads();
    XcdBarrier bar; bar.bar = (unsigned*)ctl + CW_BAR; bar.x = 0; bar.st = MISC + 8;
    const int lo = args.ph_lo, hi = args.ph_hi;
    if (hi - lo > 1) bar = xcd_barrier_post((unsigned*)ctl + CW_BAR, MISC + 8);

    KLOCALS

    if (EN_PRO && IN(0)) {
        {
            LAS float* scr = (LAS float*)(lds + wave * 8448);
            constexpr int IT_SQ = 16 * (D / 32);
            constexpr int N0 = 0, N1 = N0 + 2 * IT_SQ, N2 = N1, N3 = N2 + 2 * IT_SQ;
            for (int it = gw; it < N3; it += NGW) {
                if (it < N1) { const int q = it - N0, mtx = q / IT_SQ, r = q % IT_SQ; transpose_item<0>(args.in[I_WO] + (size_t)mtx * D * D, D, Wo_t + (size_t)mtx * D * D, scr, r, lane); }
                else if (it < N3) { const int q = it - N2, mtx = q / IT_SQ, r = q % IT_SQ; transpose_item<0>(args.in[I_HWOUT] + (size_t)mtx * D * D, D, Wout_t + (size_t)mtx * D * D, scr, r, lane); }
            }
        }
        __syncthreads();
        constexpr int NAUX = 32; const int GC = G - NAUX, ab = bid - GC;
        {
            LAS float* MX = (LAS float*)lds;
            constexpr int NGUI = 128 * (NGU / 64), NDNI = 128 * (D / 64), NINI = 2 * (NHY / 64), NQKI = 2 * (NQKV / 64);
            int par = 0;
            if (bid < GC) for (int it = bid; it < NGUI + NDNI + NINI + NQKI; it += GC, par ^= 1) {
                if (it >= NGUI + NDNI + NINI) { const int q = it - NGUI - NDNI - NINI, mtx = q / (NQKV / 64), nb = q % (NQKV / 64); convert_item64_f8<1, true>(args.in[I_WQKV] + (size_t)mtx * D * NQKV, NQKV, (unsigned char*)Wqkv_t + (size_t)mtx * NQKV * D, wsc_qkv + (size_t)mtx * NQKV, MX, par, nb, tid); }
                else if (it >= NGUI + NDNI) { const int q = it - NGUI - NDNI, mtx = q / (NHY / 64), nb = q % (NHY / 64); convert_item64_f8<3, false>(args.in[I_HWIN] + (size_t)mtx * D * NHY, NHY, (unsigned char*)Win_t + (size_t)mtx * NHY * D, wsc_in + (size_t)mtx * NHY, MX, par, nb, tid); }
                else if (it < NGUI) { const int mtx = it / (NGU / 64), nb = it % (NGU / 64); convert_item64_f8<2, false>(args.in[I_WGU] + (size_t)mtx * D * NGU, NGU, (unsigned char*)Wgu_t + (size_t)mtx * NGU * D, wsc_gu + (size_t)mtx * NGU, MX, par, nb, tid); }
                else { const int q = it - NGUI, mtx = q / (D / 64), nb = q % (D / 64); convert_item64_f8<0, false>(args.in[I_WDN] + (size_t)mtx * D * D, D, (unsigned char*)Wdn_t + (size_t)mtx * D * D, wsc_dn + (size_t)mtx * D, MX, par, nb, tid); }
            }
        }
        __syncthreads();
        {
            LAS float* S = (LAS float*)lds;
            if (ab >= 0) for (int u = ab; u < 4 * 12 * 8; u += NAUX) {
                const int kc = u & 7, cc = (u >> 3) % 12, layer = u / 96;
                __syncthreads();
                for (int i = tid; i < 128 * 20; i += NTHR) { const int k = i / 20, r = i % 20; float v = 0.f;
                    if (r < NMODROW) { const float cv = r < NB ? c_in[r * D + kc * 128 + k] : cctx_in[kc * 128 + k]; v = cv / (1.0f + __expf(-cv)); }
                    S[i] = v; }
                __syncthreads();
                const int col = cc * 512 + tid;
                const float* wp = args.in[I_WMOD] + ((size_t)layer * D + kc * 128) * MODW + col;
                float acc[20];
#pragma unroll
                for (int r = 0; r < 20; ++r) acc[r] = 0.f;
                for (int k = 0; k < 128; ++k) { const float w = wp[(size_t)k * MODW];
#pragma unroll
                    for (int q = 0; q < 5; ++q) { const f32x4 s = *(const LAS f32x4*)(S + k * 20 + 4 * q);
                        acc[4 * q] += s[0] * w; acc[4 * q + 1] += s[1] * w; acc[4 * q + 2] += s[2] * w; acc[4 * q + 3] += s[3] * w; } }
#pragma unroll
                for (int r = 0; r < NMODROW; ++r) modp[((size_t)(kc * 4 + layer) * NMODROW + r) * MODW + col] = acc[r];
            }
        }
        if (ab >= 0) for (int i = ab * NTHR + tid; i < SEQ * 32; i += NAUX * NTHR) {
            const int t = i >> 5, j = i & 31, fi = j & 15; const int pos = (j >> 4) == 0 ? (t >> 6) : (t & 63);
            const float inv = powf(10000.0f, -(float)fi / 16.0f); const float ang = (float)pos * inv;
            cosT[i] = cosf(ang); sinT[i] = sinf(ang);
        }
        {
            __syncthreads();
            LAS float* Z = (LAS float*)lds;
            LAS float* A1 = Z + 8 * 36;
            if (ab >= 0) for (int u = ab; u < 256 + 256 + 32; u += NAUX) {
                const int combo = u < 256 ? 0 : (u < 512 ? 1 : 2); const int ub = combo == 0 ? u : (combo == 1 ? u - 256 : u - 512);
                const int j = combo == 1 ? 1 : 0, Lf = combo == 2 ? CL : SEQ;
                const int tl = tid >> 6, o = tid & 63, t = ub * 8 + tl;
                __syncthreads();
                if (o < 33) { float z;
                    const float tt = (float)t / (float)(Lf - 1), w = 6.283185307179586f * (float)t / (float)Lf;
                    if (o == 0) z = tt; else { const int b = (o - 1) & 15; const float f = 1e-4f + (float)b * ((15.0f - 1e-4f) / 15.0f); z = o <= 16 ? cosf(f * w) : -sinf(f * w); }
                    Z[tl * 36 + o] = z; }
                __syncthreads();
                const float sf = args.in[I_HSF][j * 64 + o];
                { const float* w1 = args.in[I_HW1] + (size_t)j * 33 * 64; float a = args.in[I_HB1][j * 64 + o];
                  for (int i = 0; i < 33; ++i) a += Z[tl * 36 + i] * w1[i * 64 + o];
                  A1[tl * 64 + o] = sinf(sf * a); }
                __syncthreads();
                { const float* w2 = args.in[I_HW2] + (size_t)j * 64 * 64; float a = args.in[I_HB2][j * 64 + o];
                  for (int i = 0; i < 64; ++i) a += A1[tl * 64 + i] * w2[i * 64 + o];
                  a2tab[((size_t)combo * SEQ + t) * 64 + o] = sinf(sf * a); }
            }
        }
    }
    SEAMK(0, 0);

    if (EN_PRO && IN(1)) {
        for (int i = bid * NTHR + tid; i < DEPTH * NMODROW * MODW; i += G * NTHR) {
            const int layer = i / (NMODROW * MODW), rem = i % (NMODROW * MODW), col = rem % MODW; float s = args.in[I_BMOD][layer * MODW + col];
#pragma unroll
            for (int kc = 0; kc < 8; ++kc) s += modp[(size_t)(kc * 4 + layer) * NMODROW * MODW + rem];
            const int chunk = col >> 10, k = col & (D - 1);
            if (chunk == 1) s = args.in[I_N1G][layer * D + k] * (1.0f + s); else if (chunk == 4) s = args.in[I_N2G][layer * D + k] * (1.0f + s);
            modf[i] = s;
        }
        {
            LAS float* W3 = (LAS float*)lds;
            LAS float* RED = W3 + 512;
            LAS float* NRM = RED + 32;
            LAS float* HF = NRM + 4;
            for (int u = bid; u < 3 * 256; u += G) {
                const int combo = u >> 8, cg = u & 255; const int j = combo == 1 ? 1 : 0, Lf = combo == 2 ? CL : SEQ; const int c0 = cg * 4;
                LAS float* HB = HF + 4 * Lf;
                __syncthreads();
                { const int i = tid >> 3, q = tid & 7; const int col = (q >> 2) * 1024 + c0 + (q & 3);
                  W3[i * 8 + q] = args.in[I_HW3][((size_t)j * 64 + i) * 2048 + col]; }
                __syncthreads();
                float b3v[8], dec[4], asum[4] = {0.f, 0.f, 0.f, 0.f};
#pragma unroll
                for (int q = 0; q < 8; ++q) b3v[q] = args.in[I_HB3][j * 2048 + (q >> 2) * 1024 + c0 + (q & 3)];
#pragma unroll
                for (int ch = 0; ch < 4; ++ch) dec[ch] = 3.0701134573253945f + (float)(c0 + ch) * ((15.350567286626972f - 3.0701134573253945f) / 1023.0f);
                for (int t = tid; t < Lf; t += NTHR) {
                    asm volatile("" ::: "memory");
                    const float* ar = a2tab + ((size_t)combo * SEQ + t) * 64; float d[8];
#pragma unroll
                    for (int q = 0; q < 8; ++q) d[q] = b3v[q];
#pragma unroll
                    for (int i4 = 0; i4 < 16; ++i4) { const f32x4 a = *(const f32x4*)(ar + 4 * i4); asm volatile("" ::: "memory");
#pragma unroll
                        for (int e = 0; e < 4; ++e) { const f32x4 w0 = *(const LAS f32x4*)(W3 + (4 * i4 + e) * 8), w1 = *(const LAS f32x4*)(W3 + (4 * i4 + e) * 8 + 4);
                            d[0] += a[e] * w0[0]; d[1] += a[e] * w0[1]; d[2] += a[e] * w0[2]; d[3] += a[e] * w0[3]; d[4] += a[e] * w1[0]; d[5] += a[e] * w1[1]; d[6] += a[e] * w1[2]; d[7] += a[e] * w1[3]; } }
                    const float tt = (float)t / (float)(Lf - 1);
#pragma unroll
                    for (int ch = 0; ch < 4; ++ch) { const float dk = __expf(-tt * dec[ch]); const float f = d[ch] * dk, bb = d[4 + ch] * dk;
                        HF[ch * Lf + t] = f; HB[ch * Lf + t] = bb; asum[ch] += fabsf(f) + (t >= 1 ? fabsf(bb) : 0.f); }
                }
#pragma unroll
                for (int ch = 0; ch < 4; ++ch) { const float s = wave_sum(asum[ch]); if (lane == 0) RED[wave * 4 + ch] = s; }
                __syncthreads();
                if (tid < 4) { float s = 0.f; for (int w = 0; w < 8; ++w) s += RED[w * 4 + tid]; NRM[tid] = 1.0f / (s + EPS); }
                __syncthreads();
                const int P = 2 * Lf + 8, PC8 = P / 8;
                bf16_t* FI = (bf16_t*)(ws + (combo == 0 ? WS_FI0 : (combo == 1 ? WS_FI1 : WS_FI2)));
                for (int q = tid; q < 4 * PC8; q += NTHR) {
                    const int ch = q / PC8, cidx = 0, x0 = (q % PC8) * 8;
                    const float nr = NRM[ch], db = args.in[I_HDB][j * 1024 + c0 + ch]; float v[8];
#pragma unroll
                    for (int e = 0; e < 8; ++e) { const int m = Lf - (x0 + e) + cidx; const int am = m < 0 ? -m : m; float g = 0.f;
                        if (am <= Lf - 1) { g = (m >= 0 ? HF[ch * Lf + am] : HB[ch * Lf + am]) * nr; if (m == 0) g += db; }
                        v[e] = g; }
                    u32x4 o; o.x = pk2(v[0], v[1]); o.y = pk2(v[2], v[3]); o.z = pk2(v[4], v[5]); o.w = pk2(v[6], v[7]);
                    *(u32x4*)(FI + ((size_t)((c0 + ch) * 8 + cidx)) * P + x0) = o;
                }
            }
        }
    }
    SEAMK(1, 1);

    if (IN(2)) {
        const float* mo = modf;
        const int TPW = (NTOK + NGW - 1) / NGW;
        int curb = -1; f32x4 gs[4], sh[4];
        for (int ti = 0; ti < TPW; ++ti) {
            const int r = gw * TPW + ti; if (r >= NTOK) break;
            const float* src = r < NLAT ? x_in + (size_t)r * D : ctx_in + (size_t)(r - NLAT) * D;
            f32x4 v[4], h[4]; load_vec(src, lane, v);
            const int b = mod_row(r); if (b != curb) { const float* mr = mo + (size_t)b * MODW; load_vec(mr + D, lane, gs); load_vec(mr, lane, sh); curb = b; }
            norm_mod_store_f8(v, gs, sh, (unsigned char*)hA + (size_t)r * D, tsc + r, lane);
        }
    }
    SEAMK(2, 2);

    layer_body<0>(args, lds, bar, tid, lane, wave, G, bid, lo, hi);
    layer_body<1>(args, lds, bar, tid, lane, wave, G, bid, lo, hi);
    layer_body<2>(args, lds, bar, tid, lane, wave, G, bid, lo, hi);
    layer_body<3>(args, lds, bar, tid, lane, wave, G, bid, lo, hi);
#undef IN
#undef SEAM
}

extern "C" void kernel_launch(void* const* d_in, const int* in_sizes, int n_in, void* d_out, int out_size, void* d_ws, size_t ws_size, hipStream_t stream) {
    static int grid = 0;
    if (grid == 0) {
        if (n_in != 32 || out_size != NLAT * D || ws_size < WS_END) { fprintf(stderr, "kernel_launch: unexpected problem (n_in %d, out %d, ws %zu)\n", n_in, out_size, ws_size); grid = -1; return; }
        int dev = 0, cus = 0, per_cu = 0;
        if (hipGetDevice(&dev) != hipSuccess || hipDeviceGetAttribute(&cus, hipDeviceAttributeMultiprocessorCount, dev) != hipSuccess) { grid = -1; return; }
        if (hipFuncSetAttribute((const void*)fwd, hipFuncAttributeMaxDynamicSharedMemorySize, LDS_BYTES) != hipSuccess) { fprintf(stderr, "kernel_launch: hipFuncSetAttribute failed\n"); grid = -1; return; }
        if (hipOccupancyMaxActiveBlocksPerMultiprocessor(&per_cu, (const void*)fwd, NTHR, LDS_BYTES) != hipSuccess || per_cu < 1) fprintf(stderr, "kernel_launch: occupancy query says %d\n", per_cu);
        (void)hipGetLastError();
        if (cus < 256) { fprintf(stderr, "kernel_launch: built for the 256-CU MI355X (unit orders, per-wave row counts); found %d CUs; nothing launched\n", cus); grid = -1; return; }
        grid = 256;
    }
    if (grid < 0) return;
    (void)hipMemsetAsync((char*)d_ws + WS_CTL, 0, CTL_ZERO_BYTES, stream);
    Args a{};
    for (int i = 0; i < 32; ++i) a.in[i] = (const float*)d_in[i];
    a.out = (float*)d_out; a.ws = (unsigned char*)d_ws;
    constexpr int NPH = 3 + 10 * DEPTH;
#if MK_ONE_LAUNCH
    a.ph_lo = 0; a.ph_hi = NPH;
    hipLaunchKernelGGL(fwd, dim3(grid), dim3(NTHR), LDS_BYTES, stream, a);
#else
    for (int p = 0; p < NPH; ++p) {
        if (p >= 3) { const int layer = (p - 3) / 10, loc = (p - 3) % 10; if ((layer & 1) == 0 && (loc == 3 || loc == 4)) continue; }
        a.ph_lo = p; a.ph_hi = p + 1;
        hipLaunchKernelGGL(fwd, dim3(grid), dim3(NTHR), LDS_BYTES, stream, a);
    }
#endif
}
```

```cpp
#include <hip/hip_runtime.h>
#include <cstdio>
#include <cstdint>
#include <cmath>
#include <hip/hip_bf16.h>

#ifndef EN_PRO
#define EN_PRO 1
#endif
#ifndef EN_ATT
#define EN_ATT 1
#endif
#ifndef EN_CONV
#define EN_CONV 1
#endif
#ifndef EN_ROUTER
#define EN_ROUTER 1
#endif
#ifndef EN_GEMM
#define EN_GEMM 1
#endif
#ifndef EN_MISC
#define EN_MISC 1
#endif
#ifndef MK_ONE_LAUNCH
#define MK_ONE_LAUNCH 1
#endif

#define GAS __attribute__((address_space(1)))
#define LAS __attribute__((address_space(3)))
typedef unsigned short bf16_t;
typedef short bf16x8 __attribute__((ext_vector_type(8)));
typedef float f32x4 __attribute__((ext_vector_type(4)));
typedef float f32x2 __attribute__((ext_vector_type(2)));
typedef unsigned u32x4 __attribute__((ext_vector_type(4)));
typedef unsigned u32x2 __attribute__((ext_vector_type(2)));
typedef GAS unsigned gu32;
typedef float f32x16 __attribute__((ext_vector_type(16)));

constexpr int D = 1024, NB = 16, SEQ = 2048, CL = 256, KVL = SEQ + CL;
constexpr int NLAT = NB * SEQ, NCTX = NB * CL, NTOK = NLAT + NCTX;
constexpr int NE = 32, TOPK = 4, DEPTH = 4;
static_assert(NTOK < 65536, "claim-list entries carry the token in 16 bits");
constexpr int MODW = 6 * D, NMODROW = NB + 1;
constexpr int NQKV = 1536, NHY = 3072, NGU = 2048;
constexpr float EPS = 1e-6f;
constexpr float C2 = 0.125f * 1.4426950408889634f;
constexpr int NWAVES = 8, NTHR = 512;
constexpr int NPADROWS = 155648;
constexpr int MAXTILES = NPADROWS / 256;

constexpr size_t MiB = 1u << 20;
constexpr size_t WS_CTL = 0, CTL_ZERO_BYTES = 1 * MiB;
constexpr size_t WS_MODP = 2 * MiB;
constexpr size_t WS_MOD = 16 * MiB;
constexpr size_t WS_ROPE = 18 * MiB;
constexpr size_t WS_A2 = 19 * MiB;
constexpr size_t WS_PAIR = 21 * MiB;
constexpr size_t WS_CTX = 24 * MiB;
constexpr size_t WS_FI = 40 * MiB;
constexpr int FP_L = 2 * SEQ + 8, FP_C = 2 * CL + 8;
constexpr size_t FI_L_BYTES = (size_t)1024 * 8 * FP_L * 2, FI_C_BYTES = (size_t)1024 * 8 * FP_C * 2;
constexpr size_t WS_FI0 = WS_FI, WS_FI1 = WS_FI0 + 65 * MiB, WS_FI2 = WS_FI1 + 65 * MiB;
static_assert(FI_L_BYTES <= 65 * MiB && WS_FI2 + FI_C_BYTES <= 180 * MiB, "filter map");
constexpr size_t WS_WQKV = 180 * MiB, WS_WO = 186 * MiB, WS_WIN = 190 * MiB, WS_WOUT = 202 * MiB, WS_WGU = 206 * MiB, WS_WDN = 718 * MiB;
constexpr size_t WS_HA = 974 * MiB;
constexpr size_t WS_Q = 1046 * MiB;
constexpr size_t WS_K = 1118 * MiB, WS_V = 1136 * MiB;
constexpr size_t WS_UPRE = 1154 * MiB;
constexpr size_t WS_WC = 1370 * MiB;
constexpr size_t WS_YC = 1442 * MiB;
constexpr size_t WS_WSC_QKV = WS_WC + 5 * MiB;
constexpr size_t WS_WSC_IN = WS_WC + 3 * MiB, WS_TSC = WS_WC + 4 * MiB;
constexpr size_t WS_WSC_GU = WS_WC, WS_WSC_DN = WS_WC + 2 * MiB;
constexpr size_t WS_XS = 1514 * MiB;
constexpr size_t WS_AB = 1818 * MiB;
constexpr size_t WS_ELIST = 2122 * MiB;
constexpr size_t WS_XB = 2128 * MiB;
constexpr size_t WS_END = 2200 * MiB;
constexpr size_t WC_CTX_OFF = (size_t)1024 * 16 * 2048;
constexpr int CW_TMO = 0, CW_BAR = 4096, CW_CNT = 16384;

constexpr int LDS_BYTES = 160 * 1024;
constexpr int MISC_OFF = LDS_BYTES - 256;

#define RLX_AGENT __ATOMIC_RELAXED, __HIP_MEMORY_SCOPE_AGENT
#define LDS_WAIT() asm volatile("s_waitcnt lgkmcnt(0)" ::: "memory")
#define VM_WAIT() asm volatile("s_waitcnt vmcnt(0)" ::: "memory")
__device__ __forceinline__ unsigned f2bf(float f) { unsigned u = __builtin_bit_cast(unsigned, f); return (u + 0x7fffu + ((u >> 16) & 1u)) >> 16; }
typedef __bf16 bf16x2_t __attribute__((ext_vector_type(2)));
__device__ __forceinline__ unsigned pk2(float lo, float hi) { const f32x2 v = {lo, hi}; const bf16x2_t b = __builtin_convertvector(v, bf16x2_t); return __builtin_bit_cast(unsigned, b); }
constexpr float F8_HS = 8.0f;
__device__ __forceinline__ unsigned pk4f8(float a, float b, float c, float d) {
    int w = 0; w = __builtin_amdgcn_cvt_pk_fp8_f32(__builtin_amdgcn_fmed3f(a, -448.f, 448.f), __builtin_amdgcn_fmed3f(b, -448.f, 448.f), w, false);
    w = __builtin_amdgcn_cvt_pk_fp8_f32(__builtin_amdgcn_fmed3f(c, -448.f, 448.f), __builtin_amdgcn_fmed3f(d, -448.f, 448.f), w, true); return (unsigned)w; }
__device__ __forceinline__ unsigned pk4f8u(float a, float b, float c, float d) {
    int w = 0; w = __builtin_amdgcn_cvt_pk_fp8_f32(a, b, w, false); w = __builtin_amdgcn_cvt_pk_fp8_f32(c, d, w, true); return (unsigned)w; }
__device__ __forceinline__ float bf2f(unsigned h) { return __builtin_bit_cast(float, h << 16); }
__device__ __forceinline__ float bflo(unsigned w) { return __builtin_bit_cast(float, w << 16); }
__device__ __forceinline__ float bfhi(unsigned w) { return __builtin_bit_cast(float, w & 0xffff0000u); }
#define DPPF(x, ctrl, rmask, bmask) __builtin_bit_cast(float, __builtin_amdgcn_update_dpp(0, __builtin_bit_cast(int, (x)), (ctrl), (rmask), (bmask), false))
__device__ __forceinline__ float wave_sum(float x) {
    float v = x + DPPF(x, 0x111, 0xf, 0xf); v += DPPF(x, 0x112, 0xf, 0xf); v += DPPF(x, 0x113, 0xf, 0xf);
    v += DPPF(v, 0x114, 0xf, 0xe); v += DPPF(v, 0x118, 0xf, 0xc); v += DPPF(v, 0x142, 0xa, 0xf); v += DPPF(v, 0x143, 0xc, 0xf);
    return __builtin_bit_cast(float, __builtin_amdgcn_readlane(__builtin_bit_cast(int, v), 63));
}
__device__ __forceinline__ float wave_max_nn(float x) {
    float v = fmaxf(x, DPPF(x, 0x111, 0xf, 0xf)); v = fmaxf(v, DPPF(x, 0x112, 0xf, 0xf)); v = fmaxf(v, DPPF(x, 0x113, 0xf, 0xf));
    v = fmaxf(v, DPPF(v, 0x114, 0xf, 0xe)); v = fmaxf(v, DPPF(v, 0x118, 0xf, 0xc)); v = fmaxf(v, DPPF(v, 0x142, 0xa, 0xf)); v = fmaxf(v, DPPF(v, 0x143, 0xc, 0xf));
    return __builtin_bit_cast(float, __builtin_amdgcn_readlane(__builtin_bit_cast(int, v), 63));
}

#define XB_TMO      128
#define XB_XCNT(j)  (256  + 64 * (j))
#define XB_XSUB(j)  (1280 + 64 * (j))
#define XB_XGEN(j)  (2304 + 64 * (j))
#define XB_TOP      3328
#define XB_TOPGEN   3392
#define XCD_BAR_WORDS 3456
#define XB_SPIN_CAP (1u << 22)
__device__ __forceinline__ unsigned xb_ld(unsigned* p)              { return __hip_atomic_load(p, __ATOMIC_RELAXED, __HIP_MEMORY_SCOPE_AGENT); }
__device__ __forceinline__ unsigned xb_add(unsigned* p, unsigned v) { return __hip_atomic_fetch_add(p, v, __ATOMIC_RELAXED, __HIP_MEMORY_SCOPE_AGENT); }
__device__ __forceinline__ unsigned xb_xcc_id() { return (unsigned)__builtin_amdgcn_s_getreg((3 << 11) | 20) & 0xFu; }
#define XB_SPIN(cond, bar) do { unsigned _sp = 0; while (cond) { __builtin_amdgcn_s_sleep(1); \
    if ((++_sp & 255u) == 0u) { if (xb_ld(&(bar)[XB_TMO])) break; if (_sp > XB_SPIN_CAP) { atomicAdd(&(bar)[XB_TMO], 1u); break; } } } } while (0)
struct XcdBarrier { unsigned* bar; unsigned x; volatile LAS unsigned* st; };
__device__ __forceinline__ XcdBarrier xcd_barrier_post(unsigned* bar, volatile LAS unsigned* st) {
    XcdBarrier b; b.bar = bar; b.x = xb_xcc_id(); b.st = st;
    if (threadIdx.x == 0) (void)xb_add(&bar[XB_XCNT(b.x)], 1u);
    return b;
}
__device__ __forceinline__ void xcd_barrier_complete(unsigned* bar, unsigned x, unsigned& nloc, unsigned& nx) {
    const unsigned G = gridDim.x * gridDim.y * gridDim.z;
    unsigned sum, cnt, mine, sp = 0u;
    for (;;) {
        sum = 0u; cnt = 0u; mine = 0u;
#pragma unroll
        for (unsigned j = 0; j < 16; ++j) { const unsigned c = xb_ld(&bar[XB_XCNT(j)]); sum += c; cnt += (c > 0u) ? 1u : 0u; mine = (j == x) ? c : mine; }
        if (sum == G) break;
        __builtin_amdgcn_s_sleep(1);
        if ((++sp & 255u) == 0u) { if (xb_ld(&bar[XB_TMO])) break; if (sp > XB_SPIN_CAP) { atomicAdd(&bar[XB_TMO], 1u); break; } }
    }
    nloc = mine > 0u ? mine : 1u; nx = cnt > 0u ? cnt : 1u;
}
__device__ __forceinline__ void xcd_barrier(const XcdBarrier& b) {
    asm volatile("s_waitcnt vmcnt(0)" ::: "memory");
    __syncthreads();
    if (threadIdx.x == 0) {
        unsigned* bar = b.bar;
        __builtin_amdgcn_s_waitcnt(0);
        unsigned nloc = b.st[0], nx = b.st[1];
        if (nloc == 0u) { xcd_barrier_complete(bar, b.x, nloc, nx); b.st[0] = nloc; b.st[1] = nx; }
        const unsigned old = xb_add(&bar[XB_XSUB(b.x)], 1u);
        const unsigned gen = old / nloc;
        if (old + 1u == (gen + 1u) * nloc) {
            __builtin_amdgcn_fence(__ATOMIC_RELEASE, "agent");
            asm volatile("s_waitcnt vmcnt(0)" ::: "memory");
            const unsigned og = xb_add(&bar[XB_TOP], 1u);
            const unsigned tg = og / nx;
            if (og + 1u == (tg + 1u) * nx) xb_add(&bar[XB_TOPGEN], 1u);
            else XB_SPIN(xb_ld(&bar[XB_TOPGEN]) == tg, bar);
            __builtin_amdgcn_fence(__ATOMIC_ACQUIRE, "agent");
            xb_add(&bar[XB_XGEN(b.x)], 1u);
            asm volatile("s_waitcnt vmcnt(0)" ::: "memory");
        } else {
            XB_SPIN(xb_ld(&bar[XB_XGEN(b.x)]) == gen, bar);
            __builtin_amdgcn_fence(__ATOMIC_ACQUIRE, "agent");
            asm volatile("s_waitcnt vmcnt(0)" ::: "memory");
        }
    }
    __syncthreads();
}

struct Args { const float* in[32]; float* out; unsigned char* ws; int ph_lo, ph_hi; };
struct Ctx {
    LAS unsigned char* lds;
    int tid, lane, wave, G, bid;
    const float* const* in;
};
enum { I_X = 0, I_C, I_CTX, I_CCTX, I_WMOD, I_BMOD, I_N1G, I_N2G, I_WQKV, I_QG, I_KG, I_WO, I_HWIN, I_HBIN, I_HCW, I_HCB, I_HW1, I_HB1, I_HW2, I_HB2, I_HW3, I_HB3,
       I_HSF, I_HDB, I_HWOUT, I_HBOUT, I_RW, I_RB, I_WGU, I_BGU, I_WDN, I_BDN };

__device__ __forceinline__ int mod_row(int r) { return r < NLAT ? (r >> 11) : NB; }

__device__ __forceinline__ void gemm_unit_simple(const bf16_t* At, const bf16_t* Bt, f32x4 (&acc)[2][2][4][2], int wr, int wc, int fr, int fq) {
    constexpr int K = D;
#pragma unroll
    for (int a = 0; a < 2; ++a)
#pragma unroll
        for (int b = 0; b < 2; ++b)
#pragma unroll
            for (int m = 0; m < 4; ++m)
#pragma unroll
                for (int n = 0; n < 2; ++n) acc[a][b][m][n] = (f32x4){0.f, 0.f, 0.f, 0.f};
    const bf16_t* ap = At + (size_t)(wr * 64 + fr) * K + fq * 8;
    const bf16_t* bp = Bt + (size_t)(wc * 32 + fr) * K + fq * 8;
    for (int k0 = 0; k0 < K; k0 += 32) {
        bf16x8 bfr[2][2];
#pragma unroll
        for (int bj = 0; bj < 2; ++bj)
#pragma unroll
            for (int n = 0; n < 2; ++n) bfr[bj][n] = *(const bf16x8*)(bp + (size_t)(bj * 128 + n * 16) * K + k0);
#pragma unroll
        for (int ai = 0; ai < 2; ++ai)
#pragma unroll
            for (int m = 0; m < 4; ++m) {
                const bf16x8 afr = *(const bf16x8*)(ap + (size_t)(ai * 128 + m * 16) * K + k0);
#pragma unroll
                for (int bj = 0; bj < 2; ++bj)
#pragma unroll
                    for (int n = 0; n < 2; ++n) acc[ai][bj][m][n] = __builtin_amdgcn_mfma_f32_16x16x32_bf16(bfr[bj][n], afr, acc[ai][bj][m][n], 0, 0, 0);
            }
    }
}


struct Unit { int pm, pn, e, ui; };
typedef int i32x8_t __attribute__((ext_vector_type(8)));
__device__ __forceinline__ i32x8_t cat8(const bf16x8 lo, const bf16x8 hi) { const u32x4 a = __builtin_bit_cast(u32x4, lo), b = __builtin_bit_cast(u32x4, hi); return (i32x8_t){(int)a.x, (int)a.y, (int)a.z, (int)a.w, (int)b.x, (int)b.y, (int)b.z, (int)b.w}; }
__device__ __forceinline__ void glds16s(const void* sbase, unsigned voff, unsigned lds_dst) { unsigned keep;
    asm volatile("s_mov_b32 %0, m0\n\ts_mov_b32 m0, %3\n\ts_nop 0\n\tglobal_load_lds_dwordx4 %1, %2\n\ts_mov_b32 m0, %0" : "=&s"(keep) : "v"(voff), "s"(sbase), "s"(lds_dst) : "memory"); }
__device__ __forceinline__ f32x4 zero4() { f32x2 a, b; asm volatile("v_mov_b64 %0, 0" : "=v"(a)); asm volatile("v_mov_b64 %0, 0" : "=v"(b)); return (f32x4){a.x, a.y, b.x, b.y}; }
namespace pg8 {
constexpr int BM = 256, BK = 64, HALF = 128, HTB = HALF * BK * 2, STAGE_BYTES = 8 * HTB;
__device__ __forceinline__ int lds_byte(int r, int c) { const int st = (r >> 4) * 2 + (c >> 5), rr = r & 15, cc = c & 31, ob = rr * 64 + cc * 2; return st * 1024 + (ob ^ (((ob >> 9) & 1) << 5)); }
__device__ __forceinline__ void stage_rc(int b, int& R, int& C) { const int st = b / 1024, sb = b % 1024, swz = sb ^ (((sb >> 9) & 1) << 5); R = (st >> 1) * 16 + swz / 64; C = (st & 1) * 32 + (swz % 64) / 2; }
constexpr int PRE_OFF = 155648;
template <class Epi, class Sched, bool GATHER = false, bool F8 = false, bool PRE = false>
__device__ __forceinline__ void gemm_phase(LAS unsigned char* lds, const Sched& S, const Epi& E) {
    constexpr int K = D, PITCH = F8 ? K : 2 * K  , nt = PITCH / (BK * 2);
    const int tid = threadIdx.x, wid = __builtin_amdgcn_readfirstlane(tid >> 6), lane = tid & 63, wr = wid >> 2, wc = wid & 3, fr = lane & 15, fq = lane >> 4;
    unsigned voffA[2];
#pragma unroll
    for (int i = 0; i < 2; ++i) { int R, C; stage_rc(tid * 16 + i * 8192, R, C); voffA[i] = (unsigned)(R * PITCH + C * 2); }
    const size_t kstep = (size_t)(BK * 2);
    const size_t hstep = (size_t)HALF * PITCH;
    const unsigned ldsw = (unsigned)wid * 1024u, ldsb = (unsigned)(size_t)lds + ldsw;
    const int aoff = lds_byte(wr * 64 + fr, fq * 8), boff = lds_byte(wc * 32 + fr, fq * 8);
#define PG8_SA(b, h) (((b) * 2 + (h)) * HTB)
#define PG8_SB(b, h) ((4 + (b) * 2 + (h)) * HTB)
#define PG8_STAGE(bufoff, gbase, voff) do { const char* _g = (const char*)(gbase); _Pragma("unroll") for (int _i = 0; _i < 2; ++_i) glds16s(_g, (voff)[_i], ldsb + (unsigned)((bufoff) + _i * 8192)); } while (0)
#define PG8_LDA(dst, b, h) do { _Pragma("unroll") for (int m = 0; m < 4; ++m) _Pragma("unroll") for (int k = 0; k < 2; ++k) dst[m][k] = *(const LAS bf16x8*)(lds + PG8_SA(b, h) + aoff + m * 2048 + k * 1024); } while (0)
#define PG8_LDB(dst, b, h) do { _Pragma("unroll") for (int n = 0; n < 2; ++n) _Pragma("unroll") for (int k = 0; k < 2; ++k) dst[n][k] = *(const LAS bf16x8*)(lds + PG8_SB(b, h) + boff + n * 2048 + k * 1024); } while (0)
#define PG8_MMA(ai, bj, At, Bt) do { __builtin_amdgcn_s_setprio(1); _Pragma("unroll") for (int m = 0; m < 4; ++m) _Pragma("unroll") for (int n = 0; n < 2; ++n) { \
        if constexpr (F8) acc[ai][bj][m][n] = __builtin_amdgcn_mfma_scale_f32_16x16x128_f8f6f4(cat8(Bt[n][0], Bt[n][1]), cat8(At[m][0], At[m][1]), acc[ai][bj][m][n], 0, 0, 0, 0, 0, 0); \
        else { _Pragma("unroll") for (int k = 0; k < 2; ++k) acc[ai][bj][m][n] = __builtin_amdgcn_mfma_f32_16x16x32_bf16(Bt[n][k], At[m][k], acc[ai][bj][m][n], 0, 0, 0); } } __builtin_amdgcn_s_setprio(0); } while (0)
#define PG8_WAIT_V(n) asm volatile("s_waitcnt vmcnt(" #n ")" ::: "memory")
#define PG8_WAIT_L(n) asm volatile("s_waitcnt lgkmcnt(" #n ")" ::: "memory")
#define PG8_BAR __builtin_amdgcn_s_barrier()
#define PG8_SCHED __builtin_amdgcn_sched_barrier(0)
    unsigned vA[2][2];
    const char* gA = nullptr;
    if constexpr (GATHER) {
        gA = S.a_base();
        const LAS int* rw = S.rows(0);
#pragma unroll
        for (int i = 0; i < 2; ++i) { int R, C; stage_rc(tid * 16 + i * 8192, R, C);
#pragma unroll
            for (int h = 0; h < 2; ++h) vA[h][i] = ((unsigned)rw[h * HALF + R] & (F8 ? 0xffffu : ~0u)) * (unsigned)PITCH + (unsigned)(C * 2); }
    }
#define PG8_STAGEA(bufoff, P, V, kt, h) do { if constexpr (GATHER) PG8_STAGE(bufoff, gA + (size_t)(kt) * kstep, V[h]); else PG8_STAGE(bufoff, (P) + (size_t)(kt) * kstep + (size_t)(h) * hstep, voffA); } while (0)
    Unit cur, nxt; int ui = 0;
    if (!S.next(0, cur)) return;
    if constexpr (PRE) { if (wid < 2) glds16s(E.pre_src(cur, wid), (unsigned)lane * 16u, (unsigned)(size_t)lds + (unsigned)(PRE_OFF + wid * 1024)); }
    f32x4 acc[2][2][4][2];
#pragma unroll
    for (int a = 0; a < 2; ++a)
#pragma unroll
        for (int b = 0; b < 2; ++b)
#pragma unroll
            for (int m = 0; m < 4; ++m)
#pragma unroll
                for (int n = 0; n < 2; ++n) acc[a][b][m][n] = zero4();
    bf16x8 At[4][2], B0[2][2], B1[2][2];
    const char* cA = nullptr; if constexpr (!GATHER) cA = S.a_ptr(cur);
    const char* cB = S.b_ptr(cur);
    PG8_STAGE(PG8_SB(0, 0), cB, voffA); PG8_STAGE(PG8_SB(0, 1), cB + hstep, voffA); PG8_STAGEA(PG8_SA(0, 0), cA, vA, 0, 0); PG8_STAGEA(PG8_SA(0, 1), cA, vA, 0, 1);
    if (wr == 1) PG8_BAR;
    PG8_WAIT_V(2); PG8_BAR;
    PG8_STAGE(PG8_SB(1, 0), cB + kstep, voffA); PG8_STAGEA(PG8_SA(1, 0), cA, vA, 1, 0); PG8_STAGE(PG8_SB(1, 1), cB + hstep + kstep, voffA);
    PG8_WAIT_V(6); PG8_BAR;
    for (;;) {
        const bool has_next = S.next(ui + 1, nxt);
        const char* nA = cA; if constexpr (!GATHER) { if (has_next) nA = S.a_ptr(nxt); }
        const char* nB = has_next ? S.b_ptr(nxt) : cB;
#pragma unroll 1
        for (int t = 0; t < nt; t += 2) {
            const bool last = (t == nt - 2);
            const char* b2 = last ? nB : cB + (size_t)(t + 2) * kstep; const char* b3 = b2 + kstep;
            const char* pX = last ? nA : cA; const int kX = last ? 0 : t + 2;
            PG8_LDB(B0, 0, 0); PG8_LDB(B1, 0, 1); PG8_SCHED; PG8_LDA(At, 0, 0); PG8_STAGEA(PG8_SA(1, 1), cA, vA, t + 1, 1);
            PG8_WAIT_V(8); PG8_WAIT_L(0); PG8_BAR; PG8_MMA(0, 0, At, B0); PG8_MMA(0, 1, At, B1); PG8_BAR; PG8_SCHED;
            if constexpr (GATHER) { if (last && has_next) {
                const LAS int* rw = S.rows(ui + 1); int tl = tid; asm volatile("" : "+v"(tl));
#pragma unroll
                for (int i = 0; i < 2; ++i) { int R, C; stage_rc(tl * 16 + i * 8192, R, C);
#pragma unroll
                    for (int h = 0; h < 2; ++h) vA[h][i] = ((unsigned)rw[h * HALF + R] & (F8 ? 0xffffu : ~0u)) * (unsigned)PITCH + (unsigned)(C * 2); } } }
            PG8_LDA(At, 0, 1); PG8_STAGE(PG8_SB(0, 0), b2, voffA); PG8_STAGE(PG8_SB(0, 1), b2 + hstep, voffA); PG8_STAGEA(PG8_SA(0, 0), pX, vA, kX, 0);
            PG8_WAIT_V(8); PG8_WAIT_L(0); PG8_BAR; PG8_MMA(1, 0, At, B0); PG8_MMA(1, 1, At, B1); PG8_BAR; PG8_SCHED;
            PG8_LDB(B0, 1, 0); PG8_LDB(B1, 1, 1); PG8_SCHED; PG8_LDA(At, 1, 0); PG8_STAGEA(PG8_SA(0, 1), pX, vA, kX, 1);
            PG8_WAIT_V(8); PG8_WAIT_L(0); PG8_BAR; PG8_MMA(0, 0, At, B0); PG8_MMA(0, 1, At, B1); PG8_BAR; PG8_SCHED;
            PG8_LDA(At, 1, 1); PG8_STAGE(PG8_SB(1, 0), b3, voffA); PG8_STAGE(PG8_SB(1, 1), b3 + hstep, voffA); PG8_STAGEA(PG8_SA(1, 0), pX, vA, kX + 1, 0);
            PG8_WAIT_V(8); PG8_WAIT_L(0); PG8_BAR; PG8_MMA(1, 0, At, B0); PG8_MMA(1, 1, At, B1); PG8_BAR; PG8_SCHED;
        }
        if (wr == 0) PG8_BAR;
        cur.ui = ui;
        if constexpr (F8) { int tl = tid; asm volatile("" : "+v"(tl)); E(acc, cur, wr, wc, tl & 15, (tl >> 4) & 3); }
        else E(acc, cur, wr, wc, fr, fq);
        if (!has_next) break;
#pragma unroll
        for (int a = 0; a < 2; ++a)
#pragma unroll
            for (int b = 0; b < 2; ++b)
#pragma unroll
                for (int m = 0; m < 4; ++m)
#pragma unroll
                    for (int n = 0; n < 2; ++n) acc[a][b][m][n] = zero4();
        cur = nxt; cA = nA; cB = nB; ++ui;
        if (wr == 1) PG8_BAR;
        if constexpr (PRE) { if (wid < 2) glds16s(E.pre_src(cur, wid), (unsigned)lane * 16u, (unsigned)(size_t)lds + (unsigned)(PRE_OFF + (ui & 1) * 2048 + wid * 1024)); }
    }
    PG8_WAIT_V(0);
    PG8_BAR;
#undef PG8_SA
#undef PG8_SB
#undef PG8_STAGE
#undef PG8_STAGEA
#undef PG8_LDA
#undef PG8_LDB
#undef PG8_MMA
#undef PG8_WAIT_V
#undef PG8_WAIT_L
#undef PG8_BAR
#undef PG8_SCHED
}
}

template <class Epi, class Sched>
__device__ __forceinline__ void gemm_phase_simple(const Sched& S, const Epi& E) {
    const int tid = threadIdx.x, wid = __builtin_amdgcn_readfirstlane(tid >> 6), lane = tid & 63, wr = wid >> 2, wc = wid & 3, fr = lane & 15, fq = lane >> 4;
    Unit u;
    for (int i = 0; S.next(i, u); ++i) { f32x4 acc[2][2][4][2];
        gemm_unit_simple((const bf16_t*)S.a_ptr(u), (const bf16_t*)S.b_ptr(u), acc, wr, wc, fr, fq);
        E(acc, u, wr, wc, fr, fq); }
}
#ifndef FAST_GEMM
#define FAST_GEMM 1
#endif
template <class Epi, class Sched>
__device__ __forceinline__ void run_gemm(LAS unsigned char* lds, const Sched& S, const Epi& E) {
#if FAST_GEMM
    pg8::gemm_phase<Epi, Sched, false>(lds, S, E);
#else
    gemm_phase_simple<Epi, Sched>(S, E);
#endif
}
template <class Epi, class Sched>
__device__ __forceinline__ void run_gemm_f8(LAS unsigned char* lds, const Sched& S, const Epi& E) { pg8::gemm_phase<Epi, Sched, false, true>(lds, S, E); }
template <class Epi, class Sched>
__device__ __forceinline__ void run_gemm_f8_pre(LAS unsigned char* lds, const Sched& S, const Epi& E) { pg8::gemm_phase<Epi, Sched, false, true, true>(lds, S, E); }
template <class Epi, class Sched>
__device__ __forceinline__ void run_gemm_gather_f8(LAS unsigned char* lds, const Sched& S, const Epi& E) { pg8::gemm_phase<Epi, Sched, true, true, true>(lds, S, E); }
template <class Epi, class Sched>
__device__ __forceinline__ void run_gemm_gather(LAS unsigned char* lds, const Sched& S, const Epi& E) { pg8::gemm_phase<Epi, Sched, true>(lds, S, E); }
__device__ __forceinline__ bool xcd_unit(int i, int G, int c, int nM, int nN, int& pm, int& pn) {
    const int x = c & 7, s = c >> 3, nS = G >> 3;
    const int r0 = (nM * x) >> 3, r1 = (nM * (x + 1)) >> 3;
    const int q = i * nS + s; if (q >= (r1 - r0) * nN) return false;
    const int rr = q / nN; pm = r0 + rr; pn = q - rr * nN; return true;
}
struct DenseSched {
    const bf16_t* A; const bf16_t* Bt; int nM, nN, G, c;
    __device__ __forceinline__ bool next(int i, Unit& u) const { u.e = 0; return xcd_unit(i, G, c, nM, nN, u.pm, u.pn); }
    __device__ __forceinline__ const char* a_ptr(const Unit& u) const { return (const char*)(A + (size_t)u.pm * 256 * D); }
    __device__ __forceinline__ const char* b_ptr(const Unit& u) const { return (const char*)(Bt + (size_t)u.pn * 256 * D); }
};
struct QkvSched {
    const char* A; const char* Bt; int es  ; int live, G, c;
    __device__ __forceinline__ bool next(int i, Unit& u) const { u.e = 0;
        if (live) return xcd_unit(i, G, c, 144, 6, u.pm, u.pn);
        const int x = c & 7, s = c >> 3, nS = G >> 3; const int nlat = 16 * 6; const int q = i * nS + s;
        if (q < nlat) { const int rr = q / 6; u.pm = 16 * x + rr; u.pn = q - rr * 6; return true; }
        const int q2 = q - nlat; if (q2 >= 4) return false; const int t = x * 4 + q2; u.pm = 128 + (t >> 1); u.pn = 4 + (t & 1); return true; }
    __device__ __forceinline__ const char* a_ptr(const Unit& u) const { return A + (size_t)u.pm * 256 * D * es; }
    __device__ __forceinline__ const char* b_ptr(const Unit& u) const { return Bt + (size_t)u.pn * 256 * D * es; }
};
struct MoeSched {
    const bf16_t* A; const bf16_t* Bt  ; const LAS unsigned char* TE; int nM, nN, N, G, c;
    __device__ __forceinline__ bool next(int i, Unit& u) const { if (!xcd_unit(i, G, c, nM, nN, u.pm, u.pn)) return false; u.e = TE[u.pm]; return true; }
    __device__ __forceinline__ const char* a_ptr(const Unit& u) const { return (const char*)(A + (size_t)u.pm * 256 * D); }
    __device__ __forceinline__ const char* b_ptr(const Unit& u) const { return (const char*)(Bt + ((size_t)u.e * N + (size_t)u.pn * 256) * D); }
};
struct MoeSchedF8 {
    const unsigned char* A; const unsigned char* Bt; const LAS unsigned char* TE; int nM, nN, N, G, c;
    __device__ __forceinline__ bool next(int i, Unit& u) const { if (!xcd_unit(i, G, c, nM, nN, u.pm, u.pn)) return false; u.e = __builtin_amdgcn_readfirstlane((int)TE[u.pm]); return true; }
    __device__ __forceinline__ const char* a_ptr(const Unit& u) const { return (const char*)(A + (size_t)u.pm * 256 * D); }
    __device__ __forceinline__ const char* b_ptr(const Unit& u) const { return (const char*)(Bt + ((size_t)u.e * N + (size_t)u.pn * 256) * D); }
};
struct MoeGatherSchedF8 {
    const unsigned char* A; const unsigned char* Bt; const LAS unsigned char* TE; const LAS int* ROWS; int nM, nN, N, G, c;
    __device__ __forceinline__ bool next(int i, Unit& u) const { if (!xcd_unit(i, G, c, nM, nN, u.pm, u.pn)) return false; u.e = __builtin_amdgcn_readfirstlane((int)TE[u.pm]); return true; }
    __device__ __forceinline__ const char* a_base() const { return (const char*)A; }
    __device__ __forceinline__ const LAS int* rows(int ui) const { return ROWS + ui * 256; }
    __device__ __forceinline__ const char* a_ptr(const Unit& u) const { return (const char*)A; }
    __device__ __forceinline__ const char* b_ptr(const Unit& u) const { return (const char*)(Bt + ((size_t)u.e * N + (size_t)u.pn * 256) * D); }
};
struct WinTSched {
    const bf16_t* Wt  ; const bf16_t* X  ; int nTok, G, c;
    __device__ __forceinline__ bool next(int i, Unit& u) const { u.e = 0; int tok, ch; if (!xcd_unit(i, G, c, nTok, 12, tok, ch)) return false; u.pm = ch; u.pn = tok; return true; }
    __device__ __forceinline__ const char* a_ptr(const Unit& u) const { return (const char*)(Wt + (size_t)u.pm * 256 * D); }
    __device__ __forceinline__ const char* b_ptr(const Unit& u) const { return (const char*)(X + (size_t)u.pn * 256 * D); }
};
struct WinTSchedF8 {
    const unsigned char* Wt; const unsigned char* X; int nTok, G, c;
    __device__ __forceinline__ bool next(int i, Unit& u) const { u.e = 0; int tok, ch; if (!xcd_unit(i, G, c, nTok, 12, tok, ch)) return false; u.pm = ch; u.pn = tok; return true; }
    __device__ __forceinline__ const char* a_ptr(const Unit& u) const { return (const char*)(Wt + (size_t)u.pm * 256 * D); }
    __device__ __forceinline__ const char* b_ptr(const Unit& u) const { return (const char*)(X + (size_t)u.pn * 256 * D); }
};
struct MoeGatherSched {
    const bf16_t* A; const bf16_t* Bt; const LAS unsigned char* TE; const LAS int* ROWS; int nM, nN, N, G, c;
    __device__ __forceinline__ bool next(int i, Unit& u) const { if (!xcd_unit(i, G, c, nM, nN, u.pm, u.pn)) return false; u.e = TE[u.pm]; return true; }
    __device__ __forceinline__ const char* a_base() const { return (const char*)A; }
    __device__ __forceinline__ const LAS int* rows(int ui) const { return ROWS + ui * 256; }
    __device__ __forceinline__ const char* a_ptr(const Unit& u) const { return (const char*)A; }
    __device__ __forceinline__ const char* b_ptr(const Unit& u) const { return (const char*)(Bt + ((size_t)u.e * N + (size_t)u.pn * 256) * D); }
};

struct EpiQKV {
    const float* cs  ; const float* ts  ;
    bf16_t *Q, *Kb, *Vb; const float *qg, *kg; const LAS float* ropeL;
    __device__ __forceinline__ void operator()(const f32x4 (&acc)[2][2][4][2], const Unit& uu, int wr, int wc, int fr, int fq) const {
        const int pm = uu.pm, pn = uu.pn;
        const int kind = pn < 4 ? 0 : (pn == 4 ? 1 : 2);
        const float* gain = kind == 0 ? qg : kg;
        f32x4 gv[2][2];
#pragma unroll
        for (int bj = 0; bj < 2; ++bj)
#pragma unroll
            for (int n = 0; n < 2; ++n) gv[bj][n] = *(const f32x4*)(gain + 32 * bj + 16 * n + 4 * fq);
        f32x4 cv[2][2];
#pragma unroll
        for (int bj = 0; bj < 2; ++bj)
#pragma unroll
            for (int n = 0; n < 2; ++n) cv[bj][n] = *(const f32x4*)(cs + pn * 256 + bj * 128 + wc * 32 + 16 * n + 4 * fq);
#pragma unroll
        for (int ai = 0; ai < 2; ++ai)
#pragma unroll
            for (int m = 0; m < 4; ++m) {
                const int r = pm * 256 + ai * 128 + wr * 64 + m * 16 + fr;
                const bool lat = r < NLAT;
                const int b = lat ? (r >> 11) : ((r - NLAT) >> 8);
                const int pos = lat ? (r & (SEQ - 1)) : (SEQ + ((r - NLAT) & (CL - 1)));
                const float tsv = ts[r];
                f32x4 v[2][2];
#pragma unroll
                for (int bj = 0; bj < 2; ++bj)
#pragma unroll
                    for (int n = 0; n < 2; ++n) v[bj][n] = acc[ai][bj][m][n] * (cv[bj][n] * tsv);
                if (kind != 2) {
                    float ss = 0.f;
#pragma unroll
                    for (int bj = 0; bj < 2; ++bj)
#pragma unroll
                        for (int n = 0; n < 2; ++n) ss += (v[bj][n][0] * v[bj][n][0] + v[bj][n][1] * v[bj][n][1]) + (v[bj][n][2] * v[bj][n][2] + v[bj][n][3] * v[bj][n][3]);
                    ss += __shfl_xor(ss, 16); ss += __shfl_xor(ss, 32);
                    const float rinv = __builtin_amdgcn_rsqf(ss * (1.0f / 64.0f) + EPS);
#pragma unroll
                    for (int bj = 0; bj < 2; ++bj)
#pragma unroll
                        for (int n = 0; n < 2; ++n) v[bj][n] = v[bj][n] * rinv * gv[bj][n];
                    if (lat) {
#pragma unroll
                        for (int bj = 0; bj < 2; ++bj) {
                            const int to = (bj == 0 ? (pos >> 6) * 16 : 1024 + (pos & 63) * 16) + 4 * fq;
                            const f32x4 cs = *(const LAS f32x4*)(ropeL + to), sn = *(const LAS f32x4*)(ropeL + to + (bj == 0 ? 512 : 1024));
                            const f32x4 x1 = v[bj][0], x2 = v[bj][1];
                            v[bj][0] = x1 * cs - x2 * sn; v[bj][1] = x2 * cs + x1 * sn;
                        }
                    }
                    if (kind == 0) {
#pragma unroll
                        for (int bj = 0; bj < 2; ++bj)
#pragma unroll
                            for (int n = 0; n < 2; ++n) v[bj][n] = v[bj][n] * C2;
                    }
                }
                bf16_t* dst = kind == 0 ? Q + (size_t)r * D + pn * 256 + wc * 64
                                        : (kind == 1 ? Kb : Vb) + ((size_t)b * KVL + pos) * 256 + wc * 64;
#pragma unroll
                for (int bj = 0; bj < 2; ++bj) { u32x4 w; w.x = pk2(v[bj][0][0], v[bj][0][1]); w.y = pk2(v[bj][0][2], v[bj][0][3]); w.z = pk2(v[bj][1][0], v[bj][1][1]); w.w = pk2(v[bj][1][2], v[bj][1][3]);
                    *(u32x4*)(dst + 32 * bj + 8 * fq) = w; }
            }
    }
};
struct EpiBiasBf16 {
    bf16_t* O; int ldc; const float* bias0; int estride;
    __device__ __forceinline__ void operator()(const f32x4 (&acc)[2][2][4][2], const Unit& uu, int wr, int wc, int fr, int fq) const {
        const int row0 = uu.pm * 256, col0t = uu.pn * 256;
#pragma unroll
        for (int bj = 0; bj < 2; ++bj) {
            const int c = col0t + bj * 128 + wc * 32 + 8 * fq;
            const float* bp = bias0 + (size_t)uu.e * estride + c; const f32x4 b0 = *(const f32x4*)bp, b1 = *(const f32x4*)(bp + 4);
#pragma unroll
            for (int ai = 0; ai < 2; ++ai)
#pragma unroll
                for (int m = 0; m < 4; ++m) { const int r = row0 + ai * 128 + wr * 64 + m * 16 + fr; const f32x4 v0 = acc[ai][bj][m][0] + b0, v1 = acc[ai][bj][m][1] + b1;
                    u32x4 w; w.x = pk2(v0[0], v0[1]); w.y = pk2(v0[2], v0[3]); w.z = pk2(v1[0], v1[1]); w.w = pk2(v1[2], v1[3]); *(u32x4*)(O + (size_t)r * ldc + c) = w; }
        }
    }
};
struct EpiScaleBiasBf16 {
    bf16_t* O; int ldc; const float* bias0; int estride; const float* cs0  ; float sc; const LAS float* PB  ;
    __device__ __forceinline__ const float* pre_src(const Unit& u, int w) const { return (w == 0 ? bias0 : cs0) + (size_t)u.e * estride + u.pn * 256; }
    __device__ __forceinline__ void operator()(const f32x4 (&acc)[2][2][4][2], const Unit& uu, int wr, int wc, int fr, int fq) const {
        const int row0 = uu.pm * 256, col0t = uu.pn * 256; const LAS float* pb = PB + (uu.ui & 1) * 512;
#pragma unroll
        for (int bj = 0; bj < 2; ++bj) {
            const int c = col0t + bj * 128 + wc * 32 + 8 * fq; const int cl = bj * 128 + wc * 32 + 8 * fq;
            const f32x4 b0 = *(const LAS f32x4*)(pb + cl), b1 = *(const LAS f32x4*)(pb + cl + 4);
            const f32x4 s0 = *(const LAS f32x4*)(pb + 256 + cl) * sc, s1 = *(const LAS f32x4*)(pb + 256 + cl + 4) * sc;
#pragma unroll
            for (int ai = 0; ai < 2; ++ai)
#pragma unroll
                for (int m = 0; m < 4; ++m) { const int r = row0 + ai * 128 + wr * 64 + m * 16 + fr; const f32x4 v0 = acc[ai][bj][m][0] * s0 + b0, v1 = acc[ai][bj][m][1] * s1 + b1;
                    u32x4 w; w.x = pk2(v0[0], v0[1]); w.y = pk2(v0[2], v0[3]); w.z = pk2(v1[0], v1[1]); w.w = pk2(v1[2], v1[3]); *(u32x4*)(O + (size_t)r * ldc + c) = w; }
        }
    }
};
struct EpiRowBiasBf16 {
    bf16_t* O; int ldc; const float* bias;
    __device__ __forceinline__ void operator()(const f32x4 (&acc)[2][2][4][2], const Unit& uu, int wr, int wc, int fr, int fq) const {
        const int row0 = uu.pm * 256, col0t = uu.pn * 256;
#pragma unroll
        for (int ai = 0; ai < 2; ++ai)
#pragma unroll
            for (int m = 0; m < 4; ++m) { const int r = row0 + ai * 128 + wr * 64 + m * 16 + fr; const float bv = bias[r]; bf16_t* op = O + (size_t)r * ldc + col0t + wc * 32 + 8 * fq;
#pragma unroll
                for (int bj = 0; bj < 2; ++bj) { const f32x4 v0 = acc[ai][bj][m][0] + bv, v1 = acc[ai][bj][m][1] + bv;
                    u32x4 w; w.x = pk2(v0[0], v0[1]); w.y = pk2(v0[2], v0[3]); w.z = pk2(v1[0], v1[1]); w.w = pk2(v1[2], v1[3]); *(u32x4*)(op + bj * 128) = w; } }
    }
};
struct EpiRowScaleBiasBf16 {
    bf16_t* O; int ldc; const float* bias; const float* rs; const float* cs;
    __device__ __forceinline__ void operator()(const f32x4 (&acc)[2][2][4][2], const Unit& uu, int wr, int wc, int fr, int fq) const {
        const int row0 = uu.pm * 256, col0t = uu.pn * 256;
        f32x4 c0[2], c1[2];
#pragma unroll
        for (int bj = 0; bj < 2; ++bj) { const float* cp = cs + col0t + bj * 128 + wc * 32 + 8 * fq; c0[bj] = *(const f32x4*)cp; c1[bj] = *(const f32x4*)(cp + 4); }
#pragma unroll
        for (int ai = 0; ai < 2; ++ai)
#pragma unroll
            for (int m = 0; m < 4; ++m) { const int r = row0 + ai * 128 + wr * 64 + m * 16 + fr; const float bv = bias[r], rv = rs[r]; bf16_t* op = O + (size_t)r * ldc + col0t + wc * 32 + 8 * fq;
#pragma unroll
                for (int bj = 0; bj < 2; ++bj) { const f32x4 v0 = acc[ai][bj][m][0] * (c0[bj] * rv) + bv, v1 = acc[ai][bj][m][1] * (c1[bj] * rv) + bv;
                    u32x4 w; w.x = pk2(v0[0], v0[1]); w.y = pk2(v0[2], v0[3]); w.z = pk2(v1[0], v1[1]); w.w = pk2(v1[2], v1[3]); *(u32x4*)(op + bj * 128) = w; } }
    }
};
template <bool SRC32> struct EpiResid {
    const float *srcL, *srcC; bf16_t* XB; const float* gate  ; const float* bias;
    __device__ __forceinline__ void operator()(f32x4 (&acc)[2][2][4][2], const Unit& uu, int wr, int wc, int fr, int fq) const {
        const int row0 = uu.pm * 256, col0t = uu.pn * 256;
        const float* gp0 = gate + (size_t)mod_row(row0) * MODW;
        const float* sb = row0 < NLAT ? srcL + (size_t)row0 * D : srcC + (size_t)(row0 - NLAT) * D;
        bf16_t* xb = XB + (size_t)row0 * D;
#pragma unroll
        for (int bj = 0; bj < 2; ++bj) {
            const int c = col0t + bj * 128 + wc * 32 + 8 * fq;
            const f32x4 g0 = *(const f32x4*)(gp0 + c), g1 = *(const f32x4*)(gp0 + c + 4);
            f32x4 b0 = (f32x4){0.f, 0.f, 0.f, 0.f}, b1 = b0; if (bias) { b0 = *(const f32x4*)(bias + c); b1 = *(const f32x4*)(bias + c + 4); }
#pragma unroll
            for (int ai = 0; ai < 2; ++ai) {
                f32x4 x0[4], x1[4];
#pragma unroll
                for (int m = 0; m < 4; ++m) { const size_t ro = (size_t)(ai * 128 + wr * 64 + m * 16 + fr) * D + c;
                    if constexpr (SRC32) { x0[m] = *(const f32x4*)(sb + ro); x1[m] = *(const f32x4*)(sb + ro + 4); }
                    else { const u32x4 w = *(const u32x4*)(xb + ro); x0[m] = (f32x4){bflo(w.x), bfhi(w.x), bflo(w.y), bfhi(w.y)}; x1[m] = (f32x4){bflo(w.z), bfhi(w.z), bflo(w.w), bfhi(w.w)}; } }
#pragma unroll
                for (int m = 0; m < 4; ++m) { const size_t ro = (size_t)(ai * 128 + wr * 64 + m * 16 + fr) * D + c;
                    const f32x4 y0 = x0[m] + g0 * (acc[ai][bj][m][0] + b0), y1 = x1[m] + g1 * (acc[ai][bj][m][1] + b1);
                    u32x4 w; w.x = pk2(y0[0], y0[1]); w.y = pk2(y0[2], y0[3]); w.z = pk2(y1[0], y1[1]); w.w = pk2(y1[2], y1[3]); *(u32x4*)(xb + ro) = w; }
                asm volatile("" ::: "memory");
            }
        }
    }
};
template <bool F8> struct EpiSwiglu {
    bf16_t* O; const float* bgu0  ; const float* cs0  ; const LAS int* ROWS  ; const LAS float* PB  ;
    __device__ __forceinline__ const float* pre_src(const Unit& u, int w) const { return (w == 0 ? bgu0 : cs0) + (size_t)u.e * NGU + u.pn * 256; }
    __device__ __forceinline__ void operator()(const f32x4 (&acc)[2][2][4][2], const Unit& uu, int wr, int wc, int fr, int fq) const {

        const int row0 = uu.pm * 256, pn = uu.pn; const float* bgu = bgu0 + (size_t)uu.e * NGU;
        const int f = pn * 128 + wc * 32 + 8 * fq;
        f32x4 bg[2], bu[2];
#pragma unroll
        for (int n = 0; n < 2; ++n) { f32x4 q0, q1;
            if constexpr (F8) { const LAS float* pb = PB + (uu.ui & 1) * 512 + 2 * (wc * 32 + 8 * fq + 4 * n); q0 = *(const LAS f32x4*)pb; q1 = *(const LAS f32x4*)(pb + 4); }
            else { q0 = *(const f32x4*)(bgu + 2 * (f + 4 * n)); q1 = *(const f32x4*)(bgu + 2 * (f + 4 * n) + 4); }
            bg[n] = (f32x4){q0[0], q0[2], q1[0], q1[2]}; bu[n] = (f32x4){q0[1], q0[3], q1[1], q1[3]}; }
        f32x4 cg[2], cu[2];
        if constexpr (F8) {
#pragma unroll
            for (int n = 0; n < 2; ++n) { const LAS float* pb = PB + (uu.ui & 1) * 512 + 256 + 2 * (wc * 32 + 8 * fq + 4 * n); const f32x4 q0 = *(const LAS f32x4*)pb, q1 = *(const LAS f32x4*)(pb + 4);
                cg[n] = (f32x4){q0[0], q0[2], q1[0], q1[2]}; cu[n] = (f32x4){q0[1], q0[3], q1[1], q1[3]}; } }
#pragma unroll
        for (int ai = 0; ai < 2; ++ai)
#pragma unroll
            for (int m = 0; m < 4; ++m) { const int r = row0 + ai * 128 + wr * 64 + m * 16 + fr; float o[8];
                float rs = 1.0f; if constexpr (F8) rs = __builtin_bit_cast(float, (unsigned)ROWS[uu.ui * 256 + ai * 128 + wr * 64 + m * 16 + fr] & 0xffff0000u);
#pragma unroll
                for (int n = 0; n < 2; ++n) { const f32x4 gg = F8 ? acc[ai][0][m][n] * (cg[n] * rs) + bg[n] : acc[ai][0][m][n] + bg[n], uq = F8 ? acc[ai][1][m][n] * (cu[n] * rs) + bu[n] : acc[ai][1][m][n] + bu[n];
#pragma unroll
                    for (int p = 0; p < 2; ++p) {
                        f32x2 g2 = {fminf(gg[2 * p], 7.0f), fminf(gg[2 * p + 1], 7.0f)};
                        f32x2 u2 = {__builtin_amdgcn_fmed3f(uq[2 * p], -7.0f, 7.0f), __builtin_amdgcn_fmed3f(uq[2 * p + 1], -7.0f, 7.0f)};
                        const f32x2 z = g2 * (-2.4554669595930157f);
                        f32x2 e2 = {__builtin_amdgcn_exp2f(z.x), __builtin_amdgcn_exp2f(z.y)};
                        e2 = e2 + 1.0f;
                        const f32x2 r2 = {__builtin_amdgcn_rcpf(e2.x), __builtin_amdgcn_rcpf(e2.y)};
                        const f32x2 o2 = F8 ? ((u2 * F8_HS + F8_HS) * g2) * r2 : ((u2 + 1.0f) * g2) * r2;
                        o[4 * n + 2 * p] = o2.x; o[4 * n + 2 * p + 1] = o2.y; } }
                if constexpr (F8) { u32x2 w; w.x = pk4f8u(o[0], o[1], o[2], o[3]); w.y = pk4f8u(o[4], o[5], o[6], o[7]);   *(u32x2*)((unsigned char*)O + (size_t)r * D + f) = w; }
                else { u32x4 w; w.x = pk2(o[0], o[1]); w.y = pk2(o[2], o[3]); w.z = pk2(o[4], o[5]); w.w = pk2(o[6], o[7]); *(u32x4*)(O + (size_t)r * D + f) = w; } }
    }
};

__device__ __forceinline__ int slot32(int cg) { return (((cg >> 2) & 1) << 4) + ((cg >> 3) << 2) + (cg & 3); }
template <int MODE> __device__ __forceinline__ int wrow_map(int n) {
    if (MODE == 3) return n;
    if (MODE == 0) return (n & ~31) + slot32(n & 31);
    if (MODE == 1) { const int pn = n >> 8, wc = (n >> 6) & 3, bj = (n >> 5) & 1, j = n & 31;
        return (pn << 8) + (bj << 7) + (wc << 5) + (pn < 5 ? j : slot32(j)); }
    { const int f = n >> 1, pn = f >> 7, fo = f & 127; return (pn << 8) + ((n & 1) << 7) + (fo & ~31) + slot32(fo & 31); }
}
template <int MODE> __device__ __forceinline__ void transpose_item(const float* W, int N, bf16_t* WT, LAS float* scr, int item, int lane) {
    constexpr int K = D;
    const int nblk = N / 32, kb = item / nblk, nb = item % nblk, k0 = 64 * kb, n0 = 32 * nb;
#pragma unroll 8
    for (int i = 0; i < 32; ++i) { const int kk = 2 * i + (lane >> 5); scr[kk * 33 + (lane & 31)] = __builtin_nontemporal_load(W + (size_t)(k0 + kk) * N + n0 + (lane & 31)); }
    LDS_WAIT(); asm volatile("" ::: "memory");
    const int c = lane & 7;
#pragma unroll
    for (int j = 0; j < 4; ++j) { const int n = (lane >> 3) + 8 * j; const LAS float* s = scr + (8 * c) * 33 + n;
        u32x4 o; o.x = pk2(s[0 * 33], s[1 * 33]); o.y = pk2(s[2 * 33], s[3 * 33]); o.z = pk2(s[4 * 33], s[5 * 33]); o.w = pk2(s[6 * 33], s[7 * 33]);
        __builtin_nontemporal_store(o, (u32x4*)(WT + (size_t)wrow_map<MODE>(n0 + n) * K + k0 + 8 * c)); }
    LDS_WAIT(); asm volatile("" ::: "memory");
}

template <int MODE, bool WROW_SC = false> __device__ __forceinline__ void convert_item_f8(const float* W, int N, unsigned char* WT, float* wsc, LAS float* scr, LAS unsigned* AM, int par, int nb, int tid) {
    constexpr int K = D;
    const int n0 = 32 * nb, c = tid & 31, kq = tid >> 5, lane = tid & 63, wv = tid >> 6;
    __syncthreads();
    float am = 0.f;
#pragma unroll 1
    for (int i0 = 0; i0 < 64; i0 += 32) { float v[32];
#pragma unroll
        for (int i = 0; i < 32; ++i) v[i] = __builtin_nontemporal_load(W + (size_t)(kq + 16 * (i0 + i)) * N + n0 + c);
#pragma unroll
        for (int i = 0; i < 32; ++i) { scr[(kq + 16 * (i0 + i)) * 33 + c] = v[i]; am = fmaxf(am, fabsf(v[i])); } }
    __hip_atomic_fetch_max(AM + par * 32 + c, __builtin_bit_cast(unsigned, am), __ATOMIC_RELAXED, __HIP_MEMORY_SCOPE_WORKGROUP);
    if (tid < 32) AM[(par ^ 1) * 32 + tid] = 0u;
    __syncthreads();
    if (tid < 32) wsc[WROW_SC ? wrow_map<MODE>(n0 + tid) : n0 + tid] = fmaxf(__builtin_bit_cast(float, AM[par * 32 + tid]), 1e-30f) * (1.0f / 448.0f);
    const int c4 = lane & 3, nn = lane >> 2;
#pragma unroll
    for (int j = 0; j < 2; ++j) { const int n = nn + 16 * j; const float sc = 448.0f / fmaxf(__builtin_bit_cast(float, AM[par * 32 + n]), 1e-30f);
#pragma unroll
        for (int sb = 0; sb < 2; ++sb) { const int k0 = 128 * wv + 64 * sb + 16 * c4; const LAS float* sp = scr + k0 * 33 + n; float x[16];
#pragma unroll
            for (int i = 0; i < 16; ++i) x[i] = sp[i * 33] * sc;
            u32x4 o; o.x = pk4f8(x[0], x[1], x[2], x[3]); o.y = pk4f8(x[4], x[5], x[6], x[7]); o.z = pk4f8(x[8], x[9], x[10], x[11]); o.w = pk4f8(x[12], x[13], x[14], x[15]);
            __builtin_nontemporal_store(o, (u32x4*)(WT + (size_t)wrow_map<MODE>(n0 + n) * K + k0)); } }
}

template <int MODE, bool WROW_SC> __device__ __forceinline__ void convert_item64_f8(const float* W, int N, unsigned char* WT, float* wsc, LAS float* MX, int par, int nb, int tid) {
    constexpr int K = D;
    const int lane = tid & 63, wv = tid >> 6, n = 64 * nb + lane;
    const float* src = W + (size_t)(128 * wv) * N + n;
    float x[128]; float am = 0.f;
#pragma unroll
    for (int i = 0; i < 128; ++i) x[i] = __builtin_nontemporal_load(src + (size_t)i * N);
#pragma unroll
    for (int i = 0; i < 128; ++i) am = fmaxf(am, fabsf(x[i]));
    MX[(par * 8 + wv) * 64 + lane] = am;
    LDS_WAIT(); __builtin_amdgcn_s_barrier();
    float amax = 1e-30f;
#pragma unroll
    for (int w = 0; w < 8; ++w) amax = fmaxf(amax, MX[(par * 8 + w) * 64 + lane]);
    const float sc = 448.0f * __builtin_amdgcn_rcpf(amax);
    const int wrow = wrow_map<MODE>(n);
    if (wv == 0) wsc[WROW_SC ? wrow : n] = amax * (1.0f / 448.0f);
    unsigned char* dst = WT + (size_t)wrow * K + 128 * wv;
#pragma unroll
    for (int j = 0; j < 8; ++j) { u32x4 o;
        o.x = pk4f8(x[16 * j + 0] * sc, x[16 * j + 1] * sc, x[16 * j + 2] * sc, x[16 * j + 3] * sc); o.y = pk4f8(x[16 * j + 4] * sc, x[16 * j + 5] * sc, x[16 * j + 6] * sc, x[16 * j + 7] * sc);
        o.z = pk4f8(x[16 * j + 8] * sc, x[16 * j + 9] * sc, x[16 * j + 10] * sc, x[16 * j + 11] * sc); o.w = pk4f8(x[16 * j + 12] * sc, x[16 * j + 13] * sc, x[16 * j + 14] * sc, x[16 * j + 15] * sc);
        *(u32x4*)(dst + 16 * j) = o; }
}

__device__ __forceinline__ void norm_mod_store(const f32x4 (&v)[4], const f32x4 (&gs)[4], const f32x4 (&sh)[4], bf16_t* dst, int lane, f32x4 (&h)[4]) {
    float ss = 0.f;
#pragma unroll
    for (int j = 0; j < 4; ++j) ss += (v[j][0] * v[j][0] + v[j][1] * v[j][1]) + (v[j][2] * v[j][2] + v[j][3] * v[j][3]);
    ss = wave_sum(ss);
    const float rinv = __builtin_amdgcn_rsqf(ss * (1.0f / D) + EPS);
#pragma unroll
    for (int j = 0; j < 4; ++j) {
        h[j] = (v[j] * rinv) * gs[j] + sh[j];
        u32x2 w; w.x = pk2(h[j][0], h[j][1]); w.y = pk2(h[j][2], h[j][3]);
        ((u32x2*)dst)[lane + 64 * j] = w;
    }
}
__device__ __forceinline__ void norm_mod_store_f8(const f32x4 (&v)[4], const f32x4 (&gs)[4], const f32x4 (&sh)[4], unsigned char* dst, float* isc, int lane) {
    float ss = 0.f;
#pragma unroll
    for (int j = 0; j < 4; ++j) ss += (v[j][0] * v[j][0] + v[j][1] * v[j][1]) + (v[j][2] * v[j][2] + v[j][3] * v[j][3]);
    ss = wave_sum(ss);
    const float rinv = __builtin_amdgcn_rsqf(ss * (1.0f / D) + EPS);
    f32x4 h[4]; float am = 0.f;
#pragma unroll
    for (int j = 0; j < 4; ++j) { h[j] = (v[j] * rinv) * gs[j] + sh[j]; am = fmaxf(fmaxf(am, fmaxf(fabsf(h[j][0]), fabsf(h[j][1]))), fmaxf(fabsf(h[j][2]), fabsf(h[j][3]))); }
    am = wave_max_nn(am);
    const unsigned sbits = __builtin_bit_cast(unsigned, 448.0f / fmaxf(am, 1e-20f)) & 0x7f800000u;
    const float scl = __builtin_bit_cast(float, sbits);
    if (lane == 0) *isc = __builtin_bit_cast(float, 0x7f000000u - sbits);
#pragma unroll
    for (int j = 0; j < 4; ++j) { const f32x4 q = h[j] * scl; ((unsigned*)dst)[lane + 64 * j] = pk4f8(q[0], q[1], q[2], q[3]); }
}
__device__ __forceinline__ void load_vec_bf(const bf16_t* p, int lane, f32x4 (&v)[4]) {
#pragma unroll
    for (int j = 0; j < 4; ++j) { const u32x2 w = ((const u32x2*)p)[lane + 64 * j]; v[j] = (f32x4){bflo(w.x), bfhi(w.x), bflo(w.y), bfhi(w.y)}; }
}
__device__ __forceinline__ void load_vec(const float* p, int lane, f32x4 (&v)[4]) {
#pragma unroll
    for (int j = 0; j < 4; ++j) v[j] = ((const f32x4*)p)[lane + 64 * j];
}


namespace attn_body {
using bf16=__hip_bfloat16;
using bf16x8=__attribute__((ext_vector_type(8)))short;
using s16x4=__attribute__((ext_vector_type(4)))short;
using f32x16=__attribute__((ext_vector_type(16)))float;
using u32x4=__attribute__((ext_vector_type(4)))unsigned;
constexpr int D=64,DM=1024,KVP=256;
constexpr int NW=8,QBLK=32,QB=QBLK*NW,KVBLK=64;
__device__ __forceinline__ int crow(int r,int hi){return (r&3)+8*(r>>2)+4*hi;}
#define SBAR() __builtin_amdgcn_sched_barrier(0)
__device__ __forceinline__ void cmask(f32x16&p0,f32x16&p1,int jb,int qrel,int hi){
  const float NEG=-INFINITY; int kb=64*jb+4*hi;
  #pragma unroll
  for(int r=0;r<16;++r){int kv=kb+(r&3)+8*(r>>2); if(kv>qrel)p0[r]=NEG; if(kv+32>qrel)p1[r]=NEG;}
}

constexpr int NSLOT=3, SLOTB=8192;
constexpr int LDS_K=0, LDS_V=NSLOT*SLOTB, LDS_WS=2*NSLOT*SLOTB, LDS_OST=LDS_WS+NW*64*4, LDS_BYTES=LDS_OST+NW*4096;
constexpr float C2=0.125f*1.4426950408889634f;
__device__ __forceinline__ void glds16(const void*gsrc,unsigned lds_dst){unsigned keep;
  asm volatile("s_mov_b32 %0, m0\n\ts_mov_b32 m0, %2\n\ts_nop 0\n\tglobal_load_lds_dwordx4 %1, off\n\ts_mov_b32 m0, %0":"=&s"(keep):"v"(gsrc),"s"(lds_dst):"memory");}
__device__ __forceinline__ float max3f(float a,float b,float c){float r;asm("v_max3_f32 %0, %1, %2, %3":"=v"(r):"v"(a),"v"(b),"v"(c));return r;}
__device__ __forceinline__ float max2f(float a,float b){float r;asm("v_max_f32_e32 %0, %1, %2":"=v"(r):"v"(a),"v"(b));return r;}
__device__ __forceinline__ float fadd_s(float a,float b){float r;asm("v_add_f32_e32 %0, %1, %2":"=v"(r):"v"(a),"v"(b));return r;}
__device__ __forceinline__ float fsub_s(float a,float b){float r;asm("v_sub_f32_e32 %0, %1, %2":"=v"(r):"v"(a),"v"(b));return r;}
typedef float f32x2_t __attribute__((ext_vector_type(2))); typedef __bf16 bf16x2_t __attribute__((ext_vector_type(2)));
__device__ __forceinline__ unsigned cvtpk_s(float lo,float hi){f32x2_t v={lo,hi};bf16x2_t b=__builtin_convertvector(v,bf16x2_t);return __builtin_bit_cast(unsigned,b);}
#define WAIT_BAR(N) asm volatile("s_waitcnt vmcnt(" #N ") lgkmcnt(0)\n\ts_barrier":::"memory")

__device__ __forceinline__ void qkt(f32x16&p0,f32x16&p1,const char*Kslot,const bf16x8*qr,const f32x16&negm,int r32,int hi){
  const char*kb=Kslot+hi*1024+r32*16;
  #pragma unroll
  for(int d0=0;d0<4;++d0){
    const bf16x8 b0=*reinterpret_cast<const bf16x8*>(kb+d0*2048);
    const bf16x8 b1=*reinterpret_cast<const bf16x8*>(kb+d0*2048+512);
    if(d0==0){p0=__builtin_amdgcn_mfma_f32_32x32x16_bf16(b0,qr[0],negm,0,0,0);p1=__builtin_amdgcn_mfma_f32_32x32x16_bf16(b1,qr[0],negm,0,0,0);}
    else{p0=__builtin_amdgcn_mfma_f32_32x32x16_bf16(b0,qr[d0],p0,0,0,0);p1=__builtin_amdgcn_mfma_f32_32x32x16_bf16(b1,qr[d0],p1,0,0,0);}}
}
typedef __attribute__((address_space(3))) const char* lds_cptr;
typedef short v4i16_t __attribute__((ext_vector_type(4)));
__device__ __forceinline__ void kload8(bf16x8*kf,lds_cptr kp){
  kf[0]=*(const __attribute__((address_space(3))) bf16x8*)(kp);      kf[1]=*(const __attribute__((address_space(3))) bf16x8*)(kp+512);
  kf[2]=*(const __attribute__((address_space(3))) bf16x8*)(kp+2048); kf[3]=*(const __attribute__((address_space(3))) bf16x8*)(kp+2560);
  kf[4]=*(const __attribute__((address_space(3))) bf16x8*)(kp+4096); kf[5]=*(const __attribute__((address_space(3))) bf16x8*)(kp+4608);
  kf[6]=*(const __attribute__((address_space(3))) bf16x8*)(kp+6144); kf[7]=*(const __attribute__((address_space(3))) bf16x8*)(kp+6656);
}
__device__ __forceinline__ void kload2(bf16x8*kf,lds_cptr kp,int j){ kf[2*j]=*(const __attribute__((address_space(3))) bf16x8*)(kp+j*2048); kf[2*j+1]=*(const __attribute__((address_space(3))) bf16x8*)(kp+j*2048+512); }
__device__ __forceinline__ s16x4 vtr(lds_cptr p){ return __builtin_bit_cast(s16x4,__builtin_amdgcn_ds_read_tr16_b64_v4i16((__attribute__((address_space(3))) v4i16_t*)p)); }
__device__ __forceinline__ float rowmax(const f32x16&p0,const f32x16&p1){
  float a=max3f(p0[0],p0[1],p1[0]),b=max3f(p0[2],p0[3],p1[1]);a=max3f(a,p1[2],p1[3]);
  #pragma unroll
  for(int r=4;r<16;r+=4){a=max3f(a,p0[r],p0[r+1]);b=max3f(b,p0[r+2],p0[r+3]);a=max3f(a,p1[r],p1[r+1]);b=max3f(b,p1[r+2],p1[r+3]);}
  const float m=max2f(a,b);
  auto rr=__builtin_amdgcn_permlane32_swap(__float_as_uint(m),__float_as_uint(m),false,false);
  return max2f(__uint_as_float(rr[0]),__uint_as_float(rr[1]));
}
__device__ __forceinline__ void pv(f32x16*o,int vb,bf16x8 pa0,bf16x8 pa1,bf16x8 pa2,bf16x8 pa3){
  #pragma unroll
  for(int d0=0;d0<2;++d0){s16x4 lo[4],hi[4];
    #pragma unroll
    for(int ks=0;ks<4;++ks){
      asm volatile("ds_read_b64_tr_b16 %0,%1 offset:%c2":"=&v"(lo[ks]):"v"(vb),"i"(d0*4096+ks*1024):"memory");
      asm volatile("ds_read_b64_tr_b16 %0,%1 offset:%c2":"=&v"(hi[ks]):"v"(vb),"i"(d0*4096+ks*1024+512):"memory");}
    asm volatile("s_waitcnt lgkmcnt(0)":::"memory");SBAR();
    #define PK(k) (bf16x8){lo[k][0],lo[k][1],lo[k][2],lo[k][3],hi[k][0],hi[k][1],hi[k][2],hi[k][3]}
    o[d0]=__builtin_amdgcn_mfma_f32_32x32x16_bf16(pa0,PK(0),o[d0],0,0,0);
    o[d0]=__builtin_amdgcn_mfma_f32_32x32x16_bf16(pa1,PK(1),o[d0],0,0,0);
    o[d0]=__builtin_amdgcn_mfma_f32_32x32x16_bf16(pa2,PK(2),o[d0],0,0,0);
    o[d0]=__builtin_amdgcn_mfma_f32_32x32x16_bf16(pa3,PK(3),o[d0],0,0,0);
    #undef PK
  }
}

#ifndef ATTN_STORE16
#define ATTN_STORE16(p,v) (*(u32x4*)(p)=(v))
#endif
template<int THRL,bool STATIC=false> __device__ __forceinline__ void attn_unit(const bf16*Qu,const bf16*__restrict__ Kh,const bf16*__restrict__ Vh,bf16*Ou,const int NT,char*shm,const float mb=0.f){
  const int tid=threadIdx.x,lane=tid&63,r32=lane&31,hi=lane>>5; const int wid=__builtin_amdgcn_readfirstlane(tid>>6);
  const bf16*Qw=Qu+(long)(wid*QBLK)*DM;
  const unsigned lds0=(unsigned)(uintptr_t)shm;
  float*wsf=(float*)(shm+LDS_WS)+wid*64;
  const bf16*ksrc=Kh+(long)lane*KVP+wid*8;
  const bf16*vsrc=Vh+(long)(16*(wid&3)+(lane>>2))*KVP+(wid>>2)*32+(lane&3)*8;
  const unsigned kdst=lds0+LDS_K+wid*1024, vdst=lds0+LDS_V+wid*1024;
  #define DMA_K(t,slot) glds16(ksrc+(long)(t)*KVBLK*KVP,(unsigned)__builtin_amdgcn_readfirstlane(kdst+(slot)))
  #define DMA_V(t,slot) glds16(vsrc+(long)(t)*KVBLK*KVP,(unsigned)__builtin_amdgcn_readfirstlane(vdst+(slot)))
  const int vb0=(int)(lds0+LDS_V)+((lane>>4)&1)*32+(lane&3)*8+(4*hi+((lane&15)>>2))*64;
  const char*Kbase=shm+LDS_K; bf16x8 kf[8];
  const lds_cptr shm3=(lds_cptr)shm; const lds_cptr kp0=shm3+LDS_K+hi*1024+r32*16; const lds_cptr vp0=shm3+LDS_V+((lane>>4)&1)*32+(lane&3)*8+(4*hi+((lane&15)>>2))*64;
  DMA_K(0,0);DMA_V(0,0);DMA_K(1,SLOTB);
  bf16x8 qr[4];
  #pragma unroll
  for(int d0=0;d0<4;++d0)qr[d0]=*reinterpret_cast<const bf16x8*>(&Qw[(long)r32*DM+d0*16+hi*8]);
  float mhat=0.f,l_reg=0.f;f32x16 o[2];o[0]=f32x16{};o[1]=f32x16{};f32x16 negm=f32x16{};
  if constexpr(STATIC){ _Pragma("unroll") for(int r=0;r<16;++r)negm[r]=-mb; }
  asm volatile("":"+v"(negm));
  #define CMASK(P0,P1,t) do{}while(0)
  bool resc=false;
  #define START(P0,P1) do{ resc=false; if constexpr(!STATIC){ const float rm=rowmax(P0,P1); \
    { const float dl=rm; mhat=fadd_s(mhat,dl); \
      _Pragma("unroll") for(int r=0;r<16;++r){P0[r]=fsub_s(P0[r],dl);P1[r]=fsub_s(P1[r],dl);} \
      _Pragma("unroll") for(int r=0;r<16;++r)negm[r]=-mhat; asm volatile("":"+v"(negm)); } } \
    _Pragma("unroll") for(int r=0;r<16;++r)P0[r]=__builtin_amdgcn_exp2f(P0[r]); }while(0)
  #define RESC() do{ if(resc){ asm volatile("s_waitcnt lgkmcnt(0)":::"memory"); \
      _Pragma("unroll") for(int d_=0;d_<2;++d_) _Pragma("unroll") for(int r=0;r<16;++r)o[d_][r]*=wsf[crow(r,hi)]; } }while(0)
  f32x16 pA0,pA1,pB0,pB1;
  int sl_prev=0,sl_cur=0,sl_next=SLOTB;
  #define ROT() do{sl_prev=sl_cur;sl_cur=sl_next;sl_next=(sl_next==(NSLOT-1)*SLOTB)?0:sl_next+SLOTB;}while(0)
  DMA_K(2,2*SLOTB);
  WAIT_BAR(3);
  qkt(pA0,pA1,Kbase,qr,negm,r32,hi);asm volatile("s_nop 15\n\ts_nop 7":"+v"(pA0),"+v"(pA1));CMASK(pA0,pA1,0);
  START(pA0,pA1);
  _Pragma("unroll") for(int r=0;r<16;++r)pA1[r]=__builtin_amdgcn_exp2f(pA1[r]);
  WAIT_BAR(0);
  DMA_K(3,0);DMA_V(1,SLOTB);
  ROT();
  kload8(kf,kp0+sl_cur);
  WAIT_BAR(2);
  s16x4 vlo[8],vhi[8]; u32x4 pw0,pw1,pw2,pw3;
  #define PKW(P,B) cvtpk_s(P[B],P[B+1])
  #define PAF(k) __builtin_bit_cast(bf16x8,pw##k)
  #define VFR(i) (bf16x8){vlo[i][0],vlo[i][1],vlo[i][2],vlo[i][3],vhi[i][0],vhi[i][1],vhi[i][2],vhi[i][3]}
  #define PIN(x) asm volatile("":"+v"(x))
  #define MX3(a,b,c) __builtin_fmaxf(__builtin_fmaxf((a),(b)),(c))
  #define GAPA(MF,A0,A1,A2,A3,W0,W1,PW) do{ MF; sacc+=A0; sacc+=A1; sacc+=A2; sacc+=A3; PIN(sacc); W0; W1; PIN(PW); SBAR(); }while(0)
  #define EX(v) __builtin_amdgcn_exp2f(v)
  #define GAPB(MF,X,B) do{ MF; X[B]=EX(X[B]); X[B+1]=EX(X[B+1]); X[B+2]=EX(X[B+2]); X[B+3]=EX(X[B+3]); PIN(X); SBAR(); }while(0)
  #define VRD(i) do{ vlo[i]=vtr(vp_+(((i)>>2)*4096+((i)&3)*1024)); vhi[i]=vtr(vp_+(((i)>>2)*4096+((i)&3)*1024+512)); }while(0)
  #define KRD(G,j) do{ if(G){ kload2(kf,kp0+sl_next,j); SBAR(); } }while(0)
  #define STEP(C0,C1,P0,P1,t,GK,GV,GL) do{ SBAR(); \
    const lds_cptr vp_=vp0+sl_prev; \
    VRD(0); SBAR(); float sacc=(P0[0]+P0[1]); \
    GAPA(C0=__builtin_amdgcn_mfma_f32_32x32x16_bf16(kf[0],qr[0],negm,0,0,0), P0[2],P0[3],P0[4],P0[5],     pw0[0]=PKW(P0,0), pw0[1]=PKW(P0,2), pw0); \
    VRD(4); SBAR(); GAPA(C1=__builtin_amdgcn_mfma_f32_32x32x16_bf16(kf[1],qr[0],negm,0,0,0), P0[6],P0[7],P0[8],P0[9],     pw0[2]=PKW(P0,4), pw0[3]=PKW(P0,6), pw0); \
    VRD(1); SBAR(); GAPA(C0=__builtin_amdgcn_mfma_f32_32x32x16_bf16(kf[2],qr[1],C0,0,0,0),   P0[10],P0[11],P0[12],P0[13], pw1[0]=PKW(P0,8), pw1[1]=PKW(P0,10), pw1); \
    VRD(5); SBAR(); GAPA(C1=__builtin_amdgcn_mfma_f32_32x32x16_bf16(kf[3],qr[1],C1,0,0,0),   P0[14],P0[15],P1[0],P1[1],   pw1[2]=PKW(P0,12),pw1[3]=PKW(P0,14), pw1); \
    VRD(2); SBAR(); GAPA(C0=__builtin_amdgcn_mfma_f32_32x32x16_bf16(kf[4],qr[2],C0,0,0,0),   P1[2],P1[3],P1[4],P1[5],     pw2[0]=PKW(P1,0), pw2[1]=PKW(P1,2), pw2); \
    VRD(6); SBAR(); GAPA(C1=__builtin_amdgcn_mfma_f32_32x32x16_bf16(kf[5],qr[2],C1,0,0,0),   P1[6],P1[7],P1[8],P1[9],     pw2[2]=PKW(P1,4), pw2[3]=PKW(P1,6), pw2); \
    VRD(3); SBAR(); GAPA(C0=__builtin_amdgcn_mfma_f32_32x32x16_bf16(kf[6],qr[3],C0,0,0,0),   P1[10],P1[11],P1[12],P1[13], pw3[0]=PKW(P1,8), pw3[1]=PKW(P1,10), pw3); \
    VRD(7); SBAR(); GAPA(C1=__builtin_amdgcn_mfma_f32_32x32x16_bf16(kf[7],qr[3],C1,0,0,0),   P1[14],P1[15],0.f,0.f,       pw3[2]=PKW(P1,12),pw3[3]=PKW(P1,14), pw3); \
    l_reg+=sacc; \
    if(GK){DMA_K((t)+3,sl_cur);} if(GV){DMA_V((t)+1,sl_next);} \
    CMASK(C0,C1,t); \
    resc=false; if constexpr(!STATIC) { float a=MX3(C0[0],C0[1],C1[0]),b=MX3(C0[2],C0[3],C1[1]); a=MX3(a,C1[2],C1[3]); \
      _Pragma("unroll") for(int r=4;r<16;r+=4){a=MX3(a,C0[r],C0[r+1]);b=MX3(b,C0[r+2],C0[r+3]);a=MX3(a,C1[r],C1[r+1]);b=MX3(b,C1[r+2],C1[r+3]);} \
      float rm=__builtin_fmaxf(a,b); { auto rr=__builtin_amdgcn_permlane32_swap(__float_as_uint(rm),__float_as_uint(rm),false,false); rm=__builtin_fmaxf(__uint_as_float(rr[0]),__uint_as_float(rr[1])); } \
      resc=false; \
      if(__builtin_expect(__any(rm>(float)THRL),0)){ const float dl=__builtin_fmaxf(rm,0.f); mhat+=dl; \
        _Pragma("unroll") for(int r=0;r<16;++r){C0[r]-=dl;C1[r]-=dl;} \
        _Pragma("unroll") for(int r=0;r<16;++r)negm[r]=-mhat; asm volatile("":"+v"(negm)); \
        const float f=__builtin_amdgcn_exp2f(-dl); l_reg*=f; if(hi==0)wsf[r32]=f; resc=true; } } \
    SBAR(); \
    GAPB(o[0]=__builtin_amdgcn_mfma_f32_32x32x16_bf16(PAF(0),VFR(0),o[0],0,0,0), C0,0); \
    GAPB(o[1]=__builtin_amdgcn_mfma_f32_32x32x16_bf16(PAF(0),VFR(4),o[1],0,0,0), C0,4); \
    KRD(GL,0); GAPB(o[0]=__builtin_amdgcn_mfma_f32_32x32x16_bf16(PAF(1),VFR(1),o[0],0,0,0), C0,8); \
    KRD(GL,1); GAPB(o[1]=__builtin_amdgcn_mfma_f32_32x32x16_bf16(PAF(1),VFR(5),o[1],0,0,0), C0,12); \
    KRD(GL,2); GAPB(o[0]=__builtin_amdgcn_mfma_f32_32x32x16_bf16(PAF(2),VFR(2),o[0],0,0,0), C1,0); \
    KRD(GL,3); GAPB(o[1]=__builtin_amdgcn_mfma_f32_32x32x16_bf16(PAF(2),VFR(6),o[1],0,0,0), C1,4); \
    GAPB(o[0]=__builtin_amdgcn_mfma_f32_32x32x16_bf16(PAF(3),VFR(3),o[0],0,0,0), C1,8); \
    GAPB(o[1]=__builtin_amdgcn_mfma_f32_32x32x16_bf16(PAF(3),VFR(7),o[1],0,0,0), C1,12); \
    }while(0)
  int t=1;
  #undef CMASK
  #define CMASK(P0,P1,t) do{}while(0)
  for(;t+5<NT;t+=2){
    STEP(pB0,pB1,pA0,pA1,t,true,true,true);     WAIT_BAR(2); RESC(); ROT();
    STEP(pA0,pA1,pB0,pB1,t+1,true,true,true);   WAIT_BAR(2); RESC(); ROT();
  }
  #undef CMASK
  #define CMASK(P0,P1,t) do{}while(0)
  #define ENDW(tt) do{ if((tt)+3<NT){WAIT_BAR(2);} else if((tt)+2<NT){WAIT_BAR(1);} else {WAIT_BAR(0);} }while(0)
  for(;t+1<NT;t+=2){
    STEP(pB0,pB1,pA0,pA1,t,(t+3<NT),(t+1<NT),(t+1<NT));       ENDW(t);   RESC(); ROT();
    STEP(pA0,pA1,pB0,pB1,t+1,(t+4<NT),(t+2<NT),(t+2<NT));     ENDW(t+1); RESC(); ROT();
  }
  STEP(pB0,pB1,pA0,pA1,NT-1,false,false,false); RESC();
  { float sacc=pB0[0]+pB0[1]; _Pragma("unroll") for(int r=2;r<16;++r)sacc+=pB0[r]; _Pragma("unroll") for(int r=0;r<16;++r)sacc+=pB1[r]; l_reg+=sacc;
    pw0=(u32x4){PKW(pB0,0),PKW(pB0,2),PKW(pB0,4),PKW(pB0,6)};pw1=(u32x4){PKW(pB0,8),PKW(pB0,10),PKW(pB0,12),PKW(pB0,14)};pw2=(u32x4){PKW(pB1,0),PKW(pB1,2),PKW(pB1,4),PKW(pB1,6)};pw3=(u32x4){PKW(pB1,8),PKW(pB1,10),PKW(pB1,12),PKW(pB1,14)};
    SBAR(); pv(o,vb0+sl_cur,PAF(0),PAF(1),PAF(2),PAF(3)); }
  #undef PKW
  #undef PAF
  #undef VFR
  #undef PIN
  #undef MX3
  #undef GAPA
  #undef GAPB
  #undef EX
  #undef VRD
  #undef KRD
  #undef STEP
  #undef ENDW
  {auto rr=__builtin_amdgcn_permlane32_swap(__float_as_uint(l_reg),__float_as_uint(l_reg),false,false);l_reg=__uint_as_float(rr[0])+__uint_as_float(rr[1]);}
  if(hi==0)wsf[32+r32]=l_reg;asm volatile("s_waitcnt lgkmcnt(0)":::"memory");
  float rli[16];
  #pragma unroll
  for(int r=0;r<16;++r)rli[r]=__builtin_amdgcn_rcpf(wsf[32+crow(r,hi)]);
  bf16*Ow=Ou+(long)(wid*QBLK)*DM;
  { bf16*stg=(bf16*)(shm+LDS_OST)+wid*2048;
    #pragma unroll
    for(int r=0;r<16;++r){const int orow=crow(r,hi);
      #pragma unroll
      for(int d0=0;d0<2;++d0)stg[orow*64+d0*32+r32]=__float2bfloat16(o[d0][r]*rli[r]);}
    asm volatile("s_waitcnt lgkmcnt(0)":::"memory");
    #pragma unroll
    for(int i=0;i<4;++i){const int row=i*8+(lane>>3),ch=lane&7; const u32x4 v=*(const u32x4*)(stg+row*64+ch*8); ATTN_STORE16(Ow+(long)row*DM+ch*8,v);} }
  asm volatile("s_waitcnt lgkmcnt(0)\n\ts_barrier":::"memory");
  #undef DMA_K
  #undef DMA_V
  #undef CMASK
  #undef START
  #undef RESC
  #undef ROT
}
constexpr int ATTN_LDS_BYTES=LDS_BYTES;
#undef SBAR
#undef WAIT_BAR
}

template <int LF> struct ConvRegs { static constexpr int P = 2 * LF + 8, NFC = P * 2 / 16  , NF = (NFC + NTHR - 1) / NTHR, NW = NB * (LF / 8) / NTHR; u32x4 f[NF]; u32x4 fp[NF]; u32x4 x1[NW]; u32x4 v[NW]; };
template <int LF>
__device__ __forceinline__ void conv_issue(ConvRegs<LF>& R, const bf16_t* FIc, const bf16_t* x1src, const bf16_t* vsrc, int tid) {
    const u32x4* fs = (const u32x4*)FIc;
#pragma unroll
    for (int k = 0; k < ConvRegs<LF>::NF; ++k) { const int i = tid + k * NTHR; const bool ok = i < ConvRegs<LF>::NFC; R.f[k] = ok ? fs[i] : (u32x4){0u, 0u, 0u, 0u}; R.fp[k] = (ok && i > 0) ? fs[i - 1] : (u32x4){0u, 0u, 0u, 0u}; }
#pragma unroll
    for (int k = 0; k < ConvRegs<LF>::NW; ++k) { const int i = tid + k * NTHR; R.x1[k] = *(const u32x4*)(x1src + (size_t)i * 8); R.v[k] = *(const u32x4*)(vsrc + (size_t)i * 8); }
}
__device__ __forceinline__ void unpack8(const u32x4 w, float (&x)[8]) { x[0] = bflo(w.x); x[1] = bfhi(w.x); x[2] = bflo(w.y); x[3] = bfhi(w.y); x[4] = bflo(w.z); x[5] = bfhi(w.z); x[6] = bflo(w.w); x[7] = bfhi(w.w); }
template <int LF>
__device__ __forceinline__ void conv_commit(const ConvRegs<LF>& R, LAS unsigned char* lds, const float (&cw8)[8], int tid, int lane, int wave) {
    constexpr int P = 2 * LF + 8, WSTR = LF + 8, NW = ConvRegs<LF>::NW, CPR = LF / 8;
    LAS unsigned char* FIL = lds; LAS unsigned char* WL = lds + ((8 * P * 2 + 255) & ~255);
    LAS unsigned* EDGE = (LAS unsigned*)(lds + 144 * 1024);
#pragma unroll
    for (int k = 0; k < ConvRegs<LF>::NF; ++k) { const int i = tid + k * NTHR; if (i < ConvRegs<LF>::NFC) {
        const unsigned cat[8] = {R.fp[k].x, R.fp[k].y, R.fp[k].z, R.fp[k].w, R.f[k].x, R.f[k].y, R.f[k].z, R.f[k].w};
#pragma unroll
        for (int c = 0; c < 8; ++c) { constexpr int dummy = 0; (void)dummy; const int q0 = (16 - 2 * c) >> 2; u32x4 o;
            if (c & 1) { o.x = __builtin_amdgcn_alignbyte(cat[q0 + 1], cat[q0], 2); o.y = __builtin_amdgcn_alignbyte(cat[q0 + 2], cat[q0 + 1], 2); o.z = __builtin_amdgcn_alignbyte(cat[q0 + 3], cat[q0 + 2], 2); o.w = __builtin_amdgcn_alignbyte(cat[q0 + 4], cat[q0 + 3], 2); }
            else { o.x = cat[q0]; o.y = cat[q0 + 1]; o.z = cat[q0 + 2]; o.w = cat[q0 + 3]; }
            *(LAS u32x4*)(FIL + c * (P * 2) + 16 * i) = o; } } }
    if (lane == 0 || lane == 63) {
#pragma unroll
        for (int k = 0; k < NW; ++k) EDGE[(wave * NW + k) * 2 + (lane == 63)] = lane == 0 ? ((R.x1[k].x & 0xffffu) | (R.v[k].x << 16)) : ((R.x1[k].w >> 16) | (R.v[k].w & 0xffff0000u)); }
    __syncthreads();
#pragma unroll
    for (int k = 0; k < NW; ++k) { const int i = tid + k * NTHR; const int b = i / CPR, ch = i % CPR;
        float x[8], y[8]; unpack8(R.x1[k], x); unpack8(R.v[k], y);
        float xp = __shfl_up(x[7], 1), yp = __shfl_up(y[7], 1), xn = __shfl_down(x[0], 1), yn = __shfl_down(y[0], 1);
        if (lane == 0 && wave > 0) { const unsigned e = EDGE[((wave - 1) * NW + k) * 2 + 1]; xp = bflo(e); yp = bfhi(e); }
        if (lane == 63 && wave < NWAVES - 1) { const unsigned e = EDGE[((wave + 1) * NW + k) * 2 + 0]; xn = bflo(e); yn = bfhi(e); }
        if (ch == 0) { xp = 0.f; yp = 0.f; } if (ch == CPR - 1) { xn = 0.f; yn = 0.f; }
        float o[8];
#pragma unroll
        for (int j = 0; j < 8; ++j) { const float xa = j == 0 ? xp : x[j - 1], xb = j == 7 ? xn : x[j + 1], ya = j == 0 ? yp : y[j - 1], yb = j == 7 ? yn : y[j + 1];
            const float sx = cw8[3] + cw8[0] * xa + cw8[1] * x[j] + cw8[2] * xb, sy = cw8[7] + cw8[4] * ya + cw8[5] * y[j] + cw8[6] * yb; o[j] = sx * sy; }
        u32x4 w; w.x = pk2(o[0], o[1]); w.y = pk2(o[2], o[3]); w.z = pk2(o[4], o[5]); w.w = pk2(o[6], o[7]);
        *(LAS u32x4*)(WL + b * (WSTR * 2) + ch * 16) = w; }
}
template <int LF>
__device__ __forceinline__ void conv_compute(LAS unsigned char* lds, bf16_t* ydst, int lane, int wv) {
    constexpr int IPW = LF / 256, NBK = LF / 32, P = 2 * LF + 8, WSTR = LF + 8;
    LAS unsigned char* FIL = lds; LAS unsigned char* WL = lds + ((8 * P * 2 + 255) & ~255);
    f32x4 acc[IPW][2]; bf16x8 Bw[IPW];
#pragma unroll
    for (int ii = 0; ii < IPW; ++ii) { acc[ii][0] = (f32x4){0.f, 0.f, 0.f, 0.f}; acc[ii][1] = (f32x4){0.f, 0.f, 0.f, 0.f}; Bw[ii] = (bf16x8){0, 0, 0, 0, 0, 0, 0, 0}; }
    const int rr = lane & 15, q = lane >> 4;
    const int aBase = (rr & 7) * (P * 2) + 2 * (LF - (rr - (rr & 7)) + 8 * q);
    const int bBase = rr * (WSTR * 2) + 16 * q;
#define CONV_STEPS(CHECK) do { _Pragma("unroll") for (int dd = 0; dd < IPW; ++dd) { \
        const int delta = IPW * d + dd; \
        const bf16x8 a0 = *(const LAS bf16x8*)(FIL + aBase - 64 * delta), a1 = *(const LAS bf16x8*)(FIL + aBase - 64 * delta - 32); \
        const int jn = IPW * (wv - d) - dd; \
        if (!(CHECK) || (jn >= 0 && jn < NBK)) Bw[(IPW - dd) % IPW] = *(const LAS bf16x8*)(WL + bBase + 64 * jn); \
        _Pragma("unroll") for (int ii = 0; ii < IPW; ++ii) { const int j = IPW * (wv - d) + ii - dd; \
            if (!(CHECK) || (j >= 0 && j < NBK)) { \
                acc[ii][0] = __builtin_amdgcn_mfma_f32_16x16x32_bf16(a0, Bw[(ii - dd + IPW) % IPW], acc[ii][0], 0, 0, 0); \
                acc[ii][1] = __builtin_amdgcn_mfma_f32_16x16x32_bf16(a1, Bw[(ii - dd + IPW) % IPW], acc[ii][1], 0, 0, 0); } } } } while (0)
    { const int d = wv - 8; CONV_STEPS(true); }
    for (int d = wv - 7; d < wv; ++d) { CONV_STEPS(false); }
    { const int d = wv; CONV_STEPS(true); }
#undef CONV_STEPS
#pragma unroll
    for (int ii = 0; ii < IPW; ++ii)
#pragma unroll
        for (int h = 0; h < 2; ++h) { u32x2 w; w.x = pk2(acc[ii][h][0], acc[ii][h][1]); w.y = pk2(acc[ii][h][2], acc[ii][h][3]);
            u32x2* yp = (u32x2*)(ydst + (size_t)rr * LF + 32 * (IPW * wv + ii) + 16 * h + 4 * q);
            asm volatile("global_store_dwordx2 %0, %1, off" :: "v"(yp), "v"(w) : "memory"); }
}


__device__ __forceinline__ void route_reduce(float (&p)[32], int lane) {
#pragma unroll
    for (int i = 0; i < 16; ++i) { const bool up = (lane & 32) != 0; const float send = up ? p[i] : p[i + 16], keep = up ? p[i + 16] : p[i]; p[i] = keep + __shfl_xor(send, 32); }
#pragma unroll
    for (int i = 0; i < 8; ++i) { const bool up = (lane & 16) != 0; const float send = up ? p[i] : p[i + 8], keep = up ? p[i + 8] : p[i]; p[i] = keep + __shfl_xor(send, 16); }
#pragma unroll
    for (int i = 0; i < 4; ++i) { const bool up = (lane & 8) != 0; const float send = up ? p[i] : p[i + 4], keep = up ? p[i + 4] : p[i]; p[i] = keep + __shfl_xor(send, 8); }
#pragma unroll
    for (int i = 0; i < 2; ++i) { const bool up = (lane & 4) != 0; const float send = up ? p[i] : p[i + 2], keep = up ? p[i + 2] : p[i]; p[i] = keep + __shfl_xor(send, 4); }
    { const bool up = (lane & 2) != 0; const float send = up ? p[0] : p[1], keep = up ? p[1] : p[0]; p[0] = keep + __shfl_xor(send, 2); }
    p[0] += __shfl_xor(p[0], 1);
}
__device__ __forceinline__ void route_top4(float val, int myE, float (&sv)[4], int (&si)[4]) {
    int rank = 0;
#pragma unroll
    for (int e = 0; e < 32; ++e) { const float o = __builtin_bit_cast(float, __builtin_amdgcn_readlane(__builtin_bit_cast(int, val), 2 * e)); rank += (o > val || (o == val && e < myE)) ? 1 : 0; }
#pragma unroll
    for (int k = 0; k < 4; ++k) { const unsigned long long m = __ballot(rank == k); const int src = __builtin_ctzll(m);
        si[k] = src >> 1; sv[k] = __builtin_bit_cast(float, __builtin_amdgcn_readlane(__builtin_bit_cast(int, val), src)); }
}
#define IN(k) (lo <= (k) && (k) < hi)
#define SEAM(k) do { if (IN(k) && IN((k) + 1)) xcd_barrier(bar); } while (0)
#define SEAMK(k, kind) SEAM(k)
#define KLOCALS \
    const float* x_in = args.in[I_X]; const float* c_in = args.in[I_C]; const float* ctx_in = args.in[I_CTX]; const float* cctx_in = args.in[I_CCTX]; \
    float* out = args.out; \
    float* modp = (float*)(ws + WS_MODP); float* modf = (float*)(ws + WS_MOD); \
    float* cosT = (float*)(ws + WS_ROPE); float* sinT = cosT + SEQ * 32; \
    float* a2tab = (float*)(ws + WS_A2); \
    int* top_e = (int*)(ws + WS_PAIR); int* ppos = top_e + NTOK * 4; float* pgate = (float*)(ppos + NTOK * 4); int* pdest = (int*)(pgate + NTOK * 4); \
    bf16_t* XB = (bf16_t*)(ws + WS_XB); \
    bf16_t* Wqkv_t = (bf16_t*)(ws + WS_WQKV); bf16_t* Wo_t = (bf16_t*)(ws + WS_WO); bf16_t* Win_t = (bf16_t*)(ws + WS_WIN); bf16_t* Wout_t = (bf16_t*)(ws + WS_WOUT); \
    bf16_t* Wgu_t = (bf16_t*)(ws + WS_WGU); bf16_t* Wdn_t = (bf16_t*)(ws + WS_WDN); \
    bf16_t* hA = (bf16_t*)(ws + WS_HA); bf16_t* Qb = (bf16_t*)(ws + WS_Q); bf16_t* Kb = (bf16_t*)(ws + WS_K); bf16_t* Vb = (bf16_t*)(ws + WS_V); \
    bf16_t* Upre = (bf16_t*)(ws + WS_UPRE); float* wsc_gu = (float*)(ws + WS_WSC_GU); float* wsc_dn = (float*)(ws + WS_WSC_DN); float* wsc_in = (float*)(ws + WS_WSC_IN); float* wsc_qkv = (float*)(ws + WS_WSC_QKV); float* tsc = (float*)(ws + WS_TSC); bf16_t* Yc = (bf16_t*)(ws + WS_YC); \
    bf16_t* XS = (bf16_t*)(ws + WS_XS); bf16_t* AB = (bf16_t*)(ws + WS_AB); int* elist = (int*)(ws + WS_ELIST); \
    const int wr = wave >> 2, wc = wave & 3, fr = lane & 15, fq = lane >> 4;
template <int layer> __device__ __forceinline__ void layer_body(const Args& args, LAS unsigned char* lds, const XcdBarrier& bar, const int tid, const int lane, const int wave, const int G, const int bid, const int lo, const int hi) {
    const int gw = bid * NWAVES + wave, NGW = G * NWAVES;
    unsigned char* ws = args.ws;
    gu32* ctl = (gu32*)(ws + WS_CTL);
    KLOCALS
        const int pb = 3 + 10 * layer;
        const int jm = layer >> 1;
        const bool ctx_live = layer < 2;
        const int nrows = ctx_live ? NTOK : NLAT;
        const float* mo = modf + (size_t)layer * NMODROW * MODW;

        if ((layer & 1) == 0) {
            if (EN_GEMM && IN(pb + 0)) {
                LAS float* ropeL = (LAS float*)(lds + 131072);
                __syncthreads();
                for (int i = tid; i < 3072; i += NTHR) { float v;
                    if (i < 1024) { const int rr = (i & 511) >> 4, jf = i & 15; v = (i < 512 ? cosT : sinT)[(rr * 64) * 32 + jf]; }
                    else { const int q = i - 1024, cc2 = (q & 1023) >> 4, jf = q & 15; v = (q < 1024 ? cosT : sinT)[cc2 * 32 + 16 + jf]; }
                    ropeL[i] = v; }
                __syncthreads();
                EpiQKV E{wsc_qkv + (size_t)jm * NQKV, tsc, Qb, Kb, Vb, args.in[I_QG] + jm * 64, args.in[I_KG] + jm * 64, ropeL};
                const QkvSched S{(const char*)hA, (const char*)Wqkv_t + (size_t)jm * NQKV * D, 1, ctx_live ? 1 : 0, G, bid};
                run_gemm_f8(lds, S, E);
            }
            SEAMK(pb + 0, 3);
            if (EN_ATT && IN(pb + 1)) {
                typedef attn_body::bf16 abf;
                const int x = bid & 7, sl = bid >> 3, nS = G >> 3;
                float gqm = fabsf(args.in[I_QG][jm * 64 + lane]), gkm = fabsf(args.in[I_KG][jm * 64 + lane]);
#pragma unroll
                for (int o = 1; o < 64; o <<= 1) { gqm = fmaxf(gqm, __shfl_xor(gqm, o)); gkm = fmaxf(gkm, __shfl_xor(gkm, o)); }
                const float mbound = __builtin_bit_cast(float, __builtin_amdgcn_readfirstlane(__builtin_bit_cast(int, 64.0f * C2 * 1.03f * gqm * gkm)));
                const bool stat = mbound < 40.0f;
                for (int q = sl; q < 256; q += nS) {
                    const int b = 2 * x + (q >> 7), kvh = (q >> 5) & 3, head = 4 * kvh + ((q >> 3) & 3), qb = q & 7;
                    abf* Qu = (abf*)(Qb + ((size_t)b * SEQ + qb * 256) * D + head * 64);
                    const abf* Kp = (const abf*)(Kb + (size_t)b * KVL * 256 + kvh * 64); const abf* Vp = (const abf*)(Vb + (size_t)b * KVL * 256 + kvh * 64);
                    if (stat) attn_body::attn_unit<8, true>(Qu, Kp, Vp, Qu, KVL / 64, (char*)lds, mbound);
                    else attn_body::attn_unit<8, false>(Qu, Kp, Vp, Qu, KVL / 64, (char*)lds);
                }
                if (ctx_live) for (int q = sl; q < 32; q += nS) {
                    const int b = 2 * x + (q >> 4), head = q & 15, kvh = head >> 2;
                    abf* Qu = (abf*)(Qb + ((size_t)NLAT + b * CL) * D + head * 64);
                    attn_body::attn_unit<8>(Qu, (const abf*)(Kb + ((size_t)b * KVL + SEQ) * 256 + kvh * 64), (const abf*)(Vb + ((size_t)b * KVL + SEQ) * 256 + kvh * 64), Qu, CL / 64, (char*)lds);
                }
            }
            SEAMK(pb + 1, 4);
            if (EN_GEMM && IN(pb + 2)) {
                EpiResid<layer == 0> E{x_in, ctx_in, XB, mo + 2 * D, nullptr};
                const bf16_t* Wt = Wo_t + (size_t)jm * D * D;
                const DenseSched S{Qb, Wt, nrows / 256, 4, G, bid};
                run_gemm(lds, S, E);
            }
            SEAMK(pb + 2, 5);
        } else {
            const float* cw = args.in[I_HCW] + (size_t)jm * 3 * NHY; const float* cb = args.in[I_HCB] + (size_t)jm * NHY;
            if (EN_GEMM && IN(pb + 0)) {
                const EpiRowScaleBiasBf16 E{Upre, NTOK, args.in[I_HBIN] + (size_t)jm * NHY, wsc_in + (size_t)jm * NHY, tsc};
                const WinTSchedF8 S{(const unsigned char*)Win_t + (size_t)jm * NHY * D, (const unsigned char*)hA, nrows / 256, G, bid};
                run_gemm_f8(lds, S, E);
            }
            SEAMK(pb + 0, 6);
            if (EN_CONV && IN(pb + 2)) {
                const bf16_t* uT = Upre;
#define CONV_CW8(C) { cw[0 * NHY + D + (C)], cw[1 * NHY + D + (C)], cw[2 * NHY + D + (C)], cb[D + (C)], cw[0 * NHY + 2 * D + (C)], cw[1 * NHY + 2 * D + (C)], cw[2 * NHY + 2 * D + (C)], cb[2 * D + (C)] }
                { const bf16_t* FIb = (const bf16_t*)(ws + (jm == 0 ? WS_FI0 : WS_FI1));
                  ConvRegs<SEQ> R; int c = bid;
                  if (c < 1024) conv_issue<SEQ>(R, FIb + (size_t)c * 8 * FP_L, uT + (size_t)(D + c) * NTOK, uT + (size_t)(2 * D + c) * NTOK, tid);
                  for (; c < 1024; c += G) {
                      const float cw8[8] = CONV_CW8(c);
                      LDS_WAIT(); __builtin_amdgcn_s_barrier();
                      conv_commit<SEQ>(R, lds, cw8, tid, lane, wave);
                      LDS_WAIT(); __builtin_amdgcn_s_barrier();
                      if (c + G < 1024) conv_issue<SEQ>(R, FIb + (size_t)(c + G) * 8 * FP_L, uT + (size_t)(D + c + G) * NTOK, uT + (size_t)(2 * D + c + G) * NTOK, tid);
                      conv_compute<SEQ>(lds, Yc + (size_t)c * NB * SEQ, lane, wave);
                  } }
                if (ctx_live) for (int c = bid; c < 1024; c += G) {
                    const float cw8[8] = CONV_CW8(c);
                    ConvRegs<CL> R; conv_issue<CL>(R, (const bf16_t*)(ws + WS_FI2) + (size_t)c * 8 * FP_C, uT + (size_t)(D + c) * NTOK + NLAT, uT + (size_t)(2 * D + c) * NTOK + NLAT, tid);
                    __syncthreads(); conv_commit<CL>(R, lds, cw8, tid, lane, wave); __syncthreads();
                    conv_compute<CL>(lds, Yc + WC_CTX_OFF + (size_t)c * NB * CL, lane, wave);
                }
#undef CONV_CW8
            }
            SEAMK(pb + 2, 8);
            if (EN_MISC && IN(pb + 3)) {
                LAS unsigned char* T = lds;
                const bf16_t* uT = Upre;
                const int nlat_u = NB * 16 * 4, nctx_u = ctx_live ? NB * 2 * 4 : 0;
                const int hw = tid >> 5, l32 = tid & 31;
                for (int u = bid; u < nlat_u + nctx_u; u += G) {
                    int b, s0, c0, Ls, rowb; const bf16_t* srcb;
                    if (u < nlat_u) { b = u >> 6; s0 = ((u >> 2) & 15) * 128; c0 = (u & 3) * 256; Ls = SEQ; rowb = b * SEQ; srcb = Yc; }
                    else { const int q = u - nlat_u; b = q >> 3; s0 = ((q >> 2) & 1) * 128; c0 = (q & 3) * 256; Ls = CL; rowb = NLAT + b * CL; srcb = Yc + WC_CTX_OFF; }
                    __syncthreads();
                    { const int ch = tid & 15;
                      u32x4 yw[8], uw[8]; unsigned short ep[8], en[8]; float wq[8][4];
#pragma unroll
                      for (int i = 0; i < 8; ++i) { const int cg = c0 + i * 32 + (tid >> 4);
                          yw[i] = *(const u32x4*)(srcb + ((size_t)cg * NB + b) * Ls + s0 + ch * 8);
                          const bf16_t* up = uT + (size_t)cg * NTOK + rowb + s0 + ch * 8; uw[i] = *(const u32x4*)up; ep[i] = up[-1]; en[i] = up[8];
                          wq[i][0] = cw[0 * NHY + cg]; wq[i][1] = cw[1 * NHY + cg]; wq[i][2] = cw[2 * NHY + cg]; wq[i][3] = cb[cg]; }
#pragma unroll
                      for (int i = 0; i < 8; ++i) { const int c = i * 32 + (tid >> 4);
                          float x[8], y[8]; unpack8(uw[i], x); unpack8(yw[i], y);
                          float xp = __shfl_up(x[7], 1), xn = __shfl_down(x[0], 1);
                          if (ch == 0) xp = s0 > 0 ? bf2f(ep[i]) : 0.f;
                          if (ch == 15) xn = s0 + 128 < Ls ? bf2f(en[i]) : 0.f;
                          float o[8];
#pragma unroll
                          for (int j = 0; j < 8; ++j) { const float xa = j == 0 ? xp : x[j - 1], xb = j == 7 ? xn : x[j + 1]; o[j] = (wq[i][3] + wq[i][0] * xa + wq[i][1] * x[j] + wq[i][2] * xb) * y[j]; }
                          u32x4 w; w.x = pk2(o[0], o[1]); w.y = pk2(o[2], o[3]); w.z = pk2(o[4], o[5]); w.w = pk2(o[6], o[7]);
                          *(LAS u32x4*)(T + c * 256 + ((ch ^ ((c >> 3) & 15)) * 16)) = w; } }
                    __syncthreads();
                    const int cc = c0 + 8 * l32, sb = s0 + 8 * hw;
                    u32x4 zv[8];
#pragma unroll
                    for (int c = 0; c < 8; ++c) zv[c] = *(const LAS u32x4*)(T + (8 * l32 + c) * 256 + ((hw ^ (l32 & 15)) * 16));
#pragma unroll
                    for (int si = 0; si < 8; ++si) { unsigned hv[8];
#pragma unroll
                        for (int c = 0; c < 8; ++c) { const unsigned wd = zv[c][si >> 1]; hv[c] = (si & 1) ? (wd >> 16) : (wd & 0xffffu); }
                        u32x4 o; o.x = hv[0] | (hv[1] << 16); o.y = hv[2] | (hv[3] << 16); o.z = hv[4] | (hv[5] << 16); o.w = hv[6] | (hv[7] << 16);
                        *(u32x4*)(hA + (size_t)(rowb + sb + si) * D + cc) = o; }
                }
            }
            SEAMK(pb + 3, 9);
            if (EN_GEMM && IN(pb + 4)) {
                EpiResid<layer == 0> E{x_in, ctx_in, XB, mo + 2 * D, args.in[I_HBOUT] + (size_t)jm * D};
                const bf16_t* Wt = Wout_t + (size_t)jm * D * D;
                const DenseSched S{hA, Wt, nrows / 256, 4, G, bid};
                run_gemm(lds, S, E);
            }
            SEAMK(pb + 4, 10);
        }

        gu32* cnt = ctl + CW_CNT + layer * 32 * 64;
        if (EN_ROUTER && IN(pb + 5)) {
            constexpr int WSTR = D + 8, MAXT = 20;
            LAS bf16_t* WT = (LAS bf16_t*)lds;
            LAS float* CB = (LAS float*)(lds + 2 * 32 * WSTR * 2);
            LAS float* CRED = CB + 32;
            LAS int* LCNT = (LAS int*)(CRED + 512);
            LAS int* PREC = LCNT + 64;
            LAS float* RINV = (LAS float*)(PREC + 8 * MAXT * 4);
            LAS unsigned* SCLB = (LAS unsigned*)(RINV + 8 * MAXT);
            __syncthreads();
            if (tid < 64) LCNT[tid] = 0;
            for (int i = tid; i < 8 * MAXT * 4; i += NTHR) PREC[i] = -1;
            const int TPW = (((nrows + NGW - 1) / NGW) + 1) & ~1;
            const int rf = gw * TPW; const int nval = rf >= nrows ? 0 : (nrows - rf < TPW ? nrows - rf : TPW);
            { int curb = -1; f32x4 gs[4], sh[4]; u32x2 w0[4], w1[4], w2[4];
              auto ldrow = [&](u32x2 (&w)[4], int row) {
#pragma unroll
                  for (int j = 0; j < 4; ++j) w[j] = ((const u32x2*)(XB + (size_t)row * D))[lane + 64 * j]; };
              auto rowbody = [&](u32x2 (&w)[4], int ti) { const int r = rf + ti; f32x4 v[4];
#pragma unroll
                  for (int j = 0; j < 4; ++j) v[j] = (f32x4){bflo(w[j].x), bfhi(w[j].x), bflo(w[j].y), bfhi(w[j].y)};
                  if (ti + 3 < nval) ldrow(w, r + 3);
                  const int bq = mod_row(r);
                  if (bq != curb) { const float* mr = mo + (size_t)bq * MODW; load_vec(mr + 4 * D, lane, gs); load_vec(mr + 3 * D, lane, sh); curb = bq;
                      asm volatile("" : "+v"(gs[0]), "+v"(gs[1]), "+v"(gs[2]), "+v"(gs[3]), "+v"(sh[0]), "+v"(sh[1]), "+v"(sh[2]), "+v"(sh[3])); }
                  float ss = 0.f;
#pragma unroll
                  for (int j = 0; j < 4; ++j) ss += (v[j][0] * v[j][0] + v[j][1] * v[j][1]) + (v[j][2] * v[j][2] + v[j][3] * v[j][3]);
                  ss = wave_sum(ss); const float rinv = __builtin_amdgcn_rsqf(ss * (1.0f / D) + EPS);
                  f32x4 hq[4]; float am = 0.f;
#pragma unroll
                  for (int j = 0; j < 4; ++j) { hq[j] = (v[j] * rinv) * gs[j] + sh[j]; am = fmaxf(fmaxf(am, fmaxf(fabsf(hq[j][0]), fabsf(hq[j][1]))), fmaxf(fabsf(hq[j][2]), fabsf(hq[j][3]))); }
                  am = wave_max_nn(am);
                  const unsigned sbits = __builtin_bit_cast(unsigned, 448.0f / fmaxf(am, 1e-20f)) & 0x7f800000u;
                  const float scl = __builtin_bit_cast(float, sbits);
                  if (lane == 0) { RINV[wave * MAXT + ti] = rinv; SCLB[wave * MAXT + ti] = 0x7f000000u - sbits; }
#pragma unroll
                  for (int j = 0; j < 4; ++j) { const f32x4 h = hq[j] * scl; unsigned* dp = (unsigned*)((unsigned char*)hA + (size_t)r * D) + lane + 64 * j; const unsigned pv8 = pk4f8(h[0], h[1], h[2], h[3]);
                      asm volatile("global_store_dword %0, %1, off" :: "v"(dp), "v"(pv8) : "memory"); } };
              if (nval > 0) ldrow(w0, rf); if (nval > 1) ldrow(w1, rf + 1); if (nval > 2) ldrow(w2, rf + 2);
              for (int ti = 0; ti < nval; ti += 3) { rowbody(w0, ti); if (ti + 1 < nval) rowbody(w1, ti + 1); if (ti + 2 < nval) rowbody(w2, ti + 2); } }
            const int rb0 = bid * NWAVES * TPW; const int rb1 = (rb0 + NWAVES * TPW < nrows ? rb0 + NWAVES * TPW : nrows) - 1;
            const int bb0 = rb0 < nrows ? mod_row(rb0) : 1, bb1 = rb0 < nrows ? mod_row(rb1) : 0;
            const float* rw = args.in[I_RW] + (size_t)layer * D * NE; const float* rbias = args.in[I_RB] + layer * NE;
            for (int bq = bb0; bq <= bb1; ++bq) {
                __syncthreads();
                { const float* gsb = mo + (size_t)bq * MODW + 4 * D; const float* shb = mo + (size_t)bq * MODW + 3 * D;
                  const int e = tid & 31; float cpart = 0.f;
#pragma unroll 4
                  for (int jj = 0; jj < 8; ++jj) { const int k0 = 8 * ((tid >> 5) + 16 * jj);
                      const f32x4 g0 = *(const f32x4*)(gsb + k0), g1 = *(const f32x4*)(gsb + k0 + 4), s0 = *(const f32x4*)(shb + k0), s1 = *(const f32x4*)(shb + k0 + 4);
                      float wv[8];
#pragma unroll
                      for (int q = 0; q < 8; ++q) wv[q] = rw[(size_t)(k0 + q) * NE + e];
                      float pv[8]; unsigned hw[4], lw[4];
#pragma unroll
                      for (int q = 0; q < 4; ++q) { pv[q] = g0[q] * wv[q]; pv[4 + q] = g1[q] * wv[4 + q]; cpart += s0[q] * wv[q] + s1[q] * wv[4 + q]; }
#pragma unroll
                      for (int q = 0; q < 4; ++q) { hw[q] = pk2(pv[2 * q], pv[2 * q + 1]); lw[q] = pk2(pv[2 * q] - bflo(hw[q]), pv[2 * q + 1] - bfhi(hw[q])); }
                      *(LAS u32x4*)(WT + (size_t)e * WSTR + k0) = (u32x4){hw[0], hw[1], hw[2], hw[3]};
                      *(LAS u32x4*)(WT + (size_t)(32 + e) * WSTR + k0) = (u32x4){lw[0], lw[1], lw[2], lw[3]}; }
                  CRED[(tid >> 5) * 32 + e] = cpart; }
                __syncthreads();
                if (tid < 32) { float c = rbias[tid];
#pragma unroll
                    for (int q = 0; q < 16; ++q) c += CRED[q * 32 + tid];
                    CB[tid] = c; }
                __syncthreads();
                if (nval > 0 && mod_row(rf) <= bq && bq <= mod_row(rf + nval - 1)) {
                    const int e = lane & 31, kh = lane >> 5; const int trow = rf + (e < nval ? e : nval - 1);
                    const bf16_t* ap = XB + (size_t)trow * D + 8 * kh;
                    const LAS bf16_t* bhp = WT + (size_t)e * WSTR + 8 * kh; const LAS bf16_t* blp = bhp + 32 * WSTR;
                    f32x16 acc;
#pragma unroll
                    for (int q = 0; q < 16; ++q) acc[q] = 0.f;
                    bf16x8 a0[8], a1[8];
#pragma unroll
                    for (int i = 0; i < 8; ++i) a0[i] = *(const bf16x8*)(ap + 16 * i);
#pragma unroll 1
                    for (int kb = 0; kb < D / 16; kb += 16) {
#pragma unroll
                        for (int i = 0; i < 8; ++i) a1[i] = *(const bf16x8*)(ap + 16 * (kb + 8 + i));
#pragma unroll
                        for (int i = 0; i < 8; ++i) { acc = __builtin_amdgcn_mfma_f32_32x32x16_bf16(a0[i], *(const LAS bf16x8*)(bhp + 16 * (kb + i)), acc, 0, 0, 0);
                            acc = __builtin_amdgcn_mfma_f32_32x32x16_bf16(a0[i], *(const LAS bf16x8*)(blp + 16 * (kb + i)), acc, 0, 0, 0); }
                        if (kb + 16 < D / 16) {
#pragma unroll
                            for (int i = 0; i < 8; ++i) a0[i] = *(const bf16x8*)(ap + 16 * (kb + 16 + i)); }
#pragma unroll
                        for (int i = 0; i < 8; ++i) { acc = __builtin_amdgcn_mfma_f32_32x32x16_bf16(a1[i], *(const LAS bf16x8*)(bhp + 16 * (kb + 8 + i)), acc, 0, 0, 0);
                            acc = __builtin_amdgcn_mfma_f32_32x32x16_bf16(a1[i], *(const LAS bf16x8*)(blp + 16 * (kb + 8 + i)), acc, 0, 0, 0); } }
                    const float cbe = CB[e];
                    const int hf = lane >> 5;
#pragma unroll
                    for (int r = 0; r < 10; ++r) { const int tA = (r & 3) + 8 * (r >> 2), tB = tA + 4;
                        const bool okA = tA < nval && mod_row(rf + tA) == bq, okB = tB < nval && mod_row(rf + (tB < MAXT ? tB : 0)) == bq;
                        if (okA || okB) {
                            const int tmine = hf ? (tB < MAXT ? tB : MAXT - 1) : tA;
                            float val = RINV[wave * MAXT + tmine] * acc[r] + cbe;
                            float sv[4]; int si[4];
#pragma unroll
                            for (int k = 0; k < 4; ++k) {
                                int x = __builtin_bit_cast(int, val); float m = val;
                                m = fmaxf(m, __builtin_bit_cast(float, __builtin_amdgcn_update_dpp(x, x, 0xB1, 0xF, 0xF, false))); x = __builtin_bit_cast(int, m);
                                m = fmaxf(m, __builtin_bit_cast(float, __builtin_amdgcn_update_dpp(x, x, 0x4E, 0xF, 0xF, false))); x = __builtin_bit_cast(int, m);
                                m = fmaxf(m, __builtin_bit_cast(float, __builtin_amdgcn_update_dpp(x, x, 0x124, 0xF, 0xF, false))); x = __builtin_bit_cast(int, m);
                                m = fmaxf(m, __builtin_bit_cast(float, __builtin_amdgcn_update_dpp(x, x, 0x128, 0xF, 0xF, false)));
                                m = fmaxf(m, __shfl_xor(m, 16));
                                const unsigned long long mk = __ballot(val == m);
                                const int wlo = __builtin_ctz((unsigned)mk | 0x80000000u), whi = __builtin_ctz((unsigned)(mk >> 32) | 0x80000000u);
                                const int win = hf ? whi : wlo;
                                sv[k] = m; si[k] = win; if ((lane & 31) == win) val = -INFINITY; }
                            if ((lane & 31) < 4 && (hf ? okB : okA)) { const int k = lane & 31; const float e1 = __expf(sv[1] - sv[0]), e2 = __expf(sv[2] - sv[0]), e3 = __expf(sv[3] - sv[0]); const float inv = 1.0f / (1.0f + e1 + e2 + e3);
                                const int ex = k == 0 ? si[0] : (k == 1 ? si[1] : (k == 2 ? si[2] : si[3])); const float gt = (k == 0 ? 1.0f : (k == 1 ? e1 : (k == 2 ? e2 : e3))) * inv;
                                const int tt = hf ? tB : tA; const int rr = rf + tt; const int rk = __hip_atomic_fetch_add(LCNT + ex, 1, __ATOMIC_RELAXED, __HIP_MEMORY_SCOPE_WORKGROUP);
                                top_e[rr * 4 + k] = ex; pgate[rr * 4 + k] = gt; PREC[(wave * MAXT + tt) * 4 + k] = ex | (rk << 8); } } }
                }
            }
            __syncthreads();
            if (tid < 32) LCNT[32 + tid] = (int)__hip_atomic_fetch_add(cnt + tid * 64, (unsigned)LCNT[tid], RLX_AGENT);
            __syncthreads();
            for (int i = tid; i < 8 * MAXT * 4; i += NTHR) { const int rec = PREC[i]; if (rec >= 0) { const int e = rec & 255, rank = rec >> 8, w = i / (MAXT * 4), ti = (i / 4) % MAXT, k = i & 3;
                const int r = (bid * NWAVES + w) * TPW + ti; const int pos = LCNT[32 + e] + rank; ppos[r * 4 + k] = pos; elist[(size_t)e * NTOK + pos] = r | (int)SCLB[w * MAXT + ti]; } }
        }
        SEAMK(pb + 5, 11);
        LAS int* PADS = (LAS int*)(lds + LDS_BYTES - 4096);
        LAS unsigned char* TE = (LAS unsigned char*)(PADS + 128);
        if (IN(pb + 7) || IN(pb + 8) || IN(pb + 9)) {
            __syncthreads();
            if (tid < 32) PADS[64 + tid] = (int)__hip_atomic_load(cnt + tid * 64, RLX_AGENT);
            __syncthreads();
            if (tid < 64) {
                const int nt = lane < 32 ? (PADS[64 + lane] + 255) >> 8 : 0; int inc = nt;
#pragma unroll
                for (int o = 1; o < 32; o <<= 1) { const int v = __shfl_up(inc, o); if (lane >= o) inc += v; }
                if (lane < 32) PADS[lane] = (inc - nt) << 8; if (lane == 31) PADS[32] = inc << 8;
            }
            __syncthreads();
            { const int ntile = PADS[32] >> 8; for (int t = tid; t < ntile; t += NTHR) { int e = 0;
#pragma unroll
                  for (int st = 16; st >= 1; st >>= 1) if (PADS[e + st] <= (t << 8)) e += st;
                  TE[t] = (unsigned char)e; } }
            __syncthreads();
        }
        if (EN_GEMM && IN(pb + 7)) {
            const int ntile = PADS[32] >> 8;
            LAS int* ROWS = (LAS int*)(lds + 131072);
            { int nun = 0; { Unit uu; while (xcd_unit(nun, G, bid, ntile, 8, uu.pm, uu.pn)) ++nun; }
              int tokv[12];
#pragma unroll
              for (int k = 0; k < 12; ++k) { const int idx = tid + k * NTHR, ui = idx >> 8; tokv[k] = 0;
                  if (ui < nun) { Unit uu; (void)xcd_unit(ui, G, bid, ntile, 8, uu.pm, uu.pn); const int e = TE[uu.pm]; const int pos = uu.pm * 256 - PADS[e] + (idx & 255);
                      if (pos < PADS[64 + e]) tokv[k] = elist[(size_t)e * NTOK + pos]; } }
#pragma unroll
              for (int k = 0; k < 12; ++k) { const int idx = tid + k * NTHR; if ((idx >> 8) < nun) ROWS[idx] = tokv[k]; } }
            __syncthreads();
            const MoeGatherSchedF8 S{(const unsigned char*)hA, (const unsigned char*)Wgu_t + (size_t)layer * NE * NGU * D, TE, ROWS, ntile, 8, NGU, G, bid};
            const EpiSwiglu<true> E{AB, args.in[I_BGU] + (size_t)layer * NE * NGU, wsc_gu + (size_t)layer * NE * NGU, ROWS, (const LAS float*)(lds + pg8::PRE_OFF)};
            run_gemm_gather_f8(lds, S, E);
        }
        SEAMK(pb + 7, 12);
        if (EN_GEMM && IN(pb + 8)) {
            const int ntile = PADS[32] >> 8;
            const MoeSchedF8 S{(const unsigned char*)AB, (const unsigned char*)Wdn_t + (size_t)layer * NE * D * D, TE, ntile, 4, D, G, bid};
            const EpiScaleBiasBf16 E{XS, D, args.in[I_BDN] + (size_t)layer * NE * D, D, wsc_dn + (size_t)layer * NE * D, 1.0f / F8_HS, (const LAS float*)(lds + pg8::PRE_OFF)};
            run_gemm_f8_pre(lds, S, E);
        }
        SEAMK(pb + 8, 13);
        if (EN_MISC && IN(pb + 9)) {
            const bool has_next = layer + 1 < DEPTH;
            const float* mo_n = modf + (size_t)(layer + 1) * NMODROW * MODW; const float* g1n = args.in[I_N1G] + (has_next ? (layer + 1) * D : 0);
            const int nnext = (layer + 1 < 3) ? NTOK : NLAT;
            const int TPW = (nrows + NGW - 1) / NGW;
            int curb = -1; f32x4 gm[4], gsn[4], shn[4];
            for (int ti = 0; ti < TPW; ++ti) {
                const int r = gw * TPW + ti; if (r >= nrows) break;
                bf16_t* xr = XB + (size_t)r * D;
                int dest[4]; float gt[4];
#pragma unroll
                for (int k = 0; k < 4; ++k) { dest[k] = PADS[top_e[r * 4 + k]] + ppos[r * 4 + k]; gt[k] = pgate[r * 4 + k]; }
                u32x2 yw[4][4]; f32x4 v[4], h[4];
#pragma unroll
                for (int k = 0; k < 4; ++k) { const u32x2* yr = (const u32x2*)(XS + (size_t)dest[k] * D);
#pragma unroll
                    for (int j = 0; j < 4; ++j) yw[k][j] = yr[lane + 64 * j]; }
                load_vec_bf(xr, lane, v);
                const int b = mod_row(r);
                if (b != curb) { load_vec(mo + (size_t)b * MODW + 5 * D, lane, gm); if (has_next) { const float* mn = mo_n + (size_t)b * MODW; load_vec(mn + D, lane, gsn); load_vec(mn, lane, shn); } curb = b; }
#pragma unroll
                for (int j = 0; j < 4; ++j) { f32x4 y = (f32x4){0.f, 0.f, 0.f, 0.f};
#pragma unroll
                    for (int k = 0; k < 4; ++k) { const u32x2 w = yw[k][j]; y[0] += gt[k] * bflo(w.x); y[1] += gt[k] * bfhi(w.x); y[2] += gt[k] * bflo(w.y); y[3] += gt[k] * bfhi(w.y); }
                    v[j] = v[j] + gm[j] * y;
                    if (layer == DEPTH - 1) ((f32x4*)(out + (size_t)r * D))[lane + 64 * j] = v[j];
                    else { u32x2 w; w.x = pk2(v[j][0], v[j][1]); w.y = pk2(v[j][2], v[j][3]); ((u32x2*)xr)[lane + 64 * j] = w; } }
                if (has_next && r < nnext) { const int rp = (layer & 1) == 0 ? (r & ~31) + slot32(r & 31) : r;
                    norm_mod_store_f8(v, gsn, shn, (unsigned char*)hA + (size_t)rp * D, tsc + r, lane); }
            }
        }
        SEAMK(pb + 9, 14);
}

__global__ void __launch_bounds__(NTHR, 2) fwd(Args args) {
    extern __shared__ __attribute__((aligned(16))) unsigned char lds_raw[];
    LAS unsigned char* lds = (LAS unsigned char*)lds_raw;
    const int tid = threadIdx.x, lane = tid & 63, wave = __builtin_amdgcn_readfirstlane(tid >> 6);
    const int G = gridDim.x, bid = blockIdx.x;
    const int gw = bid * NWAVES + wave, NGW = G * NWAVES;
    unsigned char* ws = args.ws;
    gu32* ctl = (gu32*)(ws + WS_CTL);
    volatile LAS unsigned* MISC = (volatile LAS unsigned*)(lds + MISC_OFF);
    if (tid < 64) MISC[tid] = 0u;
    __syncthreads();
    XcdBarrier bar; bar.bar = (unsigned*)ctl + CW_BAR; bar.x = 0; bar.st = MISC + 8;
    const int lo = args.ph_lo, hi = args.ph_hi;
    if (hi - lo > 1) bar = xcd_barrier_post((unsigned*)ctl + CW_BAR, MISC + 8);

    KLOCALS

    if (EN_PRO && IN(0)) {
        {
            LAS float* scr = (LAS float*)(lds + wave * 8448);
            constexpr int IT_SQ = 16 * (D / 32);
            constexpr int N0 = 0, N1 = N0 + 2 * IT_SQ, N2 = N1, N3 = N2 + 2 * IT_SQ;
            for (int it = gw; it < N3; it += NGW) {
                if (it < N1) { const int q = it - N0, mtx = q / IT_SQ, r = q % IT_SQ; transpose_item<0>(args.in[I_WO] + (size_t)mtx * D * D, D, Wo_t + (size_t)mtx * D * D, scr, r, lane); }
                else if (it < N3) { const int q = it - N2, mtx = q / IT_SQ, r = q % IT_SQ; transpose_item<0>(args.in[I_HWOUT] + (size_t)mtx * D * D, D, Wout_t + (size_t)mtx * D * D, scr, r, lane); }
            }
        }
        __syncthreads();
        constexpr int NAUX = 32; const int GC = G - NAUX, ab = bid - GC;
        {
            LAS float* MX = (LAS float*)lds;
            constexpr int NGUI = 128 * (NGU / 64), NDNI = 128 * (D / 64), NINI = 2 * (NHY / 64), NQKI = 2 * (NQKV / 64);
            int par = 0;
            if (bid < GC) for (int it = bid; it < NGUI + NDNI + NINI + NQKI; it += GC, par ^= 1) {
                if (it >= NGUI + NDNI + NINI) { const int q = it - NGUI - NDNI - NINI, mtx = q / (NQKV / 64), nb = q % (NQKV / 64); convert_item64_f8<1, true>(args.in[I_WQKV] + (size_t)mtx * D * NQKV, NQKV, (unsigned char*)Wqkv_t + (size_t)mtx * NQKV * D, wsc_qkv + (size_t)mtx * NQKV, MX, par, nb, tid); }
                else if (it >= NGUI + NDNI) { const int q = it - NGUI - NDNI, mtx = q / (NHY / 64), nb = q % (NHY / 64); convert_item64_f8<3, false>(args.in[I_HWIN] + (size_t)mtx * D * NHY, NHY, (unsigned char*)Win_t + (size_t)mtx * NHY * D, wsc_in + (size_t)mtx * NHY, MX, par, nb, tid); }
                else if (it < NGUI) { const int mtx = it / (NGU / 64), nb = it % (NGU / 64); convert_item64_f8<2, false>(args.in[I_WGU] + (size_t)mtx * D * NGU, NGU, (unsigned char*)Wgu_t + (size_t)mtx * NGU * D, wsc_gu + (size_t)mtx * NGU, MX, par, nb, tid); }
                else { const int q = it - NGUI, mtx = q / (D / 64), nb = q % (D / 64); convert_item64_f8<0, false>(args.in[I_WDN] + (size_t)mtx * D * D, D, (unsigned char*)Wdn_t + (size_t)mtx * D * D, wsc_dn + (size_t)mtx * D, MX, par, nb, tid); }
            }
        }
        __syncthreads();
        {
            LAS float* S = (LAS float*)lds;
            if (ab >= 0) for (int u = ab; u < 4 * 12 * 8; u += NAUX) {
                const int kc = u & 7, cc = (u >> 3) % 12, layer = u / 96;
                __syncthreads();
                for (int i = tid; i < 128 * 20; i += NTHR) { const int k = i / 20, r = i % 20; float v = 0.f;
                    if (r < NMODROW) { const float cv = r < NB ? c_in[r * D + kc * 128 + k] : cctx_in[kc * 128 + k]; v = cv / (1.0f + __expf(-cv)); }
                    S[i] = v; }
                __syncthreads();
                const int col = cc * 512 + tid;
                const float* wp = args.in[I_WMOD] + ((size_t)layer * D + kc * 128) * MODW + col;
                float acc[20];
#pragma unroll
                for (int r = 0; r < 20; ++r) acc[r] = 0.f;
                for (int k = 0; k < 128; ++k) { const float w = wp[(size_t)k * MODW];
#pragma unroll
                    for (int q = 0; q < 5; ++q) { const f32x4 s = *(const LAS f32x4*)(S + k * 20 + 4 * q);
                        acc[4 * q] += s[0] * w; acc[4 * q + 1] += s[1] * w; acc[4 * q + 2] += s[2] * w; acc[4 * q + 3] += s[3] * w; } }
#pragma unroll
                for (int r = 0; r < NMODROW; ++r) modp[((size_t)(kc * 4 + layer) * NMODROW + r) * MODW + col] = acc[r];
            }
        }
        if (ab >= 0) for (int i = ab * NTHR + tid; i < SEQ * 32; i += NAUX * NTHR) {
            const int t = i >> 5, j = i & 31, fi = j & 15; const int pos = (j >> 4) == 0 ? (t >> 6) : (t & 63);
            const float inv = powf(10000.0f, -(float)fi / 16.0f); const float ang = (float)pos * inv;
            cosT[i] = cosf(ang); sinT[i] = sinf(ang);
        }
        {
            __syncthreads();
            LAS float* Z = (LAS float*)lds;
            LAS float* A1 = Z + 8 * 36;
            if (ab >= 0) for (int u = ab; u < 256 + 256 + 32; u += NAUX) {
                const int combo = u < 256 ? 0 : (u < 512 ? 1 : 2); const int ub = combo == 0 ? u : (combo == 1 ? u - 256 : u - 512);
                const int j = combo == 1 ? 1 : 0, Lf = combo == 2 ? CL : SEQ;
                const int tl = tid >> 6, o = tid & 63, t = ub * 8 + tl;
                __syncthreads();
                if (o < 33) { float z;
                    const float tt = (float)t / (float)(Lf - 1), w = 6.283185307179586f * (float)t / (float)Lf;
                    if (o == 0) z = tt; else { const int b = (o - 1) & 15; const float f = 1e-4f + (float)b * ((15.0f - 1e-4f) / 15.0f); z = o <= 16 ? cosf(f * w) : -sinf(f * w); }
                    Z[tl * 36 + o] = z; }
                __syncthreads();
                const float sf = args.in[I_HSF][j * 64 + o];
                { const float* w1 = args.in[I_HW1] + (size_t)j * 33 * 64; float a = args.in[I_HB1][j * 64 + o];
                  for (int i = 0; i < 33; ++i) a += Z[tl * 36 + i] * w1[i * 64 + o];
                  A1[tl * 64 + o] = sinf(sf * a); }
                __syncthreads();
                { const float* w2 = args.in[I_HW2] + (size_t)j * 64 * 64; float a = args.in[I_HB2][j * 64 + o];
                  for (int i = 0; i < 64; ++i) a += A1[tl * 64 + i] * w2[i * 64 + o];
                  a2tab[((size_t)combo * SEQ + t) * 64 + o] = sinf(sf * a); }
            }
        }
    }
    SEAMK(0, 0);

    if (EN_PRO && IN(1)) {
        for (int i = bid * NTHR + tid; i < DEPTH * NMODROW * MODW; i += G * NTHR) {
            const int layer = i / (NMODROW * MODW), rem = i % (NMODROW * MODW), col = rem % MODW; float s = args.in[I_BMOD][layer * MODW + col];
#pragma unroll
            for (int kc = 0; kc < 8; ++kc) s += modp[(size_t)(kc * 4 + layer) * NMODROW * MODW + rem];
            const int chunk = col >> 10, k = col & (D - 1);
            if (chunk == 1) s = args.in[I_N1G][layer * D + k] * (1.0f + s); else if (chunk == 4) s = args.in[I_N2G][layer * D + k] * (1.0f + s);
            modf[i] = s;
        }
        {
            LAS float* W3 = (LAS float*)lds;
            LAS float* RED = W3 + 512;
            LAS float* NRM = RED + 32;
            LAS float* HF = NRM + 4;
            for (int u = bid; u < 3 * 256; u += G) {
                const int combo = u >> 8, cg = u & 255; const int j = combo == 1 ? 1 : 0, Lf = combo == 2 ? CL : SEQ; const int c0 = cg * 4;
                LAS float* HB = HF + 4 * Lf;
                __syncthreads();
                { const int i = tid >> 3, q = tid & 7; const int col = (q >> 2) * 1024 + c0 + (q & 3);
                  W3[i * 8 + q] = args.in[I_HW3][((size_t)j * 64 + i) * 2048 + col]; }
                __syncthreads();
                float b3v[8], dec[4], asum[4] = {0.f, 0.f, 0.f, 0.f};
#pragma unroll
                for (int q = 0; q < 8; ++q) b3v[q] = args.in[I_HB3][j * 2048 + (q >> 2) * 1024 + c0 + (q & 3)];
#pragma unroll
                for (int ch = 0; ch < 4; ++ch) dec[ch] = 3.0701134573253945f + (float)(c0 + ch) * ((15.350567286626972f - 3.0701134573253945f) / 1023.0f);
                for (int t = tid; t < Lf; t += NTHR) {
                    asm volatile("" ::: "memory");
                    const float* ar = a2tab + ((size_t)combo * SEQ + t) * 64; float d[8];
#pragma unroll
                    for (int q = 0; q < 8; ++q) d[q] = b3v[q];
#pragma unroll
                    for (int i4 = 0; i4 < 16; ++i4) { const f32x4 a = *(const f32x4*)(ar + 4 * i4); asm volatile("" ::: "memory");
#pragma unroll
                        for (int e = 0; e < 4; ++e) { const f32x4 w0 = *(const LAS f32x4*)(W3 + (4 * i4 + e) * 8), w1 = *(const LAS f32x4*)(W3 + (4 * i4 + e) * 8 + 4);
                            d[0] += a[e] * w0[0]; d[1] += a[e] * w0[1]; d[2] += a[e] * w0[2]; d[3] += a[e] * w0[3]; d[4] += a[e] * w1[0]; d[5] += a[e] * w1[1]; d[6] += a[e] * w1[2]; d[7] += a[e] * w1[3]; } }
                    const float tt = (float)t / (float)(Lf - 1);
#pragma unroll
                    for (int ch = 0; ch < 4; ++ch) { const float dk = __expf(-tt * dec[ch]); const float f = d[ch] * dk, bb = d[4 + ch] * dk;
                        HF[ch * Lf + t] = f; HB[ch * Lf + t] = bb; asum[ch] += fabsf(f) + (t >= 1 ? fabsf(bb) : 0.f); }
                }
#pragma unroll
                for (int ch = 0; ch < 4; ++ch) { const float s = wave_sum(asum[ch]); if (lane == 0) RED[wave * 4 + ch] = s; }
                __syncthreads();
                if (tid < 4) { float s = 0.f; for (int w = 0; w < 8; ++w) s += RED[w * 4 + tid]; NRM[tid] = 1.0f / (s + EPS); }
                __syncthreads();
                const int P = 2 * Lf + 8, PC8 = P / 8;
                bf16_t* FI = (bf16_t*)(ws + (combo == 0 ? WS_FI0 : (combo == 1 ? WS_FI1 : WS_FI2)));
                for (int q = tid; q < 4 * PC8; q += NTHR) {
                    const int ch = q / PC8, cidx = 0, x0 = (q % PC8) * 8;
                    const float nr = NRM[ch], db = args.in[I_HDB][j * 1024 + c0 + ch]; float v[8];
#pragma unroll
                    for (int e = 0; e < 8; ++e) { const int m = Lf - (x0 + e) + cidx; const int am = m < 0 ? -m : m; float g = 0.f;
                        if (am <= Lf - 1) { g = (m >= 0 ? HF[ch * Lf + am] : HB[ch * Lf + am]) * nr; if (m == 0) g += db; }
                        v[e] = g; }
                    u32x4 o; o.x = pk2(v[0], v[1]); o.y = pk2(v[2], v[3]); o.z = pk2(v[4], v[5]); o.w = pk2(v[6], v[7]);
                    *(u32x4*)(FI + ((size_t)((c0 + ch) * 8 + cidx)) * P + x0) = o;
                }
            }
        }
    }
    SEAMK(1, 1);

    if (IN(2)) {
        const float* mo = modf;
        const int TPW = (NTOK + NGW - 1) / NGW;
        int curb = -1; f32x4 gs[4], sh[4];
        for (int ti = 0; ti < TPW; ++ti) {
            const int r = gw * TPW + ti; if (r >= NTOK) break;
            const float* src = r < NLAT ? x_in + (size_t)r * D : ctx_in + (size_t)(r - NLAT) * D;
            f32x4 v[4], h[4]; load_vec(src, lane, v);
            const int b = mod_row(r); if (b != curb) { const float* mr = mo + (size_t)b * MODW; load_vec(mr + D, lane, gs); load_vec(mr, lane, sh); curb = b; }
            norm_mod_store_f8(v, gs, sh, (unsigned char*)hA + (size_t)r * D, tsc + r, lane);
        }
    }
    SEAMK(2, 2);

    layer_body<0>(args, lds, bar, tid, lane, wave, G, bid, lo, hi);
    layer_body<1>(args, lds, bar, tid, lane, wave, G, bid, lo, hi);
    layer_body<2>(args, lds, bar, tid, lane, wave, G, bid, lo, hi);
    layer_body<3>(args, lds, bar, tid, lane, wave, G, bid, lo, hi);
#undef IN
#undef SEAM
}

extern "C" void kernel_launch(void* const* d_in, const int* in_sizes, int n_in, void* d_out, int out_size, void* d_ws, size_t ws_size, hipStream_t stream) {
    static int grid = 0;
    if (grid == 0) {
        if (n_in != 32 || out_size != NLAT * D || ws_size < WS_END) { fprintf(stderr, "kernel_launch: unexpected problem (n_in %d, out %d, ws %zu)\n", n_in, out_size, ws_size); grid = -1; return; }
        int dev = 0, cus = 0, per_cu = 0;
        if (hipGetDevice(&dev) != hipSuccess || hipDeviceGetAttribute(&cus, hipDeviceAttributeMultiprocessorCount, dev) != hipSuccess) { grid = -1; return; }
        if (hipFuncSetAttribute((const void*)fwd, hipFuncAttributeMaxDynamicSharedMemorySize, LDS_BYTES) != hipSuccess) { fprintf(stderr, "kernel_launch: hipFuncSetAttribute failed\n"); grid = -1; return; }
        if (hipOccupancyMaxActiveBlocksPerMultiprocessor(&per_cu, (const void*)fwd, NTHR, LDS_BYTES) != hipSuccess || per_cu < 1) fprintf(stderr, "kernel_launch: occupancy query says %d\n", per_cu);
        (void)hipGetLastError();
        if (cus < 256) { fprintf(stderr, "kernel_launch: built for the 256-CU MI355X (unit orders, per-wave row counts); found %d CUs; nothing launched\n", cus); grid = -1; return; }
        grid = 256;
    }
    if (grid < 0) return;
    (void)hipMemsetAsync((char*)d_ws + WS_CTL, 0, CTL_ZERO_BYTES, stream);
    Args a{};
    for (int i = 0; i < 32; ++i) a.in[i] = (const float*)d_in[i];
    a.out = (float*)d_out; a.ws = (unsigned char*)d_ws;
    constexpr int NPH = 3 + 10 * DEPTH;
#if MK_ONE_LAUNCH
    a.ph_lo = 0; a.ph_hi = NPH;
    hipLaunchKernelGGL(fwd, dim3(grid), dim3(NTHR), LDS_BYTES, stream, a);
#else
    for (int p = 0; p < NPH; ++p) {
        if (p >= 3) { const int layer = (p - 3) / 10, loc = (p - 3) % 10; if ((layer & 1) == 0 && (loc == 3 || loc == 4)) continue; }
        a.ph_lo = p; a.ph_hi = p + 1;
        hipLaunchKernelGGL(fwd, dim3(grid), dim3(NTHR), LDS_BYTES, stream, a);
    }
#endif
}
```
